# Optimizing an MI355X kernel written in HIP

```python
import math
import jax, jax.numpy as jnp
from jax import lax
import numpy as np

D_MODEL = 1024
BATCH = 8
SEQ = 4096
DEPTH = 1

CHUNK = 64
Q_BLOCK = 128
EPS = 1e-6
NEG_INF = -1e30

ATT_HEADS = 8
ATT_KV_HEADS = 2
ATT_HEAD_DIM = 64
ATT_Q_WIDTH = ATT_HEADS * ATT_HEAD_DIM
ATT_KV_WIDTH = ATT_KV_HEADS * ATT_HEAD_DIM
IDX_HEADS = 8
IDX_DIM = 32
TOPK_MAX = 256
ROPE_THETA = 500000.0
ROPE_FRACTION = 4

MLSTM_HEADS = 4
MLSTM_HEAD_DIM = 128
MLSTM_WIDTH = MLSTM_HEADS * MLSTM_HEAD_DIM
CONV_WIDTH = 4

N_GROUPS = 4
EXPERTS_PER_GROUP = 8
N_EXPERTS = N_GROUPS * EXPERTS_PER_GROUP
TOP_K_EXPERTS = 2
D_EXPERT = 512
MOE_BLOCK = 128

SPLIT_SIZES = (ATT_Q_WIDTH, ATT_KV_WIDTH, ATT_KV_WIDTH,
               IDX_HEADS * IDX_DIM, IDX_DIM, IDX_HEADS,
               MLSTM_WIDTH, MLSTM_WIDTH, MLSTM_WIDTH, MLSTM_WIDTH,
               MLSTM_HEADS, MLSTM_HEADS,
               D_MODEL, D_MODEL)
D_IN_PROJ = sum(SPLIT_SIZES)

kernel_name = 'hybrid_dsa_mlstm_hmoe_block'


def rmsnorm(x, g):
    xf = x.astype(jnp.float32)
    y = xf * lax.rsqrt(jnp.mean(xf * xf, axis=-1, keepdims=True) + EPS)
    return (y * g.astype(jnp.float32)).astype(x.dtype)


def partial_rope(t, positions):
    d = t.shape[-1]
    rot = d // ROPE_FRACTION
    half = rot // 2
    inv_freq = jnp.float32(ROPE_THETA) ** (-jnp.arange(half, dtype=jnp.float32) * 2.0 / rot)
    ang = positions.astype(jnp.float32)[..., None] * inv_freq
    ang = ang.reshape(ang.shape[:2] + (1,) * (t.ndim - 3) + (half,))
    cos, sin = jnp.cos(ang), jnp.sin(ang)
    t1 = t[..., :half].astype(jnp.float32)
    t2 = t[..., half:rot].astype(jnp.float32)
    rotated = jnp.concatenate([t1 * cos - t2 * sin, t2 * cos + t1 * sin], axis=-1).astype(t.dtype)
    return jnp.concatenate([rotated, t[..., rot:]], axis=-1)


def causal_depthwise_conv(u, w, b):
    c = u.shape[-1]
    y = lax.conv_general_dilated(u, w.astype(u.dtype)[:, None, :], window_strides=(1,),
                                 padding=[(CONV_WIDTH - 1, 0)],
                                 dimension_numbers=('NWC', 'WIO', 'NWC'),
                                 feature_group_count=c)
    return y + b.astype(u.dtype)


def dsa_attention(q, k, v, q_idx, k_idx, w_idx):
    bsz, seq = q.shape[0], q.shape[1]
    groups = ATT_KV_HEADS
    rep = ATT_HEADS // ATT_KV_HEADS
    topk = min(TOPK_MAX, seq // 4)
    nb = seq // Q_BLOCK
    key_chunk = jnp.arange(seq) // CHUNK
    idx_scale = (IDX_DIM * IDX_HEADS) ** -0.5
    att_scale = ATT_HEAD_DIM ** -0.5
    qb = q.reshape(bsz, nb, Q_BLOCK, groups, rep, ATT_HEAD_DIM).swapaxes(0, 1)
    qib = q_idx.reshape(bsz, nb, Q_BLOCK, IDX_HEADS, IDX_DIM).swapaxes(0, 1)
    wib = w_idx.reshape(bsz, nb, Q_BLOCK, IDX_HEADS).swapaxes(0, 1)

    def block(args):
        blk, q_b, qi_b, wi_b = args
        q_chunk = (blk * Q_BLOCK + jnp.arange(Q_BLOCK)) // CHUNK
        visible = key_chunk[None, :] <= q_chunk[:, None]
        rel = jax.nn.relu(jnp.einsum('bqhd,bsd->bqhs', qi_b, k_idx))
        score = jnp.einsum('bqhs,bqh->bqs', rel, wi_b).astype(jnp.float32) * idx_scale
        score = jnp.where(visible[None], score, NEG_INF)
        top_val, top_idx = lax.top_k(score, topk)
        valid = top_val > NEG_INF * 0.5
        k_sel = jax.vmap(lambda kb, ib: kb[ib])(k, top_idx)
        v_sel = jax.vmap(lambda vb, ib: vb[ib])(v, top_idx)
        logits = jnp.einsum('bqgrd,bqkgd->bqgrk', q_b, k_sel).astype(jnp.float32) * att_scale
        logits = jnp.where(valid[:, :, None, None, :], logits, NEG_INF)
        p = jax.nn.softmax(logits, axis=-1)
        return jnp.einsum('bqgrk,bqkgd->bqgrd', p.astype(v.dtype), v_sel)

    out = lax.map(block, (jnp.arange(nb), qb, qib, wib))
    return out.swapaxes(0, 1).reshape(bsz, seq, ATT_Q_WIDTH)


def mlstm_chunkwise(q, k, v, i_pre, f_pre):
    bsz, seq, nh, d = q.shape
    nc = seq // CHUNK

    def to_chunks(t):
        return t.reshape(bsz, nc, CHUNK, nh, d).transpose(1, 0, 3, 2, 4).astype(jnp.float32)

    def gate_chunks(g):
        return g.reshape(bsz, nc, CHUNK, nh).transpose(1, 0, 3, 2)

    q_c = to_chunks(q)
    k_c = to_chunks(k) * (d ** -0.5)
    v_c = to_chunks(v)
    lf_c = gate_chunks(jax.nn.log_sigmoid(f_pre))
    i_c = gate_chunks(i_pre)
    causal = jnp.tril(jnp.ones((CHUNK, CHUNK), dtype=bool))

    def step(carry, inp):
        c_st, n_st, m_st = carry
        qc, kc, vc, lf, ig = inp
        b = jnp.cumsum(lf, axis=-1)
        dmat = jnp.where(causal, b[..., :, None] - b[..., None, :] + ig[..., None, :], NEG_INF)
        inter = b + m_st[..., None]
        m_t = jnp.maximum(inter, jnp.max(dmat, axis=-1))
        w_intra = jnp.exp(dmat - m_t[..., None])
        w_inter = jnp.exp(inter - m_t)
        s = jnp.einsum('bhtd,bhsd->bhts', qc, kc) * w_intra
        num = w_inter[..., None] * jnp.einsum('bhtd,bhde->bhte', qc, c_st) + jnp.einsum('bhts,bhse->bhte', s, vc)
        den = w_inter * jnp.einsum('bhtd,bhd->bht', qc, n_st) + jnp.sum(s, axis=-1)
        h = num / jnp.maximum(jnp.abs(den), jnp.exp(-m_t))[..., None]
        b_last = b[..., -1]
        g = b_last[..., None] - b + ig
        m_new = jnp.maximum(b_last + m_st, jnp.max(g, axis=-1))
        decay = jnp.exp(b_last + m_st - m_new)
        wk = jnp.exp(g - m_new[..., None])
        c_new = decay[..., None, None] * c_st + jnp.einsum('bhs,bhsd,bhse->bhde', wk, kc, vc)
        n_new = decay[..., None] * n_st + jnp.einsum('bhs,bhsd->bhd', wk, kc)
        return (c_new, n_new, m_new), h

    init = (jnp.zeros((bsz, nh, d, d), jnp.float32), jnp.zeros((bsz, nh, d), jnp.float32),
            jnp.zeros((bsz, nh), jnp.float32))
    _, hs = lax.scan(step, init, (q_c, k_c, v_c, lf_c, i_c))
    return hs.transpose(1, 0, 3, 2, 4).reshape(bsz, seq, nh, d).astype(q.dtype)


def routed_experts(xt, expert_id, gate, w_gate, w_up, w_down):
    t, dm = xt.shape
    m = t * TOP_K_EXPERTS
    e_flat = expert_id.reshape(m)
    tok = jnp.arange(m, dtype=jnp.int32) // TOP_K_EXPERTS
    w_flat = gate.reshape(m)
    order = jnp.argsort(e_flat)
    e_sorted = e_flat[order]
    counts = jax.ops.segment_sum(jnp.ones((m,), jnp.int32), e_flat, num_segments=N_EXPERTS)
    padded = ((counts + MOE_BLOCK - 1) // MOE_BLOCK) * MOE_BLOCK
    starts = jnp.cumsum(counts) - counts
    pends = jnp.cumsum(padded)
    pstarts = pends - padded
    dest = pstarts[e_sorted] + (jnp.arange(m, dtype=jnp.int32) - starts[e_sorted])
    total = ((m + N_EXPERTS * MOE_BLOCK + MOE_BLOCK - 1) // MOE_BLOCK) * MOE_BLOCK
    nblk = total // MOE_BLOCK
    buf_tok = jnp.zeros((total,), jnp.int32).at[dest].set(tok[order])
    buf_w = jnp.zeros((total,), xt.dtype).at[dest].set(w_flat[order])
    block_e = jnp.minimum(jnp.searchsorted(pends, jnp.arange(nblk) * MOE_BLOCK, side='right'),
                          N_EXPERTS - 1)
    xb = xt[buf_tok].reshape(nblk, MOE_BLOCK, dm)

    def expert_block(args):
        xblk, e = args
        hid = jax.nn.silu(xblk @ w_gate[e]) * (xblk @ w_up[e])
        return hid @ w_down[e]

    yb = lax.map(expert_block, (xb, block_e)).reshape(total, dm)
    return jnp.zeros((t, dm), xt.dtype).at[buf_tok].add(yb * buf_w[:, None])


def hierarchical_moe(xn, w_router_group, b_router_group, w_router_expert, b_router_expert,
                     w_exp_gate, w_exp_up, w_exp_down):
    bsz, seq, dm = xn.shape
    xt = xn.reshape(bsz * seq, dm)
    g_logits = (xt @ w_router_group).astype(jnp.float32) + b_router_group.astype(jnp.float32)
    g_prob = jax.nn.softmax(g_logits, axis=-1)
    g_top_val, g_sel = lax.top_k(g_prob, 1)
    e_logits = ((xt @ w_router_expert).astype(jnp.float32) + b_router_expert.astype(jnp.float32))
    e_logits = e_logits.reshape(-1, N_GROUPS, EXPERTS_PER_GROUP)
    in_group = jnp.take_along_axis(e_logits, g_sel[:, :, None], axis=1)[:, 0]
    top_val, top_loc = lax.top_k(in_group, TOP_K_EXPERTS)
    gate = (jax.nn.softmax(top_val, axis=-1) * g_top_val).astype(xt.dtype)
    expert_id = g_sel * EXPERTS_PER_GROUP + top_loc
    y = routed_experts(xt, expert_id, gate, w_exp_gate, w_exp_up, w_exp_down)
    return y.reshape(bsz, seq, dm)


def hybrid_layer(x, positions, g_norm_mix, w_in, g_q_att, g_k_att, w_conv_mlstm, b_conv_mlstm,
                 b_igate, b_fgate, g_norm_mlstm_out, w_proj_att, w_proj_mlstm, w_out,
                 g_norm_moe, w_router_group, b_router_group, w_router_expert, b_router_expert,
                 w_exp_gate, w_exp_up, w_exp_down):
    bsz, seq, _ = x.shape
    h = rmsnorm(x, g_norm_mix)
    proj = h @ w_in
    points = np.cumsum(SPLIT_SIZES)[:-1].tolist()
    (aq, ak, av, iq, ik, iw, mq, mk, mv, mo, mi, mf, ga, gm) = jnp.split(proj, points, axis=-1)

    aq = partial_rope(rmsnorm(aq.reshape(bsz, seq, ATT_HEADS, ATT_HEAD_DIM), g_q_att), positions)
    ak = partial_rope(rmsnorm(ak.reshape(bsz, seq, ATT_KV_HEADS, ATT_HEAD_DIM), g_k_att), positions)
    av = av.reshape(bsz, seq, ATT_KV_HEADS, ATT_HEAD_DIM)
    iq = partial_rope(iq.reshape(bsz, seq, IDX_HEADS, IDX_DIM), positions)
    ik = partial_rope(ik, positions)
    y_att = dsa_attention(aq, ak, av, iq, ik, iw)

    qk = jax.nn.silu(causal_depthwise_conv(jnp.concatenate([mq, mk], axis=-1), w_conv_mlstm, b_conv_mlstm))
    mq, mk = jnp.split(qk, 2, axis=-1)
    shp = (bsz, seq, MLSTM_HEADS, MLSTM_HEAD_DIM)
    i_pre = mi.astype(jnp.float32) + b_igate.astype(jnp.float32)
    f_pre = mf.astype(jnp.float32) + b_fgate.astype(jnp.float32)
    hm = mlstm_chunkwise(mq.reshape(shp), mk.reshape(shp), mv.reshape(shp), i_pre, f_pre)
    hm = rmsnorm(hm, g_norm_mlstm_out.reshape(MLSTM_HEADS, MLSTM_HEAD_DIM)).reshape(bsz, seq, MLSTM_WIDTH)
    y_mlstm = jax.nn.sigmoid(mo) * hm

    merged = jax.nn.sigmoid(ga) * (y_att @ w_proj_att) + jax.nn.sigmoid(gm) * (y_mlstm @ w_proj_mlstm)
    x = x + merged @ w_out

    xn = rmsnorm(x, g_norm_moe)
    return x + hierarchical_moe(xn, w_router_group, b_router_group, w_router_expert, b_router_expert,
                                w_exp_gate, w_exp_up, w_exp_down)


def setup_inputs(seed: int = 0) -> dict:
    key = jax.random.key(seed)
    ks = jax.random.split(key, 24)
    L = DEPTH

    def nrm(k, shape, fan_in):
        return jax.random.normal(k, shape, jnp.float32) * (fan_in ** -0.5)

    def gain(k, shape):
        return 1.0 + 0.02 * jax.random.normal(k, shape, jnp.float32)

    def small(k, shape, scale):
        return scale * jax.random.normal(k, shape, jnp.float32)

    x = jax.random.normal(ks[0], (BATCH, SEQ, D_MODEL), jnp.float32)
    offsets = jax.random.randint(ks[1], (BATCH, 1), 0, 100000, dtype=jnp.int32)
    positions = (offsets + jnp.arange(SEQ, dtype=jnp.int32)[None, :]).astype(jnp.int32)
    return {
        'x': x,
        'positions': positions,
        'g_norm_mix': gain(ks[2], (L, D_MODEL)),
        'w_in': nrm(ks[3], (L, D_MODEL, D_IN_PROJ), D_MODEL),
        'g_q_att': gain(ks[4], (L, ATT_HEAD_DIM)),
        'g_k_att': gain(ks[5], (L, ATT_HEAD_DIM)),
        'w_conv_mlstm': nrm(ks[6], (L, CONV_WIDTH, 2 * MLSTM_WIDTH), CONV_WIDTH),
        'b_conv_mlstm': small(ks[7], (L, 2 * MLSTM_WIDTH), 0.01),
        'b_igate': -1.0 + small(ks[8], (L, MLSTM_HEADS), 0.1),
        'b_fgate': 3.0 + small(ks[9], (L, MLSTM_HEADS), 0.5),
        'g_norm_mlstm_out': gain(ks[10], (L, MLSTM_WIDTH)),
        'w_proj_att': nrm(ks[11], (L, ATT_Q_WIDTH, D_MODEL), ATT_Q_WIDTH),
        'w_proj_mlstm': nrm(ks[12], (L, MLSTM_WIDTH, D_MODEL), MLSTM_WIDTH),
        'w_out': nrm(ks[13], (L, D_MODEL, D_MODEL), D_MODEL),
        'g_norm_moe': gain(ks[14], (L, D_MODEL)),
        'w_router_group': nrm(ks[15], (L, D_MODEL, N_GROUPS), D_MODEL),
        'b_router_group': small(ks[16], (L, N_GROUPS), 0.01),
        'w_router_expert': nrm(ks[17], (L, D_MODEL, N_EXPERTS), D_MODEL),
        'b_router_expert': small(ks[18], (L, N_EXPERTS), 0.01),
        'w_exp_gate': nrm(ks[19], (L, N_EXPERTS, D_MODEL, D_EXPERT), D_MODEL),
        'w_exp_up': nrm(ks[20], (L, N_EXPERTS, D_MODEL, D_EXPERT), D_MODEL),
        'w_exp_down': nrm(ks[21], (L, N_EXPERTS, D_EXPERT, D_MODEL), D_EXPERT),
    }


def reference(x, positions, g_norm_mix, w_in, g_q_att, g_k_att, w_conv_mlstm, b_conv_mlstm,
              b_igate, b_fgate, g_norm_mlstm_out, w_proj_att, w_proj_mlstm, w_out,
              g_norm_moe, w_router_group, b_router_group, w_router_expert, b_router_expert,
              w_exp_gate, w_exp_up, w_exp_down):
    for l in range(DEPTH):
        x = hybrid_layer(x, positions, g_norm_mix[l], w_in[l], g_q_att[l], g_k_att[l],
                         w_conv_mlstm[l], b_conv_mlstm[l], b_igate[l], b_fgate[l],
                         g_norm_mlstm_out[l], w_proj_att[l], w_proj_mlstm[l], w_out[l],
                         g_norm_moe[l], w_router_group[l], b_router_group[l],
                         w_router_expert[l], b_router_expert[l],
                         w_exp_gate[l], w_exp_up[l], w_exp_down[l])
    return x
```

```cpp
#include <hip/hip_runtime.h>
#include <cstdio>
#include <cstdint>
namespace pg8 {
#define PG8_LAS __attribute__((address_space(3)))
typedef unsigned short bf16_t;
typedef short bf16x8 __attribute__((ext_vector_type(8)));
typedef float f32x4 __attribute__((ext_vector_type(4)));
typedef unsigned u32x4 __attribute__((ext_vector_type(4)));
constexpr int BM = 256, BK = 64, HALF = 128, HTB = HALF * BK * 2  , STAGE_BYTES = 8 * HTB, NXCD = 8, WGM = 8;

__host__ __device__ __forceinline__ int lds_byte(int r, int c) { const int st = (r >> 4) * 2 + (c >> 5), rr = r & 15, cc = c & 31, ob = rr * 64 + cc * 2; return st * 1024 + (ob ^ (((ob >> 9) & 1) << 5)); }
__host__ __device__ __forceinline__ void stage_rc(int b, int& R, int& C) { const int st = b / 1024, sb = b % 1024, swz = sb ^ (((sb >> 9) & 1) << 5); R = (st >> 1) * 16 + swz / 64; C = (st & 1) * 32 + (swz % 64) / 2; }
__host__ __device__ __forceinline__ int perm32(int rho) { const int n = rho >> 4, i = rho & 15; return 8 * (i >> 2) + 4 * n + (i & 3); }

struct Unit { int pm, pn; };
struct Gemm { const bf16_t* A; const bf16_t* Bt; int M, N, K; };

struct StaticOrder {
    int nM, nN, nwg, G, c;
    __host__ __device__ void init(int M, int N, int G_, int c_) { nM = M / BM; nN = N / BM; nwg = nM * nN; G = G_; c = c_; }
    __host__ __device__ bool next(int i, Unit& u) const {
        const long L = (long)i * G + c; if (L >= nwg) return false;
        int wgid = (int)L; { const int q = nwg / NXCD, r = nwg % NXCD, xcd = wgid % NXCD, off = wgid / NXCD; wgid = (xcd < r ? xcd * (q + 1) : r * (q + 1) + (xcd - r) * q) + off; }
        const int nig = WGM * nN, gid = wgid / nig, fm = gid * WGM, gsz = (nM - fm) < WGM ? (nM - fm) : WGM;
        u.pm = fm + ((wgid % nig) % gsz); u.pn = (wgid % nig) / gsz; return true;
    }
    __device__ __forceinline__ void a_ready(const Unit&) const {}
    __device__ __forceinline__ void done(const Unit&) const {}
};

typedef __bf16 bf2_t __attribute__((ext_vector_type(2)));
__device__ __forceinline__ unsigned cvt_pk_bf16(float lo, float hi) { bf2_t v; v[0] = (__bf16)lo; v[1] = (__bf16)hi; return __builtin_bit_cast(unsigned, v); }
typedef float f32x2 __attribute__((ext_vector_type(2)));
template <int ACT  > struct EpiBf16 {
    static constexpr bool PERM = true, AFTER_DRAIN = false; static_assert(ACT == 0, "EpiBf16: no activation here");
    bf16_t* O; int ldc; const float* bias; int split_cols; size_t split_stride; float scale0;
    __device__ __forceinline__ void operator()(const f32x4 (&acc)[2][2][4][2], const Unit& u, int wr, int wc, int fr, int fq) const {
        const int row0 = u.pm * BM + wr * 64 + fr; int colt = u.pn * BM; bf16_t* base = O;
        float sc = 1.f; if (split_cols) { const int t = colt / split_cols; base += (size_t)t * split_stride; colt -= t * split_cols; if (t == 0) sc = scale0; }
        const int col0 = colt + wc * 32 + 8 * fq, bcol0 = u.pn * BM + wc * 32 + 8 * fq;
        f32x4 bv[2][2];
#pragma unroll
        for (int bj = 0; bj < 2; ++bj)
#pragma unroll
            for (int n = 0; n < 2; ++n) bv[bj][n] = bias ? *(const f32x4*)(bias + bcol0 + bj * HALF + 4 * n) : (f32x4){0.f, 0.f, 0.f, 0.f};
#pragma unroll
        for (int ai = 0; ai < 2; ++ai)
#pragma unroll
            for (int m = 0; m < 4; ++m) { bf16_t* rowp = base + (size_t)(row0 + ai * HALF + m * 16) * ldc + col0;
#pragma unroll
                for (int bj = 0; bj < 2; ++bj) { f32x4 v0 = acc[ai][bj][m][0] + bv[bj][0], v1 = acc[ai][bj][m][1] + bv[bj][1];
                    v0 = v0 * sc; v1 = v1 * sc; u32x4 w; w.x = cvt_pk_bf16(v0[0], v0[1]); w.y = cvt_pk_bf16(v0[2], v0[3]); w.z = cvt_pk_bf16(v1[0], v1[1]); w.w = cvt_pk_bf16(v1[2], v1[3]);
                    *(u32x4*)(rowp + bj * HALF) = w; } }
    }
};
__device__ __forceinline__ float bf2f_(unsigned b16) { return __uint_as_float(b16 << 16); }
__device__ __forceinline__ float sigm_(float x) { return 1.0f / (1.0f + __expf(-x)); }
template <bool ADD> struct EpiGate {
    static constexpr bool PERM = true, AFTER_DRAIN = false;
    bf16_t* O; int ldc; const bf16_t* gate; size_t gstride;
    __device__ __forceinline__ void operator()(const f32x4 (&acc)[2][2][4][2], const Unit& u, int wr, int wc, int fr, int fq) const {
        const int row0 = u.pm * BM + wr * 64 + fr, colt = wc * 32 + 8 * fq;
        const bf16_t* gt = gate + (size_t)u.pn * gstride;
#pragma unroll
        for (int ai = 0; ai < 2; ++ai)
#pragma unroll
            for (int m = 0; m < 4; ++m) { const size_t row = (size_t)(row0 + ai * HALF + m * 16);
#pragma unroll
                for (int bj = 0; bj < 2; ++bj) { const int c = colt + bj * HALF;
                    const u32x4 gv = *(const u32x4*)(gt + row * 256 + c);
                    bf16_t* op = O + row * ldc + u.pn * BM + c;
                    float pv[8] = {0.f, 0.f, 0.f, 0.f, 0.f, 0.f, 0.f, 0.f};
                    if (ADD) { const u32x4 p = *(const u32x4*)op; pv[0] = bf2f_(p.x & 0xffffu); pv[1] = bf2f_(p.x >> 16); pv[2] = bf2f_(p.y & 0xffffu); pv[3] = bf2f_(p.y >> 16);
                        pv[4] = bf2f_(p.z & 0xffffu); pv[5] = bf2f_(p.z >> 16); pv[6] = bf2f_(p.w & 0xffffu); pv[7] = bf2f_(p.w >> 16); }
                    const f32x4 v0 = acc[ai][bj][m][0], v1 = acc[ai][bj][m][1];
                    float o[8];
                    o[0] = pv[0] + sigm_(bf2f_(gv.x & 0xffffu)) * v0[0]; o[1] = pv[1] + sigm_(bf2f_(gv.x >> 16)) * v0[1];
                    o[2] = pv[2] + sigm_(bf2f_(gv.y & 0xffffu)) * v0[2]; o[3] = pv[3] + sigm_(bf2f_(gv.y >> 16)) * v0[3];
                    o[4] = pv[4] + sigm_(bf2f_(gv.z & 0xffffu)) * v1[0]; o[5] = pv[5] + sigm_(bf2f_(gv.z >> 16)) * v1[1];
                    o[6] = pv[6] + sigm_(bf2f_(gv.w & 0xffffu)) * v1[2]; o[7] = pv[7] + sigm_(bf2f_(gv.w >> 16)) * v1[3];
                    u32x4 w; w.x = cvt_pk_bf16(o[0], o[1]); w.y = cvt_pk_bf16(o[2], o[3]); w.z = cvt_pk_bf16(o[4], o[5]); w.w = cvt_pk_bf16(o[6], o[7]);
                    *(u32x4*)op = w; } }
    }
};
struct EpiRes {
    static constexpr bool PERM = false, AFTER_DRAIN = false;
    float* C; const float* R; int ldc;
    __device__ __forceinline__ void operator()(const f32x4 (&acc)[2][2][4][2], const Unit& u, int wr, int wc, int fr, int fq) const {
        const int row0 = u.pm * BM + wr * 64 + fr, col0 = u.pn * BM + wc * 32 + 4 * fq;
#pragma unroll
        for (int ai = 0; ai < 2; ++ai)
#pragma unroll
            for (int m = 0; m < 4; ++m) { const size_t ro = (size_t)(row0 + ai * HALF + m * 16) * ldc + col0;
#pragma unroll
                for (int bj = 0; bj < 2; ++bj)
#pragma unroll
                    for (int n = 0; n < 2; ++n) { const size_t off = ro + bj * HALF + n * 16; *(f32x4*)(C + off) = *(const f32x4*)(R + off) + acc[ai][bj][m][n]; } }
    }
};
struct EpiSwiGLU {
    static constexpr bool PERM = true, AFTER_DRAIN = false;
    bf16_t* H;
    __device__ __forceinline__ void operator()(const f32x4 (&acc)[2][2][4][2], const Unit& u, int wr, int wc, int fr, int fq) const {
        const int row0 = u.pm * BM + wr * 64 + fr, hc = (u.pn & 3) * 128 + wc * 32 + 8 * fq;
#pragma unroll
        for (int ai = 0; ai < 2; ++ai)
#pragma unroll
            for (int m = 0; m < 4; ++m) { const size_t row = (size_t)(row0 + ai * HALF + m * 16);
                float o[8];
#pragma unroll
                for (int n = 0; n < 2; ++n)
#pragma unroll
                    for (int i = 0; i < 4; ++i) { const float g = acc[ai][0][m][n][i], up = acc[ai][1][m][n][i]; o[n * 4 + i] = g * sigm_(g) * up; }
                u32x4 w; w.x = cvt_pk_bf16(o[0], o[1]); w.y = cvt_pk_bf16(o[2], o[3]); w.z = cvt_pk_bf16(o[4], o[5]); w.w = cvt_pk_bf16(o[6], o[7]);
                *(u32x4*)(H + row * 512 + hc) = w; }
    }
};
struct EpiDown {
    static constexpr bool PERM = true, AFTER_DRAIN = false;
    bf16_t* Y;
    __device__ __forceinline__ void operator()(const f32x4 (&acc)[2][2][4][2], const Unit& u, int wr, int wc, int fr, int fq) const {
        const int row0 = u.pm * BM + wr * 64 + fr, c0 = (u.pn & 3) * 256 + wc * 32 + 8 * fq;
#pragma unroll
        for (int ai = 0; ai < 2; ++ai)
#pragma unroll
            for (int m = 0; m < 4; ++m) { const size_t row = (size_t)(row0 + ai * HALF + m * 16);
#pragma unroll
                for (int bj = 0; bj < 2; ++bj) { const f32x4 v0 = acc[ai][bj][m][0], v1 = acc[ai][bj][m][1];
                    u32x4 w; w.x = cvt_pk_bf16(v0[0], v0[1]); w.y = cvt_pk_bf16(v0[2], v0[3]); w.z = cvt_pk_bf16(v1[0], v1[1]); w.w = cvt_pk_bf16(v1[2], v1[3]);
                    *(u32x4*)(Y + row * 1024 + c0 + bj * HALF) = w; } }
    }
};
struct MoeOrder {
    const PG8_LAS int* ts; int G, c;
    __device__ __forceinline__ bool next(int i, Unit& u) const {
        const int nt = ts[32]; const long L = (long)i * G + c; if (L >= 4L * nt) return false;
        const int pm = (int)(L >> 2), j = (int)(L & 3); int e = 0;
#pragma unroll
        for (int k = 1; k < 32; ++k) e += (ts[k] <= pm) ? 1 : 0;
        u.pm = pm; u.pn = e * 4 + j; return true;
    }
    __device__ __forceinline__ void a_ready(const Unit&) const {}
    __device__ __forceinline__ void done(const Unit&) const {}
};
template <class Epi, class Sched, bool ALIGN_EPI = false, bool SP2 = false>
__device__ __forceinline__ void gemm_phase(PG8_LAS unsigned char* lds, const Gemm g, const Sched& S, const Epi& E) {
    const int tid = threadIdx.x, wid = __builtin_amdgcn_readfirstlane(tid >> 6), lane = tid & 63, wr = wid >> 2, wc = wid & 3, fr = lane & 15, fq = lane >> 4;
    const int K = g.K, nt = K / BK;
    unsigned voffA[2], voffB[2];
#pragma unroll
    for (int i = 0; i < 2; ++i) { int R, C; stage_rc(tid * 16 + i * 8192, R, C); const int Rb = Epi::PERM ? ((R & ~31) + perm32(R & 31)) : R;
        voffA[i] = (unsigned)(R * K + C) * 2u; voffB[i] = (unsigned)(Rb * K + C) * 2u; }
    const size_t kstep = (size_t)(BK * 2);
    const size_t hstep = (size_t)HALF * K * 2;
    const size_t tstep = 2 * hstep;
    const unsigned ldsw = (unsigned)wid * 1024u;
    const int aoff = lds_byte(wr * 64 + fr, fq * 8), boff = lds_byte(wc * 32 + fr, fq * 8);
#define PG8_SA(b, h) (((b) * 2 + (h)) * HTB)
#define PG8_SB(b, h) ((4 + (b) * 2 + (h)) * HTB)
#define PG8_STAGE(bufoff, gbase, voff) do { _Pragma("unroll") for (int _i = 0; _i < 2; ++_i) \
        __builtin_amdgcn_global_load_lds((const unsigned*)((const char*)(gbase) + (voff)[_i]), (PG8_LAS unsigned*)(lds + (bufoff) + ldsw + _i * 8192), 16, 0, 0); } while (0)
#define PG8_LDA(dst, b, h) do { _Pragma("unroll") for (int m = 0; m < 4; ++m) _Pragma("unroll") for (int k = 0; k < 2; ++k) dst[m][k] = *(const PG8_LAS bf16x8*)(lds + PG8_SA(b, h) + aoff + m * 2048 + k * 1024); } while (0)
#define PG8_LDB(dst, b, h) do { _Pragma("unroll") for (int n = 0; n < 2; ++n) _Pragma("unroll") for (int k = 0; k < 2; ++k) dst[n][k] = *(const PG8_LAS bf16x8*)(lds + PG8_SB(b, h) + boff + n * 2048 + k * 1024); } while (0)
#define PG8_MMA(ai, bj, At, Bt) do { __builtin_amdgcn_s_setprio(1); _Pragma("unroll") for (int m = 0; m < 4; ++m) _Pragma("unroll") for (int n = 0; n < 2; ++n) _Pragma("unroll") for (int k = 0; k < 2; ++k) \
        acc[ai][bj][m][n] = __builtin_amdgcn_mfma_f32_16x16x32_bf16(Bt[n][k], At[m][k], acc[ai][bj][m][n], 0, 0, 0); __builtin_amdgcn_s_setprio(0); } while (0)
#define PG8_WAIT_V(n) asm volatile("s_waitcnt vmcnt(" #n ")" ::: "memory")
#define PG8_WAIT_L(n) asm volatile("s_waitcnt lgkmcnt(" #n ")" ::: "memory")
#define PG8_BAR __builtin_amdgcn_s_barrier()
#define PG8_SCHED __builtin_amdgcn_sched_barrier(0)
    Unit cur, nxt; int ui = 0;
    if (!S.next(0, cur)) return;
    f32x4 acc[2][2][4][2];
#pragma unroll
    for (int a = 0; a < 2; ++a)
#pragma unroll
        for (int b = 0; b < 2; ++b)
#pragma unroll
            for (int m = 0; m < 4; ++m)
#pragma unroll
                for (int n = 0; n < 2; ++n) acc[a][b][m][n] = (f32x4){0.f, 0.f, 0.f, 0.f};
    bf16x8 At[4][2], B0[2][2], B1[2][2];
    const char* cA = (const char*)g.A + (size_t)cur.pm * tstep; const char* cB = (const char*)g.Bt + (size_t)cur.pn * tstep;
    S.a_ready(cur);
    if constexpr (SP2) {
        PG8_STAGE(PG8_SB(0, 0), cB, voffB); PG8_STAGE(PG8_SB(0, 1), cB + hstep, voffB); PG8_STAGE(PG8_SA(0, 0), cA, voffA); PG8_STAGE(PG8_SA(0, 1), cA + hstep, voffA);
        if (wr == 1) PG8_BAR;
        PG8_WAIT_V(2); PG8_BAR;
        PG8_STAGE(PG8_SB(1, 0), cB + kstep, voffB); PG8_STAGE(PG8_SA(1, 0), cA + kstep, voffA); PG8_STAGE(PG8_SB(1, 1), cB + hstep + kstep, voffB);
        PG8_WAIT_V(6); PG8_BAR;
    } else {
        PG8_STAGE(PG8_SB(0, 0), cB, voffB); PG8_STAGE(PG8_SA(0, 0), cA, voffA); PG8_STAGE(PG8_SB(0, 1), cB + hstep, voffB); PG8_STAGE(PG8_SA(0, 1), cA + hstep, voffA);
        if (wr == 1) PG8_BAR;
        PG8_WAIT_V(4); PG8_BAR;
        PG8_STAGE(PG8_SB(1, 0), cB + kstep, voffB); PG8_STAGE(PG8_SA(1, 0), cA + kstep, voffA); PG8_STAGE(PG8_SB(1, 1), cB + hstep + kstep, voffB);
        PG8_WAIT_V(6); PG8_BAR;
    }
    for (;;) {
        const bool has_next = S.next(ui + 1, nxt);
        const char* nA = has_next ? (const char*)g.A + (size_t)nxt.pm * tstep : cA; const char* nB = has_next ? (const char*)g.Bt + (size_t)nxt.pn * tstep : cB;
        for (int t = 0; t < nt; t += 2) {
            const bool last = (t == nt - 2);
            const char* a1 = cA + (size_t)(t + 1) * kstep;
            const char* a2 = last ? nA : cA + (size_t)(t + 2) * kstep; const char* b2 = last ? nB : cB + (size_t)(t + 2) * kstep;
            const char* a3 = a2 + kstep; const char* b3 = b2 + kstep;
            if (last && has_next) S.a_ready(nxt);
            if constexpr (SP2) {
            PG8_LDB(B0, 0, 0); PG8_LDB(B1, 0, 1); PG8_SCHED; PG8_LDA(At, 0, 0); PG8_STAGE(PG8_SA(1, 1), a1 + hstep, voffA);
            PG8_WAIT_V(8); PG8_WAIT_L(0); PG8_BAR; PG8_MMA(0, 0, At, B0); PG8_MMA(0, 1, At, B1); PG8_BAR; PG8_SCHED;
            PG8_LDA(At, 0, 1); PG8_STAGE(PG8_SB(0, 0), b2, voffB); PG8_STAGE(PG8_SB(0, 1), b2 + hstep, voffB); PG8_STAGE(PG8_SA(0, 0), a2, voffA);
            PG8_WAIT_V(8); PG8_WAIT_L(0); PG8_BAR; PG8_MMA(1, 0, At, B0); PG8_MMA(1, 1, At, B1); PG8_BAR; PG8_SCHED;
            PG8_LDB(B0, 1, 0); PG8_LDB(B1, 1, 1); PG8_SCHED; PG8_LDA(At, 1, 0); PG8_STAGE(PG8_SA(0, 1), a2 + hstep, voffA);
            PG8_WAIT_V(8); PG8_WAIT_L(0); PG8_BAR; PG8_MMA(0, 0, At, B0); PG8_MMA(0, 1, At, B1); PG8_BAR; PG8_SCHED;
            PG8_LDA(At, 1, 1); PG8_STAGE(PG8_SB(1, 0), b3, voffB); PG8_STAGE(PG8_SB(1, 1), b3 + hstep, voffB); PG8_STAGE(PG8_SA(1, 0), a3, voffA);
            PG8_WAIT_V(8); PG8_WAIT_L(0); PG8_BAR; PG8_MMA(1, 0, At, B0); PG8_MMA(1, 1, At, B1); PG8_BAR; PG8_SCHED;
            } else {
            PG8_LDB(B0, 0, 0); PG8_SCHED; PG8_LDA(At, 0, 0); PG8_STAGE(PG8_SA(1, 1), a1 + hstep, voffA);
            PG8_WAIT_L(8); PG8_BAR; PG8_WAIT_L(0); PG8_MMA(0, 0, At, B0); PG8_BAR; PG8_SCHED;
            PG8_LDB(B1, 0, 1); PG8_STAGE(PG8_SB(0, 0), b2, voffB);
            PG8_BAR; PG8_WAIT_L(0); PG8_MMA(0, 1, At, B1); PG8_BAR;
            PG8_LDA(At, 0, 1); PG8_STAGE(PG8_SA(0, 0), a2, voffA);
            PG8_BAR; PG8_WAIT_L(0); PG8_MMA(1, 0, At, B0); PG8_BAR; PG8_SCHED;
            PG8_STAGE(PG8_SB(0, 1), b2 + hstep, voffB);
            PG8_WAIT_V(6); PG8_BAR; PG8_MMA(1, 1, At, B1); PG8_BAR;
            PG8_LDB(B0, 1, 0); PG8_SCHED; PG8_LDA(At, 1, 0); PG8_STAGE(PG8_SA(0, 1), a2 + hstep, voffA);
            PG8_WAIT_L(8); PG8_BAR; PG8_WAIT_L(0); PG8_MMA(0, 0, At, B0); PG8_BAR; PG8_SCHED;
            PG8_LDB(B1, 1, 1); PG8_STAGE(PG8_SB(1, 0), b3, voffB);
            PG8_BAR; PG8_WAIT_L(0); PG8_MMA(0, 1, At, B1); PG8_BAR;
            PG8_LDA(At, 1, 1); PG8_STAGE(PG8_SA(1, 0), a3, voffA);
            PG8_BAR; PG8_WAIT_L(0); PG8_MMA(1, 0, At, B0); PG8_BAR; PG8_SCHED;
            PG8_STAGE(PG8_SB(1, 1), b3 + hstep, voffB);
            PG8_WAIT_V(6); PG8_BAR; PG8_MMA(1, 1, At, B1); PG8_BAR;
            }
        }
        if constexpr (ALIGN_EPI) { if (wr == 0) PG8_BAR; }
        if constexpr (!Epi::AFTER_DRAIN) { E(acc, cur, wr, wc, fr, fq); S.done(cur); }
        if (!has_next) break;
#pragma unroll
        for (int a = 0; a < 2; ++a)
#pragma unroll
            for (int b = 0; b < 2; ++b)
#pragma unroll
                for (int m = 0; m < 4; ++m)
#pragma unroll
                    for (int n = 0; n < 2; ++n) acc[a][b][m][n] = (f32x4){0.f, 0.f, 0.f, 0.f};
        cur = nxt; cA = nA; cB = nB; ++ui;
        if constexpr (ALIGN_EPI) { if (wr == 1) PG8_BAR; }
    }
    PG8_WAIT_V(0);
    if constexpr (!ALIGN_EPI) { if (wr == 0) PG8_BAR; }
    PG8_BAR;
    if constexpr (Epi::AFTER_DRAIN) { E.fused(acc, cur, wr, wc, fr, fq, lds, wid, lane); S.done(cur); }
#undef PG8_SA
#undef PG8_SB
#undef PG8_STAGE
#undef PG8_LDA
#undef PG8_LDB
#undef PG8_MMA
#undef PG8_WAIT_V
#undef PG8_WAIT_L
#undef PG8_BAR
#undef PG8_SCHED
}
}
constexpr int NWAVES = 8;
constexpr int BATCH = 8, SEQ = 4096, D = 1024, T = BATCH * SEQ;
constexpr int NPROJ = 5376;
constexpr int NTILE = NPROJ / 256;
constexpr float EPS = 1e-6f;
#ifndef MK_N_LAUNCHES
#define MK_N_LAUNCHES 1
#endif
#ifndef DBG_NPH
#define DBG_NPH 11
#endif
constexpr int NPH = DBG_NPH;
constexpr int N_LAUNCHES = MK_N_LAUNCHES;
static_assert(N_LAUNCHES == 1 || N_LAUNCHES == NPH, "MK_N_LAUNCHES is 1 or NPH");

constexpr size_t MiB = 1u << 20;
constexpr size_t WS_CTL = 0, CTL_ZERO_BYTES = 1 * MiB;
constexpr size_t WS_SMALL = 1 * MiB;
constexpr size_t WS_WIN = 2 * MiB;
constexpr size_t WS_WPA = 13 * MiB, WS_WPM = 14 * MiB, WS_WOUT = 15 * MiB;
constexpr size_t WS_TOKE = 17 * MiB;
constexpr size_t WS_TOKR = WS_TOKE + 256 * 1024;
constexpr size_t WS_TOKP = WS_TOKR + 256 * 1024;
constexpr size_t WS_TOKG = WS_TOKP + 256 * 1024;
constexpr size_t WS_CNT = WS_TOKG + 256 * 1024;
constexpr size_t WS_GU = 20 * MiB;
constexpr size_t WS_DN = 84 * MiB;
constexpr size_t WS_PROJ = 116 * MiB;
constexpr size_t PROJ_TILE = (size_t)T * 256 * 2;
constexpr size_t WS_MERGED = 116 * MiB;
constexpr size_t WS_XN = 180 * MiB;
constexpr size_t WS_XG = 244 * MiB;
constexpr size_t WS_HID = 388 * MiB;
constexpr size_t WS_Y = 244 * MiB;
constexpr size_t WS_END = 460 * MiB;
static_assert(WS_PROJ + NTILE * PROJ_TILE == 452 * MiB, "proj map");
constexpr size_t DO_H = 0, DO_YATT = 0, DO_YML = 32 * MiB, DO_KN = 64 * MiB, DO_IKR = 72 * MiB, DO_IQR = 74 * MiB, DO_AQN = 90 * MiB;
constexpr int TL_AQ = 0, TL_KV = 2, TL_IQ = 3, TL_SM = 4, TL_MQ = 5, TL_MK = 7, TL_MV = 9, TL_MO = 11, TL_GA = 13, TL_GM = 17;
constexpr int CW_BAR = 4096;
constexpr int CW_Q = 16384;
constexpr int LDS_BYTES = 163840, MISC_OFF = LDS_BYTES - 512;

#define GAS __attribute__((address_space(1)))
#define LAS __attribute__((address_space(3)))
typedef unsigned short bf16;
typedef unsigned v4u __attribute__((ext_vector_type(4)));
typedef unsigned v2u __attribute__((ext_vector_type(2)));
typedef float f32x4 __attribute__((ext_vector_type(4)));
typedef float f32x2 __attribute__((ext_vector_type(2)));
typedef short bf16x8 __attribute__((ext_vector_type(8)));
typedef GAS unsigned gu32;
#define RLX_AGENT __ATOMIC_RELAXED, __HIP_MEMORY_SCOPE_AGENT
#define LDS_WAIT() asm volatile("s_waitcnt lgkmcnt(0)" ::: "memory")
__device__ __forceinline__ float bf2f(unsigned b16) { return __uint_as_float(b16 << 16); }
__device__ __forceinline__ unsigned f2bf(float f) { unsigned u = __float_as_uint(f); return (u + 0x7fffu + ((u >> 16) & 1u)) >> 16; }
__device__ __forceinline__ unsigned pk2(float lo, float hi) { return pg8::cvt_pk_bf16(lo, hi); }
__device__ __forceinline__ float sigm(float x) { return 1.0f / (1.0f + __expf(-x)); }
__device__ __forceinline__ float wave_sum(float v) {
#pragma unroll
    for (int o = 1; o < 64; o <<= 1) v += __shfl_xor(v, o);
    return v;
}
__device__ __forceinline__ void unpack8(const v4u r, float (&f)[8]) {
    f[0] = bf2f(r.x & 0xffffu); f[1] = bf2f(r.x >> 16); f[2] = bf2f(r.y & 0xffffu); f[3] = bf2f(r.y >> 16);
    f[4] = bf2f(r.z & 0xffffu); f[5] = bf2f(r.z >> 16); f[6] = bf2f(r.w & 0xffffu); f[7] = bf2f(r.w >> 16);
}
__device__ __forceinline__ v4u pack8(const float (&f)[8]) { v4u w; w.x = pk2(f[0], f[1]); w.y = pk2(f[2], f[3]); w.z = pk2(f[4], f[5]); w.w = pk2(f[6], f[7]); return w; }
#define XB_TMO      128
#define XB_XCNT(j)  (256  + 64 * (j))
#define XB_XSUB(j)  (1280 + 64 * (j))
#define XB_XGEN(j)  (2304 + 64 * (j))
#define XB_TOP      3328
#define XB_TOPGEN   3392
#define XCD_BAR_WORDS 3456
#define XB_SPIN_CAP (1u << 18)

__device__ __forceinline__ unsigned xb_ld(unsigned* p)              { return __hip_atomic_load(p, __ATOMIC_RELAXED, __HIP_MEMORY_SCOPE_AGENT); }
__device__ __forceinline__ unsigned xb_add(unsigned* p, unsigned v) { return __hip_atomic_fetch_add(p, v, __ATOMIC_RELAXED, __HIP_MEMORY_SCOPE_AGENT); }
__device__ __forceinline__ unsigned xb_xcc_id() { return (unsigned)__builtin_amdgcn_s_getreg((3 << 11) | 20) & 0xFu; }
#define XB_SPIN(cond, bar) do { unsigned _sp = 0; while (cond) { __builtin_amdgcn_s_sleep(1); \
    if ((++_sp & 255u) == 0u) { if (xb_ld(&(bar)[XB_TMO])) break; if (_sp > XB_SPIN_CAP) { atomicAdd(&(bar)[XB_TMO], 1u); break; } } } } while (0)

struct XcdBarrier {
    unsigned* bar; unsigned x;
    volatile LAS unsigned* st;
};

__device__ __forceinline__ XcdBarrier xcd_barrier_post(unsigned* bar, volatile LAS unsigned* st) {
    XcdBarrier b; b.bar = bar; b.x = xb_xcc_id(); b.st = st;
    if (threadIdx.x == 0) (void)xb_add(&bar[XB_XCNT(b.x)], 1u);
    return b;
}
__device__ __forceinline__ void xcd_barrier_complete(unsigned* bar, unsigned x, unsigned& nloc, unsigned& nx) {
    const unsigned G = gridDim.x * gridDim.y * gridDim.z;
    unsigned sum, cnt, mine, sp = 0u;
    for (;;) {
        sum = 0u; cnt = 0u; mine = 0u;
#pragma unroll
        for (unsigned j = 0; j < 16; ++j) { const unsigned c = xb_ld(&bar[XB_XCNT(j)]); sum += c; cnt += (c > 0u) ? 1u : 0u; mine = (j == x) ? c : mine; }
        if (sum == G) break;
        __builtin_amdgcn_s_sleep(1);
        if ((++sp & 255u) == 0u) { if (xb_ld(&bar[XB_TMO])) break; if (sp > XB_SPIN_CAP) { atomicAdd(&bar[XB_TMO], 1u); break; } }
    }
    nloc = mine > 0u ? mine : 1u; nx = cnt > 0u ? cnt : 1u;
}

__device__ __forceinline__ void xcd_barrier(const XcdBarrier& b) {
    asm volatile("s_waitcnt vmcnt(0)" ::: "memory");
    __syncthreads();
    if (threadIdx.x == 0) {
        unsigned* bar = b.bar;
        __builtin_amdgcn_s_waitcnt(0);
        unsigned nloc = b.st[0], nx = b.st[1];
        if (nloc == 0u) { xcd_barrier_complete(bar, b.x, nloc, nx); b.st[0] = nloc; b.st[1] = nx; }
        const unsigned old = xb_add(&bar[XB_XSUB(b.x)], 1u);
        const unsigned gen = old / nloc;
        if (old + 1u == (gen + 1u) * nloc) {
            __builtin_amdgcn_fence(__ATOMIC_RELEASE, "agent");
            asm volatile("s_waitcnt vmcnt(0)" ::: "memory");
            const unsigned og = xb_add(&bar[XB_TOP], 1u);
            const unsigned tg = og / nx;
            if (og + 1u == (tg + 1u) * nx) xb_add(&bar[XB_TOPGEN], 1u);
            else XB_SPIN(xb_ld(&bar[XB_TOPGEN]) == tg, bar);
            __builtin_amdgcn_fence(__ATOMIC_ACQUIRE, "agent");
            xb_add(&bar[XB_XGEN(b.x)], 1u);
            asm volatile("s_waitcnt vmcnt(0)" ::: "memory");
        } else {
            XB_SPIN(xb_ld(&bar[XB_XGEN(b.x)]) == gen, bar);
            __builtin_amdgcn_fence(__ATOMIC_ACQUIRE, "agent");
            asm volatile("s_waitcnt vmcnt(0)" ::: "memory");
        }
    }
    __syncthreads();
}
struct Args { const float* in[22]; float* out; unsigned char* ws; int ph_lo, ph_hi, li, pad; };
struct Ctx { int tid, lane, wave, G, vcu; LAS unsigned char* lds; };
#define IN_X 0
#define IN_POS 1
#define IN_GMIX 2
#define IN_WIN 3
#define IN_GQ 4
#define IN_GK 5
#define IN_WCONV 6
#define IN_BCONV 7
#define IN_BI 8
#define IN_BF 9
#define IN_GML 10
#define IN_WPA 11
#define IN_WPM 12
#define IN_WOUT 13
#define IN_GMOE 14
#define IN_WRG 15
#define IN_BRG 16
#define IN_WRE 17
#define IN_BRE 18
#define IN_WEG 19
#define IN_WEU 20
#define IN_WED 21

__device__ __forceinline__ int win_src_col(int n) {
    if (n < 1064) return n;
    if (n < 1068) return 3112 + (n - 1064);
    if (n < 1072) return 3116 + (n - 1068);
    if (n < 1280) return -1;
    if (n < 3328) return n - 216;
    return n - 208;
}
__device__ __forceinline__ void tr_item(const float* W, int ldw, int scol, int k0, bf16* wt0, int K, LAS float* scr, int lane) {
#pragma unroll 8
    for (int i = 0; i < 32; ++i) { const int kk = 2 * i + (lane >> 5); scr[kk * 33 + (lane & 31)] = scol >= 0 ? W[(size_t)(k0 + kk) * ldw + scol] : 0.f; }
    LDS_WAIT(); asm volatile("" ::: "memory");
    const int c = lane & 7;
#pragma unroll
    for (int j = 0; j < 4; ++j) { const int n = (lane >> 3) + 8 * j; const LAS float* s = scr + (8 * c) * 33 + n;
        v4u o; o.x = pk2(s[0 * 33], s[1 * 33]); o.y = pk2(s[2 * 33], s[3 * 33]); o.z = pk2(s[4 * 33], s[5 * 33]); o.w = pk2(s[6 * 33], s[7 * 33]);
        *(v4u*)(wt0 + (size_t)n * K + 8 * c) = o; }
    LDS_WAIT(); asm volatile("" ::: "memory");
}
__device__ __forceinline__ void p0_prologue(const Args& a, const Ctx& c) {
    unsigned char* ws = a.ws;
    LAS float* scr = (LAS float*)(c.lds + c.wave * 16384);
    const int gw = c.vcu * NWAVES + c.wave, NGW = c.G * NWAVES, lane = c.lane;
    constexpr int I_IN = 16 * 168, I_PA = 8 * 32, I_PM = 8 * 32, I_OUT = 16 * 32, I_GU = 32 * 16 * 32, I_DN = 32 * 8 * 32;
    constexpr int NIT = I_IN + I_PA + I_PM + I_OUT + I_GU + I_DN;
    for (int it = gw; it < NIT; it += NGW) {
        int r = it;
        if (r < I_IN) { const int kb = r / 168, nb = r % 168; tr_item(a.in[IN_WIN], 5168, win_src_col(32 * nb + (lane & 31)), 64 * kb, (bf16*)(ws + WS_WIN) + (size_t)(32 * nb) * 1024 + 64 * kb, 1024, scr, lane); continue; } r -= I_IN;
        if (r < I_PA) { const int kb = r / 32, nb = r % 32; tr_item(a.in[IN_WPA], 1024, 32 * nb + (lane & 31), 64 * kb, (bf16*)(ws + WS_WPA) + (size_t)(32 * nb) * 512 + 64 * kb, 512, scr, lane); continue; } r -= I_PA;
        if (r < I_PM) { const int kb = r / 32, nb = r % 32; tr_item(a.in[IN_WPM], 1024, 32 * nb + (lane & 31), 64 * kb, (bf16*)(ws + WS_WPM) + (size_t)(32 * nb) * 512 + 64 * kb, 512, scr, lane); continue; } r -= I_PM;
        if (r < I_OUT) { const int kb = r / 32, nb = r % 32; tr_item(a.in[IN_WOUT], 1024, 32 * nb + (lane & 31), 64 * kb, (bf16*)(ws + WS_WOUT) + (size_t)(32 * nb) * 1024 + 64 * kb, 1024, scr, lane); continue; } r -= I_OUT;
        if (r < I_GU) { const int e = r / 512, q = r % 512, kb = q / 32, nb = q % 32, t = nb >> 3, bj = (nb >> 2) & 1, i0 = (nb & 3) * 32;
            const float* src = (bj ? a.in[IN_WEU] : a.in[IN_WEG]) + (size_t)e * 1024 * 512;
            tr_item(src, 512, 128 * t + i0 + (lane & 31), 64 * kb, (bf16*)(ws + WS_GU) + ((size_t)e * 1024 + 32 * nb) * 1024 + 64 * kb, 1024, scr, lane); continue; } r -= I_GU;
        { const int e = r / 256, q = r % 256, kb = q / 32, nb = q % 32;
            tr_item(a.in[IN_WED] + (size_t)e * 512 * 1024, 1024, 32 * nb + (lane & 31), 64 * kb, (bf16*)(ws + WS_DN) + ((size_t)e * 1024 + 32 * nb) * 512 + 64 * kb, 512, scr, lane); }
    }
    const float* g = a.in[IN_GMIX]; f32x4 gv[4];
#pragma unroll
    for (int j = 0; j < 4; ++j) gv[j] = *(const f32x4*)(g + 4 * lane + 256 * j);
    bf16* H = (bf16*)((unsigned char*)a.out + DO_H);
    for (int m = gw; m < T; m += NGW) {
        const f32x4* xr = (const f32x4*)(a.in[IN_X] + (size_t)m * D) + lane; f32x4 v[4]; float s = 0.f;
#pragma unroll
        for (int j = 0; j < 4; ++j) { v[j] = xr[64 * j]; s += (v[j].x * v[j].x + v[j].y * v[j].y) + (v[j].z * v[j].z + v[j].w * v[j].w); }
        const float r = rsqrtf(wave_sum(s) * (1.f / D) + EPS);
        v2u* o8 = (v2u*)(H + (size_t)m * D) + lane;
#pragma unroll
        for (int j = 0; j < 4; ++j) { v2u w; w.x = pk2(v[j].x * r * gv[j].x, v[j].y * r * gv[j].y); w.y = pk2(v[j].z * r * gv[j].z, v[j].w * r * gv[j].w); o8[64 * j] = w; }
    }
}

__device__ __forceinline__ const bf16* proj_tile(const Args& a, int tile) { return (const bf16*)(a.ws + WS_PROJ + (size_t)tile * PROJ_TILE); }
__device__ __forceinline__ void p2_prep(const Args& a, const Ctx& c) {
    const int lane = c.lane, gw = c.vcu * NWAVES + c.wave, NGW = c.G * NWAVES;
    float invf = 0.f;
    if (lane < 8) invf = (float)pow(500000.0, -(double)lane / 8.0); else if (lane < 12) invf = (float)pow(500000.0, -(double)(lane - 8) / 4.0);
    float gq[8], gk[8];
#pragma unroll
    for (int i = 0; i < 8; ++i) { gq[i] = a.in[IN_GQ][8 * (lane & 7) + i]; gk[i] = a.in[IN_GK][8 * (lane & 7) + i]; }
    const int* pos = (const int*)a.in[IN_POS];
    unsigned char* dout = (unsigned char*)a.out;
    bf16* AQN = (bf16*)(dout + DO_AQN); bf16* KN = (bf16*)(dout + DO_KN); bf16* IQR = (bf16*)(dout + DO_IQR); bf16* IKR = (bf16*)(dout + DO_IKR);
    const int l7 = lane & 7;
    for (int t = gw; t < T; t += NGW) {
        const float ang = (float)pos[t] * invf;
        float cs = (float)cos((double)ang), sn = (float)sin((double)ang);
        float ca[8], sa[8], ci[4], si[4];
#pragma unroll
        for (int i = 0; i < 8; ++i) { ca[i] = __shfl(cs, i); sa[i] = __shfl(sn, i); }
#pragma unroll
        for (int i = 0; i < 4; ++i) { ci[i] = __shfl(cs, 8 + i); si[i] = __shfl(sn, 8 + i); }
        { const int col = (lane >> 3) * 64 + 8 * l7; const bf16* src = proj_tile(a, TL_AQ + (col >> 8)) + (size_t)t * 256 + (col & 255);
          float f[8]; unpack8(*(const v4u*)src, f); float ss = 0.f;
#pragma unroll
          for (int i = 0; i < 8; ++i) ss += f[i] * f[i];
          ss += __shfl_xor(ss, 1); ss += __shfl_xor(ss, 2); ss += __shfl_xor(ss, 4);
          const float r = rsqrtf(ss * (1.f / 64.f) + EPS);
#pragma unroll
          for (int i = 0; i < 8; ++i) f[i] = f[i] * r * gq[i];
          float o[8];
#pragma unroll
          for (int i = 0; i < 8; ++i) { const float p = __shfl_xor(f[i], 1); o[i] = (l7 == 0) ? (f[i] * ca[i] - p * sa[i]) : ((l7 == 1) ? (f[i] * ca[i] + p * sa[i]) : f[i]); o[i] *= 0.125f; }
          *(v4u*)(AQN + (size_t)t * 512 + col) = pack8(o); }
        { const int l15 = lane & 15; const int col = (l15 >> 3) * 64 + 8 * l7; const bf16* src = proj_tile(a, TL_KV) + (size_t)t * 256 + col;
          float f[8]; unpack8(*(const v4u*)src, f); float ss = 0.f;
#pragma unroll
          for (int i = 0; i < 8; ++i) ss += f[i] * f[i];
          ss += __shfl_xor(ss, 1); ss += __shfl_xor(ss, 2); ss += __shfl_xor(ss, 4);
          const float r = rsqrtf(ss * (1.f / 64.f) + EPS);
#pragma unroll
          for (int i = 0; i < 8; ++i) f[i] = f[i] * r * gk[i];
          float o[8];
#pragma unroll
          for (int i = 0; i < 8; ++i) { const float p = __shfl_xor(f[i], 1); o[i] = (l7 == 0) ? (f[i] * ca[i] - p * sa[i]) : ((l7 == 1) ? (f[i] * ca[i] + p * sa[i]) : f[i]); }
          if (lane < 16) *(v4u*)(KN + (size_t)t * 128 + col) = pack8(o); }
        { const bf16* src = proj_tile(a, TL_IQ) + (size_t)t * 256 + 4 * lane; const v2u rw = *(const v2u*)src;
          float f[4] = {bf2f(rw.x & 0xffffu), bf2f(rw.x >> 16), bf2f(rw.y & 0xffffu), bf2f(rw.y >> 16)}; float o[4];
#pragma unroll
          for (int i = 0; i < 4; ++i) { const float p = __shfl_xor(f[i], 1); o[i] = (l7 == 0) ? (f[i] * ci[i] - p * si[i]) : ((l7 == 1) ? (f[i] * ci[i] + p * si[i]) : f[i]); }
          v2u w; w.x = pk2(o[0], o[1]); w.y = pk2(o[2], o[3]); *(v2u*)(IQR + (size_t)t * 256 + 4 * lane) = w; }
        { const bf16* src = proj_tile(a, TL_SM) + (size_t)t * 256 + 4 * l7; const v2u rw = *(const v2u*)src;
          float f[4] = {bf2f(rw.x & 0xffffu), bf2f(rw.x >> 16), bf2f(rw.y & 0xffffu), bf2f(rw.y >> 16)}; float o[4];
#pragma unroll
          for (int i = 0; i < 4; ++i) { const float p = __shfl_xor(f[i], 1); o[i] = (l7 == 0) ? (f[i] * ci[i] - p * si[i]) : ((l7 == 1) ? (f[i] * ci[i] + p * si[i]) : f[i]); }
          v2u w; w.x = pk2(o[0], o[1]); w.y = pk2(o[2], o[3]); if (lane < 8) *(v2u*)(IKR + (size_t)t * 32 + 4 * l7) = w; }
    }
}
constexpr int ML_QS = 0, ML_KS = 17408, ML_HS = 0;
constexpr int ML_KWT = 34816;
constexpr int ML_VT = 53248;
constexpr int ML_SW = 73984;
constexpr int ML_CT = 83200;
constexpr int ML_GA = 122368;
constexpr int ML_CW = ML_GA + 1024;
constexpr int ML_END = ML_CW + (1024 + 384) * 4;
static_assert(ML_END <= MISC_OFF, "mLSTM LDS map");
__device__ __forceinline__ bf16x8 lds_frag(const LAS unsigned char* base, int stride_b, int row0, int kb, int lane) {
    return *(const LAS bf16x8*)(base + (row0 + (lane & 15)) * stride_b + kb + (lane >> 4) * 16);
}
__device__ __forceinline__ bf16x8 lds_frag_sw(const LAS unsigned char* base, int row0, int ks, int lane) {
    const int row = row0 + (lane & 15); return *(const LAS bf16x8*)(base + row * 144 + 16 * (((ks * 4 + (lane >> 4)) + (row >> 3)) & 7));
}
#define MFMA16(a_, b_, c_) __builtin_amdgcn_mfma_f32_16x16x32_bf16(a_, b_, c_, 0, 0, 0)
__device__ __forceinline__ void mlstm_unit(const Args& a, const Ctx& c, int b, int h) {
    const int tid = c.tid, wave = c.wave; LAS unsigned char* lds = c.lds;
#define ML_LAUNDER() int tv_ = tid; asm volatile("" : "+v"(tv_)); const int lane = tv_ & 63, seg = tv_ & 15, r2 = (tv_ >> 4) * 2; (void)lane; (void)seg; (void)r2
    const bf16* PQ = proj_tile(a, TL_MQ + (h >> 1)) + (h & 1) * 128;
    const bf16* PK = proj_tile(a, TL_MK + (h >> 1)) + (h & 1) * 128;
    const bf16* PV = proj_tile(a, TL_MV + (h >> 1)) + (h & 1) * 128;
    const bf16* PO = proj_tile(a, TL_MO + (h >> 1)) + (h & 1) * 128;
    const bf16* PS = proj_tile(a, TL_SM);
    bf16* YML = (bf16*)((unsigned char*)a.out + DO_YML);
    LAS float* GAa = (LAS float*)(lds + ML_GA); LAS float* GAm = GAa + 64; LAS float* GAw = GAa + 128; LAS float* GAe = GAa + 192;
    LAS float* CWQ = (LAS float*)(lds + ML_CW); LAS float* CWK = CWQ + 512; LAS float* CBQ = CWQ + 1024; LAS float* CBK = CBQ + 128; LAS float* GN = CBK + 128;
    LAS bf16* VTs = (LAS bf16*)(lds + ML_VT);
    { const float* wc = a.in[IN_WCONV]; const int j = tid >> 7, d = tid & 127;
      CWQ[tid] = wc[j * 1024 + h * 128 + d]; CWK[tid] = wc[j * 1024 + 512 + h * 128 + d];
      if (tid < 128) { CBQ[tid] = a.in[IN_BCONV][h * 128 + tid]; CBK[tid] = a.in[IN_BCONV][512 + h * 128 + tid]; GN[tid] = a.in[IN_GML][h * 128 + tid]; } }
    for (int i = tid; i < 16 * 64; i += 512) { const int r = i >> 6, cc = i & 63; VTs[(128 + r) * 72 + cc] = (r == 0) ? (bf16)0x3F80 : (bf16)0; }
    for (int i = tid; i < 144 * 136 / 2; i += 512) ((LAS unsigned*)(lds + ML_CT))[i] = 0u;
    const float big = a.in[IN_BI][h], bfg = a.in[IN_BF][h];
    f32x4 cacc[9];
#pragma unroll
    for (int i = 0; i < 9; ++i) cacc[i] = (f32x4){0.f, 0.f, 0.f, 0.f};
    float m_st = 0.f;
    const size_t tb = (size_t)b * SEQ;
    const char* bq = (const char*)(PQ + tb * 256); const char* bk = (const char*)(PK + tb * 256); const char* bv = (const char*)(PV + tb * 256); const char* bo = (const char*)(PO + tb * 256); const char* bs = (const char*)(PS + tb * 256);
    v4u rq[5], rk[5], rv[2]; unsigned short gi = 0, gf = 0;
#define ML_LOAD(kc) do { _Pragma("unroll") for (int j_ = 0; j_ < 5; ++j_) { const int rr_ = 64 * (kc) + r2 - 3 + j_; const unsigned o_ = (unsigned)((rr_ < 0 ? 0 : rr_) * 512 + seg * 16); \
            v4u q_ = *(const v4u*)(bq + o_), k_ = *(const v4u*)(bk + o_); if (rr_ < 0) { q_ = (v4u){0u, 0u, 0u, 0u}; k_ = q_; } rq[j_] = q_; rk[j_] = k_; } \
        _Pragma("unroll") for (int i_ = 0; i_ < 2; ++i_) rv[i_] = *(const v4u*)(bv + (unsigned)((64 * (kc) + r2 + i_) * 512 + seg * 16)); \
        gi = *(const unsigned short*)(bs + (unsigned)((64 * (kc) + lane) * 512 + (40 + h) * 2)); gf = *(const unsigned short*)(bs + (unsigned)((64 * (kc) + lane) * 512 + (44 + h) * 2)); } while (0)
    { ML_LAUNDER(); ML_LOAD(0); }
    __syncthreads();
#pragma unroll 1
    for (int kc = 0; kc < 64; ++kc) {
        float wkv, decay, m_new;
        { ML_LAUNDER();
        const float fpre = bf2f(gf) + bfg, lf = fminf(fpre, 0.f) - log1pf(__expf(-fabsf(fpre)));
        const float ig = bf2f(gi) + big;
        float bc = lf;
#pragma unroll
        for (int o = 1; o < 64; o <<= 1) { const float v = __shfl_up(bc, o); if (lane >= o) bc += v; }
        const float av = ig - bc; float Ac = av;
#pragma unroll
        for (int o = 1; o < 64; o <<= 1) { const float v = __shfl_up(Ac, o); if (lane >= o) Ac = fmaxf(Ac, v); }
        const float mA = fmaxf(m_st, Ac), Mk = __shfl(mA, 63), blast = __shfl(bc, 63);
        wkv = __expf(av - Mk); decay = __expf(m_st - Mk); m_new = blast + Mk;
        if (wave == 0) { GAa[lane] = av; GAm[lane] = mA; GAw[lane] = __expf(m_st - mA); GAe[lane] = __expf(-(bc + mA)); } }
        { ML_LAUNDER(); float kw_[2][8];
#pragma unroll
          for (int i = 0; i < 2; ++i) { const int t = r2 + i; const float wkt = __shfl(wkv, t);
            float aq_[8], ak_[8];
            { const f32x4 b0 = *(const LAS f32x4*)(CBQ + seg * 8), b1 = *(const LAS f32x4*)(CBQ + seg * 8 + 4), c0 = *(const LAS f32x4*)(CBK + seg * 8), c1 = *(const LAS f32x4*)(CBK + seg * 8 + 4);
              aq_[0] = b0[0]; aq_[1] = b0[1]; aq_[2] = b0[2]; aq_[3] = b0[3]; aq_[4] = b1[0]; aq_[5] = b1[1]; aq_[6] = b1[2]; aq_[7] = b1[3];
              ak_[0] = c0[0]; ak_[1] = c0[1]; ak_[2] = c0[2]; ak_[3] = c0[3]; ak_[4] = c1[0]; ak_[5] = c1[1]; ak_[6] = c1[2]; ak_[7] = c1[3]; }
#pragma unroll
            for (int j = 0; j < 4; ++j) { float fq_[8], fk_[8]; unpack8(rq[i + j], fq_); unpack8(rk[i + j], fk_);
                const f32x4 w0 = *(const LAS f32x4*)(CWQ + j * 128 + seg * 8), w1 = *(const LAS f32x4*)(CWQ + j * 128 + seg * 8 + 4), x0 = *(const LAS f32x4*)(CWK + j * 128 + seg * 8), x1 = *(const LAS f32x4*)(CWK + j * 128 + seg * 8 + 4);
#pragma unroll
                for (int e = 0; e < 4; ++e) { aq_[e] += w0[e] * fq_[e]; aq_[4 + e] += w1[e] * fq_[4 + e]; ak_[e] += x0[e] * fk_[e]; ak_[4 + e] += x1[e] * fk_[4 + e]; } }
#pragma unroll
            for (int e = 0; e < 8; ++e) { aq_[e] = aq_[e] * sigm(aq_[e]); ak_[e] = ak_[e] * sigm(ak_[e]) * 0.08838834764831845f; kw_[i][e] = ak_[e] * wkt; }
            *(LAS v4u*)(lds + ML_QS + t * 272 + seg * 16) = pack8(aq_);
            *(LAS v4u*)(lds + ML_KS + t * 272 + seg * 16) = pack8(ak_); }
          const unsigned va[4] = {rv[0].x, rv[0].y, rv[0].z, rv[0].w}, vb[4] = {rv[1].x, rv[1].y, rv[1].z, rv[1].w};
          const int swo = 16 * (((r2 >> 3) + seg) & 7) + 2 * (r2 & 7);
#pragma unroll
          for (int e = 0; e < 8; ++e) { const int ro = (seg * 8 + e) * 144 + swo;
              *(LAS unsigned*)(lds + ML_KWT + ro) = pk2(kw_[0][e], kw_[1][e]);
              const unsigned lo = (e & 1) ? (va[e >> 1] >> 16) : (va[e >> 1] & 0xffffu), hi = (e & 1) ? (vb[e >> 1] >> 16) : (vb[e >> 1] & 0xffffu);
              *(LAS unsigned*)(lds + ML_VT + ro) = lo | (hi << 16); }
        if (kc + 1 < 64) ML_LOAD(kc + 1); }
        __syncthreads();
        f32x4 hacc[5]; unsigned mo_r[8];
        const int tt = wave & 3, t0 = tt * 16, ne = (wave < 4) ? 5 : 4, e_first = (wave < 4) ? 0 : 5;
        { ML_LAUNDER(); const int tq = t0 + (lane & 15);
        bf16x8 qf[4];
#pragma unroll
        for (int ks = 0; ks < 4; ++ks) qf[ks] = lds_frag(lds + ML_QS, 272, t0, ks * 64, lane);
        const float mAt = GAm[tq], wit = GAw[tq];
#pragma unroll
        for (int si = 0; si < 2; ++si) { const int ss = 2 * (wave >> 2) + si, s0 = ss * 16; f32x4 sacc = (f32x4){0.f, 0.f, 0.f, 0.f};
            if (ss <= tt) {
#pragma unroll
                for (int ks = 0; ks < 4; ++ks) sacc = MFMA16(lds_frag(lds + ML_KS, 272, s0, ks * 64, lane), qf[ks], sacc);
#pragma unroll
                for (int r = 0; r < 4; ++r) { const int s = s0 + 4 * (lane >> 4) + r; sacc[r] = (s <= tq) ? sacc[r] * __expf(GAa[s] - mAt) : 0.f; } }
            v2u w; w.x = pk2(sacc[0], sacc[1]); w.y = pk2(sacc[2], sacc[3]);
            *(LAS v2u*)(lds + ML_SW + tq * 144 + s0 * 2 + (lane >> 4) * 8) = w; }
#pragma unroll
        for (int i = 0; i < 5; ++i) { hacc[i] = (f32x4){0.f, 0.f, 0.f, 0.f};
            if (i < ne) {
#pragma unroll
                for (int ks = 0; ks < 4; ++ks) hacc[i] = MFMA16(lds_frag(lds + ML_CT, 272, (e_first + i) * 16, ks * 64, lane), qf[ks], hacc[i]);
                hacc[i] = hacc[i] * wit; } }
#pragma unroll
        for (int i = 0; i < 8; ++i) mo_r[i] = *(const unsigned*)(bo + (unsigned)((64 * kc + 8 * wave + i) * 512 + 4 * lane)); }
        __syncthreads();
        { ML_LAUNDER(); const int tq = t0 + (lane & 15); bf16x8 swf[2];
#pragma unroll
          for (int ks = 0; ks < 2; ++ks) swf[ks] = lds_frag(lds + ML_SW, 144, t0, ks * 64, lane);
#pragma unroll
          for (int i = 0; i < 5; ++i) if (i < ne) { const int ee = e_first + i;
#pragma unroll
              for (int ks = 0; ks < 2; ++ks) hacc[i] = MFMA16(lds_frag_sw(lds + ML_VT, ee * 16, ks, lane), swf[ks], hacc[i]);
              if (ee < 8) *(LAS f32x4*)(lds + ML_HS + tq * 528 + (ee * 16 + 4 * (lane >> 4)) * 4) = hacc[i];
              else if ((lane >> 4) == 0) *(LAS float*)(lds + ML_HS + tq * 528 + 128 * 4) = hacc[i][0]; } }
        { ML_LAUNDER(); const int d0 = wave * 16; bf16x8 kwf[2];
#pragma unroll
          for (int ks = 0; ks < 2; ++ks) kwf[ks] = lds_frag_sw(lds + ML_KWT, d0, ks, lane);
#pragma unroll
          for (int ee = 0; ee < 9; ++ee) { cacc[ee] = cacc[ee] * decay;
#pragma unroll
              for (int ks = 0; ks < 2; ++ks) cacc[ee] = MFMA16(kwf[ks], lds_frag_sw(lds + ML_VT, ee * 16, ks, lane), cacc[ee]);
              v2u w; w.x = pk2(cacc[ee][0], cacc[ee][1]); w.y = pk2(cacc[ee][2], cacc[ee][3]);
              *(LAS v2u*)(lds + ML_CT + (ee * 16 + (lane & 15)) * 272 + (d0 + 4 * (lane >> 4)) * 2) = w; } }
        __syncthreads();
        { ML_LAUNDER();
#pragma unroll
        for (int i = 0; i < 8; ++i) { const int t = 8 * wave + i;
            const f32x2 nv = *(const LAS f32x2*)(lds + ML_HS + t * 528 + lane * 8); const float den = *(const LAS float*)(lds + ML_HS + t * 528 + 512);
            const float dd = fmaxf(fabsf(den), GAe[t]); const float h0 = nv.x / dd, h1 = nv.y / dd;
            const float r = rsqrtf(wave_sum(h0 * h0 + h1 * h1) * (1.f / 128.f) + EPS);
            const float y0 = h0 * r * GN[2 * lane] * sigm(bf2f(mo_r[i] & 0xffffu)), y1 = h1 * r * GN[2 * lane + 1] * sigm(bf2f(mo_r[i] >> 16));
            *(unsigned*)(YML + (tb + 64 * kc + t) * 512 + h * 128 + 2 * lane) = pk2(y0, y1); } }
        m_st = m_new;
        __syncthreads();
    }
#undef ML_LOAD
#undef ML_LAUNDER
}
constexpr int AT_HIST = 0;
constexpr int AT_SEL = 131072;
constexpr int AT_SM = AT_SEL + 8192;
static_assert(AT_SM + 256 <= MISC_OFF, "attention LDS map");
__device__ __forceinline__ unsigned score_key(float s) { unsigned u = __float_as_uint(s + 0.0f); return (u & 0x80000000u) ? ~u : (u | 0x80000000u); }
__device__ __forceinline__ void attn_unit(const Args& a, const Ctx& c, int b, int qt) {
    const int tid = c.tid, lane = c.lane, wave = c.wave; LAS unsigned char* lds = c.lds;
    const int q0 = qt * 16, ch = q0 >> 6, n = 64 * (ch + 1), ntiles = n >> 4;
    const size_t tb = (size_t)b * SEQ;
    unsigned char* dout = (unsigned char*)a.out;
    const bf16* AQN = (const bf16*)(dout + DO_AQN); const bf16* KN = (const bf16*)(dout + DO_KN); const bf16* IQR = (const bf16*)(dout + DO_IQR); const bf16* IKR = (const bf16*)(dout + DO_IKR);
    bf16* YATT = (bf16*)(dout + DO_YATT);
    const bf16* VB = proj_tile(a, TL_KV); const bf16* PS = proj_tile(a, TL_SM);
    LAS unsigned* HIST = (LAS unsigned*)(lds + AT_HIST);
    LAS unsigned long long* CAND = (LAS unsigned long long*)(lds + AT_HIST);
    LAS unsigned short* SEL = (LAS unsigned short*)(lds + AT_SEL);
    LAS int* SM = (LAS int*)(lds + AT_SM);
    const int qi = lane & 15, fq = lane >> 4;
    if (n > 256) {
        for (int i = tid; i < 8192; i += 512) ((LAS v4u*)HIST)[i] = (v4u){0u, 0u, 0u, 0u};
        if (tid < 64) SM[tid] = 0;
        const size_t trow = tb + q0 + qi;
        bf16x8 qf[8]; float wv[8];
#pragma unroll
        for (int h = 0; h < 8; ++h) qf[h] = *(const bf16x8*)(IQR + trow * 256 + h * 32 + 8 * fq);
        { float t8[8]; unpack8(*(const v4u*)(PS + trow * 256 + 32), t8);
#pragma unroll
          for (int h = 0; h < 8; ++h) wv[h] = t8[h] * 0.0625f; }
        __syncthreads();
#define AT_LOADK(kt_) (*(const bf16x8*)(IKR + (tb + (size_t)(kt_) * 16 + qi) * 32 + 8 * fq))
#define AT_SCORES(kf_, sc_) do { \
        _Pragma("unroll") for (int r_ = 0; r_ < 4; ++r_) sc_[r_] = 0.f; \
        _Pragma("unroll") for (int h_ = 0; h_ < 8; ++h_) { const f32x4 d_ = MFMA16(kf_, qf[h_], ((f32x4){0.f, 0.f, 0.f, 0.f})); \
            _Pragma("unroll") for (int r_ = 0; r_ < 4; ++r_) sc_[r_] = __builtin_fmaf(wv[h_], fmaxf(d_[r_], 0.f), sc_[r_]); } } while (0)
        { bf16x8 kfc = AT_LOADK(wave < ntiles ? wave : 0);
        for (int kt = wave; kt < ntiles; kt += 8) { const bf16x8 kfu = kfc; if (kt + 8 < ntiles) kfc = AT_LOADK(kt + 8); float sc[4]; AT_SCORES(kfu, sc);
#pragma unroll
            for (int r = 0; r < 4; ++r) { const unsigned bin = score_key(sc[r]) >> 20; __hip_atomic_fetch_add(&HIST[qi * 2048 + (bin >> 1)], 1u << ((bin & 1u) * 16), __ATOMIC_RELAXED, __HIP_MEMORY_SCOPE_WORKGROUP); } } }
        __syncthreads();
#pragma unroll 1
        for (int j = 0; j < 2; ++j) { const int q = 2 * wave + j; unsigned tot = 0;
            for (int i = 0; i < 32; ++i) { const unsigned w = HIST[q * 2048 + 32 * lane + ((i + lane) & 31)]; tot += (w & 0xffffu) + (w >> 16); }
            unsigned suf = tot;
#pragma unroll
            for (int o = 1; o < 64; o <<= 1) { const unsigned v = __shfl_down(suf, o); if (lane + o < 64) suf += v; }
            const unsigned long long mk = __ballot(suf >= 256u); const int L = 63 - __clzll((long long)mk);
            if (lane == L) { unsigned run = suf - tot; int B = 0; unsigned need = 1;
                for (int i = 31; i >= 0; --i) { const unsigned w = HIST[q * 2048 + 32 * L + i]; const unsigned hi = w >> 16, lo = w & 0xffffu;
                    if (run + hi >= 256u) { B = 64 * L + 2 * i + 1; need = 256u - run; break; } run += hi;
                    if (run + lo >= 256u) { B = 64 * L + 2 * i; need = 256u - run; break; } run += lo; }
                SM[q] = B; SM[16 + q] = (int)need; } }
        __syncthreads();
        { const int Bq = SM[qi];
          bf16x8 kfc = AT_LOADK(wave < ntiles ? wave : 0);
          for (int kt = wave; kt < ntiles; kt += 8) { const bf16x8 kfu = kfc; if (kt + 8 < ntiles) kfc = AT_LOADK(kt + 8); float sc[4]; AT_SCORES(kfu, sc);
#pragma unroll
            for (int r = 0; r < 4; ++r) { const unsigned u = score_key(sc[r]); const int bin = (int)(u >> 20); const int key = kt * 16 + 4 * fq + r;
                if (bin > Bq) { const int p = __hip_atomic_fetch_add(&SM[32 + qi], 1, __ATOMIC_RELAXED, __HIP_MEMORY_SCOPE_WORKGROUP); SEL[qi * 256 + p] = (unsigned short)key; }
                else if (bin == Bq) { const int p = __hip_atomic_fetch_add(&SM[48 + qi], 1, __ATOMIC_RELAXED, __HIP_MEMORY_SCOPE_WORKGROUP); if (p < 1024) CAND[qi * 1024 + p] = ((unsigned long long)u << 32) | (unsigned long long)(0xFFFFu - (unsigned)key); } } } }
        __syncthreads();
#pragma unroll 1
        for (int j = 0; j < 2; ++j) { const int q = 2 * wave + j; int m = SM[48 + q]; m = m < 1024 ? m : 1024; const int nd = SM[16 + q], base = SM[32 + q];
            for (int i0 = 0; i0 < m; i0 += 64) { const int i = i0 + lane; const unsigned long long ci = (i < m) ? CAND[q * 1024 + i] : 0ull; int rank = 0;
                for (int jj = 0; jj < m; ++jj) rank += (CAND[q * 1024 + jj] > ci) ? 1 : 0;
                if (i < m && rank < nd) SEL[q * 256 + base + rank] = (unsigned short)(0xFFFFu - (unsigned)(ci & 0xFFFFull)); } }
        __syncthreads();
#undef AT_SCORES
#undef AT_LOADK
    } else {
#pragma unroll 1
        for (int j = 0; j < 2; ++j) { const int q = 2 * wave + j; for (int i = lane; i < n; i += 64) SEL[q * 256 + i] = (unsigned short)i; }
        __syncthreads();
    }
    const int nsel = n < 256 ? n : 256, ntl = nsel >> 4;
    LAS float* Pw = (LAS float*)(lds + AT_HIST + wave * 4096);
#pragma unroll 1
    for (int j = 0; j < 2; ++j) { const int q = 2 * wave + j; const size_t trow = tb + q0 + q;
#pragma unroll 1
        for (int g = 0; g < 2; ++g) {
            bf16x8 qf0 = (bf16x8){0, 0, 0, 0, 0, 0, 0, 0}, qf1 = qf0;
            if (qi < 4) { const bf16* qp = AQN + trow * 512 + (g * 4 + qi) * 64 + 8 * fq; qf0 = *(const bf16x8*)qp; qf1 = *(const bf16x8*)(qp + 32); }
            f32x4 lg[16];
#pragma unroll
            for (int jt = 0; jt < 16; ++jt) {
                if (jt < ntl) { const int key = SEL[q * 256 + 16 * jt + qi]; const bf16* kp = KN + (tb + key) * 128 + g * 64 + 8 * fq;
                    const bf16x8 k0 = *(const bf16x8*)kp, k1 = *(const bf16x8*)(kp + 32);
                    f32x4 d = MFMA16(k0, qf0, ((f32x4){0.f, 0.f, 0.f, 0.f})); lg[jt] = MFMA16(k1, qf1, d); }
                else lg[jt] = (f32x4){-1e30f, -1e30f, -1e30f, -1e30f}; }
            float mx = -1e30f;
#pragma unroll
            for (int jt = 0; jt < 16; ++jt) mx = fmaxf(fmaxf(fmaxf(lg[jt][0], lg[jt][1]), fmaxf(lg[jt][2], lg[jt][3])), mx);
            mx = fmaxf(mx, __shfl_xor(mx, 16)); mx = fmaxf(mx, __shfl_xor(mx, 32));
            float sum = 0.f;
#pragma unroll
            for (int jt = 0; jt < 16; ++jt)
#pragma unroll
                for (int r = 0; r < 4; ++r) { const float p = __expf(lg[jt][r] - mx); lg[jt][r] = p; sum += p; }
            sum += __shfl_xor(sum, 16); sum += __shfl_xor(sum, 32);
            const float inv = 1.0f / sum;
            if (qi < 4) {
#pragma unroll
                for (int jt = 0; jt < 16; ++jt) if (jt < ntl) {
#pragma unroll
                    for (int r = 0; r < 4; ++r) Pw[(16 * jt + 4 * fq + r) * 4 + qi] = lg[jt][r] * inv; } }
            float acc[4][8];
#pragma unroll
            for (int hh = 0; hh < 4; ++hh)
#pragma unroll
                for (int d = 0; d < 8; ++d) acc[hh][d] = 0.f;
            const int nit = nsel >> 3;
#pragma unroll 4
            for (int i = 0; i < nit; ++i) { const int slot = 8 * i + (lane >> 3); const int key = SEL[q * 256 + slot];
                const v4u vr = *(const v4u*)(VB + (tb + key) * 256 + 128 + g * 64 + 8 * (lane & 7)); const f32x4 p4 = *(const LAS f32x4*)(Pw + slot * 4);
                float vf[8]; unpack8(vr, vf);
#pragma unroll
                for (int hh = 0; hh < 4; ++hh)
#pragma unroll
                    for (int d = 0; d < 8; ++d) acc[hh][d] += p4[hh] * vf[d]; }
#pragma unroll
            for (int hh = 0; hh < 4; ++hh)
#pragma unroll
                for (int d = 0; d < 8; ++d) { float v = acc[hh][d]; v += __shfl_xor(v, 8); v += __shfl_xor(v, 16); v += __shfl_xor(v, 32); acc[hh][d] = v; }
            if (lane < 8) {
#pragma unroll
                for (int hh = 0; hh < 4; ++hh) *(v4u*)(YATT + trow * 512 + (g * 4 + hh) * 64 + 8 * lane) = pack8(acc[hh]); }
        } }
    __syncthreads();
}

__device__ __forceinline__ void p3_mixer(const Args& a, const Ctx& c, volatile LAS unsigned* MISC) {
#if defined(DBG_ZERO_ML)
    { v4u* YM = (v4u*)((unsigned char*)a.out + DO_YML); for (size_t i = (size_t)blockIdx.x * 512 + c.tid; i < (size_t)T * 512 / 8; i += (size_t)c.G * 512) YM[i] = (v4u){0u, 0u, 0u, 0u}; }
#elif !defined(NO_MLSTM)
    for (int u = blockIdx.x; u < 32; u += c.G) mlstm_unit(a, c, u >> 2, u & 3);
#endif
    unsigned* ctl = (unsigned*)(a.ws + WS_CTL);
    const int x = (int)(__builtin_amdgcn_s_getreg((3 << 11) | 20) & 7u);
#pragma unroll 1
    for (int rot = 0; rot < 8; ++rot) { const int bq = (x + rot) & 7;
        for (;;) {
            if (c.tid == 0) MISC[16] = __hip_atomic_fetch_add(ctl + CW_Q + 64 * bq, 1u, RLX_AGENT);
            __syncthreads();
            const int u = (int)MISC[16];
            __syncthreads();
            if (u >= 256) break;
#if defined(DBG_ZERO_ATT)
            { bf16* YA = (bf16*)((unsigned char*)a.out + DO_YATT) + ((size_t)bq * SEQ + (size_t)(255 - u) * 16) * 512; for (int i = c.tid; i < 16 * 512 / 8; i += 512) ((v4u*)YA)[i] = (v4u){0u, 0u, 0u, 0u}; }
#elif !defined(NO_ATTN)
            attn_unit(a, c, bq, 255 - u);
#endif
        } }
}
constexpr int RT_WR = 0;
constexpr int RT_LCNT = 147456;
static_assert(RT_LCNT + 128 <= MISC_OFF, "router LDS map");
__device__ __forceinline__ void p6_router(const Args& a, const Ctx& c) {
    const int tid = c.tid, lane = c.lane, wave = c.wave; LAS unsigned char* lds = c.lds;
    LAS float* WR = (LAS float*)(lds + RT_WR); LAS int* LCNT = (LAS int*)(lds + RT_LCNT);
    for (int i = tid; i < 1024 * 32; i += 512) WR[(i >> 5) * 36 + (i & 31)] = a.in[IN_WRE][i];
    for (int i = tid; i < 1024 * 4; i += 512) WR[(i >> 2) * 36 + 32 + (i & 3)] = a.in[IN_WRG][i];
    float gm[16];
#pragma unroll
    for (int i = 0; i < 16; ++i) gm[i] = a.in[IN_GMOE][lane + 64 * i];
    float be[32], bg[4];
#pragma unroll
    for (int i = 0; i < 32; ++i) be[i] = a.in[IN_BRE][i];
#pragma unroll
    for (int i = 0; i < 4; ++i) bg[i] = a.in[IN_BRG][i];
    const float* X1 = a.out; bf16* XN = (bf16*)(a.ws + WS_XN);
    int* TOKE = (int*)(a.ws + WS_TOKE); int* TOKR = (int*)(a.ws + WS_TOKR); float* TOKG = (float*)(a.ws + WS_TOKG); int* CNT = (int*)(a.ws + WS_CNT);
    __syncthreads();
    for (int blk = blockIdx.x; blk < 256; blk += c.G) {
        if (tid < 32) LCNT[tid] = 0;
        __syncthreads();
#pragma unroll 1
        for (int ri = 0; ri < 16; ++ri) { const int t = blk * 128 + wave * 16 + ri;
            float xv[16]; float ss = 0.f;
#pragma unroll
            for (int i = 0; i < 16; ++i) { xv[i] = X1[(size_t)t * D + lane + 64 * i]; ss += xv[i] * xv[i]; }
            const float r = rsqrtf(wave_sum(ss) * (1.f / D) + EPS);
#pragma unroll
            for (int i = 0; i < 16; ++i) { xv[i] = xv[i] * r * gm[i]; XN[(size_t)t * D + lane + 64 * i] = (bf16)f2bf(xv[i]); }
            float acc[36];
#pragma unroll
            for (int jx = 0; jx < 36; ++jx) acc[jx] = 0.f;
#pragma unroll
            for (int i = 0; i < 16; ++i) { const LAS f32x4* wp = (const LAS f32x4*)(WR + (lane + 64 * i) * 36);
#pragma unroll
                for (int jj = 0; jj < 9; ++jj) { const f32x4 w4 = wp[jj]; acc[4 * jj] += xv[i] * w4[0]; acc[4 * jj + 1] += xv[i] * w4[1]; acc[4 * jj + 2] += xv[i] * w4[2]; acc[4 * jj + 3] += xv[i] * w4[3]; } }
#pragma unroll
            for (int jx = 0; jx < 36; ++jx) acc[jx] = wave_sum(acc[jx]);
            float gl[4];
#pragma unroll
            for (int i = 0; i < 4; ++i) gl[i] = acc[32 + i] + bg[i];
            int gs = 0; float gmax = gl[0];
#pragma unroll
            for (int i = 1; i < 4; ++i) if (gl[i] > gmax) { gmax = gl[i]; gs = i; }
            float gsum = 0.f;
#pragma unroll
            for (int i = 0; i < 4; ++i) gsum += expf(gl[i] - gmax);
            const float gtop = 1.0f / gsum;
            float ev[8];
#pragma unroll
            for (int i = 0; i < 8; ++i) { float v = acc[i] + be[i];
#pragma unroll
                for (int g2 = 1; g2 < 4; ++g2) v = (gs == g2) ? (acc[g2 * 8 + i] + be[g2 * 8 + i]) : v;
                ev[i] = v; }
            int l0 = 0; float v0 = ev[0];
#pragma unroll
            for (int i = 1; i < 8; ++i) if (ev[i] > v0) { v0 = ev[i]; l0 = i; }
            int l1 = -1; float v1 = -3.0e38f;
#pragma unroll
            for (int i = 0; i < 8; ++i) if (i != l0 && ev[i] > v1) { v1 = ev[i]; l1 = i; }
            const float e1 = expf(v1 - v0), s0 = 1.0f / (1.0f + e1), s1 = e1 * s0;
            if (lane == 0) { const int ex0 = gs * 8 + l0, ex1 = gs * 8 + l1;
                const int rk0 = __hip_atomic_fetch_add(&LCNT[ex0], 1, __ATOMIC_RELAXED, __HIP_MEMORY_SCOPE_WORKGROUP);
                const int rk1 = __hip_atomic_fetch_add(&LCNT[ex1], 1, __ATOMIC_RELAXED, __HIP_MEMORY_SCOPE_WORKGROUP);
                TOKE[2 * t] = ex0; TOKE[2 * t + 1] = ex1; TOKR[2 * t] = rk0; TOKR[2 * t + 1] = rk1; TOKG[2 * t] = s0 * gtop; TOKG[2 * t + 1] = s1 * gtop; }
        }
        __syncthreads();
        if (tid < 32) CNT[blk * 32 + tid] = LCNT[tid];
        __syncthreads();
    }
}
__device__ __forceinline__ void p7_gather(const Args& a, const Ctx& c) {
    const int tid = c.tid, lane = c.lane, wave = c.wave;
    LAS int* PART = (LAS int*)c.lds; LAS int* PPRE = PART + 512; LAS int* TOT = PPRE + 512; LAS int* TS = TOT + 32; LAS int* BASE = TS + 64;
    const int* CNT = (const int*)(a.ws + WS_CNT); const int* TOKE = (const int*)(a.ws + WS_TOKE); const int* TOKR = (const int*)(a.ws + WS_TOKR); int* TOKP = (int*)(a.ws + WS_TOKP);
    const bf16* XN = (const bf16*)(a.ws + WS_XN); bf16* XG = (bf16*)(a.ws + WS_XG);
    { const int e = tid & 31, p = tid >> 5; int s = 0; for (int k = 0; k < 16; ++k) s += CNT[(16 * p + k) * 32 + e]; PART[p * 32 + e] = s; }
    __syncthreads();
    if (tid < 32) { int run = 0; for (int p = 0; p < 16; ++p) { PPRE[p * 32 + tid] = run; run += PART[p * 32 + tid]; } TOT[tid] = run; }
    __syncthreads();
    if (tid == 0) { int ts = 0; for (int e = 0; e < 32; ++e) { TS[e] = ts; ts += (TOT[e] + 255) >> 8; } TS[32] = ts; }
    __syncthreads();
    if (blockIdx.x == 0 && tid < 33) ((int*)(a.ws + WS_SMALL))[tid] = TS[tid];
    for (int blk = blockIdx.x; blk < 256; blk += c.G) {
        if (tid < 32) { int s = TS[tid] * 256 + PPRE[(blk >> 4) * 32 + tid]; for (int b2 = (blk & ~15); b2 < blk; ++b2) s += CNT[b2 * 32 + tid]; BASE[tid] = s; }
        __syncthreads();
#pragma unroll 1
        for (int ri = 0; ri < 16; ++ri) { const int t = blk * 128 + wave * 16 + ri;
            const v4u x0 = *(const v4u*)(XN + (size_t)t * D + 8 * lane), x1 = *(const v4u*)(XN + (size_t)t * D + 512 + 8 * lane);
#pragma unroll
            for (int j = 0; j < 2; ++j) { const int pos = BASE[TOKE[2 * t + j]] + TOKR[2 * t + j];
                if (lane == 0) TOKP[2 * t + j] = pos;
                *(v4u*)(XG + (size_t)pos * D + 8 * lane) = x0; *(v4u*)(XG + (size_t)pos * D + 512 + 8 * lane) = x1; } }
        __syncthreads();
    }
}
__device__ __forceinline__ void p10_combine(const Args& a, const Ctx& c) {
    const int lane = c.lane, gw = c.vcu * NWAVES + c.wave, NGW = c.G * NWAVES;
    const int* TOKP = (const int*)(a.ws + WS_TOKP); const float* TOKG = (const float*)(a.ws + WS_TOKG); const bf16* Y = (const bf16*)(a.ws + WS_Y);
    for (int t = gw; t < T; t += NGW) { const int p0 = TOKP[2 * t], p1 = TOKP[2 * t + 1]; const float g0 = TOKG[2 * t], g1 = TOKG[2 * t + 1];
#pragma unroll
        for (int j = 0; j < 4; ++j) { f32x4* op = (f32x4*)(a.out + (size_t)t * D + 4 * lane + 256 * j); f32x4 x = *op;
            const v2u y0 = *(const v2u*)(Y + (size_t)p0 * D + 4 * lane + 256 * j), y1 = *(const v2u*)(Y + (size_t)p1 * D + 4 * lane + 256 * j);
            x[0] += g0 * bf2f(y0.x & 0xffffu) + g1 * bf2f(y1.x & 0xffffu); x[1] += g0 * bf2f(y0.x >> 16) + g1 * bf2f(y1.x >> 16);
            x[2] += g0 * bf2f(y0.y & 0xffffu) + g1 * bf2f(y1.y & 0xffffu); x[3] += g0 * bf2f(y0.y >> 16) + g1 * bf2f(y1.y >> 16);
            *op = x; } }
}
__global__ void __launch_bounds__(NWAVES * 64, 2) hybrid_fwd(Args args) {
    extern __shared__ __attribute__((aligned(16))) unsigned char lds_raw[];
    Ctx c; c.lds = (LAS unsigned char*)lds_raw;
    volatile LAS unsigned* MISC = (volatile LAS unsigned*)(c.lds + MISC_OFF);
    c.tid = threadIdx.x; c.lane = c.tid & 63; c.wave = __builtin_amdgcn_readfirstlane(c.tid >> 6);
    c.G = gridDim.x; { const int bx = blockIdx.x; c.vcu = (c.G % 8 == 0) ? (bx % 8) * (c.G / 8) + bx / 8 : bx; }
    unsigned* ctl = (unsigned*)(args.ws + WS_CTL);
    if (c.tid < 128) MISC[c.tid] = 0u;
    __syncthreads();
    XcdBarrier bar; bar.bar = ctl + CW_BAR; bar.x = 0; bar.st = nullptr;
    if (N_LAUNCHES == 1) bar = xcd_barrier_post(ctl + CW_BAR, MISC + 8);
#define GRID_BAR() do { if (N_LAUNCHES == 1) xcd_barrier(bar); } while (0)
    const int lo = args.ph_lo, hi = args.ph_hi;
#ifndef PH_MASK
#define PH_MASK 0x7ff
#endif
#define IN(k) (((PH_MASK >> (k)) & 1) && lo <= (k) && (k) < hi)
#define BOTH(k) (IN(k) && IN((k) + 1))
    unsigned char* ws = args.ws; unsigned char* dout = (unsigned char*)args.out;
    if (IN(0)) { p0_prologue(args, c); if (BOTH(0)) GRID_BAR(); }
    if (IN(1)) {
        pg8::Gemm g{(const pg8::bf16_t*)(dout + DO_H), (const pg8::bf16_t*)(ws + WS_WIN), T, NPROJ, D}; pg8::StaticOrder S; S.init(T, NPROJ, c.G, (int)blockIdx.x);
        pg8::EpiBf16<0> E{(pg8::bf16_t*)(ws + WS_PROJ), 256, nullptr, 256, (size_t)T * 256, 1.f};
        pg8::gemm_phase<pg8::EpiBf16<0>, pg8::StaticOrder, true, true>(c.lds, g, S, E);
        if (BOTH(1)) GRID_BAR();
    }
    if (IN(2)) { p2_prep(args, c); if (BOTH(2)) GRID_BAR(); }
    if (IN(3)) { p3_mixer(args, c, MISC); if (BOTH(3)) GRID_BAR(); }
    if (IN(4)) {
        { pg8::Gemm g{(const pg8::bf16_t*)(dout + DO_YATT), (const pg8::bf16_t*)(ws + WS_WPA), T, D, 512}; pg8::StaticOrder S; S.init(T, D, c.G, (int)blockIdx.x);
          pg8::EpiGate<false> E{(pg8::bf16_t*)(ws + WS_MERGED), D, (const pg8::bf16_t*)(ws + WS_PROJ + (size_t)TL_GA * PROJ_TILE), (size_t)T * 256};
          pg8::gemm_phase<pg8::EpiGate<false>, pg8::StaticOrder, true, true>(c.lds, g, S, E); }
        __syncthreads();
        { pg8::Gemm g{(const pg8::bf16_t*)(dout + DO_YML), (const pg8::bf16_t*)(ws + WS_WPM), T, D, 512}; pg8::StaticOrder S; S.init(T, D, c.G, (int)blockIdx.x);
          pg8::EpiGate<true> E{(pg8::bf16_t*)(ws + WS_MERGED), D, (const pg8::bf16_t*)(ws + WS_PROJ + (size_t)TL_GM * PROJ_TILE), (size_t)T * 256};
          pg8::gemm_phase<pg8::EpiGate<true>, pg8::StaticOrder, true, true>(c.lds, g, S, E); }
        if (BOTH(4)) GRID_BAR();
    }
    if (IN(5)) {
        pg8::Gemm g{(const pg8::bf16_t*)(ws + WS_MERGED), (const pg8::bf16_t*)(ws + WS_WOUT), T, D, D}; pg8::StaticOrder S; S.init(T, D, c.G, (int)blockIdx.x);
        pg8::EpiRes E{args.out, args.in[IN_X], D};
        pg8::gemm_phase<pg8::EpiRes, pg8::StaticOrder, true, true>(c.lds, g, S, E);
        if (BOTH(5)) GRID_BAR();
    }
    if (IN(6)) { p6_router(args, c); if (BOTH(6)) GRID_BAR(); }
    if (IN(7)) { p7_gather(args, c); if (BOTH(7)) GRID_BAR(); }
    if (IN(8) || IN(9)) {
        LAS int* TSL = (LAS int*)(c.lds + MISC_OFF + 256);
        if (c.tid < 33) TSL[c.tid] = (int)__hip_atomic_load((unsigned*)(ws + WS_SMALL) + c.tid, RLX_AGENT);
        __syncthreads();
        pg8::MoeOrder S{TSL, c.G, (int)blockIdx.x};
        if (IN(8)) {
            pg8::Gemm g{(const pg8::bf16_t*)(ws + WS_XG), (const pg8::bf16_t*)(ws + WS_GU), 0, 0, D};
            pg8::EpiSwiGLU E{(pg8::bf16_t*)(ws + WS_HID)};
            pg8::gemm_phase<pg8::EpiSwiGLU, pg8::MoeOrder, true, true>(c.lds, g, S, E);
            if (BOTH(8)) GRID_BAR();
        }
        if (IN(9)) {
            pg8::Gemm g{(const pg8::bf16_t*)(ws + WS_HID), (const pg8::bf16_t*)(ws + WS_DN), 0, 0, 512};
            pg8::EpiDown E{(pg8::bf16_t*)(ws + WS_Y)};
            pg8::gemm_phase<pg8::EpiDown, pg8::MoeOrder, true, true>(c.lds, g, S, E);
            if (BOTH(9)) GRID_BAR();
        }
    }
    if (IN(10)) p10_combine(args, c);
#undef IN
#undef BOTH
#undef GRID_BAR
}

extern "C" void kernel_launch(void* const* d_in, const int* in_sizes, int n_in, void* d_out, int out_size, void* d_ws, size_t ws_size, hipStream_t stream) {
    static int grid = 0;
    if (grid == 0) {
        if (n_in != 22 || in_sizes[0] != T * D || out_size != T * D || ws_size < WS_END) { fprintf(stderr, "kernel_launch: unexpected shapes (n_in %d, in0 %d, out %d, ws %zu); nothing launched\n", n_in, n_in > 0 ? in_sizes[0] : -1, out_size, ws_size); grid = -1; return; }
        int dev = 0, cus = 0, per_cu = 0;
        if (hipGetDevice(&dev) != hipSuccess || hipDeviceGetAttribute(&cus, hipDeviceAttributeMultiprocessorCount, dev) != hipSuccess) { grid = -1; return; }
        if (hipFuncSetAttribute((const void*)hybrid_fwd, hipFuncAttributeMaxDynamicSharedMemorySize, LDS_BYTES) != hipSuccess) { fprintf(stderr, "kernel_launch: hipFuncSetAttribute failed\n"); grid = -1; return; }
        if (hipOccupancyMaxActiveBlocksPerMultiprocessor(&per_cu, (const void*)hybrid_fwd, NWAVES * 64, LDS_BYTES) != hipSuccess || per_cu < 1)
            fprintf(stderr, "kernel_launch: note: occupancy query reports %d workgroups per CU\n", per_cu);
        (void)hipGetLastError();
        grid = cus;
    }
    if (grid < 0) return;
    if (hipMemsetAsync((char*)d_ws + WS_CTL, 0, CTL_ZERO_BYTES, stream) != hipSuccess) return;
    Args a{};
    for (int i = 0; i < 22; ++i) a.in[i] = (const float*)d_in[i];
    a.out = (float*)d_out; a.ws = (unsigned char*)d_ws;
    for (int li = 0; li < N_LAUNCHES; ++li) {
        a.ph_lo = (N_LAUNCHES == 1) ? 0 : li; a.ph_hi = (N_LAUNCHES == 1) ? NPH : li + 1; a.li = li;
        hipLaunchKernelGGL(hybrid_fwd, dim3(grid), dim3(NWAVES * 64), LDS_BYTES, stream, a);
        if (hipPeekAtLastError() != hipSuccess) { fprintf(stderr, "kernel_launch: launch %d failed\n", li); break; }
    }
}
```

```cpp
#include <hip/hip_runtime.h>
#include <cstdio>
#include <cstdint>
namespace pg8 {
#define PG8_LAS __attribute__((address_space(3)))
typedef unsigned short bf16_t;
typedef short bf16x8 __attribute__((ext_vector_type(8)));
typedef float f32x4 __attribute__((ext_vector_type(4)));
typedef unsigned u32x4 __attribute__((ext_vector_type(4)));
constexpr int BM = 256, BK = 64, HALF = 128, HTB = HALF * BK * 2  , STAGE_BYTES = 8 * HTB, NXCD = 8, WGM = 8;

__host__ __device__ __forceinline__ int lds_byte(int r, int c) { const int st = (r >> 4) * 2 + (c >> 5), rr = r & 15, cc = c & 31, ob = rr * 64 + cc * 2; return st * 1024 + (ob ^ (((ob >> 9) & 1) << 5)); }
__host__ __device__ __forceinline__ void stage_rc(int b, int& R, int& C) { const int st = b / 1024, sb = b % 1024, swz = sb ^ (((sb >> 9) & 1) << 5); R = (st >> 1) * 16 + swz / 64; C = (st & 1) * 32 + (swz % 64) / 2; }
__host__ __device__ __forceinline__ int perm32(int rho) { const int n = rho >> 4, i = rho & 15; return 8 * (i >> 2) + 4 * n + (i & 3); }

struct Unit { int pm, pn; };
struct Gemm { const bf16_t* A; const bf16_t* Bt; int M, N, K; };

struct StaticOrder {
    int nM, nN, nwg, G, c;
    __host__ __device__ void init(int M, int N, int G_, int c_) { nM = M / BM; nN = N / BM; nwg = nM * nN; G = G_; c = c_; }
    __host__ __device__ bool next(int i, Unit& u) const {
        const long L = (long)i * G + c; if (L >= nwg) return false;
        int wgid = (int)L; { const int q = nwg / NXCD, r = nwg % NXCD, xcd = wgid % NXCD, off = wgid / NXCD; wgid = (xcd < r ? xcd * (q + 1) : r * (q + 1) + (xcd - r) * q) + off; }
        const int nig = WGM * nN, gid = wgid / nig, fm = gid * WGM, gsz = (nM - fm) < WGM ? (nM - fm) : WGM;
        u.pm = fm + ((wgid % nig) % gsz); u.pn = (wgid % nig) / gsz; return true;
    }
    __device__ __forceinline__ void a_ready(const Unit&) const {}
    __device__ __forceinline__ void done(const Unit&) const {}
};

typedef __bf16 bf2_t __attribute__((ext_vector_type(2)));
__device__ __forceinline__ unsigned cvt_pk_bf16(float lo, float hi) { bf2_t v; v[0] = (__bf16)lo; v[1] = (__bf16)hi; return __builtin_bit_cast(unsigned, v); }
typedef float f32x2 __attribute__((ext_vector_type(2)));
template <int ACT  > struct EpiBf16 {
    static constexpr bool PERM = true, AFTER_DRAIN = false; static_assert(ACT == 0, "EpiBf16: no activation here");
    bf16_t* O; int ldc; const float* bias; int split_cols; size_t split_stride; float scale0;
    __device__ __forceinline__ void operator()(const f32x4 (&acc)[2][2][4][2], const Unit& u, int wr, int wc, int fr, int fq) const {
        const int row0 = u.pm * BM + wr * 64 + fr; int colt = u.pn * BM; bf16_t* base = O;
        float sc = 1.f; if (split_cols) { const int t = colt / split_cols; base += (size_t)t * split_stride; colt -= t * split_cols; if (t == 0) sc = scale0; }
        const int col0 = colt + wc * 32 + 8 * fq, bcol0 = u.pn * BM + wc * 32 + 8 * fq;
        f32x4 bv[2][2];
#pragma unroll
        for (int bj = 0; bj < 2; ++bj)
#pragma unroll
            for (int n = 0; n < 2; ++n) bv[bj][n] = bias ? *(const f32x4*)(bias + bcol0 + bj * HALF + 4 * n) : (f32x4){0.f, 0.f, 0.f, 0.f};
#pragma unroll
        for (int ai = 0; ai < 2; ++ai)
#pragma unroll
            for (int m = 0; m < 4; ++m) { bf16_t* rowp = base + (size_t)(row0 + ai * HALF + m * 16) * ldc + col0;
#pragma unroll
                for (int bj = 0; bj < 2; ++bj) { f32x4 v0 = acc[ai][bj][m][0] + bv[bj][0], v1 = acc[ai][bj][m][1] + bv[bj][1];
                    v0 = v0 * sc; v1 = v1 * sc; u32x4 w; w.x = cvt_pk_bf16(v0[0], v0[1]); w.y = cvt_pk_bf16(v0[2], v0[3]); w.z = cvt_pk_bf16(v1[0], v1[1]); w.w = cvt_pk_bf16(v1[2], v1[3]);
                    *(u32x4*)(rowp + bj * HALF) = w; } }
    }
};
__device__ __forceinline__ float bf2f_(unsigned b16) { return __uint_as_float(b16 << 16); }
__device__ __forceinline__ float sigm_(float x) { return 1.0f / (1.0f + __expf(-x)); }
template <bool ADD> struct EpiGate {
    static constexpr bool PERM = true, AFTER_DRAIN = false;
    bf16_t* O; int ldc; const bf16_t* gate; size_t gstride;
    __device__ __forceinline__ void operator()(const f32x4 (&acc)[2][2][4][2], const Unit& u, int wr, int wc, int fr, int fq) const {
        const int row0 = u.pm * BM + wr * 64 + fr, colt = wc * 32 + 8 * fq;
        const bf16_t* gt = gate + (size_t)u.pn * gstride;
#pragma unroll
        for (int ai = 0; ai < 2; ++ai)
#pragma unroll
            for (int m = 0; m < 4; ++m) { const size_t row = (size_t)(row0 + ai * HALF + m * 16);
#pragma unroll
                for (int bj = 0; bj < 2; ++bj) { const int c = colt + bj * HALF;
                    const u32x4 gv = *(const u32x4*)(gt + row * 256 + c);
                    bf16_t* op = O + row * ldc + u.pn * BM + c;
                    float pv[8] = {0.f, 0.f, 0.f, 0.f, 0.f, 0.f, 0.f, 0.f};
                    if (ADD) { const u32x4 p = *(const u32x4*)op; pv[0] = bf2f_(p.x & 0xffffu); pv[1] = bf2f_(p.x >> 16); pv[2] = bf2f_(p.y & 0xffffu); pv[3] = bf2f_(p.y >> 16);
                        pv[4] = bf2f_(p.z & 0xffffu); pv[5] = bf2f_(p.z >> 16); pv[6] = bf2f_(p.w & 0xffffu); pv[7] = bf2f_(p.w >> 16); }
                    const f32x4 v0 = acc[ai][bj][m][0], v1 = acc[ai][bj][m][1];
                    float o[8];
                    o[0] = pv[0] + sigm_(bf2f_(gv.x & 0xffffu)) * v0[0]; o[1] = pv[1] + sigm_(bf2f_(gv.x >> 16)) * v0[1];
                    o[2] = pv[2] + sigm_(bf2f_(gv.y & 0xffffu)) * v0[2]; o[3] = pv[3] + sigm_(bf2f_(gv.y >> 16)) * v0[3];
                    o[4] = pv[4] + sigm_(bf2f_(gv.z & 0xffffu)) * v1[0]; o[5] = pv[5] + sigm_(bf2f_(gv.z >> 16)) * v1[1];
                    o[6] = pv[6] + sigm_(bf2f_(gv.w & 0xffffu)) * v1[2]; o[7] = pv[7] + sigm_(bf2f_(gv.w >> 16)) * v1[3];
                    u32x4 w; w.x = cvt_pk_bf16(o[0], o[1]); w.y = cvt_pk_bf16(o[2], o[3]); w.z = cvt_pk_bf16(o[4], o[5]); w.w = cvt_pk_bf16(o[6], o[7]);
                    *(u32x4*)op = w; } }
    }
};
struct EpiRes {
    static constexpr bool PERM = false, AFTER_DRAIN = false;
    float* C; const float* R; int ldc;
    __device__ __forceinline__ void operator()(const f32x4 (&acc)[2][2][4][2], const Unit& u, int wr, int wc, int fr, int fq) const {
        const int row0 = u.pm * BM + wr * 64 + fr, col0 = u.pn * BM + wc * 32 + 4 * fq;
#pragma unroll
        for (int ai = 0; ai < 2; ++ai)
#pragma unroll
            for (int m = 0; m < 4; ++m) { const size_t ro = (size_t)(row0 + ai * HALF + m * 16) * ldc + col0;
#pragma unroll
                for (int bj = 0; bj < 2; ++bj)
#pragma unroll
                    for (int n = 0; n < 2; ++n) { const size_t off = ro + bj * HALF + n * 16; *(f32x4*)(C + off) = *(const f32x4*)(R + off) + acc[ai][bj][m][n]; } }
    }
};
struct EpiSwiGLU {
    static constexpr bool PERM = true, AFTER_DRAIN = false;
    bf16_t* H;
    __device__ __forceinline__ void operator()(const f32x4 (&acc)[2][2][4][2], const Unit& u, int wr, int wc, int fr, int fq) const {
        const int row0 = u.pm * BM + wr * 64 + fr, hc = (u.pn & 3) * 128 + wc * 32 + 8 * fq;
#pragma unroll
        for (int ai = 0; ai < 2; ++ai)
#pragma unroll
            for (int m = 0; m < 4; ++m) { const size_t row = (size_t)(row0 + ai * HALF + m * 16);
                float o[8];
#pragma unroll
                for (int n = 0; n < 2; ++n)
#pragma unroll
                    for (int i = 0; i < 4; ++i) { const float g = acc[ai][0][m][n][i], up = acc[ai][1][m][n][i]; o[n * 4 + i] = g * sigm_(g) * up; }
                u32x4 w; w.x = cvt_pk_bf16(o[0], o[1]); w.y = cvt_pk_bf16(o[2], o[3]); w.z = cvt_pk_bf16(o[4], o[5]); w.w = cvt_pk_bf16(o[6], o[7]);
                *(u32x4*)(H + row * 512 + hc) = w; }
    }
};
struct EpiDown {
    static constexpr bool PERM = true, AFTER_DRAIN = false;
    bf16_t* Y;
    __device__ __forceinline__ void operator()(const f32x4 (&acc)[2][2][4][2], const Unit& u, int wr, int wc, int fr, int fq) const {
        const int row0 = u.pm * BM + wr * 64 + fr, c0 = (u.pn & 3) * 256 + wc * 32 + 8 * fq;
#pragma unroll
        for (int ai = 0; ai < 2; ++ai)
#pragma unroll
            for (int m = 0; m < 4; ++m) { const size_t row = (size_t)(row0 + ai * HALF + m * 16);
#pragma unroll
                for (int bj = 0; bj < 2; ++bj) { const f32x4 v0 = acc[ai][bj][m][0], v1 = acc[ai][bj][m][1];
                    u32x4 w; w.x = cvt_pk_bf16(v0[0], v0[1]); w.y = cvt_pk_bf16(v0[2], v0[3]); w.z = cvt_pk_bf16(v1[0], v1[1]); w.w = cvt_pk_bf16(v1[2], v1[3]);
                    *(u32x4*)(Y + row * 1024 + c0 + bj * HALF) = w; } }
    }
};
struct MoeOrder {
    const PG8_LAS int* ts; int G, c;
    __device__ __forceinline__ bool next(int i, Unit& u) const {
        const int nt = ts[32]; const long L = (long)i * G + c; if (L >= 4L * nt) return false;
        const int pm = (int)(L >> 2), j = (int)(L & 3); int e = 0;
#pragma unroll
        for (int k = 1; k < 32; ++k) e += (ts[k] <= pm) ? 1 : 0;
        u.pm = pm; u.pn = e * 4 + j; return true;
    }
    __device__ __forceinline__ void a_ready(const Unit&) const {}
    __device__ __forceinline__ void done(const Unit&) const {}
};
template <class Epi, class Sched, bool ALIGN_EPI = false, bool SP2 = false>
__device__ __forceinline__ void gemm_phase(PG8_LAS unsigned char* lds, const Gemm g, const Sched& S, const Epi& E) {
    const int tid = threadIdx.x, wid = __builtin_amdgcn_readfirstlane(tid >> 6), lane = tid & 63, wr = wid >> 2, wc = wid & 3, fr = lane & 15, fq = lane >> 4;
    const int K = g.K, nt = K / BK;
    unsigned voffA[2], voffB[2];
#pragma unroll
    for (int i = 0; i < 2; ++i) { int R, C; stage_rc(tid * 16 + i * 8192, R, C); const int Rb = Epi::PERM ? ((R & ~31) + perm32(R & 31)) : R;
        voffA[i] = (unsigned)(R * K + C) * 2u; voffB[i] = (unsigned)(Rb * K + C) * 2u; }
    const size_t kstep = (size_t)(BK * 2);
    const size_t hstep = (size_t)HALF * K * 2;
    const size_t tstep = 2 * hstep;
    const unsigned ldsw = (unsigned)wid * 1024u;
    const int aoff = lds_byte(wr * 64 + fr, fq * 8), boff = lds_byte(wc * 32 + fr, fq * 8);
#define PG8_SA(b, h) (((b) * 2 + (h)) * HTB)
#define PG8_SB(b, h) ((4 + (b) * 2 + (h)) * HTB)
#define PG8_STAGE(bufoff, gbase, voff) do { _Pragma("unroll") for (int _i = 0; _i < 2; ++_i) \
        __builtin_amdgcn_global_load_lds((const unsigned*)((const char*)(gbase) + (voff)[_i]), (PG8_LAS unsigned*)(lds + (bufoff) + ldsw + _i * 8192), 16, 0, 0); } while (0)
#define PG8_LDA(dst, b, h) do { _Pragma("unroll") for (int m = 0; m < 4; ++m) _Pragma("unroll") for (int k = 0; k < 2; ++k) dst[m][k] = *(const PG8_LAS bf16x8*)(lds + PG8_SA(b, h) + aoff + m * 2048 + k * 1024); } while (0)
#define PG8_LDB(dst, b, h) do { _Pragma("unroll") for (int n = 0; n < 2; ++n) _Pragma("unroll") for (int k = 0; k < 2; ++k) dst[n][k] = *(const PG8_LAS bf16x8*)(lds + PG8_SB(b, h) + boff + n * 2048 + k * 1024); } while (0)
#define PG8_MMA(ai, bj, At, Bt) do { __builtin_amdgcn_s_setprio(1); _Pragma("unroll") for (int m = 0; m < 4; ++m) _Pragma("unroll") for (int n = 0; n < 2; ++n) _Pragma("unroll") for (int k = 0; k < 2; ++k) \
        acc[ai][bj][m][n] = __builtin_amdgcn_mfma_f32_16x16x32_bf16(Bt[n][k], At[m][k], acc[ai][bj][m][n], 0, 0, 0); __builtin_amdgcn_s_setprio(0); } while (0)
#define PG8_WAIT_V(n) asm volatile("s_waitcnt vmcnt(" #n ")" ::: "memory")
#define PG8_WAIT_L(n) asm volatile("s_waitcnt lgkmcnt(" #n ")" ::: "memory")
#define PG8_BAR __builtin_amdgcn_s_barrier()
#define PG8_SCHED __builtin_amdgcn_sched_barrier(0)
    Unit cur, nxt; int ui = 0;
    if (!S.next(0, cur)) return;
    f32x4 acc[2][2][4][2];
#pragma unroll
    for (int a = 0; a < 2; ++a)
#pragma unroll
        for (int b = 0; b < 2; ++b)
#pragma unroll
            for (int m = 0; m < 4; ++m)
#pragma unroll
                for (int n = 0; n < 2; ++n) acc[a][b][m][n] = (f32x4){0.f, 0.f, 0.f, 0.f};
    bf16x8 At[4][2], B0[2][2], B1[2][2];
    const char* cA = (const char*)g.A + (size_t)cur.pm * tstep; const char* cB = (const char*)g.Bt + (size_t)cur.pn * tstep;
    S.a_ready(cur);
    if constexpr (SP2) {
        PG8_STAGE(PG8_SB(0, 0), cB, voffB); PG8_STAGE(PG8_SB(0, 1), cB + hstep, voffB); PG8_STAGE(PG8_SA(0, 0), cA, voffA); PG8_STAGE(PG8_SA(0, 1), cA + hstep, voffA);
        if (wr == 1) PG8_BAR;
        PG8_WAIT_V(2); PG8_BAR;
        PG8_STAGE(PG8_SB(1, 0), cB + kstep, voffB); PG8_STAGE(PG8_SA(1, 0), cA + kstep, voffA); PG8_STAGE(PG8_SB(1, 1), cB + hstep + kstep, voffB);
        PG8_WAIT_V(6); PG8_BAR;
    } else {
        PG8_STAGE(PG8_SB(0, 0), cB, voffB); PG8_STAGE(PG8_SA(0, 0), cA, voffA); PG8_STAGE(PG8_SB(0, 1), cB + hstep, voffB); PG8_STAGE(PG8_SA(0, 1), cA + hstep, voffA);
        if (wr == 1) PG8_BAR;
        PG8_WAIT_V(4); PG8_BAR;
        PG8_STAGE(PG8_SB(1, 0), cB + kstep, voffB); PG8_STAGE(PG8_SA(1, 0), cA + kstep, voffA); PG8_STAGE(PG8_SB(1, 1), cB + hstep + kstep, voffB);
        PG8_WAIT_V(6); PG8_BAR;
    }
    for (;;) {
        const bool has_next = S.next(ui + 1, nxt);
        const char* nA = has_next ? (const char*)g.A + (size_t)nxt.pm * tstep : cA; const char* nB = has_next ? (const char*)g.Bt + (size_t)nxt.pn * tstep : cB;
        for (int t = 0; t < nt; t += 2) {
            const bool last = (t == nt - 2);
            const char* a1 = cA + (size_t)(t + 1) * kstep;
            const char* a2 = last ? nA : cA + (size_t)(t + 2) * kstep; const char* b2 = last ? nB : cB + (size_t)(t + 2) * kstep;
            const char* a3 = a2 + kstep; const char* b3 = b2 + kstep;
            if (last && has_next) S.a_ready(nxt);
            if constexpr (SP2) {
            PG8_LDB(B0, 0, 0); PG8_LDB(B1, 0, 1); PG8_SCHED; PG8_LDA(At, 0, 0); PG8_STAGE(PG8_SA(1, 1), a1 + hstep, voffA);
            PG8_WAIT_V(8); PG8_WAIT_L(0); PG8_BAR; PG8_MMA(0, 0, At, B0); PG8_MMA(0, 1, At, B1); PG8_BAR; PG8_SCHED;
            PG8_LDA(At, 0, 1); PG8_STAGE(PG8_SB(0, 0), b2, voffB); PG8_STAGE(PG8_SB(0, 1), b2 + hstep, voffB); PG8_STAGE(PG8_SA(0, 0), a2, voffA);
            PG8_WAIT_V(8); PG8_WAIT_L(0); PG8_BAR; PG8_MMA(1, 0, At, B0); PG8_MMA(1, 1, At, B1); PG8_BAR; PG8_SCHED;
            PG8_LDB(B0, 1, 0); PG8_LDB(B1, 1, 1); PG8_SCHED; PG8_LDA(At, 1, 0); PG8_STAGE(PG8_SA(0, 1), a2 + hstep, voffA);
            PG8_WAIT_V(8); PG8_WAIT_L(0); PG8_BAR; PG8_MMA(0, 0, At, B0); PG8_MMA(0, 1, At, B1); PG8_BAR; PG8_SCHED;
            PG8_LDA(At, 1, 1); PG8_STAGE(PG8_SB(1, 0), b3, voffB); PG8_STAGE(PG8_SB(1, 1), b3 + hstep, voffB); PG8_STAGE(PG8_SA(1, 0), a3, voffA);
            PG8_WAIT_V(8); PG8_WAIT_L(0); PG8_BAR; PG8_MMA(1, 0, At, B0); PG8_MMA(1, 1, At, B1); PG8_BAR; PG8_SCHED;
            } else {
            PG8_LDB(B0, 0, 0); PG8_SCHED; PG8_LDA(At, 0, 0); PG8_STAGE(PG8_SA(1, 1), a1 + hstep, voffA);
            PG8_WAIT_L(8); PG8_BAR; PG8_WAIT_L(0); PG8_MMA(0, 0, At, B0); PG8_BAR; PG8_SCHED;
            PG8_LDB(B1, 0, 1); PG8_STAGE(PG8_SB(0, 0), b2, voffB);
            PG8_BAR; PG8_WAIT_L(0); PG8_MMA(0, 1, At, B1); PG8_BAR;
            PG8_LDA(At, 0, 1); PG8_STAGE(PG8_SA(0, 0), a2, voffA);
            PG8_BAR; PG8_WAIT_L(0); PG8_MMA(1, 0, At, B0); PG8_BAR; PG8_SCHED;
            PG8_STAGE(PG8_SB(0, 1), b2 + hstep, voffB);
            PG8_WAIT_V(6); PG8_BAR; PG8_MMA(1, 1, At, B1); PG8_BAR;
            PG8_LDB(B0, 1, 0); PG8_SCHED; PG8_LDA(At, 1, 0); PG8_STAGE(PG8_SA(0, 1), a2 + hstep, voffA);
            PG8_WAIT_L(8); PG8_BAR; PG8_WAIT_L(0); PG8_MMA(0, 0, At, B0); PG8_BAR; PG8_SCHED;
            PG8_LDB(B1, 1, 1); PG8_STAGE(PG8_SB(1, 0), b3, voffB);
            PG8_BAR; PG8_WAIT_L(0); PG8_MMA(0, 1, At, B1); PG8_BAR;
            PG8_LDA(At, 1, 1); PG8_STAGE(PG8_SA(1, 0), a3, voffA);
            PG8_BAR; PG8_WAIT_L(0); PG8_MMA(1, 0, At, B0); PG8_BAR; PG8_SCHED;
            PG8_STAGE(PG8_SB(1, 1), b3 + hstep, voffB);
            PG8_WAIT_V(6); PG8_BAR; PG8_MMA(1, 1, At, B1); PG8_BAR;
            }
        }
        if constexpr (ALIGN_EPI) { if (wr == 0) PG8_BAR; }
        if constexpr (!Epi::AFTER_DRAIN) { E(acc, cur, wr, wc, fr, fq); S.done(cur); }
        if (!has_next) break;
#pragma unroll
        for (int a = 0; a < 2; ++a)
#pragma unroll
            for (int b = 0; b < 2; ++b)
#pragma unroll
                for (int m = 0; m < 4; ++m)
#pragma unroll
                    for (int n = 0; n < 2; ++n) acc[a][b][m][n] = (f32x4){0.f, 0.f, 0.f, 0.f};
        cur = nxt; cA = nA; cB = nB; ++ui;
        if constexpr (ALIGN_EPI) { if (wr == 1) PG8_BAR; }
    }
    PG8_WAIT_V(0);
    if constexpr (!ALIGN_EPI) { if (wr == 0) PG8_BAR; }
    PG8_BAR;
    if constexpr (Epi::AFTER_DRAIN) { E.fused(acc, cur, wr, wc, fr, fq, lds, wid, lane); S.done(cur); }
#undef PG8_SA
#undef PG8_SB
#undef PG8_STAGE
#undef PG8_LDA
#undef PG8_LDB
#undef PG8_MMA
#undef PG8_WAIT_V
#undef PG8_WAIT_L
#undef PG8_BAR
#undef PG8_SCHED
}
}
constexpr int NWAVES = 8;
constexpr int BATCH = 8, SEQ = 4096, D = 1024, T = BATCH * SEQ;
constexpr int NPROJ = 5376;
constexpr int NTILE = NPROJ / 256;
constexpr float EPS = 1e-6f;
#ifndef MK_N_LAUNCHES
#define MK_N_LAUNCHES 1
#endif
#ifndef DBG_NPH
#define DBG_NPH 12
#endif
constexpr int NPH = DBG_NPH;
constexpr int N_LAUNCHES = MK_N_LAUNCHES;
static_assert(N_LAUNCHES == 1 || N_LAUNCHES == NPH, "MK_N_LAUNCHES is 1 or NPH");

constexpr size_t MiB = 1u << 20;
constexpr size_t WS_CTL = 0, CTL_ZERO_BYTES = 1 * MiB;
constexpr size_t WS_SMALL = 1 * MiB;
constexpr size_t WS_WIN = 2 * MiB;
constexpr size_t WS_WPA = 13 * MiB, WS_WPM = 14 * MiB, WS_WOUT = 15 * MiB;
constexpr size_t WS_TOKE = 17 * MiB;
constexpr size_t WS_TOKR = WS_TOKE + 256 * 1024;
constexpr size_t WS_TOKP = WS_TOKR + 256 * 1024;
constexpr size_t WS_TOKG = WS_TOKP + 256 * 1024;
constexpr size_t WS_CNT = WS_TOKG + 256 * 1024;
constexpr size_t WS_GU = 20 * MiB;
constexpr size_t WS_DN = 84 * MiB;
constexpr size_t WS_PROJ = 116 * MiB;
constexpr size_t PROJ_TILE = (size_t)T * 256 * 2;
constexpr size_t WS_MLST = 116 * MiB;
constexpr size_t WS_MERGED = 116 * MiB;
constexpr size_t WS_XN = 180 * MiB;
constexpr size_t WS_XG = 244 * MiB;
constexpr size_t WS_HID = 388 * MiB;
constexpr size_t WS_Y = 244 * MiB;
constexpr size_t WS_END = 460 * MiB;
static_assert(WS_PROJ + NTILE * PROJ_TILE == 452 * MiB, "proj map");
constexpr size_t DO_H = 0, DO_YATT = 0, DO_YML = 32 * MiB, DO_KN = 64 * MiB, DO_IKR = 72 * MiB, DO_IQR = 74 * MiB, DO_AQN = 90 * MiB;
constexpr int TL_AQ = 0, TL_KV = 2, TL_IQ = 3, TL_SM = 4, TL_MQ = 5, TL_MK = 7, TL_MV = 9, TL_MO = 11, TL_GA = 13, TL_GM = 17;
constexpr int CW_BAR = 4096;
constexpr int CW_Q = 16384;
constexpr int LDS_BYTES = 163840, MISC_OFF = LDS_BYTES - 512;

#define GAS __attribute__((address_space(1)))
#define LAS __attribute__((address_space(3)))
typedef unsigned short bf16;
typedef unsigned v4u __attribute__((ext_vector_type(4)));
typedef unsigned v2u __attribute__((ext_vector_type(2)));
typedef float f32x4 __attribute__((ext_vector_type(4)));
typedef float f32x2 __attribute__((ext_vector_type(2)));
typedef short bf16x8 __attribute__((ext_vector_type(8)));
typedef GAS unsigned gu32;
#define RLX_AGENT __ATOMIC_RELAXED, __HIP_MEMORY_SCOPE_AGENT
#define LDS_WAIT() asm volatile("s_waitcnt lgkmcnt(0)" ::: "memory")
__device__ __forceinline__ float bf2f(unsigned b16) { return __uint_as_float(b16 << 16); }
__device__ __forceinline__ unsigned f2bf(float f) { unsigned u = __float_as_uint(f); return (u + 0x7fffu + ((u >> 16) & 1u)) >> 16; }
__device__ __forceinline__ unsigned pk2(float lo, float hi) { return pg8::cvt_pk_bf16(lo, hi); }
__device__ __forceinline__ float sigm(float x) { return 1.0f / (1.0f + __expf(-x)); }
__device__ __forceinline__ float wave_sum(float v) {
#pragma unroll
    for (int o = 1; o < 64; o <<= 1) v += __shfl_xor(v, o);
    return v;
}
__device__ __forceinline__ void unpack8(const v4u r, float (&f)[8]) {
    f[0] = bf2f(r.x & 0xffffu); f[1] = bf2f(r.x >> 16); f[2] = bf2f(r.y & 0xffffu); f[3] = bf2f(r.y >> 16);
    f[4] = bf2f(r.z & 0xffffu); f[5] = bf2f(r.z >> 16); f[6] = bf2f(r.w & 0xffffu); f[7] = bf2f(r.w >> 16);
}
__device__ __forceinline__ v4u pack8(const float (&f)[8]) { v4u w; w.x = pk2(f[0], f[1]); w.y = pk2(f[2], f[3]); w.z = pk2(f[4], f[5]); w.w = pk2(f[6], f[7]); return w; }
#define XB_TMO      128
#define XB_XCNT(j)  (256  + 64 * (j))
#define XB_XSUB(j)  (1280 + 64 * (j))
#define XB_XGEN(j)  (2304 + 64 * (j))
#define XB_TOP      3328
#define XB_TOPGEN   3392
#define XCD_BAR_WORDS 3456
#define XB_SPIN_CAP (1u << 18)

__device__ __forceinline__ unsigned xb_ld(unsigned* p)              { return __hip_atomic_load(p, __ATOMIC_RELAXED, __HIP_MEMORY_SCOPE_AGENT); }
__device__ __forceinline__ unsigned xb_add(unsigned* p, unsigned v) { return __hip_atomic_fetch_add(p, v, __ATOMIC_RELAXED, __HIP_MEMORY_SCOPE_AGENT); }
__device__ __forceinline__ unsigned xb_xcc_id() { return (unsigned)__builtin_amdgcn_s_getreg((3 << 11) | 20) & 0xFu; }
#define XB_SPIN(cond, bar) do { unsigned _sp = 0; while (cond) { __builtin_amdgcn_s_sleep(1); \
    if ((++_sp & 255u) == 0u) { if (xb_ld(&(bar)[XB_TMO])) break; if (_sp > XB_SPIN_CAP) { atomicAdd(&(bar)[XB_TMO], 1u); break; } } } } while (0)

struct XcdBarrier {
    unsigned* bar; unsigned x;
    volatile LAS unsigned* st;
};

__device__ __forceinline__ XcdBarrier xcd_barrier_post(unsigned* bar, volatile LAS unsigned* st) {
    XcdBarrier b; b.bar = bar; b.x = xb_xcc_id(); b.st = st;
    if (threadIdx.x == 0) (void)xb_add(&bar[XB_XCNT(b.x)], 1u);
    return b;
}
__device__ __forceinline__ void xcd_barrier_complete(unsigned* bar, unsigned x, unsigned& nloc, unsigned& nx) {
    const unsigned G = gridDim.x * gridDim.y * gridDim.z;
    unsigned sum, cnt, mine, sp = 0u;
    for (;;) {
        sum = 0u; cnt = 0u; mine = 0u;
#pragma unroll
        for (unsigned j = 0; j < 16; ++j) { const unsigned c = xb_ld(&bar[XB_XCNT(j)]); sum += c; cnt += (c > 0u) ? 1u : 0u; mine = (j == x) ? c : mine; }
        if (sum == G) break;
        __builtin_amdgcn_s_sleep(1);
        if ((++sp & 255u) == 0u) { if (xb_ld(&bar[XB_TMO])) break; if (sp > XB_SPIN_CAP) { atomicAdd(&bar[XB_TMO], 1u); break; } }
    }
    nloc = mine > 0u ? mine : 1u; nx = cnt > 0u ? cnt : 1u;
}

__device__ __forceinline__ void xcd_barrier(const XcdBarrier& b) {
    asm volatile("s_waitcnt vmcnt(0)" ::: "memory");
    __syncthreads();
    if (threadIdx.x == 0) {
        unsigned* bar = b.bar;
        __builtin_amdgcn_s_waitcnt(0);
        unsigned nloc = b.st[0], nx = b.st[1];
        if (nloc == 0u) { xcd_barrier_complete(bar, b.x, nloc, nx); b.st[0] = nloc; b.st[1] = nx; }
        const unsigned old = xb_add(&bar[XB_XSUB(b.x)], 1u);
        const unsigned gen = old / nloc;
        if (old + 1u == (gen + 1u) * nloc) {
            __builtin_amdgcn_fence(__ATOMIC_RELEASE, "agent");
            asm volatile("s_waitcnt vmcnt(0)" ::: "memory");
            const unsigned og = xb_add(&bar[XB_TOP], 1u);
            const unsigned tg = og / nx;
            if (og + 1u == (tg + 1u) * nx) xb_add(&bar[XB_TOPGEN], 1u);
            else XB_SPIN(xb_ld(&bar[XB_TOPGEN]) == tg, bar);
            __builtin_amdgcn_fence(__ATOMIC_ACQUIRE, "agent");
            xb_add(&bar[XB_XGEN(b.x)], 1u);
            asm volatile("s_waitcnt vmcnt(0)" ::: "memory");
        } else {
            XB_SPIN(xb_ld(&bar[XB_XGEN(b.x)]) == gen, bar);
            __builtin_amdgcn_fence(__ATOMIC_ACQUIRE, "agent");
            asm volatile("s_waitcnt vmcnt(0)" ::: "memory");
        }
    }
    __syncthreads();
}
struct Args { const float* in[22]; float* out; unsigned char* ws; int ph_lo, ph_hi, li, pad; };
struct Ctx { int tid, lane, wave, G, vcu; LAS unsigned char* lds; };
#define IN_X 0
#define IN_POS 1
#define IN_GMIX 2
#define IN_WIN 3
#define IN_GQ 4
#define IN_GK 5
#define IN_WCONV 6
#define IN_BCONV 7
#define IN_BI 8
#define IN_BF 9
#define IN_GML 10
#define IN_WPA 11
#define IN_WPM 12
#define IN_WOUT 13
#define IN_GMOE 14
#define IN_WRG 15
#define IN_BRG 16
#define IN_WRE 17
#define IN_BRE 18
#define IN_WEG 19
#define IN_WEU 20
#define IN_WED 21

__device__ __forceinline__ int win_src_col(int n) {
    if (n < 1064) return n;
    if (n < 1068) return 3112 + (n - 1064);
    if (n < 1072) return 3116 + (n - 1068);
    if (n < 1280) return -1;
    if (n < 3328) return n - 216;
    return n - 208;
}
__device__ __forceinline__ void tr_item(const float* W, int ldw, int scol, int k0, bf16* wt0, int K, LAS float* scr, int lane) {
#pragma unroll 8
    for (int i = 0; i < 32; ++i) { const int kk = 2 * i + (lane >> 5); scr[kk * 33 + (lane & 31)] = scol >= 0 ? W[(size_t)(k0 + kk) * ldw + scol] : 0.f; }
    LDS_WAIT(); asm volatile("" ::: "memory");
    const int c = lane & 7;
#pragma unroll
    for (int j = 0; j < 4; ++j) { const int n = (lane >> 3) + 8 * j; const LAS float* s = scr + (8 * c) * 33 + n;
        v4u o; o.x = pk2(s[0 * 33], s[1 * 33]); o.y = pk2(s[2 * 33], s[3 * 33]); o.z = pk2(s[4 * 33], s[5 * 33]); o.w = pk2(s[6 * 33], s[7 * 33]);
        *(v4u*)(wt0 + (size_t)n * K + 8 * c) = o; }
    LDS_WAIT(); asm volatile("" ::: "memory");
}
__device__ __forceinline__ void p0_prologue(const Args& a, const Ctx& c) {
    unsigned char* ws = a.ws;
    LAS float* scr = (LAS float*)(c.lds + c.wave * 16384);
    const int gw = c.vcu * NWAVES + c.wave, NGW = c.G * NWAVES, lane = c.lane;
    constexpr int I_IN = 16 * 168, I_PA = 8 * 32, I_PM = 8 * 32, I_OUT = 16 * 32, I_GU = 32 * 16 * 32, I_DN = 32 * 8 * 32;
    constexpr int NIT = I_IN + I_PA + I_PM + I_OUT + I_GU + I_DN;
    for (int it = gw; it < NIT; it += NGW) {
        int r = it;
        if (r < I_IN) { const int kb = r / 168, nb = r % 168; tr_item(a.in[IN_WIN], 5168, win_src_col(32 * nb + (lane & 31)), 64 * kb, (bf16*)(ws + WS_WIN) + (size_t)(32 * nb) * 1024 + 64 * kb, 1024, scr, lane); continue; } r -= I_IN;
        if (r < I_PA) { const int kb = r / 32, nb = r % 32; tr_item(a.in[IN_WPA], 1024, 32 * nb + (lane & 31), 64 * kb, (bf16*)(ws + WS_WPA) + (size_t)(32 * nb) * 512 + 64 * kb, 512, scr, lane); continue; } r -= I_PA;
        if (r < I_PM) { const int kb = r / 32, nb = r % 32; tr_item(a.in[IN_WPM], 1024, 32 * nb + (lane & 31), 64 * kb, (bf16*)(ws + WS_WPM) + (size_t)(32 * nb) * 512 + 64 * kb, 512, scr, lane); continue; } r -= I_PM;
        if (r < I_OUT) { const int kb = r / 32, nb = r % 32; tr_item(a.in[IN_WOUT], 1024, 32 * nb + (lane & 31), 64 * kb, (bf16*)(ws + WS_WOUT) + (size_t)(32 * nb) * 1024 + 64 * kb, 1024, scr, lane); continue; } r -= I_OUT;
        if (r < I_GU) { const int e = r / 512, q = r % 512, kb = q / 32, nb = q % 32, t = nb >> 3, bj = (nb >> 2) & 1, i0 = (nb & 3) * 32;
            const float* src = (bj ? a.in[IN_WEU] : a.in[IN_WEG]) + (size_t)e * 1024 * 512;
            tr_item(src, 512, 128 * t + i0 + (lane & 31), 64 * kb, (bf16*)(ws + WS_GU) + ((size_t)e * 1024 + 32 * nb) * 1024 + 64 * kb, 1024, scr, lane); continue; } r -= I_GU;
        { const int e = r / 256, q = r % 256, kb = q / 32, nb = q % 32;
            tr_item(a.in[IN_WED] + (size_t)e * 512 * 1024, 1024, 32 * nb + (lane & 31), 64 * kb, (bf16*)(ws + WS_DN) + ((size_t)e * 1024 + 32 * nb) * 512 + 64 * kb, 512, scr, lane); }
    }
    const float* g = a.in[IN_GMIX]; f32x4 gv[4];
#pragma unroll
    for (int j = 0; j < 4; ++j) gv[j] = *(const f32x4*)(g + 4 * lane + 256 * j);
    bf16* H = (bf16*)((unsigned char*)a.out + DO_H);
    for (int m = gw; m < T; m += NGW) {
        const f32x4* xr = (const f32x4*)(a.in[IN_X] + (size_t)m * D) + lane; f32x4 v[4]; float s = 0.f;
#pragma unroll
        for (int j = 0; j < 4; ++j) { v[j] = xr[64 * j]; s += (v[j].x * v[j].x + v[j].y * v[j].y) + (v[j].z * v[j].z + v[j].w * v[j].w); }
        const float r = rsqrtf(wave_sum(s) * (1.f / D) + EPS);
        v2u* o8 = (v2u*)(H + (size_t)m * D) + lane;
#pragma unroll
        for (int j = 0; j < 4; ++j) { v2u w; w.x = pk2(v[j].x * r * gv[j].x, v[j].y * r * gv[j].y); w.y = pk2(v[j].z * r * gv[j].z, v[j].w * r * gv[j].w); o8[64 * j] = w; }
    }
}

__device__ __forceinline__ const bf16* proj_tile(const Args& a, int tile) { return (const bf16*)(a.ws + WS_PROJ + (size_t)tile * PROJ_TILE); }
__device__ __forceinline__ void p2_prep(const Args& a, const Ctx& c) {
    const int lane = c.lane, gw = c.vcu * NWAVES + c.wave, NGW = c.G * NWAVES;
    float invf = 0.f;
    if (lane < 8) invf = (float)pow(500000.0, -(double)lane / 8.0); else if (lane < 12) invf = (float)pow(500000.0, -(double)(lane - 8) / 4.0);
    float gq[8], gk[8];
#pragma unroll
    for (int i = 0; i < 8; ++i) { gq[i] = a.in[IN_GQ][8 * (lane & 7) + i]; gk[i] = a.in[IN_GK][8 * (lane & 7) + i]; }
    const int* pos = (const int*)a.in[IN_POS];
    unsigned char* dout = (unsigned char*)a.out;
    bf16* AQN = (bf16*)(dout + DO_AQN); bf16* KN = (bf16*)(dout + DO_KN); bf16* IQR = (bf16*)(dout + DO_IQR); bf16* IKR = (bf16*)(dout + DO_IKR);
    const int l7 = lane & 7;
    for (int t = gw; t < T; t += NGW) {
        const float ang = (float)pos[t] * invf;
        float cs = (float)cos((double)ang), sn = (float)sin((double)ang);
        float ca[8], sa[8], ci[4], si[4];
#pragma unroll
        for (int i = 0; i < 8; ++i) { ca[i] = __shfl(cs, i); sa[i] = __shfl(sn, i); }
#pragma unroll
        for (int i = 0; i < 4; ++i) { ci[i] = __shfl(cs, 8 + i); si[i] = __shfl(sn, 8 + i); }
        { const int col = (lane >> 3) * 64 + 8 * l7; const bf16* src = proj_tile(a, TL_AQ + (col >> 8)) + (size_t)t * 256 + (col & 255);
          float f[8]; unpack8(*(const v4u*)src, f); float ss = 0.f;
#pragma unroll
          for (int i = 0; i < 8; ++i) ss += f[i] * f[i];
          ss += __shfl_xor(ss, 1); ss += __shfl_xor(ss, 2); ss += __shfl_xor(ss, 4);
          const float r = rsqrtf(ss * (1.f / 64.f) + EPS);
#pragma unroll
          for (int i = 0; i < 8; ++i) f[i] = f[i] * r * gq[i];
          float o[8];
#pragma unroll
          for (int i = 0; i < 8; ++i) { const float p = __shfl_xor(f[i], 1); o[i] = (l7 == 0) ? (f[i] * ca[i] - p * sa[i]) : ((l7 == 1) ? (f[i] * ca[i] + p * sa[i]) : f[i]); o[i] *= 0.125f * 1.4426950408889634f; }
          *(v4u*)(AQN + (size_t)t * 512 + col) = pack8(o); }
        { const int l15 = lane & 15; const int col = (l15 >> 3) * 64 + 8 * l7; const bf16* src = proj_tile(a, TL_KV) + (size_t)t * 256 + col;
          float f[8]; unpack8(*(const v4u*)src, f); float ss = 0.f;
#pragma unroll
          for (int i = 0; i < 8; ++i) ss += f[i] * f[i];
          ss += __shfl_xor(ss, 1); ss += __shfl_xor(ss, 2); ss += __shfl_xor(ss, 4);
          const float r = rsqrtf(ss * (1.f / 64.f) + EPS);
#pragma unroll
          for (int i = 0; i < 8; ++i) f[i] = f[i] * r * gk[i];
          float o[8];
#pragma unroll
          for (int i = 0; i < 8; ++i) { const float p = __shfl_xor(f[i], 1); o[i] = (l7 == 0) ? (f[i] * ca[i] - p * sa[i]) : ((l7 == 1) ? (f[i] * ca[i] + p * sa[i]) : f[i]); }
          if (lane < 16) *(v4u*)(KN + (size_t)t * 128 + col) = pack8(o); }
        { const bf16* src = proj_tile(a, TL_IQ) + (size_t)t * 256 + 4 * lane; const v2u rw = *(const v2u*)src;
          float f[4] = {bf2f(rw.x & 0xffffu), bf2f(rw.x >> 16), bf2f(rw.y & 0xffffu), bf2f(rw.y >> 16)}; float o[4];
#pragma unroll
          for (int i = 0; i < 4; ++i) { const float p = __shfl_xor(f[i], 1); o[i] = (l7 == 0) ? (f[i] * ci[i] - p * si[i]) : ((l7 == 1) ? (f[i] * ci[i] + p * si[i]) : f[i]); }
          v2u w; w.x = pk2(o[0], o[1]); w.y = pk2(o[2], o[3]); *(v2u*)(IQR + (size_t)t * 256 + 4 * lane) = w; }
        { const bf16* src = proj_tile(a, TL_SM) + (size_t)t * 256 + 4 * l7; const v2u rw = *(const v2u*)src;
          float f[4] = {bf2f(rw.x & 0xffffu), bf2f(rw.x >> 16), bf2f(rw.y & 0xffffu), bf2f(rw.y >> 16)}; float o[4];
#pragma unroll
          for (int i = 0; i < 4; ++i) { const float p = __shfl_xor(f[i], 1); o[i] = (l7 == 0) ? (f[i] * ci[i] - p * si[i]) : ((l7 == 1) ? (f[i] * ci[i] + p * si[i]) : f[i]); }
          v2u w; w.x = pk2(o[0], o[1]); w.y = pk2(o[2], o[3]); if (lane < 8) *(v2u*)(IKR + (size_t)t * 32 + 4 * l7) = w; }
    }
}
constexpr int ML_QS = 0, ML_KS = 17408, ML_HS = 0;
constexpr int ML_KWT = 34816;
constexpr int ML_VT = 53248;
constexpr int ML_SW = 73984;
constexpr int ML_CT = 83200;
constexpr int ML_GA = 122368;
constexpr int ML_CW = ML_GA + 1024;
constexpr int ML_END = ML_CW + (1024 + 384) * 4;
static_assert(ML_END <= MISC_OFF, "mLSTM LDS map");
constexpr size_t ML_STATE_BYTES = 8 * 9 * 64 * 16;
__device__ __forceinline__ bf16x8 lds_frag(const LAS unsigned char* base, int stride_b, int row0, int kb, int lane) {
    return *(const LAS bf16x8*)(base + (row0 + (lane & 15)) * stride_b + kb + (lane >> 4) * 16);
}
__device__ __forceinline__ bf16x8 lds_frag_sw(const LAS unsigned char* base, int row0, int ks, int lane) {
    const int row = row0 + (lane & 15); return *(const LAS bf16x8*)(base + row * 144 + 16 * (((ks * 4 + (lane >> 4)) + (row >> 3)) & 7));
}
#define MFMA16(a_, b_, c_) __builtin_amdgcn_mfma_f32_16x16x32_bf16(a_, b_, c_, 0, 0, 0)
template <int MODE>
__device__ __forceinline__ void mlstm_unit(const Args& a, const Ctx& c, int b, int h, int g) {
    const int tid = c.tid, wave = c.wave; LAS unsigned char* lds = c.lds;
#define ML_LAUNDER() int tv_ = tid; asm volatile("" : "+v"(tv_)); const int lane = tv_ & 63, seg = tv_ & 15, r2 = (tv_ >> 4) * 2; (void)lane; (void)seg; (void)r2
    const bf16* PQ = proj_tile(a, TL_MQ + (h >> 1)) + (h & 1) * 128;
    const bf16* PK = proj_tile(a, TL_MK + (h >> 1)) + (h & 1) * 128;
    const bf16* PV = proj_tile(a, TL_MV + (h >> 1)) + (h & 1) * 128;
    const bf16* PO = proj_tile(a, TL_MO + (h >> 1)) + (h & 1) * 128;
    const bf16* PS = proj_tile(a, TL_SM);
    bf16* YML = (bf16*)((unsigned char*)a.out + DO_YML);
    unsigned char* STB = a.ws + WS_MLST; float* MST = (float*)(a.ws + WS_MLST + 256 * ML_STATE_BYTES);
    LAS float* GAa = (LAS float*)(lds + ML_GA); LAS float* GAm = GAa + 64; LAS float* GAw = GAa + 128; LAS float* GAe = GAa + 192;
    LAS float* CWQ = (LAS float*)(lds + ML_CW); LAS float* CWK = CWQ + 512; LAS float* CBQ = CWQ + 1024; LAS float* CBK = CBQ + 128; LAS float* GN = CBK + 128;
    LAS bf16* VTs = (LAS bf16*)(lds + ML_VT);
    { const float* wc = a.in[IN_WCONV]; const int j = tid >> 7, d = tid & 127;
      CWQ[tid] = wc[j * 1024 + h * 128 + d]; CWK[tid] = wc[j * 1024 + 512 + h * 128 + d];
      if (tid < 128) { CBQ[tid] = a.in[IN_BCONV][h * 128 + tid]; CBK[tid] = a.in[IN_BCONV][512 + h * 128 + tid]; GN[tid] = a.in[IN_GML][h * 128 + tid]; } }
    for (int i = tid; i < 16 * 64; i += 512) { const int r = i >> 6, cc = i & 63; VTs[(128 + r) * 72 + cc] = (r == 0) ? (bf16)0x3F80 : (bf16)0; }
    const float big = a.in[IN_BI][h], bfg = a.in[IN_BF][h];
    const int slot0 = (b * 4 + h) * 8;
    f32x4 cacc[9];
    float m_st = 0.f;
    if (MODE == 1 && g > 0) { ML_LAUNDER();
        const f32x4* sp = (const f32x4*)(STB + (size_t)(slot0 + g) * ML_STATE_BYTES) + wave * 576 + lane;
#pragma unroll
        for (int i = 0; i < 9; ++i) cacc[i] = sp[64 * i];
        m_st = MST[slot0 + g];
#pragma unroll
        for (int ee = 0; ee < 9; ++ee) { v2u w; w.x = pk2(cacc[ee][0], cacc[ee][1]); w.y = pk2(cacc[ee][2], cacc[ee][3]);
            *(LAS v2u*)(lds + ML_CT + (ee * 16 + (lane & 15)) * 272 + (wave * 16 + 4 * (lane >> 4)) * 2) = w; }
    } else {
#pragma unroll
        for (int i = 0; i < 9; ++i) cacc[i] = (f32x4){0.f, 0.f, 0.f, 0.f};
        for (int i = tid; i < 144 * 136 / 2; i += 512) ((LAS unsigned*)(lds + ML_CT))[i] = 0u;
    }
    const size_t tb = (size_t)b * SEQ;
    const char* bq = (const char*)(PQ + tb * 256); const char* bk = (const char*)(PK + tb * 256); const char* bv = (const char*)(PV + tb * 256); const char* bo = (const char*)(PO + tb * 256); const char* bs = (const char*)(PS + tb * 256);
    v4u rq[5], rk[5], rv[2]; unsigned short gi = 0, gf = 0;
#define ML_LOAD(kc) do { _Pragma("unroll") for (int j_ = 0; j_ < 5; ++j_) { const int rr_ = 64 * (kc) + r2 - 3 + j_; const unsigned o_ = (unsigned)((rr_ < 0 ? 0 : rr_) * 512 + seg * 16); \
            v4u q_ = (v4u){0u, 0u, 0u, 0u}; if (MODE == 1) q_ = *(const v4u*)(bq + o_); v4u k_ = *(const v4u*)(bk + o_); if (rr_ < 0) { q_ = (v4u){0u, 0u, 0u, 0u}; k_ = q_; } rq[j_] = q_; rk[j_] = k_; } \
        _Pragma("unroll") for (int i_ = 0; i_ < 2; ++i_) rv[i_] = *(const v4u*)(bv + (unsigned)((64 * (kc) + r2 + i_) * 512 + seg * 16)); \
        gi = *(const unsigned short*)(bs + (unsigned)((64 * (kc) + lane) * 512 + (40 + h) * 2)); gf = *(const unsigned short*)(bs + (unsigned)((64 * (kc) + lane) * 512 + (44 + h) * 2)); } while (0)
    const int kc0 = (MODE == 1) ? 8 * g : 0, kc1 = (MODE == 1) ? 8 * g + 8 : 56;
    { ML_LAUNDER(); ML_LOAD(kc0); }
    __syncthreads();
#pragma unroll 1
    for (int kc = kc0; kc < kc1; ++kc) {
        float wkv, decay, m_new;
        if (MODE == 0 && kc > 0 && (kc & 7) == 0) { ML_LAUNDER();
            f32x4* sp = (f32x4*)(STB + (size_t)(slot0 + (kc >> 3)) * ML_STATE_BYTES) + wave * 576 + lane;
#pragma unroll
            for (int i = 0; i < 9; ++i) sp[64 * i] = cacc[i];
            if (tid == 0) MST[slot0 + (kc >> 3)] = m_st; }
        { ML_LAUNDER();
        const float fpre = bf2f(gf) + bfg, lf = fminf(fpre, 0.f) - log1pf(__expf(-fabsf(fpre)));
        const float ig = bf2f(gi) + big;
        float bc = lf;
#pragma unroll
        for (int o = 1; o < 64; o <<= 1) { const float v = __shfl_up(bc, o); if (lane >= o) bc += v; }
        const float av = ig - bc; float Ac = av;
#pragma unroll
        for (int o = 1; o < 64; o <<= 1) { const float v = __shfl_up(Ac, o); if (lane >= o) Ac = fmaxf(Ac, v); }
        const float mA = fmaxf(m_st, Ac), Mk = __shfl(mA, 63), blast = __shfl(bc, 63);
        wkv = __expf(av - Mk); decay = __expf(m_st - Mk); m_new = blast + Mk;
        if (MODE == 1 && wave == 0) { GAa[lane] = av; GAm[lane] = mA; GAw[lane] = __expf(m_st - mA); GAe[lane] = __expf(-(bc + mA)); } }
        { ML_LAUNDER(); float kw_[2][8];
#pragma unroll
          for (int i = 0; i < 2; ++i) { const int t = r2 + i; const float wkt = __shfl(wkv, t);
            float aq_[8], ak_[8];
            { const f32x4 b0 = *(const LAS f32x4*)(CBQ + seg * 8), b1 = *(const LAS f32x4*)(CBQ + seg * 8 + 4), c0 = *(const LAS f32x4*)(CBK + seg * 8), c1 = *(const LAS f32x4*)(CBK + seg * 8 + 4);
              aq_[0] = b0[0]; aq_[1] = b0[1]; aq_[2] = b0[2]; aq_[3] = b0[3]; aq_[4] = b1[0]; aq_[5] = b1[1]; aq_[6] = b1[2]; aq_[7] = b1[3];
              ak_[0] = c0[0]; ak_[1] = c0[1]; ak_[2] = c0[2]; ak_[3] = c0[3]; ak_[4] = c1[0]; ak_[5] = c1[1]; ak_[6] = c1[2]; ak_[7] = c1[3]; }
#pragma unroll
            for (int j = 0; j < 4; ++j) { float fk_[8]; unpack8(rk[i + j], fk_);
                const f32x4 x0 = *(const LAS f32x4*)(CWK + j * 128 + seg * 8), x1 = *(const LAS f32x4*)(CWK + j * 128 + seg * 8 + 4);
#pragma unroll
                for (int e = 0; e < 4; ++e) { ak_[e] += x0[e] * fk_[e]; ak_[4 + e] += x1[e] * fk_[4 + e]; }
                if (MODE == 1) { float fq_[8]; unpack8(rq[i + j], fq_);
                    const f32x4 w0 = *(const LAS f32x4*)(CWQ + j * 128 + seg * 8), w1 = *(const LAS f32x4*)(CWQ + j * 128 + seg * 8 + 4);
#pragma unroll
                    for (int e = 0; e < 4; ++e) { aq_[e] += w0[e] * fq_[e]; aq_[4 + e] += w1[e] * fq_[4 + e]; } } }
#pragma unroll
            for (int e = 0; e < 8; ++e) { ak_[e] = ak_[e] * sigm(ak_[e]) * 0.08838834764831845f; kw_[i][e] = ak_[e] * wkt; }
            if (MODE == 1) {
#pragma unroll
                for (int e = 0; e < 8; ++e) aq_[e] = aq_[e] * sigm(aq_[e]);
                *(LAS v4u*)(lds + ML_QS + t * 272 + seg * 16) = pack8(aq_);
                *(LAS v4u*)(lds + ML_KS + t * 272 + seg * 16) = pack8(ak_); } }
          const unsigned va[4] = {rv[0].x, rv[0].y, rv[0].z, rv[0].w}, vb[4] = {rv[1].x, rv[1].y, rv[1].z, rv[1].w};
          const int swo = 16 * (((r2 >> 3) + seg) & 7) + 2 * (r2 & 7);
#pragma unroll
          for (int e = 0; e < 8; ++e) { const int ro = (seg * 8 + e) * 144 + swo;
              *(LAS unsigned*)(lds + ML_KWT + ro) = pk2(kw_[0][e], kw_[1][e]);
              const unsigned lo = (e & 1) ? (va[e >> 1] >> 16) : (va[e >> 1] & 0xffffu), hi = (e & 1) ? (vb[e >> 1] >> 16) : (vb[e >> 1] & 0xffffu);
              *(LAS unsigned*)(lds + ML_VT + ro) = lo | (hi << 16); }
        if (kc + 1 < kc1) ML_LOAD(kc + 1); }
        __syncthreads();
        f32x4 hacc[5]; unsigned mo_r[8];
        const int tt = wave & 3, t0 = tt * 16, ne = (wave < 4) ? 5 : 4, e_first = (wave < 4) ? 0 : 5;
        if (MODE == 1) {
        { ML_LAUNDER(); const int tq = t0 + (lane & 15);
        bf16x8 qf[4];
#pragma unroll
        for (int ks = 0; ks < 4; ++ks) qf[ks] = lds_frag(lds + ML_QS, 272, t0, ks * 64, lane);
        const float mAt = GAm[tq], wit = GAw[tq];
#pragma unroll
        for (int si = 0; si < 2; ++si) { const int ss = 2 * (wave >> 2) + si, s0 = ss * 16; f32x4 sacc = (f32x4){0.f, 0.f, 0.f, 0.f};
            if (ss <= tt) {
#pragma unroll
                for (int ks = 0; ks < 4; ++ks) sacc = MFMA16(lds_frag(lds + ML_KS, 272, s0, ks * 64, lane), qf[ks], sacc);
#pragma unroll
                for (int r = 0; r < 4; ++r) { const int s = s0 + 4 * (lane >> 4) + r; sacc[r] = (s <= tq) ? sacc[r] * __expf(GAa[s] - mAt) : 0.f; } }
            v2u w; w.x = pk2(sacc[0], sacc[1]); w.y = pk2(sacc[2], sacc[3]);
            *(LAS v2u*)(lds + ML_SW + tq * 144 + s0 * 2 + (lane >> 4) * 8) = w; }
#pragma unroll
        for (int i = 0; i < 5; ++i) { hacc[i] = (f32x4){0.f, 0.f, 0.f, 0.f};
            if (i < ne) {
#pragma unroll
                for (int ks = 0; ks < 4; ++ks) hacc[i] = MFMA16(lds_frag(lds + ML_CT, 272, (e_first + i) * 16, ks * 64, lane), qf[ks], hacc[i]);
                hacc[i] = hacc[i] * wit; } }
#pragma unroll
        for (int i = 0; i < 8; ++i) mo_r[i] = *(const unsigned*)(bo + (unsigned)((64 * kc + 8 * wave + i) * 512 + 4 * lane)); }
        __syncthreads();
        { ML_LAUNDER(); const int tq = t0 + (lane & 15); bf16x8 swf[2];
#pragma unroll
          for (int ks = 0; ks < 2; ++ks) swf[ks] = lds_frag(lds + ML_SW, 144, t0, ks * 64, lane);
#pragma unroll
          for (int i = 0; i < 5; ++i) if (i < ne) { const int ee = e_first + i;
#pragma unroll
              for (int ks = 0; ks < 2; ++ks) hacc[i] = MFMA16(lds_frag_sw(lds + ML_VT, ee * 16, ks, lane), swf[ks], hacc[i]);
              if (ee < 8) *(LAS f32x4*)(lds + ML_HS + tq * 528 + (ee * 16 + 4 * (lane >> 4)) * 4) = hacc[i];
              else if ((lane >> 4) == 0) *(LAS float*)(lds + ML_HS + tq * 528 + 128 * 4) = hacc[i][0]; } }
        }
        { ML_LAUNDER(); const int d0 = wave * 16; bf16x8 kwf[2];
#pragma unroll
          for (int ks = 0; ks < 2; ++ks) kwf[ks] = lds_frag_sw(lds + ML_KWT, d0, ks, lane);
#pragma unroll
          for (int ee = 0; ee < 9; ++ee) { cacc[ee] = cacc[ee] * decay;
#pragma unroll
              for (int ks = 0; ks < 2; ++ks) cacc[ee] = MFMA16(kwf[ks], lds_frag_sw(lds + ML_VT, ee * 16, ks, lane), cacc[ee]);
              if (MODE == 1) { v2u w; w.x = pk2(cacc[ee][0], cacc[ee][1]); w.y = pk2(cacc[ee][2], cacc[ee][3]);
                  *(LAS v2u*)(lds + ML_CT + (ee * 16 + (lane & 15)) * 272 + (d0 + 4 * (lane >> 4)) * 2) = w; } } }
        __syncthreads();
        if (MODE == 1) {
        { ML_LAUNDER();
#pragma unroll
        for (int i = 0; i < 8; ++i) { const int t = 8 * wave + i;
            const f32x2 nv = *(const LAS f32x2*)(lds + ML_HS + t * 528 + lane * 8); const float den = *(const LAS float*)(lds + ML_HS + t * 528 + 512);
            const float dd = fmaxf(fabsf(den), GAe[t]); const float h0 = nv.x / dd, h1 = nv.y / dd;
            const float r = rsqrtf(wave_sum(h0 * h0 + h1 * h1) * (1.f / 128.f) + EPS);
            const float y0 = h0 * r * GN[2 * lane] * sigm(bf2f(mo_r[i] & 0xffffu)), y1 = h1 * r * GN[2 * lane + 1] * sigm(bf2f(mo_r[i] >> 16));
            *(unsigned*)(YML + (tb + 64 * kc + t) * 512 + h * 128 + 2 * lane) = pk2(y0, y1); } }
        __syncthreads();
        }
        m_st = m_new;
    }
    if (MODE == 0) { ML_LAUNDER();
        f32x4* sp = (f32x4*)(STB + (size_t)(slot0 + 7) * ML_STATE_BYTES) + wave * 576 + lane;
#pragma unroll
        for (int i = 0; i < 9; ++i) sp[64 * i] = cacc[i];
        if (tid == 0) MST[slot0 + 7] = m_st; }
#undef ML_LOAD
#undef ML_LAUNDER
}
constexpr int AT_HIST = 0;
constexpr int AT_HROW = 2049;
constexpr int AT_SEL = 131072 + 256;
constexpr int AT_SM = AT_SEL + 8192;
static_assert(AT_SM + 256 <= MISC_OFF, "attention LDS map");
__device__ __forceinline__ unsigned score_key(float s) { unsigned u = __float_as_uint(s + 0.0f); return (u & 0x80000000u) ? ~u : (u | 0x80000000u); }
template <int NK> __device__ __forceinline__ void at_resolve(const LAS unsigned long long* cand, LAS unsigned* mask, int m, int nd, int lane) {
    unsigned long long cv[NK];
#pragma unroll
    for (int k = 0; k < NK; ++k) { const int i = 64 * k + lane; unsigned long long x = 0ull; if (i < m) x = cand[i]; cv[k] = (i < m) ? ((((x >> 32) & 0xFFFFFull) << 16) | (x & 0xFFFFull)) : 0ull; }
    unsigned long long T = 0ull;
#pragma unroll 1
    for (int bit = 35; bit >= 16; --bit) { const unsigned long long test = T | (1ull << bit); int cge = 0;
#pragma unroll
        for (int k = 0; k < NK; ++k) cge += __popcll(__ballot(cv[k] >= test));
        if (cge >= nd) T = test; }
    int g = 0, t = 0;
#pragma unroll
    for (int k = 0; k < NK; ++k) { g += __popcll(__ballot(cv[k] >= T + 0x10000ull)); t += __popcll(__ballot(cv[k] >= T)); }
    t -= g;
    if (t > nd - g) {
#pragma unroll 1
        for (int bit = 15; bit >= 0; --bit) { const unsigned long long test = T | (1ull << bit); int cge = 0;
#pragma unroll
            for (int k = 0; k < NK; ++k) cge += __popcll(__ballot(cv[k] >= test));
            if (cge >= nd) T = test; } }
#pragma unroll
    for (int k = 0; k < NK; ++k) if (cv[k] >= T && cv[k] != 0ull) { const unsigned key = 0xFFFFu - (unsigned)(cv[k] & 0xFFFFull);
        __hip_atomic_fetch_or(&mask[key >> 5], 1u << (key & 31u), __ATOMIC_RELAXED, __HIP_MEMORY_SCOPE_WORKGROUP); }
}
__device__ __forceinline__ void attn_unit(const Args& a, const Ctx& c, int b, int qt) {
    const int tid = c.tid, wave = c.wave; LAS unsigned char* lds = c.lds;
#define AT_LAUNDER() int tv_ = tid; asm volatile("" : "+v"(tv_)); const int lane = tv_ & 63, qi = tv_ & 15, fq = (tv_ >> 4) & 3; (void)lane; (void)qi; (void)fq
    const int q0 = qt * 16, ch = q0 >> 6, n = 64 * (ch + 1), ntiles = n >> 4;
    const size_t tb = (size_t)b * SEQ;
    unsigned char* dout = (unsigned char*)a.out;
    const bf16* AQN = (const bf16*)(dout + DO_AQN); const bf16* KN = (const bf16*)(dout + DO_KN); const bf16* IQR = (const bf16*)(dout + DO_IQR); const bf16* IKR = (const bf16*)(dout + DO_IKR);
    bf16* YATT = (bf16*)(dout + DO_YATT);
    const bf16* VB = proj_tile(a, TL_KV); const bf16* PS = proj_tile(a, TL_SM);
    LAS unsigned* HIST = (LAS unsigned*)(lds + AT_HIST);
    LAS unsigned long long* CAND = (LAS unsigned long long*)(lds + AT_HIST);
    LAS unsigned* MASK = (LAS unsigned*)(lds + AT_SEL);
    LAS int* SM = (LAS int*)(lds + AT_SM);
#ifndef DBG_REP_SEL
#define DBG_REP_SEL 1
#endif
#ifndef DBG_REP_DENSE
#define DBG_REP_DENSE 1
#endif
#pragma unroll 1
    for (int rsel = 0; rsel < DBG_REP_SEL; ++rsel) {
    if (n > 256) {
        for (int i = tid; i < 8192 + 4; i += 512) ((LAS v4u*)HIST)[i] = (v4u){0u, 0u, 0u, 0u};
        if (tid < 64) SM[tid] = 0;
        for (int i = tid; i < 2048; i += 512) MASK[i] = 0u;
        bf16x8 qf[8]; float wv[8];
        { AT_LAUNDER();
        const size_t trow = tb + q0 + qi;
#pragma unroll
        for (int h = 0; h < 8; ++h) qf[h] = *(const bf16x8*)(IQR + trow * 256 + h * 32 + 8 * fq);
        { float t8[8]; unpack8(*(const v4u*)(PS + trow * 256 + 32), t8);
#pragma unroll
          for (int h = 0; h < 8; ++h) wv[h] = t8[h] * 0.0625f; } }
        __syncthreads();
#define AT_LOADK(kt_) (*(const bf16x8*)(IKR + (tb + (size_t)(kt_) * 16 + qi) * 32 + 8 * fq))
#define AT_SCORES(kf_, sc_) do { \
        _Pragma("unroll") for (int r_ = 0; r_ < 4; ++r_) sc_[r_] = 0.f; \
        _Pragma("unroll") for (int h_ = 0; h_ < 8; ++h_) { const f32x4 d_ = MFMA16(kf_, qf[h_], ((f32x4){0.f, 0.f, 0.f, 0.f})); \
            _Pragma("unroll") for (int r_ = 0; r_ < 4; ++r_) { const int di_ = __float_as_int(d_[r_]); sc_[r_] = __builtin_fmaf(wv[h_], __int_as_float(di_ > 0 ? di_ : 0), sc_[r_]); } } } while (0)
        const int cnt = (ntiles - wave + 7) >> 3;
#ifndef DBG_RA
#define DBG_RA 1
#endif
#pragma unroll 1
        for (int rA = 0; rA < DBG_RA; ++rA) { if (rA) { for (int i = tid; i < 8192 + 4; i += 512) ((LAS v4u*)HIST)[i] = (v4u){0u, 0u, 0u, 0u}; __syncthreads(); }
#define AT_LOADG(dst_, i0_) do { _Pragma("unroll") for (int j_ = 0; j_ < 8; ++j_) { int kt_ = wave + 8 * ((i0_) + j_); kt_ = kt_ < ntiles ? kt_ : ntiles - 1; dst_[j_] = AT_LOADK(kt_); } } while (0)
        { AT_LAUNDER(); bf16x8 kcur[8], knxt[8]; AT_LOADG(kcur, 0);
#pragma unroll 1
          for (int i0 = 0; i0 < cnt; i0 += 8) {
            if (i0 + 8 < cnt) AT_LOADG(knxt, i0 + 8);
#pragma unroll
            for (int j2 = 0; j2 < 8; ++j2) { const bool valid = (i0 + j2 < cnt); float sc[4]; AT_SCORES(kcur[j2], sc);
#pragma unroll
                for (int r = 0; r < 4; ++r) { const unsigned bin = score_key(sc[r]) >> 20;
                    __hip_atomic_fetch_add(&HIST[qi * AT_HROW + (bin >> 1)], valid ? (1u << ((bin & 1u) * 16)) : 0u, __ATOMIC_RELAXED, __HIP_MEMORY_SCOPE_WORKGROUP); } }
#pragma unroll
            for (int j2 = 0; j2 < 8; ++j2) kcur[j2] = knxt[j2]; } }
        __syncthreads();
        }
#ifndef DBG_RB
#define DBG_RB 1
#endif
#pragma unroll 1
        for (int rB = 0; rB < DBG_RB; ++rB) {
#pragma unroll 1
        for (int j = 0; j < 2; ++j) { AT_LAUNDER(); const int q = 2 * wave + j; unsigned tot = 0;
            for (int i = 0; i < 32; ++i) { const unsigned w = HIST[q * AT_HROW + 32 * lane + ((i + lane) & 31)]; tot += (w & 0xffffu) + (w >> 16); }
            unsigned suf = tot;
#pragma unroll
            for (int o = 1; o < 64; o <<= 1) { const unsigned v = __shfl_down(suf, o); if (lane + o < 64) suf += v; }
            const unsigned long long mk = __ballot(suf >= 256u); const int L = 63 - __clzll((long long)mk);
            const unsigned above_L = __shfl(suf - tot, L);
            const unsigned w2 = HIST[q * AT_HROW + 32 * L + (lane >> 1)]; const unsigned cb = (lane & 1) ? (w2 >> 16) : (w2 & 0xffffu);
            unsigned sfx = cb;
#pragma unroll
            for (int o = 1; o < 64; o <<= 1) { const unsigned v = __shfl_down(sfx, o); if (lane + o < 64) sfx += v; }
            const unsigned long long mk2 = __ballot(above_L + sfx >= 256u); const int l2 = 63 - __clzll((long long)mk2);
            if (lane == l2) { SM[q] = 64 * L + l2; SM[16 + q] = (int)(256u - (above_L + sfx - cb)); } }
        __syncthreads();
        }
#ifndef DBG_RC
#define DBG_RC 1
#endif
#pragma unroll 1
        for (int rC = 0; rC < DBG_RC; ++rC) { if (rC) { if (tid < 16) SM[48 + tid] = 0; __syncthreads(); }
        { AT_LAUNDER(); const int Bq = SM[qi]; bf16x8 kcur[8], knxt[8]; AT_LOADG(kcur, 0);
#pragma unroll 1
          for (int i0 = 0; i0 < cnt; i0 += 8) {
            if (i0 + 8 < cnt) AT_LOADG(knxt, i0 + 8);
#pragma unroll
            for (int j2 = 0; j2 < 8; ++j2) { const bool valid = (i0 + j2 < cnt); const int kt = wave + 8 * (i0 + j2); float sc[4]; AT_SCORES(kcur[j2], sc);
                unsigned nib = 0u;
#pragma unroll
                for (int r = 0; r < 4; ++r) { const unsigned u = score_key(sc[r]); const int bin = (int)(u >> 20); const int key = kt * 16 + 4 * fq + r;
                    if (bin > Bq) nib |= 1u << r;
                    else if (valid && bin == Bq) { const int p = __hip_atomic_fetch_add(&SM[48 + qi], 1, __ATOMIC_RELAXED, __HIP_MEMORY_SCOPE_WORKGROUP); if (p < 512) CAND[qi * 1024 + p] = ((unsigned long long)u << 32) | (unsigned long long)(0xFFFFu - (unsigned)key); } }
                if (valid && nib) __hip_atomic_fetch_or(&MASK[qi * 128 + (kt >> 1)], nib << (16 * (kt & 1) + 4 * fq), __ATOMIC_RELAXED, __HIP_MEMORY_SCOPE_WORKGROUP); }
#pragma unroll
            for (int j2 = 0; j2 < 8; ++j2) kcur[j2] = knxt[j2]; } }
        __syncthreads();
        }
#ifndef DBG_RD
#define DBG_RD 1
#endif
#pragma unroll 1
        for (int rD = 0; rD < DBG_RD; ++rD) {
#pragma unroll 1
        for (int j = 0; j < 2; ++j) { AT_LAUNDER(); const int q = 2 * wave + j; int m = SM[48 + q]; m = m < 512 ? m : 512; const int nd = SM[16 + q];
            if (m <= 256) at_resolve<4>(CAND + q * 1024, MASK + q * 128, m, nd, lane); else at_resolve<8>(CAND + q * 1024, MASK + q * 128, m, nd, lane); }
        __syncthreads();
        }
#undef AT_SCORES
#undef AT_LOADK
#undef AT_LOADG
    } else {
#pragma unroll 1
        for (int i = tid; i < 2048; i += 512) MASK[i] = ((i & 127) < (n >> 5)) ? 0xFFFFFFFFu : 0u;
        __syncthreads();
    }
    }
#pragma unroll 1
    for (int rden = 0; rden < DBG_REP_DENSE; ++rden) {
    { const int g = wave >> 2, hh = wave & 3, NS = n >> 6;
      float cshift;
      { AT_LAUNDER(); float gq = fabsf(a.in[IN_GQ][lane]), gk = fabsf(a.in[IN_GK][lane]);
#pragma unroll
        for (int o = 1; o < 64; o <<= 1) { gq = fmaxf(gq, __shfl_xor(gq, o)); gk = fmaxf(gk, __shfl_xor(gk, o)); }
        cshift = 8.0f * 1.4426950408889634f * gq * gk; }
      const unsigned ring0 = (unsigned)(size_t)(lds + AT_HIST);
#define AT_STAGE(s_) do { AT_LAUNDER(); const unsigned sb_ = ring0 + (unsigned)(((s_) & 3) * 32768); \
        _Pragma("unroll") for (int i_ = 0; i_ < 4; ++i_) { const int in_ = 4 * wave + i_; const int row_ = 4 * (in_ & 15) + (lane >> 4), pos_ = lane & 15; \
            const bf16* src_ = (in_ < 16) ? (KN + (tb + 64 * (s_) + row_) * 128 + ((pos_ ^ (row_ & 15)) << 3)) : (VB + (tb + 64 * (s_) + row_) * 256 + 128 + ((pos_ ^ (2 * (row_ & 7))) << 3)); \
            const unsigned dst_ = __builtin_amdgcn_readfirstlane(sb_ + (unsigned)(in_ * 1024)); unsigned keep_; \
            asm volatile("s_mov_b32 %0, m0\n\ts_mov_b32 m0, %2\n\ts_nop 0\n\tglobal_load_lds_dwordx4 %1, off\n\ts_mov_b32 m0, %0" : "=&s"(keep_) : "v"(src_), "s"(dst_) : "memory"); } } while (0)
      bf16x8 qa, qb; f32x4 oacc[4], lacc = (f32x4){0.f, 0.f, 0.f, 0.f};
      { AT_LAUNDER(); const bf16* qp = AQN + (tb + q0 + qi) * 512 + (g * 4 + hh) * 64 + 8 * fq; qa = *(const bf16x8*)qp; qb = *(const bf16x8*)(qp + 32); }
#pragma unroll
      for (int dt = 0; dt < 4; ++dt) oacc[dt] = (f32x4){0.f, 0.f, 0.f, 0.f};
      const bf16x8 ones = (bf16x8){0x3F80, 0x3F80, 0x3F80, 0x3F80, 0x3F80, 0x3F80, 0x3F80, 0x3F80};
      asm volatile("s_waitcnt vmcnt(0)" ::: "memory");
#pragma unroll 1
      for (int s = 0; s < 3 && s < NS; ++s) AT_STAGE(s);
      typedef short s4_t __attribute__((ext_vector_type(4)));
#pragma unroll 1
      for (int s = 0; s < NS; ++s) {
          if (s + 2 < NS) asm volatile("s_waitcnt vmcnt(8)" ::: "memory"); else asm volatile("s_waitcnt vmcnt(0)" ::: "memory");
          __builtin_amdgcn_s_barrier(); asm volatile("" ::: "memory");
          if (s + 3 < NS) AT_STAGE(s + 3);
          { AT_LAUNDER(); const LAS unsigned char* kb = lds + AT_HIST + (s & 3) * 32768; const LAS unsigned char* vbs = kb + 16384;
            const unsigned mw0 = MASK[qi * 128 + 2 * s] >> (4 * fq), mw1 = MASK[qi * 128 + 2 * s + 1] >> (4 * fq);
            f32x4 st[4];
#pragma unroll
            for (int t = 0; t < 4; ++t) { const int row = 16 * t + qi;
                const bf16x8 k0 = *(const LAS bf16x8*)(kb + row * 256 + (((g * 8 + fq) ^ (row & 15)) << 4)), k1 = *(const LAS bf16x8*)(kb + row * 256 + (((g * 8 + 4 + fq) ^ (row & 15)) << 4));
                f32x4 d = MFMA16(k0, qa, ((f32x4){0.f, 0.f, 0.f, 0.f})); st[t] = MFMA16(k1, qb, d); }
            bf16x8 pb[2];
#pragma unroll
            for (int u = 0; u < 2; ++u) { const unsigned mw = u ? mw1 : mw0; float pv[8];
#pragma unroll
                for (int j = 0; j < 8; ++j) { const float e = __builtin_amdgcn_exp2f(st[2 * u + (j >> 2)][j & 3] - cshift);
                    const int keep = __builtin_amdgcn_sbfe((int)mw, 16 * (j >> 2) + (j & 3), 1); pv[j] = __uint_as_float(__float_as_uint(e) & (unsigned)keep); }
                v4u pw; pw.x = pk2(pv[0], pv[1]); pw.y = pk2(pv[2], pv[3]); pw.z = pk2(pv[4], pv[5]); pw.w = pk2(pv[6], pv[7]); pb[u] = __builtin_bit_cast(bf16x8, pw);
                lacc = MFMA16(ones, pb[u], lacc); }
#pragma unroll
            for (int u = 0; u < 2; ++u)
#pragma unroll
            for (int dt = 0; dt < 4; ++dt) { const int r1 = 32 * u + 4 * fq + (qi >> 2), r2 = r1 + 16; const int ch = g * 8 + 2 * dt + ((lane & 3) >> 1);
                const s4_t lo = __builtin_amdgcn_ds_read_tr16_b64_v4i16((LAS s4_t*)(vbs + r1 * 256 + ((ch ^ (2 * (r1 & 7))) << 4) + (lane & 1) * 8));
                const s4_t hi = __builtin_amdgcn_ds_read_tr16_b64_v4i16((LAS s4_t*)(vbs + r2 * 256 + ((ch ^ (2 * (r2 & 7))) << 4) + (lane & 1) * 8));
                const bf16x8 va = (bf16x8){lo[0], lo[1], lo[2], lo[3], hi[0], hi[1], hi[2], hi[3]};
                oacc[dt] = MFMA16(va, pb[u], oacc[dt]); } } }
      { AT_LAUNDER(); const float inv = 1.0f / lacc[0];
        bf16* yp = YATT + (tb + q0 + qi) * 512 + (g * 4 + hh) * 64 + 4 * fq;
#pragma unroll
        for (int dt = 0; dt < 4; ++dt) { v2u w; w.x = pk2(oacc[dt][0] * inv, oacc[dt][1] * inv); w.y = pk2(oacc[dt][2] * inv, oacc[dt][3] * inv); *(v2u*)(yp + 16 * dt) = w; } }
#undef AT_STAGE
    }
    __syncthreads();
    }
#undef AT_LAUNDER
    __syncthreads();
}

#ifndef DBG_REP_ML
#define DBG_REP_ML 1
#endif
#ifndef DBG_REP_ATT
#define DBG_REP_ATT 1
#endif
__device__ __forceinline__ void p3_mixer(const Args& a, const Ctx& c, volatile LAS unsigned* MISC, int rep) {
#if !defined(NO_MLSTM)
#pragma unroll 1
    for (int rr = 0; rr < DBG_REP_ML; ++rr)
#pragma unroll 1
        for (int u = blockIdx.x; u < 32; u += c.G) mlstm_unit<0>(a, c, u >> 2, u & 3, 0);
#endif
    unsigned* ctl = (unsigned*)(a.ws + WS_CTL);
    const int x = (int)(__builtin_amdgcn_s_getreg((3 << 11) | 20) & 7u);
#pragma unroll 1
    for (int rot = 0; rot < 8 * DBG_REP_ATT; ++rot) { rep = rot >> 3; const int bq = (x + rot) & 7;
        for (;;) {
            if (c.tid == 0) MISC[16] = __hip_atomic_fetch_add(ctl + CW_Q + 512 * rep + 64 * bq, 1u, RLX_AGENT);
            __syncthreads();
            const int u = (int)MISC[16];
            __syncthreads();
            if (u >= 256) break;
#if defined(DBG_ZERO_ATT)
            { bf16* YA = (bf16*)((unsigned char*)a.out + DO_YATT) + ((size_t)bq * SEQ + (size_t)(255 - u) * 16) * 512; for (int i = c.tid; i < 16 * 512 / 8; i += 512) ((v4u*)YA)[i] = (v4u){0u, 0u, 0u, 0u}; }
#elif !defined(NO_ATTN)
            attn_unit(a, c, bq, 255 - u);
#endif
        } }
}
constexpr int RT_WR = 0;
constexpr int RT_LCNT = 147456;
static_assert(RT_LCNT + 128 <= MISC_OFF, "router LDS map");
__device__ __forceinline__ void p6_router(const Args& a, const Ctx& c) {
    const int tid = c.tid, lane = c.lane, wave = c.wave; LAS unsigned char* lds = c.lds;
    LAS float* WR = (LAS float*)(lds + RT_WR); LAS int* LCNT = (LAS int*)(lds + RT_LCNT);
    for (int i = tid; i < 1024 * 32; i += 512) WR[(i >> 5) * 36 + (i & 31)] = a.in[IN_WRE][i];
    for (int i = tid; i < 1024 * 4; i += 512) WR[(i >> 2) * 36 + 32 + (i & 3)] = a.in[IN_WRG][i];
    float gm[16];
#pragma unroll
    for (int i = 0; i < 16; ++i) gm[i] = a.in[IN_GMOE][lane + 64 * i];
    float be[32], bg[4];
#pragma unroll
    for (int i = 0; i < 32; ++i) be[i] = a.in[IN_BRE][i];
#pragma unroll
    for (int i = 0; i < 4; ++i) bg[i] = a.in[IN_BRG][i];
    const float* X1 = a.out; bf16* XN = (bf16*)(a.ws + WS_XN);
    int* TOKE = (int*)(a.ws + WS_TOKE); int* TOKR = (int*)(a.ws + WS_TOKR); float* TOKG = (float*)(a.ws + WS_TOKG); int* CNT = (int*)(a.ws + WS_CNT);
    __syncthreads();
    for (int blk = blockIdx.x; blk < 256; blk += c.G) {
        if (tid < 32) LCNT[tid] = 0;
        __syncthreads();
#pragma unroll 1
        for (int ri = 0; ri < 16; ++ri) { const int t = blk * 128 + wave * 16 + ri;
            float xv[16]; float ss = 0.f;
#pragma unroll
            for (int i = 0; i < 16; ++i) { xv[i] = X1[(size_t)t * D + lane + 64 * i]; ss += xv[i] * xv[i]; }
            const float r = rsqrtf(wave_sum(ss) * (1.f / D) + EPS);
#pragma unroll
            for (int i = 0; i < 16; ++i) { xv[i] = xv[i] * r * gm[i]; XN[(size_t)t * D + lane + 64 * i] = (bf16)f2bf(xv[i]); }
            float acc[36];
#pragma unroll
            for (int jx = 0; jx < 36; ++jx) acc[jx] = 0.f;
#pragma unroll
            for (int i = 0; i < 16; ++i) { const LAS f32x4* wp = (const LAS f32x4*)(WR + (lane + 64 * i) * 36);
#pragma unroll
                for (int jj = 0; jj < 9; ++jj) { const f32x4 w4 = wp[jj]; acc[4 * jj] += xv[i] * w4[0]; acc[4 * jj + 1] += xv[i] * w4[1]; acc[4 * jj + 2] += xv[i] * w4[2]; acc[4 * jj + 3] += xv[i] * w4[3]; } }
#pragma unroll
            for (int jx = 0; jx < 36; ++jx) acc[jx] = wave_sum(acc[jx]);
            float gl[4];
#pragma unroll
            for (int i = 0; i < 4; ++i) gl[i] = acc[32 + i] + bg[i];
            int gs = 0; float gmax = gl[0];
#pragma unroll
            for (int i = 1; i < 4; ++i) if (gl[i] > gmax) { gmax = gl[i]; gs = i; }
            float gsum = 0.f;
#pragma unroll
            for (int i = 0; i < 4; ++i) gsum += expf(gl[i] - gmax);
            const float gtop = 1.0f / gsum;
            float ev[8];
#pragma unroll
            for (int i = 0; i < 8; ++i) { float v = acc[i] + be[i];
#pragma unroll
                for (int g2 = 1; g2 < 4; ++g2) v = (gs == g2) ? (acc[g2 * 8 + i] + be[g2 * 8 + i]) : v;
                ev[i] = v; }
            int l0 = 0; float v0 = ev[0];
#pragma unroll
            for (int i = 1; i < 8; ++i) if (ev[i] > v0) { v0 = ev[i]; l0 = i; }
            int l1 = -1; float v1 = -3.0e38f;
#pragma unroll
            for (int i = 0; i < 8; ++i) if (i != l0 && ev[i] > v1) { v1 = ev[i]; l1 = i; }
            const float e1 = expf(v1 - v0), s0 = 1.0f / (1.0f + e1), s1 = e1 * s0;
            if (lane == 0) { const int ex0 = gs * 8 + l0, ex1 = gs * 8 + l1;
                const int rk0 = __hip_atomic_fetch_add(&LCNT[ex0], 1, __ATOMIC_RELAXED, __HIP_MEMORY_SCOPE_WORKGROUP);
                const int rk1 = __hip_atomic_fetch_add(&LCNT[ex1], 1, __ATOMIC_RELAXED, __HIP_MEMORY_SCOPE_WORKGROUP);
                TOKE[2 * t] = ex0; TOKE[2 * t + 1] = ex1; TOKR[2 * t] = rk0; TOKR[2 * t + 1] = rk1; TOKG[2 * t] = s0 * gtop; TOKG[2 * t + 1] = s1 * gtop; }
        }
        __syncthreads();
        if (tid < 32) CNT[blk * 32 + tid] = LCNT[tid];
        __syncthreads();
    }
}
__device__ __forceinline__ void p7_gather(const Args& a, const Ctx& c) {
    const int tid = c.tid, lane = c.lane, wave = c.wave;
    LAS int* PART = (LAS int*)c.lds; LAS int* PPRE = PART + 512; LAS int* TOT = PPRE + 512; LAS int* TS = TOT + 32; LAS int* BASE = TS + 64;
    const int* CNT = (const int*)(a.ws + WS_CNT); const int* TOKE = (const int*)(a.ws + WS_TOKE); const int* TOKR = (const int*)(a.ws + WS_TOKR); int* TOKP = (int*)(a.ws + WS_TOKP);
    const bf16* XN = (const bf16*)(a.ws + WS_XN); bf16* XG = (bf16*)(a.ws + WS_XG);
    { const int e = tid & 31, p = tid >> 5; int s = 0; for (int k = 0; k < 16; ++k) s += CNT[(16 * p + k) * 32 + e]; PART[p * 32 + e] = s; }
    __syncthreads();
    if (tid < 32) { int run = 0; for (int p = 0; p < 16; ++p) { PPRE[p * 32 + tid] = run; run += PART[p * 32 + tid]; } TOT[tid] = run; }
    __syncthreads();
    if (tid == 0) { int ts = 0; for (int e = 0; e < 32; ++e) { TS[e] = ts; ts += (TOT[e] + 255) >> 8; } TS[32] = ts; }
    __syncthreads();
    if (blockIdx.x == 0 && tid < 33) ((int*)(a.ws + WS_SMALL))[tid] = TS[tid];
    for (int blk = blockIdx.x; blk < 256; blk += c.G) {
        if (tid < 32) { int s = TS[tid] * 256 + PPRE[(blk >> 4) * 32 + tid]; for (int b2 = (blk & ~15); b2 < blk; ++b2) s += CNT[b2 * 32 + tid]; BASE[tid] = s; }
        __syncthreads();
#pragma unroll 1
        for (int ri = 0; ri < 16; ++ri) { const int t = blk * 128 + wave * 16 + ri;
            const v4u x0 = *(const v4u*)(XN + (size_t)t * D + 8 * lane), x1 = *(const v4u*)(XN + (size_t)t * D + 512 + 8 * lane);
#pragma unroll
            for (int j = 0; j < 2; ++j) { const int pos = BASE[TOKE[2 * t + j]] + TOKR[2 * t + j];
                if (lane == 0) TOKP[2 * t + j] = pos;
                *(v4u*)(XG + (size_t)pos * D + 8 * lane) = x0; *(v4u*)(XG + (size_t)pos * D + 512 + 8 * lane) = x1; } }
        __syncthreads();
    }
}
__device__ __forceinline__ void p10_combine(const Args& a, const Ctx& c) {
    const int lane = c.lane, gw = c.vcu * NWAVES + c.wave, NGW = c.G * NWAVES;
    const int* TOKP = (const int*)(a.ws + WS_TOKP); const float* TOKG = (const float*)(a.ws + WS_TOKG); const bf16* Y = (const bf16*)(a.ws + WS_Y);
    for (int t = gw; t < T; t += NGW) { const int p0 = TOKP[2 * t], p1 = TOKP[2 * t + 1]; const float g0 = TOKG[2 * t], g1 = TOKG[2 * t + 1];
#pragma unroll
        for (int j = 0; j < 4; ++j) { f32x4* op = (f32x4*)(a.out + (size_t)t * D + 4 * lane + 256 * j); f32x4 x = *op;
            const v2u y0 = *(const v2u*)(Y + (size_t)p0 * D + 4 * lane + 256 * j), y1 = *(const v2u*)(Y + (size_t)p1 * D + 4 * lane + 256 * j);
            x[0] += g0 * bf2f(y0.x & 0xffffu) + g1 * bf2f(y1.x & 0xffffu); x[1] += g0 * bf2f(y0.x >> 16) + g1 * bf2f(y1.x >> 16);
            x[2] += g0 * bf2f(y0.y & 0xffffu) + g1 * bf2f(y1.y & 0xffffu); x[3] += g0 * bf2f(y0.y >> 16) + g1 * bf2f(y1.y >> 16);
            *op = x; } }
}
__global__ void __launch_bounds__(NWAVES * 64, 2) hybrid_fwd(Args args) {
    extern __shared__ __attribute__((aligned(16))) unsigned char lds_raw[];
    Ctx c; c.lds = (LAS unsigned char*)lds_raw;
    volatile LAS unsigned* MISC = (volatile LAS unsigned*)(c.lds + MISC_OFF);
    c.tid = threadIdx.x; c.lane = c.tid & 63; c.wave = __builtin_amdgcn_readfirstlane(c.tid >> 6);
    c.G = gridDim.x; { const int bx = blockIdx.x; c.vcu = (c.G % 8 == 0) ? (bx % 8) * (c.G / 8) + bx / 8 : bx; }
    unsigned* ctl = (unsigned*)(args.ws + WS_CTL);
    if (c.tid < 128) MISC[c.tid] = 0u;
    __syncthreads();
    XcdBarrier bar; bar.bar = ctl + CW_BAR; bar.x = 0; bar.st = nullptr;
    if (N_LAUNCHES == 1) bar = xcd_barrier_post(ctl + CW_BAR, MISC + 8);
#define GRID_BAR() do { if (N_LAUNCHES == 1) xcd_barrier(bar); } while (0)
    const int lo = args.ph_lo, hi = args.ph_hi;
#ifndef PH_MASK
#define PH_MASK 0xfff
#endif
#define IN(k) (((PH_MASK >> (k)) & 1) && lo <= (k) && (k) < hi)
#define BOTH(k) (IN(k) && IN((k) + 1))
    unsigned char* ws = args.ws; unsigned char* dout = (unsigned char*)args.out;
#ifndef DBG_REPEAT
#define DBG_REPEAT -1
#endif
#define REPS(k) (((k) == DBG_REPEAT) ? 2 : 1)
    if (IN(0)) { _Pragma("unroll") for (int rep = 0; rep < REPS(0); ++rep) { if (rep) GRID_BAR(); p0_prologue(args, c); } if (BOTH(0)) GRID_BAR(); }
    if (IN(1)) { _Pragma("unroll") for (int rep = 0; rep < REPS(1); ++rep) { if (rep) GRID_BAR();
        pg8::Gemm g{(const pg8::bf16_t*)(dout + DO_H), (const pg8::bf16_t*)(ws + WS_WIN), T, NPROJ, D}; pg8::StaticOrder S; S.init(T, NPROJ, c.G, (int)blockIdx.x);
        pg8::EpiBf16<0> E{(pg8::bf16_t*)(ws + WS_PROJ), 256, nullptr, 256, (size_t)T * 256, 1.f};
        pg8::gemm_phase<pg8::EpiBf16<0>, pg8::StaticOrder, true, true>(c.lds, g, S, E); }
        if (BOTH(1)) GRID_BAR();
    }
    if (IN(2)) { _Pragma("unroll") for (int rep = 0; rep < REPS(2); ++rep) { if (rep) GRID_BAR(); p2_prep(args, c); } if (BOTH(2)) GRID_BAR(); }
    if (IN(3)) { _Pragma("unroll") for (int rep = 0; rep < REPS(3); ++rep) { if (rep) GRID_BAR(); p3_mixer(args, c, MISC, rep); } if (BOTH(3)) GRID_BAR(); }
    if (IN(4)) {
#pragma unroll 1
        for (int u = blockIdx.x; u < 256; u += c.G) mlstm_unit<1>(args, c, u >> 5, (u >> 3) & 3, u & 7);
        if (BOTH(4)) GRID_BAR();
    }
    if (IN(5)) {
        { pg8::Gemm g{(const pg8::bf16_t*)(dout + DO_YATT), (const pg8::bf16_t*)(ws + WS_WPA), T, D, 512}; pg8::StaticOrder S; S.init(T, D, c.G, (int)blockIdx.x);
          pg8::EpiGate<false> E{(pg8::bf16_t*)(ws + WS_MERGED), D, (const pg8::bf16_t*)(ws + WS_PROJ + (size_t)TL_GA * PROJ_TILE), (size_t)T * 256};
          pg8::gemm_phase<pg8::EpiGate<false>, pg8::StaticOrder, true, true>(c.lds, g, S, E); }
        __syncthreads();
        { pg8::Gemm g{(const pg8::bf16_t*)(dout + DO_YML), (const pg8::bf16_t*)(ws + WS_WPM), T, D, 512}; pg8::StaticOrder S; S.init(T, D, c.G, (int)blockIdx.x);
          pg8::EpiGate<true> E{(pg8::bf16_t*)(ws + WS_MERGED), D, (const pg8::bf16_t*)(ws + WS_PROJ + (size_t)TL_GM * PROJ_TILE), (size_t)T * 256};
          pg8::gemm_phase<pg8::EpiGate<true>, pg8::StaticOrder, true, true>(c.lds, g, S, E); }
        if (BOTH(5)) GRID_BAR();
    }
    if (IN(6)) {
        pg8::Gemm g{(const pg8::bf16_t*)(ws + WS_MERGED), (const pg8::bf16_t*)(ws + WS_WOUT), T, D, D}; pg8::StaticOrder S; S.init(T, D, c.G, (int)blockIdx.x);
        pg8::EpiRes E{args.out, args.in[IN_X], D};
        pg8::gemm_phase<pg8::EpiRes, pg8::StaticOrder, true, true>(c.lds, g, S, E);
        if (BOTH(6)) GRID_BAR();
    }
    if (IN(7)) { _Pragma("unroll") for (int rep = 0; rep < REPS(7); ++rep) { if (rep) GRID_BAR(); p6_router(args, c); } if (BOTH(7)) GRID_BAR(); }
    if (IN(8)) { _Pragma("unroll") for (int rep = 0; rep < REPS(8); ++rep) { if (rep) GRID_BAR(); p7_gather(args, c); } if (BOTH(8)) GRID_BAR(); }
    if (IN(9) || IN(10)) {
        LAS int* TSL = (LAS int*)(c.lds + MISC_OFF + 256);
        if (c.tid < 33) TSL[c.tid] = (int)__hip_atomic_load((unsigned*)(ws + WS_SMALL) + c.tid, RLX_AGENT);
        __syncthreads();
        pg8::MoeOrder S{TSL, c.G, (int)blockIdx.x};
        if (IN(9)) {
            pg8::Gemm g{(const pg8::bf16_t*)(ws + WS_XG), (const pg8::bf16_t*)(ws + WS_GU), 0, 0, D};
            pg8::EpiSwiGLU E{(pg8::bf16_t*)(ws + WS_HID)};
            pg8::gemm_phase<pg8::EpiSwiGLU, pg8::MoeOrder, true, true>(c.lds, g, S, E);
            if (BOTH(9)) GRID_BAR();
        }
        if (IN(10)) {
            pg8::Gemm g{(const pg8::bf16_t*)(ws + WS_HID), (const pg8::bf16_t*)(ws + WS_DN), 0, 0, 512};
            pg8::EpiDown E{(pg8::bf16_t*)(ws + WS_Y)};
            pg8::gemm_phase<pg8::EpiDown, pg8::MoeOrder, true, true>(c.lds, g, S, E);
            if (BOTH(10)) GRID_BAR();
        }
    }
    if (IN(11)) p10_combine(args, c);
#undef IN
#undef BOTH
#undef GRID_BAR
}

extern "C" void kernel_launch(void* const* d_in, const int* in_sizes, int n_in, void* d_out, int out_size, void* d_ws, size_t ws_size, hipStream_t stream) {
    static int grid = 0;
    if (grid == 0) {
        if (n_in != 22 || in_sizes[0] != T * D || out_size != T * D || ws_size < WS_END) { fprintf(stderr, "kernel_launch: unexpected shapes (n_in %d, in0 %d, out %d, ws %zu); nothing launched\n", n_in, n_in > 0 ? in_sizes[0] : -1, out_size, ws_size); grid = -1; return; }
        int dev = 0, cus = 0, per_cu = 0;
        if (hipGetDevice(&dev) != hipSuccess || hipDeviceGetAttribute(&cus, hipDeviceAttributeMultiprocessorCount, dev) != hipSuccess) { grid = -1; return; }
        if (hipFuncSetAttribute((const void*)hybrid_fwd, hipFuncAttributeMaxDynamicSharedMemorySize, LDS_BYTES) != hipSuccess) { fprintf(stderr, "kernel_launch: hipFuncSetAttribute failed\n"); grid = -1; return; }
        if (hipOccupancyMaxActiveBlocksPerMultiprocessor(&per_cu, (const void*)hybrid_fwd, NWAVES * 64, LDS_BYTES) != hipSuccess || per_cu < 1)
            fprintf(stderr, "kernel_launch: note: occupancy query reports %d workgroups per CU\n", per_cu);
        (void)hipGetLastError();
        grid = cus;
    }
    if (grid < 0) return;
    if (hipMemsetAsync((char*)d_ws + WS_CTL, 0, CTL_ZERO_BYTES, stream) != hipSuccess) return;
    Args a{};
    for (int i = 0; i < 22; ++i) a.in[i] = (const float*)d_in[i];
    a.out = (float*)d_out; a.ws = (unsigned char*)d_ws;
    for (int li = 0; li < N_LAUNCHES; ++li) {
        a.ph_lo = (N_LAUNCHES == 1) ? 0 : li; a.ph_hi = (N_LAUNCHES == 1) ? NPH : li + 1; a.li = li;
        hipLaunchKernelGGL(hybrid_fwd, dim3(grid), dim3(NWAVES * 64), LDS_BYTES, stream, a);
        if (hipPeekAtLastError() != hipSuccess) { fprintf(stderr, "kernel_launch: launch %d failed\n", li); break; }
    }
}
```

```cpp
#include <hip/hip_runtime.h>
#include <cstdio>
#include <cstdint>
namespace pg8 {
#define PG8_LAS __attribute__((address_space(3)))
typedef unsigned short bf16_t;
typedef short bf16x8 __attribute__((ext_vector_type(8)));
typedef float f32x4 __attribute__((ext_vector_type(4)));
typedef unsigned u32x4 __attribute__((ext_vector_type(4)));
constexpr int BM = 256, BK = 64, HALF = 128, HTB = HALF * BK * 2  , STAGE_BYTES = 8 * HTB, NXCD = 8, WGM = 8;

__host__ __device__ __forceinline__ int lds_byte(int r, int c) { const int st = (r >> 4) * 2 + (c >> 5), rr = r & 15, cc = c & 31, ob = rr * 64 + cc * 2; return st * 1024 + (ob ^ (((ob >> 9) & 1) << 5)); }
__host__ __device__ __forceinline__ void stage_rc(int b, int& R, int& C) { const int st = b / 1024, sb = b % 1024, swz = sb ^ (((sb >> 9) & 1) << 5); R = (st >> 1) * 16 + swz / 64; C = (st & 1) * 32 + (swz % 64) / 2; }
__host__ __device__ __forceinline__ int perm32(int rho) { const int n = rho >> 4, i = rho & 15; return 8 * (i >> 2) + 4 * n + (i & 3); }

struct Unit { int pm, pn; };
struct Gemm { const bf16_t* A; const bf16_t* Bt; int M, N, K; };

struct StaticOrder {
    static constexpr bool GATHER = false;
    int nM, nN, nwg, G, c;
    __host__ __device__ void init(int M, int N, int G_, int c_) { nM = M / BM; nN = N / BM; nwg = nM * nN; G = G_; c = c_; }
    __host__ __device__ bool next(int i, Unit& u) const {
        const long L = (long)i * G + c; if (L >= nwg) return false;
        int wgid = (int)L; { const int q = nwg / NXCD, r = nwg % NXCD, xcd = wgid % NXCD, off = wgid / NXCD; wgid = (xcd < r ? xcd * (q + 1) : r * (q + 1) + (xcd - r) * q) + off; }
        const int nig = WGM * nN, gid = wgid / nig, fm = gid * WGM, gsz = (nM - fm) < WGM ? (nM - fm) : WGM;
        u.pm = fm + ((wgid % nig) % gsz); u.pn = (wgid % nig) / gsz; return true;
    }
    __device__ __forceinline__ void a_ready(const Unit&) const {}
    __device__ __forceinline__ void done(const Unit&) const {}
};

typedef __bf16 bf2_t __attribute__((ext_vector_type(2)));
__device__ __forceinline__ unsigned cvt_pk_bf16(float lo, float hi) { bf2_t v; v[0] = (__bf16)lo; v[1] = (__bf16)hi; return __builtin_bit_cast(unsigned, v); }
typedef float f32x2 __attribute__((ext_vector_type(2)));
template <int ACT  > struct EpiBf16 {
    static constexpr bool PERM = true, AFTER_DRAIN = false; static_assert(ACT == 0, "EpiBf16: no activation here");
    bf16_t* O; int ldc; const float* bias; int split_cols; size_t split_stride; float scale0;
    __device__ __forceinline__ void operator()(const f32x4 (&acc)[2][2][4][2], const Unit& u, int wr, int wc, int fr, int fq) const {
        const int row0 = u.pm * BM + wr * 64 + fr; int colt = u.pn * BM; bf16_t* base = O;
        float sc = 1.f; if (split_cols) { const int t = colt / split_cols; base += (size_t)t * split_stride; colt -= t * split_cols; if (t == 0) sc = scale0; }
        const int col0 = colt + wc * 32 + 8 * fq, bcol0 = u.pn * BM + wc * 32 + 8 * fq;
        f32x4 bv[2][2];
#pragma unroll
        for (int bj = 0; bj < 2; ++bj)
#pragma unroll
            for (int n = 0; n < 2; ++n) bv[bj][n] = bias ? *(const f32x4*)(bias + bcol0 + bj * HALF + 4 * n) : (f32x4){0.f, 0.f, 0.f, 0.f};
#pragma unroll
        for (int ai = 0; ai < 2; ++ai)
#pragma unroll
            for (int m = 0; m < 4; ++m) { bf16_t* rowp = base + (size_t)(row0 + ai * HALF + m * 16) * ldc + col0;
#pragma unroll
                for (int bj = 0; bj < 2; ++bj) { f32x4 v0 = acc[ai][bj][m][0] + bv[bj][0], v1 = acc[ai][bj][m][1] + bv[bj][1];
                    v0 = v0 * sc; v1 = v1 * sc; u32x4 w; w.x = cvt_pk_bf16(v0[0], v0[1]); w.y = cvt_pk_bf16(v0[2], v0[3]); w.z = cvt_pk_bf16(v1[0], v1[1]); w.w = cvt_pk_bf16(v1[2], v1[3]);
                    *(u32x4*)(rowp + bj * HALF) = w; } }
    }
};
__device__ __forceinline__ float bf2f_(unsigned b16) { return __uint_as_float(b16 << 16); }
__device__ __forceinline__ float sigm_(float x) { return 1.0f / (1.0f + __expf(-x)); }
template <bool ADD> struct EpiGate {
    static constexpr bool PERM = true, AFTER_DRAIN = false;
    bf16_t* O; int ldc; const bf16_t* gate; size_t gstride;
    __device__ __forceinline__ void operator()(const f32x4 (&acc)[2][2][4][2], const Unit& u, int wr, int wc, int fr, int fq) const {
        const int row0 = u.pm * BM + wr * 64 + fr, colt = wc * 32 + 8 * fq;
        const bf16_t* gt = gate + (size_t)u.pn * gstride;
#pragma unroll
        for (int ai = 0; ai < 2; ++ai)
#pragma unroll
            for (int m = 0; m < 4; ++m) { const size_t row = (size_t)(row0 + ai * HALF + m * 16);
#pragma unroll
                for (int bj = 0; bj < 2; ++bj) { const int c = colt + bj * HALF;
                    const u32x4 gv = *(const u32x4*)(gt + row * 256 + c);
                    bf16_t* op = O + row * ldc + u.pn * BM + c;
                    float pv[8] = {0.f, 0.f, 0.f, 0.f, 0.f, 0.f, 0.f, 0.f};
                    if (ADD) { const u32x4 p = *(const u32x4*)op; pv[0] = bf2f_(p.x & 0xffffu); pv[1] = bf2f_(p.x >> 16); pv[2] = bf2f_(p.y & 0xffffu); pv[3] = bf2f_(p.y >> 16);
                        pv[4] = bf2f_(p.z & 0xffffu); pv[5] = bf2f_(p.z >> 16); pv[6] = bf2f_(p.w & 0xffffu); pv[7] = bf2f_(p.w >> 16); }
                    const f32x4 v0 = acc[ai][bj][m][0], v1 = acc[ai][bj][m][1];
                    float o[8];
                    o[0] = pv[0] + sigm_(bf2f_(gv.x & 0xffffu)) * v0[0]; o[1] = pv[1] + sigm_(bf2f_(gv.x >> 16)) * v0[1];
                    o[2] = pv[2] + sigm_(bf2f_(gv.y & 0xffffu)) * v0[2]; o[3] = pv[3] + sigm_(bf2f_(gv.y >> 16)) * v0[3];
                    o[4] = pv[4] + sigm_(bf2f_(gv.z & 0xffffu)) * v1[0]; o[5] = pv[5] + sigm_(bf2f_(gv.z >> 16)) * v1[1];
                    o[6] = pv[6] + sigm_(bf2f_(gv.w & 0xffffu)) * v1[2]; o[7] = pv[7] + sigm_(bf2f_(gv.w >> 16)) * v1[3];
                    u32x4 w; w.x = cvt_pk_bf16(o[0], o[1]); w.y = cvt_pk_bf16(o[2], o[3]); w.z = cvt_pk_bf16(o[4], o[5]); w.w = cvt_pk_bf16(o[6], o[7]);
                    *(u32x4*)op = w; } }
    }
};
struct EpiRes {
    static constexpr bool PERM = false, AFTER_DRAIN = false;
    float* C; const float* R; int ldc;
    __device__ __forceinline__ void operator()(const f32x4 (&acc)[2][2][4][2], const Unit& u, int wr, int wc, int fr, int fq) const {
        const int row0 = u.pm * BM + wr * 64 + fr, col0 = u.pn * BM + wc * 32 + 4 * fq;
#pragma unroll
        for (int ai = 0; ai < 2; ++ai)
#pragma unroll
            for (int m = 0; m < 4; ++m) { const size_t ro = (size_t)(row0 + ai * HALF + m * 16) * ldc + col0;
#pragma unroll
                for (int bj = 0; bj < 2; ++bj)
#pragma unroll
                    for (int n = 0; n < 2; ++n) { const size_t off = ro + bj * HALF + n * 16; *(f32x4*)(C + off) = *(const f32x4*)(R + off) + acc[ai][bj][m][n]; } }
    }
};
struct EpiSwiGLU {
    static constexpr bool PERM = true, AFTER_DRAIN = false;
    bf16_t* H;
    __device__ __forceinline__ void operator()(const f32x4 (&acc)[2][2][4][2], const Unit& u, int wr, int wc, int fr, int fq) const {
        const int row0 = u.pm * BM + wr * 64 + fr, hc = (u.pn & 3) * 128 + wc * 32 + 8 * fq;
#pragma unroll
        for (int ai = 0; ai < 2; ++ai)
#pragma unroll
            for (int m = 0; m < 4; ++m) { const size_t row = (size_t)(row0 + ai * HALF + m * 16);
                float o[8];
#pragma unroll
                for (int n = 0; n < 2; ++n)
#pragma unroll
                    for (int i = 0; i < 4; ++i) { const float g = acc[ai][0][m][n][i], up = acc[ai][1][m][n][i]; o[n * 4 + i] = g * sigm_(g) * up; }
                u32x4 w; w.x = cvt_pk_bf16(o[0], o[1]); w.y = cvt_pk_bf16(o[2], o[3]); w.z = cvt_pk_bf16(o[4], o[5]); w.w = cvt_pk_bf16(o[6], o[7]);
                *(u32x4*)(H + row * 512 + hc) = w; }
    }
};
struct EpiDown {
    static constexpr bool PERM = true, AFTER_DRAIN = false;
    bf16_t* Y;
    __device__ __forceinline__ void operator()(const f32x4 (&acc)[2][2][4][2], const Unit& u, int wr, int wc, int fr, int fq) const {
        const int row0 = u.pm * BM + wr * 64 + fr, c0 = (u.pn & 3) * 256 + wc * 32 + 8 * fq;
#pragma unroll
        for (int ai = 0; ai < 2; ++ai)
#pragma unroll
            for (int m = 0; m < 4; ++m) { const size_t row = (size_t)(row0 + ai * HALF + m * 16);
#pragma unroll
                for (int bj = 0; bj < 2; ++bj) { const f32x4 v0 = acc[ai][bj][m][0], v1 = acc[ai][bj][m][1];
                    u32x4 w; w.x = cvt_pk_bf16(v0[0], v0[1]); w.y = cvt_pk_bf16(v0[2], v0[3]); w.z = cvt_pk_bf16(v1[0], v1[1]); w.w = cvt_pk_bf16(v1[2], v1[3]);
                    *(u32x4*)(Y + row * 1024 + c0 + bj * HALF) = w; } }
    }
};
template <bool GA_> struct MoeOrder {
    static constexpr bool GATHER = GA_;
    const PG8_LAS int* ts; int G, c; const int* rowtok;
    __device__ __forceinline__ bool next(int i, Unit& u) const {
        const int nt = ts[32]; const long L = (long)i * G + c; if (L >= 4L * nt) return false;
        const int pm = (int)(L >> 2), j = (int)(L & 3); int e = 0;
#pragma unroll
        for (int k = 1; k < 32; ++k) e += (ts[k] <= pm) ? 1 : 0;
        u.pm = pm; u.pn = e * 4 + j; return true;
    }
    __device__ __forceinline__ void a_ready(const Unit&) const {}
    __device__ __forceinline__ void done(const Unit&) const {}
};
template <class Epi, class Sched, bool ALIGN_EPI = false, bool SP2 = false>
__device__ __forceinline__ void gemm_phase(PG8_LAS unsigned char* lds, const Gemm g, const Sched& S, const Epi& E) {
    const int tid = threadIdx.x, wid = __builtin_amdgcn_readfirstlane(tid >> 6), lane = tid & 63, wr = wid >> 2, wc = wid & 3, fr = lane & 15, fq = lane >> 4;
    const int K = g.K, nt = K / BK;
    unsigned voffA[2], voffB[2];
#pragma unroll
    for (int i = 0; i < 2; ++i) { int R, C; stage_rc(tid * 16 + i * 8192, R, C); const int Rb = Epi::PERM ? ((R & ~31) + perm32(R & 31)) : R;
        voffA[i] = (unsigned)(R * K + C) * 2u; voffB[i] = (unsigned)(Rb * K + C) * 2u; }
    const size_t kstep = (size_t)(BK * 2);
    const size_t hstep = (size_t)HALF * K * 2;
    const size_t tstep = 2 * hstep;
    constexpr bool GA = Sched::GATHER;
    static_assert(!GA || SP2, "gathered A rows: SP2 loop only");
    const size_t hstepA = GA ? 0 : hstep;
    unsigned gcur[2][2] = {{0u, 0u}, {0u, 0u}}, gnxt[2][2] = {{0u, 0u}, {0u, 0u}}; int gR[2] = {0, 0}; unsigned gC[2] = {0u, 0u};
    if constexpr (GA) { _Pragma("unroll") for (int i = 0; i < 2; ++i) { int R, C; stage_rc(tid * 16 + i * 8192, R, C); gR[i] = R; gC[i] = (unsigned)C * 2u; } }
#define PG8_GOFF(dst, u) do { if constexpr (GA) { _Pragma("unroll") for (int h_ = 0; h_ < 2; ++h_) _Pragma("unroll") for (int i_ = 0; i_ < 2; ++i_) dst[h_][i_] = (unsigned)S.rowtok[(u).pm * BM + h_ * HALF + gR[i_]] * (unsigned)(K * 2) + gC[i_]; } } while (0)
#define PG8_VA(h, sel) (GA ? ((sel) ? gnxt[h] : gcur[h]) : voffA)
    const unsigned ldsw = (unsigned)wid * 1024u;
    const int aoff = lds_byte(wr * 64 + fr, fq * 8), boff = lds_byte(wc * 32 + fr, fq * 8);
#define PG8_SA(b, h) (((b) * 2 + (h)) * HTB)
#define PG8_SB(b, h) ((4 + (b) * 2 + (h)) * HTB)
#define PG8_STAGE(bufoff, gbase, voff) do { _Pragma("unroll") for (int _i = 0; _i < 2; ++_i) \
        __builtin_amdgcn_global_load_lds((const unsigned*)((const char*)(gbase) + (voff)[_i]), (PG8_LAS unsigned*)(lds + (bufoff) + ldsw + _i * 8192), 16, 0, 0); } while (0)
#define PG8_LDA(dst, b, h) do { _Pragma("unroll") for (int m = 0; m < 4; ++m) _Pragma("unroll") for (int k = 0; k < 2; ++k) dst[m][k] = *(const PG8_LAS bf16x8*)(lds + PG8_SA(b, h) + aoff + m * 2048 + k * 1024); } while (0)
#define PG8_LDB(dst, b, h) do { _Pragma("unroll") for (int n = 0; n < 2; ++n) _Pragma("unroll") for (int k = 0; k < 2; ++k) dst[n][k] = *(const PG8_LAS bf16x8*)(lds + PG8_SB(b, h) + boff + n * 2048 + k * 1024); } while (0)
#define PG8_MMA(ai, bj, At, Bt) do { __builtin_amdgcn_s_setprio(1); _Pragma("unroll") for (int m = 0; m < 4; ++m) _Pragma("unroll") for (int n = 0; n < 2; ++n) _Pragma("unroll") for (int k = 0; k < 2; ++k) \
        acc[ai][bj][m][n] = __builtin_amdgcn_mfma_f32_16x16x32_bf16(Bt[n][k], At[m][k], acc[ai][bj][m][n], 0, 0, 0); __builtin_amdgcn_s_setprio(0); } while (0)
#define PG8_WAIT_V(n) asm volatile("s_waitcnt vmcnt(" #n ")" ::: "memory")
#define PG8_WAIT_L(n) asm volatile("s_waitcnt lgkmcnt(" #n ")" ::: "memory")
#define PG8_BAR __builtin_amdgcn_s_barrier()
#define PG8_SCHED __builtin_amdgcn_sched_barrier(0)
    Unit cur, nxt; int ui = 0;
    if (!S.next(0, cur)) return;
    f32x4 acc[2][2][4][2];
#pragma unroll
    for (int a = 0; a < 2; ++a)
#pragma unroll
        for (int b = 0; b < 2; ++b)
#pragma unroll
            for (int m = 0; m < 4; ++m)
#pragma unroll
                for (int n = 0; n < 2; ++n) acc[a][b][m][n] = (f32x4){0.f, 0.f, 0.f, 0.f};
    bf16x8 At[4][2], B0[2][2], B1[2][2];
    const char* cA = (const char*)g.A + (GA ? 0 : (size_t)cur.pm * tstep); const char* cB = (const char*)g.Bt + (size_t)cur.pn * tstep;
    S.a_ready(cur);
    PG8_GOFF(gcur, cur);
    if constexpr (SP2) {
        PG8_STAGE(PG8_SB(0, 0), cB, voffB); PG8_STAGE(PG8_SB(0, 1), cB + hstep, voffB); PG8_STAGE(PG8_SA(0, 0), cA, PG8_VA(0, false)); PG8_STAGE(PG8_SA(0, 1), cA + hstepA, PG8_VA(1, false));
        if (wr == 1) PG8_BAR;
        PG8_WAIT_V(2); PG8_BAR;
        PG8_STAGE(PG8_SB(1, 0), cB + kstep, voffB); PG8_STAGE(PG8_SA(1, 0), cA + kstep, PG8_VA(0, false)); PG8_STAGE(PG8_SB(1, 1), cB + hstep + kstep, voffB);
        PG8_WAIT_V(6); PG8_BAR;
    } else {
        PG8_STAGE(PG8_SB(0, 0), cB, voffB); PG8_STAGE(PG8_SA(0, 0), cA, voffA); PG8_STAGE(PG8_SB(0, 1), cB + hstep, voffB); PG8_STAGE(PG8_SA(0, 1), cA + hstep, voffA);
        if (wr == 1) PG8_BAR;
        PG8_WAIT_V(4); PG8_BAR;
        PG8_STAGE(PG8_SB(1, 0), cB + kstep, voffB); PG8_STAGE(PG8_SA(1, 0), cA + kstep, voffA); PG8_STAGE(PG8_SB(1, 1), cB + hstep + kstep, voffB);
        PG8_WAIT_V(6); PG8_BAR;
    }
    for (;;) {
        const bool has_next = S.next(ui + 1, nxt);
        if (has_next) PG8_GOFF(gnxt, nxt);
        const char* nA = has_next ? (const char*)g.A + (GA ? 0 : (size_t)nxt.pm * tstep) : cA; const char* nB = has_next ? (const char*)g.Bt + (size_t)nxt.pn * tstep : cB;
        for (int t = 0; t < nt; t += 2) {
            const bool last = (t == nt - 2);
            const char* a1 = cA + (size_t)(t + 1) * kstep;
            const char* a2 = last ? nA : cA + (size_t)(t + 2) * kstep; const char* b2 = last ? nB : cB + (size_t)(t + 2) * kstep;
            const char* a3 = a2 + kstep; const char* b3 = b2 + kstep;
            if (last && has_next) S.a_ready(nxt);
            const bool seln = last && has_next;
            if constexpr (SP2) {
            PG8_LDB(B0, 0, 0); PG8_LDB(B1, 0, 1); PG8_SCHED; PG8_LDA(At, 0, 0); PG8_STAGE(PG8_SA(1, 1), a1 + hstepA, PG8_VA(1, false));
            PG8_WAIT_V(8); PG8_WAIT_L(0); PG8_BAR; PG8_MMA(0, 0, At, B0); PG8_MMA(0, 1, At, B1); PG8_BAR; PG8_SCHED;
            PG8_LDA(At, 0, 1); PG8_STAGE(PG8_SB(0, 0), b2, voffB); PG8_STAGE(PG8_SB(0, 1), b2 + hstep, voffB); PG8_STAGE(PG8_SA(0, 0), a2, PG8_VA(0, seln));
            PG8_WAIT_V(8); PG8_WAIT_L(0); PG8_BAR; PG8_MMA(1, 0, At, B0); PG8_MMA(1, 1, At, B1); PG8_BAR; PG8_SCHED;
            PG8_LDB(B0, 1, 0); PG8_LDB(B1, 1, 1); PG8_SCHED; PG8_LDA(At, 1, 0); PG8_STAGE(PG8_SA(0, 1), a2 + hstepA, PG8_VA(1, seln));
            PG8_WAIT_V(8); PG8_WAIT_L(0); PG8_BAR; PG8_MMA(0, 0, At, B0); PG8_MMA(0, 1, At, B1); PG8_BAR; PG8_SCHED;
            PG8_LDA(At, 1, 1); PG8_STAGE(PG8_SB(1, 0), b3, voffB); PG8_STAGE(PG8_SB(1, 1), b3 + hstep, voffB); PG8_STAGE(PG8_SA(1, 0), a3, PG8_VA(0, seln));
            PG8_WAIT_V(8); PG8_WAIT_L(0); PG8_BAR; PG8_MMA(1, 0, At, B0); PG8_MMA(1, 1, At, B1); PG8_BAR; PG8_SCHED;
            } else {
            PG8_LDB(B0, 0, 0); PG8_SCHED; PG8_LDA(At, 0, 0); PG8_STAGE(PG8_SA(1, 1), a1 + hstep, voffA);
            PG8_WAIT_L(8); PG8_BAR; PG8_WAIT_L(0); PG8_MMA(0, 0, At, B0); PG8_BAR; PG8_SCHED;
            PG8_LDB(B1, 0, 1); PG8_STAGE(PG8_SB(0, 0), b2, voffB);
            PG8_BAR; PG8_WAIT_L(0); PG8_MMA(0, 1, At, B1); PG8_BAR;
            PG8_LDA(At, 0, 1); PG8_STAGE(PG8_SA(0, 0), a2, voffA);
            PG8_BAR; PG8_WAIT_L(0); PG8_MMA(1, 0, At, B0); PG8_BAR; PG8_SCHED;
            PG8_STAGE(PG8_SB(0, 1), b2 + hstep, voffB);
            PG8_WAIT_V(6); PG8_BAR; PG8_MMA(1, 1, At, B1); PG8_BAR;
            PG8_LDB(B0, 1, 0); PG8_SCHED; PG8_LDA(At, 1, 0); PG8_STAGE(PG8_SA(0, 1), a2 + hstep, voffA);
            PG8_WAIT_L(8); PG8_BAR; PG8_WAIT_L(0); PG8_MMA(0, 0, At, B0); PG8_BAR; PG8_SCHED;
            PG8_LDB(B1, 1, 1); PG8_STAGE(PG8_SB(1, 0), b3, voffB);
            PG8_BAR; PG8_WAIT_L(0); PG8_MMA(0, 1, At, B1); PG8_BAR;
            PG8_LDA(At, 1, 1); PG8_STAGE(PG8_SA(1, 0), a3, voffA);
            PG8_BAR; PG8_WAIT_L(0); PG8_MMA(1, 0, At, B0); PG8_BAR; PG8_SCHED;
            PG8_STAGE(PG8_SB(1, 1), b3 + hstep, voffB);
            PG8_WAIT_V(6); PG8_BAR; PG8_MMA(1, 1, At, B1); PG8_BAR;
            }
        }
        if constexpr (ALIGN_EPI) { if (wr == 0) PG8_BAR; }
        if constexpr (!Epi::AFTER_DRAIN) { E(acc, cur, wr, wc, fr, fq); S.done(cur); }
        if (!has_next) break;
#pragma unroll
        for (int a = 0; a < 2; ++a)
#pragma unroll
            for (int b = 0; b < 2; ++b)
#pragma unroll
                for (int m = 0; m < 4; ++m)
#pragma unroll
                    for (int n = 0; n < 2; ++n) acc[a][b][m][n] = (f32x4){0.f, 0.f, 0.f, 0.f};
        cur = nxt; cA = nA; cB = nB; ++ui;
        if constexpr (GA) { _Pragma("unroll") for (int h_ = 0; h_ < 2; ++h_) _Pragma("unroll") for (int i_ = 0; i_ < 2; ++i_) gcur[h_][i_] = gnxt[h_][i_]; }
        if constexpr (ALIGN_EPI) { if (wr == 1) PG8_BAR; }
    }
    PG8_WAIT_V(0);
    if constexpr (!ALIGN_EPI) { if (wr == 0) PG8_BAR; }
    PG8_BAR;
    if constexpr (Epi::AFTER_DRAIN) { E.fused(acc, cur, wr, wc, fr, fq, lds, wid, lane); S.done(cur); }
#undef PG8_GOFF
#undef PG8_VA
#undef PG8_SA
#undef PG8_SB
#undef PG8_STAGE
#undef PG8_LDA
#undef PG8_LDB
#undef PG8_MMA
#undef PG8_WAIT_V
#undef PG8_WAIT_L
#undef PG8_BAR
#undef PG8_SCHED
}
}
constexpr int NWAVES = 8;
constexpr int BATCH = 8, SEQ = 4096, D = 1024, T = BATCH * SEQ;
constexpr int NPROJ = 5376;
constexpr int NTILE = NPROJ / 256;
constexpr float EPS = 1e-6f;
#ifndef MK_N_LAUNCHES
#define MK_N_LAUNCHES 1
#endif
#ifndef DBG_NPH
#define DBG_NPH 12
#endif
constexpr int NPH = DBG_NPH;
constexpr int N_LAUNCHES = MK_N_LAUNCHES;
static_assert(N_LAUNCHES == 1 || N_LAUNCHES == NPH, "MK_N_LAUNCHES is 1 or NPH");

constexpr size_t MiB = 1u << 20;
constexpr size_t WS_CTL = 0, CTL_ZERO_BYTES = 1 * MiB;
constexpr size_t WS_SMALL = 1 * MiB;
constexpr size_t WS_WIN = 2 * MiB;
constexpr size_t WS_WPA = 13 * MiB, WS_WPM = 14 * MiB, WS_WOUT = 15 * MiB;
constexpr size_t WS_TOKE = 17 * MiB;
constexpr size_t WS_TOKR = WS_TOKE + 256 * 1024;
constexpr size_t WS_TOKP = WS_TOKR + 256 * 1024;
constexpr size_t WS_TOKG = WS_TOKP + 256 * 1024;
constexpr size_t WS_CNT = WS_TOKG + 256 * 1024;
constexpr size_t WS_ROWTOK = WS_CNT + 64 * 1024;
constexpr int NROWS_MAX = 73728;
constexpr size_t WS_SC = 20 * MiB;
constexpr size_t WS_GU = 20 * MiB;
constexpr size_t WS_DN = 84 * MiB;
constexpr size_t WS_PROJ = 116 * MiB;
constexpr size_t PROJ_TILE = (size_t)T * 256 * 2;
constexpr size_t WS_MLST = 116 * MiB;
constexpr size_t WS_MERGED = 116 * MiB;
constexpr size_t WS_XN = 180 * MiB;
constexpr size_t WS_XG = 244 * MiB;
constexpr size_t WS_HID = 388 * MiB;
constexpr size_t WS_Y = 244 * MiB;
constexpr size_t WS_END = 460 * MiB;
static_assert(WS_PROJ + NTILE * PROJ_TILE == 452 * MiB, "proj map");
constexpr size_t DO_H = 0, DO_YATT = 0, DO_YML = 32 * MiB, DO_KN = 64 * MiB, DO_IKR = 72 * MiB, DO_IQR = 74 * MiB, DO_AQN = 90 * MiB;
constexpr int TL_AQ = 0, TL_KV = 2, TL_IQ = 3, TL_SM = 4, TL_MQ = 5, TL_MK = 7, TL_MV = 9, TL_MO = 11, TL_GA = 13, TL_GM = 17;
constexpr int CW_BAR = 4096;
constexpr int CW_Q = 16384;
constexpr int LDS_BYTES = 163840, MISC_OFF = LDS_BYTES - 512;

#define GAS __attribute__((address_space(1)))
#define LAS __attribute__((address_space(3)))
typedef unsigned short bf16;
typedef unsigned v4u __attribute__((ext_vector_type(4)));
typedef unsigned v2u __attribute__((ext_vector_type(2)));
typedef float f32x4 __attribute__((ext_vector_type(4)));
typedef float f32x2 __attribute__((ext_vector_type(2)));
typedef short bf16x8 __attribute__((ext_vector_type(8)));
typedef GAS unsigned gu32;
#define RLX_AGENT __ATOMIC_RELAXED, __HIP_MEMORY_SCOPE_AGENT
#define LDS_WAIT() asm volatile("s_waitcnt lgkmcnt(0)" ::: "memory")
__device__ __forceinline__ float bf2f(unsigned b16) { return __uint_as_float(b16 << 16); }
__device__ __forceinline__ unsigned f2bf(float f) { unsigned u = __float_as_uint(f); return (u + 0x7fffu + ((u >> 16) & 1u)) >> 16; }
__device__ __forceinline__ unsigned pk2(float lo, float hi) { return pg8::cvt_pk_bf16(lo, hi); }
__device__ __forceinline__ float sigm(float x) { return 1.0f / (1.0f + __expf(-x)); }
__device__ __forceinline__ float wave_sum(float v) {
    v += __int_as_float(__builtin_amdgcn_update_dpp(0, __float_as_int(v), 0xB1, 0xF, 0xF, true));
    v += __int_as_float(__builtin_amdgcn_update_dpp(0, __float_as_int(v), 0x4E, 0xF, 0xF, true));
    v += __int_as_float(__builtin_amdgcn_update_dpp(0, __float_as_int(v), 0x124, 0xF, 0xF, true));
    v += __int_as_float(__builtin_amdgcn_update_dpp(0, __float_as_int(v), 0x128, 0xF, 0xF, true));
    { const auto r = __builtin_amdgcn_permlane16_swap(__float_as_uint(v), __float_as_uint(v), false, false); v = __uint_as_float(r[0]) + __uint_as_float(r[1]); }
    { const auto r = __builtin_amdgcn_permlane32_swap(__float_as_uint(v), __float_as_uint(v), false, false); v = __uint_as_float(r[0]) + __uint_as_float(r[1]); }
    return v;
}
__device__ __forceinline__ void unpack8(const v4u r, float (&f)[8]) {
    f[0] = bf2f(r.x & 0xffffu); f[1] = bf2f(r.x >> 16); f[2] = bf2f(r.y & 0xffffu); f[3] = bf2f(r.y >> 16);
    f[4] = bf2f(r.z & 0xffffu); f[5] = bf2f(r.z >> 16); f[6] = bf2f(r.w & 0xffffu); f[7] = bf2f(r.w >> 16);
}
__device__ __forceinline__ v4u pack8(const float (&f)[8]) { v4u w; w.x = pk2(f[0], f[1]); w.y = pk2(f[2], f[3]); w.z = pk2(f[4], f[5]); w.w = pk2(f[6], f[7]); return w; }
#define XB_TMO      128
#define XB_XCNT(j)  (256  + 64 * (j))
#define XB_XSUB(j)  (1280 + 64 * (j))
#define XB_XGEN(j)  (2304 + 64 * (j))
#define XB_TOP      3328
#define XB_TOPGEN   3392
#define XCD_BAR_WORDS 3456
#define XB_SPIN_CAP (1u << 18)

__device__ __forceinline__ unsigned xb_ld(unsigned* p)              { return __hip_atomic_load(p, __ATOMIC_RELAXED, __HIP_MEMORY_SCOPE_AGENT); }
__device__ __forceinline__ unsigned xb_add(unsigned* p, unsigned v) { return __hip_atomic_fetch_add(p, v, __ATOMIC_RELAXED, __HIP_MEMORY_SCOPE_AGENT); }
__device__ __forceinline__ unsigned xb_xcc_id() { return (unsigned)__builtin_amdgcn_s_getreg((3 << 11) | 20) & 0xFu; }
#define XB_SPIN(cond, bar) do { unsigned _sp = 0; while (cond) { __builtin_amdgcn_s_sleep(1); \
    if ((++_sp & 255u) == 0u) { if (xb_ld(&(bar)[XB_TMO])) break; if (_sp > XB_SPIN_CAP) { atomicAdd(&(bar)[XB_TMO], 1u); break; } } } } while (0)

struct XcdBarrier {
    unsigned* bar; unsigned x;
    volatile LAS unsigned* st;
};

__device__ __forceinline__ XcdBarrier xcd_barrier_post(unsigned* bar, volatile LAS unsigned* st) {
    XcdBarrier b; b.bar = bar; b.x = xb_xcc_id(); b.st = st;
    if (threadIdx.x == 0) (void)xb_add(&bar[XB_XCNT(b.x)], 1u);
    return b;
}
__device__ __forceinline__ void xcd_barrier_complete(unsigned* bar, unsigned x, unsigned& nloc, unsigned& nx) {
    const unsigned G = gridDim.x * gridDim.y * gridDim.z;
    unsigned sum, cnt, mine, sp = 0u;
    for (;;) {
        sum = 0u; cnt = 0u; mine = 0u;
#pragma unroll
        for (unsigned j = 0; j < 16; ++j) { const unsigned c = xb_ld(&bar[XB_XCNT(j)]); sum += c; cnt += (c > 0u) ? 1u : 0u; mine = (j == x) ? c : mine; }
        if (sum == G) break;
        __builtin_amdgcn_s_sleep(1);
        if ((++sp & 255u) == 0u) { if (xb_ld(&bar[XB_TMO])) break; if (sp > XB_SPIN_CAP) { atomicAdd(&bar[XB_TMO], 1u); break; } }
    }
    nloc = mine > 0u ? mine : 1u; nx = cnt > 0u ? cnt : 1u;
}

__device__ __forceinline__ void xcd_barrier(const XcdBarrier& b) {
    asm volatile("s_waitcnt vmcnt(0)" ::: "memory");
    __syncthreads();
    if (threadIdx.x == 0) {
        unsigned* bar = b.bar;
        __builtin_amdgcn_s_waitcnt(0);
        unsigned nloc = b.st[0], nx = b.st[1];
        if (nloc == 0u) { xcd_barrier_complete(bar, b.x, nloc, nx); b.st[0] = nloc; b.st[1] = nx; }
        const unsigned old = xb_add(&bar[XB_XSUB(b.x)], 1u);
        const unsigned gen = old / nloc;
        if (old + 1u == (gen + 1u) * nloc) {
            __builtin_amdgcn_fence(__ATOMIC_RELEASE, "agent");
            asm volatile("s_waitcnt vmcnt(0)" ::: "memory");
            const unsigned og = xb_add(&bar[XB_TOP], 1u);
            const unsigned tg = og / nx;
            if (og + 1u == (tg + 1u) * nx) xb_add(&bar[XB_TOPGEN], 1u);
            else XB_SPIN(xb_ld(&bar[XB_TOPGEN]) == tg, bar);
            __builtin_amdgcn_fence(__ATOMIC_ACQUIRE, "agent");
            xb_add(&bar[XB_XGEN(b.x)], 1u);
            asm volatile("s_waitcnt vmcnt(0)" ::: "memory");
        } else {
            XB_SPIN(xb_ld(&bar[XB_XGEN(b.x)]) == gen, bar);
            __builtin_amdgcn_fence(__ATOMIC_ACQUIRE, "agent");
            asm volatile("s_waitcnt vmcnt(0)" ::: "memory");
        }
    }
    __syncthreads();
}
struct Args { const float* in[22]; float* out; unsigned char* ws; int ph_lo, ph_hi, li, pad; };
struct Ctx { int tid, lane, wave, G, vcu; LAS unsigned char* lds; };
#define IN_X 0
#define IN_POS 1
#define IN_GMIX 2
#define IN_WIN 3
#define IN_GQ 4
#define IN_GK 5
#define IN_WCONV 6
#define IN_BCONV 7
#define IN_BI 8
#define IN_BF 9
#define IN_GML 10
#define IN_WPA 11
#define IN_WPM 12
#define IN_WOUT 13
#define IN_GMOE 14
#define IN_WRG 15
#define IN_BRG 16
#define IN_WRE 17
#define IN_BRE 18
#define IN_WEG 19
#define IN_WEU 20
#define IN_WED 21

__device__ __forceinline__ int win_src_col(int n) {
    if (n < 1064) return n;
    if (n < 1068) return 3112 + (n - 1064);
    if (n < 1072) return 3116 + (n - 1068);
    if (n < 1280) return -1;
    if (n < 3328) return n - 216;
    return n - 208;
}
__device__ __forceinline__ void tr_item(const float* W, int ldw, int scol, int k0, bf16* wt0, int K, LAS float* scr, int lane) {
#pragma unroll 8
    for (int i = 0; i < 32; ++i) { const int kk = 2 * i + (lane >> 5); scr[kk * 33 + (lane & 31)] = scol >= 0 ? W[(size_t)(k0 + kk) * ldw + scol] : 0.f; }
    LDS_WAIT(); asm volatile("" ::: "memory");
    const int c = lane & 7;
#pragma unroll
    for (int j = 0; j < 4; ++j) { const int n = (lane >> 3) + 8 * j; const LAS float* s = scr + (8 * c) * 33 + n;
        v4u o; o.x = pk2(s[0 * 33], s[1 * 33]); o.y = pk2(s[2 * 33], s[3 * 33]); o.z = pk2(s[4 * 33], s[5 * 33]); o.w = pk2(s[6 * 33], s[7 * 33]);
        *(v4u*)(wt0 + (size_t)n * K + 8 * c) = o; }
    LDS_WAIT(); asm volatile("" ::: "memory");
}
template <int PART> __device__ __forceinline__ void p0_prologue(const Args& a, const Ctx& c) {
    unsigned char* ws = a.ws;
    LAS float* scr = (LAS float*)(c.lds + c.wave * 16384);
    const int gw = c.vcu * NWAVES + c.wave, NGW = c.G * NWAVES, lane = c.lane;
    constexpr int I_IN = 16 * 168, I_PA = 8 * 32, I_PM = 8 * 32, I_OUT = 16 * 32, I_GU = 32 * 16 * 32, I_DN = 32 * 8 * 32;
    constexpr int NPRJ = I_IN + I_PA + I_PM + I_OUT, NIT = NPRJ + I_GU + I_DN;
    for (int it = (PART ? NPRJ : 0) + gw; it < (PART ? NIT : NPRJ); it += NGW) {
        int r = it;
        if (r < I_IN) { const int kb = r / 168, nb = r % 168; tr_item(a.in[IN_WIN], 5168, win_src_col(32 * nb + (lane & 31)), 64 * kb, (bf16*)(ws + WS_WIN) + (size_t)(32 * nb) * 1024 + 64 * kb, 1024, scr, lane); continue; } r -= I_IN;
        if (r < I_PA) { const int kb = r / 32, nb = r % 32; tr_item(a.in[IN_WPA], 1024, 32 * nb + (lane & 31), 64 * kb, (bf16*)(ws + WS_WPA) + (size_t)(32 * nb) * 512 + 64 * kb, 512, scr, lane); continue; } r -= I_PA;
        if (r < I_PM) { const int kb = r / 32, nb = r % 32; tr_item(a.in[IN_WPM], 1024, 32 * nb + (lane & 31), 64 * kb, (bf16*)(ws + WS_WPM) + (size_t)(32 * nb) * 512 + 64 * kb, 512, scr, lane); continue; } r -= I_PM;
        if (r < I_OUT) { const int kb = r / 32, nb = r % 32; tr_item(a.in[IN_WOUT], 1024, 32 * nb + (lane & 31), 64 * kb, (bf16*)(ws + WS_WOUT) + (size_t)(32 * nb) * 1024 + 64 * kb, 1024, scr, lane); continue; } r -= I_OUT;
        if (r < I_GU) { const int e = r / 512, q = r % 512, kb = q / 32, nb = q % 32, t = nb >> 3, bj = (nb >> 2) & 1, i0 = (nb & 3) * 32;
            const float* src = (bj ? a.in[IN_WEU] : a.in[IN_WEG]) + (size_t)e * 1024 * 512;
            tr_item(src, 512, 128 * t + i0 + (lane & 31), 64 * kb, (bf16*)(ws + WS_GU) + ((size_t)e * 1024 + 32 * nb) * 1024 + 64 * kb, 1024, scr, lane); continue; } r -= I_GU;
        { const int e = r / 256, q = r % 256, kb = q / 32, nb = q % 32;
            tr_item(a.in[IN_WED] + (size_t)e * 512 * 1024, 1024, 32 * nb + (lane & 31), 64 * kb, (bf16*)(ws + WS_DN) + ((size_t)e * 1024 + 32 * nb) * 512 + 64 * kb, 512, scr, lane); }
    }
    if (PART) return;
    const float* g = a.in[IN_GMIX]; f32x4 gv[4];
#pragma unroll
    for (int j = 0; j < 4; ++j) gv[j] = *(const f32x4*)(g + 4 * lane + 256 * j);
    bf16* H = (bf16*)((unsigned char*)a.out + DO_H);
    for (int m = gw; m < T; m += NGW) {
        const f32x4* xr = (const f32x4*)(a.in[IN_X] + (size_t)m * D) + lane; f32x4 v[4]; float s = 0.f;
#pragma unroll
        for (int j = 0; j < 4; ++j) { v[j] = xr[64 * j]; s += (v[j].x * v[j].x + v[j].y * v[j].y) + (v[j].z * v[j].z + v[j].w * v[j].w); }
        const float r = rsqrtf(wave_sum(s) * (1.f / D) + EPS);
        v2u* o8 = (v2u*)(H + (size_t)m * D) + lane;
#pragma unroll
        for (int j = 0; j < 4; ++j) { v2u w; w.x = pk2(v[j].x * r * gv[j].x, v[j].y * r * gv[j].y); w.y = pk2(v[j].z * r * gv[j].z, v[j].w * r * gv[j].w); o8[64 * j] = w; }
    }
}

__device__ __forceinline__ const bf16* proj_tile(const Args& a, int tile) { return (const bf16*)(a.ws + WS_PROJ + (size_t)tile * PROJ_TILE); }
#define DPPF(x_, ctrl_) __int_as_float(__builtin_amdgcn_update_dpp(0, __float_as_int(x_), ctrl_, 0xF, 0xF, true))
__device__ __forceinline__ void p2_prep(const Args& a, const Ctx& c) {
    const int lane = c.lane, gw = c.vcu * NWAVES + c.wave, NGW = c.G * NWAVES;
    float invf = 0.f;
    if (lane < 8) invf = (float)pow(500000.0, -(double)lane / 8.0); else if (lane < 12) invf = (float)pow(500000.0, -(double)(lane - 8) / 4.0);
    float gq[8], gk[8];
#pragma unroll
    for (int i = 0; i < 8; ++i) { gq[i] = a.in[IN_GQ][8 * (lane & 7) + i]; gk[i] = a.in[IN_GK][8 * (lane & 7) + i]; }
    const int* pos = (const int*)a.in[IN_POS];
    unsigned char* dout = (unsigned char*)a.out;
    bf16* AQN = (bf16*)(dout + DO_AQN); bf16* KN = (bf16*)(dout + DO_KN); bf16* IQR = (bf16*)(dout + DO_IQR); bf16* IKR = (bf16*)(dout + DO_IKR);
    const int l7 = lane & 7;
    for (int t = gw; t < T; t += NGW) {
        const float ang = (float)pos[t] * invf;
        const double rev = (double)ang * 0.15915494309189535; const float frv = (float)(rev - __builtin_rint(rev));
        float cs = __builtin_amdgcn_cosf(frv), sn = __builtin_amdgcn_sinf(frv);
        float ca[8], sa[8], ci[4], si[4];
#pragma unroll
        for (int i = 0; i < 8; ++i) { ca[i] = __int_as_float(__builtin_amdgcn_readlane(__float_as_int(cs), i)); sa[i] = __int_as_float(__builtin_amdgcn_readlane(__float_as_int(sn), i)); }
#pragma unroll
        for (int i = 0; i < 4; ++i) { ci[i] = __int_as_float(__builtin_amdgcn_readlane(__float_as_int(cs), 8 + i)); si[i] = __int_as_float(__builtin_amdgcn_readlane(__float_as_int(sn), 8 + i)); }
        { const int col = (lane >> 3) * 64 + 8 * l7; const bf16* src = proj_tile(a, TL_AQ + (col >> 8)) + (size_t)t * 256 + (col & 255);
          float f[8]; unpack8(*(const v4u*)src, f); float ss = 0.f;
#pragma unroll
          for (int i = 0; i < 8; ++i) ss += f[i] * f[i];
          ss += DPPF(ss, 0xB1); ss += DPPF(ss, 0x4E); ss += DPPF(ss, 0x141);
          const float r = rsqrtf(ss * (1.f / 64.f) + EPS);
#pragma unroll
          for (int i = 0; i < 8; ++i) f[i] = f[i] * r * gq[i];
          float o[8];
#pragma unroll
          for (int i = 0; i < 8; ++i) { const float p = DPPF(f[i], 0xB1); o[i] = (l7 == 0) ? (f[i] * ca[i] - p * sa[i]) : ((l7 == 1) ? (f[i] * ca[i] + p * sa[i]) : f[i]); o[i] *= 0.125f * 1.4426950408889634f; }
          *(v4u*)(AQN + (size_t)t * 512 + col) = pack8(o); }
        { const int l15 = lane & 15; const int col = (l15 >> 3) * 64 + 8 * l7; const bf16* src = proj_tile(a, TL_KV) + (size_t)t * 256 + col;
          float f[8]; unpack8(*(const v4u*)src, f); float ss = 0.f;
#pragma unroll
          for (int i = 0; i < 8; ++i) ss += f[i] * f[i];
          ss += DPPF(ss, 0xB1); ss += DPPF(ss, 0x4E); ss += DPPF(ss, 0x141);
          const float r = rsqrtf(ss * (1.f / 64.f) + EPS);
#pragma unroll
          for (int i = 0; i < 8; ++i) f[i] = f[i] * r * gk[i];
          float o[8];
#pragma unroll
          for (int i = 0; i < 8; ++i) { const float p = DPPF(f[i], 0xB1); o[i] = (l7 == 0) ? (f[i] * ca[i] - p * sa[i]) : ((l7 == 1) ? (f[i] * ca[i] + p * sa[i]) : f[i]); }
          if (lane < 16) *(v4u*)(KN + (size_t)t * 128 + col) = pack8(o); }
        { const bf16* src = proj_tile(a, TL_IQ) + (size_t)t * 256 + 4 * lane; const v2u rw = *(const v2u*)src;
          float f[4] = {bf2f(rw.x & 0xffffu), bf2f(rw.x >> 16), bf2f(rw.y & 0xffffu), bf2f(rw.y >> 16)}; float o[4];
#pragma unroll
          for (int i = 0; i < 4; ++i) { const float p = DPPF(f[i], 0xB1); o[i] = (l7 == 0) ? (f[i] * ci[i] - p * si[i]) : ((l7 == 1) ? (f[i] * ci[i] + p * si[i]) : f[i]); }
          v2u w; w.x = pk2(o[0], o[1]); w.y = pk2(o[2], o[3]); *(v2u*)(IQR + (size_t)t * 256 + 4 * lane) = w; }
        { const bf16* src = proj_tile(a, TL_SM) + (size_t)t * 256 + 4 * l7; const v2u rw = *(const v2u*)src;
          float f[4] = {bf2f(rw.x & 0xffffu), bf2f(rw.x >> 16), bf2f(rw.y & 0xffffu), bf2f(rw.y >> 16)}; float o[4];
#pragma unroll
          for (int i = 0; i < 4; ++i) { const float p = DPPF(f[i], 0xB1); o[i] = (l7 == 0) ? (f[i] * ci[i] - p * si[i]) : ((l7 == 1) ? (f[i] * ci[i] + p * si[i]) : f[i]); }
          v2u w; w.x = pk2(o[0], o[1]); w.y = pk2(o[2], o[3]); if (lane < 8) *(v2u*)(IKR + (size_t)t * 32 + 4 * l7) = w; }
    }
}
constexpr int ML_QS = 0, ML_KS = 17408, ML_HS = 0;
constexpr int ML_KWT = 34816;
constexpr int ML_VT = 53248;
constexpr int ML_SW = 73984;
constexpr int ML_CT = 83200;
constexpr int ML_GA = 122368;
constexpr int ML_CW = ML_GA + 1024;
constexpr int ML_END = ML_CW + (1024 + 384) * 4;
static_assert(ML_END <= MISC_OFF, "mLSTM LDS map");
constexpr size_t ML_STATE_BYTES = 8 * 9 * 64 * 16;
__device__ __forceinline__ bf16x8 lds_frag(const LAS unsigned char* base, int stride_b, int row0, int kb, int lane) {
    return *(const LAS bf16x8*)(base + (row0 + (lane & 15)) * stride_b + kb + (lane >> 4) * 16);
}
__device__ __forceinline__ bf16x8 lds_frag_sw(const LAS unsigned char* base, int row0, int ks, int lane) {
    const int row = row0 + (lane & 15); return *(const LAS bf16x8*)(base + row * 144 + 16 * (((ks * 4 + (lane >> 4)) + (row >> 3)) & 7));
}
#define MFMA16(a_, b_, c_) __builtin_amdgcn_mfma_f32_16x16x32_bf16(a_, b_, c_, 0, 0, 0)
template <int MODE>
__device__ __forceinline__ void mlstm_unit(const Args& a, const Ctx& c, int b, int h, int g) {
    const int tid = c.tid, wave = c.wave; LAS unsigned char* lds = c.lds;
#define ML_LAUNDER() int tv_ = tid; asm volatile("" : "+v"(tv_)); const int lane = tv_ & 63, seg = tv_ & 15, r2 = (tv_ >> 4) * 2; (void)lane; (void)seg; (void)r2
    const bf16* PQ = proj_tile(a, TL_MQ + (h >> 1)) + (h & 1) * 128;
    const bf16* PK = proj_tile(a, TL_MK + (h >> 1)) + (h & 1) * 128;
    const bf16* PV = proj_tile(a, TL_MV + (h >> 1)) + (h & 1) * 128;
    const bf16* PO = proj_tile(a, TL_MO + (h >> 1)) + (h & 1) * 128;
    const bf16* PS = proj_tile(a, TL_SM);
    bf16* YML = (bf16*)((unsigned char*)a.out + DO_YML);
    unsigned char* STB = a.ws + WS_MLST; float* MST = (float*)(a.ws + WS_MLST + 256 * ML_STATE_BYTES);
    LAS float* GAa = (LAS float*)(lds + ML_GA); LAS float* GAm = GAa + 64; LAS float* GAw = GAa + 128; LAS float* GAe = GAa + 192;
    LAS float* CWQ = (LAS float*)(lds + ML_CW); LAS float* CWK = CWQ + 512; LAS float* CBQ = CWQ + 1024; LAS float* CBK = CBQ + 128; LAS float* GN = CBK + 128;
    LAS bf16* VTs = (LAS bf16*)(lds + ML_VT);
    { const float* wc = a.in[IN_WCONV]; const int j = tid >> 7, d = tid & 127;
      CWQ[tid] = wc[j * 1024 + h * 128 + d]; CWK[tid] = wc[j * 1024 + 512 + h * 128 + d];
      if (tid < 128) { CBQ[tid] = a.in[IN_BCONV][h * 128 + tid]; CBK[tid] = a.in[IN_BCONV][512 + h * 128 + tid]; GN[tid] = a.in[IN_GML][h * 128 + tid]; } }
    for (int i = tid; i < 16 * 64; i += 512) { const int r = i >> 6, cc = i & 63; VTs[(128 + r) * 72 + cc] = (r == 0) ? (bf16)0x3F80 : (bf16)0; }
    const float big = a.in[IN_BI][h], bfg = a.in[IN_BF][h];
    const int slot0 = (b * 4 + h) * 8;
    f32x4 cacc[9];
    float m_st = 0.f;
    if (MODE == 1 && g > 0) { ML_LAUNDER();
        const f32x4* sp = (const f32x4*)(STB + (size_t)(slot0 + g) * ML_STATE_BYTES) + wave * 576 + lane;
#pragma unroll
        for (int i = 0; i < 9; ++i) cacc[i] = sp[64 * i];
        m_st = MST[slot0 + g];
#pragma unroll
        for (int ee = 0; ee < 9; ++ee) { v2u w; w.x = pk2(cacc[ee][0], cacc[ee][1]); w.y = pk2(cacc[ee][2], cacc[ee][3]);
            *(LAS v2u*)(lds + ML_CT + (ee * 16 + (lane & 15)) * 272 + (wave * 16 + 4 * (lane >> 4)) * 2) = w; }
    } else {
#pragma unroll
        for (int i = 0; i < 9; ++i) cacc[i] = (f32x4){0.f, 0.f, 0.f, 0.f};
        for (int i = tid; i < 144 * 136 / 2; i += 512) ((LAS unsigned*)(lds + ML_CT))[i] = 0u;
    }
    const size_t tb = (size_t)b * SEQ;
    const char* bq = (const char*)(PQ + tb * 256); const char* bk = (const char*)(PK + tb * 256); const char* bv = (const char*)(PV + tb * 256); const char* bo = (const char*)(PO + tb * 256); const char* bs = (const char*)(PS + tb * 256);
    v4u rq[5], rk[5], rv[2]; unsigned short gi = 0, gf = 0;
#define ML_LOAD(kc) do { _Pragma("unroll") for (int j_ = 0; j_ < 5; ++j_) { const int rr_ = 64 * (kc) + r2 - 3 + j_; const unsigned o_ = (unsigned)((rr_ < 0 ? 0 : rr_) * 512 + seg * 16); \
            v4u q_ = (v4u){0u, 0u, 0u, 0u}; if (MODE == 1) q_ = *(const v4u*)(bq + o_); v4u k_ = *(const v4u*)(bk + o_); if (rr_ < 0) { q_ = (v4u){0u, 0u, 0u, 0u}; k_ = q_; } rq[j_] = q_; rk[j_] = k_; } \
        _Pragma("unroll") for (int i_ = 0; i_ < 2; ++i_) rv[i_] = *(const v4u*)(bv + (unsigned)((64 * (kc) + r2 + i_) * 512 + seg * 16)); \
        gi = *(const unsigned short*)(bs + (unsigned)((64 * (kc) + lane) * 512 + (40 + h) * 2)); gf = *(const unsigned short*)(bs + (unsigned)((64 * (kc) + lane) * 512 + (44 + h) * 2)); } while (0)
    const int kc0 = (MODE == 1) ? 8 * g : 0, kc1 = (MODE == 1) ? 8 * g + 8 : 56;
    { ML_LAUNDER(); ML_LOAD(kc0); }
    __syncthreads();
#pragma unroll 1
    for (int kc = kc0; kc < kc1; ++kc) {
        float wkv, decay, m_new;
        if (MODE == 0 && kc > 0 && (kc & 7) == 0) { ML_LAUNDER();
            f32x4* sp = (f32x4*)(STB + (size_t)(slot0 + (kc >> 3)) * ML_STATE_BYTES) + wave * 576 + lane;
#pragma unroll
            for (int i = 0; i < 9; ++i) sp[64 * i] = cacc[i];
            if (tid == 0) MST[slot0 + (kc >> 3)] = m_st; }
        { ML_LAUNDER();
        const float fpre = bf2f(gf) + bfg, lf = fminf(fpre, 0.f) - log1pf(__expf(-fabsf(fpre)));
        const float ig = bf2f(gi) + big;
        float bc = lf;
#pragma unroll
        for (int o = 1; o < 64; o <<= 1) { const float v = __shfl_up(bc, o); if (lane >= o) bc += v; }
        const float av = ig - bc; float Ac = av;
#pragma unroll
        for (int o = 1; o < 64; o <<= 1) { const float v = __shfl_up(Ac, o); if (lane >= o) Ac = fmaxf(Ac, v); }
        const float mA = fmaxf(m_st, Ac), Mk = __shfl(mA, 63), blast = __shfl(bc, 63);
        wkv = __expf(av - Mk); decay = __expf(m_st - Mk); m_new = blast + Mk;
        if (MODE == 1 && wave == 0) { GAa[lane] = av; GAm[lane] = mA; GAw[lane] = __expf(m_st - mA); GAe[lane] = __expf(-(bc + mA)); } }
        { ML_LAUNDER(); float kw_[2][8];
#pragma unroll
          for (int i = 0; i < 2; ++i) { const int t = r2 + i; const float wkt = __shfl(wkv, t);
            float aq_[8], ak_[8];
            { const f32x4 b0 = *(const LAS f32x4*)(CBQ + seg * 8), b1 = *(const LAS f32x4*)(CBQ + seg * 8 + 4), c0 = *(const LAS f32x4*)(CBK + seg * 8), c1 = *(const LAS f32x4*)(CBK + seg * 8 + 4);
              aq_[0] = b0[0]; aq_[1] = b0[1]; aq_[2] = b0[2]; aq_[3] = b0[3]; aq_[4] = b1[0]; aq_[5] = b1[1]; aq_[6] = b1[2]; aq_[7] = b1[3];
              ak_[0] = c0[0]; ak_[1] = c0[1]; ak_[2] = c0[2]; ak_[3] = c0[3]; ak_[4] = c1[0]; ak_[5] = c1[1]; ak_[6] = c1[2]; ak_[7] = c1[3]; }
#pragma unroll
            for (int j = 0; j < 4; ++j) { float fk_[8]; unpack8(rk[i + j], fk_);
                const f32x4 x0 = *(const LAS f32x4*)(CWK + j * 128 + seg * 8), x1 = *(const LAS f32x4*)(CWK + j * 128 + seg * 8 + 4);
#pragma unroll
                for (int e = 0; e < 4; ++e) { ak_[e] += x0[e] * fk_[e]; ak_[4 + e] += x1[e] * fk_[4 + e]; }
                if (MODE == 1) { float fq_[8]; unpack8(rq[i + j], fq_);
                    const f32x4 w0 = *(const LAS f32x4*)(CWQ + j * 128 + seg * 8), w1 = *(const LAS f32x4*)(CWQ + j * 128 + seg * 8 + 4);
#pragma unroll
                    for (int e = 0; e < 4; ++e) { aq_[e] += w0[e] * fq_[e]; aq_[4 + e] += w1[e] * fq_[4 + e]; } } }
#pragma unroll
            for (int e = 0; e < 8; ++e) { ak_[e] = ak_[e] * sigm(ak_[e]) * 0.08838834764831845f; kw_[i][e] = ak_[e] * wkt; }
            if (MODE == 1) {
#pragma unroll
                for (int e = 0; e < 8; ++e) aq_[e] = aq_[e] * sigm(aq_[e]);
                *(LAS v4u*)(lds + ML_QS + t * 272 + seg * 16) = pack8(aq_);
                *(LAS v4u*)(lds + ML_KS + t * 272 + seg * 16) = pack8(ak_); } }
          const unsigned va[4] = {rv[0].x, rv[0].y, rv[0].z, rv[0].w}, vb[4] = {rv[1].x, rv[1].y, rv[1].z, rv[1].w};
          const int swo = 16 * (((r2 >> 3) + seg) & 7) + 2 * (r2 & 7);
#pragma unroll
          for (int e = 0; e < 8; ++e) { const int ro = (seg * 8 + e) * 144 + swo;
              *(LAS unsigned*)(lds + ML_KWT + ro) = pk2(kw_[0][e], kw_[1][e]);
              const unsigned lo = (e & 1) ? (va[e >> 1] >> 16) : (va[e >> 1] & 0xffffu), hi = (e & 1) ? (vb[e >> 1] >> 16) : (vb[e >> 1] & 0xffffu);
              *(LAS unsigned*)(lds + ML_VT + ro) = lo | (hi << 16); }
        if (kc + 1 < kc1) ML_LOAD(kc + 1); }
        __syncthreads();
        f32x4 hacc[5]; unsigned mo_r[8];
        const int tt = wave & 3, t0 = tt * 16, ne = (wave < 4) ? 5 : 4, e_first = (wave < 4) ? 0 : 5;
        if (MODE == 1) {
        { ML_LAUNDER(); const int tq = t0 + (lane & 15);
        bf16x8 qf[4];
#pragma unroll
        for (int ks = 0; ks < 4; ++ks) qf[ks] = lds_frag(lds + ML_QS, 272, t0, ks * 64, lane);
        const float mAt = GAm[tq], wit = GAw[tq];
#pragma unroll
        for (int si = 0; si < 2; ++si) { const int ss = 2 * (wave >> 2) + si, s0 = ss * 16; f32x4 sacc = (f32x4){0.f, 0.f, 0.f, 0.f};
            if (ss <= tt) {
#pragma unroll
                for (int ks = 0; ks < 4; ++ks) sacc = MFMA16(lds_frag(lds + ML_KS, 272, s0, ks * 64, lane), qf[ks], sacc);
#pragma unroll
                for (int r = 0; r < 4; ++r) { const int s = s0 + 4 * (lane >> 4) + r; sacc[r] = (s <= tq) ? sacc[r] * __expf(GAa[s] - mAt) : 0.f; } }
            v2u w; w.x = pk2(sacc[0], sacc[1]); w.y = pk2(sacc[2], sacc[3]);
            *(LAS v2u*)(lds + ML_SW + tq * 144 + s0 * 2 + (lane >> 4) * 8) = w; }
#pragma unroll
        for (int i = 0; i < 5; ++i) { hacc[i] = (f32x4){0.f, 0.f, 0.f, 0.f};
            if (i < ne) {
#pragma unroll
                for (int ks = 0; ks < 4; ++ks) hacc[i] = MFMA16(lds_frag(lds + ML_CT, 272, (e_first + i) * 16, ks * 64, lane), qf[ks], hacc[i]);
                hacc[i] = hacc[i] * wit; } }
#pragma unroll
        for (int i = 0; i < 8; ++i) mo_r[i] = *(const unsigned*)(bo + (unsigned)((64 * kc + 8 * wave + i) * 512 + 4 * lane)); }
        __syncthreads();
        { ML_LAUNDER(); const int tq = t0 + (lane & 15); bf16x8 swf[2];
#pragma unroll
          for (int ks = 0; ks < 2; ++ks) swf[ks] = lds_frag(lds + ML_SW, 144, t0, ks * 64, lane);
#pragma unroll
          for (int i = 0; i < 5; ++i) if (i < ne) { const int ee = e_first + i;
#pragma unroll
              for (int ks = 0; ks < 2; ++ks) hacc[i] = MFMA16(lds_frag_sw(lds + ML_VT, ee * 16, ks, lane), swf[ks], hacc[i]);
              if (ee < 8) *(LAS f32x4*)(lds + ML_HS + tq * 528 + (ee * 16 + 4 * (lane >> 4)) * 4) = hacc[i];
              else if ((lane >> 4) == 0) *(LAS float*)(lds + ML_HS + tq * 528 + 128 * 4) = hacc[i][0]; } }
        }
        { ML_LAUNDER(); const int d0 = wave * 16; bf16x8 kwf[2];
#pragma unroll
          for (int ks = 0; ks < 2; ++ks) kwf[ks] = lds_frag_sw(lds + ML_KWT, d0, ks, lane);
#pragma unroll
          for (int ee = 0; ee < 9; ++ee) { cacc[ee] = cacc[ee] * decay;
#pragma unroll
              for (int ks = 0; ks < 2; ++ks) cacc[ee] = MFMA16(kwf[ks], lds_frag_sw(lds + ML_VT, ee * 16, ks, lane), cacc[ee]);
              if (MODE == 1) { v2u w; w.x = pk2(cacc[ee][0], cacc[ee][1]); w.y = pk2(cacc[ee][2], cacc[ee][3]);
                  *(LAS v2u*)(lds + ML_CT + (ee * 16 + (lane & 15)) * 272 + (d0 + 4 * (lane >> 4)) * 2) = w; } } }
        __syncthreads();
        if (MODE == 1) {
        { ML_LAUNDER();
#pragma unroll
        for (int i = 0; i < 8; ++i) { const int t = 8 * wave + i;
            const f32x2 nv = *(const LAS f32x2*)(lds + ML_HS + t * 528 + lane * 8); const float den = *(const LAS float*)(lds + ML_HS + t * 528 + 512);
            const float dd = fmaxf(fabsf(den), GAe[t]); const float h0 = nv.x / dd, h1 = nv.y / dd;
            const float r = rsqrtf(wave_sum(h0 * h0 + h1 * h1) * (1.f / 128.f) + EPS);
            const float y0 = h0 * r * GN[2 * lane] * sigm(bf2f(mo_r[i] & 0xffffu)), y1 = h1 * r * GN[2 * lane + 1] * sigm(bf2f(mo_r[i] >> 16));
            *(unsigned*)(YML + (tb + 64 * kc + t) * 512 + h * 128 + 2 * lane) = pk2(y0, y1); } }
        __syncthreads();
        }
        m_st = m_new;
    }
    if (MODE == 0) { ML_LAUNDER();
        f32x4* sp = (f32x4*)(STB + (size_t)(slot0 + 7) * ML_STATE_BYTES) + wave * 576 + lane;
#pragma unroll
        for (int i = 0; i < 9; ++i) sp[64 * i] = cacc[i];
        if (tid == 0) MST[slot0 + 7] = m_st; }
#undef ML_LOAD
#undef ML_LAUNDER
}
constexpr int AT_HIST = 0;
constexpr int AT_HROW = 2049;
constexpr int AT_SEL = 131072 + 256;
constexpr int AT_SM = AT_SEL + 8192;
static_assert(AT_SM + 256 <= MISC_OFF, "attention LDS map");
__device__ __forceinline__ unsigned score_key(float s) { unsigned u = __float_as_uint(s + 0.0f); return (u & 0x80000000u) ? ~u : (u | 0x80000000u); }
template <int NK> __device__ __forceinline__ void at_resolve(const LAS unsigned long long* cand, LAS unsigned* mask, int m, int nd, int lane) {
    unsigned long long cv[NK];
#pragma unroll
    for (int k = 0; k < NK; ++k) { const int i = 64 * k + lane; unsigned long long x = 0ull; if (i < m) x = cand[i]; cv[k] = (i < m) ? ((((x >> 32) & 0xFFFFFull) << 16) | (x & 0xFFFFull)) : 0ull; }
    unsigned long long T = 0ull;
#pragma unroll 1
    for (int bit = 35; bit >= 16; --bit) { const unsigned long long test = T | (1ull << bit); int cge = 0;
#pragma unroll
        for (int k = 0; k < NK; ++k) cge += __popcll(__ballot(cv[k] >= test));
        if (cge >= nd) T = test; }
    int g = 0, t = 0;
#pragma unroll
    for (int k = 0; k < NK; ++k) { g += __popcll(__ballot(cv[k] >= T + 0x10000ull)); t += __popcll(__ballot(cv[k] >= T)); }
    t -= g;
    if (t > nd - g) {
#pragma unroll 1
        for (int bit = 15; bit >= 0; --bit) { const unsigned long long test = T | (1ull << bit); int cge = 0;
#pragma unroll
            for (int k = 0; k < NK; ++k) cge += __popcll(__ballot(cv[k] >= test));
            if (cge >= nd) T = test; } }
#pragma unroll
    for (int k = 0; k < NK; ++k) if (cv[k] >= T && cv[k] != 0ull) { const unsigned key = 0xFFFFu - (unsigned)(cv[k] & 0xFFFFull);
        __hip_atomic_fetch_or(&mask[key >> 5], 1u << (key & 31u), __ATOMIC_RELAXED, __HIP_MEMORY_SCOPE_WORKGROUP); }
}
__device__ __forceinline__ void attn_unit(const Args& a, const Ctx& c, int b, int qt) {
    const int tid = c.tid, wave = c.wave; LAS unsigned char* lds = c.lds;
#define AT_LAUNDER() int tv_ = tid; asm volatile("" : "+v"(tv_)); const int lane = tv_ & 63, qi = tv_ & 15, fq = (tv_ >> 4) & 3; (void)lane; (void)qi; (void)fq
    const int q0 = qt * 16, ch = q0 >> 6, n = 64 * (ch + 1), ntiles = n >> 4;
    const size_t tb = (size_t)b * SEQ;
    unsigned char* dout = (unsigned char*)a.out;
    const bf16* AQN = (const bf16*)(dout + DO_AQN); const bf16* KN = (const bf16*)(dout + DO_KN); const bf16* IQR = (const bf16*)(dout + DO_IQR); const bf16* IKR = (const bf16*)(dout + DO_IKR);
    bf16* YATT = (bf16*)(dout + DO_YATT);
    const bf16* VB = proj_tile(a, TL_KV); const bf16* PS = proj_tile(a, TL_SM);
    LAS unsigned* HIST = (LAS unsigned*)(lds + AT_HIST);
    LAS unsigned long long* CAND = (LAS unsigned long long*)(lds + AT_HIST);
    LAS unsigned* MASK = (LAS unsigned*)(lds + AT_SEL);
    LAS int* SM = (LAS int*)(lds + AT_SM);
    float* SC = (float*)(a.ws + WS_SC) + (size_t)blockIdx.x * (16 * 4096);
#ifndef DBG_REP_SEL
#define DBG_REP_SEL 1
#endif
#ifndef DBG_REP_DENSE
#define DBG_REP_DENSE 1
#endif
#pragma unroll 1
    for (int rsel = 0; rsel < DBG_REP_SEL; ++rsel) {
    if (n > 256) {
        for (int i = tid; i < 8192 + 4; i += 512) ((LAS v4u*)HIST)[i] = (v4u){0u, 0u, 0u, 0u};
        if (tid < 64) SM[tid] = 0;
        for (int i = tid; i < 2048; i += 512) MASK[i] = 0u;
        bf16x8 qf[8]; float wv[8];
        { AT_LAUNDER();
        const size_t trow = tb + q0 + qi;
#pragma unroll
        for (int h = 0; h < 8; ++h) qf[h] = *(const bf16x8*)(IQR + trow * 256 + h * 32 + 8 * fq);
        { float t8[8]; unpack8(*(const v4u*)(PS + trow * 256 + 32), t8);
#pragma unroll
          for (int h = 0; h < 8; ++h) wv[h] = t8[h] * 0.0625f; } }
        __syncthreads();
#define AT_LOADK(kt_) (*(const bf16x8*)(IKR + (tb + (size_t)(kt_) * 16 + qi) * 32 + 8 * fq))
#define AT_SCORES(kf_, sc_) do { \
        _Pragma("unroll") for (int r_ = 0; r_ < 4; ++r_) sc_[r_] = 0.f; \
        _Pragma("unroll") for (int h_ = 0; h_ < 8; ++h_) { const f32x4 d_ = MFMA16(kf_, qf[h_], ((f32x4){0.f, 0.f, 0.f, 0.f})); \
            _Pragma("unroll") for (int r_ = 0; r_ < 4; ++r_) { const int di_ = __float_as_int(d_[r_]); sc_[r_] = __builtin_fmaf(wv[h_], __int_as_float(di_ > 0 ? di_ : 0), sc_[r_]); } } } while (0)
        const int cnt = (ntiles - wave + 7) >> 3;
#ifndef DBG_RA
#define DBG_RA 1
#endif
#pragma unroll 1
        for (int rA = 0; rA < DBG_RA; ++rA) { if (rA) { for (int i = tid; i < 8192 + 4; i += 512) ((LAS v4u*)HIST)[i] = (v4u){0u, 0u, 0u, 0u}; __syncthreads(); }
#define AT_LOADG(dst_, i0_) do { _Pragma("unroll") for (int j_ = 0; j_ < 8; ++j_) { int kt_ = wave + 8 * ((i0_) + j_); kt_ = kt_ < ntiles ? kt_ : ntiles - 1; dst_[j_] = AT_LOADK(kt_); } } while (0)
        { AT_LAUNDER(); bf16x8 kcur[8], knxt[8]; AT_LOADG(kcur, 0);
#pragma unroll 1
          for (int i0 = 0; i0 < cnt; i0 += 8) {
            if (i0 + 8 < cnt) AT_LOADG(knxt, i0 + 8);
#pragma unroll
            for (int j2 = 0; j2 < 8; ++j2) { const bool valid = (i0 + j2 < cnt); const int kt = wave + 8 * (i0 + j2); float sc[4]; AT_SCORES(kcur[j2], sc);
                if (valid) *(f32x4*)(SC + qi * 4096 + kt * 16 + 4 * fq) = (f32x4){sc[0], sc[1], sc[2], sc[3]};
#pragma unroll
                for (int r = 0; r < 4; ++r) { const unsigned bin = score_key(sc[r]) >> 20;
                    __hip_atomic_fetch_add(&HIST[qi * AT_HROW + (bin >> 1)], valid ? (1u << ((bin & 1u) * 16)) : 0u, __ATOMIC_RELAXED, __HIP_MEMORY_SCOPE_WORKGROUP); } }
#pragma unroll
            for (int j2 = 0; j2 < 8; ++j2) kcur[j2] = knxt[j2]; } }
        __syncthreads();
        }
#ifndef DBG_RB
#define DBG_RB 1
#endif
#pragma unroll 1
        for (int rB = 0; rB < DBG_RB; ++rB) {
#pragma unroll 1
        for (int j = 0; j < 2; ++j) { AT_LAUNDER(); const int q = 2 * wave + j; unsigned tot = 0;
            for (int i = 0; i < 32; ++i) { const unsigned w = HIST[q * AT_HROW + 32 * lane + ((i + lane) & 31)]; tot += (w & 0xffffu) + (w >> 16); }
            unsigned suf = tot;
#pragma unroll
            for (int o = 1; o < 64; o <<= 1) { const unsigned v = __shfl_down(suf, o); if (lane + o < 64) suf += v; }
            const unsigned long long mk = __ballot(suf >= 256u); const int L = 63 - __clzll((long long)mk);
            const unsigned above_L = __shfl(suf - tot, L);
            const unsigned w2 = HIST[q * AT_HROW + 32 * L + (lane >> 1)]; const unsigned cb = (lane & 1) ? (w2 >> 16) : (w2 & 0xffffu);
            unsigned sfx = cb;
#pragma unroll
            for (int o = 1; o < 64; o <<= 1) { const unsigned v = __shfl_down(sfx, o); if (lane + o < 64) sfx += v; }
            const unsigned long long mk2 = __ballot(above_L + sfx >= 256u); const int l2 = 63 - __clzll((long long)mk2);
            if (lane == l2) { SM[q] = 64 * L + l2; SM[16 + q] = (int)(256u - (above_L + sfx - cb)); } }
        __syncthreads();
        }
#ifndef DBG_RC
#define DBG_RC 1
#endif
#pragma unroll 1
        for (int rC = 0; rC < DBG_RC; ++rC) { if (rC) { if (tid < 16) SM[48 + tid] = 0; __syncthreads(); }
        { AT_LAUNDER(); const int Bq = SM[qi]; f32x4 scur[8], snxt[8];
#define AT_LOADS(dst_, i0_) do { _Pragma("unroll") for (int j_ = 0; j_ < 8; ++j_) { int kt_ = wave + 8 * ((i0_) + j_); kt_ = kt_ < ntiles ? kt_ : ntiles - 1; dst_[j_] = *(const f32x4*)(SC + qi * 4096 + kt_ * 16 + 4 * fq); } } while (0)
          AT_LOADS(scur, 0);
#pragma unroll 1
          for (int i0 = 0; i0 < cnt; i0 += 8) {
            if (i0 + 8 < cnt) AT_LOADS(snxt, i0 + 8);
#pragma unroll
            for (int j2 = 0; j2 < 8; ++j2) { const bool valid = (i0 + j2 < cnt); const int kt = wave + 8 * (i0 + j2);
                unsigned nib = 0u, cnib = 0u; unsigned uu[4];
#pragma unroll
                for (int r = 0; r < 4; ++r) { uu[r] = score_key(scur[j2][r]); const int bin = (int)(uu[r] >> 20); nib |= (bin > Bq) ? (1u << r) : 0u; cnib |= (bin == Bq) ? (1u << r) : 0u; }
                if (!valid) { nib = 0u; cnib = 0u; }
                if (cnib) {
                    int p = __hip_atomic_fetch_add(&SM[48 + qi], (int)__popc(cnib), __ATOMIC_RELAXED, __HIP_MEMORY_SCOPE_WORKGROUP);
#pragma unroll
                    for (int r = 0; r < 4; ++r) if ((cnib >> r) & 1u) { if (p < 512) CAND[qi * 1024 + p] = ((unsigned long long)uu[r] << 32) | (unsigned long long)(0xFFFFu - (unsigned)(kt * 16 + 4 * fq + r)); ++p; } }
                if (nib) __hip_atomic_fetch_or(&MASK[qi * 128 + (kt >> 1)], nib << (16 * (kt & 1) + 4 * fq), __ATOMIC_RELAXED, __HIP_MEMORY_SCOPE_WORKGROUP); }
#pragma unroll
            for (int j2 = 0; j2 < 8; ++j2) scur[j2] = snxt[j2]; } }
#undef AT_LOADS
        __syncthreads();
        }
#ifndef DBG_RD
#define DBG_RD 1
#endif
#pragma unroll 1
        for (int rD = 0; rD < DBG_RD; ++rD) {
#pragma unroll 1
        for (int j = 0; j < 2; ++j) { AT_LAUNDER(); const int q = 2 * wave + j; int m = SM[48 + q]; m = m < 512 ? m : 512; const int nd = SM[16 + q];
            if (m <= 256) at_resolve<4>(CAND + q * 1024, MASK + q * 128, m, nd, lane); else at_resolve<8>(CAND + q * 1024, MASK + q * 128, m, nd, lane); }
        __syncthreads();
        }
#undef AT_SCORES
#undef AT_LOADK
#undef AT_LOADG
    } else {
#pragma unroll 1
        for (int i = tid; i < 2048; i += 512) MASK[i] = ((i & 127) < (n >> 5)) ? 0xFFFFFFFFu : 0u;
        __syncthreads();
    }
    }
#pragma unroll 1
    for (int rden = 0; rden < DBG_REP_DENSE; ++rden) {
    { const int g = wave >> 2, hh = wave & 3, NS = n >> 6;
      float cshift;
      { AT_LAUNDER(); float gq = fabsf(a.in[IN_GQ][lane]), gk = fabsf(a.in[IN_GK][lane]);
#pragma unroll
        for (int o = 1; o < 64; o <<= 1) { gq = fmaxf(gq, __shfl_xor(gq, o)); gk = fmaxf(gk, __shfl_xor(gk, o)); }
        cshift = 8.0f * 1.4426950408889634f * gq * gk; }
      const unsigned ring0 = (unsigned)(size_t)(lds + AT_HIST);
#define AT_STAGE(s_) do { AT_LAUNDER(); const unsigned sb_ = ring0 + (unsigned)(((s_) & 3) * 32768); \
        _Pragma("unroll") for (int i_ = 0; i_ < 4; ++i_) { const int in_ = 4 * wave + i_; const int row_ = 4 * (in_ & 15) + (lane >> 4), pos_ = lane & 15; \
            const bf16* src_ = (in_ < 16) ? (KN + (tb + 64 * (s_) + row_) * 128 + ((pos_ ^ (row_ & 15)) << 3)) : (VB + (tb + 64 * (s_) + row_) * 256 + 128 + ((pos_ ^ (2 * (row_ & 7))) << 3)); \
            const unsigned dst_ = __builtin_amdgcn_readfirstlane(sb_ + (unsigned)(in_ * 1024)); unsigned keep_; \
            asm volatile("s_mov_b32 %0, m0\n\ts_mov_b32 m0, %2\n\ts_nop 0\n\tglobal_load_lds_dwordx4 %1, off\n\ts_mov_b32 m0, %0" : "=&s"(keep_) : "v"(src_), "s"(dst_) : "memory"); } } while (0)
      bf16x8 qa, qb; f32x4 oacc[4], lacc = (f32x4){0.f, 0.f, 0.f, 0.f};
      { AT_LAUNDER(); const bf16* qp = AQN + (tb + q0 + qi) * 512 + (g * 4 + hh) * 64 + 8 * fq; qa = *(const bf16x8*)qp; qb = *(const bf16x8*)(qp + 32); }
#pragma unroll
      for (int dt = 0; dt < 4; ++dt) oacc[dt] = (f32x4){0.f, 0.f, 0.f, 0.f};
      const bf16x8 ones = (bf16x8){0x3F80, 0x3F80, 0x3F80, 0x3F80, 0x3F80, 0x3F80, 0x3F80, 0x3F80};
      asm volatile("s_waitcnt vmcnt(0)" ::: "memory");
#pragma unroll 1
      for (int s = 0; s < 3 && s < NS; ++s) AT_STAGE(s);
      typedef short s4_t __attribute__((ext_vector_type(4)));
#pragma unroll 1
      for (int s = 0; s < NS; ++s) {
          if (s + 2 < NS) asm volatile("s_waitcnt vmcnt(8)" ::: "memory"); else asm volatile("s_waitcnt vmcnt(0)" ::: "memory");
          __builtin_amdgcn_s_barrier(); asm volatile("" ::: "memory");
          if (s + 3 < NS) AT_STAGE(s + 3);
          { AT_LAUNDER(); const LAS unsigned char* kb = lds + AT_HIST + (s & 3) * 32768; const LAS unsigned char* vbs = kb + 16384;
            const unsigned mw0 = MASK[qi * 128 + 2 * s] >> (4 * fq), mw1 = MASK[qi * 128 + 2 * s + 1] >> (4 * fq);
            f32x4 st[4];
#pragma unroll
            for (int t = 0; t < 4; ++t) { const int row = 16 * t + qi;
                const bf16x8 k0 = *(const LAS bf16x8*)(kb + row * 256 + (((g * 8 + fq) ^ (row & 15)) << 4)), k1 = *(const LAS bf16x8*)(kb + row * 256 + (((g * 8 + 4 + fq) ^ (row & 15)) << 4));
                f32x4 d = MFMA16(k0, qa, ((f32x4){0.f, 0.f, 0.f, 0.f})); st[t] = MFMA16(k1, qb, d); }
            bf16x8 pb[2];
#pragma unroll
            for (int u = 0; u < 2; ++u) { const unsigned mw = u ? mw1 : mw0; float pv[8];
#pragma unroll
                for (int j = 0; j < 8; ++j) { const float e = __builtin_amdgcn_exp2f(st[2 * u + (j >> 2)][j & 3] - cshift);
                    const int keep = __builtin_amdgcn_sbfe((int)mw, 16 * (j >> 2) + (j & 3), 1); pv[j] = __uint_as_float(__float_as_uint(e) & (unsigned)keep); }
                v4u pw; pw.x = pk2(pv[0], pv[1]); pw.y = pk2(pv[2], pv[3]); pw.z = pk2(pv[4], pv[5]); pw.w = pk2(pv[6], pv[7]); pb[u] = __builtin_bit_cast(bf16x8, pw);
                lacc = MFMA16(ones, pb[u], lacc); }
#pragma unroll
            for (int u = 0; u < 2; ++u)
#pragma unroll
            for (int dt = 0; dt < 4; ++dt) { const int r1 = 32 * u + 4 * fq + (qi >> 2), r2 = r1 + 16; const int ch = g * 8 + 2 * dt + ((lane & 3) >> 1);
                const s4_t lo = __builtin_amdgcn_ds_read_tr16_b64_v4i16((LAS s4_t*)(vbs + r1 * 256 + ((ch ^ (2 * (r1 & 7))) << 4) + (lane & 1) * 8));
                const s4_t hi = __builtin_amdgcn_ds_read_tr16_b64_v4i16((LAS s4_t*)(vbs + r2 * 256 + ((ch ^ (2 * (r2 & 7))) << 4) + (lane & 1) * 8));
                const bf16x8 va = (bf16x8){lo[0], lo[1], lo[2], lo[3], hi[0], hi[1], hi[2], hi[3]};
                oacc[dt] = MFMA16(va, pb[u], oacc[dt]); } } }
      { AT_LAUNDER(); const float inv = 1.0f / lacc[0];
        bf16* yp = YATT + (tb + q0 + qi) * 512 + (g * 4 + hh) * 64 + 4 * fq;
#pragma unroll
        for (int dt = 0; dt < 4; ++dt) { v2u w; w.x = pk2(oacc[dt][0] * inv, oacc[dt][1] * inv); w.y = pk2(oacc[dt][2] * inv, oacc[dt][3] * inv); *(v2u*)(yp + 16 * dt) = w; } }
#undef AT_STAGE
    }
    __syncthreads();
    }
#undef AT_LAUNDER
    __syncthreads();
}

#ifndef DBG_REP_ML
#define DBG_REP_ML 1
#endif
#ifndef DBG_REP_ATT
#define DBG_REP_ATT 1
#endif
__device__ __forceinline__ void p3_mixer(const Args& a, const Ctx& c, volatile LAS unsigned* MISC, int rep) {
#if !defined(NO_MLSTM)
#pragma unroll 1
    for (int rr = 0; rr < DBG_REP_ML; ++rr)
#pragma unroll 1
        for (int u = blockIdx.x; u < 32; u += c.G) mlstm_unit<0>(a, c, u >> 2, u & 3, 0);
#endif
    unsigned* ctl = (unsigned*)(a.ws + WS_CTL);
    const int x = (int)(__builtin_amdgcn_s_getreg((3 << 11) | 20) & 7u);
#pragma unroll 1
    for (int rot = 0; rot < 8 * DBG_REP_ATT; ++rot) { rep = rot >> 3; const int bq = (x + rot) & 7;
        for (;;) {
            if (c.tid == 0) MISC[16] = __hip_atomic_fetch_add(ctl + CW_Q + 512 * rep + 64 * bq, 1u, RLX_AGENT);
            __syncthreads();
            const int u = (int)MISC[16];
            __syncthreads();
            if (u >= 256) break;
#if defined(DBG_ZERO_ATT)
            { bf16* YA = (bf16*)((unsigned char*)a.out + DO_YATT) + ((size_t)bq * SEQ + (size_t)(255 - u) * 16) * 512; for (int i = c.tid; i < 16 * 512 / 8; i += 512) ((v4u*)YA)[i] = (v4u){0u, 0u, 0u, 0u}; }
#elif !defined(NO_ATTN)
            attn_unit(a, c, bq, 255 - u);
#endif
        } }
}
constexpr int RT_WR = 0;
constexpr int RT_LCNT = 147456;
static_assert(RT_LCNT + 128 <= MISC_OFF, "router LDS map");
__device__ __forceinline__ void p6_router(const Args& a, const Ctx& c) {
    const int tid = c.tid, lane = c.lane, wave = c.wave; LAS unsigned char* lds = c.lds;
    LAS float* WR = (LAS float*)(lds + RT_WR); LAS int* LCNT = (LAS int*)(lds + RT_LCNT);
    for (int i = tid; i < 1024 * 32; i += 512) WR[(i >> 5) * 36 + (i & 31)] = a.in[IN_WRE][i];
    for (int i = tid; i < 1024 * 4; i += 512) WR[(i >> 2) * 36 + 32 + (i & 3)] = a.in[IN_WRG][i];
    float gm[16];
#pragma unroll
    for (int i = 0; i < 16; ++i) gm[i] = a.in[IN_GMOE][lane + 64 * i];
    float be[32], bg[4];
#pragma unroll
    for (int i = 0; i < 32; ++i) be[i] = a.in[IN_BRE][i];
#pragma unroll
    for (int i = 0; i < 4; ++i) bg[i] = a.in[IN_BRG][i];
    { int* RT = (int*)(a.ws + WS_ROWTOK); for (int i = blockIdx.x * 512 + tid; i < NROWS_MAX; i += c.G * 512) RT[i] = 0; }
    const float* X1 = a.out; bf16* XN = (bf16*)(a.ws + WS_XN);
    int* TOKE = (int*)(a.ws + WS_TOKE); int* TOKR = (int*)(a.ws + WS_TOKR); float* TOKG = (float*)(a.ws + WS_TOKG); int* CNT = (int*)(a.ws + WS_CNT);
    __syncthreads();
    for (int blk = blockIdx.x; blk < 256; blk += c.G) {
        if (tid < 32) LCNT[tid] = 0;
        __syncthreads();
#pragma unroll 1
        for (int ri = 0; ri < 16; ++ri) { const int t = blk * 128 + wave * 16 + ri;
            float xv[16]; float ss = 0.f;
#pragma unroll
            for (int i = 0; i < 16; ++i) { xv[i] = X1[(size_t)t * D + lane + 64 * i]; ss += xv[i] * xv[i]; }
            const float r = rsqrtf(wave_sum(ss) * (1.f / D) + EPS);
#pragma unroll
            for (int i = 0; i < 16; ++i) { xv[i] = xv[i] * r * gm[i]; XN[(size_t)t * D + lane + 64 * i] = (bf16)f2bf(xv[i]); }
            float acc[36];
#pragma unroll
            for (int jx = 0; jx < 36; ++jx) acc[jx] = 0.f;
#pragma unroll
            for (int i = 0; i < 16; ++i) { const LAS f32x4* wp = (const LAS f32x4*)(WR + (lane + 64 * i) * 36);
#pragma unroll
                for (int jj = 0; jj < 9; ++jj) { const f32x4 w4 = wp[jj]; acc[4 * jj] += xv[i] * w4[0]; acc[4 * jj + 1] += xv[i] * w4[1]; acc[4 * jj + 2] += xv[i] * w4[2]; acc[4 * jj + 3] += xv[i] * w4[3]; } }
#pragma unroll
            for (int jx = 0; jx < 36; ++jx) acc[jx] = wave_sum(acc[jx]);
            float gl[4];
#pragma unroll
            for (int i = 0; i < 4; ++i) gl[i] = acc[32 + i] + bg[i];
            int gs = 0; float gmax = gl[0];
#pragma unroll
            for (int i = 1; i < 4; ++i) if (gl[i] > gmax) { gmax = gl[i]; gs = i; }
            float gsum = 0.f;
#pragma unroll
            for (int i = 0; i < 4; ++i) gsum += expf(gl[i] - gmax);
            const float gtop = 1.0f / gsum;
            float ev[8];
#pragma unroll
            for (int i = 0; i < 8; ++i) { float v = acc[i] + be[i];
#pragma unroll
                for (int g2 = 1; g2 < 4; ++g2) v = (gs == g2) ? (acc[g2 * 8 + i] + be[g2 * 8 + i]) : v;
                ev[i] = v; }
            int l0 = 0; float v0 = ev[0];
#pragma unroll
            for (int i = 1; i < 8; ++i) if (ev[i] > v0) { v0 = ev[i]; l0 = i; }
            int l1 = -1; float v1 = -3.0e38f;
#pragma unroll
            for (int i = 0; i < 8; ++i) if (i != l0 && ev[i] > v1) { v1 = ev[i]; l1 = i; }
            const float e1 = expf(v1 - v0), s0 = 1.0f / (1.0f + e1), s1 = e1 * s0;
            if (lane == 0) { const int ex0 = gs * 8 + l0, ex1 = gs * 8 + l1;
                const int rk0 = __hip_atomic_fetch_add(&LCNT[ex0], 1, __ATOMIC_RELAXED, __HIP_MEMORY_SCOPE_WORKGROUP);
                const int rk1 = __hip_atomic_fetch_add(&LCNT[ex1], 1, __ATOMIC_RELAXED, __HIP_MEMORY_SCOPE_WORKGROUP);
                TOKE[2 * t] = ex0; TOKE[2 * t + 1] = ex1; TOKR[2 * t] = rk0; TOKR[2 * t + 1] = rk1; TOKG[2 * t] = s0 * gtop; TOKG[2 * t + 1] = s1 * gtop; }
        }
        __syncthreads();
        if (tid < 32) CNT[blk * 32 + tid] = LCNT[tid];
        __syncthreads();
    }
}
__device__ __forceinline__ void p7_gather(const Args& a, const Ctx& c) {
    const int tid = c.tid, lane = c.lane, wave = c.wave;
    LAS int* PART = (LAS int*)c.lds; LAS int* PPRE = PART + 512; LAS int* TOT = PPRE + 512; LAS int* TS = TOT + 32; LAS int* BASE = TS + 64;
    const int* CNT = (const int*)(a.ws + WS_CNT); const int* TOKE = (const int*)(a.ws + WS_TOKE); const int* TOKR = (const int*)(a.ws + WS_TOKR); int* TOKP = (int*)(a.ws + WS_TOKP);
    int* RT = (int*)(a.ws + WS_ROWTOK);
    { const int e = tid & 31, p = tid >> 5; int s = 0; for (int k = 0; k < 16; ++k) s += CNT[(16 * p + k) * 32 + e]; PART[p * 32 + e] = s; }
    __syncthreads();
    if (tid < 32) { int run = 0; for (int p = 0; p < 16; ++p) { PPRE[p * 32 + tid] = run; run += PART[p * 32 + tid]; } TOT[tid] = run; }
    __syncthreads();
    if (tid == 0) { int ts = 0; for (int e = 0; e < 32; ++e) { TS[e] = ts; ts += (TOT[e] + 255) >> 8; } TS[32] = ts; }
    __syncthreads();
    if (blockIdx.x == 0 && tid < 33) ((int*)(a.ws + WS_SMALL))[tid] = TS[tid];
    for (int blk = blockIdx.x; blk < 256; blk += c.G) {
        if (tid < 32) { int s = TS[tid] * 256 + PPRE[(blk >> 4) * 32 + tid]; for (int b2 = (blk & ~15); b2 < blk; ++b2) s += CNT[b2 * 32 + tid]; BASE[tid] = s; }
        __syncthreads();
        { const int t = blk * 128 + (tid >> 2), jj = tid & 3;
          if (jj < 2) { const int pos = BASE[TOKE[2 * t + jj]] + TOKR[2 * t + jj]; TOKP[2 * t + jj] = pos; RT[pos] = t; } }
        __syncthreads();
    }
}
__device__ __forceinline__ void p10_combine(const Args& a, const Ctx& c) {
    const int lane = c.lane, gw = c.vcu * NWAVES + c.wave, NGW = c.G * NWAVES;
    const int* TOKP = (const int*)(a.ws + WS_TOKP); const float* TOKG = (const float*)(a.ws + WS_TOKG); const bf16* Y = (const bf16*)(a.ws + WS_Y);
    for (int t = gw; t < T; t += NGW) { const int p0 = TOKP[2 * t], p1 = TOKP[2 * t + 1]; const float g0 = TOKG[2 * t], g1 = TOKG[2 * t + 1];
#pragma unroll
        for (int j = 0; j < 4; ++j) { f32x4* op = (f32x4*)(a.out + (size_t)t * D + 4 * lane + 256 * j); f32x4 x = *op;
            const v2u y0 = *(const v2u*)(Y + (size_t)p0 * D + 4 * lane + 256 * j), y1 = *(const v2u*)(Y + (size_t)p1 * D + 4 * lane + 256 * j);
            x[0] += g0 * bf2f(y0.x & 0xffffu) + g1 * bf2f(y1.x & 0xffffu); x[1] += g0 * bf2f(y0.x >> 16) + g1 * bf2f(y1.x >> 16);
            x[2] += g0 * bf2f(y0.y & 0xffffu) + g1 * bf2f(y1.y & 0xffffu); x[3] += g0 * bf2f(y0.y >> 16) + g1 * bf2f(y1.y >> 16);
            *op = x; } }
}
__global__ void __launch_bounds__(NWAVES * 64, 2) hybrid_fwd(Args args) {
    extern __shared__ __attribute__((aligned(16))) unsigned char lds_raw[];
    Ctx c; c.lds = (LAS unsigned char*)lds_raw;
    volatile LAS unsigned* MISC = (volatile LAS unsigned*)(c.lds + MISC_OFF);
    c.tid = threadIdx.x; c.lane = c.tid & 63; c.wave = __builtin_amdgcn_readfirstlane(c.tid >> 6);
    c.G = gridDim.x; { const int bx = blockIdx.x; c.vcu = (c.G % 8 == 0) ? (bx % 8) * (c.G / 8) + bx / 8 : bx; }
    unsigned* ctl = (unsigned*)(args.ws + WS_CTL);
    if (c.tid < 128) MISC[c.tid] = 0u;
    __syncthreads();
    XcdBarrier bar; bar.bar = ctl + CW_BAR; bar.x = 0; bar.st = nullptr;
    if (N_LAUNCHES == 1) bar = xcd_barrier_post(ctl + CW_BAR, MISC + 8);
#define GRID_BAR() do { if (N_LAUNCHES == 1) xcd_barrier(bar); } while (0)
    const int lo = args.ph_lo, hi = args.ph_hi;
#ifndef PH_MASK
#define PH_MASK 0xfff
#endif
#define IN(k) (((PH_MASK >> (k)) & 1) && lo <= (k) && (k) < hi)
#define BOTH(k) (IN(k) && IN((k) + 1))
    unsigned char* ws = args.ws; unsigned char* dout = (unsigned char*)args.out;
#ifndef DBG_REPEAT
#define DBG_REPEAT -1
#endif
#define REPS(k) (((k) == DBG_REPEAT) ? 2 : 1)
    if (IN(0)) { _Pragma("unroll") for (int rep = 0; rep < REPS(0); ++rep) { if (rep) GRID_BAR(); p0_prologue<0>(args, c); } if (BOTH(0)) GRID_BAR(); }
    if (IN(1)) { _Pragma("unroll") for (int rep = 0; rep < REPS(1); ++rep) { if (rep) GRID_BAR();
        pg8::Gemm g{(const pg8::bf16_t*)(dout + DO_H), (const pg8::bf16_t*)(ws + WS_WIN), T, NPROJ, D}; pg8::StaticOrder S; S.init(T, NPROJ, c.G, (int)blockIdx.x);
        pg8::EpiBf16<0> E{(pg8::bf16_t*)(ws + WS_PROJ), 256, nullptr, 256, (size_t)T * 256, 1.f};
        pg8::gemm_phase<pg8::EpiBf16<0>, pg8::StaticOrder, true, true>(c.lds, g, S, E); }
        if (BOTH(1)) GRID_BAR();
    }
    if (IN(2)) { _Pragma("unroll") for (int rep = 0; rep < REPS(2); ++rep) { if (rep) GRID_BAR(); p2_prep(args, c); } if (BOTH(2)) GRID_BAR(); }
    if (IN(3)) { _Pragma("unroll") for (int rep = 0; rep < REPS(3); ++rep) { if (rep) GRID_BAR(); p3_mixer(args, c, MISC, rep); } if (BOTH(3)) GRID_BAR(); }
    if (IN(4)) {
        p0_prologue<1>(args, c);
        __syncthreads();
#pragma unroll 1
        for (int u = blockIdx.x; u < 256; u += c.G) mlstm_unit<1>(args, c, u >> 5, (u >> 3) & 3, u & 7);
        if (BOTH(4)) GRID_BAR();
    }
    if (IN(5)) {
        { pg8::Gemm g{(const pg8::bf16_t*)(dout + DO_YATT), (const pg8::bf16_t*)(ws + WS_WPA), T, D, 512}; pg8::StaticOrder S; S.init(T, D, c.G, (int)blockIdx.x);
          pg8::EpiGate<false> E{(pg8::bf16_t*)(ws + WS_MERGED), D, (const pg8::bf16_t*)(ws + WS_PROJ + (size_t)TL_GA * PROJ_TILE), (size_t)T * 256};
          pg8::gemm_phase<pg8::EpiGate<false>, pg8::StaticOrder, true, true>(c.lds, g, S, E); }
        __syncthreads();
        { pg8::Gemm g{(const pg8::bf16_t*)(dout + DO_YML), (const pg8::bf16_t*)(ws + WS_WPM), T, D, 512}; pg8::StaticOrder S; S.init(T, D, c.G, (int)blockIdx.x);
          pg8::EpiGate<true> E{(pg8::bf16_t*)(ws + WS_MERGED), D, (const pg8::bf16_t*)(ws + WS_PROJ + (size_t)TL_GM * PROJ_TILE), (size_t)T * 256};
          pg8::gemm_phase<pg8::EpiGate<true>, pg8::StaticOrder, true, true>(c.lds, g, S, E); }
        if (BOTH(5)) GRID_BAR();
    }
    if (IN(6)) {
        pg8::Gemm g{(const pg8::bf16_t*)(ws + WS_MERGED), (const pg8::bf16_t*)(ws + WS_WOUT), T, D, D}; pg8::StaticOrder S; S.init(T, D, c.G, (int)blockIdx.x);
        pg8::EpiRes E{args.out, args.in[IN_X], D};
        pg8::gemm_phase<pg8::EpiRes, pg8::StaticOrder, true, true>(c.lds, g, S, E);
        if (BOTH(6)) GRID_BAR();
    }
    if (IN(7)) { _Pragma("unroll") for (int rep = 0; rep < REPS(7); ++rep) { if (rep) GRID_BAR(); p6_router(args, c); } if (BOTH(7)) GRID_BAR(); }
    if (IN(8)) { _Pragma("unroll") for (int rep = 0; rep < REPS(8); ++rep) { if (rep) GRID_BAR(); p7_gather(args, c); } if (BOTH(8)) GRID_BAR(); }
    if (IN(9) || IN(10)) {
        LAS int* TSL = (LAS int*)(c.lds + MISC_OFF + 256);
        if (c.tid < 33) TSL[c.tid] = (int)__hip_atomic_load((unsigned*)(ws + WS_SMALL) + c.tid, RLX_AGENT);
        __syncthreads();
        if (IN(9)) {
            pg8::MoeOrder<true> S{TSL, c.G, (int)blockIdx.x, (const int*)(ws + WS_ROWTOK)};
            pg8::Gemm g{(const pg8::bf16_t*)(ws + WS_XN), (const pg8::bf16_t*)(ws + WS_GU), 0, 0, D};
            pg8::EpiSwiGLU E{(pg8::bf16_t*)(ws + WS_HID)};
            pg8::gemm_phase<pg8::EpiSwiGLU, pg8::MoeOrder<true>, true, true>(c.lds, g, S, E);
            if (BOTH(9)) GRID_BAR();
        }
        if (IN(10)) {
            pg8::MoeOrder<false> S{TSL, c.G, (int)blockIdx.x, nullptr};
            pg8::Gemm g{(const pg8::bf16_t*)(ws + WS_HID), (const pg8::bf16_t*)(ws + WS_DN), 0, 0, 512};
            pg8::EpiDown E{(pg8::bf16_t*)(ws + WS_Y)};
            pg8::gemm_phase<pg8::EpiDown, pg8::MoeOrder<false>, true, true>(c.lds, g, S, E);
            if (BOTH(10)) GRID_BAR();
        }
    }
    if (IN(11)) p10_combine(args, c);
#undef IN
#undef BOTH
#undef GRID_BAR
}

extern "C" void kernel_launch(void* const* d_in, const int* in_sizes, int n_in, void* d_out, int out_size, void* d_ws, size_t ws_size, hipStream_t stream) {
    static int grid = 0;
    if (grid == 0) {
        if (n_in != 22 || in_sizes[0] != T * D || out_size != T * D || ws_size < WS_END) { fprintf(stderr, "kernel_launch: unexpected shapes (n_in %d, in0 %d, out %d, ws %zu); nothing launched\n", n_in, n_in > 0 ? in_sizes[0] : -1, out_size, ws_size); grid = -1; return; }
        int dev = 0, cus = 0, per_cu = 0;
        if (hipGetDevice(&dev) != hipSuccess || hipDeviceGetAttribute(&cus, hipDeviceAttributeMultiprocessorCount, dev) != hipSuccess) { grid = -1; return; }
        if (hipFuncSetAttribute((const void*)hybrid_fwd, hipFuncAttributeMaxDynamicSharedMemorySize, LDS_BYTES) != hipSuccess) { fprintf(stderr, "kernel_launch: hipFuncSetAttribute failed\n"); grid = -1; return; }
        if (hipOccupancyMaxActiveBlocksPerMultiprocessor(&per_cu, (const void*)hybrid_fwd, NWAVES * 64, LDS_BYTES) != hipSuccess || per_cu < 1)
            fprintf(stderr, "kernel_launch: note: occupancy query reports %d workgroups per CU\n", per_cu);
        (void)hipGetLastError();
        grid = cus;
    }
    if (grid < 0) return;
    if (hipMemsetAsync((char*)d_ws + WS_CTL, 0, CTL_ZERO_BYTES, stream) != hipSuccess) return;
    Args a{};
    for (int i = 0; i < 22; ++i) a.in[i] = (const float*)d_in[i];
    a.out = (float*)d_out; a.ws = (unsigned char*)d_ws;
    for (int li = 0; li < N_LAUNCHES; ++li) {
        a.ph_lo = (N_LAUNCHES == 1) ? 0 : li; a.ph_hi = (N_LAUNCHES == 1) ? NPH : li + 1; a.li = li;
        hipLaunchKernelGGL(hybrid_fwd, dim3(grid), dim3(NWAVES * 64), LDS_BYTES, stream, a);
        if (hipPeekAtLastError() != hipSuccess) { fprintf(stderr, "kernel_launch: launch %d failed\n", li); break; }
    }
}
```

```cpp
#include <hip/hip_runtime.h>
#include <cstdio>
#include <cstdint>
namespace pg8 {
#define PG8_LAS __attribute__((address_space(3)))
typedef unsigned short bf16_t;
typedef short bf16x8 __attribute__((ext_vector_type(8)));
typedef float f32x4 __attribute__((ext_vector_type(4)));
typedef unsigned u32x4 __attribute__((ext_vector_type(4)));
constexpr int BM = 256, BK = 64, HALF = 128, HTB = HALF * BK * 2  , STAGE_BYTES = 8 * HTB, NXCD = 8, WGM = 8;

__host__ __device__ __forceinline__ int lds_byte(int r, int c) { const int st = (r >> 4) * 2 + (c >> 5), rr = r & 15, cc = c & 31, ob = rr * 64 + cc * 2; return st * 1024 + (ob ^ (((ob >> 9) & 1) << 5)); }
__host__ __device__ __forceinline__ void stage_rc(int b, int& R, int& C) { const int st = b / 1024, sb = b % 1024, swz = sb ^ (((sb >> 9) & 1) << 5); R = (st >> 1) * 16 + swz / 64; C = (st & 1) * 32 + (swz % 64) / 2; }
__host__ __device__ __forceinline__ int perm32(int rho) { const int n = rho >> 4, i = rho & 15; return 8 * (i >> 2) + 4 * n + (i & 3); }

struct Unit { int pm, pn; };
struct Gemm { const bf16_t* A; const bf16_t* Bt; int M, N, K; };

struct StaticOrder {
    static constexpr bool GATHER = false;
    int nM, nN, nwg, G, c;
    __host__ __device__ void init(int M, int N, int G_, int c_) { nM = M / BM; nN = N / BM; nwg = nM * nN; G = G_; c = c_; }
    __host__ __device__ bool next(int i, Unit& u) const {
        const long L = (long)i * G + c; if (L >= nwg) return false;
        int wgid = (int)L; { const int q = nwg / NXCD, r = nwg % NXCD, xcd = wgid % NXCD, off = wgid / NXCD; wgid = (xcd < r ? xcd * (q + 1) : r * (q + 1) + (xcd - r) * q) + off; }
        const int nig = WGM * nN, gid = wgid / nig, fm = gid * WGM, gsz = (nM - fm) < WGM ? (nM - fm) : WGM;
        u.pm = fm + ((wgid % nig) % gsz); u.pn = (wgid % nig) / gsz; return true;
    }
    __device__ __forceinline__ void a_ready(const Unit&) const {}
    __device__ __forceinline__ void done(const Unit&) const {}
};

typedef __bf16 bf2_t __attribute__((ext_vector_type(2)));
__device__ __forceinline__ unsigned cvt_pk_bf16(float lo, float hi) { bf2_t v; v[0] = (__bf16)lo; v[1] = (__bf16)hi; return __builtin_bit_cast(unsigned, v); }
typedef float f32x2 __attribute__((ext_vector_type(2)));
template <int ACT  > struct EpiBf16 {
    static constexpr bool PERM = true, AFTER_DRAIN = false; static_assert(ACT == 0, "EpiBf16: no activation here");
    bf16_t* O; int ldc; const float* bias; int split_cols; size_t split_stride; float scale0;
    __device__ __forceinline__ void operator()(const f32x4 (&acc)[2][2][4][2], const Unit& u, int wr, int wc, int fr, int fq) const {
        const int row0 = u.pm * BM + wr * 64 + fr; int colt = u.pn * BM; bf16_t* base = O;
        float sc = 1.f; if (split_cols) { const int t = colt / split_cols; base += (size_t)t * split_stride; colt -= t * split_cols; if (t == 0) sc = scale0; }
        const int col0 = colt + wc * 32 + 8 * fq, bcol0 = u.pn * BM + wc * 32 + 8 * fq;
        f32x4 bv[2][2];
#pragma unroll
        for (int bj = 0; bj < 2; ++bj)
#pragma unroll
            for (int n = 0; n < 2; ++n) bv[bj][n] = bias ? *(const f32x4*)(bias + bcol0 + bj * HALF + 4 * n) : (f32x4){0.f, 0.f, 0.f, 0.f};
#pragma unroll
        for (int ai = 0; ai < 2; ++ai)
#pragma unroll
            for (int m = 0; m < 4; ++m) { bf16_t* rowp = base + (size_t)(row0 + ai * HALF + m * 16) * ldc + col0;
#pragma unroll
                for (int bj = 0; bj < 2; ++bj) { f32x4 v0 = acc[ai][bj][m][0] + bv[bj][0], v1 = acc[ai][bj][m][1] + bv[bj][1];
                    v0 = v0 * sc; v1 = v1 * sc; u32x4 w; w.x = cvt_pk_bf16(v0[0], v0[1]); w.y = cvt_pk_bf16(v0[2], v0[3]); w.z = cvt_pk_bf16(v1[0], v1[1]); w.w = cvt_pk_bf16(v1[2], v1[3]);
                    *(u32x4*)(rowp + bj * HALF) = w; } }
    }
};
__device__ __forceinline__ float bf2f_(unsigned b16) { return __uint_as_float(b16 << 16); }
__device__ __forceinline__ float sigm_(float x) { return 1.0f / (1.0f + __expf(-x)); }
template <bool ADD> struct EpiGate {
    static constexpr bool PERM = true, AFTER_DRAIN = false;
    bf16_t* O; int ldc; const bf16_t* gate; size_t gstride;
    __device__ __forceinline__ void operator()(const f32x4 (&acc)[2][2][4][2], const Unit& u, int wr, int wc, int fr, int fq) const {
        const int row0 = u.pm * BM + wr * 64 + fr, colt = wc * 32 + 8 * fq;
        const bf16_t* gt = gate + (size_t)u.pn * gstride;
#pragma unroll
        for (int ai = 0; ai < 2; ++ai)
#pragma unroll
            for (int m = 0; m < 4; ++m) { const size_t row = (size_t)(row0 + ai * HALF + m * 16);
#pragma unroll
                for (int bj = 0; bj < 2; ++bj) { const int c = colt + bj * HALF;
                    const u32x4 gv = *(const u32x4*)(gt + row * 256 + c);
                    bf16_t* op = O + row * ldc + u.pn * BM + c;
                    float pv[8] = {0.f, 0.f, 0.f, 0.f, 0.f, 0.f, 0.f, 0.f};
                    if (ADD) { const u32x4 p = *(const u32x4*)op; pv[0] = bf2f_(p.x & 0xffffu); pv[1] = bf2f_(p.x >> 16); pv[2] = bf2f_(p.y & 0xffffu); pv[3] = bf2f_(p.y >> 16);
                        pv[4] = bf2f_(p.z & 0xffffu); pv[5] = bf2f_(p.z >> 16); pv[6] = bf2f_(p.w & 0xffffu); pv[7] = bf2f_(p.w >> 16); }
                    const f32x4 v0 = acc[ai][bj][m][0], v1 = acc[ai][bj][m][1];
                    float o[8];
                    o[0] = pv[0] + sigm_(bf2f_(gv.x & 0xffffu)) * v0[0]; o[1] = pv[1] + sigm_(bf2f_(gv.x >> 16)) * v0[1];
                    o[2] = pv[2] + sigm_(bf2f_(gv.y & 0xffffu)) * v0[2]; o[3] = pv[3] + sigm_(bf2f_(gv.y >> 16)) * v0[3];
                    o[4] = pv[4] + sigm_(bf2f_(gv.z & 0xffffu)) * v1[0]; o[5] = pv[5] + sigm_(bf2f_(gv.z >> 16)) * v1[1];
                    o[6] = pv[6] + sigm_(bf2f_(gv.w & 0xffffu)) * v1[2]; o[7] = pv[7] + sigm_(bf2f_(gv.w >> 16)) * v1[3];
                    u32x4 w; w.x = cvt_pk_bf16(o[0], o[1]); w.y = cvt_pk_bf16(o[2], o[3]); w.z = cvt_pk_bf16(o[4], o[5]); w.w = cvt_pk_bf16(o[6], o[7]);
                    *(u32x4*)op = w; } }
    }
};
struct EpiRes {
    static constexpr bool PERM = false, AFTER_DRAIN = false;
    float* C; const float* R; int ldc;
    __device__ __forceinline__ void operator()(const f32x4 (&acc)[2][2][4][2], const Unit& u, int wr, int wc, int fr, int fq) const {
        const int row0 = u.pm * BM + wr * 64 + fr, col0 = u.pn * BM + wc * 32 + 4 * fq;
#pragma unroll
        for (int ai = 0; ai < 2; ++ai)
#pragma unroll
            for (int m = 0; m < 4; ++m) { const size_t ro = (size_t)(row0 + ai * HALF + m * 16) * ldc + col0;
#pragma unroll
                for (int bj = 0; bj < 2; ++bj)
#pragma unroll
                    for (int n = 0; n < 2; ++n) { const size_t off = ro + bj * HALF + n * 16; *(f32x4*)(C + off) = *(const f32x4*)(R + off) + acc[ai][bj][m][n]; } }
    }
};
struct EpiSwiGLU {
    static constexpr bool PERM = true, AFTER_DRAIN = false;
    bf16_t* H;
    __device__ __forceinline__ void operator()(const f32x4 (&acc)[2][2][4][2], const Unit& u, int wr, int wc, int fr, int fq) const {
        const int row0 = u.pm * BM + wr * 64 + fr, hc = (u.pn & 3) * 128 + wc * 32 + 8 * fq;
#pragma unroll
        for (int ai = 0; ai < 2; ++ai)
#pragma unroll
            for (int m = 0; m < 4; ++m) { const size_t row = (size_t)(row0 + ai * HALF + m * 16);
                float o[8];
#pragma unroll
                for (int n = 0; n < 2; ++n)
#pragma unroll
                    for (int i = 0; i < 4; ++i) { const float g = acc[ai][0][m][n][i], up = acc[ai][1][m][n][i]; o[n * 4 + i] = g * sigm_(g) * up; }
                u32x4 w; w.x = cvt_pk_bf16(o[0], o[1]); w.y = cvt_pk_bf16(o[2], o[3]); w.z = cvt_pk_bf16(o[4], o[5]); w.w = cvt_pk_bf16(o[6], o[7]);
                *(u32x4*)(H + row * 512 + hc) = w; }
    }
};
struct EpiDown {
    static constexpr bool PERM = true, AFTER_DRAIN = false;
    bf16_t* Y;
    __device__ __forceinline__ void operator()(const f32x4 (&acc)[2][2][4][2], const Unit& u, int wr, int wc, int fr, int fq) const {
        const int row0 = u.pm * BM + wr * 64 + fr, c0 = (u.pn & 3) * 256 + wc * 32 + 8 * fq;
#pragma unroll
        for (int ai = 0; ai < 2; ++ai)
#pragma unroll
            for (int m = 0; m < 4; ++m) { const size_t row = (size_t)(row0 + ai * HALF + m * 16);
#pragma unroll
                for (int bj = 0; bj < 2; ++bj) { const f32x4 v0 = acc[ai][bj][m][0], v1 = acc[ai][bj][m][1];
                    u32x4 w; w.x = cvt_pk_bf16(v0[0], v0[1]); w.y = cvt_pk_bf16(v0[2], v0[3]); w.z = cvt_pk_bf16(v1[0], v1[1]); w.w = cvt_pk_bf16(v1[2], v1[3]);
                    *(u32x4*)(Y + row * 1024 + c0 + bj * HALF) = w; } }
    }
};
template <bool GA_> struct MoeOrder {
    static constexpr bool GATHER = GA_;
    const PG8_LAS int* ts; int G, c; const int* rowtok;
    __device__ __forceinline__ bool next(int i, Unit& u) const {
        const int nt = ts[32]; const long L = (long)i * G + c; if (L >= 4L * nt) return false;
        const int pm = (int)(L >> 2), j = (int)(L & 3); int e = 0;
#pragma unroll
        for (int k = 1; k < 32; ++k) e += (ts[k] <= pm) ? 1 : 0;
        u.pm = pm; u.pn = e * 4 + j; return true;
    }
    __device__ __forceinline__ void a_ready(const Unit&) const {}
    __device__ __forceinline__ void done(const Unit&) const {}
};
template <class Epi, class Sched, bool ALIGN_EPI = false, bool SP2 = false>
__device__ __forceinline__ void gemm_phase(PG8_LAS unsigned char* lds, const Gemm g, const Sched& S, const Epi& E) {
    const int tid = threadIdx.x, wid = __builtin_amdgcn_readfirstlane(tid >> 6), lane = tid & 63, wr = wid >> 2, wc = wid & 3, fr = lane & 15, fq = lane >> 4;
    const int K = g.K, nt = K / BK;
    unsigned voffA[2], voffB[2];
#pragma unroll
    for (int i = 0; i < 2; ++i) { int R, C; stage_rc(tid * 16 + i * 8192, R, C); const int Rb = Epi::PERM ? ((R & ~31) + perm32(R & 31)) : R;
        voffA[i] = (unsigned)(R * K + C) * 2u; voffB[i] = (unsigned)(Rb * K + C) * 2u; }
    const size_t kstep = (size_t)(BK * 2);
    const size_t hstep = (size_t)HALF * K * 2;
    const size_t tstep = 2 * hstep;
    constexpr bool GA = Sched::GATHER;
    static_assert(!GA || SP2, "gathered A rows: SP2 loop only");
    const size_t hstepA = GA ? 0 : hstep;
    unsigned gcur[2][2] = {{0u, 0u}, {0u, 0u}}, gnxt[2][2] = {{0u, 0u}, {0u, 0u}}; int gR[2] = {0, 0}; unsigned gC[2] = {0u, 0u};
    if constexpr (GA) { _Pragma("unroll") for (int i = 0; i < 2; ++i) { int R, C; stage_rc(tid * 16 + i * 8192, R, C); gR[i] = R; gC[i] = (unsigned)C * 2u; } }
#define PG8_GOFF(dst, u) do { if constexpr (GA) { _Pragma("unroll") for (int h_ = 0; h_ < 2; ++h_) _Pragma("unroll") for (int i_ = 0; i_ < 2; ++i_) dst[h_][i_] = (unsigned)S.rowtok[(u).pm * BM + h_ * HALF + gR[i_]] * (unsigned)(K * 2) + gC[i_]; } } while (0)
#define PG8_VA(h, sel) (GA ? ((sel) ? gnxt[h] : gcur[h]) : voffA)
    const unsigned ldsw = (unsigned)wid * 1024u;
    const int aoff = lds_byte(wr * 64 + fr, fq * 8), boff = lds_byte(wc * 32 + fr, fq * 8);
#define PG8_SA(b, h) (((b) * 2 + (h)) * HTB)
#define PG8_SB(b, h) ((4 + (b) * 2 + (h)) * HTB)
#define PG8_STAGE(bufoff, gbase, voff) do { _Pragma("unroll") for (int _i = 0; _i < 2; ++_i) \
        __builtin_amdgcn_global_load_lds((const unsigned*)((const char*)(gbase) + (voff)[_i]), (PG8_LAS unsigned*)(lds + (bufoff) + ldsw + _i * 8192), 16, 0, 0); } while (0)
#define PG8_LDA(dst, b, h) do { _Pragma("unroll") for (int m = 0; m < 4; ++m) _Pragma("unroll") for (int k = 0; k < 2; ++k) dst[m][k] = *(const PG8_LAS bf16x8*)(lds + PG8_SA(b, h) + aoff + m * 2048 + k * 1024); } while (0)
#define PG8_LDB(dst, b, h) do { _Pragma("unroll") for (int n = 0; n < 2; ++n) _Pragma("unroll") for (int k = 0; k < 2; ++k) dst[n][k] = *(const PG8_LAS bf16x8*)(lds + PG8_SB(b, h) + boff + n * 2048 + k * 1024); } while (0)
#define PG8_MMA(ai, bj, At, Bt) do { __builtin_amdgcn_s_setprio(1); _Pragma("unroll") for (int m = 0; m < 4; ++m) _Pragma("unroll") for (int n = 0; n < 2; ++n) _Pragma("unroll") for (int k = 0; k < 2; ++k) \
        acc[ai][bj][m][n] = __builtin_amdgcn_mfma_f32_16x16x32_bf16(Bt[n][k], At[m][k], acc[ai][bj][m][n], 0, 0, 0); __builtin_amdgcn_s_setprio(0); } while (0)
#define PG8_WAIT_V(n) asm volatile("s_waitcnt vmcnt(" #n ")" ::: "memory")
#define PG8_WAIT_L(n) asm volatile("s_waitcnt lgkmcnt(" #n ")" ::: "memory")
#define PG8_BAR __builtin_amdgcn_s_barrier()
#define PG8_SCHED __builtin_amdgcn_sched_barrier(0)
    Unit cur, nxt; int ui = 0;
    if (!S.next(0, cur)) return;
    f32x4 acc[2][2][4][2];
#pragma unroll
    for (int a = 0; a < 2; ++a)
#pragma unroll
        for (int b = 0; b < 2; ++b)
#pragma unroll
            for (int m = 0; m < 4; ++m)
#pragma unroll
                for (int n = 0; n < 2; ++n) acc[a][b][m][n] = (f32x4){0.f, 0.f, 0.f, 0.f};
    bf16x8 At[4][2], B0[2][2], B1[2][2];
    const char* cA = (const char*)g.A + (GA ? 0 : (size_t)cur.pm * tstep); const char* cB = (const char*)g.Bt + (size_t)cur.pn * tstep;
    S.a_ready(cur);
    PG8_GOFF(gcur, cur);
    if constexpr (SP2) {
        PG8_STAGE(PG8_SB(0, 0), cB, voffB); PG8_STAGE(PG8_SB(0, 1), cB + hstep, voffB); PG8_STAGE(PG8_SA(0, 0), cA, PG8_VA(0, false)); PG8_STAGE(PG8_SA(0, 1), cA + hstepA, PG8_VA(1, false));
        if (wr == 1) PG8_BAR;
        PG8_WAIT_V(2); PG8_BAR;
        PG8_STAGE(PG8_SB(1, 0), cB + kstep, voffB); PG8_STAGE(PG8_SA(1, 0), cA + kstep, PG8_VA(0, false)); PG8_STAGE(PG8_SB(1, 1), cB + hstep + kstep, voffB);
        PG8_WAIT_V(6); PG8_BAR;
    } else {
        PG8_STAGE(PG8_SB(0, 0), cB, voffB); PG8_STAGE(PG8_SA(0, 0), cA, voffA); PG8_STAGE(PG8_SB(0, 1), cB + hstep, voffB); PG8_STAGE(PG8_SA(0, 1), cA + hstep, voffA);
        if (wr == 1) PG8_BAR;
        PG8_WAIT_V(4); PG8_BAR;
        PG8_STAGE(PG8_SB(1, 0), cB + kstep, voffB); PG8_STAGE(PG8_SA(1, 0), cA + kstep, voffA); PG8_STAGE(PG8_SB(1, 1), cB + hstep + kstep, voffB);
        PG8_WAIT_V(6); PG8_BAR;
    }
    for (;;) {
        const bool has_next = S.next(ui + 1, nxt);
        if (has_next) PG8_GOFF(gnxt, nxt);
        const char* nA = has_next ? (const char*)g.A + (GA ? 0 : (size_t)nxt.pm * tstep) : cA; const char* nB = has_next ? (const char*)g.Bt + (size_t)nxt.pn * tstep : cB;
        for (int t = 0; t < nt; t += 2) {
            const bool last = (t == nt - 2);
            const char* a1 = cA + (size_t)(t + 1) * kstep;
            const char* a2 = last ? nA : cA + (size_t)(t + 2) * kstep; const char* b2 = last ? nB : cB + (size_t)(t + 2) * kstep;
            const char* a3 = a2 + kstep; const char* b3 = b2 + kstep;
            if (last && has_next) S.a_ready(nxt);
            const bool seln = last && has_next;
            if constexpr (SP2) {
            PG8_LDB(B0, 0, 0); PG8_LDB(B1, 0, 1); PG8_SCHED; PG8_LDA(At, 0, 0); PG8_STAGE(PG8_SA(1, 1), a1 + hstepA, PG8_VA(1, false));
            PG8_WAIT_V(8); PG8_WAIT_L(0); PG8_BAR; PG8_MMA(0, 0, At, B0); PG8_MMA(0, 1, At, B1); PG8_BAR; PG8_SCHED;
            PG8_LDA(At, 0, 1); PG8_STAGE(PG8_SB(0, 0), b2, voffB); PG8_STAGE(PG8_SB(0, 1), b2 + hstep, voffB); PG8_STAGE(PG8_SA(0, 0), a2, PG8_VA(0, seln));
            PG8_WAIT_V(8); PG8_WAIT_L(0); PG8_BAR; PG8_MMA(1, 0, At, B0); PG8_MMA(1, 1, At, B1); PG8_BAR; PG8_SCHED;
            PG8_LDB(B0, 1, 0); PG8_LDB(B1, 1, 1); PG8_SCHED; PG8_LDA(At, 1, 0); PG8_STAGE(PG8_SA(0, 1), a2 + hstepA, PG8_VA(1, seln));
            PG8_WAIT_V(8); PG8_WAIT_L(0); PG8_BAR; PG8_MMA(0, 0, At, B0); PG8_MMA(0, 1, At, B1); PG8_BAR; PG8_SCHED;
            PG8_LDA(At, 1, 1); PG8_STAGE(PG8_SB(1, 0), b3, voffB); PG8_STAGE(PG8_SB(1, 1), b3 + hstep, voffB); PG8_STAGE(PG8_SA(1, 0), a3, PG8_VA(0, seln));
            PG8_WAIT_V(8); PG8_WAIT_L(0); PG8_BAR; PG8_MMA(1, 0, At, B0); PG8_MMA(1, 1, At, B1); PG8_BAR; PG8_SCHED;
            } else {
            PG8_LDB(B0, 0, 0); PG8_SCHED; PG8_LDA(At, 0, 0); PG8_STAGE(PG8_SA(1, 1), a1 + hstep, voffA);
            PG8_WAIT_L(8); PG8_BAR; PG8_WAIT_L(0); PG8_MMA(0, 0, At, B0); PG8_BAR; PG8_SCHED;
            PG8_LDB(B1, 0, 1); PG8_STAGE(PG8_SB(0, 0), b2, voffB);
            PG8_BAR; PG8_WAIT_L(0); PG8_MMA(0, 1, At, B1); PG8_BAR;
            PG8_LDA(At, 0, 1); PG8_STAGE(PG8_SA(0, 0), a2, voffA);
            PG8_BAR; PG8_WAIT_L(0); PG8_MMA(1, 0, At, B0); PG8_BAR; PG8_SCHED;
            PG8_STAGE(PG8_SB(0, 1), b2 + hstep, voffB);
            PG8_WAIT_V(6); PG8_BAR; PG8_MMA(1, 1, At, B1); PG8_BAR;
            PG8_LDB(B0, 1, 0); PG8_SCHED; PG8_LDA(At, 1, 0); PG8_STAGE(PG8_SA(0, 1), a2 + hstep, voffA);
            PG8_WAIT_L(8); PG8_BAR; PG8_WAIT_L(0); PG8_MMA(0, 0, At, B0); PG8_BAR; PG8_SCHED;
            PG8_LDB(B1, 1, 1); PG8_STAGE(PG8_SB(1, 0), b3, voffB);
            PG8_BAR; PG8_WAIT_L(0); PG8_MMA(0, 1, At, B1); PG8_BAR;
            PG8_LDA(At, 1, 1); PG8_STAGE(PG8_SA(1, 0), a3, voffA);
            PG8_BAR; PG8_WAIT_L(0); PG8_MMA(1, 0, At, B0); PG8_BAR; PG8_SCHED;
            PG8_STAGE(PG8_SB(1, 1), b3 + hstep, voffB);
            PG8_WAIT_V(6); PG8_BAR; PG8_MMA(1, 1, At, B1); PG8_BAR;
            }
        }
        if constexpr (ALIGN_EPI) { if (wr == 0) PG8_BAR; }
        if constexpr (!Epi::AFTER_DRAIN) { E(acc, cur, wr, wc, fr, fq); S.done(cur); }
        if (!has_next) break;
#pragma unroll
        for (int a = 0; a < 2; ++a)
#pragma unroll
            for (int b = 0; b < 2; ++b)
#pragma unroll
                for (int m = 0; m < 4; ++m)
#pragma unroll
                    for (int n = 0; n < 2; ++n) acc[a][b][m][n] = (f32x4){0.f, 0.f, 0.f, 0.f};
        cur = nxt; cA = nA; cB = nB; ++ui;
        if constexpr (GA) { _Pragma("unroll") for (int h_ = 0; h_ < 2; ++h_) _Pragma("unroll") for (int i_ = 0; i_ < 2; ++i_) gcur[h_][i_] = gnxt[h_][i_]; }
        if constexpr (ALIGN_EPI) { if (wr == 1) PG8_BAR; }
    }
    PG8_WAIT_V(0);
    if constexpr (!ALIGN_EPI) { if (wr == 0) PG8_BAR; }
    PG8_BAR;
    if constexpr (Epi::AFTER_DRAIN) { E.fused(acc, cur, wr, wc, fr, fq, lds, wid, lane); S.done(cur); }
#undef PG8_GOFF
#undef PG8_VA
#undef PG8_SA
#undef PG8_SB
#undef PG8_STAGE
#undef PG8_LDA
#undef PG8_LDB
#undef PG8_MMA
#undef PG8_WAIT_V
#undef PG8_WAIT_L
#undef PG8_BAR
#undef PG8_SCHED
}
}
constexpr int NWAVES = 8;
constexpr int BATCH = 8, SEQ = 4096, D = 1024, T = BATCH * SEQ;
constexpr int NPROJ = 5376;
constexpr int NTILE = NPROJ / 256;
constexpr float EPS = 1e-6f;
#ifndef MK_N_LAUNCHES
#define MK_N_LAUNCHES 1
#endif
#ifndef DBG_NPH
#define DBG_NPH 12
#endif
constexpr int NPH = DBG_NPH;
constexpr int N_LAUNCHES = MK_N_LAUNCHES;
static_assert(N_LAUNCHES == 1 || N_LAUNCHES == NPH, "MK_N_LAUNCHES is 1 or NPH");

constexpr size_t MiB = 1u << 20;
constexpr size_t WS_CTL = 0, CTL_ZERO_BYTES = 1 * MiB;
constexpr size_t WS_SMALL = 1 * MiB;
constexpr size_t WS_WIN = 2 * MiB;
constexpr size_t WS_WPA = 13 * MiB, WS_WPM = 14 * MiB, WS_WOUT = 15 * MiB;
constexpr size_t WS_TOKE = 17 * MiB;
constexpr size_t WS_TOKR = WS_TOKE + 256 * 1024;
constexpr size_t WS_TOKP = WS_TOKR + 256 * 1024;
constexpr size_t WS_TOKG = WS_TOKP + 256 * 1024;
constexpr size_t WS_CNT = WS_TOKG + 256 * 1024;
constexpr size_t WS_ROWTOK = WS_CNT + 64 * 1024;
constexpr int NROWS_MAX = 73728;
constexpr size_t WS_SC = 452 * MiB;
constexpr size_t WS_SC2 = 116 * MiB + 3 * ((size_t)T * 256 * 2);
constexpr size_t WS_GU = 20 * MiB;
constexpr size_t WS_DN = 84 * MiB;
constexpr size_t WS_PROJ = 116 * MiB;
constexpr size_t PROJ_TILE = (size_t)T * 256 * 2;
constexpr size_t WS_MLST = 116 * MiB;
constexpr size_t WS_MERGED = 116 * MiB;
constexpr size_t WS_XN = 180 * MiB;
constexpr size_t WS_XG = 244 * MiB;
constexpr size_t WS_HID = 388 * MiB;
constexpr size_t WS_Y = 244 * MiB;
constexpr size_t WS_END = 512 * MiB;
static_assert(WS_PROJ + NTILE * PROJ_TILE == 452 * MiB, "proj map");
constexpr size_t DO_H = 0, DO_YATT = 0, DO_YML = 32 * MiB, DO_KN = 64 * MiB, DO_IKR = 72 * MiB, DO_IQR = 74 * MiB, DO_AQN = 90 * MiB;
constexpr int TL_AQ = 0, TL_KV = 2, TL_IQ = 3, TL_SM = 4, TL_MQ = 5, TL_MK = 7, TL_MV = 9, TL_MO = 11, TL_GA = 13, TL_GM = 17;
constexpr int CW_BAR = 4096;
constexpr int CW_Q = 16384;
constexpr int LDS_BYTES = 163840, MISC_OFF = LDS_BYTES - 512;

#define GAS __attribute__((address_space(1)))
#define LAS __attribute__((address_space(3)))
typedef unsigned short bf16;
typedef unsigned v4u __attribute__((ext_vector_type(4)));
typedef unsigned v2u __attribute__((ext_vector_type(2)));
typedef float f32x4 __attribute__((ext_vector_type(4)));
typedef float f32x2 __attribute__((ext_vector_type(2)));
typedef short bf16x8 __attribute__((ext_vector_type(8)));
typedef GAS unsigned gu32;
#define RLX_AGENT __ATOMIC_RELAXED, __HIP_MEMORY_SCOPE_AGENT
#define LDS_WAIT() asm volatile("s_waitcnt lgkmcnt(0)" ::: "memory")
__device__ __forceinline__ float bf2f(unsigned b16) { return __uint_as_float(b16 << 16); }
__device__ __forceinline__ unsigned f2bf(float f) { unsigned u = __float_as_uint(f); return (u + 0x7fffu + ((u >> 16) & 1u)) >> 16; }
__device__ __forceinline__ unsigned pk2(float lo, float hi) { return pg8::cvt_pk_bf16(lo, hi); }
__device__ __forceinline__ float sigm(float x) { return 1.0f / (1.0f + __expf(-x)); }
__device__ __forceinline__ float wave_sum(float v) {
    v += __int_as_float(__builtin_amdgcn_update_dpp(0, __float_as_int(v), 0xB1, 0xF, 0xF, true));
    v += __int_as_float(__builtin_amdgcn_update_dpp(0, __float_as_int(v), 0x4E, 0xF, 0xF, true));
    v += __int_as_float(__builtin_amdgcn_update_dpp(0, __float_as_int(v), 0x124, 0xF, 0xF, true));
    v += __int_as_float(__builtin_amdgcn_update_dpp(0, __float_as_int(v), 0x128, 0xF, 0xF, true));
    { const auto r = __builtin_amdgcn_permlane16_swap(__float_as_uint(v), __float_as_uint(v), false, false); v = __uint_as_float(r[0]) + __uint_as_float(r[1]); }
    { const auto r = __builtin_amdgcn_permlane32_swap(__float_as_uint(v), __float_as_uint(v), false, false); v = __uint_as_float(r[0]) + __uint_as_float(r[1]); }
    return v;
}
__device__ __forceinline__ void unpack8(const v4u r, float (&f)[8]) {
    f[0] = bf2f(r.x & 0xffffu); f[1] = bf2f(r.x >> 16); f[2] = bf2f(r.y & 0xffffu); f[3] = bf2f(r.y >> 16);
    f[4] = bf2f(r.z & 0xffffu); f[5] = bf2f(r.z >> 16); f[6] = bf2f(r.w & 0xffffu); f[7] = bf2f(r.w >> 16);
}
__device__ __forceinline__ v4u pack8(const float (&f)[8]) { v4u w; w.x = pk2(f[0], f[1]); w.y = pk2(f[2], f[3]); w.z = pk2(f[4], f[5]); w.w = pk2(f[6], f[7]); return w; }
#define XB_TMO      128
#define XB_XCNT(j)  (256  + 64 * (j))
#define XB_XSUB(j)  (1280 + 64 * (j))
#define XB_XGEN(j)  (2304 + 64 * (j))
#define XB_TOP      3328
#define XB_TOPGEN   3392
#define XCD_BAR_WORDS 3456
#define XB_SPIN_CAP (1u << 18)

__device__ __forceinline__ unsigned xb_ld(unsigned* p)              { return __hip_atomic_load(p, __ATOMIC_RELAXED, __HIP_MEMORY_SCOPE_AGENT); }
__device__ __forceinline__ unsigned xb_add(unsigned* p, unsigned v) { return __hip_atomic_fetch_add(p, v, __ATOMIC_RELAXED, __HIP_MEMORY_SCOPE_AGENT); }
__device__ __forceinline__ unsigned xb_xcc_id() { return (unsigned)__builtin_amdgcn_s_getreg((3 << 11) | 20) & 0xFu; }
#define XB_SPIN(cond, bar) do { unsigned _sp = 0; while (cond) { __builtin_amdgcn_s_sleep(1); \
    if ((++_sp & 255u) == 0u) { if (xb_ld(&(bar)[XB_TMO])) break; if (_sp > XB_SPIN_CAP) { atomicAdd(&(bar)[XB_TMO], 1u); break; } } } } while (0)

struct XcdBarrier {
    unsigned* bar; unsigned x;
    volatile LAS unsigned* st;
};

__device__ __forceinline__ XcdBarrier xcd_barrier_post(unsigned* bar, volatile LAS unsigned* st) {
    XcdBarrier b; b.bar = bar; b.x = xb_xcc_id(); b.st = st;
    if (threadIdx.x == 0) (void)xb_add(&bar[XB_XCNT(b.x)], 1u);
    return b;
}
__device__ __forceinline__ void xcd_barrier_complete(unsigned* bar, unsigned x, unsigned& nloc, unsigned& nx) {
    const unsigned G = gridDim.x * gridDim.y * gridDim.z;
    unsigned sum, cnt, mine, sp = 0u;
    for (;;) {
        sum = 0u; cnt = 0u; mine = 0u;
#pragma unroll
        for (unsigned j = 0; j < 16; ++j) { const unsigned c = xb_ld(&bar[XB_XCNT(j)]); sum += c; cnt += (c > 0u) ? 1u : 0u; mine = (j == x) ? c : mine; }
        if (sum == G) break;
        __builtin_amdgcn_s_sleep(1);
        if ((++sp & 255u) == 0u) { if (xb_ld(&bar[XB_TMO])) break; if (sp > XB_SPIN_CAP) { atomicAdd(&bar[XB_TMO], 1u); break; } }
    }
    nloc = mine > 0u ? mine : 1u; nx = cnt > 0u ? cnt : 1u;
}

__device__ __forceinline__ void xcd_barrier(const XcdBarrier& b) {
    asm volatile("s_waitcnt vmcnt(0)" ::: "memory");
    __syncthreads();
    if (threadIdx.x == 0) {
        unsigned* bar = b.bar;
        __builtin_amdgcn_s_waitcnt(0);
        unsigned nloc = b.st[0], nx = b.st[1];
        if (nloc == 0u) { xcd_barrier_complete(bar, b.x, nloc, nx); b.st[0] = nloc; b.st[1] = nx; }
        const unsigned old = xb_add(&bar[XB_XSUB(b.x)], 1u);
        const unsigned gen = old / nloc;
        if (old + 1u == (gen + 1u) * nloc) {
            __builtin_amdgcn_fence(__ATOMIC_RELEASE, "agent");
            asm volatile("s_waitcnt vmcnt(0)" ::: "memory");
            const unsigned og = xb_add(&bar[XB_TOP], 1u);
            const unsigned tg = og / nx;
            if (og + 1u == (tg + 1u) * nx) xb_add(&bar[XB_TOPGEN], 1u);
            else XB_SPIN(xb_ld(&bar[XB_TOPGEN]) == tg, bar);
            __builtin_amdgcn_fence(__ATOMIC_ACQUIRE, "agent");
            xb_add(&bar[XB_XGEN(b.x)], 1u);
            asm volatile("s_waitcnt vmcnt(0)" ::: "memory");
        } else {
            XB_SPIN(xb_ld(&bar[XB_XGEN(b.x)]) == gen, bar);
            __builtin_amdgcn_fence(__ATOMIC_ACQUIRE, "agent");
            asm volatile("s_waitcnt vmcnt(0)" ::: "memory");
        }
    }
    __syncthreads();
}
struct Args { const float* in[22]; float* out; unsigned char* ws; int ph_lo, ph_hi, li, pad; };
struct Ctx { int tid, lane, wave, G, vcu; LAS unsigned char* lds; };
#define IN_X 0
#define IN_POS 1
#define IN_GMIX 2
#define IN_WIN 3
#define IN_GQ 4
#define IN_GK 5
#define IN_WCONV 6
#define IN_BCONV 7
#define IN_BI 8
#define IN_BF 9
#define IN_GML 10
#define IN_WPA 11
#define IN_WPM 12
#define IN_WOUT 13
#define IN_GMOE 14
#define IN_WRG 15
#define IN_BRG 16
#define IN_WRE 17
#define IN_BRE 18
#define IN_WEG 19
#define IN_WEU 20
#define IN_WED 21

__device__ __forceinline__ int win_src_col(int n) {
    if (n < 1064) return n;
    if (n < 1068) return 3112 + (n - 1064);
    if (n < 1072) return 3116 + (n - 1068);
    if (n < 1280) return -1;
    if (n < 3328) return n - 216;
    return n - 208;
}
__device__ __forceinline__ void tr_item(const float* W, int ldw, int scol, int k0, bf16* wt0, int K, LAS float* scr, int lane) {
    const int sc0 = __builtin_amdgcn_readfirstlane(scol), sc31 = __builtin_amdgcn_readlane(scol, 31);
    if (sc0 >= 0 && sc31 == sc0 + 31 && (sc0 & 3) == 0 && (ldw & 3) == 0) {
#pragma unroll
        for (int i = 0; i < 8; ++i) { const int kk = 8 * i + (lane >> 3); const f32x4 v = *(const f32x4*)(W + (size_t)(k0 + kk) * ldw + sc0 + 4 * (lane & 7));
            LAS float* d = scr + kk * 33 + 4 * (lane & 7); d[0] = v[0]; d[1] = v[1]; d[2] = v[2]; d[3] = v[3]; }
    } else {
#pragma unroll 8
        for (int i = 0; i < 32; ++i) { const int kk = 2 * i + (lane >> 5); scr[kk * 33 + (lane & 31)] = scol >= 0 ? W[(size_t)(k0 + kk) * ldw + scol] : 0.f; }
    }
    LDS_WAIT(); asm volatile("" ::: "memory");
    const int c = lane & 7;
#pragma unroll
    for (int j = 0; j < 4; ++j) { const int n = (lane >> 3) + 8 * j; const LAS float* s = scr + (8 * c) * 33 + n;
        v4u o; o.x = pk2(s[0 * 33], s[1 * 33]); o.y = pk2(s[2 * 33], s[3 * 33]); o.z = pk2(s[4 * 33], s[5 * 33]); o.w = pk2(s[6 * 33], s[7 * 33]);
        *(v4u*)(wt0 + (size_t)n * K + 8 * c) = o; }
    LDS_WAIT(); asm volatile("" ::: "memory");
}
template <int PART> __device__ __forceinline__ void p0_prologue(const Args& a, const Ctx& c, int gw, int NGW) {
    unsigned char* ws = a.ws;
    LAS float* scr = (LAS float*)(c.lds + c.wave * 16384);
    const int lane = c.lane;
    constexpr int I_IN = 16 * 168, I_PA = 8 * 32, I_PM = 8 * 32, I_OUT = 16 * 32, I_GU = 32 * 16 * 32, I_DN = 32 * 8 * 32;
    constexpr int NPRJ = I_IN + I_PA + I_PM + I_OUT, NIT = NPRJ + I_GU + I_DN;
    for (int it = (PART ? NPRJ : 0) + gw; it < (PART ? NIT : NPRJ); it += NGW) {
        int r = it;
        if (r < I_IN) { const int kb = r / 168, nb = r % 168; tr_item(a.in[IN_WIN], 5168, win_src_col(32 * nb + (lane & 31)), 64 * kb, (bf16*)(ws + WS_WIN) + (size_t)(32 * nb) * 1024 + 64 * kb, 1024, scr, lane); continue; } r -= I_IN;
        if (r < I_PA) { const int kb = r / 32, nb = r % 32; tr_item(a.in[IN_WPA], 1024, 32 * nb + (lane & 31), 64 * kb, (bf16*)(ws + WS_WPA) + (size_t)(32 * nb) * 512 + 64 * kb, 512, scr, lane); continue; } r -= I_PA;
        if (r < I_PM) { const int kb = r / 32, nb = r % 32; tr_item(a.in[IN_WPM], 1024, 32 * nb + (lane & 31), 64 * kb, (bf16*)(ws + WS_WPM) + (size_t)(32 * nb) * 512 + 64 * kb, 512, scr, lane); continue; } r -= I_PM;
        if (r < I_OUT) { const int kb = r / 32, nb = r % 32; tr_item(a.in[IN_WOUT], 1024, 32 * nb + (lane & 31), 64 * kb, (bf16*)(ws + WS_WOUT) + (size_t)(32 * nb) * 1024 + 64 * kb, 1024, scr, lane); continue; } r -= I_OUT;
        if (r < I_GU) { const int e = r / 512, q = r % 512, kb = q / 32, nb = q % 32, t = nb >> 3, bj = (nb >> 2) & 1, i0 = (nb & 3) * 32;
            const float* src = (bj ? a.in[IN_WEU] : a.in[IN_WEG]) + (size_t)e * 1024 * 512;
            tr_item(src, 512, 128 * t + i0 + (lane & 31), 64 * kb, (bf16*)(ws + WS_GU) + ((size_t)e * 1024 + 32 * nb) * 1024 + 64 * kb, 1024, scr, lane); continue; } r -= I_GU;
        { const int e = r / 256, q = r % 256, kb = q / 32, nb = q % 32;
            tr_item(a.in[IN_WED] + (size_t)e * 512 * 1024, 1024, 32 * nb + (lane & 31), 64 * kb, (bf16*)(ws + WS_DN) + ((size_t)e * 1024 + 32 * nb) * 512 + 64 * kb, 512, scr, lane); }
    }
    if (PART) return;
    const float* g = a.in[IN_GMIX]; f32x4 gv[4];
#pragma unroll
    for (int j = 0; j < 4; ++j) gv[j] = *(const f32x4*)(g + 4 * lane + 256 * j);
    bf16* H = (bf16*)((unsigned char*)a.out + DO_H);
    for (int m = gw; m < T; m += NGW) {
        const f32x4* xr = (const f32x4*)(a.in[IN_X] + (size_t)m * D) + lane; f32x4 v[4]; float s = 0.f;
#pragma unroll
        for (int j = 0; j < 4; ++j) { v[j] = xr[64 * j]; s += (v[j].x * v[j].x + v[j].y * v[j].y) + (v[j].z * v[j].z + v[j].w * v[j].w); }
        const float r = rsqrtf(wave_sum(s) * (1.f / D) + EPS);
        v2u* o8 = (v2u*)(H + (size_t)m * D) + lane;
#pragma unroll
        for (int j = 0; j < 4; ++j) { v2u w; w.x = pk2(v[j].x * r * gv[j].x, v[j].y * r * gv[j].y); w.y = pk2(v[j].z * r * gv[j].z, v[j].w * r * gv[j].w); o8[64 * j] = w; }
    }
}

__device__ __forceinline__ const bf16* proj_tile(const Args& a, int tile) { return (const bf16*)(a.ws + WS_PROJ + (size_t)tile * PROJ_TILE); }
#define DPPF(x_, ctrl_) __int_as_float(__builtin_amdgcn_update_dpp(0, __float_as_int(x_), ctrl_, 0xF, 0xF, true))
__device__ __forceinline__ void p2_prep(const Args& a, const Ctx& c) {
    const int lane = c.lane, gw = c.vcu * NWAVES + c.wave, NGW = c.G * NWAVES;
    float invf = 0.f;
    if (lane < 8) invf = (float)pow(500000.0, -(double)lane / 8.0); else if (lane < 12) invf = (float)pow(500000.0, -(double)(lane - 8) / 4.0);
    float gq[8], gk[8];
#pragma unroll
    for (int i = 0; i < 8; ++i) { gq[i] = a.in[IN_GQ][8 * (lane & 7) + i]; gk[i] = a.in[IN_GK][8 * (lane & 7) + i]; }
    const int* pos = (const int*)a.in[IN_POS];
    unsigned char* dout = (unsigned char*)a.out;
    bf16* AQN = (bf16*)(dout + DO_AQN); bf16* KN = (bf16*)(dout + DO_KN); bf16* IQR = (bf16*)(dout + DO_IQR); bf16* IKR = (bf16*)(dout + DO_IKR);
    const int l7 = lane & 7;
    for (int t = gw; t < T; t += NGW) {
        const float ang = (float)pos[t] * invf;
        const double rev = (double)ang * 0.15915494309189535; const float frv = (float)(rev - __builtin_rint(rev));
        float cs = __builtin_amdgcn_cosf(frv), sn = __builtin_amdgcn_sinf(frv);
        float ca[8], sa[8], ci[4], si[4];
#pragma unroll
        for (int i = 0; i < 8; ++i) { ca[i] = __int_as_float(__builtin_amdgcn_readlane(__float_as_int(cs), i)); sa[i] = __int_as_float(__builtin_amdgcn_readlane(__float_as_int(sn), i)); }
#pragma unroll
        for (int i = 0; i < 4; ++i) { ci[i] = __int_as_float(__builtin_amdgcn_readlane(__float_as_int(cs), 8 + i)); si[i] = __int_as_float(__builtin_amdgcn_readlane(__float_as_int(sn), 8 + i)); }
        { const int col = (lane >> 3) * 64 + 8 * l7; const bf16* src = proj_tile(a, TL_AQ + (col >> 8)) + (size_t)t * 256 + (col & 255);
          float f[8]; unpack8(*(const v4u*)src, f); float ss = 0.f;
#pragma unroll
          for (int i = 0; i < 8; ++i) ss += f[i] * f[i];
          ss += DPPF(ss, 0xB1); ss += DPPF(ss, 0x4E); ss += DPPF(ss, 0x141);
          const float r = rsqrtf(ss * (1.f / 64.f) + EPS);
#pragma unroll
          for (int i = 0; i < 8; ++i) f[i] = f[i] * r * gq[i];
          float o[8];
#pragma unroll
          for (int i = 0; i < 8; ++i) { const float p = DPPF(f[i], 0xB1); o[i] = (l7 == 0) ? (f[i] * ca[i] - p * sa[i]) : ((l7 == 1) ? (f[i] * ca[i] + p * sa[i]) : f[i]); o[i] *= 0.125f * 1.4426950408889634f; }
          *(v4u*)(AQN + (size_t)t * 512 + col) = pack8(o); }
        { const int l15 = lane & 15; const int col = (l15 >> 3) * 64 + 8 * l7; const bf16* src = proj_tile(a, TL_KV) + (size_t)t * 256 + col;
          float f[8]; unpack8(*(const v4u*)src, f); float ss = 0.f;
#pragma unroll
          for (int i = 0; i < 8; ++i) ss += f[i] * f[i];
          ss += DPPF(ss, 0xB1); ss += DPPF(ss, 0x4E); ss += DPPF(ss, 0x141);
          const float r = rsqrtf(ss * (1.f / 64.f) + EPS);
#pragma unroll
          for (int i = 0; i < 8; ++i) f[i] = f[i] * r * gk[i];
          float o[8];
#pragma unroll
          for (int i = 0; i < 8; ++i) { const float p = DPPF(f[i], 0xB1); o[i] = (l7 == 0) ? (f[i] * ca[i] - p * sa[i]) : ((l7 == 1) ? (f[i] * ca[i] + p * sa[i]) : f[i]); }
          if (lane < 16) *(v4u*)(KN + (size_t)t * 128 + col) = pack8(o); }
        { const bf16* src = proj_tile(a, TL_IQ) + (size_t)t * 256 + 4 * lane; const v2u rw = *(const v2u*)src;
          float f[4] = {bf2f(rw.x & 0xffffu), bf2f(rw.x >> 16), bf2f(rw.y & 0xffffu), bf2f(rw.y >> 16)}; float o[4];
#pragma unroll
          for (int i = 0; i < 4; ++i) { const float p = DPPF(f[i], 0xB1); o[i] = (l7 == 0) ? (f[i] * ci[i] - p * si[i]) : ((l7 == 1) ? (f[i] * ci[i] + p * si[i]) : f[i]); }
          v2u w; w.x = pk2(o[0], o[1]); w.y = pk2(o[2], o[3]); *(v2u*)(IQR + (size_t)t * 256 + 4 * lane) = w; }
        { const bf16* src = proj_tile(a, TL_SM) + (size_t)t * 256 + 4 * l7; const v2u rw = *(const v2u*)src;
          float f[4] = {bf2f(rw.x & 0xffffu), bf2f(rw.x >> 16), bf2f(rw.y & 0xffffu), bf2f(rw.y >> 16)}; float o[4];
#pragma unroll
          for (int i = 0; i < 4; ++i) { const float p = DPPF(f[i], 0xB1); o[i] = (l7 == 0) ? (f[i] * ci[i] - p * si[i]) : ((l7 == 1) ? (f[i] * ci[i] + p * si[i]) : f[i]); }
          v2u w; w.x = pk2(o[0], o[1]); w.y = pk2(o[2], o[3]); if (lane < 8) *(v2u*)(IKR + (size_t)t * 32 + 4 * l7) = w; }
    }
}
constexpr int ML_QS = 0, ML_KS = 17408, ML_HS = 0;
constexpr int ML_KWT = 34816;
constexpr int ML_VT = 53248;
constexpr int ML_SW = 73984;
constexpr int ML_CT = 83200;
constexpr int ML_GA = 122368;
constexpr int ML_CW = ML_GA + 1024;
constexpr int ML_END = ML_CW + (1024 + 384) * 4;
static_assert(ML_END <= MISC_OFF, "mLSTM LDS map");
constexpr size_t ML_STATE_BYTES = 8 * 9 * 64 * 16;
__device__ __forceinline__ bf16x8 lds_frag(const LAS unsigned char* base, int stride_b, int row0, int kb, int lane) {
    return *(const LAS bf16x8*)(base + (row0 + (lane & 15)) * stride_b + kb + (lane >> 4) * 16);
}
__device__ __forceinline__ bf16x8 lds_frag_sw(const LAS unsigned char* base, int row0, int ks, int lane) {
    const int row = row0 + (lane & 15); return *(const LAS bf16x8*)(base + row * 144 + 16 * (((ks * 4 + (lane >> 4)) + (row >> 3)) & 7));
}
#define MFMA16(a_, b_, c_) __builtin_amdgcn_mfma_f32_16x16x32_bf16(a_, b_, c_, 0, 0, 0)
template <int MODE>
__device__ __forceinline__ void mlstm_unit(const Args& a, const Ctx& c, int b, int h, int g) {
    const int tid = c.tid, wave = c.wave; LAS unsigned char* lds = c.lds;
#define ML_LAUNDER() int tv_ = tid; asm volatile("" : "+v"(tv_)); const int lane = tv_ & 63, seg = tv_ & 15, r2 = (tv_ >> 4) * 2; (void)lane; (void)seg; (void)r2
    const bf16* PQ = proj_tile(a, TL_MQ + (h >> 1)) + (h & 1) * 128;
    const bf16* PK = proj_tile(a, TL_MK + (h >> 1)) + (h & 1) * 128;
    const bf16* PV = proj_tile(a, TL_MV + (h >> 1)) + (h & 1) * 128;
    const bf16* PO = proj_tile(a, TL_MO + (h >> 1)) + (h & 1) * 128;
    const bf16* PS = proj_tile(a, TL_SM);
    bf16* YML = (bf16*)((unsigned char*)a.out + DO_YML);
    unsigned char* STB = a.ws + WS_MLST; float* MST = (float*)(a.ws + WS_MLST + 256 * ML_STATE_BYTES);
    LAS float* GAa = (LAS float*)(lds + ML_GA); LAS float* GAm = GAa + 64; LAS float* GAw = GAa + 128; LAS float* GAe = GAa + 192;
    LAS float* CWQ = (LAS float*)(lds + ML_CW); LAS float* CWK = CWQ + 512; LAS float* CBQ = CWQ + 1024; LAS float* CBK = CBQ + 128; LAS float* GN = CBK + 128;
    LAS bf16* VTs = (LAS bf16*)(lds + ML_VT);
    { const float* wc = a.in[IN_WCONV]; const int j = tid >> 7, d = tid & 127;
      CWQ[tid] = wc[j * 1024 + h * 128 + d]; CWK[tid] = wc[j * 1024 + 512 + h * 128 + d];
      if (tid < 128) { CBQ[tid] = a.in[IN_BCONV][h * 128 + tid]; CBK[tid] = a.in[IN_BCONV][512 + h * 128 + tid]; GN[tid] = a.in[IN_GML][h * 128 + tid]; } }
    for (int i = tid; i < 16 * 64; i += 512) { const int r = i >> 6, cc = i & 63; VTs[(128 + r) * 72 + cc] = (r == 0) ? (bf16)0x3F80 : (bf16)0; }
    const float big = a.in[IN_BI][h], bfg = a.in[IN_BF][h];
    const int slot0 = (b * 4 + h) * 8;
    f32x4 cacc[9];
    float m_st = 0.f;
    if (MODE == 1 && g > 0) { ML_LAUNDER();
        const f32x4* sp = (const f32x4*)(STB + (size_t)(slot0 + g) * ML_STATE_BYTES) + wave * 576 + lane;
#pragma unroll
        for (int i = 0; i < 9; ++i) cacc[i] = sp[64 * i];
        m_st = MST[slot0 + g];
#pragma unroll
        for (int ee = 0; ee < 9; ++ee) { v2u w; w.x = pk2(cacc[ee][0], cacc[ee][1]); w.y = pk2(cacc[ee][2], cacc[ee][3]);
            *(LAS v2u*)(lds + ML_CT + (ee * 16 + (lane & 15)) * 272 + (wave * 16 + 4 * (lane >> 4)) * 2) = w; }
    } else {
#pragma unroll
        for (int i = 0; i < 9; ++i) cacc[i] = (f32x4){0.f, 0.f, 0.f, 0.f};
        for (int i = tid; i < 144 * 136 / 2; i += 512) ((LAS unsigned*)(lds + ML_CT))[i] = 0u;
    }
    const size_t tb = (size_t)b * SEQ;
    const char* bq = (const char*)(PQ + tb * 256); const char* bk = (const char*)(PK + tb * 256); const char* bv = (const char*)(PV + tb * 256); const char* bo = (const char*)(PO + tb * 256); const char* bs = (const char*)(PS + tb * 256);
    v4u rq[5], rk[5], rv[2]; unsigned short gi = 0, gf = 0;
#define ML_LOAD(kc) do { _Pragma("unroll") for (int j_ = 0; j_ < 5; ++j_) { const int rr_ = 64 * (kc) + r2 - 3 + j_; const unsigned o_ = (unsigned)((rr_ < 0 ? 0 : rr_) * 512 + seg * 16); \
            v4u q_ = (v4u){0u, 0u, 0u, 0u}; if (MODE == 1) q_ = *(const v4u*)(bq + o_); v4u k_ = *(const v4u*)(bk + o_); if (rr_ < 0) { q_ = (v4u){0u, 0u, 0u, 0u}; k_ = q_; } rq[j_] = q_; rk[j_] = k_; } \
        _Pragma("unroll") for (int i_ = 0; i_ < 2; ++i_) rv[i_] = *(const v4u*)(bv + (unsigned)((64 * (kc) + r2 + i_) * 512 + seg * 16)); \
        gi = *(const unsigned short*)(bs + (unsigned)((64 * (kc) + lane) * 512 + (40 + h) * 2)); gf = *(const unsigned short*)(bs + (unsigned)((64 * (kc) + lane) * 512 + (44 + h) * 2)); } while (0)
    const int kc0 = (MODE == 1) ? 8 * g : 0, kc1 = (MODE == 1) ? 8 * g + 8 : 56;
    { ML_LAUNDER(); ML_LOAD(kc0); }
    __syncthreads();
#pragma unroll 1
    for (int kc = kc0; kc < kc1; ++kc) {
        float wkv, decay, m_new;
        if (MODE == 0 && kc > 0 && (kc & 7) == 0) { ML_LAUNDER();
            f32x4* sp = (f32x4*)(STB + (size_t)(slot0 + (kc >> 3)) * ML_STATE_BYTES) + wave * 576 + lane;
#pragma unroll
            for (int i = 0; i < 9; ++i) sp[64 * i] = cacc[i];
            if (tid == 0) MST[slot0 + (kc >> 3)] = m_st; }
        { ML_LAUNDER();
        const float fpre = bf2f(gf) + bfg, lf = fminf(fpre, 0.f) - log1pf(__expf(-fabsf(fpre)));
        const float ig = bf2f(gi) + big;
        float bc = lf;
#pragma unroll
        for (int o = 1; o < 64; o <<= 1) { const float v = __shfl_up(bc, o); if (lane >= o) bc += v; }
        const float av = ig - bc; float Ac = av;
#pragma unroll
        for (int o = 1; o < 64; o <<= 1) { const float v = __shfl_up(Ac, o); if (lane >= o) Ac = fmaxf(Ac, v); }
        const float mA = fmaxf(m_st, Ac), Mk = __shfl(mA, 63), blast = __shfl(bc, 63);
        wkv = __expf(av - Mk); decay = __expf(m_st - Mk); m_new = blast + Mk;
        if (MODE == 1 && wave == 0) { GAa[lane] = av; GAm[lane] = mA; GAw[lane] = __expf(m_st - mA); GAe[lane] = __expf(-(bc + mA)); } }
        { ML_LAUNDER(); float kw_[2][8];
#pragma unroll
          for (int i = 0; i < 2; ++i) { const int t = r2 + i; const float wkt = __shfl(wkv, t);
            float aq_[8], ak_[8];
            { const f32x4 b0 = *(const LAS f32x4*)(CBQ + seg * 8), b1 = *(const LAS f32x4*)(CBQ + seg * 8 + 4), c0 = *(const LAS f32x4*)(CBK + seg * 8), c1 = *(const LAS f32x4*)(CBK + seg * 8 + 4);
              aq_[0] = b0[0]; aq_[1] = b0[1]; aq_[2] = b0[2]; aq_[3] = b0[3]; aq_[4] = b1[0]; aq_[5] = b1[1]; aq_[6] = b1[2]; aq_[7] = b1[3];
              ak_[0] = c0[0]; ak_[1] = c0[1]; ak_[2] = c0[2]; ak_[3] = c0[3]; ak_[4] = c1[0]; ak_[5] = c1[1]; ak_[6] = c1[2]; ak_[7] = c1[3]; }
#pragma unroll
            for (int j = 0; j < 4; ++j) { float fk_[8]; unpack8(rk[i + j], fk_);
                const f32x4 x0 = *(const LAS f32x4*)(CWK + j * 128 + seg * 8), x1 = *(const LAS f32x4*)(CWK + j * 128 + seg * 8 + 4);
#pragma unroll
                for (int e = 0; e < 4; ++e) { ak_[e] += x0[e] * fk_[e]; ak_[4 + e] += x1[e] * fk_[4 + e]; }
                if (MODE == 1) { float fq_[8]; unpack8(rq[i + j], fq_);
                    const f32x4 w0 = *(const LAS f32x4*)(CWQ + j * 128 + seg * 8), w1 = *(const LAS f32x4*)(CWQ + j * 128 + seg * 8 + 4);
#pragma unroll
                    for (int e = 0; e < 4; ++e) { aq_[e] += w0[e] * fq_[e]; aq_[4 + e] += w1[e] * fq_[4 + e]; } } }
#pragma unroll
            for (int e = 0; e < 8; ++e) { ak_[e] = ak_[e] * sigm(ak_[e]) * 0.08838834764831845f; kw_[i][e] = ak_[e] * wkt; }
            if (MODE == 1) {
#pragma unroll
                for (int e = 0; e < 8; ++e) aq_[e] = aq_[e] * sigm(aq_[e]);
                *(LAS v4u*)(lds + ML_QS + t * 272 + seg * 16) = pack8(aq_);
                *(LAS v4u*)(lds + ML_KS + t * 272 + seg * 16) = pack8(ak_); } }
          const unsigned va[4] = {rv[0].x, rv[0].y, rv[0].z, rv[0].w}, vb[4] = {rv[1].x, rv[1].y, rv[1].z, rv[1].w};
          const int swo = 16 * (((r2 >> 3) + seg) & 7) + 2 * (r2 & 7);
#pragma unroll
          for (int e = 0; e < 8; ++e) { const int ro = (seg * 8 + e) * 144 + swo;
              *(LAS unsigned*)(lds + ML_KWT + ro) = pk2(kw_[0][e], kw_[1][e]);
              const unsigned lo = (e & 1) ? (va[e >> 1] >> 16) : (va[e >> 1] & 0xffffu), hi = (e & 1) ? (vb[e >> 1] >> 16) : (vb[e >> 1] & 0xffffu);
              *(LAS unsigned*)(lds + ML_VT + ro) = lo | (hi << 16); }
        if (kc + 1 < kc1) ML_LOAD(kc + 1); }
        __syncthreads();
        f32x4 hacc[5]; unsigned mo_r[8];
        const int tt = wave & 3, t0 = tt * 16, ne = (wave < 4) ? 5 : 4, e_first = (wave < 4) ? 0 : 5;
        if (MODE == 1) {
        { ML_LAUNDER(); const int tq = t0 + (lane & 15);
        bf16x8 qf[4];
#pragma unroll
        for (int ks = 0; ks < 4; ++ks) qf[ks] = lds_frag(lds + ML_QS, 272, t0, ks * 64, lane);
        const float mAt = GAm[tq], wit = GAw[tq];
#pragma unroll
        for (int si = 0; si < 2; ++si) { const int ss = 2 * (wave >> 2) + si, s0 = ss * 16; f32x4 sacc = (f32x4){0.f, 0.f, 0.f, 0.f};
            if (ss <= tt) {
#pragma unroll
                for (int ks = 0; ks < 4; ++ks) sacc = MFMA16(lds_frag(lds + ML_KS, 272, s0, ks * 64, lane), qf[ks], sacc);
#pragma unroll
                for (int r = 0; r < 4; ++r) { const int s = s0 + 4 * (lane >> 4) + r; sacc[r] = (s <= tq) ? sacc[r] * __expf(GAa[s] - mAt) : 0.f; } }
            v2u w; w.x = pk2(sacc[0], sacc[1]); w.y = pk2(sacc[2], sacc[3]);
            *(LAS v2u*)(lds + ML_SW + tq * 144 + s0 * 2 + (lane >> 4) * 8) = w; }
#pragma unroll
        for (int i = 0; i < 5; ++i) { hacc[i] = (f32x4){0.f, 0.f, 0.f, 0.f};
            if (i < ne) {
#pragma unroll
                for (int ks = 0; ks < 4; ++ks) hacc[i] = MFMA16(lds_frag(lds + ML_CT, 272, (e_first + i) * 16, ks * 64, lane), qf[ks], hacc[i]);
                hacc[i] = hacc[i] * wit; } }
#pragma unroll
        for (int i = 0; i < 8; ++i) mo_r[i] = *(const unsigned*)(bo + (unsigned)((64 * kc + 8 * wave + i) * 512 + 4 * lane)); }
        __syncthreads();
        { ML_LAUNDER(); const int tq = t0 + (lane & 15); bf16x8 swf[2];
#pragma unroll
          for (int ks = 0; ks < 2; ++ks) swf[ks] = lds_frag(lds + ML_SW, 144, t0, ks * 64, lane);
#pragma unroll
          for (int i = 0; i < 5; ++i) if (i < ne) { const int ee = e_first + i;
#pragma unroll
              for (int ks = 0; ks < 2; ++ks) hacc[i] = MFMA16(lds_frag_sw(lds + ML_VT, ee * 16, ks, lane), swf[ks], hacc[i]);
              if (ee < 8) *(LAS f32x4*)(lds + ML_HS + tq * 528 + (ee * 16 + 4 * (lane >> 4)) * 4) = hacc[i];
              else if ((lane >> 4) == 0) *(LAS float*)(lds + ML_HS + tq * 528 + 128 * 4) = hacc[i][0]; } }
        }
        { ML_LAUNDER(); const int d0 = wave * 16; bf16x8 kwf[2];
#pragma unroll
          for (int ks = 0; ks < 2; ++ks) kwf[ks] = lds_frag_sw(lds + ML_KWT, d0, ks, lane);
#pragma unroll
          for (int ee = 0; ee < 9; ++ee) { cacc[ee] = cacc[ee] * decay;
#pragma unroll
              for (int ks = 0; ks < 2; ++ks) cacc[ee] = MFMA16(kwf[ks], lds_frag_sw(lds + ML_VT, ee * 16, ks, lane), cacc[ee]);
              if (MODE == 1) { v2u w; w.x = pk2(cacc[ee][0], cacc[ee][1]); w.y = pk2(cacc[ee][2], cacc[ee][3]);
                  *(LAS v2u*)(lds + ML_CT + (ee * 16 + (lane & 15)) * 272 + (d0 + 4 * (lane >> 4)) * 2) = w; } } }
        __syncthreads();
        if (MODE == 1) {
        { ML_LAUNDER();
#pragma unroll
        for (int i = 0; i < 8; ++i) { const int t = 8 * wave + i;
            const f32x2 nv = *(const LAS f32x2*)(lds + ML_HS + t * 528 + lane * 8); const float den = *(const LAS float*)(lds + ML_HS + t * 528 + 512);
            const float dd = fmaxf(fabsf(den), GAe[t]); const float h0 = nv.x / dd, h1 = nv.y / dd;
            const float r = rsqrtf(wave_sum(h0 * h0 + h1 * h1) * (1.f / 128.f) + EPS);
            const float y0 = h0 * r * GN[2 * lane] * sigm(bf2f(mo_r[i] & 0xffffu)), y1 = h1 * r * GN[2 * lane + 1] * sigm(bf2f(mo_r[i] >> 16));
            *(unsigned*)(YML + (tb + 64 * kc + t) * 512 + h * 128 + 2 * lane) = pk2(y0, y1); } }
        __syncthreads();
        }
        m_st = m_new;
    }
    if (MODE == 0) { ML_LAUNDER();
        f32x4* sp = (f32x4*)(STB + (size_t)(slot0 + 7) * ML_STATE_BYTES) + wave * 576 + lane;
#pragma unroll
        for (int i = 0; i < 9; ++i) sp[64 * i] = cacc[i];
        if (tid == 0) MST[slot0 + 7] = m_st; }
#undef ML_LOAD
#undef ML_LAUNDER
}
constexpr int AT_HIST = 0;
constexpr int AT_HROW = 2049;
constexpr int AT_SEL = 131072 + 256;
constexpr int AT_MROW = 129;
constexpr int AT_SM = AT_SEL + 8448;
static_assert(AT_SM + 256 <= MISC_OFF, "attention LDS map");
__device__ __forceinline__ unsigned score_key(float s) { unsigned u = __float_as_uint(s + 0.0f); return (u & 0x80000000u) ? ~u : (u | 0x80000000u); }
template <int NK> __device__ __forceinline__ void at_resolve(const LAS unsigned long long* cand, LAS unsigned* mask, int m, int nd, int lane) {
    unsigned long long cv[NK];
#pragma unroll
    for (int k = 0; k < NK; ++k) { const int i = 64 * k + lane; unsigned long long x = 0ull; if (i < m) x = cand[i]; cv[k] = (i < m) ? ((((x >> 32) & 0xFFFFFull) << 16) | (x & 0xFFFFull)) : 0ull; }
    unsigned long long T = 0ull;
#pragma unroll 1
    for (int bit = 35; bit >= 16; --bit) { const unsigned long long test = T | (1ull << bit); int cge = 0;
#pragma unroll
        for (int k = 0; k < NK; ++k) cge += __popcll(__ballot(cv[k] >= test));
        if (cge >= nd) T = test; }
    int g = 0, t = 0;
#pragma unroll
    for (int k = 0; k < NK; ++k) { g += __popcll(__ballot(cv[k] >= T + 0x10000ull)); t += __popcll(__ballot(cv[k] >= T)); }
    t -= g;
    if (t > nd - g) {
#pragma unroll 1
        for (int bit = 15; bit >= 0; --bit) { const unsigned long long test = T | (1ull << bit); int cge = 0;
#pragma unroll
            for (int k = 0; k < NK; ++k) cge += __popcll(__ballot(cv[k] >= test));
            if (cge >= nd) T = test; } }
#pragma unroll
    for (int k = 0; k < NK; ++k) if (cv[k] >= T && cv[k] != 0ull) { const unsigned key = 0xFFFFu - (unsigned)(cv[k] & 0xFFFFull);
        __hip_atomic_fetch_or(&mask[key >> 5], 1u << (key & 31u), __ATOMIC_RELAXED, __HIP_MEMORY_SCOPE_WORKGROUP); }
}
__device__ __forceinline__ void attn_unit(const Args& a, const Ctx& c, int b, int qt) {
    const int tid = c.tid, wave = c.wave; LAS unsigned char* lds = c.lds;
#define AT_LAUNDER() int tv_ = tid; asm volatile("" : "+v"(tv_)); const int lane = tv_ & 63, qi = tv_ & 15, fq = (tv_ >> 4) & 3; (void)lane; (void)qi; (void)fq
    const int q0 = qt * 16, ch = q0 >> 6, n = 64 * (ch + 1), ntiles = n >> 4;
    const size_t tb = (size_t)b * SEQ;
    unsigned char* dout = (unsigned char*)a.out;
    const bf16* AQN = (const bf16*)(dout + DO_AQN); const bf16* KN = (const bf16*)(dout + DO_KN); const bf16* IQR = (const bf16*)(dout + DO_IQR); const bf16* IKR = (const bf16*)(dout + DO_IKR);
    bf16* YATT = (bf16*)(dout + DO_YATT);
    const bf16* VB = proj_tile(a, TL_KV); const bf16* PS = proj_tile(a, TL_SM);
    LAS unsigned* HIST = (LAS unsigned*)(lds + AT_HIST);
    LAS unsigned long long* CAND = (LAS unsigned long long*)(lds + AT_HIST);
    LAS unsigned* MASK = (LAS unsigned*)(lds + AT_SEL);
    LAS int* SM = (LAS int*)(lds + AT_SM);
    float* SC = (blockIdx.x < 240) ? (float*)(a.ws + WS_SC) + (size_t)blockIdx.x * (16 * 4096) : (float*)(a.ws + WS_SC2) + (size_t)(blockIdx.x - 240) * (16 * 4096);
#ifndef DBG_REP_SEL
#define DBG_REP_SEL 1
#endif
#ifndef DBG_REP_DENSE
#define DBG_REP_DENSE 1
#endif
#pragma unroll 1
    for (int rsel = 0; rsel < DBG_REP_SEL; ++rsel) {
    if (n > 256) {
        for (int i = tid; i < 8192 + 4; i += 512) ((LAS v4u*)HIST)[i] = (v4u){0u, 0u, 0u, 0u};
        if (tid < 64) SM[tid] = 0;
        for (int i = tid; i < 16 * AT_MROW; i += 512) MASK[i] = 0u;
        bf16x8 qf[8]; float wv[8];
        { AT_LAUNDER();
        const size_t trow = tb + q0 + qi;
#pragma unroll
        for (int h = 0; h < 8; ++h) qf[h] = *(const bf16x8*)(IQR + trow * 256 + h * 32 + 8 * fq);
        { float t8[8]; unpack8(*(const v4u*)(PS + trow * 256 + 32), t8);
#pragma unroll
          for (int h = 0; h < 8; ++h) wv[h] = t8[h] * 0.0625f; } }
        __syncthreads();
#define AT_LOADK(kt_) (*(const bf16x8*)(IKR + (tb + (size_t)(kt_) * 16 + qi) * 32 + 8 * fq))
#define AT_SCORES(kf_, sc_) do { \
        _Pragma("unroll") for (int r_ = 0; r_ < 4; ++r_) sc_[r_] = 0.f; \
        _Pragma("unroll") for (int h_ = 0; h_ < 8; ++h_) { const f32x4 d_ = MFMA16(kf_, qf[h_], ((f32x4){0.f, 0.f, 0.f, 0.f})); \
            _Pragma("unroll") for (int r_ = 0; r_ < 4; ++r_) { const int di_ = __float_as_int(d_[r_]); sc_[r_] = __builtin_fmaf(wv[h_], __int_as_float(di_ > 0 ? di_ : 0), sc_[r_]); } } } while (0)
        const int cnt = (ntiles - wave + 7) >> 3;
#ifndef DBG_RA
#define DBG_RA 1
#endif
#pragma unroll 1
        for (int rA = 0; rA < DBG_RA; ++rA) { if (rA) { for (int i = tid; i < 8192 + 4; i += 512) ((LAS v4u*)HIST)[i] = (v4u){0u, 0u, 0u, 0u}; __syncthreads(); }
#define AT_LOADG(dst_, i0_) do { _Pragma("unroll") for (int j_ = 0; j_ < 8; ++j_) { int kt_ = wave + 8 * ((i0_) + j_); kt_ = kt_ < ntiles ? kt_ : ntiles - 1; dst_[j_] = AT_LOADK(kt_); } } while (0)
        { AT_LAUNDER(); bf16x8 kcur[8], knxt[8]; AT_LOADG(kcur, 0);
#pragma unroll 1
          for (int i0 = 0; i0 < cnt; i0 += 8) {
            if (i0 + 8 < cnt) AT_LOADG(knxt, i0 + 8);
#pragma unroll
            for (int j2 = 0; j2 < 8; ++j2) { const bool valid = (i0 + j2 < cnt); const int kt = wave + 8 * (i0 + j2); float sc[4]; AT_SCORES(kcur[j2], sc);
                if (valid) *(f32x4*)(SC + qi * 4096 + kt * 16 + 4 * fq) = (f32x4){sc[0], sc[1], sc[2], sc[3]};
#pragma unroll
                for (int r = 0; r < 4; ++r) { const unsigned bin = score_key(sc[r]) >> 20;
                    __hip_atomic_fetch_add(&HIST[qi * AT_HROW + (bin >> 1)], valid ? (1u << ((bin & 1u) * 16)) : 0u, __ATOMIC_RELAXED, __HIP_MEMORY_SCOPE_WORKGROUP); } }
#pragma unroll
            for (int j2 = 0; j2 < 8; ++j2) kcur[j2] = knxt[j2]; } }
        __syncthreads();
        }
#ifndef DBG_RB
#define DBG_RB 1
#endif
#pragma unroll 1
        for (int rB = 0; rB < DBG_RB; ++rB) {
#pragma unroll 1
        for (int j = 0; j < 2; ++j) { AT_LAUNDER(); const int q = 2 * wave + j; unsigned tot = 0;
            for (int i = 0; i < 32; ++i) { const unsigned w = HIST[q * AT_HROW + 32 * lane + ((i + lane) & 31)]; tot += (w & 0xffffu) + (w >> 16); }
            unsigned suf = tot;
#pragma unroll
            for (int o = 1; o < 64; o <<= 1) { const unsigned v = __shfl_down(suf, o); if (lane + o < 64) suf += v; }
            const unsigned long long mk = __ballot(suf >= 256u); const int L = 63 - __clzll((long long)mk);
            const unsigned above_L = __shfl(suf - tot, L);
            const unsigned w2 = HIST[q * AT_HROW + 32 * L + (lane >> 1)]; const unsigned cb = (lane & 1) ? (w2 >> 16) : (w2 & 0xffffu);
            unsigned sfx = cb;
#pragma unroll
            for (int o = 1; o < 64; o <<= 1) { const unsigned v = __shfl_down(sfx, o); if (lane + o < 64) sfx += v; }
            const unsigned long long mk2 = __ballot(above_L + sfx >= 256u); const int l2 = 63 - __clzll((long long)mk2);
            if (lane == l2) { SM[q] = 64 * L + l2; SM[16 + q] = (int)(256u - (above_L + sfx - cb)); } }
        __syncthreads();
        }
#ifndef DBG_RC
#define DBG_RC 1
#endif
#pragma unroll 1
        for (int rC = 0; rC < DBG_RC; ++rC) { if (rC) { if (tid < 16) SM[48 + tid] = 0; __syncthreads(); }
        { AT_LAUNDER(); const int Bq = SM[qi]; f32x4 scur[8], snxt[8];
#define AT_LOADS(dst_, i0_) do { _Pragma("unroll") for (int j_ = 0; j_ < 8; ++j_) { int kt_ = wave + 8 * ((i0_) + j_); kt_ = kt_ < ntiles ? kt_ : ntiles - 1; dst_[j_] = *(const f32x4*)(SC + qi * 4096 + kt_ * 16 + 4 * fq); } } while (0)
          AT_LOADS(scur, 0);
#pragma unroll 1
          for (int i0 = 0; i0 < cnt; i0 += 8) {
            if (i0 + 8 < cnt) AT_LOADS(snxt, i0 + 8);
#pragma unroll
            for (int j2 = 0; j2 < 8; ++j2) { const bool valid = (i0 + j2 < cnt); const int kt = wave + 8 * (i0 + j2);
                unsigned nib = 0u, cnib = 0u; unsigned uu[4];
#pragma unroll
                for (int r = 0; r < 4; ++r) { uu[r] = score_key(scur[j2][r]); const int bin = (int)(uu[r] >> 20); nib |= (bin > Bq) ? (1u << r) : 0u; cnib |= (bin == Bq) ? (1u << r) : 0u; }
                if (!valid) { nib = 0u; cnib = 0u; }
                if (cnib) {
                    int p = __hip_atomic_fetch_add(&SM[48 + qi], (int)__popc(cnib), __ATOMIC_RELAXED, __HIP_MEMORY_SCOPE_WORKGROUP);
#pragma unroll
                    for (int r = 0; r < 4; ++r) if ((cnib >> r) & 1u) { if (p < 512) CAND[qi * 1024 + p] = ((unsigned long long)uu[r] << 32) | (unsigned long long)(0xFFFFu - (unsigned)(kt * 16 + 4 * fq + r)); ++p; } }
                if (nib) __hip_atomic_fetch_or(&MASK[qi * AT_MROW + (kt >> 1)], nib << (16 * (kt & 1) + 4 * fq), __ATOMIC_RELAXED, __HIP_MEMORY_SCOPE_WORKGROUP); }
#pragma unroll
            for (int j2 = 0; j2 < 8; ++j2) scur[j2] = snxt[j2]; } }
#undef AT_LOADS
        __syncthreads();
        }
#ifndef DBG_RD
#define DBG_RD 1
#endif
#pragma unroll 1
        for (int rD = 0; rD < DBG_RD; ++rD) {
#pragma unroll 1
        for (int j = 0; j < 2; ++j) { AT_LAUNDER(); const int q = 2 * wave + j; int m = SM[48 + q]; m = m < 512 ? m : 512; const int nd = SM[16 + q];
            if (m <= 256) at_resolve<4>(CAND + q * 1024, MASK + q * AT_MROW, m, nd, lane); else at_resolve<8>(CAND + q * 1024, MASK + q * AT_MROW, m, nd, lane); }
        __syncthreads();
        }
#undef AT_SCORES
#undef AT_LOADK
#undef AT_LOADG
    } else {
#pragma unroll 1
        for (int i = tid; i < 16 * AT_MROW; i += 512) MASK[i] = ((i % AT_MROW) < (n >> 5)) ? 0xFFFFFFFFu : 0u;
        __syncthreads();
    }
    }
#pragma unroll 1
    for (int rden = 0; rden < DBG_REP_DENSE; ++rden) {
    { const int g = wave >> 2, kh = (wave >> 1) & 1, hp = wave & 1, NS = n >> 6;
      float cshift;
      { AT_LAUNDER(); float gq = fabsf(a.in[IN_GQ][lane]), gk = fabsf(a.in[IN_GK][lane]);
#pragma unroll
        for (int o = 1; o < 64; o <<= 1) { gq = fmaxf(gq, __shfl_xor(gq, o)); gk = fmaxf(gk, __shfl_xor(gk, o)); }
        cshift = 8.0f * 1.4426950408889634f * gq * gk; }
      const unsigned ring0 = (unsigned)(size_t)(lds + AT_HIST);
#define AT_STAGE(s_) do { AT_LAUNDER(); const unsigned sb_ = ring0 + (unsigned)(((s_) & 3) * 32768); \
        _Pragma("unroll") for (int i_ = 0; i_ < 4; ++i_) { const int in_ = 4 * wave + i_; const int row_ = 4 * (in_ & 15) + (lane >> 4), pos_ = lane & 15; \
            const bf16* src_ = (in_ < 16) ? (KN + (tb + 64 * (s_) + row_) * 128 + ((pos_ ^ (row_ & 15)) << 3)) : (VB + (tb + 64 * (s_) + row_) * 256 + 128 + ((pos_ ^ (2 * (row_ & 7))) << 3)); \
            const unsigned dst_ = __builtin_amdgcn_readfirstlane(sb_ + (unsigned)(in_ * 1024)); unsigned keep_; \
            asm volatile("s_mov_b32 %0, m0\n\ts_mov_b32 m0, %2\n\ts_nop 0\n\tglobal_load_lds_dwordx4 %1, off\n\ts_mov_b32 m0, %0" : "=&s"(keep_) : "v"(src_), "s"(dst_) : "memory"); } } while (0)
      bf16x8 qa[2], qb[2]; f32x4 oacc[2][4], lacc[2];
      { AT_LAUNDER();
#pragma unroll
        for (int hi = 0; hi < 2; ++hi) { const bf16* qp = AQN + (tb + q0 + qi) * 512 + (g * 4 + 2 * hp + hi) * 64 + 8 * fq; qa[hi] = *(const bf16x8*)qp; qb[hi] = *(const bf16x8*)(qp + 32); } }
#pragma unroll
      for (int hi = 0; hi < 2; ++hi) { lacc[hi] = (f32x4){0.f, 0.f, 0.f, 0.f};
#pragma unroll
        for (int dt = 0; dt < 4; ++dt) oacc[hi][dt] = (f32x4){0.f, 0.f, 0.f, 0.f}; }
      const bf16x8 ones = (bf16x8){0x3F80, 0x3F80, 0x3F80, 0x3F80, 0x3F80, 0x3F80, 0x3F80, 0x3F80};
      asm volatile("s_waitcnt vmcnt(0)" ::: "memory");
#pragma unroll 1
      for (int s = 0; s < 3 && s < NS; ++s) AT_STAGE(s);
      typedef short s4_t __attribute__((ext_vector_type(4)));
#pragma unroll 1
      for (int s = 0; s < NS; ++s) {
          if (s + 2 < NS) asm volatile("s_waitcnt vmcnt(8)" ::: "memory"); else asm volatile("s_waitcnt vmcnt(0)" ::: "memory");
          __builtin_amdgcn_s_barrier(); asm volatile("" ::: "memory");
          if (s + 3 < NS) AT_STAGE(s + 3);
          { AT_LAUNDER(); const LAS unsigned char* kb = lds + AT_HIST + (s & 3) * 32768; const LAS unsigned char* vbs = kb + 16384;
            const unsigned mw = MASK[qi * AT_MROW + 2 * s + kh] >> (4 * fq);
            f32x4 st[2][2];
#pragma unroll
            for (int t = 0; t < 2; ++t) { const int row = 16 * (2 * kh + t) + qi;
                const bf16x8 k0 = *(const LAS bf16x8*)(kb + row * 256 + (((g * 8 + fq) ^ (row & 15)) << 4)), k1 = *(const LAS bf16x8*)(kb + row * 256 + (((g * 8 + 4 + fq) ^ (row & 15)) << 4));
#pragma unroll
                for (int hi = 0; hi < 2; ++hi) { f32x4 d = MFMA16(k0, qa[hi], ((f32x4){0.f, 0.f, 0.f, 0.f})); st[hi][t] = MFMA16(k1, qb[hi], d); } }
            bf16x8 pb[2];
#pragma unroll
            for (int hi = 0; hi < 2; ++hi) { float pv[8];
#pragma unroll
                for (int j = 0; j < 8; ++j) { const float e = __builtin_amdgcn_exp2f(st[hi][j >> 2][j & 3] - cshift);
                    const int keep = __builtin_amdgcn_sbfe((int)mw, 16 * (j >> 2) + (j & 3), 1); pv[j] = __uint_as_float(__float_as_uint(e) & (unsigned)keep); }
                v4u pw; pw.x = pk2(pv[0], pv[1]); pw.y = pk2(pv[2], pv[3]); pw.z = pk2(pv[4], pv[5]); pw.w = pk2(pv[6], pv[7]); pb[hi] = __builtin_bit_cast(bf16x8, pw);
                lacc[hi] = MFMA16(ones, pb[hi], lacc[hi]); }
#pragma unroll
            for (int dt = 0; dt < 4; ++dt) { const int r1 = 32 * kh + 4 * fq + (qi >> 2), r2 = r1 + 16; const int ch = g * 8 + 2 * dt + ((lane & 3) >> 1);
                const s4_t lo = __builtin_amdgcn_ds_read_tr16_b64_v4i16((LAS s4_t*)(vbs + r1 * 256 + ((ch ^ (2 * (r1 & 7))) << 4) + (lane & 1) * 8));
                const s4_t hi4 = __builtin_amdgcn_ds_read_tr16_b64_v4i16((LAS s4_t*)(vbs + r2 * 256 + ((ch ^ (2 * (r2 & 7))) << 4) + (lane & 1) * 8));
                const bf16x8 va = (bf16x8){lo[0], lo[1], lo[2], lo[3], hi4[0], hi4[1], hi4[2], hi4[3]};
#pragma unroll
                for (int hi = 0; hi < 2; ++hi) oacc[hi][dt] = MFMA16(va, pb[hi], oacc[hi][dt]); } } }
      __syncthreads();
      { AT_LAUNDER(); LAS unsigned char* red = lds + AT_HIST + (g * 2 + hp) * 8704;
        if (kh == 1) {
#pragma unroll
            for (int hi = 0; hi < 2; ++hi) {
#pragma unroll
                for (int dt = 0; dt < 4; ++dt) *(LAS f32x4*)(red + (hi * 4 + dt) * 1024 + lane * 16) = oacc[hi][dt];
                *(LAS float*)(red + 8192 + hi * 256 + lane * 4) = lacc[hi][0]; } } }
      __syncthreads();
      if (kh == 0) { AT_LAUNDER(); const LAS unsigned char* red = lds + AT_HIST + (g * 2 + hp) * 8704;
#pragma unroll
        for (int hi = 0; hi < 2; ++hi) { const float inv = 1.0f / (lacc[hi][0] + *(const LAS float*)(red + 8192 + hi * 256 + lane * 4));
            bf16* yp = YATT + (tb + q0 + qi) * 512 + (g * 4 + 2 * hp + hi) * 64 + 4 * fq;
#pragma unroll
            for (int dt = 0; dt < 4; ++dt) { const f32x4 o = oacc[hi][dt] + *(const LAS f32x4*)(red + (hi * 4 + dt) * 1024 + lane * 16);
                v2u w; w.x = pk2(o[0] * inv, o[1] * inv); w.y = pk2(o[2] * inv, o[3] * inv); *(v2u*)(yp + 16 * dt) = w; } } }
#undef AT_STAGE
    }
    __syncthreads();
    }
#undef AT_LAUNDER
    __syncthreads();
}

#ifndef DBG_REP_ML
#define DBG_REP_ML 1
#endif
#ifndef DBG_REP_ATT
#define DBG_REP_ATT 1
#endif
__device__ __forceinline__ void p3_mixer(const Args& a, const Ctx& c, volatile LAS unsigned* MISC, int rep) {
#if !defined(NO_MLSTM)
#pragma unroll 1
    for (int rr = 0; rr < DBG_REP_ML; ++rr)
#pragma unroll 1
        for (int u = blockIdx.x; u < 32; u += c.G) mlstm_unit<0>(a, c, u >> 2, u & 3, 0);
#endif
    unsigned* ctl = (unsigned*)(a.ws + WS_CTL);
    const int x = (int)(__builtin_amdgcn_s_getreg((3 << 11) | 20) & 7u);
#pragma unroll 1
    for (int rot = 0; rot < 8 * DBG_REP_ATT; ++rot) { rep = rot >> 3; const int bq = (x + rot) & 7;
        for (;;) {
            if (c.tid == 0) MISC[16] = __hip_atomic_fetch_add(ctl + CW_Q + 512 * rep + 64 * bq, 1u, RLX_AGENT);
            __syncthreads();
            const int u = (int)MISC[16];
            __syncthreads();
            if (u >= 256) break;
#if defined(DBG_ZERO_ATT)
            { bf16* YA = (bf16*)((unsigned char*)a.out + DO_YATT) + ((size_t)bq * SEQ + (size_t)(255 - u) * 16) * 512; for (int i = c.tid; i < 16 * 512 / 8; i += 512) ((v4u*)YA)[i] = (v4u){0u, 0u, 0u, 0u}; }
#elif !defined(NO_ATTN)
            attn_unit(a, c, bq, 255 - u);
#endif
        } }
}
constexpr int RT_WR = 0;
constexpr int RT_LCNT = 147456;
static_assert(RT_LCNT + 128 <= MISC_OFF, "router LDS map");
__device__ __forceinline__ void p6_router(const Args& a, const Ctx& c) {
    const int tid = c.tid, lane = c.lane, wave = c.wave; LAS unsigned char* lds = c.lds;
    LAS float* WR = (LAS float*)(lds + RT_WR); LAS int* LCNT = (LAS int*)(lds + RT_LCNT);
    for (int i = tid; i < 1024 * 32; i += 512) WR[(i >> 5) * 36 + (i & 31)] = a.in[IN_WRE][i];
    for (int i = tid; i < 1024 * 4; i += 512) WR[(i >> 2) * 36 + 32 + (i & 3)] = a.in[IN_WRG][i];
    float gm[16];
#pragma unroll
    for (int i = 0; i < 16; ++i) gm[i] = a.in[IN_GMOE][lane + 64 * i];
    float be[32], bg[4];
#pragma unroll
    for (int i = 0; i < 32; ++i) be[i] = a.in[IN_BRE][i];
#pragma unroll
    for (int i = 0; i < 4; ++i) bg[i] = a.in[IN_BRG][i];
    { int* RT = (int*)(a.ws + WS_ROWTOK); for (int i = blockIdx.x * 512 + tid; i < NROWS_MAX; i += c.G * 512) RT[i] = 0; }
    const float* X1 = a.out; bf16* XN = (bf16*)(a.ws + WS_XN);
    int* TOKE = (int*)(a.ws + WS_TOKE); int* TOKR = (int*)(a.ws + WS_TOKR); float* TOKG = (float*)(a.ws + WS_TOKG); int* CNT = (int*)(a.ws + WS_CNT);
    __syncthreads();
    for (int blk = blockIdx.x; blk < 256; blk += c.G) {
        if (tid < 32) LCNT[tid] = 0;
        __syncthreads();
#pragma unroll 1
        for (int ri = 0; ri < 16; ++ri) { const int t = blk * 128 + wave * 16 + ri;
            float xv[16]; float ss = 0.f;
#pragma unroll
            for (int i = 0; i < 16; ++i) { xv[i] = X1[(size_t)t * D + lane + 64 * i]; ss += xv[i] * xv[i]; }
            const float r = rsqrtf(wave_sum(ss) * (1.f / D) + EPS);
#pragma unroll
            for (int i = 0; i < 16; ++i) { xv[i] = xv[i] * r * gm[i]; XN[(size_t)t * D + lane + 64 * i] = (bf16)f2bf(xv[i]); }
            float acc[36];
#pragma unroll
            for (int jx = 0; jx < 36; ++jx) acc[jx] = 0.f;
#pragma unroll
            for (int i = 0; i < 16; ++i) { const LAS f32x4* wp = (const LAS f32x4*)(WR + (lane + 64 * i) * 36);
#pragma unroll
                for (int jj = 0; jj < 9; ++jj) { const f32x4 w4 = wp[jj]; acc[4 * jj] += xv[i] * w4[0]; acc[4 * jj + 1] += xv[i] * w4[1]; acc[4 * jj + 2] += xv[i] * w4[2]; acc[4 * jj + 3] += xv[i] * w4[3]; } }
#pragma unroll
            for (int jx = 0; jx < 36; ++jx) acc[jx] = wave_sum(acc[jx]);
            float gl[4];
#pragma unroll
            for (int i = 0; i < 4; ++i) gl[i] = acc[32 + i] + bg[i];
            int gs = 0; float gmax = gl[0];
#pragma unroll
            for (int i = 1; i < 4; ++i) if (gl[i] > gmax) { gmax = gl[i]; gs = i; }
            float gsum = 0.f;
#pragma unroll
            for (int i = 0; i < 4; ++i) gsum += expf(gl[i] - gmax);
            const float gtop = 1.0f / gsum;
            float ev[8];
#pragma unroll
            for (int i = 0; i < 8; ++i) { float v = acc[i] + be[i];
#pragma unroll
                for (int g2 = 1; g2 < 4; ++g2) v = (gs == g2) ? (acc[g2 * 8 + i] + be[g2 * 8 + i]) : v;
                ev[i] = v; }
            int l0 = 0; float v0 = ev[0];
#pragma unroll
            for (int i = 1; i < 8; ++i) if (ev[i] > v0) { v0 = ev[i]; l0 = i; }
            int l1 = -1; float v1 = -3.0e38f;
#pragma unroll
            for (int i = 0; i < 8; ++i) if (i != l0 && ev[i] > v1) { v1 = ev[i]; l1 = i; }
            const float e1 = expf(v1 - v0), s0 = 1.0f / (1.0f + e1), s1 = e1 * s0;
            if (lane == 0) { const int ex0 = gs * 8 + l0, ex1 = gs * 8 + l1;
                const int rk0 = __hip_atomic_fetch_add(&LCNT[ex0], 1, __ATOMIC_RELAXED, __HIP_MEMORY_SCOPE_WORKGROUP);
                const int rk1 = __hip_atomic_fetch_add(&LCNT[ex1], 1, __ATOMIC_RELAXED, __HIP_MEMORY_SCOPE_WORKGROUP);
                TOKE[2 * t] = ex0; TOKE[2 * t + 1] = ex1; TOKR[2 * t] = rk0; TOKR[2 * t + 1] = rk1; TOKG[2 * t] = s0 * gtop; TOKG[2 * t + 1] = s1 * gtop; }
        }
        __syncthreads();
        if (tid < 32) CNT[blk * 32 + tid] = LCNT[tid];
        __syncthreads();
    }
}
__device__ __forceinline__ void p7_gather(const Args& a, const Ctx& c) {
    const int tid = c.tid, lane = c.lane, wave = c.wave;
    LAS int* PART = (LAS int*)c.lds; LAS int* PPRE = PART + 512; LAS int* TOT = PPRE + 512; LAS int* TS = TOT + 32; LAS int* BASE = TS + 64;
    const int* CNT = (const int*)(a.ws + WS_CNT); const int* TOKE = (const int*)(a.ws + WS_TOKE); const int* TOKR = (const int*)(a.ws + WS_TOKR); int* TOKP = (int*)(a.ws + WS_TOKP);
    int* RT = (int*)(a.ws + WS_ROWTOK);
    { const int e = tid & 31, p = tid >> 5; int s = 0; for (int k = 0; k < 16; ++k) s += CNT[(16 * p + k) * 32 + e]; PART[p * 32 + e] = s; }
    __syncthreads();
    if (tid < 32) { int run = 0; for (int p = 0; p < 16; ++p) { PPRE[p * 32 + tid] = run; run += PART[p * 32 + tid]; } TOT[tid] = run; }
    __syncthreads();
    if (tid == 0) { int ts = 0; for (int e = 0; e < 32; ++e) { TS[e] = ts; ts += (TOT[e] + 255) >> 8; } TS[32] = ts; }
    __syncthreads();
    if (blockIdx.x == 0 && tid < 33) ((int*)(a.ws + WS_SMALL))[tid] = TS[tid];
    for (int blk = blockIdx.x; blk < 256; blk += c.G) {
        if (tid < 32) { int s = TS[tid] * 256 + PPRE[(blk >> 4) * 32 + tid]; for (int b2 = (blk & ~15); b2 < blk; ++b2) s += CNT[b2 * 32 + tid]; BASE[tid] = s; }
        __syncthreads();
        { const int t = blk * 128 + (tid >> 2), jj = tid & 3;
          if (jj < 2) { const int pos = BASE[TOKE[2 * t + jj]] + TOKR[2 * t + jj]; TOKP[2 * t + jj] = pos; RT[pos] = t; } }
        __syncthreads();
    }
}
__device__ __forceinline__ void p10_combine(const Args& a, const Ctx& c) {
    const int lane = c.lane, gw = c.vcu * NWAVES + c.wave, NGW = c.G * NWAVES;
    const int* TOKP = (const int*)(a.ws + WS_TOKP); const float* TOKG = (const float*)(a.ws + WS_TOKG); const bf16* Y = (const bf16*)(a.ws + WS_Y);
    for (int t = gw; t < T; t += NGW) { const int p0 = TOKP[2 * t], p1 = TOKP[2 * t + 1]; const float g0 = TOKG[2 * t], g1 = TOKG[2 * t + 1];
#pragma unroll
        for (int j = 0; j < 4; ++j) { f32x4* op = (f32x4*)(a.out + (size_t)t * D + 4 * lane + 256 * j); f32x4 x = *op;
            const v2u y0 = *(const v2u*)(Y + (size_t)p0 * D + 4 * lane + 256 * j), y1 = *(const v2u*)(Y + (size_t)p1 * D + 4 * lane + 256 * j);
            x[0] += g0 * bf2f(y0.x & 0xffffu) + g1 * bf2f(y1.x & 0xffffu); x[1] += g0 * bf2f(y0.x >> 16) + g1 * bf2f(y1.x >> 16);
            x[2] += g0 * bf2f(y0.y & 0xffffu) + g1 * bf2f(y1.y & 0xffffu); x[3] += g0 * bf2f(y0.y >> 16) + g1 * bf2f(y1.y >> 16);
            *op = x; } }
}
__global__ void __launch_bounds__(NWAVES * 64, 2) hybrid_fwd(Args args) {
    extern __shared__ __attribute__((aligned(16))) unsigned char lds_raw[];
    Ctx c; c.lds = (LAS unsigned char*)lds_raw;
    volatile LAS unsigned* MISC = (volatile LAS unsigned*)(c.lds + MISC_OFF);
    c.tid = threadIdx.x; c.lane = c.tid & 63; c.wave = __builtin_amdgcn_readfirstlane(c.tid >> 6);
    c.G = gridDim.x; { const int bx = blockIdx.x; c.vcu = (c.G % 8 == 0) ? (bx % 8) * (c.G / 8) + bx / 8 : bx; }
    unsigned* ctl = (unsigned*)(args.ws + WS_CTL);
    if (c.tid < 128) MISC[c.tid] = 0u;
    __syncthreads();
    XcdBarrier bar; bar.bar = ctl + CW_BAR; bar.x = 0; bar.st = nullptr;
    if (N_LAUNCHES == 1) bar = xcd_barrier_post(ctl + CW_BAR, MISC + 8);
#define GRID_BAR() do { if (N_LAUNCHES == 1) xcd_barrier(bar); } while (0)
    const int lo = args.ph_lo, hi = args.ph_hi;
#ifndef PH_MASK
#define PH_MASK 0xfff
#endif
#define IN(k) (((PH_MASK >> (k)) & 1) && lo <= (k) && (k) < hi)
#define BOTH(k) (IN(k) && IN((k) + 1))
    unsigned char* ws = args.ws; unsigned char* dout = (unsigned char*)args.out;
#ifndef DBG_REPEAT
#define DBG_REPEAT -1
#endif
#define REPS(k) (((k) == DBG_REPEAT) ? 2 : 1)
    if (IN(0)) { _Pragma("unroll") for (int rep = 0; rep < REPS(0); ++rep) { if (rep) GRID_BAR(); p0_prologue<0>(args, c, c.vcu * NWAVES + c.wave, c.G * NWAVES); } if (BOTH(0)) GRID_BAR(); }
    if (IN(1)) { _Pragma("unroll") for (int rep = 0; rep < REPS(1); ++rep) { if (rep) GRID_BAR();
        pg8::Gemm g{(const pg8::bf16_t*)(dout + DO_H), (const pg8::bf16_t*)(ws + WS_WIN), T, NPROJ, D}; pg8::StaticOrder S; S.init(T, NPROJ, c.G, (int)blockIdx.x);
        pg8::EpiBf16<0> E{(pg8::bf16_t*)(ws + WS_PROJ), 256, nullptr, 256, (size_t)T * 256, 1.f};
        pg8::gemm_phase<pg8::EpiBf16<0>, pg8::StaticOrder, true, true>(c.lds, g, S, E); }
        if (BOTH(1)) GRID_BAR();
    }
    if (IN(2)) { _Pragma("unroll") for (int rep = 0; rep < REPS(2); ++rep) { if (rep) GRID_BAR(); p2_prep(args, c); } if (BOTH(2)) GRID_BAR(); }
    if (IN(3)) { _Pragma("unroll") for (int rep = 0; rep < REPS(3); ++rep) { if (rep) GRID_BAR(); p3_mixer(args, c, MISC, rep); } if (BOTH(3)) GRID_BAR(); }
    if (IN(4)) {
        p0_prologue<1>(args, c, c.vcu * NWAVES + c.wave, c.G * NWAVES);
        __syncthreads();
#pragma unroll 1
        for (int u = blockIdx.x; u < 256; u += c.G) mlstm_unit<1>(args, c, u >> 5, (u >> 3) & 3, u & 7);
        if (BOTH(4)) GRID_BAR();
    }
    if (IN(5)) {
        { pg8::Gemm g{(const pg8::bf16_t*)(dout + DO_YATT), (const pg8::bf16_t*)(ws + WS_WPA), T, D, 512}; pg8::StaticOrder S; S.init(T, D, c.G, (int)blockIdx.x);
          pg8::EpiGate<false> E{(pg8::bf16_t*)(ws + WS_MERGED), D, (const pg8::bf16_t*)(ws + WS_PROJ + (size_t)TL_GA * PROJ_TILE), (size_t)T * 256};
          pg8::gemm_phase<pg8::EpiGate<false>, pg8::StaticOrder, true, true>(c.lds, g, S, E); }
        __syncthreads();
        { pg8::Gemm g{(const pg8::bf16_t*)(dout + DO_YML), (const pg8::bf16_t*)(ws + WS_WPM), T, D, 512}; pg8::StaticOrder S; S.init(T, D, c.G, (int)blockIdx.x);
          pg8::EpiGate<true> E{(pg8::bf16_t*)(ws + WS_MERGED), D, (const pg8::bf16_t*)(ws + WS_PROJ + (size_t)TL_GM * PROJ_TILE), (size_t)T * 256};
          pg8::gemm_phase<pg8::EpiGate<true>, pg8::StaticOrder, true, true>(c.lds, g, S, E); }
        if (BOTH(5)) GRID_BAR();
    }
    if (IN(6)) {
        pg8::Gemm g{(const pg8::bf16_t*)(ws + WS_MERGED), (const pg8::bf16_t*)(ws + WS_WOUT), T, D, D}; pg8::StaticOrder S; S.init(T, D, c.G, (int)blockIdx.x);
        pg8::EpiRes E{args.out, args.in[IN_X], D};
        pg8::gemm_phase<pg8::EpiRes, pg8::StaticOrder, true, true>(c.lds, g, S, E);
        if (BOTH(6)) GRID_BAR();
    }
    if (IN(7)) { _Pragma("unroll") for (int rep = 0; rep < REPS(7); ++rep) { if (rep) GRID_BAR(); p6_router(args, c); } if (BOTH(7)) GRID_BAR(); }
    if (IN(8)) { _Pragma("unroll") for (int rep = 0; rep < REPS(8); ++rep) { if (rep) GRID_BAR(); p7_gather(args, c); } if (BOTH(8)) GRID_BAR(); }
    if (IN(9) || IN(10)) {
        LAS int* TSL = (LAS int*)(c.lds + MISC_OFF + 256);
        if (c.tid < 33) TSL[c.tid] = (int)__hip_atomic_load((unsigned*)(ws + WS_SMALL) + c.tid, RLX_AGENT);
        __syncthreads();
        if (IN(9)) {
            pg8::MoeOrder<true> S{TSL, c.G, (int)blockIdx.x, (const int*)(ws + WS_ROWTOK)};
            pg8::Gemm g{(const pg8::bf16_t*)(ws + WS_XN), (const pg8::bf16_t*)(ws + WS_GU), 0, 0, D};
            pg8::EpiSwiGLU E{(pg8::bf16_t*)(ws + WS_HID)};
            pg8::gemm_phase<pg8::EpiSwiGLU, pg8::MoeOrder<true>, true, true>(c.lds, g, S, E);
            if (BOTH(9)) GRID_BAR();
        }
        if (IN(10)) {
            pg8::MoeOrder<false> S{TSL, c.G, (int)blockIdx.x, nullptr};
            pg8::Gemm g{(const pg8::bf16_t*)(ws + WS_HID), (const pg8::bf16_t*)(ws + WS_DN), 0, 0, 512};
            pg8::EpiDown E{(pg8::bf16_t*)(ws + WS_Y)};
            pg8::gemm_phase<pg8::EpiDown, pg8::MoeOrder<false>, true, true>(c.lds, g, S, E);
            if (BOTH(10)) GRID_BAR();
        }
    }
    if (IN(11)) p10_combine(args, c);
#undef IN
#undef BOTH
#undef GRID_BAR
}

extern "C" void kernel_launch(void* const* d_in, const int* in_sizes, int n_in, void* d_out, int out_size, void* d_ws, size_t ws_size, hipStream_t stream) {
    static int grid = 0;
    if (grid == 0) {
        if (n_in != 22 || in_sizes[0] != T * D || out_size != T * D || ws_size < WS_END) { fprintf(stderr, "kernel_launch: unexpected shapes (n_in %d, in0 %d, out %d, ws %zu); nothing launched\n", n_in, n_in > 0 ? in_sizes[0] : -1, out_size, ws_size); grid = -1; return; }
        int dev = 0, cus = 0, per_cu = 0;
        if (hipGetDevice(&dev) != hipSuccess || hipDeviceGetAttribute(&cus, hipDeviceAttributeMultiprocessorCount, dev) != hipSuccess) { grid = -1; return; }
        if (hipFuncSetAttribute((const void*)hybrid_fwd, hipFuncAttributeMaxDynamicSharedMemorySize, LDS_BYTES) != hipSuccess) { fprintf(stderr, "kernel_launch: hipFuncSetAttribute failed\n"); grid = -1; return; }
        if (hipOccupancyMaxActiveBlocksPerMultiprocessor(&per_cu, (const void*)hybrid_fwd, NWAVES * 64, LDS_BYTES) != hipSuccess || per_cu < 1)
            fprintf(stderr, "kernel_launch: note: occupancy query reports %d workgroups per CU\n", per_cu);
        (void)hipGetLastError();
        grid = cus;
    }
    if (grid < 0) return;
    if (hipMemsetAsync((char*)d_ws + WS_CTL, 0, CTL_ZERO_BYTES, stream) != hipSuccess) return;
    Args a{};
    for (int i = 0; i < 22; ++i) a.in[i] = (const float*)d_in[i];
    a.out = (float*)d_out; a.ws = (unsigned char*)d_ws;
    for (int li = 0; li < N_LAUNCHES; ++li) {
        a.ph_lo = (N_LAUNCHES == 1) ? 0 : li; a.ph_hi = (N_LAUNCHES == 1) ? NPH : li + 1; a.li = li;
        hipLaunchKernelGGL(hybrid_fwd, dim3(grid), dim3(NWAVES * 64), LDS_BYTES, stream, a);
        if (hipPeekAtLastError() != hipSuccess) { fprintf(stderr, "kernel_launch: launch %d failed\n", li); break; }
    }
}
```

```cpp
#include <hip/hip_runtime.h>
#include <cstdio>
#include <cstdint>
namespace pg8 {
#define PG8_LAS __attribute__((address_space(3)))
typedef unsigned short bf16_t;
typedef short bf16x8 __attribute__((ext_vector_type(8)));
typedef float f32x4 __attribute__((ext_vector_type(4)));
typedef unsigned u32x4 __attribute__((ext_vector_type(4)));
constexpr int BM = 256, BK = 64, HALF = 128, HTB = HALF * BK * 2  , STAGE_BYTES = 8 * HTB, NXCD = 8, WGM = 8;

__host__ __device__ __forceinline__ int lds_byte(int r, int c) { const int st = (r >> 4) * 2 + (c >> 5), rr = r & 15, cc = c & 31, ob = rr * 64 + cc * 2; return st * 1024 + (ob ^ (((ob >> 9) & 1) << 5)); }
__host__ __device__ __forceinline__ void stage_rc(int b, int& R, int& C) { const int st = b / 1024, sb = b % 1024, swz = sb ^ (((sb >> 9) & 1) << 5); R = (st >> 1) * 16 + swz / 64; C = (st & 1) * 32 + (swz % 64) / 2; }
__host__ __device__ __forceinline__ int perm32(int rho) { const int n = rho >> 4, i = rho & 15; return 8 * (i >> 2) + 4 * n + (i & 3); }

struct Unit { int pm, pn; };
struct Gemm { const bf16_t* A; const bf16_t* Bt; int M, N, K; };

struct StaticOrder {
    static constexpr bool GATHER = false;
    int nM, nN, nwg, G, c;
    __host__ __device__ void init(int M, int N, int G_, int c_) { nM = M / BM; nN = N / BM; nwg = nM * nN; G = G_; c = c_; }
    __host__ __device__ bool next(int i, Unit& u) const {
        const long L = (long)i * G + c; if (L >= nwg) return false;
        int wgid = (int)L; { const int q = nwg / NXCD, r = nwg % NXCD, xcd = wgid % NXCD, off = wgid / NXCD; wgid = (xcd < r ? xcd * (q + 1) : r * (q + 1) + (xcd - r) * q) + off; }
        const int nig = WGM * nN, gid = wgid / nig, fm = gid * WGM, gsz = (nM - fm) < WGM ? (nM - fm) : WGM;
        u.pm = fm + ((wgid % nig) % gsz); u.pn = (wgid % nig) / gsz; return true;
    }
    __device__ __forceinline__ void a_ready(const Unit&) const {}
    __device__ __forceinline__ void done(const Unit&) const {}
};

typedef __bf16 bf2_t __attribute__((ext_vector_type(2)));
__device__ __forceinline__ unsigned cvt_pk_bf16(float lo, float hi) { bf2_t v; v[0] = (__bf16)lo; v[1] = (__bf16)hi; return __builtin_bit_cast(unsigned, v); }
typedef float f32x2 __attribute__((ext_vector_type(2)));
template <int ACT  > struct EpiBf16 {
    static constexpr bool PERM = true, AFTER_DRAIN = false; static_assert(ACT == 0, "EpiBf16: no activation here");
    bf16_t* O; int ldc; const float* bias; int split_cols; size_t split_stride; float scale0;
    __device__ __forceinline__ void operator()(const f32x4 (&acc)[2][2][4][2], const Unit& u, int wr, int wc, int fr, int fq) const {
        const int row0 = u.pm * BM + wr * 64 + fr; int colt = u.pn * BM; bf16_t* base = O;
        float sc = 1.f; if (split_cols) { const int t = colt / split_cols; base += (size_t)t * split_stride; colt -= t * split_cols; if (t == 0) sc = scale0; }
        const int col0 = colt + wc * 32 + 8 * fq, bcol0 = u.pn * BM + wc * 32 + 8 * fq;
        f32x4 bv[2][2];
#pragma unroll
        for (int bj = 0; bj < 2; ++bj)
#pragma unroll
            for (int n = 0; n < 2; ++n) bv[bj][n] = bias ? *(const f32x4*)(bias + bcol0 + bj * HALF + 4 * n) : (f32x4){0.f, 0.f, 0.f, 0.f};
#pragma unroll
        for (int ai = 0; ai < 2; ++ai)
#pragma unroll
            for (int m = 0; m < 4; ++m) { bf16_t* rowp = base + (size_t)(row0 + ai * HALF + m * 16) * ldc + col0;
#pragma unroll
                for (int bj = 0; bj < 2; ++bj) { f32x4 v0 = acc[ai][bj][m][0] + bv[bj][0], v1 = acc[ai][bj][m][1] + bv[bj][1];
                    v0 = v0 * sc; v1 = v1 * sc; u32x4 w; w.x = cvt_pk_bf16(v0[0], v0[1]); w.y = cvt_pk_bf16(v0[2], v0[3]); w.z = cvt_pk_bf16(v1[0], v1[1]); w.w = cvt_pk_bf16(v1[2], v1[3]);
                    *(u32x4*)(rowp + bj * HALF) = w; } }
    }
};
__device__ __forceinline__ float bf2f_(unsigned b16) { return __uint_as_float(b16 << 16); }
__device__ __forceinline__ float sigm_(float x) { return 1.0f / (1.0f + __expf(-x)); }
template <bool ADD> struct EpiGate {
    static constexpr bool PERM = true, AFTER_DRAIN = false;
    bf16_t* O; int ldc; const bf16_t* gate; size_t gstride;
    __device__ __forceinline__ void operator()(const f32x4 (&acc)[2][2][4][2], const Unit& u, int wr, int wc, int fr, int fq) const {
        const int row0 = u.pm * BM + wr * 64 + fr, colt = wc * 32 + 8 * fq;
        const bf16_t* gt = gate + (size_t)u.pn * gstride;
#pragma unroll
        for (int ai = 0; ai < 2; ++ai)
#pragma unroll
            for (int m = 0; m < 4; ++m) { const size_t row = (size_t)(row0 + ai * HALF + m * 16);
#pragma unroll
                for (int bj = 0; bj < 2; ++bj) { const int c = colt + bj * HALF;
                    const u32x4 gv = *(const u32x4*)(gt + row * 256 + c);
                    bf16_t* op = O + row * ldc + u.pn * BM + c;
                    float pv[8] = {0.f, 0.f, 0.f, 0.f, 0.f, 0.f, 0.f, 0.f};
                    if (ADD) { const u32x4 p = *(const u32x4*)op; pv[0] = bf2f_(p.x & 0xffffu); pv[1] = bf2f_(p.x >> 16); pv[2] = bf2f_(p.y & 0xffffu); pv[3] = bf2f_(p.y >> 16);
                        pv[4] = bf2f_(p.z & 0xffffu); pv[5] = bf2f_(p.z >> 16); pv[6] = bf2f_(p.w & 0xffffu); pv[7] = bf2f_(p.w >> 16); }
                    const f32x4 v0 = acc[ai][bj][m][0], v1 = acc[ai][bj][m][1];
                    float o[8];
                    o[0] = pv[0] + sigm_(bf2f_(gv.x & 0xffffu)) * v0[0]; o[1] = pv[1] + sigm_(bf2f_(gv.x >> 16)) * v0[1];
                    o[2] = pv[2] + sigm_(bf2f_(gv.y & 0xffffu)) * v0[2]; o[3] = pv[3] + sigm_(bf2f_(gv.y >> 16)) * v0[3];
                    o[4] = pv[4] + sigm_(bf2f_(gv.z & 0xffffu)) * v1[0]; o[5] = pv[5] + sigm_(bf2f_(gv.z >> 16)) * v1[1];
                    o[6] = pv[6] + sigm_(bf2f_(gv.w & 0xffffu)) * v1[2]; o[7] = pv[7] + sigm_(bf2f_(gv.w >> 16)) * v1[3];
                    u32x4 w; w.x = cvt_pk_bf16(o[0], o[1]); w.y = cvt_pk_bf16(o[2], o[3]); w.z = cvt_pk_bf16(o[4], o[5]); w.w = cvt_pk_bf16(o[6], o[7]);
                    *(u32x4*)op = w; } }
    }
};
struct EpiRes {
    static constexpr bool PERM = false, AFTER_DRAIN = false;
    float* C; const float* R; int ldc;
    __device__ __forceinline__ void operator()(const f32x4 (&acc)[2][2][4][2], const Unit& u, int wr, int wc, int fr, int fq) const {
        const int row0 = u.pm * BM + wr * 64 + fr, col0 = u.pn * BM + wc * 32 + 4 * fq;
#pragma unroll
        for (int ai = 0; ai < 2; ++ai)
#pragma unroll
            for (int m = 0; m < 4; ++m) { const size_t ro = (size_t)(row0 + ai * HALF + m * 16) * ldc + col0;
#pragma unroll
                for (int bj = 0; bj < 2; ++bj)
#pragma unroll
                    for (int n = 0; n < 2; ++n) { const size_t off = ro + bj * HALF + n * 16; *(f32x4*)(C + off) = *(const f32x4*)(R + off) + acc[ai][bj][m][n]; } }
    }
};
struct EpiSwiGLU {
    static constexpr bool PERM = true, AFTER_DRAIN = false;
    bf16_t* H;
    __device__ __forceinline__ void operator()(const f32x4 (&acc)[2][2][4][2], const Unit& u, int wr, int wc, int fr, int fq) const {
        const int row0 = u.pm * BM + wr * 64 + fr, hc = (u.pn & 3) * 128 + wc * 32 + 8 * fq;
#pragma unroll
        for (int ai = 0; ai < 2; ++ai)
#pragma unroll
            for (int m = 0; m < 4; ++m) { const size_t row = (size_t)(row0 + ai * HALF + m * 16);
                float o[8];
#pragma unroll
                for (int n = 0; n < 2; ++n)
#pragma unroll
                    for (int i = 0; i < 4; ++i) { const float g = acc[ai][0][m][n][i], up = acc[ai][1][m][n][i]; o[n * 4 + i] = g * sigm_(g) * up; }
                u32x4 w; w.x = cvt_pk_bf16(o[0], o[1]); w.y = cvt_pk_bf16(o[2], o[3]); w.z = cvt_pk_bf16(o[4], o[5]); w.w = cvt_pk_bf16(o[6], o[7]);
                *(u32x4*)(H + row * 512 + hc) = w; }
    }
};
struct EpiDown {
    static constexpr bool PERM = true, AFTER_DRAIN = false;
    bf16_t* Y;
    __device__ __forceinline__ void operator()(const f32x4 (&acc)[2][2][4][2], const Unit& u, int wr, int wc, int fr, int fq) const {
        const int row0 = u.pm * BM + wr * 64 + fr, c0 = (u.pn & 3) * 256 + wc * 32 + 8 * fq;
#pragma unroll
        for (int ai = 0; ai < 2; ++ai)
#pragma unroll
            for (int m = 0; m < 4; ++m) { const size_t row = (size_t)(row0 + ai * HALF + m * 16);
#pragma unroll
                for (int bj = 0; bj < 2; ++bj) { const f32x4 v0 = acc[ai][bj][m][0], v1 = acc[ai][bj][m][1];
                    u32x4 w; w.x = cvt_pk_bf16(v0[0], v0[1]); w.y = cvt_pk_bf16(v0[2], v0[3]); w.z = cvt_pk_bf16(v1[0], v1[1]); w.w = cvt_pk_bf16(v1[2], v1[3]);
                    *(u32x4*)(Y + row * 1024 + c0 + bj * HALF) = w; } }
    }
};
template <bool GA_> struct MoeOrder {
    static constexpr bool GATHER = GA_;
    const PG8_LAS int* ts; int G, c; const int* rowtok;
    __device__ __forceinline__ bool next(int i, Unit& u) const {
        const int nt = ts[32]; const long L = (long)i * G + c; if (L >= 4L * nt) return false;
        const int pm = (int)(L >> 2), j = (int)(L & 3); int e = 0;
#pragma unroll
        for (int k = 1; k < 32; ++k) e += (ts[k] <= pm) ? 1 : 0;
        u.pm = pm; u.pn = e * 4 + j; return true;
    }
    __device__ __forceinline__ void a_ready(const Unit&) const {}
    __device__ __forceinline__ void done(const Unit&) const {}
};
template <class Epi, class Sched, bool ALIGN_EPI = false, bool SP2 = false>
__device__ __forceinline__ void gemm_phase(PG8_LAS unsigned char* lds, const Gemm g, const Sched& S, const Epi& E) {
    const int tid = threadIdx.x, wid = __builtin_amdgcn_readfirstlane(tid >> 6), lane = tid & 63, wr = wid >> 2, wc = wid & 3, fr = lane & 15, fq = lane >> 4;
    const int K = g.K, nt = K / BK;
    unsigned voffA[2], voffB[2];
#pragma unroll
    for (int i = 0; i < 2; ++i) { int R, C; stage_rc(tid * 16 + i * 8192, R, C); const int Rb = Epi::PERM ? ((R & ~31) + perm32(R & 31)) : R;
        voffA[i] = (unsigned)(R * K + C) * 2u; voffB[i] = (unsigned)(Rb * K + C) * 2u; }
    const size_t kstep = (size_t)(BK * 2);
    const size_t hstep = (size_t)HALF * K * 2;
    const size_t tstep = 2 * hstep;
    constexpr bool GA = Sched::GATHER;
    static_assert(!GA || SP2, "gathered A rows: SP2 loop only");
    const size_t hstepA = GA ? 0 : hstep;
    unsigned gcur[2][2] = {{0u, 0u}, {0u, 0u}}, gnxt[2][2] = {{0u, 0u}, {0u, 0u}}; int gR[2] = {0, 0}; unsigned gC[2] = {0u, 0u};
    if constexpr (GA) { _Pragma("unroll") for (int i = 0; i < 2; ++i) { int R, C; stage_rc(tid * 16 + i * 8192, R, C); gR[i] = R; gC[i] = (unsigned)C * 2u; } }
#define PG8_GOFF(dst, u) do { if constexpr (GA) { _Pragma("unroll") for (int h_ = 0; h_ < 2; ++h_) _Pragma("unroll") for (int i_ = 0; i_ < 2; ++i_) dst[h_][i_] = (unsigned)S.rowtok[(u).pm * BM + h_ * HALF + gR[i_]] * (unsigned)(K * 2) + gC[i_]; } } while (0)
#define PG8_VA(h, sel) (GA ? ((sel) ? gnxt[h] : gcur[h]) : voffA)
    const unsigned ldsw = (unsigned)wid * 1024u;
    const int aoff = lds_byte(wr * 64 + fr, fq * 8), boff = lds_byte(wc * 32 + fr, fq * 8);
#define PG8_SA(b, h) (((b) * 2 + (h)) * HTB)
#define PG8_SB(b, h) ((4 + (b) * 2 + (h)) * HTB)
#define PG8_STAGE(bufoff, gbase, voff) do { _Pragma("unroll") for (int _i = 0; _i < 2; ++_i) \
        __builtin_amdgcn_global_load_lds((const unsigned*)((const char*)(gbase) + (voff)[_i]), (PG8_LAS unsigned*)(lds + (bufoff) + ldsw + _i * 8192), 16, 0, 0); } while (0)
#define PG8_LDA(dst, b, h) do { _Pragma("unroll") for (int m = 0; m < 4; ++m) _Pragma("unroll") for (int k = 0; k < 2; ++k) dst[m][k] = *(const PG8_LAS bf16x8*)(lds + PG8_SA(b, h) + aoff + m * 2048 + k * 1024); } while (0)
#define PG8_LDB(dst, b, h) do { _Pragma("unroll") for (int n = 0; n < 2; ++n) _Pragma("unroll") for (int k = 0; k < 2; ++k) dst[n][k] = *(const PG8_LAS bf16x8*)(lds + PG8_SB(b, h) + boff + n * 2048 + k * 1024); } while (0)
#define PG8_MMA(ai, bj, At, Bt) do { __builtin_amdgcn_s_setprio(1); _Pragma("unroll") for (int m = 0; m < 4; ++m) _Pragma("unroll") for (int n = 0; n < 2; ++n) _Pragma("unroll") for (int k = 0; k < 2; ++k) \
        acc[ai][bj][m][n] = __builtin_amdgcn_mfma_f32_16x16x32_bf16(Bt[n][k], At[m][k], acc[ai][bj][m][n], 0, 0, 0); __builtin_amdgcn_s_setprio(0); } while (0)
#define PG8_WAIT_V(n) asm volatile("s_waitcnt vmcnt(" #n ")" ::: "memory")
#define PG8_WAIT_L(n) asm volatile("s_waitcnt lgkmcnt(" #n ")" ::: "memory")
#define PG8_BAR __builtin_amdgcn_s_barrier()
#define PG8_SCHED __builtin_amdgcn_sched_barrier(0)
    Unit cur, nxt; int ui = 0;
    if (!S.next(0, cur)) return;
    f32x4 acc[2][2][4][2];
#pragma unroll
    for (int a = 0; a < 2; ++a)
#pragma unroll
        for (int b = 0; b < 2; ++b)
#pragma unroll
            for (int m = 0; m < 4; ++m)
#pragma unroll
                for (int n = 0; n < 2; ++n) acc[a][b][m][n] = (f32x4){0.f, 0.f, 0.f, 0.f};
    bf16x8 At[4][2], B0[2][2], B1[2][2];
    const char* cA = (const char*)g.A + (GA ? 0 : (size_t)cur.pm * tstep); const char* cB = (const char*)g.Bt + (size_t)cur.pn * tstep;
    S.a_ready(cur);
    PG8_GOFF(gcur, cur);
    if constexpr (SP2) {
        PG8_STAGE(PG8_SB(0, 0), cB, voffB); PG8_STAGE(PG8_SB(0, 1), cB + hstep, voffB); PG8_STAGE(PG8_SA(0, 0), cA, PG8_VA(0, false)); PG8_STAGE(PG8_SA(0, 1), cA + hstepA, PG8_VA(1, false));
        if (wr == 1) PG8_BAR;
        PG8_WAIT_V(2); PG8_BAR;
        PG8_STAGE(PG8_SB(1, 0), cB + kstep, voffB); PG8_STAGE(PG8_SA(1, 0), cA + kstep, PG8_VA(0, false)); PG8_STAGE(PG8_SB(1, 1), cB + hstep + kstep, voffB);
        PG8_WAIT_V(6); PG8_BAR;
    } else {
        PG8_STAGE(PG8_SB(0, 0), cB, voffB); PG8_STAGE(PG8_SA(0, 0), cA, voffA); PG8_STAGE(PG8_SB(0, 1), cB + hstep, voffB); PG8_STAGE(PG8_SA(0, 1), cA + hstep, voffA);
        if (wr == 1) PG8_BAR;
        PG8_WAIT_V(4); PG8_BAR;
        PG8_STAGE(PG8_SB(1, 0), cB + kstep, voffB); PG8_STAGE(PG8_SA(1, 0), cA + kstep, voffA); PG8_STAGE(PG8_SB(1, 1), cB + hstep + kstep, voffB);
        PG8_WAIT_V(6); PG8_BAR;
    }
    for (;;) {
        const bool has_next = S.next(ui + 1, nxt);
        if (has_next) PG8_GOFF(gnxt, nxt);
        const char* nA = has_next ? (const char*)g.A + (GA ? 0 : (size_t)nxt.pm * tstep) : cA; const char* nB = has_next ? (const char*)g.Bt + (size_t)nxt.pn * tstep : cB;
        for (int t = 0; t < nt; t += 2) {
            const bool last = (t == nt - 2);
            const char* a1 = cA + (size_t)(t + 1) * kstep;
            const char* a2 = last ? nA : cA + (size_t)(t + 2) * kstep; const char* b2 = last ? nB : cB + (size_t)(t + 2) * kstep;
            const char* a3 = a2 + kstep; const char* b3 = b2 + kstep;
            if (last && has_next) S.a_ready(nxt);
            const bool seln = last && has_next;
            if constexpr (SP2) {
            PG8_LDB(B0, 0, 0); PG8_LDB(B1, 0, 1); PG8_SCHED; PG8_LDA(At, 0, 0); PG8_STAGE(PG8_SA(1, 1), a1 + hstepA, PG8_VA(1, false));
            PG8_WAIT_V(8); PG8_WAIT_L(0); PG8_BAR; PG8_MMA(0, 0, At, B0); PG8_MMA(0, 1, At, B1); PG8_BAR; PG8_SCHED;
            PG8_LDA(At, 0, 1); PG8_STAGE(PG8_SB(0, 0), b2, voffB); PG8_STAGE(PG8_SB(0, 1), b2 + hstep, voffB); PG8_STAGE(PG8_SA(0, 0), a2, PG8_VA(0, seln));
            PG8_WAIT_V(8); PG8_WAIT_L(0); PG8_BAR; PG8_MMA(1, 0, At, B0); PG8_MMA(1, 1, At, B1); PG8_BAR; PG8_SCHED;
            PG8_LDB(B0, 1, 0); PG8_LDB(B1, 1, 1); PG8_SCHED; PG8_LDA(At, 1, 0); PG8_STAGE(PG8_SA(0, 1), a2 + hstepA, PG8_VA(1, seln));
            PG8_WAIT_V(8); PG8_WAIT_L(0); PG8_BAR; PG8_MMA(0, 0, At, B0); PG8_MMA(0, 1, At, B1); PG8_BAR; PG8_SCHED;
            PG8_LDA(At, 1, 1); PG8_STAGE(PG8_SB(1, 0), b3, voffB); PG8_STAGE(PG8_SB(1, 1), b3 + hstep, voffB); PG8_STAGE(PG8_SA(1, 0), a3, PG8_VA(0, seln));
            PG8_WAIT_V(8); PG8_WAIT_L(0); PG8_BAR; PG8_MMA(1, 0, At, B0); PG8_MMA(1, 1, At, B1); PG8_BAR; PG8_SCHED;
            } else {
            PG8_LDB(B0, 0, 0); PG8_SCHED; PG8_LDA(At, 0, 0); PG8_STAGE(PG8_SA(1, 1), a1 + hstep, voffA);
            PG8_WAIT_L(8); PG8_BAR; PG8_WAIT_L(0); PG8_MMA(0, 0, At, B0); PG8_BAR; PG8_SCHED;
            PG8_LDB(B1, 0, 1); PG8_STAGE(PG8_SB(0, 0), b2, voffB);
            PG8_BAR; PG8_WAIT_L(0); PG8_MMA(0, 1, At, B1); PG8_BAR;
            PG8_LDA(At, 0, 1); PG8_STAGE(PG8_SA(0, 0), a2, voffA);
            PG8_BAR; PG8_WAIT_L(0); PG8_MMA(1, 0, At, B0); PG8_BAR; PG8_SCHED;
            PG8_STAGE(PG8_SB(0, 1), b2 + hstep, voffB);
            PG8_WAIT_V(6); PG8_BAR; PG8_MMA(1, 1, At, B1); PG8_BAR;
            PG8_LDB(B0, 1, 0); PG8_SCHED; PG8_LDA(At, 1, 0); PG8_STAGE(PG8_SA(0, 1), a2 + hstep, voffA);
            PG8_WAIT_L(8); PG8_BAR; PG8_WAIT_L(0); PG8_MMA(0, 0, At, B0); PG8_BAR; PG8_SCHED;
            PG8_LDB(B1, 1, 1); PG8_STAGE(PG8_SB(1, 0), b3, voffB);
            PG8_BAR; PG8_WAIT_L(0); PG8_MMA(0, 1, At, B1); PG8_BAR;
            PG8_LDA(At, 1, 1); PG8_STAGE(PG8_SA(1, 0), a3, voffA);
            PG8_BAR; PG8_WAIT_L(0); PG8_MMA(1, 0, At, B0); PG8_BAR; PG8_SCHED;
            PG8_STAGE(PG8_SB(1, 1), b3 + hstep, voffB);
            PG8_WAIT_V(6); PG8_BAR; PG8_MMA(1, 1, At, B1); PG8_BAR;
            }
        }
        if constexpr (ALIGN_EPI) { if (wr == 0) PG8_BAR; }
        if constexpr (!Epi::AFTER_DRAIN) { E(acc, cur, wr, wc, fr, fq); S.done(cur); }
        if (!has_next) break;
#pragma unroll
        for (int a = 0; a < 2; ++a)
#pragma unroll
            for (int b = 0; b < 2; ++b)
#pragma unroll
                for (int m = 0; m < 4; ++m)
#pragma unroll
                    for (int n = 0; n < 2; ++n) acc[a][b][m][n] = (f32x4){0.f, 0.f, 0.f, 0.f};
        cur = nxt; cA = nA; cB = nB; ++ui;
        if constexpr (GA) { _Pragma("unroll") for (int h_ = 0; h_ < 2; ++h_) _Pragma("unroll") for (int i_ = 0; i_ < 2; ++i_) gcur[h_][i_] = gnxt[h_][i_]; }
        if constexpr (ALIGN_EPI) { if (wr == 1) PG8_BAR; }
    }
    PG8_WAIT_V(0);
    if constexpr (!ALIGN_EPI) { if (wr == 0) PG8_BAR; }
    PG8_BAR;
    if constexpr (Epi::AFTER_DRAIN) { E.fused(acc, cur, wr, wc, fr, fq, lds, wid, lane); S.done(cur); }
#undef PG8_GOFF
#undef PG8_VA
#undef PG8_SA
#undef PG8_SB
#undef PG8_STAGE
#undef PG8_LDA
#undef PG8_LDB
#undef PG8_MMA
#undef PG8_WAIT_V
#undef PG8_WAIT_L
#undef PG8_BAR
#undef PG8_SCHED
}
}
constexpr int NWAVES = 8;
constexpr int BATCH = 8, SEQ = 4096, D = 1024, T = BATCH * SEQ;
constexpr int NPROJ = 5376;
constexpr int NTILE = NPROJ / 256;
constexpr float EPS = 1e-6f;
#ifndef MK_N_LAUNCHES
#define MK_N_LAUNCHES 1
#endif
#ifndef DBG_NPH
#define DBG_NPH 12
#endif
constexpr int NPH = DBG_NPH;
constexpr int N_LAUNCHES = MK_N_LAUNCHES;
static_assert(N_LAUNCHES == 1 || N_LAUNCHES == NPH, "MK_N_LAUNCHES is 1 or NPH");

constexpr size_t MiB = 1u << 20;
constexpr size_t WS_CTL = 0, CTL_ZERO_BYTES = 1 * MiB;
constexpr size_t WS_SMALL = 1 * MiB;
constexpr size_t WS_WIN = 2 * MiB;
constexpr size_t WS_WPA = 13 * MiB, WS_WPM = 14 * MiB, WS_WOUT = 15 * MiB;
constexpr size_t WS_TOKE = 17 * MiB;
constexpr size_t WS_TOKR = WS_TOKE + 256 * 1024;
constexpr size_t WS_TOKP = WS_TOKR + 256 * 1024;
constexpr size_t WS_TOKG = WS_TOKP + 256 * 1024;
constexpr size_t WS_CNT = WS_TOKG + 256 * 1024;
constexpr size_t WS_ROWTOK = WS_CNT + 64 * 1024;
constexpr int NROWS_MAX = 73728;
constexpr size_t WS_SC = 452 * MiB;
constexpr size_t WS_SC2 = 116 * MiB + 3 * ((size_t)T * 256 * 2);
constexpr size_t WS_GU = 20 * MiB;
constexpr size_t WS_DN = 84 * MiB;
constexpr size_t WS_PROJ = 116 * MiB;
constexpr size_t PROJ_TILE = (size_t)T * 256 * 2;
constexpr size_t WS_MLST = 116 * MiB;
constexpr size_t WS_MERGED = 116 * MiB;
constexpr size_t WS_XN = 180 * MiB;
constexpr size_t WS_XG = 244 * MiB;
constexpr size_t WS_HID = 388 * MiB;
constexpr size_t WS_Y = 244 * MiB;
constexpr size_t WS_END = 512 * MiB;
static_assert(WS_PROJ + NTILE * PROJ_TILE == 452 * MiB, "proj map");
constexpr size_t DO_H = 0, DO_YATT = 0, DO_YML = 32 * MiB, DO_KN = 64 * MiB, DO_IKR = 72 * MiB, DO_IQR = 74 * MiB, DO_AQN = 90 * MiB;
constexpr int TL_AQ = 0, TL_KV = 2, TL_IQ = 3, TL_SM = 4, TL_MQ = 5, TL_MK = 7, TL_MV = 9, TL_MO = 11, TL_GA = 13, TL_GM = 17;
constexpr int CW_BAR = 4096;
constexpr int CW_Q = 16384;
constexpr int LDS_BYTES = 163840, MISC_OFF = LDS_BYTES - 512;

#define GAS __attribute__((address_space(1)))
#define LAS __attribute__((address_space(3)))
typedef unsigned short bf16;
typedef unsigned v4u __attribute__((ext_vector_type(4)));
typedef unsigned v2u __attribute__((ext_vector_type(2)));
typedef float f32x4 __attribute__((ext_vector_type(4)));
typedef float f32x2 __attribute__((ext_vector_type(2)));
typedef short bf16x8 __attribute__((ext_vector_type(8)));
typedef GAS unsigned gu32;
#define RLX_AGENT __ATOMIC_RELAXED, __HIP_MEMORY_SCOPE_AGENT
#define LDS_WAIT() asm volatile("s_waitcnt lgkmcnt(0)" ::: "memory")
__device__ __forceinline__ float bf2f(unsigned b16) { return __uint_as_float(b16 << 16); }
__device__ __forceinline__ unsigned f2bf(float f) { unsigned u = __float_as_uint(f); return (u + 0x7fffu + ((u >> 16) & 1u)) >> 16; }
__device__ __forceinline__ unsigned pk2(float lo, float hi) { return pg8::cvt_pk_bf16(lo, hi); }
__device__ __forceinline__ float sigm(float x) { return 1.0f / (1.0f + __expf(-x)); }
__device__ __forceinline__ float wave_sum(float v) {
    v += __int_as_float(__builtin_amdgcn_update_dpp(0, __float_as_int(v), 0xB1, 0xF, 0xF, true));
    v += __int_as_float(__builtin_amdgcn_update_dpp(0, __float_as_int(v), 0x4E, 0xF, 0xF, true));
    v += __int_as_float(__builtin_amdgcn_update_dpp(0, __float_as_int(v), 0x124, 0xF, 0xF, true));
    v += __int_as_float(__builtin_amdgcn_update_dpp(0, __float_as_int(v), 0x128, 0xF, 0xF, true));
    { const auto r = __builtin_amdgcn_permlane16_swap(__float_as_uint(v), __float_as_uint(v), false, false); v = __uint_as_float(r[0]) + __uint_as_float(r[1]); }
    { const auto r = __builtin_amdgcn_permlane32_swap(__float_as_uint(v), __float_as_uint(v), false, false); v = __uint_as_float(r[0]) + __uint_as_float(r[1]); }
    return v;
}
__device__ __forceinline__ void unpack8(const v4u r, float (&f)[8]) {
    f[0] = bf2f(r.x & 0xffffu); f[1] = bf2f(r.x >> 16); f[2] = bf2f(r.y & 0xffffu); f[3] = bf2f(r.y >> 16);
    f[4] = bf2f(r.z & 0xffffu); f[5] = bf2f(r.z >> 16); f[6] = bf2f(r.w & 0xffffu); f[7] = bf2f(r.w >> 16);
}
__device__ __forceinline__ v4u pack8(const float (&f)[8]) { v4u w; w.x = pk2(f[0], f[1]); w.y = pk2(f[2], f[3]); w.z = pk2(f[4], f[5]); w.w = pk2(f[6], f[7]); return w; }
#define XB_TMO      128
#define XB_XCNT(j)  (256  + 64 * (j))
#define XB_XSUB(j)  (1280 + 64 * (j))
#define XB_XGEN(j)  (2304 + 64 * (j))
#define XB_TOP      3328
#define XB_TOPGEN   3392
#define XCD_BAR_WORDS 3456
#define XB_SPIN_CAP (1u << 18)

__device__ __forceinline__ unsigned xb_ld(unsigned* p)              { return __hip_atomic_load(p, __ATOMIC_RELAXED, __HIP_MEMORY_SCOPE_AGENT); }
__device__ __forceinline__ unsigned xb_add(unsigned* p, unsigned v) { return __hip_atomic_fetch_add(p, v, __ATOMIC_RELAXED, __HIP_MEMORY_SCOPE_AGENT); }
__device__ __forceinline__ unsigned xb_xcc_id() { return (unsigned)__builtin_amdgcn_s_getreg((3 << 11) | 20) & 0xFu; }
#define XB_SPIN(cond, bar) do { unsigned _sp = 0; while (cond) { __builtin_amdgcn_s_sleep(1); \
    if ((++_sp & 255u) == 0u) { if (xb_ld(&(bar)[XB_TMO])) break; if (_sp > XB_SPIN_CAP) { atomicAdd(&(bar)[XB_TMO], 1u); break; } } } } while (0)

struct XcdBarrier {
    unsigned* bar; unsigned x;
    volatile LAS unsigned* st;
};

__device__ __forceinline__ XcdBarrier xcd_barrier_post(unsigned* bar, volatile LAS unsigned* st) {
    XcdBarrier b; b.bar = bar; b.x = xb_xcc_id(); b.st = st;
    if (threadIdx.x == 0) (void)xb_add(&bar[XB_XCNT(b.x)], 1u);
    return b;
}
__device__ __forceinline__ void xcd_barrier_complete(unsigned* bar, unsigned x, unsigned& nloc, unsigned& nx) {
    const unsigned G = gridDim.x * gridDim.y * gridDim.z;
    unsigned sum, cnt, mine, sp = 0u;
    for (;;) {
        sum = 0u; cnt = 0u; mine = 0u;
#pragma unroll
        for (unsigned j = 0; j < 16; ++j) { const unsigned c = xb_ld(&bar[XB_XCNT(j)]); sum += c; cnt += (c > 0u) ? 1u : 0u; mine = (j == x) ? c : mine; }
        if (sum == G) break;
        __builtin_amdgcn_s_sleep(1);
        if ((++sp & 255u) == 0u) { if (xb_ld(&bar[XB_TMO])) break; if (sp > XB_SPIN_CAP) { atomicAdd(&bar[XB_TMO], 1u); break; } }
    }
    nloc = mine > 0u ? mine : 1u; nx = cnt > 0u ? cnt : 1u;
}

__device__ __forceinline__ void xcd_barrier(const XcdBarrier& b) {
    asm volatile("s_waitcnt vmcnt(0)" ::: "memory");
    __syncthreads();
    if (threadIdx.x == 0) {
        unsigned* bar = b.bar;
        __builtin_amdgcn_s_waitcnt(0);
        unsigned nloc = b.st[0], nx = b.st[1];
        if (nloc == 0u) { xcd_barrier_complete(bar, b.x, nloc, nx); b.st[0] = nloc; b.st[1] = nx; }
        const unsigned old = xb_add(&bar[XB_XSUB(b.x)], 1u);
        const unsigned gen = old / nloc;
        if (old + 1u == (gen + 1u) * nloc) {
            __builtin_amdgcn_fence(__ATOMIC_RELEASE, "agent");
            asm volatile("s_waitcnt vmcnt(0)" ::: "memory");
            const unsigned og = xb_add(&bar[XB_TOP], 1u);
            const unsigned tg = og / nx;
            if (og + 1u == (tg + 1u) * nx) xb_add(&bar[XB_TOPGEN], 1u);
            else XB_SPIN(xb_ld(&bar[XB_TOPGEN]) == tg, bar);
            __builtin_amdgcn_fence(__ATOMIC_ACQUIRE, "agent");
            xb_add(&bar[XB_XGEN(b.x)], 1u);
            asm volatile("s_waitcnt vmcnt(0)" ::: "memory");
        } else {
            XB_SPIN(xb_ld(&bar[XB_XGEN(b.x)]) == gen, bar);
            __builtin_amdgcn_fence(__ATOMIC_ACQUIRE, "agent");
            asm volatile("s_waitcnt vmcnt(0)" ::: "memory");
        }
    }
    __syncthreads();
}
struct Args { const float* in[22]; float* out; unsigned char* ws; int ph_lo, ph_hi, li, pad; };
struct Ctx { int tid, lane, wave, G, vcu; LAS unsigned char* lds; };
#define IN_X 0
#define IN_POS 1
#define IN_GMIX 2
#define IN_WIN 3
#define IN_GQ 4
#define IN_GK 5
#define IN_WCONV 6
#define IN_BCONV 7
#define IN_BI 8
#define IN_BF 9
#define IN_GML 10
#define IN_WPA 11
#define IN_WPM 12
#define IN_WOUT 13
#define IN_GMOE 14
#define IN_WRG 15
#define IN_BRG 16
#define IN_WRE 17
#define IN_BRE 18
#define IN_WEG 19
#define IN_WEU 20
#define IN_WED 21

__device__ __forceinline__ int win_src_col(int n) {
    if (n < 1064) return n;
    if (n < 1068) return 3112 + (n - 1064);
    if (n < 1072) return 3116 + (n - 1068);
    if (n < 1280) return -1;
    if (n < 3328) return n - 216;
    return n - 208;
}
__device__ __forceinline__ void tr_item(const float* W, int ldw, int scol, int k0, bf16* wt0, int K, LAS float* scr, int lane) {
    const int sc0 = __builtin_amdgcn_readfirstlane(scol), sc31 = __builtin_amdgcn_readlane(scol, 31);
    if (sc0 >= 0 && sc31 == sc0 + 31 && (sc0 & 3) == 0 && (ldw & 3) == 0) {
#pragma unroll
        for (int i = 0; i < 8; ++i) { const int kk = 8 * i + (lane >> 3); const f32x4 v = *(const f32x4*)(W + (size_t)(k0 + kk) * ldw + sc0 + 4 * (lane & 7));
            LAS float* d = scr + kk * 33 + 4 * (lane & 7); d[0] = v[0]; d[1] = v[1]; d[2] = v[2]; d[3] = v[3]; }
    } else {
#pragma unroll 8
        for (int i = 0; i < 32; ++i) { const int kk = 2 * i + (lane >> 5); scr[kk * 33 + (lane & 31)] = scol >= 0 ? W[(size_t)(k0 + kk) * ldw + scol] : 0.f; }
    }
    LDS_WAIT(); asm volatile("" ::: "memory");
    const int c = lane & 7;
#pragma unroll
    for (int j = 0; j < 4; ++j) { const int n = (lane >> 3) + 8 * j; const LAS float* s = scr + (8 * c) * 33 + n;
        v4u o; o.x = pk2(s[0 * 33], s[1 * 33]); o.y = pk2(s[2 * 33], s[3 * 33]); o.z = pk2(s[4 * 33], s[5 * 33]); o.w = pk2(s[6 * 33], s[7 * 33]);
        *(v4u*)(wt0 + (size_t)n * K + 8 * c) = o; }
    LDS_WAIT(); asm volatile("" ::: "memory");
}
template <int PART> __device__ __forceinline__ void p0_prologue(const Args& a, const Ctx& c, int gw, int NGW) {
    unsigned char* ws = a.ws;
    LAS float* scr = (LAS float*)(c.lds + c.wave * 16384);
    const int lane = c.lane;
    constexpr int I_IN = 16 * 168, I_PA = 8 * 32, I_PM = 8 * 32, I_OUT = 16 * 32, I_GU = 32 * 16 * 32, I_DN = 32 * 8 * 32;
    constexpr int NPRJ = I_IN + I_PA + I_PM + I_OUT, NIT = NPRJ + I_GU + I_DN;
    for (int it = (PART ? NPRJ : 0) + gw; it < (PART ? NIT : NPRJ); it += NGW) {
        int r = it;
        if (r < I_IN) { const int kb = r / 168, nb = r % 168; tr_item(a.in[IN_WIN], 5168, win_src_col(32 * nb + (lane & 31)), 64 * kb, (bf16*)(ws + WS_WIN) + (size_t)(32 * nb) * 1024 + 64 * kb, 1024, scr, lane); continue; } r -= I_IN;
        if (r < I_PA) { const int kb = r / 32, nb = r % 32; tr_item(a.in[IN_WPA], 1024, 32 * nb + (lane & 31), 64 * kb, (bf16*)(ws + WS_WPA) + (size_t)(32 * nb) * 512 + 64 * kb, 512, scr, lane); continue; } r -= I_PA;
        if (r < I_PM) { const int kb = r / 32, nb = r % 32; tr_item(a.in[IN_WPM], 1024, 32 * nb + (lane & 31), 64 * kb, (bf16*)(ws + WS_WPM) + (size_t)(32 * nb) * 512 + 64 * kb, 512, scr, lane); continue; } r -= I_PM;
        if (r < I_OUT) { const int kb = r / 32, nb = r % 32; tr_item(a.in[IN_WOUT], 1024, 32 * nb + (lane & 31), 64 * kb, (bf16*)(ws + WS_WOUT) + (size_t)(32 * nb) * 1024 + 64 * kb, 1024, scr, lane); continue; } r -= I_OUT;
        if (r < I_GU) { const int e = r / 512, q = r % 512, kb = q / 32, nb = q % 32, t = nb >> 3, bj = (nb >> 2) & 1, i0 = (nb & 3) * 32;
            const float* src = (bj ? a.in[IN_WEU] : a.in[IN_WEG]) + (size_t)e * 1024 * 512;
            tr_item(src, 512, 128 * t + i0 + (lane & 31), 64 * kb, (bf16*)(ws + WS_GU) + ((size_t)e * 1024 + 32 * nb) * 1024 + 64 * kb, 1024, scr, lane); continue; } r -= I_GU;
        { const int e = r / 256, q = r % 256, kb = q / 32, nb = q % 32;
            tr_item(a.in[IN_WED] + (size_t)e * 512 * 1024, 1024, 32 * nb + (lane & 31), 64 * kb, (bf16*)(ws + WS_DN) + ((size_t)e * 1024 + 32 * nb) * 512 + 64 * kb, 512, scr, lane); }
    }
    if (PART) return;
    const float* g = a.in[IN_GMIX]; f32x4 gv[4];
#pragma unroll
    for (int j = 0; j < 4; ++j) gv[j] = *(const f32x4*)(g + 4 * lane + 256 * j);
    bf16* H = (bf16*)((unsigned char*)a.out + DO_H);
    for (int m = gw; m < T; m += NGW) {
        const f32x4* xr = (const f32x4*)(a.in[IN_X] + (size_t)m * D) + lane; f32x4 v[4]; float s = 0.f;
#pragma unroll
        for (int j = 0; j < 4; ++j) { v[j] = xr[64 * j]; s += (v[j].x * v[j].x + v[j].y * v[j].y) + (v[j].z * v[j].z + v[j].w * v[j].w); }
        const float r = rsqrtf(wave_sum(s) * (1.f / D) + EPS);
        v2u* o8 = (v2u*)(H + (size_t)m * D) + lane;
#pragma unroll
        for (int j = 0; j < 4; ++j) { v2u w; w.x = pk2(v[j].x * r * gv[j].x, v[j].y * r * gv[j].y); w.y = pk2(v[j].z * r * gv[j].z, v[j].w * r * gv[j].w); o8[64 * j] = w; }
    }
}

__device__ __forceinline__ const bf16* proj_tile(const Args& a, int tile) { return (const bf16*)(a.ws + WS_PROJ + (size_t)tile * PROJ_TILE); }
#define DPPF(x_, ctrl_) __int_as_float(__builtin_amdgcn_update_dpp(0, __float_as_int(x_), ctrl_, 0xF, 0xF, true))
__device__ __forceinline__ void p2_prep(const Args& a, const Ctx& c) {
    const int lane = c.lane, gw = c.vcu * NWAVES + c.wave, NGW = c.G * NWAVES;
    float invf = 0.f;
    if (lane < 8) invf = (float)pow(500000.0, -(double)lane / 8.0); else if (lane < 12) invf = (float)pow(500000.0, -(double)(lane - 8) / 4.0);
    float gq[8], gk[8];
#pragma unroll
    for (int i = 0; i < 8; ++i) { gq[i] = a.in[IN_GQ][8 * (lane & 7) + i]; gk[i] = a.in[IN_GK][8 * (lane & 7) + i]; }
    const int* pos = (const int*)a.in[IN_POS];
    unsigned char* dout = (unsigned char*)a.out;
    bf16* AQN = (bf16*)(dout + DO_AQN); bf16* KN = (bf16*)(dout + DO_KN); bf16* IQR = (bf16*)(dout + DO_IQR); bf16* IKR = (bf16*)(dout + DO_IKR);
    const int l7 = lane & 7;
    for (int t = gw; t < T; t += NGW) {
        const float ang = (float)pos[t] * invf;
        const double rev = (double)ang * 0.15915494309189535; const float frv = (float)(rev - __builtin_rint(rev));
        float cs = __builtin_amdgcn_cosf(frv), sn = __builtin_amdgcn_sinf(frv);
        float ca[8], sa[8], ci[4], si[4];
#pragma unroll
        for (int i = 0; i < 8; ++i) { ca[i] = __int_as_float(__builtin_amdgcn_readlane(__float_as_int(cs), i)); sa[i] = __int_as_float(__builtin_amdgcn_readlane(__float_as_int(sn), i)); }
#pragma unroll
        for (int i = 0; i < 4; ++i) { ci[i] = __int_as_float(__builtin_amdgcn_readlane(__float_as_int(cs), 8 + i)); si[i] = __int_as_float(__builtin_amdgcn_readlane(__float_as_int(sn), 8 + i)); }
        { const int col = (lane >> 3) * 64 + 8 * l7; const bf16* src = proj_tile(a, TL_AQ + (col >> 8)) + (size_t)t * 256 + (col & 255);
          float f[8]; unpack8(*(const v4u*)src, f); float ss = 0.f;
#pragma unroll
          for (int i = 0; i < 8; ++i) ss += f[i] * f[i];
          ss += DPPF(ss, 0xB1); ss += DPPF(ss, 0x4E); ss += DPPF(ss, 0x141);
          const float r = rsqrtf(ss * (1.f / 64.f) + EPS);
#pragma unroll
          for (int i = 0; i < 8; ++i) f[i] = f[i] * r * gq[i];
          float o[8];
#pragma unroll
          for (int i = 0; i < 8; ++i) { const float p = DPPF(f[i], 0xB1); o[i] = (l7 == 0) ? (f[i] * ca[i] - p * sa[i]) : ((l7 == 1) ? (f[i] * ca[i] + p * sa[i]) : f[i]); o[i] *= 0.125f * 1.4426950408889634f; }
          *(v4u*)(AQN + (size_t)t * 512 + col) = pack8(o); }
        { const int l15 = lane & 15; const int col = (l15 >> 3) * 64 + 8 * l7; const bf16* src = proj_tile(a, TL_KV) + (size_t)t * 256 + col;
          float f[8]; unpack8(*(const v4u*)src, f); float ss = 0.f;
#pragma unroll
          for (int i = 0; i < 8; ++i) ss += f[i] * f[i];
          ss += DPPF(ss, 0xB1); ss += DPPF(ss, 0x4E); ss += DPPF(ss, 0x141);
          const float r = rsqrtf(ss * (1.f / 64.f) + EPS);
#pragma unroll
          for (int i = 0; i < 8; ++i) f[i] = f[i] * r * gk[i];
          float o[8];
#pragma unroll
          for (int i = 0; i < 8; ++i) { const float p = DPPF(f[i], 0xB1); o[i] = (l7 == 0) ? (f[i] * ca[i] - p * sa[i]) : ((l7 == 1) ? (f[i] * ca[i] + p * sa[i]) : f[i]); }
          if (lane < 16) *(v4u*)(KN + (size_t)t * 128 + col) = pack8(o); }
        { const bf16* src = proj_tile(a, TL_IQ) + (size_t)t * 256 + 4 * lane; const v2u rw = *(const v2u*)src;
          float f[4] = {bf2f(rw.x & 0xffffu), bf2f(rw.x >> 16), bf2f(rw.y & 0xffffu), bf2f(rw.y >> 16)}; float o[4];
#pragma unroll
          for (int i = 0; i < 4; ++i) { const float p = DPPF(f[i], 0xB1); o[i] = (l7 == 0) ? (f[i] * ci[i] - p * si[i]) : ((l7 == 1) ? (f[i] * ci[i] + p * si[i]) : f[i]); }
          v2u w; w.x = pk2(o[0], o[1]); w.y = pk2(o[2], o[3]); *(v2u*)(IQR + (size_t)t * 256 + 4 * lane) = w; }
        { const bf16* src = proj_tile(a, TL_SM) + (size_t)t * 256 + 4 * l7; const v2u rw = *(const v2u*)src;
          float f[4] = {bf2f(rw.x & 0xffffu), bf2f(rw.x >> 16), bf2f(rw.y & 0xffffu), bf2f(rw.y >> 16)}; float o[4];
#pragma unroll
          for (int i = 0; i < 4; ++i) { const float p = DPPF(f[i], 0xB1); o[i] = (l7 == 0) ? (f[i] * ci[i] - p * si[i]) : ((l7 == 1) ? (f[i] * ci[i] + p * si[i]) : f[i]); }
          v2u w; w.x = pk2(o[0], o[1]); w.y = pk2(o[2], o[3]); if (lane < 8) *(v2u*)(IKR + (size_t)t * 32 + 4 * l7) = w; }
    }
}
constexpr int ML_QS = 0, ML_KS = 17408, ML_HS = 0;
constexpr int ML_KWT = 34816;
constexpr int ML_VT = 53248;
constexpr int ML_SW = 73984;
constexpr int ML_CT = 83200;
constexpr int ML_GA = 122368;
constexpr int ML_CW = ML_GA + 1024;
constexpr int ML_END = ML_CW + (1024 + 384) * 4;
static_assert(ML_END <= MISC_OFF, "mLSTM LDS map");
constexpr size_t ML_STATE_BYTES = 8 * 9 * 64 * 16;
__device__ __forceinline__ bf16x8 lds_frag(const LAS unsigned char* base, int stride_b, int row0, int kb, int lane) {
    return *(const LAS bf16x8*)(base + (row0 + (lane & 15)) * stride_b + kb + (lane >> 4) * 16);
}
__device__ __forceinline__ bf16x8 lds_frag_sw(const LAS unsigned char* base, int row0, int ks, int lane) {
    const int row = row0 + (lane & 15); return *(const LAS bf16x8*)(base + row * 144 + 16 * (((ks * 4 + (lane >> 4)) + (row >> 3)) & 7));
}
#define MFMA16(a_, b_, c_) __builtin_amdgcn_mfma_f32_16x16x32_bf16(a_, b_, c_, 0, 0, 0)
template <int MODE>
__device__ __forceinline__ void mlstm_unit(const Args& a, const Ctx& c, int b, int h, int g) {
    const int tid = c.tid, wave = c.wave; LAS unsigned char* lds = c.lds;
#define ML_LAUNDER() int tv_ = tid; asm volatile("" : "+v"(tv_)); const int lane = tv_ & 63, seg = tv_ & 15, r2 = (tv_ >> 4) * 2; (void)lane; (void)seg; (void)r2
    const bf16* PQ = proj_tile(a, TL_MQ + (h >> 1)) + (h & 1) * 128;
    const bf16* PK = proj_tile(a, TL_MK + (h >> 1)) + (h & 1) * 128;
    const bf16* PV = proj_tile(a, TL_MV + (h >> 1)) + (h & 1) * 128;
    const bf16* PO = proj_tile(a, TL_MO + (h >> 1)) + (h & 1) * 128;
    const bf16* PS = proj_tile(a, TL_SM);
    bf16* YML = (bf16*)((unsigned char*)a.out + DO_YML);
    unsigned char* STB = a.ws + WS_MLST; float* MST = (float*)(a.ws + WS_MLST + 256 * ML_STATE_BYTES);
    LAS float* GAa = (LAS float*)(lds + ML_GA); LAS float* GAm = GAa + 64; LAS float* GAw = GAa + 128; LAS float* GAe = GAa + 192;
    LAS float* CWQ = (LAS float*)(lds + ML_CW); LAS float* CWK = CWQ + 512; LAS float* CBQ = CWQ + 1024; LAS float* CBK = CBQ + 128; LAS float* GN = CBK + 128;
    LAS bf16* VTs = (LAS bf16*)(lds + ML_VT);
    { const float* wc = a.in[IN_WCONV]; const int j = tid >> 7, d = tid & 127;
      CWQ[tid] = wc[j * 1024 + h * 128 + d]; CWK[tid] = wc[j * 1024 + 512 + h * 128 + d];
      if (tid < 128) { CBQ[tid] = a.in[IN_BCONV][h * 128 + tid]; CBK[tid] = a.in[IN_BCONV][512 + h * 128 + tid]; GN[tid] = a.in[IN_GML][h * 128 + tid]; } }
    for (int i = tid; i < 16 * 64; i += 512) { const int r = i >> 6, cc = i & 63; VTs[(128 + r) * 72 + cc] = (r == 0) ? (bf16)0x3F80 : (bf16)0; }
    const float big = a.in[IN_BI][h], bfg = a.in[IN_BF][h];
    const int slot0 = (b * 4 + h) * 8;
    f32x4 cacc[9];
    float m_st = 0.f;
    if (MODE == 1 && g > 0) { ML_LAUNDER();
        const f32x4* sp = (const f32x4*)(STB + (size_t)(slot0 + g) * ML_STATE_BYTES) + wave * 576 + lane;
#pragma unroll
        for (int i = 0; i < 9; ++i) cacc[i] = sp[64 * i];
        m_st = MST[slot0 + g];
#pragma unroll
        for (int ee = 0; ee < 9; ++ee) { v2u w; w.x = pk2(cacc[ee][0], cacc[ee][1]); w.y = pk2(cacc[ee][2], cacc[ee][3]);
            *(LAS v2u*)(lds + ML_CT + (ee * 16 + (lane & 15)) * 272 + (wave * 16 + 4 * (lane >> 4)) * 2) = w; }
    } else {
#pragma unroll
        for (int i = 0; i < 9; ++i) cacc[i] = (f32x4){0.f, 0.f, 0.f, 0.f};
        for (int i = tid; i < 144 * 136 / 2; i += 512) ((LAS unsigned*)(lds + ML_CT))[i] = 0u;
    }
    const size_t tb = (size_t)b * SEQ;
    const char* bq = (const char*)(PQ + tb * 256); const char* bk = (const char*)(PK + tb * 256); const char* bv = (const char*)(PV + tb * 256); const char* bo = (const char*)(PO + tb * 256); const char* bs = (const char*)(PS + tb * 256);
    v4u rq[5], rk[5], rv[2]; unsigned short gi = 0, gf = 0;
#define ML_LOAD(kc) do { _Pragma("unroll") for (int j_ = 0; j_ < 5; ++j_) { const int rr_ = 64 * (kc) + r2 - 3 + j_; const unsigned o_ = (unsigned)((rr_ < 0 ? 0 : rr_) * 512 + seg * 16); \
            v4u q_ = (v4u){0u, 0u, 0u, 0u}; if (MODE == 1) q_ = *(const v4u*)(bq + o_); v4u k_ = *(const v4u*)(bk + o_); if (rr_ < 0) { q_ = (v4u){0u, 0u, 0u, 0u}; k_ = q_; } rq[j_] = q_; rk[j_] = k_; } \
        _Pragma("unroll") for (int i_ = 0; i_ < 2; ++i_) rv[i_] = *(const v4u*)(bv + (unsigned)((64 * (kc) + r2 + i_) * 512 + seg * 16)); \
        gi = *(const unsigned short*)(bs + (unsigned)((64 * (kc) + lane) * 512 + (40 + h) * 2)); gf = *(const unsigned short*)(bs + (unsigned)((64 * (kc) + lane) * 512 + (44 + h) * 2)); } while (0)
    const int kc0 = (MODE == 1) ? 8 * g : 0, kc1 = (MODE == 1) ? 8 * g + 8 : 56;
    { ML_LAUNDER(); ML_LOAD(kc0); }
    __syncthreads();
#pragma unroll 1
    for (int kc = kc0; kc < kc1; ++kc) {
        float wkv, decay, m_new;
        if (MODE == 0 && kc > 0 && (kc & 7) == 0) { ML_LAUNDER();
            f32x4* sp = (f32x4*)(STB + (size_t)(slot0 + (kc >> 3)) * ML_STATE_BYTES) + wave * 576 + lane;
#pragma unroll
            for (int i = 0; i < 9; ++i) sp[64 * i] = cacc[i];
            if (tid == 0) MST[slot0 + (kc >> 3)] = m_st; }
        { ML_LAUNDER();
        const float fpre = bf2f(gf) + bfg, lf = fminf(fpre, 0.f) - log1pf(__expf(-fabsf(fpre)));
        const float ig = bf2f(gi) + big;
        float bc = lf;
#pragma unroll
        for (int o = 1; o < 64; o <<= 1) { const float v = __shfl_up(bc, o); if (lane >= o) bc += v; }
        const float av = ig - bc; float Ac = av;
#pragma unroll
        for (int o = 1; o < 64; o <<= 1) { const float v = __shfl_up(Ac, o); if (lane >= o) Ac = fmaxf(Ac, v); }
        const float mA = fmaxf(m_st, Ac), Mk = __shfl(mA, 63), blast = __shfl(bc, 63);
        wkv = __expf(av - Mk); decay = __expf(m_st - Mk); m_new = blast + Mk;
        if (MODE == 1 && wave == 0) { GAa[lane] = av; GAm[lane] = mA; GAw[lane] = __expf(m_st - mA); GAe[lane] = __expf(-(bc + mA)); } }
        { ML_LAUNDER(); float kw_[2][8];
#pragma unroll
          for (int i = 0; i < 2; ++i) { const int t = r2 + i; const float wkt = __shfl(wkv, t);
            float aq_[8], ak_[8];
            { const f32x4 b0 = *(const LAS f32x4*)(CBQ + seg * 8), b1 = *(const LAS f32x4*)(CBQ + seg * 8 + 4), c0 = *(const LAS f32x4*)(CBK + seg * 8), c1 = *(const LAS f32x4*)(CBK + seg * 8 + 4);
              aq_[0] = b0[0]; aq_[1] = b0[1]; aq_[2] = b0[2]; aq_[3] = b0[3]; aq_[4] = b1[0]; aq_[5] = b1[1]; aq_[6] = b1[2]; aq_[7] = b1[3];
              ak_[0] = c0[0]; ak_[1] = c0[1]; ak_[2] = c0[2]; ak_[3] = c0[3]; ak_[4] = c1[0]; ak_[5] = c1[1]; ak_[6] = c1[2]; ak_[7] = c1[3]; }
#pragma unroll
            for (int j = 0; j < 4; ++j) { float fk_[8]; unpack8(rk[i + j], fk_);
                const f32x4 x0 = *(const LAS f32x4*)(CWK + j * 128 + seg * 8), x1 = *(const LAS f32x4*)(CWK + j * 128 + seg * 8 + 4);
#pragma unroll
                for (int e = 0; e < 4; ++e) { ak_[e] += x0[e] * fk_[e]; ak_[4 + e] += x1[e] * fk_[4 + e]; }
                if (MODE == 1) { float fq_[8]; unpack8(rq[i + j], fq_);
                    const f32x4 w0 = *(const LAS f32x4*)(CWQ + j * 128 + seg * 8), w1 = *(const LAS f32x4*)(CWQ + j * 128 + seg * 8 + 4);
#pragma unroll
                    for (int e = 0; e < 4; ++e) { aq_[e] += w0[e] * fq_[e]; aq_[4 + e] += w1[e] * fq_[4 + e]; } } }
#pragma unroll
            for (int e = 0; e < 8; ++e) { ak_[e] = ak_[e] * sigm(ak_[e]) * 0.08838834764831845f; kw_[i][e] = ak_[e] * wkt; }
            if (MODE == 1) {
#pragma unroll
                for (int e = 0; e < 8; ++e) aq_[e] = aq_[e] * sigm(aq_[e]);
                *(LAS v4u*)(lds + ML_QS + t * 272 + seg * 16) = pack8(aq_);
                *(LAS v4u*)(lds + ML_KS + t * 272 + seg * 16) = pack8(ak_); } }
          const unsigned va[4] = {rv[0].x, rv[0].y, rv[0].z, rv[0].w}, vb[4] = {rv[1].x, rv[1].y, rv[1].z, rv[1].w};
          const int swo = 16 * (((r2 >> 3) + seg) & 7) + 2 * (r2 & 7);
#pragma unroll
          for (int e = 0; e < 8; ++e) { const int ro = (seg * 8 + e) * 144 + swo;
              *(LAS unsigned*)(lds + ML_KWT + ro) = pk2(kw_[0][e], kw_[1][e]);
              const unsigned lo = (e & 1) ? (va[e >> 1] >> 16) : (va[e >> 1] & 0xffffu), hi = (e & 1) ? (vb[e >> 1] >> 16) : (vb[e >> 1] & 0xffffu);
              *(LAS unsigned*)(lds + ML_VT + ro) = lo | (hi << 16); }
        if (kc + 1 < kc1) ML_LOAD(kc + 1); }
        __syncthreads();
        f32x4 hacc[5]; unsigned mo_r[8];
        const int tt = wave & 3, t0 = tt * 16, ne = (wave < 4) ? 5 : 4, e_first = (wave < 4) ? 0 : 5;
        if (MODE == 1) {
        { ML_LAUNDER(); const int tq = t0 + (lane & 15);
        bf16x8 qf[4];
#pragma unroll
        for (int ks = 0; ks < 4; ++ks) qf[ks] = lds_frag(lds + ML_QS, 272, t0, ks * 64, lane);
        const float mAt = GAm[tq], wit = GAw[tq];
#pragma unroll
        for (int si = 0; si < 2; ++si) { const int ss = 2 * (wave >> 2) + si, s0 = ss * 16; f32x4 sacc = (f32x4){0.f, 0.f, 0.f, 0.f};
            if (ss <= tt) {
#pragma unroll
                for (int ks = 0; ks < 4; ++ks) sacc = MFMA16(lds_frag(lds + ML_KS, 272, s0, ks * 64, lane), qf[ks], sacc);
#pragma unroll
                for (int r = 0; r < 4; ++r) { const int s = s0 + 4 * (lane >> 4) + r; sacc[r] = (s <= tq) ? sacc[r] * __expf(GAa[s] - mAt) : 0.f; } }
            v2u w; w.x = pk2(sacc[0], sacc[1]); w.y = pk2(sacc[2], sacc[3]);
            *(LAS v2u*)(lds + ML_SW + tq * 144 + s0 * 2 + (lane >> 4) * 8) = w; }
#pragma unroll
        for (int i = 0; i < 5; ++i) { hacc[i] = (f32x4){0.f, 0.f, 0.f, 0.f};
            if (i < ne) {
#pragma unroll
                for (int ks = 0; ks < 4; ++ks) hacc[i] = MFMA16(lds_frag(lds + ML_CT, 272, (e_first + i) * 16, ks * 64, lane), qf[ks], hacc[i]);
                hacc[i] = hacc[i] * wit; } }
#pragma unroll
        for (int i = 0; i < 8; ++i) mo_r[i] = *(const unsigned*)(bo + (unsigned)((64 * kc + 8 * wave + i) * 512 + 4 * lane)); }
        __syncthreads();
        { ML_LAUNDER(); const int tq = t0 + (lane & 15); bf16x8 swf[2];
#pragma unroll
          for (int ks = 0; ks < 2; ++ks) swf[ks] = lds_frag(lds + ML_SW, 144, t0, ks * 64, lane);
#pragma unroll
          for (int i = 0; i < 5; ++i) if (i < ne) { const int ee = e_first + i;
#pragma unroll
              for (int ks = 0; ks < 2; ++ks) hacc[i] = MFMA16(lds_frag_sw(lds + ML_VT, ee * 16, ks, lane), swf[ks], hacc[i]);
              if (ee < 8) *(LAS f32x4*)(lds + ML_HS + tq * 528 + (ee * 16 + 4 * (lane >> 4)) * 4) = hacc[i];
              else if ((lane >> 4) == 0) *(LAS float*)(lds + ML_HS + tq * 528 + 128 * 4) = hacc[i][0]; } }
        }
        { ML_LAUNDER(); const int d0 = wave * 16; bf16x8 kwf[2];
#pragma unroll
          for (int ks = 0; ks < 2; ++ks) kwf[ks] = lds_frag_sw(lds + ML_KWT, d0, ks, lane);
#pragma unroll
          for (int ee = 0; ee < 9; ++ee) { cacc[ee] = cacc[ee] * decay;
#pragma unroll
              for (int ks = 0; ks < 2; ++ks) cacc[ee] = MFMA16(kwf[ks], lds_frag_sw(lds + ML_VT, ee * 16, ks, lane), cacc[ee]);
              if (MODE == 1) { v2u w; w.x = pk2(cacc[ee][0], cacc[ee][1]); w.y = pk2(cacc[ee][2], cacc[ee][3]);
                  *(LAS v2u*)(lds + ML_CT + (ee * 16 + (lane & 15)) * 272 + (d0 + 4 * (lane >> 4)) * 2) = w; } } }
        __syncthreads();
        if (MODE == 1) {
        { ML_LAUNDER();
#pragma unroll
        for (int i = 0; i < 8; ++i) { const int t = 8 * wave + i;
            const f32x2 nv = *(const LAS f32x2*)(lds + ML_HS + t * 528 + lane * 8); const float den = *(const LAS float*)(lds + ML_HS + t * 528 + 512);
            const float dd = fmaxf(fabsf(den), GAe[t]); const float h0 = nv.x / dd, h1 = nv.y / dd;
            const float r = rsqrtf(wave_sum(h0 * h0 + h1 * h1) * (1.f / 128.f) + EPS);
            const float y0 = h0 * r * GN[2 * lane] * sigm(bf2f(mo_r[i] & 0xffffu)), y1 = h1 * r * GN[2 * lane + 1] * sigm(bf2f(mo_r[i] >> 16));
            *(unsigned*)(YML + (tb + 64 * kc + t) * 512 + h * 128 + 2 * lane) = pk2(y0, y1); } }
        __syncthreads();
        }
        m_st = m_new;
    }
    if (MODE == 0) { ML_LAUNDER();
        f32x4* sp = (f32x4*)(STB + (size_t)(slot0 + 7) * ML_STATE_BYTES) + wave * 576 + lane;
#pragma unroll
        for (int i = 0; i < 9; ++i) sp[64 * i] = cacc[i];
        if (tid == 0) MST[slot0 + 7] = m_st; }
#undef ML_LOAD
#undef ML_LAUNDER
}
constexpr int AT_HIST = 0;
constexpr int AT_HROW = 2049;
constexpr int AT_SEL = 131072 + 256;
constexpr int AT_MROW = 129;
constexpr int AT_SM = AT_SEL + 8448;
static_assert(AT_SM + 256 <= MISC_OFF, "attention LDS map");
__device__ __forceinline__ unsigned score_key(float s) { unsigned u = __float_as_uint(s + 0.0f); return (u & 0x80000000u) ? ~u : (u | 0x80000000u); }
template <int NK> __device__ __forceinline__ void at_resolve(const LAS unsigned long long* cand, LAS unsigned* mask, int m, int nd, int lane) {
    unsigned long long cv[NK];
#pragma unroll
    for (int k = 0; k < NK; ++k) { const int i = 64 * k + lane; unsigned long long x = 0ull; if (i < m) x = cand[i]; cv[k] = (i < m) ? ((((x >> 32) & 0xFFFFFull) << 16) | (x & 0xFFFFull)) : 0ull; }
    unsigned long long T = 0ull;
#pragma unroll 1
    for (int bit = 35; bit >= 16; --bit) { const unsigned long long test = T | (1ull << bit); int cge = 0;
#pragma unroll
        for (int k = 0; k < NK; ++k) cge += __popcll(__ballot(cv[k] >= test));
        if (cge >= nd) T = test; }
    int g = 0, t = 0;
#pragma unroll
    for (int k = 0; k < NK; ++k) { g += __popcll(__ballot(cv[k] >= T + 0x10000ull)); t += __popcll(__ballot(cv[k] >= T)); }
    t -= g;
    if (t > nd - g) {
#pragma unroll 1
        for (int bit = 15; bit >= 0; --bit) { const unsigned long long test = T | (1ull << bit); int cge = 0;
#pragma unroll
            for (int k = 0; k < NK; ++k) cge += __popcll(__ballot(cv[k] >= test));
            if (cge >= nd) T = test; } }
#pragma unroll
    for (int k = 0; k < NK; ++k) if (cv[k] >= T && cv[k] != 0ull) { const unsigned key = 0xFFFFu - (unsigned)(cv[k] & 0xFFFFull);
        __hip_atomic_fetch_or(&mask[key >> 5], 1u << (key & 31u), __ATOMIC_RELAXED, __HIP_MEMORY_SCOPE_WORKGROUP); }
}
__device__ __forceinline__ void attn_unit(const Args& a, const Ctx& c, int b, int qt) {
    const int tid = c.tid, wave = c.wave; LAS unsigned char* lds = c.lds;
#define AT_LAUNDER() int tv_ = tid; asm volatile("" : "+v"(tv_)); const int lane = tv_ & 63, qi = tv_ & 15, fq = (tv_ >> 4) & 3; (void)lane; (void)qi; (void)fq
    const int q0 = qt * 16, ch = q0 >> 6, n = 64 * (ch + 1), ntiles = n >> 4;
    const size_t tb = (size_t)b * SEQ;
    unsigned char* dout = (unsigned char*)a.out;
    const bf16* AQN = (const bf16*)(dout + DO_AQN); const bf16* KN = (const bf16*)(dout + DO_KN); const bf16* IQR = (const bf16*)(dout + DO_IQR); const bf16* IKR = (const bf16*)(dout + DO_IKR);
    bf16* YATT = (bf16*)(dout + DO_YATT);
    const bf16* VB = proj_tile(a, TL_KV); const bf16* PS = proj_tile(a, TL_SM);
    LAS unsigned* HIST = (LAS unsigned*)(lds + AT_HIST);
    LAS unsigned long long* CAND = (LAS unsigned long long*)(lds + AT_HIST);
    LAS unsigned* MASK = (LAS unsigned*)(lds + AT_SEL);
    LAS int* SM = (LAS int*)(lds + AT_SM);
    float* SC = (blockIdx.x < 240) ? (float*)(a.ws + WS_SC) + (size_t)blockIdx.x * (16 * 4096) : (float*)(a.ws + WS_SC2) + (size_t)(blockIdx.x - 240) * (16 * 4096);
#ifndef DBG_REP_SEL
#define DBG_REP_SEL 1
#endif
#ifndef DBG_REP_DENSE
#define DBG_REP_DENSE 1
#endif
#pragma unroll 1
    for (int rsel = 0; rsel < DBG_REP_SEL; ++rsel) {
    if (n > 256) {
        for (int i = tid; i < 8192 + 4; i += 512) ((LAS v4u*)HIST)[i] = (v4u){0u, 0u, 0u, 0u};
        if (tid < 64) SM[tid] = 0;
        for (int i = tid; i < 16 * AT_MROW; i += 512) MASK[i] = 0u;
        bf16x8 qf[8]; float wv[8];
        { AT_LAUNDER();
        const size_t trow = tb + q0 + qi;
#pragma unroll
        for (int h = 0; h < 8; ++h) qf[h] = *(const bf16x8*)(IQR + trow * 256 + h * 32 + 8 * fq);
        { float t8[8]; unpack8(*(const v4u*)(PS + trow * 256 + 32), t8);
#pragma unroll
          for (int h = 0; h < 8; ++h) wv[h] = t8[h] * 0.0625f; } }
        __syncthreads();
#define AT_LOADK(kt_) (*(const bf16x8*)(IKR + (tb + (size_t)(kt_) * 16 + qi) * 32 + 8 * fq))
#define AT_SCORES(kf_, sc_) do { \
        _Pragma("unroll") for (int r_ = 0; r_ < 4; ++r_) sc_[r_] = 0.f; \
        _Pragma("unroll") for (int h_ = 0; h_ < 8; ++h_) { const f32x4 d_ = MFMA16(kf_, qf[h_], ((f32x4){0.f, 0.f, 0.f, 0.f})); \
            _Pragma("unroll") for (int r_ = 0; r_ < 4; ++r_) { const int di_ = __float_as_int(d_[r_]); sc_[r_] = __builtin_fmaf(wv[h_], __int_as_float(di_ > 0 ? di_ : 0), sc_[r_]); } } } while (0)
        const int cnt = (ntiles - wave + 7) >> 3;
#ifndef DBG_RA
#define DBG_RA 1
#endif
#pragma unroll 1
        for (int rA = 0; rA < DBG_RA; ++rA) { if (rA) { for (int i = tid; i < 8192 + 4; i += 512) ((LAS v4u*)HIST)[i] = (v4u){0u, 0u, 0u, 0u}; __syncthreads(); }
#define AT_LOADG(dst_, i0_) do { _Pragma("unroll") for (int j_ = 0; j_ < 8; ++j_) { int kt_ = wave + 8 * ((i0_) + j_); kt_ = kt_ < ntiles ? kt_ : ntiles - 1; dst_[j_] = AT_LOADK(kt_); } } while (0)
        { AT_LAUNDER(); bf16x8 kcur[8], knxt[8]; AT_LOADG(kcur, 0);
#pragma unroll 1
          for (int i0 = 0; i0 < cnt; i0 += 8) {
            if (i0 + 8 < cnt) AT_LOADG(knxt, i0 + 8);
#pragma unroll
            for (int j2 = 0; j2 < 8; ++j2) { const bool valid = (i0 + j2 < cnt); const int kt = wave + 8 * (i0 + j2); float sc[4]; AT_SCORES(kcur[j2], sc);
                if (valid) *(f32x4*)(SC + qi * 4096 + kt * 16 + 4 * fq) = (f32x4){sc[0], sc[1], sc[2], sc[3]};
#pragma unroll
                for (int r = 0; r < 4; ++r) { const unsigned bin = score_key(sc[r]) >> 20;
                    __hip_atomic_fetch_add(&HIST[qi * AT_HROW + (bin >> 1)], valid ? (1u << ((bin & 1u) * 16)) : 0u, __ATOMIC_RELAXED, __HIP_MEMORY_SCOPE_WORKGROUP); } }
#pragma unroll
            for (int j2 = 0; j2 < 8; ++j2) kcur[j2] = knxt[j2]; } }
        __syncthreads();
        }
#ifndef DBG_RB
#define DBG_RB 1
#endif
#pragma unroll 1
        for (int rB = 0; rB < DBG_RB; ++rB) {
#pragma unroll 1
        for (int j = 0; j < 2; ++j) { AT_LAUNDER(); const int q = 2 * wave + j; unsigned tot = 0;
            for (int i = 0; i < 32; ++i) { const unsigned w = HIST[q * AT_HROW + 32 * lane + ((i + lane) & 31)]; tot += (w & 0xffffu) + (w >> 16); }
            unsigned suf = tot;
#pragma unroll
            for (int o = 1; o < 64; o <<= 1) { const unsigned v = __shfl_down(suf, o); if (lane + o < 64) suf += v; }
            const unsigned long long mk = __ballot(suf >= 256u); const int L = 63 - __clzll((long long)mk);
            const unsigned above_L = __shfl(suf - tot, L);
            const unsigned w2 = HIST[q * AT_HROW + 32 * L + (lane >> 1)]; const unsigned cb = (lane & 1) ? (w2 >> 16) : (w2 & 0xffffu);
            unsigned sfx = cb;
#pragma unroll
            for (int o = 1; o < 64; o <<= 1) { const unsigned v = __shfl_down(sfx, o); if (lane + o < 64) sfx += v; }
            const unsigned long long mk2 = __ballot(above_L + sfx >= 256u); const int l2 = 63 - __clzll((long long)mk2);
            if (lane == l2) { SM[q] = 64 * L + l2; SM[16 + q] = (int)(256u - (above_L + sfx - cb)); } }
        __syncthreads();
        }
#ifndef DBG_RC
#define DBG_RC 1
#endif
#pragma unroll 1
        for (int rC = 0; rC < DBG_RC; ++rC) { if (rC) { if (tid < 16) SM[48 + tid] = 0; __syncthreads(); }
        { AT_LAUNDER(); const int Bq = SM[qi]; f32x4 scur[8], snxt[8];
#define AT_LOADS(dst_, i0_) do { _Pragma("unroll") for (int j_ = 0; j_ < 8; ++j_) { int kt_ = wave + 8 * ((i0_) + j_); kt_ = kt_ < ntiles ? kt_ : ntiles - 1; dst_[j_] = *(const f32x4*)(SC + qi * 4096 + kt_ * 16 + 4 * fq); } } while (0)
          AT_LOADS(scur, 0);
#pragma unroll 1
          for (int i0 = 0; i0 < cnt; i0 += 8) {
            if (i0 + 8 < cnt) AT_LOADS(snxt, i0 + 8);
#pragma unroll
            for (int j2 = 0; j2 < 8; ++j2) { const bool valid = (i0 + j2 < cnt); const int kt = wave + 8 * (i0 + j2);
                unsigned nib = 0u, cnib = 0u; unsigned uu[4];
#pragma unroll
                for (int r = 0; r < 4; ++r) { uu[r] = score_key(scur[j2][r]); const int bin = (int)(uu[r] >> 20); nib |= (bin > Bq) ? (1u << r) : 0u; cnib |= (bin == Bq) ? (1u << r) : 0u; }
                if (!valid) { nib = 0u; cnib = 0u; }
                if (cnib) {
                    int p = __hip_atomic_fetch_add(&SM[48 + qi], (int)__popc(cnib), __ATOMIC_RELAXED, __HIP_MEMORY_SCOPE_WORKGROUP);
#pragma unroll
                    for (int r = 0; r < 4; ++r) if ((cnib >> r) & 1u) { if (p < 512) CAND[qi * 1024 + p] = ((unsigned long long)uu[r] << 32) | (unsigned long long)(0xFFFFu - (unsigned)(kt * 16 + 4 * fq + r)); ++p; } }
                if (nib) __hip_atomic_fetch_or(&MASK[qi * AT_MROW + (kt >> 1)], nib << (16 * (kt & 1) + 4 * fq), __ATOMIC_RELAXED, __HIP_MEMORY_SCOPE_WORKGROUP); }
#pragma unroll
            for (int j2 = 0; j2 < 8; ++j2) scur[j2] = snxt[j2]; } }
#undef AT_LOADS
        __syncthreads();
        }
#ifndef DBG_RD
#define DBG_RD 1
#endif
#pragma unroll 1
        for (int rD = 0; rD < DBG_RD; ++rD) {
#pragma unroll 1
        for (int j = 0; j < 2; ++j) { AT_LAUNDER(); const int q = 2 * wave + j; int m = SM[48 + q]; m = m < 512 ? m : 512; const int nd = SM[16 + q];
            if (m <= 256) at_resolve<4>(CAND + q * 1024, MASK + q * AT_MROW, m, nd, lane); else at_resolve<8>(CAND + q * 1024, MASK + q * AT_MROW, m, nd, lane); }
        __syncthreads();
        }
#undef AT_SCORES
#undef AT_LOADK
#undef AT_LOADG
    } else {
#pragma unroll 1
        for (int i = tid; i < 16 * AT_MROW; i += 512) MASK[i] = ((i % AT_MROW) < (n >> 5)) ? 0xFFFFFFFFu : 0u;
        __syncthreads();
    }
    }
#pragma unroll 1
    for (int rden = 0; rden < DBG_REP_DENSE; ++rden) {
    { const int g = wave >> 2, kh = (wave >> 1) & 1, hp = wave & 1, NS = n >> 6;
      float cshift;
      { AT_LAUNDER(); float gq = fabsf(a.in[IN_GQ][lane]), gk = fabsf(a.in[IN_GK][lane]);
#pragma unroll
        for (int o = 1; o < 64; o <<= 1) { gq = fmaxf(gq, __shfl_xor(gq, o)); gk = fmaxf(gk, __shfl_xor(gk, o)); }
        cshift = 8.0f * 1.4426950408889634f * gq * gk; }
      const unsigned ring0 = (unsigned)(size_t)(lds + AT_HIST);
      const bf16* dsrc[4]; unsigned ddst[4];
      { AT_LAUNDER();
#pragma unroll
        for (int i_ = 0; i_ < 4; ++i_) { const int in_ = 4 * wave + i_; const int row_ = 4 * (in_ & 15) + (lane >> 4), pos_ = lane & 15;
            dsrc[i_] = (in_ < 16) ? (KN + (tb + row_) * 128 + ((pos_ ^ (row_ & 15)) << 3)) : (VB + (tb + row_) * 256 + 128 + ((pos_ ^ (2 * (row_ & 7))) << 3));
            ddst[i_] = (unsigned)(in_ * 1024); } }
      const size_t dstep = (wave < 4) ? (size_t)64 * 128 : (size_t)64 * 256;
#define AT_STAGE(s_) do { const unsigned sb_ = ring0 + (unsigned)(((s_) & 3) * 32768); \
        _Pragma("unroll") for (int i_ = 0; i_ < 4; ++i_) { const bf16* src_ = dsrc[i_] + (size_t)(s_) * dstep; \
            const unsigned dst_ = __builtin_amdgcn_readfirstlane(sb_ + ddst[i_]); unsigned keep_; \
            asm volatile("s_mov_b32 %0, m0\n\ts_mov_b32 m0, %2\n\ts_nop 0\n\tglobal_load_lds_dwordx4 %1, off\n\ts_mov_b32 m0, %0" : "=&s"(keep_) : "v"(src_), "s"(dst_) : "memory"); } } while (0)
      bf16x8 qa[2], qb[2]; f32x4 oacc[2][4], lacc[2];
      { AT_LAUNDER();
#pragma unroll
        for (int hi = 0; hi < 2; ++hi) { const bf16* qp = AQN + (tb + q0 + qi) * 512 + (g * 4 + 2 * hp + hi) * 64 + 8 * fq; qa[hi] = *(const bf16x8*)qp; qb[hi] = *(const bf16x8*)(qp + 32); } }
#pragma unroll
      for (int hi = 0; hi < 2; ++hi) { lacc[hi] = (f32x4){0.f, 0.f, 0.f, 0.f};
#pragma unroll
        for (int dt = 0; dt < 4; ++dt) oacc[hi][dt] = (f32x4){0.f, 0.f, 0.f, 0.f}; }
      const bf16x8 ones = (bf16x8){0x3F80, 0x3F80, 0x3F80, 0x3F80, 0x3F80, 0x3F80, 0x3F80, 0x3F80};
      asm volatile("s_waitcnt vmcnt(0)" ::: "memory");
#pragma unroll 1
      for (int s = 0; s < 3 && s < NS; ++s) AT_STAGE(s);
      typedef short s4_t __attribute__((ext_vector_type(4)));
      AT_LAUNDER();
#pragma unroll 1
      for (int s = 0; s < NS; ++s) {
          if (s + 2 < NS) asm volatile("s_waitcnt vmcnt(8)" ::: "memory"); else asm volatile("s_waitcnt vmcnt(0)" ::: "memory");
          __builtin_amdgcn_s_barrier(); asm volatile("" ::: "memory");
          if (s + 3 < NS) AT_STAGE(s + 3);
          { const LAS unsigned char* kb = lds + AT_HIST + (s & 3) * 32768; const LAS unsigned char* vbs = kb + 16384;
            const unsigned mw = MASK[qi * AT_MROW + 2 * s + kh] >> (4 * fq);
            f32x4 st[2][2];
#pragma unroll
            for (int t = 0; t < 2; ++t) { const int row = 16 * (2 * kh + t) + qi;
                const bf16x8 k0 = *(const LAS bf16x8*)(kb + row * 256 + (((g * 8 + fq) ^ (row & 15)) << 4)), k1 = *(const LAS bf16x8*)(kb + row * 256 + (((g * 8 + 4 + fq) ^ (row & 15)) << 4));
#pragma unroll
                for (int hi = 0; hi < 2; ++hi) { f32x4 d = MFMA16(k0, qa[hi], ((f32x4){0.f, 0.f, 0.f, 0.f})); st[hi][t] = MFMA16(k1, qb[hi], d); } }
            bf16x8 pb[2];
#pragma unroll
            for (int hi = 0; hi < 2; ++hi) { float pv[8];
#pragma unroll
                for (int j = 0; j < 8; ++j) { const float e = __builtin_amdgcn_exp2f(st[hi][j >> 2][j & 3] - cshift);
                    const int keep = __builtin_amdgcn_sbfe((int)mw, 16 * (j >> 2) + (j & 3), 1); pv[j] = __uint_as_float(__float_as_uint(e) & (unsigned)keep); }
                v4u pw; pw.x = pk2(pv[0], pv[1]); pw.y = pk2(pv[2], pv[3]); pw.z = pk2(pv[4], pv[5]); pw.w = pk2(pv[6], pv[7]); pb[hi] = __builtin_bit_cast(bf16x8, pw);
                lacc[hi] = MFMA16(ones, pb[hi], lacc[hi]); }
#pragma unroll
            for (int dt = 0; dt < 4; ++dt) { const int r1 = 32 * kh + 4 * fq + (qi >> 2), r2 = r1 + 16; const int ch = g * 8 + 2 * dt + ((lane & 3) >> 1);
                const s4_t lo = __builtin_amdgcn_ds_read_tr16_b64_v4i16((LAS s4_t*)(vbs + r1 * 256 + ((ch ^ (2 * (r1 & 7))) << 4) + (lane & 1) * 8));
                const s4_t hi4 = __builtin_amdgcn_ds_read_tr16_b64_v4i16((LAS s4_t*)(vbs + r2 * 256 + ((ch ^ (2 * (r2 & 7))) << 4) + (lane & 1) * 8));
                const bf16x8 va = (bf16x8){lo[0], lo[1], lo[2], lo[3], hi4[0], hi4[1], hi4[2], hi4[3]};
#pragma unroll
                for (int hi = 0; hi < 2; ++hi) oacc[hi][dt] = MFMA16(va, pb[hi], oacc[hi][dt]); } } }
      __syncthreads();
      { AT_LAUNDER(); LAS unsigned char* red = lds + AT_HIST + (g * 2 + hp) * 8704;
        if (kh == 1) {
#pragma unroll
            for (int hi = 0; hi < 2; ++hi) {
#pragma unroll
                for (int dt = 0; dt < 4; ++dt) *(LAS f32x4*)(red + (hi * 4 + dt) * 1024 + lane * 16) = oacc[hi][dt];
                *(LAS float*)(red + 8192 + hi * 256 + lane * 4) = lacc[hi][0]; } } }
      __syncthreads();
      if (kh == 0) { AT_LAUNDER(); const LAS unsigned char* red = lds + AT_HIST + (g * 2 + hp) * 8704;
#pragma unroll
        for (int hi = 0; hi < 2; ++hi) { const float inv = 1.0f / (lacc[hi][0] + *(const LAS float*)(red + 8192 + hi * 256 + lane * 4));
            bf16* yp = YATT + (tb + q0 + qi) * 512 + (g * 4 + 2 * hp + hi) * 64 + 4 * fq;
#pragma unroll
            for (int dt = 0; dt < 4; ++dt) { const f32x4 o = oacc[hi][dt] + *(const LAS f32x4*)(red + (hi * 4 + dt) * 1024 + lane * 16);
                v2u w; w.x = pk2(o[0] * inv, o[1] * inv); w.y = pk2(o[2] * inv, o[3] * inv); *(v2u*)(yp + 16 * dt) = w; } } }
#undef AT_STAGE
    }
    __syncthreads();
    }
#undef AT_LAUNDER
    __syncthreads();
}

#ifndef DBG_REP_ML
#define DBG_REP_ML 1
#endif
#ifndef DBG_REP_ATT
#define DBG_REP_ATT 1
#endif
__device__ __forceinline__ void p3_mixer(const Args& a, const Ctx& c, volatile LAS unsigned* MISC, int rep) {
#if !defined(NO_MLSTM)
#pragma unroll 1
    for (int rr = 0; rr < DBG_REP_ML; ++rr)
#pragma unroll 1
        for (int u = blockIdx.x; u < 32; u += c.G) mlstm_unit<0>(a, c, u >> 2, u & 3, 0);
#endif
    unsigned* ctl = (unsigned*)(a.ws + WS_CTL);
    const int x = (int)(__builtin_amdgcn_s_getreg((3 << 11) | 20) & 7u);
#pragma unroll 1
    for (int rot = 0; rot < 8 * DBG_REP_ATT; ++rot) { rep = rot >> 3; const int bq = (x + rot) & 7;
        for (;;) {
            if (c.tid == 0) MISC[16] = __hip_atomic_fetch_add(ctl + CW_Q + 512 * rep + 64 * bq, 1u, RLX_AGENT);
            __syncthreads();
            const int u = (int)MISC[16];
            __syncthreads();
            if (u >= 256) break;
#if defined(DBG_ZERO_ATT)
            { bf16* YA = (bf16*)((unsigned char*)a.out + DO_YATT) + ((size_t)bq * SEQ + (size_t)(255 - u) * 16) * 512; for (int i = c.tid; i < 16 * 512 / 8; i += 512) ((v4u*)YA)[i] = (v4u){0u, 0u, 0u, 0u}; }
#elif !defined(NO_ATTN)
            attn_unit(a, c, bq, 255 - u);
#endif
        } }
}
constexpr int RT_WR = 0;
constexpr int RT_LCNT = 147456;
static_assert(RT_LCNT + 128 <= MISC_OFF, "router LDS map");
__device__ __forceinline__ void p6_router(const Args& a, const Ctx& c) {
    const int tid = c.tid, lane = c.lane, wave = c.wave; LAS unsigned char* lds = c.lds;
    LAS float* WR = (LAS float*)(lds + RT_WR); LAS int* LCNT = (LAS int*)(lds + RT_LCNT);
    for (int i = tid; i < 1024 * 32; i += 512) WR[(i >> 5) * 36 + (i & 31)] = a.in[IN_WRE][i];
    for (int i = tid; i < 1024 * 4; i += 512) WR[(i >> 2) * 36 + 32 + (i & 3)] = a.in[IN_WRG][i];
    float gm[16];
#pragma unroll
    for (int i = 0; i < 16; ++i) gm[i] = a.in[IN_GMOE][lane + 64 * i];
    float be[32], bg[4];
#pragma unroll
    for (int i = 0; i < 32; ++i) be[i] = a.in[IN_BRE][i];
#pragma unroll
    for (int i = 0; i < 4; ++i) bg[i] = a.in[IN_BRG][i];
    { int* RT = (int*)(a.ws + WS_ROWTOK); for (int i = blockIdx.x * 512 + tid; i < NROWS_MAX; i += c.G * 512) RT[i] = 0; }
    const float* X1 = a.out; bf16* XN = (bf16*)(a.ws + WS_XN);
    int* TOKE = (int*)(a.ws + WS_TOKE); int* TOKR = (int*)(a.ws + WS_TOKR); float* TOKG = (float*)(a.ws + WS_TOKG); int* CNT = (int*)(a.ws + WS_CNT);
    __syncthreads();
    for (int blk = blockIdx.x; blk < 256; blk += c.G) {
        if (tid < 32) LCNT[tid] = 0;
        __syncthreads();
#pragma unroll 1
        for (int ri = 0; ri < 16; ++ri) { const int t = blk * 128 + wave * 16 + ri;
            float xv[16]; float ss = 0.f;
#pragma unroll
            for (int i = 0; i < 16; ++i) { xv[i] = X1[(size_t)t * D + lane + 64 * i]; ss += xv[i] * xv[i]; }
            const float r = rsqrtf(wave_sum(ss) * (1.f / D) + EPS);
#pragma unroll
            for (int i = 0; i < 16; ++i) { xv[i] = xv[i] * r * gm[i]; XN[(size_t)t * D + lane + 64 * i] = (bf16)f2bf(xv[i]); }
            float acc[36];
#pragma unroll
            for (int jx = 0; jx < 36; ++jx) acc[jx] = 0.f;
#pragma unroll
            for (int i = 0; i < 16; ++i) { const LAS f32x4* wp = (const LAS f32x4*)(WR + (lane + 64 * i) * 36);
#pragma unroll
                for (int jj = 0; jj < 9; ++jj) { const f32x4 w4 = wp[jj]; acc[4 * jj] += xv[i] * w4[0]; acc[4 * jj + 1] += xv[i] * w4[1]; acc[4 * jj + 2] += xv[i] * w4[2]; acc[4 * jj + 3] += xv[i] * w4[3]; } }
#pragma unroll
            for (int jx = 0; jx < 36; ++jx) acc[jx] = wave_sum(acc[jx]);
            float gl[4];
#pragma unroll
            for (int i = 0; i < 4; ++i) gl[i] = acc[32 + i] + bg[i];
            int gs = 0; float gmax = gl[0];
#pragma unroll
            for (int i = 1; i < 4; ++i) if (gl[i] > gmax) { gmax = gl[i]; gs = i; }
            float gsum = 0.f;
#pragma unroll
            for (int i = 0; i < 4; ++i) gsum += expf(gl[i] - gmax);
            const float gtop = 1.0f / gsum;
            float ev[8];
#pragma unroll
            for (int i = 0; i < 8; ++i) { float v = acc[i] + be[i];
#pragma unroll
                for (int g2 = 1; g2 < 4; ++g2) v = (gs == g2) ? (acc[g2 * 8 + i] + be[g2 * 8 + i]) : v;
                ev[i] = v; }
            int l0 = 0; float v0 = ev[0];
#pragma unroll
            for (int i = 1; i < 8; ++i) if (ev[i] > v0) { v0 = ev[i]; l0 = i; }
            int l1 = -1; float v1 = -3.0e38f;
#pragma unroll
            for (int i = 0; i < 8; ++i) if (i != l0 && ev[i] > v1) { v1 = ev[i]; l1 = i; }
            const float e1 = expf(v1 - v0), s0 = 1.0f / (1.0f + e1), s1 = e1 * s0;
            if (lane == 0) { const int ex0 = gs * 8 + l0, ex1 = gs * 8 + l1;
                const int rk0 = __hip_atomic_fetch_add(&LCNT[ex0], 1, __ATOMIC_RELAXED, __HIP_MEMORY_SCOPE_WORKGROUP);
                const int rk1 = __hip_atomic_fetch_add(&LCNT[ex1], 1, __ATOMIC_RELAXED, __HIP_MEMORY_SCOPE_WORKGROUP);
                TOKE[2 * t] = ex0; TOKE[2 * t + 1] = ex1; TOKR[2 * t] = rk0; TOKR[2 * t + 1] = rk1; TOKG[2 * t] = s0 * gtop; TOKG[2 * t + 1] = s1 * gtop; }
        }
        __syncthreads();
        if (tid < 32) CNT[blk * 32 + tid] = LCNT[tid];
        __syncthreads();
    }
}
__device__ __forceinline__ void p7_gather(const Args& a, const Ctx& c) {
    const int tid = c.tid, lane = c.lane, wave = c.wave;
    LAS int* PART = (LAS int*)c.lds; LAS int* PPRE = PART + 512; LAS int* TOT = PPRE + 512; LAS int* TS = TOT + 32; LAS int* BASE = TS + 64;
    const int* CNT = (const int*)(a.ws + WS_CNT); const int* TOKE = (const int*)(a.ws + WS_TOKE); const int* TOKR = (const int*)(a.ws + WS_TOKR); int* TOKP = (int*)(a.ws + WS_TOKP);
    int* RT = (int*)(a.ws + WS_ROWTOK);
    { const int e = tid & 31, p = tid >> 5; int s = 0; for (int k = 0; k < 16; ++k) s += CNT[(16 * p + k) * 32 + e]; PART[p * 32 + e] = s; }
    __syncthreads();
    if (tid < 32) { int run = 0; for (int p = 0; p < 16; ++p) { PPRE[p * 32 + tid] = run; run += PART[p * 32 + tid]; } TOT[tid] = run; }
    __syncthreads();
    if (tid == 0) { int ts = 0; for (int e = 0; e < 32; ++e) { TS[e] = ts; ts += (TOT[e] + 255) >> 8; } TS[32] = ts; }
    __syncthreads();
    if (blockIdx.x == 0 && tid < 33) ((int*)(a.ws + WS_SMALL))[tid] = TS[tid];
    for (int blk = blockIdx.x; blk < 256; blk += c.G) {
        if (tid < 32) { int s = TS[tid] * 256 + PPRE[(blk >> 4) * 32 + tid]; for (int b2 = (blk & ~15); b2 < blk; ++b2) s += CNT[b2 * 32 + tid]; BASE[tid] = s; }
        __syncthreads();
        { const int t = blk * 128 + (tid >> 2), jj = tid & 3;
          if (jj < 2) { const int pos = BASE[TOKE[2 * t + jj]] + TOKR[2 * t + jj]; TOKP[2 * t + jj] = pos; RT[pos] = t; } }
        __syncthreads();
    }
}
__device__ __forceinline__ void p10_combine(const Args& a, const Ctx& c) {
    const int lane = c.lane, gw = c.vcu * NWAVES + c.wave, NGW = c.G * NWAVES;
    const int* TOKP = (const int*)(a.ws + WS_TOKP); const float* TOKG = (const float*)(a.ws + WS_TOKG); const bf16* Y = (const bf16*)(a.ws + WS_Y);
    for (int t = gw; t < T; t += NGW) { const int p0 = TOKP[2 * t], p1 = TOKP[2 * t + 1]; const float g0 = TOKG[2 * t], g1 = TOKG[2 * t + 1];
#pragma unroll
        for (int j = 0; j < 4; ++j) { f32x4* op = (f32x4*)(a.out + (size_t)t * D + 4 * lane + 256 * j); f32x4 x = *op;
            const v2u y0 = *(const v2u*)(Y + (size_t)p0 * D + 4 * lane + 256 * j), y1 = *(const v2u*)(Y + (size_t)p1 * D + 4 * lane + 256 * j);
            x[0] += g0 * bf2f(y0.x & 0xffffu) + g1 * bf2f(y1.x & 0xffffu); x[1] += g0 * bf2f(y0.x >> 16) + g1 * bf2f(y1.x >> 16);
            x[2] += g0 * bf2f(y0.y & 0xffffu) + g1 * bf2f(y1.y & 0xffffu); x[3] += g0 * bf2f(y0.y >> 16) + g1 * bf2f(y1.y >> 16);
            *op = x; } }
}
__global__ void __launch_bounds__(NWAVES * 64, 2) hybrid_fwd(Args args) {
    extern __shared__ __attribute__((aligned(16))) unsigned char lds_raw[];
    Ctx c; c.lds = (LAS unsigned char*)lds_raw;
    volatile LAS unsigned* MISC = (volatile LAS unsigned*)(c.lds + MISC_OFF);
    c.tid = threadIdx.x; c.lane = c.tid & 63; c.wave = __builtin_amdgcn_readfirstlane(c.tid >> 6);
    c.G = gridDim.x; { const int bx = blockIdx.x; c.vcu = (c.G % 8 == 0) ? (bx % 8) * (c.G / 8) + bx / 8 : bx; }
    unsigned* ctl = (unsigned*)(args.ws + WS_CTL);
    if (c.tid < 128) MISC[c.tid] = 0u;
    __syncthreads();
    XcdBarrier bar; bar.bar = ctl + CW_BAR; bar.x = 0; bar.st = nullptr;
    if (N_LAUNCHES == 1) bar = xcd_barrier_post(ctl + CW_BAR, MISC + 8);
#define GRID_BAR() do { if (N_LAUNCHES == 1) xcd_barrier(bar); } while (0)
    const int lo = args.ph_lo, hi = args.ph_hi;
#ifndef PH_MASK
#define PH_MASK 0xfff
#endif
#define IN(k) (((PH_MASK >> (k)) & 1) && lo <= (k) && (k) < hi)
#define BOTH(k) (IN(k) && IN((k) + 1))
    unsigned char* ws = args.ws; unsigned char* dout = (unsigned char*)args.out;
#ifndef DBG_REPEAT
#define DBG_REPEAT -1
#endif
#define REPS(k) (((k) == DBG_REPEAT) ? 2 : 1)
    if (IN(0)) { _Pragma("unroll") for (int rep = 0; rep < REPS(0); ++rep) { if (rep) GRID_BAR(); p0_prologue<0>(args, c, c.vcu * NWAVES + c.wave, c.G * NWAVES); } if (BOTH(0)) GRID_BAR(); }
    if (IN(1)) { _Pragma("unroll") for (int rep = 0; rep < REPS(1); ++rep) { if (rep) GRID_BAR();
        pg8::Gemm g{(const pg8::bf16_t*)(dout + DO_H), (const pg8::bf16_t*)(ws + WS_WIN), T, NPROJ, D}; pg8::StaticOrder S; S.init(T, NPROJ, c.G, (int)blockIdx.x);
        pg8::EpiBf16<0> E{(pg8::bf16_t*)(ws + WS_PROJ), 256, nullptr, 256, (size_t)T * 256, 1.f};
        pg8::gemm_phase<pg8::EpiBf16<0>, pg8::StaticOrder, true, true>(c.lds, g, S, E); }
        if (BOTH(1)) GRID_BAR();
    }
    if (IN(2)) { _Pragma("unroll") for (int rep = 0; rep < REPS(2); ++rep) { if (rep) GRID_BAR(); p2_prep(args, c); } if (BOTH(2)) GRID_BAR(); }
    if (IN(3)) { _Pragma("unroll") for (int rep = 0; rep < REPS(3); ++rep) { if (rep) GRID_BAR(); p3_mixer(args, c, MISC, rep); } if (BOTH(3)) GRID_BAR(); }
    if (IN(4)) {
        p0_prologue<1>(args, c, c.vcu * NWAVES + c.wave, c.G * NWAVES);
        __syncthreads();
#pragma unroll 1
        for (int u = blockIdx.x; u < 256; u += c.G) mlstm_unit<1>(args, c, u >> 5, (u >> 3) & 3, u & 7);
        if (BOTH(4)) GRID_BAR();
    }
    if (IN(5)) {
        { pg8::Gemm g{(const pg8::bf16_t*)(dout + DO_YATT), (const pg8::bf16_t*)(ws + WS_WPA), T, D, 512}; pg8::StaticOrder S; S.init(T, D, c.G, (int)blockIdx.x);
          pg8::EpiGate<false> E{(pg8::bf16_t*)(ws + WS_MERGED), D, (const pg8::bf16_t*)(ws + WS_PROJ + (size_t)TL_GA * PROJ_TILE), (size_t)T * 256};
          pg8::gemm_phase<pg8::EpiGate<false>, pg8::StaticOrder, true, true>(c.lds, g, S, E); }
        __syncthreads();
        { pg8::Gemm g{(const pg8::bf16_t*)(dout + DO_YML), (const pg8::bf16_t*)(ws + WS_WPM), T, D, 512}; pg8::StaticOrder S; S.init(T, D, c.G, (int)blockIdx.x);
          pg8::EpiGate<true> E{(pg8::bf16_t*)(ws + WS_MERGED), D, (const pg8::bf16_t*)(ws + WS_PROJ + (size_t)TL_GM * PROJ_TILE), (size_t)T * 256};
          pg8::gemm_phase<pg8::EpiGate<true>, pg8::StaticOrder, true, true>(c.lds, g, S, E); }
        if (BOTH(5)) GRID_BAR();
    }
    if (IN(6)) {
        pg8::Gemm g{(const pg8::bf16_t*)(ws + WS_MERGED), (const pg8::bf16_t*)(ws + WS_WOUT), T, D, D}; pg8::StaticOrder S; S.init(T, D, c.G, (int)blockIdx.x);
        pg8::EpiRes E{args.out, args.in[IN_X], D};
        pg8::gemm_phase<pg8::EpiRes, pg8::StaticOrder, true, true>(c.lds, g, S, E);
        if (BOTH(6)) GRID_BAR();
    }
    if (IN(7)) { _Pragma("unroll") for (int rep = 0; rep < REPS(7); ++rep) { if (rep) GRID_BAR(); p6_router(args, c); } if (BOTH(7)) GRID_BAR(); }
    if (IN(8)) { _Pragma("unroll") for (int rep = 0; rep < REPS(8); ++rep) { if (rep) GRID_BAR(); p7_gather(args, c); } if (BOTH(8)) GRID_BAR(); }
    if (IN(9) || IN(10)) {
        LAS int* TSL = (LAS int*)(c.lds + MISC_OFF + 256);
        if (c.tid < 33) TSL[c.tid] = (int)__hip_atomic_load((unsigned*)(ws + WS_SMALL) + c.tid, RLX_AGENT);
        __syncthreads();
        if (IN(9)) {
            pg8::MoeOrder<true> S{TSL, c.G, (int)blockIdx.x, (const int*)(ws + WS_ROWTOK)};
            pg8::Gemm g{(const pg8::bf16_t*)(ws + WS_XN), (const pg8::bf16_t*)(ws + WS_GU), 0, 0, D};
            pg8::EpiSwiGLU E{(pg8::bf16_t*)(ws + WS_HID)};
            pg8::gemm_phase<pg8::EpiSwiGLU, pg8::MoeOrder<true>, true, true>(c.lds, g, S, E);
            if (BOTH(9)) GRID_BAR();
        }
        if (IN(10)) {
            pg8::MoeOrder<false> S{TSL, c.G, (int)blockIdx.x, nullptr};
            pg8::Gemm g{(const pg8::bf16_t*)(ws + WS_HID), (const pg8::bf16_t*)(ws + WS_DN), 0, 0, 512};
            pg8::EpiDown E{(pg8::bf16_t*)(ws + WS_Y)};
            pg8::gemm_phase<pg8::EpiDown, pg8::MoeOrder<false>, true, true>(c.lds, g, S, E);
            if (BOTH(10)) GRID_BAR();
        }
    }
    if (IN(11)) p10_combine(args, c);
#undef IN
#undef BOTH
#undef GRID_BAR
}

extern "C" void kernel_launch(void* const* d_in, const int* in_sizes, int n_in, void* d_out, int out_size, void* d_ws, size_t ws_size, hipStream_t stream) {
    static int grid = 0;
    if (grid == 0) {
        if (n_in != 22 || in_sizes[0] != T * D || out_size != T * D || ws_size < WS_END) { fprintf(stderr, "kernel_launch: unexpected shapes (n_in %d, in0 %d, out %d, ws %zu); nothing launched\n", n_in, n_in > 0 ? in_sizes[0] : -1, out_size, ws_size); grid = -1; return; }
        int dev = 0, cus = 0, per_cu = 0;
        if (hipGetDevice(&dev) != hipSuccess || hipDeviceGetAttribute(&cus, hipDeviceAttributeMultiprocessorCount, dev) != hipSuccess) { grid = -1; return; }
        if (hipFuncSetAttribute((const void*)hybrid_fwd, hipFuncAttributeMaxDynamicSharedMemorySize, LDS_BYTES) != hipSuccess) { fprintf(stderr, "kernel_launch: hipFuncSetAttribute failed\n"); grid = -1; return; }
        if (hipOccupancyMaxActiveBlocksPerMultiprocessor(&per_cu, (const void*)hybrid_fwd, NWAVES * 64, LDS_BYTES) != hipSuccess || per_cu < 1)
            fprintf(stderr, "kernel_launch: note: occupancy query reports %d workgroups per CU\n", per_cu);
        (void)hipGetLastError();
        grid = cus;
    }
    if (grid < 0) return;
    if (hipMemsetAsync((char*)d_ws + WS_CTL, 0, CTL_ZERO_BYTES, stream) != hipSuccess) return;
    Args a{};
    for (int i = 0; i < 22; ++i) a.in[i] = (const float*)d_in[i];
    a.out = (float*)d_out; a.ws = (unsigned char*)d_ws;
    for (int li = 0; li < N_LAUNCHES; ++li) {
        a.ph_lo = (N_LAUNCHES == 1) ? 0 : li; a.ph_hi = (N_LAUNCHES == 1) ? NPH : li + 1; a.li = li;
        hipLaunchKernelGGL(hybrid_fwd, dim3(grid), dim3(NWAVES * 64), LDS_BYTES, stream, a);
        if (hipPeekAtLastError() != hipSuccess) { fprintf(stderr, "kernel_launch: launch %d failed\n", li); break; }
    }
}
```

```cpp
#include <hip/hip_runtime.h>
#include <cstdio>
#include <cstdint>
namespace pg8 {
#define PG8_LAS __attribute__((address_space(3)))
typedef unsigned short bf16_t;
typedef short bf16x8 __attribute__((ext_vector_type(8)));
typedef float f32x4 __attribute__((ext_vector_type(4)));
typedef unsigned u32x4 __attribute__((ext_vector_type(4)));
constexpr int BM = 256, BK = 64, HALF = 128, HTB = HALF * BK * 2  , STAGE_BYTES = 8 * HTB, NXCD = 8, WGM = 8;

__host__ __device__ __forceinline__ int lds_byte(int r, int c) { const int st = (r >> 4) * 2 + (c >> 5), rr = r & 15, cc = c & 31, ob = rr * 64 + cc * 2; return st * 1024 + (ob ^ (((ob >> 9) & 1) << 5)); }
__host__ __device__ __forceinline__ void stage_rc(int b, int& R, int& C) { const int st = b / 1024, sb = b % 1024, swz = sb ^ (((sb >> 9) & 1) << 5); R = (st >> 1) * 16 + swz / 64; C = (st & 1) * 32 + (swz % 64) / 2; }
__host__ __device__ __forceinline__ int perm32(int rho) { const int n = rho >> 4, i = rho & 15; return 8 * (i >> 2) + 4 * n + (i & 3); }

struct Unit { int pm, pn; };
struct Gemm { const bf16_t* A; const bf16_t* Bt; int M, N, K; };

struct StaticOrder {
    static constexpr bool GATHER = false;
    int nM, nN, nwg, G, c;
    __host__ __device__ void init(int M, int N, int G_, int c_) { nM = M / BM; nN = N / BM; nwg = nM * nN; G = G_; c = c_; }
    __host__ __device__ bool next(int i, Unit& u) const {
        const long L = (long)i * G + c; if (L >= nwg) return false;
        int wgid = (int)L; { const int q = nwg / NXCD, r = nwg % NXCD, xcd = wgid % NXCD, off = wgid / NXCD; wgid = (xcd < r ? xcd * (q + 1) : r * (q + 1) + (xcd - r) * q) + off; }
        const int nig = WGM * nN, gid = wgid / nig, fm = gid * WGM, gsz = (nM - fm) < WGM ? (nM - fm) : WGM;
        u.pm = fm + ((wgid % nig) % gsz); u.pn = (wgid % nig) / gsz; return true;
    }
    __device__ __forceinline__ void a_ready(const Unit&) const {}
    __device__ __forceinline__ void done(const Unit&) const {}
};

typedef __bf16 bf2_t __attribute__((ext_vector_type(2)));
__device__ __forceinline__ unsigned cvt_pk_bf16(float lo, float hi) { bf2_t v; v[0] = (__bf16)lo; v[1] = (__bf16)hi; return __builtin_bit_cast(unsigned, v); }
typedef float f32x2 __attribute__((ext_vector_type(2)));
template <int ACT  > struct EpiBf16 {
    static constexpr bool PERM = true, AFTER_DRAIN = false; static_assert(ACT == 0, "EpiBf16: no activation here");
    bf16_t* O; int ldc; const float* bias; int split_cols; size_t split_stride; float scale0;
    __device__ __forceinline__ void operator()(const f32x4 (&acc)[2][2][4][2], const Unit& u, int wr, int wc, int fr, int fq) const {
        const int row0 = u.pm * BM + wr * 64 + fr; int colt = u.pn * BM; bf16_t* base = O;
        float sc = 1.f; if (split_cols) { const int t = colt / split_cols; base += (size_t)t * split_stride; colt -= t * split_cols; if (t == 0) sc = scale0; }
        const int col0 = colt + wc * 32 + 8 * fq, bcol0 = u.pn * BM + wc * 32 + 8 * fq;
        f32x4 bv[2][2];
#pragma unroll
        for (int bj = 0; bj < 2; ++bj)
#pragma unroll
            for (int n = 0; n < 2; ++n) bv[bj][n] = bias ? *(const f32x4*)(bias + bcol0 + bj * HALF + 4 * n) : (f32x4){0.f, 0.f, 0.f, 0.f};
#pragma unroll
        for (int ai = 0; ai < 2; ++ai)
#pragma unroll
            for (int m = 0; m < 4; ++m) { bf16_t* rowp = base + (size_t)(row0 + ai * HALF + m * 16) * ldc + col0;
#pragma unroll
                for (int bj = 0; bj < 2; ++bj) { f32x4 v0 = acc[ai][bj][m][0] + bv[bj][0], v1 = acc[ai][bj][m][1] + bv[bj][1];
                    v0 = v0 * sc; v1 = v1 * sc; u32x4 w; w.x = cvt_pk_bf16(v0[0], v0[1]); w.y = cvt_pk_bf16(v0[2], v0[3]); w.z = cvt_pk_bf16(v1[0], v1[1]); w.w = cvt_pk_bf16(v1[2], v1[3]);
                    *(u32x4*)(rowp + bj * HALF) = w; } }
    }
};
__device__ __forceinline__ float bf2f_(unsigned b16) { return __uint_as_float(b16 << 16); }
__device__ __forceinline__ float sigm_(float x) { return 1.0f / (1.0f + __expf(-x)); }
template <bool ADD> struct EpiGate {
    static constexpr bool PERM = true, AFTER_DRAIN = false;
    bf16_t* O; int ldc; const bf16_t* gate; size_t gstride;
    __device__ __forceinline__ void operator()(const f32x4 (&acc)[2][2][4][2], const Unit& u, int wr, int wc, int fr, int fq) const {
        const int row0 = u.pm * BM + wr * 64 + fr, colt = wc * 32 + 8 * fq;
        const bf16_t* gt = gate + (size_t)u.pn * gstride;
#pragma unroll
        for (int ai = 0; ai < 2; ++ai)
#pragma unroll
            for (int m = 0; m < 4; ++m) { const size_t row = (size_t)(row0 + ai * HALF + m * 16);
#pragma unroll
                for (int bj = 0; bj < 2; ++bj) { const int c = colt + bj * HALF;
                    const u32x4 gv = *(const u32x4*)(gt + row * 256 + c);
                    bf16_t* op = O + row * ldc + u.pn * BM + c;
                    float pv[8] = {0.f, 0.f, 0.f, 0.f, 0.f, 0.f, 0.f, 0.f};
                    if (ADD) { const u32x4 p = *(const u32x4*)op; pv[0] = bf2f_(p.x & 0xffffu); pv[1] = bf2f_(p.x >> 16); pv[2] = bf2f_(p.y & 0xffffu); pv[3] = bf2f_(p.y >> 16);
                        pv[4] = bf2f_(p.z & 0xffffu); pv[5] = bf2f_(p.z >> 16); pv[6] = bf2f_(p.w & 0xffffu); pv[7] = bf2f_(p.w >> 16); }
                    const f32x4 v0 = acc[ai][bj][m][0], v1 = acc[ai][bj][m][1];
                    float o[8];
                    o[0] = pv[0] + sigm_(bf2f_(gv.x & 0xffffu)) * v0[0]; o[1] = pv[1] + sigm_(bf2f_(gv.x >> 16)) * v0[1];
                    o[2] = pv[2] + sigm_(bf2f_(gv.y & 0xffffu)) * v0[2]; o[3] = pv[3] + sigm_(bf2f_(gv.y >> 16)) * v0[3];
                    o[4] = pv[4] + sigm_(bf2f_(gv.z & 0xffffu)) * v1[0]; o[5] = pv[5] + sigm_(bf2f_(gv.z >> 16)) * v1[1];
                    o[6] = pv[6] + sigm_(bf2f_(gv.w & 0xffffu)) * v1[2]; o[7] = pv[7] + sigm_(bf2f_(gv.w >> 16)) * v1[3];
                    u32x4 w; w.x = cvt_pk_bf16(o[0], o[1]); w.y = cvt_pk_bf16(o[2], o[3]); w.z = cvt_pk_bf16(o[4], o[5]); w.w = cvt_pk_bf16(o[6], o[7]);
                    *(u32x4*)op = w; } }
    }
};
struct EpiRes {
    static constexpr bool PERM = false, AFTER_DRAIN = false;
    float* C; const float* R; int ldc;
    __device__ __forceinline__ void operator()(const f32x4 (&acc)[2][2][4][2], const Unit& u, int wr, int wc, int fr, int fq) const {
        const int row0 = u.pm * BM + wr * 64 + fr, col0 = u.pn * BM + wc * 32 + 4 * fq;
#pragma unroll
        for (int ai = 0; ai < 2; ++ai)
#pragma unroll
            for (int m = 0; m < 4; ++m) { const size_t ro = (size_t)(row0 + ai * HALF + m * 16) * ldc + col0;
#pragma unroll
                for (int bj = 0; bj < 2; ++bj)
#pragma unroll
                    for (int n = 0; n < 2; ++n) { const size_t off = ro + bj * HALF + n * 16; *(f32x4*)(C + off) = *(const f32x4*)(R + off) + acc[ai][bj][m][n]; } }
    }
};
struct EpiSwiGLU {
    static constexpr bool PERM = true, AFTER_DRAIN = false;
    bf16_t* H;
    __device__ __forceinline__ void operator()(const f32x4 (&acc)[2][2][4][2], const Unit& u, int wr, int wc, int fr, int fq) const {
        const int row0 = u.pm * BM + wr * 64 + fr, hc = (u.pn & 3) * 128 + wc * 32 + 8 * fq;
#pragma unroll
        for (int ai = 0; ai < 2; ++ai)
#pragma unroll
            for (int m = 0; m < 4; ++m) { const size_t row = (size_t)(row0 + ai * HALF + m * 16);
                float o[8];
#pragma unroll
                for (int n = 0; n < 2; ++n)
#pragma unroll
                    for (int i = 0; i < 4; ++i) { const float g = acc[ai][0][m][n][i], up = acc[ai][1][m][n][i]; o[n * 4 + i] = g * sigm_(g) * up; }
                u32x4 w; w.x = cvt_pk_bf16(o[0], o[1]); w.y = cvt_pk_bf16(o[2], o[3]); w.z = cvt_pk_bf16(o[4], o[5]); w.w = cvt_pk_bf16(o[6], o[7]);
                *(u32x4*)(H + row * 512 + hc) = w; }
    }
};
struct EpiDown {
    static constexpr bool PERM = true, AFTER_DRAIN = false;
    bf16_t* Y;
    __device__ __forceinline__ void operator()(const f32x4 (&acc)[2][2][4][2], const Unit& u, int wr, int wc, int fr, int fq) const {
        const int row0 = u.pm * BM + wr * 64 + fr, c0 = (u.pn & 3) * 256 + wc * 32 + 8 * fq;
#pragma unroll
        for (int ai = 0; ai < 2; ++ai)
#pragma unroll
            for (int m = 0; m < 4; ++m) { const size_t row = (size_t)(row0 + ai * HALF + m * 16);
#pragma unroll
                for (int bj = 0; bj < 2; ++bj) { const f32x4 v0 = acc[ai][bj][m][0], v1 = acc[ai][bj][m][1];
                    u32x4 w; w.x = cvt_pk_bf16(v0[0], v0[1]); w.y = cvt_pk_bf16(v0[2], v0[3]); w.z = cvt_pk_bf16(v1[0], v1[1]); w.w = cvt_pk_bf16(v1[2], v1[3]);
                    *(u32x4*)(Y + row * 1024 + c0 + bj * HALF) = w; } }
    }
};
template <bool GA_> struct MoeOrder {
    static constexpr bool GATHER = GA_;
    const PG8_LAS int* ts; int G, c; const int* rowtok;
    __device__ __forceinline__ bool next(int i, Unit& u) const {
        const int nt = ts[32]; const long L = (long)i * G + c; if (L >= 4L * nt) return false;
        const int pm = (int)(L >> 2), j = (int)(L & 3); int e = 0;
#pragma unroll
        for (int k = 1; k < 32; ++k) e += (ts[k] <= pm) ? 1 : 0;
        u.pm = pm; u.pn = e * 4 + j; return true;
    }
    __device__ __forceinline__ void a_ready(const Unit&) const {}
    __device__ __forceinline__ void done(const Unit&) const {}
};
template <class Epi, class Sched, bool ALIGN_EPI = false, bool SP2 = false>
__device__ __forceinline__ void gemm_phase(PG8_LAS unsigned char* lds, const Gemm g, const Sched& S, const Epi& E) {
    const int tid = threadIdx.x, wid = __builtin_amdgcn_readfirstlane(tid >> 6), lane = tid & 63, wr = wid >> 2, wc = wid & 3, fr = lane & 15, fq = lane >> 4;
    const int K = g.K, nt = K / BK;
    unsigned voffA[2], voffB[2];
#pragma unroll
    for (int i = 0; i < 2; ++i) { int R, C; stage_rc(tid * 16 + i * 8192, R, C); const int Rb = Epi::PERM ? ((R & ~31) + perm32(R & 31)) : R;
        voffA[i] = (unsigned)(R * K + C) * 2u; voffB[i] = (unsigned)(Rb * K + C) * 2u; }
    const size_t kstep = (size_t)(BK * 2);
    const size_t hstep = (size_t)HALF * K * 2;
    const size_t tstep = 2 * hstep;
    constexpr bool GA = Sched::GATHER;
    static_assert(!GA || SP2, "gathered A rows: SP2 loop only");
    const size_t hstepA = GA ? 0 : hstep;
    unsigned gcur[2][2] = {{0u, 0u}, {0u, 0u}}, gnxt[2][2] = {{0u, 0u}, {0u, 0u}}; int gR[2] = {0, 0}; unsigned gC[2] = {0u, 0u};
    if constexpr (GA) { _Pragma("unroll") for (int i = 0; i < 2; ++i) { int R, C; stage_rc(tid * 16 + i * 8192, R, C); gR[i] = R; gC[i] = (unsigned)C * 2u; } }
#define PG8_GOFF(dst, u) do { if constexpr (GA) { _Pragma("unroll") for (int h_ = 0; h_ < 2; ++h_) _Pragma("unroll") for (int i_ = 0; i_ < 2; ++i_) dst[h_][i_] = (unsigned)S.rowtok[(u).pm * BM + h_ * HALF + gR[i_]] * (unsigned)(K * 2) + gC[i_]; } } while (0)
#define PG8_VA(h, sel) (GA ? ((sel) ? gnxt[h] : gcur[h]) : voffA)
    const unsigned ldsw = (unsigned)wid * 1024u;
    const int aoff = lds_byte(wr * 64 + fr, fq * 8), boff = lds_byte(wc * 32 + fr, fq * 8);
#define PG8_SA(b, h) (((b) * 2 + (h)) * HTB)
#define PG8_SB(b, h) ((4 + (b) * 2 + (h)) * HTB)
#define PG8_STAGE(bufoff, gbase, voff) do { _Pragma("unroll") for (int _i = 0; _i < 2; ++_i) \
        __builtin_amdgcn_global_load_lds((const unsigned*)((const char*)(gbase) + (voff)[_i]), (PG8_LAS unsigned*)(lds + (bufoff) + ldsw + _i * 8192), 16, 0, 0); } while (0)
#define PG8_LDA(dst, b, h) do { _Pragma("unroll") for (int m = 0; m < 4; ++m) _Pragma("unroll") for (int k = 0; k < 2; ++k) dst[m][k] = *(const PG8_LAS bf16x8*)(lds + PG8_SA(b, h) + aoff + m * 2048 + k * 1024); } while (0)
#define PG8_LDB(dst, b, h) do { _Pragma("unroll") for (int n = 0; n < 2; ++n) _Pragma("unroll") for (int k = 0; k < 2; ++k) dst[n][k] = *(const PG8_LAS bf16x8*)(lds + PG8_SB(b, h) + boff + n * 2048 + k * 1024); } while (0)
#define PG8_MMA(ai, bj, At, Bt) do { __builtin_amdgcn_s_setprio(1); _Pragma("unroll") for (int m = 0; m < 4; ++m) _Pragma("unroll") for (int n = 0; n < 2; ++n) _Pragma("unroll") for (int k = 0; k < 2; ++k) \
        acc[ai][bj][m][n] = __builtin_amdgcn_mfma_f32_16x16x32_bf16(Bt[n][k], At[m][k], acc[ai][bj][m][n], 0, 0, 0); __builtin_amdgcn_s_setprio(0); } while (0)
#define PG8_WAIT_V(n) asm volatile("s_waitcnt vmcnt(" #n ")" ::: "memory")
#define PG8_WAIT_L(n) asm volatile("s_waitcnt lgkmcnt(" #n ")" ::: "memory")
#define PG8_BAR __builtin_amdgcn_s_barrier()
#define PG8_SCHED __builtin_amdgcn_sched_barrier(0)
    Unit cur, nxt; int ui = 0;
    if (!S.next(0, cur)) return;
    f32x4 acc[2][2][4][2];
#pragma unroll
    for (int a = 0; a < 2; ++a)
#pragma unroll
        for (int b = 0; b < 2; ++b)
#pragma unroll
            for (int m = 0; m < 4; ++m)
#pragma unroll
                for (int n = 0; n < 2; ++n) acc[a][b][m][n] = (f32x4){0.f, 0.f, 0.f, 0.f};
    bf16x8 At[4][2], B0[2][2], B1[2][2];
    const char* cA = (const char*)g.A + (GA ? 0 : (size_t)cur.pm * tstep); const char* cB = (const char*)g.Bt + (size_t)cur.pn * tstep;
    S.a_ready(cur);
    PG8_GOFF(gcur, cur);
    if constexpr (SP2) {
        PG8_STAGE(PG8_SB(0, 0), cB, voffB); PG8_STAGE(PG8_SB(0, 1), cB + hstep, voffB); PG8_STAGE(PG8_SA(0, 0), cA, PG8_VA(0, false)); PG8_STAGE(PG8_SA(0, 1), cA + hstepA, PG8_VA(1, false));
        if (wr == 1) PG8_BAR;
        PG8_WAIT_V(2); PG8_BAR;
        PG8_STAGE(PG8_SB(1, 0), cB + kstep, voffB); PG8_STAGE(PG8_SA(1, 0), cA + kstep, PG8_VA(0, false)); PG8_STAGE(PG8_SB(1, 1), cB + hstep + kstep, voffB);
        PG8_WAIT_V(6); PG8_BAR;
    } else {
        PG8_STAGE(PG8_SB(0, 0), cB, voffB); PG8_STAGE(PG8_SA(0, 0), cA, voffA); PG8_STAGE(PG8_SB(0, 1), cB + hstep, voffB); PG8_STAGE(PG8_SA(0, 1), cA + hstep, voffA);
        if (wr == 1) PG8_BAR;
        PG8_WAIT_V(4); PG8_BAR;
        PG8_STAGE(PG8_SB(1, 0), cB + kstep, voffB); PG8_STAGE(PG8_SA(1, 0), cA + kstep, voffA); PG8_STAGE(PG8_SB(1, 1), cB + hstep + kstep, voffB);
        PG8_WAIT_V(6); PG8_BAR;
    }
    for (;;) {
        const bool has_next = S.next(ui + 1, nxt);
        if (has_next) PG8_GOFF(gnxt, nxt);
        const char* nA = has_next ? (const char*)g.A + (GA ? 0 : (size_t)nxt.pm * tstep) : cA; const char* nB = has_next ? (const char*)g.Bt + (size_t)nxt.pn * tstep : cB;
        for (int t = 0; t < nt; t += 2) {
            const bool last = (t == nt - 2);
            const char* a1 = cA + (size_t)(t + 1) * kstep;
            const char* a2 = last ? nA : cA + (size_t)(t + 2) * kstep; const char* b2 = last ? nB : cB + (size_t)(t + 2) * kstep;
            const char* a3 = a2 + kstep; const char* b3 = b2 + kstep;
            if (last && has_next) S.a_ready(nxt);
            const bool seln = last && has_next;
            if constexpr (SP2) {
            PG8_LDB(B0, 0, 0); PG8_LDB(B1, 0, 1); PG8_SCHED; PG8_LDA(At, 0, 0); PG8_STAGE(PG8_SA(1, 1), a1 + hstepA, PG8_VA(1, false));
            PG8_WAIT_V(8); PG8_WAIT_L(0); PG8_BAR; PG8_MMA(0, 0, At, B0); PG8_MMA(0, 1, At, B1); PG8_BAR; PG8_SCHED;
            PG8_LDA(At, 0, 1); PG8_STAGE(PG8_SB(0, 0), b2, voffB); PG8_STAGE(PG8_SB(0, 1), b2 + hstep, voffB); PG8_STAGE(PG8_SA(0, 0), a2, PG8_VA(0, seln));
            PG8_WAIT_V(8); PG8_WAIT_L(0); PG8_BAR; PG8_MMA(1, 0, At, B0); PG8_MMA(1, 1, At, B1); PG8_BAR; PG8_SCHED;
            PG8_LDB(B0, 1, 0); PG8_LDB(B1, 1, 1); PG8_SCHED; PG8_LDA(At, 1, 0); PG8_STAGE(PG8_SA(0, 1), a2 + hstepA, PG8_VA(1, seln));
            PG8_WAIT_V(8); PG8_WAIT_L(0); PG8_BAR; PG8_MMA(0, 0, At, B0); PG8_MMA(0, 1, At, B1); PG8_BAR; PG8_SCHED;
            PG8_LDA(At, 1, 1); PG8_STAGE(PG8_SB(1, 0), b3, voffB); PG8_STAGE(PG8_SB(1, 1), b3 + hstep, voffB); PG8_STAGE(PG8_SA(1, 0), a3, PG8_VA(0, seln));
            PG8_WAIT_V(8); PG8_WAIT_L(0); PG8_BAR; PG8_MMA(1, 0, At, B0); PG8_MMA(1, 1, At, B1); PG8_BAR; PG8_SCHED;
            } else {
            PG8_LDB(B0, 0, 0); PG8_SCHED; PG8_LDA(At, 0, 0); PG8_STAGE(PG8_SA(1, 1), a1 + hstep, voffA);
            PG8_WAIT_L(8); PG8_BAR; PG8_WAIT_L(0); PG8_MMA(0, 0, At, B0); PG8_BAR; PG8_SCHED;
            PG8_LDB(B1, 0, 1); PG8_STAGE(PG8_SB(0, 0), b2, voffB);
            PG8_BAR; PG8_WAIT_L(0); PG8_MMA(0, 1, At, B1); PG8_BAR;
            PG8_LDA(At, 0, 1); PG8_STAGE(PG8_SA(0, 0), a2, voffA);
            PG8_BAR; PG8_WAIT_L(0); PG8_MMA(1, 0, At, B0); PG8_BAR; PG8_SCHED;
            PG8_STAGE(PG8_SB(0, 1), b2 + hstep, voffB);
            PG8_WAIT_V(6); PG8_BAR; PG8_MMA(1, 1, At, B1); PG8_BAR;
            PG8_LDB(B0, 1, 0); PG8_SCHED; PG8_LDA(At, 1, 0); PG8_STAGE(PG8_SA(0, 1), a2 + hstep, voffA);
            PG8_WAIT_L(8); PG8_BAR; PG8_WAIT_L(0); PG8_MMA(0, 0, At, B0); PG8_BAR; PG8_SCHED;
            PG8_LDB(B1, 1, 1); PG8_STAGE(PG8_SB(1, 0), b3, voffB);
            PG8_BAR; PG8_WAIT_L(0); PG8_MMA(0, 1, At, B1); PG8_BAR;
            PG8_LDA(At, 1, 1); PG8_STAGE(PG8_SA(1, 0), a3, voffA);
            PG8_BAR; PG8_WAIT_L(0); PG8_MMA(1, 0, At, B0); PG8_BAR; PG8_SCHED;
            PG8_STAGE(PG8_SB(1, 1), b3 + hstep, voffB);
            PG8_WAIT_V(6); PG8_BAR; PG8_MMA(1, 1, At, B1); PG8_BAR;
            }
        }
        if constexpr (ALIGN_EPI) { if (wr == 0) PG8_BAR; }
        if constexpr (!Epi::AFTER_DRAIN) { E(acc, cur, wr, wc, fr, fq); S.done(cur); }
        if (!has_next) break;
#pragma unroll
        for (int a = 0; a < 2; ++a)
#pragma unroll
            for (int b = 0; b < 2; ++b)
#pragma unroll
                for (int m = 0; m < 4; ++m)
#pragma unroll
                    for (int n = 0; n < 2; ++n) acc[a][b][m][n] = (f32x4){0.f, 0.f, 0.f, 0.f};
        cur = nxt; cA = nA; cB = nB; ++ui;
        if constexpr (GA) { _Pragma("unroll") for (int h_ = 0; h_ < 2; ++h_) _Pragma("unroll") for (int i_ = 0; i_ < 2; ++i_) gcur[h_][i_] = gnxt[h_][i_]; }
        if constexpr (ALIGN_EPI) { if (wr == 1) PG8_BAR; }
    }
    PG8_WAIT_V(0);
    if constexpr (!ALIGN_EPI) { if (wr == 0) PG8_BAR; }
    PG8_BAR;
    if constexpr (Epi::AFTER_DRAIN) { E.fused(acc, cur, wr, wc, fr, fq, lds, wid, lane); S.done(cur); }
#undef PG8_GOFF
#undef PG8_VA
#undef PG8_SA
#undef PG8_SB
#undef PG8_STAGE
#undef PG8_LDA
#undef PG8_LDB
#undef PG8_MMA
#undef PG8_WAIT_V
#undef PG8_WAIT_L
#undef PG8_BAR
#undef PG8_SCHED
}
}
constexpr int NWAVES = 8;
constexpr int BATCH = 8, SEQ = 4096, D = 1024, T = BATCH * SEQ;
constexpr int NPROJ = 5120;
constexpr int NTILE = NPROJ / 256;
constexpr float EPS = 1e-6f;
#ifndef MK_N_LAUNCHES
#define MK_N_LAUNCHES 1
#endif
#ifndef DBG_NPH
#define DBG_NPH 12
#endif
constexpr int NPH = DBG_NPH;
constexpr int N_LAUNCHES = MK_N_LAUNCHES;
static_assert(N_LAUNCHES == 1 || N_LAUNCHES == NPH, "MK_N_LAUNCHES is 1 or NPH");

constexpr size_t MiB = 1u << 20;
constexpr size_t WS_CTL = 0, CTL_ZERO_BYTES = 1 * MiB;
constexpr size_t WS_SMALL = 1 * MiB;
constexpr size_t WS_WIN = 2 * MiB;
constexpr size_t WS_WPA = 13 * MiB, WS_WPM = 14 * MiB, WS_WOUT = 15 * MiB;
constexpr size_t WS_TOKE = 17 * MiB;
constexpr size_t WS_TOKR = WS_TOKE + 256 * 1024;
constexpr size_t WS_TOKP = WS_TOKR + 256 * 1024;
constexpr size_t WS_TOKG = WS_TOKP + 256 * 1024;
constexpr size_t WS_CNT = WS_TOKG + 256 * 1024;
constexpr size_t WS_ROWTOK = WS_CNT + 64 * 1024;
constexpr int NROWS_MAX = 73728;
constexpr size_t WS_SC = 452 * MiB;
constexpr size_t WS_SC2 = 116 * MiB + 3 * ((size_t)T * 256 * 2);
constexpr size_t WS_GU = 20 * MiB;
constexpr size_t WS_DN = 84 * MiB;
constexpr size_t WS_PROJ = 116 * MiB;
constexpr size_t PROJ_TILE = (size_t)T * 256 * 2;
constexpr size_t WS_MLST = 116 * MiB;
constexpr size_t WS_MERGED = 116 * MiB;
constexpr size_t WS_XN = 180 * MiB;
constexpr size_t WS_XG = 244 * MiB;
constexpr size_t WS_HID = 388 * MiB;
constexpr size_t WS_Y = 244 * MiB;
constexpr size_t WS_END = 512 * MiB;
static_assert(WS_PROJ + NTILE * PROJ_TILE == 436 * MiB, "proj map");
constexpr size_t DO_H = 0, DO_YATT = 0, DO_YML = 32 * MiB, DO_KN = 64 * MiB, DO_IKR = 72 * MiB, DO_IQR = 74 * MiB, DO_AQN = 90 * MiB;
constexpr int TL_AQ = 0, TL_KV = 2, TL_IQ = 3, TL_MQ = 4, TL_MK = 6, TL_MV = 8, TL_MO = 10, TL_GA = 12, TL_GM = 16;
constexpr size_t WS_WSM = WS_SMALL + 64 * 1024;
constexpr size_t WS_WTG = WS_SMALL + 192 * 1024;
constexpr size_t DO_SMB = 122 * MiB;
constexpr int CW_BAR = 4096;
constexpr int CW_Q = 16384;
constexpr int LDS_BYTES = 163840, MISC_OFF = LDS_BYTES - 512;

#define GAS __attribute__((address_space(1)))
#define LAS __attribute__((address_space(3)))
typedef unsigned short bf16;
typedef unsigned v4u __attribute__((ext_vector_type(4)));
typedef unsigned v2u __attribute__((ext_vector_type(2)));
typedef float f32x4 __attribute__((ext_vector_type(4)));
typedef float f32x2 __attribute__((ext_vector_type(2)));
typedef short bf16x8 __attribute__((ext_vector_type(8)));
typedef GAS unsigned gu32;
#define RLX_AGENT __ATOMIC_RELAXED, __HIP_MEMORY_SCOPE_AGENT
#define LDS_WAIT() asm volatile("s_waitcnt lgkmcnt(0)" ::: "memory")
__device__ __forceinline__ float bf2f(unsigned b16) { return __uint_as_float(b16 << 16); }
__device__ __forceinline__ unsigned f2bf(float f) { unsigned u = __float_as_uint(f); return (u + 0x7fffu + ((u >> 16) & 1u)) >> 16; }
__device__ __forceinline__ unsigned pk2(float lo, float hi) { return pg8::cvt_pk_bf16(lo, hi); }
__device__ __forceinline__ float sigm(float x) { return 1.0f / (1.0f + __expf(-x)); }
__device__ __forceinline__ float wave_sum(float v) {
    v += __int_as_float(__builtin_amdgcn_update_dpp(0, __float_as_int(v), 0xB1, 0xF, 0xF, true));
    v += __int_as_float(__builtin_amdgcn_update_dpp(0, __float_as_int(v), 0x4E, 0xF, 0xF, true));
    v += __int_as_float(__builtin_amdgcn_update_dpp(0, __float_as_int(v), 0x124, 0xF, 0xF, true));
    v += __int_as_float(__builtin_amdgcn_update_dpp(0, __float_as_int(v), 0x128, 0xF, 0xF, true));
    { const auto r = __builtin_amdgcn_permlane16_swap(__float_as_uint(v), __float_as_uint(v), false, false); v = __uint_as_float(r[0]) + __uint_as_float(r[1]); }
    { const auto r = __builtin_amdgcn_permlane32_swap(__float_as_uint(v), __float_as_uint(v), false, false); v = __uint_as_float(r[0]) + __uint_as_float(r[1]); }
    return v;
}
__device__ __forceinline__ void unpack8(const v4u r, float (&f)[8]) {
    f[0] = bf2f(r.x & 0xffffu); f[1] = bf2f(r.x >> 16); f[2] = bf2f(r.y & 0xffffu); f[3] = bf2f(r.y >> 16);
    f[4] = bf2f(r.z & 0xffffu); f[5] = bf2f(r.z >> 16); f[6] = bf2f(r.w & 0xffffu); f[7] = bf2f(r.w >> 16);
}
__device__ __forceinline__ v4u pack8(const float (&f)[8]) { v4u w; w.x = pk2(f[0], f[1]); w.y = pk2(f[2], f[3]); w.z = pk2(f[4], f[5]); w.w = pk2(f[6], f[7]); return w; }
#define XB_TMO      128
#define XB_XCNT(j)  (256  + 64 * (j))
#define XB_XSUB(j)  (1280 + 64 * (j))
#define XB_XGEN(j)  (2304 + 64 * (j))
#define XB_TOP      3328
#define XB_TOPGEN   3392
#define XCD_BAR_WORDS 3456
#define XB_SPIN_CAP (1u << 18)

__device__ __forceinline__ unsigned xb_ld(unsigned* p)              { return __hip_atomic_load(p, __ATOMIC_RELAXED, __HIP_MEMORY_SCOPE_AGENT); }
__device__ __forceinline__ unsigned xb_add(unsigned* p, unsigned v) { return __hip_atomic_fetch_add(p, v, __ATOMIC_RELAXED, __HIP_MEMORY_SCOPE_AGENT); }
__device__ __forceinline__ unsigned xb_xcc_id() { return (unsigned)__builtin_amdgcn_s_getreg((3 << 11) | 20) & 0xFu; }
#define XB_SPIN(cond, bar) do { unsigned _sp = 0; while (cond) { __builtin_amdgcn_s_sleep(1); \
    if ((++_sp & 255u) == 0u) { if (xb_ld(&(bar)[XB_TMO])) break; if (_sp > XB_SPIN_CAP) { atomicAdd(&(bar)[XB_TMO], 1u); break; } } } } while (0)

struct XcdBarrier {
    unsigned* bar; unsigned x;
    volatile LAS unsigned* st;
};

__device__ __forceinline__ XcdBarrier xcd_barrier_post(unsigned* bar, volatile LAS unsigned* st) {
    XcdBarrier b; b.bar = bar; b.x = xb_xcc_id(); b.st = st;
    if (threadIdx.x == 0) (void)xb_add(&bar[XB_XCNT(b.x)], 1u);
    return b;
}
__device__ __forceinline__ void xcd_barrier_complete(unsigned* bar, unsigned x, unsigned& nloc, unsigned& nx) {
    const unsigned G = gridDim.x * gridDim.y * gridDim.z;
    unsigned sum, cnt, mine, sp = 0u;
    for (;;) {
        sum = 0u; cnt = 0u; mine = 0u;
#pragma unroll
        for (unsigned j = 0; j < 16; ++j) { const unsigned c = xb_ld(&bar[XB_XCNT(j)]); sum += c; cnt += (c > 0u) ? 1u : 0u; mine = (j == x) ? c : mine; }
        if (sum == G) break;
        __builtin_amdgcn_s_sleep(1);
        if ((++sp & 255u) == 0u) { if (xb_ld(&bar[XB_TMO])) break; if (sp > XB_SPIN_CAP) { atomicAdd(&bar[XB_TMO], 1u); break; } }
    }
    nloc = mine > 0u ? mine : 1u; nx = cnt > 0u ? cnt : 1u;
}

__device__ __forceinline__ void xcd_barrier(const XcdBarrier& b) {
    asm volatile("s_waitcnt vmcnt(0)" ::: "memory");
    __syncthreads();
    if (threadIdx.x == 0) {
        unsigned* bar = b.bar;
        __builtin_amdgcn_s_waitcnt(0);
        unsigned nloc = b.st[0], nx = b.st[1];
        if (nloc == 0u) { xcd_barrier_complete(bar, b.x, nloc, nx); b.st[0] = nloc; b.st[1] = nx; }
        const unsigned old = xb_add(&bar[XB_XSUB(b.x)], 1u);
        const unsigned gen = old / nloc;
        if (old + 1u == (gen + 1u) * nloc) {
            __builtin_amdgcn_fence(__ATOMIC_RELEASE, "agent");
            asm volatile("s_waitcnt vmcnt(0)" ::: "memory");
            const unsigned og = xb_add(&bar[XB_TOP], 1u);
            const unsigned tg = og / nx;
            if (og + 1u == (tg + 1u) * nx) xb_add(&bar[XB_TOPGEN], 1u);
            else XB_SPIN(xb_ld(&bar[XB_TOPGEN]) == tg, bar);
            __builtin_amdgcn_fence(__ATOMIC_ACQUIRE, "agent");
            xb_add(&bar[XB_XGEN(b.x)], 1u);
            asm volatile("s_waitcnt vmcnt(0)" ::: "memory");
        } else {
            XB_SPIN(xb_ld(&bar[XB_XGEN(b.x)]) == gen, bar);
            __builtin_amdgcn_fence(__ATOMIC_ACQUIRE, "agent");
            asm volatile("s_waitcnt vmcnt(0)" ::: "memory");
        }
    }
    __syncthreads();
}
struct Args { const float* in[22]; float* out; unsigned char* ws; int ph_lo, ph_hi, li, pad; };
struct Ctx { int tid, lane, wave, G, vcu; LAS unsigned char* lds; };
#define IN_X 0
#define IN_POS 1
#define IN_GMIX 2
#define IN_WIN 3
#define IN_GQ 4
#define IN_GK 5
#define IN_WCONV 6
#define IN_BCONV 7
#define IN_BI 8
#define IN_BF 9
#define IN_GML 10
#define IN_WPA 11
#define IN_WPM 12
#define IN_WOUT 13
#define IN_GMOE 14
#define IN_WRG 15
#define IN_BRG 16
#define IN_WRE 17
#define IN_BRE 18
#define IN_WEG 19
#define IN_WEU 20
#define IN_WED 21

__device__ __forceinline__ int win_src_col(int n) {
    if (n < 1024) return n;
    if (n < 3072) return n + 40;
    return n + 48;
}
__device__ __forceinline__ int wsm_src_col(int r) {
    return r < 40 ? 1024 + r : (r < 44 ? 3112 + (r - 40) : 3116 + (r - 44));
}
__device__ __forceinline__ void tr_item(const float* W, int ldw, int scol, int k0, bf16* wt0, int K, LAS float* scr, int lane) {
    const int sc0 = __builtin_amdgcn_readfirstlane(scol), sc31 = __builtin_amdgcn_readlane(scol, 31);
    if (sc0 >= 0 && sc31 == sc0 + 31 && (sc0 & 3) == 0 && (ldw & 3) == 0) {
#pragma unroll
        for (int i = 0; i < 8; ++i) { const int kk = 8 * i + (lane >> 3); const f32x4 v = *(const f32x4*)(W + (size_t)(k0 + kk) * ldw + sc0 + 4 * (lane & 7));
            LAS float* d = scr + kk * 33 + 4 * (lane & 7); d[0] = v[0]; d[1] = v[1]; d[2] = v[2]; d[3] = v[3]; }
    } else {
#pragma unroll 8
        for (int i = 0; i < 32; ++i) { const int kk = 2 * i + (lane >> 5); scr[kk * 33 + (lane & 31)] = scol >= 0 ? W[(size_t)(k0 + kk) * ldw + scol] : 0.f; }
    }
    LDS_WAIT(); asm volatile("" ::: "memory");
    const int c = lane & 7;
#pragma unroll
    for (int j = 0; j < 4; ++j) { const int n = (lane >> 3) + 8 * j; const LAS float* s = scr + (8 * c) * 33 + n;
        v4u o; o.x = pk2(s[0 * 33], s[1 * 33]); o.y = pk2(s[2 * 33], s[3 * 33]); o.z = pk2(s[4 * 33], s[5 * 33]); o.w = pk2(s[6 * 33], s[7 * 33]);
        *(v4u*)(wt0 + (size_t)n * K + 8 * c) = o; }
    LDS_WAIT(); asm volatile("" ::: "memory");
}
template <int PART> __device__ __forceinline__ void p0_prologue(const Args& a, const Ctx& c, int gw, int NGW) {
    unsigned char* ws = a.ws;
    LAS float* scr = (LAS float*)(c.lds + c.wave * 16384);
    const int lane = c.lane;
    constexpr int I_IN = 16 * 160, I_PA = 8 * 32, I_PM = 8 * 32, I_OUT = 16 * 32, I_GU = 32 * 16 * 32, I_DN = 32 * 8 * 32;
    constexpr int NPRJ = I_IN + I_PA + I_PM + I_OUT, NIT = NPRJ + I_GU + I_DN;
    for (int it = (PART ? NPRJ : 0) + gw; it < (PART ? NIT : NPRJ); it += NGW) {
        int r = it;
        if (r < I_IN) { const int kb = r / 160, nb = r % 160; tr_item(a.in[IN_WIN], 5168, win_src_col(32 * nb + (lane & 31)), 64 * kb, (bf16*)(ws + WS_WIN) + (size_t)(32 * nb) * 1024 + 64 * kb, 1024, scr, lane); continue; } r -= I_IN;
        if (r < I_PA) { const int kb = r / 32, nb = r % 32; tr_item(a.in[IN_WPA], 1024, 32 * nb + (lane & 31), 64 * kb, (bf16*)(ws + WS_WPA) + (size_t)(32 * nb) * 512 + 64 * kb, 512, scr, lane); continue; } r -= I_PA;
        if (r < I_PM) { const int kb = r / 32, nb = r % 32; tr_item(a.in[IN_WPM], 1024, 32 * nb + (lane & 31), 64 * kb, (bf16*)(ws + WS_WPM) + (size_t)(32 * nb) * 512 + 64 * kb, 512, scr, lane); continue; } r -= I_PM;
        if (r < I_OUT) { const int kb = r / 32, nb = r % 32; tr_item(a.in[IN_WOUT], 1024, 32 * nb + (lane & 31), 64 * kb, (bf16*)(ws + WS_WOUT) + (size_t)(32 * nb) * 1024 + 64 * kb, 1024, scr, lane); continue; } r -= I_OUT;
        if (r < I_GU) { const int e = r / 512, q = r % 512, kb = q / 32, nb = q % 32, t = nb >> 3, bj = (nb >> 2) & 1, i0 = (nb & 3) * 32;
            const float* src = (bj ? a.in[IN_WEU] : a.in[IN_WEG]) + (size_t)e * 1024 * 512;
            tr_item(src, 512, 128 * t + i0 + (lane & 31), 64 * kb, (bf16*)(ws + WS_GU) + ((size_t)e * 1024 + 32 * nb) * 1024 + 64 * kb, 1024, scr, lane); continue; } r -= I_GU;
        { const int e = r / 256, q = r % 256, kb = q / 32, nb = q % 32;
            tr_item(a.in[IN_WED] + (size_t)e * 512 * 1024, 1024, 32 * nb + (lane & 31), 64 * kb, (bf16*)(ws + WS_DN) + ((size_t)e * 1024 + 32 * nb) * 512 + 64 * kb, 512, scr, lane); }
    }
    if (PART) return;
    { float* WTG = (float*)(ws + WS_WTG); for (int i = gw * 64 + lane; i < 36 * 1024; i += NGW * 64) { const int j = i >> 10, k = i & 1023;
        WTG[j * 1028 + k] = (j < 32 ? a.in[IN_WRE][k * 32 + j] : a.in[IN_WRG][k * 4 + (j - 32)]) * a.in[IN_GMOE][k]; } }
    { bf16* WSM = (bf16*)(ws + WS_WSM); for (int i = gw * 64 + lane; i < 48 * 1024; i += NGW * 64) { const int r = i >> 10, k = i & 1023; WSM[i] = (bf16)f2bf(a.in[IN_WIN][(size_t)k * 5168 + wsm_src_col(r)]); } }
    const float* g = a.in[IN_GMIX]; f32x4 gv[4];
#pragma unroll
    for (int j = 0; j < 4; ++j) gv[j] = *(const f32x4*)(g + 4 * lane + 256 * j);
    bf16* H = (bf16*)((unsigned char*)a.out + DO_H);
    for (int m0 = gw; m0 < T; m0 += 2 * NGW) {
        const int mA = m0, mB = (m0 + NGW < T) ? m0 + NGW : m0; const bool hasB = (m0 + NGW < T);
        const f32x4* xa = (const f32x4*)(a.in[IN_X] + (size_t)mA * D) + lane; const f32x4* xb = (const f32x4*)(a.in[IN_X] + (size_t)mB * D) + lane;
        f32x4 va[4], vb[4]; float sa = 0.f, sb = 0.f;
#pragma unroll
        for (int j = 0; j < 4; ++j) { va[j] = xa[64 * j]; vb[j] = xb[64 * j]; }
#pragma unroll
        for (int j = 0; j < 4; ++j) { sa += (va[j].x * va[j].x + va[j].y * va[j].y) + (va[j].z * va[j].z + va[j].w * va[j].w); sb += (vb[j].x * vb[j].x + vb[j].y * vb[j].y) + (vb[j].z * vb[j].z + vb[j].w * vb[j].w); }
        const float ra = rsqrtf(wave_sum(sa) * (1.f / D) + EPS), rb = rsqrtf(wave_sum(sb) * (1.f / D) + EPS);
        v2u* oa = (v2u*)(H + (size_t)mA * D) + lane; v2u* ob = (v2u*)(H + (size_t)mB * D) + lane;
#pragma unroll
        for (int j = 0; j < 4; ++j) { v2u w; w.x = pk2(va[j].x * ra * gv[j].x, va[j].y * ra * gv[j].y); w.y = pk2(va[j].z * ra * gv[j].z, va[j].w * ra * gv[j].w); oa[64 * j] = w; }
        if (hasB) {
#pragma unroll
        for (int j = 0; j < 4; ++j) { v2u w; w.x = pk2(vb[j].x * rb * gv[j].x, vb[j].y * rb * gv[j].y); w.y = pk2(vb[j].z * rb * gv[j].z, vb[j].w * rb * gv[j].w); ob[64 * j] = w; } }
    }
}

__device__ __forceinline__ const bf16* proj_tile(const Args& a, int tile) { return (const bf16*)(a.ws + WS_PROJ + (size_t)tile * PROJ_TILE); }
#define DPPF(x_, ctrl_) __int_as_float(__builtin_amdgcn_update_dpp(0, __float_as_int(x_), ctrl_, 0xF, 0xF, true))
__device__ __forceinline__ void p2_prep(const Args& a, const Ctx& c) {
    const int lane = c.lane, gw = c.vcu * NWAVES + c.wave, NGW = c.G * NWAVES;
    float invf = 0.f;
    if (lane < 8) invf = (float)pow(500000.0, -(double)lane / 8.0); else if (lane < 12) invf = (float)pow(500000.0, -(double)(lane - 8) / 4.0);
    float gq[8], gk[8];
#pragma unroll
    for (int i = 0; i < 8; ++i) { gq[i] = a.in[IN_GQ][8 * (lane & 7) + i]; gk[i] = a.in[IN_GK][8 * (lane & 7) + i]; }
    const int* pos = (const int*)a.in[IN_POS];
    unsigned char* dout = (unsigned char*)a.out;
    bf16* AQN = (bf16*)(dout + DO_AQN); bf16* KN = (bf16*)(dout + DO_KN); bf16* IQR = (bf16*)(dout + DO_IQR); bf16* IKR = (bf16*)(dout + DO_IKR);
    { const bf16* Hh = (const bf16*)(dout + DO_H); const bf16* WSM = (const bf16*)(a.ws + WS_WSM); bf16* SMB = (bf16*)(dout + DO_SMB);
      const int row = lane & 15, kg = lane >> 4;
      const float invfk = (float)pow(500000.0, -(double)(lane & 3) / 4.0);
      for (int tile = gw; tile < T / 16; tile += NGW) { const int t0 = tile * 16;
          f32x4 acc[3];
#pragma unroll
          for (int ct = 0; ct < 3; ++ct) acc[ct] = (f32x4){0.f, 0.f, 0.f, 0.f};
          const bf16* ap = Hh + (size_t)(t0 + row) * 1024 + 8 * kg; const bf16* bp = WSM + (size_t)row * 1024 + 8 * kg;
#pragma unroll 8
          for (int ks = 0; ks < 32; ++ks) { const bf16x8 av = *(const bf16x8*)(ap + 32 * ks);
#pragma unroll
              for (int ct = 0; ct < 3; ++ct) acc[ct] = __builtin_amdgcn_mfma_f32_16x16x32_bf16(av, *(const bf16x8*)(bp + (size_t)ct * 16 * 1024 + 32 * ks), acc[ct], 0, 0, 0); }
          const int col = lane & 15;
#pragma unroll
          for (int r = 0; r < 4; ++r) { const int t = t0 + 4 * kg + r;
              const float angk = (float)pos[t] * invfk;
              const double revk = (double)angk * 0.15915494309189535; const float frk = (float)(revk - __builtin_rint(revk));
              const float ck = __builtin_amdgcn_cosf(frk), sk = __builtin_amdgcn_sinf(frk);
              const float v0 = acc[0][r], pr = __shfl_xor(v0, 4);
              const float o0 = (col < 4) ? (v0 * ck - pr * sk) : ((col < 8) ? (v0 * ck + pr * sk) : v0);
              IKR[(size_t)t * 32 + col] = (bf16)f2bf(o0); IKR[(size_t)t * 32 + 16 + col] = (bf16)f2bf(acc[1][r]);
              SMB[(size_t)t * 16 + col] = (bf16)f2bf(acc[2][r]); } } }
    const int l7 = lane & 7;
    for (int t = gw; t < T; t += NGW) {
        const float ang = (float)pos[t] * invf;
        const double rev = (double)ang * 0.15915494309189535; const float frv = (float)(rev - __builtin_rint(rev));
        float cs = __builtin_amdgcn_cosf(frv), sn = __builtin_amdgcn_sinf(frv);
        float ca[8], sa[8], ci[4], si[4];
#pragma unroll
        for (int i = 0; i < 8; ++i) { ca[i] = __int_as_float(__builtin_amdgcn_readlane(__float_as_int(cs), i)); sa[i] = __int_as_float(__builtin_amdgcn_readlane(__float_as_int(sn), i)); }
#pragma unroll
        for (int i = 0; i < 4; ++i) { ci[i] = __int_as_float(__builtin_amdgcn_readlane(__float_as_int(cs), 8 + i)); si[i] = __int_as_float(__builtin_amdgcn_readlane(__float_as_int(sn), 8 + i)); }
        { const int col = (lane >> 3) * 64 + 8 * l7; const bf16* src = proj_tile(a, TL_AQ + (col >> 8)) + (size_t)t * 256 + (col & 255);
          float f[8]; unpack8(*(const v4u*)src, f); float ss = 0.f;
#pragma unroll
          for (int i = 0; i < 8; ++i) ss += f[i] * f[i];
          ss += DPPF(ss, 0xB1); ss += DPPF(ss, 0x4E); ss += DPPF(ss, 0x141);
          const float r = rsqrtf(ss * (1.f / 64.f) + EPS);
#pragma unroll
          for (int i = 0; i < 8; ++i) f[i] = f[i] * r * gq[i];
          float o[8];
#pragma unroll
          for (int i = 0; i < 8; ++i) { const float p = DPPF(f[i], 0xB1); o[i] = (l7 == 0) ? (f[i] * ca[i] - p * sa[i]) : ((l7 == 1) ? (f[i] * ca[i] + p * sa[i]) : f[i]); o[i] *= 0.125f * 1.4426950408889634f; }
          *(v4u*)(AQN + (size_t)t * 512 + col) = pack8(o); }
        { const int l15 = lane & 15; const int col = (l15 >> 3) * 64 + 8 * l7; const bf16* src = proj_tile(a, TL_KV) + (size_t)t * 256 + col;
          float f[8]; unpack8(*(const v4u*)src, f); float ss = 0.f;
#pragma unroll
          for (int i = 0; i < 8; ++i) ss += f[i] * f[i];
          ss += DPPF(ss, 0xB1); ss += DPPF(ss, 0x4E); ss += DPPF(ss, 0x141);
          const float r = rsqrtf(ss * (1.f / 64.f) + EPS);
#pragma unroll
          for (int i = 0; i < 8; ++i) f[i] = f[i] * r * gk[i];
          float o[8];
#pragma unroll
          for (int i = 0; i < 8; ++i) { const float p = DPPF(f[i], 0xB1); o[i] = (l7 == 0) ? (f[i] * ca[i] - p * sa[i]) : ((l7 == 1) ? (f[i] * ca[i] + p * sa[i]) : f[i]); }
          if (lane < 16) *(v4u*)(KN + (size_t)t * 128 + col) = pack8(o); }
        { const bf16* src = proj_tile(a, TL_IQ) + (size_t)t * 256 + 4 * lane; const v2u rw = *(const v2u*)src;
          float f[4] = {bf2f(rw.x & 0xffffu), bf2f(rw.x >> 16), bf2f(rw.y & 0xffffu), bf2f(rw.y >> 16)}; float o[4];
#pragma unroll
          for (int i = 0; i < 4; ++i) { const float p = DPPF(f[i], 0xB1); o[i] = (l7 == 0) ? (f[i] * ci[i] - p * si[i]) : ((l7 == 1) ? (f[i] * ci[i] + p * si[i]) : f[i]); }
          v2u w; w.x = pk2(o[0], o[1]); w.y = pk2(o[2], o[3]); *(v2u*)(IQR + (size_t)t * 256 + 4 * lane) = w; }
    }
}
constexpr int ML_QS = 0, ML_KS = 17408, ML_HS = 0;
constexpr int ML_KWT = 34816;
constexpr int ML_VT = 53248;
constexpr int ML_SW = 73984;
constexpr int ML_CT = 83200;
constexpr int ML_GA = 122368;
constexpr int ML_CW = ML_GA + 1024;
constexpr int ML_END = ML_CW + (1024 + 384) * 4;
static_assert(ML_END <= MISC_OFF, "mLSTM LDS map");
constexpr size_t ML_STATE_BYTES = 8 * 9 * 64 * 16;
__device__ __forceinline__ bf16x8 lds_frag(const LAS unsigned char* base, int stride_b, int row0, int kb, int lane) {
    return *(const LAS bf16x8*)(base + (row0 + (lane & 15)) * stride_b + kb + (lane >> 4) * 16);
}
__device__ __forceinline__ bf16x8 lds_frag_sw(const LAS unsigned char* base, int row0, int ks, int lane) {
    const int row = row0 + (lane & 15); return *(const LAS bf16x8*)(base + row * 144 + 16 * (((ks * 4 + (lane >> 4)) + (row >> 3)) & 7));
}
#define MFMA16(a_, b_, c_) __builtin_amdgcn_mfma_f32_16x16x32_bf16(a_, b_, c_, 0, 0, 0)
template <int MODE>
__device__ __forceinline__ void mlstm_unit(const Args& a, const Ctx& c, int b, int h, int g) {
    const int tid = c.tid, wave = c.wave; LAS unsigned char* lds = c.lds;
#define ML_LAUNDER() int tv_ = tid; asm volatile("" : "+v"(tv_)); const int lane = tv_ & 63, seg = tv_ & 15, r2 = (tv_ >> 4) * 2; (void)lane; (void)seg; (void)r2
    const bf16* PQ = proj_tile(a, TL_MQ + (h >> 1)) + (h & 1) * 128;
    const bf16* PK = proj_tile(a, TL_MK + (h >> 1)) + (h & 1) * 128;
    const bf16* PV = proj_tile(a, TL_MV + (h >> 1)) + (h & 1) * 128;
    const bf16* PO = proj_tile(a, TL_MO + (h >> 1)) + (h & 1) * 128;
    const bf16* PS = (const bf16*)((unsigned char*)a.out + DO_SMB);
    bf16* YML = (bf16*)((unsigned char*)a.out + DO_YML);
    unsigned char* STB = a.ws + WS_MLST; float* MST = (float*)(a.ws + WS_MLST + 256 * ML_STATE_BYTES);
    LAS float* GAa = (LAS float*)(lds + ML_GA); LAS float* GAm = GAa + 64; LAS float* GAw = GAa + 128; LAS float* GAe = GAa + 192;
    LAS float* CWQ = (LAS float*)(lds + ML_CW); LAS float* CWK = CWQ + 512; LAS float* CBQ = CWQ + 1024; LAS float* CBK = CBQ + 128; LAS float* GN = CBK + 128;
    LAS bf16* VTs = (LAS bf16*)(lds + ML_VT);
    { const float* wc = a.in[IN_WCONV]; const int j = tid >> 7, d = tid & 127;
      CWQ[tid] = wc[j * 1024 + h * 128 + d]; CWK[tid] = wc[j * 1024 + 512 + h * 128 + d];
      if (tid < 128) { CBQ[tid] = a.in[IN_BCONV][h * 128 + tid]; CBK[tid] = a.in[IN_BCONV][512 + h * 128 + tid]; GN[tid] = a.in[IN_GML][h * 128 + tid]; } }
    for (int i = tid; i < 16 * 64; i += 512) { const int r = i >> 6, cc = i & 63; VTs[(128 + r) * 72 + cc] = (r == 0) ? (bf16)0x3F80 : (bf16)0; }
    const float big = a.in[IN_BI][h], bfg = a.in[IN_BF][h];
    const int slot0 = (b * 4 + h) * 8;
    f32x4 cacc[9];
    float m_st = 0.f;
    if (MODE == 1 && g > 0) { ML_LAUNDER();
        const f32x4* sp = (const f32x4*)(STB + (size_t)(slot0 + g) * ML_STATE_BYTES) + wave * 576 + lane;
#pragma unroll
        for (int i = 0; i < 9; ++i) cacc[i] = sp[64 * i];
        m_st = MST[slot0 + g];
#pragma unroll
        for (int ee = 0; ee < 9; ++ee) { v2u w; w.x = pk2(cacc[ee][0], cacc[ee][1]); w.y = pk2(cacc[ee][2], cacc[ee][3]);
            *(LAS v2u*)(lds + ML_CT + (ee * 16 + (lane & 15)) * 272 + (wave * 16 + 4 * (lane >> 4)) * 2) = w; }
    } else {
#pragma unroll
        for (int i = 0; i < 9; ++i) cacc[i] = (f32x4){0.f, 0.f, 0.f, 0.f};
        for (int i = tid; i < 144 * 136 / 2; i += 512) ((LAS unsigned*)(lds + ML_CT))[i] = 0u;
    }
    const size_t tb = (size_t)b * SEQ;
    const char* bq = (const char*)(PQ + tb * 256); const char* bk = (const char*)(PK + tb * 256); const char* bv = (const char*)(PV + tb * 256); const char* bo = (const char*)(PO + tb * 256); const char* bs = (const char*)(PS + tb * 16);
    v4u rq[5], rk[5], rv[2]; unsigned short gi = 0, gf = 0;
#define ML_LOAD(kc) do { _Pragma("unroll") for (int j_ = 0; j_ < 5; ++j_) { const int rr_ = 64 * (kc) + r2 - 3 + j_; const unsigned o_ = (unsigned)((rr_ < 0 ? 0 : rr_) * 512 + seg * 16); \
            v4u q_ = (v4u){0u, 0u, 0u, 0u}; if (MODE == 1) q_ = *(const v4u*)(bq + o_); v4u k_ = *(const v4u*)(bk + o_); if (rr_ < 0) { q_ = (v4u){0u, 0u, 0u, 0u}; k_ = q_; } rq[j_] = q_; rk[j_] = k_; } \
        _Pragma("unroll") for (int i_ = 0; i_ < 2; ++i_) rv[i_] = *(const v4u*)(bv + (unsigned)((64 * (kc) + r2 + i_) * 512 + seg * 16)); \
        gi = *(const unsigned short*)(bs + (unsigned)((64 * (kc) + lane) * 32 + (8 + h) * 2)); gf = *(const unsigned short*)(bs + (unsigned)((64 * (kc) + lane) * 32 + (12 + h) * 2)); } while (0)
    const int kc0 = (MODE == 1) ? 8 * g : 0, kc1 = (MODE == 1) ? 8 * g + 8 : 56;
    { ML_LAUNDER(); ML_LOAD(kc0); }
    __syncthreads();
#pragma unroll 1
    for (int kc = kc0; kc < kc1; ++kc) {
        float wkv, decay, m_new;
        if (MODE == 0 && kc > 0 && (kc & 7) == 0) { ML_LAUNDER();
            f32x4* sp = (f32x4*)(STB + (size_t)(slot0 + (kc >> 3)) * ML_STATE_BYTES) + wave * 576 + lane;
#pragma unroll
            for (int i = 0; i < 9; ++i) sp[64 * i] = cacc[i];
            if (tid == 0) MST[slot0 + (kc >> 3)] = m_st; }
        { ML_LAUNDER();
        const float fpre = bf2f(gf) + bfg, lf = fminf(fpre, 0.f) - log1pf(__expf(-fabsf(fpre)));
        const float ig = bf2f(gi) + big;
        float bc = lf;
#pragma unroll
        for (int o = 1; o < 64; o <<= 1) { const float v = __shfl_up(bc, o); if (lane >= o) bc += v; }
        const float av = ig - bc; float Ac = av;
#pragma unroll
        for (int o = 1; o < 64; o <<= 1) { const float v = __shfl_up(Ac, o); if (lane >= o) Ac = fmaxf(Ac, v); }
        const float mA = fmaxf(m_st, Ac), Mk = __shfl(mA, 63), blast = __shfl(bc, 63);
        wkv = __expf(av - Mk); decay = __expf(m_st - Mk); m_new = blast + Mk;
        if (MODE == 1 && wave == 0) { GAa[lane] = av; GAm[lane] = mA; GAw[lane] = __expf(m_st - mA); GAe[lane] = __expf(-(bc + mA)); } }
        { ML_LAUNDER(); float kw_[2][8];
#pragma unroll
          for (int i = 0; i < 2; ++i) { const int t = r2 + i; const float wkt = __shfl(wkv, t);
            float aq_[8], ak_[8];
            { const f32x4 b0 = *(const LAS f32x4*)(CBQ + seg * 8), b1 = *(const LAS f32x4*)(CBQ + seg * 8 + 4), c0 = *(const LAS f32x4*)(CBK + seg * 8), c1 = *(const LAS f32x4*)(CBK + seg * 8 + 4);
              aq_[0] = b0[0]; aq_[1] = b0[1]; aq_[2] = b0[2]; aq_[3] = b0[3]; aq_[4] = b1[0]; aq_[5] = b1[1]; aq_[6] = b1[2]; aq_[7] = b1[3];
              ak_[0] = c0[0]; ak_[1] = c0[1]; ak_[2] = c0[2]; ak_[3] = c0[3]; ak_[4] = c1[0]; ak_[5] = c1[1]; ak_[6] = c1[2]; ak_[7] = c1[3]; }
#pragma unroll
            for (int j = 0; j < 4; ++j) { float fk_[8]; unpack8(rk[i + j], fk_);
                const f32x4 x0 = *(const LAS f32x4*)(CWK + j * 128 + seg * 8), x1 = *(const LAS f32x4*)(CWK + j * 128 + seg * 8 + 4);
#pragma unroll
                for (int e = 0; e < 4; ++e) { ak_[e] += x0[e] * fk_[e]; ak_[4 + e] += x1[e] * fk_[4 + e]; }
                if (MODE == 1) { float fq_[8]; unpack8(rq[i + j], fq_);
                    const f32x4 w0 = *(const LAS f32x4*)(CWQ + j * 128 + seg * 8), w1 = *(const LAS f32x4*)(CWQ + j * 128 + seg * 8 + 4);
#pragma unroll
                    for (int e = 0; e < 4; ++e) { aq_[e] += w0[e] * fq_[e]; aq_[4 + e] += w1[e] * fq_[4 + e]; } } }
#pragma unroll
            for (int e = 0; e < 8; ++e) { ak_[e] = ak_[e] * sigm(ak_[e]) * 0.08838834764831845f; kw_[i][e] = ak_[e] * wkt; }
            if (MODE == 1) {
#pragma unroll
                for (int e = 0; e < 8; ++e) aq_[e] = aq_[e] * sigm(aq_[e]);
                *(LAS v4u*)(lds + ML_QS + t * 272 + seg * 16) = pack8(aq_);
                *(LAS v4u*)(lds + ML_KS + t * 272 + seg * 16) = pack8(ak_); } }
          const unsigned va[4] = {rv[0].x, rv[0].y, rv[0].z, rv[0].w}, vb[4] = {rv[1].x, rv[1].y, rv[1].z, rv[1].w};
          const int swo = 16 * (((r2 >> 3) + seg) & 7) + 2 * (r2 & 7);
#pragma unroll
          for (int e = 0; e < 8; ++e) { const int ro = (seg * 8 + e) * 144 + swo;
              *(LAS unsigned*)(lds + ML_KWT + ro) = pk2(kw_[0][e], kw_[1][e]);
              const unsigned lo = (e & 1) ? (va[e >> 1] >> 16) : (va[e >> 1] & 0xffffu), hi = (e & 1) ? (vb[e >> 1] >> 16) : (vb[e >> 1] & 0xffffu);
              *(LAS unsigned*)(lds + ML_VT + ro) = lo | (hi << 16); }
        if (kc + 1 < kc1) ML_LOAD(kc + 1); }
        __syncthreads();
        f32x4 hacc[5]; unsigned mo_r[8];
        const int tt = wave & 3, t0 = tt * 16, ne = (wave < 4) ? 5 : 4, e_first = (wave < 4) ? 0 : 5;
        if (MODE == 1) {
        { ML_LAUNDER(); const int tq = t0 + (lane & 15);
        bf16x8 qf[4];
#pragma unroll
        for (int ks = 0; ks < 4; ++ks) qf[ks] = lds_frag(lds + ML_QS, 272, t0, ks * 64, lane);
        const float mAt = GAm[tq], wit = GAw[tq];
#pragma unroll
        for (int si = 0; si < 2; ++si) { const int ss = 2 * (wave >> 2) + si, s0 = ss * 16; f32x4 sacc = (f32x4){0.f, 0.f, 0.f, 0.f};
            if (ss <= tt) {
#pragma unroll
                for (int ks = 0; ks < 4; ++ks) sacc = MFMA16(lds_frag(lds + ML_KS, 272, s0, ks * 64, lane), qf[ks], sacc);
#pragma unroll
                for (int r = 0; r < 4; ++r) { const int s = s0 + 4 * (lane >> 4) + r; sacc[r] = (s <= tq) ? sacc[r] * __expf(GAa[s] - mAt) : 0.f; } }
            v2u w; w.x = pk2(sacc[0], sacc[1]); w.y = pk2(sacc[2], sacc[3]);
            *(LAS v2u*)(lds + ML_SW + tq * 144 + s0 * 2 + (lane >> 4) * 8) = w; }
#pragma unroll
        for (int i = 0; i < 5; ++i) { hacc[i] = (f32x4){0.f, 0.f, 0.f, 0.f};
            if (i < ne) {
#pragma unroll
                for (int ks = 0; ks < 4; ++ks) hacc[i] = MFMA16(lds_frag(lds + ML_CT, 272, (e_first + i) * 16, ks * 64, lane), qf[ks], hacc[i]);
                hacc[i] = hacc[i] * wit; } }
#pragma unroll
        for (int i = 0; i < 8; ++i) mo_r[i] = *(const unsigned*)(bo + (unsigned)((64 * kc + 8 * wave + i) * 512 + 4 * lane)); }
        __syncthreads();
        { ML_LAUNDER(); const int tq = t0 + (lane & 15); bf16x8 swf[2];
#pragma unroll
          for (int ks = 0; ks < 2; ++ks) swf[ks] = lds_frag(lds + ML_SW, 144, t0, ks * 64, lane);
#pragma unroll
          for (int i = 0; i < 5; ++i) if (i < ne) { const int ee = e_first + i;
#pragma unroll
              for (int ks = 0; ks < 2; ++ks) hacc[i] = MFMA16(lds_frag_sw(lds + ML_VT, ee * 16, ks, lane), swf[ks], hacc[i]);
              if (ee < 8) *(LAS f32x4*)(lds + ML_HS + tq * 528 + (ee * 16 + 4 * (lane >> 4)) * 4) = hacc[i];
              else if ((lane >> 4) == 0) *(LAS float*)(lds + ML_HS + tq * 528 + 128 * 4) = hacc[i][0]; } }
        }
        { ML_LAUNDER(); const int d0 = wave * 16; bf16x8 kwf[2];
#pragma unroll
          for (int ks = 0; ks < 2; ++ks) kwf[ks] = lds_frag_sw(lds + ML_KWT, d0, ks, lane);
#pragma unroll
          for (int ee = 0; ee < 9; ++ee) { cacc[ee] = cacc[ee] * decay;
#pragma unroll
              for (int ks = 0; ks < 2; ++ks) cacc[ee] = MFMA16(kwf[ks], lds_frag_sw(lds + ML_VT, ee * 16, ks, lane), cacc[ee]);
              if (MODE == 1) { v2u w; w.x = pk2(cacc[ee][0], cacc[ee][1]); w.y = pk2(cacc[ee][2], cacc[ee][3]);
                  *(LAS v2u*)(lds + ML_CT + (ee * 16 + (lane & 15)) * 272 + (d0 + 4 * (lane >> 4)) * 2) = w; } } }
        __syncthreads();
        if (MODE == 1) {
        { ML_LAUNDER();
#pragma unroll
        for (int i = 0; i < 8; ++i) { const int t = 8 * wave + i;
            const f32x2 nv = *(const LAS f32x2*)(lds + ML_HS + t * 528 + lane * 8); const float den = *(const LAS float*)(lds + ML_HS + t * 528 + 512);
            const float dd = fmaxf(fabsf(den), GAe[t]); const float h0 = nv.x / dd, h1 = nv.y / dd;
            const float r = rsqrtf(wave_sum(h0 * h0 + h1 * h1) * (1.f / 128.f) + EPS);
            const float y0 = h0 * r * GN[2 * lane] * sigm(bf2f(mo_r[i] & 0xffffu)), y1 = h1 * r * GN[2 * lane + 1] * sigm(bf2f(mo_r[i] >> 16));
            *(unsigned*)(YML + (tb + 64 * kc + t) * 512 + h * 128 + 2 * lane) = pk2(y0, y1); } }
        __syncthreads();
        }
        m_st = m_new;
    }
    if (MODE == 0) { ML_LAUNDER();
        f32x4* sp = (f32x4*)(STB + (size_t)(slot0 + 7) * ML_STATE_BYTES) + wave * 576 + lane;
#pragma unroll
        for (int i = 0; i < 9; ++i) sp[64 * i] = cacc[i];
        if (tid == 0) MST[slot0 + 7] = m_st; }
#undef ML_LOAD
#undef ML_LAUNDER
}
constexpr int AT_HIST = 0;
constexpr int AT_HROW = 2049;
constexpr int AT_SEL = 131072 + 256;
constexpr int AT_MROW = 129;
constexpr int AT_SM = AT_SEL + 8448;
static_assert(AT_SM + 256 <= MISC_OFF, "attention LDS map");
__device__ __forceinline__ unsigned score_key(float s) { unsigned u = __float_as_uint(s + 0.0f); return (u & 0x80000000u) ? ~u : (u | 0x80000000u); }
template <int NK> __device__ __forceinline__ void at_resolve(const LAS unsigned long long* cand, LAS unsigned* mask, int m, int nd, int lane) {
    unsigned long long cv[NK];
#pragma unroll
    for (int k = 0; k < NK; ++k) { const int i = 64 * k + lane; unsigned long long x = 0ull; if (i < m) x = cand[i]; cv[k] = (i < m) ? ((((x >> 32) & 0xFFFFFull) << 16) | (x & 0xFFFFull)) : 0ull; }
    unsigned long long T = 0ull;
#pragma unroll 1
    for (int bit = 35; bit >= 16; --bit) { const unsigned long long test = T | (1ull << bit); int cge = 0;
#pragma unroll
        for (int k = 0; k < NK; ++k) cge += __popcll(__ballot(cv[k] >= test));
        if (cge >= nd) T = test; }
    int g = 0, t = 0;
#pragma unroll
    for (int k = 0; k < NK; ++k) { g += __popcll(__ballot(cv[k] >= T + 0x10000ull)); t += __popcll(__ballot(cv[k] >= T)); }
    t -= g;
    if (t > nd - g) {
#pragma unroll 1
        for (int bit = 15; bit >= 0; --bit) { const unsigned long long test = T | (1ull << bit); int cge = 0;
#pragma unroll
            for (int k = 0; k < NK; ++k) cge += __popcll(__ballot(cv[k] >= test));
            if (cge >= nd) T = test; } }
#pragma unroll
    for (int k = 0; k < NK; ++k) if (cv[k] >= T && cv[k] != 0ull) { const unsigned key = 0xFFFFu - (unsigned)(cv[k] & 0xFFFFull);
        __hip_atomic_fetch_or(&mask[key >> 5], 1u << (key & 31u), __ATOMIC_RELAXED, __HIP_MEMORY_SCOPE_WORKGROUP); }
}
__device__ __forceinline__ void attn_unit(const Args& a, const Ctx& c, int b, int qt, float cshift) {
    const int tid = c.tid, wave = c.wave; LAS unsigned char* lds = c.lds;
#define AT_LAUNDER() int tv_ = tid; asm volatile("" : "+v"(tv_)); const int lane = tv_ & 63, qi = tv_ & 15, fq = (tv_ >> 4) & 3; (void)lane; (void)qi; (void)fq
    const int q0 = qt * 16, ch = q0 >> 6, n = 64 * (ch + 1), ntiles = n >> 4;
    const size_t tb = (size_t)b * SEQ;
    unsigned char* dout = (unsigned char*)a.out;
    const bf16* AQN = (const bf16*)(dout + DO_AQN); const bf16* KN = (const bf16*)(dout + DO_KN); const bf16* IQR = (const bf16*)(dout + DO_IQR); const bf16* IKR = (const bf16*)(dout + DO_IKR);
    bf16* YATT = (bf16*)(dout + DO_YATT);
    const bf16* VB = proj_tile(a, TL_KV); const bf16* PS = (const bf16*)(dout + DO_SMB);
    LAS unsigned* HIST = (LAS unsigned*)(lds + AT_HIST);
    LAS unsigned long long* CAND = (LAS unsigned long long*)(lds + AT_HIST);
    LAS unsigned* MASK = (LAS unsigned*)(lds + AT_SEL);
    LAS int* SM = (LAS int*)(lds + AT_SM);
    float* SC = (blockIdx.x < 240) ? (float*)(a.ws + WS_SC) + (size_t)blockIdx.x * (16 * 4096) : (float*)(a.ws + WS_SC2) + (size_t)(blockIdx.x - 240) * (16 * 4096);
#ifndef DBG_REP_SEL
#define DBG_REP_SEL 1
#endif
#ifndef DBG_REP_DENSE
#define DBG_REP_DENSE 1
#endif
#pragma unroll 1
    for (int rsel = 0; rsel < DBG_REP_SEL; ++rsel) {
    if (n > 256) {
        for (int i = tid; i < 8192 + 4; i += 512) ((LAS v4u*)HIST)[i] = (v4u){0u, 0u, 0u, 0u};
        if (tid < 64) SM[tid] = 0;
        for (int i = tid; i < 16 * AT_MROW; i += 512) MASK[i] = 0u;
        bf16x8 qf[8]; float wv[8];
        { AT_LAUNDER();
        const size_t trow = tb + q0 + qi;
#pragma unroll
        for (int h = 0; h < 8; ++h) qf[h] = *(const bf16x8*)(IQR + trow * 256 + h * 32 + 8 * fq);
        { float t8[8]; unpack8(*(const v4u*)(PS + trow * 16), t8);
#pragma unroll
          for (int h = 0; h < 8; ++h) wv[h] = t8[h] * 0.0625f; } }
        __syncthreads();
#define AT_LOADK(kt_) (*(const bf16x8*)(IKR + (tb + (size_t)(kt_) * 16 + qi) * 32 + 8 * fq))
#define AT_SCORES(kf_, sc_) do { \
        _Pragma("unroll") for (int r_ = 0; r_ < 4; ++r_) sc_[r_] = 0.f; \
        _Pragma("unroll") for (int h_ = 0; h_ < 8; ++h_) { const f32x4 d_ = MFMA16(kf_, qf[h_], ((f32x4){0.f, 0.f, 0.f, 0.f})); \
            _Pragma("unroll") for (int r_ = 0; r_ < 4; ++r_) { const int di_ = __float_as_int(d_[r_]); sc_[r_] = __builtin_fmaf(wv[h_], __int_as_float(di_ > 0 ? di_ : 0), sc_[r_]); } } } while (0)
        const int cnt = (ntiles - wave + 7) >> 3;
#ifndef DBG_RA
#define DBG_RA 1
#endif
#pragma unroll 1
        for (int rA = 0; rA < DBG_RA; ++rA) { if (rA) { for (int i = tid; i < 8192 + 4; i += 512) ((LAS v4u*)HIST)[i] = (v4u){0u, 0u, 0u, 0u}; __syncthreads(); }
#define AT_LOADG(dst_, i0_) do { _Pragma("unroll") for (int j_ = 0; j_ < 8; ++j_) { int kt_ = wave + 8 * ((i0_) + j_); kt_ = kt_ < ntiles ? kt_ : ntiles - 1; dst_[j_] = AT_LOADK(kt_); } } while (0)
#define AT_P1GROUP(buf_, base_) do { _Pragma("unroll") for (int j2 = 0; j2 < 8; ++j2) { const bool valid = ((base_) + j2 < cnt); const int kt = wave + 8 * ((base_) + j2); float sc[4]; AT_SCORES(buf_[j2], sc); \
                if (valid) *(f32x4*)(SC + qi * 4096 + kt * 16 + 4 * fq) = (f32x4){sc[0], sc[1], sc[2], sc[3]}; \
                _Pragma("unroll") for (int r = 0; r < 4; ++r) { const unsigned bin = score_key(sc[r]) >> 20; \
                    __hip_atomic_fetch_add(&HIST[qi * AT_HROW + (bin >> 1)], valid ? (1u << ((bin & 1u) * 16)) : 0u, __ATOMIC_RELAXED, __HIP_MEMORY_SCOPE_WORKGROUP); } } } while (0)
        { AT_LAUNDER(); bf16x8 ka[8], kb[8]; AT_LOADG(ka, 0);
#pragma unroll 1
          for (int i0 = 0; i0 < cnt; i0 += 16) {
            AT_LOADG(kb, i0 + 8);
            AT_P1GROUP(ka, i0);
            AT_LOADG(ka, i0 + 16);
            AT_P1GROUP(kb, i0 + 8); } }
#undef AT_P1GROUP
        __syncthreads();
        }
#ifndef DBG_RB
#define DBG_RB 1
#endif
#pragma unroll 1
        for (int rB = 0; rB < DBG_RB; ++rB) {
#pragma unroll 1
        for (int j = 0; j < 2; ++j) { AT_LAUNDER(); const int q = 2 * wave + j; unsigned tot = 0;
            for (int i = 0; i < 32; ++i) { const unsigned w = HIST[q * AT_HROW + 32 * lane + ((i + lane) & 31)]; tot += (w & 0xffffu) + (w >> 16); }
            unsigned suf = tot;
#pragma unroll
            for (int o = 1; o < 64; o <<= 1) { const unsigned v = __shfl_down(suf, o); if (lane + o < 64) suf += v; }
            const unsigned long long mk = __ballot(suf >= 256u); const int L = 63 - __clzll((long long)mk);
            const unsigned above_L = __shfl(suf - tot, L);
            const unsigned w2 = HIST[q * AT_HROW + 32 * L + (lane >> 1)]; const unsigned cb = (lane & 1) ? (w2 >> 16) : (w2 & 0xffffu);
            unsigned sfx = cb;
#pragma unroll
            for (int o = 1; o < 64; o <<= 1) { const unsigned v = __shfl_down(sfx, o); if (lane + o < 64) sfx += v; }
            const unsigned long long mk2 = __ballot(above_L + sfx >= 256u); const int l2 = 63 - __clzll((long long)mk2);
            if (lane == l2) { SM[q] = 64 * L + l2; SM[16 + q] = (int)(256u - (above_L + sfx - cb)); } }
        __syncthreads();
        }
#ifndef DBG_RC
#define DBG_RC 1
#endif
#pragma unroll 1
        for (int rC = 0; rC < DBG_RC; ++rC) { if (rC) { if (tid < 16) SM[48 + tid] = 0; __syncthreads(); }
        { AT_LAUNDER(); const int Bq = SM[qi]; f32x4 scur[8];
#define AT_LOADS(dst_, i0_) do { _Pragma("unroll") for (int j_ = 0; j_ < 8; ++j_) { int kt_ = wave + 8 * ((i0_) + j_); kt_ = kt_ < ntiles ? kt_ : ntiles - 1; dst_[j_] = *(const f32x4*)(SC + qi * 4096 + kt_ * 16 + 4 * fq); } } while (0)
#define AT_P2GROUP(buf_, base_) do { _Pragma("unroll") for (int j2 = 0; j2 < 8; ++j2) { const bool valid = ((base_) + j2 < cnt); const int kt = wave + 8 * ((base_) + j2); \
                unsigned nib = 0u, cnib = 0u; unsigned uu[4]; \
                _Pragma("unroll") for (int r = 0; r < 4; ++r) { uu[r] = score_key(buf_[j2][r]); const int bin = (int)(uu[r] >> 20); nib |= (bin > Bq) ? (1u << r) : 0u; cnib |= (bin == Bq) ? (1u << r) : 0u; } \
                if (!valid) { nib = 0u; cnib = 0u; } \
                if (cnib) { int p = __hip_atomic_fetch_add(&SM[48 + qi], (int)__popc(cnib), __ATOMIC_RELAXED, __HIP_MEMORY_SCOPE_WORKGROUP); \
                    _Pragma("unroll") for (int r = 0; r < 4; ++r) if ((cnib >> r) & 1u) { if (p < 512) CAND[qi * 1024 + p] = ((unsigned long long)uu[r] << 32) | (unsigned long long)(0xFFFFu - (unsigned)(kt * 16 + 4 * fq + r)); ++p; } } \
                if (nib) __hip_atomic_fetch_or(&MASK[qi * AT_MROW + (kt >> 1)], nib << (16 * (kt & 1) + 4 * fq), __ATOMIC_RELAXED, __HIP_MEMORY_SCOPE_WORKGROUP); } } while (0)
          f32x4 sb2[8];
          AT_LOADS(scur, 0);
#pragma unroll 1
          for (int i0 = 0; i0 < cnt; i0 += 16) {
            AT_LOADS(sb2, i0 + 8);
            AT_P2GROUP(scur, i0);
            AT_LOADS(scur, i0 + 16);
            AT_P2GROUP(sb2, i0 + 8); } }
#undef AT_P2GROUP
#undef AT_LOADS
        __syncthreads();
        }
#ifndef DBG_RD
#define DBG_RD 1
#endif
#pragma unroll 1
        for (int rD = 0; rD < DBG_RD; ++rD) {
#pragma unroll 1
        for (int j = 0; j < 2; ++j) { AT_LAUNDER(); const int q = 2 * wave + j; int m = SM[48 + q]; m = m < 512 ? m : 512; const int nd = SM[16 + q];
            if (m <= 256) at_resolve<4>(CAND + q * 1024, MASK + q * AT_MROW, m, nd, lane); else at_resolve<8>(CAND + q * 1024, MASK + q * AT_MROW, m, nd, lane); }
        __syncthreads();
        }
#undef AT_SCORES
#undef AT_LOADK
#undef AT_LOADG
    } else {
#pragma unroll 1
        for (int i = tid; i < 16 * AT_MROW; i += 512) MASK[i] = ((i % AT_MROW) < (n >> 5)) ? 0xFFFFFFFFu : 0u;
        __syncthreads();
    }
    }
#pragma unroll 1
    for (int rden = 0; rden < DBG_REP_DENSE; ++rden) {
    { const int g = wave >> 2, kh = (wave >> 1) & 1, hp = wave & 1, NS = n >> 6;
      const unsigned ring0 = (unsigned)(size_t)(lds + AT_HIST);
      const bf16* dsrc[4]; unsigned ddst[4];
      { AT_LAUNDER();
#pragma unroll
        for (int i_ = 0; i_ < 4; ++i_) { const int in_ = 4 * wave + i_; const int row_ = 4 * (in_ & 15) + (lane >> 4), pos_ = lane & 15;
            dsrc[i_] = (in_ < 16) ? (KN + (tb + row_) * 128 + ((pos_ ^ (row_ & 15)) << 3)) : (VB + (tb + row_) * 256 + 128 + ((pos_ ^ (2 * (row_ & 7))) << 3));
            ddst[i_] = (unsigned)(in_ * 1024); } }
      const size_t dstep = (wave < 4) ? (size_t)64 * 128 : (size_t)64 * 256;
#define AT_STAGE(s_) do { const unsigned sb_ = ring0 + (unsigned)(((s_) & 3) * 32768); \
        _Pragma("unroll") for (int i_ = 0; i_ < 4; ++i_) { const bf16* src_ = dsrc[i_] + (size_t)(s_) * dstep; \
            const unsigned dst_ = __builtin_amdgcn_readfirstlane(sb_ + ddst[i_]); unsigned keep_; \
            asm volatile("s_mov_b32 %0, m0\n\ts_mov_b32 m0, %2\n\ts_nop 0\n\tglobal_load_lds_dwordx4 %1, off\n\ts_mov_b32 m0, %0" : "=&s"(keep_) : "v"(src_), "s"(dst_) : "memory"); } } while (0)
      bf16x8 qa[2], qb[2]; f32x4 oacc[2][4], lacc[2];
      { AT_LAUNDER();
#pragma unroll
        for (int hi = 0; hi < 2; ++hi) { const bf16* qp = AQN + (tb + q0 + qi) * 512 + (g * 4 + 2 * hp + hi) * 64 + 8 * fq; qa[hi] = *(const bf16x8*)qp; qb[hi] = *(const bf16x8*)(qp + 32); } }
#pragma unroll
      for (int hi = 0; hi < 2; ++hi) { lacc[hi] = (f32x4){0.f, 0.f, 0.f, 0.f};
#pragma unroll
        for (int dt = 0; dt < 4; ++dt) oacc[hi][dt] = (f32x4){0.f, 0.f, 0.f, 0.f}; }
      const bf16x8 ones = (bf16x8){0x3F80, 0x3F80, 0x3F80, 0x3F80, 0x3F80, 0x3F80, 0x3F80, 0x3F80};
      const f32x4 negc = (f32x4){-cshift, -cshift, -cshift, -cshift};
      asm volatile("s_waitcnt vmcnt(0)" ::: "memory");
#pragma unroll 1
      for (int s = 0; s < 3 && s < NS; ++s) AT_STAGE(s);
      typedef short s4_t __attribute__((ext_vector_type(4)));
      AT_LAUNDER();
#pragma unroll 1
      for (int s = 0; s < NS; ++s) {
          if (s + 2 < NS) asm volatile("s_waitcnt vmcnt(8)" ::: "memory"); else asm volatile("s_waitcnt vmcnt(0)" ::: "memory");
          __builtin_amdgcn_s_barrier(); asm volatile("" ::: "memory");
          if (s + 3 < NS) AT_STAGE(s + 3);
          { const LAS unsigned char* kb = lds + AT_HIST + (s & 3) * 32768; const LAS unsigned char* vbs = kb + 16384;
            const unsigned mw = MASK[qi * AT_MROW + 2 * s + kh] >> (4 * fq);
            f32x4 st[2][2];
#pragma unroll
            for (int t = 0; t < 2; ++t) { const int row = 16 * (2 * kh + t) + qi;
                const bf16x8 k0 = *(const LAS bf16x8*)(kb + row * 256 + (((g * 8 + fq) ^ (row & 15)) << 4)), k1 = *(const LAS bf16x8*)(kb + row * 256 + (((g * 8 + 4 + fq) ^ (row & 15)) << 4));
#pragma unroll
                for (int hi = 0; hi < 2; ++hi) { f32x4 d = MFMA16(k0, qa[hi], negc); st[hi][t] = MFMA16(k1, qb[hi], d); } }
            bf16x8 pb[2];
#pragma unroll
            for (int hi = 0; hi < 2; ++hi) { float pv[8];
#pragma unroll
                for (int j = 0; j < 8; ++j) { const float e = __builtin_amdgcn_exp2f(st[hi][j >> 2][j & 3]);
                    const int keep = __builtin_amdgcn_sbfe((int)mw, 16 * (j >> 2) + (j & 3), 1); pv[j] = __uint_as_float(__float_as_uint(e) & (unsigned)keep); }
                v4u pw; pw.x = pk2(pv[0], pv[1]); pw.y = pk2(pv[2], pv[3]); pw.z = pk2(pv[4], pv[5]); pw.w = pk2(pv[6], pv[7]); pb[hi] = __builtin_bit_cast(bf16x8, pw);
                lacc[hi] = MFMA16(ones, pb[hi], lacc[hi]); }
#pragma unroll
            for (int dt = 0; dt < 4; ++dt) { const int r1 = 32 * kh + 4 * fq + (qi >> 2), r2 = r1 + 16; const int ch = g * 8 + 2 * dt + ((lane & 3) >> 1);
                const s4_t lo = __builtin_amdgcn_ds_read_tr16_b64_v4i16((LAS s4_t*)(vbs + r1 * 256 + ((ch ^ (2 * (r1 & 7))) << 4) + (lane & 1) * 8));
                const s4_t hi4 = __builtin_amdgcn_ds_read_tr16_b64_v4i16((LAS s4_t*)(vbs + r2 * 256 + ((ch ^ (2 * (r2 & 7))) << 4) + (lane & 1) * 8));
                const bf16x8 va = (bf16x8){lo[0], lo[1], lo[2], lo[3], hi4[0], hi4[1], hi4[2], hi4[3]};
#pragma unroll
                for (int hi = 0; hi < 2; ++hi) oacc[hi][dt] = MFMA16(va, pb[hi], oacc[hi][dt]); } } }
      __syncthreads();
      { AT_LAUNDER(); LAS unsigned char* red = lds + AT_HIST + (g * 2 + hp) * 8704;
        if (kh == 1) {
#pragma unroll
            for (int hi = 0; hi < 2; ++hi) {
#pragma unroll
                for (int dt = 0; dt < 4; ++dt) *(LAS f32x4*)(red + (hi * 4 + dt) * 1024 + lane * 16) = oacc[hi][dt];
                *(LAS float*)(red + 8192 + hi * 256 + lane * 4) = lacc[hi][0]; } } }
      __syncthreads();
      if (kh == 0) { AT_LAUNDER(); const LAS unsigned char* red = lds + AT_HIST + (g * 2 + hp) * 8704;
#pragma unroll
        for (int hi = 0; hi < 2; ++hi) { const float inv = 1.0f / (lacc[hi][0] + *(const LAS float*)(red + 8192 + hi * 256 + lane * 4));
            bf16* yp = YATT + (tb + q0 + qi) * 512 + (g * 4 + 2 * hp + hi) * 64 + 4 * fq;
#pragma unroll
            for (int dt = 0; dt < 4; ++dt) { const f32x4 o = oacc[hi][dt] + *(const LAS f32x4*)(red + (hi * 4 + dt) * 1024 + lane * 16);
                v2u w; w.x = pk2(o[0] * inv, o[1] * inv); w.y = pk2(o[2] * inv, o[3] * inv); *(v2u*)(yp + 16 * dt) = w; } } }
#undef AT_STAGE
    }
    __syncthreads();
    }
#undef AT_LAUNDER
    __syncthreads();
}

#ifndef DBG_REP_ML
#define DBG_REP_ML 1
#endif
#ifndef DBG_REP_ATT
#define DBG_REP_ATT 1
#endif
__device__ __forceinline__ void p3_mixer(const Args& a, const Ctx& c, volatile LAS unsigned* MISC, int rep) {
#if !defined(NO_MLSTM)
#pragma unroll 1
    for (int rr = 0; rr < DBG_REP_ML; ++rr)
#pragma unroll 1
        for (int u = blockIdx.x; u < 32; u += c.G) mlstm_unit<0>(a, c, u >> 2, u & 3, 0);
#endif
    unsigned* ctl = (unsigned*)(a.ws + WS_CTL);
    const int x = (int)(__builtin_amdgcn_s_getreg((3 << 11) | 20) & 7u);
    float cshift;
    { float gq = fabsf(a.in[IN_GQ][c.lane]), gk = fabsf(a.in[IN_GK][c.lane]);
#pragma unroll
      for (int o = 1; o < 64; o <<= 1) { gq = fmaxf(gq, __shfl_xor(gq, o)); gk = fmaxf(gk, __shfl_xor(gk, o)); }
      cshift = 8.0f * 1.4426950408889634f * gq * gk; }
#pragma unroll 1
    for (int rot = 0; rot < 8 * DBG_REP_ATT; ++rot) { rep = rot >> 3; const int bq = (x + rot) & 7;
        if (c.tid == 0) MISC[16] = __hip_atomic_fetch_add(ctl + CW_Q + 512 * rep + 64 * bq, 1u, RLX_AGENT);
        __syncthreads();
        int u = (int)MISC[16];
        __syncthreads();
#pragma unroll 1
        while (u < 256) {
            unsigned nxt = 0u;
            if (c.tid == 0) nxt = __hip_atomic_fetch_add(ctl + CW_Q + 512 * rep + 64 * bq, 1u, RLX_AGENT);
#if !defined(NO_ATTN)
            attn_unit(a, c, bq, 255 - u, cshift);
#endif
            if (c.tid == 0) MISC[16] = nxt;
            __syncthreads();
            u = (int)MISC[16];
            __syncthreads();
        } }
}
constexpr int RT_WT = 0;
constexpr int RT_WROW = 1028;
constexpr int RT_LG = 36 * RT_WROW * 4;
constexpr int RT_RSTD = RT_LG + 64 * 36 * 4;
constexpr int RT_LCNT = RT_RSTD + 512;
static_assert(RT_LCNT + 128 <= MISC_OFF, "router LDS map");
__device__ __forceinline__ void p6_router(const Args& a, const Ctx& c) {
    const int tid = c.tid, lane = c.lane, wave = c.wave; LAS unsigned char* lds = c.lds;
    LAS float* WT = (LAS float*)(lds + RT_WT); LAS float* LG = (LAS float*)(lds + RT_LG); LAS float* RSTD = (LAS float*)(lds + RT_RSTD); LAS int* LCNT = (LAS int*)(lds + RT_LCNT);
    { int* RT = (int*)(a.ws + WS_ROWTOK); for (int i = blockIdx.x * 512 + tid; i < NROWS_MAX; i += c.G * 512) RT[i] = 0; }
    { const f32x4* src = (const f32x4*)(a.ws + WS_WTG); LAS f32x4* dst = (LAS f32x4*)WT; for (int i = tid; i < 36 * RT_WROW / 4; i += 512) dst[i] = src[i]; }
    f32x4 gv[4];
#pragma unroll
    for (int j = 0; j < 4; ++j) gv[j] = *(const f32x4*)(a.in[IN_GMOE] + 4 * lane + 256 * j);
    const float* X1 = a.out; bf16* XN = (bf16*)(a.ws + WS_XN);
    int* TOKE = (int*)(a.ws + WS_TOKE); int* TOKR = (int*)(a.ws + WS_TOKR); float* TOKG = (float*)(a.ws + WS_TOKG); int* CNT = (int*)(a.ws + WS_CNT);
    __syncthreads();
    for (int blk = blockIdx.x; blk < 256; blk += c.G) {
        if (tid < 32) LCNT[tid] = 0;
#pragma unroll 1
        for (int ri = 0; ri < 16; ri += 2) { const int tA = blk * 128 + wave * 16 + ri, tB = tA + 1;
            const f32x4* xa = (const f32x4*)(X1 + (size_t)tA * D) + lane; const f32x4* xb = (const f32x4*)(X1 + (size_t)tB * D) + lane;
            f32x4 va[4], vb[4]; float sa = 0.f, sb = 0.f;
#pragma unroll
            for (int j = 0; j < 4; ++j) { va[j] = xa[64 * j]; vb[j] = xb[64 * j]; }
#pragma unroll
            for (int j = 0; j < 4; ++j) { sa += (va[j].x * va[j].x + va[j].y * va[j].y) + (va[j].z * va[j].z + va[j].w * va[j].w); sb += (vb[j].x * vb[j].x + vb[j].y * vb[j].y) + (vb[j].z * vb[j].z + vb[j].w * vb[j].w); }
            const float ra = rsqrtf(wave_sum(sa) * (1.f / D) + EPS), rb = rsqrtf(wave_sum(sb) * (1.f / D) + EPS);
            if (lane == 0) { RSTD[wave * 16 + ri] = ra; RSTD[wave * 16 + ri + 1] = rb; }
            v2u* oa = (v2u*)(XN + (size_t)tA * D) + lane; v2u* ob = (v2u*)(XN + (size_t)tB * D) + lane;
#pragma unroll
            for (int j = 0; j < 4; ++j) { v2u w; w.x = pk2(va[j].x * ra * gv[j].x, va[j].y * ra * gv[j].y); w.y = pk2(va[j].z * ra * gv[j].z, va[j].w * ra * gv[j].w); oa[64 * j] = w;
                v2u u; u.x = pk2(vb[j].x * rb * gv[j].x, vb[j].y * rb * gv[j].y); u.y = pk2(vb[j].z * rb * gv[j].z, vb[j].w * rb * gv[j].w); ob[64 * j] = u; } }
        f32x4 acc[3];
#pragma unroll
        for (int ct = 0; ct < 3; ++ct) acc[ct] = (f32x4){0.f, 0.f, 0.f, 0.f};
        { const int row = lane & 15, kq = lane >> 4;
          const f32x4* ap = (const f32x4*)(X1 + (size_t)(blk * 128 + wave * 16 + row) * D + 4 * kq);
          int cj[3]; cj[0] = row; cj[1] = 16 + row; cj[2] = (32 + row) < 36 ? (32 + row) : 35;
          const LAS f32x4* bp0 = (const LAS f32x4*)(WT + cj[0] * RT_WROW + 4 * kq); const LAS f32x4* bp1 = (const LAS f32x4*)(WT + cj[1] * RT_WROW + 4 * kq); const LAS f32x4* bp2 = (const LAS f32x4*)(WT + cj[2] * RT_WROW + 4 * kq);
#define RT_LOADA(dst_, b_) do { _Pragma("unroll") for (int i_ = 0; i_ < 8; ++i_) dst_[i_] = ap[4 * (8 * ((b_) < 8 ? (b_) : 7) + i_)]; } while (0)
#define RT_MMA(src_, b_) do { _Pragma("unroll") for (int i_ = 0; i_ < 8; ++i_) { const int ks_ = 8 * (b_) + i_; const f32x4 b0 = bp0[4 * ks_], b1 = bp1[4 * ks_], b2 = bp2[4 * ks_]; \
              _Pragma("unroll") for (int j = 0; j < 4; ++j) { acc[0] = __builtin_amdgcn_mfma_f32_16x16x4f32(src_[i_][j], b0[j], acc[0], 0, 0, 0); acc[1] = __builtin_amdgcn_mfma_f32_16x16x4f32(src_[i_][j], b1[j], acc[1], 0, 0, 0); \
                  acc[2] = __builtin_amdgcn_mfma_f32_16x16x4f32(src_[i_][j], b2[j], acc[2], 0, 0, 0); } } } while (0)
          f32x4 aA[8], aB[8]; RT_LOADA(aA, 0);
#pragma unroll 1
          for (int bb = 0; bb < 8; bb += 2) { RT_LOADA(aB, bb + 1); RT_MMA(aA, bb); RT_LOADA(aA, bb + 2); RT_MMA(aB, bb + 1); }
#undef RT_LOADA
#undef RT_MMA
        }
#pragma unroll 1
        for (int half = 0; half < 2; ++half) {
            __syncthreads();
            if ((wave >> 2) == half) { const int col = lane & 15, kq = lane >> 4;
#pragma unroll
                for (int ct = 0; ct < 3; ++ct) if (16 * ct + col < 36) {
#pragma unroll
                    for (int r = 0; r < 4; ++r) LG[((wave & 3) * 16 + 4 * kq + r) * 36 + 16 * ct + col] = acc[ct][r]; } }
            __syncthreads();
            if (tid < 64) { const int row = half * 64 + tid, t = blk * 128 + row; const float rs = RSTD[row]; const LAS float* lg = LG + tid * 36;
                float gl[4];
#pragma unroll
                for (int i = 0; i < 4; ++i) gl[i] = rs * lg[32 + i] + a.in[IN_BRG][i];
                int gs = 0; float gmax = gl[0];
#pragma unroll
                for (int i = 1; i < 4; ++i) if (gl[i] > gmax) { gmax = gl[i]; gs = i; }
                float gsum = 0.f;
#pragma unroll
                for (int i = 0; i < 4; ++i) gsum += expf(gl[i] - gmax);
                const float gtop = 1.0f / gsum;
                float ev[8];
#pragma unroll
                for (int i = 0; i < 8; ++i) ev[i] = rs * lg[gs * 8 + i] + a.in[IN_BRE][gs * 8 + i];
                int l0 = 0; float v0 = ev[0];
#pragma unroll
                for (int i = 1; i < 8; ++i) if (ev[i] > v0) { v0 = ev[i]; l0 = i; }
                int l1 = -1; float v1 = -3.0e38f;
#pragma unroll
                for (int i = 0; i < 8; ++i) if (i != l0 && ev[i] > v1) { v1 = ev[i]; l1 = i; }
                const float e1 = expf(v1 - v0), s0 = 1.0f / (1.0f + e1), s1 = e1 * s0;
                const int ex0 = gs * 8 + l0, ex1 = gs * 8 + l1;
                const int rk0 = __hip_atomic_fetch_add(&LCNT[ex0], 1, __ATOMIC_RELAXED, __HIP_MEMORY_SCOPE_WORKGROUP);
                const int rk1 = __hip_atomic_fetch_add(&LCNT[ex1], 1, __ATOMIC_RELAXED, __HIP_MEMORY_SCOPE_WORKGROUP);
                TOKE[2 * t] = ex0; TOKE[2 * t + 1] = ex1; TOKR[2 * t] = rk0; TOKR[2 * t + 1] = rk1; TOKG[2 * t] = s0 * gtop; TOKG[2 * t + 1] = s1 * gtop; }
        }
        __syncthreads();
        if (tid < 32) CNT[blk * 32 + tid] = LCNT[tid];
        __syncthreads();
    }
}
__device__ __forceinline__ void p7_gather(const Args& a, const Ctx& c) {
    const int tid = c.tid, lane = c.lane, wave = c.wave;
    LAS int* PART = (LAS int*)c.lds; LAS int* PPRE = PART + 512; LAS int* TOT = PPRE + 512; LAS int* TS = TOT + 32; LAS int* BASE = TS + 64;
    const int* CNT = (const int*)(a.ws + WS_CNT); const int* TOKE = (const int*)(a.ws + WS_TOKE); const int* TOKR = (const int*)(a.ws + WS_TOKR); int* TOKP = (int*)(a.ws + WS_TOKP);
    int* RT = (int*)(a.ws + WS_ROWTOK);
    { const int e = tid & 31, p = tid >> 5; int s = 0; for (int k = 0; k < 16; ++k) s += CNT[(16 * p + k) * 32 + e]; PART[p * 32 + e] = s; }
    __syncthreads();
    if (tid < 32) { int run = 0; for (int p = 0; p < 16; ++p) { PPRE[p * 32 + tid] = run; run += PART[p * 32 + tid]; } TOT[tid] = run; }
    __syncthreads();
    if (tid == 0) { int ts = 0; for (int e = 0; e < 32; ++e) { TS[e] = ts; ts += (TOT[e] + 255) >> 8; } TS[32] = ts; }
    __syncthreads();
    if (blockIdx.x == 0 && tid < 33) ((int*)(a.ws + WS_SMALL))[tid] = TS[tid];
    for (int blk = blockIdx.x; blk < 256; blk += c.G) {
        if (tid < 32) { int s = TS[tid] * 256 + PPRE[(blk >> 4) * 32 + tid]; for (int b2 = (blk & ~15); b2 < blk; ++b2) s += CNT[b2 * 32 + tid]; BASE[tid] = s; }
        __syncthreads();
        { const int t = blk * 128 + (tid >> 2), jj = tid & 3;
          if (jj < 2) { const int pos = BASE[TOKE[2 * t + jj]] + TOKR[2 * t + jj]; TOKP[2 * t + jj] = pos; RT[pos] = t; } }
        __syncthreads();
    }
}
__device__ __forceinline__ void p10_combine(const Args& a, const Ctx& c) {
    const int lane = c.lane, gw = c.vcu * NWAVES + c.wave, NGW = c.G * NWAVES;
    const int* TOKP = (const int*)(a.ws + WS_TOKP); const float* TOKG = (const float*)(a.ws + WS_TOKG); const bf16* Y = (const bf16*)(a.ws + WS_Y);
    for (int t0 = gw; t0 < T; t0 += 2 * NGW) {
        const int tA = t0, tB = (t0 + NGW < T) ? t0 + NGW : t0; const bool hasB = (t0 + NGW < T);
        const int pA0 = TOKP[2 * tA], pA1 = TOKP[2 * tA + 1], pB0 = TOKP[2 * tB], pB1 = TOKP[2 * tB + 1];
        const float gA0 = TOKG[2 * tA], gA1 = TOKG[2 * tA + 1], gB0 = TOKG[2 * tB], gB1 = TOKG[2 * tB + 1];
        f32x4 xa[4], xb[4]; v2u ya0[4], ya1[4], yb0[4], yb1[4];
#pragma unroll
        for (int j = 0; j < 4; ++j) { const int cc = 4 * lane + 256 * j;
            xa[j] = *(const f32x4*)(a.out + (size_t)tA * D + cc); xb[j] = *(const f32x4*)(a.out + (size_t)tB * D + cc);
            ya0[j] = *(const v2u*)(Y + (size_t)pA0 * D + cc); ya1[j] = *(const v2u*)(Y + (size_t)pA1 * D + cc);
            yb0[j] = *(const v2u*)(Y + (size_t)pB0 * D + cc); yb1[j] = *(const v2u*)(Y + (size_t)pB1 * D + cc); }
#pragma unroll
        for (int j = 0; j < 4; ++j) { const int cc = 4 * lane + 256 * j; f32x4 x = xa[j];
            x[0] += gA0 * bf2f(ya0[j].x & 0xffffu) + gA1 * bf2f(ya1[j].x & 0xffffu); x[1] += gA0 * bf2f(ya0[j].x >> 16) + gA1 * bf2f(ya1[j].x >> 16);
            x[2] += gA0 * bf2f(ya0[j].y & 0xffffu) + gA1 * bf2f(ya1[j].y & 0xffffu); x[3] += gA0 * bf2f(ya0[j].y >> 16) + gA1 * bf2f(ya1[j].y >> 16);
            *(f32x4*)(a.out + (size_t)tA * D + cc) = x; }
        if (hasB) {
#pragma unroll
        for (int j = 0; j < 4; ++j) { const int cc = 4 * lane + 256 * j; f32x4 x = xb[j];
            x[0] += gB0 * bf2f(yb0[j].x & 0xffffu) + gB1 * bf2f(yb1[j].x & 0xffffu); x[1] += gB0 * bf2f(yb0[j].x >> 16) + gB1 * bf2f(yb1[j].x >> 16);
            x[2] += gB0 * bf2f(yb0[j].y & 0xffffu) + gB1 * bf2f(yb1[j].y & 0xffffu); x[3] += gB0 * bf2f(yb0[j].y >> 16) + gB1 * bf2f(yb1[j].y >> 16);
            *(f32x4*)(a.out + (size_t)tB * D + cc) = x; } }
    }
}
__global__ void __launch_bounds__(NWAVES * 64, 2) hybrid_fwd(Args args) {
    extern __shared__ __attribute__((aligned(16))) unsigned char lds_raw[];
    Ctx c; c.lds = (LAS unsigned char*)lds_raw;
    volatile LAS unsigned* MISC = (volatile LAS unsigned*)(c.lds + MISC_OFF);
    c.tid = threadIdx.x; c.lane = c.tid & 63; c.wave = __builtin_amdgcn_readfirstlane(c.tid >> 6);
    c.G = gridDim.x; { const int bx = blockIdx.x; c.vcu = (c.G % 8 == 0) ? (bx % 8) * (c.G / 8) + bx / 8 : bx; }
    unsigned* ctl = (unsigned*)(args.ws + WS_CTL);
    if (c.tid < 128) MISC[c.tid] = 0u;
    __syncthreads();
    XcdBarrier bar; bar.bar = ctl + CW_BAR; bar.x = 0; bar.st = nullptr;
    if (N_LAUNCHES == 1) bar = xcd_barrier_post(ctl + CW_BAR, MISC + 8);
#define GRID_BAR() do { if (N_LAUNCHES == 1) xcd_barrier(bar); } while (0)
    const int lo = args.ph_lo, hi = args.ph_hi;
#ifndef PH_MASK
#define PH_MASK 0xfff
#endif
#define IN(k) (((PH_MASK >> (k)) & 1) && lo <= (k) && (k) < hi)
#define BOTH(k) (IN(k) && IN((k) + 1))
    unsigned char* ws = args.ws; unsigned char* dout = (unsigned char*)args.out;
#ifndef DBG_REPEAT
#define DBG_REPEAT -1
#endif
#define REPS(k) (((k) == DBG_REPEAT) ? 2 : 1)
    if (IN(0)) { _Pragma("unroll") for (int rep = 0; rep < REPS(0); ++rep) { if (rep) GRID_BAR(); p0_prologue<0>(args, c, c.vcu * NWAVES + c.wave, c.G * NWAVES); } if (BOTH(0)) GRID_BAR(); }
    if (IN(1)) { _Pragma("unroll") for (int rep = 0; rep < REPS(1); ++rep) { if (rep) GRID_BAR();
        pg8::Gemm g{(const pg8::bf16_t*)(dout + DO_H), (const pg8::bf16_t*)(ws + WS_WIN), T, NPROJ, D}; pg8::StaticOrder S; S.init(T, NPROJ, c.G, (int)blockIdx.x);
        pg8::EpiBf16<0> E{(pg8::bf16_t*)(ws + WS_PROJ), 256, nullptr, 256, (size_t)T * 256, 1.f};
        pg8::gemm_phase<pg8::EpiBf16<0>, pg8::StaticOrder, true, true>(c.lds, g, S, E); }
        if (BOTH(1)) GRID_BAR();
    }
#ifndef DBG_R2
#define DBG_R2 1
#endif
#ifndef DBG_R4A
#define DBG_R4A 1
#endif
#ifndef DBG_R4B
#define DBG_R4B 1
#endif
#ifndef DBG_R7
#define DBG_R7 1
#endif
    if (IN(2)) { _Pragma("unroll 1") for (int rep = 0; rep < DBG_R2; ++rep) { if (rep) GRID_BAR(); p2_prep(args, c); } if (BOTH(2)) GRID_BAR(); }
    if (IN(3)) { _Pragma("unroll") for (int rep = 0; rep < REPS(3); ++rep) { if (rep) GRID_BAR(); p3_mixer(args, c, MISC, rep); } if (BOTH(3)) GRID_BAR(); }
    if (IN(4)) {
#pragma unroll 1
        for (int rep = 0; rep < DBG_R4A; ++rep) { p0_prologue<1>(args, c, c.vcu * NWAVES + c.wave, c.G * NWAVES); __syncthreads(); }
#pragma unroll 1
        for (int rep = 0; rep < DBG_R4B; ++rep)
#pragma unroll 1
        for (int u = blockIdx.x; u < 256; u += c.G) mlstm_unit<1>(args, c, u >> 5, (u >> 3) & 3, u & 7);
        if (BOTH(4)) GRID_BAR();
    }
    if (IN(5)) {
        { pg8::Gemm g{(const pg8::bf16_t*)(dout + DO_YATT), (const pg8::bf16_t*)(ws + WS_WPA), T, D, 512}; pg8::StaticOrder S; S.init(T, D, c.G, (int)blockIdx.x);
          pg8::EpiGate<false> E{(pg8::bf16_t*)(ws + WS_MERGED), D, (const pg8::bf16_t*)(ws + WS_PROJ + (size_t)TL_GA * PROJ_TILE), (size_t)T * 256};
          pg8::gemm_phase<pg8::EpiGate<false>, pg8::StaticOrder, true, true>(c.lds, g, S, E); }
        __syncthreads();
        { pg8::Gemm g{(const pg8::bf16_t*)(dout + DO_YML), (const pg8::bf16_t*)(ws + WS_WPM), T, D, 512}; pg8::StaticOrder S; S.init(T, D, c.G, (int)blockIdx.x);
          pg8::EpiGate<true> E{(pg8::bf16_t*)(ws + WS_MERGED), D, (const pg8::bf16_t*)(ws + WS_PROJ + (size_t)TL_GM * PROJ_TILE), (size_t)T * 256};
          pg8::gemm_phase<pg8::EpiGate<true>, pg8::StaticOrder, true, true>(c.lds, g, S, E); }
        if (BOTH(5)) GRID_BAR();
    }
    if (IN(6)) {
        pg8::Gemm g{(const pg8::bf16_t*)(ws + WS_MERGED), (const pg8::bf16_t*)(ws + WS_WOUT), T, D, D}; pg8::StaticOrder S; S.init(T, D, c.G, (int)blockIdx.x);
        pg8::EpiRes E{args.out, args.in[IN_X], D};
        pg8::gemm_phase<pg8::EpiRes, pg8::StaticOrder, true, true>(c.lds, g, S, E);
        if (BOTH(6)) GRID_BAR();
    }
    if (IN(7)) { _Pragma("unroll 1") for (int rep = 0; rep < DBG_R7; ++rep) { if (rep) { GRID_BAR(); } p6_router(args, c); } if (BOTH(7)) GRID_BAR(); }
    if (IN(8)) { _Pragma("unroll") for (int rep = 0; rep < REPS(8); ++rep) { if (rep) GRID_BAR(); p7_gather(args, c); } if (BOTH(8)) GRID_BAR(); }
    if (IN(9) || IN(10)) {
        LAS int* TSL = (LAS int*)(c.lds + MISC_OFF + 256);
        if (c.tid < 33) TSL[c.tid] = (int)__hip_atomic_load((unsigned*)(ws + WS_SMALL) + c.tid, RLX_AGENT);
        __syncthreads();
        if (IN(9)) {
            pg8::MoeOrder<true> S{TSL, c.G, (int)blockIdx.x, (const int*)(ws + WS_ROWTOK)};
            pg8::Gemm g{(const pg8::bf16_t*)(ws + WS_XN), (const pg8::bf16_t*)(ws + WS_GU), 0, 0, D};
            pg8::EpiSwiGLU E{(pg8::bf16_t*)(ws + WS_HID)};
            pg8::gemm_phase<pg8::EpiSwiGLU, pg8::MoeOrder<true>, true, true>(c.lds, g, S, E);
            if (BOTH(9)) GRID_BAR();
        }
        if (IN(10)) {
            pg8::MoeOrder<false> S{TSL, c.G, (int)blockIdx.x, nullptr};
            pg8::Gemm g{(const pg8::bf16_t*)(ws + WS_HID), (const pg8::bf16_t*)(ws + WS_DN), 0, 0, 512};
            pg8::EpiDown E{(pg8::bf16_t*)(ws + WS_Y)};
            pg8::gemm_phase<pg8::EpiDown, pg8::MoeOrder<false>, true, true>(c.lds, g, S, E);
            if (BOTH(10)) GRID_BAR();
        }
    }
    if (IN(11)) p10_combine(args, c);
#undef IN
#undef BOTH
#undef GRID_BAR
}

extern "C" void kernel_launch(void* const* d_in, const int* in_sizes, int n_in, void* d_out, int out_size, void* d_ws, size_t ws_size, hipStream_t stream) {
    static int grid = 0;
    if (grid == 0) {
        if (n_in != 22 || in_sizes[0] != T * D || out_size != T * D || ws_size < WS_END) { fprintf(stderr, "kernel_launch: unexpected shapes (n_in %d, in0 %d, out %d, ws %zu); nothing launched\n", n_in, n_in > 0 ? in_sizes[0] : -1, out_size, ws_size); grid = -1; return; }
        int dev = 0, cus = 0, per_cu = 0;
        if (hipGetDevice(&dev) != hipSuccess || hipDeviceGetAttribute(&cus, hipDeviceAttributeMultiprocessorCount, dev) != hipSuccess) { grid = -1; return; }
        if (hipFuncSetAttribute((const void*)hybrid_fwd, hipFuncAttributeMaxDynamicSharedMemorySize, LDS_BYTES) != hipSuccess) { fprintf(stderr, "kernel_launch: hipFuncSetAttribute failed\n"); grid = -1; return; }
        if (hipOccupancyMaxActiveBlocksPerMultiprocessor(&per_cu, (const void*)hybrid_fwd, NWAVES * 64, LDS_BYTES) != hipSuccess || per_cu < 1)
            fprintf(stderr, "kernel_launch: note: occupancy query reports %d workgroups per CU\n", per_cu);
        (void)hipGetLastError();
        grid = cus;
    }
    if (grid < 0) return;
    if (hipMemsetAsync((char*)d_ws + WS_CTL, 0, CTL_ZERO_BYTES, stream) != hipSuccess) return;
    Args a{};
    for (int i = 0; i < 22; ++i) a.in[i] = (const float*)d_in[i];
    a.out = (float*)d_out; a.ws = (unsigned char*)d_ws;
    for (int li = 0; li < N_LAUNCHES; ++li) {
        a.ph_lo = (N_LAUNCHES == 1) ? 0 : li; a.ph_hi = (N_LAUNCHES == 1) ? NPH : li + 1; a.li = li;
        hipLaunchKernelGGL(hybrid_fwd, dim3(grid), dim3(NWAVES * 64), LDS_BYTES, stream, a);
        if (hipPeekAtLastError() != hipSuccess) { fprintf(stderr, "kernel_launch: launch %d failed\n", li); break; }
    }
}
```

```cpp
#include <hip/hip_runtime.h>
#include <cstdio>
#include <cstdint>
namespace pg8 {
#define PG8_LAS __attribute__((address_space(3)))
typedef unsigned short bf16_t;
typedef short bf16x8 __attribute__((ext_vector_type(8)));
typedef float f32x4 __attribute__((ext_vector_type(4)));
typedef unsigned u32x4 __attribute__((ext_vector_type(4)));
constexpr int BM = 256, BK = 64, HALF = 128, HTB = HALF * BK * 2  , STAGE_BYTES = 8 * HTB, NXCD = 8, WGM = 8;

__host__ __device__ __forceinline__ int lds_byte(int r, int c) { const int st = (r >> 4) * 2 + (c >> 5), rr = r & 15, cc = c & 31, ob = rr * 64 + cc * 2; return st * 1024 + (ob ^ (((ob >> 9) & 1) << 5)); }
__host__ __device__ __forceinline__ void stage_rc(int b, int& R, int& C) { const int st = b / 1024, sb = b % 1024, swz = sb ^ (((sb >> 9) & 1) << 5); R = (st >> 1) * 16 + swz / 64; C = (st & 1) * 32 + (swz % 64) / 2; }
__host__ __device__ __forceinline__ int perm32(int rho) { const int n = rho >> 4, i = rho & 15; return 8 * (i >> 2) + 4 * n + (i & 3); }

struct Unit { int pm, pn; };
struct Gemm { const bf16_t* A; const bf16_t* Bt; int M, N, K; };

struct StaticOrder {
    static constexpr bool GATHER = false;
    int nM, nN, nwg, G, c;
    __host__ __device__ void init(int M, int N, int G_, int c_) { nM = M / BM; nN = N / BM; nwg = nM * nN; G = G_; c = c_; }
    __host__ __device__ bool next(int i, Unit& u) const {
        const long L = (long)i * G + c; if (L >= nwg) return false;
        int wgid = (int)L; { const int q = nwg / NXCD, r = nwg % NXCD, xcd = wgid % NXCD, off = wgid / NXCD; wgid = (xcd < r ? xcd * (q + 1) : r * (q + 1) + (xcd - r) * q) + off; }
        const int nig = WGM * nN, gid = wgid / nig, fm = gid * WGM, gsz = (nM - fm) < WGM ? (nM - fm) : WGM;
        u.pm = fm + ((wgid % nig) % gsz); u.pn = (wgid % nig) / gsz; return true;
    }
    __device__ __forceinline__ void a_ready(const Unit&) const {}
    __device__ __forceinline__ void done(const Unit&) const {}
};

typedef __bf16 bf2_t __attribute__((ext_vector_type(2)));
__device__ __forceinline__ unsigned cvt_pk_bf16(float lo, float hi) { bf2_t v; v[0] = (__bf16)lo; v[1] = (__bf16)hi; return __builtin_bit_cast(unsigned, v); }
typedef float f32x2 __attribute__((ext_vector_type(2)));
template <int ACT  > struct EpiBf16 {
    static constexpr bool PERM = true, AFTER_DRAIN = false; static_assert(ACT == 0, "EpiBf16: no activation here");
    bf16_t* O; int ldc; const float* bias; int split_cols; size_t split_stride; float scale0;
    __device__ __forceinline__ void operator()(const f32x4 (&acc)[2][2][4][2], const Unit& u, int wr, int wc, int fr, int fq) const {
        const int row0 = u.pm * BM + wr * 64 + fr; int colt = u.pn * BM; bf16_t* base = O;
        float sc = 1.f; if (split_cols) { const int t = colt / split_cols; base += (size_t)t * split_stride; colt -= t * split_cols; if (t == 0) sc = scale0; }
        const int col0 = colt + wc * 32 + 8 * fq, bcol0 = u.pn * BM + wc * 32 + 8 * fq;
        f32x4 bv[2][2];
#pragma unroll
        for (int bj = 0; bj < 2; ++bj)
#pragma unroll
            for (int n = 0; n < 2; ++n) bv[bj][n] = bias ? *(const f32x4*)(bias + bcol0 + bj * HALF + 4 * n) : (f32x4){0.f, 0.f, 0.f, 0.f};
#pragma unroll
        for (int ai = 0; ai < 2; ++ai)
#pragma unroll
            for (int m = 0; m < 4; ++m) { bf16_t* rowp = base + (size_t)(row0 + ai * HALF + m * 16) * ldc + col0;
#pragma unroll
                for (int bj = 0; bj < 2; ++bj) { f32x4 v0 = acc[ai][bj][m][0] + bv[bj][0], v1 = acc[ai][bj][m][1] + bv[bj][1];
                    v0 = v0 * sc; v1 = v1 * sc; u32x4 w; w.x = cvt_pk_bf16(v0[0], v0[1]); w.y = cvt_pk_bf16(v0[2], v0[3]); w.z = cvt_pk_bf16(v1[0], v1[1]); w.w = cvt_pk_bf16(v1[2], v1[3]);
                    *(u32x4*)(rowp + bj * HALF) = w; } }
    }
};
__device__ __forceinline__ float bf2f_(unsigned b16) { return __uint_as_float(b16 << 16); }
__device__ __forceinline__ float sigm_(float x) { return 1.0f / (1.0f + __expf(-x)); }
template <bool ADD> struct EpiGate {
    static constexpr bool PERM = true, AFTER_DRAIN = false;
    bf16_t* O; int ldc; const bf16_t* gate; size_t gstride;
    __device__ __forceinline__ void operator()(const f32x4 (&acc)[2][2][4][2], const Unit& u, int wr, int wc, int fr, int fq) const {
        const int row0 = u.pm * BM + wr * 64 + fr, colt = wc * 32 + 8 * fq;
        const bf16_t* gt = gate + (size_t)u.pn * gstride;
#pragma unroll
        for (int ai = 0; ai < 2; ++ai)
#pragma unroll
            for (int m = 0; m < 4; ++m) { const size_t row = (size_t)(row0 + ai * HALF + m * 16);
#pragma unroll
                for (int bj = 0; bj < 2; ++bj) { const int c = colt + bj * HALF;
                    const u32x4 gv = *(const u32x4*)(gt + row * 256 + c);
                    bf16_t* op = O + row * ldc + u.pn * BM + c;
                    float pv[8] = {0.f, 0.f, 0.f, 0.f, 0.f, 0.f, 0.f, 0.f};
                    if (ADD) { const u32x4 p = *(const u32x4*)op; pv[0] = bf2f_(p.x & 0xffffu); pv[1] = bf2f_(p.x >> 16); pv[2] = bf2f_(p.y & 0xffffu); pv[3] = bf2f_(p.y >> 16);
                        pv[4] = bf2f_(p.z & 0xffffu); pv[5] = bf2f_(p.z >> 16); pv[6] = bf2f_(p.w & 0xffffu); pv[7] = bf2f_(p.w >> 16); }
                    const f32x4 v0 = acc[ai][bj][m][0], v1 = acc[ai][bj][m][1];
                    float o[8];
                    o[0] = pv[0] + sigm_(bf2f_(gv.x & 0xffffu)) * v0[0]; o[1] = pv[1] + sigm_(bf2f_(gv.x >> 16)) * v0[1];
                    o[2] = pv[2] + sigm_(bf2f_(gv.y & 0xffffu)) * v0[2]; o[3] = pv[3] + sigm_(bf2f_(gv.y >> 16)) * v0[3];
                    o[4] = pv[4] + sigm_(bf2f_(gv.z & 0xffffu)) * v1[0]; o[5] = pv[5] + sigm_(bf2f_(gv.z >> 16)) * v1[1];
                    o[6] = pv[6] + sigm_(bf2f_(gv.w & 0xffffu)) * v1[2]; o[7] = pv[7] + sigm_(bf2f_(gv.w >> 16)) * v1[3];
                    u32x4 w; w.x = cvt_pk_bf16(o[0], o[1]); w.y = cvt_pk_bf16(o[2], o[3]); w.z = cvt_pk_bf16(o[4], o[5]); w.w = cvt_pk_bf16(o[6], o[7]);
                    *(u32x4*)op = w; } }
    }
};
struct EpiRes {
    static constexpr bool PERM = false, AFTER_DRAIN = false;
    float* C; const float* R; int ldc;
    __device__ __forceinline__ void operator()(const f32x4 (&acc)[2][2][4][2], const Unit& u, int wr, int wc, int fr, int fq) const {
        const int row0 = u.pm * BM + wr * 64 + fr, col0 = u.pn * BM + wc * 32 + 4 * fq;
#pragma unroll
        for (int ai = 0; ai < 2; ++ai)
#pragma unroll
            for (int m = 0; m < 4; ++m) { const size_t ro = (size_t)(row0 + ai * HALF + m * 16) * ldc + col0;
#pragma unroll
                for (int bj = 0; bj < 2; ++bj)
#pragma unroll
                    for (int n = 0; n < 2; ++n) { const size_t off = ro + bj * HALF + n * 16; *(f32x4*)(C + off) = *(const f32x4*)(R + off) + acc[ai][bj][m][n]; } }
    }
};
struct EpiSwiGLU {
    static constexpr bool PERM = true, AFTER_DRAIN = false;
    bf16_t* H;
    __device__ __forceinline__ void operator()(const f32x4 (&acc)[2][2][4][2], const Unit& u, int wr, int wc, int fr, int fq) const {
        const int row0 = u.pm * BM + wr * 64 + fr, hc = (u.pn & 3) * 128 + wc * 32 + 8 * fq;
#pragma unroll
        for (int ai = 0; ai < 2; ++ai)
#pragma unroll
            for (int m = 0; m < 4; ++m) { const size_t row = (size_t)(row0 + ai * HALF + m * 16);
                float o[8];
#pragma unroll
                for (int n = 0; n < 2; ++n)
#pragma unroll
                    for (int i = 0; i < 4; ++i) { const float g = acc[ai][0][m][n][i], up = acc[ai][1][m][n][i]; o[n * 4 + i] = g * sigm_(g) * up; }
                u32x4 w; w.x = cvt_pk_bf16(o[0], o[1]); w.y = cvt_pk_bf16(o[2], o[3]); w.z = cvt_pk_bf16(o[4], o[5]); w.w = cvt_pk_bf16(o[6], o[7]);
                *(u32x4*)(H + row * 512 + hc) = w; }
    }
};
struct EpiDown {
    static constexpr bool PERM = true, AFTER_DRAIN = false;
    bf16_t* Y;
    __device__ __forceinline__ void operator()(const f32x4 (&acc)[2][2][4][2], const Unit& u, int wr, int wc, int fr, int fq) const {
        const int row0 = u.pm * BM + wr * 64 + fr, c0 = (u.pn & 3) * 256 + wc * 32 + 8 * fq;
#pragma unroll
        for (int ai = 0; ai < 2; ++ai)
#pragma unroll
            for (int m = 0; m < 4; ++m) { const size_t row = (size_t)(row0 + ai * HALF + m * 16);
#pragma unroll
                for (int bj = 0; bj < 2; ++bj) { const f32x4 v0 = acc[ai][bj][m][0], v1 = acc[ai][bj][m][1];
                    u32x4 w; w.x = cvt_pk_bf16(v0[0], v0[1]); w.y = cvt_pk_bf16(v0[2], v0[3]); w.z = cvt_pk_bf16(v1[0], v1[1]); w.w = cvt_pk_bf16(v1[2], v1[3]);
                    *(u32x4*)(Y + row * 1024 + c0 + bj * HALF) = w; } }
    }
};
template <bool GA_> struct MoeOrder {
    static constexpr bool GATHER = GA_;
    const PG8_LAS int* ts; int G, c; const int* rowtok;
    __device__ __forceinline__ bool next(int i, Unit& u) const {
        const int nt = ts[32]; const long L = (long)i * G + c; if (L >= 4L * nt) return false;
        const int pm = (int)(L >> 2), j = (int)(L & 3); int e = 0;
#pragma unroll
        for (int k = 1; k < 32; ++k) e += (ts[k] <= pm) ? 1 : 0;
        u.pm = pm; u.pn = e * 4 + j; return true;
    }
    __device__ __forceinline__ void a_ready(const Unit&) const {}
    __device__ __forceinline__ void done(const Unit&) const {}
};
template <class Epi, class Sched, bool ALIGN_EPI = false, bool SP2 = false>
__device__ __forceinline__ void gemm_phase(PG8_LAS unsigned char* lds, const Gemm g, const Sched& S, const Epi& E) {
    const int tid = threadIdx.x, wid = __builtin_amdgcn_readfirstlane(tid >> 6), lane = tid & 63, wr = wid >> 2, wc = wid & 3, fr = lane & 15, fq = lane >> 4;
    const int K = g.K, nt = K / BK;
    unsigned voffA[2], voffB[2];
#pragma unroll
    for (int i = 0; i < 2; ++i) { int R, C; stage_rc(tid * 16 + i * 8192, R, C); const int Rb = Epi::PERM ? ((R & ~31) + perm32(R & 31)) : R;
        voffA[i] = (unsigned)(R * K + C) * 2u; voffB[i] = (unsigned)(Rb * K + C) * 2u; }
    const size_t kstep = (size_t)(BK * 2);
    const size_t hstep = (size_t)HALF * K * 2;
    const size_t tstep = 2 * hstep;
    constexpr bool GA = Sched::GATHER;
    static_assert(!GA || SP2, "gathered A rows: SP2 loop only");
    const size_t hstepA = GA ? 0 : hstep;
    unsigned gcur[2][2] = {{0u, 0u}, {0u, 0u}}, gnxt[2][2] = {{0u, 0u}, {0u, 0u}}; int gR[2] = {0, 0}; unsigned gC[2] = {0u, 0u};
    if constexpr (GA) { _Pragma("unroll") for (int i = 0; i < 2; ++i) { int R, C; stage_rc(tid * 16 + i * 8192, R, C); gR[i] = R; gC[i] = (unsigned)C * 2u; } }
#define PG8_GOFF(dst, u) do { if constexpr (GA) { _Pragma("unroll") for (int h_ = 0; h_ < 2; ++h_) _Pragma("unroll") for (int i_ = 0; i_ < 2; ++i_) dst[h_][i_] = (unsigned)S.rowtok[(u).pm * BM + h_ * HALF + gR[i_]] * (unsigned)(K * 2) + gC[i_]; } } while (0)
#define PG8_VA(h, sel) (GA ? ((sel) ? gnxt[h] : gcur[h]) : voffA)
    const unsigned ldsw = (unsigned)wid * 1024u;
    const int aoff = lds_byte(wr * 64 + fr, fq * 8), boff = lds_byte(wc * 32 + fr, fq * 8);
#define PG8_SA(b, h) (((b) * 2 + (h)) * HTB)
#define PG8_SB(b, h) ((4 + (b) * 2 + (h)) * HTB)
#define PG8_STAGE(bufoff, gbase, voff) do { _Pragma("unroll") for (int _i = 0; _i < 2; ++_i) \
        __builtin_amdgcn_global_load_lds((const unsigned*)((const char*)(gbase) + (voff)[_i]), (PG8_LAS unsigned*)(lds + (bufoff) + ldsw + _i * 8192), 16, 0, 0); } while (0)
#define PG8_LDA(dst, b, h) do { _Pragma("unroll") for (int m = 0; m < 4; ++m) _Pragma("unroll") for (int k = 0; k < 2; ++k) dst[m][k] = *(const PG8_LAS bf16x8*)(lds + PG8_SA(b, h) + aoff + m * 2048 + k * 1024); } while (0)
#define PG8_LDB(dst, b, h) do { _Pragma("unroll") for (int n = 0; n < 2; ++n) _Pragma("unroll") for (int k = 0; k < 2; ++k) dst[n][k] = *(const PG8_LAS bf16x8*)(lds + PG8_SB(b, h) + boff + n * 2048 + k * 1024); } while (0)
#define PG8_MMA(ai, bj, At, Bt) do { __builtin_amdgcn_s_setprio(1); _Pragma("unroll") for (int m = 0; m < 4; ++m) _Pragma("unroll") for (int n = 0; n < 2; ++n) _Pragma("unroll") for (int k = 0; k < 2; ++k) \
        acc[ai][bj][m][n] = __builtin_amdgcn_mfma_f32_16x16x32_bf16(Bt[n][k], At[m][k], acc[ai][bj][m][n], 0, 0, 0); __builtin_amdgcn_s_setprio(0); } while (0)
#define PG8_WAIT_V(n) asm volatile("s_waitcnt vmcnt(" #n ")" ::: "memory")
#define PG8_WAIT_L(n) asm volatile("s_waitcnt lgkmcnt(" #n ")" ::: "memory")
#define PG8_BAR __builtin_amdgcn_s_barrier()
#define PG8_SCHED __builtin_amdgcn_sched_barrier(0)
    Unit cur, nxt; int ui = 0;
    if (!S.next(0, cur)) return;
    f32x4 acc[2][2][4][2];
#pragma unroll
    for (int a = 0; a < 2; ++a)
#pragma unroll
        for (int b = 0; b < 2; ++b)
#pragma unroll
            for (int m = 0; m < 4; ++m)
#pragma unroll
                for (int n = 0; n < 2; ++n) acc[a][b][m][n] = (f32x4){0.f, 0.f, 0.f, 0.f};
    bf16x8 At[4][2], B0[2][2], B1[2][2];
    const char* cA = (const char*)g.A + (GA ? 0 : (size_t)cur.pm * tstep); const char* cB = (const char*)g.Bt + (size_t)cur.pn * tstep;
    S.a_ready(cur);
    PG8_GOFF(gcur, cur);
    if constexpr (SP2) {
        PG8_STAGE(PG8_SB(0, 0), cB, voffB); PG8_STAGE(PG8_SB(0, 1), cB + hstep, voffB); PG8_STAGE(PG8_SA(0, 0), cA, PG8_VA(0, false)); PG8_STAGE(PG8_SA(0, 1), cA + hstepA, PG8_VA(1, false));
        if (wr == 1) PG8_BAR;
        PG8_WAIT_V(2); PG8_BAR;
        PG8_STAGE(PG8_SB(1, 0), cB + kstep, voffB); PG8_STAGE(PG8_SA(1, 0), cA + kstep, PG8_VA(0, false)); PG8_STAGE(PG8_SB(1, 1), cB + hstep + kstep, voffB);
        PG8_WAIT_V(6); PG8_BAR;
    } else {
        PG8_STAGE(PG8_SB(0, 0), cB, voffB); PG8_STAGE(PG8_SA(0, 0), cA, voffA); PG8_STAGE(PG8_SB(0, 1), cB + hstep, voffB); PG8_STAGE(PG8_SA(0, 1), cA + hstep, voffA);
        if (wr == 1) PG8_BAR;
        PG8_WAIT_V(4); PG8_BAR;
        PG8_STAGE(PG8_SB(1, 0), cB + kstep, voffB); PG8_STAGE(PG8_SA(1, 0), cA + kstep, voffA); PG8_STAGE(PG8_SB(1, 1), cB + hstep + kstep, voffB);
        PG8_WAIT_V(6); PG8_BAR;
    }
    for (;;) {
        const bool has_next = S.next(ui + 1, nxt);
        if (has_next) PG8_GOFF(gnxt, nxt);
        const char* nA = has_next ? (const char*)g.A + (GA ? 0 : (size_t)nxt.pm * tstep) : cA; const char* nB = has_next ? (const char*)g.Bt + (size_t)nxt.pn * tstep : cB;
        for (int t = 0; t < nt; t += 2) {
            const bool last = (t == nt - 2);
            const char* a1 = cA + (size_t)(t + 1) * kstep;
            const char* a2 = last ? nA : cA + (size_t)(t + 2) * kstep; const char* b2 = last ? nB : cB + (size_t)(t + 2) * kstep;
            const char* a3 = a2 + kstep; const char* b3 = b2 + kstep;
            if (last && has_next) S.a_ready(nxt);
            const bool seln = last && has_next;
            if constexpr (SP2) {
            PG8_LDB(B0, 0, 0); PG8_LDB(B1, 0, 1); PG8_SCHED; PG8_LDA(At, 0, 0); PG8_STAGE(PG8_SA(1, 1), a1 + hstepA, PG8_VA(1, false));
            PG8_WAIT_V(8); PG8_WAIT_L(0); PG8_BAR; PG8_MMA(0, 0, At, B0); PG8_MMA(0, 1, At, B1); PG8_BAR; PG8_SCHED;
            PG8_LDA(At, 0, 1); PG8_STAGE(PG8_SB(0, 0), b2, voffB); PG8_STAGE(PG8_SB(0, 1), b2 + hstep, voffB); PG8_STAGE(PG8_SA(0, 0), a2, PG8_VA(0, seln));
            PG8_WAIT_V(8); PG8_WAIT_L(0); PG8_BAR; PG8_MMA(1, 0, At, B0); PG8_MMA(1, 1, At, B1); PG8_BAR; PG8_SCHED;
            PG8_LDB(B0, 1, 0); PG8_LDB(B1, 1, 1); PG8_SCHED; PG8_LDA(At, 1, 0); PG8_STAGE(PG8_SA(0, 1), a2 + hstepA, PG8_VA(1, seln));
            PG8_WAIT_V(8); PG8_WAIT_L(0); PG8_BAR; PG8_MMA(0, 0, At, B0); PG8_MMA(0, 1, At, B1); PG8_BAR; PG8_SCHED;
            PG8_LDA(At, 1, 1); PG8_STAGE(PG8_SB(1, 0), b3, voffB); PG8_STAGE(PG8_SB(1, 1), b3 + hstep, voffB); PG8_STAGE(PG8_SA(1, 0), a3, PG8_VA(0, seln));
            PG8_WAIT_V(8); PG8_WAIT_L(0); PG8_BAR; PG8_MMA(1, 0, At, B0); PG8_MMA(1, 1, At, B1); PG8_BAR; PG8_SCHED;
            } else {
            PG8_LDB(B0, 0, 0); PG8_SCHED; PG8_LDA(At, 0, 0); PG8_STAGE(PG8_SA(1, 1), a1 + hstep, voffA);
            PG8_WAIT_L(8); PG8_BAR; PG8_WAIT_L(0); PG8_MMA(0, 0, At, B0); PG8_BAR; PG8_SCHED;
            PG8_LDB(B1, 0, 1); PG8_STAGE(PG8_SB(0, 0), b2, voffB);
            PG8_BAR; PG8_WAIT_L(0); PG8_MMA(0, 1, At, B1); PG8_BAR;
            PG8_LDA(At, 0, 1); PG8_STAGE(PG8_SA(0, 0), a2, voffA);
            PG8_BAR; PG8_WAIT_L(0); PG8_MMA(1, 0, At, B0); PG8_BAR; PG8_SCHED;
            PG8_STAGE(PG8_SB(0, 1), b2 + hstep, voffB);
            PG8_WAIT_V(6); PG8_BAR; PG8_MMA(1, 1, At, B1); PG8_BAR;
            PG8_LDB(B0, 1, 0); PG8_SCHED; PG8_LDA(At, 1, 0); PG8_STAGE(PG8_SA(0, 1), a2 + hstep, voffA);
            PG8_WAIT_L(8); PG8_BAR; PG8_WAIT_L(0); PG8_MMA(0, 0, At, B0); PG8_BAR; PG8_SCHED;
            PG8_LDB(B1, 1, 1); PG8_STAGE(PG8_SB(1, 0), b3, voffB);
            PG8_BAR; PG8_WAIT_L(0); PG8_MMA(0, 1, At, B1); PG8_BAR;
            PG8_LDA(At, 1, 1); PG8_STAGE(PG8_SA(1, 0), a3, voffA);
            PG8_BAR; PG8_WAIT_L(0); PG8_MMA(1, 0, At, B0); PG8_BAR; PG8_SCHED;
            PG8_STAGE(PG8_SB(1, 1), b3 + hstep, voffB);
            PG8_WAIT_V(6); PG8_BAR; PG8_MMA(1, 1, At, B1); PG8_BAR;
            }
        }
        if constexpr (ALIGN_EPI) { if (wr == 0) PG8_BAR; }
        if constexpr (!Epi::AFTER_DRAIN) { E(acc, cur, wr, wc, fr, fq); S.done(cur); }
        if (!has_next) break;
#pragma unroll
        for (int a = 0; a < 2; ++a)
#pragma unroll
            for (int b = 0; b < 2; ++b)
#pragma unroll
                for (int m = 0; m < 4; ++m)
#pragma unroll
                    for (int n = 0; n < 2; ++n) acc[a][b][m][n] = (f32x4){0.f, 0.f, 0.f, 0.f};
        cur = nxt; cA = nA; cB = nB; ++ui;
        if constexpr (GA) { _Pragma("unroll") for (int h_ = 0; h_ < 2; ++h_) _Pragma("unroll") for (int i_ = 0; i_ < 2; ++i_) gcur[h_][i_] = gnxt[h_][i_]; }
        if constexpr (ALIGN_EPI) { if (wr == 1) PG8_BAR; }
    }
    PG8_WAIT_V(0);
    if constexpr (!ALIGN_EPI) { if (wr == 0) PG8_BAR; }
    PG8_BAR;
    if constexpr (Epi::AFTER_DRAIN) { E.fused(acc, cur, wr, wc, fr, fq, lds, wid, lane); S.done(cur); }
#undef PG8_GOFF
#undef PG8_VA
#undef PG8_SA
#undef PG8_SB
#undef PG8_STAGE
#undef PG8_LDA
#undef PG8_LDB
#undef PG8_MMA
#undef PG8_WAIT_V
#undef PG8_WAIT_L
#undef PG8_BAR
#undef PG8_SCHED
}
}
constexpr int NWAVES = 8;
constexpr int BATCH = 8, SEQ = 4096, D = 1024, T = BATCH * SEQ;
constexpr int NPROJ = 5120;
constexpr int NTILE = NPROJ / 256;
constexpr float EPS = 1e-6f;
#ifndef MK_N_LAUNCHES
#define MK_N_LAUNCHES 1
#endif
#ifndef DBG_NPH
#define DBG_NPH 12
#endif
constexpr int NPH = DBG_NPH;
constexpr int N_LAUNCHES = MK_N_LAUNCHES;
static_assert(N_LAUNCHES == 1 || N_LAUNCHES == NPH, "MK_N_LAUNCHES is 1 or NPH");

constexpr size_t MiB = 1u << 20;
constexpr size_t WS_CTL = 0, CTL_ZERO_BYTES = 1 * MiB;
constexpr size_t WS_SMALL = 1 * MiB;
constexpr size_t WS_WIN = 2 * MiB;
constexpr size_t WS_WPA = 13 * MiB, WS_WPM = 14 * MiB, WS_WOUT = 15 * MiB;
constexpr size_t WS_TOKE = 17 * MiB;
constexpr size_t WS_TOKR = WS_TOKE + 256 * 1024;
constexpr size_t WS_TOKP = WS_TOKR + 256 * 1024;
constexpr size_t WS_TOKG = WS_TOKP + 256 * 1024;
constexpr size_t WS_CNT = WS_TOKG + 256 * 1024;
constexpr size_t WS_ROWTOK = WS_CNT + 64 * 1024;
constexpr int NROWS_MAX = 73728;
constexpr size_t WS_SC = 452 * MiB;
constexpr size_t WS_SC2 = 116 * MiB + 3 * ((size_t)T * 256 * 2);
constexpr size_t WS_GU = 20 * MiB;
constexpr size_t WS_DN = 84 * MiB;
constexpr size_t WS_PROJ = 116 * MiB;
constexpr size_t PROJ_TILE = (size_t)T * 256 * 2;
constexpr size_t WS_MLST = 116 * MiB;
constexpr size_t WS_MERGED = 116 * MiB;
constexpr size_t WS_XN = 180 * MiB;
constexpr size_t WS_XG = 244 * MiB;
constexpr size_t WS_HID = 388 * MiB;
constexpr size_t WS_Y = 244 * MiB;
constexpr size_t WS_END = 512 * MiB;
static_assert(WS_PROJ + NTILE * PROJ_TILE == 436 * MiB, "proj map");
constexpr size_t DO_H = 0, DO_YATT = 0, DO_YML = 32 * MiB, DO_KN = 64 * MiB, DO_IKR = 72 * MiB, DO_IQR = 74 * MiB, DO_AQN = 90 * MiB;
constexpr int TL_AQ = 0, TL_KV = 2, TL_IQ = 3, TL_MQ = 4, TL_MK = 6, TL_MV = 8, TL_MO = 10, TL_GA = 12, TL_GM = 16;
constexpr size_t WS_WSM = WS_SMALL + 64 * 1024;
constexpr size_t WS_WTG = WS_SMALL + 192 * 1024;
constexpr size_t DO_SMB = 122 * MiB;
constexpr int CW_BAR = 4096;
constexpr int CW_Q = 16384;
constexpr int LDS_BYTES = 163840, MISC_OFF = LDS_BYTES - 512;

#define GAS __attribute__((address_space(1)))
#define LAS __attribute__((address_space(3)))
typedef unsigned short bf16;
typedef unsigned v4u __attribute__((ext_vector_type(4)));
typedef unsigned v2u __attribute__((ext_vector_type(2)));
typedef float f32x4 __attribute__((ext_vector_type(4)));
typedef float f32x2 __attribute__((ext_vector_type(2)));
typedef short bf16x8 __attribute__((ext_vector_type(8)));
typedef GAS unsigned gu32;
#define RLX_AGENT __ATOMIC_RELAXED, __HIP_MEMORY_SCOPE_AGENT
#define LDS_WAIT() asm volatile("s_waitcnt lgkmcnt(0)" ::: "memory")
__device__ __forceinline__ float bf2f(unsigned b16) { return __uint_as_float(b16 << 16); }
__device__ __forceinline__ unsigned f2bf(float f) { unsigned u = __float_as_uint(f); return (u + 0x7fffu + ((u >> 16) & 1u)) >> 16; }
__device__ __forceinline__ unsigned pk2(float lo, float hi) { return pg8::cvt_pk_bf16(lo, hi); }
__device__ __forceinline__ float sigm(float x) { return 1.0f / (1.0f + __expf(-x)); }
__device__ __forceinline__ float wave_sum(float v) {
    v += __int_as_float(__builtin_amdgcn_update_dpp(0, __float_as_int(v), 0xB1, 0xF, 0xF, true));
    v += __int_as_float(__builtin_amdgcn_update_dpp(0, __float_as_int(v), 0x4E, 0xF, 0xF, true));
    v += __int_as_float(__builtin_amdgcn_update_dpp(0, __float_as_int(v), 0x124, 0xF, 0xF, true));
    v += __int_as_float(__builtin_amdgcn_update_dpp(0, __float_as_int(v), 0x128, 0xF, 0xF, true));
    { const auto r = __builtin_amdgcn_permlane16_swap(__float_as_uint(v), __float_as_uint(v), false, false); v = __uint_as_float(r[0]) + __uint_as_float(r[1]); }
    { const auto r = __builtin_amdgcn_permlane32_swap(__float_as_uint(v), __float_as_uint(v), false, false); v = __uint_as_float(r[0]) + __uint_as_float(r[1]); }
    return v;
}
__device__ __forceinline__ void unpack8(const v4u r, float (&f)[8]) {
    f[0] = bf2f(r.x & 0xffffu); f[1] = bf2f(r.x >> 16); f[2] = bf2f(r.y & 0xffffu); f[3] = bf2f(r.y >> 16);
    f[4] = bf2f(r.z & 0xffffu); f[5] = bf2f(r.z >> 16); f[6] = bf2f(r.w & 0xffffu); f[7] = bf2f(r.w >> 16);
}
__device__ __forceinline__ v4u pack8(const float (&f)[8]) { v4u w; w.x = pk2(f[0], f[1]); w.y = pk2(f[2], f[3]); w.z = pk2(f[4], f[5]); w.w = pk2(f[6], f[7]); return w; }
#define XB_TMO      128
#define XB_XCNT(j)  (256  + 64 * (j))
#define XB_XSUB(j)  (1280 + 64 * (j))
#define XB_XGEN(j)  (2304 + 64 * (j))
#define XB_TOP      3328
#define XB_TOPGEN   3392
#define XCD_BAR_WORDS 3456
#define XB_SPIN_CAP (1u << 18)

__device__ __forceinline__ unsigned xb_ld(unsigned* p)              { return __hip_atomic_load(p, __ATOMIC_RELAXED, __HIP_MEMORY_SCOPE_AGENT); }
__device__ __forceinline__ unsigned xb_add(unsigned* p, unsigned v) { return __hip_atomic_fetch_add(p, v, __ATOMIC_RELAXED, __HIP_MEMORY_SCOPE_AGENT); }
__device__ __forceinline__ unsigned xb_xcc_id() { return (unsigned)__builtin_amdgcn_s_getreg((3 << 11) | 20) & 0xFu; }
#define XB_SPIN(cond, bar) do { unsigned _sp = 0; while (cond) { __builtin_amdgcn_s_sleep(1); \
    if ((++_sp & 255u) == 0u) { if (xb_ld(&(bar)[XB_TMO])) break; if (_sp > XB_SPIN_CAP) { atomicAdd(&(bar)[XB_TMO], 1u); break; } } } } while (0)

struct XcdBarrier {
    unsigned* bar; unsigned x;
    volatile LAS unsigned* st;
};

__device__ __forceinline__ XcdBarrier xcd_barrier_post(unsigned* bar, volatile LAS unsigned* st) {
    XcdBarrier b; b.bar = bar; b.x = xb_xcc_id(); b.st = st;
    if (threadIdx.x == 0) (void)xb_add(&bar[XB_XCNT(b.x)], 1u);
    return b;
}
__device__ __forceinline__ void xcd_barrier_complete(unsigned* bar, unsigned x, unsigned& nloc, unsigned& nx) {
    const unsigned G = gridDim.x * gridDim.y * gridDim.z;
    unsigned sum, cnt, mine, sp = 0u;
    for (;;) {
        sum = 0u; cnt = 0u; mine = 0u;
#pragma unroll
        for (unsigned j = 0; j < 16; ++j) { const unsigned c = xb_ld(&bar[XB_XCNT(j)]); sum += c; cnt += (c > 0u) ? 1u : 0u; mine = (j == x) ? c : mine; }
        if (sum == G) break;
        __builtin_amdgcn_s_sleep(1);
        if ((++sp & 255u) == 0u) { if (xb_ld(&bar[XB_TMO])) break; if (sp > XB_SPIN_CAP) { atomicAdd(&bar[XB_TMO], 1u); break; } }
    }
    nloc = mine > 0u ? mine : 1u; nx = cnt > 0u ? cnt : 1u;
}

__device__ __forceinline__ void xcd_barrier(const XcdBarrier& b) {
    asm volatile("s_waitcnt vmcnt(0)" ::: "memory");
    __syncthreads();
    if (threadIdx.x == 0) {
        unsigned* bar = b.bar;
        __builtin_amdgcn_s_waitcnt(0);
        unsigned nloc = b.st[0], nx = b.st[1];
        if (nloc == 0u) { xcd_barrier_complete(bar, b.x, nloc, nx); b.st[0] = nloc; b.st[1] = nx; }
        const unsigned old = xb_add(&bar[XB_XSUB(b.x)], 1u);
        const unsigned gen = old / nloc;
        if (old + 1u == (gen + 1u) * nloc) {
            __builtin_amdgcn_fence(__ATOMIC_RELEASE, "agent");
            asm volatile("s_waitcnt vmcnt(0)" ::: "memory");
            const unsigned og = xb_add(&bar[XB_TOP], 1u);
            const unsigned tg = og / nx;
            if (og + 1u == (tg + 1u) * nx) xb_add(&bar[XB_TOPGEN], 1u);
            else XB_SPIN(xb_ld(&bar[XB_TOPGEN]) == tg, bar);
            __builtin_amdgcn_fence(__ATOMIC_ACQUIRE, "agent");
            xb_add(&bar[XB_XGEN(b.x)], 1u);
            asm volatile("s_waitcnt vmcnt(0)" ::: "memory");
        } else {
            XB_SPIN(xb_ld(&bar[XB_XGEN(b.x)]) == gen, bar);
            __builtin_amdgcn_fence(__ATOMIC_ACQUIRE, "agent");
            asm volatile("s_waitcnt vmcnt(0)" ::: "memory");
        }
    }
    __syncthreads();
}
struct Args { const float* in[22]; float* out; unsigned char* ws; int ph_lo, ph_hi, li, pad; };
struct Ctx { int tid, lane, wave, G, vcu; LAS unsigned char* lds; };
#define IN_X 0
#define IN_POS 1
#define IN_GMIX 2
#define IN_WIN 3
#define IN_GQ 4
#define IN_GK 5
#define IN_WCONV 6
#define IN_BCONV 7
#define IN_BI 8
#define IN_BF 9
#define IN_GML 10
#define IN_WPA 11
#define IN_WPM 12
#define IN_WOUT 13
#define IN_GMOE 14
#define IN_WRG 15
#define IN_BRG 16
#define IN_WRE 17
#define IN_BRE 18
#define IN_WEG 19
#define IN_WEU 20
#define IN_WED 21

__device__ __forceinline__ int win_src_col(int n) {
    if (n < 1024) return n;
    if (n < 3072) return n + 40;
    return n + 48;
}
__device__ __forceinline__ int wsm_src_col(int r) {
    return r < 40 ? 1024 + r : (r < 44 ? 3112 + (r - 40) : 3116 + (r - 44));
}
__device__ __forceinline__ void tr_item(const float* W, int ldw, int scol, int k0, bf16* wt0, int K, LAS float* scr, int lane) {
    const int sc0 = __builtin_amdgcn_readfirstlane(scol), sc31 = __builtin_amdgcn_readlane(scol, 31);
    if (sc0 >= 0 && sc31 == sc0 + 31 && (sc0 & 3) == 0 && (ldw & 3) == 0) {
#pragma unroll
        for (int i = 0; i < 8; ++i) { const int kk = 8 * i + (lane >> 3); const f32x4 v = *(const f32x4*)(W + (size_t)(k0 + kk) * ldw + sc0 + 4 * (lane & 7));
            LAS float* d = scr + kk * 33 + 4 * (lane & 7); d[0] = v[0]; d[1] = v[1]; d[2] = v[2]; d[3] = v[3]; }
    } else {
#pragma unroll 8
        for (int i = 0; i < 32; ++i) { const int kk = 2 * i + (lane >> 5); scr[kk * 33 + (lane & 31)] = scol >= 0 ? W[(size_t)(k0 + kk) * ldw + scol] : 0.f; }
    }
    LDS_WAIT(); asm volatile("" ::: "memory");
    const int c = lane & 7;
#pragma unroll
    for (int j = 0; j < 4; ++j) { const int n = (lane >> 3) + 8 * j; const LAS float* s = scr + (8 * c) * 33 + n;
        v4u o; o.x = pk2(s[0 * 33], s[1 * 33]); o.y = pk2(s[2 * 33], s[3 * 33]); o.z = pk2(s[4 * 33], s[5 * 33]); o.w = pk2(s[6 * 33], s[7 * 33]);
        *(v4u*)(wt0 + (size_t)n * K + 8 * c) = o; }
    LDS_WAIT(); asm volatile("" ::: "memory");
}
template <int PART> __device__ __forceinline__ void p0_prologue(const Args& a, const Ctx& c, int gw, int NGW) {
    unsigned char* ws = a.ws;
    LAS float* scr = (LAS float*)(c.lds + c.wave * 16384);
    const int lane = c.lane;
    constexpr int I_IN = 16 * 160, I_PA = 8 * 32, I_PM = 8 * 32, I_OUT = 16 * 32, I_GU = 32 * 16 * 32, I_DN = 32 * 8 * 32;
    constexpr int NPRJ = I_IN + I_PA + I_PM + I_OUT, NIT = NPRJ + I_GU + I_DN;
    for (int it = (PART ? NPRJ : 0) + gw; it < (PART ? NIT : NPRJ); it += NGW) {
        int r = it;
        if (r < I_IN) { const int kb = r / 160, nb = r % 160; tr_item(a.in[IN_WIN], 5168, win_src_col(32 * nb + (lane & 31)), 64 * kb, (bf16*)(ws + WS_WIN) + (size_t)(32 * nb) * 1024 + 64 * kb, 1024, scr, lane); continue; } r -= I_IN;
        if (r < I_PA) { const int kb = r / 32, nb = r % 32; tr_item(a.in[IN_WPA], 1024, 32 * nb + (lane & 31), 64 * kb, (bf16*)(ws + WS_WPA) + (size_t)(32 * nb) * 512 + 64 * kb, 512, scr, lane); continue; } r -= I_PA;
        if (r < I_PM) { const int kb = r / 32, nb = r % 32; tr_item(a.in[IN_WPM], 1024, 32 * nb + (lane & 31), 64 * kb, (bf16*)(ws + WS_WPM) + (size_t)(32 * nb) * 512 + 64 * kb, 512, scr, lane); continue; } r -= I_PM;
        if (r < I_OUT) { const int kb = r / 32, nb = r % 32; tr_item(a.in[IN_WOUT], 1024, 32 * nb + (lane & 31), 64 * kb, (bf16*)(ws + WS_WOUT) + (size_t)(32 * nb) * 1024 + 64 * kb, 1024, scr, lane); continue; } r -= I_OUT;
        if (r < I_GU) { const int e = r / 512, q = r % 512, kb = q / 32, nb = q % 32, t = nb >> 3, bj = (nb >> 2) & 1, i0 = (nb & 3) * 32;
            const float* src = (bj ? a.in[IN_WEU] : a.in[IN_WEG]) + (size_t)e * 1024 * 512;
            tr_item(src, 512, 128 * t + i0 + (lane & 31), 64 * kb, (bf16*)(ws + WS_GU) + ((size_t)e * 1024 + 32 * nb) * 1024 + 64 * kb, 1024, scr, lane); continue; } r -= I_GU;
        { const int e = r / 256, q = r % 256, kb = q / 32, nb = q % 32;
            tr_item(a.in[IN_WED] + (size_t)e * 512 * 1024, 1024, 32 * nb + (lane & 31), 64 * kb, (bf16*)(ws + WS_DN) + ((size_t)e * 1024 + 32 * nb) * 512 + 64 * kb, 512, scr, lane); }
    }
    if (PART) return;
    { float* WTG = (float*)(ws + WS_WTG); for (int i = gw * 64 + lane; i < 36 * 1024; i += NGW * 64) { const int j = i >> 10, k = i & 1023;
        WTG[j * 1028 + k] = (j < 32 ? a.in[IN_WRE][k * 32 + j] : a.in[IN_WRG][k * 4 + (j - 32)]) * a.in[IN_GMOE][k]; } }
    { bf16* WSM = (bf16*)(ws + WS_WSM); for (int i = gw * 64 + lane; i < 48 * 1024; i += NGW * 64) { const int r = i >> 10, k = i & 1023; WSM[i] = (bf16)f2bf(a.in[IN_WIN][(size_t)k * 5168 + wsm_src_col(r)]); } }
    const float* g = a.in[IN_GMIX]; f32x4 gv[4];
#pragma unroll
    for (int j = 0; j < 4; ++j) gv[j] = *(const f32x4*)(g + 4 * lane + 256 * j);
    bf16* H = (bf16*)((unsigned char*)a.out + DO_H);
    for (int m0 = gw; m0 < T; m0 += 2 * NGW) {
        const int mA = m0, mB = (m0 + NGW < T) ? m0 + NGW : m0; const bool hasB = (m0 + NGW < T);
        const f32x4* xa = (const f32x4*)(a.in[IN_X] + (size_t)mA * D) + lane; const f32x4* xb = (const f32x4*)(a.in[IN_X] + (size_t)mB * D) + lane;
        f32x4 va[4], vb[4]; float sa = 0.f, sb = 0.f;
#pragma unroll
        for (int j = 0; j < 4; ++j) { va[j] = xa[64 * j]; vb[j] = xb[64 * j]; }
#pragma unroll
        for (int j = 0; j < 4; ++j) { sa += (va[j].x * va[j].x + va[j].y * va[j].y) + (va[j].z * va[j].z + va[j].w * va[j].w); sb += (vb[j].x * vb[j].x + vb[j].y * vb[j].y) + (vb[j].z * vb[j].z + vb[j].w * vb[j].w); }
        const float ra = rsqrtf(wave_sum(sa) * (1.f / D) + EPS), rb = rsqrtf(wave_sum(sb) * (1.f / D) + EPS);
        v2u* oa = (v2u*)(H + (size_t)mA * D) + lane; v2u* ob = (v2u*)(H + (size_t)mB * D) + lane;
#pragma unroll
        for (int j = 0; j < 4; ++j) { v2u w; w.x = pk2(va[j].x * ra * gv[j].x, va[j].y * ra * gv[j].y); w.y = pk2(va[j].z * ra * gv[j].z, va[j].w * ra * gv[j].w); oa[64 * j] = w; }
        if (hasB) {
#pragma unroll
        for (int j = 0; j < 4; ++j) { v2u w; w.x = pk2(vb[j].x * rb * gv[j].x, vb[j].y * rb * gv[j].y); w.y = pk2(vb[j].z * rb * gv[j].z, vb[j].w * rb * gv[j].w); ob[64 * j] = w; } }
    }
}

__device__ __forceinline__ const bf16* proj_tile(const Args& a, int tile) { return (const bf16*)(a.ws + WS_PROJ + (size_t)tile * PROJ_TILE); }
#define DPPF(x_, ctrl_) __int_as_float(__builtin_amdgcn_update_dpp(0, __float_as_int(x_), ctrl_, 0xF, 0xF, true))
__device__ __forceinline__ void p2_prep(const Args& a, const Ctx& c) {
    const int lane = c.lane, gw = c.vcu * NWAVES + c.wave, NGW = c.G * NWAVES;
    float invf = 0.f;
    if (lane < 8) invf = (float)pow(500000.0, -(double)lane / 8.0); else if (lane < 12) invf = (float)pow(500000.0, -(double)(lane - 8) / 4.0);
    float gq[8], gk[8];
#pragma unroll
    for (int i = 0; i < 8; ++i) { gq[i] = a.in[IN_GQ][8 * (lane & 7) + i]; gk[i] = a.in[IN_GK][8 * (lane & 7) + i]; }
    const int* pos = (const int*)a.in[IN_POS];
    unsigned char* dout = (unsigned char*)a.out;
    bf16* AQN = (bf16*)(dout + DO_AQN); bf16* KN = (bf16*)(dout + DO_KN); bf16* IQR = (bf16*)(dout + DO_IQR); bf16* IKR = (bf16*)(dout + DO_IKR);
    { const bf16* Hh = (const bf16*)(dout + DO_H); const bf16* WSM = (const bf16*)(a.ws + WS_WSM); bf16* SMB = (bf16*)(dout + DO_SMB);
      const int row = lane & 15, kg = lane >> 4;
      const float invfk = (float)pow(500000.0, -(double)(lane & 3) / 4.0);
      for (int tile = gw; tile < T / 16; tile += NGW) { const int t0 = tile * 16;
          f32x4 acc[3];
#pragma unroll
          for (int ct = 0; ct < 3; ++ct) acc[ct] = (f32x4){0.f, 0.f, 0.f, 0.f};
          const bf16* ap = Hh + (size_t)(t0 + row) * 1024 + 8 * kg; const bf16* bp = WSM + (size_t)row * 1024 + 8 * kg;
#pragma unroll 8
          for (int ks = 0; ks < 32; ++ks) { const bf16x8 av = *(const bf16x8*)(ap + 32 * ks);
#pragma unroll
              for (int ct = 0; ct < 3; ++ct) acc[ct] = __builtin_amdgcn_mfma_f32_16x16x32_bf16(av, *(const bf16x8*)(bp + (size_t)ct * 16 * 1024 + 32 * ks), acc[ct], 0, 0, 0); }
          const int col = lane & 15;
#pragma unroll
          for (int r = 0; r < 4; ++r) { const int t = t0 + 4 * kg + r;
              const float angk = (float)pos[t] * invfk;
              const double revk = (double)angk * 0.15915494309189535; const float frk = (float)(revk - __builtin_rint(revk));
              const float ck = __builtin_amdgcn_cosf(frk), sk = __builtin_amdgcn_sinf(frk);
              const float v0 = acc[0][r], pr = __shfl_xor(v0, 4);
              const float o0 = (col < 4) ? (v0 * ck - pr * sk) : ((col < 8) ? (v0 * ck + pr * sk) : v0);
              IKR[(size_t)t * 32 + col] = (bf16)f2bf(o0); IKR[(size_t)t * 32 + 16 + col] = (bf16)f2bf(acc[1][r]);
              SMB[(size_t)t * 16 + col] = (bf16)f2bf(acc[2][r]); } } }
    const int l7 = lane & 7;
    for (int t = gw; t < T; t += NGW) {
        const float ang = (float)pos[t] * invf;
        const double rev = (double)ang * 0.15915494309189535; const float frv = (float)(rev - __builtin_rint(rev));
        float cs = __builtin_amdgcn_cosf(frv), sn = __builtin_amdgcn_sinf(frv);
        float ca[8], sa[8], ci[4], si[4];
#pragma unroll
        for (int i = 0; i < 8; ++i) { ca[i] = __int_as_float(__builtin_amdgcn_readlane(__float_as_int(cs), i)); sa[i] = __int_as_float(__builtin_amdgcn_readlane(__float_as_int(sn), i)); }
#pragma unroll
        for (int i = 0; i < 4; ++i) { ci[i] = __int_as_float(__builtin_amdgcn_readlane(__float_as_int(cs), 8 + i)); si[i] = __int_as_float(__builtin_amdgcn_readlane(__float_as_int(sn), 8 + i)); }
        { const int col = (lane >> 3) * 64 + 8 * l7; const bf16* src = proj_tile(a, TL_AQ + (col >> 8)) + (size_t)t * 256 + (col & 255);
          float f[8]; unpack8(*(const v4u*)src, f); float ss = 0.f;
#pragma unroll
          for (int i = 0; i < 8; ++i) ss += f[i] * f[i];
          ss += DPPF(ss, 0xB1); ss += DPPF(ss, 0x4E); ss += DPPF(ss, 0x141);
          const float r = rsqrtf(ss * (1.f / 64.f) + EPS);
#pragma unroll
          for (int i = 0; i < 8; ++i) f[i] = f[i] * r * gq[i];
          float o[8];
#pragma unroll
          for (int i = 0; i < 8; ++i) { const float p = DPPF(f[i], 0xB1); o[i] = (l7 == 0) ? (f[i] * ca[i] - p * sa[i]) : ((l7 == 1) ? (f[i] * ca[i] + p * sa[i]) : f[i]); o[i] *= 0.125f * 1.4426950408889634f; }
          *(v4u*)(AQN + (size_t)t * 512 + col) = pack8(o); }
        { const int l15 = lane & 15; const int col = (l15 >> 3) * 64 + 8 * l7; const bf16* src = proj_tile(a, TL_KV) + (size_t)t * 256 + col;
          float f[8]; unpack8(*(const v4u*)src, f); float ss = 0.f;
#pragma unroll
          for (int i = 0; i < 8; ++i) ss += f[i] * f[i];
          ss += DPPF(ss, 0xB1); ss += DPPF(ss, 0x4E); ss += DPPF(ss, 0x141);
          const float r = rsqrtf(ss * (1.f / 64.f) + EPS);
#pragma unroll
          for (int i = 0; i < 8; ++i) f[i] = f[i] * r * gk[i];
          float o[8];
#pragma unroll
          for (int i = 0; i < 8; ++i) { const float p = DPPF(f[i], 0xB1); o[i] = (l7 == 0) ? (f[i] * ca[i] - p * sa[i]) : ((l7 == 1) ? (f[i] * ca[i] + p * sa[i]) : f[i]); }
          if (lane < 16) *(v4u*)(KN + (size_t)t * 128 + col) = pack8(o); }
        { const bf16* src = proj_tile(a, TL_IQ) + (size_t)t * 256 + 4 * lane; const v2u rw = *(const v2u*)src;
          float f[4] = {bf2f(rw.x & 0xffffu), bf2f(rw.x >> 16), bf2f(rw.y & 0xffffu), bf2f(rw.y >> 16)}; float o[4];
#pragma unroll
          for (int i = 0; i < 4; ++i) { const float p = DPPF(f[i], 0xB1); o[i] = (l7 == 0) ? (f[i] * ci[i] - p * si[i]) : ((l7 == 1) ? (f[i] * ci[i] + p * si[i]) : f[i]); }
          v2u w; w.x = pk2(o[0], o[1]); w.y = pk2(o[2], o[3]); *(v2u*)(IQR + (size_t)t * 256 + 4 * lane) = w; }
    }
}
constexpr int ML_QS = 0, ML_KS = 17408, ML_HS = 0;
constexpr int ML_KWT = 34816;
constexpr int ML_VT = 53248;
constexpr int ML_SW = 73984;
constexpr int ML_CT = 83200;
constexpr int ML_GA = 122368;
constexpr int ML_CW = ML_GA + 1024;
constexpr int ML_END = ML_CW + (1024 + 384) * 4;
static_assert(ML_END <= MISC_OFF, "mLSTM LDS map");
constexpr size_t ML_STATE_BYTES = 8 * 9 * 64 * 16;
__device__ __forceinline__ bf16x8 lds_frag(const LAS unsigned char* base, int stride_b, int row0, int kb, int lane) {
    return *(const LAS bf16x8*)(base + (row0 + (lane & 15)) * stride_b + kb + (lane >> 4) * 16);
}
__device__ __forceinline__ bf16x8 lds_frag_sw(const LAS unsigned char* base, int row0, int ks, int lane) {
    const int row = row0 + (lane & 15); return *(const LAS bf16x8*)(base + row * 144 + 16 * (((ks * 4 + (lane >> 4)) + (row >> 3)) & 7));
}
#define MFMA16(a_, b_, c_) __builtin_amdgcn_mfma_f32_16x16x32_bf16(a_, b_, c_, 0, 0, 0)
template <int MODE>
__device__ __forceinline__ void mlstm_unit(const Args& a, const Ctx& c, int b, int h, int g) {
    const int tid = c.tid, wave = c.wave; LAS unsigned char* lds = c.lds;
#define ML_LAUNDER() int tv_ = tid; asm volatile("" : "+v"(tv_)); const int lane = tv_ & 63, seg = tv_ & 15, r2 = (tv_ >> 4) * 2; (void)lane; (void)seg; (void)r2
    const bf16* PQ = proj_tile(a, TL_MQ + (h >> 1)) + (h & 1) * 128;
    const bf16* PK = proj_tile(a, TL_MK + (h >> 1)) + (h & 1) * 128;
    const bf16* PV = proj_tile(a, TL_MV + (h >> 1)) + (h & 1) * 128;
    const bf16* PO = proj_tile(a, TL_MO + (h >> 1)) + (h & 1) * 128;
    const bf16* PS = (const bf16*)((unsigned char*)a.out + DO_SMB);
    bf16* YML = (bf16*)((unsigned char*)a.out + DO_YML);
    unsigned char* STB = a.ws + WS_MLST; float* MST = (float*)(a.ws + WS_MLST + 256 * ML_STATE_BYTES);
    LAS float* GAa = (LAS float*)(lds + ML_GA); LAS float* GAm = GAa + 64; LAS float* GAw = GAa + 128; LAS float* GAe = GAa + 192;
    LAS float* CWQ = (LAS float*)(lds + ML_CW); LAS float* CWK = CWQ + 512; LAS float* CBQ = CWQ + 1024; LAS float* CBK = CBQ + 128; LAS float* GN = CBK + 128;
    LAS bf16* VTs = (LAS bf16*)(lds + ML_VT);
    { const float* wc = a.in[IN_WCONV]; const int j = tid >> 7, d = tid & 127;
      CWQ[tid] = wc[j * 1024 + h * 128 + d]; CWK[tid] = wc[j * 1024 + 512 + h * 128 + d];
      if (tid < 128) { CBQ[tid] = a.in[IN_BCONV][h * 128 + tid]; CBK[tid] = a.in[IN_BCONV][512 + h * 128 + tid]; GN[tid] = a.in[IN_GML][h * 128 + tid]; } }
    for (int i = tid; i < 16 * 64; i += 512) { const int r = i >> 6, cc = i & 63; VTs[(128 + r) * 72 + cc] = (r == 0) ? (bf16)0x3F80 : (bf16)0; }
    const float big = a.in[IN_BI][h], bfg = a.in[IN_BF][h];
    const int slot0 = (b * 4 + h) * 8;
    f32x4 cacc[9];
    float m_st = 0.f;
    if (MODE == 1 && g > 0) { ML_LAUNDER();
        const f32x4* sp = (const f32x4*)(STB + (size_t)(slot0 + g) * ML_STATE_BYTES) + wave * 576 + lane;
#pragma unroll
        for (int i = 0; i < 9; ++i) cacc[i] = sp[64 * i];
        m_st = MST[slot0 + g];
#pragma unroll
        for (int ee = 0; ee < 9; ++ee) { v2u w; w.x = pk2(cacc[ee][0], cacc[ee][1]); w.y = pk2(cacc[ee][2], cacc[ee][3]);
            *(LAS v2u*)(lds + ML_CT + (ee * 16 + (lane & 15)) * 272 + (wave * 16 + 4 * (lane >> 4)) * 2) = w; }
    } else {
#pragma unroll
        for (int i = 0; i < 9; ++i) cacc[i] = (f32x4){0.f, 0.f, 0.f, 0.f};
        for (int i = tid; i < 144 * 136 / 2; i += 512) ((LAS unsigned*)(lds + ML_CT))[i] = 0u;
    }
    const size_t tb = (size_t)b * SEQ;
    const char* bq = (const char*)(PQ + tb * 256); const char* bk = (const char*)(PK + tb * 256); const char* bv = (const char*)(PV + tb * 256); const char* bo = (const char*)(PO + tb * 256); const char* bs = (const char*)(PS + tb * 16);
    v4u rq[5], rk[5], rv[2]; unsigned short gi = 0, gf = 0;
#define ML_LOAD(kc) do { _Pragma("unroll") for (int j_ = 0; j_ < 5; ++j_) { const int rr_ = 64 * (kc) + r2 - 3 + j_; const unsigned o_ = (unsigned)((rr_ < 0 ? 0 : rr_) * 512 + seg * 16); \
            v4u q_ = (v4u){0u, 0u, 0u, 0u}; if (MODE == 1) q_ = *(const v4u*)(bq + o_); v4u k_ = *(const v4u*)(bk + o_); if (rr_ < 0) { q_ = (v4u){0u, 0u, 0u, 0u}; k_ = q_; } rq[j_] = q_; rk[j_] = k_; } \
        _Pragma("unroll") for (int i_ = 0; i_ < 2; ++i_) rv[i_] = *(const v4u*)(bv + (unsigned)((64 * (kc) + r2 + i_) * 512 + seg * 16)); \
        gi = *(const unsigned short*)(bs + (unsigned)((64 * (kc) + lane) * 32 + (8 + h) * 2)); gf = *(const unsigned short*)(bs + (unsigned)((64 * (kc) + lane) * 32 + (12 + h) * 2)); } while (0)
    const int kc0 = (MODE == 1) ? 8 * g : 0, kc1 = (MODE == 1) ? 8 * g + 8 : 56;
    { ML_LAUNDER(); ML_LOAD(kc0); }
    __syncthreads();
#pragma unroll 1
    for (int kc = kc0; kc < kc1; ++kc) {
        float wkv, decay, m_new;
        if (MODE == 0 && kc > 0 && (kc & 7) == 0) { ML_LAUNDER();
            f32x4* sp = (f32x4*)(STB + (size_t)(slot0 + (kc >> 3)) * ML_STATE_BYTES) + wave * 576 + lane;
#pragma unroll
            for (int i = 0; i < 9; ++i) sp[64 * i] = cacc[i];
            if (tid == 0) MST[slot0 + (kc >> 3)] = m_st; }
        { ML_LAUNDER();
        const float fpre = bf2f(gf) + bfg, lf = fminf(fpre, 0.f) - log1pf(__expf(-fabsf(fpre)));
        const float ig = bf2f(gi) + big;
#define ML_SHR(x_, n_, id_) __int_as_float(__builtin_amdgcn_update_dpp(__float_as_int(id_), __float_as_int(x_), 0x110 + (n_), 0xF, 0xF, false))
        float bc = lf;
        bc += ML_SHR(bc, 1, 0.f); bc += ML_SHR(bc, 2, 0.f); bc += ML_SHR(bc, 4, 0.f); bc += ML_SHR(bc, 8, 0.f);
        { const float t0 = __int_as_float(__builtin_amdgcn_readlane(__float_as_int(bc), 15)), t1 = __int_as_float(__builtin_amdgcn_readlane(__float_as_int(bc), 31)), t2 = __int_as_float(__builtin_amdgcn_readlane(__float_as_int(bc), 47));
          bc += (lane >= 48) ? (t0 + t1 + t2) : ((lane >= 32) ? (t0 + t1) : ((lane >= 16) ? t0 : 0.f)); }
        const float av = ig - bc; float Ac = av;
        Ac = fmaxf(Ac, ML_SHR(Ac, 1, -3.0e38f)); Ac = fmaxf(Ac, ML_SHR(Ac, 2, -3.0e38f)); Ac = fmaxf(Ac, ML_SHR(Ac, 4, -3.0e38f)); Ac = fmaxf(Ac, ML_SHR(Ac, 8, -3.0e38f));
        { const float t0 = __int_as_float(__builtin_amdgcn_readlane(__float_as_int(Ac), 15)), t1 = __int_as_float(__builtin_amdgcn_readlane(__float_as_int(Ac), 31)), t2 = __int_as_float(__builtin_amdgcn_readlane(__float_as_int(Ac), 47));
          const float m01 = fmaxf(t0, t1), m012 = fmaxf(m01, t2);
          Ac = fmaxf(Ac, (lane >= 48) ? m012 : ((lane >= 32) ? m01 : ((lane >= 16) ? t0 : -3.0e38f))); }
#undef ML_SHR
        const float mA = fmaxf(m_st, Ac), Mk = __int_as_float(__builtin_amdgcn_readlane(__float_as_int(mA), 63)), blast = __int_as_float(__builtin_amdgcn_readlane(__float_as_int(bc), 63));
        wkv = __expf(av - Mk); decay = __expf(m_st - Mk); m_new = blast + Mk;
        if (MODE == 1 && wave == 0) { GAa[lane] = av; GAm[lane] = mA; GAw[lane] = __expf(m_st - mA); GAe[lane] = __expf(-(bc + mA)); } }
        { ML_LAUNDER(); float kw_[2][8];
#pragma unroll
          for (int i = 0; i < 2; ++i) { const int t = r2 + i; const float wkt = __shfl(wkv, t);
            float aq_[8], ak_[8];
            { const f32x4 b0 = *(const LAS f32x4*)(CBQ + seg * 8), b1 = *(const LAS f32x4*)(CBQ + seg * 8 + 4), c0 = *(const LAS f32x4*)(CBK + seg * 8), c1 = *(const LAS f32x4*)(CBK + seg * 8 + 4);
              aq_[0] = b0[0]; aq_[1] = b0[1]; aq_[2] = b0[2]; aq_[3] = b0[3]; aq_[4] = b1[0]; aq_[5] = b1[1]; aq_[6] = b1[2]; aq_[7] = b1[3];
              ak_[0] = c0[0]; ak_[1] = c0[1]; ak_[2] = c0[2]; ak_[3] = c0[3]; ak_[4] = c1[0]; ak_[5] = c1[1]; ak_[6] = c1[2]; ak_[7] = c1[3]; }
#pragma unroll
            for (int j = 0; j < 4; ++j) { float fk_[8]; unpack8(rk[i + j], fk_);
                const f32x4 x0 = *(const LAS f32x4*)(CWK + j * 128 + seg * 8), x1 = *(const LAS f32x4*)(CWK + j * 128 + seg * 8 + 4);
#pragma unroll
                for (int e = 0; e < 4; ++e) { ak_[e] += x0[e] * fk_[e]; ak_[4 + e] += x1[e] * fk_[4 + e]; }
                if (MODE == 1) { float fq_[8]; unpack8(rq[i + j], fq_);
                    const f32x4 w0 = *(const LAS f32x4*)(CWQ + j * 128 + seg * 8), w1 = *(const LAS f32x4*)(CWQ + j * 128 + seg * 8 + 4);
#pragma unroll
                    for (int e = 0; e < 4; ++e) { aq_[e] += w0[e] * fq_[e]; aq_[4 + e] += w1[e] * fq_[4 + e]; } } }
#pragma unroll
            for (int e = 0; e < 8; ++e) { ak_[e] = ak_[e] * sigm(ak_[e]) * 0.08838834764831845f; kw_[i][e] = ak_[e] * wkt; }
            if (MODE == 1) {
#pragma unroll
                for (int e = 0; e < 8; ++e) aq_[e] = aq_[e] * sigm(aq_[e]);
                *(LAS v4u*)(lds + ML_QS + t * 272 + seg * 16) = pack8(aq_);
                *(LAS v4u*)(lds + ML_KS + t * 272 + seg * 16) = pack8(ak_); } }
          const unsigned va[4] = {rv[0].x, rv[0].y, rv[0].z, rv[0].w}, vb[4] = {rv[1].x, rv[1].y, rv[1].z, rv[1].w};
          const int swo = 16 * (((r2 >> 3) + seg) & 7) + 2 * (r2 & 7);
#pragma unroll
          for (int e = 0; e < 8; ++e) { const int ro = (seg * 8 + e) * 144 + swo;
              *(LAS unsigned*)(lds + ML_KWT + ro) = pk2(kw_[0][e], kw_[1][e]);
              const unsigned lo = (e & 1) ? (va[e >> 1] >> 16) : (va[e >> 1] & 0xffffu), hi = (e & 1) ? (vb[e >> 1] >> 16) : (vb[e >> 1] & 0xffffu);
              *(LAS unsigned*)(lds + ML_VT + ro) = lo | (hi << 16); }
        if (kc + 1 < kc1) ML_LOAD(kc + 1); }
        __syncthreads();
        f32x4 hacc[5]; unsigned mo_r[8];
        const int tt = wave & 3, t0 = tt * 16, ne = (wave < 4) ? 5 : 4, e_first = (wave < 4) ? 0 : 5;
        if (MODE == 1) {
        { ML_LAUNDER(); const int tq = t0 + (lane & 15);
        bf16x8 qf[4];
#pragma unroll
        for (int ks = 0; ks < 4; ++ks) qf[ks] = lds_frag(lds + ML_QS, 272, t0, ks * 64, lane);
        const float mAt = GAm[tq], wit = GAw[tq];
#pragma unroll
        for (int si = 0; si < 2; ++si) { const int ss = 2 * (wave >> 2) + si, s0 = ss * 16; f32x4 sacc = (f32x4){0.f, 0.f, 0.f, 0.f};
            if (ss <= tt) {
#pragma unroll
                for (int ks = 0; ks < 4; ++ks) sacc = MFMA16(lds_frag(lds + ML_KS, 272, s0, ks * 64, lane), qf[ks], sacc);
#pragma unroll
                for (int r = 0; r < 4; ++r) { const int s = s0 + 4 * (lane >> 4) + r; sacc[r] = (s <= tq) ? sacc[r] * __expf(GAa[s] - mAt) : 0.f; } }
            v2u w; w.x = pk2(sacc[0], sacc[1]); w.y = pk2(sacc[2], sacc[3]);
            *(LAS v2u*)(lds + ML_SW + tq * 144 + s0 * 2 + (lane >> 4) * 8) = w; }
#pragma unroll
        for (int i = 0; i < 5; ++i) { hacc[i] = (f32x4){0.f, 0.f, 0.f, 0.f};
            if (i < ne) {
#pragma unroll
                for (int ks = 0; ks < 4; ++ks) hacc[i] = MFMA16(lds_frag(lds + ML_CT, 272, (e_first + i) * 16, ks * 64, lane), qf[ks], hacc[i]);
                hacc[i] = hacc[i] * wit; } }
#pragma unroll
        for (int i = 0; i < 8; ++i) mo_r[i] = *(const unsigned*)(bo + (unsigned)((64 * kc + 8 * wave + i) * 512 + 4 * lane)); }
        __syncthreads();
        { ML_LAUNDER(); const int tq = t0 + (lane & 15); bf16x8 swf[2];
#pragma unroll
          for (int ks = 0; ks < 2; ++ks) swf[ks] = lds_frag(lds + ML_SW, 144, t0, ks * 64, lane);
#pragma unroll
          for (int i = 0; i < 5; ++i) if (i < ne) { const int ee = e_first + i;
#pragma unroll
              for (int ks = 0; ks < 2; ++ks) hacc[i] = MFMA16(lds_frag_sw(lds + ML_VT, ee * 16, ks, lane), swf[ks], hacc[i]);
              if (ee < 8) *(LAS f32x4*)(lds + ML_HS + tq * 528 + (ee * 16 + 4 * (lane >> 4)) * 4) = hacc[i];
              else if ((lane >> 4) == 0) *(LAS float*)(lds + ML_HS + tq * 528 + 128 * 4) = hacc[i][0]; } }
        }
        { ML_LAUNDER(); const int d0 = wave * 16; bf16x8 kwf[2];
#pragma unroll
          for (int ks = 0; ks < 2; ++ks) kwf[ks] = lds_frag_sw(lds + ML_KWT, d0, ks, lane);
#pragma unroll
          for (int ee = 0; ee < 9; ++ee) { cacc[ee] = cacc[ee] * decay;
#pragma unroll
              for (int ks = 0; ks < 2; ++ks) cacc[ee] = MFMA16(kwf[ks], lds_frag_sw(lds + ML_VT, ee * 16, ks, lane), cacc[ee]);
              if (MODE == 1) { v2u w; w.x = pk2(cacc[ee][0], cacc[ee][1]); w.y = pk2(cacc[ee][2], cacc[ee][3]);
                  *(LAS v2u*)(lds + ML_CT + (ee * 16 + (lane & 15)) * 272 + (d0 + 4 * (lane >> 4)) * 2) = w; } } }
        __syncthreads();
        if (MODE == 1) {
        { ML_LAUNDER();
#pragma unroll
        for (int i = 0; i < 8; ++i) { const int t = 8 * wave + i;
            const f32x2 nv = *(const LAS f32x2*)(lds + ML_HS + t * 528 + lane * 8); const float den = *(const LAS float*)(lds + ML_HS + t * 528 + 512);
            const float dd = fmaxf(fabsf(den), GAe[t]); const float h0 = nv.x / dd, h1 = nv.y / dd;
            const float r = rsqrtf(wave_sum(h0 * h0 + h1 * h1) * (1.f / 128.f) + EPS);
            const float y0 = h0 * r * GN[2 * lane] * sigm(bf2f(mo_r[i] & 0xffffu)), y1 = h1 * r * GN[2 * lane + 1] * sigm(bf2f(mo_r[i] >> 16));
            *(unsigned*)(YML + (tb + 64 * kc + t) * 512 + h * 128 + 2 * lane) = pk2(y0, y1); } }
        __syncthreads();
        }
        m_st = m_new;
    }
    if (MODE == 0) { ML_LAUNDER();
        f32x4* sp = (f32x4*)(STB + (size_t)(slot0 + 7) * ML_STATE_BYTES) + wave * 576 + lane;
#pragma unroll
        for (int i = 0; i < 9; ++i) sp[64 * i] = cacc[i];
        if (tid == 0) MST[slot0 + 7] = m_st; }
#undef ML_LOAD
#undef ML_LAUNDER
}
constexpr int AT_HIST = 0;
constexpr int AT_HROW = 2049;
constexpr int AT_SEL = 131072 + 256;
constexpr int AT_MROW = 129;
constexpr int AT_SM = AT_SEL + 8448;
static_assert(AT_SM + 256 <= MISC_OFF, "attention LDS map");
__device__ __forceinline__ unsigned score_key(float s) { unsigned u = __float_as_uint(s + 0.0f); return (u & 0x80000000u) ? ~u : (u | 0x80000000u); }
__device__ __forceinline__ unsigned wave_suffix_sum(unsigned v, int lane) {
#define AT_SHL(x_, n_) ((unsigned)__builtin_amdgcn_update_dpp(0, (int)(x_), 0x100 + (n_), 0xF, 0xF, false))
    v += AT_SHL(v, 1); v += AT_SHL(v, 2); v += AT_SHL(v, 4); v += AT_SHL(v, 8);
#undef AT_SHL
    const unsigned t1 = (unsigned)__builtin_amdgcn_readlane((int)v, 16), t2 = (unsigned)__builtin_amdgcn_readlane((int)v, 32), t3 = (unsigned)__builtin_amdgcn_readlane((int)v, 48);
    return v + ((lane < 16) ? (t1 + t2 + t3) : ((lane < 32) ? (t2 + t3) : ((lane < 48) ? t3 : 0u)));
}
template <int NK> __device__ __forceinline__ void at_resolve(const LAS unsigned long long* cand, LAS unsigned* mask, int m, int nd, int lane) {
    unsigned long long cv[NK];
#pragma unroll
    for (int k = 0; k < NK; ++k) { const int i = 64 * k + lane; unsigned long long x = 0ull; if (i < m) x = cand[i]; cv[k] = (i < m) ? ((((x >> 32) & 0xFFFFFull) << 16) | (x & 0xFFFFull)) : 0ull; }
    unsigned long long T = 0ull;
#pragma unroll 1
    for (int bit = 35; bit >= 16; --bit) { const unsigned long long test = T | (1ull << bit); int cge = 0;
#pragma unroll
        for (int k = 0; k < NK; ++k) cge += __popcll(__ballot(cv[k] >= test));
        if (cge >= nd) T = test; }
    int g = 0, t = 0;
#pragma unroll
    for (int k = 0; k < NK; ++k) { g += __popcll(__ballot(cv[k] >= T + 0x10000ull)); t += __popcll(__ballot(cv[k] >= T)); }
    t -= g;
    if (t > nd - g) {
#pragma unroll 1
        for (int bit = 15; bit >= 0; --bit) { const unsigned long long test = T | (1ull << bit); int cge = 0;
#pragma unroll
            for (int k = 0; k < NK; ++k) cge += __popcll(__ballot(cv[k] >= test));
            if (cge >= nd) T = test; } }
#pragma unroll
    for (int k = 0; k < NK; ++k) if (cv[k] >= T && cv[k] != 0ull) { const unsigned key = 0xFFFFu - (unsigned)(cv[k] & 0xFFFFull);
        __hip_atomic_fetch_or(&mask[key >> 5], 1u << (key & 31u), __ATOMIC_RELAXED, __HIP_MEMORY_SCOPE_WORKGROUP); }
}
__device__ __forceinline__ void attn_unit(const Args& a, const Ctx& c, int b, int qt, float cshift) {
    const int tid = c.tid, wave = c.wave; LAS unsigned char* lds = c.lds;
#define AT_LAUNDER() int tv_ = tid; asm volatile("" : "+v"(tv_)); const int lane = tv_ & 63, qi = tv_ & 15, fq = (tv_ >> 4) & 3; (void)lane; (void)qi; (void)fq
    const int q0 = qt * 16, ch = q0 >> 6, n = 64 * (ch + 1), ntiles = n >> 4;
    const size_t tb = (size_t)b * SEQ;
    unsigned char* dout = (unsigned char*)a.out;
    const bf16* AQN = (const bf16*)(dout + DO_AQN); const bf16* KN = (const bf16*)(dout + DO_KN); const bf16* IQR = (const bf16*)(dout + DO_IQR); const bf16* IKR = (const bf16*)(dout + DO_IKR);
    bf16* YATT = (bf16*)(dout + DO_YATT);
    const bf16* VB = proj_tile(a, TL_KV); const bf16* PS = (const bf16*)(dout + DO_SMB);
    LAS unsigned* HIST = (LAS unsigned*)(lds + AT_HIST);
    LAS unsigned long long* CAND = (LAS unsigned long long*)(lds + AT_HIST);
    LAS unsigned* MASK = (LAS unsigned*)(lds + AT_SEL);
    LAS int* SM = (LAS int*)(lds + AT_SM);
    float* SC = (blockIdx.x < 240) ? (float*)(a.ws + WS_SC) + (size_t)blockIdx.x * (16 * 4096) : (float*)(a.ws + WS_SC2) + (size_t)(blockIdx.x - 240) * (16 * 4096);
#ifndef DBG_REP_SEL
#define DBG_REP_SEL 1
#endif
#ifndef DBG_REP_DENSE
#define DBG_REP_DENSE 1
#endif
#pragma unroll 1
    for (int rsel = 0; rsel < DBG_REP_SEL; ++rsel) {
    if (n > 256) {
        for (int i = tid; i < 8192 + 4; i += 512) ((LAS v4u*)HIST)[i] = (v4u){0u, 0u, 0u, 0u};
        if (tid < 64) SM[tid] = 0;
        for (int i = tid; i < 16 * AT_MROW; i += 512) MASK[i] = 0u;
        bf16x8 qf[8]; float wv[8];
        { AT_LAUNDER();
        const size_t trow = tb + q0 + qi;
#pragma unroll
        for (int h = 0; h < 8; ++h) qf[h] = *(const bf16x8*)(IQR + trow * 256 + h * 32 + 8 * fq);
        { float t8[8]; unpack8(*(const v4u*)(PS + trow * 16), t8);
#pragma unroll
          for (int h = 0; h < 8; ++h) wv[h] = t8[h] * 0.0625f; } }
        __syncthreads();
#define AT_LOADK(kt_) (*(const bf16x8*)(IKR + (tb + (size_t)(kt_) * 16 + qi) * 32 + 8 * fq))
#define AT_SCORES(kf_, sc_) do { \
        _Pragma("unroll") for (int r_ = 0; r_ < 4; ++r_) sc_[r_] = 0.f; \
        _Pragma("unroll") for (int h_ = 0; h_ < 8; ++h_) { const f32x4 d_ = MFMA16(kf_, qf[h_], ((f32x4){0.f, 0.f, 0.f, 0.f})); \
            _Pragma("unroll") for (int r_ = 0; r_ < 4; ++r_) { const int di_ = __float_as_int(d_[r_]); sc_[r_] = __builtin_fmaf(wv[h_], __int_as_float(di_ > 0 ? di_ : 0), sc_[r_]); } } } while (0)
        const int cnt = (ntiles - wave + 7) >> 3;
#ifndef DBG_RA
#define DBG_RA 1
#endif
#pragma unroll 1
        for (int rA = 0; rA < DBG_RA; ++rA) { if (rA) { for (int i = tid; i < 8192 + 4; i += 512) ((LAS v4u*)HIST)[i] = (v4u){0u, 0u, 0u, 0u}; __syncthreads(); }
#define AT_LOADG(dst_, i0_) do { _Pragma("unroll") for (int j_ = 0; j_ < 8; ++j_) { int kt_ = wave + 8 * ((i0_) + j_); kt_ = kt_ < ntiles ? kt_ : ntiles - 1; dst_[j_] = AT_LOADK(kt_); } } while (0)
#define AT_P1GROUP(buf_, base_) do { _Pragma("unroll") for (int j2 = 0; j2 < 8; ++j2) { const bool valid = ((base_) + j2 < cnt); const int kt = wave + 8 * ((base_) + j2); float sc[4]; AT_SCORES(buf_[j2], sc); \
                if (valid) *(f32x4*)(SC + qi * 4096 + kt * 16 + 4 * fq) = (f32x4){sc[0], sc[1], sc[2], sc[3]}; \
                _Pragma("unroll") for (int r = 0; r < 4; ++r) { const unsigned bin = score_key(sc[r]) >> 20; \
                    __hip_atomic_fetch_add(&HIST[qi * AT_HROW + (bin >> 1)], valid ? (1u << ((bin & 1u) * 16)) : 0u, __ATOMIC_RELAXED, __HIP_MEMORY_SCOPE_WORKGROUP); } } } while (0)
        { AT_LAUNDER(); bf16x8 ka[8], kb[8]; AT_LOADG(ka, 0);
#pragma unroll 1
          for (int i0 = 0; i0 < cnt; i0 += 16) {
            AT_LOADG(kb, i0 + 8);
            AT_P1GROUP(ka, i0);
            AT_LOADG(ka, i0 + 16);
            AT_P1GROUP(kb, i0 + 8); } }
#undef AT_P1GROUP
        __syncthreads();
        }
#ifndef DBG_RB
#define DBG_RB 1
#endif
#pragma unroll 1
        for (int rB = 0; rB < DBG_RB; ++rB) {
#pragma unroll 1
        for (int j = 0; j < 2; ++j) { AT_LAUNDER(); const int q = 2 * wave + j; unsigned tot = 0;
            for (int i = 0; i < 32; ++i) { const unsigned w = HIST[q * AT_HROW + 32 * lane + ((i + lane) & 31)]; tot += (w & 0xffffu) + (w >> 16); }
            const unsigned suf = wave_suffix_sum(tot, lane);
            const unsigned long long mk = __ballot(suf >= 256u); const int L = 63 - __clzll((long long)mk);
            const unsigned above_L = (unsigned)__builtin_amdgcn_readlane((int)(suf - tot), L);
            const unsigned w2 = HIST[q * AT_HROW + 32 * L + (lane >> 1)]; const unsigned cb = (lane & 1) ? (w2 >> 16) : (w2 & 0xffffu);
            const unsigned sfx = wave_suffix_sum(cb, lane);
            const unsigned long long mk2 = __ballot(above_L + sfx >= 256u); const int l2 = 63 - __clzll((long long)mk2);
            if (lane == l2) { SM[q] = 64 * L + l2; SM[16 + q] = (int)(256u - (above_L + sfx - cb)); } }
        __syncthreads();
        }
#ifndef DBG_RC
#define DBG_RC 1
#endif
#pragma unroll 1
        for (int rC = 0; rC < DBG_RC; ++rC) { if (rC) { if (tid < 16) SM[48 + tid] = 0; __syncthreads(); }
        { AT_LAUNDER(); const int Bq = SM[qi]; f32x4 scur[8];
#define AT_LOADS(dst_, i0_) do { _Pragma("unroll") for (int j_ = 0; j_ < 8; ++j_) { int kt_ = wave + 8 * ((i0_) + j_); kt_ = kt_ < ntiles ? kt_ : ntiles - 1; dst_[j_] = *(const f32x4*)(SC + qi * 4096 + kt_ * 16 + 4 * fq); } } while (0)
#define AT_P2GROUP(buf_, base_) do { _Pragma("unroll") for (int j2 = 0; j2 < 8; ++j2) { const bool valid = ((base_) + j2 < cnt); const int kt = wave + 8 * ((base_) + j2); \
                unsigned nib = 0u, cnib = 0u; unsigned uu[4]; \
                _Pragma("unroll") for (int r = 0; r < 4; ++r) { uu[r] = score_key(buf_[j2][r]); const int bin = (int)(uu[r] >> 20); nib |= (bin > Bq) ? (1u << r) : 0u; cnib |= (bin == Bq) ? (1u << r) : 0u; } \
                if (!valid) { nib = 0u; cnib = 0u; } \
                if (cnib) { int p = __hip_atomic_fetch_add(&SM[48 + qi], (int)__popc(cnib), __ATOMIC_RELAXED, __HIP_MEMORY_SCOPE_WORKGROUP); \
                    _Pragma("unroll") for (int r = 0; r < 4; ++r) if ((cnib >> r) & 1u) { if (p < 512) CAND[qi * 1024 + p] = ((unsigned long long)uu[r] << 32) | (unsigned long long)(0xFFFFu - (unsigned)(kt * 16 + 4 * fq + r)); ++p; } } \
                if (nib) __hip_atomic_fetch_or(&MASK[qi * AT_MROW + (kt >> 1)], nib << (16 * (kt & 1) + 4 * fq), __ATOMIC_RELAXED, __HIP_MEMORY_SCOPE_WORKGROUP); } } while (0)
          f32x4 sb2[8];
          AT_LOADS(scur, 0);
#pragma unroll 1
          for (int i0 = 0; i0 < cnt; i0 += 16) {
            AT_LOADS(sb2, i0 + 8);
            AT_P2GROUP(scur, i0);
            AT_LOADS(scur, i0 + 16);
            AT_P2GROUP(sb2, i0 + 8); } }
#undef AT_P2GROUP
#undef AT_LOADS
        __syncthreads();
        }
#ifndef DBG_RD
#define DBG_RD 1
#endif
#pragma unroll 1
        for (int rD = 0; rD < DBG_RD; ++rD) {
#pragma unroll 1
        for (int j = 0; j < 2; ++j) { AT_LAUNDER(); const int q = 2 * wave + j; int m = SM[48 + q]; m = m < 512 ? m : 512; const int nd = SM[16 + q];
            if (m <= 256) at_resolve<4>(CAND + q * 1024, MASK + q * AT_MROW, m, nd, lane); else at_resolve<8>(CAND + q * 1024, MASK + q * AT_MROW, m, nd, lane); }
        __syncthreads();
        }
#undef AT_SCORES
#undef AT_LOADK
#undef AT_LOADG
    } else {
#pragma unroll 1
        for (int i = tid; i < 16 * AT_MROW; i += 512) MASK[i] = ((i % AT_MROW) < (n >> 5)) ? 0xFFFFFFFFu : 0u;
        __syncthreads();
    }
    }
#pragma unroll 1
    for (int rden = 0; rden < DBG_REP_DENSE; ++rden) {
    { const int g = wave >> 2, kh = (wave >> 1) & 1, hp = wave & 1, NS = n >> 6;
      const unsigned ring0 = (unsigned)(size_t)(lds + AT_HIST);
      const bf16* dsrc[4]; unsigned ddst[4];
      { AT_LAUNDER();
#pragma unroll
        for (int i_ = 0; i_ < 4; ++i_) { const int in_ = 4 * wave + i_; const int row_ = 4 * (in_ & 15) + (lane >> 4), pos_ = lane & 15;
            dsrc[i_] = (in_ < 16) ? (KN + (tb + row_) * 128 + ((pos_ ^ (row_ & 15)) << 3)) : (VB + (tb + row_) * 256 + 128 + ((pos_ ^ (2 * (row_ & 7))) << 3));
            ddst[i_] = (unsigned)(in_ * 1024); } }
      const size_t dstep = (wave < 4) ? (size_t)64 * 128 : (size_t)64 * 256;
#define AT_STAGE(s_) do { const unsigned sb_ = ring0 + (unsigned)(((s_) & 3) * 32768); \
        _Pragma("unroll") for (int i_ = 0; i_ < 4; ++i_) { const bf16* src_ = dsrc[i_] + (size_t)(s_) * dstep; \
            const unsigned dst_ = __builtin_amdgcn_readfirstlane(sb_ + ddst[i_]); unsigned keep_; \
            asm volatile("s_mov_b32 %0, m0\n\ts_mov_b32 m0, %2\n\ts_nop 0\n\tglobal_load_lds_dwordx4 %1, off\n\ts_mov_b32 m0, %0" : "=&s"(keep_) : "v"(src_), "s"(dst_) : "memory"); } } while (0)
      bf16x8 qa[2], qb[2]; f32x4 oacc[2][4], lacc[2];
      { AT_LAUNDER();
#pragma unroll
        for (int hi = 0; hi < 2; ++hi) { const bf16* qp = AQN + (tb + q0 + qi) * 512 + (g * 4 + 2 * hp + hi) * 64 + 8 * fq; qa[hi] = *(const bf16x8*)qp; qb[hi] = *(const bf16x8*)(qp + 32); } }
#pragma unroll
      for (int hi = 0; hi < 2; ++hi) { lacc[hi] = (f32x4){0.f, 0.f, 0.f, 0.f};
#pragma unroll
        for (int dt = 0; dt < 4; ++dt) oacc[hi][dt] = (f32x4){0.f, 0.f, 0.f, 0.f}; }
      const bf16x8 ones = (bf16x8){0x3F80, 0x3F80, 0x3F80, 0x3F80, 0x3F80, 0x3F80, 0x3F80, 0x3F80};
      const f32x4 negc = (f32x4){-cshift, -cshift, -cshift, -cshift};
      asm volatile("s_waitcnt vmcnt(0)" ::: "memory");
#pragma unroll 1
      for (int s = 0; s < 3 && s < NS; ++s) AT_STAGE(s);
      typedef short s4_t __attribute__((ext_vector_type(4)));
      AT_LAUNDER();
#pragma unroll 1
      for (int s = 0; s < NS; ++s) {
          if (s + 2 < NS) asm volatile("s_waitcnt vmcnt(8)" ::: "memory"); else asm volatile("s_waitcnt vmcnt(0)" ::: "memory");
          __builtin_amdgcn_s_barrier(); asm volatile("" ::: "memory");
          if (s + 3 < NS) AT_STAGE(s + 3);
          { const LAS unsigned char* kb = lds + AT_HIST + (s & 3) * 32768; const LAS unsigned char* vbs = kb + 16384;
            const unsigned mw = MASK[qi * AT_MROW + 2 * s + kh] >> (4 * fq);
            f32x4 st[2][2];
#pragma unroll
            for (int t = 0; t < 2; ++t) { const int row = 16 * (2 * kh + t) + qi;
                const bf16x8 k0 = *(const LAS bf16x8*)(kb + row * 256 + (((g * 8 + fq) ^ (row & 15)) << 4)), k1 = *(const LAS bf16x8*)(kb + row * 256 + (((g * 8 + 4 + fq) ^ (row & 15)) << 4));
#pragma unroll
                for (int hi = 0; hi < 2; ++hi) { f32x4 d = MFMA16(k0, qa[hi], negc); st[hi][t] = MFMA16(k1, qb[hi], d); } }
            bf16x8 pb[2];
#pragma unroll
            for (int hi = 0; hi < 2; ++hi) { float pv[8];
#pragma unroll
                for (int j = 0; j < 8; ++j) { const float e = __builtin_amdgcn_exp2f(st[hi][j >> 2][j & 3]);
                    const int keep = __builtin_amdgcn_sbfe((int)mw, 16 * (j >> 2) + (j & 3), 1); pv[j] = __uint_as_float(__float_as_uint(e) & (unsigned)keep); }
                v4u pw; pw.x = pk2(pv[0], pv[1]); pw.y = pk2(pv[2], pv[3]); pw.z = pk2(pv[4], pv[5]); pw.w = pk2(pv[6], pv[7]); pb[hi] = __builtin_bit_cast(bf16x8, pw);
                lacc[hi] = MFMA16(ones, pb[hi], lacc[hi]); }
#pragma unroll
            for (int dt = 0; dt < 4; ++dt) { const int r1 = 32 * kh + 4 * fq + (qi >> 2), r2 = r1 + 16; const int ch = g * 8 + 2 * dt + ((lane & 3) >> 1);
                const s4_t lo = __builtin_amdgcn_ds_read_tr16_b64_v4i16((LAS s4_t*)(vbs + r1 * 256 + ((ch ^ (2 * (r1 & 7))) << 4) + (lane & 1) * 8));
                const s4_t hi4 = __builtin_amdgcn_ds_read_tr16_b64_v4i16((LAS s4_t*)(vbs + r2 * 256 + ((ch ^ (2 * (r2 & 7))) << 4) + (lane & 1) * 8));
                const bf16x8 va = (bf16x8){lo[0], lo[1], lo[2], lo[3], hi4[0], hi4[1], hi4[2], hi4[3]};
#pragma unroll
                for (int hi = 0; hi < 2; ++hi) oacc[hi][dt] = MFMA16(va, pb[hi], oacc[hi][dt]); } } }
      __syncthreads();
      { AT_LAUNDER(); LAS unsigned char* red = lds + AT_HIST + (g * 2 + hp) * 8704;
        if (kh == 1) {
#pragma unroll
            for (int hi = 0; hi < 2; ++hi) {
#pragma unroll
                for (int dt = 0; dt < 4; ++dt) *(LAS f32x4*)(red + (hi * 4 + dt) * 1024 + lane * 16) = oacc[hi][dt];
                *(LAS float*)(red + 8192 + hi * 256 + lane * 4) = lacc[hi][0]; } } }
      __syncthreads();
      if (kh == 0) { AT_LAUNDER(); const LAS unsigned char* red = lds + AT_HIST + (g * 2 + hp) * 8704;
#pragma unroll
        for (int hi = 0; hi < 2; ++hi) { const float inv = 1.0f / (lacc[hi][0] + *(const LAS float*)(red + 8192 + hi * 256 + lane * 4));
            bf16* yp = YATT + (tb + q0 + qi) * 512 + (g * 4 + 2 * hp + hi) * 64 + 4 * fq;
#pragma unroll
            for (int dt = 0; dt < 4; ++dt) { const f32x4 o = oacc[hi][dt] + *(const LAS f32x4*)(red + (hi * 4 + dt) * 1024 + lane * 16);
                v2u w; w.x = pk2(o[0] * inv, o[1] * inv); w.y = pk2(o[2] * inv, o[3] * inv); *(v2u*)(yp + 16 * dt) = w; } } }
#undef AT_STAGE
    }
    __syncthreads();
    }
#undef AT_LAUNDER
    __syncthreads();
}

#ifndef DBG_REP_ML
#define DBG_REP_ML 1
#endif
#ifndef DBG_REP_ATT
#define DBG_REP_ATT 1
#endif
__device__ __forceinline__ void p3_mixer(const Args& a, const Ctx& c, volatile LAS unsigned* MISC, int rep) {
#if !defined(NO_MLSTM)
#pragma unroll 1
    for (int rr = 0; rr < DBG_REP_ML; ++rr)
#pragma unroll 1
        for (int u = blockIdx.x; u < 32; u += c.G) mlstm_unit<0>(a, c, u >> 2, u & 3, 0);
#endif
    unsigned* ctl = (unsigned*)(a.ws + WS_CTL);
    const int x = (int)(__builtin_amdgcn_s_getreg((3 << 11) | 20) & 7u);
    float cshift;
    { float gq = fabsf(a.in[IN_GQ][c.lane]), gk = fabsf(a.in[IN_GK][c.lane]);
#pragma unroll
      for (int o = 1; o < 64; o <<= 1) { gq = fmaxf(gq, __shfl_xor(gq, o)); gk = fmaxf(gk, __shfl_xor(gk, o)); }
      cshift = 8.0f * 1.4426950408889634f * gq * gk; }
#pragma unroll 1
    for (int rot = 0; rot < 8 * DBG_REP_ATT; ++rot) { rep = rot >> 3; const int bq = (x + rot) & 7;
        if (c.tid == 0) MISC[16] = __hip_atomic_fetch_add(ctl + CW_Q + 512 * rep + 64 * bq, 1u, RLX_AGENT);
        __syncthreads();
        int u = (int)MISC[16];
        __syncthreads();
#pragma unroll 1
        while (u < 256) {
            unsigned nxt = 0u;
            if (c.tid == 0) nxt = __hip_atomic_fetch_add(ctl + CW_Q + 512 * rep + 64 * bq, 1u, RLX_AGENT);
#if !defined(NO_ATTN)
            attn_unit(a, c, bq, 255 - u, cshift);
#endif
            if (c.tid == 0) MISC[16] = nxt;
            __syncthreads();
            u = (int)MISC[16];
            __syncthreads();
        } }
}
constexpr int RT_WT = 0;
constexpr int RT_WROW = 1028;
constexpr int RT_LG = 36 * RT_WROW * 4;
constexpr int RT_RSTD = RT_LG + 64 * 36 * 4;
constexpr int RT_LCNT = RT_RSTD + 512;
static_assert(RT_LCNT + 128 <= MISC_OFF, "router LDS map");
__device__ __forceinline__ void p6_router(const Args& a, const Ctx& c) {
    const int tid = c.tid, lane = c.lane, wave = c.wave; LAS unsigned char* lds = c.lds;
    LAS float* WT = (LAS float*)(lds + RT_WT); LAS float* LG = (LAS float*)(lds + RT_LG); LAS float* RSTD = (LAS float*)(lds + RT_RSTD); LAS int* LCNT = (LAS int*)(lds + RT_LCNT);
    { int* RT = (int*)(a.ws + WS_ROWTOK); for (int i = blockIdx.x * 512 + tid; i < NROWS_MAX; i += c.G * 512) RT[i] = 0; }
    { const f32x4* src = (const f32x4*)(a.ws + WS_WTG); LAS f32x4* dst = (LAS f32x4*)WT; for (int i = tid; i < 36 * RT_WROW / 4; i += 512) dst[i] = src[i]; }
    f32x4 gv[4];
#pragma unroll
    for (int j = 0; j < 4; ++j) gv[j] = *(const f32x4*)(a.in[IN_GMOE] + 4 * lane + 256 * j);
    const float* X1 = a.out; bf16* XN = (bf16*)(a.ws + WS_XN);
    int* TOKE = (int*)(a.ws + WS_TOKE); int* TOKR = (int*)(a.ws + WS_TOKR); float* TOKG = (float*)(a.ws + WS_TOKG); int* CNT = (int*)(a.ws + WS_CNT);
    __syncthreads();
    for (int blk = blockIdx.x; blk < 256; blk += c.G) {
        if (tid < 32) LCNT[tid] = 0;
#pragma unroll 1
        for (int ri = 0; ri < 16; ri += 2) { const int tA = blk * 128 + wave * 16 + ri, tB = tA + 1;
            const f32x4* xa = (const f32x4*)(X1 + (size_t)tA * D) + lane; const f32x4* xb = (const f32x4*)(X1 + (size_t)tB * D) + lane;
            f32x4 va[4], vb[4]; float sa = 0.f, sb = 0.f;
#pragma unroll
            for (int j = 0; j < 4; ++j) { va[j] = xa[64 * j]; vb[j] = xb[64 * j]; }
#pragma unroll
            for (int j = 0; j < 4; ++j) { sa += (va[j].x * va[j].x + va[j].y * va[j].y) + (va[j].z * va[j].z + va[j].w * va[j].w); sb += (vb[j].x * vb[j].x + vb[j].y * vb[j].y) + (vb[j].z * vb[j].z + vb[j].w * vb[j].w); }
            const float ra = rsqrtf(wave_sum(sa) * (1.f / D) + EPS), rb = rsqrtf(wave_sum(sb) * (1.f / D) + EPS);
            if (lane == 0) { RSTD[wave * 16 + ri] = ra; RSTD[wave * 16 + ri + 1] = rb; }
            v2u* oa = (v2u*)(XN + (size_t)tA * D) + lane; v2u* ob = (v2u*)(XN + (size_t)tB * D) + lane;
#pragma unroll
            for (int j = 0; j < 4; ++j) { v2u w; w.x = pk2(va[j].x * ra * gv[j].x, va[j].y * ra * gv[j].y); w.y = pk2(va[j].z * ra * gv[j].z, va[j].w * ra * gv[j].w); oa[64 * j] = w;
                v2u u; u.x = pk2(vb[j].x * rb * gv[j].x, vb[j].y * rb * gv[j].y); u.y = pk2(vb[j].z * rb * gv[j].z, vb[j].w * rb * gv[j].w); ob[64 * j] = u; } }
        f32x4 acc[3];
#pragma unroll
        for (int ct = 0; ct < 3; ++ct) acc[ct] = (f32x4){0.f, 0.f, 0.f, 0.f};
        { const int row = lane & 15, kq = lane >> 4;
          const f32x4* ap = (const f32x4*)(X1 + (size_t)(blk * 128 + wave * 16 + row) * D + 4 * kq);
          int cj[3]; cj[0] = row; cj[1] = 16 + row; cj[2] = (32 + row) < 36 ? (32 + row) : 35;
          const LAS f32x4* bp0 = (const LAS f32x4*)(WT + cj[0] * RT_WROW + 4 * kq); const LAS f32x4* bp1 = (const LAS f32x4*)(WT + cj[1] * RT_WROW + 4 * kq); const LAS f32x4* bp2 = (const LAS f32x4*)(WT + cj[2] * RT_WROW + 4 * kq);
#define RT_LOADA(dst_, b_) do { _Pragma("unroll") for (int i_ = 0; i_ < 8; ++i_) dst_[i_] = ap[4 * (8 * ((b_) < 8 ? (b_) : 7) + i_)]; } while (0)
#define RT_MMA(src_, b_) do { _Pragma("unroll") for (int i_ = 0; i_ < 8; ++i_) { const int ks_ = 8 * (b_) + i_; const f32x4 b0 = bp0[4 * ks_], b1 = bp1[4 * ks_], b2 = bp2[4 * ks_]; \
              _Pragma("unroll") for (int j = 0; j < 4; ++j) { acc[0] = __builtin_amdgcn_mfma_f32_16x16x4f32(src_[i_][j], b0[j], acc[0], 0, 0, 0); acc[1] = __builtin_amdgcn_mfma_f32_16x16x4f32(src_[i_][j], b1[j], acc[1], 0, 0, 0); \
                  acc[2] = __builtin_amdgcn_mfma_f32_16x16x4f32(src_[i_][j], b2[j], acc[2], 0, 0, 0); } } } while (0)
          f32x4 aA[8], aB[8]; RT_LOADA(aA, 0);
#pragma unroll 1
          for (int bb = 0; bb < 8; bb += 2) { RT_LOADA(aB, bb + 1); RT_MMA(aA, bb); RT_LOADA(aA, bb + 2); RT_MMA(aB, bb + 1); }
#undef RT_LOADA
#undef RT_MMA
        }
#pragma unroll 1
        for (int half = 0; half < 2; ++half) {
            __syncthreads();
            if ((wave >> 2) == half) { const int col = lane & 15, kq = lane >> 4;
#pragma unroll
                for (int ct = 0; ct < 3; ++ct) if (16 * ct + col < 36) {
#pragma unroll
                    for (int r = 0; r < 4; ++r) LG[((wave & 3) * 16 + 4 * kq + r) * 36 + 16 * ct + col] = acc[ct][r]; } }
            __syncthreads();
            if (tid < 64) { const int row = half * 64 + tid, t = blk * 128 + row; const float rs = RSTD[row]; const LAS float* lg = LG + tid * 36;
                float gl[4];
#pragma unroll
                for (int i = 0; i < 4; ++i) gl[i] = rs * lg[32 + i] + a.in[IN_BRG][i];
                int gs = 0; float gmax = gl[0];
#pragma unroll
                for (int i = 1; i < 4; ++i) if (gl[i] > gmax) { gmax = gl[i]; gs = i; }
                float gsum = 0.f;
#pragma unroll
                for (int i = 0; i < 4; ++i) gsum += expf(gl[i] - gmax);
                const float gtop = 1.0f / gsum;
                float ev[8];
#pragma unroll
                for (int i = 0; i < 8; ++i) ev[i] = rs * lg[gs * 8 + i] + a.in[IN_BRE][gs * 8 + i];
                int l0 = 0; float v0 = ev[0];
#pragma unroll
                for (int i = 1; i < 8; ++i) if (ev[i] > v0) { v0 = ev[i]; l0 = i; }
                int l1 = -1; float v1 = -3.0e38f;
#pragma unroll
                for (int i = 0; i < 8; ++i) if (i != l0 && ev[i] > v1) { v1 = ev[i]; l1 = i; }
                const float e1 = expf(v1 - v0), s0 = 1.0f / (1.0f + e1), s1 = e1 * s0;
                const int ex0 = gs * 8 + l0, ex1 = gs * 8 + l1;
                const int rk0 = __hip_atomic_fetch_add(&LCNT[ex0], 1, __ATOMIC_RELAXED, __HIP_MEMORY_SCOPE_WORKGROUP);
                const int rk1 = __hip_atomic_fetch_add(&LCNT[ex1], 1, __ATOMIC_RELAXED, __HIP_MEMORY_SCOPE_WORKGROUP);
                TOKE[2 * t] = ex0; TOKE[2 * t + 1] = ex1; TOKR[2 * t] = rk0; TOKR[2 * t + 1] = rk1; TOKG[2 * t] = s0 * gtop; TOKG[2 * t + 1] = s1 * gtop; }
        }
        __syncthreads();
        if (tid < 32) CNT[blk * 32 + tid] = LCNT[tid];
        __syncthreads();
    }
}
__device__ __forceinline__ void p7_gather(const Args& a, const Ctx& c) {
    const int tid = c.tid, lane = c.lane, wave = c.wave;
    LAS int* PART = (LAS int*)c.lds; LAS int* PPRE = PART + 512; LAS int* TOT = PPRE + 512; LAS int* TS = TOT + 32; LAS int* BASE = TS + 64;
    const int* CNT = (const int*)(a.ws + WS_CNT); const int* TOKE = (const int*)(a.ws + WS_TOKE); const int* TOKR = (const int*)(a.ws + WS_TOKR); int* TOKP = (int*)(a.ws + WS_TOKP);
    int* RT = (int*)(a.ws + WS_ROWTOK);
    { const int e = tid & 31, p = tid >> 5; int s = 0; for (int k = 0; k < 16; ++k) s += CNT[(16 * p + k) * 32 + e]; PART[p * 32 + e] = s; }
    __syncthreads();
    if (tid < 32) { int run = 0; for (int p = 0; p < 16; ++p) { PPRE[p * 32 + tid] = run; run += PART[p * 32 + tid]; } TOT[tid] = run; }
    __syncthreads();
    if (tid == 0) { int ts = 0; for (int e = 0; e < 32; ++e) { TS[e] = ts; ts += (TOT[e] + 255) >> 8; } TS[32] = ts; }
    __syncthreads();
    if (blockIdx.x == 0 && tid < 33) ((int*)(a.ws + WS_SMALL))[tid] = TS[tid];
    for (int blk = blockIdx.x; blk < 256; blk += c.G) {
        if (tid < 32) { int s = TS[tid] * 256 + PPRE[(blk >> 4) * 32 + tid]; for (int b2 = (blk & ~15); b2 < blk; ++b2) s += CNT[b2 * 32 + tid]; BASE[tid] = s; }
        __syncthreads();
        { const int t = blk * 128 + (tid >> 2), jj = tid & 3;
          if (jj < 2) { const int pos = BASE[TOKE[2 * t + jj]] + TOKR[2 * t + jj]; TOKP[2 * t + jj] = pos; RT[pos] = t; } }
        __syncthreads();
    }
}
__device__ __forceinline__ void p10_combine(const Args& a, const Ctx& c) {
    const int lane = c.lane, gw = c.vcu * NWAVES + c.wave, NGW = c.G * NWAVES;
    const int* TOKP = (const int*)(a.ws + WS_TOKP); const float* TOKG = (const float*)(a.ws + WS_TOKG); const bf16* Y = (const bf16*)(a.ws + WS_Y);
    for (int t0 = gw; t0 < T; t0 += 2 * NGW) {
        const int tA = t0, tB = (t0 + NGW < T) ? t0 + NGW : t0; const bool hasB = (t0 + NGW < T);
        const int pA0 = TOKP[2 * tA], pA1 = TOKP[2 * tA + 1], pB0 = TOKP[2 * tB], pB1 = TOKP[2 * tB + 1];
        const float gA0 = TOKG[2 * tA], gA1 = TOKG[2 * tA + 1], gB0 = TOKG[2 * tB], gB1 = TOKG[2 * tB + 1];
        f32x4 xa[4], xb[4]; v2u ya0[4], ya1[4], yb0[4], yb1[4];
#pragma unroll
        for (int j = 0; j < 4; ++j) { const int cc = 4 * lane + 256 * j;
            xa[j] = *(const f32x4*)(a.out + (size_t)tA * D + cc); xb[j] = *(const f32x4*)(a.out + (size_t)tB * D + cc);
            ya0[j] = *(const v2u*)(Y + (size_t)pA0 * D + cc); ya1[j] = *(const v2u*)(Y + (size_t)pA1 * D + cc);
            yb0[j] = *(const v2u*)(Y + (size_t)pB0 * D + cc); yb1[j] = *(const v2u*)(Y + (size_t)pB1 * D + cc); }
#pragma unroll
        for (int j = 0; j < 4; ++j) { const int cc = 4 * lane + 256 * j; f32x4 x = xa[j];
            x[0] += gA0 * bf2f(ya0[j].x & 0xffffu) + gA1 * bf2f(ya1[j].x & 0xffffu); x[1] += gA0 * bf2f(ya0[j].x >> 16) + gA1 * bf2f(ya1[j].x >> 16);
            x[2] += gA0 * bf2f(ya0[j].y & 0xffffu) + gA1 * bf2f(ya1[j].y & 0xffffu); x[3] += gA0 * bf2f(ya0[j].y >> 16) + gA1 * bf2f(ya1[j].y >> 16);
            *(f32x4*)(a.out + (size_t)tA * D + cc) = x; }
        if (hasB) {
#pragma unroll
        for (int j = 0; j < 4; ++j) { const int cc = 4 * lane + 256 * j; f32x4 x = xb[j];
            x[0] += gB0 * bf2f(yb0[j].x & 0xffffu) + gB1 * bf2f(yb1[j].x & 0xffffu); x[1] += gB0 * bf2f(yb0[j].x >> 16) + gB1 * bf2f(yb1[j].x >> 16);
            x[2] += gB0 * bf2f(yb0[j].y & 0xffffu) + gB1 * bf2f(yb1[j].y & 0xffffu); x[3] += gB0 * bf2f(yb0[j].y >> 16) + gB1 * bf2f(yb1[j].y >> 16);
            *(f32x4*)(a.out + (size_t)tB * D + cc) = x; } }
    }
}
__global__ void __launch_bounds__(NWAVES * 64, 2) hybrid_fwd(Args args) {
    extern __shared__ __attribute__((aligned(16))) unsigned char lds_raw[];
    Ctx c; c.lds = (LAS unsigned char*)lds_raw;
    volatile LAS unsigned* MISC = (volatile LAS unsigned*)(c.lds + MISC_OFF);
    c.tid = threadIdx.x; c.lane = c.tid & 63; c.wave = __builtin_amdgcn_readfirstlane(c.tid >> 6);
    c.G = gridDim.x; { const int bx = blockIdx.x; c.vcu = (c.G % 8 == 0) ? (bx % 8) * (c.G / 8) + bx / 8 : bx; }
    unsigned* ctl = (unsigned*)(args.ws + WS_CTL);
    if (c.tid < 128) MISC[c.tid] = 0u;
    __syncthreads();
    XcdBarrier bar; bar.bar = ctl + CW_BAR; bar.x = 0; bar.st = nullptr;
    if (N_LAUNCHES == 1) bar = xcd_barrier_post(ctl + CW_BAR, MISC + 8);
#define GRID_BAR() do { if (N_LAUNCHES == 1) xcd_barrier(bar); } while (0)
    const int lo = args.ph_lo, hi = args.ph_hi;
#ifndef PH_MASK
#define PH_MASK 0xfff
#endif
#define IN(k) (((PH_MASK >> (k)) & 1) && lo <= (k) && (k) < hi)
#define BOTH(k) (IN(k) && IN((k) + 1))
    unsigned char* ws = args.ws; unsigned char* dout = (unsigned char*)args.out;
#ifndef DBG_REPEAT
#define DBG_REPEAT -1
#endif
#define REPS(k) (((k) == DBG_REPEAT) ? 2 : 1)
    if (IN(0)) { _Pragma("unroll") for (int rep = 0; rep < REPS(0); ++rep) { if (rep) GRID_BAR(); p0_prologue<0>(args, c, c.vcu * NWAVES + c.wave, c.G * NWAVES); } if (BOTH(0)) GRID_BAR(); }
    if (IN(1)) { _Pragma("unroll") for (int rep = 0; rep < REPS(1); ++rep) { if (rep) GRID_BAR();
        pg8::Gemm g{(const pg8::bf16_t*)(dout + DO_H), (const pg8::bf16_t*)(ws + WS_WIN), T, NPROJ, D}; pg8::StaticOrder S; S.init(T, NPROJ, c.G, (int)blockIdx.x);
        pg8::EpiBf16<0> E{(pg8::bf16_t*)(ws + WS_PROJ), 256, nullptr, 256, (size_t)T * 256, 1.f};
        pg8::gemm_phase<pg8::EpiBf16<0>, pg8::StaticOrder, true, true>(c.lds, g, S, E); }
        if (BOTH(1)) GRID_BAR();
    }
#ifndef DBG_R2
#define DBG_R2 1
#endif
#ifndef DBG_R4A
#define DBG_R4A 1
#endif
#ifndef DBG_R4B
#define DBG_R4B 1
#endif
#ifndef DBG_R7
#define DBG_R7 1
#endif
    if (IN(2)) { _Pragma("unroll 1") for (int rep = 0; rep < DBG_R2; ++rep) { if (rep) GRID_BAR(); p2_prep(args, c); } if (BOTH(2)) GRID_BAR(); }
    if (IN(3)) { _Pragma("unroll") for (int rep = 0; rep < REPS(3); ++rep) { if (rep) GRID_BAR(); p3_mixer(args, c, MISC, rep); } if (BOTH(3)) GRID_BAR(); }
    if (IN(4)) {
#pragma unroll 1
        for (int rep = 0; rep < DBG_R4A; ++rep) { p0_prologue<1>(args, c, c.vcu * NWAVES + c.wave, c.G * NWAVES); __syncthreads(); }
#pragma unroll 1
        for (int rep = 0; rep < DBG_R4B; ++rep)
#pragma unroll 1
        for (int u = blockIdx.x; u < 256; u += c.G) mlstm_unit<1>(args, c, u >> 5, (u >> 3) & 3, u & 7);
        if (BOTH(4)) GRID_BAR();
    }
    if (IN(5)) {
        { pg8::Gemm g{(const pg8::bf16_t*)(dout + DO_YATT), (const pg8::bf16_t*)(ws + WS_WPA), T, D, 512}; pg8::StaticOrder S; S.init(T, D, c.G, (int)blockIdx.x);
          pg8::EpiGate<false> E{(pg8::bf16_t*)(ws + WS_MERGED), D, (const pg8::bf16_t*)(ws + WS_PROJ + (size_t)TL_GA * PROJ_TILE), (size_t)T * 256};
          pg8::gemm_phase<pg8::EpiGate<false>, pg8::StaticOrder, true, true>(c.lds, g, S, E); }
        __syncthreads();
        { pg8::Gemm g{(const pg8::bf16_t*)(dout + DO_YML), (const pg8::bf16_t*)(ws + WS_WPM), T, D, 512}; pg8::StaticOrder S; S.init(T, D, c.G, (int)blockIdx.x);
          pg8::EpiGate<true> E{(pg8::bf16_t*)(ws + WS_MERGED), D, (const pg8::bf16_t*)(ws + WS_PROJ + (size_t)TL_GM * PROJ_TILE), (size_t)T * 256};
          pg8::gemm_phase<pg8::EpiGate<true>, pg8::StaticOrder, true, true>(c.lds, g, S, E); }
        if (BOTH(5)) GRID_BAR();
    }
    if (IN(6)) {
        pg8::Gemm g{(const pg8::bf16_t*)(ws + WS_MERGED), (const pg8::bf16_t*)(ws + WS_WOUT), T, D, D}; pg8::StaticOrder S; S.init(T, D, c.G, (int)blockIdx.x);
        pg8::EpiRes E{args.out, args.in[IN_X], D};
        pg8::gemm_phase<pg8::EpiRes, pg8::StaticOrder, true, true>(c.lds, g, S, E);
        if (BOTH(6)) GRID_BAR();
    }
    if (IN(7)) { _Pragma("unroll 1") for (int rep = 0; rep < DBG_R7; ++rep) { if (rep) { GRID_BAR(); } p6_router(args, c); } if (BOTH(7)) GRID_BAR(); }
    if (IN(8)) { _Pragma("unroll") for (int rep = 0; rep < REPS(8); ++rep) { if (rep) GRID_BAR(); p7_gather(args, c); } if (BOTH(8)) GRID_BAR(); }
    if (IN(9) || IN(10)) {
        LAS int* TSL = (LAS int*)(c.lds + MISC_OFF + 256);
        if (c.tid < 33) TSL[c.tid] = (int)__hip_atomic_load((unsigned*)(ws + WS_SMALL) + c.tid, RLX_AGENT);
        __syncthreads();
        if (IN(9)) {
            pg8::MoeOrder<true> S{TSL, c.G, (int)blockIdx.x, (const int*)(ws + WS_ROWTOK)};
            pg8::Gemm g{(const pg8::bf16_t*)(ws + WS_XN), (const pg8::bf16_t*)(ws + WS_GU), 0, 0, D};
            pg8::EpiSwiGLU E{(pg8::bf16_t*)(ws + WS_HID)};
            pg8::gemm_phase<pg8::EpiSwiGLU, pg8::MoeOrder<true>, true, true>(c.lds, g, S, E);
            if (BOTH(9)) GRID_BAR();
        }
        if (IN(10)) {
            pg8::MoeOrder<false> S{TSL, c.G, (int)blockIdx.x, nullptr};
            pg8::Gemm g{(const pg8::bf16_t*)(ws + WS_HID), (const pg8::bf16_t*)(ws + WS_DN), 0, 0, 512};
            pg8::EpiDown E{(pg8::bf16_t*)(ws + WS_Y)};
            pg8::gemm_phase<pg8::EpiDown, pg8::MoeOrder<false>, true, true>(c.lds, g, S, E);
            if (BOTH(10)) GRID_BAR();
        }
    }
    if (IN(11)) p10_combine(args, c);
#undef IN
#undef BOTH
#undef GRID_BAR
}

extern "C" void kernel_launch(void* const* d_in, const int* in_sizes, int n_in, void* d_out, int out_size, void* d_ws, size_t ws_size, hipStream_t stream) {
    static int grid = 0;
    if (grid == 0) {
        if (n_in != 22 || in_sizes[0] != T * D || out_size != T * D || ws_size < WS_END) { fprintf(stderr, "kernel_launch: unexpected shapes (n_in %d, in0 %d, out %d, ws %zu); nothing launched\n", n_in, n_in > 0 ? in_sizes[0] : -1, out_size, ws_size); grid = -1; return; }
        int dev = 0, cus = 0, per_cu = 0;
        if (hipGetDevice(&dev) != hipSuccess || hipDeviceGetAttribute(&cus, hipDeviceAttributeMultiprocessorCount, dev) != hipSuccess) { grid = -1; return; }
        if (hipFuncSetAttribute((const void*)hybrid_fwd, hipFuncAttributeMaxDynamicSharedMemorySize, LDS_BYTES) != hipSuccess) { fprintf(stderr, "kernel_launch: hipFuncSetAttribute failed\n"); grid = -1; return; }
        if (hipOccupancyMaxActiveBlocksPerMultiprocessor(&per_cu, (const void*)hybrid_fwd, NWAVES * 64, LDS_BYTES) != hipSuccess || per_cu < 1)
            fprintf(stderr, "kernel_launch: note: occupancy query reports %d workgroups per CU\n", per_cu);
        (void)hipGetLastError();
        grid = cus;
    }
    if (grid < 0) return;
    if (hipMemsetAsync((char*)d_ws + WS_CTL, 0, CTL_ZERO_BYTES, stream) != hipSuccess) return;
    Args a{};
    for (int i = 0; i < 22; ++i) a.in[i] = (const float*)d_in[i];
    a.out = (float*)d_out; a.ws = (unsigned char*)d_ws;
    for (int li = 0; li < N_LAUNCHES; ++li) {
        a.ph_lo = (N_LAUNCHES == 1) ? 0 : li; a.ph_hi = (N_LAUNCHES == 1) ? NPH : li + 1; a.li = li;
        hipLaunchKernelGGL(hybrid_fwd, dim3(grid), dim3(NWAVES * 64), LDS_BYTES, stream, a);
        if (hipPeekAtLastError() != hipSuccess) { fprintf(stderr, "kernel_launch: launch %d failed\n", li); break; }
    }
}
```

```cpp
#include <hip/hip_runtime.h>
#include <cstdio>
#include <cstdint>
namespace pg8 {
#define PG8_LAS __attribute__((address_space(3)))
typedef unsigned short bf16_t;
typedef short bf16x8 __attribute__((ext_vector_type(8)));
typedef float f32x4 __attribute__((ext_vector_type(4)));
typedef unsigned u32x4 __attribute__((ext_vector_type(4)));
constexpr int BM = 256, BK = 64, HALF = 128, HTB = HALF * BK * 2  , STAGE_BYTES = 8 * HTB, NXCD = 8, WGM = 8;

__host__ __device__ __forceinline__ int lds_byte(int r, int c) { const int st = (r >> 4) * 2 + (c >> 5), rr = r & 15, cc = c & 31, ob = rr * 64 + cc * 2; return st * 1024 + (ob ^ (((ob >> 9) & 1) << 5)); }
__host__ __device__ __forceinline__ void stage_rc(int b, int& R, int& C) { const int st = b / 1024, sb = b % 1024, swz = sb ^ (((sb >> 9) & 1) << 5); R = (st >> 1) * 16 + swz / 64; C = (st & 1) * 32 + (swz % 64) / 2; }
__host__ __device__ __forceinline__ int perm32(int rho) { const int n = rho >> 4, i = rho & 15; return 8 * (i >> 2) + 4 * n + (i & 3); }

struct Unit { int pm, pn; };
struct Gemm { const bf16_t* A; const bf16_t* Bt; int M, N, K; };

struct StaticOrder {
    static constexpr bool GATHER = false;
    int nM, nN, nwg, G, c;
    __host__ __device__ void init(int M, int N, int G_, int c_) { nM = M / BM; nN = N / BM; nwg = nM * nN; G = G_; c = c_; }
    __host__ __device__ bool next(int i, Unit& u) const {
        const long L = (long)i * G + c; if (L >= nwg) return false;
        int wgid = (int)L; { const int q = nwg / NXCD, r = nwg % NXCD, xcd = wgid % NXCD, off = wgid / NXCD; wgid = (xcd < r ? xcd * (q + 1) : r * (q + 1) + (xcd - r) * q) + off; }
        const int nig = WGM * nN, gid = wgid / nig, fm = gid * WGM, gsz = (nM - fm) < WGM ? (nM - fm) : WGM;
        u.pm = fm + ((wgid % nig) % gsz); u.pn = (wgid % nig) / gsz; return true;
    }
    __device__ __forceinline__ void a_ready(const Unit&) const {}
    __device__ __forceinline__ void done(const Unit&) const {}
};

typedef __bf16 bf2_t __attribute__((ext_vector_type(2)));
__device__ __forceinline__ unsigned cvt_pk_bf16(float lo, float hi) { bf2_t v; v[0] = (__bf16)lo; v[1] = (__bf16)hi; return __builtin_bit_cast(unsigned, v); }
typedef float f32x2 __attribute__((ext_vector_type(2)));
template <int ACT  > struct EpiBf16 {
    static constexpr bool PERM = true, AFTER_DRAIN = false; static_assert(ACT == 0, "EpiBf16: no activation here");
    bf16_t* O; int ldc; const float* bias; int split_cols; size_t split_stride; float scale0;
    __device__ __forceinline__ void operator()(const f32x4 (&acc)[2][2][4][2], const Unit& u, int wr, int wc, int fr, int fq) const {
        const int row0 = u.pm * BM + wr * 64 + fr; int colt = u.pn * BM; bf16_t* base = O;
        float sc = 1.f; if (split_cols) { const int t = colt / split_cols; base += (size_t)t * split_stride; colt -= t * split_cols; if (t == 0) sc = scale0; }
        const int col0 = colt + wc * 32 + 8 * fq, bcol0 = u.pn * BM + wc * 32 + 8 * fq;
        f32x4 bv[2][2];
#pragma unroll
        for (int bj = 0; bj < 2; ++bj)
#pragma unroll
            for (int n = 0; n < 2; ++n) bv[bj][n] = bias ? *(const f32x4*)(bias + bcol0 + bj * HALF + 4 * n) : (f32x4){0.f, 0.f, 0.f, 0.f};
#pragma unroll
        for (int ai = 0; ai < 2; ++ai)
#pragma unroll
            for (int m = 0; m < 4; ++m) { bf16_t* rowp = base + (size_t)(row0 + ai * HALF + m * 16) * ldc + col0;
#pragma unroll
                for (int bj = 0; bj < 2; ++bj) { f32x4 v0 = acc[ai][bj][m][0] + bv[bj][0], v1 = acc[ai][bj][m][1] + bv[bj][1];
                    v0 = v0 * sc; v1 = v1 * sc; u32x4 w; w.x = cvt_pk_bf16(v0[0], v0[1]); w.y = cvt_pk_bf16(v0[2], v0[3]); w.z = cvt_pk_bf16(v1[0], v1[1]); w.w = cvt_pk_bf16(v1[2], v1[3]);
                    *(u32x4*)(rowp + bj * HALF) = w; } }
    }
};
__device__ __forceinline__ float bf2f_(unsigned b16) { return __uint_as_float(b16 << 16); }
__device__ __forceinline__ float sigm_(float x) { return 1.0f / (1.0f + __expf(-x)); }
template <bool ADD> struct EpiGate {
    static constexpr bool PERM = true, AFTER_DRAIN = false;
    bf16_t* O; int ldc; const bf16_t* gate; size_t gstride;
    __device__ __forceinline__ void operator()(const f32x4 (&acc)[2][2][4][2], const Unit& u, int wr, int wc, int fr, int fq) const {
        const int row0 = u.pm * BM + wr * 64 + fr, colt = wc * 32 + 8 * fq;
        const bf16_t* gt = gate + (size_t)u.pn * gstride;
#pragma unroll
        for (int ai = 0; ai < 2; ++ai)
#pragma unroll
            for (int m = 0; m < 4; ++m) { const size_t row = (size_t)(row0 + ai * HALF + m * 16);
#pragma unroll
                for (int bj = 0; bj < 2; ++bj) { const int c = colt + bj * HALF;
                    const u32x4 gv = *(const u32x4*)(gt + row * 256 + c);
                    bf16_t* op = O + row * ldc + u.pn * BM + c;
                    float pv[8] = {0.f, 0.f, 0.f, 0.f, 0.f, 0.f, 0.f, 0.f};
                    if (ADD) { const u32x4 p = *(const u32x4*)op; pv[0] = bf2f_(p.x & 0xffffu); pv[1] = bf2f_(p.x >> 16); pv[2] = bf2f_(p.y & 0xffffu); pv[3] = bf2f_(p.y >> 16);
                        pv[4] = bf2f_(p.z & 0xffffu); pv[5] = bf2f_(p.z >> 16); pv[6] = bf2f_(p.w & 0xffffu); pv[7] = bf2f_(p.w >> 16); }
                    const f32x4 v0 = acc[ai][bj][m][0], v1 = acc[ai][bj][m][1];
                    float o[8];
                    o[0] = pv[0] + sigm_(bf2f_(gv.x & 0xffffu)) * v0[0]; o[1] = pv[1] + sigm_(bf2f_(gv.x >> 16)) * v0[1];
                    o[2] = pv[2] + sigm_(bf2f_(gv.y & 0xffffu)) * v0[2]; o[3] = pv[3] + sigm_(bf2f_(gv.y >> 16)) * v0[3];
                    o[4] = pv[4] + sigm_(bf2f_(gv.z & 0xffffu)) * v1[0]; o[5] = pv[5] + sigm_(bf2f_(gv.z >> 16)) * v1[1];
                    o[6] = pv[6] + sigm_(bf2f_(gv.w & 0xffffu)) * v1[2]; o[7] = pv[7] + sigm_(bf2f_(gv.w >> 16)) * v1[3];
                    u32x4 w; w.x = cvt_pk_bf16(o[0], o[1]); w.y = cvt_pk_bf16(o[2], o[3]); w.z = cvt_pk_bf16(o[4], o[5]); w.w = cvt_pk_bf16(o[6], o[7]);
                    *(u32x4*)op = w; } }
    }
};
struct EpiRes {
    static constexpr bool PERM = false, AFTER_DRAIN = false;
    float* C; const float* R; int ldc;
    __device__ __forceinline__ void operator()(const f32x4 (&acc)[2][2][4][2], const Unit& u, int wr, int wc, int fr, int fq) const {
        const int row0 = u.pm * BM + wr * 64 + fr, col0 = u.pn * BM + wc * 32 + 4 * fq;
#pragma unroll
        for (int ai = 0; ai < 2; ++ai)
#pragma unroll
            for (int m = 0; m < 4; ++m) { const size_t ro = (size_t)(row0 + ai * HALF + m * 16) * ldc + col0;
#pragma unroll
                for (int bj = 0; bj < 2; ++bj)
#pragma unroll
                    for (int n = 0; n < 2; ++n) { const size_t off = ro + bj * HALF + n * 16; *(f32x4*)(C + off) = *(const f32x4*)(R + off) + acc[ai][bj][m][n]; } }
    }
};
struct EpiSwiGLU {
    static constexpr bool PERM = true, AFTER_DRAIN = false;
    bf16_t* H;
    __device__ __forceinline__ void operator()(const f32x4 (&acc)[2][2][4][2], const Unit& u, int wr, int wc, int fr, int fq) const {
        const int row0 = u.pm * BM + wr * 64 + fr, hc = (u.pn & 3) * 128 + wc * 32 + 8 * fq;
#pragma unroll
        for (int ai = 0; ai < 2; ++ai)
#pragma unroll
            for (int m = 0; m < 4; ++m) { const size_t row = (size_t)(row0 + ai * HALF + m * 16);
                float o[8];
#pragma unroll
                for (int n = 0; n < 2; ++n)
#pragma unroll
                    for (int i = 0; i < 4; ++i) { const float g = acc[ai][0][m][n][i], up = acc[ai][1][m][n][i]; o[n * 4 + i] = g * sigm_(g) * up; }
                u32x4 w; w.x = cvt_pk_bf16(o[0], o[1]); w.y = cvt_pk_bf16(o[2], o[3]); w.z = cvt_pk_bf16(o[4], o[5]); w.w = cvt_pk_bf16(o[6], o[7]);
                *(u32x4*)(H + row * 512 + hc) = w; }
    }
};
struct EpiDown {
    static constexpr bool PERM = true, AFTER_DRAIN = false;
    bf16_t* Y;
    __device__ __forceinline__ void operator()(const f32x4 (&acc)[2][2][4][2], const Unit& u, int wr, int wc, int fr, int fq) const {
        const int row0 = u.pm * BM + wr * 64 + fr, c0 = (u.pn & 3) * 256 + wc * 32 + 8 * fq;
#pragma unroll
        for (int ai = 0; ai < 2; ++ai)
#pragma unroll
            for (int m = 0; m < 4; ++m) { const size_t row = (size_t)(row0 + ai * HALF + m * 16);
#pragma unroll
                for (int bj = 0; bj < 2; ++bj) { const f32x4 v0 = acc[ai][bj][m][0], v1 = acc[ai][bj][m][1];
                    u32x4 w; w.x = cvt_pk_bf16(v0[0], v0[1]); w.y = cvt_pk_bf16(v0[2], v0[3]); w.z = cvt_pk_bf16(v1[0], v1[1]); w.w = cvt_pk_bf16(v1[2], v1[3]);
                    *(u32x4*)(Y + row * 1024 + c0 + bj * HALF) = w; } }
    }
};
template <bool GA_> struct MoeOrder {
    static constexpr bool GATHER = GA_;
    const PG8_LAS int* ts; int G, c; const int* rowtok;
    __device__ __forceinline__ bool next(int i, Unit& u) const {
        const int nt = ts[32]; const long L = (long)i * G + c; if (L >= 4L * nt) return false;
        const int pm = (int)(L >> 2), j = (int)(L & 3); int e = 0;
#pragma unroll
        for (int k = 1; k < 32; ++k) e += (ts[k] <= pm) ? 1 : 0;
        u.pm = pm; u.pn = e * 4 + j; return true;
    }
    __device__ __forceinline__ void a_ready(const Unit&) const {}
    __device__ __forceinline__ void done(const Unit&) const {}
};
template <class Epi, class Sched, bool ALIGN_EPI = false, bool SP2 = false>
__device__ __forceinline__ void gemm_phase(PG8_LAS unsigned char* lds, const Gemm g, const Sched& S, const Epi& E) {
    const int tid = threadIdx.x, wid = __builtin_amdgcn_readfirstlane(tid >> 6), lane = tid & 63, wr = wid >> 2, wc = wid & 3, fr = lane & 15, fq = lane >> 4;
    const int K = g.K, nt = K / BK;
    unsigned voffA[2], voffB[2];
#pragma unroll
    for (int i = 0; i < 2; ++i) { int R, C; stage_rc(tid * 16 + i * 8192, R, C); const int Rb = Epi::PERM ? ((R & ~31) + perm32(R & 31)) : R;
        voffA[i] = (unsigned)(R * K + C) * 2u; voffB[i] = (unsigned)(Rb * K + C) * 2u; }
    const size_t kstep = (size_t)(BK * 2);
    const size_t hstep = (size_t)HALF * K * 2;
    const size_t tstep = 2 * hstep;
    constexpr bool GA = Sched::GATHER;
    static_assert(!GA || SP2, "gathered A rows: SP2 loop only");
    const size_t hstepA = GA ? 0 : hstep;
    unsigned gcur[2][2] = {{0u, 0u}, {0u, 0u}}, gnxt[2][2] = {{0u, 0u}, {0u, 0u}}; int gR[2] = {0, 0}; unsigned gC[2] = {0u, 0u};
    if constexpr (GA) { _Pragma("unroll") for (int i = 0; i < 2; ++i) { int R, C; stage_rc(tid * 16 + i * 8192, R, C); gR[i] = R; gC[i] = (unsigned)C * 2u; } }
#define PG8_GOFF(dst, u) do { if constexpr (GA) { _Pragma("unroll") for (int h_ = 0; h_ < 2; ++h_) _Pragma("unroll") for (int i_ = 0; i_ < 2; ++i_) dst[h_][i_] = (unsigned)S.rowtok[(u).pm * BM + h_ * HALF + gR[i_]] * (unsigned)(K * 2) + gC[i_]; } } while (0)
#define PG8_VA(h, sel) (GA ? ((sel) ? gnxt[h] : gcur[h]) : voffA)
    const unsigned ldsw = (unsigned)wid * 1024u;
    const int aoff = lds_byte(wr * 64 + fr, fq * 8), boff = lds_byte(wc * 32 + fr, fq * 8);
#define PG8_SA(b, h) (((b) * 2 + (h)) * HTB)
#define PG8_SB(b, h) ((4 + (b) * 2 + (h)) * HTB)
#define PG8_STAGE(bufoff, gbase, voff) do { _Pragma("unroll") for (int _i = 0; _i < 2; ++_i) \
        __builtin_amdgcn_global_load_lds((const unsigned*)((const char*)(gbase) + (voff)[_i]), (PG8_LAS unsigned*)(lds + (bufoff) + ldsw + _i * 8192), 16, 0, 0); } while (0)
#define PG8_LDA(dst, b, h) do { _Pragma("unroll") for (int m = 0; m < 4; ++m) _Pragma("unroll") for (int k = 0; k < 2; ++k) dst[m][k] = *(const PG8_LAS bf16x8*)(lds + PG8_SA(b, h) + aoff + m * 2048 + k * 1024); } while (0)
#define PG8_LDB(dst, b, h) do { _Pragma("unroll") for (int n = 0; n < 2; ++n) _Pragma("unroll") for (int k = 0; k < 2; ++k) dst[n][k] = *(const PG8_LAS bf16x8*)(lds + PG8_SB(b, h) + boff + n * 2048 + k * 1024); } while (0)
#define PG8_MMA(ai, bj, At, Bt) do { __builtin_amdgcn_s_setprio(1); _Pragma("unroll") for (int m = 0; m < 4; ++m) _Pragma("unroll") for (int n = 0; n < 2; ++n) _Pragma("unroll") for (int k = 0; k < 2; ++k) \
        acc[ai][bj][m][n] = __builtin_amdgcn_mfma_f32_16x16x32_bf16(Bt[n][k], At[m][k], acc[ai][bj][m][n], 0, 0, 0); __builtin_amdgcn_s_setprio(0); } while (0)
#define PG8_WAIT_V(n) asm volatile("s_waitcnt vmcnt(" #n ")" ::: "memory")
#define PG8_WAIT_L(n) asm volatile("s_waitcnt lgkmcnt(" #n ")" ::: "memory")
#define PG8_BAR __builtin_amdgcn_s_barrier()
#define PG8_SCHED __builtin_amdgcn_sched_barrier(0)
    Unit cur, nxt; int ui = 0;
    if (!S.next(0, cur)) return;
    f32x4 acc[2][2][4][2];
#pragma unroll
    for (int a = 0; a < 2; ++a)
#pragma unroll
        for (int b = 0; b < 2; ++b)
#pragma unroll
            for (int m = 0; m < 4; ++m)
#pragma unroll
                for (int n = 0; n < 2; ++n) acc[a][b][m][n] = (f32x4){0.f, 0.f, 0.f, 0.f};
    bf16x8 At[4][2], B0[2][2], B1[2][2];
    const char* cA = (const char*)g.A + (GA ? 0 : (size_t)cur.pm * tstep); const char* cB = (const char*)g.Bt + (size_t)cur.pn * tstep;
    S.a_ready(cur);
    PG8_GOFF(gcur, cur);
    if constexpr (SP2) {
        PG8_STAGE(PG8_SB(0, 0), cB, voffB); PG8_STAGE(PG8_SB(0, 1), cB + hstep, voffB); PG8_STAGE(PG8_SA(0, 0), cA, PG8_VA(0, false)); PG8_STAGE(PG8_SA(0, 1), cA + hstepA, PG8_VA(1, false));
        if (wr == 1) PG8_BAR;
        PG8_WAIT_V(2); PG8_BAR;
        PG8_STAGE(PG8_SB(1, 0), cB + kstep, voffB); PG8_STAGE(PG8_SA(1, 0), cA + kstep, PG8_VA(0, false)); PG8_STAGE(PG8_SB(1, 1), cB + hstep + kstep, voffB);
        PG8_WAIT_V(6); PG8_BAR;
    } else {
        PG8_STAGE(PG8_SB(0, 0), cB, voffB); PG8_STAGE(PG8_SA(0, 0), cA, voffA); PG8_STAGE(PG8_SB(0, 1), cB + hstep, voffB); PG8_STAGE(PG8_SA(0, 1), cA + hstep, voffA);
        if (wr == 1) PG8_BAR;
        PG8_WAIT_V(4); PG8_BAR;
        PG8_STAGE(PG8_SB(1, 0), cB + kstep, voffB); PG8_STAGE(PG8_SA(1, 0), cA + kstep, voffA); PG8_STAGE(PG8_SB(1, 1), cB + hstep + kstep, voffB);
        PG8_WAIT_V(6); PG8_BAR;
    }
    for (;;) {
        const bool has_next = S.next(ui + 1, nxt);
        if (has_next) PG8_GOFF(gnxt, nxt);
        const char* nA = has_next ? (const char*)g.A + (GA ? 0 : (size_t)nxt.pm * tstep) : cA; const char* nB = has_next ? (const char*)g.Bt + (size_t)nxt.pn * tstep : cB;
        for (int t = 0; t < nt; t += 2) {
            const bool last = (t == nt - 2);
            const char* a1 = cA + (size_t)(t + 1) * kstep;
            const char* a2 = last ? nA : cA + (size_t)(t + 2) * kstep; const char* b2 = last ? nB : cB + (size_t)(t + 2) * kstep;
            const char* a3 = a2 + kstep; const char* b3 = b2 + kstep;
            if (last && has_next) S.a_ready(nxt);
            const bool seln = last && has_next;
            if constexpr (SP2) {
            PG8_LDB(B0, 0, 0); PG8_LDB(B1, 0, 1); PG8_SCHED; PG8_LDA(At, 0, 0); PG8_STAGE(PG8_SA(1, 1), a1 + hstepA, PG8_VA(1, false));
            PG8_WAIT_V(8); PG8_WAIT_L(0); PG8_BAR; PG8_MMA(0, 0, At, B0); PG8_MMA(0, 1, At, B1); PG8_BAR; PG8_SCHED;
            PG8_LDA(At, 0, 1); PG8_STAGE(PG8_SB(0, 0), b2, voffB); PG8_STAGE(PG8_SB(0, 1), b2 + hstep, voffB); PG8_STAGE(PG8_SA(0, 0), a2, PG8_VA(0, seln));
            PG8_WAIT_V(8); PG8_WAIT_L(0); PG8_BAR; PG8_MMA(1, 0, At, B0); PG8_MMA(1, 1, At, B1); PG8_BAR; PG8_SCHED;
            PG8_LDB(B0, 1, 0); PG8_LDB(B1, 1, 1); PG8_SCHED; PG8_LDA(At, 1, 0); PG8_STAGE(PG8_SA(0, 1), a2 + hstepA, PG8_VA(1, seln));
            PG8_WAIT_V(8); PG8_WAIT_L(0); PG8_BAR; PG8_MMA(0, 0, At, B0); PG8_MMA(0, 1, At, B1); PG8_BAR; PG8_SCHED;
            PG8_LDA(At, 1, 1); PG8_STAGE(PG8_SB(1, 0), b3, voffB); PG8_STAGE(PG8_SB(1, 1), b3 + hstep, voffB); PG8_STAGE(PG8_SA(1, 0), a3, PG8_VA(0, seln));
            PG8_WAIT_V(8); PG8_WAIT_L(0); PG8_BAR; PG8_MMA(1, 0, At, B0); PG8_MMA(1, 1, At, B1); PG8_BAR; PG8_SCHED;
            } else {
            PG8_LDB(B0, 0, 0); PG8_SCHED; PG8_LDA(At, 0, 0); PG8_STAGE(PG8_SA(1, 1), a1 + hstep, voffA);
            PG8_WAIT_L(8); PG8_BAR; PG8_WAIT_L(0); PG8_MMA(0, 0, At, B0); PG8_BAR; PG8_SCHED;
            PG8_LDB(B1, 0, 1); PG8_STAGE(PG8_SB(0, 0), b2, voffB);
            PG8_BAR; PG8_WAIT_L(0); PG8_MMA(0, 1, At, B1); PG8_BAR;
            PG8_LDA(At, 0, 1); PG8_STAGE(PG8_SA(0, 0), a2, voffA);
            PG8_BAR; PG8_WAIT_L(0); PG8_MMA(1, 0, At, B0); PG8_BAR; PG8_SCHED;
            PG8_STAGE(PG8_SB(0, 1), b2 + hstep, voffB);
            PG8_WAIT_V(6); PG8_BAR; PG8_MMA(1, 1, At, B1); PG8_BAR;
            PG8_LDB(B0, 1, 0); PG8_SCHED; PG8_LDA(At, 1, 0); PG8_STAGE(PG8_SA(0, 1), a2 + hstep, voffA);
            PG8_WAIT_L(8); PG8_BAR; PG8_WAIT_L(0); PG8_MMA(0, 0, At, B0); PG8_BAR; PG8_SCHED;
            PG8_LDB(B1, 1, 1); PG8_STAGE(PG8_SB(1, 0), b3, voffB);
            PG8_BAR; PG8_WAIT_L(0); PG8_MMA(0, 1, At, B1); PG8_BAR;
            PG8_LDA(At, 1, 1); PG8_STAGE(PG8_SA(1, 0), a3, voffA);
            PG8_BAR; PG8_WAIT_L(0); PG8_MMA(1, 0, At, B0); PG8_BAR; PG8_SCHED;
            PG8_STAGE(PG8_SB(1, 1), b3 + hstep, voffB);
            PG8_WAIT_V(6); PG8_BAR; PG8_MMA(1, 1, At, B1); PG8_BAR;
            }
        }
        if constexpr (ALIGN_EPI) { if (wr == 0) PG8_BAR; }
        if constexpr (!Epi::AFTER_DRAIN) { E(acc, cur, wr, wc, fr, fq); S.done(cur); }
        if (!has_next) break;
#pragma unroll
        for (int a = 0; a < 2; ++a)
#pragma unroll
            for (int b = 0; b < 2; ++b)
#pragma unroll
                for (int m = 0; m < 4; ++m)
#pragma unroll
                    for (int n = 0; n < 2; ++n) acc[a][b][m][n] = (f32x4){0.f, 0.f, 0.f, 0.f};
        cur = nxt; cA = nA; cB = nB; ++ui;
        if constexpr (GA) { _Pragma("unroll") for (int h_ = 0; h_ < 2; ++h_) _Pragma("unroll") for (int i_ = 0; i_ < 2; ++i_) gcur[h_][i_] = gnxt[h_][i_]; }
        if constexpr (ALIGN_EPI) { if (wr == 1) PG8_BAR; }
    }
    PG8_WAIT_V(0);
    if constexpr (!ALIGN_EPI) { if (wr == 0) PG8_BAR; }
    PG8_BAR;
    if constexpr (Epi::AFTER_DRAIN) { E.fused(acc, cur, wr, wc, fr, fq, lds, wid, lane); S.done(cur); }
#undef PG8_GOFF
#undef PG8_VA
#undef PG8_SA
#undef PG8_SB
#undef PG8_STAGE
#undef PG8_LDA
#undef PG8_LDB
#undef PG8_MMA
#undef PG8_WAIT_V
#undef PG8_WAIT_L
#undef PG8_BAR
#undef PG8_SCHED
}
}
constexpr int NWAVES = 8;
constexpr int BATCH = 8, SEQ = 4096, D = 1024, T = BATCH * SEQ;
constexpr int NPROJ = 5120;
constexpr int NTILE = NPROJ / 256;
constexpr float EPS = 1e-6f;
#ifndef MK_N_LAUNCHES
#define MK_N_LAUNCHES 1
#endif
#ifndef DBG_NPH
#define DBG_NPH 12
#endif
constexpr int NPH = DBG_NPH;
constexpr int N_LAUNCHES = MK_N_LAUNCHES;
static_assert(N_LAUNCHES == 1 || N_LAUNCHES == NPH, "MK_N_LAUNCHES is 1 or NPH");

constexpr size_t MiB = 1u << 20;
constexpr size_t WS_CTL = 0, CTL_ZERO_BYTES = 1 * MiB;
constexpr size_t WS_SMALL = 1 * MiB;
constexpr size_t WS_WIN = 2 * MiB;
constexpr size_t WS_WPA = 13 * MiB, WS_WPM = 14 * MiB, WS_WOUT = 15 * MiB;
constexpr size_t WS_TOKE = 17 * MiB;
constexpr size_t WS_TOKR = WS_TOKE + 256 * 1024;
constexpr size_t WS_TOKP = WS_TOKR + 256 * 1024;
constexpr size_t WS_TOKG = WS_TOKP + 256 * 1024;
constexpr size_t WS_CNT = WS_TOKG + 256 * 1024;
constexpr size_t WS_ROWTOK = WS_CNT + 64 * 1024;
constexpr int NROWS_MAX = 73728;
constexpr size_t WS_SC = 452 * MiB;
constexpr size_t WS_SC2 = 116 * MiB + 3 * ((size_t)T * 256 * 2);
constexpr size_t WS_GU = 20 * MiB;
constexpr size_t WS_DN = 84 * MiB;
constexpr size_t WS_PROJ = 116 * MiB;
constexpr size_t PROJ_TILE = (size_t)T * 256 * 2;
constexpr size_t WS_MLST = 116 * MiB;
constexpr size_t WS_MERGED = 116 * MiB;
constexpr size_t WS_XN = 180 * MiB;
constexpr size_t WS_XG = 244 * MiB;
constexpr size_t WS_HID = 388 * MiB;
constexpr size_t WS_Y = 244 * MiB;
constexpr size_t WS_END = 512 * MiB;
static_assert(WS_PROJ + NTILE * PROJ_TILE == 436 * MiB, "proj map");
constexpr size_t DO_H = 0, DO_YATT = 0, DO_YML = 32 * MiB, DO_KN = 64 * MiB, DO_IKR = 72 * MiB, DO_IQR = 74 * MiB, DO_AQN = 90 * MiB;
constexpr int TL_AQ = 0, TL_KV = 2, TL_IQ = 3, TL_MQ = 4, TL_MK = 6, TL_MV = 8, TL_MO = 10, TL_GA = 12, TL_GM = 16;
constexpr size_t WS_WSM = WS_SMALL + 64 * 1024;
constexpr size_t WS_WTG = WS_SMALL + 192 * 1024;
constexpr size_t DO_SMB = 122 * MiB;
constexpr int CW_BAR = 4096;
constexpr int CW_Q = 16384;
constexpr int LDS_BYTES = 163840, MISC_OFF = LDS_BYTES - 512;

#define GAS __attribute__((address_space(1)))
#define LAS __attribute__((address_space(3)))
typedef unsigned short bf16;
typedef unsigned v4u __attribute__((ext_vector_type(4)));
typedef unsigned v2u __attribute__((ext_vector_type(2)));
typedef float f32x4 __attribute__((ext_vector_type(4)));
typedef float f32x2 __attribute__((ext_vector_type(2)));
typedef short bf16x8 __attribute__((ext_vector_type(8)));
typedef GAS unsigned gu32;
#define RLX_AGENT __ATOMIC_RELAXED, __HIP_MEMORY_SCOPE_AGENT
#define LDS_WAIT() asm volatile("s_waitcnt lgkmcnt(0)" ::: "memory")
__device__ __forceinline__ float bf2f(unsigned b16) { return __uint_as_float(b16 << 16); }
__device__ __forceinline__ unsigned f2bf(float f) { unsigned u = __float_as_uint(f); return (u + 0x7fffu + ((u >> 16) & 1u)) >> 16; }
__device__ __forceinline__ unsigned pk2(float lo, float hi) { return pg8::cvt_pk_bf16(lo, hi); }
__device__ __forceinline__ float sigm(float x) { return 1.0f / (1.0f + __expf(-x)); }
__device__ __forceinline__ float wave_sum(float v) {
    v += __int_as_float(__builtin_amdgcn_update_dpp(0, __float_as_int(v), 0xB1, 0xF, 0xF, true));
    v += __int_as_float(__builtin_amdgcn_update_dpp(0, __float_as_int(v), 0x4E, 0xF, 0xF, true));
    v += __int_as_float(__builtin_amdgcn_update_dpp(0, __float_as_int(v), 0x124, 0xF, 0xF, true));
    v += __int_as_float(__builtin_amdgcn_update_dpp(0, __float_as_int(v), 0x128, 0xF, 0xF, true));
    { const auto r = __builtin_amdgcn_permlane16_swap(__float_as_uint(v), __float_as_uint(v), false, false); v = __uint_as_float(r[0]) + __uint_as_float(r[1]); }
    { const auto r = __builtin_amdgcn_permlane32_swap(__float_as_uint(v), __float_as_uint(v), false, false); v = __uint_as_float(r[0]) + __uint_as_float(r[1]); }
    return v;
}
__device__ __forceinline__ void unpack8(const v4u r, float (&f)[8]) {
    f[0] = bf2f(r.x & 0xffffu); f[1] = bf2f(r.x >> 16); f[2] = bf2f(r.y & 0xffffu); f[3] = bf2f(r.y >> 16);
    f[4] = bf2f(r.z & 0xffffu); f[5] = bf2f(r.z >> 16); f[6] = bf2f(r.w & 0xffffu); f[7] = bf2f(r.w >> 16);
}
__device__ __forceinline__ v4u pack8(const float (&f)[8]) { v4u w; w.x = pk2(f[0], f[1]); w.y = pk2(f[2], f[3]); w.z = pk2(f[4], f[5]); w.w = pk2(f[6], f[7]); return w; }
#define XB_TMO      128
#define XB_XCNT(j)  (256  + 64 * (j))
#define XB_XSUB(j)  (1280 + 64 * (j))
#define XB_XGEN(j)  (2304 + 64 * (j))
#define XB_TOP      3328
#define XB_TOPGEN   3392
#define XCD_BAR_WORDS 3456
#define XB_SPIN_CAP (1u << 18)

__device__ __forceinline__ unsigned xb_ld(unsigned* p)              { return __hip_atomic_load(p, __ATOMIC_RELAXED, __HIP_MEMORY_SCOPE_AGENT); }
__device__ __forceinline__ unsigned xb_add(unsigned* p, unsigned v) { return __hip_atomic_fetch_add(p, v, __ATOMIC_RELAXED, __HIP_MEMORY_SCOPE_AGENT); }
__device__ __forceinline__ unsigned xb_xcc_id() { return (unsigned)__builtin_amdgcn_s_getreg((3 << 11) | 20) & 0xFu; }
#define XB_SPIN(cond, bar) do { unsigned _sp = 0; while (cond) { __builtin_amdgcn_s_sleep(1); \
    if ((++_sp & 255u) == 0u) { if (xb_ld(&(bar)[XB_TMO])) break; if (_sp > XB_SPIN_CAP) { atomicAdd(&(bar)[XB_TMO], 1u); break; } } } } while (0)

struct XcdBarrier {
    unsigned* bar; unsigned x;
    volatile LAS unsigned* st;
};

__device__ __forceinline__ XcdBarrier xcd_barrier_post(unsigned* bar, volatile LAS unsigned* st) {
    XcdBarrier b; b.bar = bar; b.x = xb_xcc_id(); b.st = st;
    if (threadIdx.x == 0) (void)xb_add(&bar[XB_XCNT(b.x)], 1u);
    return b;
}
__device__ __forceinline__ void xcd_barrier_complete(unsigned* bar, unsigned x, unsigned& nloc, unsigned& nx) {
    const unsigned G = gridDim.x * gridDim.y * gridDim.z;
    unsigned sum, cnt, mine, sp = 0u;
    for (;;) {
        sum = 0u; cnt = 0u; mine = 0u;
#pragma unroll
        for (unsigned j = 0; j < 16; ++j) { const unsigned c = xb_ld(&bar[XB_XCNT(j)]); sum += c; cnt += (c > 0u) ? 1u : 0u; mine = (j == x) ? c : mine; }
        if (sum == G) break;
        __builtin_amdgcn_s_sleep(1);
        if ((++sp & 255u) == 0u) { if (xb_ld(&bar[XB_TMO])) break; if (sp > XB_SPIN_CAP) { atomicAdd(&bar[XB_TMO], 1u); break; } }
    }
    nloc = mine > 0u ? mine : 1u; nx = cnt > 0u ? cnt : 1u;
}

__device__ __forceinline__ void xcd_barrier(const XcdBarrier& b) {
    asm volatile("s_waitcnt vmcnt(0)" ::: "memory");
    __syncthreads();
    if (threadIdx.x == 0) {
        unsigned* bar = b.bar;
        __builtin_amdgcn_s_waitcnt(0);
        unsigned nloc = b.st[0], nx = b.st[1];
        if (nloc == 0u) { xcd_barrier_complete(bar, b.x, nloc, nx); b.st[0] = nloc; b.st[1] = nx; }
        const unsigned old = xb_add(&bar[XB_XSUB(b.x)], 1u);
        const unsigned gen = old / nloc;
        if (old + 1u == (gen + 1u) * nloc) {
            __builtin_amdgcn_fence(__ATOMIC_RELEASE, "agent");
            asm volatile("s_waitcnt vmcnt(0)" ::: "memory");
            const unsigned og = xb_add(&bar[XB_TOP], 1u);
            const unsigned tg = og / nx;
            if (og + 1u == (tg + 1u) * nx) xb_add(&bar[XB_TOPGEN], 1u);
            else XB_SPIN(xb_ld(&bar[XB_TOPGEN]) == tg, bar);
            __builtin_amdgcn_fence(__ATOMIC_ACQUIRE, "agent");
            xb_add(&bar[XB_XGEN(b.x)], 1u);
            asm volatile("s_waitcnt vmcnt(0)" ::: "memory");
        } else {
            XB_SPIN(xb_ld(&bar[XB_XGEN(b.x)]) == gen, bar);
            __builtin_amdgcn_fence(__ATOMIC_ACQUIRE, "agent");
            asm volatile("s_waitcnt vmcnt(0)" ::: "memory");
        }
    }
    __syncthreads();
}
struct Args { const float* in[22]; float* out; unsigned char* ws; int ph_lo, ph_hi, li, pad; };
struct Ctx { int tid, lane, wave, G, vcu; LAS unsigned char* lds; };
#define IN_X 0
#define IN_POS 1
#define IN_GMIX 2
#define IN_WIN 3
#define IN_GQ 4
#define IN_GK 5
#define IN_WCONV 6
#define IN_BCONV 7
#define IN_BI 8
#define IN_BF 9
#define IN_GML 10
#define IN_WPA 11
#define IN_WPM 12
#define IN_WOUT 13
#define IN_GMOE 14
#define IN_WRG 15
#define IN_BRG 16
#define IN_WRE 17
#define IN_BRE 18
#define IN_WEG 19
#define IN_WEU 20
#define IN_WED 21

__device__ __forceinline__ int win_src_col(int n) {
    if (n < 1024) return n;
    if (n < 3072) return n + 40;
    return n + 48;
}
__device__ __forceinline__ int wsm_src_col(int r) {
    return r < 40 ? 1024 + r : (r < 44 ? 3112 + (r - 40) : 3116 + (r - 44));
}
__device__ __forceinline__ void tr_item(const float* W, int ldw, int scol, int k0, bf16* wt0, int K, LAS float* scr, int lane) {
    const int sc0 = __builtin_amdgcn_readfirstlane(scol), sc31 = __builtin_amdgcn_readlane(scol, 31);
    if (sc0 >= 0 && sc31 == sc0 + 31 && (sc0 & 3) == 0 && (ldw & 3) == 0) {
#pragma unroll
        for (int i = 0; i < 8; ++i) { const int kk = 8 * i + (lane >> 3); const f32x4 v = *(const f32x4*)(W + (size_t)(k0 + kk) * ldw + sc0 + 4 * (lane & 7));
            LAS float* d = scr + kk * 33 + 4 * (lane & 7); d[0] = v[0]; d[1] = v[1]; d[2] = v[2]; d[3] = v[3]; }
    } else {
#pragma unroll 8
        for (int i = 0; i < 32; ++i) { const int kk = 2 * i + (lane >> 5); scr[kk * 33 + (lane & 31)] = scol >= 0 ? W[(size_t)(k0 + kk) * ldw + scol] : 0.f; }
    }
    LDS_WAIT(); asm volatile("" ::: "memory");
    const int c = lane & 7;
#pragma unroll
    for (int j = 0; j < 4; ++j) { const int n = (lane >> 3) + 8 * j; const LAS float* s = scr + (8 * c) * 33 + n;
        v4u o; o.x = pk2(s[0 * 33], s[1 * 33]); o.y = pk2(s[2 * 33], s[3 * 33]); o.z = pk2(s[4 * 33], s[5 * 33]); o.w = pk2(s[6 * 33], s[7 * 33]);
        *(v4u*)(wt0 + (size_t)n * K + 8 * c) = o; }
    LDS_WAIT(); asm volatile("" ::: "memory");
}
template <int PART> __device__ __forceinline__ void p0_prologue(const Args& a, const Ctx& c, int gw, int NGW) {
    unsigned char* ws = a.ws;
    LAS float* scr = (LAS float*)(c.lds + c.wave * 16384);
    const int lane = c.lane;
    constexpr int I_IN = 16 * 160, I_PA = 8 * 32, I_PM = 8 * 32, I_OUT = 16 * 32, I_GU = 32 * 16 * 32, I_DN = 32 * 8 * 32;
    constexpr int NPRJ = I_IN + I_PA + I_PM + I_OUT, NIT = NPRJ + I_GU + I_DN;
    for (int it = (PART ? NPRJ : 0) + gw; it < (PART ? NIT : NPRJ); it += NGW) {
        int r = it;
        if (r < I_IN) { const int kb = r / 160, nb = r % 160; tr_item(a.in[IN_WIN], 5168, win_src_col(32 * nb + (lane & 31)), 64 * kb, (bf16*)(ws + WS_WIN) + (size_t)(32 * nb) * 1024 + 64 * kb, 1024, scr, lane); continue; } r -= I_IN;
        if (r < I_PA) { const int kb = r / 32, nb = r % 32; tr_item(a.in[IN_WPA], 1024, 32 * nb + (lane & 31), 64 * kb, (bf16*)(ws + WS_WPA) + (size_t)(32 * nb) * 512 + 64 * kb, 512, scr, lane); continue; } r -= I_PA;
        if (r < I_PM) { const int kb = r / 32, nb = r % 32; tr_item(a.in[IN_WPM], 1024, 32 * nb + (lane & 31), 64 * kb, (bf16*)(ws + WS_WPM) + (size_t)(32 * nb) * 512 + 64 * kb, 512, scr, lane); continue; } r -= I_PM;
        if (r < I_OUT) { const int kb = r / 32, nb = r % 32; tr_item(a.in[IN_WOUT], 1024, 32 * nb + (lane & 31), 64 * kb, (bf16*)(ws + WS_WOUT) + (size_t)(32 * nb) * 1024 + 64 * kb, 1024, scr, lane); continue; } r -= I_OUT;
        if (r < I_GU) { const int e = r / 512, q = r % 512, kb = q / 32, nb = q % 32, t = nb >> 3, bj = (nb >> 2) & 1, i0 = (nb & 3) * 32;
            const float* src = (bj ? a.in[IN_WEU] : a.in[IN_WEG]) + (size_t)e * 1024 * 512;
            tr_item(src, 512, 128 * t + i0 + (lane & 31), 64 * kb, (bf16*)(ws + WS_GU) + ((size_t)e * 1024 + 32 * nb) * 1024 + 64 * kb, 1024, scr, lane); continue; } r -= I_GU;
        { const int e = r / 256, q = r % 256, kb = q / 32, nb = q % 32;
            tr_item(a.in[IN_WED] + (size_t)e * 512 * 1024, 1024, 32 * nb + (lane & 31), 64 * kb, (bf16*)(ws + WS_DN) + ((size_t)e * 1024 + 32 * nb) * 512 + 64 * kb, 512, scr, lane); }
    }
    if (PART) return;
    { float* WTG = (float*)(ws + WS_WTG); for (int i = gw * 64 + lane; i < 36 * 1024; i += NGW * 64) { const int j = i >> 10, k = i & 1023;
        WTG[j * 1028 + k] = (j < 32 ? a.in[IN_WRE][k * 32 + j] : a.in[IN_WRG][k * 4 + (j - 32)]) * a.in[IN_GMOE][k]; } }
    { bf16* WSM = (bf16*)(ws + WS_WSM); for (int i = gw * 64 + lane; i < 48 * 1024; i += NGW * 64) { const int r = i >> 10, k = i & 1023; WSM[i] = (bf16)f2bf(a.in[IN_WIN][(size_t)k * 5168 + wsm_src_col(r)]); } }
    const float* g = a.in[IN_GMIX]; f32x4 gv[4];
#pragma unroll
    for (int j = 0; j < 4; ++j) gv[j] = *(const f32x4*)(g + 4 * lane + 256 * j);
    bf16* H = (bf16*)((unsigned char*)a.out + DO_H);
    for (int m0 = gw; m0 < T; m0 += 2 * NGW) {
        const int mA = m0, mB = (m0 + NGW < T) ? m0 + NGW : m0; const bool hasB = (m0 + NGW < T);
        const f32x4* xa = (const f32x4*)(a.in[IN_X] + (size_t)mA * D) + lane; const f32x4* xb = (const f32x4*)(a.in[IN_X] + (size_t)mB * D) + lane;
        f32x4 va[4], vb[4]; float sa = 0.f, sb = 0.f;
#pragma unroll
        for (int j = 0; j < 4; ++j) { va[j] = xa[64 * j]; vb[j] = xb[64 * j]; }
#pragma unroll
        for (int j = 0; j < 4; ++j) { sa += (va[j].x * va[j].x + va[j].y * va[j].y) + (va[j].z * va[j].z + va[j].w * va[j].w); sb += (vb[j].x * vb[j].x + vb[j].y * vb[j].y) + (vb[j].z * vb[j].z + vb[j].w * vb[j].w); }
        const float ra = rsqrtf(wave_sum(sa) * (1.f / D) + EPS), rb = rsqrtf(wave_sum(sb) * (1.f / D) + EPS);
        v2u* oa = (v2u*)(H + (size_t)mA * D) + lane; v2u* ob = (v2u*)(H + (size_t)mB * D) + lane;
#pragma unroll
        for (int j = 0; j < 4; ++j) { v2u w; w.x = pk2(va[j].x * ra * gv[j].x, va[j].y * ra * gv[j].y); w.y = pk2(va[j].z * ra * gv[j].z, va[j].w * ra * gv[j].w); oa[64 * j] = w; }
        if (hasB) {
#pragma unroll
        for (int j = 0; j < 4; ++j) { v2u w; w.x = pk2(vb[j].x * rb * gv[j].x, vb[j].y * rb * gv[j].y); w.y = pk2(vb[j].z * rb * gv[j].z, vb[j].w * rb * gv[j].w); ob[64 * j] = w; } }
    }
}

__device__ __forceinline__ const bf16* proj_tile(const Args& a, int tile) { return (const bf16*)(a.ws + WS_PROJ + (size_t)tile * PROJ_TILE); }
#define DPPF(x_, ctrl_) __int_as_float(__builtin_amdgcn_update_dpp(0, __float_as_int(x_), ctrl_, 0xF, 0xF, true))
__device__ __forceinline__ void p2_prep(const Args& a, const Ctx& c) {
    const int lane = c.lane, gw = c.vcu * NWAVES + c.wave, NGW = c.G * NWAVES;
    float invf = 0.f;
    if (lane < 8) invf = (float)pow(500000.0, -(double)lane / 8.0); else if (lane < 12) invf = (float)pow(500000.0, -(double)(lane - 8) / 4.0);
    float gq[8], gk[8];
#pragma unroll
    for (int i = 0; i < 8; ++i) { gq[i] = a.in[IN_GQ][8 * (lane & 7) + i]; gk[i] = a.in[IN_GK][8 * (lane & 7) + i]; }
    const int* pos = (const int*)a.in[IN_POS];
    unsigned char* dout = (unsigned char*)a.out;
    bf16* AQN = (bf16*)(dout + DO_AQN); bf16* KN = (bf16*)(dout + DO_KN); bf16* IQR = (bf16*)(dout + DO_IQR); bf16* IKR = (bf16*)(dout + DO_IKR);
    { const bf16* Hh = (const bf16*)(dout + DO_H); const bf16* WSM = (const bf16*)(a.ws + WS_WSM); bf16* SMB = (bf16*)(dout + DO_SMB);
      const int row = lane & 15, kg = lane >> 4;
      const float invfk = (float)pow(500000.0, -(double)(lane & 3) / 4.0);
      for (int tile = gw; tile < T / 16; tile += NGW) { const int t0 = tile * 16;
          f32x4 acc[3];
#pragma unroll
          for (int ct = 0; ct < 3; ++ct) acc[ct] = (f32x4){0.f, 0.f, 0.f, 0.f};
          const bf16* ap = Hh + (size_t)(t0 + row) * 1024 + 8 * kg; const bf16* bp = WSM + (size_t)row * 1024 + 8 * kg;
#pragma unroll 8
          for (int ks = 0; ks < 32; ++ks) { const bf16x8 av = *(const bf16x8*)(ap + 32 * ks);
#pragma unroll
              for (int ct = 0; ct < 3; ++ct) acc[ct] = __builtin_amdgcn_mfma_f32_16x16x32_bf16(av, *(const bf16x8*)(bp + (size_t)ct * 16 * 1024 + 32 * ks), acc[ct], 0, 0, 0); }
          const int col = lane & 15;
#pragma unroll
          for (int r = 0; r < 4; ++r) { const int t = t0 + 4 * kg + r;
              const float angk = (float)pos[t] * invfk;
              const double revk = (double)angk * 0.15915494309189535; const float frk = (float)(revk - __builtin_rint(revk));
              const float ck = __builtin_amdgcn_cosf(frk), sk = __builtin_amdgcn_sinf(frk);
              const float v0 = acc[0][r], pr = __shfl_xor(v0, 4);
              const float o0 = (col < 4) ? (v0 * ck - pr * sk) : ((col < 8) ? (v0 * ck + pr * sk) : v0);
              IKR[(size_t)t * 32 + col] = (bf16)f2bf(o0); IKR[(size_t)t * 32 + 16 + col] = (bf16)f2bf(acc[1][r]);
              SMB[(size_t)t * 16 + col] = (bf16)f2bf(acc[2][r]); } } }
    const int l7 = lane & 7;
    const int aqcol = (lane >> 3) * 64 + 8 * l7, akcol = ((lane & 15) >> 3) * 64 + 8 * l7;
    const bf16* aqsrc = proj_tile(a, TL_AQ + (aqcol >> 8)) + (aqcol & 255); const bf16* aksrc = proj_tile(a, TL_KV) + akcol; const bf16* iqsrc = proj_tile(a, TL_IQ) + 4 * lane;
#define P2_LOADROW(t_, P_, A_, K_, Q_) do { const int tt_ = (t_) < T ? (t_) : T - 1; P_ = pos[tt_]; A_ = *(const v4u*)(aqsrc + (size_t)tt_ * 256); K_ = *(const v4u*)(aksrc + (size_t)tt_ * 256); Q_ = *(const v2u*)(iqsrc + (size_t)tt_ * 256); } while (0)
#define P2_DOROW(t, P_, A_, K_, Q_) do { \
        const float ang = (float)(P_) * invf; \
        const double rev = (double)ang * 0.15915494309189535; const float frv = (float)(rev - __builtin_rint(rev)); \
        float cs = __builtin_amdgcn_cosf(frv), sn = __builtin_amdgcn_sinf(frv); \
        float ca[8], sa[8], ci[4], si[4]; \
        _Pragma("unroll") for (int i = 0; i < 8; ++i) { ca[i] = __int_as_float(__builtin_amdgcn_readlane(__float_as_int(cs), i)); sa[i] = __int_as_float(__builtin_amdgcn_readlane(__float_as_int(sn), i)); } \
        _Pragma("unroll") for (int i = 0; i < 4; ++i) { ci[i] = __int_as_float(__builtin_amdgcn_readlane(__float_as_int(cs), 8 + i)); si[i] = __int_as_float(__builtin_amdgcn_readlane(__float_as_int(sn), 8 + i)); } \
        { float f[8]; unpack8(A_, f); float ss = 0.f; \
          _Pragma("unroll") for (int i = 0; i < 8; ++i) ss += f[i] * f[i]; \
          ss += DPPF(ss, 0xB1); ss += DPPF(ss, 0x4E); ss += DPPF(ss, 0x141); \
          const float r = rsqrtf(ss * (1.f / 64.f) + EPS); \
          _Pragma("unroll") for (int i = 0; i < 8; ++i) f[i] = f[i] * r * gq[i]; \
          float o[8]; \
          _Pragma("unroll") for (int i = 0; i < 8; ++i) { const float p = DPPF(f[i], 0xB1); o[i] = (l7 == 0) ? (f[i] * ca[i] - p * sa[i]) : ((l7 == 1) ? (f[i] * ca[i] + p * sa[i]) : f[i]); o[i] *= 0.125f * 1.4426950408889634f; } \
          *(v4u*)(AQN + (size_t)(t) * 512 + aqcol) = pack8(o); } \
        { float f[8]; unpack8(K_, f); float ss = 0.f; \
          _Pragma("unroll") for (int i = 0; i < 8; ++i) ss += f[i] * f[i]; \
          ss += DPPF(ss, 0xB1); ss += DPPF(ss, 0x4E); ss += DPPF(ss, 0x141); \
          const float r = rsqrtf(ss * (1.f / 64.f) + EPS); \
          _Pragma("unroll") for (int i = 0; i < 8; ++i) f[i] = f[i] * r * gk[i]; \
          float o[8]; \
          _Pragma("unroll") for (int i = 0; i < 8; ++i) { const float p = DPPF(f[i], 0xB1); o[i] = (l7 == 0) ? (f[i] * ca[i] - p * sa[i]) : ((l7 == 1) ? (f[i] * ca[i] + p * sa[i]) : f[i]); } \
          if (lane < 16) *(v4u*)(KN + (size_t)(t) * 128 + akcol) = pack8(o); } \
        { const v2u rw = Q_; \
          float f[4] = {bf2f(rw.x & 0xffffu), bf2f(rw.x >> 16), bf2f(rw.y & 0xffffu), bf2f(rw.y >> 16)}; float o[4]; \
          _Pragma("unroll") for (int i = 0; i < 4; ++i) { const float p = DPPF(f[i], 0xB1); o[i] = (l7 == 0) ? (f[i] * ci[i] - p * si[i]) : ((l7 == 1) ? (f[i] * ci[i] + p * si[i]) : f[i]); } \
          v2u w; w.x = pk2(o[0], o[1]); w.y = pk2(o[2], o[3]); *(v2u*)(IQR + (size_t)(t) * 256 + 4 * lane) = w; } } while (0)
    { int pA, pB; v4u aA, aB, kA, kB; v2u qA, qB;
      P2_LOADROW(gw, pA, aA, kA, qA);
#pragma unroll 1
      for (int t = gw; t < T; t += 2 * NGW) {
          P2_LOADROW(t + NGW, pB, aB, kB, qB);
          P2_DOROW(t, pA, aA, kA, qA);
          P2_LOADROW(t + 2 * NGW, pA, aA, kA, qA);
          if (t + NGW < T) P2_DOROW(t + NGW, pB, aB, kB, qB);
      } }
#undef P2_LOADROW
#undef P2_DOROW
}
constexpr int ML_QS = 0, ML_KS = 17408, ML_HS = 0;
constexpr int ML_KWT = 34816;
constexpr int ML_VT = 53248;
constexpr int ML_SW = 73984;
constexpr int ML_CT = 83200;
constexpr int ML_GA = 122368;
constexpr int ML_CW = ML_GA + 1024;
constexpr int ML_END = ML_CW + (1024 + 384) * 4;
static_assert(ML_END <= MISC_OFF, "mLSTM LDS map");
constexpr size_t ML_STATE_BYTES = 8 * 9 * 64 * 16;
__device__ __forceinline__ bf16x8 lds_frag(const LAS unsigned char* base, int stride_b, int row0, int kb, int lane) {
    return *(const LAS bf16x8*)(base + (row0 + (lane & 15)) * stride_b + kb + (lane >> 4) * 16);
}
__device__ __forceinline__ bf16x8 lds_frag_sw(const LAS unsigned char* base, int row0, int ks, int lane) {
    const int row = row0 + (lane & 15); return *(const LAS bf16x8*)(base + row * 144 + 16 * (((ks * 4 + (lane >> 4)) + (row >> 3)) & 7));
}
#define MFMA16(a_, b_, c_) __builtin_amdgcn_mfma_f32_16x16x32_bf16(a_, b_, c_, 0, 0, 0)
template <int MODE>
__device__ __forceinline__ void mlstm_unit(const Args& a, const Ctx& c, int b, int h, int g) {
    const int tid = c.tid, wave = c.wave; LAS unsigned char* lds = c.lds;
#define ML_LAUNDER() int tv_ = tid; asm volatile("" : "+v"(tv_)); const int lane = tv_ & 63, seg = tv_ & 15, r2 = (tv_ >> 4) * 2; (void)lane; (void)seg; (void)r2
    const bf16* PQ = proj_tile(a, TL_MQ + (h >> 1)) + (h & 1) * 128;
    const bf16* PK = proj_tile(a, TL_MK + (h >> 1)) + (h & 1) * 128;
    const bf16* PV = proj_tile(a, TL_MV + (h >> 1)) + (h & 1) * 128;
    const bf16* PO = proj_tile(a, TL_MO + (h >> 1)) + (h & 1) * 128;
    const bf16* PS = (const bf16*)((unsigned char*)a.out + DO_SMB);
    bf16* YML = (bf16*)((unsigned char*)a.out + DO_YML);
    unsigned char* STB = a.ws + WS_MLST; float* MST = (float*)(a.ws + WS_MLST + 256 * ML_STATE_BYTES);
    LAS float* GAa = (LAS float*)(lds + ML_GA); LAS float* GAm = GAa + 64; LAS float* GAw = GAa + 128; LAS float* GAe = GAa + 192;
    LAS float* CWQ = (LAS float*)(lds + ML_CW); LAS float* CWK = CWQ + 512; LAS float* CBQ = CWQ + 1024; LAS float* CBK = CBQ + 128; LAS float* GN = CBK + 128;
    LAS bf16* VTs = (LAS bf16*)(lds + ML_VT);
    { const float* wc = a.in[IN_WCONV]; const int j = tid >> 7, d = tid & 127;
      CWQ[tid] = wc[j * 1024 + h * 128 + d]; CWK[tid] = wc[j * 1024 + 512 + h * 128 + d];
      if (tid < 128) { CBQ[tid] = a.in[IN_BCONV][h * 128 + tid]; CBK[tid] = a.in[IN_BCONV][512 + h * 128 + tid]; GN[tid] = a.in[IN_GML][h * 128 + tid]; } }
    for (int i = tid; i < 16 * 64; i += 512) { const int r = i >> 6, cc = i & 63; VTs[(128 + r) * 72 + cc] = (r == 0) ? (bf16)0x3F80 : (bf16)0; }
    const float big = a.in[IN_BI][h], bfg = a.in[IN_BF][h];
    const int slot0 = (b * 4 + h) * 8;
    f32x4 cacc[9];
    float m_st = 0.f;
    if (MODE == 1 && g > 0) { ML_LAUNDER();
        const f32x4* sp = (const f32x4*)(STB + (size_t)(slot0 + g) * ML_STATE_BYTES) + wave * 576 + lane;
#pragma unroll
        for (int i = 0; i < 9; ++i) cacc[i] = sp[64 * i];
        m_st = MST[slot0 + g];
#pragma unroll
        for (int ee = 0; ee < 9; ++ee) { v2u w; w.x = pk2(cacc[ee][0], cacc[ee][1]); w.y = pk2(cacc[ee][2], cacc[ee][3]);
            *(LAS v2u*)(lds + ML_CT + (ee * 16 + (lane & 15)) * 272 + (wave * 16 + 4 * (lane >> 4)) * 2) = w; }
    } else {
#pragma unroll
        for (int i = 0; i < 9; ++i) cacc[i] = (f32x4){0.f, 0.f, 0.f, 0.f};
        for (int i = tid; i < 144 * 136 / 2; i += 512) ((LAS unsigned*)(lds + ML_CT))[i] = 0u;
    }
    const size_t tb = (size_t)b * SEQ;
    const char* bq = (const char*)(PQ + tb * 256); const char* bk = (const char*)(PK + tb * 256); const char* bv = (const char*)(PV + tb * 256); const char* bo = (const char*)(PO + tb * 256); const char* bs = (const char*)(PS + tb * 16);
    v4u rq[5], rk[5], rv[2]; unsigned short gi = 0, gf = 0;
#define ML_LOAD(kc) do { _Pragma("unroll") for (int j_ = 0; j_ < 5; ++j_) { const int rr_ = 64 * (kc) + r2 - 3 + j_; const unsigned o_ = (unsigned)((rr_ < 0 ? 0 : rr_) * 512 + seg * 16); \
            v4u q_ = (v4u){0u, 0u, 0u, 0u}; if (MODE == 1) q_ = *(const v4u*)(bq + o_); v4u k_ = *(const v4u*)(bk + o_); if (rr_ < 0) { q_ = (v4u){0u, 0u, 0u, 0u}; k_ = q_; } rq[j_] = q_; rk[j_] = k_; } \
        _Pragma("unroll") for (int i_ = 0; i_ < 2; ++i_) rv[i_] = *(const v4u*)(bv + (unsigned)((64 * (kc) + r2 + i_) * 512 + seg * 16)); \
        gi = *(const unsigned short*)(bs + (unsigned)((64 * (kc) + lane) * 32 + (8 + h) * 2)); gf = *(const unsigned short*)(bs + (unsigned)((64 * (kc) + lane) * 32 + (12 + h) * 2)); } while (0)
    const int kc0 = (MODE == 1) ? 8 * g : 0, kc1 = (MODE == 1) ? 8 * g + 8 : 56;
    { ML_LAUNDER(); ML_LOAD(kc0); }
    __syncthreads();
#pragma unroll 1
    for (int kc = kc0; kc < kc1; ++kc) {
        float wkv, decay, m_new;
        if (MODE == 0 && kc > 0 && (kc & 7) == 0) { ML_LAUNDER();
            f32x4* sp = (f32x4*)(STB + (size_t)(slot0 + (kc >> 3)) * ML_STATE_BYTES) + wave * 576 + lane;
#pragma unroll
            for (int i = 0; i < 9; ++i) sp[64 * i] = cacc[i];
            if (tid == 0) MST[slot0 + (kc >> 3)] = m_st; }
        { ML_LAUNDER();
        const float fpre = bf2f(gf) + bfg, lf = fminf(fpre, 0.f) - log1pf(__expf(-fabsf(fpre)));
        const float ig = bf2f(gi) + big;
#define ML_SHR(x_, n_, id_) __int_as_float(__builtin_amdgcn_update_dpp(__float_as_int(id_), __float_as_int(x_), 0x110 + (n_), 0xF, 0xF, false))
        float bc = lf;
        bc += ML_SHR(bc, 1, 0.f); bc += ML_SHR(bc, 2, 0.f); bc += ML_SHR(bc, 4, 0.f); bc += ML_SHR(bc, 8, 0.f);
        { const float t0 = __int_as_float(__builtin_amdgcn_readlane(__float_as_int(bc), 15)), t1 = __int_as_float(__builtin_amdgcn_readlane(__float_as_int(bc), 31)), t2 = __int_as_float(__builtin_amdgcn_readlane(__float_as_int(bc), 47));
          bc += (lane >= 48) ? (t0 + t1 + t2) : ((lane >= 32) ? (t0 + t1) : ((lane >= 16) ? t0 : 0.f)); }
        const float av = ig - bc; float Ac = av;
        Ac = fmaxf(Ac, ML_SHR(Ac, 1, -3.0e38f)); Ac = fmaxf(Ac, ML_SHR(Ac, 2, -3.0e38f)); Ac = fmaxf(Ac, ML_SHR(Ac, 4, -3.0e38f)); Ac = fmaxf(Ac, ML_SHR(Ac, 8, -3.0e38f));
        { const float t0 = __int_as_float(__builtin_amdgcn_readlane(__float_as_int(Ac), 15)), t1 = __int_as_float(__builtin_amdgcn_readlane(__float_as_int(Ac), 31)), t2 = __int_as_float(__builtin_amdgcn_readlane(__float_as_int(Ac), 47));
          const float m01 = fmaxf(t0, t1), m012 = fmaxf(m01, t2);
          Ac = fmaxf(Ac, (lane >= 48) ? m012 : ((lane >= 32) ? m01 : ((lane >= 16) ? t0 : -3.0e38f))); }
#undef ML_SHR
        const float mA = fmaxf(m_st, Ac), Mk = __int_as_float(__builtin_amdgcn_readlane(__float_as_int(mA), 63)), blast = __int_as_float(__builtin_amdgcn_readlane(__float_as_int(bc), 63));
        wkv = __expf(av - Mk); decay = __expf(m_st - Mk); m_new = blast + Mk;
        if (MODE == 1 && wave == 0) { GAa[lane] = av; GAm[lane] = mA; GAw[lane] = __expf(m_st - mA); GAe[lane] = __expf(-(bc + mA)); } }
        { ML_LAUNDER(); float kw_[2][8];
#pragma unroll
          for (int i = 0; i < 2; ++i) { const int t = r2 + i; const float wkt = __shfl(wkv, t);
            float aq_[8], ak_[8];
            { const f32x4 b0 = *(const LAS f32x4*)(CBQ + seg * 8), b1 = *(const LAS f32x4*)(CBQ + seg * 8 + 4), c0 = *(const LAS f32x4*)(CBK + seg * 8), c1 = *(const LAS f32x4*)(CBK + seg * 8 + 4);
              aq_[0] = b0[0]; aq_[1] = b0[1]; aq_[2] = b0[2]; aq_[3] = b0[3]; aq_[4] = b1[0]; aq_[5] = b1[1]; aq_[6] = b1[2]; aq_[7] = b1[3];
              ak_[0] = c0[0]; ak_[1] = c0[1]; ak_[2] = c0[2]; ak_[3] = c0[3]; ak_[4] = c1[0]; ak_[5] = c1[1]; ak_[6] = c1[2]; ak_[7] = c1[3]; }
#pragma unroll
            for (int j = 0; j < 4; ++j) { float fk_[8]; unpack8(rk[i + j], fk_);
                const f32x4 x0 = *(const LAS f32x4*)(CWK + j * 128 + seg * 8), x1 = *(const LAS f32x4*)(CWK + j * 128 + seg * 8 + 4);
#pragma unroll
                for (int e = 0; e < 4; ++e) { ak_[e] += x0[e] * fk_[e]; ak_[4 + e] += x1[e] * fk_[4 + e]; }
                if (MODE == 1) { float fq_[8]; unpack8(rq[i + j], fq_);
                    const f32x4 w0 = *(const LAS f32x4*)(CWQ + j * 128 + seg * 8), w1 = *(const LAS f32x4*)(CWQ + j * 128 + seg * 8 + 4);
#pragma unroll
                    for (int e = 0; e < 4; ++e) { aq_[e] += w0[e] * fq_[e]; aq_[4 + e] += w1[e] * fq_[4 + e]; } } }
#pragma unroll
            for (int e = 0; e < 8; ++e) { ak_[e] = ak_[e] * sigm(ak_[e]) * 0.08838834764831845f; kw_[i][e] = ak_[e] * wkt; }
            if (MODE == 1) {
#pragma unroll
                for (int e = 0; e < 8; ++e) aq_[e] = aq_[e] * sigm(aq_[e]);
                *(LAS v4u*)(lds + ML_QS + t * 272 + seg * 16) = pack8(aq_);
                *(LAS v4u*)(lds + ML_KS + t * 272 + seg * 16) = pack8(ak_); } }
          const unsigned va[4] = {rv[0].x, rv[0].y, rv[0].z, rv[0].w}, vb[4] = {rv[1].x, rv[1].y, rv[1].z, rv[1].w};
          const int swo = 16 * (((r2 >> 3) + seg) & 7) + 2 * (r2 & 7);
#pragma unroll
          for (int e = 0; e < 8; ++e) { const int ro = (seg * 8 + e) * 144 + swo;
              *(LAS unsigned*)(lds + ML_KWT + ro) = pk2(kw_[0][e], kw_[1][e]);
              const unsigned lo = (e & 1) ? (va[e >> 1] >> 16) : (va[e >> 1] & 0xffffu), hi = (e & 1) ? (vb[e >> 1] >> 16) : (vb[e >> 1] & 0xffffu);
              *(LAS unsigned*)(lds + ML_VT + ro) = lo | (hi << 16); }
        if (kc + 1 < kc1) ML_LOAD(kc + 1); }
        __syncthreads();
        f32x4 hacc[5]; unsigned mo_r[8];
        const int tt = wave & 3, t0 = tt * 16, ne = (wave < 4) ? 5 : 4, e_first = (wave < 4) ? 0 : 5;
        if (MODE == 1) {
        { ML_LAUNDER(); const int tq = t0 + (lane & 15);
        bf16x8 qf[4];
#pragma unroll
        for (int ks = 0; ks < 4; ++ks) qf[ks] = lds_frag(lds + ML_QS, 272, t0, ks * 64, lane);
        const float mAt = GAm[tq], wit = GAw[tq];
#pragma unroll
        for (int si = 0; si < 2; ++si) { const int ss = 2 * (wave >> 2) + si, s0 = ss * 16; f32x4 sacc = (f32x4){0.f, 0.f, 0.f, 0.f};
            if (ss <= tt) {
#pragma unroll
                for (int ks = 0; ks < 4; ++ks) sacc = MFMA16(lds_frag(lds + ML_KS, 272, s0, ks * 64, lane), qf[ks], sacc);
#pragma unroll
                for (int r = 0; r < 4; ++r) { const int s = s0 + 4 * (lane >> 4) + r; sacc[r] = (s <= tq) ? sacc[r] * __expf(GAa[s] - mAt) : 0.f; } }
            v2u w; w.x = pk2(sacc[0], sacc[1]); w.y = pk2(sacc[2], sacc[3]);
            *(LAS v2u*)(lds + ML_SW + tq * 144 + s0 * 2 + (lane >> 4) * 8) = w; }
#pragma unroll
        for (int i = 0; i < 5; ++i) { hacc[i] = (f32x4){0.f, 0.f, 0.f, 0.f};
            if (i < ne) {
#pragma unroll
                for (int ks = 0; ks < 4; ++ks) hacc[i] = MFMA16(lds_frag(lds + ML_CT, 272, (e_first + i) * 16, ks * 64, lane), qf[ks], hacc[i]);
                hacc[i] = hacc[i] * wit; } }
#pragma unroll
        for (int i = 0; i < 8; ++i) mo_r[i] = *(const unsigned*)(bo + (unsigned)((64 * kc + 8 * wave + i) * 512 + 4 * lane)); }
        __syncthreads();
        { ML_LAUNDER(); const int tq = t0 + (lane & 15); bf16x8 swf[2];
#pragma unroll
          for (int ks = 0; ks < 2; ++ks) swf[ks] = lds_frag(lds + ML_SW, 144, t0, ks * 64, lane);
#pragma unroll
          for (int i = 0; i < 5; ++i) if (i < ne) { const int ee = e_first + i;
#pragma unroll
              for (int ks = 0; ks < 2; ++ks) hacc[i] = MFMA16(lds_frag_sw(lds + ML_VT, ee * 16, ks, lane), swf[ks], hacc[i]);
              if (ee < 8) *(LAS f32x4*)(lds + ML_HS + tq * 528 + (ee * 16 + 4 * (lane >> 4)) * 4) = hacc[i];
              else if ((lane >> 4) == 0) *(LAS float*)(lds + ML_HS + tq * 528 + 128 * 4) = hacc[i][0]; } }
        }
        { ML_LAUNDER(); const int d0 = wave * 16; bf16x8 kwf[2];
#pragma unroll
          for (int ks = 0; ks < 2; ++ks) kwf[ks] = lds_frag_sw(lds + ML_KWT, d0, ks, lane);
#pragma unroll
          for (int ee = 0; ee < 9; ++ee) { cacc[ee] = cacc[ee] * decay;
#pragma unroll
              for (int ks = 0; ks < 2; ++ks) cacc[ee] = MFMA16(kwf[ks], lds_frag_sw(lds + ML_VT, ee * 16, ks, lane), cacc[ee]);
              if (MODE == 1) { v2u w; w.x = pk2(cacc[ee][0], cacc[ee][1]); w.y = pk2(cacc[ee][2], cacc[ee][3]);
                  *(LAS v2u*)(lds + ML_CT + (ee * 16 + (lane & 15)) * 272 + (d0 + 4 * (lane >> 4)) * 2) = w; } } }
        __syncthreads();
        if (MODE == 1) {
        { ML_LAUNDER();
#pragma unroll
        for (int i = 0; i < 8; ++i) { const int t = 8 * wave + i;
            const f32x2 nv = *(const LAS f32x2*)(lds + ML_HS + t * 528 + lane * 8); const float den = *(const LAS float*)(lds + ML_HS + t * 528 + 512);
            const float dd = fmaxf(fabsf(den), GAe[t]); const float h0 = nv.x / dd, h1 = nv.y / dd;
            const float r = rsqrtf(wave_sum(h0 * h0 + h1 * h1) * (1.f / 128.f) + EPS);
            const float y0 = h0 * r * GN[2 * lane] * sigm(bf2f(mo_r[i] & 0xffffu)), y1 = h1 * r * GN[2 * lane + 1] * sigm(bf2f(mo_r[i] >> 16));
            *(unsigned*)(YML + (tb + 64 * kc + t) * 512 + h * 128 + 2 * lane) = pk2(y0, y1); } }
        __syncthreads();
        }
        m_st = m_new;
    }
    if (MODE == 0) { ML_LAUNDER();
        f32x4* sp = (f32x4*)(STB + (size_t)(slot0 + 7) * ML_STATE_BYTES) + wave * 576 + lane;
#pragma unroll
        for (int i = 0; i < 9; ++i) sp[64 * i] = cacc[i];
        if (tid == 0) MST[slot0 + 7] = m_st; }
#undef ML_LOAD
#undef ML_LAUNDER
}
constexpr int AT_HIST = 0;
constexpr int AT_HROW = 2049;
constexpr int AT_SEL = 131072 + 256;
constexpr int AT_MROW = 129;
constexpr int AT_SM = AT_SEL + 8448;
static_assert(AT_SM + 256 <= MISC_OFF, "attention LDS map");
__device__ __forceinline__ unsigned score_key(float s) { unsigned u = __float_as_uint(s + 0.0f); return (u & 0x80000000u) ? ~u : (u | 0x80000000u); }
__device__ __forceinline__ unsigned wave_suffix_sum(unsigned v, int lane) {
#define AT_SHL(x_, n_) ((unsigned)__builtin_amdgcn_update_dpp(0, (int)(x_), 0x100 + (n_), 0xF, 0xF, false))
    v += AT_SHL(v, 1); v += AT_SHL(v, 2); v += AT_SHL(v, 4); v += AT_SHL(v, 8);
#undef AT_SHL
    const unsigned t1 = (unsigned)__builtin_amdgcn_readlane((int)v, 16), t2 = (unsigned)__builtin_amdgcn_readlane((int)v, 32), t3 = (unsigned)__builtin_amdgcn_readlane((int)v, 48);
    return v + ((lane < 16) ? (t1 + t2 + t3) : ((lane < 32) ? (t2 + t3) : ((lane < 48) ? t3 : 0u)));
}
template <int NK> __device__ __forceinline__ void at_resolve(const LAS unsigned long long* cand, LAS unsigned* mask, int m, int nd, int lane) {
    unsigned long long cv[NK];
#pragma unroll
    for (int k = 0; k < NK; ++k) { const int i = 64 * k + lane; unsigned long long x = 0ull; if (i < m) x = cand[i]; cv[k] = (i < m) ? ((((x >> 32) & 0xFFFFFull) << 16) | (x & 0xFFFFull)) : 0ull; }
    unsigned long long T = 0ull;
#pragma unroll 1
    for (int bit = 35; bit >= 16; --bit) { const unsigned long long test = T | (1ull << bit); int cge = 0;
#pragma unroll
        for (int k = 0; k < NK; ++k) cge += __popcll(__ballot(cv[k] >= test));
        if (cge >= nd) T = test; }
    int g = 0, t = 0;
#pragma unroll
    for (int k = 0; k < NK; ++k) { g += __popcll(__ballot(cv[k] >= T + 0x10000ull)); t += __popcll(__ballot(cv[k] >= T)); }
    t -= g;
    if (t > nd - g) {
#pragma unroll 1
        for (int bit = 15; bit >= 0; --bit) { const unsigned long long test = T | (1ull << bit); int cge = 0;
#pragma unroll
            for (int k = 0; k < NK; ++k) cge += __popcll(__ballot(cv[k] >= test));
            if (cge >= nd) T = test; } }
#pragma unroll
    for (int k = 0; k < NK; ++k) if (cv[k] >= T && cv[k] != 0ull) { const unsigned key = 0xFFFFu - (unsigned)(cv[k] & 0xFFFFull);
        __hip_atomic_fetch_or(&mask[key >> 5], 1u << (key & 31u), __ATOMIC_RELAXED, __HIP_MEMORY_SCOPE_WORKGROUP); }
}
__device__ __forceinline__ void attn_unit(const Args& a, const Ctx& c, int b, int qt, float cshift) {
    const int tid = c.tid, wave = c.wave; LAS unsigned char* lds = c.lds;
#define AT_LAUNDER() int tv_ = tid; asm volatile("" : "+v"(tv_)); const int lane = tv_ & 63, qi = tv_ & 15, fq = (tv_ >> 4) & 3; (void)lane; (void)qi; (void)fq
    const int q0 = qt * 16, ch = q0 >> 6, n = 64 * (ch + 1), ntiles = n >> 4;
    const size_t tb = (size_t)b * SEQ;
    unsigned char* dout = (unsigned char*)a.out;
    const bf16* AQN = (const bf16*)(dout + DO_AQN); const bf16* KN = (const bf16*)(dout + DO_KN); const bf16* IQR = (const bf16*)(dout + DO_IQR); const bf16* IKR = (const bf16*)(dout + DO_IKR);
    bf16* YATT = (bf16*)(dout + DO_YATT);
    const bf16* VB = proj_tile(a, TL_KV); const bf16* PS = (const bf16*)(dout + DO_SMB);
    LAS unsigned* HIST = (LAS unsigned*)(lds + AT_HIST);
    LAS unsigned long long* CAND = (LAS unsigned long long*)(lds + AT_HIST);
    LAS unsigned* MASK = (LAS unsigned*)(lds + AT_SEL);
    LAS int* SM = (LAS int*)(lds + AT_SM);
    float* SC = (blockIdx.x < 240) ? (float*)(a.ws + WS_SC) + (size_t)blockIdx.x * (16 * 4096) : (float*)(a.ws + WS_SC2) + (size_t)(blockIdx.x - 240) * (16 * 4096);
#ifndef DBG_REP_SEL
#define DBG_REP_SEL 1
#endif
#ifndef DBG_REP_DENSE
#define DBG_REP_DENSE 1
#endif
#pragma unroll 1
    for (int rsel = 0; rsel < DBG_REP_SEL; ++rsel) {
    if (n > 256) {
        for (int i = tid; i < 8192 + 4; i += 512) ((LAS v4u*)HIST)[i] = (v4u){0u, 0u, 0u, 0u};
        if (tid < 64) SM[tid] = 0;
        for (int i = tid; i < 16 * AT_MROW; i += 512) MASK[i] = 0u;
        bf16x8 qf[8]; float wv[8];
        { AT_LAUNDER();
        const size_t trow = tb + q0 + qi;
#pragma unroll
        for (int h = 0; h < 8; ++h) qf[h] = *(const bf16x8*)(IQR + trow * 256 + h * 32 + 8 * fq);
        { float t8[8]; unpack8(*(const v4u*)(PS + trow * 16), t8);
#pragma unroll
          for (int h = 0; h < 8; ++h) wv[h] = t8[h] * 0.0625f; } }
        __syncthreads();
#define AT_LOADK(kt_) (*(const bf16x8*)(IKR + (tb + (size_t)(kt_) * 16 + qi) * 32 + 8 * fq))
#define AT_SCORES(kf_, sc_) do { \
        _Pragma("unroll") for (int r_ = 0; r_ < 4; ++r_) sc_[r_] = 0.f; \
        _Pragma("unroll") for (int h_ = 0; h_ < 8; ++h_) { const f32x4 d_ = MFMA16(kf_, qf[h_], ((f32x4){0.f, 0.f, 0.f, 0.f})); \
            _Pragma("unroll") for (int r_ = 0; r_ < 4; ++r_) { const int di_ = __float_as_int(d_[r_]); sc_[r_] = __builtin_fmaf(wv[h_], __int_as_float(di_ > 0 ? di_ : 0), sc_[r_]); } } } while (0)
        const int cnt = (ntiles - wave + 7) >> 3;
#ifndef DBG_RA
#define DBG_RA 1
#endif
#pragma unroll 1
        for (int rA = 0; rA < DBG_RA; ++rA) { if (rA) { for (int i = tid; i < 8192 + 4; i += 512) ((LAS v4u*)HIST)[i] = (v4u){0u, 0u, 0u, 0u}; __syncthreads(); }
#define AT_LOADG(dst_, i0_) do { _Pragma("unroll") for (int j_ = 0; j_ < 8; ++j_) { int kt_ = wave + 8 * ((i0_) + j_); kt_ = kt_ < ntiles ? kt_ : ntiles - 1; dst_[j_] = AT_LOADK(kt_); } } while (0)
#define AT_P1GROUP(buf_, base_) do { _Pragma("unroll") for (int j2 = 0; j2 < 8; ++j2) { const bool valid = ((base_) + j2 < cnt); const int kt = wave + 8 * ((base_) + j2); float sc[4]; AT_SCORES(buf_[j2], sc); \
                if (valid) *(f32x4*)(SC + qi * 4096 + kt * 16 + 4 * fq) = (f32x4){sc[0], sc[1], sc[2], sc[3]}; \
                _Pragma("unroll") for (int r = 0; r < 4; ++r) { const unsigned bin = score_key(sc[r]) >> 20; \
                    __hip_atomic_fetch_add(&HIST[qi * AT_HROW + (bin >> 1)], valid ? (1u << ((bin & 1u) * 16)) : 0u, __ATOMIC_RELAXED, __HIP_MEMORY_SCOPE_WORKGROUP); } } } while (0)
        { AT_LAUNDER(); bf16x8 ka[8], kb[8]; AT_LOADG(ka, 0);
#pragma unroll 1
          for (int i0 = 0; i0 < cnt; i0 += 16) {
            AT_LOADG(kb, i0 + 8);
            AT_P1GROUP(ka, i0);
            AT_LOADG(ka, i0 + 16);
            AT_P1GROUP(kb, i0 + 8); } }
#undef AT_P1GROUP
        __syncthreads();
        }
#ifndef DBG_RB
#define DBG_RB 1
#endif
#pragma unroll 1
        for (int rB = 0; rB < DBG_RB; ++rB) {
#pragma unroll 1
        for (int j = 0; j < 2; ++j) { AT_LAUNDER(); const int q = 2 * wave + j; unsigned tot = 0;
            for (int i = 0; i < 32; ++i) { const unsigned w = HIST[q * AT_HROW + 32 * lane + ((i + lane) & 31)]; tot += (w & 0xffffu) + (w >> 16); }
            const unsigned suf = wave_suffix_sum(tot, lane);
            const unsigned long long mk = __ballot(suf >= 256u); const int L = 63 - __clzll((long long)mk);
            const unsigned above_L = (unsigned)__builtin_amdgcn_readlane((int)(suf - tot), L);
            const unsigned w2 = HIST[q * AT_HROW + 32 * L + (lane >> 1)]; const unsigned cb = (lane & 1) ? (w2 >> 16) : (w2 & 0xffffu);
            const unsigned sfx = wave_suffix_sum(cb, lane);
            const unsigned long long mk2 = __ballot(above_L + sfx >= 256u); const int l2 = 63 - __clzll((long long)mk2);
            if (lane == l2) { SM[q] = 64 * L + l2; SM[16 + q] = (int)(256u - (above_L + sfx - cb)); } }
        __syncthreads();
        }
#ifndef DBG_RC
#define DBG_RC 1
#endif
#pragma unroll 1
        for (int rC = 0; rC < DBG_RC; ++rC) { if (rC) { if (tid < 16) SM[48 + tid] = 0; __syncthreads(); }
        { AT_LAUNDER(); const int Bq = SM[qi]; f32x4 scur[8];
#define AT_LOADS(dst_, i0_) do { _Pragma("unroll") for (int j_ = 0; j_ < 8; ++j_) { int kt_ = wave + 8 * ((i0_) + j_); kt_ = kt_ < ntiles ? kt_ : ntiles - 1; dst_[j_] = *(const f32x4*)(SC + qi * 4096 + kt_ * 16 + 4 * fq); } } while (0)
#define AT_P2GROUP(buf_, base_) do { _Pragma("unroll") for (int j2 = 0; j2 < 8; ++j2) { const bool valid = ((base_) + j2 < cnt); const int kt = wave + 8 * ((base_) + j2); \
                unsigned nib = 0u, cnib = 0u; unsigned uu[4]; \
                _Pragma("unroll") for (int r = 0; r < 4; ++r) { uu[r] = score_key(buf_[j2][r]); const int bin = (int)(uu[r] >> 20); nib |= (bin > Bq) ? (1u << r) : 0u; cnib |= (bin == Bq) ? (1u << r) : 0u; } \
                if (!valid) { nib = 0u; cnib = 0u; } \
                if (cnib) { int p = __hip_atomic_fetch_add(&SM[48 + qi], (int)__popc(cnib), __ATOMIC_RELAXED, __HIP_MEMORY_SCOPE_WORKGROUP); \
                    _Pragma("unroll") for (int r = 0; r < 4; ++r) if ((cnib >> r) & 1u) { if (p < 512) CAND[qi * 1024 + p] = ((unsigned long long)uu[r] << 32) | (unsigned long long)(0xFFFFu - (unsigned)(kt * 16 + 4 * fq + r)); ++p; } } \
                if (nib) __hip_atomic_fetch_or(&MASK[qi * AT_MROW + (kt >> 1)], nib << (16 * (kt & 1) + 4 * fq), __ATOMIC_RELAXED, __HIP_MEMORY_SCOPE_WORKGROUP); } } while (0)
          f32x4 sb2[8];
          AT_LOADS(scur, 0);
#pragma unroll 1
          for (int i0 = 0; i0 < cnt; i0 += 16) {
            AT_LOADS(sb2, i0 + 8);
            AT_P2GROUP(scur, i0);
            AT_LOADS(scur, i0 + 16);
            AT_P2GROUP(sb2, i0 + 8); } }
#undef AT_P2GROUP
#undef AT_LOADS
        __syncthreads();
        }
#ifndef DBG_RD
#define DBG_RD 1
#endif
#pragma unroll 1
        for (int rD = 0; rD < DBG_RD; ++rD) {
#pragma unroll 1
        for (int j = 0; j < 2; ++j) { AT_LAUNDER(); const int q = 2 * wave + j; int m = SM[48 + q]; m = m < 512 ? m : 512; const int nd = SM[16 + q];
            if (m <= 256) at_resolve<4>(CAND + q * 1024, MASK + q * AT_MROW, m, nd, lane); else at_resolve<8>(CAND + q * 1024, MASK + q * AT_MROW, m, nd, lane); }
        __syncthreads();
        }
#undef AT_SCORES
#undef AT_LOADK
#undef AT_LOADG
    } else {
#pragma unroll 1
        for (int i = tid; i < 16 * AT_MROW; i += 512) MASK[i] = ((i % AT_MROW) < (n >> 5)) ? 0xFFFFFFFFu : 0u;
        __syncthreads();
    }
    }
#pragma unroll 1
    for (int rden = 0; rden < DBG_REP_DENSE; ++rden) {
    { const int g = wave >> 2, kh = (wave >> 1) & 1, hp = wave & 1, NS = n >> 6;
      const unsigned ring0 = (unsigned)(size_t)(lds + AT_HIST);
      const bf16* dsrc[4]; unsigned ddst[4];
      { AT_LAUNDER();
#pragma unroll
        for (int i_ = 0; i_ < 4; ++i_) { const int in_ = 4 * wave + i_; const int row_ = 4 * (in_ & 15) + (lane >> 4), pos_ = lane & 15;
            dsrc[i_] = (in_ < 16) ? (KN + (tb + row_) * 128 + ((pos_ ^ (row_ & 15)) << 3)) : (VB + (tb + row_) * 256 + 128 + ((pos_ ^ (2 * (row_ & 7))) << 3));
            ddst[i_] = (unsigned)(in_ * 1024); } }
      const size_t dstep = (wave < 4) ? (size_t)64 * 128 : (size_t)64 * 256;
#define AT_STAGE(s_) do { const unsigned sb_ = ring0 + (unsigned)(((s_) & 3) * 32768); \
        _Pragma("unroll") for (int i_ = 0; i_ < 4; ++i_) { const bf16* src_ = dsrc[i_] + (size_t)(s_) * dstep; \
            const unsigned dst_ = __builtin_amdgcn_readfirstlane(sb_ + ddst[i_]); unsigned keep_; \
            asm volatile("s_mov_b32 %0, m0\n\ts_mov_b32 m0, %2\n\ts_nop 0\n\tglobal_load_lds_dwordx4 %1, off\n\ts_mov_b32 m0, %0" : "=&s"(keep_) : "v"(src_), "s"(dst_) : "memory"); } } while (0)
      bf16x8 qa[2], qb[2]; f32x4 oacc[2][4], lacc[2];
      { AT_LAUNDER();
#pragma unroll
        for (int hi = 0; hi < 2; ++hi) { const bf16* qp = AQN + (tb + q0 + qi) * 512 + (g * 4 + 2 * hp + hi) * 64 + 8 * fq; qa[hi] = *(const bf16x8*)qp; qb[hi] = *(const bf16x8*)(qp + 32); } }
#pragma unroll
      for (int hi = 0; hi < 2; ++hi) { lacc[hi] = (f32x4){0.f, 0.f, 0.f, 0.f};
#pragma unroll
        for (int dt = 0; dt < 4; ++dt) oacc[hi][dt] = (f32x4){0.f, 0.f, 0.f, 0.f}; }
      const bf16x8 ones = (bf16x8){0x3F80, 0x3F80, 0x3F80, 0x3F80, 0x3F80, 0x3F80, 0x3F80, 0x3F80};
      const f32x4 negc = (f32x4){-cshift, -cshift, -cshift, -cshift};
      asm volatile("s_waitcnt vmcnt(0)" ::: "memory");
#pragma unroll 1
      for (int s = 0; s < 3 && s < NS; ++s) AT_STAGE(s);
      typedef short s4_t __attribute__((ext_vector_type(4)));
      AT_LAUNDER();
#pragma unroll 1
      for (int s = 0; s < NS; ++s) {
          if (s + 2 < NS) asm volatile("s_waitcnt vmcnt(8)" ::: "memory"); else asm volatile("s_waitcnt vmcnt(0)" ::: "memory");
          __builtin_amdgcn_s_barrier(); asm volatile("" ::: "memory");
          if (s + 3 < NS) AT_STAGE(s + 3);
          { const LAS unsigned char* kb = lds + AT_HIST + (s & 3) * 32768; const LAS unsigned char* vbs = kb + 16384;
            const unsigned mw = MASK[qi * AT_MROW + 2 * s + kh] >> (4 * fq);
            f32x4 st[2][2];
#pragma unroll
            for (int t = 0; t < 2; ++t) { const int row = 16 * (2 * kh + t) + qi;
                const bf16x8 k0 = *(const LAS bf16x8*)(kb + row * 256 + (((g * 8 + fq) ^ (row & 15)) << 4)), k1 = *(const LAS bf16x8*)(kb + row * 256 + (((g * 8 + 4 + fq) ^ (row & 15)) << 4));
#pragma unroll
                for (int hi = 0; hi < 2; ++hi) { f32x4 d = MFMA16(k0, qa[hi], negc); st[hi][t] = MFMA16(k1, qb[hi], d); } }
            bf16x8 pb[2];
#pragma unroll
            for (int hi = 0; hi < 2; ++hi) { float pv[8];
#pragma unroll
                for (int j = 0; j < 8; ++j) { const float e = __builtin_amdgcn_exp2f(st[hi][j >> 2][j & 3]);
                    const int keep = __builtin_amdgcn_sbfe((int)mw, 16 * (j >> 2) + (j & 3), 1); pv[j] = __uint_as_float(__float_as_uint(e) & (unsigned)keep); }
                v4u pw; pw.x = pk2(pv[0], pv[1]); pw.y = pk2(pv[2], pv[3]); pw.z = pk2(pv[4], pv[5]); pw.w = pk2(pv[6], pv[7]); pb[hi] = __builtin_bit_cast(bf16x8, pw);
                lacc[hi] = MFMA16(ones, pb[hi], lacc[hi]); }
#pragma unroll
            for (int dt = 0; dt < 4; ++dt) { const int r1 = 32 * kh + 4 * fq + (qi >> 2), r2 = r1 + 16; const int ch = g * 8 + 2 * dt + ((lane & 3) >> 1);
                const s4_t lo = __builtin_amdgcn_ds_read_tr16_b64_v4i16((LAS s4_t*)(vbs + r1 * 256 + ((ch ^ (2 * (r1 & 7))) << 4) + (lane & 1) * 8));
                const s4_t hi4 = __builtin_amdgcn_ds_read_tr16_b64_v4i16((LAS s4_t*)(vbs + r2 * 256 + ((ch ^ (2 * (r2 & 7))) << 4) + (lane & 1) * 8));
                const bf16x8 va = (bf16x8){lo[0], lo[1], lo[2], lo[3], hi4[0], hi4[1], hi4[2], hi4[3]};
#pragma unroll
                for (int hi = 0; hi < 2; ++hi) oacc[hi][dt] = MFMA16(va, pb[hi], oacc[hi][dt]); } } }
      __syncthreads();
      { AT_LAUNDER(); LAS unsigned char* red = lds + AT_HIST + (g * 2 + hp) * 8704;
        if (kh == 1) {
#pragma unroll
            for (int hi = 0; hi < 2; ++hi) {
#pragma unroll
                for (int dt = 0; dt < 4; ++dt) *(LAS f32x4*)(red + (hi * 4 + dt) * 1024 + lane * 16) = oacc[hi][dt];
                *(LAS float*)(red + 8192 + hi * 256 + lane * 4) = lacc[hi][0]; } } }
      __syncthreads();
      if (kh == 0) { AT_LAUNDER(); const LAS unsigned char* red = lds + AT_HIST + (g * 2 + hp) * 8704;
#pragma unroll
        for (int hi = 0; hi < 2; ++hi) { const float inv = 1.0f / (lacc[hi][0] + *(const LAS float*)(red + 8192 + hi * 256 + lane * 4));
            bf16* yp = YATT + (tb + q0 + qi) * 512 + (g * 4 + 2 * hp + hi) * 64 + 4 * fq;
#pragma unroll
            for (int dt = 0; dt < 4; ++dt) { const f32x4 o = oacc[hi][dt] + *(const LAS f32x4*)(red + (hi * 4 + dt) * 1024 + lane * 16);
                v2u w; w.x = pk2(o[0] * inv, o[1] * inv); w.y = pk2(o[2] * inv, o[3] * inv); *(v2u*)(yp + 16 * dt) = w; } } }
#undef AT_STAGE
    }
    __syncthreads();
    }
#undef AT_LAUNDER
    __syncthreads();
}

#ifndef DBG_REP_ML
#define DBG_REP_ML 1
#endif
#ifndef DBG_REP_ATT
#define DBG_REP_ATT 1
#endif
__device__ __forceinline__ void p3_mixer(const Args& a, const Ctx& c, volatile LAS unsigned* MISC, int rep) {
#if !defined(NO_MLSTM)
#pragma unroll 1
    for (int rr = 0; rr < DBG_REP_ML; ++rr)
#pragma unroll 1
        for (int u = blockIdx.x; u < 32; u += c.G) mlstm_unit<0>(a, c, u >> 2, u & 3, 0);
#endif
    unsigned* ctl = (unsigned*)(a.ws + WS_CTL);
    const int x = (int)(__builtin_amdgcn_s_getreg((3 << 11) | 20) & 7u);
    float cshift;
    { float gq = fabsf(a.in[IN_GQ][c.lane]), gk = fabsf(a.in[IN_GK][c.lane]);
#pragma unroll
      for (int o = 1; o < 64; o <<= 1) { gq = fmaxf(gq, __shfl_xor(gq, o)); gk = fmaxf(gk, __shfl_xor(gk, o)); }
      cshift = 8.0f * 1.4426950408889634f * gq * gk; }
#pragma unroll 1
    for (int rot = 0; rot < 8 * DBG_REP_ATT; ++rot) { rep = rot >> 3; const int bq = (x + rot) & 7;
        if (c.tid == 0) MISC[16] = __hip_atomic_fetch_add(ctl + CW_Q + 512 * rep + 64 * bq, 1u, RLX_AGENT);
        __syncthreads();
        int u = (int)MISC[16];
        __syncthreads();
#pragma unroll 1
        while (u < 256) {
            unsigned nxt = 0u;
            if (c.tid == 0) nxt = __hip_atomic_fetch_add(ctl + CW_Q + 512 * rep + 64 * bq, 1u, RLX_AGENT);
#if !defined(NO_ATTN)
            attn_unit(a, c, bq, 255 - u, cshift);
#endif
            if (c.tid == 0) MISC[16] = nxt;
            __syncthreads();
            u = (int)MISC[16];
            __syncthreads();
        } }
}
constexpr int RT_WT = 0;
constexpr int RT_WROW = 1028;
constexpr int RT_LG = 36 * RT_WROW * 4;
constexpr int RT_RSTD = RT_LG + 64 * 36 * 4;
constexpr int RT_LCNT = RT_RSTD + 512;
static_assert(RT_LCNT + 128 <= MISC_OFF, "router LDS map");
__device__ __forceinline__ void p6_router(const Args& a, const Ctx& c) {
    const int tid = c.tid, lane = c.lane, wave = c.wave; LAS unsigned char* lds = c.lds;
    LAS float* WT = (LAS float*)(lds + RT_WT); LAS float* LG = (LAS float*)(lds + RT_LG); LAS float* RSTD = (LAS float*)(lds + RT_RSTD); LAS int* LCNT = (LAS int*)(lds + RT_LCNT);
    { int* RT = (int*)(a.ws + WS_ROWTOK); for (int i = blockIdx.x * 512 + tid; i < NROWS_MAX; i += c.G * 512) RT[i] = 0; }
    { const f32x4* src = (const f32x4*)(a.ws + WS_WTG); LAS f32x4* dst = (LAS f32x4*)WT; for (int i = tid; i < 36 * RT_WROW / 4; i += 512) dst[i] = src[i]; }
    f32x4 gv[4];
#pragma unroll
    for (int j = 0; j < 4; ++j) gv[j] = *(const f32x4*)(a.in[IN_GMOE] + 4 * lane + 256 * j);
    const float* X1 = a.out; bf16* XN = (bf16*)(a.ws + WS_XN);
    int* TOKE = (int*)(a.ws + WS_TOKE); int* TOKR = (int*)(a.ws + WS_TOKR); float* TOKG = (float*)(a.ws + WS_TOKG); int* CNT = (int*)(a.ws + WS_CNT);
    __syncthreads();
    for (int blk = blockIdx.x; blk < 256; blk += c.G) {
        if (tid < 32) LCNT[tid] = 0;
#pragma unroll 1
        for (int ri = 0; ri < 16; ri += 2) { const int tA = blk * 128 + wave * 16 + ri, tB = tA + 1;
            const f32x4* xa = (const f32x4*)(X1 + (size_t)tA * D) + lane; const f32x4* xb = (const f32x4*)(X1 + (size_t)tB * D) + lane;
            f32x4 va[4], vb[4]; float sa = 0.f, sb = 0.f;
#pragma unroll
            for (int j = 0; j < 4; ++j) { va[j] = xa[64 * j]; vb[j] = xb[64 * j]; }
#pragma unroll
            for (int j = 0; j < 4; ++j) { sa += (va[j].x * va[j].x + va[j].y * va[j].y) + (va[j].z * va[j].z + va[j].w * va[j].w); sb += (vb[j].x * vb[j].x + vb[j].y * vb[j].y) + (vb[j].z * vb[j].z + vb[j].w * vb[j].w); }
            const float ra = rsqrtf(wave_sum(sa) * (1.f / D) + EPS), rb = rsqrtf(wave_sum(sb) * (1.f / D) + EPS);
            if (lane == 0) { RSTD[wave * 16 + ri] = ra; RSTD[wave * 16 + ri + 1] = rb; }
            v2u* oa = (v2u*)(XN + (size_t)tA * D) + lane; v2u* ob = (v2u*)(XN + (size_t)tB * D) + lane;
#pragma unroll
            for (int j = 0; j < 4; ++j) { v2u w; w.x = pk2(va[j].x * ra * gv[j].x, va[j].y * ra * gv[j].y); w.y = pk2(va[j].z * ra * gv[j].z, va[j].w * ra * gv[j].w); oa[64 * j] = w;
                v2u u; u.x = pk2(vb[j].x * rb * gv[j].x, vb[j].y * rb * gv[j].y); u.y = pk2(vb[j].z * rb * gv[j].z, vb[j].w * rb * gv[j].w); ob[64 * j] = u; } }
        f32x4 acc[3];
#pragma unroll
        for (int ct = 0; ct < 3; ++ct) acc[ct] = (f32x4){0.f, 0.f, 0.f, 0.f};
        { const int row = lane & 15, kq = lane >> 4;
          const f32x4* ap = (const f32x4*)(X1 + (size_t)(blk * 128 + wave * 16 + row) * D + 4 * kq);
          int cj[3]; cj[0] = row; cj[1] = 16 + row; cj[2] = (32 + row) < 36 ? (32 + row) : 35;
          const LAS f32x4* bp0 = (const LAS f32x4*)(WT + cj[0] * RT_WROW + 4 * kq); const LAS f32x4* bp1 = (const LAS f32x4*)(WT + cj[1] * RT_WROW + 4 * kq); const LAS f32x4* bp2 = (const LAS f32x4*)(WT + cj[2] * RT_WROW + 4 * kq);
#define RT_LOADA(dst_, b_) do { _Pragma("unroll") for (int i_ = 0; i_ < 8; ++i_) dst_[i_] = ap[4 * (8 * ((b_) < 8 ? (b_) : 7) + i_)]; } while (0)
#define RT_MMA(src_, b_) do { _Pragma("unroll") for (int i_ = 0; i_ < 8; ++i_) { const int ks_ = 8 * (b_) + i_; const f32x4 b0 = bp0[4 * ks_], b1 = bp1[4 * ks_], b2 = bp2[4 * ks_]; \
              _Pragma("unroll") for (int j = 0; j < 4; ++j) { acc[0] = __builtin_amdgcn_mfma_f32_16x16x4f32(src_[i_][j], b0[j], acc[0], 0, 0, 0); acc[1] = __builtin_amdgcn_mfma_f32_16x16x4f32(src_[i_][j], b1[j], acc[1], 0, 0, 0); \
                  acc[2] = __builtin_amdgcn_mfma_f32_16x16x4f32(src_[i_][j], b2[j], acc[2], 0, 0, 0); } } } while (0)
          f32x4 aA[8], aB[8]; RT_LOADA(aA, 0);
#pragma unroll 1
          for (int bb = 0; bb < 8; bb += 2) { RT_LOADA(aB, bb + 1); RT_MMA(aA, bb); RT_LOADA(aA, bb + 2); RT_MMA(aB, bb + 1); }
#undef RT_LOADA
#undef RT_MMA
        }
#pragma unroll 1
        for (int half = 0; half < 2; ++half) {
            __syncthreads();
            if ((wave >> 2) == half) { const int col = lane & 15, kq = lane >> 4;
#pragma unroll
                for (int ct = 0; ct < 3; ++ct) if (16 * ct + col < 36) {
#pragma unroll
                    for (int r = 0; r < 4; ++r) LG[((wave & 3) * 16 + 4 * kq + r) * 36 + 16 * ct + col] = acc[ct][r]; } }
            __syncthreads();
            if (tid < 64) { const int row = half * 64 + tid, t = blk * 128 + row; const float rs = RSTD[row]; const LAS float* lg = LG + tid * 36;
                float gl[4];
#pragma unroll
                for (int i = 0; i < 4; ++i) gl[i] = rs * lg[32 + i] + a.in[IN_BRG][i];
                int gs = 0; float gmax = gl[0];
#pragma unroll
                for (int i = 1; i < 4; ++i) if (gl[i] > gmax) { gmax = gl[i]; gs = i; }
                float gsum = 0.f;
#pragma unroll
                for (int i = 0; i < 4; ++i) gsum += expf(gl[i] - gmax);
                const float gtop = 1.0f / gsum;
                float ev[8];
#pragma unroll
                for (int i = 0; i < 8; ++i) ev[i] = rs * lg[gs * 8 + i] + a.in[IN_BRE][gs * 8 + i];
                int l0 = 0; float v0 = ev[0];
#pragma unroll
                for (int i = 1; i < 8; ++i) if (ev[i] > v0) { v0 = ev[i]; l0 = i; }
                int l1 = -1; float v1 = -3.0e38f;
#pragma unroll
                for (int i = 0; i < 8; ++i) if (i != l0 && ev[i] > v1) { v1 = ev[i]; l1 = i; }
                const float e1 = expf(v1 - v0), s0 = 1.0f / (1.0f + e1), s1 = e1 * s0;
                const int ex0 = gs * 8 + l0, ex1 = gs * 8 + l1;
                const int rk0 = __hip_atomic_fetch_add(&LCNT[ex0], 1, __ATOMIC_RELAXED, __HIP_MEMORY_SCOPE_WORKGROUP);
                const int rk1 = __hip_atomic_fetch_add(&LCNT[ex1], 1, __ATOMIC_RELAXED, __HIP_MEMORY_SCOPE_WORKGROUP);
                TOKE[2 * t] = ex0; TOKE[2 * t + 1] = ex1; TOKR[2 * t] = rk0; TOKR[2 * t + 1] = rk1; TOKG[2 * t] = s0 * gtop; TOKG[2 * t + 1] = s1 * gtop; }
        }
        __syncthreads();
        if (tid < 32) CNT[blk * 32 + tid] = LCNT[tid];
        __syncthreads();
    }
}
__device__ __forceinline__ void p7_gather(const Args& a, const Ctx& c) {
    const int tid = c.tid, lane = c.lane, wave = c.wave;
    LAS int* PART = (LAS int*)c.lds; LAS int* PPRE = PART + 512; LAS int* TOT = PPRE + 512; LAS int* TS = TOT + 32; LAS int* BASE = TS + 64;
    const int* CNT = (const int*)(a.ws + WS_CNT); const int* TOKE = (const int*)(a.ws + WS_TOKE); const int* TOKR = (const int*)(a.ws + WS_TOKR); int* TOKP = (int*)(a.ws + WS_TOKP);
    int* RT = (int*)(a.ws + WS_ROWTOK);
    { const int e = tid & 31, p = tid >> 5; int s = 0; for (int k = 0; k < 16; ++k) s += CNT[(16 * p + k) * 32 + e]; PART[p * 32 + e] = s; }
    __syncthreads();
    if (tid < 32) { int run = 0; for (int p = 0; p < 16; ++p) { PPRE[p * 32 + tid] = run; run += PART[p * 32 + tid]; } TOT[tid] = run; }
    __syncthreads();
    if (tid == 0) { int ts = 0; for (int e = 0; e < 32; ++e) { TS[e] = ts; ts += (TOT[e] + 255) >> 8; } TS[32] = ts; }
    __syncthreads();
    if (blockIdx.x == 0 && tid < 33) ((int*)(a.ws + WS_SMALL))[tid] = TS[tid];
    for (int blk = blockIdx.x; blk < 256; blk += c.G) {
        if (tid < 32) { int s = TS[tid] * 256 + PPRE[(blk >> 4) * 32 + tid]; for (int b2 = (blk & ~15); b2 < blk; ++b2) s += CNT[b2 * 32 + tid]; BASE[tid] = s; }
        __syncthreads();
        { const int t = blk * 128 + (tid >> 2), jj = tid & 3;
          if (jj < 2) { const int pos = BASE[TOKE[2 * t + jj]] + TOKR[2 * t + jj]; TOKP[2 * t + jj] = pos; RT[pos] = t; } }
        __syncthreads();
    }
}
__device__ __forceinline__ void p10_combine(const Args& a, const Ctx& c) {
    const int lane = c.lane, gw = c.vcu * NWAVES + c.wave, NGW = c.G * NWAVES;
    const int* TOKP = (const int*)(a.ws + WS_TOKP); const float* TOKG = (const float*)(a.ws + WS_TOKG); const bf16* Y = (const bf16*)(a.ws + WS_Y);
    for (int t0 = gw; t0 < T; t0 += 2 * NGW) {
        const int tA = t0, tB = (t0 + NGW < T) ? t0 + NGW : t0; const bool hasB = (t0 + NGW < T);
        const int pA0 = TOKP[2 * tA], pA1 = TOKP[2 * tA + 1], pB0 = TOKP[2 * tB], pB1 = TOKP[2 * tB + 1];
        const float gA0 = TOKG[2 * tA], gA1 = TOKG[2 * tA + 1], gB0 = TOKG[2 * tB], gB1 = TOKG[2 * tB + 1];
        f32x4 xa[4], xb[4]; v2u ya0[4], ya1[4], yb0[4], yb1[4];
#pragma unroll
        for (int j = 0; j < 4; ++j) { const int cc = 4 * lane + 256 * j;
            xa[j] = *(const f32x4*)(a.out + (size_t)tA * D + cc); xb[j] = *(const f32x4*)(a.out + (size_t)tB * D + cc);
            ya0[j] = *(const v2u*)(Y + (size_t)pA0 * D + cc); ya1[j] = *(const v2u*)(Y + (size_t)pA1 * D + cc);
            yb0[j] = *(const v2u*)(Y + (size_t)pB0 * D + cc); yb1[j] = *(const v2u*)(Y + (size_t)pB1 * D + cc); }
#pragma unroll
        for (int j = 0; j < 4; ++j) { const int cc = 4 * lane + 256 * j; f32x4 x = xa[j];
            x[0] += gA0 * bf2f(ya0[j].x & 0xffffu) + gA1 * bf2f(ya1[j].x & 0xffffu); x[1] += gA0 * bf2f(ya0[j].x >> 16) + gA1 * bf2f(ya1[j].x >> 16);
            x[2] += gA0 * bf2f(ya0[j].y & 0xffffu) + gA1 * bf2f(ya1[j].y & 0xffffu); x[3] += gA0 * bf2f(ya0[j].y >> 16) + gA1 * bf2f(ya1[j].y >> 16);
            *(f32x4*)(a.out + (size_t)tA * D + cc) = x; }
        if (hasB) {
#pragma unroll
        for (int j = 0; j < 4; ++j) { const int cc = 4 * lane + 256 * j; f32x4 x = xb[j];
            x[0] += gB0 * bf2f(yb0[j].x & 0xffffu) + gB1 * bf2f(yb1[j].x & 0xffffu); x[1] += gB0 * bf2f(yb0[j].x >> 16) + gB1 * bf2f(yb1[j].x >> 16);
            x[2] += gB0 * bf2f(yb0[j].y & 0xffffu) + gB1 * bf2f(yb1[j].y & 0xffffu); x[3] += gB0 * bf2f(yb0[j].y >> 16) + gB1 * bf2f(yb1[j].y >> 16);
            *(f32x4*)(a.out + (size_t)tB * D + cc) = x; } }
    }
}
__global__ void __launch_bounds__(NWAVES * 64, 2) hybrid_fwd(Args args) {
    extern __shared__ __attribute__((aligned(16))) unsigned char lds_raw[];
    Ctx c; c.lds = (LAS unsigned char*)lds_raw;
    volatile LAS unsigned* MISC = (volatile LAS unsigned*)(c.lds + MISC_OFF);
    c.tid = threadIdx.x; c.lane = c.tid & 63; c.wave = __builtin_amdgcn_readfirstlane(c.tid >> 6);
    c.G = gridDim.x; { const int bx = blockIdx.x; c.vcu = (c.G % 8 == 0) ? (bx % 8) * (c.G / 8) + bx / 8 : bx; }
    unsigned* ctl = (unsigned*)(args.ws + WS_CTL);
    if (c.tid < 128) MISC[c.tid] = 0u;
    __syncthreads();
    XcdBarrier bar; bar.bar = ctl + CW_BAR; bar.x = 0; bar.st = nullptr;
    if (N_LAUNCHES == 1) bar = xcd_barrier_post(ctl + CW_BAR, MISC + 8);
#define GRID_BAR() do { if (N_LAUNCHES == 1) xcd_barrier(bar); } while (0)
    const int lo = args.ph_lo, hi = args.ph_hi;
#ifndef PH_MASK
#define PH_MASK 0xfff
#endif
#define IN(k) (((PH_MASK >> (k)) & 1) && lo <= (k) && (k) < hi)
#define BOTH(k) (IN(k) && IN((k) + 1))
    unsigned char* ws = args.ws; unsigned char* dout = (unsigned char*)args.out;
#ifndef DBG_REPEAT
#define DBG_REPEAT -1
#endif
#define REPS(k) (((k) == DBG_REPEAT) ? 2 : 1)
    if (IN(0)) { _Pragma("unroll") for (int rep = 0; rep < REPS(0); ++rep) { if (rep) GRID_BAR(); p0_prologue<0>(args, c, c.vcu * NWAVES + c.wave, c.G * NWAVES); } if (BOTH(0)) GRID_BAR(); }
    if (IN(1)) { _Pragma("unroll") for (int rep = 0; rep < REPS(1); ++rep) { if (rep) GRID_BAR();
        pg8::Gemm g{(const pg8::bf16_t*)(dout + DO_H), (const pg8::bf16_t*)(ws + WS_WIN), T, NPROJ, D}; pg8::StaticOrder S; S.init(T, NPROJ, c.G, (int)blockIdx.x);
        pg8::EpiBf16<0> E{(pg8::bf16_t*)(ws + WS_PROJ), 256, nullptr, 256, (size_t)T * 256, 1.f};
        pg8::gemm_phase<pg8::EpiBf16<0>, pg8::StaticOrder, true, true>(c.lds, g, S, E); }
        if (BOTH(1)) GRID_BAR();
    }
#ifndef DBG_R2
#define DBG_R2 1
#endif
#ifndef DBG_R4A
#define DBG_R4A 1
#endif
#ifndef DBG_R4B
#define DBG_R4B 1
#endif
#ifndef DBG_R7
#define DBG_R7 1
#endif
    if (IN(2)) { _Pragma("unroll 1") for (int rep = 0; rep < DBG_R2; ++rep) { if (rep) GRID_BAR(); p2_prep(args, c); } if (BOTH(2)) GRID_BAR(); }
    if (IN(3)) { _Pragma("unroll") for (int rep = 0; rep < REPS(3); ++rep) { if (rep) GRID_BAR(); p3_mixer(args, c, MISC, rep); } if (BOTH(3)) GRID_BAR(); }
    if (IN(4)) {
#pragma unroll 1
        for (int rep = 0; rep < DBG_R4A; ++rep) { p0_prologue<1>(args, c, c.vcu * NWAVES + c.wave, c.G * NWAVES); __syncthreads(); }
#pragma unroll 1
        for (int rep = 0; rep < DBG_R4B; ++rep)
#pragma unroll 1
        for (int u = blockIdx.x; u < 256; u += c.G) mlstm_unit<1>(args, c, u >> 5, (u >> 3) & 3, u & 7);
        if (BOTH(4)) GRID_BAR();
    }
    if (IN(5)) {
        { pg8::Gemm g{(const pg8::bf16_t*)(dout + DO_YATT), (const pg8::bf16_t*)(ws + WS_WPA), T, D, 512}; pg8::StaticOrder S; S.init(T, D, c.G, (int)blockIdx.x);
          pg8::EpiGate<false> E{(pg8::bf16_t*)(ws + WS_MERGED), D, (const pg8::bf16_t*)(ws + WS_PROJ + (size_t)TL_GA * PROJ_TILE), (size_t)T * 256};
          pg8::gemm_phase<pg8::EpiGate<false>, pg8::StaticOrder, true, true>(c.lds, g, S, E); }
        __syncthreads();
        { pg8::Gemm g{(const pg8::bf16_t*)(dout + DO_YML), (const pg8::bf16_t*)(ws + WS_WPM), T, D, 512}; pg8::StaticOrder S; S.init(T, D, c.G, (int)blockIdx.x);
          pg8::EpiGate<true> E{(pg8::bf16_t*)(ws + WS_MERGED), D, (const pg8::bf16_t*)(ws + WS_PROJ + (size_t)TL_GM * PROJ_TILE), (size_t)T * 256};
          pg8::gemm_phase<pg8::EpiGate<true>, pg8::StaticOrder, true, true>(c.lds, g, S, E); }
        if (BOTH(5)) GRID_BAR();
    }
    if (IN(6)) {
        pg8::Gemm g{(const pg8::bf16_t*)(ws + WS_MERGED), (const pg8::bf16_t*)(ws + WS_WOUT), T, D, D}; pg8::StaticOrder S; S.init(T, D, c.G, (int)blockIdx.x);
        pg8::EpiRes E{args.out, args.in[IN_X], D};
        pg8::gemm_phase<pg8::EpiRes, pg8::StaticOrder, true, true>(c.lds, g, S, E);
        if (BOTH(6)) GRID_BAR();
    }
    if (IN(7)) { _Pragma("unroll 1") for (int rep = 0; rep < DBG_R7; ++rep) { if (rep) { GRID_BAR(); } p6_router(args, c); } if (BOTH(7)) GRID_BAR(); }
    if (IN(8)) { _Pragma("unroll") for (int rep = 0; rep < REPS(8); ++rep) { if (rep) GRID_BAR(); p7_gather(args, c); } if (BOTH(8)) GRID_BAR(); }
    if (IN(9) || IN(10)) {
        LAS int* TSL = (LAS int*)(c.lds + MISC_OFF + 256);
        if (c.tid < 33) TSL[c.tid] = (int)__hip_atomic_load((unsigned*)(ws + WS_SMALL) + c.tid, RLX_AGENT);
        __syncthreads();
        if (IN(9)) {
            pg8::MoeOrder<true> S{TSL, c.G, (int)blockIdx.x, (const int*)(ws + WS_ROWTOK)};
            pg8::Gemm g{(const pg8::bf16_t*)(ws + WS_XN), (const pg8::bf16_t*)(ws + WS_GU), 0, 0, D};
            pg8::EpiSwiGLU E{(pg8::bf16_t*)(ws + WS_HID)};
            pg8::gemm_phase<pg8::EpiSwiGLU, pg8::MoeOrder<true>, true, true>(c.lds, g, S, E);
            if (BOTH(9)) GRID_BAR();
        }
        if (IN(10)) {
            pg8::MoeOrder<false> S{TSL, c.G, (int)blockIdx.x, nullptr};
            pg8::Gemm g{(const pg8::bf16_t*)(ws + WS_HID), (const pg8::bf16_t*)(ws + WS_DN), 0, 0, 512};
            pg8::EpiDown E{(pg8::bf16_t*)(ws + WS_Y)};
            pg8::gemm_phase<pg8::EpiDown, pg8::MoeOrder<false>, true, true>(c.lds, g, S, E);
            if (BOTH(10)) GRID_BAR();
        }
    }
    if (IN(11)) p10_combine(args, c);
#undef IN
#undef BOTH
#undef GRID_BAR
}

extern "C" void kernel_launch(void* const* d_in, const int* in_sizes, int n_in, void* d_out, int out_size, void* d_ws, size_t ws_size, hipStream_t stream) {
    static int grid = 0;
    if (grid == 0) {
        if (n_in != 22 || in_sizes[0] != T * D || out_size != T * D || ws_size < WS_END) { fprintf(stderr, "kernel_launch: unexpected shapes (n_in %d, in0 %d, out %d, ws %zu); nothing launched\n", n_in, n_in > 0 ? in_sizes[0] : -1, out_size, ws_size); grid = -1; return; }
        int dev = 0, cus = 0, per_cu = 0;
        if (hipGetDevice(&dev) != hipSuccess || hipDeviceGetAttribute(&cus, hipDeviceAttributeMultiprocessorCount, dev) != hipSuccess) { grid = -1; return; }
        if (hipFuncSetAttribute((const void*)hybrid_fwd, hipFuncAttributeMaxDynamicSharedMemorySize, LDS_BYTES) != hipSuccess) { fprintf(stderr, "kernel_launch: hipFuncSetAttribute failed\n"); grid = -1; return; }
        if (hipOccupancyMaxActiveBlocksPerMultiprocessor(&per_cu, (const void*)hybrid_fwd, NWAVES * 64, LDS_BYTES) != hipSuccess || per_cu < 1)
            fprintf(stderr, "kernel_launch: note: occupancy query reports %d workgroups per CU\n", per_cu);
        (void)hipGetLastError();
        grid = cus;
    }
    if (grid < 0) return;
    if (hipMemsetAsync((char*)d_ws + WS_CTL, 0, CTL_ZERO_BYTES, stream) != hipSuccess) return;
    Args a{};
    for (int i = 0; i < 22; ++i) a.in[i] = (const float*)d_in[i];
    a.out = (float*)d_out; a.ws = (unsigned char*)d_ws;
    for (int li = 0; li < N_LAUNCHES; ++li) {
        a.ph_lo = (N_LAUNCHES == 1) ? 0 : li; a.ph_hi = (N_LAUNCHES == 1) ? NPH : li + 1; a.li = li;
        hipLaunchKernelGGL(hybrid_fwd, dim3(grid), dim3(NWAVES * 64), LDS_BYTES, stream, a);
        if (hipPeekAtLastError() != hipSuccess) { fprintf(stderr, "kernel_launch: launch %d failed\n", li); break; }
    }
}
```

```cpp
#include <hip/hip_runtime.h>
#include <cstdio>
#include <cstdint>
namespace pg8 {
#define PG8_LAS __attribute__((address_space(3)))
typedef unsigned short bf16_t;
typedef short bf16x8 __attribute__((ext_vector_type(8)));
typedef float f32x4 __attribute__((ext_vector_type(4)));
typedef unsigned u32x4 __attribute__((ext_vector_type(4)));
constexpr int BM = 256, BK = 64, HALF = 128, HTB = HALF * BK * 2  , STAGE_BYTES = 8 * HTB, NXCD = 8, WGM = 8;

__host__ __device__ __forceinline__ int lds_byte(int r, int c) { const int st = (r >> 4) * 2 + (c >> 5), rr = r & 15, cc = c & 31, ob = rr * 64 + cc * 2; return st * 1024 + (ob ^ (((ob >> 9) & 1) << 5)); }
__host__ __device__ __forceinline__ void stage_rc(int b, int& R, int& C) { const int st = b / 1024, sb = b % 1024, swz = sb ^ (((sb >> 9) & 1) << 5); R = (st >> 1) * 16 + swz / 64; C = (st & 1) * 32 + (swz % 64) / 2; }
__host__ __device__ __forceinline__ int perm32(int rho) { const int n = rho >> 4, i = rho & 15; return 8 * (i >> 2) + 4 * n + (i & 3); }

struct Unit { int pm, pn; };
struct Gemm { const bf16_t* A; const bf16_t* Bt; int M, N, K; };

struct StaticOrder {
    static constexpr bool GATHER = false;
    int nM, nN, nwg, G, c;
    __host__ __device__ void init(int M, int N, int G_, int c_) { nM = M / BM; nN = N / BM; nwg = nM * nN; G = G_; c = c_; }
    __host__ __device__ bool next(int i, Unit& u) const {
        const long L = (long)i * G + c; if (L >= nwg) return false;
        int wgid = (int)L; { const int q = nwg / NXCD, r = nwg % NXCD, xcd = wgid % NXCD, off = wgid / NXCD; wgid = (xcd < r ? xcd * (q + 1) : r * (q + 1) + (xcd - r) * q) + off; }
        const int nig = WGM * nN, gid = wgid / nig, fm = gid * WGM, gsz = (nM - fm) < WGM ? (nM - fm) : WGM;
        u.pm = fm + ((wgid % nig) % gsz); u.pn = (wgid % nig) / gsz; return true;
    }
    __device__ __forceinline__ void a_ready(const Unit&) const {}
    __device__ __forceinline__ void done(const Unit&) const {}
};

typedef __bf16 bf2_t __attribute__((ext_vector_type(2)));
__device__ __forceinline__ unsigned cvt_pk_bf16(float lo, float hi) { bf2_t v; v[0] = (__bf16)lo; v[1] = (__bf16)hi; return __builtin_bit_cast(unsigned, v); }
typedef float f32x2 __attribute__((ext_vector_type(2)));
template <int ACT  > struct EpiBf16 {
    static constexpr bool PERM = true, AFTER_DRAIN = false; static_assert(ACT == 0, "EpiBf16: no activation here");
    bf16_t* O; int ldc; const float* bias; int split_cols; size_t split_stride; float scale0;
    __device__ __forceinline__ void operator()(const f32x4 (&acc)[2][2][4][2], const Unit& u, int wr, int wc, int fr, int fq) const {
        const int row0 = u.pm * BM + wr * 64 + fr; int colt = u.pn * BM; bf16_t* base = O;
        float sc = 1.f; if (split_cols) { const int t = colt / split_cols; base += (size_t)t * split_stride; colt -= t * split_cols; if (t == 0) sc = scale0; }
        const int col0 = colt + wc * 32 + 8 * fq, bcol0 = u.pn * BM + wc * 32 + 8 * fq;
        f32x4 bv[2][2];
#pragma unroll
        for (int bj = 0; bj < 2; ++bj)
#pragma unroll
            for (int n = 0; n < 2; ++n) bv[bj][n] = bias ? *(const f32x4*)(bias + bcol0 + bj * HALF + 4 * n) : (f32x4){0.f, 0.f, 0.f, 0.f};
#pragma unroll
        for (int ai = 0; ai < 2; ++ai)
#pragma unroll
            for (int m = 0; m < 4; ++m) { bf16_t* rowp = base + (size_t)(row0 + ai * HALF + m * 16) * ldc + col0;
#pragma unroll
                for (int bj = 0; bj < 2; ++bj) { f32x4 v0 = acc[ai][bj][m][0] + bv[bj][0], v1 = acc[ai][bj][m][1] + bv[bj][1];
                    v0 = v0 * sc; v1 = v1 * sc; u32x4 w; w.x = cvt_pk_bf16(v0[0], v0[1]); w.y = cvt_pk_bf16(v0[2], v0[3]); w.z = cvt_pk_bf16(v1[0], v1[1]); w.w = cvt_pk_bf16(v1[2], v1[3]);
                    *(u32x4*)(rowp + bj * HALF) = w; } }
    }
};
__device__ __forceinline__ float bf2f_(unsigned b16) { return __uint_as_float(b16 << 16); }
__device__ __forceinline__ float sigm_(float x) { return 1.0f / (1.0f + __expf(-x)); }
template <bool ADD> struct EpiGate {
    static constexpr bool PERM = true, AFTER_DRAIN = false;
    bf16_t* O; int ldc; const bf16_t* gate; size_t gstride;
    __device__ __forceinline__ void operator()(const f32x4 (&acc)[2][2][4][2], const Unit& u, int wr, int wc, int fr, int fq) const {
        const int row0 = u.pm * BM + wr * 64 + fr, colt = wc * 32 + 8 * fq;
        const bf16_t* gt = gate + (size_t)u.pn * gstride;
#pragma unroll
        for (int ai = 0; ai < 2; ++ai)
#pragma unroll
            for (int m = 0; m < 4; ++m) { const size_t row = (size_t)(row0 + ai * HALF + m * 16);
#pragma unroll
                for (int bj = 0; bj < 2; ++bj) { const int c = colt + bj * HALF;
                    const u32x4 gv = *(const u32x4*)(gt + row * 256 + c);
                    bf16_t* op = O + row * ldc + u.pn * BM + c;
                    float pv[8] = {0.f, 0.f, 0.f, 0.f, 0.f, 0.f, 0.f, 0.f};
                    if (ADD) { const u32x4 p = *(const u32x4*)op; pv[0] = bf2f_(p.x & 0xffffu); pv[1] = bf2f_(p.x >> 16); pv[2] = bf2f_(p.y & 0xffffu); pv[3] = bf2f_(p.y >> 16);
                        pv[4] = bf2f_(p.z & 0xffffu); pv[5] = bf2f_(p.z >> 16); pv[6] = bf2f_(p.w & 0xffffu); pv[7] = bf2f_(p.w >> 16); }
                    const f32x4 v0 = acc[ai][bj][m][0], v1 = acc[ai][bj][m][1];
                    float o[8];
                    o[0] = pv[0] + sigm_(bf2f_(gv.x & 0xffffu)) * v0[0]; o[1] = pv[1] + sigm_(bf2f_(gv.x >> 16)) * v0[1];
                    o[2] = pv[2] + sigm_(bf2f_(gv.y & 0xffffu)) * v0[2]; o[3] = pv[3] + sigm_(bf2f_(gv.y >> 16)) * v0[3];
                    o[4] = pv[4] + sigm_(bf2f_(gv.z & 0xffffu)) * v1[0]; o[5] = pv[5] + sigm_(bf2f_(gv.z >> 16)) * v1[1];
                    o[6] = pv[6] + sigm_(bf2f_(gv.w & 0xffffu)) * v1[2]; o[7] = pv[7] + sigm_(bf2f_(gv.w >> 16)) * v1[3];
                    u32x4 w; w.x = cvt_pk_bf16(o[0], o[1]); w.y = cvt_pk_bf16(o[2], o[3]); w.z = cvt_pk_bf16(o[4], o[5]); w.w = cvt_pk_bf16(o[6], o[7]);
                    *(u32x4*)op = w; } }
    }
};
struct EpiRes {
    static constexpr bool PERM = false, AFTER_DRAIN = false;
    float* C; const float* R; int ldc;
    __device__ __forceinline__ void operator()(const f32x4 (&acc)[2][2][4][2], const Unit& u, int wr, int wc, int fr, int fq) const {
        const int row0 = u.pm * BM + wr * 64 + fr, col0 = u.pn * BM + wc * 32 + 4 * fq;
#pragma unroll
        for (int ai = 0; ai < 2; ++ai)
#pragma unroll
            for (int m = 0; m < 4; ++m) { const size_t ro = (size_t)(row0 + ai * HALF + m * 16) * ldc + col0;
#pragma unroll
                for (int bj = 0; bj < 2; ++bj)
#pragma unroll
                    for (int n = 0; n < 2; ++n) { const size_t off = ro + bj * HALF + n * 16; *(f32x4*)(C + off) = *(const f32x4*)(R + off) + acc[ai][bj][m][n]; } }
    }
};
struct EpiSwiGLU {
    static constexpr bool PERM = true, AFTER_DRAIN = false;
    bf16_t* H;
    __device__ __forceinline__ void operator()(const f32x4 (&acc)[2][2][4][2], const Unit& u, int wr, int wc, int fr, int fq) const {
        const int row0 = u.pm * BM + wr * 64 + fr, hc = (u.pn & 3) * 128 + wc * 32 + 8 * fq;
#pragma unroll
        for (int ai = 0; ai < 2; ++ai)
#pragma unroll
            for (int m = 0; m < 4; ++m) { const size_t row = (size_t)(row0 + ai * HALF + m * 16);
                float o[8];
#pragma unroll
                for (int n = 0; n < 2; ++n)
#pragma unroll
                    for (int i = 0; i < 4; ++i) { const float g = acc[ai][0][m][n][i], up = acc[ai][1][m][n][i]; o[n * 4 + i] = g * sigm_(g) * up; }
                u32x4 w; w.x = cvt_pk_bf16(o[0], o[1]); w.y = cvt_pk_bf16(o[2], o[3]); w.z = cvt_pk_bf16(o[4], o[5]); w.w = cvt_pk_bf16(o[6], o[7]);
                *(u32x4*)(H + row * 512 + hc) = w; }
    }
};
struct EpiDown {
    static constexpr bool PERM = true, AFTER_DRAIN = false;
    bf16_t* Y;
    __device__ __forceinline__ void operator()(const f32x4 (&acc)[2][2][4][2], const Unit& u, int wr, int wc, int fr, int fq) const {
        const int row0 = u.pm * BM + wr * 64 + fr, c0 = (u.pn & 3) * 256 + wc * 32 + 8 * fq;
#pragma unroll
        for (int ai = 0; ai < 2; ++ai)
#pragma unroll
            for (int m = 0; m < 4; ++m) { const size_t row = (size_t)(row0 + ai * HALF + m * 16);
#pragma unroll
                for (int bj = 0; bj < 2; ++bj) { const f32x4 v0 = acc[ai][bj][m][0], v1 = acc[ai][bj][m][1];
                    u32x4 w; w.x = cvt_pk_bf16(v0[0], v0[1]); w.y = cvt_pk_bf16(v0[2], v0[3]); w.z = cvt_pk_bf16(v1[0], v1[1]); w.w = cvt_pk_bf16(v1[2], v1[3]);
                    *(u32x4*)(Y + row * 1024 + c0 + bj * HALF) = w; } }
    }
};
template <bool GA_> struct MoeOrder {
    static constexpr bool GATHER = GA_;
    const PG8_LAS int* ts; int G, c; const int* rowtok;
    __device__ __forceinline__ bool next(int i, Unit& u) const {
        const int nt = ts[32]; const long L = (long)i * G + c; if (L >= 4L * nt) return false;
        const int pm = (int)(L >> 2), j = (int)(L & 3); int e = 0;
#pragma unroll
        for (int k = 1; k < 32; ++k) e += (ts[k] <= pm) ? 1 : 0;
        u.pm = pm; u.pn = e * 4 + j; return true;
    }
    __device__ __forceinline__ void a_ready(const Unit&) const {}
    __device__ __forceinline__ void done(const Unit&) const {}
};
template <class Epi, class Sched, bool ALIGN_EPI = false, bool SP2 = false>
__device__ __forceinline__ void gemm_phase(PG8_LAS unsigned char* lds, const Gemm g, const Sched& S, const Epi& E) {
    const int tid = threadIdx.x, wid = __builtin_amdgcn_readfirstlane(tid >> 6), lane = tid & 63, wr = wid >> 2, wc = wid & 3, fr = lane & 15, fq = lane >> 4;
    const int K = g.K, nt = K / BK;
    unsigned voffA[2], voffB[2];
#pragma unroll
    for (int i = 0; i < 2; ++i) { int R, C; stage_rc(tid * 16 + i * 8192, R, C); const int Rb = Epi::PERM ? ((R & ~31) + perm32(R & 31)) : R;
        voffA[i] = (unsigned)(R * K + C) * 2u; voffB[i] = (unsigned)(Rb * K + C) * 2u; }
    const size_t kstep = (size_t)(BK * 2);
    const size_t hstep = (size_t)HALF * K * 2;
    const size_t tstep = 2 * hstep;
    constexpr bool GA = Sched::GATHER;
    static_assert(!GA || SP2, "gathered A rows: SP2 loop only");
    const size_t hstepA = GA ? 0 : hstep;
    unsigned gcur[2][2] = {{0u, 0u}, {0u, 0u}}, gnxt[2][2] = {{0u, 0u}, {0u, 0u}}; int gR[2] = {0, 0}; unsigned gC[2] = {0u, 0u};
    if constexpr (GA) { _Pragma("unroll") for (int i = 0; i < 2; ++i) { int R, C; stage_rc(tid * 16 + i * 8192, R, C); gR[i] = R; gC[i] = (unsigned)C * 2u; } }
#define PG8_GOFF(dst, u) do { if constexpr (GA) { _Pragma("unroll") for (int h_ = 0; h_ < 2; ++h_) _Pragma("unroll") for (int i_ = 0; i_ < 2; ++i_) dst[h_][i_] = (unsigned)S.rowtok[(u).pm * BM + h_ * HALF + gR[i_]] * (unsigned)(K * 2) + gC[i_]; } } while (0)
#define PG8_VA(h, sel) (GA ? ((sel) ? gnxt[h] : gcur[h]) : voffA)
    const unsigned ldsw = (unsigned)wid * 1024u;
    const int aoff = lds_byte(wr * 64 + fr, fq * 8), boff = lds_byte(wc * 32 + fr, fq * 8);
#define PG8_SA(b, h) (((b) * 2 + (h)) * HTB)
#define PG8_SB(b, h) ((4 + (b) * 2 + (h)) * HTB)
#define PG8_STAGE(bufoff, gbase, voff) do { _Pragma("unroll") for (int _i = 0; _i < 2; ++_i) \
        __builtin_amdgcn_global_load_lds((const unsigned*)((const char*)(gbase) + (voff)[_i]), (PG8_LAS unsigned*)(lds + (bufoff) + ldsw + _i * 8192), 16, 0, 0); } while (0)
#define PG8_LDA(dst, b, h) do { _Pragma("unroll") for (int m = 0; m < 4; ++m) _Pragma("unroll") for (int k = 0; k < 2; ++k) dst[m][k] = *(const PG8_LAS bf16x8*)(lds + PG8_SA(b, h) + aoff + m * 2048 + k * 1024); } while (0)
#define PG8_LDB(dst, b, h) do { _Pragma("unroll") for (int n = 0; n < 2; ++n) _Pragma("unroll") for (int k = 0; k < 2; ++k) dst[n][k] = *(const PG8_LAS bf16x8*)(lds + PG8_SB(b, h) + boff + n * 2048 + k * 1024); } while (0)
#define PG8_MMA(ai, bj, At, Bt) do { __builtin_amdgcn_s_setprio(1); _Pragma("unroll") for (int m = 0; m < 4; ++m) _Pragma("unroll") for (int n = 0; n < 2; ++n) _Pragma("unroll") for (int k = 0; k < 2; ++k) \
        acc[ai][bj][m][n] = __builtin_amdgcn_mfma_f32_16x16x32_bf16(Bt[n][k], At[m][k], acc[ai][bj][m][n], 0, 0, 0); __builtin_amdgcn_s_setprio(0); } while (0)
#define PG8_WAIT_V(n) asm volatile("s_waitcnt vmcnt(" #n ")" ::: "memory")
#define PG8_WAIT_L(n) asm volatile("s_waitcnt lgkmcnt(" #n ")" ::: "memory")
#define PG8_BAR __builtin_amdgcn_s_barrier()
#define PG8_SCHED __builtin_amdgcn_sched_barrier(0)
    Unit cur, nxt; int ui = 0;
    if (!S.next(0, cur)) return;
    f32x4 acc[2][2][4][2];
#pragma unroll
    for (int a = 0; a < 2; ++a)
#pragma unroll
        for (int b = 0; b < 2; ++b)
#pragma unroll
            for (int m = 0; m < 4; ++m)
#pragma unroll
                for (int n = 0; n < 2; ++n) acc[a][b][m][n] = (f32x4){0.f, 0.f, 0.f, 0.f};
    bf16x8 At[4][2], B0[2][2], B1[2][2];
    const char* cA = (const char*)g.A + (GA ? 0 : (size_t)cur.pm * tstep); const char* cB = (const char*)g.Bt + (size_t)cur.pn * tstep;
    S.a_ready(cur);
    PG8_GOFF(gcur, cur);
    if constexpr (SP2) {
        PG8_STAGE(PG8_SB(0, 0), cB, voffB); PG8_STAGE(PG8_SB(0, 1), cB + hstep, voffB); PG8_STAGE(PG8_SA(0, 0), cA, PG8_VA(0, false)); PG8_STAGE(PG8_SA(0, 1), cA + hstepA, PG8_VA(1, false));
        if (wr == 1) PG8_BAR;
        PG8_WAIT_V(2); PG8_BAR;
        PG8_STAGE(PG8_SB(1, 0), cB + kstep, voffB); PG8_STAGE(PG8_SA(1, 0), cA + kstep, PG8_VA(0, false)); PG8_STAGE(PG8_SB(1, 1), cB + hstep + kstep, voffB);
        PG8_WAIT_V(6); PG8_BAR;
    } else {
        PG8_STAGE(PG8_SB(0, 0), cB, voffB); PG8_STAGE(PG8_SA(0, 0), cA, voffA); PG8_STAGE(PG8_SB(0, 1), cB + hstep, voffB); PG8_STAGE(PG8_SA(0, 1), cA + hstep, voffA);
        if (wr == 1) PG8_BAR;
        PG8_WAIT_V(4); PG8_BAR;
        PG8_STAGE(PG8_SB(1, 0), cB + kstep, voffB); PG8_STAGE(PG8_SA(1, 0), cA + kstep, voffA); PG8_STAGE(PG8_SB(1, 1), cB + hstep + kstep, voffB);
        PG8_WAIT_V(6); PG8_BAR;
    }
    for (;;) {
        const bool has_next = S.next(ui + 1, nxt);
        if (has_next) PG8_GOFF(gnxt, nxt);
        const char* nA = has_next ? (const char*)g.A + (GA ? 0 : (size_t)nxt.pm * tstep) : cA; const char* nB = has_next ? (const char*)g.Bt + (size_t)nxt.pn * tstep : cB;
        for (int t = 0; t < nt; t += 2) {
            const bool last = (t == nt - 2);
            const char* a1 = cA + (size_t)(t + 1) * kstep;
            const char* a2 = last ? nA : cA + (size_t)(t + 2) * kstep; const char* b2 = last ? nB : cB + (size_t)(t + 2) * kstep;
            const char* a3 = a2 + kstep; const char* b3 = b2 + kstep;
            if (last && has_next) S.a_ready(nxt);
            const bool seln = last && has_next;
            if constexpr (SP2) {
            PG8_LDB(B0, 0, 0); PG8_LDB(B1, 0, 1); PG8_SCHED; PG8_LDA(At, 0, 0); PG8_STAGE(PG8_SA(1, 1), a1 + hstepA, PG8_VA(1, false));
            PG8_WAIT_V(8); PG8_WAIT_L(0); PG8_BAR; PG8_MMA(0, 0, At, B0); PG8_MMA(0, 1, At, B1); PG8_BAR; PG8_SCHED;
            PG8_LDA(At, 0, 1); PG8_STAGE(PG8_SB(0, 0), b2, voffB); PG8_STAGE(PG8_SB(0, 1), b2 + hstep, voffB); PG8_STAGE(PG8_SA(0, 0), a2, PG8_VA(0, seln));
            PG8_WAIT_V(8); PG8_WAIT_L(0); PG8_BAR; PG8_MMA(1, 0, At, B0); PG8_MMA(1, 1, At, B1); PG8_BAR; PG8_SCHED;
            PG8_LDB(B0, 1, 0); PG8_LDB(B1, 1, 1); PG8_SCHED; PG8_LDA(At, 1, 0); PG8_STAGE(PG8_SA(0, 1), a2 + hstepA, PG8_VA(1, seln));
            PG8_WAIT_V(8); PG8_WAIT_L(0); PG8_BAR; PG8_MMA(0, 0, At, B0); PG8_MMA(0, 1, At, B1); PG8_BAR; PG8_SCHED;
            PG8_LDA(At, 1, 1); PG8_STAGE(PG8_SB(1, 0), b3, voffB); PG8_STAGE(PG8_SB(1, 1), b3 + hstep, voffB); PG8_STAGE(PG8_SA(1, 0), a3, PG8_VA(0, seln));
            PG8_WAIT_V(8); PG8_WAIT_L(0); PG8_BAR; PG8_MMA(1, 0, At, B0); PG8_MMA(1, 1, At, B1); PG8_BAR; PG8_SCHED;
            } else {
            PG8_LDB(B0, 0, 0); PG8_SCHED; PG8_LDA(At, 0, 0); PG8_STAGE(PG8_SA(1, 1), a1 + hstep, voffA);
            PG8_WAIT_L(8); PG8_BAR; PG8_WAIT_L(0); PG8_MMA(0, 0, At, B0); PG8_BAR; PG8_SCHED;
            PG8_LDB(B1, 0, 1); PG8_STAGE(PG8_SB(0, 0), b2, voffB);
            PG8_BAR; PG8_WAIT_L(0); PG8_MMA(0, 1, At, B1); PG8_BAR;
            PG8_LDA(At, 0, 1); PG8_STAGE(PG8_SA(0, 0), a2, voffA);
            PG8_BAR; PG8_WAIT_L(0); PG8_MMA(1, 0, At, B0); PG8_BAR; PG8_SCHED;
            PG8_STAGE(PG8_SB(0, 1), b2 + hstep, voffB);
            PG8_WAIT_V(6); PG8_BAR; PG8_MMA(1, 1, At, B1); PG8_BAR;
            PG8_LDB(B0, 1, 0); PG8_SCHED; PG8_LDA(At, 1, 0); PG8_STAGE(PG8_SA(0, 1), a2 + hstep, voffA);
            PG8_WAIT_L(8); PG8_BAR; PG8_WAIT_L(0); PG8_MMA(0, 0, At, B0); PG8_BAR; PG8_SCHED;
            PG8_LDB(B1, 1, 1); PG8_STAGE(PG8_SB(1, 0), b3, voffB);
            PG8_BAR; PG8_WAIT_L(0); PG8_MMA(0, 1, At, B1); PG8_BAR;
            PG8_LDA(At, 1, 1); PG8_STAGE(PG8_SA(1, 0), a3, voffA);
            PG8_BAR; PG8_WAIT_L(0); PG8_MMA(1, 0, At, B0); PG8_BAR; PG8_SCHED;
            PG8_STAGE(PG8_SB(1, 1), b3 + hstep, voffB);
            PG8_WAIT_V(6); PG8_BAR; PG8_MMA(1, 1, At, B1); PG8_BAR;
            }
        }
        if constexpr (ALIGN_EPI) { if (wr == 0) PG8_BAR; }
        if constexpr (!Epi::AFTER_DRAIN) { E(acc, cur, wr, wc, fr, fq); S.done(cur); }
        if (!has_next) break;
#pragma unroll
        for (int a = 0; a < 2; ++a)
#pragma unroll
            for (int b = 0; b < 2; ++b)
#pragma unroll
                for (int m = 0; m < 4; ++m)
#pragma unroll
                    for (int n = 0; n < 2; ++n) acc[a][b][m][n] = (f32x4){0.f, 0.f, 0.f, 0.f};
        cur = nxt; cA = nA; cB = nB; ++ui;
        if constexpr (GA) { _Pragma("unroll") for (int h_ = 0; h_ < 2; ++h_) _Pragma("unroll") for (int i_ = 0; i_ < 2; ++i_) gcur[h_][i_] = gnxt[h_][i_]; }
        if constexpr (ALIGN_EPI) { if (wr == 1) PG8_BAR; }
    }
    PG8_WAIT_V(0);
    if constexpr (!ALIGN_EPI) { if (wr == 0) PG8_BAR; }
    PG8_BAR;
    if constexpr (Epi::AFTER_DRAIN) { E.fused(acc, cur, wr, wc, fr, fq, lds, wid, lane); S.done(cur); }
#undef PG8_GOFF
#undef PG8_VA
#undef PG8_SA
#undef PG8_SB
#undef PG8_STAGE
#undef PG8_LDA
#undef PG8_LDB
#undef PG8_MMA
#undef PG8_WAIT_V
#undef PG8_WAIT_L
#undef PG8_BAR
#undef PG8_SCHED
}
}
constexpr int NWAVES = 8;
constexpr int BATCH = 8, SEQ = 4096, D = 1024, T = BATCH * SEQ;
constexpr int NPROJ = 5120;
constexpr int NTILE = NPROJ / 256;
constexpr float EPS = 1e-6f;
#ifndef MK_N_LAUNCHES
#define MK_N_LAUNCHES 1
#endif
#ifndef DBG_NPH
#define DBG_NPH 12
#endif
constexpr int NPH = DBG_NPH;
constexpr int N_LAUNCHES = MK_N_LAUNCHES;
static_assert(N_LAUNCHES == 1 || N_LAUNCHES == NPH, "MK_N_LAUNCHES is 1 or NPH");

constexpr size_t MiB = 1u << 20;
constexpr size_t WS_CTL = 0, CTL_ZERO_BYTES = 1 * MiB;
constexpr size_t WS_SMALL = 1 * MiB;
constexpr size_t WS_WIN = 2 * MiB;
constexpr size_t WS_WPA = 13 * MiB, WS_WPM = 14 * MiB, WS_WOUT = 15 * MiB;
constexpr size_t WS_TOKE = 17 * MiB;
constexpr size_t WS_TOKR = WS_TOKE + 256 * 1024;
constexpr size_t WS_TOKP = WS_TOKR + 256 * 1024;
constexpr size_t WS_TOKG = WS_TOKP + 256 * 1024;
constexpr size_t WS_CNT = WS_TOKG + 256 * 1024;
constexpr size_t WS_ROWTOK = WS_CNT + 64 * 1024;
constexpr int NROWS_MAX = 73728;
constexpr size_t WS_SC = 452 * MiB;
constexpr size_t WS_SC2 = 116 * MiB + 3 * ((size_t)T * 256 * 2);
constexpr size_t WS_GU = 20 * MiB;
constexpr size_t WS_DN = 84 * MiB;
constexpr size_t WS_PROJ = 116 * MiB;
constexpr size_t PROJ_TILE = (size_t)T * 256 * 2;
constexpr size_t WS_MLST = 116 * MiB;
constexpr size_t WS_MERGED = 116 * MiB;
constexpr size_t WS_XN = 180 * MiB;
constexpr size_t WS_XG = 244 * MiB;
constexpr size_t WS_HID = 388 * MiB;
constexpr size_t WS_Y = 244 * MiB;
constexpr size_t WS_END = 512 * MiB;
static_assert(WS_PROJ + NTILE * PROJ_TILE == 436 * MiB, "proj map");
constexpr size_t DO_H = 0, DO_YATT = 0, DO_YML = 32 * MiB, DO_KN = 64 * MiB, DO_IKR = 72 * MiB, DO_IQR = 74 * MiB, DO_AQN = 90 * MiB;
constexpr int TL_AQ = 0, TL_KV = 2, TL_IQ = 3, TL_MQ = 4, TL_MK = 6, TL_MV = 8, TL_MO = 10, TL_GA = 12, TL_GM = 16;
constexpr size_t WS_WSM = WS_SMALL + 64 * 1024;
constexpr size_t WS_WTG = WS_SMALL + 192 * 1024;
constexpr size_t DO_SMB = 122 * MiB;
constexpr int CW_BAR = 4096;
constexpr int CW_Q = 16384;
constexpr int LDS_BYTES = 163840, MISC_OFF = LDS_BYTES - 512;

#define GAS __attribute__((address_space(1)))
#define LAS __attribute__((address_space(3)))
typedef unsigned short bf16;
typedef unsigned v4u __attribute__((ext_vector_type(4)));
typedef unsigned v2u __attribute__((ext_vector_type(2)));
typedef float f32x4 __attribute__((ext_vector_type(4)));
typedef float f32x2 __attribute__((ext_vector_type(2)));
typedef short bf16x8 __attribute__((ext_vector_type(8)));
typedef GAS unsigned gu32;
#define RLX_AGENT __ATOMIC_RELAXED, __HIP_MEMORY_SCOPE_AGENT
#define LDS_WAIT() asm volatile("s_waitcnt lgkmcnt(0)" ::: "memory")
__device__ __forceinline__ float bf2f(unsigned b16) { return __uint_as_float(b16 << 16); }
__device__ __forceinline__ unsigned f2bf(float f) { unsigned u = __float_as_uint(f); return (u + 0x7fffu + ((u >> 16) & 1u)) >> 16; }
__device__ __forceinline__ unsigned pk2(float lo, float hi) { return pg8::cvt_pk_bf16(lo, hi); }
__device__ __forceinline__ float sigm(float x) { return 1.0f / (1.0f + __expf(-x)); }
__device__ __forceinline__ float wave_sum(float v) {
    v += __int_as_float(__builtin_amdgcn_update_dpp(0, __float_as_int(v), 0xB1, 0xF, 0xF, true));
    v += __int_as_float(__builtin_amdgcn_update_dpp(0, __float_as_int(v), 0x4E, 0xF, 0xF, true));
    v += __int_as_float(__builtin_amdgcn_update_dpp(0, __float_as_int(v), 0x124, 0xF, 0xF, true));
    v += __int_as_float(__builtin_amdgcn_update_dpp(0, __float_as_int(v), 0x128, 0xF, 0xF, true));
    { const auto r = __builtin_amdgcn_permlane16_swap(__float_as_uint(v), __float_as_uint(v), false, false); v = __uint_as_float(r[0]) + __uint_as_float(r[1]); }
    { const auto r = __builtin_amdgcn_permlane32_swap(__float_as_uint(v), __float_as_uint(v), false, false); v = __uint_as_float(r[0]) + __uint_as_float(r[1]); }
    return v;
}
__device__ __forceinline__ void unpack8(const v4u r, float (&f)[8]) {
    f[0] = bf2f(r.x & 0xffffu); f[1] = bf2f(r.x >> 16); f[2] = bf2f(r.y & 0xffffu); f[3] = bf2f(r.y >> 16);
    f[4] = bf2f(r.z & 0xffffu); f[5] = bf2f(r.z >> 16); f[6] = bf2f(r.w & 0xffffu); f[7] = bf2f(r.w >> 16);
}
__device__ __forceinline__ v4u pack8(const float (&f)[8]) { v4u w; w.x = pk2(f[0], f[1]); w.y = pk2(f[2], f[3]); w.z = pk2(f[4], f[5]); w.w = pk2(f[6], f[7]); return w; }
#define XB_TMO      128
#define XB_XCNT(j)  (256  + 64 * (j))
#define XB_XSUB(j)  (1280 + 64 * (j))
#define XB_XGEN(j)  (2304 + 64 * (j))
#define XB_TOP      3328
#define XB_TOPGEN   3392
#define XCD_BAR_WORDS 3456
#define XB_SPIN_CAP (1u << 18)

__device__ __forceinline__ unsigned xb_ld(unsigned* p)              { return __hip_atomic_load(p, __ATOMIC_RELAXED, __HIP_MEMORY_SCOPE_AGENT); }
__device__ __forceinline__ unsigned xb_add(unsigned* p, unsigned v) { return __hip_atomic_fetch_add(p, v, __ATOMIC_RELAXED, __HIP_MEMORY_SCOPE_AGENT); }
__device__ __forceinline__ unsigned xb_xcc_id() { return (unsigned)__builtin_amdgcn_s_getreg((3 << 11) | 20) & 0xFu; }
#define XB_SPIN(cond, bar) do { unsigned _sp = 0; while (cond) { __builtin_amdgcn_s_sleep(1); \
    if ((++_sp & 255u) == 0u) { if (xb_ld(&(bar)[XB_TMO])) break; if (_sp > XB_SPIN_CAP) { atomicAdd(&(bar)[XB_TMO], 1u); break; } } } } while (0)

struct XcdBarrier {
    unsigned* bar; unsigned x;
    volatile LAS unsigned* st;
};

__device__ __forceinline__ XcdBarrier xcd_barrier_post(unsigned* bar, volatile LAS unsigned* st) {
    XcdBarrier b; b.bar = bar; b.x = xb_xcc_id(); b.st = st;
    if (threadIdx.x == 0) (void)xb_add(&bar[XB_XCNT(b.x)], 1u);
    return b;
}
__device__ __forceinline__ void xcd_barrier_complete(unsigned* bar, unsigned x, unsigned& nloc, unsigned& nx) {
    const unsigned G = gridDim.x * gridDim.y * gridDim.z;
    unsigned sum, cnt, mine, sp = 0u;
    for (;;) {
        sum = 0u; cnt = 0u; mine = 0u;
#pragma unroll
        for (unsigned j = 0; j < 16; ++j) { const unsigned c = xb_ld(&bar[XB_XCNT(j)]); sum += c; cnt += (c > 0u) ? 1u : 0u; mine = (j == x) ? c : mine; }
        if (sum == G) break;
        __builtin_amdgcn_s_sleep(1);
        if ((++sp & 255u) == 0u) { if (xb_ld(&bar[XB_TMO])) break; if (sp > XB_SPIN_CAP) { atomicAdd(&bar[XB_TMO], 1u); break; } }
    }
    nloc = mine > 0u ? mine : 1u; nx = cnt > 0u ? cnt : 1u;
}

__device__ __forceinline__ void xcd_barrier(const XcdBarrier& b) {
    asm volatile("s_waitcnt vmcnt(0)" ::: "memory");
    __syncthreads();
    if (threadIdx.x == 0) {
        unsigned* bar = b.bar;
        __builtin_amdgcn_s_waitcnt(0);
        unsigned nloc = b.st[0], nx = b.st[1];
        if (nloc == 0u) { xcd_barrier_complete(bar, b.x, nloc, nx); b.st[0] = nloc; b.st[1] = nx; }
        const unsigned old = xb_add(&bar[XB_XSUB(b.x)], 1u);
        const unsigned gen = old / nloc;
        if (old + 1u == (gen + 1u) * nloc) {
            __builtin_amdgcn_fence(__ATOMIC_RELEASE, "agent");
            asm volatile("s_waitcnt vmcnt(0)" ::: "memory");
            const unsigned og = xb_add(&bar[XB_TOP], 1u);
            const unsigned tg = og / nx;
            if (og + 1u == (tg + 1u) * nx) xb_add(&bar[XB_TOPGEN], 1u);
            else XB_SPIN(xb_ld(&bar[XB_TOPGEN]) == tg, bar);
            __builtin_amdgcn_fence(__ATOMIC_ACQUIRE, "agent");
            xb_add(&bar[XB_XGEN(b.x)], 1u);
            asm volatile("s_waitcnt vmcnt(0)" ::: "memory");
        } else {
            XB_SPIN(xb_ld(&bar[XB_XGEN(b.x)]) == gen, bar);
            __builtin_amdgcn_fence(__ATOMIC_ACQUIRE, "agent");
            asm volatile("s_waitcnt vmcnt(0)" ::: "memory");
        }
    }
    __syncthreads();
}
struct Args { const float* in[22]; float* out; unsigned char* ws; int ph_lo, ph_hi, li, pad; };
struct Ctx { int tid, lane, wave, G, vcu; LAS unsigned char* lds; };
#define IN_X 0
#define IN_POS 1
#define IN_GMIX 2
#define IN_WIN 3
#define IN_GQ 4
#define IN_GK 5
#define IN_WCONV 6
#define IN_BCONV 7
#define IN_BI 8
#define IN_BF 9
#define IN_GML 10
#define IN_WPA 11
#define IN_WPM 12
#define IN_WOUT 13
#define IN_GMOE 14
#define IN_WRG 15
#define IN_BRG 16
#define IN_WRE 17
#define IN_BRE 18
#define IN_WEG 19
#define IN_WEU 20
#define IN_WED 21

__device__ __forceinline__ int win_src_col(int n) {
    if (n < 1024) return n;
    if (n < 3072) return n + 40;
    return n + 48;
}
__device__ __forceinline__ int wsm_src_col(int r) {
    return r < 40 ? 1024 + r : (r < 44 ? 3112 + (r - 40) : 3116 + (r - 44));
}
__device__ __forceinline__ void tr_item(const float* W, int ldw, int scol, int k0, bf16* wt0, int K, LAS float* scr, int lane) {
    const int sc0 = __builtin_amdgcn_readfirstlane(scol), sc31 = __builtin_amdgcn_readlane(scol, 31);
    if (sc0 >= 0 && sc31 == sc0 + 31 && (sc0 & 3) == 0 && (ldw & 3) == 0) {
#pragma unroll
        for (int i = 0; i < 8; ++i) { const int kk = 8 * i + (lane >> 3); const f32x4 v = *(const f32x4*)(W + (size_t)(k0 + kk) * ldw + sc0 + 4 * (lane & 7));
            LAS float* d = scr + kk * 33 + 4 * (lane & 7); d[0] = v[0]; d[1] = v[1]; d[2] = v[2]; d[3] = v[3]; }
    } else {
#pragma unroll 8
        for (int i = 0; i < 32; ++i) { const int kk = 2 * i + (lane >> 5); scr[kk * 33 + (lane & 31)] = scol >= 0 ? W[(size_t)(k0 + kk) * ldw + scol] : 0.f; }
    }
    LDS_WAIT(); asm volatile("" ::: "memory");
    const int c = lane & 7;
#pragma unroll
    for (int j = 0; j < 4; ++j) { const int n = (lane >> 3) + 8 * j; const LAS float* s = scr + (8 * c) * 33 + n;
        v4u o; o.x = pk2(s[0 * 33], s[1 * 33]); o.y = pk2(s[2 * 33], s[3 * 33]); o.z = pk2(s[4 * 33], s[5 * 33]); o.w = pk2(s[6 * 33], s[7 * 33]);
        *(v4u*)(wt0 + (size_t)n * K + 8 * c) = o; }
    LDS_WAIT(); asm volatile("" ::: "memory");
}
template <int PART> __device__ __forceinline__ void p0_prologue(const Args& a, const Ctx& c, int gw, int NGW) {
    unsigned char* ws = a.ws;
    LAS float* scr = (LAS float*)(c.lds + c.wave * 16384);
    const int lane = c.lane;
    constexpr int I_IN = 16 * 160, I_PA = 8 * 32, I_PM = 8 * 32, I_OUT = 16 * 32, I_GU = 32 * 16 * 32, I_DN = 32 * 8 * 32;
    constexpr int NPRJ = I_IN + I_PA + I_PM + I_OUT, NIT = NPRJ + I_GU + I_DN;
    for (int it = (PART ? NPRJ : 0) + gw; it < (PART ? NIT : NPRJ); it += NGW) {
        int r = it;
        if (r < I_IN) { const int kb = r / 160, nb = r % 160; tr_item(a.in[IN_WIN], 5168, win_src_col(32 * nb + (lane & 31)), 64 * kb, (bf16*)(ws + WS_WIN) + (size_t)(32 * nb) * 1024 + 64 * kb, 1024, scr, lane); continue; } r -= I_IN;
        if (r < I_PA) { const int kb = r / 32, nb = r % 32; tr_item(a.in[IN_WPA], 1024, 32 * nb + (lane & 31), 64 * kb, (bf16*)(ws + WS_WPA) + (size_t)(32 * nb) * 512 + 64 * kb, 512, scr, lane); continue; } r -= I_PA;
        if (r < I_PM) { const int kb = r / 32, nb = r % 32; tr_item(a.in[IN_WPM], 1024, 32 * nb + (lane & 31), 64 * kb, (bf16*)(ws + WS_WPM) + (size_t)(32 * nb) * 512 + 64 * kb, 512, scr, lane); continue; } r -= I_PM;
        if (r < I_OUT) { const int kb = r / 32, nb = r % 32; tr_item(a.in[IN_WOUT], 1024, 32 * nb + (lane & 31), 64 * kb, (bf16*)(ws + WS_WOUT) + (size_t)(32 * nb) * 1024 + 64 * kb, 1024, scr, lane); continue; } r -= I_OUT;
        if (r < I_GU) { const int e = r / 512, q = r % 512, kb = q / 32, nb = q % 32, t = nb >> 3, bj = (nb >> 2) & 1, i0 = (nb & 3) * 32;
            const float* src = (bj ? a.in[IN_WEU] : a.in[IN_WEG]) + (size_t)e * 1024 * 512;
            tr_item(src, 512, 128 * t + i0 + (lane & 31), 64 * kb, (bf16*)(ws + WS_GU) + ((size_t)e * 1024 + 32 * nb) * 1024 + 64 * kb, 1024, scr, lane); continue; } r -= I_GU;
        { const int e = r / 256, q = r % 256, kb = q / 32, nb = q % 32;
            tr_item(a.in[IN_WED] + (size_t)e * 512 * 1024, 1024, 32 * nb + (lane & 31), 64 * kb, (bf16*)(ws + WS_DN) + ((size_t)e * 1024 + 32 * nb) * 512 + 64 * kb, 512, scr, lane); }
    }
    if (PART) return;
    { float* WTG = (float*)(ws + WS_WTG); for (int i = gw * 64 + lane; i < 36 * 1024; i += NGW * 64) { const int j = i >> 10, k = i & 1023;
        WTG[j * 1028 + k] = (j < 32 ? a.in[IN_WRE][k * 32 + j] : a.in[IN_WRG][k * 4 + (j - 32)]) * a.in[IN_GMOE][k]; } }
    { bf16* WSM = (bf16*)(ws + WS_WSM); for (int i = gw * 64 + lane; i < 48 * 1024; i += NGW * 64) { const int r = i >> 10, k = i & 1023; WSM[i] = (bf16)f2bf(a.in[IN_WIN][(size_t)k * 5168 + wsm_src_col(r)]); } }
    const float* g = a.in[IN_GMIX]; f32x4 gv[4];
#pragma unroll
    for (int j = 0; j < 4; ++j) gv[j] = *(const f32x4*)(g + 4 * lane + 256 * j);
    bf16* H = (bf16*)((unsigned char*)a.out + DO_H);
    for (int m0 = gw; m0 < T; m0 += 2 * NGW) {
        const int mA = m0, mB = (m0 + NGW < T) ? m0 + NGW : m0; const bool hasB = (m0 + NGW < T);
        const f32x4* xa = (const f32x4*)(a.in[IN_X] + (size_t)mA * D) + lane; const f32x4* xb = (const f32x4*)(a.in[IN_X] + (size_t)mB * D) + lane;
        f32x4 va[4], vb[4]; float sa = 0.f, sb = 0.f;
#pragma unroll
        for (int j = 0; j < 4; ++j) { va[j] = xa[64 * j]; vb[j] = xb[64 * j]; }
#pragma unroll
        for (int j = 0; j < 4; ++j) { sa += (va[j].x * va[j].x + va[j].y * va[j].y) + (va[j].z * va[j].z + va[j].w * va[j].w); sb += (vb[j].x * vb[j].x + vb[j].y * vb[j].y) + (vb[j].z * vb[j].z + vb[j].w * vb[j].w); }
        const float ra = rsqrtf(wave_sum(sa) * (1.f / D) + EPS), rb = rsqrtf(wave_sum(sb) * (1.f / D) + EPS);
        v2u* oa = (v2u*)(H + (size_t)mA * D) + lane; v2u* ob = (v2u*)(H + (size_t)mB * D) + lane;
#pragma unroll
        for (int j = 0; j < 4; ++j) { v2u w; w.x = pk2(va[j].x * ra * gv[j].x, va[j].y * ra * gv[j].y); w.y = pk2(va[j].z * ra * gv[j].z, va[j].w * ra * gv[j].w); oa[64 * j] = w; }
        if (hasB) {
#pragma unroll
        for (int j = 0; j < 4; ++j) { v2u w; w.x = pk2(vb[j].x * rb * gv[j].x, vb[j].y * rb * gv[j].y); w.y = pk2(vb[j].z * rb * gv[j].z, vb[j].w * rb * gv[j].w); ob[64 * j] = w; } }
    }
}

__device__ __forceinline__ const bf16* proj_tile(const Args& a, int tile) { return (const bf16*)(a.ws + WS_PROJ + (size_t)tile * PROJ_TILE); }
#define DPPF(x_, ctrl_) __int_as_float(__builtin_amdgcn_update_dpp(0, __float_as_int(x_), ctrl_, 0xF, 0xF, true))
__device__ __forceinline__ void p2_prep(const Args& a, const Ctx& c) {
    const int lane = c.lane, gw = c.vcu * NWAVES + c.wave, NGW = c.G * NWAVES;
    float invf = 0.f;
    if (lane < 8) invf = (float)pow(500000.0, -(double)lane / 8.0); else if (lane < 12) invf = (float)pow(500000.0, -(double)(lane - 8) / 4.0);
    float gq[8], gk[8];
#pragma unroll
    for (int i = 0; i < 8; ++i) { gq[i] = a.in[IN_GQ][8 * (lane & 7) + i]; gk[i] = a.in[IN_GK][8 * (lane & 7) + i]; }
    const int* pos = (const int*)a.in[IN_POS];
    unsigned char* dout = (unsigned char*)a.out;
    bf16* AQN = (bf16*)(dout + DO_AQN); bf16* KN = (bf16*)(dout + DO_KN); bf16* IQR = (bf16*)(dout + DO_IQR); bf16* IKR = (bf16*)(dout + DO_IKR);
    { const bf16* Hh = (const bf16*)(dout + DO_H); const bf16* WSM = (const bf16*)(a.ws + WS_WSM); bf16* SMB = (bf16*)(dout + DO_SMB);
      const int row = lane & 15, kg = lane >> 4;
      const float invfk = (float)pow(500000.0, -(double)(lane & 3) / 4.0);
      for (int tile = gw; tile < T / 16; tile += NGW) { const int t0 = tile * 16;
          f32x4 acc[3];
#pragma unroll
          for (int ct = 0; ct < 3; ++ct) acc[ct] = (f32x4){0.f, 0.f, 0.f, 0.f};
          const bf16* ap = Hh + (size_t)(t0 + row) * 1024 + 8 * kg; const bf16* bp = WSM + (size_t)row * 1024 + 8 * kg;
#pragma unroll 8
          for (int ks = 0; ks < 32; ++ks) { const bf16x8 av = *(const bf16x8*)(ap + 32 * ks);
#pragma unroll
              for (int ct = 0; ct < 3; ++ct) acc[ct] = __builtin_amdgcn_mfma_f32_16x16x32_bf16(av, *(const bf16x8*)(bp + (size_t)ct * 16 * 1024 + 32 * ks), acc[ct], 0, 0, 0); }
          const int col = lane & 15;
#pragma unroll
          for (int r = 0; r < 4; ++r) { const int t = t0 + 4 * kg + r;
              const float angk = (float)pos[t] * invfk;
              const double revk = (double)angk * 0.15915494309189535; const float frk = (float)(revk - __builtin_rint(revk));
              const float ck = __builtin_amdgcn_cosf(frk), sk = __builtin_amdgcn_sinf(frk);
              const float v0 = acc[0][r], pr = __shfl_xor(v0, 4);
              const float o0 = (col < 4) ? (v0 * ck - pr * sk) : ((col < 8) ? (v0 * ck + pr * sk) : v0);
              IKR[(size_t)t * 32 + col] = (bf16)f2bf(o0); IKR[(size_t)t * 32 + 16 + col] = (bf16)f2bf(acc[1][r]);
              SMB[(size_t)t * 16 + col] = (bf16)f2bf(acc[2][r]); } } }
    const int l7 = lane & 7;
    const int aqcol = (lane >> 3) * 64 + 8 * l7, akcol = ((lane & 15) >> 3) * 64 + 8 * l7;
    const bf16* aqsrc = proj_tile(a, TL_AQ + (aqcol >> 8)) + (aqcol & 255); const bf16* aksrc = proj_tile(a, TL_KV) + akcol; const bf16* iqsrc = proj_tile(a, TL_IQ) + 4 * lane;
#define P2_LOADROW(t_, P_, A_, K_, Q_) do { const int tt_ = (t_) < T ? (t_) : T - 1; P_ = pos[tt_]; A_ = *(const v4u*)(aqsrc + (size_t)tt_ * 256); K_ = *(const v4u*)(aksrc + (size_t)tt_ * 256); Q_ = *(const v2u*)(iqsrc + (size_t)tt_ * 256); } while (0)
#define P2_DOROW(t, P_, A_, K_, Q_) do { \
        const float ang = (float)(P_) * invf; \
        const double rev = (double)ang * 0.15915494309189535; const float frv = (float)(rev - __builtin_rint(rev)); \
        float cs = __builtin_amdgcn_cosf(frv), sn = __builtin_amdgcn_sinf(frv); \
        float ca[8], sa[8], ci[4], si[4]; \
        _Pragma("unroll") for (int i = 0; i < 8; ++i) { ca[i] = __int_as_float(__builtin_amdgcn_readlane(__float_as_int(cs), i)); sa[i] = __int_as_float(__builtin_amdgcn_readlane(__float_as_int(sn), i)); } \
        _Pragma("unroll") for (int i = 0; i < 4; ++i) { ci[i] = __int_as_float(__builtin_amdgcn_readlane(__float_as_int(cs), 8 + i)); si[i] = __int_as_float(__builtin_amdgcn_readlane(__float_as_int(sn), 8 + i)); } \
        { float f[8]; unpack8(A_, f); float ss = 0.f; \
          _Pragma("unroll") for (int i = 0; i < 8; ++i) ss += f[i] * f[i]; \
          ss += DPPF(ss, 0xB1); ss += DPPF(ss, 0x4E); ss += DPPF(ss, 0x141); \
          const float r = rsqrtf(ss * (1.f / 64.f) + EPS); \
          _Pragma("unroll") for (int i = 0; i < 8; ++i) f[i] = f[i] * r * gq[i]; \
          float o[8]; \
          _Pragma("unroll") for (int i = 0; i < 8; ++i) { const float p = DPPF(f[i], 0xB1); o[i] = (l7 == 0) ? (f[i] * ca[i] - p * sa[i]) : ((l7 == 1) ? (f[i] * ca[i] + p * sa[i]) : f[i]); o[i] *= 0.125f * 1.4426950408889634f; } \
          *(v4u*)(AQN + (size_t)(t) * 512 + aqcol) = pack8(o); } \
        { float f[8]; unpack8(K_, f); float ss = 0.f; \
          _Pragma("unroll") for (int i = 0; i < 8; ++i) ss += f[i] * f[i]; \
          ss += DPPF(ss, 0xB1); ss += DPPF(ss, 0x4E); ss += DPPF(ss, 0x141); \
          const float r = rsqrtf(ss * (1.f / 64.f) + EPS); \
          _Pragma("unroll") for (int i = 0; i < 8; ++i) f[i] = f[i] * r * gk[i]; \
          float o[8]; \
          _Pragma("unroll") for (int i = 0; i < 8; ++i) { const float p = DPPF(f[i], 0xB1); o[i] = (l7 == 0) ? (f[i] * ca[i] - p * sa[i]) : ((l7 == 1) ? (f[i] * ca[i] + p * sa[i]) : f[i]); } \
          if (lane < 16) *(v4u*)(KN + (size_t)(t) * 128 + akcol) = pack8(o); } \
        { const v2u rw = Q_; \
          float f[4] = {bf2f(rw.x & 0xffffu), bf2f(rw.x >> 16), bf2f(rw.y & 0xffffu), bf2f(rw.y >> 16)}; float o[4]; \
          _Pragma("unroll") for (int i = 0; i < 4; ++i) { const float p = DPPF(f[i], 0xB1); o[i] = (l7 == 0) ? (f[i] * ci[i] - p * si[i]) : ((l7 == 1) ? (f[i] * ci[i] + p * si[i]) : f[i]); } \
          v2u w; w.x = pk2(o[0], o[1]); w.y = pk2(o[2], o[3]); *(v2u*)(IQR + (size_t)(t) * 256 + 4 * lane) = w; } } while (0)
    { int pA, pB; v4u aA, aB, kA, kB; v2u qA, qB;
      P2_LOADROW(gw, pA, aA, kA, qA);
#pragma unroll 1
      for (int t = gw; t < T; t += 2 * NGW) {
          P2_LOADROW(t + NGW, pB, aB, kB, qB);
          P2_DOROW(t, pA, aA, kA, qA);
          P2_LOADROW(t + 2 * NGW, pA, aA, kA, qA);
          if (t + NGW < T) P2_DOROW(t + NGW, pB, aB, kB, qB);
      } }
#undef P2_LOADROW
#undef P2_DOROW
}
constexpr int ML_QS = 0, ML_KS = 17408, ML_HS = 0;
constexpr int ML_KWT = 34816;
constexpr int ML_VT = 53248;
constexpr int ML_SW = 73984;
constexpr int ML_CT = 83200;
constexpr int ML_GA = 122368;
constexpr int ML_CW = ML_GA + 1024;
constexpr int ML_END = ML_CW + (1024 + 384) * 4;
static_assert(ML_END <= MISC_OFF, "mLSTM LDS map");
constexpr size_t ML_STATE_BYTES = 8 * 9 * 64 * 16;
__device__ __forceinline__ bf16x8 lds_frag(const LAS unsigned char* base, int stride_b, int row0, int kb, int lane) {
    return *(const LAS bf16x8*)(base + (row0 + (lane & 15)) * stride_b + kb + (lane >> 4) * 16);
}
__device__ __forceinline__ bf16x8 lds_frag_sw(const LAS unsigned char* base, int row0, int ks, int lane) {
    const int row = row0 + (lane & 15); return *(const LAS bf16x8*)(base + row * 144 + 16 * (((ks * 4 + (lane >> 4)) + (row >> 3)) & 7));
}
#define MFMA16(a_, b_, c_) __builtin_amdgcn_mfma_f32_16x16x32_bf16(a_, b_, c_, 0, 0, 0)
template <int MODE>
__device__ __forceinline__ void mlstm_unit(const Args& a, const Ctx& c, int b, int h, int g) {
    const int tid = c.tid, wave = c.wave; LAS unsigned char* lds = c.lds;
#define ML_LAUNDER() int tv_ = tid; asm volatile("" : "+v"(tv_)); const int lane = tv_ & 63, seg = tv_ & 15, r2 = (tv_ >> 4) * 2; (void)lane; (void)seg; (void)r2
    const bf16* PQ = proj_tile(a, TL_MQ + (h >> 1)) + (h & 1) * 128;
    const bf16* PK = proj_tile(a, TL_MK + (h >> 1)) + (h & 1) * 128;
    const bf16* PV = proj_tile(a, TL_MV + (h >> 1)) + (h & 1) * 128;
    const bf16* PO = proj_tile(a, TL_MO + (h >> 1)) + (h & 1) * 128;
    const bf16* PS = (const bf16*)((unsigned char*)a.out + DO_SMB);
    bf16* YML = (bf16*)((unsigned char*)a.out + DO_YML);
    unsigned char* STB = a.ws + WS_MLST; float* MST = (float*)(a.ws + WS_MLST + 256 * ML_STATE_BYTES);
    LAS float* GAa = (LAS float*)(lds + ML_GA); LAS float* GAm = GAa + 64; LAS float* GAw = GAa + 128; LAS float* GAe = GAa + 192;
    LAS float* CWQ = (LAS float*)(lds + ML_CW); LAS float* CWK = CWQ + 512; LAS float* CBQ = CWQ + 1024; LAS float* CBK = CBQ + 128; LAS float* GN = CBK + 128;
    LAS bf16* VTs = (LAS bf16*)(lds + ML_VT);
    { const float* wc = a.in[IN_WCONV]; const int j = tid >> 7, d = tid & 127;
      CWQ[tid] = wc[j * 1024 + h * 128 + d]; CWK[tid] = wc[j * 1024 + 512 + h * 128 + d];
      if (tid < 128) { CBQ[tid] = a.in[IN_BCONV][h * 128 + tid]; CBK[tid] = a.in[IN_BCONV][512 + h * 128 + tid]; GN[tid] = a.in[IN_GML][h * 128 + tid]; } }
    for (int i = tid; i < 16 * 64; i += 512) { const int r = i >> 6, cc = i & 63; VTs[(128 + r) * 72 + cc] = (r == 0) ? (bf16)0x3F80 : (bf16)0; }
    const float big = a.in[IN_BI][h], bfg = a.in[IN_BF][h];
    const int slot0 = (b * 4 + h) * 8;
    f32x4 cacc[9];
    float m_st = 0.f;
    if (MODE == 1 && g > 0) { ML_LAUNDER();
        const f32x4* sp = (const f32x4*)(STB + (size_t)(slot0 + g) * ML_STATE_BYTES) + wave * 576 + lane;
#pragma unroll
        for (int i = 0; i < 9; ++i) cacc[i] = sp[64 * i];
        m_st = MST[slot0 + g];
#pragma unroll
        for (int ee = 0; ee < 9; ++ee) { v2u w; w.x = pk2(cacc[ee][0], cacc[ee][1]); w.y = pk2(cacc[ee][2], cacc[ee][3]);
            *(LAS v2u*)(lds + ML_CT + (ee * 16 + (lane & 15)) * 272 + (wave * 16 + 4 * (lane >> 4)) * 2) = w; }
    } else {
#pragma unroll
        for (int i = 0; i < 9; ++i) cacc[i] = (f32x4){0.f, 0.f, 0.f, 0.f};
        for (int i = tid; i < 144 * 136 / 2; i += 512) ((LAS unsigned*)(lds + ML_CT))[i] = 0u;
    }
    const size_t tb = (size_t)b * SEQ;
    const char* bq = (const char*)(PQ + tb * 256); const char* bk = (const char*)(PK + tb * 256); const char* bv = (const char*)(PV + tb * 256); const char* bo = (const char*)(PO + tb * 256); const char* bs = (const char*)(PS + tb * 16);
    v4u rq[5], rk[5], rv[2]; unsigned short gi = 0, gf = 0;
#define ML_LOAD(kc) do { _Pragma("unroll") for (int j_ = 0; j_ < 5; ++j_) { const int rr_ = 64 * (kc) + r2 - 3 + j_; const unsigned o_ = (unsigned)((rr_ < 0 ? 0 : rr_) * 512 + seg * 16); \
            v4u q_ = (v4u){0u, 0u, 0u, 0u}; if (MODE == 1) q_ = *(const v4u*)(bq + o_); v4u k_ = *(const v4u*)(bk + o_); if (rr_ < 0) { q_ = (v4u){0u, 0u, 0u, 0u}; k_ = q_; } rq[j_] = q_; rk[j_] = k_; } \
        _Pragma("unroll") for (int i_ = 0; i_ < 2; ++i_) rv[i_] = *(const v4u*)(bv + (unsigned)((64 * (kc) + r2 + i_) * 512 + seg * 16)); \
        gi = *(const unsigned short*)(bs + (unsigned)((64 * (kc) + lane) * 32 + (8 + h) * 2)); gf = *(const unsigned short*)(bs + (unsigned)((64 * (kc) + lane) * 32 + (12 + h) * 2)); } while (0)
    const int kc0 = (MODE == 1) ? 8 * g : 0, kc1 = (MODE == 1) ? 8 * g + 8 : 56;
    { ML_LAUNDER(); ML_LOAD(kc0); }
    __syncthreads();
#pragma unroll 1
    for (int kc = kc0; kc < kc1; ++kc) {
        float wkv, decay, m_new;
        if (MODE == 0 && kc > 0 && (kc & 7) == 0) { ML_LAUNDER();
            f32x4* sp = (f32x4*)(STB + (size_t)(slot0 + (kc >> 3)) * ML_STATE_BYTES) + wave * 576 + lane;
#pragma unroll
            for (int i = 0; i < 9; ++i) sp[64 * i] = cacc[i];
            if (tid == 0) MST[slot0 + (kc >> 3)] = m_st; }
        { ML_LAUNDER();
        const float fpre = bf2f(gf) + bfg, lf = fminf(fpre, 0.f) - log1pf(__expf(-fabsf(fpre)));
        const float ig = bf2f(gi) + big;
#define ML_SHR(x_, n_, id_) __int_as_float(__builtin_amdgcn_update_dpp(__float_as_int(id_), __float_as_int(x_), 0x110 + (n_), 0xF, 0xF, false))
        float bc = lf;
        bc += ML_SHR(bc, 1, 0.f); bc += ML_SHR(bc, 2, 0.f); bc += ML_SHR(bc, 4, 0.f); bc += ML_SHR(bc, 8, 0.f);
        { const float t0 = __int_as_float(__builtin_amdgcn_readlane(__float_as_int(bc), 15)), t1 = __int_as_float(__builtin_amdgcn_readlane(__float_as_int(bc), 31)), t2 = __int_as_float(__builtin_amdgcn_readlane(__float_as_int(bc), 47));
          bc += (lane >= 48) ? (t0 + t1 + t2) : ((lane >= 32) ? (t0 + t1) : ((lane >= 16) ? t0 : 0.f)); }
        const float av = ig - bc; float Ac = av;
        Ac = fmaxf(Ac, ML_SHR(Ac, 1, -3.0e38f)); Ac = fmaxf(Ac, ML_SHR(Ac, 2, -3.0e38f)); Ac = fmaxf(Ac, ML_SHR(Ac, 4, -3.0e38f)); Ac = fmaxf(Ac, ML_SHR(Ac, 8, -3.0e38f));
        { const float t0 = __int_as_float(__builtin_amdgcn_readlane(__float_as_int(Ac), 15)), t1 = __int_as_float(__builtin_amdgcn_readlane(__float_as_int(Ac), 31)), t2 = __int_as_float(__builtin_amdgcn_readlane(__float_as_int(Ac), 47));
          const float m01 = fmaxf(t0, t1), m012 = fmaxf(m01, t2);
          Ac = fmaxf(Ac, (lane >= 48) ? m012 : ((lane >= 32) ? m01 : ((lane >= 16) ? t0 : -3.0e38f))); }
#undef ML_SHR
        const float mA = fmaxf(m_st, Ac), Mk = __int_as_float(__builtin_amdgcn_readlane(__float_as_int(mA), 63)), blast = __int_as_float(__builtin_amdgcn_readlane(__float_as_int(bc), 63));
        wkv = __expf(av - Mk); decay = __expf(m_st - Mk); m_new = blast + Mk;
        if (MODE == 1 && wave == 0) { GAa[lane] = av; GAm[lane] = mA; GAw[lane] = __expf(m_st - mA); GAe[lane] = __expf(-(bc + mA)); } }
        { ML_LAUNDER(); float kw_[2][8];
#pragma unroll
          for (int i = 0; i < 2; ++i) { const int t = r2 + i; const float wkt = __shfl(wkv, t);
            float aq_[8], ak_[8];
            { const f32x4 b0 = *(const LAS f32x4*)(CBQ + seg * 8), b1 = *(const LAS f32x4*)(CBQ + seg * 8 + 4), c0 = *(const LAS f32x4*)(CBK + seg * 8), c1 = *(const LAS f32x4*)(CBK + seg * 8 + 4);
              aq_[0] = b0[0]; aq_[1] = b0[1]; aq_[2] = b0[2]; aq_[3] = b0[3]; aq_[4] = b1[0]; aq_[5] = b1[1]; aq_[6] = b1[2]; aq_[7] = b1[3];
              ak_[0] = c0[0]; ak_[1] = c0[1]; ak_[2] = c0[2]; ak_[3] = c0[3]; ak_[4] = c1[0]; ak_[5] = c1[1]; ak_[6] = c1[2]; ak_[7] = c1[3]; }
#pragma unroll
            for (int j = 0; j < 4; ++j) { float fk_[8]; unpack8(rk[i + j], fk_);
                const f32x4 x0 = *(const LAS f32x4*)(CWK + j * 128 + seg * 8), x1 = *(const LAS f32x4*)(CWK + j * 128 + seg * 8 + 4);
#pragma unroll
                for (int e = 0; e < 4; ++e) { ak_[e] += x0[e] * fk_[e]; ak_[4 + e] += x1[e] * fk_[4 + e]; }
                if (MODE == 1) { float fq_[8]; unpack8(rq[i + j], fq_);
                    const f32x4 w0 = *(const LAS f32x4*)(CWQ + j * 128 + seg * 8), w1 = *(const LAS f32x4*)(CWQ + j * 128 + seg * 8 + 4);
#pragma unroll
                    for (int e = 0; e < 4; ++e) { aq_[e] += w0[e] * fq_[e]; aq_[4 + e] += w1[e] * fq_[4 + e]; } } }
#pragma unroll
            for (int e = 0; e < 8; ++e) { ak_[e] = ak_[e] * sigm(ak_[e]) * 0.08838834764831845f; kw_[i][e] = ak_[e] * wkt; }
            if (MODE == 1) {
#pragma unroll
                for (int e = 0; e < 8; ++e) aq_[e] = aq_[e] * sigm(aq_[e]);
                *(LAS v4u*)(lds + ML_QS + t * 272 + seg * 16) = pack8(aq_);
                *(LAS v4u*)(lds + ML_KS + t * 272 + seg * 16) = pack8(ak_); } }
          const unsigned va[4] = {rv[0].x, rv[0].y, rv[0].z, rv[0].w}, vb[4] = {rv[1].x, rv[1].y, rv[1].z, rv[1].w};
          const int swo = 16 * (((r2 >> 3) + seg) & 7) + 2 * (r2 & 7);
#pragma unroll
          for (int e = 0; e < 8; ++e) { const int ro = (seg * 8 + e) * 144 + swo;
              *(LAS unsigned*)(lds + ML_KWT + ro) = pk2(kw_[0][e], kw_[1][e]);
              const unsigned lo = (e & 1) ? (va[e >> 1] >> 16) : (va[e >> 1] & 0xffffu), hi = (e & 1) ? (vb[e >> 1] >> 16) : (vb[e >> 1] & 0xffffu);
              *(LAS unsigned*)(lds + ML_VT + ro) = lo | (hi << 16); }
        if (kc + 1 < kc1) ML_LOAD(kc + 1); }
        __syncthreads();
        f32x4 hacc[5]; unsigned mo_r[8];
        const int tt = wave & 3, t0 = tt * 16, ne = (wave < 4) ? 5 : 4, e_first = (wave < 4) ? 0 : 5;
        if (MODE == 1) {
        { ML_LAUNDER(); const int tq = t0 + (lane & 15);
        bf16x8 qf[4];
#pragma unroll
        for (int ks = 0; ks < 4; ++ks) qf[ks] = lds_frag(lds + ML_QS, 272, t0, ks * 64, lane);
        const float mAt = GAm[tq], wit = GAw[tq];
#pragma unroll
        for (int si = 0; si < 2; ++si) { const int ss = 2 * (wave >> 2) + si, s0 = ss * 16; f32x4 sacc = (f32x4){0.f, 0.f, 0.f, 0.f};
            if (ss <= tt) {
#pragma unroll
                for (int ks = 0; ks < 4; ++ks) sacc = MFMA16(lds_frag(lds + ML_KS, 272, s0, ks * 64, lane), qf[ks], sacc);
#pragma unroll
                for (int r = 0; r < 4; ++r) { const int s = s0 + 4 * (lane >> 4) + r; sacc[r] = (s <= tq) ? sacc[r] * __expf(GAa[s] - mAt) : 0.f; } }
            v2u w; w.x = pk2(sacc[0], sacc[1]); w.y = pk2(sacc[2], sacc[3]);
            *(LAS v2u*)(lds + ML_SW + tq * 144 + s0 * 2 + (lane >> 4) * 8) = w; }
#pragma unroll
        for (int i = 0; i < 5; ++i) { hacc[i] = (f32x4){0.f, 0.f, 0.f, 0.f};
            if (i < ne) {
#pragma unroll
                for (int ks = 0; ks < 4; ++ks) hacc[i] = MFMA16(lds_frag(lds + ML_CT, 272, (e_first + i) * 16, ks * 64, lane), qf[ks], hacc[i]);
                hacc[i] = hacc[i] * wit; } }
#pragma unroll
        for (int i = 0; i < 8; ++i) mo_r[i] = *(const unsigned*)(bo + (unsigned)((64 * kc + 8 * wave + i) * 512 + 4 * lane)); }
        __syncthreads();
        { ML_LAUNDER(); const int tq = t0 + (lane & 15); bf16x8 swf[2];
#pragma unroll
          for (int ks = 0; ks < 2; ++ks) swf[ks] = lds_frag(lds + ML_SW, 144, t0, ks * 64, lane);
#pragma unroll
          for (int i = 0; i < 5; ++i) if (i < ne) { const int ee = e_first + i;
#pragma unroll
              for (int ks = 0; ks < 2; ++ks) hacc[i] = MFMA16(lds_frag_sw(lds + ML_VT, ee * 16, ks, lane), swf[ks], hacc[i]);
              if (ee < 8) *(LAS f32x4*)(lds + ML_HS + tq * 528 + (ee * 16 + 4 * (lane >> 4)) * 4) = hacc[i];
              else if ((lane >> 4) == 0) *(LAS float*)(lds + ML_HS + tq * 528 + 128 * 4) = hacc[i][0]; } }
        }
        { ML_LAUNDER(); const int d0 = wave * 16; bf16x8 kwf[2];
#pragma unroll
          for (int ks = 0; ks < 2; ++ks) kwf[ks] = lds_frag_sw(lds + ML_KWT, d0, ks, lane);
#pragma unroll
          for (int ee = 0; ee < 9; ++ee) { cacc[ee] = cacc[ee] * decay;
#pragma unroll
              for (int ks = 0; ks < 2; ++ks) cacc[ee] = MFMA16(kwf[ks], lds_frag_sw(lds + ML_VT, ee * 16, ks, lane), cacc[ee]);
              if (MODE == 1) { v2u w; w.x = pk2(cacc[ee][0], cacc[ee][1]); w.y = pk2(cacc[ee][2], cacc[ee][3]);
                  *(LAS v2u*)(lds + ML_CT + (ee * 16 + (lane & 15)) * 272 + (d0 + 4 * (lane >> 4)) * 2) = w; } } }
        __syncthreads();
        if (MODE == 1) {
        { ML_LAUNDER();
#pragma unroll
        for (int i = 0; i < 8; ++i) { const int t = 8 * wave + i;
            const f32x2 nv = *(const LAS f32x2*)(lds + ML_HS + t * 528 + lane * 8); const float den = *(const LAS float*)(lds + ML_HS + t * 528 + 512);
            const float dd = fmaxf(fabsf(den), GAe[t]); const float h0 = nv.x / dd, h1 = nv.y / dd;
            const float r = rsqrtf(wave_sum(h0 * h0 + h1 * h1) * (1.f / 128.f) + EPS);
            const float y0 = h0 * r * GN[2 * lane] * sigm(bf2f(mo_r[i] & 0xffffu)), y1 = h1 * r * GN[2 * lane + 1] * sigm(bf2f(mo_r[i] >> 16));
            *(unsigned*)(YML + (tb + 64 * kc + t) * 512 + h * 128 + 2 * lane) = pk2(y0, y1); } }
        __syncthreads();
        }
        m_st = m_new;
    }
    if (MODE == 0) { ML_LAUNDER();
        f32x4* sp = (f32x4*)(STB + (size_t)(slot0 + 7) * ML_STATE_BYTES) + wave * 576 + lane;
#pragma unroll
        for (int i = 0; i < 9; ++i) sp[64 * i] = cacc[i];
        if (tid == 0) MST[slot0 + 7] = m_st; }
#undef ML_LOAD
#undef ML_LAUNDER
}
constexpr int AT_HIST = 0;
constexpr int AT_HROW = 2049;
constexpr int AT_SEL = 131072 + 256;
constexpr int AT_MROW = 129;
constexpr int AT_SM = AT_SEL + 8448;
static_assert(AT_SM + 256 <= MISC_OFF, "attention LDS map");
__device__ __forceinline__ unsigned score_key(float s) { unsigned u = __float_as_uint(s + 0.0f); return (u & 0x80000000u) ? ~u : (u | 0x80000000u); }
__device__ __forceinline__ unsigned wave_suffix_sum(unsigned v, int lane) {
#define AT_SHL(x_, n_) ((unsigned)__builtin_amdgcn_update_dpp(0, (int)(x_), 0x100 + (n_), 0xF, 0xF, false))
    v += AT_SHL(v, 1); v += AT_SHL(v, 2); v += AT_SHL(v, 4); v += AT_SHL(v, 8);
#undef AT_SHL
    const unsigned t1 = (unsigned)__builtin_amdgcn_readlane((int)v, 16), t2 = (unsigned)__builtin_amdgcn_readlane((int)v, 32), t3 = (unsigned)__builtin_amdgcn_readlane((int)v, 48);
    return v + ((lane < 16) ? (t1 + t2 + t3) : ((lane < 32) ? (t2 + t3) : ((lane < 48) ? t3 : 0u)));
}
template <int NK> __device__ __forceinline__ void at_resolve(const LAS unsigned long long* cand, LAS unsigned* mask, int m, int nd, int lane) {
    unsigned long long cv[NK];
#pragma unroll
    for (int k = 0; k < NK; ++k) { const int i = 64 * k + lane; unsigned long long x = 0ull; if (i < m) x = cand[i]; cv[k] = (i < m) ? ((((x >> 32) & 0xFFFFFull) << 16) | (x & 0xFFFFull)) : 0ull; }
    unsigned long long T = 0ull;
#pragma unroll 1
    for (int bit = 35; bit >= 16; --bit) { const unsigned long long test = T | (1ull << bit); int cge = 0;
#pragma unroll
        for (int k = 0; k < NK; ++k) cge += __popcll(__ballot(cv[k] >= test));
        if (cge >= nd) T = test; }
    int g = 0, t = 0;
#pragma unroll
    for (int k = 0; k < NK; ++k) { g += __popcll(__ballot(cv[k] >= T + 0x10000ull)); t += __popcll(__ballot(cv[k] >= T)); }
    t -= g;
    if (t > nd - g) {
#pragma unroll 1
        for (int bit = 15; bit >= 0; --bit) { const unsigned long long test = T | (1ull << bit); int cge = 0;
#pragma unroll
            for (int k = 0; k < NK; ++k) cge += __popcll(__ballot(cv[k] >= test));
            if (cge >= nd) T = test; } }
#pragma unroll
    for (int k = 0; k < NK; ++k) if (cv[k] >= T && cv[k] != 0ull) { const unsigned key = 0xFFFFu - (unsigned)(cv[k] & 0xFFFFull);
        __hip_atomic_fetch_or(&mask[key >> 5], 1u << (key & 31u), __ATOMIC_RELAXED, __HIP_MEMORY_SCOPE_WORKGROUP); }
}
__device__ __forceinline__ void attn_unit(const Args& a, const Ctx& c, int b, int qt, float cshift) {
    const int tid = c.tid, wave = c.wave; LAS unsigned char* lds = c.lds;
#define AT_LAUNDER() int tv_ = tid; asm volatile("" : "+v"(tv_)); const int lane = tv_ & 63, qi = tv_ & 15, fq = (tv_ >> 4) & 3; (void)lane; (void)qi; (void)fq
    const int q0 = qt * 16, ch = q0 >> 6, n = 64 * (ch + 1), ntiles = n >> 4;
    const size_t tb = (size_t)b * SEQ;
    unsigned char* dout = (unsigned char*)a.out;
    const bf16* AQN = (const bf16*)(dout + DO_AQN); const bf16* KN = (const bf16*)(dout + DO_KN); const bf16* IQR = (const bf16*)(dout + DO_IQR); const bf16* IKR = (const bf16*)(dout + DO_IKR);
    bf16* YATT = (bf16*)(dout + DO_YATT);
    const bf16* VB = proj_tile(a, TL_KV); const bf16* PS = (const bf16*)(dout + DO_SMB);
    LAS unsigned* HIST = (LAS unsigned*)(lds + AT_HIST);
    LAS unsigned long long* CAND = (LAS unsigned long long*)(lds + AT_HIST);
    LAS unsigned* MASK = (LAS unsigned*)(lds + AT_SEL);
    LAS int* SM = (LAS int*)(lds + AT_SM);
    float* SC = (blockIdx.x < 240) ? (float*)(a.ws + WS_SC) + (size_t)blockIdx.x * (16 * 4096) : (float*)(a.ws + WS_SC2) + (size_t)(blockIdx.x - 240) * (16 * 4096);
#ifndef DBG_REP_SEL
#define DBG_REP_SEL 1
#endif
#ifndef DBG_REP_DENSE
#define DBG_REP_DENSE 1
#endif
#pragma unroll 1
    for (int rsel = 0; rsel < DBG_REP_SEL; ++rsel) {
    if (n > 256) {
        for (int i = tid; i < 8192 + 4; i += 512) ((LAS v4u*)HIST)[i] = (v4u){0u, 0u, 0u, 0u};
        if (tid < 64) SM[tid] = 0;
        for (int i = tid; i < 16 * AT_MROW; i += 512) MASK[i] = 0u;
        bf16x8 qf[8]; float wv[8];
        { AT_LAUNDER();
        const size_t trow = tb + q0 + qi;
#pragma unroll
        for (int h = 0; h < 8; ++h) qf[h] = *(const bf16x8*)(IQR + trow * 256 + h * 32 + 8 * fq);
        { float t8[8]; unpack8(*(const v4u*)(PS + trow * 16), t8);
#pragma unroll
          for (int h = 0; h < 8; ++h) wv[h] = t8[h] * 0.0625f; } }
        __syncthreads();
#define AT_LOADK(kt_) (*(const bf16x8*)(IKR + (tb + (size_t)(kt_) * 16 + qi) * 32 + 8 * fq))
#define AT_SCORES(kf_, sc_) do { \
        _Pragma("unroll") for (int r_ = 0; r_ < 4; ++r_) sc_[r_] = 0.f; \
        _Pragma("unroll") for (int h_ = 0; h_ < 8; ++h_) { const f32x4 d_ = MFMA16(kf_, qf[h_], ((f32x4){0.f, 0.f, 0.f, 0.f})); \
            _Pragma("unroll") for (int r_ = 0; r_ < 4; ++r_) { const int di_ = __float_as_int(d_[r_]); sc_[r_] = __builtin_fmaf(wv[h_], __int_as_float(di_ > 0 ? di_ : 0), sc_[r_]); } } } while (0)
        const int cnt = (ntiles - wave + 7) >> 3;
#ifndef DBG_RA
#define DBG_RA 1
#endif
#pragma unroll 1
        for (int rA = 0; rA < DBG_RA; ++rA) { if (rA) { for (int i = tid; i < 8192 + 4; i += 512) ((LAS v4u*)HIST)[i] = (v4u){0u, 0u, 0u, 0u}; __syncthreads(); }
#define AT_LOADG(dst_, i0_) do { _Pragma("unroll") for (int j_ = 0; j_ < 8; ++j_) { int kt_ = wave + 8 * ((i0_) + j_); kt_ = kt_ < ntiles ? kt_ : ntiles - 1; dst_[j_] = AT_LOADK(kt_); } } while (0)
#define AT_P1GROUP(buf_, base_) do { _Pragma("unroll") for (int j2 = 0; j2 < 8; ++j2) { const bool valid = ((base_) + j2 < cnt); const int kt = wave + 8 * ((base_) + j2); float sc[4]; AT_SCORES(buf_[j2], sc); \
                if (valid) *(f32x4*)(SC + qi * 4096 + kt * 16 + 4 * fq) = (f32x4){sc[0], sc[1], sc[2], sc[3]}; \
                _Pragma("unroll") for (int r = 0; r < 4; ++r) { const unsigned bin = score_key(sc[r]) >> 20; \
                    __hip_atomic_fetch_add(&HIST[qi * AT_HROW + (bin >> 1)], valid ? (1u << ((bin & 1u) * 16)) : 0u, __ATOMIC_RELAXED, __HIP_MEMORY_SCOPE_WORKGROUP); } } } while (0)
        { AT_LAUNDER(); bf16x8 ka[8], kb[8]; AT_LOADG(ka, 0);
#pragma unroll 1
          for (int i0 = 0; i0 < cnt; i0 += 16) {
            AT_LOADG(kb, i0 + 8);
            AT_P1GROUP(ka, i0);
            AT_LOADG(ka, i0 + 16);
            AT_P1GROUP(kb, i0 + 8); } }
#undef AT_P1GROUP
        __syncthreads();
        }
#ifndef DBG_RB
#define DBG_RB 1
#endif
#pragma unroll 1
        for (int rB = 0; rB < DBG_RB; ++rB) {
#pragma unroll 1
        for (int j = 0; j < 2; ++j) { AT_LAUNDER(); const int q = 2 * wave + j; unsigned tot = 0;
            for (int i = 0; i < 32; ++i) { const unsigned w = HIST[q * AT_HROW + 32 * lane + ((i + lane) & 31)]; tot += (w & 0xffffu) + (w >> 16); }
            const unsigned suf = wave_suffix_sum(tot, lane);
            const unsigned long long mk = __ballot(suf >= 256u); const int L = 63 - __clzll((long long)mk);
            const unsigned above_L = (unsigned)__builtin_amdgcn_readlane((int)(suf - tot), L);
            const unsigned w2 = HIST[q * AT_HROW + 32 * L + (lane >> 1)]; const unsigned cb = (lane & 1) ? (w2 >> 16) : (w2 & 0xffffu);
            const unsigned sfx = wave_suffix_sum(cb, lane);
            const unsigned long long mk2 = __ballot(above_L + sfx >= 256u); const int l2 = 63 - __clzll((long long)mk2);
            if (lane == l2) { SM[q] = 64 * L + l2; SM[16 + q] = (int)(256u - (above_L + sfx - cb)); } }
        __syncthreads();
        }
#ifndef DBG_RC
#define DBG_RC 1
#endif
#pragma unroll 1
        for (int rC = 0; rC < DBG_RC; ++rC) { if (rC) { if (tid < 16) SM[48 + tid] = 0; __syncthreads(); }
        { AT_LAUNDER(); const int Bq = SM[qi]; f32x4 scur[8];
#define AT_LOADS(dst_, i0_) do { _Pragma("unroll") for (int j_ = 0; j_ < 8; ++j_) { int kt_ = wave + 8 * ((i0_) + j_); kt_ = kt_ < ntiles ? kt_ : ntiles - 1; dst_[j_] = *(const f32x4*)(SC + qi * 4096 + kt_ * 16 + 4 * fq); } } while (0)
#define AT_P2GROUP(buf_, base_) do { _Pragma("unroll") for (int j2 = 0; j2 < 8; ++j2) { const bool valid = ((base_) + j2 < cnt); const int kt = wave + 8 * ((base_) + j2); \
                unsigned nib = 0u, cnib = 0u; unsigned uu[4]; \
                _Pragma("unroll") for (int r = 0; r < 4; ++r) { uu[r] = score_key(buf_[j2][r]); const int bin = (int)(uu[r] >> 20); nib |= (bin > Bq) ? (1u << r) : 0u; cnib |= (bin == Bq) ? (1u << r) : 0u; } \
                if (!valid) { nib = 0u; cnib = 0u; } \
                if (cnib) { int p = __hip_atomic_fetch_add(&SM[48 + qi], (int)__popc(cnib), __ATOMIC_RELAXED, __HIP_MEMORY_SCOPE_WORKGROUP); \
                    _Pragma("unroll") for (int r = 0; r < 4; ++r) if ((cnib >> r) & 1u) { if (p < 512) CAND[qi * 1024 + p] = ((unsigned long long)uu[r] << 32) | (unsigned long long)(0xFFFFu - (unsigned)(kt * 16 + 4 * fq + r)); ++p; } } \
                if (nib) __hip_atomic_fetch_or(&MASK[qi * AT_MROW + (kt >> 1)], nib << (16 * (kt & 1) + 4 * fq), __ATOMIC_RELAXED, __HIP_MEMORY_SCOPE_WORKGROUP); } } while (0)
          f32x4 sb2[8];
          AT_LOADS(scur, 0);
#pragma unroll 1
          for (int i0 = 0; i0 < cnt; i0 += 16) {
            AT_LOADS(sb2, i0 + 8);
            AT_P2GROUP(scur, i0);
            AT_LOADS(scur, i0 + 16);
            AT_P2GROUP(sb2, i0 + 8); } }
#undef AT_P2GROUP
#undef AT_LOADS
        __syncthreads();
        }
#ifndef DBG_RD
#define DBG_RD 1
#endif
#pragma unroll 1
        for (int rD = 0; rD < DBG_RD; ++rD) {
#pragma unroll 1
        for (int j = 0; j < 2; ++j) { AT_LAUNDER(); const int q = 2 * wave + j; int m = SM[48 + q]; m = m < 512 ? m : 512; const int nd = SM[16 + q];
            if (m <= 256) at_resolve<4>(CAND + q * 1024, MASK + q * AT_MROW, m, nd, lane); else at_resolve<8>(CAND + q * 1024, MASK + q * AT_MROW, m, nd, lane); }
        __syncthreads();
        }
#undef AT_SCORES
#undef AT_LOADK
#undef AT_LOADG
    } else {
#pragma unroll 1
        for (int i = tid; i < 16 * AT_MROW; i += 512) MASK[i] = ((i % AT_MROW) < (n >> 5)) ? 0xFFFFFFFFu : 0u;
        __syncthreads();
    }
    }
#pragma unroll 1
    for (int rden = 0; rden < DBG_REP_DENSE; ++rden) {
    { const int g = wave >> 2, kh = (wave >> 1) & 1, hp = wave & 1, NS = n >> 6;
      const unsigned ring0 = (unsigned)(size_t)(lds + AT_HIST);
      const bf16* dsrc[4]; unsigned ddst[4];
      { AT_LAUNDER();
#pragma unroll
        for (int i_ = 0; i_ < 4; ++i_) { const int in_ = 4 * wave + i_; const int row_ = 4 * (in_ & 15) + (lane >> 4), pos_ = lane & 15;
            dsrc[i_] = (in_ < 16) ? (KN + (tb + row_) * 128 + ((pos_ ^ (row_ & 15)) << 3)) : (VB + (tb + row_) * 256 + 128 + ((pos_ ^ (2 * (row_ & 7))) << 3));
            ddst[i_] = (unsigned)(in_ * 1024); } }
      const size_t dstep = (wave < 4) ? (size_t)64 * 128 : (size_t)64 * 256;
#define AT_STAGE(s_) do { const unsigned sb_ = ring0 + (unsigned)(((s_) & 3) * 32768); \
        _Pragma("unroll") for (int i_ = 0; i_ < 4; ++i_) { const bf16* src_ = dsrc[i_] + (size_t)(s_) * dstep; \
            const unsigned dst_ = __builtin_amdgcn_readfirstlane(sb_ + ddst[i_]); unsigned keep_; \
            asm volatile("s_mov_b32 %0, m0\n\ts_mov_b32 m0, %2\n\ts_nop 0\n\tglobal_load_lds_dwordx4 %1, off\n\ts_mov_b32 m0, %0" : "=&s"(keep_) : "v"(src_), "s"(dst_) : "memory"); } } while (0)
      bf16x8 qa[2], qb[2]; f32x4 oacc[2][4], lacc[2];
      { AT_LAUNDER();
#pragma unroll
        for (int hi = 0; hi < 2; ++hi) { const bf16* qp = AQN + (tb + q0 + qi) * 512 + (g * 4 + 2 * hp + hi) * 64 + 8 * fq; qa[hi] = *(const bf16x8*)qp; qb[hi] = *(const bf16x8*)(qp + 32); } }
#pragma unroll
      for (int hi = 0; hi < 2; ++hi) { lacc[hi] = (f32x4){0.f, 0.f, 0.f, 0.f};
#pragma unroll
        for (int dt = 0; dt < 4; ++dt) oacc[hi][dt] = (f32x4){0.f, 0.f, 0.f, 0.f}; }
      const bf16x8 ones = (bf16x8){0x3F80, 0x3F80, 0x3F80, 0x3F80, 0x3F80, 0x3F80, 0x3F80, 0x3F80};
      const f32x4 negc = (f32x4){-cshift, -cshift, -cshift, -cshift};
      asm volatile("s_waitcnt vmcnt(0)" ::: "memory");
#pragma unroll 1
      for (int s = 0; s < 3 && s < NS; ++s) AT_STAGE(s);
      typedef short s4_t __attribute__((ext_vector_type(4)));
      AT_LAUNDER();
#define AT_KLOAD(kf_, s_) do { const LAS unsigned char* kb_ = lds + AT_HIST + ((s_) & 3) * 32768; \
          _Pragma("unroll") for (int t = 0; t < 2; ++t) { const int row = 16 * (2 * kh + t) + qi; \
              kf_[t][0] = *(const LAS bf16x8*)(kb_ + row * 256 + (((g * 8 + fq) ^ (row & 15)) << 4)); kf_[t][1] = *(const LAS bf16x8*)(kb_ + row * 256 + (((g * 8 + 4 + fq) ^ (row & 15)) << 4)); } } while (0)
#define AT_QKM(dst_, kf_) do { \
          _Pragma("unroll") for (int t = 0; t < 2; ++t) { \
              _Pragma("unroll") for (int hi = 0; hi < 2; ++hi) { f32x4 d = MFMA16(kf_[t][0], qa[hi], negc); dst_[hi][t] = MFMA16(kf_[t][1], qb[hi], d); } } } while (0)
      f32x4 st[2][2];
      if (NS >= 3) asm volatile("s_waitcnt vmcnt(8)" ::: "memory"); else asm volatile("s_waitcnt vmcnt(0)" ::: "memory");
      __builtin_amdgcn_s_barrier(); asm volatile("" ::: "memory");
      { bf16x8 kf0[2][2]; AT_KLOAD(kf0, 0); AT_QKM(st, kf0); }
#pragma unroll 2
      for (int s = 0; s < NS; ++s) {
          if (s + 2 < NS) asm volatile("s_waitcnt vmcnt(4)" ::: "memory"); else asm volatile("s_waitcnt vmcnt(0)" ::: "memory");
          __builtin_amdgcn_s_barrier(); asm volatile("" ::: "memory");
          if (s + 3 < NS) AT_STAGE(s + 3);
          { const LAS unsigned char* vbs = lds + AT_HIST + (s & 3) * 32768 + 16384;
            const unsigned mw = MASK[qi * AT_MROW + 2 * s + kh] >> (4 * fq);
            f32x4 stn[2][2]; bf16x8 kf[2][2]; bf16x8 va[4];
            { const int s1 = (s + 1 < NS) ? s + 1 : s; AT_KLOAD(kf, s1); }
#pragma unroll
            for (int dt = 0; dt < 4; ++dt) { const int r1 = 32 * kh + 4 * fq + (qi >> 2), r2 = r1 + 16; const int ch = g * 8 + 2 * dt + ((lane & 3) >> 1);
                const s4_t lo = __builtin_amdgcn_ds_read_tr16_b64_v4i16((LAS s4_t*)(vbs + r1 * 256 + ((ch ^ (2 * (r1 & 7))) << 4) + (lane & 1) * 8));
                const s4_t hi4 = __builtin_amdgcn_ds_read_tr16_b64_v4i16((LAS s4_t*)(vbs + r2 * 256 + ((ch ^ (2 * (r2 & 7))) << 4) + (lane & 1) * 8));
                va[dt] = (bf16x8){lo[0], lo[1], lo[2], lo[3], hi4[0], hi4[1], hi4[2], hi4[3]}; }
            asm volatile("" ::: "memory");
            AT_QKM(stn, kf);
            bf16x8 pb[2];
#pragma unroll
            for (int hi = 0; hi < 2; ++hi) { float pv[8];
#pragma unroll
                for (int j = 0; j < 8; ++j) { const float e = __builtin_amdgcn_exp2f(st[hi][j >> 2][j & 3]);
                    const int keep = __builtin_amdgcn_sbfe((int)mw, 16 * (j >> 2) + (j & 3), 1); pv[j] = __uint_as_float(__float_as_uint(e) & (unsigned)keep); }
                v4u pw; pw.x = pk2(pv[0], pv[1]); pw.y = pk2(pv[2], pv[3]); pw.z = pk2(pv[4], pv[5]); pw.w = pk2(pv[6], pv[7]); pb[hi] = __builtin_bit_cast(bf16x8, pw);
                lacc[hi] = MFMA16(ones, pb[hi], lacc[hi]); }
#pragma unroll
            for (int dt = 0; dt < 4; ++dt) {
#pragma unroll
                for (int hi = 0; hi < 2; ++hi) oacc[hi][dt] = MFMA16(va[dt], pb[hi], oacc[hi][dt]); }
#pragma unroll
            for (int hi = 0; hi < 2; ++hi) { st[hi][0] = stn[hi][0]; st[hi][1] = stn[hi][1]; } } }
#undef AT_KLOAD
#undef AT_QKM
      __syncthreads();
      { AT_LAUNDER(); LAS unsigned char* red = lds + AT_HIST + (g * 2 + hp) * 8704;
        if (kh == 1) {
#pragma unroll
            for (int hi = 0; hi < 2; ++hi) {
#pragma unroll
                for (int dt = 0; dt < 4; ++dt) *(LAS f32x4*)(red + (hi * 4 + dt) * 1024 + lane * 16) = oacc[hi][dt];
                *(LAS float*)(red + 8192 + hi * 256 + lane * 4) = lacc[hi][0]; } } }
      __syncthreads();
      if (kh == 0) { AT_LAUNDER(); const LAS unsigned char* red = lds + AT_HIST + (g * 2 + hp) * 8704;
#pragma unroll
        for (int hi = 0; hi < 2; ++hi) { const float inv = 1.0f / (lacc[hi][0] + *(const LAS float*)(red + 8192 + hi * 256 + lane * 4));
            bf16* yp = YATT + (tb + q0 + qi) * 512 + (g * 4 + 2 * hp + hi) * 64 + 4 * fq;
#pragma unroll
            for (int dt = 0; dt < 4; ++dt) { const f32x4 o = oacc[hi][dt] + *(const LAS f32x4*)(red + (hi * 4 + dt) * 1024 + lane * 16);
                v2u w; w.x = pk2(o[0] * inv, o[1] * inv); w.y = pk2(o[2] * inv, o[3] * inv); *(v2u*)(yp + 16 * dt) = w; } } }
#undef AT_STAGE
    }
    __syncthreads();
    }
#undef AT_LAUNDER
    __syncthreads();
}

#ifndef DBG_REP_ML
#define DBG_REP_ML 1
#endif
#ifndef DBG_REP_ATT
#define DBG_REP_ATT 1
#endif
__device__ __forceinline__ void p3_mixer(const Args& a, const Ctx& c, volatile LAS unsigned* MISC, int rep) {
#if !defined(NO_MLSTM)
#pragma unroll 1
    for (int rr = 0; rr < DBG_REP_ML; ++rr)
#pragma unroll 1
        for (int u = blockIdx.x; u < 32; u += c.G) mlstm_unit<0>(a, c, u >> 2, u & 3, 0);
#endif
    unsigned* ctl = (unsigned*)(a.ws + WS_CTL);
    const int x = (int)(__builtin_amdgcn_s_getreg((3 << 11) | 20) & 7u);
    float cshift;
    { float gq = fabsf(a.in[IN_GQ][c.lane]), gk = fabsf(a.in[IN_GK][c.lane]);
#pragma unroll
      for (int o = 1; o < 64; o <<= 1) { gq = fmaxf(gq, __shfl_xor(gq, o)); gk = fmaxf(gk, __shfl_xor(gk, o)); }
      cshift = 8.0f * 1.4426950408889634f * gq * gk; }
#pragma unroll 1
    for (int rot = 0; rot < 8 * DBG_REP_ATT; ++rot) { rep = rot >> 3; const int bq = (x + rot) & 7;
        if (c.tid == 0) MISC[16] = __hip_atomic_fetch_add(ctl + CW_Q + 512 * rep + 64 * bq, 1u, RLX_AGENT);
        __syncthreads();
        int u = (int)MISC[16];
        __syncthreads();
#pragma unroll 1
        while (u < 256) {
            unsigned nxt = 0u;
            if (c.tid == 0) nxt = __hip_atomic_fetch_add(ctl + CW_Q + 512 * rep + 64 * bq, 1u, RLX_AGENT);
#if !defined(NO_ATTN)
            attn_unit(a, c, bq, 255 - u, cshift);
#endif
            if (c.tid == 0) MISC[16] = nxt;
            __syncthreads();
            u = (int)MISC[16];
            __syncthreads();
        } }
}
constexpr int RT_WT = 0;
constexpr int RT_WROW = 1028;
constexpr int RT_LG = 36 * RT_WROW * 4;
constexpr int RT_RSTD = RT_LG + 64 * 36 * 4;
constexpr int RT_LCNT = RT_RSTD + 512;
static_assert(RT_LCNT + 128 <= MISC_OFF, "router LDS map");
__device__ __forceinline__ void p6_router(const Args& a, const Ctx& c) {
    const int tid = c.tid, lane = c.lane, wave = c.wave; LAS unsigned char* lds = c.lds;
    LAS float* WT = (LAS float*)(lds + RT_WT); LAS float* LG = (LAS float*)(lds + RT_LG); LAS float* RSTD = (LAS float*)(lds + RT_RSTD); LAS int* LCNT = (LAS int*)(lds + RT_LCNT);
    { int* RT = (int*)(a.ws + WS_ROWTOK); for (int i = blockIdx.x * 512 + tid; i < NROWS_MAX; i += c.G * 512) RT[i] = 0; }
    { const f32x4* src = (const f32x4*)(a.ws + WS_WTG); LAS f32x4* dst = (LAS f32x4*)WT; for (int i = tid; i < 36 * RT_WROW / 4; i += 512) dst[i] = src[i]; }
    f32x4 gv[4];
#pragma unroll
    for (int j = 0; j < 4; ++j) gv[j] = *(const f32x4*)(a.in[IN_GMOE] + 4 * lane + 256 * j);
    const float* X1 = a.out; bf16* XN = (bf16*)(a.ws + WS_XN);
    int* TOKE = (int*)(a.ws + WS_TOKE); int* TOKR = (int*)(a.ws + WS_TOKR); float* TOKG = (float*)(a.ws + WS_TOKG); int* CNT = (int*)(a.ws + WS_CNT);
    __syncthreads();
    for (int blk = blockIdx.x; blk < 256; blk += c.G) {
        if (tid < 32) LCNT[tid] = 0;
#pragma unroll 1
        for (int ri = 0; ri < 16; ri += 2) { const int tA = blk * 128 + wave * 16 + ri, tB = tA + 1;
            const f32x4* xa = (const f32x4*)(X1 + (size_t)tA * D) + lane; const f32x4* xb = (const f32x4*)(X1 + (size_t)tB * D) + lane;
            f32x4 va[4], vb[4]; float sa = 0.f, sb = 0.f;
#pragma unroll
            for (int j = 0; j < 4; ++j) { va[j] = xa[64 * j]; vb[j] = xb[64 * j]; }
#pragma unroll
            for (int j = 0; j < 4; ++j) { sa += (va[j].x * va[j].x + va[j].y * va[j].y) + (va[j].z * va[j].z + va[j].w * va[j].w); sb += (vb[j].x * vb[j].x + vb[j].y * vb[j].y) + (vb[j].z * vb[j].z + vb[j].w * vb[j].w); }
            const float ra = rsqrtf(wave_sum(sa) * (1.f / D) + EPS), rb = rsqrtf(wave_sum(sb) * (1.f / D) + EPS);
            if (lane == 0) { RSTD[wave * 16 + ri] = ra; RSTD[wave * 16 + ri + 1] = rb; }
            v2u* oa = (v2u*)(XN + (size_t)tA * D) + lane; v2u* ob = (v2u*)(XN + (size_t)tB * D) + lane;
#pragma unroll
            for (int j = 0; j < 4; ++j) { v2u w; w.x = pk2(va[j].x * ra * gv[j].x, va[j].y * ra * gv[j].y); w.y = pk2(va[j].z * ra * gv[j].z, va[j].w * ra * gv[j].w); oa[64 * j] = w;
                v2u u; u.x = pk2(vb[j].x * rb * gv[j].x, vb[j].y * rb * gv[j].y); u.y = pk2(vb[j].z * rb * gv[j].z, vb[j].w * rb * gv[j].w); ob[64 * j] = u; } }
        f32x4 acc[3];
#pragma unroll
        for (int ct = 0; ct < 3; ++ct) acc[ct] = (f32x4){0.f, 0.f, 0.f, 0.f};
        { const int row = lane & 15, kq = lane >> 4;
          const f32x4* ap = (const f32x4*)(X1 + (size_t)(blk * 128 + wave * 16 + row) * D + 4 * kq);
          int cj[3]; cj[0] = row; cj[1] = 16 + row; cj[2] = (32 + row) < 36 ? (32 + row) : 35;
          const LAS f32x4* bp0 = (const LAS f32x4*)(WT + cj[0] * RT_WROW + 4 * kq); const LAS f32x4* bp1 = (const LAS f32x4*)(WT + cj[1] * RT_WROW + 4 * kq); const LAS f32x4* bp2 = (const LAS f32x4*)(WT + cj[2] * RT_WROW + 4 * kq);
#define RT_LOADA(dst_, b_) do { _Pragma("unroll") for (int i_ = 0; i_ < 8; ++i_) dst_[i_] = ap[4 * (8 * ((b_) < 8 ? (b_) : 7) + i_)]; } while (0)
#define RT_MMA(src_, b_) do { _Pragma("unroll") for (int i_ = 0; i_ < 8; ++i_) { const int ks_ = 8 * (b_) + i_; const f32x4 b0 = bp0[4 * ks_], b1 = bp1[4 * ks_], b2 = bp2[4 * ks_]; \
              _Pragma("unroll") for (int j = 0; j < 4; ++j) { acc[0] = __builtin_amdgcn_mfma_f32_16x16x4f32(src_[i_][j], b0[j], acc[0], 0, 0, 0); acc[1] = __builtin_amdgcn_mfma_f32_16x16x4f32(src_[i_][j], b1[j], acc[1], 0, 0, 0); \
                  acc[2] = __builtin_amdgcn_mfma_f32_16x16x4f32(src_[i_][j], b2[j], acc[2], 0, 0, 0); } } } while (0)
          f32x4 aA[8], aB[8]; RT_LOADA(aA, 0);
#pragma unroll 1
          for (int bb = 0; bb < 8; bb += 2) { RT_LOADA(aB, bb + 1); RT_MMA(aA, bb); RT_LOADA(aA, bb + 2); RT_MMA(aB, bb + 1); }
#undef RT_LOADA
#undef RT_MMA
        }
#pragma unroll 1
        for (int half = 0; half < 2; ++half) {
            __syncthreads();
            if ((wave >> 2) == half) { const int col = lane & 15, kq = lane >> 4;
#pragma unroll
                for (int ct = 0; ct < 3; ++ct) if (16 * ct + col < 36) {
#pragma unroll
                    for (int r = 0; r < 4; ++r) LG[((wave & 3) * 16 + 4 * kq + r) * 36 + 16 * ct + col] = acc[ct][r]; } }
            __syncthreads();
            if (tid < 64) { const int row = half * 64 + tid, t = blk * 128 + row; const float rs = RSTD[row]; const LAS float* lg = LG + tid * 36;
                float gl[4];
#pragma unroll
                for (int i = 0; i < 4; ++i) gl[i] = rs * lg[32 + i] + a.in[IN_BRG][i];
                int gs = 0; float gmax = gl[0];
#pragma unroll
                for (int i = 1; i < 4; ++i) if (gl[i] > gmax) { gmax = gl[i]; gs = i; }
                float gsum = 0.f;
#pragma unroll
                for (int i = 0; i < 4; ++i) gsum += expf(gl[i] - gmax);
                const float gtop = 1.0f / gsum;
                float ev[8];
#pragma unroll
                for (int i = 0; i < 8; ++i) ev[i] = rs * lg[gs * 8 + i] + a.in[IN_BRE][gs * 8 + i];
                int l0 = 0; float v0 = ev[0];
#pragma unroll
                for (int i = 1; i < 8; ++i) if (ev[i] > v0) { v0 = ev[i]; l0 = i; }
                int l1 = -1; float v1 = -3.0e38f;
#pragma unroll
                for (int i = 0; i < 8; ++i) if (i != l0 && ev[i] > v1) { v1 = ev[i]; l1 = i; }
                const float e1 = expf(v1 - v0), s0 = 1.0f / (1.0f + e1), s1 = e1 * s0;
                const int ex0 = gs * 8 + l0, ex1 = gs * 8 + l1;
                const int rk0 = __hip_atomic_fetch_add(&LCNT[ex0], 1, __ATOMIC_RELAXED, __HIP_MEMORY_SCOPE_WORKGROUP);
                const int rk1 = __hip_atomic_fetch_add(&LCNT[ex1], 1, __ATOMIC_RELAXED, __HIP_MEMORY_SCOPE_WORKGROUP);
                TOKE[2 * t] = ex0; TOKE[2 * t + 1] = ex1; TOKR[2 * t] = rk0; TOKR[2 * t + 1] = rk1; TOKG[2 * t] = s0 * gtop; TOKG[2 * t + 1] = s1 * gtop; }
        }
        __syncthreads();
        if (tid < 32) CNT[blk * 32 + tid] = LCNT[tid];
        __syncthreads();
    }
}
__device__ __forceinline__ void p7_gather(const Args& a, const Ctx& c) {
    const int tid = c.tid, lane = c.lane, wave = c.wave;
    LAS int* PART = (LAS int*)c.lds; LAS int* PPRE = PART + 512; LAS int* TOT = PPRE + 512; LAS int* TS = TOT + 32; LAS int* BASE = TS + 64;
    const int* CNT = (const int*)(a.ws + WS_CNT); const int* TOKE = (const int*)(a.ws + WS_TOKE); const int* TOKR = (const int*)(a.ws + WS_TOKR); int* TOKP = (int*)(a.ws + WS_TOKP);
    int* RT = (int*)(a.ws + WS_ROWTOK);
    { const int e = tid & 31, p = tid >> 5; int s = 0; for (int k = 0; k < 16; ++k) s += CNT[(16 * p + k) * 32 + e]; PART[p * 32 + e] = s; }
    __syncthreads();
    if (tid < 32) { int run = 0; for (int p = 0; p < 16; ++p) { PPRE[p * 32 + tid] = run; run += PART[p * 32 + tid]; } TOT[tid] = run; }
    __syncthreads();
    if (tid == 0) { int ts = 0; for (int e = 0; e < 32; ++e) { TS[e] = ts; ts += (TOT[e] + 255) >> 8; } TS[32] = ts; }
    __syncthreads();
    if (blockIdx.x == 0 && tid < 33) ((int*)(a.ws + WS_SMALL))[tid] = TS[tid];
    for (int blk = blockIdx.x; blk < 256; blk += c.G) {
        if (tid < 32) { int s = TS[tid] * 256 + PPRE[(blk >> 4) * 32 + tid]; for (int b2 = (blk & ~15); b2 < blk; ++b2) s += CNT[b2 * 32 + tid]; BASE[tid] = s; }
        __syncthreads();
        { const int t = blk * 128 + (tid >> 2), jj = tid & 3;
          if (jj < 2) { const int pos = BASE[TOKE[2 * t + jj]] + TOKR[2 * t + jj]; TOKP[2 * t + jj] = pos; RT[pos] = t; } }
        __syncthreads();
    }
}
__device__ __forceinline__ void p10_combine(const Args& a, const Ctx& c) {
    const int lane = c.lane, gw = c.vcu * NWAVES + c.wave, NGW = c.G * NWAVES;
    const int* TOKP = (const int*)(a.ws + WS_TOKP); const float* TOKG = (const float*)(a.ws + WS_TOKG); const bf16* Y = (const bf16*)(a.ws + WS_Y);
    for (int t0 = gw; t0 < T; t0 += 2 * NGW) {
        const int tA = t0, tB = (t0 + NGW < T) ? t0 + NGW : t0; const bool hasB = (t0 + NGW < T);
        const int pA0 = TOKP[2 * tA], pA1 = TOKP[2 * tA + 1], pB0 = TOKP[2 * tB], pB1 = TOKP[2 * tB + 1];
        const float gA0 = TOKG[2 * tA], gA1 = TOKG[2 * tA + 1], gB0 = TOKG[2 * tB], gB1 = TOKG[2 * tB + 1];
        f32x4 xa[4], xb[4]; v2u ya0[4], ya1[4], yb0[4], yb1[4];
#pragma unroll
        for (int j = 0; j < 4; ++j) { const int cc = 4 * lane + 256 * j;
            xa[j] = *(const f32x4*)(a.out + (size_t)tA * D + cc); xb[j] = *(const f32x4*)(a.out + (size_t)tB * D + cc);
            ya0[j] = *(const v2u*)(Y + (size_t)pA0 * D + cc); ya1[j] = *(const v2u*)(Y + (size_t)pA1 * D + cc);
            yb0[j] = *(const v2u*)(Y + (size_t)pB0 * D + cc); yb1[j] = *(const v2u*)(Y + (size_t)pB1 * D + cc); }
#pragma unroll
        for (int j = 0; j < 4; ++j) { const int cc = 4 * lane + 256 * j; f32x4 x = xa[j];
            x[0] += gA0 * bf2f(ya0[j].x & 0xffffu) + gA1 * bf2f(ya1[j].x & 0xffffu); x[1] += gA0 * bf2f(ya0[j].x >> 16) + gA1 * bf2f(ya1[j].x >> 16);
            x[2] += gA0 * bf2f(ya0[j].y & 0xffffu) + gA1 * bf2f(ya1[j].y & 0xffffu); x[3] += gA0 * bf2f(ya0[j].y >> 16) + gA1 * bf2f(ya1[j].y >> 16);
            *(f32x4*)(a.out + (size_t)tA * D + cc) = x; }
        if (hasB) {
#pragma unroll
        for (int j = 0; j < 4; ++j) { const int cc = 4 * lane + 256 * j; f32x4 x = xb[j];
            x[0] += gB0 * bf2f(yb0[j].x & 0xffffu) + gB1 * bf2f(yb1[j].x & 0xffffu); x[1] += gB0 * bf2f(yb0[j].x >> 16) + gB1 * bf2f(yb1[j].x >> 16);
            x[2] += gB0 * bf2f(yb0[j].y & 0xffffu) + gB1 * bf2f(yb1[j].y & 0xffffu); x[3] += gB0 * bf2f(yb0[j].y >> 16) + gB1 * bf2f(yb1[j].y >> 16);
            *(f32x4*)(a.out + (size_t)tB * D + cc) = x; } }
    }
}
__global__ void __launch_bounds__(NWAVES * 64, 2) hybrid_fwd(Args args) {
    extern __shared__ __attribute__((aligned(16))) unsigned char lds_raw[];
    Ctx c; c.lds = (LAS unsigned char*)lds_raw;
    volatile LAS unsigned* MISC = (volatile LAS unsigned*)(c.lds + MISC_OFF);
    c.tid = threadIdx.x; c.lane = c.tid & 63; c.wave = __builtin_amdgcn_readfirstlane(c.tid >> 6);
    c.G = gridDim.x; { const int bx = blockIdx.x; c.vcu = (c.G % 8 == 0) ? (bx % 8) * (c.G / 8) + bx / 8 : bx; }
    unsigned* ctl = (unsigned*)(args.ws + WS_CTL);
    if (c.tid < 128) MISC[c.tid] = 0u;
    __syncthreads();
    XcdBarrier bar; bar.bar = ctl + CW_BAR; bar.x = 0; bar.st = nullptr;
    if (N_LAUNCHES == 1) bar = xcd_barrier_post(ctl + CW_BAR, MISC + 8);
#define GRID_BAR() do { if (N_LAUNCHES == 1) xcd_barrier(bar); } while (0)
    const int lo = args.ph_lo, hi = args.ph_hi;
#ifndef PH_MASK
#define PH_MASK 0xfff
#endif
#define IN(k) (((PH_MASK >> (k)) & 1) && lo <= (k) && (k) < hi)
#define BOTH(k) (IN(k) && IN((k) + 1))
    unsigned char* ws = args.ws; unsigned char* dout = (unsigned char*)args.out;
#ifndef DBG_REPEAT
#define DBG_REPEAT -1
#endif
#define REPS(k) (((k) == DBG_REPEAT) ? 2 : 1)
    if (IN(0)) { _Pragma("unroll") for (int rep = 0; rep < REPS(0); ++rep) { if (rep) GRID_BAR(); p0_prologue<0>(args, c, c.vcu * NWAVES + c.wave, c.G * NWAVES); } if (BOTH(0)) GRID_BAR(); }
    if (IN(1)) { _Pragma("unroll") for (int rep = 0; rep < REPS(1); ++rep) { if (rep) GRID_BAR();
        pg8::Gemm g{(const pg8::bf16_t*)(dout + DO_H), (const pg8::bf16_t*)(ws + WS_WIN), T, NPROJ, D}; pg8::StaticOrder S; S.init(T, NPROJ, c.G, (int)blockIdx.x);
        pg8::EpiBf16<0> E{(pg8::bf16_t*)(ws + WS_PROJ), 256, nullptr, 256, (size_t)T * 256, 1.f};
        pg8::gemm_phase<pg8::EpiBf16<0>, pg8::StaticOrder, true, true>(c.lds, g, S, E); }
        if (BOTH(1)) GRID_BAR();
    }
#ifndef DBG_R2
#define DBG_R2 1
#endif
#ifndef DBG_R4A
#define DBG_R4A 1
#endif
#ifndef DBG_R4B
#define DBG_R4B 1
#endif
#ifndef DBG_R7
#define DBG_R7 1
#endif
    if (IN(2)) { _Pragma("unroll 1") for (int rep = 0; rep < DBG_R2; ++rep) { if (rep) GRID_BAR(); p2_prep(args, c); } if (BOTH(2)) GRID_BAR(); }
    if (IN(3)) { _Pragma("unroll") for (int rep = 0; rep < REPS(3); ++rep) { if (rep) GRID_BAR(); p3_mixer(args, c, MISC, rep); } if (BOTH(3)) GRID_BAR(); }
    if (IN(4)) {
#pragma unroll 1
        for (int rep = 0; rep < DBG_R4A; ++rep) { p0_prologue<1>(args, c, c.vcu * NWAVES + c.wave, c.G * NWAVES); __syncthreads(); }
#pragma unroll 1
        for (int rep = 0; rep < DBG_R4B; ++rep)
#pragma unroll 1
        for (int u = blockIdx.x; u < 256; u += c.G) mlstm_unit<1>(args, c, u >> 5, (u >> 3) & 3, u & 7);
        if (BOTH(4)) GRID_BAR();
    }
    if (IN(5)) {
        { pg8::Gemm g{(const pg8::bf16_t*)(dout + DO_YATT), (const pg8::bf16_t*)(ws + WS_WPA), T, D, 512}; pg8::StaticOrder S; S.init(T, D, c.G, (int)blockIdx.x);
          pg8::EpiGate<false> E{(pg8::bf16_t*)(ws + WS_MERGED), D, (const pg8::bf16_t*)(ws + WS_PROJ + (size_t)TL_GA * PROJ_TILE), (size_t)T * 256};
          pg8::gemm_phase<pg8::EpiGate<false>, pg8::StaticOrder, true, true>(c.lds, g, S, E); }
        __syncthreads();
        { pg8::Gemm g{(const pg8::bf16_t*)(dout + DO_YML), (const pg8::bf16_t*)(ws + WS_WPM), T, D, 512}; pg8::StaticOrder S; S.init(T, D, c.G, (int)blockIdx.x);
          pg8::EpiGate<true> E{(pg8::bf16_t*)(ws + WS_MERGED), D, (const pg8::bf16_t*)(ws + WS_PROJ + (size_t)TL_GM * PROJ_TILE), (size_t)T * 256};
          pg8::gemm_phase<pg8::EpiGate<true>, pg8::StaticOrder, true, true>(c.lds, g, S, E); }
        if (BOTH(5)) GRID_BAR();
    }
    if (IN(6)) {
        pg8::Gemm g{(const pg8::bf16_t*)(ws + WS_MERGED), (const pg8::bf16_t*)(ws + WS_WOUT), T, D, D}; pg8::StaticOrder S; S.init(T, D, c.G, (int)blockIdx.x);
        pg8::EpiRes E{args.out, args.in[IN_X], D};
        pg8::gemm_phase<pg8::EpiRes, pg8::StaticOrder, true, true>(c.lds, g, S, E);
        if (BOTH(6)) GRID_BAR();
    }
    if (IN(7)) { _Pragma("unroll 1") for (int rep = 0; rep < DBG_R7; ++rep) { if (rep) { GRID_BAR(); } p6_router(args, c); } if (BOTH(7)) GRID_BAR(); }
    if (IN(8)) { _Pragma("unroll") for (int rep = 0; rep < REPS(8); ++rep) { if (rep) GRID_BAR(); p7_gather(args, c); } if (BOTH(8)) GRID_BAR(); }
    if (IN(9) || IN(10)) {
        LAS int* TSL = (LAS int*)(c.lds + MISC_OFF + 256);
        if (c.tid < 33) TSL[c.tid] = (int)__hip_atomic_load((unsigned*)(ws + WS_SMALL) + c.tid, RLX_AGENT);
        __syncthreads();
        if (IN(9)) {
            pg8::MoeOrder<true> S{TSL, c.G, (int)blockIdx.x, (const int*)(ws + WS_ROWTOK)};
            pg8::Gemm g{(const pg8::bf16_t*)(ws + WS_XN), (const pg8::bf16_t*)(ws + WS_GU), 0, 0, D};
            pg8::EpiSwiGLU E{(pg8::bf16_t*)(ws + WS_HID)};
            pg8::gemm_phase<pg8::EpiSwiGLU, pg8::MoeOrder<true>, true, true>(c.lds, g, S, E);
            if (BOTH(9)) GRID_BAR();
        }
        if (IN(10)) {
            pg8::MoeOrder<false> S{TSL, c.G, (int)blockIdx.x, nullptr};
            pg8::Gemm g{(const pg8::bf16_t*)(ws + WS_HID), (const pg8::bf16_t*)(ws + WS_DN), 0, 0, 512};
            pg8::EpiDown E{(pg8::bf16_t*)(ws + WS_Y)};
            pg8::gemm_phase<pg8::EpiDown, pg8::MoeOrder<false>, true, true>(c.lds, g, S, E);
            if (BOTH(10)) GRID_BAR();
        }
    }
    if (IN(11)) p10_combine(args, c);
#undef IN
#undef BOTH
#undef GRID_BAR
}

extern "C" void kernel_launch(void* const* d_in, const int* in_sizes, int n_in, void* d_out, int out_size, void* d_ws, size_t ws_size, hipStream_t stream) {
    static int grid = 0;
    if (grid == 0) {
        if (n_in != 22 || in_sizes[0] != T * D || out_size != T * D || ws_size < WS_END) { fprintf(stderr, "kernel_launch: unexpected shapes (n_in %d, in0 %d, out %d, ws %zu); nothing launched\n", n_in, n_in > 0 ? in_sizes[0] : -1, out_size, ws_size); grid = -1; return; }
        int dev = 0, cus = 0, per_cu = 0;
        if (hipGetDevice(&dev) != hipSuccess || hipDeviceGetAttribute(&cus, hipDeviceAttributeMultiprocessorCount, dev) != hipSuccess) { grid = -1; return; }
        if (hipFuncSetAttribute((const void*)hybrid_fwd, hipFuncAttributeMaxDynamicSharedMemorySize, LDS_BYTES) != hipSuccess) { fprintf(stderr, "kernel_launch: hipFuncSetAttribute failed\n"); grid = -1; return; }
        if (hipOccupancyMaxActiveBlocksPerMultiprocessor(&per_cu, (const void*)hybrid_fwd, NWAVES * 64, LDS_BYTES) != hipSuccess || per_cu < 1)
            fprintf(stderr, "kernel_launch: note: occupancy query reports %d workgroups per CU\n", per_cu);
        (void)hipGetLastError();
        grid = cus;
    }
    if (grid < 0) return;
    if (hipMemsetAsync((char*)d_ws + WS_CTL, 0, CTL_ZERO_BYTES, stream) != hipSuccess) return;
    Args a{};
    for (int i = 0; i < 22; ++i) a.in[i] = (const float*)d_in[i];
    a.out = (float*)d_out; a.ws = (unsigned char*)d_ws;
    for (int li = 0; li < N_LAUNCHES; ++li) {
        a.ph_lo = (N_LAUNCHES == 1) ? 0 : li; a.ph_hi = (N_LAUNCHES == 1) ? NPH : li + 1; a.li = li;
        hipLaunchKernelGGL(hybrid_fwd, dim3(grid), dim3(NWAVES * 64), LDS_BYTES, stream, a);
        if (hipPeekAtLastError() != hipSuccess) { fprintf(stderr, "kernel_launch: launch %d failed\n", li); break; }
    }
}
```

```cpp
#include <hip/hip_runtime.h>
#include <cstdio>
#include <cstdint>
namespace pg8 {
#define PG8_LAS __attribute__((address_space(3)))
typedef unsigned short bf16_t;
typedef short bf16x8 __attribute__((ext_vector_type(8)));
typedef float f32x4 __attribute__((ext_vector_type(4)));
typedef unsigned u32x4 __attribute__((ext_vector_type(4)));
constexpr int BM = 256, BK = 64, HALF = 128, HTB = HALF * BK * 2  , STAGE_BYTES = 8 * HTB, NXCD = 8, WGM = 8;

__host__ __device__ __forceinline__ int lds_byte(int r, int c) { const int st = (r >> 4) * 2 + (c >> 5), rr = r & 15, cc = c & 31, ob = rr * 64 + cc * 2; return st * 1024 + (ob ^ (((ob >> 9) & 1) << 5)); }
__host__ __device__ __forceinline__ void stage_rc(int b, int& R, int& C) { const int st = b / 1024, sb = b % 1024, swz = sb ^ (((sb >> 9) & 1) << 5); R = (st >> 1) * 16 + swz / 64; C = (st & 1) * 32 + (swz % 64) / 2; }
__host__ __device__ __forceinline__ int perm32(int rho) { const int n = rho >> 4, i = rho & 15; return 8 * (i >> 2) + 4 * n + (i & 3); }

struct Unit { int pm, pn; };
struct Gemm { const bf16_t* A; const bf16_t* Bt; int M, N, K; };

struct StaticOrder {
    static constexpr bool GATHER = false;
    int nM, nN, nwg, G, c;
    __host__ __device__ void init(int M, int N, int G_, int c_) { nM = M / BM; nN = N / BM; nwg = nM * nN; G = G_; c = c_; }
    __host__ __device__ bool next(int i, Unit& u) const {
        const long L = (long)i * G + c; if (L >= nwg) return false;
        int wgid = (int)L; { const int q = nwg / NXCD, r = nwg % NXCD, xcd = wgid % NXCD, off = wgid / NXCD; wgid = (xcd < r ? xcd * (q + 1) : r * (q + 1) + (xcd - r) * q) + off; }
        const int nig = WGM * nN, gid = wgid / nig, fm = gid * WGM, gsz = (nM - fm) < WGM ? (nM - fm) : WGM;
        u.pm = fm + ((wgid % nig) % gsz); u.pn = (wgid % nig) / gsz; return true;
    }
    __device__ __forceinline__ void a_ready(const Unit&) const {}
    __device__ __forceinline__ void done(const Unit&) const {}
};

typedef __bf16 bf2_t __attribute__((ext_vector_type(2)));
__device__ __forceinline__ unsigned cvt_pk_bf16(float lo, float hi) { bf2_t v; v[0] = (__bf16)lo; v[1] = (__bf16)hi; return __builtin_bit_cast(unsigned, v); }
typedef float f32x2 __attribute__((ext_vector_type(2)));
template <int ACT  > struct EpiBf16 {
    static constexpr bool PERM = true, AFTER_DRAIN = false; static_assert(ACT == 0, "EpiBf16: no activation here");
    bf16_t* O; int ldc; const float* bias; int split_cols; size_t split_stride; float scale0;
    __device__ __forceinline__ void operator()(const f32x4 (&acc)[2][2][4][2], const Unit& u, int wr, int wc, int fr, int fq) const {
        const int row0 = u.pm * BM + wr * 64 + fr; int colt = u.pn * BM; bf16_t* base = O;
        float sc = 1.f; if (split_cols) { const int t = colt / split_cols; base += (size_t)t * split_stride; colt -= t * split_cols; if (t == 0) sc = scale0; }
        const int col0 = colt + wc * 32 + 8 * fq, bcol0 = u.pn * BM + wc * 32 + 8 * fq;
        f32x4 bv[2][2];
#pragma unroll
        for (int bj = 0; bj < 2; ++bj)
#pragma unroll
            for (int n = 0; n < 2; ++n) bv[bj][n] = bias ? *(const f32x4*)(bias + bcol0 + bj * HALF + 4 * n) : (f32x4){0.f, 0.f, 0.f, 0.f};
#pragma unroll
        for (int ai = 0; ai < 2; ++ai)
#pragma unroll
            for (int m = 0; m < 4; ++m) { bf16_t* rowp = base + (size_t)(row0 + ai * HALF + m * 16) * ldc + col0;
#pragma unroll
                for (int bj = 0; bj < 2; ++bj) { f32x4 v0 = acc[ai][bj][m][0] + bv[bj][0], v1 = acc[ai][bj][m][1] + bv[bj][1];
                    v0 = v0 * sc; v1 = v1 * sc; u32x4 w; w.x = cvt_pk_bf16(v0[0], v0[1]); w.y = cvt_pk_bf16(v0[2], v0[3]); w.z = cvt_pk_bf16(v1[0], v1[1]); w.w = cvt_pk_bf16(v1[2], v1[3]);
                    *(u32x4*)(rowp + bj * HALF) = w; } }
    }
};
__device__ __forceinline__ float bf2f_(unsigned b16) { return __uint_as_float(b16 << 16); }
__device__ __forceinline__ float sigm_(float x) { return 1.0f / (1.0f + __expf(-x)); }
template <bool ADD> struct EpiGate {
    static constexpr bool PERM = true, AFTER_DRAIN = false;
    bf16_t* O; int ldc; const bf16_t* gate; size_t gstride;
    __device__ __forceinline__ void operator()(const f32x4 (&acc)[2][2][4][2], const Unit& u, int wr, int wc, int fr, int fq) const {
        const int row0 = u.pm * BM + wr * 64 + fr, colt = wc * 32 + 8 * fq;
        const bf16_t* gt = gate + (size_t)u.pn * gstride;
#pragma unroll
        for (int ai = 0; ai < 2; ++ai)
#pragma unroll
            for (int m = 0; m < 4; ++m) { const size_t row = (size_t)(row0 + ai * HALF + m * 16);
#pragma unroll
                for (int bj = 0; bj < 2; ++bj) { const int c = colt + bj * HALF;
                    const u32x4 gv = *(const u32x4*)(gt + row * 256 + c);
                    bf16_t* op = O + row * ldc + u.pn * BM + c;
                    float pv[8] = {0.f, 0.f, 0.f, 0.f, 0.f, 0.f, 0.f, 0.f};
                    if (ADD) { const u32x4 p = *(const u32x4*)op; pv[0] = bf2f_(p.x & 0xffffu); pv[1] = bf2f_(p.x >> 16); pv[2] = bf2f_(p.y & 0xffffu); pv[3] = bf2f_(p.y >> 16);
                        pv[4] = bf2f_(p.z & 0xffffu); pv[5] = bf2f_(p.z >> 16); pv[6] = bf2f_(p.w & 0xffffu); pv[7] = bf2f_(p.w >> 16); }
                    const f32x4 v0 = acc[ai][bj][m][0], v1 = acc[ai][bj][m][1];
                    float o[8];
                    o[0] = pv[0] + sigm_(bf2f_(gv.x & 0xffffu)) * v0[0]; o[1] = pv[1] + sigm_(bf2f_(gv.x >> 16)) * v0[1];
                    o[2] = pv[2] + sigm_(bf2f_(gv.y & 0xffffu)) * v0[2]; o[3] = pv[3] + sigm_(bf2f_(gv.y >> 16)) * v0[3];
                    o[4] = pv[4] + sigm_(bf2f_(gv.z & 0xffffu)) * v1[0]; o[5] = pv[5] + sigm_(bf2f_(gv.z >> 16)) * v1[1];
                    o[6] = pv[6] + sigm_(bf2f_(gv.w & 0xffffu)) * v1[2]; o[7] = pv[7] + sigm_(bf2f_(gv.w >> 16)) * v1[3];
                    u32x4 w; w.x = cvt_pk_bf16(o[0], o[1]); w.y = cvt_pk_bf16(o[2], o[3]); w.z = cvt_pk_bf16(o[4], o[5]); w.w = cvt_pk_bf16(o[6], o[7]);
                    *(u32x4*)op = w; } }
    }
};
struct EpiRes {
    static constexpr bool PERM = false, AFTER_DRAIN = false;
    float* C; const float* R; int ldc;
    __device__ __forceinline__ void operator()(const f32x4 (&acc)[2][2][4][2], const Unit& u, int wr, int wc, int fr, int fq) const {
        const int row0 = u.pm * BM + wr * 64 + fr, col0 = u.pn * BM + wc * 32 + 4 * fq;
#pragma unroll
        for (int ai = 0; ai < 2; ++ai)
#pragma unroll
            for (int m = 0; m < 4; ++m) { const size_t ro = (size_t)(row0 + ai * HALF + m * 16) * ldc + col0;
#pragma unroll
                for (int bj = 0; bj < 2; ++bj)
#pragma unroll
                    for (int n = 0; n < 2; ++n) { const size_t off = ro + bj * HALF + n * 16; *(f32x4*)(C + off) = *(const f32x4*)(R + off) + acc[ai][bj][m][n]; } }
    }
};
struct EpiSwiGLU {
    static constexpr bool PERM = true, AFTER_DRAIN = false;
    bf16_t* H;
    __device__ __forceinline__ void operator()(const f32x4 (&acc)[2][2][4][2], const Unit& u, int wr, int wc, int fr, int fq) const {
        const int row0 = u.pm * BM + wr * 64 + fr, hc = (u.pn & 3) * 128 + wc * 32 + 8 * fq;
#pragma unroll
        for (int ai = 0; ai < 2; ++ai)
#pragma unroll
            for (int m = 0; m < 4; ++m) { const size_t row = (size_t)(row0 + ai * HALF + m * 16);
                float o[8];
#pragma unroll
                for (int n = 0; n < 2; ++n)
#pragma unroll
                    for (int i = 0; i < 4; ++i) { const float g = acc[ai][0][m][n][i], up = acc[ai][1][m][n][i]; o[n * 4 + i] = g * sigm_(g) * up; }
                u32x4 w; w.x = cvt_pk_bf16(o[0], o[1]); w.y = cvt_pk_bf16(o[2], o[3]); w.z = cvt_pk_bf16(o[4], o[5]); w.w = cvt_pk_bf16(o[6], o[7]);
                *(u32x4*)(H + row * 512 + hc) = w; }
    }
};
struct EpiDown {
    static constexpr bool PERM = true, AFTER_DRAIN = false;
    bf16_t* Y;
    __device__ __forceinline__ void operator()(const f32x4 (&acc)[2][2][4][2], const Unit& u, int wr, int wc, int fr, int fq) const {
        const int row0 = u.pm * BM + wr * 64 + fr, c0 = (u.pn & 3) * 256 + wc * 32 + 8 * fq;
#pragma unroll
        for (int ai = 0; ai < 2; ++ai)
#pragma unroll
            for (int m = 0; m < 4; ++m) { const size_t row = (size_t)(row0 + ai * HALF + m * 16);
#pragma unroll
                for (int bj = 0; bj < 2; ++bj) { const f32x4 v0 = acc[ai][bj][m][0], v1 = acc[ai][bj][m][1];
                    u32x4 w; w.x = cvt_pk_bf16(v0[0], v0[1]); w.y = cvt_pk_bf16(v0[2], v0[3]); w.z = cvt_pk_bf16(v1[0], v1[1]); w.w = cvt_pk_bf16(v1[2], v1[3]);
                    *(u32x4*)(Y + row * 1024 + c0 + bj * HALF) = w; } }
    }
};
template <bool GA_> struct MoeOrder {
    static constexpr bool GATHER = GA_;
    const PG8_LAS int* ts; int G, c; const int* rowtok;
    __device__ __forceinline__ bool next(int i, Unit& u) const {
        const int nt = ts[32]; const long L = (long)i * G + c; if (L >= 4L * nt) return false;
        const int pm = (int)(L >> 2), j = (int)(L & 3); int e = 0;
#pragma unroll
        for (int k = 1; k < 32; ++k) e += (ts[k] <= pm) ? 1 : 0;
        u.pm = pm; u.pn = e * 4 + j; return true;
    }
    __device__ __forceinline__ void a_ready(const Unit&) const {}
    __device__ __forceinline__ void done(const Unit&) const {}
};
template <class Epi, class Sched, bool ALIGN_EPI = false, bool SP2 = false>
__device__ __forceinline__ void gemm_phase(PG8_LAS unsigned char* lds, const Gemm g, const Sched& S, const Epi& E) {
    const int tid = threadIdx.x, wid = __builtin_amdgcn_readfirstlane(tid >> 6), lane = tid & 63, wr = wid >> 2, wc = wid & 3, fr = lane & 15, fq = lane >> 4;
    const int K = g.K, nt = K / BK;
    unsigned voffA[2], voffB[2];
#pragma unroll
    for (int i = 0; i < 2; ++i) { int R, C; stage_rc(tid * 16 + i * 8192, R, C); const int Rb = Epi::PERM ? ((R & ~31) + perm32(R & 31)) : R;
        voffA[i] = (unsigned)(R * K + C) * 2u; voffB[i] = (unsigned)(Rb * K + C) * 2u; }
    const size_t kstep = (size_t)(BK * 2);
    const size_t hstep = (size_t)HALF * K * 2;
    const size_t tstep = 2 * hstep;
    constexpr bool GA = Sched::GATHER;
    static_assert(!GA || SP2, "gathered A rows: SP2 loop only");
    const size_t hstepA = GA ? 0 : hstep;
    unsigned gcur[2][2] = {{0u, 0u}, {0u, 0u}}, gnxt[2][2] = {{0u, 0u}, {0u, 0u}}; int gR[2] = {0, 0}; unsigned gC[2] = {0u, 0u};
    if constexpr (GA) { _Pragma("unroll") for (int i = 0; i < 2; ++i) { int R, C; stage_rc(tid * 16 + i * 8192, R, C); gR[i] = R; gC[i] = (unsigned)C * 2u; } }
#define PG8_GOFF(dst, u) do { if constexpr (GA) { _Pragma("unroll") for (int h_ = 0; h_ < 2; ++h_) _Pragma("unroll") for (int i_ = 0; i_ < 2; ++i_) dst[h_][i_] = (unsigned)S.rowtok[(u).pm * BM + h_ * HALF + gR[i_]] * (unsigned)(K * 2) + gC[i_]; } } while (0)
#define PG8_VA(h, sel) (GA ? ((sel) ? gnxt[h] : gcur[h]) : voffA)
    const unsigned ldsw = (unsigned)wid * 1024u;
    const int aoff = lds_byte(wr * 64 + fr, fq * 8), boff = lds_byte(wc * 32 + fr, fq * 8);
#define PG8_SA(b, h) (((b) * 2 + (h)) * HTB)
#define PG8_SB(b, h) ((4 + (b) * 2 + (h)) * HTB)
#define PG8_STAGE(bufoff, gbase, voff) do { _Pragma("unroll") for (int _i = 0; _i < 2; ++_i) \
        __builtin_amdgcn_global_load_lds((const unsigned*)((const char*)(gbase) + (voff)[_i]), (PG8_LAS unsigned*)(lds + (bufoff) + ldsw + _i * 8192), 16, 0, 0); } while (0)
#define PG8_LDA(dst, b, h) do { _Pragma("unroll") for (int m = 0; m < 4; ++m) _Pragma("unroll") for (int k = 0; k < 2; ++k) dst[m][k] = *(const PG8_LAS bf16x8*)(lds + PG8_SA(b, h) + aoff + m * 2048 + k * 1024); } while (0)
#define PG8_LDB(dst, b, h) do { _Pragma("unroll") for (int n = 0; n < 2; ++n) _Pragma("unroll") for (int k = 0; k < 2; ++k) dst[n][k] = *(const PG8_LAS bf16x8*)(lds + PG8_SB(b, h) + boff + n * 2048 + k * 1024); } while (0)
#define PG8_MMA(ai, bj, At, Bt) do { __builtin_amdgcn_s_setprio(1); _Pragma("unroll") for (int m = 0; m < 4; ++m) _Pragma("unroll") for (int n = 0; n < 2; ++n) _Pragma("unroll") for (int k = 0; k < 2; ++k) \
        acc[ai][bj][m][n] = __builtin_amdgcn_mfma_f32_16x16x32_bf16(Bt[n][k], At[m][k], acc[ai][bj][m][n], 0, 0, 0); __builtin_amdgcn_s_setprio(0); } while (0)
#define PG8_WAIT_V(n) asm volatile("s_waitcnt vmcnt(" #n ")" ::: "memory")
#define PG8_WAIT_L(n) asm volatile("s_waitcnt lgkmcnt(" #n ")" ::: "memory")
#define PG8_BAR __builtin_amdgcn_s_barrier()
#define PG8_SCHED __builtin_amdgcn_sched_barrier(0)
    Unit cur, nxt; int ui = 0;
    if (!S.next(0, cur)) return;
    f32x4 acc[2][2][4][2];
#pragma unroll
    for (int a = 0; a < 2; ++a)
#pragma unroll
        for (int b = 0; b < 2; ++b)
#pragma unroll
            for (int m = 0; m < 4; ++m)
#pragma unroll
                for (int n = 0; n < 2; ++n) acc[a][b][m][n] = (f32x4){0.f, 0.f, 0.f, 0.f};
    bf16x8 At[4][2], B0[2][2], B1[2][2];
    const char* cA = (const char*)g.A + (GA ? 0 : (size_t)cur.pm * tstep); const char* cB = (const char*)g.Bt + (size_t)cur.pn * tstep;
    S.a_ready(cur);
    PG8_GOFF(gcur, cur);
    if constexpr (SP2) {
        PG8_STAGE(PG8_SB(0, 0), cB, voffB); PG8_STAGE(PG8_SB(0, 1), cB + hstep, voffB); PG8_STAGE(PG8_SA(0, 0), cA, PG8_VA(0, false)); PG8_STAGE(PG8_SA(0, 1), cA + hstepA, PG8_VA(1, false));
        if (wr == 1) PG8_BAR;
        PG8_WAIT_V(2); PG8_BAR;
        PG8_STAGE(PG8_SB(1, 0), cB + kstep, voffB); PG8_STAGE(PG8_SA(1, 0), cA + kstep, PG8_VA(0, false)); PG8_STAGE(PG8_SB(1, 1), cB + hstep + kstep, voffB);
        PG8_WAIT_V(6); PG8_BAR;
    } else {
        PG8_STAGE(PG8_SB(0, 0), cB, voffB); PG8_STAGE(PG8_SA(0, 0), cA, voffA); PG8_STAGE(PG8_SB(0, 1), cB + hstep, voffB); PG8_STAGE(PG8_SA(0, 1), cA + hstep, voffA);
        if (wr == 1) PG8_BAR;
        PG8_WAIT_V(4); PG8_BAR;
        PG8_STAGE(PG8_SB(1, 0), cB + kstep, voffB); PG8_STAGE(PG8_SA(1, 0), cA + kstep, voffA); PG8_STAGE(PG8_SB(1, 1), cB + hstep + kstep, voffB);
        PG8_WAIT_V(6); PG8_BAR;
    }
    for (;;) {
        const bool has_next = S.next(ui + 1, nxt);
        if (has_next) PG8_GOFF(gnxt, nxt);
        const char* nA = has_next ? (const char*)g.A + (GA ? 0 : (size_t)nxt.pm * tstep) : cA; const char* nB = has_next ? (const char*)g.Bt + (size_t)nxt.pn * tstep : cB;
        for (int t = 0; t < nt; t += 2) {
            const bool last = (t == nt - 2);
            const char* a1 = cA + (size_t)(t + 1) * kstep;
            const char* a2 = last ? nA : cA + (size_t)(t + 2) * kstep; const char* b2 = last ? nB : cB + (size_t)(t + 2) * kstep;
            const char* a3 = a2 + kstep; const char* b3 = b2 + kstep;
            if (last && has_next) S.a_ready(nxt);
            const bool seln = last && has_next;
            if constexpr (SP2) {
            PG8_LDB(B0, 0, 0); PG8_LDB(B1, 0, 1); PG8_SCHED; PG8_LDA(At, 0, 0); PG8_STAGE(PG8_SA(1, 1), a1 + hstepA, PG8_VA(1, false));
            PG8_WAIT_V(8); PG8_WAIT_L(0); PG8_BAR; PG8_MMA(0, 0, At, B0); PG8_MMA(0, 1, At, B1); PG8_BAR; PG8_SCHED;
            PG8_LDA(At, 0, 1); PG8_STAGE(PG8_SB(0, 0), b2, voffB); PG8_STAGE(PG8_SB(0, 1), b2 + hstep, voffB); PG8_STAGE(PG8_SA(0, 0), a2, PG8_VA(0, seln));
            PG8_WAIT_V(8); PG8_WAIT_L(0); PG8_BAR; PG8_MMA(1, 0, At, B0); PG8_MMA(1, 1, At, B1); PG8_BAR; PG8_SCHED;
            PG8_LDB(B0, 1, 0); PG8_LDB(B1, 1, 1); PG8_SCHED; PG8_LDA(At, 1, 0); PG8_STAGE(PG8_SA(0, 1), a2 + hstepA, PG8_VA(1, seln));
            PG8_WAIT_V(8); PG8_WAIT_L(0); PG8_BAR; PG8_MMA(0, 0, At, B0); PG8_MMA(0, 1, At, B1); PG8_BAR; PG8_SCHED;
            PG8_LDA(At, 1, 1); PG8_STAGE(PG8_SB(1, 0), b3, voffB); PG8_STAGE(PG8_SB(1, 1), b3 + hstep, voffB); PG8_STAGE(PG8_SA(1, 0), a3, PG8_VA(0, seln));
            PG8_WAIT_V(8); PG8_WAIT_L(0); PG8_BAR; PG8_MMA(1, 0, At, B0); PG8_MMA(1, 1, At, B1); PG8_BAR; PG8_SCHED;
            } else {
            PG8_LDB(B0, 0, 0); PG8_SCHED; PG8_LDA(At, 0, 0); PG8_STAGE(PG8_SA(1, 1), a1 + hstep, voffA);
            PG8_WAIT_L(8); PG8_BAR; PG8_WAIT_L(0); PG8_MMA(0, 0, At, B0); PG8_BAR; PG8_SCHED;
            PG8_LDB(B1, 0, 1); PG8_STAGE(PG8_SB(0, 0), b2, voffB);
            PG8_BAR; PG8_WAIT_L(0); PG8_MMA(0, 1, At, B1); PG8_BAR;
            PG8_LDA(At, 0, 1); PG8_STAGE(PG8_SA(0, 0), a2, voffA);
            PG8_BAR; PG8_WAIT_L(0); PG8_MMA(1, 0, At, B0); PG8_BAR; PG8_SCHED;
            PG8_STAGE(PG8_SB(0, 1), b2 + hstep, voffB);
            PG8_WAIT_V(6); PG8_BAR; PG8_MMA(1, 1, At, B1); PG8_BAR;
            PG8_LDB(B0, 1, 0); PG8_SCHED; PG8_LDA(At, 1, 0); PG8_STAGE(PG8_SA(0, 1), a2 + hstep, voffA);
            PG8_WAIT_L(8); PG8_BAR; PG8_WAIT_L(0); PG8_MMA(0, 0, At, B0); PG8_BAR; PG8_SCHED;
            PG8_LDB(B1, 1, 1); PG8_STAGE(PG8_SB(1, 0), b3, voffB);
            PG8_BAR; PG8_WAIT_L(0); PG8_MMA(0, 1, At, B1); PG8_BAR;
            PG8_LDA(At, 1, 1); PG8_STAGE(PG8_SA(1, 0), a3, voffA);
            PG8_BAR; PG8_WAIT_L(0); PG8_MMA(1, 0, At, B0); PG8_BAR; PG8_SCHED;
            PG8_STAGE(PG8_SB(1, 1), b3 + hstep, voffB);
            PG8_WAIT_V(6); PG8_BAR; PG8_MMA(1, 1, At, B1); PG8_BAR;
            }
        }
        if constexpr (ALIGN_EPI) { if (wr == 0) PG8_BAR; }
        if constexpr (!Epi::AFTER_DRAIN) { E(acc, cur, wr, wc, fr, fq); S.done(cur); }
        if (!has_next) break;
#pragma unroll
        for (int a = 0; a < 2; ++a)
#pragma unroll
            for (int b = 0; b < 2; ++b)
#pragma unroll
                for (int m = 0; m < 4; ++m)
#pragma unroll
                    for (int n = 0; n < 2; ++n) acc[a][b][m][n] = (f32x4){0.f, 0.f, 0.f, 0.f};
        cur = nxt; cA = nA; cB = nB; ++ui;
        if constexpr (GA) { _Pragma("unroll") for (int h_ = 0; h_ < 2; ++h_) _Pragma("unroll") for (int i_ = 0; i_ < 2; ++i_) gcur[h_][i_] = gnxt[h_][i_]; }
        if constexpr (ALIGN_EPI) { if (wr == 1) PG8_BAR; }
    }
    PG8_WAIT_V(0);
    if constexpr (!ALIGN_EPI) { if (wr == 0) PG8_BAR; }
    PG8_BAR;
    if constexpr (Epi::AFTER_DRAIN) { E.fused(acc, cur, wr, wc, fr, fq, lds, wid, lane); S.done(cur); }
#undef PG8_GOFF
#undef PG8_VA
#undef PG8_SA
#undef PG8_SB
#undef PG8_STAGE
#undef PG8_LDA
#undef PG8_LDB
#undef PG8_MMA
#undef PG8_WAIT_V
#undef PG8_WAIT_L
#undef PG8_BAR
#undef PG8_SCHED
}
}
constexpr int NWAVES = 8;
constexpr int BATCH = 8, SEQ = 4096, D = 1024, T = BATCH * SEQ;
constexpr int NPROJ = 5120;
constexpr int NTILE = NPROJ / 256;
constexpr float EPS = 1e-6f;
#ifndef MK_N_LAUNCHES
#define MK_N_LAUNCHES 1
#endif
#ifndef DBG_NPH
#define DBG_NPH 12
#endif
constexpr int NPH = DBG_NPH;
constexpr int N_LAUNCHES = MK_N_LAUNCHES;
static_assert(N_LAUNCHES == 1 || N_LAUNCHES == NPH, "MK_N_LAUNCHES is 1 or NPH");

constexpr size_t MiB = 1u << 20;
constexpr size_t WS_CTL = 0, CTL_ZERO_BYTES = 1 * MiB;
constexpr size_t WS_SMALL = 1 * MiB;
constexpr size_t WS_WIN = 2 * MiB;
constexpr size_t WS_WPA = 13 * MiB, WS_WPM = 14 * MiB, WS_WOUT = 15 * MiB;
constexpr size_t WS_TOKE = 17 * MiB;
constexpr size_t WS_TOKR = WS_TOKE + 256 * 1024;
constexpr size_t WS_TOKP = WS_TOKR + 256 * 1024;
constexpr size_t WS_TOKG = WS_TOKP + 256 * 1024;
constexpr size_t WS_CNT = WS_TOKG + 256 * 1024;
constexpr size_t WS_ROWTOK = WS_CNT + 64 * 1024;
constexpr int NROWS_MAX = 73728;
constexpr size_t WS_SC = 452 * MiB;
constexpr size_t WS_SC2 = 116 * MiB + 3 * ((size_t)T * 256 * 2);
constexpr size_t WS_GU = 20 * MiB;
constexpr size_t WS_DN = 84 * MiB;
constexpr size_t WS_PROJ = 116 * MiB;
constexpr size_t PROJ_TILE = (size_t)T * 256 * 2;
constexpr size_t WS_MLST = 116 * MiB;
constexpr size_t WS_MERGED = 116 * MiB;
constexpr size_t WS_XN = 180 * MiB;
constexpr size_t WS_XG = 244 * MiB;
constexpr size_t WS_HID = 388 * MiB;
constexpr size_t WS_Y = 244 * MiB;
constexpr size_t WS_END = 512 * MiB;
static_assert(WS_PROJ + NTILE * PROJ_TILE == 436 * MiB, "proj map");
constexpr size_t DO_H = 0, DO_YATT = 0, DO_YML = 32 * MiB, DO_KN = 64 * MiB, DO_IKR = 72 * MiB, DO_IQR = 74 * MiB, DO_AQN = 90 * MiB;
constexpr int TL_AQ = 0, TL_KV = 2, TL_IQ = 3, TL_MQ = 4, TL_MK = 6, TL_MV = 8, TL_MO = 10, TL_GA = 12, TL_GM = 16;
constexpr size_t WS_WSM = WS_SMALL + 64 * 1024;
constexpr size_t WS_WTG = WS_SMALL + 192 * 1024;
constexpr size_t DO_SMB = 122 * MiB;
constexpr int CW_BAR = 4096;
constexpr int CW_Q = 16384;
constexpr int LDS_BYTES = 163840, MISC_OFF = LDS_BYTES - 512;

#define GAS __attribute__((address_space(1)))
#define LAS __attribute__((address_space(3)))
typedef unsigned short bf16;
typedef unsigned v4u __attribute__((ext_vector_type(4)));
typedef unsigned v2u __attribute__((ext_vector_type(2)));
typedef float f32x4 __attribute__((ext_vector_type(4)));
typedef float f32x2 __attribute__((ext_vector_type(2)));
typedef short bf16x8 __attribute__((ext_vector_type(8)));
typedef GAS unsigned gu32;
#define RLX_AGENT __ATOMIC_RELAXED, __HIP_MEMORY_SCOPE_AGENT
#define LDS_WAIT() asm volatile("s_waitcnt lgkmcnt(0)" ::: "memory")
__device__ __forceinline__ float bf2f(unsigned b16) { return __uint_as_float(b16 << 16); }
__device__ __forceinline__ unsigned f2bf(float f) { unsigned u = __float_as_uint(f); return (u + 0x7fffu + ((u >> 16) & 1u)) >> 16; }
__device__ __forceinline__ unsigned pk2(float lo, float hi) { return pg8::cvt_pk_bf16(lo, hi); }
__device__ __forceinline__ float sigm(float x) { return 1.0f / (1.0f + __expf(-x)); }
__device__ __forceinline__ float wave_sum(float v) {
    v += __int_as_float(__builtin_amdgcn_update_dpp(0, __float_as_int(v), 0xB1, 0xF, 0xF, true));
    v += __int_as_float(__builtin_amdgcn_update_dpp(0, __float_as_int(v), 0x4E, 0xF, 0xF, true));
    v += __int_as_float(__builtin_amdgcn_update_dpp(0, __float_as_int(v), 0x124, 0xF, 0xF, true));
    v += __int_as_float(__builtin_amdgcn_update_dpp(0, __float_as_int(v), 0x128, 0xF, 0xF, true));
    { const auto r = __builtin_amdgcn_permlane16_swap(__float_as_uint(v), __float_as_uint(v), false, false); v = __uint_as_float(r[0]) + __uint_as_float(r[1]); }
    { const auto r = __builtin_amdgcn_permlane32_swap(__float_as_uint(v), __float_as_uint(v), false, false); v = __uint_as_float(r[0]) + __uint_as_float(r[1]); }
    return v;
}
__device__ __forceinline__ void unpack8(const v4u r, float (&f)[8]) {
    f[0] = bf2f(r.x & 0xffffu); f[1] = bf2f(r.x >> 16); f[2] = bf2f(r.y & 0xffffu); f[3] = bf2f(r.y >> 16);
    f[4] = bf2f(r.z & 0xffffu); f[5] = bf2f(r.z >> 16); f[6] = bf2f(r.w & 0xffffu); f[7] = bf2f(r.w >> 16);
}
__device__ __forceinline__ v4u pack8(const float (&f)[8]) { v4u w; w.x = pk2(f[0], f[1]); w.y = pk2(f[2], f[3]); w.z = pk2(f[4], f[5]); w.w = pk2(f[6], f[7]); return w; }
#define XB_TMO      128
#define XB_XCNT(j)  (256  + 64 * (j))
#define XB_XSUB(j)  (1280 + 64 * (j))
#define XB_XGEN(j)  (2304 + 64 * (j))
#define XB_TOP      3328
#define XB_TOPGEN   3392
#define XCD_BAR_WORDS 3456
#define XB_SPIN_CAP (1u << 18)

__device__ __forceinline__ unsigned xb_ld(unsigned* p)              { return __hip_atomic_load(p, __ATOMIC_RELAXED, __HIP_MEMORY_SCOPE_AGENT); }
__device__ __forceinline__ unsigned xb_add(unsigned* p, unsigned v) { return __hip_atomic_fetch_add(p, v, __ATOMIC_RELAXED, __HIP_MEMORY_SCOPE_AGENT); }
__device__ __forceinline__ unsigned xb_xcc_id() { return (unsigned)__builtin_amdgcn_s_getreg((3 << 11) | 20) & 0xFu; }
#define XB_SPIN(cond, bar) do { unsigned _sp = 0; while (cond) { __builtin_amdgcn_s_sleep(1); \
    if ((++_sp & 255u) == 0u) { if (xb_ld(&(bar)[XB_TMO])) break; if (_sp > XB_SPIN_CAP) { atomicAdd(&(bar)[XB_TMO], 1u); break; } } } } while (0)

struct XcdBarrier {
    unsigned* bar; unsigned x;
    volatile LAS unsigned* st;
};

__device__ __forceinline__ XcdBarrier xcd_barrier_post(unsigned* bar, volatile LAS unsigned* st) {
    XcdBarrier b; b.bar = bar; b.x = xb_xcc_id(); b.st = st;
    if (threadIdx.x == 0) (void)xb_add(&bar[XB_XCNT(b.x)], 1u);
    return b;
}
__device__ __forceinline__ void xcd_barrier_complete(unsigned* bar, unsigned x, unsigned& nloc, unsigned& nx) {
    const unsigned G = gridDim.x * gridDim.y * gridDim.z;
    unsigned sum, cnt, mine, sp = 0u;
    for (;;) {
        sum = 0u; cnt = 0u; mine = 0u;
#pragma unroll
        for (unsigned j = 0; j < 16; ++j) { const unsigned c = xb_ld(&bar[XB_XCNT(j)]); sum += c; cnt += (c > 0u) ? 1u : 0u; mine = (j == x) ? c : mine; }
        if (sum == G) break;
        __builtin_amdgcn_s_sleep(1);
        if ((++sp & 255u) == 0u) { if (xb_ld(&bar[XB_TMO])) break; if (sp > XB_SPIN_CAP) { atomicAdd(&bar[XB_TMO], 1u); break; } }
    }
    nloc = mine > 0u ? mine : 1u; nx = cnt > 0u ? cnt : 1u;
}

__device__ __forceinline__ void xcd_barrier(const XcdBarrier& b) {
    asm volatile("s_waitcnt vmcnt(0)" ::: "memory");
    __syncthreads();
    if (threadIdx.x == 0) {
        unsigned* bar = b.bar;
        __builtin_amdgcn_s_waitcnt(0);
        unsigned nloc = b.st[0], nx = b.st[1];
        if (nloc == 0u) { xcd_barrier_complete(bar, b.x, nloc, nx); b.st[0] = nloc; b.st[1] = nx; }
        const unsigned old = xb_add(&bar[XB_XSUB(b.x)], 1u);
        const unsigned gen = old / nloc;
        if (old + 1u == (gen + 1u) * nloc) {
            __builtin_amdgcn_fence(__ATOMIC_RELEASE, "agent");
            asm volatile("s_waitcnt vmcnt(0)" ::: "memory");
            const unsigned og = xb_add(&bar[XB_TOP], 1u);
            const unsigned tg = og / nx;
            if (og + 1u == (tg + 1u) * nx) xb_add(&bar[XB_TOPGEN], 1u);
            else XB_SPIN(xb_ld(&bar[XB_TOPGEN]) == tg, bar);
            __builtin_amdgcn_fence(__ATOMIC_ACQUIRE, "agent");
            xb_add(&bar[XB_XGEN(b.x)], 1u);
            asm volatile("s_waitcnt vmcnt(0)" ::: "memory");
        } else {
            XB_SPIN(xb_ld(&bar[XB_XGEN(b.x)]) == gen, bar);
            __builtin_amdgcn_fence(__ATOMIC_ACQUIRE, "agent");
            asm volatile("s_waitcnt vmcnt(0)" ::: "memory");
        }
    }
    __syncthreads();
}
struct Args { const float* in[22]; float* out; unsigned char* ws; int ph_lo, ph_hi, li, pad; };
struct Ctx { int tid, lane, wave, G, vcu; LAS unsigned char* lds; };
#define IN_X 0
#define IN_POS 1
#define IN_GMIX 2
#define IN_WIN 3
#define IN_GQ 4
#define IN_GK 5
#define IN_WCONV 6
#define IN_BCONV 7
#define IN_BI 8
#define IN_BF 9
#define IN_GML 10
#define IN_WPA 11
#define IN_WPM 12
#define IN_WOUT 13
#define IN_GMOE 14
#define IN_WRG 15
#define IN_BRG 16
#define IN_WRE 17
#define IN_BRE 18
#define IN_WEG 19
#define IN_WEU 20
#define IN_WED 21

__device__ __forceinline__ int win_src_col(int n) {
    if (n < 1024) return n;
    if (n < 3072) return n + 40;
    return n + 48;
}
__device__ __forceinline__ int wsm_src_col(int r) {
    return r < 40 ? 1024 + r : (r < 44 ? 3112 + (r - 40) : 3116 + (r - 44));
}
__device__ __forceinline__ void tr_item(const float* W, int ldw, int scol, int k0, bf16* wt0, int K, LAS float* scr, int lane) {
    const int sc0 = __builtin_amdgcn_readfirstlane(scol), sc31 = __builtin_amdgcn_readlane(scol, 31);
    if (sc0 >= 0 && sc31 == sc0 + 31 && (sc0 & 3) == 0 && (ldw & 3) == 0) {
#pragma unroll
        for (int i = 0; i < 8; ++i) { const int kk = 8 * i + (lane >> 3); const f32x4 v = *(const f32x4*)(W + (size_t)(k0 + kk) * ldw + sc0 + 4 * (lane & 7));
            LAS float* d = scr + kk * 33 + 4 * (lane & 7); d[0] = v[0]; d[1] = v[1]; d[2] = v[2]; d[3] = v[3]; }
    } else {
#pragma unroll 8
        for (int i = 0; i < 32; ++i) { const int kk = 2 * i + (lane >> 5); scr[kk * 33 + (lane & 31)] = scol >= 0 ? W[(size_t)(k0 + kk) * ldw + scol] : 0.f; }
    }
    LDS_WAIT(); asm volatile("" ::: "memory");
    const int c = lane & 7;
#pragma unroll
    for (int j = 0; j < 4; ++j) { const int n = (lane >> 3) + 8 * j; const LAS float* s = scr + (8 * c) * 33 + n;
        v4u o; o.x = pk2(s[0 * 33], s[1 * 33]); o.y = pk2(s[2 * 33], s[3 * 33]); o.z = pk2(s[4 * 33], s[5 * 33]); o.w = pk2(s[6 * 33], s[7 * 33]);
        *(v4u*)(wt0 + (size_t)n * K + 8 * c) = o; }
    LDS_WAIT(); asm volatile("" ::: "memory");
}
template <int PART> __device__ __forceinline__ void p0_prologue(const Args& a, const Ctx& c, int gw, int NGW) {
    unsigned char* ws = a.ws;
    LAS float* scr = (LAS float*)(c.lds + c.wave * 16384);
    const int lane = c.lane;
    constexpr int I_IN = 16 * 160, I_PA = 8 * 32, I_PM = 8 * 32, I_OUT = 16 * 32, I_GU = 32 * 16 * 32, I_DN = 32 * 8 * 32;
    constexpr int NPRJ = I_IN + I_PA + I_PM + I_OUT, NIT = NPRJ + I_GU + I_DN;
    for (int it = (PART ? NPRJ : 0) + gw; it < (PART ? NIT : NPRJ); it += NGW) {
        int r = it;
        if (r < I_IN) { const int kb = r / 160, nb = r % 160; tr_item(a.in[IN_WIN], 5168, win_src_col(32 * nb + (lane & 31)), 64 * kb, (bf16*)(ws + WS_WIN) + (size_t)(32 * nb) * 1024 + 64 * kb, 1024, scr, lane); continue; } r -= I_IN;
        if (r < I_PA) { const int kb = r / 32, nb = r % 32; tr_item(a.in[IN_WPA], 1024, 32 * nb + (lane & 31), 64 * kb, (bf16*)(ws + WS_WPA) + (size_t)(32 * nb) * 512 + 64 * kb, 512, scr, lane); continue; } r -= I_PA;
        if (r < I_PM) { const int kb = r / 32, nb = r % 32; tr_item(a.in[IN_WPM], 1024, 32 * nb + (lane & 31), 64 * kb, (bf16*)(ws + WS_WPM) + (size_t)(32 * nb) * 512 + 64 * kb, 512, scr, lane); continue; } r -= I_PM;
        if (r < I_OUT) { const int kb = r / 32, nb = r % 32; tr_item(a.in[IN_WOUT], 1024, 32 * nb + (lane & 31), 64 * kb, (bf16*)(ws + WS_WOUT) + (size_t)(32 * nb) * 1024 + 64 * kb, 1024, scr, lane); continue; } r -= I_OUT;
        if (r < I_GU) { const int e = r / 512, q = r % 512, kb = q / 32, nb = q % 32, t = nb >> 3, bj = (nb >> 2) & 1, i0 = (nb & 3) * 32;
            const float* src = (bj ? a.in[IN_WEU] : a.in[IN_WEG]) + (size_t)e * 1024 * 512;
            tr_item(src, 512, 128 * t + i0 + (lane & 31), 64 * kb, (bf16*)(ws + WS_GU) + ((size_t)e * 1024 + 32 * nb) * 1024 + 64 * kb, 1024, scr, lane); continue; } r -= I_GU;
        { const int e = r / 256, q = r % 256, kb = q / 32, nb = q % 32;
            tr_item(a.in[IN_WED] + (size_t)e * 512 * 1024, 1024, 32 * nb + (lane & 31), 64 * kb, (bf16*)(ws + WS_DN) + ((size_t)e * 1024 + 32 * nb) * 512 + 64 * kb, 512, scr, lane); }
    }
    if (PART) return;
    { float* WTG = (float*)(ws + WS_WTG); for (int i = gw * 64 + lane; i < 36 * 1024; i += NGW * 64) { const int j = i >> 10, k = i & 1023;
        WTG[j * 1028 + k] = (j < 32 ? a.in[IN_WRE][k * 32 + j] : a.in[IN_WRG][k * 4 + (j - 32)]) * a.in[IN_GMOE][k]; } }
    { bf16* WSM = (bf16*)(ws + WS_WSM); for (int i = gw * 64 + lane; i < 48 * 1024; i += NGW * 64) { const int r = i >> 10, k = i & 1023; WSM[i] = (bf16)f2bf(a.in[IN_WIN][(size_t)k * 5168 + wsm_src_col(r)]); } }
    const float* g = a.in[IN_GMIX]; f32x4 gv[4];
#pragma unroll
    for (int j = 0; j < 4; ++j) gv[j] = *(const f32x4*)(g + 4 * lane + 256 * j);
    bf16* H = (bf16*)((unsigned char*)a.out + DO_H);
    for (int m0 = gw; m0 < T; m0 += 2 * NGW) {
        const int mA = m0, mB = (m0 + NGW < T) ? m0 + NGW : m0; const bool hasB = (m0 + NGW < T);
        const f32x4* xa = (const f32x4*)(a.in[IN_X] + (size_t)mA * D) + lane; const f32x4* xb = (const f32x4*)(a.in[IN_X] + (size_t)mB * D) + lane;
        f32x4 va[4], vb[4]; float sa = 0.f, sb = 0.f;
#pragma unroll
        for (int j = 0; j < 4; ++j) { va[j] = xa[64 * j]; vb[j] = xb[64 * j]; }
#pragma unroll
        for (int j = 0; j < 4; ++j) { sa += (va[j].x * va[j].x + va[j].y * va[j].y) + (va[j].z * va[j].z + va[j].w * va[j].w); sb += (vb[j].x * vb[j].x + vb[j].y * vb[j].y) + (vb[j].z * vb[j].z + vb[j].w * vb[j].w); }
        const float ra = rsqrtf(wave_sum(sa) * (1.f / D) + EPS), rb = rsqrtf(wave_sum(sb) * (1.f / D) + EPS);
        v2u* oa = (v2u*)(H + (size_t)mA * D) + lane; v2u* ob = (v2u*)(H + (size_t)mB * D) + lane;
#pragma unroll
        for (int j = 0; j < 4; ++j) { v2u w; w.x = pk2(va[j].x * ra * gv[j].x, va[j].y * ra * gv[j].y); w.y = pk2(va[j].z * ra * gv[j].z, va[j].w * ra * gv[j].w); oa[64 * j] = w; }
        if (hasB) {
#pragma unroll
        for (int j = 0; j < 4; ++j) { v2u w; w.x = pk2(vb[j].x * rb * gv[j].x, vb[j].y * rb * gv[j].y); w.y = pk2(vb[j].z * rb * gv[j].z, vb[j].w * rb * gv[j].w); ob[64 * j] = w; } }
    }
}

__device__ __forceinline__ const bf16* proj_tile(const Args& a, int tile) { return (const bf16*)(a.ws + WS_PROJ + (size_t)tile * PROJ_TILE); }
#define DPPF(x_, ctrl_) __int_as_float(__builtin_amdgcn_update_dpp(0, __float_as_int(x_), ctrl_, 0xF, 0xF, true))
__device__ __forceinline__ void p2_prep(const Args& a, const Ctx& c) {
    const int lane = c.lane, gw = c.vcu * NWAVES + c.wave, NGW = c.G * NWAVES;
    float invf = 0.f;
    if (lane < 8) invf = (float)pow(500000.0, -(double)lane / 8.0); else if (lane < 12) invf = (float)pow(500000.0, -(double)(lane - 8) / 4.0);
    float gq[8], gk[8];
#pragma unroll
    for (int i = 0; i < 8; ++i) { gq[i] = a.in[IN_GQ][8 * (lane & 7) + i]; gk[i] = a.in[IN_GK][8 * (lane & 7) + i]; }
    const int* pos = (const int*)a.in[IN_POS];
    unsigned char* dout = (unsigned char*)a.out;
    bf16* AQN = (bf16*)(dout + DO_AQN); bf16* KN = (bf16*)(dout + DO_KN); bf16* IQR = (bf16*)(dout + DO_IQR); bf16* IKR = (bf16*)(dout + DO_IKR);
    { const bf16* Hh = (const bf16*)(dout + DO_H); const bf16* WSM = (const bf16*)(a.ws + WS_WSM); bf16* SMB = (bf16*)(dout + DO_SMB);
      const int row = lane & 15, kg = lane >> 4;
      const float invfk = (float)pow(500000.0, -(double)(lane & 3) / 4.0);
      for (int tile = gw; tile < T / 16; tile += NGW) { const int t0 = tile * 16;
          f32x4 acc[3];
#pragma unroll
          for (int ct = 0; ct < 3; ++ct) acc[ct] = (f32x4){0.f, 0.f, 0.f, 0.f};
          const bf16* ap = Hh + (size_t)(t0 + row) * 1024 + 8 * kg; const bf16* bp = WSM + (size_t)row * 1024 + 8 * kg;
#pragma unroll 8
          for (int ks = 0; ks < 32; ++ks) { const bf16x8 av = *(const bf16x8*)(ap + 32 * ks);
#pragma unroll
              for (int ct = 0; ct < 3; ++ct) acc[ct] = __builtin_amdgcn_mfma_f32_16x16x32_bf16(av, *(const bf16x8*)(bp + (size_t)ct * 16 * 1024 + 32 * ks), acc[ct], 0, 0, 0); }
          const int col = lane & 15;
#pragma unroll
          for (int r = 0; r < 4; ++r) { const int t = t0 + 4 * kg + r;
              const float angk = (float)pos[t] * invfk;
              const double revk = (double)angk * 0.15915494309189535; const float frk = (float)(revk - __builtin_rint(revk));
              const float ck = __builtin_amdgcn_cosf(frk), sk = __builtin_amdgcn_sinf(frk);
              const float v0 = acc[0][r], pr = __shfl_xor(v0, 4);
              const float o0 = (col < 4) ? (v0 * ck - pr * sk) : ((col < 8) ? (v0 * ck + pr * sk) : v0);
              IKR[(size_t)t * 32 + col] = (bf16)f2bf(o0); IKR[(size_t)t * 32 + 16 + col] = (bf16)f2bf(acc[1][r]);
              SMB[(size_t)t * 16 + col] = (bf16)f2bf(acc[2][r]); } } }
    const int l7 = lane & 7;
    const int aqcol = (lane >> 3) * 64 + 8 * l7, akcol = ((lane & 15) >> 3) * 64 + 8 * l7;
    const bf16* aqsrc = proj_tile(a, TL_AQ + (aqcol >> 8)) + (aqcol & 255); const bf16* aksrc = proj_tile(a, TL_KV) + akcol; const bf16* iqsrc = proj_tile(a, TL_IQ) + 4 * lane;
#define P2_LOADROW(t_, P_, A_, K_, Q_) do { const int tt_ = (t_) < T ? (t_) : T - 1; P_ = pos[tt_]; A_ = *(const v4u*)(aqsrc + (size_t)tt_ * 256); K_ = *(const v4u*)(aksrc + (size_t)tt_ * 256); Q_ = *(const v2u*)(iqsrc + (size_t)tt_ * 256); } while (0)
#define P2_DOROW(t, P_, A_, K_, Q_) do { \
        const float ang = (float)(P_) * invf; \
        const double rev = (double)ang * 0.15915494309189535; const float frv = (float)(rev - __builtin_rint(rev)); \
        float cs = __builtin_amdgcn_cosf(frv), sn = __builtin_amdgcn_sinf(frv); \
        float ca[8], sa[8], ci[4], si[4]; \
        _Pragma("unroll") for (int i = 0; i < 8; ++i) { ca[i] = __int_as_float(__builtin_amdgcn_readlane(__float_as_int(cs), i)); sa[i] = __int_as_float(__builtin_amdgcn_readlane(__float_as_int(sn), i)); } \
        _Pragma("unroll") for (int i = 0; i < 4; ++i) { ci[i] = __int_as_float(__builtin_amdgcn_readlane(__float_as_int(cs), 8 + i)); si[i] = __int_as_float(__builtin_amdgcn_readlane(__float_as_int(sn), 8 + i)); } \
        { float f[8]; unpack8(A_, f); float ss = 0.f; \
          _Pragma("unroll") for (int i = 0; i < 8; ++i) ss += f[i] * f[i]; \
          ss += DPPF(ss, 0xB1); ss += DPPF(ss, 0x4E); ss += DPPF(ss, 0x141); \
          const float r = rsqrtf(ss * (1.f / 64.f) + EPS); \
          _Pragma("unroll") for (int i = 0; i < 8; ++i) f[i] = f[i] * r * gq[i]; \
          float o[8]; \
          _Pragma("unroll") for (int i = 0; i < 8; ++i) { const float p = DPPF(f[i], 0xB1); o[i] = (l7 == 0) ? (f[i] * ca[i] - p * sa[i]) : ((l7 == 1) ? (f[i] * ca[i] + p * sa[i]) : f[i]); o[i] *= 0.125f * 1.4426950408889634f; } \
          *(v4u*)(AQN + (size_t)(t) * 512 + aqcol) = pack8(o); } \
        { float f[8]; unpack8(K_, f); float ss = 0.f; \
          _Pragma("unroll") for (int i = 0; i < 8; ++i) ss += f[i] * f[i]; \
          ss += DPPF(ss, 0xB1); ss += DPPF(ss, 0x4E); ss += DPPF(ss, 0x141); \
          const float r = rsqrtf(ss * (1.f / 64.f) + EPS); \
          _Pragma("unroll") for (int i = 0; i < 8; ++i) f[i] = f[i] * r * gk[i]; \
          float o[8]; \
          _Pragma("unroll") for (int i = 0; i < 8; ++i) { const float p = DPPF(f[i], 0xB1); o[i] = (l7 == 0) ? (f[i] * ca[i] - p * sa[i]) : ((l7 == 1) ? (f[i] * ca[i] + p * sa[i]) : f[i]); } \
          if (lane < 16) *(v4u*)(KN + (size_t)(t) * 128 + akcol) = pack8(o); } \
        { const v2u rw = Q_; \
          float f[4] = {bf2f(rw.x & 0xffffu), bf2f(rw.x >> 16), bf2f(rw.y & 0xffffu), bf2f(rw.y >> 16)}; float o[4]; \
          _Pragma("unroll") for (int i = 0; i < 4; ++i) { const float p = DPPF(f[i], 0xB1); o[i] = (l7 == 0) ? (f[i] * ci[i] - p * si[i]) : ((l7 == 1) ? (f[i] * ci[i] + p * si[i]) : f[i]); } \
          v2u w; w.x = pk2(o[0], o[1]); w.y = pk2(o[2], o[3]); *(v2u*)(IQR + (size_t)(t) * 256 + 4 * lane) = w; } } while (0)
    { int pA, pB; v4u aA, aB, kA, kB; v2u qA, qB;
      P2_LOADROW(gw, pA, aA, kA, qA);
#pragma unroll 1
      for (int t = gw; t < T; t += 2 * NGW) {
          P2_LOADROW(t + NGW, pB, aB, kB, qB);
          P2_DOROW(t, pA, aA, kA, qA);
          P2_LOADROW(t + 2 * NGW, pA, aA, kA, qA);
          if (t + NGW < T) P2_DOROW(t + NGW, pB, aB, kB, qB);
      } }
#undef P2_LOADROW
#undef P2_DOROW
}
constexpr int ML_QS = 0, ML_KS = 17408, ML_HS = 0;
constexpr int ML_KWT = 34816;
constexpr int ML_VT = 53248;
constexpr int ML_SW = 73984;
constexpr int ML_CT = 83200;
constexpr int ML_GA = 122368;
constexpr int ML_CW = ML_GA + 1024;
constexpr int ML_END = ML_CW + (1024 + 384) * 4;
static_assert(ML_END <= MISC_OFF, "mLSTM LDS map");
constexpr size_t ML_STATE_BYTES = 8 * 9 * 64 * 16;
__device__ __forceinline__ bf16x8 lds_frag(const LAS unsigned char* base, int stride_b, int row0, int kb, int lane) {
    return *(const LAS bf16x8*)(base + (row0 + (lane & 15)) * stride_b + kb + (lane >> 4) * 16);
}
__device__ __forceinline__ bf16x8 lds_frag_sw(const LAS unsigned char* base, int row0, int ks, int lane) {
    const int row = row0 + (lane & 15); return *(const LAS bf16x8*)(base + row * 144 + 16 * (((ks * 4 + (lane >> 4)) + (row >> 3)) & 7));
}
#define MFMA16(a_, b_, c_) __builtin_amdgcn_mfma_f32_16x16x32_bf16(a_, b_, c_, 0, 0, 0)
template <int MODE>
__device__ __forceinline__ void mlstm_unit(const Args& a, const Ctx& c, int b, int h, int g) {
    const int tid = c.tid, wave = c.wave; LAS unsigned char* lds = c.lds;
#define ML_LAUNDER() int tv_ = tid; asm volatile("" : "+v"(tv_)); const int lane = tv_ & 63, seg = tv_ & 15, r2 = (tv_ >> 4) * 2; (void)lane; (void)seg; (void)r2
    const bf16* PQ = proj_tile(a, TL_MQ + (h >> 1)) + (h & 1) * 128;
    const bf16* PK = proj_tile(a, TL_MK + (h >> 1)) + (h & 1) * 128;
    const bf16* PV = proj_tile(a, TL_MV + (h >> 1)) + (h & 1) * 128;
    const bf16* PO = proj_tile(a, TL_MO + (h >> 1)) + (h & 1) * 128;
    const bf16* PS = (const bf16*)((unsigned char*)a.out + DO_SMB);
    bf16* YML = (bf16*)((unsigned char*)a.out + DO_YML);
    unsigned char* STB = a.ws + WS_MLST; float* MST = (float*)(a.ws + WS_MLST + 256 * ML_STATE_BYTES);
    LAS float* GAa = (LAS float*)(lds + ML_GA); LAS float* GAm = GAa + 64; LAS float* GAw = GAa + 128; LAS float* GAe = GAa + 192;
    LAS float* CWQ = (LAS float*)(lds + ML_CW); LAS float* CWK = CWQ + 512; LAS float* CBQ = CWQ + 1024; LAS float* CBK = CBQ + 128; LAS float* GN = CBK + 128;
    LAS bf16* VTs = (LAS bf16*)(lds + ML_VT);
    { const float* wc = a.in[IN_WCONV]; const int j = tid >> 7, d = tid & 127;
      CWQ[tid] = wc[j * 1024 + h * 128 + d]; CWK[tid] = wc[j * 1024 + 512 + h * 128 + d];
      if (tid < 128) { CBQ[tid] = a.in[IN_BCONV][h * 128 + tid]; CBK[tid] = a.in[IN_BCONV][512 + h * 128 + tid]; GN[tid] = a.in[IN_GML][h * 128 + tid]; } }
    for (int i = tid; i < 16 * 64; i += 512) { const int r = i >> 6, cc = i & 63; VTs[(128 + r) * 72 + cc] = (r == 0) ? (bf16)0x3F80 : (bf16)0; }
    const float big = a.in[IN_BI][h], bfg = a.in[IN_BF][h];
    const int slot0 = (b * 4 + h) * 8;
    f32x4 cacc[9];
    float m_st = 0.f;
    if (MODE == 1 && g > 0) { ML_LAUNDER();
        const f32x4* sp = (const f32x4*)(STB + (size_t)(slot0 + g) * ML_STATE_BYTES) + wave * 576 + lane;
#pragma unroll
        for (int i = 0; i < 9; ++i) cacc[i] = sp[64 * i];
        m_st = MST[slot0 + g];
#pragma unroll
        for (int ee = 0; ee < 9; ++ee) { v2u w; w.x = pk2(cacc[ee][0], cacc[ee][1]); w.y = pk2(cacc[ee][2], cacc[ee][3]);
            *(LAS v2u*)(lds + ML_CT + (ee * 16 + (lane & 15)) * 272 + (wave * 16 + 4 * (lane >> 4)) * 2) = w; }
    } else {
#pragma unroll
        for (int i = 0; i < 9; ++i) cacc[i] = (f32x4){0.f, 0.f, 0.f, 0.f};
        for (int i = tid; i < 144 * 136 / 2; i += 512) ((LAS unsigned*)(lds + ML_CT))[i] = 0u;
    }
    const size_t tb = (size_t)b * SEQ;
    const char* bq = (const char*)(PQ + tb * 256); const char* bk = (const char*)(PK + tb * 256); const char* bv = (const char*)(PV + tb * 256); const char* bo = (const char*)(PO + tb * 256); const char* bs = (const char*)(PS + tb * 16);
    v4u rq[5], rk[5], rv[2]; unsigned short gi = 0, gf = 0;
#define ML_LOAD(kc) do { _Pragma("unroll") for (int j_ = 0; j_ < 5; ++j_) { const int rr_ = 64 * (kc) + r2 - 3 + j_; const unsigned o_ = (unsigned)((rr_ < 0 ? 0 : rr_) * 512 + seg * 16); \
            v4u q_ = (v4u){0u, 0u, 0u, 0u}; if (MODE == 1) q_ = *(const v4u*)(bq + o_); v4u k_ = *(const v4u*)(bk + o_); if (rr_ < 0) { q_ = (v4u){0u, 0u, 0u, 0u}; k_ = q_; } rq[j_] = q_; rk[j_] = k_; } \
        _Pragma("unroll") for (int i_ = 0; i_ < 2; ++i_) rv[i_] = *(const v4u*)(bv + (unsigned)((64 * (kc) + r2 + i_) * 512 + seg * 16)); \
        gi = *(const unsigned short*)(bs + (unsigned)((64 * (kc) + lane) * 32 + (8 + h) * 2)); gf = *(const unsigned short*)(bs + (unsigned)((64 * (kc) + lane) * 32 + (12 + h) * 2)); } while (0)
    const int kc0 = (MODE == 1) ? 8 * g : 0, kc1 = (MODE == 1) ? 8 * g + 8 : 56;
    { ML_LAUNDER(); ML_LOAD(kc0); }
    __syncthreads();
#pragma unroll 1
    for (int kc = kc0; kc < kc1; ++kc) {
        float wkv, decay, m_new;
        if (MODE == 0 && kc > 0 && (kc & 7) == 0) { ML_LAUNDER();
            f32x4* sp = (f32x4*)(STB + (size_t)(slot0 + (kc >> 3)) * ML_STATE_BYTES) + wave * 576 + lane;
#pragma unroll
            for (int i = 0; i < 9; ++i) sp[64 * i] = cacc[i];
            if (tid == 0) MST[slot0 + (kc >> 3)] = m_st; }
        { ML_LAUNDER();
        const float fpre = bf2f(gf) + bfg, lf = fminf(fpre, 0.f) - log1pf(__expf(-fabsf(fpre)));
        const float ig = bf2f(gi) + big;
#define ML_SHR(x_, n_, id_) __int_as_float(__builtin_amdgcn_update_dpp(__float_as_int(id_), __float_as_int(x_), 0x110 + (n_), 0xF, 0xF, false))
        float bc = lf;
        bc += ML_SHR(bc, 1, 0.f); bc += ML_SHR(bc, 2, 0.f); bc += ML_SHR(bc, 4, 0.f); bc += ML_SHR(bc, 8, 0.f);
        { const float t0 = __int_as_float(__builtin_amdgcn_readlane(__float_as_int(bc), 15)), t1 = __int_as_float(__builtin_amdgcn_readlane(__float_as_int(bc), 31)), t2 = __int_as_float(__builtin_amdgcn_readlane(__float_as_int(bc), 47));
          bc += (lane >= 48) ? (t0 + t1 + t2) : ((lane >= 32) ? (t0 + t1) : ((lane >= 16) ? t0 : 0.f)); }
        const float av = ig - bc; float Ac = av;
        Ac = fmaxf(Ac, ML_SHR(Ac, 1, -3.0e38f)); Ac = fmaxf(Ac, ML_SHR(Ac, 2, -3.0e38f)); Ac = fmaxf(Ac, ML_SHR(Ac, 4, -3.0e38f)); Ac = fmaxf(Ac, ML_SHR(Ac, 8, -3.0e38f));
        { const float t0 = __int_as_float(__builtin_amdgcn_readlane(__float_as_int(Ac), 15)), t1 = __int_as_float(__builtin_amdgcn_readlane(__float_as_int(Ac), 31)), t2 = __int_as_float(__builtin_amdgcn_readlane(__float_as_int(Ac), 47));
          const float m01 = fmaxf(t0, t1), m012 = fmaxf(m01, t2);
          Ac = fmaxf(Ac, (lane >= 48) ? m012 : ((lane >= 32) ? m01 : ((lane >= 16) ? t0 : -3.0e38f))); }
#undef ML_SHR
        const float mA = fmaxf(m_st, Ac), Mk = __int_as_float(__builtin_amdgcn_readlane(__float_as_int(mA), 63)), blast = __int_as_float(__builtin_amdgcn_readlane(__float_as_int(bc), 63));
        wkv = __expf(av - Mk); decay = __expf(m_st - Mk); m_new = blast + Mk;
        if (MODE == 1 && wave == 0) { GAa[lane] = av; GAm[lane] = mA; GAw[lane] = __expf(m_st - mA); GAe[lane] = __expf(-(bc + mA)); } }
        { ML_LAUNDER(); float kw_[2][8];
#pragma unroll
          for (int i = 0; i < 2; ++i) { const int t = r2 + i; const float wkt = __shfl(wkv, t);
            float aq_[8], ak_[8];
            { const f32x4 b0 = *(const LAS f32x4*)(CBQ + seg * 8), b1 = *(const LAS f32x4*)(CBQ + seg * 8 + 4), c0 = *(const LAS f32x4*)(CBK + seg * 8), c1 = *(const LAS f32x4*)(CBK + seg * 8 + 4);
              aq_[0] = b0[0]; aq_[1] = b0[1]; aq_[2] = b0[2]; aq_[3] = b0[3]; aq_[4] = b1[0]; aq_[5] = b1[1]; aq_[6] = b1[2]; aq_[7] = b1[3];
              ak_[0] = c0[0]; ak_[1] = c0[1]; ak_[2] = c0[2]; ak_[3] = c0[3]; ak_[4] = c1[0]; ak_[5] = c1[1]; ak_[6] = c1[2]; ak_[7] = c1[3]; }
#pragma unroll
            for (int j = 0; j < 4; ++j) { float fk_[8]; unpack8(rk[i + j], fk_);
                const f32x4 x0 = *(const LAS f32x4*)(CWK + j * 128 + seg * 8), x1 = *(const LAS f32x4*)(CWK + j * 128 + seg * 8 + 4);
#pragma unroll
                for (int e = 0; e < 4; ++e) { ak_[e] += x0[e] * fk_[e]; ak_[4 + e] += x1[e] * fk_[4 + e]; }
                if (MODE == 1) { float fq_[8]; unpack8(rq[i + j], fq_);
                    const f32x4 w0 = *(const LAS f32x4*)(CWQ + j * 128 + seg * 8), w1 = *(const LAS f32x4*)(CWQ + j * 128 + seg * 8 + 4);
#pragma unroll
                    for (int e = 0; e < 4; ++e) { aq_[e] += w0[e] * fq_[e]; aq_[4 + e] += w1[e] * fq_[4 + e]; } } }
#pragma unroll
            for (int e = 0; e < 8; ++e) { ak_[e] = ak_[e] * sigm(ak_[e]) * 0.08838834764831845f; kw_[i][e] = ak_[e] * wkt; }
            if (MODE == 1) {
#pragma unroll
                for (int e = 0; e < 8; ++e) aq_[e] = aq_[e] * sigm(aq_[e]);
                *(LAS v4u*)(lds + ML_QS + t * 272 + seg * 16) = pack8(aq_);
                *(LAS v4u*)(lds + ML_KS + t * 272 + seg * 16) = pack8(ak_); } }
          const unsigned va[4] = {rv[0].x, rv[0].y, rv[0].z, rv[0].w}, vb[4] = {rv[1].x, rv[1].y, rv[1].z, rv[1].w};
          const int swo = 16 * (((r2 >> 3) + seg) & 7) + 2 * (r2 & 7);
#pragma unroll
          for (int e = 0; e < 8; ++e) { const int ro = (seg * 8 + e) * 144 + swo;
              *(LAS unsigned*)(lds + ML_KWT + ro) = pk2(kw_[0][e], kw_[1][e]);
              const unsigned lo = (e & 1) ? (va[e >> 1] >> 16) : (va[e >> 1] & 0xffffu), hi = (e & 1) ? (vb[e >> 1] >> 16) : (vb[e >> 1] & 0xffffu);
              *(LAS unsigned*)(lds + ML_VT + ro) = lo | (hi << 16); }
        if (kc + 1 < kc1) ML_LOAD(kc + 1); }
        __syncthreads();
        f32x4 hacc[5]; unsigned mo_r[8];
        const int tt = wave & 3, t0 = tt * 16, ne = (wave < 4) ? 5 : 4, e_first = (wave < 4) ? 0 : 5;
        if (MODE == 1) {
        { ML_LAUNDER(); const int tq = t0 + (lane & 15);
        bf16x8 qf[4];
#pragma unroll
        for (int ks = 0; ks < 4; ++ks) qf[ks] = lds_frag(lds + ML_QS, 272, t0, ks * 64, lane);
        const float mAt = GAm[tq], wit = GAw[tq];
#pragma unroll
        for (int si = 0; si < 2; ++si) { const int ss = 2 * (wave >> 2) + si, s0 = ss * 16; f32x4 sacc = (f32x4){0.f, 0.f, 0.f, 0.f};
            if (ss <= tt) {
#pragma unroll
                for (int ks = 0; ks < 4; ++ks) sacc = MFMA16(lds_frag(lds + ML_KS, 272, s0, ks * 64, lane), qf[ks], sacc);
#pragma unroll
                for (int r = 0; r < 4; ++r) { const int s = s0 + 4 * (lane >> 4) + r; sacc[r] = (s <= tq) ? sacc[r] * __expf(GAa[s] - mAt) : 0.f; } }
            v2u w; w.x = pk2(sacc[0], sacc[1]); w.y = pk2(sacc[2], sacc[3]);
            *(LAS v2u*)(lds + ML_SW + tq * 144 + s0 * 2 + (lane >> 4) * 8) = w; }
#pragma unroll
        for (int i = 0; i < 5; ++i) { hacc[i] = (f32x4){0.f, 0.f, 0.f, 0.f};
            if (i < ne) {
#pragma unroll
                for (int ks = 0; ks < 4; ++ks) hacc[i] = MFMA16(lds_frag(lds + ML_CT, 272, (e_first + i) * 16, ks * 64, lane), qf[ks], hacc[i]);
                hacc[i] = hacc[i] * wit; } }
#pragma unroll
        for (int i = 0; i < 8; ++i) mo_r[i] = *(const unsigned*)(bo + (unsigned)((64 * kc + 8 * wave + i) * 512 + 4 * lane)); }
        __syncthreads();
        { ML_LAUNDER(); const int tq = t0 + (lane & 15); bf16x8 swf[2];
#pragma unroll
          for (int ks = 0; ks < 2; ++ks) swf[ks] = lds_frag(lds + ML_SW, 144, t0, ks * 64, lane);
#pragma unroll
          for (int i = 0; i < 5; ++i) if (i < ne) { const int ee = e_first + i;
#pragma unroll
              for (int ks = 0; ks < 2; ++ks) hacc[i] = MFMA16(lds_frag_sw(lds + ML_VT, ee * 16, ks, lane), swf[ks], hacc[i]);
              if (ee < 8) *(LAS f32x4*)(lds + ML_HS + tq * 528 + (ee * 16 + 4 * (lane >> 4)) * 4) = hacc[i];
              else if ((lane >> 4) == 0) *(LAS float*)(lds + ML_HS + tq * 528 + 128 * 4) = hacc[i][0]; } }
        }
        { ML_LAUNDER(); const int d0 = wave * 16; bf16x8 kwf[2];
#pragma unroll
          for (int ks = 0; ks < 2; ++ks) kwf[ks] = lds_frag_sw(lds + ML_KWT, d0, ks, lane);
#pragma unroll
          for (int ee = 0; ee < 9; ++ee) { cacc[ee] = cacc[ee] * decay;
#pragma unroll
              for (int ks = 0; ks < 2; ++ks) cacc[ee] = MFMA16(kwf[ks], lds_frag_sw(lds + ML_VT, ee * 16, ks, lane), cacc[ee]);
              if (MODE == 1) { v2u w; w.x = pk2(cacc[ee][0], cacc[ee][1]); w.y = pk2(cacc[ee][2], cacc[ee][3]);
                  *(LAS v2u*)(lds + ML_CT + (ee * 16 + (lane & 15)) * 272 + (d0 + 4 * (lane >> 4)) * 2) = w; } } }
        __syncthreads();
        if (MODE == 1) {
        { ML_LAUNDER();
#pragma unroll
        for (int i = 0; i < 8; ++i) { const int t = 8 * wave + i;
            const f32x2 nv = *(const LAS f32x2*)(lds + ML_HS + t * 528 + lane * 8); const float den = *(const LAS float*)(lds + ML_HS + t * 528 + 512);
            const float dd = fmaxf(fabsf(den), GAe[t]); const float h0 = nv.x / dd, h1 = nv.y / dd;
            const float r = rsqrtf(wave_sum(h0 * h0 + h1 * h1) * (1.f / 128.f) + EPS);
            const float y0 = h0 * r * GN[2 * lane] * sigm(bf2f(mo_r[i] & 0xffffu)), y1 = h1 * r * GN[2 * lane + 1] * sigm(bf2f(mo_r[i] >> 16));
            *(unsigned*)(YML + (tb + 64 * kc + t) * 512 + h * 128 + 2 * lane) = pk2(y0, y1); } }
        __syncthreads();
        }
        m_st = m_new;
    }
    if (MODE == 0) { ML_LAUNDER();
        f32x4* sp = (f32x4*)(STB + (size_t)(slot0 + 7) * ML_STATE_BYTES) + wave * 576 + lane;
#pragma unroll
        for (int i = 0; i < 9; ++i) sp[64 * i] = cacc[i];
        if (tid == 0) MST[slot0 + 7] = m_st; }
#undef ML_LOAD
#undef ML_LAUNDER
}
constexpr int AT_HIST = 0;
constexpr int AT_HROW = 2049;
constexpr int AT_SEL = 131072 + 256;
constexpr int AT_MROW = 129;
constexpr int AT_SM = AT_SEL + 8448;
constexpr int AT_LUT = AT_SM + 256;
constexpr int AT_SEL2 = AT_LUT + 256;
static_assert(AT_SEL2 + 8448 <= MISC_OFF, "attention LDS map");
__device__ __forceinline__ unsigned score_key(float s) { unsigned u = __float_as_uint(s + 0.0f); return (u & 0x80000000u) ? ~u : (u | 0x80000000u); }
__device__ __forceinline__ unsigned wave_suffix_sum(unsigned v, int lane) {
#define AT_SHL(x_, n_) ((unsigned)__builtin_amdgcn_update_dpp(0, (int)(x_), 0x100 + (n_), 0xF, 0xF, false))
    v += AT_SHL(v, 1); v += AT_SHL(v, 2); v += AT_SHL(v, 4); v += AT_SHL(v, 8);
#undef AT_SHL
    const unsigned t1 = (unsigned)__builtin_amdgcn_readlane((int)v, 16), t2 = (unsigned)__builtin_amdgcn_readlane((int)v, 32), t3 = (unsigned)__builtin_amdgcn_readlane((int)v, 48);
    return v + ((lane < 16) ? (t1 + t2 + t3) : ((lane < 32) ? (t2 + t3) : ((lane < 48) ? t3 : 0u)));
}
template <int NK> __device__ __forceinline__ void at_resolve(const LAS unsigned long long* cand, LAS unsigned* mask, int m, int nd, int lane) {
    unsigned long long cv[NK];
#pragma unroll
    for (int k = 0; k < NK; ++k) { const int i = 64 * k + lane; unsigned long long x = 0ull; if (i < m) x = cand[i]; cv[k] = (i < m) ? ((((x >> 32) & 0xFFFFFull) << 16) | (x & 0xFFFFull)) : 0ull; }
    unsigned long long T = 0ull;
#pragma unroll 1
    for (int bit = 35; bit >= 16; --bit) { const unsigned long long test = T | (1ull << bit); int cge = 0;
#pragma unroll
        for (int k = 0; k < NK; ++k) cge += __popcll(__ballot(cv[k] >= test));
        if (cge >= nd) T = test; }
    int g = 0, t = 0;
#pragma unroll
    for (int k = 0; k < NK; ++k) { g += __popcll(__ballot(cv[k] >= T + 0x10000ull)); t += __popcll(__ballot(cv[k] >= T)); }
    t -= g;
    if (t > nd - g) {
#pragma unroll 1
        for (int bit = 15; bit >= 0; --bit) { const unsigned long long test = T | (1ull << bit); int cge = 0;
#pragma unroll
            for (int k = 0; k < NK; ++k) cge += __popcll(__ballot(cv[k] >= test));
            if (cge >= nd) T = test; } }
#pragma unroll
    for (int k = 0; k < NK; ++k) if (cv[k] >= T && cv[k] != 0ull) { const unsigned key = 0xFFFFu - (unsigned)(cv[k] & 0xFFFFull);
        __hip_atomic_fetch_or(&mask[key >> 5], 1u << (key & 31u), __ATOMIC_RELAXED, __HIP_MEMORY_SCOPE_WORKGROUP); }
}
__device__ __forceinline__ void attn_unit(const Args& a, const Ctx& c, int b, int qt, float cshift) {
    const int tid = c.tid, wave = c.wave; LAS unsigned char* lds = c.lds;
#define AT_LAUNDER() int tv_ = tid; asm volatile("" : "+v"(tv_)); const int lane = tv_ & 63, qi = tv_ & 15, fq = (tv_ >> 4) & 3; (void)lane; (void)qi; (void)fq
    const int q0u = qt * 32, ch = q0u >> 6, n = 64 * (ch + 1), ntiles = n >> 4;
    const size_t tb = (size_t)b * SEQ;
    unsigned char* dout = (unsigned char*)a.out;
    const bf16* AQN = (const bf16*)(dout + DO_AQN); const bf16* KN = (const bf16*)(dout + DO_KN); const bf16* IQR = (const bf16*)(dout + DO_IQR); const bf16* IKR = (const bf16*)(dout + DO_IKR);
    bf16* YATT = (bf16*)(dout + DO_YATT);
    const bf16* VB = proj_tile(a, TL_KV); const bf16* PS = (const bf16*)(dout + DO_SMB);
    LAS unsigned* HIST = (LAS unsigned*)(lds + AT_HIST);
    LAS unsigned long long* CAND = (LAS unsigned long long*)(lds + AT_HIST);
    LAS int* SM = (LAS int*)(lds + AT_SM);
    float* SC = (blockIdx.x < 240) ? (float*)(a.ws + WS_SC) + (size_t)blockIdx.x * (16 * 4096) : (float*)(a.ws + WS_SC2) + (size_t)(blockIdx.x - 240) * (16 * 4096);
#ifndef DBG_REP_DENSE
#define DBG_REP_DENSE 1
#endif
#pragma unroll 1
    for (int rsel = 0; rsel < 2; ++rsel) {
    const int q0 = q0u + 16 * rsel;
    LAS unsigned* MASK = (LAS unsigned*)(lds + (rsel ? AT_SEL2 : AT_SEL));
    if (n > 256) {
        for (int i = tid; i < 8192 + 4; i += 512) ((LAS v4u*)HIST)[i] = (v4u){0u, 0u, 0u, 0u};
        if (tid < 64) SM[tid] = 0;
        for (int i = tid; i < 16 * AT_MROW; i += 512) MASK[i] = 0u;
        bf16x8 qf[8]; float wv[8];
        { AT_LAUNDER();
        const size_t trow = tb + q0 + qi;
#pragma unroll
        for (int h = 0; h < 8; ++h) qf[h] = *(const bf16x8*)(IQR + trow * 256 + h * 32 + 8 * fq);
        { float t8[8]; unpack8(*(const v4u*)(PS + trow * 16), t8);
#pragma unroll
          for (int h = 0; h < 8; ++h) wv[h] = t8[h] * 0.0625f; } }
        __syncthreads();
#define AT_LOADK(kt_) (*(const bf16x8*)(IKR + (tb + (size_t)(kt_) * 16 + qi) * 32 + 8 * fq))
#define AT_SCORES(kf_, sc_) do { \
        _Pragma("unroll") for (int r_ = 0; r_ < 4; ++r_) sc_[r_] = 0.f; \
        _Pragma("unroll") for (int h_ = 0; h_ < 8; ++h_) { const f32x4 d_ = MFMA16(kf_, qf[h_], ((f32x4){0.f, 0.f, 0.f, 0.f})); \
            _Pragma("unroll") for (int r_ = 0; r_ < 4; ++r_) { const int di_ = __float_as_int(d_[r_]); sc_[r_] = __builtin_fmaf(wv[h_], __int_as_float(di_ > 0 ? di_ : 0), sc_[r_]); } } } while (0)
        const int cnt = (ntiles - wave + 7) >> 3;
#ifndef DBG_RA
#define DBG_RA 1
#endif
#pragma unroll 1
        for (int rA = 0; rA < DBG_RA; ++rA) { if (rA) { for (int i = tid; i < 8192 + 4; i += 512) ((LAS v4u*)HIST)[i] = (v4u){0u, 0u, 0u, 0u}; __syncthreads(); }
#define AT_LOADG(dst_, i0_) do { _Pragma("unroll") for (int j_ = 0; j_ < 8; ++j_) { int kt_ = wave + 8 * ((i0_) + j_); kt_ = kt_ < ntiles ? kt_ : ntiles - 1; dst_[j_] = AT_LOADK(kt_); } } while (0)
#define AT_P1GROUP(buf_, base_) do { _Pragma("unroll") for (int j2 = 0; j2 < 8; ++j2) { const bool valid = ((base_) + j2 < cnt); const int kt = wave + 8 * ((base_) + j2); float sc[4]; AT_SCORES(buf_[j2], sc); \
                if (valid) *(f32x4*)(SC + qi * 4096 + kt * 16 + 4 * fq) = (f32x4){sc[0], sc[1], sc[2], sc[3]}; \
                _Pragma("unroll") for (int r = 0; r < 4; ++r) { const unsigned bin = score_key(sc[r]) >> 20; \
                    __hip_atomic_fetch_add(&HIST[qi * AT_HROW + (bin >> 1)], valid ? (1u << ((bin & 1u) * 16)) : 0u, __ATOMIC_RELAXED, __HIP_MEMORY_SCOPE_WORKGROUP); } } } while (0)
        { AT_LAUNDER(); bf16x8 ka[8], kb[8]; AT_LOADG(ka, 0);
#pragma unroll 1
          for (int i0 = 0; i0 < cnt; i0 += 16) {
            AT_LOADG(kb, i0 + 8);
            AT_P1GROUP(ka, i0);
            AT_LOADG(ka, i0 + 16);
            AT_P1GROUP(kb, i0 + 8); } }
#undef AT_P1GROUP
        __syncthreads();
        }
#ifndef DBG_RB
#define DBG_RB 1
#endif
#pragma unroll 1
        for (int rB = 0; rB < DBG_RB; ++rB) {
#pragma unroll 1
        for (int j = 0; j < 2; ++j) { AT_LAUNDER(); const int q = 2 * wave + j; unsigned tot = 0;
            for (int i = 0; i < 32; ++i) { const unsigned w = HIST[q * AT_HROW + 32 * lane + ((i + lane) & 31)]; tot += (w & 0xffffu) + (w >> 16); }
            const unsigned suf = wave_suffix_sum(tot, lane);
            const unsigned long long mk = __ballot(suf >= 256u); const int L = 63 - __clzll((long long)mk);
            const unsigned above_L = (unsigned)__builtin_amdgcn_readlane((int)(suf - tot), L);
            const unsigned w2 = HIST[q * AT_HROW + 32 * L + (lane >> 1)]; const unsigned cb = (lane & 1) ? (w2 >> 16) : (w2 & 0xffffu);
            const unsigned sfx = wave_suffix_sum(cb, lane);
            const unsigned long long mk2 = __ballot(above_L + sfx >= 256u); const int l2 = 63 - __clzll((long long)mk2);
            if (lane == l2) { SM[q] = 64 * L + l2; SM[16 + q] = (int)(256u - (above_L + sfx - cb)); } }
        __syncthreads();
        }
#ifndef DBG_RC
#define DBG_RC 1
#endif
#pragma unroll 1
        for (int rC = 0; rC < DBG_RC; ++rC) { if (rC) { if (tid < 16) SM[48 + tid] = 0; __syncthreads(); }
        { AT_LAUNDER(); const int Bq = SM[qi]; f32x4 scur[8];
#define AT_LOADS(dst_, i0_) do { _Pragma("unroll") for (int j_ = 0; j_ < 8; ++j_) { int kt_ = wave + 8 * ((i0_) + j_); kt_ = kt_ < ntiles ? kt_ : ntiles - 1; dst_[j_] = *(const f32x4*)(SC + qi * 4096 + kt_ * 16 + 4 * fq); } } while (0)
#define AT_P2GROUP(buf_, base_) do { _Pragma("unroll") for (int j2 = 0; j2 < 8; ++j2) { const bool valid = ((base_) + j2 < cnt); const int kt = wave + 8 * ((base_) + j2); \
                unsigned nib = 0u, cnib = 0u; unsigned uu[4]; \
                _Pragma("unroll") for (int r = 0; r < 4; ++r) { uu[r] = score_key(buf_[j2][r]); const int bin = (int)(uu[r] >> 20); nib |= (bin > Bq) ? (1u << r) : 0u; cnib |= (bin == Bq) ? (1u << r) : 0u; } \
                if (!valid) { nib = 0u; cnib = 0u; } \
                if (cnib) { int p = __hip_atomic_fetch_add(&SM[48 + qi], (int)__popc(cnib), __ATOMIC_RELAXED, __HIP_MEMORY_SCOPE_WORKGROUP); \
                    _Pragma("unroll") for (int r = 0; r < 4; ++r) if ((cnib >> r) & 1u) { if (p < 512) CAND[qi * 1024 + p] = ((unsigned long long)uu[r] << 32) | (unsigned long long)(0xFFFFu - (unsigned)(kt * 16 + 4 * fq + r)); ++p; } } \
                if (nib) __hip_atomic_fetch_or(&MASK[qi * AT_MROW + (kt >> 1)], nib << (16 * (kt & 1) + 4 * fq), __ATOMIC_RELAXED, __HIP_MEMORY_SCOPE_WORKGROUP); } } while (0)
          f32x4 sb2[8];
          AT_LOADS(scur, 0);
#pragma unroll 1
          for (int i0 = 0; i0 < cnt; i0 += 16) {
            AT_LOADS(sb2, i0 + 8);
            AT_P2GROUP(scur, i0);
            AT_LOADS(scur, i0 + 16);
            AT_P2GROUP(sb2, i0 + 8); } }
#undef AT_P2GROUP
#undef AT_LOADS
        __syncthreads();
        }
#ifndef DBG_RD
#define DBG_RD 1
#endif
#pragma unroll 1
        for (int rD = 0; rD < DBG_RD; ++rD) {
#pragma unroll 1
        for (int j = 0; j < 2; ++j) { AT_LAUNDER(); const int q = 2 * wave + j; int m = SM[48 + q]; m = m < 512 ? m : 512; const int nd = SM[16 + q];
            if (m <= 256) at_resolve<4>(CAND + q * 1024, MASK + q * AT_MROW, m, nd, lane); else at_resolve<8>(CAND + q * 1024, MASK + q * AT_MROW, m, nd, lane); }
        __syncthreads();
        }
#undef AT_SCORES
#undef AT_LOADK
#undef AT_LOADG
    } else {
#pragma unroll 1
        for (int i = tid; i < 16 * AT_MROW; i += 512) MASK[i] = ((i % AT_MROW) < (n >> 5)) ? 0xFFFFFFFFu : 0u;
        __syncthreads();
    }
    }
#pragma unroll 1
    for (int rden = 0; rden < DBG_REP_DENSE; ++rden) {
    { const int g = wave >> 2, qh = (wave >> 1) & 1, hp = wave & 1, NS = n >> 6;
      const unsigned ring0 = (unsigned)(size_t)(lds + AT_HIST);
      if (tid < 64) *(LAS float*)(lds + AT_LUT + 4 * tid) = ((tid >> 2) >> (tid & 3)) & 1 ? -cshift : -1.0e30f;
      const bf16* dsrc[4]; unsigned ddst[4];
      { AT_LAUNDER();
#pragma unroll
        for (int i_ = 0; i_ < 4; ++i_) { const int in_ = 4 * wave + i_; const int row_ = 4 * (in_ & 15) + (lane >> 4), pos_ = lane & 15;
            dsrc[i_] = (in_ < 16) ? (KN + (tb + row_) * 128 + ((pos_ ^ (row_ & 15)) << 3)) : (VB + (tb + row_) * 256 + 128 + ((pos_ ^ (2 * (row_ & 7))) << 3));
            ddst[i_] = (unsigned)(in_ * 1024); } }
      const size_t dstep = (wave < 4) ? (size_t)64 * 128 : (size_t)64 * 256;
#define AT_STAGE(s_) do { const unsigned sb_ = ring0 + (unsigned)(((s_) & 3) * 32768); \
        _Pragma("unroll") for (int i_ = 0; i_ < 4; ++i_) { const bf16* src_ = dsrc[i_] + (size_t)(s_) * dstep; \
            const unsigned dst_ = __builtin_amdgcn_readfirstlane(sb_ + ddst[i_]); unsigned keep_; \
            asm volatile("s_mov_b32 %0, m0\n\ts_mov_b32 m0, %2\n\ts_nop 0\n\tglobal_load_lds_dwordx4 %1, off\n\ts_mov_b32 m0, %0" : "=&s"(keep_) : "v"(src_), "s"(dst_) : "memory"); } } while (0)
      bf16x8 qa[2], qb[2]; f32x4 oacc[2][4], lacc[2];
      { AT_LAUNDER();
#pragma unroll
        for (int hi = 0; hi < 2; ++hi) { const bf16* qp = AQN + (tb + q0u + 16 * qh + qi) * 512 + (g * 4 + 2 * hp + hi) * 64 + 8 * fq; qa[hi] = *(const bf16x8*)qp; qb[hi] = *(const bf16x8*)(qp + 32); } }
#pragma unroll
      for (int hi = 0; hi < 2; ++hi) { lacc[hi] = (f32x4){0.f, 0.f, 0.f, 0.f};
#pragma unroll
        for (int dt = 0; dt < 4; ++dt) oacc[hi][dt] = (f32x4){0.f, 0.f, 0.f, 0.f}; }
      const bf16x8 ones = (bf16x8){0x3F80, 0x3F80, 0x3F80, 0x3F80, 0x3F80, 0x3F80, 0x3F80, 0x3F80};
      asm volatile("s_waitcnt vmcnt(0)" ::: "memory");
#pragma unroll 1
      for (int s = 0; s < 3 && s < NS; ++s) AT_STAGE(s);
      typedef short s4_t __attribute__((ext_vector_type(4)));
      AT_LAUNDER();
      const LAS unsigned* mrow = (const LAS unsigned*)(lds + (qh ? AT_SEL2 : AT_SEL)) + qi * AT_MROW;
      const unsigned koff0 = (unsigned)(qi * 256 + (((g * 8 + fq) ^ qi) << 4)), koff1 = (unsigned)(qi * 256 + (((g * 8 + 4 + fq) ^ qi) << 4));
#define AT_HALF(cur_, nxt_, nslot_, ntp_, nmw_, vslot_, vkh_) do { \
          const LAS unsigned char* kb_ = lds + AT_HIST + (nslot_) * 32768 + (ntp_) * 8192; const LAS unsigned char* vb_ = lds + AT_HIST + (vslot_) * 32768 + 16384 + (vkh_) * 8192; \
          bf16x8 kf_[2][2]; f32x4 ci_[2]; bf16x8 va_[4]; \
          _Pragma("unroll") for (int t = 0; t < 2; ++t) { kf_[t][0] = *(const LAS bf16x8*)(kb_ + t * 4096 + koff0); kf_[t][1] = *(const LAS bf16x8*)(kb_ + t * 4096 + koff1); \
              ci_[t] = *(const LAS f32x4*)(lds + AT_LUT + ((((nmw_) >> (16 * t + 4 * fq)) & 15u) << 4)); } \
          _Pragma("unroll") for (int dt = 0; dt < 4; ++dt) { const int r1 = 4 * fq + (qi >> 2); const int ch_ = g * 8 + 2 * dt + ((lane & 3) >> 1); \
              const s4_t lo = __builtin_amdgcn_ds_read_tr16_b64_v4i16((LAS s4_t*)(vb_ + r1 * 256 + ((ch_ ^ (2 * (r1 & 7))) << 4) + (lane & 1) * 8)); \
              const s4_t hi4 = __builtin_amdgcn_ds_read_tr16_b64_v4i16((LAS s4_t*)(vb_ + (r1 + 16) * 256 + ((ch_ ^ (2 * (r1 & 7))) << 4) + (lane & 1) * 8)); \
              va_[dt] = (bf16x8){lo[0], lo[1], lo[2], lo[3], hi4[0], hi4[1], hi4[2], hi4[3]}; } \
          _Pragma("unroll") for (int t = 0; t < 2; ++t) { \
              _Pragma("unroll") for (int hi = 0; hi < 2; ++hi) { const f32x4 d_ = MFMA16(kf_[t][0], qa[hi], ci_[t]); nxt_[hi][t] = MFMA16(kf_[t][1], qb[hi], d_); } } \
          bf16x8 pb_[2]; \
          _Pragma("unroll") for (int hi = 0; hi < 2; ++hi) { float pv[8]; \
              _Pragma("unroll") for (int j = 0; j < 8; ++j) pv[j] = __builtin_amdgcn_exp2f(cur_[hi][j >> 2][j & 3]); \
              v4u pw; pw.x = pk2(pv[0], pv[1]); pw.y = pk2(pv[2], pv[3]); pw.z = pk2(pv[4], pv[5]); pw.w = pk2(pv[6], pv[7]); pb_[hi] = __builtin_bit_cast(bf16x8, pw); \
              lacc[hi] = MFMA16(ones, pb_[hi], lacc[hi]); } \
          _Pragma("unroll") for (int dt = 0; dt < 4; ++dt) { \
              _Pragma("unroll") for (int hi = 0; hi < 2; ++hi) oacc[hi][dt] = MFMA16(va_[dt], pb_[hi], oacc[hi][dt]); } } while (0)
      f32x4 st0[2][2], st1[2][2];
      if (NS >= 3) asm volatile("s_waitcnt vmcnt(8)" ::: "memory"); else asm volatile("s_waitcnt vmcnt(0)" ::: "memory");
      __builtin_amdgcn_s_barrier(); asm volatile("" ::: "memory");
      unsigned mwB;
      { const unsigned mwA = mrow[0]; mwB = mrow[1];
        const LAS unsigned char* kb_ = lds + AT_HIST;
#pragma unroll
        for (int t = 0; t < 2; ++t) { const bf16x8 k0 = *(const LAS bf16x8*)(kb_ + t * 4096 + koff0), k1 = *(const LAS bf16x8*)(kb_ + t * 4096 + koff1);
            const f32x4 ci = *(const LAS f32x4*)(lds + AT_LUT + (((mwA >> (16 * t + 4 * fq)) & 15u) << 4));
#pragma unroll
            for (int hi = 0; hi < 2; ++hi) { const f32x4 d_ = MFMA16(k0, qa[hi], ci); st0[hi][t] = MFMA16(k1, qb[hi], d_); } } }
#pragma unroll 1
      for (int s = 0; s < NS; ++s) {
          if (s + 2 < NS) asm volatile("s_waitcnt vmcnt(4)" ::: "memory"); else asm volatile("s_waitcnt vmcnt(0)" ::: "memory");
          __builtin_amdgcn_s_barrier(); asm volatile("" ::: "memory");
          if (s + 3 < NS) AT_STAGE(s + 3);
          const int s1 = (s + 1 < NS) ? s + 1 : s;
          const unsigned nA = mrow[2 * s1], nB = mrow[2 * s1 + 1];
          AT_HALF(st0, st1, (s & 3), 1, mwB, (s & 3), 0);
          AT_HALF(st1, st0, (s1 & 3), 0, nA, (s & 3), 1);
          mwB = nB; }
#undef AT_HALF
      { AT_LAUNDER();
#pragma unroll
        for (int hi = 0; hi < 2; ++hi) { const float inv = 1.0f / lacc[hi][0];
            bf16* yp = YATT + (tb + q0u + 16 * qh + qi) * 512 + (g * 4 + 2 * hp + hi) * 64 + 4 * fq;
#pragma unroll
            for (int dt = 0; dt < 4; ++dt) { const f32x4 o = oacc[hi][dt];
                v2u w; w.x = pk2(o[0] * inv, o[1] * inv); w.y = pk2(o[2] * inv, o[3] * inv); *(v2u*)(yp + 16 * dt) = w; } } }
#undef AT_STAGE
    }
    __syncthreads();
    }
#undef AT_LAUNDER
    __syncthreads();
}

#ifndef DBG_REP_ML
#define DBG_REP_ML 1
#endif
#ifndef DBG_REP_ATT
#define DBG_REP_ATT 1
#endif
__device__ __forceinline__ void p3_mixer(const Args& a, const Ctx& c, volatile LAS unsigned* MISC, int rep) {
#if !defined(NO_MLSTM)
#pragma unroll 1
    for (int rr = 0; rr < DBG_REP_ML; ++rr)
#pragma unroll 1
        for (int u = blockIdx.x; u < 32; u += c.G) mlstm_unit<0>(a, c, u >> 2, u & 3, 0);
#endif
    unsigned* ctl = (unsigned*)(a.ws + WS_CTL);
    const int x = (int)(__builtin_amdgcn_s_getreg((3 << 11) | 20) & 7u);
    float cshift;
    { float gq = fabsf(a.in[IN_GQ][c.lane]), gk = fabsf(a.in[IN_GK][c.lane]);
#pragma unroll
      for (int o = 1; o < 64; o <<= 1) { gq = fmaxf(gq, __shfl_xor(gq, o)); gk = fmaxf(gk, __shfl_xor(gk, o)); }
      cshift = 8.0f * 1.4426950408889634f * gq * gk; }
#pragma unroll 1
    for (int rot = 0; rot < 8 * DBG_REP_ATT; ++rot) { rep = rot >> 3; const int bq = (x + rot) & 7;
        if (c.tid == 0) MISC[16] = __hip_atomic_fetch_add(ctl + CW_Q + 512 * rep + 64 * bq, 1u, RLX_AGENT);
        __syncthreads();
        int u = (int)MISC[16];
        __syncthreads();
#pragma unroll 1
        while (u < 128) {
            unsigned nxt = 0u;
            if (c.tid == 0) nxt = __hip_atomic_fetch_add(ctl + CW_Q + 512 * rep + 64 * bq, 1u, RLX_AGENT);
#if !defined(NO_ATTN)
            attn_unit(a, c, bq, 127 - u, cshift);
#endif
            if (c.tid == 0) MISC[16] = nxt;
            __syncthreads();
            u = (int)MISC[16];
            __syncthreads();
        } }
}
constexpr int RT_WT = 0;
constexpr int RT_WROW = 1028;
constexpr int RT_LG = 36 * RT_WROW * 4;
constexpr int RT_RSTD = RT_LG + 64 * 36 * 4;
constexpr int RT_LCNT = RT_RSTD + 512;
static_assert(RT_LCNT + 128 <= MISC_OFF, "router LDS map");
__device__ __forceinline__ void p6_router(const Args& a, const Ctx& c) {
    const int tid = c.tid, lane = c.lane, wave = c.wave; LAS unsigned char* lds = c.lds;
    LAS float* WT = (LAS float*)(lds + RT_WT); LAS float* LG = (LAS float*)(lds + RT_LG); LAS float* RSTD = (LAS float*)(lds + RT_RSTD); LAS int* LCNT = (LAS int*)(lds + RT_LCNT);
    { int* RT = (int*)(a.ws + WS_ROWTOK); for (int i = blockIdx.x * 512 + tid; i < NROWS_MAX; i += c.G * 512) RT[i] = 0; }
    { const f32x4* src = (const f32x4*)(a.ws + WS_WTG); LAS f32x4* dst = (LAS f32x4*)WT; for (int i = tid; i < 36 * RT_WROW / 4; i += 512) dst[i] = src[i]; }
    f32x4 gv[4];
#pragma unroll
    for (int j = 0; j < 4; ++j) gv[j] = *(const f32x4*)(a.in[IN_GMOE] + 4 * lane + 256 * j);
    const float* X1 = a.out; bf16* XN = (bf16*)(a.ws + WS_XN);
    int* TOKE = (int*)(a.ws + WS_TOKE); int* TOKR = (int*)(a.ws + WS_TOKR); float* TOKG = (float*)(a.ws + WS_TOKG); int* CNT = (int*)(a.ws + WS_CNT);
    __syncthreads();
    for (int blk = blockIdx.x; blk < 256; blk += c.G) {
        if (tid < 32) LCNT[tid] = 0;
#pragma unroll 1
        for (int ri = 0; ri < 16; ri += 2) { const int tA = blk * 128 + wave * 16 + ri, tB = tA + 1;
            const f32x4* xa = (const f32x4*)(X1 + (size_t)tA * D) + lane; const f32x4* xb = (const f32x4*)(X1 + (size_t)tB * D) + lane;
            f32x4 va[4], vb[4]; float sa = 0.f, sb = 0.f;
#pragma unroll
            for (int j = 0; j < 4; ++j) { va[j] = xa[64 * j]; vb[j] = xb[64 * j]; }
#pragma unroll
            for (int j = 0; j < 4; ++j) { sa += (va[j].x * va[j].x + va[j].y * va[j].y) + (va[j].z * va[j].z + va[j].w * va[j].w); sb += (vb[j].x * vb[j].x + vb[j].y * vb[j].y) + (vb[j].z * vb[j].z + vb[j].w * vb[j].w); }
            const float ra = rsqrtf(wave_sum(sa) * (1.f / D) + EPS), rb = rsqrtf(wave_sum(sb) * (1.f / D) + EPS);
            if (lane == 0) { RSTD[wave * 16 + ri] = ra; RSTD[wave * 16 + ri + 1] = rb; }
            v2u* oa = (v2u*)(XN + (size_t)tA * D) + lane; v2u* ob = (v2u*)(XN + (size_t)tB * D) + lane;
#pragma unroll
            for (int j = 0; j < 4; ++j) { v2u w; w.x = pk2(va[j].x * ra * gv[j].x, va[j].y * ra * gv[j].y); w.y = pk2(va[j].z * ra * gv[j].z, va[j].w * ra * gv[j].w); oa[64 * j] = w;
                v2u u; u.x = pk2(vb[j].x * rb * gv[j].x, vb[j].y * rb * gv[j].y); u.y = pk2(vb[j].z * rb * gv[j].z, vb[j].w * rb * gv[j].w); ob[64 * j] = u; } }
        f32x4 acc[3];
#pragma unroll
        for (int ct = 0; ct < 3; ++ct) acc[ct] = (f32x4){0.f, 0.f, 0.f, 0.f};
        { const int row = lane & 15, kq = lane >> 4;
          const f32x4* ap = (const f32x4*)(X1 + (size_t)(blk * 128 + wave * 16 + row) * D + 4 * kq);
          int cj[3]; cj[0] = row; cj[1] = 16 + row; cj[2] = (32 + row) < 36 ? (32 + row) : 35;
          const LAS f32x4* bp0 = (const LAS f32x4*)(WT + cj[0] * RT_WROW + 4 * kq); const LAS f32x4* bp1 = (const LAS f32x4*)(WT + cj[1] * RT_WROW + 4 * kq); const LAS f32x4* bp2 = (const LAS f32x4*)(WT + cj[2] * RT_WROW + 4 * kq);
#define RT_LOADA(dst_, b_) do { _Pragma("unroll") for (int i_ = 0; i_ < 8; ++i_) dst_[i_] = ap[4 * (8 * ((b_) < 8 ? (b_) : 7) + i_)]; } while (0)
#define RT_MMA(src_, b_) do { _Pragma("unroll") for (int i_ = 0; i_ < 8; ++i_) { const int ks_ = 8 * (b_) + i_; const f32x4 b0 = bp0[4 * ks_], b1 = bp1[4 * ks_], b2 = bp2[4 * ks_]; \
              _Pragma("unroll") for (int j = 0; j < 4; ++j) { acc[0] = __builtin_amdgcn_mfma_f32_16x16x4f32(src_[i_][j], b0[j], acc[0], 0, 0, 0); acc[1] = __builtin_amdgcn_mfma_f32_16x16x4f32(src_[i_][j], b1[j], acc[1], 0, 0, 0); \
                  acc[2] = __builtin_amdgcn_mfma_f32_16x16x4f32(src_[i_][j], b2[j], acc[2], 0, 0, 0); } } } while (0)
          f32x4 aA[8], aB[8]; RT_LOADA(aA, 0);
#pragma unroll 1
          for (int bb = 0; bb < 8; bb += 2) { RT_LOADA(aB, bb + 1); RT_MMA(aA, bb); RT_LOADA(aA, bb + 2); RT_MMA(aB, bb + 1); }
#undef RT_LOADA
#undef RT_MMA
        }
#pragma unroll 1
        for (int half = 0; half < 2; ++half) {
            __syncthreads();
            if ((wave >> 2) == half) { const int col = lane & 15, kq = lane >> 4;
#pragma unroll
                for (int ct = 0; ct < 3; ++ct) if (16 * ct + col < 36) {
#pragma unroll
                    for (int r = 0; r < 4; ++r) LG[((wave & 3) * 16 + 4 * kq + r) * 36 + 16 * ct + col] = acc[ct][r]; } }
            __syncthreads();
            if (tid < 64) { const int row = half * 64 + tid, t = blk * 128 + row; const float rs = RSTD[row]; const LAS float* lg = LG + tid * 36;
                float gl[4];
#pragma unroll
                for (int i = 0; i < 4; ++i) gl[i] = rs * lg[32 + i] + a.in[IN_BRG][i];
                int gs = 0; float gmax = gl[0];
#pragma unroll
                for (int i = 1; i < 4; ++i) if (gl[i] > gmax) { gmax = gl[i]; gs = i; }
                float gsum = 0.f;
#pragma unroll
                for (int i = 0; i < 4; ++i) gsum += expf(gl[i] - gmax);
                const float gtop = 1.0f / gsum;
                float ev[8];
#pragma unroll
                for (int i = 0; i < 8; ++i) ev[i] = rs * lg[gs * 8 + i] + a.in[IN_BRE][gs * 8 + i];
                int l0 = 0; float v0 = ev[0];
#pragma unroll
                for (int i = 1; i < 8; ++i) if (ev[i] > v0) { v0 = ev[i]; l0 = i; }
                int l1 = -1; float v1 = -3.0e38f;
#pragma unroll
                for (int i = 0; i < 8; ++i) if (i != l0 && ev[i] > v1) { v1 = ev[i]; l1 = i; }
                const float e1 = expf(v1 - v0), s0 = 1.0f / (1.0f + e1), s1 = e1 * s0;
                const int ex0 = gs * 8 + l0, ex1 = gs * 8 + l1;
                const int rk0 = __hip_atomic_fetch_add(&LCNT[ex0], 1, __ATOMIC_RELAXED, __HIP_MEMORY_SCOPE_WORKGROUP);
                const int rk1 = __hip_atomic_fetch_add(&LCNT[ex1], 1, __ATOMIC_RELAXED, __HIP_MEMORY_SCOPE_WORKGROUP);
                TOKE[2 * t] = ex0; TOKE[2 * t + 1] = ex1; TOKR[2 * t] = rk0; TOKR[2 * t + 1] = rk1; TOKG[2 * t] = s0 * gtop; TOKG[2 * t + 1] = s1 * gtop; }
        }
        __syncthreads();
        if (tid < 32) CNT[blk * 32 + tid] = LCNT[tid];
        __syncthreads();
    }
}
__device__ __forceinline__ void p7_gather(const Args& a, const Ctx& c) {
    const int tid = c.tid, lane = c.lane, wave = c.wave;
    LAS int* PART = (LAS int*)c.lds; LAS int* PPRE = PART + 512; LAS int* TOT = PPRE + 512; LAS int* TS = TOT + 32; LAS int* BASE = TS + 64;
    const int* CNT = (const int*)(a.ws + WS_CNT); const int* TOKE = (const int*)(a.ws + WS_TOKE); const int* TOKR = (const int*)(a.ws + WS_TOKR); int* TOKP = (int*)(a.ws + WS_TOKP);
    int* RT = (int*)(a.ws + WS_ROWTOK);
    { const int e = tid & 31, p = tid >> 5; int s = 0; for (int k = 0; k < 16; ++k) s += CNT[(16 * p + k) * 32 + e]; PART[p * 32 + e] = s; }
    __syncthreads();
    if (tid < 32) { int run = 0; for (int p = 0; p < 16; ++p) { PPRE[p * 32 + tid] = run; run += PART[p * 32 + tid]; } TOT[tid] = run; }
    __syncthreads();
    if (tid == 0) { int ts = 0; for (int e = 0; e < 32; ++e) { TS[e] = ts; ts += (TOT[e] + 255) >> 8; } TS[32] = ts; }
    __syncthreads();
    if (blockIdx.x == 0 && tid < 33) ((int*)(a.ws + WS_SMALL))[tid] = TS[tid];
    for (int blk = blockIdx.x; blk < 256; blk += c.G) {
        if (tid < 32) { int s = TS[tid] * 256 + PPRE[(blk >> 4) * 32 + tid]; for (int b2 = (blk & ~15); b2 < blk; ++b2) s += CNT[b2 * 32 + tid]; BASE[tid] = s; }
        __syncthreads();
        { const int t = blk * 128 + (tid >> 2), jj = tid & 3;
          if (jj < 2) { const int pos = BASE[TOKE[2 * t + jj]] + TOKR[2 * t + jj]; TOKP[2 * t + jj] = pos; RT[pos] = t; } }
        __syncthreads();
    }
}
__device__ __forceinline__ void p10_combine(const Args& a, const Ctx& c) {
    const int lane = c.lane, gw = c.vcu * NWAVES + c.wave, NGW = c.G * NWAVES;
    const int* TOKP = (const int*)(a.ws + WS_TOKP); const float* TOKG = (const float*)(a.ws + WS_TOKG); const bf16* Y = (const bf16*)(a.ws + WS_Y);
    for (int t0 = gw; t0 < T; t0 += 2 * NGW) {
        const int tA = t0, tB = (t0 + NGW < T) ? t0 + NGW : t0; const bool hasB = (t0 + NGW < T);
        const int pA0 = TOKP[2 * tA], pA1 = TOKP[2 * tA + 1], pB0 = TOKP[2 * tB], pB1 = TOKP[2 * tB + 1];
        const float gA0 = TOKG[2 * tA], gA1 = TOKG[2 * tA + 1], gB0 = TOKG[2 * tB], gB1 = TOKG[2 * tB + 1];
        f32x4 xa[4], xb[4]; v2u ya0[4], ya1[4], yb0[4], yb1[4];
#pragma unroll
        for (int j = 0; j < 4; ++j) { const int cc = 4 * lane + 256 * j;
            xa[j] = *(const f32x4*)(a.out + (size_t)tA * D + cc); xb[j] = *(const f32x4*)(a.out + (size_t)tB * D + cc);
            ya0[j] = *(const v2u*)(Y + (size_t)pA0 * D + cc); ya1[j] = *(const v2u*)(Y + (size_t)pA1 * D + cc);
            yb0[j] = *(const v2u*)(Y + (size_t)pB0 * D + cc); yb1[j] = *(const v2u*)(Y + (size_t)pB1 * D + cc); }
#pragma unroll
        for (int j = 0; j < 4; ++j) { const int cc = 4 * lane + 256 * j; f32x4 x = xa[j];
            x[0] += gA0 * bf2f(ya0[j].x & 0xffffu) + gA1 * bf2f(ya1[j].x & 0xffffu); x[1] += gA0 * bf2f(ya0[j].x >> 16) + gA1 * bf2f(ya1[j].x >> 16);
            x[2] += gA0 * bf2f(ya0[j].y & 0xffffu) + gA1 * bf2f(ya1[j].y & 0xffffu); x[3] += gA0 * bf2f(ya0[j].y >> 16) + gA1 * bf2f(ya1[j].y >> 16);
            *(f32x4*)(a.out + (size_t)tA * D + cc) = x; }
        if (hasB) {
#pragma unroll
        for (int j = 0; j < 4; ++j) { const int cc = 4 * lane + 256 * j; f32x4 x = xb[j];
            x[0] += gB0 * bf2f(yb0[j].x & 0xffffu) + gB1 * bf2f(yb1[j].x & 0xffffu); x[1] += gB0 * bf2f(yb0[j].x >> 16) + gB1 * bf2f(yb1[j].x >> 16);
            x[2] += gB0 * bf2f(yb0[j].y & 0xffffu) + gB1 * bf2f(yb1[j].y & 0xffffu); x[3] += gB0 * bf2f(yb0[j].y >> 16) + gB1 * bf2f(yb1[j].y >> 16);
            *(f32x4*)(a.out + (size_t)tB * D + cc) = x; } }
    }
}
__global__ void __launch_bounds__(NWAVES * 64, 2) hybrid_fwd(Args args) {
    extern __shared__ __attribute__((aligned(16))) unsigned char lds_raw[];
    Ctx c; c.lds = (LAS unsigned char*)lds_raw;
    volatile LAS unsigned* MISC = (volatile LAS unsigned*)(c.lds + MISC_OFF);
    c.tid = threadIdx.x; c.lane = c.tid & 63; c.wave = __builtin_amdgcn_readfirstlane(c.tid >> 6);
    c.G = gridDim.x; { const int bx = blockIdx.x; c.vcu = (c.G % 8 == 0) ? (bx % 8) * (c.G / 8) + bx / 8 : bx; }
    unsigned* ctl = (unsigned*)(args.ws + WS_CTL);
    if (c.tid < 128) MISC[c.tid] = 0u;
    __syncthreads();
    XcdBarrier bar; bar.bar = ctl + CW_BAR; bar.x = 0; bar.st = nullptr;
    if (N_LAUNCHES == 1) bar = xcd_barrier_post(ctl + CW_BAR, MISC + 8);
#define GRID_BAR() do { if (N_LAUNCHES == 1) xcd_barrier(bar); } while (0)
    const int lo = args.ph_lo, hi = args.ph_hi;
#ifndef PH_MASK
#define PH_MASK 0xfff
#endif
#define IN(k) (((PH_MASK >> (k)) & 1) && lo <= (k) && (k) < hi)
#define BOTH(k) (IN(k) && IN((k) + 1))
    unsigned char* ws = args.ws; unsigned char* dout = (unsigned char*)args.out;
#ifndef DBG_REPEAT
#define DBG_REPEAT -1
#endif
#define REPS(k) (((k) == DBG_REPEAT) ? 2 : 1)
    if (IN(0)) { _Pragma("unroll") for (int rep = 0; rep < REPS(0); ++rep) { if (rep) GRID_BAR(); p0_prologue<0>(args, c, c.vcu * NWAVES + c.wave, c.G * NWAVES); } if (BOTH(0)) GRID_BAR(); }
    if (IN(1)) { _Pragma("unroll") for (int rep = 0; rep < REPS(1); ++rep) { if (rep) GRID_BAR();
        pg8::Gemm g{(const pg8::bf16_t*)(dout + DO_H), (const pg8::bf16_t*)(ws + WS_WIN), T, NPROJ, D}; pg8::StaticOrder S; S.init(T, NPROJ, c.G, (int)blockIdx.x);
        pg8::EpiBf16<0> E{(pg8::bf16_t*)(ws + WS_PROJ), 256, nullptr, 256, (size_t)T * 256, 1.f};
        pg8::gemm_phase<pg8::EpiBf16<0>, pg8::StaticOrder, true, true>(c.lds, g, S, E); }
        if (BOTH(1)) GRID_BAR();
    }
#ifndef DBG_R2
#define DBG_R2 1
#endif
#ifndef DBG_R4A
#define DBG_R4A 1
#endif
#ifndef DBG_R4B
#define DBG_R4B 1
#endif
#ifndef DBG_R7
#define DBG_R7 1
#endif
    if (IN(2)) { _Pragma("unroll 1") for (int rep = 0; rep < DBG_R2; ++rep) { if (rep) GRID_BAR(); p2_prep(args, c); } if (BOTH(2)) GRID_BAR(); }
    if (IN(3)) { _Pragma("unroll") for (int rep = 0; rep < REPS(3); ++rep) { if (rep) GRID_BAR(); p3_mixer(args, c, MISC, rep); } if (BOTH(3)) GRID_BAR(); }
    if (IN(4)) {
#pragma unroll 1
        for (int rep = 0; rep < DBG_R4A; ++rep) { p0_prologue<1>(args, c, c.vcu * NWAVES + c.wave, c.G * NWAVES); __syncthreads(); }
#pragma unroll 1
        for (int rep = 0; rep < DBG_R4B; ++rep)
#pragma unroll 1
        for (int u = blockIdx.x; u < 256; u += c.G) mlstm_unit<1>(args, c, u >> 5, (u >> 3) & 3, u & 7);
        if (BOTH(4)) GRID_BAR();
    }
    if (IN(5)) {
        { pg8::Gemm g{(const pg8::bf16_t*)(dout + DO_YATT), (const pg8::bf16_t*)(ws + WS_WPA), T, D, 512}; pg8::StaticOrder S; S.init(T, D, c.G, (int)blockIdx.x);
          pg8::EpiGate<false> E{(pg8::bf16_t*)(ws + WS_MERGED), D, (const pg8::bf16_t*)(ws + WS_PROJ + (size_t)TL_GA * PROJ_TILE), (size_t)T * 256};
          pg8::gemm_phase<pg8::EpiGate<false>, pg8::StaticOrder, true, true>(c.lds, g, S, E); }
        __syncthreads();
        { pg8::Gemm g{(const pg8::bf16_t*)(dout + DO_YML), (const pg8::bf16_t*)(ws + WS_WPM), T, D, 512}; pg8::StaticOrder S; S.init(T, D, c.G, (int)blockIdx.x);
          pg8::EpiGate<true> E{(pg8::bf16_t*)(ws + WS_MERGED), D, (const pg8::bf16_t*)(ws + WS_PROJ + (size_t)TL_GM * PROJ_TILE), (size_t)T * 256};
          pg8::gemm_phase<pg8::EpiGate<true>, pg8::StaticOrder, true, true>(c.lds, g, S, E); }
        if (BOTH(5)) GRID_BAR();
    }
    if (IN(6)) {
        pg8::Gemm g{(const pg8::bf16_t*)(ws + WS_MERGED), (const pg8::bf16_t*)(ws + WS_WOUT), T, D, D}; pg8::StaticOrder S; S.init(T, D, c.G, (int)blockIdx.x);
        pg8::EpiRes E{args.out, args.in[IN_X], D};
        pg8::gemm_phase<pg8::EpiRes, pg8::StaticOrder, true, true>(c.lds, g, S, E);
        if (BOTH(6)) GRID_BAR();
    }
    if (IN(7)) { _Pragma("unroll 1") for (int rep = 0; rep < DBG_R7; ++rep) { if (rep) { GRID_BAR(); } p6_router(args, c); } if (BOTH(7)) GRID_BAR(); }
    if (IN(8)) { _Pragma("unroll") for (int rep = 0; rep < REPS(8); ++rep) { if (rep) GRID_BAR(); p7_gather(args, c); } if (BOTH(8)) GRID_BAR(); }
    if (IN(9) || IN(10)) {
        LAS int* TSL = (LAS int*)(c.lds + MISC_OFF + 256);
        if (c.tid < 33) TSL[c.tid] = (int)__hip_atomic_load((unsigned*)(ws + WS_SMALL) + c.tid, RLX_AGENT);
        __syncthreads();
        if (IN(9)) {
            pg8::MoeOrder<true> S{TSL, c.G, (int)blockIdx.x, (const int*)(ws + WS_ROWTOK)};
            pg8::Gemm g{(const pg8::bf16_t*)(ws + WS_XN), (const pg8::bf16_t*)(ws + WS_GU), 0, 0, D};
            pg8::EpiSwiGLU E{(pg8::bf16_t*)(ws + WS_HID)};
            pg8::gemm_phase<pg8::EpiSwiGLU, pg8::MoeOrder<true>, true, true>(c.lds, g, S, E);
            if (BOTH(9)) GRID_BAR();
        }
        if (IN(10)) {
            pg8::MoeOrder<false> S{TSL, c.G, (int)blockIdx.x, nullptr};
            pg8::Gemm g{(const pg8::bf16_t*)(ws + WS_HID), (const pg8::bf16_t*)(ws + WS_DN), 0, 0, 512};
            pg8::EpiDown E{(pg8::bf16_t*)(ws + WS_Y)};
            pg8::gemm_phase<pg8::EpiDown, pg8::MoeOrder<false>, true, true>(c.lds, g, S, E);
            if (BOTH(10)) GRID_BAR();
        }
    }
    if (IN(11)) p10_combine(args, c);
#undef IN
#undef BOTH
#undef GRID_BAR
}

extern "C" void kernel_launch(void* const* d_in, const int* in_sizes, int n_in, void* d_out, int out_size, void* d_ws, size_t ws_size, hipStream_t stream) {
    static int grid = 0;
    if (grid == 0) {
        if (n_in != 22 || in_sizes[0] != T * D || out_size != T * D || ws_size < WS_END) { fprintf(stderr, "kernel_launch: unexpected shapes (n_in %d, in0 %d, out %d, ws %zu); nothing launched\n", n_in, n_in > 0 ? in_sizes[0] : -1, out_size, ws_size); grid = -1; return; }
        int dev = 0, cus = 0, per_cu = 0;
        if (hipGetDevice(&dev) != hipSuccess || hipDeviceGetAttribute(&cus, hipDeviceAttributeMultiprocessorCount, dev) != hipSuccess) { grid = -1; return; }
        if (hipFuncSetAttribute((const void*)hybrid_fwd, hipFuncAttributeMaxDynamicSharedMemorySize, LDS_BYTES) != hipSuccess) { fprintf(stderr, "kernel_launch: hipFuncSetAttribute failed\n"); grid = -1; return; }
        if (hipOccupancyMaxActiveBlocksPerMultiprocessor(&per_cu, (const void*)hybrid_fwd, NWAVES * 64, LDS_BYTES) != hipSuccess || per_cu < 1)
            fprintf(stderr, "kernel_launch: note: occupancy query reports %d workgroups per CU\n", per_cu);
        (void)hipGetLastError();
        grid = cus;
    }
    if (grid < 0) return;
    if (hipMemsetAsync((char*)d_ws + WS_CTL, 0, CTL_ZERO_BYTES, stream) != hipSuccess) return;
    Args a{};
    for (int i = 0; i < 22; ++i) a.in[i] = (const float*)d_in[i];
    a.out = (float*)d_out; a.ws = (unsigned char*)d_ws;
    for (int li = 0; li < N_LAUNCHES; ++li) {
        a.ph_lo = (N_LAUNCHES == 1) ? 0 : li; a.ph_hi = (N_LAUNCHES == 1) ? NPH : li + 1; a.li = li;
        hipLaunchKernelGGL(hybrid_fwd, dim3(grid), dim3(NWAVES * 64), LDS_BYTES, stream, a);
        if (hipPeekAtLastError() != hipSuccess) { fprintf(stderr, "kernel_launch: launch %d failed\n", li); break; }
    }
}
```

```cpp
#include <hip/hip_runtime.h>
#include <cstdio>
#include <cstdint>
namespace pg8 {
#define PG8_LAS __attribute__((address_space(3)))
typedef unsigned short bf16_t;
typedef short bf16x8 __attribute__((ext_vector_type(8)));
typedef float f32x4 __attribute__((ext_vector_type(4)));
typedef unsigned u32x4 __attribute__((ext_vector_type(4)));
constexpr int BM = 256, BK = 64, HALF = 128, HTB = HALF * BK * 2  , STAGE_BYTES = 8 * HTB, NXCD = 8, WGM = 8;

__host__ __device__ __forceinline__ int lds_byte(int r, int c) { const int st = (r >> 4) * 2 + (c >> 5), rr = r & 15, cc = c & 31, ob = rr * 64 + cc * 2; return st * 1024 + (ob ^ (((ob >> 9) & 1) << 5)); }
__host__ __device__ __forceinline__ void stage_rc(int b, int& R, int& C) { const int st = b / 1024, sb = b % 1024, swz = sb ^ (((sb >> 9) & 1) << 5); R = (st >> 1) * 16 + swz / 64; C = (st & 1) * 32 + (swz % 64) / 2; }
__host__ __device__ __forceinline__ int perm32(int rho) { const int n = rho >> 4, i = rho & 15; return 8 * (i >> 2) + 4 * n + (i & 3); }

struct Unit { int pm, pn; };
struct Gemm { const bf16_t* A; const bf16_t* Bt; int M, N, K; };

struct StaticOrder {
    static constexpr bool GATHER = false;
    int nM, nN, nwg, G, c;
    __host__ __device__ void init(int M, int N, int G_, int c_) { nM = M / BM; nN = N / BM; nwg = nM * nN; G = G_; c = c_; }
    __host__ __device__ bool next(int i, Unit& u) const {
        const long L = (long)i * G + c; if (L >= nwg) return false;
        int wgid = (int)L; { const int q = nwg / NXCD, r = nwg % NXCD, xcd = wgid % NXCD, off = wgid / NXCD; wgid = (xcd < r ? xcd * (q + 1) : r * (q + 1) + (xcd - r) * q) + off; }
        const int nig = WGM * nN, gid = wgid / nig, fm = gid * WGM, gsz = (nM - fm) < WGM ? (nM - fm) : WGM;
        u.pm = fm + ((wgid % nig) % gsz); u.pn = (wgid % nig) / gsz; return true;
    }
    __device__ __forceinline__ void a_ready(const Unit&) const {}
    __device__ __forceinline__ void done(const Unit&) const {}
};

typedef __bf16 bf2_t __attribute__((ext_vector_type(2)));
__device__ __forceinline__ unsigned cvt_pk_bf16(float lo, float hi) { bf2_t v; v[0] = (__bf16)lo; v[1] = (__bf16)hi; return __builtin_bit_cast(unsigned, v); }
typedef float f32x2 __attribute__((ext_vector_type(2)));
template <int ACT  > struct EpiBf16 {
    static constexpr bool PERM = true, AFTER_DRAIN = false; static_assert(ACT == 0, "EpiBf16: no activation here");
    bf16_t* O; int ldc; const float* bias; int split_cols; size_t split_stride; float scale0;
    __device__ __forceinline__ void operator()(const f32x4 (&acc)[2][2][4][2], const Unit& u, int wr, int wc, int fr, int fq) const {
        const int row0 = u.pm * BM + wr * 64 + fr; int colt = u.pn * BM; bf16_t* base = O;
        float sc = 1.f; if (split_cols) { const int t = colt / split_cols; base += (size_t)t * split_stride; colt -= t * split_cols; if (t == 0) sc = scale0; }
        const int col0 = colt + wc * 32 + 8 * fq, bcol0 = u.pn * BM + wc * 32 + 8 * fq;
        f32x4 bv[2][2];
#pragma unroll
        for (int bj = 0; bj < 2; ++bj)
#pragma unroll
            for (int n = 0; n < 2; ++n) bv[bj][n] = bias ? *(const f32x4*)(bias + bcol0 + bj * HALF + 4 * n) : (f32x4){0.f, 0.f, 0.f, 0.f};
#pragma unroll
        for (int ai = 0; ai < 2; ++ai)
#pragma unroll
            for (int m = 0; m < 4; ++m) { bf16_t* rowp = base + (size_t)(row0 + ai * HALF + m * 16) * ldc + col0;
#pragma unroll
                for (int bj = 0; bj < 2; ++bj) { f32x4 v0 = acc[ai][bj][m][0] + bv[bj][0], v1 = acc[ai][bj][m][1] + bv[bj][1];
                    v0 = v0 * sc; v1 = v1 * sc; u32x4 w; w.x = cvt_pk_bf16(v0[0], v0[1]); w.y = cvt_pk_bf16(v0[2], v0[3]); w.z = cvt_pk_bf16(v1[0], v1[1]); w.w = cvt_pk_bf16(v1[2], v1[3]);
                    *(u32x4*)(rowp + bj * HALF) = w; } }
    }
};
__device__ __forceinline__ float bf2f_(unsigned b16) { return __uint_as_float(b16 << 16); }
__device__ __forceinline__ float sigm_(float x) { return 1.0f / (1.0f + __expf(-x)); }
template <bool ADD> struct EpiGate {
    static constexpr bool PERM = true, AFTER_DRAIN = false;
    bf16_t* O; int ldc; const bf16_t* gate; size_t gstride;
    __device__ __forceinline__ void operator()(const f32x4 (&acc)[2][2][4][2], const Unit& u, int wr, int wc, int fr, int fq) const {
        const int row0 = u.pm * BM + wr * 64 + fr, colt = wc * 32 + 8 * fq;
        const bf16_t* gt = gate + (size_t)u.pn * gstride;
#pragma unroll
        for (int ai = 0; ai < 2; ++ai)
#pragma unroll
            for (int m = 0; m < 4; ++m) { const size_t row = (size_t)(row0 + ai * HALF + m * 16);
#pragma unroll
                for (int bj = 0; bj < 2; ++bj) { const int c = colt + bj * HALF;
                    const u32x4 gv = *(const u32x4*)(gt + row * 256 + c);
                    bf16_t* op = O + row * ldc + u.pn * BM + c;
                    float pv[8] = {0.f, 0.f, 0.f, 0.f, 0.f, 0.f, 0.f, 0.f};
                    if (ADD) { const u32x4 p = *(const u32x4*)op; pv[0] = bf2f_(p.x & 0xffffu); pv[1] = bf2f_(p.x >> 16); pv[2] = bf2f_(p.y & 0xffffu); pv[3] = bf2f_(p.y >> 16);
                        pv[4] = bf2f_(p.z & 0xffffu); pv[5] = bf2f_(p.z >> 16); pv[6] = bf2f_(p.w & 0xffffu); pv[7] = bf2f_(p.w >> 16); }
                    const f32x4 v0 = acc[ai][bj][m][0], v1 = acc[ai][bj][m][1];
                    float o[8];
                    o[0] = pv[0] + sigm_(bf2f_(gv.x & 0xffffu)) * v0[0]; o[1] = pv[1] + sigm_(bf2f_(gv.x >> 16)) * v0[1];
                    o[2] = pv[2] + sigm_(bf2f_(gv.y & 0xffffu)) * v0[2]; o[3] = pv[3] + sigm_(bf2f_(gv.y >> 16)) * v0[3];
                    o[4] = pv[4] + sigm_(bf2f_(gv.z & 0xffffu)) * v1[0]; o[5] = pv[5] + sigm_(bf2f_(gv.z >> 16)) * v1[1];
                    o[6] = pv[6] + sigm_(bf2f_(gv.w & 0xffffu)) * v1[2]; o[7] = pv[7] + sigm_(bf2f_(gv.w >> 16)) * v1[3];
                    u32x4 w; w.x = cvt_pk_bf16(o[0], o[1]); w.y = cvt_pk_bf16(o[2], o[3]); w.z = cvt_pk_bf16(o[4], o[5]); w.w = cvt_pk_bf16(o[6], o[7]);
                    *(u32x4*)op = w; } }
    }
};
struct EpiRes {
    static constexpr bool PERM = false, AFTER_DRAIN = false;
    float* C; const float* R; int ldc;
    __device__ __forceinline__ void operator()(const f32x4 (&acc)[2][2][4][2], const Unit& u, int wr, int wc, int fr, int fq) const {
        const int row0 = u.pm * BM + wr * 64 + fr, col0 = u.pn * BM + wc * 32 + 4 * fq;
#pragma unroll
        for (int ai = 0; ai < 2; ++ai)
#pragma unroll
            for (int m = 0; m < 4; ++m) { const size_t ro = (size_t)(row0 + ai * HALF + m * 16) * ldc + col0;
#pragma unroll
                for (int bj = 0; bj < 2; ++bj)
#pragma unroll
                    for (int n = 0; n < 2; ++n) { const size_t off = ro + bj * HALF + n * 16; *(f32x4*)(C + off) = *(const f32x4*)(R + off) + acc[ai][bj][m][n]; } }
    }
};
struct EpiSwiGLU {
    static constexpr bool PERM = true, AFTER_DRAIN = false;
    bf16_t* H;
    __device__ __forceinline__ void operator()(const f32x4 (&acc)[2][2][4][2], const Unit& u, int wr, int wc, int fr, int fq) const {
        const int row0 = u.pm * BM + wr * 64 + fr, hc = (u.pn & 3) * 128 + wc * 32 + 8 * fq;
#pragma unroll
        for (int ai = 0; ai < 2; ++ai)
#pragma unroll
            for (int m = 0; m < 4; ++m) { const size_t row = (size_t)(row0 + ai * HALF + m * 16);
                float o[8];
#pragma unroll
                for (int n = 0; n < 2; ++n)
#pragma unroll
                    for (int i = 0; i < 4; ++i) { const float g = acc[ai][0][m][n][i], up = acc[ai][1][m][n][i]; o[n * 4 + i] = g * sigm_(g) * up; }
                u32x4 w; w.x = cvt_pk_bf16(o[0], o[1]); w.y = cvt_pk_bf16(o[2], o[3]); w.z = cvt_pk_bf16(o[4], o[5]); w.w = cvt_pk_bf16(o[6], o[7]);
                *(u32x4*)(H + row * 512 + hc) = w; }
    }
};
struct EpiDown {
    static constexpr bool PERM = true, AFTER_DRAIN = false;
    bf16_t* Y;
    __device__ __forceinline__ void operator()(const f32x4 (&acc)[2][2][4][2], const Unit& u, int wr, int wc, int fr, int fq) const {
        const int row0 = u.pm * BM + wr * 64 + fr, c0 = (u.pn & 3) * 256 + wc * 32 + 8 * fq;
#pragma unroll
        for (int ai = 0; ai < 2; ++ai)
#pragma unroll
            for (int m = 0; m < 4; ++m) { const size_t row = (size_t)(row0 + ai * HALF + m * 16);
#pragma unroll
                for (int bj = 0; bj < 2; ++bj) { const f32x4 v0 = acc[ai][bj][m][0], v1 = acc[ai][bj][m][1];
                    u32x4 w; w.x = cvt_pk_bf16(v0[0], v0[1]); w.y = cvt_pk_bf16(v0[2], v0[3]); w.z = cvt_pk_bf16(v1[0], v1[1]); w.w = cvt_pk_bf16(v1[2], v1[3]);
                    *(u32x4*)(Y + row * 1024 + c0 + bj * HALF) = w; } }
    }
};
template <bool GA_> struct MoeOrder {
    static constexpr bool GATHER = GA_;
    const PG8_LAS int* ts; int G, c; const int* rowtok;
    __device__ __forceinline__ bool next(int i, Unit& u) const {
        const int nt = ts[32]; const long L = (long)i * G + c; if (L >= 4L * nt) return false;
        const int pm = (int)(L >> 2), j = (int)(L & 3); int e = 0;
#pragma unroll
        for (int k = 1; k < 32; ++k) e += (ts[k] <= pm) ? 1 : 0;
        u.pm = pm; u.pn = e * 4 + j; return true;
    }
    __device__ __forceinline__ void a_ready(const Unit&) const {}
    __device__ __forceinline__ void done(const Unit&) const {}
};
template <class Epi, class Sched, bool ALIGN_EPI = false, bool SP2 = false>
__device__ __forceinline__ void gemm_phase(PG8_LAS unsigned char* lds, const Gemm g, const Sched& S, const Epi& E) {
    const int tid = threadIdx.x, wid = __builtin_amdgcn_readfirstlane(tid >> 6), lane = tid & 63, wr = wid >> 2, wc = wid & 3, fr = lane & 15, fq = lane >> 4;
    const int K = g.K, nt = K / BK;
    unsigned voffA[2], voffB[2];
#pragma unroll
    for (int i = 0; i < 2; ++i) { int R, C; stage_rc(tid * 16 + i * 8192, R, C); const int Rb = Epi::PERM ? ((R & ~31) + perm32(R & 31)) : R;
        voffA[i] = (unsigned)(R * K + C) * 2u; voffB[i] = (unsigned)(Rb * K + C) * 2u; }
    const size_t kstep = (size_t)(BK * 2);
    const size_t hstep = (size_t)HALF * K * 2;
    const size_t tstep = 2 * hstep;
    constexpr bool GA = Sched::GATHER;
    static_assert(!GA || SP2, "gathered A rows: SP2 loop only");
    const size_t hstepA = GA ? 0 : hstep;
    unsigned gcur[2][2] = {{0u, 0u}, {0u, 0u}}, gnxt[2][2] = {{0u, 0u}, {0u, 0u}}; int gR[2] = {0, 0}; unsigned gC[2] = {0u, 0u};
    if constexpr (GA) { _Pragma("unroll") for (int i = 0; i < 2; ++i) { int R, C; stage_rc(tid * 16 + i * 8192, R, C); gR[i] = R; gC[i] = (unsigned)C * 2u; } }
#define PG8_GOFF(dst, u) do { if constexpr (GA) { _Pragma("unroll") for (int h_ = 0; h_ < 2; ++h_) _Pragma("unroll") for (int i_ = 0; i_ < 2; ++i_) dst[h_][i_] = (unsigned)S.rowtok[(u).pm * BM + h_ * HALF + gR[i_]] * (unsigned)(K * 2) + gC[i_]; } } while (0)
#define PG8_VA(h, sel) (GA ? ((sel) ? gnxt[h] : gcur[h]) : voffA)
    const unsigned ldsw = (unsigned)wid * 1024u;
    const int aoff = lds_byte(wr * 64 + fr, fq * 8), boff = lds_byte(wc * 32 + fr, fq * 8);
#define PG8_SA(b, h) (((b) * 2 + (h)) * HTB)
#define PG8_SB(b, h) ((4 + (b) * 2 + (h)) * HTB)
#define PG8_STAGE(bufoff, gbase, voff) do { _Pragma("unroll") for (int _i = 0; _i < 2; ++_i) \
        __builtin_amdgcn_global_load_lds((const unsigned*)((const char*)(gbase) + (voff)[_i]), (PG8_LAS unsigned*)(lds + (bufoff) + ldsw + _i * 8192), 16, 0, 0); } while (0)
#define PG8_LDA(dst, b, h) do { _Pragma("unroll") for (int m = 0; m < 4; ++m) _Pragma("unroll") for (int k = 0; k < 2; ++k) dst[m][k] = *(const PG8_LAS bf16x8*)(lds + PG8_SA(b, h) + aoff + m * 2048 + k * 1024); } while (0)
#define PG8_LDB(dst, b, h) do { _Pragma("unroll") for (int n = 0; n < 2; ++n) _Pragma("unroll") for (int k = 0; k < 2; ++k) dst[n][k] = *(const PG8_LAS bf16x8*)(lds + PG8_SB(b, h) + boff + n * 2048 + k * 1024); } while (0)
#define PG8_MMA(ai, bj, At, Bt) do { __builtin_amdgcn_s_setprio(1); _Pragma("unroll") for (int m = 0; m < 4; ++m) _Pragma("unroll") for (int n = 0; n < 2; ++n) _Pragma("unroll") for (int k = 0; k < 2; ++k) \
        acc[ai][bj][m][n] = __builtin_amdgcn_mfma_f32_16x16x32_bf16(Bt[n][k], At[m][k], acc[ai][bj][m][n], 0, 0, 0); __builtin_amdgcn_s_setprio(0); } while (0)
#define PG8_WAIT_V(n) asm volatile("s_waitcnt vmcnt(" #n ")" ::: "memory")
#define PG8_WAIT_L(n) asm volatile("s_waitcnt lgkmcnt(" #n ")" ::: "memory")
#define PG8_BAR __builtin_amdgcn_s_barrier()
#define PG8_SCHED __builtin_amdgcn_sched_barrier(0)
    Unit cur, nxt; int ui = 0;
    if (!S.next(0, cur)) return;
    f32x4 acc[2][2][4][2];
#pragma unroll
    for (int a = 0; a < 2; ++a)
#pragma unroll
        for (int b = 0; b < 2; ++b)
#pragma unroll
            for (int m = 0; m < 4; ++m)
#pragma unroll
                for (int n = 0; n < 2; ++n) acc[a][b][m][n] = (f32x4){0.f, 0.f, 0.f, 0.f};
    bf16x8 At[4][2], B0[2][2], B1[2][2];
    const char* cA = (const char*)g.A + (GA ? 0 : (size_t)cur.pm * tstep); const char* cB = (const char*)g.Bt + (size_t)cur.pn * tstep;
    S.a_ready(cur);
    PG8_GOFF(gcur, cur);
    if constexpr (SP2) {
        PG8_STAGE(PG8_SB(0, 0), cB, voffB); PG8_STAGE(PG8_SB(0, 1), cB + hstep, voffB); PG8_STAGE(PG8_SA(0, 0), cA, PG8_VA(0, false)); PG8_STAGE(PG8_SA(0, 1), cA + hstepA, PG8_VA(1, false));
        if (wr == 1) PG8_BAR;
        PG8_WAIT_V(2); PG8_BAR;
        PG8_STAGE(PG8_SB(1, 0), cB + kstep, voffB); PG8_STAGE(PG8_SA(1, 0), cA + kstep, PG8_VA(0, false)); PG8_STAGE(PG8_SB(1, 1), cB + hstep + kstep, voffB);
        PG8_WAIT_V(6); PG8_BAR;
    } else {
        PG8_STAGE(PG8_SB(0, 0), cB, voffB); PG8_STAGE(PG8_SA(0, 0), cA, voffA); PG8_STAGE(PG8_SB(0, 1), cB + hstep, voffB); PG8_STAGE(PG8_SA(0, 1), cA + hstep, voffA);
        if (wr == 1) PG8_BAR;
        PG8_WAIT_V(4); PG8_BAR;
        PG8_STAGE(PG8_SB(1, 0), cB + kstep, voffB); PG8_STAGE(PG8_SA(1, 0), cA + kstep, voffA); PG8_STAGE(PG8_SB(1, 1), cB + hstep + kstep, voffB);
        PG8_WAIT_V(6); PG8_BAR;
    }
    for (;;) {
        const bool has_next = S.next(ui + 1, nxt);
        if (has_next) PG8_GOFF(gnxt, nxt);
        const char* nA = has_next ? (const char*)g.A + (GA ? 0 : (size_t)nxt.pm * tstep) : cA; const char* nB = has_next ? (const char*)g.Bt + (size_t)nxt.pn * tstep : cB;
        for (int t = 0; t < nt; t += 2) {
            const bool last = (t == nt - 2);
            const char* a1 = cA + (size_t)(t + 1) * kstep;
            const char* a2 = last ? nA : cA + (size_t)(t + 2) * kstep; const char* b2 = last ? nB : cB + (size_t)(t + 2) * kstep;
            const char* a3 = a2 + kstep; const char* b3 = b2 + kstep;
            if (last && has_next) S.a_ready(nxt);
            const bool seln = last && has_next;
            if constexpr (SP2) {
            PG8_LDB(B0, 0, 0); PG8_LDB(B1, 0, 1); PG8_SCHED; PG8_LDA(At, 0, 0); PG8_STAGE(PG8_SA(1, 1), a1 + hstepA, PG8_VA(1, false));
            PG8_WAIT_V(8); PG8_WAIT_L(0); PG8_BAR; PG8_MMA(0, 0, At, B0); PG8_MMA(0, 1, At, B1); PG8_BAR; PG8_SCHED;
            PG8_LDA(At, 0, 1); PG8_STAGE(PG8_SB(0, 0), b2, voffB); PG8_STAGE(PG8_SB(0, 1), b2 + hstep, voffB); PG8_STAGE(PG8_SA(0, 0), a2, PG8_VA(0, seln));
            PG8_WAIT_V(8); PG8_WAIT_L(0); PG8_BAR; PG8_MMA(1, 0, At, B0); PG8_MMA(1, 1, At, B1); PG8_BAR; PG8_SCHED;
            PG8_LDB(B0, 1, 0); PG8_LDB(B1, 1, 1); PG8_SCHED; PG8_LDA(At, 1, 0); PG8_STAGE(PG8_SA(0, 1), a2 + hstepA, PG8_VA(1, seln));
            PG8_WAIT_V(8); PG8_WAIT_L(0); PG8_BAR; PG8_MMA(0, 0, At, B0); PG8_MMA(0, 1, At, B1); PG8_BAR; PG8_SCHED;
            PG8_LDA(At, 1, 1); PG8_STAGE(PG8_SB(1, 0), b3, voffB); PG8_STAGE(PG8_SB(1, 1), b3 + hstep, voffB); PG8_STAGE(PG8_SA(1, 0), a3, PG8_VA(0, seln));
            PG8_WAIT_V(8); PG8_WAIT_L(0); PG8_BAR; PG8_MMA(1, 0, At, B0); PG8_MMA(1, 1, At, B1); PG8_BAR; PG8_SCHED;
            } else {
            PG8_LDB(B0, 0, 0); PG8_SCHED; PG8_LDA(At, 0, 0); PG8_STAGE(PG8_SA(1, 1), a1 + hstep, voffA);
            PG8_WAIT_L(8); PG8_BAR; PG8_WAIT_L(0); PG8_MMA(0, 0, At, B0); PG8_BAR; PG8_SCHED;
            PG8_LDB(B1, 0, 1); PG8_STAGE(PG8_SB(0, 0), b2, voffB);
            PG8_BAR; PG8_WAIT_L(0); PG8_MMA(0, 1, At, B1); PG8_BAR;
            PG8_LDA(At, 0, 1); PG8_STAGE(PG8_SA(0, 0), a2, voffA);
            PG8_BAR; PG8_WAIT_L(0); PG8_MMA(1, 0, At, B0); PG8_BAR; PG8_SCHED;
            PG8_STAGE(PG8_SB(0, 1), b2 + hstep, voffB);
            PG8_WAIT_V(6); PG8_BAR; PG8_MMA(1, 1, At, B1); PG8_BAR;
            PG8_LDB(B0, 1, 0); PG8_SCHED; PG8_LDA(At, 1, 0); PG8_STAGE(PG8_SA(0, 1), a2 + hstep, voffA);
            PG8_WAIT_L(8); PG8_BAR; PG8_WAIT_L(0); PG8_MMA(0, 0, At, B0); PG8_BAR; PG8_SCHED;
            PG8_LDB(B1, 1, 1); PG8_STAGE(PG8_SB(1, 0), b3, voffB);
            PG8_BAR; PG8_WAIT_L(0); PG8_MMA(0, 1, At, B1); PG8_BAR;
            PG8_LDA(At, 1, 1); PG8_STAGE(PG8_SA(1, 0), a3, voffA);
            PG8_BAR; PG8_WAIT_L(0); PG8_MMA(1, 0, At, B0); PG8_BAR; PG8_SCHED;
            PG8_STAGE(PG8_SB(1, 1), b3 + hstep, voffB);
            PG8_WAIT_V(6); PG8_BAR; PG8_MMA(1, 1, At, B1); PG8_BAR;
            }
        }
        if constexpr (ALIGN_EPI) { if (wr == 0) PG8_BAR; }
        if constexpr (!Epi::AFTER_DRAIN) { E(acc, cur, wr, wc, fr, fq); S.done(cur); }
        if (!has_next) break;
#pragma unroll
        for (int a = 0; a < 2; ++a)
#pragma unroll
            for (int b = 0; b < 2; ++b)
#pragma unroll
                for (int m = 0; m < 4; ++m)
#pragma unroll
                    for (int n = 0; n < 2; ++n) acc[a][b][m][n] = (f32x4){0.f, 0.f, 0.f, 0.f};
        cur = nxt; cA = nA; cB = nB; ++ui;
        if constexpr (GA) { _Pragma("unroll") for (int h_ = 0; h_ < 2; ++h_) _Pragma("unroll") for (int i_ = 0; i_ < 2; ++i_) gcur[h_][i_] = gnxt[h_][i_]; }
        if constexpr (ALIGN_EPI) { if (wr == 1) PG8_BAR; }
    }
    PG8_WAIT_V(0);
    if constexpr (!ALIGN_EPI) { if (wr == 0) PG8_BAR; }
    PG8_BAR;
    if constexpr (Epi::AFTER_DRAIN) { E.fused(acc, cur, wr, wc, fr, fq, lds, wid, lane); S.done(cur); }
#undef PG8_GOFF
#undef PG8_VA
#undef PG8_SA
#undef PG8_SB
#undef PG8_STAGE
#undef PG8_LDA
#undef PG8_LDB
#undef PG8_MMA
#undef PG8_WAIT_V
#undef PG8_WAIT_L
#undef PG8_BAR
#undef PG8_SCHED
}
}
constexpr int NWAVES = 8;
constexpr int BATCH = 8, SEQ = 4096, D = 1024, T = BATCH * SEQ;
constexpr int NPROJ = 5120;
constexpr int NTILE = NPROJ / 256;
constexpr float EPS = 1e-6f;
#ifndef MK_N_LAUNCHES
#define MK_N_LAUNCHES 1
#endif
#ifndef DBG_NPH
#define DBG_NPH 12
#endif
constexpr int NPH = DBG_NPH;
constexpr int N_LAUNCHES = MK_N_LAUNCHES;
static_assert(N_LAUNCHES == 1 || N_LAUNCHES == NPH, "MK_N_LAUNCHES is 1 or NPH");

constexpr size_t MiB = 1u << 20;
constexpr size_t WS_CTL = 0, CTL_ZERO_BYTES = 1 * MiB;
constexpr size_t WS_SMALL = 1 * MiB;
constexpr size_t WS_WIN = 2 * MiB;
constexpr size_t WS_WPA = 13 * MiB, WS_WPM = 14 * MiB, WS_WOUT = 15 * MiB;
constexpr size_t WS_TOKE = 17 * MiB;
constexpr size_t WS_TOKR = WS_TOKE + 256 * 1024;
constexpr size_t WS_TOKP = WS_TOKR + 256 * 1024;
constexpr size_t WS_TOKG = WS_TOKP + 256 * 1024;
constexpr size_t WS_CNT = WS_TOKG + 256 * 1024;
constexpr size_t WS_ROWTOK = WS_CNT + 64 * 1024;
constexpr int NROWS_MAX = 73728;
constexpr size_t WS_SC = 452 * MiB;
constexpr size_t WS_SC2 = 116 * MiB + 3 * ((size_t)T * 256 * 2);
constexpr size_t WS_GU = 20 * MiB;
constexpr size_t WS_DN = 84 * MiB;
constexpr size_t WS_PROJ = 116 * MiB;
constexpr size_t PROJ_TILE = (size_t)T * 256 * 2;
constexpr size_t WS_MLST = 116 * MiB;
constexpr size_t WS_MERGED = 116 * MiB;
constexpr size_t WS_XN = 180 * MiB;
constexpr size_t WS_XG = 244 * MiB;
constexpr size_t WS_HID = 388 * MiB;
constexpr size_t WS_Y = 244 * MiB;
constexpr size_t WS_END = 512 * MiB;
static_assert(WS_PROJ + NTILE * PROJ_TILE == 436 * MiB, "proj map");
constexpr size_t DO_H = 0, DO_YATT = 0, DO_YML = 32 * MiB, DO_KN = 64 * MiB, DO_IKR = 72 * MiB, DO_IQR = 74 * MiB, DO_AQN = 90 * MiB;
constexpr int TL_AQ = 0, TL_KV = 2, TL_IQ = 3, TL_MQ = 4, TL_MK = 6, TL_MV = 8, TL_MO = 10, TL_GA = 12, TL_GM = 16;
constexpr size_t WS_WSM = WS_SMALL + 64 * 1024;
constexpr size_t WS_WTG = WS_SMALL + 192 * 1024;
constexpr size_t DO_SMB = 122 * MiB;
constexpr int CW_BAR = 4096;
constexpr int CW_Q = 16384;
constexpr int LDS_BYTES = 163840, MISC_OFF = LDS_BYTES - 512;

#define GAS __attribute__((address_space(1)))
#define LAS __attribute__((address_space(3)))
typedef unsigned short bf16;
typedef unsigned v4u __attribute__((ext_vector_type(4)));
typedef unsigned v2u __attribute__((ext_vector_type(2)));
typedef float f32x4 __attribute__((ext_vector_type(4)));
typedef float f32x2 __attribute__((ext_vector_type(2)));
typedef short bf16x8 __attribute__((ext_vector_type(8)));
typedef GAS unsigned gu32;
#define RLX_AGENT __ATOMIC_RELAXED, __HIP_MEMORY_SCOPE_AGENT
#define LDS_WAIT() asm volatile("s_waitcnt lgkmcnt(0)" ::: "memory")
__device__ __forceinline__ float bf2f(unsigned b16) { return __uint_as_float(b16 << 16); }
__device__ __forceinline__ unsigned f2bf(float f) { unsigned u = __float_as_uint(f); return (u + 0x7fffu + ((u >> 16) & 1u)) >> 16; }
__device__ __forceinline__ unsigned pk2(float lo, float hi) { return pg8::cvt_pk_bf16(lo, hi); }
__device__ __forceinline__ float sigm(float x) { return 1.0f / (1.0f + __expf(-x)); }
__device__ __forceinline__ float wave_sum(float v) {
    v += __int_as_float(__builtin_amdgcn_update_dpp(0, __float_as_int(v), 0xB1, 0xF, 0xF, true));
    v += __int_as_float(__builtin_amdgcn_update_dpp(0, __float_as_int(v), 0x4E, 0xF, 0xF, true));
    v += __int_as_float(__builtin_amdgcn_update_dpp(0, __float_as_int(v), 0x124, 0xF, 0xF, true));
    v += __int_as_float(__builtin_amdgcn_update_dpp(0, __float_as_int(v), 0x128, 0xF, 0xF, true));
    { const auto r = __builtin_amdgcn_permlane16_swap(__float_as_uint(v), __float_as_uint(v), false, false); v = __uint_as_float(r[0]) + __uint_as_float(r[1]); }
    { const auto r = __builtin_amdgcn_permlane32_swap(__float_as_uint(v), __float_as_uint(v), false, false); v = __uint_as_float(r[0]) + __uint_as_float(r[1]); }
    return v;
}
__device__ __forceinline__ void unpack8(const v4u r, float (&f)[8]) {
    f[0] = bf2f(r.x & 0xffffu); f[1] = bf2f(r.x >> 16); f[2] = bf2f(r.y & 0xffffu); f[3] = bf2f(r.y >> 16);
    f[4] = bf2f(r.z & 0xffffu); f[5] = bf2f(r.z >> 16); f[6] = bf2f(r.w & 0xffffu); f[7] = bf2f(r.w >> 16);
}
__device__ __forceinline__ v4u pack8(const float (&f)[8]) { v4u w; w.x = pk2(f[0], f[1]); w.y = pk2(f[2], f[3]); w.z = pk2(f[4], f[5]); w.w = pk2(f[6], f[7]); return w; }
#define XB_TMO      128
#define XB_XCNT(j)  (256  + 64 * (j))
#define XB_XSUB(j)  (1280 + 64 * (j))
#define XB_XGEN(j)  (2304 + 64 * (j))
#define XB_TOP      3328
#define XB_TOPGEN   3392
#define XCD_BAR_WORDS 3456
#define XB_SPIN_CAP (1u << 18)

__device__ __forceinline__ unsigned xb_ld(unsigned* p)              { return __hip_atomic_load(p, __ATOMIC_RELAXED, __HIP_MEMORY_SCOPE_AGENT); }
__device__ __forceinline__ unsigned xb_add(unsigned* p, unsigned v) { return __hip_atomic_fetch_add(p, v, __ATOMIC_RELAXED, __HIP_MEMORY_SCOPE_AGENT); }
__device__ __forceinline__ unsigned xb_xcc_id() { return (unsigned)__builtin_amdgcn_s_getreg((3 << 11) | 20) & 0xFu; }
#define XB_SPIN(cond, bar) do { unsigned _sp = 0; while (cond) { __builtin_amdgcn_s_sleep(1); \
    if ((++_sp & 255u) == 0u) { if (xb_ld(&(bar)[XB_TMO])) break; if (_sp > XB_SPIN_CAP) { atomicAdd(&(bar)[XB_TMO], 1u); break; } } } } while (0)

struct XcdBarrier {
    unsigned* bar; unsigned x;
    volatile LAS unsigned* st;
};

__device__ __forceinline__ XcdBarrier xcd_barrier_post(unsigned* bar, volatile LAS unsigned* st) {
    XcdBarrier b; b.bar = bar; b.x = xb_xcc_id(); b.st = st;
    if (threadIdx.x == 0) (void)xb_add(&bar[XB_XCNT(b.x)], 1u);
    return b;
}
__device__ __forceinline__ void xcd_barrier_complete(unsigned* bar, unsigned x, unsigned& nloc, unsigned& nx) {
    const unsigned G = gridDim.x * gridDim.y * gridDim.z;
    unsigned sum, cnt, mine, sp = 0u;
    for (;;) {
        sum = 0u; cnt = 0u; mine = 0u;
#pragma unroll
        for (unsigned j = 0; j < 16; ++j) { const unsigned c = xb_ld(&bar[XB_XCNT(j)]); sum += c; cnt += (c > 0u) ? 1u : 0u; mine = (j == x) ? c : mine; }
        if (sum == G) break;
        __builtin_amdgcn_s_sleep(1);
        if ((++sp & 255u) == 0u) { if (xb_ld(&bar[XB_TMO])) break; if (sp > XB_SPIN_CAP) { atomicAdd(&bar[XB_TMO], 1u); break; } }
    }
    nloc = mine > 0u ? mine : 1u; nx = cnt > 0u ? cnt : 1u;
}

__device__ __forceinline__ void xcd_barrier(const XcdBarrier& b) {
    asm volatile("s_waitcnt vmcnt(0)" ::: "memory");
    __syncthreads();
    if (threadIdx.x == 0) {
        unsigned* bar = b.bar;
        __builtin_amdgcn_s_waitcnt(0);
        unsigned nloc = b.st[0], nx = b.st[1];
        if (nloc == 0u) { xcd_barrier_complete(bar, b.x, nloc, nx); b.st[0] = nloc; b.st[1] = nx; }
        const unsigned old = xb_add(&bar[XB_XSUB(b.x)], 1u);
        const unsigned gen = old / nloc;
        if (old + 1u == (gen + 1u) * nloc) {
            __builtin_amdgcn_fence(__ATOMIC_RELEASE, "agent");
            asm volatile("s_waitcnt vmcnt(0)" ::: "memory");
            const unsigned og = xb_add(&bar[XB_TOP], 1u);
            const unsigned tg = og / nx;
            if (og + 1u == (tg + 1u) * nx) xb_add(&bar[XB_TOPGEN], 1u);
            else XB_SPIN(xb_ld(&bar[XB_TOPGEN]) == tg, bar);
            __builtin_amdgcn_fence(__ATOMIC_ACQUIRE, "agent");
            xb_add(&bar[XB_XGEN(b.x)], 1u);
            asm volatile("s_waitcnt vmcnt(0)" ::: "memory");
        } else {
            XB_SPIN(xb_ld(&bar[XB_XGEN(b.x)]) == gen, bar);
            __builtin_amdgcn_fence(__ATOMIC_ACQUIRE, "agent");
            asm volatile("s_waitcnt vmcnt(0)" ::: "memory");
        }
    }
    __syncthreads();
}
struct Args { const float* in[22]; float* out; unsigned char* ws; int ph_lo, ph_hi, li, pad; };
struct Ctx { int tid, lane, wave, G, vcu; LAS unsigned char* lds; };
#define IN_X 0
#define IN_POS 1
#define IN_GMIX 2
#define IN_WIN 3
#define IN_GQ 4
#define IN_GK 5
#define IN_WCONV 6
#define IN_BCONV 7
#define IN_BI 8
#define IN_BF 9
#define IN_GML 10
#define IN_WPA 11
#define IN_WPM 12
#define IN_WOUT 13
#define IN_GMOE 14
#define IN_WRG 15
#define IN_BRG 16
#define IN_WRE 17
#define IN_BRE 18
#define IN_WEG 19
#define IN_WEU 20
#define IN_WED 21

__device__ __forceinline__ int win_src_col(int n) {
    if (n < 1024) return n;
    if (n < 3072) return n + 40;
    return n + 48;
}
__device__ __forceinline__ int wsm_src_col(int r) {
    return r < 40 ? 1024 + r : (r < 44 ? 3112 + (r - 40) : 3116 + (r - 44));
}
__device__ __forceinline__ void tr_item(const float* W, int ldw, int scol, int k0, bf16* wt0, int K, LAS float* scr, int lane) {
    const int sc0 = __builtin_amdgcn_readfirstlane(scol), sc31 = __builtin_amdgcn_readlane(scol, 31);
    if (sc0 >= 0 && sc31 == sc0 + 31 && (sc0 & 3) == 0 && (ldw & 3) == 0) {
#pragma unroll
        for (int i = 0; i < 8; ++i) { const int kk = 8 * i + (lane >> 3); const f32x4 v = *(const f32x4*)(W + (size_t)(k0 + kk) * ldw + sc0 + 4 * (lane & 7));
            LAS float* d = scr + kk * 33 + 4 * (lane & 7); d[0] = v[0]; d[1] = v[1]; d[2] = v[2]; d[3] = v[3]; }
    } else {
#pragma unroll 8
        for (int i = 0; i < 32; ++i) { const int kk = 2 * i + (lane >> 5); scr[kk * 33 + (lane & 31)] = scol >= 0 ? W[(size_t)(k0 + kk) * ldw + scol] : 0.f; }
    }
    LDS_WAIT(); asm volatile("" ::: "memory");
    const int c = lane & 7;
#pragma unroll
    for (int j = 0; j < 4; ++j) { const int n = (lane >> 3) + 8 * j; const LAS float* s = scr + (8 * c) * 33 + n;
        v4u o; o.x = pk2(s[0 * 33], s[1 * 33]); o.y = pk2(s[2 * 33], s[3 * 33]); o.z = pk2(s[4 * 33], s[5 * 33]); o.w = pk2(s[6 * 33], s[7 * 33]);
        *(v4u*)(wt0 + (size_t)n * K + 8 * c) = o; }
    LDS_WAIT(); asm volatile("" ::: "memory");
}
template <int PART> __device__ __forceinline__ void p0_prologue(const Args& a, const Ctx& c, int gw, int NGW) {
    unsigned char* ws = a.ws;
    LAS float* scr = (LAS float*)(c.lds + c.wave * 16384);
    const int lane = c.lane;
    constexpr int I_IN = 16 * 160, I_PA = 8 * 32, I_PM = 8 * 32, I_OUT = 16 * 32, I_GU = 32 * 16 * 32, I_DN = 32 * 8 * 32;
    constexpr int NPRJ = I_IN + I_PA + I_PM + I_OUT, NIT = NPRJ + I_GU + I_DN;
    for (int it = (PART ? NPRJ : 0) + gw; it < (PART ? NIT : NPRJ); it += NGW) {
        int r = it;
        if (r < I_IN) { const int kb = r / 160, nb = r % 160; tr_item(a.in[IN_WIN], 5168, win_src_col(32 * nb + (lane & 31)), 64 * kb, (bf16*)(ws + WS_WIN) + (size_t)(32 * nb) * 1024 + 64 * kb, 1024, scr, lane); continue; } r -= I_IN;
        if (r < I_PA) { const int kb = r / 32, nb = r % 32; tr_item(a.in[IN_WPA], 1024, 32 * nb + (lane & 31), 64 * kb, (bf16*)(ws + WS_WPA) + (size_t)(32 * nb) * 512 + 64 * kb, 512, scr, lane); continue; } r -= I_PA;
        if (r < I_PM) { const int kb = r / 32, nb = r % 32; tr_item(a.in[IN_WPM], 1024, 32 * nb + (lane & 31), 64 * kb, (bf16*)(ws + WS_WPM) + (size_t)(32 * nb) * 512 + 64 * kb, 512, scr, lane); continue; } r -= I_PM;
        if (r < I_OUT) { const int kb = r / 32, nb = r % 32; tr_item(a.in[IN_WOUT], 1024, 32 * nb + (lane & 31), 64 * kb, (bf16*)(ws + WS_WOUT) + (size_t)(32 * nb) * 1024 + 64 * kb, 1024, scr, lane); continue; } r -= I_OUT;
        if (r < I_GU) { const int e = r / 512, q = r % 512, kb = q / 32, nb = q % 32, t = nb >> 3, bj = (nb >> 2) & 1, i0 = (nb & 3) * 32;
            const float* src = (bj ? a.in[IN_WEU] : a.in[IN_WEG]) + (size_t)e * 1024 * 512;
            tr_item(src, 512, 128 * t + i0 + (lane & 31), 64 * kb, (bf16*)(ws + WS_GU) + ((size_t)e * 1024 + 32 * nb) * 1024 + 64 * kb, 1024, scr, lane); continue; } r -= I_GU;
        { const int e = r / 256, q = r % 256, kb = q / 32, nb = q % 32;
            tr_item(a.in[IN_WED] + (size_t)e * 512 * 1024, 1024, 32 * nb + (lane & 31), 64 * kb, (bf16*)(ws + WS_DN) + ((size_t)e * 1024 + 32 * nb) * 512 + 64 * kb, 512, scr, lane); }
    }
    if (PART) return;
    { float* WTG = (float*)(ws + WS_WTG); for (int i = gw * 64 + lane; i < 36 * 1024; i += NGW * 64) { const int j = i >> 10, k = i & 1023;
        WTG[j * 1028 + k] = (j < 32 ? a.in[IN_WRE][k * 32 + j] : a.in[IN_WRG][k * 4 + (j - 32)]) * a.in[IN_GMOE][k]; } }
    { bf16* WSM = (bf16*)(ws + WS_WSM); for (int i = gw * 64 + lane; i < 48 * 1024; i += NGW * 64) { const int r = i >> 10, k = i & 1023; WSM[i] = (bf16)f2bf(a.in[IN_WIN][(size_t)k * 5168 + wsm_src_col(r)]); } }
    const float* g = a.in[IN_GMIX]; f32x4 gv[4];
#pragma unroll
    for (int j = 0; j < 4; ++j) gv[j] = *(const f32x4*)(g + 4 * lane + 256 * j);
    bf16* H = (bf16*)((unsigned char*)a.out + DO_H);
    for (int m0 = gw; m0 < T; m0 += 2 * NGW) {
        const int mA = m0, mB = (m0 + NGW < T) ? m0 + NGW : m0; const bool hasB = (m0 + NGW < T);
        const f32x4* xa = (const f32x4*)(a.in[IN_X] + (size_t)mA * D) + lane; const f32x4* xb = (const f32x4*)(a.in[IN_X] + (size_t)mB * D) + lane;
        f32x4 va[4], vb[4]; float sa = 0.f, sb = 0.f;
#pragma unroll
        for (int j = 0; j < 4; ++j) { va[j] = xa[64 * j]; vb[j] = xb[64 * j]; }
#pragma unroll
        for (int j = 0; j < 4; ++j) { sa += (va[j].x * va[j].x + va[j].y * va[j].y) + (va[j].z * va[j].z + va[j].w * va[j].w); sb += (vb[j].x * vb[j].x + vb[j].y * vb[j].y) + (vb[j].z * vb[j].z + vb[j].w * vb[j].w); }
        const float ra = rsqrtf(wave_sum(sa) * (1.f / D) + EPS), rb = rsqrtf(wave_sum(sb) * (1.f / D) + EPS);
        v2u* oa = (v2u*)(H + (size_t)mA * D) + lane; v2u* ob = (v2u*)(H + (size_t)mB * D) + lane;
#pragma unroll
        for (int j = 0; j < 4; ++j) { v2u w; w.x = pk2(va[j].x * ra * gv[j].x, va[j].y * ra * gv[j].y); w.y = pk2(va[j].z * ra * gv[j].z, va[j].w * ra * gv[j].w); oa[64 * j] = w; }
        if (hasB) {
#pragma unroll
        for (int j = 0; j < 4; ++j) { v2u w; w.x = pk2(vb[j].x * rb * gv[j].x, vb[j].y * rb * gv[j].y); w.y = pk2(vb[j].z * rb * gv[j].z, vb[j].w * rb * gv[j].w); ob[64 * j] = w; } }
    }
}

__device__ __forceinline__ const bf16* proj_tile(const Args& a, int tile) { return (const bf16*)(a.ws + WS_PROJ + (size_t)tile * PROJ_TILE); }
#define DPPF(x_, ctrl_) __int_as_float(__builtin_amdgcn_update_dpp(0, __float_as_int(x_), ctrl_, 0xF, 0xF, true))
__device__ __forceinline__ void p2_prep(const Args& a, const Ctx& c) {
    const int lane = c.lane, gw = c.vcu * NWAVES + c.wave, NGW = c.G * NWAVES;
    float invf = 0.f;
    if (lane < 8) invf = (float)pow(500000.0, -(double)lane / 8.0); else if (lane < 12) invf = (float)pow(500000.0, -(double)(lane - 8) / 4.0);
    float gq[8], gk[8];
#pragma unroll
    for (int i = 0; i < 8; ++i) { gq[i] = a.in[IN_GQ][8 * (lane & 7) + i]; gk[i] = a.in[IN_GK][8 * (lane & 7) + i]; }
    const int* pos = (const int*)a.in[IN_POS];
    unsigned char* dout = (unsigned char*)a.out;
    bf16* AQN = (bf16*)(dout + DO_AQN); bf16* KN = (bf16*)(dout + DO_KN); bf16* IQR = (bf16*)(dout + DO_IQR); bf16* IKR = (bf16*)(dout + DO_IKR);
    { const bf16* Hh = (const bf16*)(dout + DO_H); const bf16* WSM = (const bf16*)(a.ws + WS_WSM); bf16* SMB = (bf16*)(dout + DO_SMB);
      const int row = lane & 15, kg = lane >> 4;
      const float invfk = (float)pow(500000.0, -(double)(lane & 3) / 4.0);
      for (int tile = gw; tile < T / 16; tile += NGW) { const int t0 = tile * 16;
          f32x4 acc[3];
#pragma unroll
          for (int ct = 0; ct < 3; ++ct) acc[ct] = (f32x4){0.f, 0.f, 0.f, 0.f};
          const bf16* ap = Hh + (size_t)(t0 + row) * 1024 + 8 * kg; const bf16* bp = WSM + (size_t)row * 1024 + 8 * kg;
#pragma unroll 8
          for (int ks = 0; ks < 32; ++ks) { const bf16x8 av = *(const bf16x8*)(ap + 32 * ks);
#pragma unroll
              for (int ct = 0; ct < 3; ++ct) acc[ct] = __builtin_amdgcn_mfma_f32_16x16x32_bf16(av, *(const bf16x8*)(bp + (size_t)ct * 16 * 1024 + 32 * ks), acc[ct], 0, 0, 0); }
          const int col = lane & 15;
#pragma unroll
          for (int r = 0; r < 4; ++r) { const int t = t0 + 4 * kg + r;
              const float angk = (float)pos[t] * invfk;
              const double revk = (double)angk * 0.15915494309189535; const float frk = (float)(revk - __builtin_rint(revk));
              const float ck = __builtin_amdgcn_cosf(frk), sk = __builtin_amdgcn_sinf(frk);
              const float v0 = acc[0][r], pr = __shfl_xor(v0, 4);
              const float o0 = (col < 4) ? (v0 * ck - pr * sk) : ((col < 8) ? (v0 * ck + pr * sk) : v0);
              IKR[(size_t)t * 32 + col] = (bf16)f2bf(o0); IKR[(size_t)t * 32 + 16 + col] = (bf16)f2bf(acc[1][r]);
              SMB[(size_t)t * 16 + col] = (bf16)f2bf(acc[2][r]); } } }
    const int l7 = lane & 7;
    const int aqcol = (lane >> 3) * 64 + 8 * l7, akcol = ((lane & 15) >> 3) * 64 + 8 * l7;
    const bf16* aqsrc = proj_tile(a, TL_AQ + (aqcol >> 8)) + (aqcol & 255); const bf16* aksrc = proj_tile(a, TL_KV) + akcol; const bf16* iqsrc = proj_tile(a, TL_IQ) + 4 * lane;
#define P2_LOADROW(t_, P_, A_, K_, Q_) do { const int tt_ = (t_) < T ? (t_) : T - 1; P_ = pos[tt_]; A_ = *(const v4u*)(aqsrc + (size_t)tt_ * 256); K_ = *(const v4u*)(aksrc + (size_t)tt_ * 256); Q_ = *(const v2u*)(iqsrc + (size_t)tt_ * 256); } while (0)
#define P2_DOROW(t, P_, A_, K_, Q_) do { \
        const float ang = (float)(P_) * invf; \
        const double rev = (double)ang * 0.15915494309189535; const float frv = (float)(rev - __builtin_rint(rev)); \
        float cs = __builtin_amdgcn_cosf(frv), sn = __builtin_amdgcn_sinf(frv); \
        float ca[8], sa[8], ci[4], si[4]; \
        _Pragma("unroll") for (int i = 0; i < 8; ++i) { ca[i] = __int_as_float(__builtin_amdgcn_readlane(__float_as_int(cs), i)); sa[i] = __int_as_float(__builtin_amdgcn_readlane(__float_as_int(sn), i)); } \
        _Pragma("unroll") for (int i = 0; i < 4; ++i) { ci[i] = __int_as_float(__builtin_amdgcn_readlane(__float_as_int(cs), 8 + i)); si[i] = __int_as_float(__builtin_amdgcn_readlane(__float_as_int(sn), 8 + i)); } \
        { float f[8]; unpack8(A_, f); float ss = 0.f; \
          _Pragma("unroll") for (int i = 0; i < 8; ++i) ss += f[i] * f[i]; \
          ss += DPPF(ss, 0xB1); ss += DPPF(ss, 0x4E); ss += DPPF(ss, 0x141); \
          const float r = rsqrtf(ss * (1.f / 64.f) + EPS); \
          _Pragma("unroll") for (int i = 0; i < 8; ++i) f[i] = f[i] * r * gq[i]; \
          float o[8]; \
          _Pragma("unroll") for (int i = 0; i < 8; ++i) { const float p = DPPF(f[i], 0xB1); o[i] = (l7 == 0) ? (f[i] * ca[i] - p * sa[i]) : ((l7 == 1) ? (f[i] * ca[i] + p * sa[i]) : f[i]); o[i] *= 0.125f * 1.4426950408889634f; } \
          *(v4u*)(AQN + (size_t)(t) * 512 + aqcol) = pack8(o); } \
        { float f[8]; unpack8(K_, f); float ss = 0.f; \
          _Pragma("unroll") for (int i = 0; i < 8; ++i) ss += f[i] * f[i]; \
          ss += DPPF(ss, 0xB1); ss += DPPF(ss, 0x4E); ss += DPPF(ss, 0x141); \
          const float r = rsqrtf(ss * (1.f / 64.f) + EPS); \
          _Pragma("unroll") for (int i = 0; i < 8; ++i) f[i] = f[i] * r * gk[i]; \
          float o[8]; \
          _Pragma("unroll") for (int i = 0; i < 8; ++i) { const float p = DPPF(f[i], 0xB1); o[i] = (l7 == 0) ? (f[i] * ca[i] - p * sa[i]) : ((l7 == 1) ? (f[i] * ca[i] + p * sa[i]) : f[i]); } \
          if (lane < 16) *(v4u*)(KN + (size_t)(t) * 128 + akcol) = pack8(o); } \
        { const v2u rw = Q_; \
          float f[4] = {bf2f(rw.x & 0xffffu), bf2f(rw.x >> 16), bf2f(rw.y & 0xffffu), bf2f(rw.y >> 16)}; float o[4]; \
          _Pragma("unroll") for (int i = 0; i < 4; ++i) { const float p = DPPF(f[i], 0xB1); o[i] = (l7 == 0) ? (f[i] * ci[i] - p * si[i]) : ((l7 == 1) ? (f[i] * ci[i] + p * si[i]) : f[i]); } \
          v2u w; w.x = pk2(o[0], o[1]); w.y = pk2(o[2], o[3]); *(v2u*)(IQR + (size_t)(t) * 256 + 4 * lane) = w; } } while (0)
    { int pA, pB; v4u aA, aB, kA, kB; v2u qA, qB;
      P2_LOADROW(gw, pA, aA, kA, qA);
#pragma unroll 1
      for (int t = gw; t < T; t += 2 * NGW) {
          P2_LOADROW(t + NGW, pB, aB, kB, qB);
          P2_DOROW(t, pA, aA, kA, qA);
          P2_LOADROW(t + 2 * NGW, pA, aA, kA, qA);
          if (t + NGW < T) P2_DOROW(t + NGW, pB, aB, kB, qB);
      } }
#undef P2_LOADROW
#undef P2_DOROW
}
constexpr int ML_QS = 0, ML_KS = 17408, ML_HS = 0;
constexpr int ML_KWT = 34816;
constexpr int ML_VT = 53248;
constexpr int ML_SW = 73984;
constexpr int ML_CT = 83200;
constexpr int ML_GA = 122368;
constexpr int ML_CW = ML_GA + 1024;
constexpr int ML_END = ML_CW + (1024 + 384) * 4;
static_assert(ML_END <= MISC_OFF, "mLSTM LDS map");
constexpr size_t ML_STATE_BYTES = 8 * 9 * 64 * 16;
__device__ __forceinline__ bf16x8 lds_frag(const LAS unsigned char* base, int stride_b, int row0, int kb, int lane) {
    return *(const LAS bf16x8*)(base + (row0 + (lane & 15)) * stride_b + kb + (lane >> 4) * 16);
}
__device__ __forceinline__ bf16x8 lds_frag_sw(const LAS unsigned char* base, int row0, int ks, int lane) {
    const int row = row0 + (lane & 15); return *(const LAS bf16x8*)(base + row * 144 + 16 * (((ks * 4 + (lane >> 4)) + (row >> 3)) & 7));
}
#define MFMA16(a_, b_, c_) __builtin_amdgcn_mfma_f32_16x16x32_bf16(a_, b_, c_, 0, 0, 0)
template <int MODE>
__device__ __forceinline__ void mlstm_unit(const Args& a, const Ctx& c, int b, int h, int g) {
    const int tid = c.tid, wave = c.wave; LAS unsigned char* lds = c.lds;
#define ML_LAUNDER() int tv_ = tid; asm volatile("" : "+v"(tv_)); const int lane = tv_ & 63, seg = tv_ & 15, r2 = (tv_ >> 4) * 2; (void)lane; (void)seg; (void)r2
    const bf16* PQ = proj_tile(a, TL_MQ + (h >> 1)) + (h & 1) * 128;
    const bf16* PK = proj_tile(a, TL_MK + (h >> 1)) + (h & 1) * 128;
    const bf16* PV = proj_tile(a, TL_MV + (h >> 1)) + (h & 1) * 128;
    const bf16* PO = proj_tile(a, TL_MO + (h >> 1)) + (h & 1) * 128;
    const bf16* PS = (const bf16*)((unsigned char*)a.out + DO_SMB);
    bf16* YML = (bf16*)((unsigned char*)a.out + DO_YML);
    unsigned char* STB = a.ws + WS_MLST; float* MST = (float*)(a.ws + WS_MLST + 256 * ML_STATE_BYTES);
    LAS float* GAa = (LAS float*)(lds + ML_GA); LAS float* GAm = GAa + 64; LAS float* GAw = GAa + 128; LAS float* GAe = GAa + 192;
    LAS float* CWQ = (LAS float*)(lds + ML_CW); LAS float* CWK = CWQ + 512; LAS float* CBQ = CWQ + 1024; LAS float* CBK = CBQ + 128; LAS float* GN = CBK + 128;
    LAS bf16* VTs = (LAS bf16*)(lds + ML_VT);
    { const float* wc = a.in[IN_WCONV]; const int j = tid >> 7, d = tid & 127;
      CWQ[tid] = wc[j * 1024 + h * 128 + d]; CWK[tid] = wc[j * 1024 + 512 + h * 128 + d];
      if (tid < 128) { CBQ[tid] = a.in[IN_BCONV][h * 128 + tid]; CBK[tid] = a.in[IN_BCONV][512 + h * 128 + tid]; GN[tid] = a.in[IN_GML][h * 128 + tid]; } }
    for (int i = tid; i < 16 * 64; i += 512) { const int r = i >> 6, cc = i & 63; VTs[(128 + r) * 72 + cc] = (r == 0) ? (bf16)0x3F80 : (bf16)0; }
    const float big = a.in[IN_BI][h], bfg = a.in[IN_BF][h];
    const int slot0 = (b * 4 + h) * 8;
    f32x4 cacc[9];
    float m_st = 0.f;
    if (MODE == 1 && g > 0) { ML_LAUNDER();
        const f32x4* sp = (const f32x4*)(STB + (size_t)(slot0 + g) * ML_STATE_BYTES) + wave * 576 + lane;
#pragma unroll
        for (int i = 0; i < 9; ++i) cacc[i] = sp[64 * i];
        m_st = MST[slot0 + g];
#pragma unroll
        for (int ee = 0; ee < 9; ++ee) { v2u w; w.x = pk2(cacc[ee][0], cacc[ee][1]); w.y = pk2(cacc[ee][2], cacc[ee][3]);
            *(LAS v2u*)(lds + ML_CT + (ee * 16 + (lane & 15)) * 272 + (wave * 16 + 4 * (lane >> 4)) * 2) = w; }
    } else {
#pragma unroll
        for (int i = 0; i < 9; ++i) cacc[i] = (f32x4){0.f, 0.f, 0.f, 0.f};
        for (int i = tid; i < 144 * 136 / 2; i += 512) ((LAS unsigned*)(lds + ML_CT))[i] = 0u;
    }
    const size_t tb = (size_t)b * SEQ;
    const char* bq = (const char*)(PQ + tb * 256); const char* bk = (const char*)(PK + tb * 256); const char* bv = (const char*)(PV + tb * 256); const char* bo = (const char*)(PO + tb * 256); const char* bs = (const char*)(PS + tb * 16);
    v4u rq[5], rk[5], rv[2]; unsigned short gi = 0, gf = 0;
#define ML_LOAD(kc) do { _Pragma("unroll") for (int j_ = 0; j_ < 5; ++j_) { const int rr_ = 64 * (kc) + r2 - 3 + j_; const unsigned o_ = (unsigned)((rr_ < 0 ? 0 : rr_) * 512 + seg * 16); \
            v4u q_ = (v4u){0u, 0u, 0u, 0u}; if (MODE == 1) q_ = *(const v4u*)(bq + o_); v4u k_ = *(const v4u*)(bk + o_); if (rr_ < 0) { q_ = (v4u){0u, 0u, 0u, 0u}; k_ = q_; } rq[j_] = q_; rk[j_] = k_; } \
        _Pragma("unroll") for (int i_ = 0; i_ < 2; ++i_) rv[i_] = *(const v4u*)(bv + (unsigned)((64 * (kc) + r2 + i_) * 512 + seg * 16)); \
        gi = *(const unsigned short*)(bs + (unsigned)((64 * (kc) + lane) * 32 + (8 + h) * 2)); gf = *(const unsigned short*)(bs + (unsigned)((64 * (kc) + lane) * 32 + (12 + h) * 2)); } while (0)
    const int kc0 = (MODE == 1) ? 8 * g : 0, kc1 = (MODE == 1) ? 8 * g + 8 : 56;
    { ML_LAUNDER(); ML_LOAD(kc0); }
    __syncthreads();
#pragma unroll 1
    for (int kc = kc0; kc < kc1; ++kc) {
        float wkv, decay, m_new;
        if (MODE == 0 && kc > 0 && (kc & 7) == 0) { ML_LAUNDER();
            f32x4* sp = (f32x4*)(STB + (size_t)(slot0 + (kc >> 3)) * ML_STATE_BYTES) + wave * 576 + lane;
#pragma unroll
            for (int i = 0; i < 9; ++i) sp[64 * i] = cacc[i];
            if (tid == 0) MST[slot0 + (kc >> 3)] = m_st; }
        { ML_LAUNDER();
        const float fpre = bf2f(gf) + bfg, lf = fminf(fpre, 0.f) - log1pf(__expf(-fabsf(fpre)));
        const float ig = bf2f(gi) + big;
#define ML_SHR(x_, n_, id_) __int_as_float(__builtin_amdgcn_update_dpp(__float_as_int(id_), __float_as_int(x_), 0x110 + (n_), 0xF, 0xF, false))
        float bc = lf;
        bc += ML_SHR(bc, 1, 0.f); bc += ML_SHR(bc, 2, 0.f); bc += ML_SHR(bc, 4, 0.f); bc += ML_SHR(bc, 8, 0.f);
        { const float t0 = __int_as_float(__builtin_amdgcn_readlane(__float_as_int(bc), 15)), t1 = __int_as_float(__builtin_amdgcn_readlane(__float_as_int(bc), 31)), t2 = __int_as_float(__builtin_amdgcn_readlane(__float_as_int(bc), 47));
          bc += (lane >= 48) ? (t0 + t1 + t2) : ((lane >= 32) ? (t0 + t1) : ((lane >= 16) ? t0 : 0.f)); }
        const float av = ig - bc; float Ac = av;
        Ac = fmaxf(Ac, ML_SHR(Ac, 1, -3.0e38f)); Ac = fmaxf(Ac, ML_SHR(Ac, 2, -3.0e38f)); Ac = fmaxf(Ac, ML_SHR(Ac, 4, -3.0e38f)); Ac = fmaxf(Ac, ML_SHR(Ac, 8, -3.0e38f));
        { const float t0 = __int_as_float(__builtin_amdgcn_readlane(__float_as_int(Ac), 15)), t1 = __int_as_float(__builtin_amdgcn_readlane(__float_as_int(Ac), 31)), t2 = __int_as_float(__builtin_amdgcn_readlane(__float_as_int(Ac), 47));
          const float m01 = fmaxf(t0, t1), m012 = fmaxf(m01, t2);
          Ac = fmaxf(Ac, (lane >= 48) ? m012 : ((lane >= 32) ? m01 : ((lane >= 16) ? t0 : -3.0e38f))); }
#undef ML_SHR
        const float mA = fmaxf(m_st, Ac), Mk = __int_as_float(__builtin_amdgcn_readlane(__float_as_int(mA), 63)), blast = __int_as_float(__builtin_amdgcn_readlane(__float_as_int(bc), 63));
        wkv = __expf(av - Mk); decay = __expf(m_st - Mk); m_new = blast + Mk;
        if (MODE == 1 && wave == 0) { GAa[lane] = av; GAm[lane] = mA; GAw[lane] = __expf(m_st - mA); GAe[lane] = __expf(-(bc + mA)); } }
        { ML_LAUNDER(); float kw_[2][8];
#pragma unroll
          for (int i = 0; i < 2; ++i) { const int t = r2 + i; const float wkt = __shfl(wkv, t);
            float aq_[8], ak_[8];
            { const f32x4 b0 = *(const LAS f32x4*)(CBQ + seg * 8), b1 = *(const LAS f32x4*)(CBQ + seg * 8 + 4), c0 = *(const LAS f32x4*)(CBK + seg * 8), c1 = *(const LAS f32x4*)(CBK + seg * 8 + 4);
              aq_[0] = b0[0]; aq_[1] = b0[1]; aq_[2] = b0[2]; aq_[3] = b0[3]; aq_[4] = b1[0]; aq_[5] = b1[1]; aq_[6] = b1[2]; aq_[7] = b1[3];
              ak_[0] = c0[0]; ak_[1] = c0[1]; ak_[2] = c0[2]; ak_[3] = c0[3]; ak_[4] = c1[0]; ak_[5] = c1[1]; ak_[6] = c1[2]; ak_[7] = c1[3]; }
#pragma unroll
            for (int j = 0; j < 4; ++j) { float fk_[8]; unpack8(rk[i + j], fk_);
                const f32x4 x0 = *(const LAS f32x4*)(CWK + j * 128 + seg * 8), x1 = *(const LAS f32x4*)(CWK + j * 128 + seg * 8 + 4);
#pragma unroll
                for (int e = 0; e < 4; ++e) { ak_[e] += x0[e] * fk_[e]; ak_[4 + e] += x1[e] * fk_[4 + e]; }
                if (MODE == 1) { float fq_[8]; unpack8(rq[i + j], fq_);
                    const f32x4 w0 = *(const LAS f32x4*)(CWQ + j * 128 + seg * 8), w1 = *(const LAS f32x4*)(CWQ + j * 128 + seg * 8 + 4);
#pragma unroll
                    for (int e = 0; e < 4; ++e) { aq_[e] += w0[e] * fq_[e]; aq_[4 + e] += w1[e] * fq_[4 + e]; } } }
#pragma unroll
            for (int e = 0; e < 8; ++e) { ak_[e] = ak_[e] * sigm(ak_[e]) * 0.08838834764831845f; kw_[i][e] = ak_[e] * wkt; }
            if (MODE == 1) {
#pragma unroll
                for (int e = 0; e < 8; ++e) aq_[e] = aq_[e] * sigm(aq_[e]);
                *(LAS v4u*)(lds + ML_QS + t * 272 + seg * 16) = pack8(aq_);
                *(LAS v4u*)(lds + ML_KS + t * 272 + seg * 16) = pack8(ak_); } }
          const unsigned va[4] = {rv[0].x, rv[0].y, rv[0].z, rv[0].w}, vb[4] = {rv[1].x, rv[1].y, rv[1].z, rv[1].w};
          const int swo = 16 * (((r2 >> 3) + seg) & 7) + 2 * (r2 & 7);
#pragma unroll
          for (int e = 0; e < 8; ++e) { const int ro = (seg * 8 + e) * 144 + swo;
              *(LAS unsigned*)(lds + ML_KWT + ro) = pk2(kw_[0][e], kw_[1][e]);
              const unsigned lo = (e & 1) ? (va[e >> 1] >> 16) : (va[e >> 1] & 0xffffu), hi = (e & 1) ? (vb[e >> 1] >> 16) : (vb[e >> 1] & 0xffffu);
              *(LAS unsigned*)(lds + ML_VT + ro) = lo | (hi << 16); }
        if (kc + 1 < kc1) ML_LOAD(kc + 1); }
        __syncthreads();
        f32x4 hacc[5]; unsigned mo_r[8];
        const int tt = wave & 3, t0 = tt * 16, ne = (wave < 4) ? 5 : 4, e_first = (wave < 4) ? 0 : 5;
        if (MODE == 1) {
        { ML_LAUNDER(); const int tq = t0 + (lane & 15);
        bf16x8 qf[4];
#pragma unroll
        for (int ks = 0; ks < 4; ++ks) qf[ks] = lds_frag(lds + ML_QS, 272, t0, ks * 64, lane);
        const float mAt = GAm[tq], wit = GAw[tq];
#pragma unroll
        for (int si = 0; si < 2; ++si) { const int ss = 2 * (wave >> 2) + si, s0 = ss * 16; f32x4 sacc = (f32x4){0.f, 0.f, 0.f, 0.f};
            if (ss <= tt) {
#pragma unroll
                for (int ks = 0; ks < 4; ++ks) sacc = MFMA16(lds_frag(lds + ML_KS, 272, s0, ks * 64, lane), qf[ks], sacc);
#pragma unroll
                for (int r = 0; r < 4; ++r) { const int s = s0 + 4 * (lane >> 4) + r; sacc[r] = (s <= tq) ? sacc[r] * __expf(GAa[s] - mAt) : 0.f; } }
            v2u w; w.x = pk2(sacc[0], sacc[1]); w.y = pk2(sacc[2], sacc[3]);
            *(LAS v2u*)(lds + ML_SW + tq * 144 + s0 * 2 + (lane >> 4) * 8) = w; }
#pragma unroll
        for (int i = 0; i < 5; ++i) { hacc[i] = (f32x4){0.f, 0.f, 0.f, 0.f};
            if (i < ne) {
#pragma unroll
                for (int ks = 0; ks < 4; ++ks) hacc[i] = MFMA16(lds_frag(lds + ML_CT, 272, (e_first + i) * 16, ks * 64, lane), qf[ks], hacc[i]);
                hacc[i] = hacc[i] * wit; } }
#pragma unroll
        for (int i = 0; i < 8; ++i) mo_r[i] = *(const unsigned*)(bo + (unsigned)((64 * kc + 8 * wave + i) * 512 + 4 * lane)); }
        __syncthreads();
        { ML_LAUNDER(); const int tq = t0 + (lane & 15); bf16x8 swf[2];
#pragma unroll
          for (int ks = 0; ks < 2; ++ks) swf[ks] = lds_frag(lds + ML_SW, 144, t0, ks * 64, lane);
#pragma unroll
          for (int i = 0; i < 5; ++i) if (i < ne) { const int ee = e_first + i;
#pragma unroll
              for (int ks = 0; ks < 2; ++ks) hacc[i] = MFMA16(lds_frag_sw(lds + ML_VT, ee * 16, ks, lane), swf[ks], hacc[i]);
              if (ee < 8) *(LAS f32x4*)(lds + ML_HS + tq * 528 + (ee * 16 + 4 * (lane >> 4)) * 4) = hacc[i];
              else if ((lane >> 4) == 0) *(LAS float*)(lds + ML_HS + tq * 528 + 128 * 4) = hacc[i][0]; } }
        }
        { ML_LAUNDER(); const int d0 = wave * 16; bf16x8 kwf[2];
#pragma unroll
          for (int ks = 0; ks < 2; ++ks) kwf[ks] = lds_frag_sw(lds + ML_KWT, d0, ks, lane);
#pragma unroll
          for (int ee = 0; ee < 9; ++ee) { cacc[ee] = cacc[ee] * decay;
#pragma unroll
              for (int ks = 0; ks < 2; ++ks) cacc[ee] = MFMA16(kwf[ks], lds_frag_sw(lds + ML_VT, ee * 16, ks, lane), cacc[ee]);
              if (MODE == 1) { v2u w; w.x = pk2(cacc[ee][0], cacc[ee][1]); w.y = pk2(cacc[ee][2], cacc[ee][3]);
                  *(LAS v2u*)(lds + ML_CT + (ee * 16 + (lane & 15)) * 272 + (d0 + 4 * (lane >> 4)) * 2) = w; } } }
        __syncthreads();
        if (MODE == 1) {
        { ML_LAUNDER();
#pragma unroll
        for (int i = 0; i < 8; ++i) { const int t = 8 * wave + i;
            const f32x2 nv = *(const LAS f32x2*)(lds + ML_HS + t * 528 + lane * 8); const float den = *(const LAS float*)(lds + ML_HS + t * 528 + 512);
            const float dd = fmaxf(fabsf(den), GAe[t]); const float h0 = nv.x / dd, h1 = nv.y / dd;
            const float r = rsqrtf(wave_sum(h0 * h0 + h1 * h1) * (1.f / 128.f) + EPS);
            const float y0 = h0 * r * GN[2 * lane] * sigm(bf2f(mo_r[i] & 0xffffu)), y1 = h1 * r * GN[2 * lane + 1] * sigm(bf2f(mo_r[i] >> 16));
            *(unsigned*)(YML + (tb + 64 * kc + t) * 512 + h * 128 + 2 * lane) = pk2(y0, y1); } }
        __syncthreads();
        }
        m_st = m_new;
    }
    if (MODE == 0) { ML_LAUNDER();
        f32x4* sp = (f32x4*)(STB + (size_t)(slot0 + 7) * ML_STATE_BYTES) + wave * 576 + lane;
#pragma unroll
        for (int i = 0; i < 9; ++i) sp[64 * i] = cacc[i];
        if (tid == 0) MST[slot0 + 7] = m_st; }
#undef ML_LOAD
#undef ML_LAUNDER
}
constexpr int AT_HIST = 0;
constexpr int AT_HROW = 2049;
constexpr int AT_SEL = 131072 + 256;
constexpr int AT_MROW = 129;
constexpr int AT_SM = AT_SEL + 8448;
constexpr int AT_LUT = AT_SM + 256;
constexpr int AT_SEL2 = AT_LUT + 256;
static_assert(AT_SEL2 + 8448 <= MISC_OFF, "attention LDS map");
__device__ __forceinline__ unsigned score_key(float s) { unsigned u = __float_as_uint(s + 0.0f); return (u & 0x80000000u) ? ~u : (u | 0x80000000u); }
__device__ __forceinline__ unsigned wave_suffix_sum(unsigned v, int lane) {
#define AT_SHL(x_, n_) ((unsigned)__builtin_amdgcn_update_dpp(0, (int)(x_), 0x100 + (n_), 0xF, 0xF, false))
    v += AT_SHL(v, 1); v += AT_SHL(v, 2); v += AT_SHL(v, 4); v += AT_SHL(v, 8);
#undef AT_SHL
    const unsigned t1 = (unsigned)__builtin_amdgcn_readlane((int)v, 16), t2 = (unsigned)__builtin_amdgcn_readlane((int)v, 32), t3 = (unsigned)__builtin_amdgcn_readlane((int)v, 48);
    return v + ((lane < 16) ? (t1 + t2 + t3) : ((lane < 32) ? (t2 + t3) : ((lane < 48) ? t3 : 0u)));
}
template <int NK> __device__ __forceinline__ void at_resolve(const LAS unsigned long long* cand, LAS unsigned* mask, int m, int nd, int lane) {
    unsigned long long cv[NK];
#pragma unroll
    for (int k = 0; k < NK; ++k) { const int i = 64 * k + lane; unsigned long long x = 0ull; if (i < m) x = cand[i]; cv[k] = (i < m) ? ((((x >> 32) & 0xFFFFFull) << 16) | (x & 0xFFFFull)) : 0ull; }
    unsigned long long T = 0ull;
#pragma unroll 1
    for (int bit = 35; bit >= 16; --bit) { const unsigned long long test = T | (1ull << bit); int cge = 0;
#pragma unroll
        for (int k = 0; k < NK; ++k) cge += __popcll(__ballot(cv[k] >= test));
        if (cge >= nd) T = test; }
    int g = 0, t = 0;
#pragma unroll
    for (int k = 0; k < NK; ++k) { g += __popcll(__ballot(cv[k] >= T + 0x10000ull)); t += __popcll(__ballot(cv[k] >= T)); }
    t -= g;
    if (t > nd - g) {
#pragma unroll 1
        for (int bit = 15; bit >= 0; --bit) { const unsigned long long test = T | (1ull << bit); int cge = 0;
#pragma unroll
            for (int k = 0; k < NK; ++k) cge += __popcll(__ballot(cv[k] >= test));
            if (cge >= nd) T = test; } }
#pragma unroll
    for (int k = 0; k < NK; ++k) if (cv[k] >= T && cv[k] != 0ull) { const unsigned key = 0xFFFFu - (unsigned)(cv[k] & 0xFFFFull);
        __hip_atomic_fetch_or(&mask[key >> 5], 1u << (key & 31u), __ATOMIC_RELAXED, __HIP_MEMORY_SCOPE_WORKGROUP); }
}
__device__ __forceinline__ void attn_unit(const Args& a, const Ctx& c, int b, int qt, float cshift) {
    const int tid = c.tid, wave = c.wave; LAS unsigned char* lds = c.lds;
#define AT_LAUNDER() int tv_ = tid; asm volatile("" : "+v"(tv_)); const int lane = tv_ & 63, qi = tv_ & 15, fq = (tv_ >> 4) & 3; (void)lane; (void)qi; (void)fq
    const int q0u = qt * 32, ch = q0u >> 6, n = 64 * (ch + 1), ntiles = n >> 4;
    const size_t tb = (size_t)b * SEQ;
    unsigned char* dout = (unsigned char*)a.out;
    const bf16* AQN = (const bf16*)(dout + DO_AQN); const bf16* KN = (const bf16*)(dout + DO_KN); const bf16* IQR = (const bf16*)(dout + DO_IQR); const bf16* IKR = (const bf16*)(dout + DO_IKR);
    bf16* YATT = (bf16*)(dout + DO_YATT);
    const bf16* VB = proj_tile(a, TL_KV); const bf16* PS = (const bf16*)(dout + DO_SMB);
    LAS unsigned* HIST = (LAS unsigned*)(lds + AT_HIST);
    LAS unsigned long long* CAND = (LAS unsigned long long*)(lds + AT_HIST);
    LAS int* SM = (LAS int*)(lds + AT_SM);
    float* SC = (blockIdx.x < 240) ? (float*)(a.ws + WS_SC) + (size_t)blockIdx.x * (16 * 4096) : (float*)(a.ws + WS_SC2) + (size_t)(blockIdx.x - 240) * (16 * 4096);
#ifndef DBG_REP_DENSE
#define DBG_REP_DENSE 1
#endif
#pragma unroll 1
    for (int rsel = 0; rsel < 2; ++rsel) {
    const int q0 = q0u + 16 * rsel;
    LAS unsigned* MASK = (LAS unsigned*)(lds + (rsel ? AT_SEL2 : AT_SEL));
    if (n > 256) {
        for (int i = tid; i < 8192 + 4; i += 512) ((LAS v4u*)HIST)[i] = (v4u){0u, 0u, 0u, 0u};
        if (tid < 64) SM[tid] = 0;
        for (int i = tid; i < 16 * AT_MROW; i += 512) MASK[i] = 0u;
        bf16x8 qf[8]; float wv[8]; bf16x8 qsh, qsl;
        { AT_LAUNDER();
        const size_t trow = tb + q0 + qi;
#pragma unroll
        for (int h = 0; h < 8; ++h) qf[h] = *(const bf16x8*)(IQR + trow * 256 + h * 32 + 8 * fq);
        { float t8[8]; unpack8(*(const v4u*)(PS + trow * 16), t8);
#pragma unroll
          for (int h = 0; h < 8; ++h) wv[h] = t8[h] * 0.03125f; }
        { float qs[8];
#pragma unroll
          for (int j = 0; j < 8; ++j) qs[j] = 0.f;
#pragma unroll
          for (int h = 0; h < 8; ++h) { float f8[8]; unpack8(__builtin_bit_cast(v4u, qf[h]), f8);
#pragma unroll
            for (int j = 0; j < 8; ++j) qs[j] = __builtin_fmaf(wv[h], f8[j], qs[j]); }
          float hi8[8], lo8[8]; const v4u ph = pack8(qs); unpack8(ph, hi8);
#pragma unroll
          for (int j = 0; j < 8; ++j) lo8[j] = qs[j] - hi8[j];
          qsh = __builtin_bit_cast(bf16x8, ph); qsl = __builtin_bit_cast(bf16x8, pack8(lo8)); } }
        __syncthreads();
#define AT_LOADK(kt_) (*(const bf16x8*)(IKR + (tb + (size_t)(kt_) * 16 + qi) * 32 + 8 * fq))
#define AT_SCORES(kf_, sc_) do { \
        { const f32x4 l0_ = MFMA16(kf_, qsl, ((f32x4){0.f, 0.f, 0.f, 0.f})); const f32x4 l1_ = MFMA16(kf_, qsh, l0_); \
          _Pragma("unroll") for (int r_ = 0; r_ < 4; ++r_) sc_[r_] = l1_[r_]; } \
        _Pragma("unroll") for (int h_ = 0; h_ < 8; ++h_) { const f32x4 d_ = MFMA16(kf_, qf[h_], ((f32x4){0.f, 0.f, 0.f, 0.f})); \
            _Pragma("unroll") for (int r_ = 0; r_ < 4; ++r_) { sc_[r_] = __builtin_fmaf(wv[h_], __builtin_fabsf(d_[r_]), sc_[r_]); asm("" : "+v"(sc_[r_])); } } } while (0)
        const int cnt = (ntiles - wave + 7) >> 3;
#ifndef DBG_RA
#define DBG_RA 1
#endif
#pragma unroll 1
        for (int rA = 0; rA < DBG_RA; ++rA) { if (rA) { for (int i = tid; i < 8192 + 4; i += 512) ((LAS v4u*)HIST)[i] = (v4u){0u, 0u, 0u, 0u}; __syncthreads(); }
#define AT_LOADG(dst_, i0_) do { _Pragma("unroll") for (int j_ = 0; j_ < 8; ++j_) { int kt_ = wave + 8 * ((i0_) + j_); kt_ = kt_ < ntiles ? kt_ : ntiles - 1; dst_[j_] = AT_LOADK(kt_); } } while (0)
#define AT_P1GROUP(buf_, base_) do { _Pragma("unroll") for (int j2 = 0; j2 < 8; ++j2) { const bool valid = ((base_) + j2 < cnt); const int kt = wave + 8 * ((base_) + j2); float sc[4]; AT_SCORES(buf_[j2], sc); \
                if (valid) *(f32x4*)(SC + qi * 4096 + kt * 16 + 4 * fq) = (f32x4){sc[0], sc[1], sc[2], sc[3]}; \
                _Pragma("unroll") for (int r = 0; r < 4; ++r) { const unsigned bin = score_key(sc[r]) >> 20; \
                    __hip_atomic_fetch_add(&HIST[qi * AT_HROW + (bin >> 1)], valid ? (1u << ((bin & 1u) * 16)) : 0u, __ATOMIC_RELAXED, __HIP_MEMORY_SCOPE_WORKGROUP); } } } while (0)
        { AT_LAUNDER(); bf16x8 ka[8], kb[8]; AT_LOADG(ka, 0);
#pragma unroll 1
          for (int i0 = 0; i0 < cnt; i0 += 16) {
            AT_LOADG(kb, i0 + 8);
            AT_P1GROUP(ka, i0);
            AT_LOADG(ka, i0 + 16);
            AT_P1GROUP(kb, i0 + 8); } }
#undef AT_P1GROUP
        __syncthreads();
        }
#ifndef DBG_RB
#define DBG_RB 1
#endif
#pragma unroll 1
        for (int rB = 0; rB < DBG_RB; ++rB) {
#pragma unroll 1
        for (int j = 0; j < 2; ++j) { AT_LAUNDER(); const int q = 2 * wave + j; unsigned tot = 0;
            for (int i = 0; i < 32; ++i) { const unsigned w = HIST[q * AT_HROW + 32 * lane + ((i + lane) & 31)]; tot += (w & 0xffffu) + (w >> 16); }
            const unsigned suf = wave_suffix_sum(tot, lane);
            const unsigned long long mk = __ballot(suf >= 256u); const int L = 63 - __clzll((long long)mk);
            const unsigned above_L = (unsigned)__builtin_amdgcn_readlane((int)(suf - tot), L);
            const unsigned w2 = HIST[q * AT_HROW + 32 * L + (lane >> 1)]; const unsigned cb = (lane & 1) ? (w2 >> 16) : (w2 & 0xffffu);
            const unsigned sfx = wave_suffix_sum(cb, lane);
            const unsigned long long mk2 = __ballot(above_L + sfx >= 256u); const int l2 = 63 - __clzll((long long)mk2);
            if (lane == l2) { SM[q] = 64 * L + l2; SM[16 + q] = (int)(256u - (above_L + sfx - cb)); } }
        __syncthreads();
        }
#ifndef DBG_RC
#define DBG_RC 1
#endif
#pragma unroll 1
        for (int rC = 0; rC < DBG_RC; ++rC) { if (rC) { if (tid < 16) SM[48 + tid] = 0; __syncthreads(); }
        { AT_LAUNDER(); const int Bq = SM[qi]; f32x4 scur[8];
#define AT_LOADS(dst_, i0_) do { _Pragma("unroll") for (int j_ = 0; j_ < 8; ++j_) { int kt_ = wave + 8 * ((i0_) + j_); kt_ = kt_ < ntiles ? kt_ : ntiles - 1; dst_[j_] = *(const f32x4*)(SC + qi * 4096 + kt_ * 16 + 4 * fq); } } while (0)
#define AT_P2GROUP(buf_, base_) do { _Pragma("unroll") for (int j2 = 0; j2 < 8; ++j2) { const bool valid = ((base_) + j2 < cnt); const int kt = wave + 8 * ((base_) + j2); \
                unsigned nib = 0u, cnib = 0u; unsigned uu[4]; \
                _Pragma("unroll") for (int r = 0; r < 4; ++r) { uu[r] = score_key(buf_[j2][r]); const int bin = (int)(uu[r] >> 20); nib |= (bin > Bq) ? (1u << r) : 0u; cnib |= (bin == Bq) ? (1u << r) : 0u; } \
                if (!valid) { nib = 0u; cnib = 0u; } \
                if (cnib) { int p = __hip_atomic_fetch_add(&SM[48 + qi], (int)__popc(cnib), __ATOMIC_RELAXED, __HIP_MEMORY_SCOPE_WORKGROUP); \
                    _Pragma("unroll") for (int r = 0; r < 4; ++r) if ((cnib >> r) & 1u) { if (p < 512) CAND[qi * 1024 + p] = ((unsigned long long)uu[r] << 32) | (unsigned long long)(0xFFFFu - (unsigned)(kt * 16 + 4 * fq + r)); ++p; } } \
                if (nib) __hip_atomic_fetch_or(&MASK[qi * AT_MROW + (kt >> 1)], nib << (16 * (kt & 1) + 4 * fq), __ATOMIC_RELAXED, __HIP_MEMORY_SCOPE_WORKGROUP); } } while (0)
          f32x4 sb2[8];
          AT_LOADS(scur, 0);
#pragma unroll 1
          for (int i0 = 0; i0 < cnt; i0 += 16) {
            AT_LOADS(sb2, i0 + 8);
            AT_P2GROUP(scur, i0);
            AT_LOADS(scur, i0 + 16);
            AT_P2GROUP(sb2, i0 + 8); } }
#undef AT_P2GROUP
#undef AT_LOADS
        __syncthreads();
        }
#ifndef DBG_RD
#define DBG_RD 1
#endif
#pragma unroll 1
        for (int rD = 0; rD < DBG_RD; ++rD) {
#pragma unroll 1
        for (int j = 0; j < 2; ++j) { AT_LAUNDER(); const int q = 2 * wave + j; int m = SM[48 + q]; m = m < 512 ? m : 512; const int nd = SM[16 + q];
            if (m <= 256) at_resolve<4>(CAND + q * 1024, MASK + q * AT_MROW, m, nd, lane); else at_resolve<8>(CAND + q * 1024, MASK + q * AT_MROW, m, nd, lane); }
        __syncthreads();
        }
#undef AT_SCORES
#undef AT_LOADK
#undef AT_LOADG
    } else {
#pragma unroll 1
        for (int i = tid; i < 16 * AT_MROW; i += 512) MASK[i] = ((i % AT_MROW) < (n >> 5)) ? 0xFFFFFFFFu : 0u;
        __syncthreads();
    }
    }
#pragma unroll 1
    for (int rden = 0; rden < DBG_REP_DENSE; ++rden) {
    { const int g = wave >> 2, qh = (wave >> 1) & 1, hp = wave & 1, NS = n >> 6;
      const unsigned ring0 = (unsigned)(size_t)(lds + AT_HIST);
      if (tid < 64) *(LAS float*)(lds + AT_LUT + 4 * tid) = ((tid >> 2) >> (tid & 3)) & 1 ? -cshift : -1.0e30f;
      const bf16* dsrc[4]; unsigned ddst[4];
      { AT_LAUNDER();
#pragma unroll
        for (int i_ = 0; i_ < 4; ++i_) { const int in_ = 4 * wave + i_; const int row_ = 4 * (in_ & 15) + (lane >> 4), pos_ = lane & 15;
            dsrc[i_] = (in_ < 16) ? (KN + (tb + row_) * 128 + ((pos_ ^ (row_ & 15)) << 3)) : (VB + (tb + row_) * 256 + 128 + ((pos_ ^ (2 * (row_ & 7))) << 3));
            ddst[i_] = (unsigned)(in_ * 1024); } }
      const size_t dstep = (wave < 4) ? (size_t)64 * 128 : (size_t)64 * 256;
#define AT_STAGE(s_) do { const unsigned sb_ = ring0 + (unsigned)(((s_) & 3) * 32768); \
        _Pragma("unroll") for (int i_ = 0; i_ < 4; ++i_) { const bf16* src_ = dsrc[i_] + (size_t)(s_) * dstep; \
            const unsigned dst_ = __builtin_amdgcn_readfirstlane(sb_ + ddst[i_]); unsigned keep_; \
            asm volatile("s_mov_b32 %0, m0\n\ts_mov_b32 m0, %2\n\ts_nop 0\n\tglobal_load_lds_dwordx4 %1, off\n\ts_mov_b32 m0, %0" : "=&s"(keep_) : "v"(src_), "s"(dst_) : "memory"); } } while (0)
      bf16x8 qa[2], qb[2]; f32x4 oacc[2][4], lacc[2];
      { AT_LAUNDER();
#pragma unroll
        for (int hi = 0; hi < 2; ++hi) { const bf16* qp = AQN + (tb + q0u + 16 * qh + qi) * 512 + (g * 4 + 2 * hp + hi) * 64 + 8 * fq; qa[hi] = *(const bf16x8*)qp; qb[hi] = *(const bf16x8*)(qp + 32); } }
#pragma unroll
      for (int hi = 0; hi < 2; ++hi) { lacc[hi] = (f32x4){0.f, 0.f, 0.f, 0.f};
#pragma unroll
        for (int dt = 0; dt < 4; ++dt) oacc[hi][dt] = (f32x4){0.f, 0.f, 0.f, 0.f}; }
      const bf16x8 ones = (bf16x8){0x3F80, 0x3F80, 0x3F80, 0x3F80, 0x3F80, 0x3F80, 0x3F80, 0x3F80};
      asm volatile("s_waitcnt vmcnt(0)" ::: "memory");
#pragma unroll 1
      for (int s = 0; s < 3 && s < NS; ++s) AT_STAGE(s);
      typedef short s4_t __attribute__((ext_vector_type(4)));
      AT_LAUNDER();
      const LAS unsigned* mrow = (const LAS unsigned*)(lds + (qh ? AT_SEL2 : AT_SEL)) + qi * AT_MROW;
      const unsigned koff0 = (unsigned)(qi * 256 + (((g * 8 + fq) ^ qi) << 4)), koff1 = (unsigned)(qi * 256 + (((g * 8 + 4 + fq) ^ qi) << 4));
#define AT_LDK(kf_, ci_, slot_, tp_, mw_) do { const LAS unsigned char* kb_ = lds + AT_HIST + (slot_) * 32768 + (tp_) * 8192; \
          _Pragma("unroll") for (int t = 0; t < 2; ++t) { kf_[t][0] = *(const LAS bf16x8*)(kb_ + t * 4096 + koff0); kf_[t][1] = *(const LAS bf16x8*)(kb_ + t * 4096 + koff1); \
              ci_[t] = *(const LAS f32x4*)(lds + AT_LUT + ((((mw_) >> (16 * t + 4 * fq)) & 15u) << 4)); } } while (0)
#define AT_LDV(va_, slot_, vkh_) do { const LAS unsigned char* vb_ = lds + AT_HIST + (slot_) * 32768 + 16384 + (vkh_) * 8192; \
          _Pragma("unroll") for (int dt = 0; dt < 4; ++dt) { const int r1 = 4 * fq + (qi >> 2); const int ch_ = g * 8 + 2 * dt + ((lane & 3) >> 1); \
              const s4_t lo = __builtin_amdgcn_ds_read_tr16_b64_v4i16((LAS s4_t*)(vb_ + r1 * 256 + ((ch_ ^ (2 * (r1 & 7))) << 4) + (lane & 1) * 8)); \
              const s4_t hi4 = __builtin_amdgcn_ds_read_tr16_b64_v4i16((LAS s4_t*)(vb_ + (r1 + 16) * 256 + ((ch_ ^ (2 * (r1 & 7))) << 4) + (lane & 1) * 8)); \
              va_[dt] = (bf16x8){lo[0], lo[1], lo[2], lo[3], hi4[0], hi4[1], hi4[2], hi4[3]}; } } while (0)
#define AT_QKM(dst_, kf_, ci_) do { \
          _Pragma("unroll") for (int t = 0; t < 2; ++t) { \
              _Pragma("unroll") for (int hi = 0; hi < 2; ++hi) { const f32x4 d_ = MFMA16(kf_[t][0], qa[hi], ci_[t]); dst_[hi][t] = MFMA16(kf_[t][1], qb[hi], d_); } } } while (0)
#define AT_EXP(pb_, cur_) do { \
          _Pragma("unroll") for (int hi = 0; hi < 2; ++hi) { float pv[8]; \
              _Pragma("unroll") for (int j = 0; j < 8; ++j) pv[j] = __builtin_amdgcn_exp2f(cur_[hi][j >> 2][j & 3]); \
              v4u pw; pw.x = pk2(pv[0], pv[1]); pw.y = pk2(pv[2], pv[3]); pw.z = pk2(pv[4], pv[5]); pw.w = pk2(pv[6], pv[7]); pb_[hi] = __builtin_bit_cast(bf16x8, pw); } } while (0)
#define AT_PV(pb_, va_) do { \
          _Pragma("unroll") for (int hi = 0; hi < 2; ++hi) lacc[hi] = MFMA16(ones, pb_[hi], lacc[hi]); \
          _Pragma("unroll") for (int dt = 0; dt < 4; ++dt) { \
              _Pragma("unroll") for (int hi = 0; hi < 2; ++hi) oacc[hi][dt] = MFMA16(va_[dt], pb_[hi], oacc[hi][dt]); } } while (0)
      f32x4 st0[2][2], st1[2][2]; bf16x8 kfA[2][2], kfB[2][2]; f32x4 ciA[2], ciB[2]; bf16x8 vaP[4], vaQ[4], pbP[2], pbQ[2];
      if (NS >= 3) asm volatile("s_waitcnt vmcnt(8)" ::: "memory"); else asm volatile("s_waitcnt vmcnt(0)" ::: "memory");
      __builtin_amdgcn_s_barrier(); asm volatile("" ::: "memory");
      unsigned m1A, m1B;
      { const unsigned m0A = mrow[0], m0B = mrow[1]; const int sx = (NS > 1) ? 1 : 0; m1A = mrow[2 * sx]; m1B = mrow[2 * sx + 1];
        AT_LDK(kfB, ciB, 0, 0, m0A); AT_LDK(kfA, ciA, 0, 1, m0B);
        AT_QKM(st0, kfB, ciB);
#pragma unroll
        for (int hi = 0; hi < 2; ++hi) pbP[hi] = (bf16x8){0, 0, 0, 0, 0, 0, 0, 0};
#pragma unroll
        for (int dt = 0; dt < 4; ++dt) vaP[dt] = (bf16x8){0, 0, 0, 0, 0, 0, 0, 0}; }
#pragma unroll 1
      for (int s = 0; s < NS; ++s) {
          if (s + 2 < NS) asm volatile("s_waitcnt vmcnt(4)" ::: "memory"); else asm volatile("s_waitcnt vmcnt(0)" ::: "memory");
          __builtin_amdgcn_s_barrier(); asm volatile("" ::: "memory");
          if (s + 3 < NS) AT_STAGE(s + 3);
          const int s1 = (s + 1 < NS) ? s + 1 : s, s2 = (s + 2 < NS) ? s + 2 : NS - 1;
          const unsigned m2A = mrow[2 * s2], m2B = mrow[2 * s2 + 1];
          AT_LDK(kfB, ciB, (s1 & 3), 0, m1A); AT_LDV(vaQ, (s & 3), 0);
          AT_QKM(st1, kfA, ciA); AT_EXP(pbQ, st0); AT_PV(pbP, vaP);
          __builtin_amdgcn_sched_barrier(0);
          AT_LDK(kfA, ciA, (s1 & 3), 1, m1B); AT_LDV(vaP, (s & 3), 1);
          AT_QKM(st0, kfB, ciB); AT_EXP(pbP, st1); AT_PV(pbQ, vaQ);
          __builtin_amdgcn_sched_barrier(0);
          m1A = m2A; m1B = m2B; }
      AT_PV(pbP, vaP);
#undef AT_LDK
#undef AT_LDV
#undef AT_QKM
#undef AT_EXP
#undef AT_PV
      { AT_LAUNDER();
#pragma unroll
        for (int hi = 0; hi < 2; ++hi) { const float inv = 1.0f / lacc[hi][0];
            bf16* yp = YATT + (tb + q0u + 16 * qh + qi) * 512 + (g * 4 + 2 * hp + hi) * 64 + 4 * fq;
#pragma unroll
            for (int dt = 0; dt < 4; ++dt) { const f32x4 o = oacc[hi][dt];
                v2u w; w.x = pk2(o[0] * inv, o[1] * inv); w.y = pk2(o[2] * inv, o[3] * inv); *(v2u*)(yp + 16 * dt) = w; } } }
#undef AT_STAGE
    }
    __syncthreads();
    }
#undef AT_LAUNDER
    __syncthreads();
}

#ifndef DBG_REP_ML
#define DBG_REP_ML 1
#endif
#ifndef DBG_REP_ATT
#define DBG_REP_ATT 1
#endif
__device__ __forceinline__ void p3_mixer(const Args& a, const Ctx& c, volatile LAS unsigned* MISC, int rep) {
#if !defined(NO_MLSTM)
#pragma unroll 1
    for (int rr = 0; rr < DBG_REP_ML; ++rr)
#pragma unroll 1
        for (int u = blockIdx.x; u < 32; u += c.G) mlstm_unit<0>(a, c, u >> 2, u & 3, 0);
#endif
    unsigned* ctl = (unsigned*)(a.ws + WS_CTL);
    const int x = (int)(__builtin_amdgcn_s_getreg((3 << 11) | 20) & 7u);
    float cshift;
    { float gq = fabsf(a.in[IN_GQ][c.lane]), gk = fabsf(a.in[IN_GK][c.lane]);
#pragma unroll
      for (int o = 1; o < 64; o <<= 1) { gq = fmaxf(gq, __shfl_xor(gq, o)); gk = fmaxf(gk, __shfl_xor(gk, o)); }
      cshift = 8.0f * 1.4426950408889634f * gq * gk; }
#pragma unroll 1
    for (int rot = 0; rot < 8 * DBG_REP_ATT; ++rot) { rep = rot >> 3; const int bq = (x + rot) & 7;
        if (c.tid == 0) MISC[16] = __hip_atomic_fetch_add(ctl + CW_Q + 512 * rep + 64 * bq, 1u, RLX_AGENT);
        __syncthreads();
        int u = (int)MISC[16];
        __syncthreads();
#pragma unroll 1
        while (u < 128) {
            unsigned nxt = 0u;
            if (c.tid == 0) nxt = __hip_atomic_fetch_add(ctl + CW_Q + 512 * rep + 64 * bq, 1u, RLX_AGENT);
#if !defined(NO_ATTN)
            attn_unit(a, c, bq, 127 - u, cshift);
#endif
            if (c.tid == 0) MISC[16] = nxt;
            __syncthreads();
            u = (int)MISC[16];
            __syncthreads();
        } }
}
constexpr int RT_WT = 0;
constexpr int RT_WROW = 1028;
constexpr int RT_LG = 36 * RT_WROW * 4;
constexpr int RT_RSTD = RT_LG + 64 * 36 * 4;
constexpr int RT_LCNT = RT_RSTD + 512;
static_assert(RT_LCNT + 128 <= MISC_OFF, "router LDS map");
__device__ __forceinline__ void p6_router(const Args& a, const Ctx& c) {
    const int tid = c.tid, lane = c.lane, wave = c.wave; LAS unsigned char* lds = c.lds;
    LAS float* WT = (LAS float*)(lds + RT_WT); LAS float* LG = (LAS float*)(lds + RT_LG); LAS float* RSTD = (LAS float*)(lds + RT_RSTD); LAS int* LCNT = (LAS int*)(lds + RT_LCNT);
    { int* RT = (int*)(a.ws + WS_ROWTOK); for (int i = blockIdx.x * 512 + tid; i < NROWS_MAX; i += c.G * 512) RT[i] = 0; }
    { const f32x4* src = (const f32x4*)(a.ws + WS_WTG); LAS f32x4* dst = (LAS f32x4*)WT; for (int i = tid; i < 36 * RT_WROW / 4; i += 512) dst[i] = src[i]; }
    f32x4 gv[4];
#pragma unroll
    for (int j = 0; j < 4; ++j) gv[j] = *(const f32x4*)(a.in[IN_GMOE] + 4 * lane + 256 * j);
    const float* X1 = a.out; bf16* XN = (bf16*)(a.ws + WS_XN);
    int* TOKE = (int*)(a.ws + WS_TOKE); int* TOKR = (int*)(a.ws + WS_TOKR); float* TOKG = (float*)(a.ws + WS_TOKG); int* CNT = (int*)(a.ws + WS_CNT);
    __syncthreads();
    for (int blk = blockIdx.x; blk < 256; blk += c.G) {
        if (tid < 32) LCNT[tid] = 0;
#pragma unroll 1
        for (int ri = 0; ri < 16; ri += 2) { const int tA = blk * 128 + wave * 16 + ri, tB = tA + 1;
            const f32x4* xa = (const f32x4*)(X1 + (size_t)tA * D) + lane; const f32x4* xb = (const f32x4*)(X1 + (size_t)tB * D) + lane;
            f32x4 va[4], vb[4]; float sa = 0.f, sb = 0.f;
#pragma unroll
            for (int j = 0; j < 4; ++j) { va[j] = xa[64 * j]; vb[j] = xb[64 * j]; }
#pragma unroll
            for (int j = 0; j < 4; ++j) { sa += (va[j].x * va[j].x + va[j].y * va[j].y) + (va[j].z * va[j].z + va[j].w * va[j].w); sb += (vb[j].x * vb[j].x + vb[j].y * vb[j].y) + (vb[j].z * vb[j].z + vb[j].w * vb[j].w); }
            const float ra = rsqrtf(wave_sum(sa) * (1.f / D) + EPS), rb = rsqrtf(wave_sum(sb) * (1.f / D) + EPS);
            if (lane == 0) { RSTD[wave * 16 + ri] = ra; RSTD[wave * 16 + ri + 1] = rb; }
            v2u* oa = (v2u*)(XN + (size_t)tA * D) + lane; v2u* ob = (v2u*)(XN + (size_t)tB * D) + lane;
#pragma unroll
            for (int j = 0; j < 4; ++j) { v2u w; w.x = pk2(va[j].x * ra * gv[j].x, va[j].y * ra * gv[j].y); w.y = pk2(va[j].z * ra * gv[j].z, va[j].w * ra * gv[j].w); oa[64 * j] = w;
                v2u u; u.x = pk2(vb[j].x * rb * gv[j].x, vb[j].y * rb * gv[j].y); u.y = pk2(vb[j].z * rb * gv[j].z, vb[j].w * rb * gv[j].w); ob[64 * j] = u; } }
        f32x4 acc[3];
#pragma unroll
        for (int ct = 0; ct < 3; ++ct) acc[ct] = (f32x4){0.f, 0.f, 0.f, 0.f};
        { const int row = lane & 15, kq = lane >> 4;
          const f32x4* ap = (const f32x4*)(X1 + (size_t)(blk * 128 + wave * 16 + row) * D + 4 * kq);
          int cj[3]; cj[0] = row; cj[1] = 16 + row; cj[2] = (32 + row) < 36 ? (32 + row) : 35;
          const LAS f32x4* bp0 = (const LAS f32x4*)(WT + cj[0] * RT_WROW + 4 * kq); const LAS f32x4* bp1 = (const LAS f32x4*)(WT + cj[1] * RT_WROW + 4 * kq); const LAS f32x4* bp2 = (const LAS f32x4*)(WT + cj[2] * RT_WROW + 4 * kq);
#define RT_LOADA(dst_, b_) do { _Pragma("unroll") for (int i_ = 0; i_ < 8; ++i_) dst_[i_] = ap[4 * (8 * ((b_) < 8 ? (b_) : 7) + i_)]; } while (0)
#define RT_MMA(src_, b_) do { _Pragma("unroll") for (int i_ = 0; i_ < 8; ++i_) { const int ks_ = 8 * (b_) + i_; const f32x4 b0 = bp0[4 * ks_], b1 = bp1[4 * ks_], b2 = bp2[4 * ks_]; \
              _Pragma("unroll") for (int j = 0; j < 4; ++j) { acc[0] = __builtin_amdgcn_mfma_f32_16x16x4f32(src_[i_][j], b0[j], acc[0], 0, 0, 0); acc[1] = __builtin_amdgcn_mfma_f32_16x16x4f32(src_[i_][j], b1[j], acc[1], 0, 0, 0); \
                  acc[2] = __builtin_amdgcn_mfma_f32_16x16x4f32(src_[i_][j], b2[j], acc[2], 0, 0, 0); } } } while (0)
          f32x4 aA[8], aB[8]; RT_LOADA(aA, 0);
#pragma unroll 1
          for (int bb = 0; bb < 8; bb += 2) { RT_LOADA(aB, bb + 1); RT_MMA(aA, bb); RT_LOADA(aA, bb + 2); RT_MMA(aB, bb + 1); }
#undef RT_LOADA
#undef RT_MMA
        }
#pragma unroll 1
        for (int half = 0; half < 2; ++half) {
            __syncthreads();
            if ((wave >> 2) == half) { const int col = lane & 15, kq = lane >> 4;
#pragma unroll
                for (int ct = 0; ct < 3; ++ct) if (16 * ct + col < 36) {
#pragma unroll
                    for (int r = 0; r < 4; ++r) LG[((wave & 3) * 16 + 4 * kq + r) * 36 + 16 * ct + col] = acc[ct][r]; } }
            __syncthreads();
            if (tid < 64) { const int row = half * 64 + tid, t = blk * 128 + row; const float rs = RSTD[row]; const LAS float* lg = LG + tid * 36;
                float gl[4];
#pragma unroll
                for (int i = 0; i < 4; ++i) gl[i] = rs * lg[32 + i] + a.in[IN_BRG][i];
                int gs = 0; float gmax = gl[0];
#pragma unroll
                for (int i = 1; i < 4; ++i) if (gl[i] > gmax) { gmax = gl[i]; gs = i; }
                float gsum = 0.f;
#pragma unroll
                for (int i = 0; i < 4; ++i) gsum += expf(gl[i] - gmax);
                const float gtop = 1.0f / gsum;
                float ev[8];
#pragma unroll
                for (int i = 0; i < 8; ++i) ev[i] = rs * lg[gs * 8 + i] + a.in[IN_BRE][gs * 8 + i];
                int l0 = 0; float v0 = ev[0];
#pragma unroll
                for (int i = 1; i < 8; ++i) if (ev[i] > v0) { v0 = ev[i]; l0 = i; }
                int l1 = -1; float v1 = -3.0e38f;
#pragma unroll
                for (int i = 0; i < 8; ++i) if (i != l0 && ev[i] > v1) { v1 = ev[i]; l1 = i; }
                const float e1 = expf(v1 - v0), s0 = 1.0f / (1.0f + e1), s1 = e1 * s0;
                const int ex0 = gs * 8 + l0, ex1 = gs * 8 + l1;
                const int rk0 = __hip_atomic_fetch_add(&LCNT[ex0], 1, __ATOMIC_RELAXED, __HIP_MEMORY_SCOPE_WORKGROUP);
                const int rk1 = __hip_atomic_fetch_add(&LCNT[ex1], 1, __ATOMIC_RELAXED, __HIP_MEMORY_SCOPE_WORKGROUP);
                TOKE[2 * t] = ex0; TOKE[2 * t + 1] = ex1; TOKR[2 * t] = rk0; TOKR[2 * t + 1] = rk1; TOKG[2 * t] = s0 * gtop; TOKG[2 * t + 1] = s1 * gtop; }
        }
        __syncthreads();
        if (tid < 32) CNT[blk * 32 + tid] = LCNT[tid];
        __syncthreads();
    }
}
__device__ __forceinline__ void p7_gather(const Args& a, const Ctx& c) {
    const int tid = c.tid, lane = c.lane, wave = c.wave;
    LAS int* PART = (LAS int*)c.lds; LAS int* PPRE = PART + 512; LAS int* TOT = PPRE + 512; LAS int* TS = TOT + 32; LAS int* BASE = TS + 64;
    const int* CNT = (const int*)(a.ws + WS_CNT); const int* TOKE = (const int*)(a.ws + WS_TOKE); const int* TOKR = (const int*)(a.ws + WS_TOKR); int* TOKP = (int*)(a.ws + WS_TOKP);
    int* RT = (int*)(a.ws + WS_ROWTOK);
    { const int e = tid & 31, p = tid >> 5; int s = 0; for (int k = 0; k < 16; ++k) s += CNT[(16 * p + k) * 32 + e]; PART[p * 32 + e] = s; }
    __syncthreads();
    if (tid < 32) { int run = 0; for (int p = 0; p < 16; ++p) { PPRE[p * 32 + tid] = run; run += PART[p * 32 + tid]; } TOT[tid] = run; }
    __syncthreads();
    if (tid == 0) { int ts = 0; for (int e = 0; e < 32; ++e) { TS[e] = ts; ts += (TOT[e] + 255) >> 8; } TS[32] = ts; }
    __syncthreads();
    if (blockIdx.x == 0 && tid < 33) ((int*)(a.ws + WS_SMALL))[tid] = TS[tid];
    for (int blk = blockIdx.x; blk < 256; blk += c.G) {
        if (tid < 32) { int s = TS[tid] * 256 + PPRE[(blk >> 4) * 32 + tid]; for (int b2 = (blk & ~15); b2 < blk; ++b2) s += CNT[b2 * 32 + tid]; BASE[tid] = s; }
        __syncthreads();
        { const int t = blk * 128 + (tid >> 2), jj = tid & 3;
          if (jj < 2) { const int pos = BASE[TOKE[2 * t + jj]] + TOKR[2 * t + jj]; TOKP[2 * t + jj] = pos; RT[pos] = t; } }
        __syncthreads();
    }
}
__device__ __forceinline__ void p10_combine(const Args& a, const Ctx& c) {
    const int lane = c.lane, gw = c.vcu * NWAVES + c.wave, NGW = c.G * NWAVES;
    const int* TOKP = (const int*)(a.ws + WS_TOKP); const float* TOKG = (const float*)(a.ws + WS_TOKG); const bf16* Y = (const bf16*)(a.ws + WS_Y);
    for (int t0 = gw; t0 < T; t0 += 2 * NGW) {
        const int tA = t0, tB = (t0 + NGW < T) ? t0 + NGW : t0; const bool hasB = (t0 + NGW < T);
        const int pA0 = TOKP[2 * tA], pA1 = TOKP[2 * tA + 1], pB0 = TOKP[2 * tB], pB1 = TOKP[2 * tB + 1];
        const float gA0 = TOKG[2 * tA], gA1 = TOKG[2 * tA + 1], gB0 = TOKG[2 * tB], gB1 = TOKG[2 * tB + 1];
        f32x4 xa[4], xb[4]; v2u ya0[4], ya1[4], yb0[4], yb1[4];
#pragma unroll
        for (int j = 0; j < 4; ++j) { const int cc = 4 * lane + 256 * j;
            xa[j] = *(const f32x4*)(a.out + (size_t)tA * D + cc); xb[j] = *(const f32x4*)(a.out + (size_t)tB * D + cc);
            ya0[j] = *(const v2u*)(Y + (size_t)pA0 * D + cc); ya1[j] = *(const v2u*)(Y + (size_t)pA1 * D + cc);
            yb0[j] = *(const v2u*)(Y + (size_t)pB0 * D + cc); yb1[j] = *(const v2u*)(Y + (size_t)pB1 * D + cc); }
#pragma unroll
        for (int j = 0; j < 4; ++j) { const int cc = 4 * lane + 256 * j; f32x4 x = xa[j];
            x[0] += gA0 * bf2f(ya0[j].x & 0xffffu) + gA1 * bf2f(ya1[j].x & 0xffffu); x[1] += gA0 * bf2f(ya0[j].x >> 16) + gA1 * bf2f(ya1[j].x >> 16);
            x[2] += gA0 * bf2f(ya0[j].y & 0xffffu) + gA1 * bf2f(ya1[j].y & 0xffffu); x[3] += gA0 * bf2f(ya0[j].y >> 16) + gA1 * bf2f(ya1[j].y >> 16);
            *(f32x4*)(a.out + (size_t)tA * D + cc) = x; }
        if (hasB) {
#pragma unroll
        for (int j = 0; j < 4; ++j) { const int cc = 4 * lane + 256 * j; f32x4 x = xb[j];
            x[0] += gB0 * bf2f(yb0[j].x & 0xffffu) + gB1 * bf2f(yb1[j].x & 0xffffu); x[1] += gB0 * bf2f(yb0[j].x >> 16) + gB1 * bf2f(yb1[j].x >> 16);
            x[2] += gB0 * bf2f(yb0[j].y & 0xffffu) + gB1 * bf2f(yb1[j].y & 0xffffu); x[3] += gB0 * bf2f(yb0[j].y >> 16) + gB1 * bf2f(yb1[j].y >> 16);
            *(f32x4*)(a.out + (size_t)tB * D + cc) = x; } }
    }
}
__global__ void __launch_bounds__(NWAVES * 64, 2) hybrid_fwd(Args args) {
    extern __shared__ __attribute__((aligned(16))) unsigned char lds_raw[];
    Ctx c; c.lds = (LAS unsigned char*)lds_raw;
    volatile LAS unsigned* MISC = (volatile LAS unsigned*)(c.lds + MISC_OFF);
    c.tid = threadIdx.x; c.lane = c.tid & 63; c.wave = __builtin_amdgcn_readfirstlane(c.tid >> 6);
    c.G = gridDim.x; { const int bx = blockIdx.x; c.vcu = (c.G % 8 == 0) ? (bx % 8) * (c.G / 8) + bx / 8 : bx; }
    unsigned* ctl = (unsigned*)(args.ws + WS_CTL);
    if (c.tid < 128) MISC[c.tid] = 0u;
    __syncthreads();
    XcdBarrier bar; bar.bar = ctl + CW_BAR; bar.x = 0; bar.st = nullptr;
    if (N_LAUNCHES == 1) bar = xcd_barrier_post(ctl + CW_BAR, MISC + 8);
#define GRID_BAR() do { if (N_LAUNCHES == 1) xcd_barrier(bar); } while (0)
    const int lo = args.ph_lo, hi = args.ph_hi;
#ifndef PH_MASK
#define PH_MASK 0xfff
#endif
#define IN(k) (((PH_MASK >> (k)) & 1) && lo <= (k) && (k) < hi)
#define BOTH(k) (IN(k) && IN((k) + 1))
    unsigned char* ws = args.ws; unsigned char* dout = (unsigned char*)args.out;
#ifndef DBG_REPEAT
#define DBG_REPEAT -1
#endif
#define REPS(k) (((k) == DBG_REPEAT) ? 2 : 1)
    if (IN(0)) { _Pragma("unroll") for (int rep = 0; rep < REPS(0); ++rep) { if (rep) GRID_BAR(); p0_prologue<0>(args, c, c.vcu * NWAVES + c.wave, c.G * NWAVES); } if (BOTH(0)) GRID_BAR(); }
    if (IN(1)) { _Pragma("unroll") for (int rep = 0; rep < REPS(1); ++rep) { if (rep) GRID_BAR();
        pg8::Gemm g{(const pg8::bf16_t*)(dout + DO_H), (const pg8::bf16_t*)(ws + WS_WIN), T, NPROJ, D}; pg8::StaticOrder S; S.init(T, NPROJ, c.G, (int)blockIdx.x);
        pg8::EpiBf16<0> E{(pg8::bf16_t*)(ws + WS_PROJ), 256, nullptr, 256, (size_t)T * 256, 1.f};
        pg8::gemm_phase<pg8::EpiBf16<0>, pg8::StaticOrder, true, true>(c.lds, g, S, E); }
        if (BOTH(1)) GRID_BAR();
    }
#ifndef DBG_R2
#define DBG_R2 1
#endif
#ifndef DBG_R4A
#define DBG_R4A 1
#endif
#ifndef DBG_R4B
#define DBG_R4B 1
#endif
#ifndef DBG_R7
#define DBG_R7 1
#endif
    if (IN(2)) { _Pragma("unroll 1") for (int rep = 0; rep < DBG_R2; ++rep) { if (rep) GRID_BAR(); p2_prep(args, c); } if (BOTH(2)) GRID_BAR(); }
    if (IN(3)) { _Pragma("unroll") for (int rep = 0; rep < REPS(3); ++rep) { if (rep) GRID_BAR(); p3_mixer(args, c, MISC, rep); } if (BOTH(3)) GRID_BAR(); }
    if (IN(4)) {
#pragma unroll 1
        for (int rep = 0; rep < DBG_R4A; ++rep) { p0_prologue<1>(args, c, c.vcu * NWAVES + c.wave, c.G * NWAVES); __syncthreads(); }
#pragma unroll 1
        for (int rep = 0; rep < DBG_R4B; ++rep)
#pragma unroll 1
        for (int u = blockIdx.x; u < 256; u += c.G) mlstm_unit<1>(args, c, u >> 5, (u >> 3) & 3, u & 7);
        if (BOTH(4)) GRID_BAR();
    }
    if (IN(5)) {
        { pg8::Gemm g{(const pg8::bf16_t*)(dout + DO_YATT), (const pg8::bf16_t*)(ws + WS_WPA), T, D, 512}; pg8::StaticOrder S; S.init(T, D, c.G, (int)blockIdx.x);
          pg8::EpiGate<false> E{(pg8::bf16_t*)(ws + WS_MERGED), D, (const pg8::bf16_t*)(ws + WS_PROJ + (size_t)TL_GA * PROJ_TILE), (size_t)T * 256};
          pg8::gemm_phase<pg8::EpiGate<false>, pg8::StaticOrder, true, true>(c.lds, g, S, E); }
        __syncthreads();
        { pg8::Gemm g{(const pg8::bf16_t*)(dout + DO_YML), (const pg8::bf16_t*)(ws + WS_WPM), T, D, 512}; pg8::StaticOrder S; S.init(T, D, c.G, (int)blockIdx.x);
          pg8::EpiGate<true> E{(pg8::bf16_t*)(ws + WS_MERGED), D, (const pg8::bf16_t*)(ws + WS_PROJ + (size_t)TL_GM * PROJ_TILE), (size_t)T * 256};
          pg8::gemm_phase<pg8::EpiGate<true>, pg8::StaticOrder, true, true>(c.lds, g, S, E); }
        if (BOTH(5)) GRID_BAR();
    }
    if (IN(6)) {
        pg8::Gemm g{(const pg8::bf16_t*)(ws + WS_MERGED), (const pg8::bf16_t*)(ws + WS_WOUT), T, D, D}; pg8::StaticOrder S; S.init(T, D, c.G, (int)blockIdx.x);
        pg8::EpiRes E{args.out, args.in[IN_X], D};
        pg8::gemm_phase<pg8::EpiRes, pg8::StaticOrder, true, true>(c.lds, g, S, E);
        if (BOTH(6)) GRID_BAR();
    }
    if (IN(7)) { _Pragma("unroll 1") for (int rep = 0; rep < DBG_R7; ++rep) { if (rep) { GRID_BAR(); } p6_router(args, c); } if (BOTH(7)) GRID_BAR(); }
    if (IN(8)) { _Pragma("unroll") for (int rep = 0; rep < REPS(8); ++rep) { if (rep) GRID_BAR(); p7_gather(args, c); } if (BOTH(8)) GRID_BAR(); }
    if (IN(9) || IN(10)) {
        LAS int* TSL = (LAS int*)(c.lds + MISC_OFF + 256);
        if (c.tid < 33) TSL[c.tid] = (int)__hip_atomic_load((unsigned*)(ws + WS_SMALL) + c.tid, RLX_AGENT);
        __syncthreads();
        if (IN(9)) {
            pg8::MoeOrder<true> S{TSL, c.G, (int)blockIdx.x, (const int*)(ws + WS_ROWTOK)};
            pg8::Gemm g{(const pg8::bf16_t*)(ws + WS_XN), (const pg8::bf16_t*)(ws + WS_GU), 0, 0, D};
            pg8::EpiSwiGLU E{(pg8::bf16_t*)(ws + WS_HID)};
            pg8::gemm_phase<pg8::EpiSwiGLU, pg8::MoeOrder<true>, true, true>(c.lds, g, S, E);
            if (BOTH(9)) GRID_BAR();
        }
        if (IN(10)) {
            pg8::MoeOrder<false> S{TSL, c.G, (int)blockIdx.x, nullptr};
            pg8::Gemm g{(const pg8::bf16_t*)(ws + WS_HID), (const pg8::bf16_t*)(ws + WS_DN), 0, 0, 512};
            pg8::EpiDown E{(pg8::bf16_t*)(ws + WS_Y)};
            pg8::gemm_phase<pg8::EpiDown, pg8::MoeOrder<false>, true, true>(c.lds, g, S, E);
            if (BOTH(10)) GRID_BAR();
        }
    }
    if (IN(11)) p10_combine(args, c);
#undef IN
#undef BOTH
#undef GRID_BAR
}

extern "C" void kernel_launch(void* const* d_in, const int* in_sizes, int n_in, void* d_out, int out_size, void* d_ws, size_t ws_size, hipStream_t stream) {
    static int grid = 0;
    if (grid == 0) {
        if (n_in != 22 || in_sizes[0] != T * D || out_size != T * D || ws_size < WS_END) { fprintf(stderr, "kernel_launch: unexpected shapes (n_in %d, in0 %d, out %d, ws %zu); nothing launched\n", n_in, n_in > 0 ? in_sizes[0] : -1, out_size, ws_size); grid = -1; return; }
        int dev = 0, cus = 0, per_cu = 0;
        if (hipGetDevice(&dev) != hipSuccess || hipDeviceGetAttribute(&cus, hipDeviceAttributeMultiprocessorCount, dev) != hipSuccess) { grid = -1; return; }
        if (hipFuncSetAttribute((const void*)hybrid_fwd, hipFuncAttributeMaxDynamicSharedMemorySize, LDS_BYTES) != hipSuccess) { fprintf(stderr, "kernel_launch: hipFuncSetAttribute failed\n"); grid = -1; return; }
        if (hipOccupancyMaxActiveBlocksPerMultiprocessor(&per_cu, (const void*)hybrid_fwd, NWAVES * 64, LDS_BYTES) != hipSuccess || per_cu < 1)
            fprintf(stderr, "kernel_launch: note: occupancy query reports %d workgroups per CU\n", per_cu);
        (void)hipGetLastError();
        grid = cus;
    }
    if (grid < 0) return;
    if (hipMemsetAsync((char*)d_ws + WS_CTL, 0, CTL_ZERO_BYTES, stream) != hipSuccess) return;
    Args a{};
    for (int i = 0; i < 22; ++i) a.in[i] = (const float*)d_in[i];
    a.out = (float*)d_out; a.ws = (unsigned char*)d_ws;
    for (int li = 0; li < N_LAUNCHES; ++li) {
        a.ph_lo = (N_LAUNCHES == 1) ? 0 : li; a.ph_hi = (N_LAUNCHES == 1) ? NPH : li + 1; a.li = li;
        hipLaunchKernelGGL(hybrid_fwd, dim3(grid), dim3(NWAVES * 64), LDS_BYTES, stream, a);
        if (hipPeekAtLastError() != hipSuccess) { fprintf(stderr, "kernel_launch: launch %d failed\n", li); break; }
    }
}
```

```cpp
#include <hip/hip_runtime.h>
#include <cstdio>
#include <cstdint>
namespace pg8 {
#define PG8_LAS __attribute__((address_space(3)))
typedef unsigned short bf16_t;
typedef short bf16x8 __attribute__((ext_vector_type(8)));
typedef float f32x4 __attribute__((ext_vector_type(4)));
typedef unsigned u32x4 __attribute__((ext_vector_type(4)));
constexpr int BM = 256, BK = 64, HALF = 128, HTB = HALF * BK * 2  , STAGE_BYTES = 8 * HTB, NXCD = 8, WGM = 8;

__host__ __device__ __forceinline__ int lds_byte(int r, int c) { const int st = (r >> 4) * 2 + (c >> 5), rr = r & 15, cc = c & 31, ob = rr * 64 + cc * 2; return st * 1024 + (ob ^ (((ob >> 9) & 1) << 5)); }
__host__ __device__ __forceinline__ void stage_rc(int b, int& R, int& C) { const int st = b / 1024, sb = b % 1024, swz = sb ^ (((sb >> 9) & 1) << 5); R = (st >> 1) * 16 + swz / 64; C = (st & 1) * 32 + (swz % 64) / 2; }
__host__ __device__ __forceinline__ int perm32(int rho) { const int n = rho >> 4, i = rho & 15; return 8 * (i >> 2) + 4 * n + (i & 3); }

struct Unit { int pm, pn; };
struct Gemm { const bf16_t* A; const bf16_t* Bt; int M, N, K; };

struct StaticOrder {
    static constexpr bool GATHER = false;
    int nM, nN, nwg, G, c;
    __host__ __device__ void init(int M, int N, int G_, int c_) { nM = M / BM; nN = N / BM; nwg = nM * nN; G = G_; c = c_; }
    __host__ __device__ bool next(int i, Unit& u) const {
        const long L = (long)i * G + c; if (L >= nwg) return false;
        int wgid = (int)L; { const int q = nwg / NXCD, r = nwg % NXCD, xcd = wgid % NXCD, off = wgid / NXCD; wgid = (xcd < r ? xcd * (q + 1) : r * (q + 1) + (xcd - r) * q) + off; }
        const int nig = WGM * nN, gid = wgid / nig, fm = gid * WGM, gsz = (nM - fm) < WGM ? (nM - fm) : WGM;
        u.pm = fm + ((wgid % nig) % gsz); u.pn = (wgid % nig) / gsz; return true;
    }
    __device__ __forceinline__ void a_ready(const Unit&) const {}
    __device__ __forceinline__ void done(const Unit&) const {}
};

typedef __bf16 bf2_t __attribute__((ext_vector_type(2)));
__device__ __forceinline__ unsigned cvt_pk_bf16(float lo, float hi) { bf2_t v; v[0] = (__bf16)lo; v[1] = (__bf16)hi; return __builtin_bit_cast(unsigned, v); }
typedef float f32x2 __attribute__((ext_vector_type(2)));
template <int ACT  > struct EpiBf16 {
    static constexpr bool PERM = true, AFTER_DRAIN = false; static_assert(ACT == 0, "EpiBf16: no activation here");
    bf16_t* O; int ldc; const float* bias; int split_cols; size_t split_stride; float scale0;
    __device__ __forceinline__ void operator()(const f32x4 (&acc)[2][2][4][2], const Unit& u, int wr, int wc, int fr, int fq) const {
        const int row0 = u.pm * BM + wr * 64 + fr; int colt = u.pn * BM; bf16_t* base = O;
        float sc = 1.f; if (split_cols) { const int t = colt / split_cols; base += (size_t)t * split_stride; colt -= t * split_cols; if (t == 0) sc = scale0; }
        const int col0 = colt + wc * 32 + 8 * fq, bcol0 = u.pn * BM + wc * 32 + 8 * fq;
        f32x4 bv[2][2];
#pragma unroll
        for (int bj = 0; bj < 2; ++bj)
#pragma unroll
            for (int n = 0; n < 2; ++n) bv[bj][n] = bias ? *(const f32x4*)(bias + bcol0 + bj * HALF + 4 * n) : (f32x4){0.f, 0.f, 0.f, 0.f};
#pragma unroll
        for (int ai = 0; ai < 2; ++ai)
#pragma unroll
            for (int m = 0; m < 4; ++m) { bf16_t* rowp = base + (size_t)(row0 + ai * HALF + m * 16) * ldc + col0;
#pragma unroll
                for (int bj = 0; bj < 2; ++bj) { f32x4 v0 = acc[ai][bj][m][0] + bv[bj][0], v1 = acc[ai][bj][m][1] + bv[bj][1];
                    v0 = v0 * sc; v1 = v1 * sc; u32x4 w; w.x = cvt_pk_bf16(v0[0], v0[1]); w.y = cvt_pk_bf16(v0[2], v0[3]); w.z = cvt_pk_bf16(v1[0], v1[1]); w.w = cvt_pk_bf16(v1[2], v1[3]);
                    *(u32x4*)(rowp + bj * HALF) = w; } }
    }
};
__device__ __forceinline__ float bf2f_(unsigned b16) { return __uint_as_float(b16 << 16); }
__device__ __forceinline__ float sigm_(float x) { return 1.0f / (1.0f + __expf(-x)); }
template <bool ADD> struct EpiGate {
    static constexpr bool PERM = true, AFTER_DRAIN = false;
    bf16_t* O; int ldc; const bf16_t* gate; size_t gstride;
    __device__ __forceinline__ void operator()(const f32x4 (&acc)[2][2][4][2], const Unit& u, int wr, int wc, int fr, int fq) const {
        const int row0 = u.pm * BM + wr * 64 + fr, colt = wc * 32 + 8 * fq;
        const bf16_t* gt = gate + (size_t)u.pn * gstride;
#pragma unroll
        for (int ai = 0; ai < 2; ++ai)
#pragma unroll
            for (int m = 0; m < 4; ++m) { const size_t row = (size_t)(row0 + ai * HALF + m * 16);
#pragma unroll
                for (int bj = 0; bj < 2; ++bj) { const int c = colt + bj * HALF;
                    const u32x4 gv = *(const u32x4*)(gt + row * 256 + c);
                    bf16_t* op = O + row * ldc + u.pn * BM + c;
                    float pv[8] = {0.f, 0.f, 0.f, 0.f, 0.f, 0.f, 0.f, 0.f};
                    if (ADD) { const u32x4 p = *(const u32x4*)op; pv[0] = bf2f_(p.x & 0xffffu); pv[1] = bf2f_(p.x >> 16); pv[2] = bf2f_(p.y & 0xffffu); pv[3] = bf2f_(p.y >> 16);
                        pv[4] = bf2f_(p.z & 0xffffu); pv[5] = bf2f_(p.z >> 16); pv[6] = bf2f_(p.w & 0xffffu); pv[7] = bf2f_(p.w >> 16); }
                    const f32x4 v0 = acc[ai][bj][m][0], v1 = acc[ai][bj][m][1];
                    float o[8];
                    o[0] = pv[0] + sigm_(bf2f_(gv.x & 0xffffu)) * v0[0]; o[1] = pv[1] + sigm_(bf2f_(gv.x >> 16)) * v0[1];
                    o[2] = pv[2] + sigm_(bf2f_(gv.y & 0xffffu)) * v0[2]; o[3] = pv[3] + sigm_(bf2f_(gv.y >> 16)) * v0[3];
                    o[4] = pv[4] + sigm_(bf2f_(gv.z & 0xffffu)) * v1[0]; o[5] = pv[5] + sigm_(bf2f_(gv.z >> 16)) * v1[1];
                    o[6] = pv[6] + sigm_(bf2f_(gv.w & 0xffffu)) * v1[2]; o[7] = pv[7] + sigm_(bf2f_(gv.w >> 16)) * v1[3];
                    u32x4 w; w.x = cvt_pk_bf16(o[0], o[1]); w.y = cvt_pk_bf16(o[2], o[3]); w.z = cvt_pk_bf16(o[4], o[5]); w.w = cvt_pk_bf16(o[6], o[7]);
                    *(u32x4*)op = w; } }
    }
};
struct EpiRes {
    static constexpr bool PERM = false, AFTER_DRAIN = false;
    float* C; const float* R; int ldc;
    __device__ __forceinline__ void operator()(const f32x4 (&acc)[2][2][4][2], const Unit& u, int wr, int wc, int fr, int fq) const {
        const int row0 = u.pm * BM + wr * 64 + fr, col0 = u.pn * BM + wc * 32 + 4 * fq;
#pragma unroll
        for (int ai = 0; ai < 2; ++ai)
#pragma unroll
            for (int m = 0; m < 4; ++m) { const size_t ro = (size_t)(row0 + ai * HALF + m * 16) * ldc + col0;
#pragma unroll
                for (int bj = 0; bj < 2; ++bj)
#pragma unroll
                    for (int n = 0; n < 2; ++n) { const size_t off = ro + bj * HALF + n * 16; *(f32x4*)(C + off) = *(const f32x4*)(R + off) + acc[ai][bj][m][n]; } }
    }
};
struct EpiSwiGLU {
    static constexpr bool PERM = true, AFTER_DRAIN = false;
    bf16_t* H;
    __device__ __forceinline__ void operator()(const f32x4 (&acc)[2][2][4][2], const Unit& u, int wr, int wc, int fr, int fq) const {
        const int row0 = u.pm * BM + wr * 64 + fr, hc = (u.pn & 3) * 128 + wc * 32 + 8 * fq;
#pragma unroll
        for (int ai = 0; ai < 2; ++ai)
#pragma unroll
            for (int m = 0; m < 4; ++m) { const size_t row = (size_t)(row0 + ai * HALF + m * 16);
                float o[8];
#pragma unroll
                for (int n = 0; n < 2; ++n)
#pragma unroll
                    for (int i = 0; i < 4; ++i) { const float g = acc[ai][0][m][n][i], up = acc[ai][1][m][n][i]; o[n * 4 + i] = g * sigm_(g) * up; }
                u32x4 w; w.x = cvt_pk_bf16(o[0], o[1]); w.y = cvt_pk_bf16(o[2], o[3]); w.z = cvt_pk_bf16(o[4], o[5]); w.w = cvt_pk_bf16(o[6], o[7]);
                *(u32x4*)(H + row * 512 + hc) = w; }
    }
};
struct EpiDown {
    static constexpr bool PERM = true, AFTER_DRAIN = false;
    bf16_t* Y;
    __device__ __forceinline__ void operator()(const f32x4 (&acc)[2][2][4][2], const Unit& u, int wr, int wc, int fr, int fq) const {
        const int row0 = u.pm * BM + wr * 64 + fr, c0 = (u.pn & 3) * 256 + wc * 32 + 8 * fq;
#pragma unroll
        for (int ai = 0; ai < 2; ++ai)
#pragma unroll
            for (int m = 0; m < 4; ++m) { const size_t row = (size_t)(row0 + ai * HALF + m * 16);
#pragma unroll
                for (int bj = 0; bj < 2; ++bj) { const f32x4 v0 = acc[ai][bj][m][0], v1 = acc[ai][bj][m][1];
                    u32x4 w; w.x = cvt_pk_bf16(v0[0], v0[1]); w.y = cvt_pk_bf16(v0[2], v0[3]); w.z = cvt_pk_bf16(v1[0], v1[1]); w.w = cvt_pk_bf16(v1[2], v1[3]);
                    *(u32x4*)(Y + row * 1024 + c0 + bj * HALF) = w; } }
    }
};
template <bool GA_> struct MoeOrder {
    static constexpr bool GATHER = GA_;
    const PG8_LAS int* ts; int G, c; const int* rowtok;
    __device__ __forceinline__ bool next(int i, Unit& u) const {
        const int nt = ts[32]; const long L = (long)i * G + c; if (L >= 4L * nt) return false;
        const int pm = (int)(L >> 2), j = (int)(L & 3); int e = 0;
#pragma unroll
        for (int k = 1; k < 32; ++k) e += (ts[k] <= pm) ? 1 : 0;
        u.pm = pm; u.pn = e * 4 + j; return true;
    }
    __device__ __forceinline__ void a_ready(const Unit&) const {}
    __device__ __forceinline__ void done(const Unit&) const {}
};
template <class E_> struct is_epibf16 { static constexpr bool value = false; }; template <int A_> struct is_epibf16<EpiBf16<A_>> { static constexpr bool value = true; };
template <class Epi, class Sched, bool ALIGN_EPI = false, bool SP2 = false>
__device__ __forceinline__ void gemm_phase(PG8_LAS unsigned char* lds, const Gemm g, const Sched& S, const Epi& E) {
    const int tid = threadIdx.x, wid = __builtin_amdgcn_readfirstlane(tid >> 6), lane = tid & 63, wr = wid >> 2, wc = wid & 3, fr = lane & 15, fq = lane >> 4;
    const int K = g.K, nt = K / BK;
    unsigned voffA[2], voffB[2];
#pragma unroll
    for (int i = 0; i < 2; ++i) { int R, C; stage_rc(tid * 16 + i * 8192, R, C); const int Rb = Epi::PERM ? ((R & ~31) + perm32(R & 31)) : R;
        voffA[i] = (unsigned)(R * K + C) * 2u; voffB[i] = (unsigned)(Rb * K + C) * 2u; }
    const size_t kstep = (size_t)(BK * 2);
    const size_t hstep = (size_t)HALF * K * 2;
    const size_t tstep = 2 * hstep;
    constexpr bool GA = Sched::GATHER;
    static_assert(!GA || SP2, "gathered A rows: SP2 loop only");
    const size_t hstepA = GA ? 0 : hstep;
    unsigned gcur[2][2] = {{0u, 0u}, {0u, 0u}}, gnxt[2][2] = {{0u, 0u}, {0u, 0u}}; int gR[2] = {0, 0}; unsigned gC[2] = {0u, 0u};
    if constexpr (GA) { _Pragma("unroll") for (int i = 0; i < 2; ++i) { int R, C; stage_rc(tid * 16 + i * 8192, R, C); gR[i] = R; gC[i] = (unsigned)C * 2u; } }
#define PG8_GOFF(dst, u) do { if constexpr (GA) { _Pragma("unroll") for (int h_ = 0; h_ < 2; ++h_) _Pragma("unroll") for (int i_ = 0; i_ < 2; ++i_) dst[h_][i_] = (unsigned)S.rowtok[(u).pm * BM + h_ * HALF + gR[i_]] * (unsigned)(K * 2) + gC[i_]; } } while (0)
#define PG8_VA(h, sel) (GA ? ((sel) ? gnxt[h] : gcur[h]) : voffA)
    const unsigned ldsw = (unsigned)wid * 1024u;
    const int aoff = lds_byte(wr * 64 + fr, fq * 8), boff = lds_byte(wc * 32 + fr, fq * 8);
#define PG8_SA(b, h) (((b) * 2 + (h)) * HTB)
#define PG8_SB(b, h) ((4 + (b) * 2 + (h)) * HTB)
#define PG8_STAGE(bufoff, gbase, voff) do { _Pragma("unroll") for (int _i = 0; _i < 2; ++_i) \
        __builtin_amdgcn_global_load_lds((const unsigned*)((const char*)(gbase) + (voff)[_i]), (PG8_LAS unsigned*)(lds + (bufoff) + ldsw + _i * 8192), 16, 0, 0); } while (0)
#define PG8_LDA(dst, b, h) do { _Pragma("unroll") for (int m = 0; m < 4; ++m) _Pragma("unroll") for (int k = 0; k < 2; ++k) dst[m][k] = *(const PG8_LAS bf16x8*)(lds + PG8_SA(b, h) + aoff + m * 2048 + k * 1024); } while (0)
#define PG8_LDB(dst, b, h) do { _Pragma("unroll") for (int n = 0; n < 2; ++n) _Pragma("unroll") for (int k = 0; k < 2; ++k) dst[n][k] = *(const PG8_LAS bf16x8*)(lds + PG8_SB(b, h) + boff + n * 2048 + k * 1024); } while (0)
#define PG8_MMA(ai, bj, At, Bt) do { __builtin_amdgcn_s_setprio(1); _Pragma("unroll") for (int m = 0; m < 4; ++m) _Pragma("unroll") for (int n = 0; n < 2; ++n) _Pragma("unroll") for (int k = 0; k < 2; ++k) \
        acc[ai][bj][m][n] = __builtin_amdgcn_mfma_f32_16x16x32_bf16(Bt[n][k], At[m][k], acc[ai][bj][m][n], 0, 0, 0); __builtin_amdgcn_s_setprio(0); } while (0)
#define PG8_WAIT_V(n) asm volatile("s_waitcnt vmcnt(" #n ")" ::: "memory")
#define PG8_WAIT_L(n) asm volatile("s_waitcnt lgkmcnt(" #n ")" ::: "memory")
#define PG8_BAR __builtin_amdgcn_s_barrier()
#define PG8_SCHED __builtin_amdgcn_sched_barrier(0)
    Unit cur, nxt; int ui = 0;
    if (!S.next(0, cur)) return;
    f32x4 acc[2][2][4][2];
#pragma unroll
    for (int a = 0; a < 2; ++a)
#pragma unroll
        for (int b = 0; b < 2; ++b)
#pragma unroll
            for (int m = 0; m < 4; ++m)
#pragma unroll
                for (int n = 0; n < 2; ++n) acc[a][b][m][n] = (f32x4){0.f, 0.f, 0.f, 0.f};
    bf16x8 At[4][2], B0[2][2], B1[2][2];
    const char* cA = (const char*)g.A + (GA ? 0 : (size_t)cur.pm * tstep); const char* cB = (const char*)g.Bt + (size_t)cur.pn * tstep;
    S.a_ready(cur);
    PG8_GOFF(gcur, cur);
    if constexpr (SP2) {
        PG8_STAGE(PG8_SB(0, 0), cB, voffB); PG8_STAGE(PG8_SB(0, 1), cB + hstep, voffB); PG8_STAGE(PG8_SA(0, 0), cA, PG8_VA(0, false)); PG8_STAGE(PG8_SA(0, 1), cA + hstepA, PG8_VA(1, false));
        if (wr == 1) PG8_BAR;
        PG8_WAIT_V(2); PG8_BAR;
        PG8_STAGE(PG8_SB(1, 0), cB + kstep, voffB); PG8_STAGE(PG8_SA(1, 0), cA + kstep, PG8_VA(0, false)); PG8_STAGE(PG8_SB(1, 1), cB + hstep + kstep, voffB);
        PG8_WAIT_V(6); PG8_BAR;
    } else {
        PG8_STAGE(PG8_SB(0, 0), cB, voffB); PG8_STAGE(PG8_SA(0, 0), cA, voffA); PG8_STAGE(PG8_SB(0, 1), cB + hstep, voffB); PG8_STAGE(PG8_SA(0, 1), cA + hstep, voffA);
        if (wr == 1) PG8_BAR;
        PG8_WAIT_V(4); PG8_BAR;
        PG8_STAGE(PG8_SB(1, 0), cB + kstep, voffB); PG8_STAGE(PG8_SA(1, 0), cA + kstep, voffA); PG8_STAGE(PG8_SB(1, 1), cB + hstep + kstep, voffB);
        PG8_WAIT_V(6); PG8_BAR;
    }
    for (;;) {
        const bool has_next = S.next(ui + 1, nxt);
        if (has_next) PG8_GOFF(gnxt, nxt);
        const char* nA = has_next ? (const char*)g.A + (GA ? 0 : (size_t)nxt.pm * tstep) : cA; const char* nB = has_next ? (const char*)g.Bt + (size_t)nxt.pn * tstep : cB;
        for (int t = 0; t < nt; t += 2) {
            const bool last = (t == nt - 2);
            const char* a1 = cA + (size_t)(t + 1) * kstep;
            const char* a2 = last ? nA : cA + (size_t)(t + 2) * kstep; const char* b2 = last ? nB : cB + (size_t)(t + 2) * kstep;
            const char* a3 = a2 + kstep; const char* b3 = b2 + kstep;
            if (last && has_next) S.a_ready(nxt);
            const bool seln = last && has_next;
            if constexpr (SP2) {
            PG8_LDB(B0, 0, 0); PG8_LDB(B1, 0, 1); PG8_SCHED; PG8_LDA(At, 0, 0); PG8_STAGE(PG8_SA(1, 1), a1 + hstepA, PG8_VA(1, false));
            PG8_WAIT_V(8); PG8_WAIT_L(0); PG8_BAR; PG8_MMA(0, 0, At, B0); PG8_MMA(0, 1, At, B1); PG8_BAR; PG8_SCHED;
            PG8_LDA(At, 0, 1); PG8_STAGE(PG8_SB(0, 0), b2, voffB); PG8_STAGE(PG8_SB(0, 1), b2 + hstep, voffB); PG8_STAGE(PG8_SA(0, 0), a2, PG8_VA(0, seln));
            PG8_WAIT_V(8); PG8_WAIT_L(0); PG8_BAR; PG8_MMA(1, 0, At, B0); PG8_MMA(1, 1, At, B1); PG8_BAR; PG8_SCHED;
            PG8_LDB(B0, 1, 0); PG8_LDB(B1, 1, 1); PG8_SCHED; PG8_LDA(At, 1, 0); PG8_STAGE(PG8_SA(0, 1), a2 + hstepA, PG8_VA(1, seln));
            PG8_WAIT_V(8); PG8_WAIT_L(0); PG8_BAR; PG8_MMA(0, 0, At, B0); PG8_MMA(0, 1, At, B1); PG8_BAR; PG8_SCHED;
            PG8_LDA(At, 1, 1); PG8_STAGE(PG8_SB(1, 0), b3, voffB); PG8_STAGE(PG8_SB(1, 1), b3 + hstep, voffB); PG8_STAGE(PG8_SA(1, 0), a3, PG8_VA(0, seln));
            PG8_WAIT_V(8); PG8_WAIT_L(0); PG8_BAR; PG8_MMA(1, 0, At, B0); PG8_MMA(1, 1, At, B1); PG8_BAR; PG8_SCHED;
            } else {
            PG8_LDB(B0, 0, 0); PG8_SCHED; PG8_LDA(At, 0, 0); PG8_STAGE(PG8_SA(1, 1), a1 + hstep, voffA);
            PG8_WAIT_L(8); PG8_BAR; PG8_WAIT_L(0); PG8_MMA(0, 0, At, B0); PG8_BAR; PG8_SCHED;
            PG8_LDB(B1, 0, 1); PG8_STAGE(PG8_SB(0, 0), b2, voffB);
            PG8_BAR; PG8_WAIT_L(0); PG8_MMA(0, 1, At, B1); PG8_BAR;
            PG8_LDA(At, 0, 1); PG8_STAGE(PG8_SA(0, 0), a2, voffA);
            PG8_BAR; PG8_WAIT_L(0); PG8_MMA(1, 0, At, B0); PG8_BAR; PG8_SCHED;
            PG8_STAGE(PG8_SB(0, 1), b2 + hstep, voffB);
            PG8_WAIT_V(6); PG8_BAR; PG8_MMA(1, 1, At, B1); PG8_BAR;
            PG8_LDB(B0, 1, 0); PG8_SCHED; PG8_LDA(At, 1, 0); PG8_STAGE(PG8_SA(0, 1), a2 + hstep, voffA);
            PG8_WAIT_L(8); PG8_BAR; PG8_WAIT_L(0); PG8_MMA(0, 0, At, B0); PG8_BAR; PG8_SCHED;
            PG8_LDB(B1, 1, 1); PG8_STAGE(PG8_SB(1, 0), b3, voffB);
            PG8_BAR; PG8_WAIT_L(0); PG8_MMA(0, 1, At, B1); PG8_BAR;
            PG8_LDA(At, 1, 1); PG8_STAGE(PG8_SA(1, 0), a3, voffA);
            PG8_BAR; PG8_WAIT_L(0); PG8_MMA(1, 0, At, B0); PG8_BAR; PG8_SCHED;
            PG8_STAGE(PG8_SB(1, 1), b3 + hstep, voffB);
            PG8_WAIT_V(6); PG8_BAR; PG8_MMA(1, 1, At, B1); PG8_BAR;
            }
        }
        if constexpr (ALIGN_EPI) { if (wr == 0) PG8_BAR; }
        if constexpr (!Epi::AFTER_DRAIN) { E(acc, cur, wr, wc, fr, fq); S.done(cur); }
#ifdef DBG_EPI2
        if constexpr (is_epibf16<Epi>::value) { asm volatile("" ::: "memory"); E(acc, cur, wr, wc, fr, fq); }
#endif
        if (!has_next) break;
#pragma unroll
        for (int a = 0; a < 2; ++a)
#pragma unroll
            for (int b = 0; b < 2; ++b)
#pragma unroll
                for (int m = 0; m < 4; ++m)
#pragma unroll
                    for (int n = 0; n < 2; ++n) acc[a][b][m][n] = (f32x4){0.f, 0.f, 0.f, 0.f};
        cur = nxt; cA = nA; cB = nB; ++ui;
        if constexpr (GA) { _Pragma("unroll") for (int h_ = 0; h_ < 2; ++h_) _Pragma("unroll") for (int i_ = 0; i_ < 2; ++i_) gcur[h_][i_] = gnxt[h_][i_]; }
        if constexpr (ALIGN_EPI) { if (wr == 1) PG8_BAR; }
    }
    PG8_WAIT_V(0);
    if constexpr (!ALIGN_EPI) { if (wr == 0) PG8_BAR; }
    PG8_BAR;
    if constexpr (Epi::AFTER_DRAIN) { E.fused(acc, cur, wr, wc, fr, fq, lds, wid, lane); S.done(cur); }
#undef PG8_GOFF
#undef PG8_VA
#undef PG8_SA
#undef PG8_SB
#undef PG8_STAGE
#undef PG8_LDA
#undef PG8_LDB
#undef PG8_MMA
#undef PG8_WAIT_V
#undef PG8_WAIT_L
#undef PG8_BAR
#undef PG8_SCHED
}
}
constexpr int NWAVES = 8;
constexpr int BATCH = 8, SEQ = 4096, D = 1024, T = BATCH * SEQ;
constexpr int NPROJ = 5120;
constexpr int NTILE = NPROJ / 256;
constexpr float EPS = 1e-6f;
#ifndef MK_N_LAUNCHES
#define MK_N_LAUNCHES 1
#endif
#ifndef DBG_NPH
#define DBG_NPH 12
#endif
constexpr int NPH = DBG_NPH;
constexpr int N_LAUNCHES = MK_N_LAUNCHES;
static_assert(N_LAUNCHES == 1 || N_LAUNCHES == NPH, "MK_N_LAUNCHES is 1 or NPH");

constexpr size_t MiB = 1u << 20;
constexpr size_t WS_CTL = 0, CTL_ZERO_BYTES = 1 * MiB;
constexpr size_t WS_SMALL = 1 * MiB;
constexpr size_t WS_WIN = 2 * MiB;
constexpr size_t WS_WPA = 13 * MiB, WS_WPM = 14 * MiB, WS_WOUT = 15 * MiB;
constexpr size_t WS_TOKE = 17 * MiB;
constexpr size_t WS_TOKR = WS_TOKE + 256 * 1024;
constexpr size_t WS_TOKP = WS_TOKR + 256 * 1024;
constexpr size_t WS_TOKG = WS_TOKP + 256 * 1024;
constexpr size_t WS_CNT = WS_TOKG + 256 * 1024;
constexpr size_t WS_ROWTOK = WS_CNT + 64 * 1024;
constexpr int NROWS_MAX = 73728;
constexpr size_t WS_SC = 452 * MiB;
constexpr size_t WS_SC2 = 116 * MiB + 3 * ((size_t)T * 256 * 2);
constexpr size_t WS_GU = 20 * MiB;
constexpr size_t WS_DN = 84 * MiB;
constexpr size_t WS_PROJ = 116 * MiB;
constexpr size_t PROJ_TILE = (size_t)T * 256 * 2;
constexpr size_t WS_MLST = 116 * MiB;
constexpr size_t WS_MERGED = 116 * MiB;
constexpr size_t WS_XN = 180 * MiB;
constexpr size_t WS_XG = 244 * MiB;
constexpr size_t WS_HID = 388 * MiB;
constexpr size_t WS_Y = 244 * MiB;
constexpr size_t WS_END = 512 * MiB;
static_assert(WS_PROJ + NTILE * PROJ_TILE == 436 * MiB, "proj map");
constexpr size_t DO_H = 0, DO_YATT = 0, DO_YML = 32 * MiB, DO_KN = 64 * MiB, DO_IKR = 72 * MiB, DO_IQR = 74 * MiB, DO_AQN = 90 * MiB;
constexpr int TL_AQ = 0, TL_KV = 2, TL_IQ = 3, TL_MQ = 4, TL_MK = 6, TL_MV = 8, TL_MO = 10, TL_GA = 12, TL_GM = 16;
constexpr size_t WS_WSM = WS_SMALL + 64 * 1024;
constexpr size_t WS_WTG = WS_SMALL + 192 * 1024;
constexpr size_t DO_SMB = 122 * MiB;
constexpr int CW_BAR = 4096;
constexpr int CW_Q = 16384;
constexpr int LDS_BYTES = 163840, MISC_OFF = LDS_BYTES - 512;

#define GAS __attribute__((address_space(1)))
#define LAS __attribute__((address_space(3)))
typedef unsigned short bf16;
typedef unsigned v4u __attribute__((ext_vector_type(4)));
typedef unsigned v2u __attribute__((ext_vector_type(2)));
typedef float f32x4 __attribute__((ext_vector_type(4)));
typedef float f32x2 __attribute__((ext_vector_type(2)));
typedef short bf16x8 __attribute__((ext_vector_type(8)));
typedef GAS unsigned gu32;
#define RLX_AGENT __ATOMIC_RELAXED, __HIP_MEMORY_SCOPE_AGENT
#define LDS_WAIT() asm volatile("s_waitcnt lgkmcnt(0)" ::: "memory")
__device__ __forceinline__ float bf2f(unsigned b16) { return __uint_as_float(b16 << 16); }
__device__ __forceinline__ unsigned f2bf(float f) { unsigned u = __float_as_uint(f); return (u + 0x7fffu + ((u >> 16) & 1u)) >> 16; }
__device__ __forceinline__ unsigned pk2(float lo, float hi) { return pg8::cvt_pk_bf16(lo, hi); }
__device__ __forceinline__ float sigm(float x) { return 1.0f / (1.0f + __expf(-x)); }
__device__ __forceinline__ float wave_sum(float v) {
    v += __int_as_float(__builtin_amdgcn_update_dpp(0, __float_as_int(v), 0xB1, 0xF, 0xF, true));
    v += __int_as_float(__builtin_amdgcn_update_dpp(0, __float_as_int(v), 0x4E, 0xF, 0xF, true));
    v += __int_as_float(__builtin_amdgcn_update_dpp(0, __float_as_int(v), 0x124, 0xF, 0xF, true));
    v += __int_as_float(__builtin_amdgcn_update_dpp(0, __float_as_int(v), 0x128, 0xF, 0xF, true));
    { const auto r = __builtin_amdgcn_permlane16_swap(__float_as_uint(v), __float_as_uint(v), false, false); v = __uint_as_float(r[0]) + __uint_as_float(r[1]); }
    { const auto r = __builtin_amdgcn_permlane32_swap(__float_as_uint(v), __float_as_uint(v), false, false); v = __uint_as_float(r[0]) + __uint_as_float(r[1]); }
    return v;
}
__device__ __forceinline__ void unpack8(const v4u r, float (&f)[8]) {
    f[0] = bf2f(r.x & 0xffffu); f[1] = bf2f(r.x >> 16); f[2] = bf2f(r.y & 0xffffu); f[3] = bf2f(r.y >> 16);
    f[4] = bf2f(r.z & 0xffffu); f[5] = bf2f(r.z >> 16); f[6] = bf2f(r.w & 0xffffu); f[7] = bf2f(r.w >> 16);
}
__device__ __forceinline__ v4u pack8(const float (&f)[8]) { v4u w; w.x = pk2(f[0], f[1]); w.y = pk2(f[2], f[3]); w.z = pk2(f[4], f[5]); w.w = pk2(f[6], f[7]); return w; }
#define XB_TMO      128
#define XB_XCNT(j)  (256  + 64 * (j))
#define XB_XSUB(j)  (1280 + 64 * (j))
#define XB_XGEN(j)  (2304 + 64 * (j))
#define XB_TOP      3328
#define XB_TOPGEN   3392
#define XCD_BAR_WORDS 3456
#define XB_SPIN_CAP (1u << 18)

__device__ __forceinline__ unsigned xb_ld(unsigned* p)              { return __hip_atomic_load(p, __ATOMIC_RELAXED, __HIP_MEMORY_SCOPE_AGENT); }
__device__ __forceinline__ unsigned xb_add(unsigned* p, unsigned v) { return __hip_atomic_fetch_add(p, v, __ATOMIC_RELAXED, __HIP_MEMORY_SCOPE_AGENT); }
__device__ __forceinline__ unsigned xb_xcc_id() { return (unsigned)__builtin_amdgcn_s_getreg((3 << 11) | 20) & 0xFu; }
#define XB_SPIN(cond, bar) do { unsigned _sp = 0; while (cond) { __builtin_amdgcn_s_sleep(1); \
    if ((++_sp & 255u) == 0u) { if (xb_ld(&(bar)[XB_TMO])) break; if (_sp > XB_SPIN_CAP) { atomicAdd(&(bar)[XB_TMO], 1u); break; } } } } while (0)

struct XcdBarrier {
    unsigned* bar; unsigned x;
    volatile LAS unsigned* st;
};

__device__ __forceinline__ XcdBarrier xcd_barrier_post(unsigned* bar, volatile LAS unsigned* st) {
    XcdBarrier b; b.bar = bar; b.x = xb_xcc_id(); b.st = st;
    if (threadIdx.x == 0) (void)xb_add(&bar[XB_XCNT(b.x)], 1u);
    return b;
}
__device__ __forceinline__ void xcd_barrier_complete(unsigned* bar, unsigned x, unsigned& nloc, unsigned& nx) {
    const unsigned G = gridDim.x * gridDim.y * gridDim.z;
    unsigned sum, cnt, mine, sp = 0u;
    for (;;) {
        sum = 0u; cnt = 0u; mine = 0u;
#pragma unroll
        for (unsigned j = 0; j < 16; ++j) { const unsigned c = xb_ld(&bar[XB_XCNT(j)]); sum += c; cnt += (c > 0u) ? 1u : 0u; mine = (j == x) ? c : mine; }
        if (sum == G) break;
        __builtin_amdgcn_s_sleep(1);
        if ((++sp & 255u) == 0u) { if (xb_ld(&bar[XB_TMO])) break; if (sp > XB_SPIN_CAP) { atomicAdd(&bar[XB_TMO], 1u); break; } }
    }
    nloc = mine > 0u ? mine : 1u; nx = cnt > 0u ? cnt : 1u;
}

__device__ __forceinline__ void xcd_barrier(const XcdBarrier& b) {
    asm volatile("s_waitcnt vmcnt(0)" ::: "memory");
    __syncthreads();
    if (threadIdx.x == 0) {
        unsigned* bar = b.bar;
        __builtin_amdgcn_s_waitcnt(0);
        unsigned nloc = b.st[0], nx = b.st[1];
        if (nloc == 0u) { xcd_barrier_complete(bar, b.x, nloc, nx); b.st[0] = nloc; b.st[1] = nx; }
        const unsigned old = xb_add(&bar[XB_XSUB(b.x)], 1u);
        const unsigned gen = old / nloc;
        if (old + 1u == (gen + 1u) * nloc) {
            __builtin_amdgcn_fence(__ATOMIC_RELEASE, "agent");
            asm volatile("s_waitcnt vmcnt(0)" ::: "memory");
            const unsigned og = xb_add(&bar[XB_TOP], 1u);
            const unsigned tg = og / nx;
            if (og + 1u == (tg + 1u) * nx) xb_add(&bar[XB_TOPGEN], 1u);
            else XB_SPIN(xb_ld(&bar[XB_TOPGEN]) == tg, bar);
            __builtin_amdgcn_fence(__ATOMIC_ACQUIRE, "agent");
            xb_add(&bar[XB_XGEN(b.x)], 1u);
            asm volatile("s_waitcnt vmcnt(0)" ::: "memory");
        } else {
            XB_SPIN(xb_ld(&bar[XB_XGEN(b.x)]) == gen, bar);
            __builtin_amdgcn_fence(__ATOMIC_ACQUIRE, "agent");
            asm volatile("s_waitcnt vmcnt(0)" ::: "memory");
        }
    }
    __syncthreads();
}
struct Args { const float* in[22]; float* out; unsigned char* ws; int ph_lo, ph_hi, li, pad; };
struct Ctx { int tid, lane, wave, G, vcu; LAS unsigned char* lds; };
#define IN_X 0
#define IN_POS 1
#define IN_GMIX 2
#define IN_WIN 3
#define IN_GQ 4
#define IN_GK 5
#define IN_WCONV 6
#define IN_BCONV 7
#define IN_BI 8
#define IN_BF 9
#define IN_GML 10
#define IN_WPA 11
#define IN_WPM 12
#define IN_WOUT 13
#define IN_GMOE 14
#define IN_WRG 15
#define IN_BRG 16
#define IN_WRE 17
#define IN_BRE 18
#define IN_WEG 19
#define IN_WEU 20
#define IN_WED 21

__device__ __forceinline__ int win_src_col(int n) {
    if (n < 1024) return n;
    if (n < 3072) return n + 40;
    return n + 48;
}
__device__ __forceinline__ int wsm_src_col(int r) {
    return r < 40 ? 1024 + r : (r < 44 ? 3112 + (r - 40) : 3116 + (r - 44));
}
__device__ __forceinline__ void tr_item(const float* W, int ldw, int scol, int k0, bf16* wt0, int K, LAS float* scr, int lane) {
    const int sc0 = __builtin_amdgcn_readfirstlane(scol), sc31 = __builtin_amdgcn_readlane(scol, 31);
    if (sc0 >= 0 && sc31 == sc0 + 31 && (sc0 & 3) == 0 && (ldw & 3) == 0) {
#pragma unroll
        for (int i = 0; i < 8; ++i) { const int kk = 8 * i + (lane >> 3); const f32x4 v = *(const f32x4*)(W + (size_t)(k0 + kk) * ldw + sc0 + 4 * (lane & 7));
            LAS float* d = scr + kk * 33 + 4 * (lane & 7); d[0] = v[0]; d[1] = v[1]; d[2] = v[2]; d[3] = v[3]; }
    } else {
#pragma unroll 8
        for (int i = 0; i < 32; ++i) { const int kk = 2 * i + (lane >> 5); scr[kk * 33 + (lane & 31)] = scol >= 0 ? W[(size_t)(k0 + kk) * ldw + scol] : 0.f; }
    }
    LDS_WAIT(); asm volatile("" ::: "memory");
    const int c = lane & 7;
#pragma unroll
    for (int j = 0; j < 4; ++j) { const int n = (lane >> 3) + 8 * j; const LAS float* s = scr + (8 * c) * 33 + n;
        v4u o; o.x = pk2(s[0 * 33], s[1 * 33]); o.y = pk2(s[2 * 33], s[3 * 33]); o.z = pk2(s[4 * 33], s[5 * 33]); o.w = pk2(s[6 * 33], s[7 * 33]);
        *(v4u*)(wt0 + (size_t)n * K + 8 * c) = o; }
    LDS_WAIT(); asm volatile("" ::: "memory");
}
template <int PART> __device__ __forceinline__ void p0_prologue(const Args& a, const Ctx& c, int gw, int NGW) {
    unsigned char* ws = a.ws;
    LAS float* scr = (LAS float*)(c.lds + c.wave * 16384);
    const int lane = c.lane;
    constexpr int I_IN = 16 * 160, I_PA = 8 * 32, I_PM = 8 * 32, I_OUT = 16 * 32, I_GU = 32 * 16 * 32, I_DN = 32 * 8 * 32;
    constexpr int NPRJ = I_IN + I_PA + I_PM + I_OUT, NIT = NPRJ + I_GU + I_DN;
    for (int it = (PART ? NPRJ : 0) + gw; it < (PART ? NIT : NPRJ); it += NGW) {
        int r = it;
        if (r < I_IN) { const int kb = r / 160, nb = r % 160; tr_item(a.in[IN_WIN], 5168, win_src_col(32 * nb + (lane & 31)), 64 * kb, (bf16*)(ws + WS_WIN) + (size_t)(32 * nb) * 1024 + 64 * kb, 1024, scr, lane); continue; } r -= I_IN;
        if (r < I_PA) { const int kb = r / 32, nb = r % 32; tr_item(a.in[IN_WPA], 1024, 32 * nb + (lane & 31), 64 * kb, (bf16*)(ws + WS_WPA) + (size_t)(32 * nb) * 512 + 64 * kb, 512, scr, lane); continue; } r -= I_PA;
        if (r < I_PM) { const int kb = r / 32, nb = r % 32; tr_item(a.in[IN_WPM], 1024, 32 * nb + (lane & 31), 64 * kb, (bf16*)(ws + WS_WPM) + (size_t)(32 * nb) * 512 + 64 * kb, 512, scr, lane); continue; } r -= I_PM;
        if (r < I_OUT) { const int kb = r / 32, nb = r % 32; tr_item(a.in[IN_WOUT], 1024, 32 * nb + (lane & 31), 64 * kb, (bf16*)(ws + WS_WOUT) + (size_t)(32 * nb) * 1024 + 64 * kb, 1024, scr, lane); continue; } r -= I_OUT;
        if (r < I_GU) { const int e = r / 512, q = r % 512, kb = q / 32, nb = q % 32, t = nb >> 3, bj = (nb >> 2) & 1, i0 = (nb & 3) * 32;
            const float* src = (bj ? a.in[IN_WEU] : a.in[IN_WEG]) + (size_t)e * 1024 * 512;
            tr_item(src, 512, 128 * t + i0 + (lane & 31), 64 * kb, (bf16*)(ws + WS_GU) + ((size_t)e * 1024 + 32 * nb) * 1024 + 64 * kb, 1024, scr, lane); continue; } r -= I_GU;
        { const int e = r / 256, q = r % 256, kb = q / 32, nb = q % 32;
            tr_item(a.in[IN_WED] + (size_t)e * 512 * 1024, 1024, 32 * nb + (lane & 31), 64 * kb, (bf16*)(ws + WS_DN) + ((size_t)e * 1024 + 32 * nb) * 512 + 64 * kb, 512, scr, lane); }
    }
    if (PART) return;
    { float* WTG = (float*)(ws + WS_WTG); for (int i = gw * 64 + lane; i < 36 * 1024; i += NGW * 64) { const int j = i >> 10, k = i & 1023;
        WTG[j * 1028 + k] = (j < 32 ? a.in[IN_WRE][k * 32 + j] : a.in[IN_WRG][k * 4 + (j - 32)]) * a.in[IN_GMOE][k]; } }
    { bf16* WSM = (bf16*)(ws + WS_WSM); for (int i = gw * 64 + lane; i < 48 * 1024; i += NGW * 64) { const int r = i >> 10, k = i & 1023; WSM[i] = (bf16)f2bf(a.in[IN_WIN][(size_t)k * 5168 + wsm_src_col(r)]); } }
    const float* g = a.in[IN_GMIX]; f32x4 gv[4];
#pragma unroll
    for (int j = 0; j < 4; ++j) gv[j] = *(const f32x4*)(g + 4 * lane + 256 * j);
    bf16* H = (bf16*)((unsigned char*)a.out + DO_H);
    for (int m0 = gw; m0 < T; m0 += 2 * NGW) {
        const int mA = m0, mB = (m0 + NGW < T) ? m0 + NGW : m0; const bool hasB = (m0 + NGW < T);
        const f32x4* xa = (const f32x4*)(a.in[IN_X] + (size_t)mA * D) + lane; const f32x4* xb = (const f32x4*)(a.in[IN_X] + (size_t)mB * D) + lane;
        f32x4 va[4], vb[4]; float sa = 0.f, sb = 0.f;
#pragma unroll
        for (int j = 0; j < 4; ++j) { va[j] = xa[64 * j]; vb[j] = xb[64 * j]; }
#pragma unroll
        for (int j = 0; j < 4; ++j) { sa += (va[j].x * va[j].x + va[j].y * va[j].y) + (va[j].z * va[j].z + va[j].w * va[j].w); sb += (vb[j].x * vb[j].x + vb[j].y * vb[j].y) + (vb[j].z * vb[j].z + vb[j].w * vb[j].w); }
        const float ra = rsqrtf(wave_sum(sa) * (1.f / D) + EPS), rb = rsqrtf(wave_sum(sb) * (1.f / D) + EPS);
        v2u* oa = (v2u*)(H + (size_t)mA * D) + lane; v2u* ob = (v2u*)(H + (size_t)mB * D) + lane;
#pragma unroll
        for (int j = 0; j < 4; ++j) { v2u w; w.x = pk2(va[j].x * ra * gv[j].x, va[j].y * ra * gv[j].y); w.y = pk2(va[j].z * ra * gv[j].z, va[j].w * ra * gv[j].w); oa[64 * j] = w; }
        if (hasB) {
#pragma unroll
        for (int j = 0; j < 4; ++j) { v2u w; w.x = pk2(vb[j].x * rb * gv[j].x, vb[j].y * rb * gv[j].y); w.y = pk2(vb[j].z * rb * gv[j].z, vb[j].w * rb * gv[j].w); ob[64 * j] = w; } }
    }
}

__device__ __forceinline__ const bf16* proj_tile(const Args& a, int tile) { return (const bf16*)(a.ws + WS_PROJ + (size_t)tile * PROJ_TILE); }
#define DPPF(x_, ctrl_) __int_as_float(__builtin_amdgcn_update_dpp(0, __float_as_int(x_), ctrl_, 0xF, 0xF, true))
__device__ __forceinline__ void p2_prep(const Args& a, const Ctx& c) {
    const int lane = c.lane, gw = c.vcu * NWAVES + c.wave, NGW = c.G * NWAVES;
    float invf = 0.f;
    if (lane < 8) invf = (float)pow(500000.0, -(double)lane / 8.0); else if (lane < 12) invf = (float)pow(500000.0, -(double)(lane - 8) / 4.0);
    float gq[8], gk[8];
#pragma unroll
    for (int i = 0; i < 8; ++i) { gq[i] = a.in[IN_GQ][8 * (lane & 7) + i]; gk[i] = a.in[IN_GK][8 * (lane & 7) + i]; }
    const int* pos = (const int*)a.in[IN_POS];
    unsigned char* dout = (unsigned char*)a.out;
    bf16* AQN = (bf16*)(dout + DO_AQN); bf16* KN = (bf16*)(dout + DO_KN); bf16* IQR = (bf16*)(dout + DO_IQR); bf16* IKR = (bf16*)(dout + DO_IKR);
    { const bf16* Hh = (const bf16*)(dout + DO_H); const bf16* WSM = (const bf16*)(a.ws + WS_WSM); bf16* SMB = (bf16*)(dout + DO_SMB);
      const int row = lane & 15, kg = lane >> 4;
      const float invfk = (float)pow(500000.0, -(double)(lane & 3) / 4.0);
      for (int tile = gw; tile < T / 16; tile += NGW) { const int t0 = tile * 16;
          f32x4 acc[3];
#pragma unroll
          for (int ct = 0; ct < 3; ++ct) acc[ct] = (f32x4){0.f, 0.f, 0.f, 0.f};
          const bf16* ap = Hh + (size_t)(t0 + row) * 1024 + 8 * kg; const bf16* bp = WSM + (size_t)row * 1024 + 8 * kg;
#pragma unroll 8
          for (int ks = 0; ks < 32; ++ks) { const bf16x8 av = *(const bf16x8*)(ap + 32 * ks);
#pragma unroll
              for (int ct = 0; ct < 3; ++ct) acc[ct] = __builtin_amdgcn_mfma_f32_16x16x32_bf16(av, *(const bf16x8*)(bp + (size_t)ct * 16 * 1024 + 32 * ks), acc[ct], 0, 0, 0); }
          const int col = lane & 15;
#pragma unroll
          for (int r = 0; r < 4; ++r) { const int t = t0 + 4 * kg + r;
              const float angk = (float)pos[t] * invfk;
              const double revk = (double)angk * 0.15915494309189535; const float frk = (float)(revk - __builtin_rint(revk));
              const float ck = __builtin_amdgcn_cosf(frk), sk = __builtin_amdgcn_sinf(frk);
              const float v0 = acc[0][r], pr = __shfl_xor(v0, 4);
              const float o0 = (col < 4) ? (v0 * ck - pr * sk) : ((col < 8) ? (v0 * ck + pr * sk) : v0);
              IKR[(size_t)t * 32 + col] = (bf16)f2bf(o0); IKR[(size_t)t * 32 + 16 + col] = (bf16)f2bf(acc[1][r]);
              SMB[(size_t)t * 16 + col] = (bf16)f2bf(acc[2][r]); } } }
    const int l7 = lane & 7;
    const int aqcol = (lane >> 3) * 64 + 8 * l7, akcol = ((lane & 15) >> 3) * 64 + 8 * l7;
    const bf16* aqsrc = proj_tile(a, TL_AQ + (aqcol >> 8)) + (aqcol & 255); const bf16* aksrc = proj_tile(a, TL_KV) + akcol; const bf16* iqsrc = proj_tile(a, TL_IQ) + 4 * lane;
#define P2_LOADROW(t_, P_, A_, K_, Q_) do { const int tt_ = (t_) < T ? (t_) : T - 1; P_ = pos[tt_]; A_ = *(const v4u*)(aqsrc + (size_t)tt_ * 256); K_ = *(const v4u*)(aksrc + (size_t)tt_ * 256); Q_ = *(const v2u*)(iqsrc + (size_t)tt_ * 256); } while (0)
#define P2_DOROW(t, P_, A_, K_, Q_) do { \
        const float ang = (float)(P_) * invf; \
        const double rev = (double)ang * 0.15915494309189535; const float frv = (float)(rev - __builtin_rint(rev)); \
        float cs = __builtin_amdgcn_cosf(frv), sn = __builtin_amdgcn_sinf(frv); \
        float ca[8], sa[8], ci[4], si[4]; \
        _Pragma("unroll") for (int i = 0; i < 8; ++i) { ca[i] = __int_as_float(__builtin_amdgcn_readlane(__float_as_int(cs), i)); sa[i] = __int_as_float(__builtin_amdgcn_readlane(__float_as_int(sn), i)); } \
        _Pragma("unroll") for (int i = 0; i < 4; ++i) { ci[i] = __int_as_float(__builtin_amdgcn_readlane(__float_as_int(cs), 8 + i)); si[i] = __int_as_float(__builtin_amdgcn_readlane(__float_as_int(sn), 8 + i)); } \
        { float f[8]; unpack8(A_, f); float ss = 0.f; \
          _Pragma("unroll") for (int i = 0; i < 8; ++i) ss += f[i] * f[i]; \
          ss += DPPF(ss, 0xB1); ss += DPPF(ss, 0x4E); ss += DPPF(ss, 0x141); \
          const float r = rsqrtf(ss * (1.f / 64.f) + EPS); \
          _Pragma("unroll") for (int i = 0; i < 8; ++i) f[i] = f[i] * r * gq[i]; \
          float o[8]; \
          _Pragma("unroll") for (int i = 0; i < 8; ++i) { const float p = DPPF(f[i], 0xB1); o[i] = (l7 == 0) ? (f[i] * ca[i] - p * sa[i]) : ((l7 == 1) ? (f[i] * ca[i] + p * sa[i]) : f[i]); o[i] *= 0.125f * 1.4426950408889634f; } \
          *(v4u*)(AQN + (size_t)(t) * 512 + aqcol) = pack8(o); } \
        { float f[8]; unpack8(K_, f); float ss = 0.f; \
          _Pragma("unroll") for (int i = 0; i < 8; ++i) ss += f[i] * f[i]; \
          ss += DPPF(ss, 0xB1); ss += DPPF(ss, 0x4E); ss += DPPF(ss, 0x141); \
          const float r = rsqrtf(ss * (1.f / 64.f) + EPS); \
          _Pragma("unroll") for (int i = 0; i < 8; ++i) f[i] = f[i] * r * gk[i]; \
          float o[8]; \
          _Pragma("unroll") for (int i = 0; i < 8; ++i) { const float p = DPPF(f[i], 0xB1); o[i] = (l7 == 0) ? (f[i] * ca[i] - p * sa[i]) : ((l7 == 1) ? (f[i] * ca[i] + p * sa[i]) : f[i]); } \
          if (lane < 16) *(v4u*)(KN + (size_t)(t) * 128 + akcol) = pack8(o); } \
        { const v2u rw = Q_; \
          float f[4] = {bf2f(rw.x & 0xffffu), bf2f(rw.x >> 16), bf2f(rw.y & 0xffffu), bf2f(rw.y >> 16)}; float o[4]; \
          _Pragma("unroll") for (int i = 0; i < 4; ++i) { const float p = DPPF(f[i], 0xB1); o[i] = (l7 == 0) ? (f[i] * ci[i] - p * si[i]) : ((l7 == 1) ? (f[i] * ci[i] + p * si[i]) : f[i]); } \
          v2u w; w.x = pk2(o[0], o[1]); w.y = pk2(o[2], o[3]); *(v2u*)(IQR + (size_t)(t) * 256 + 4 * lane) = w; } } while (0)
    { int pA, pB; v4u aA, aB, kA, kB; v2u qA, qB;
      P2_LOADROW(gw, pA, aA, kA, qA);
#pragma unroll 1
      for (int t = gw; t < T; t += 2 * NGW) {
          P2_LOADROW(t + NGW, pB, aB, kB, qB);
          P2_DOROW(t, pA, aA, kA, qA);
          P2_LOADROW(t + 2 * NGW, pA, aA, kA, qA);
          if (t + NGW < T) P2_DOROW(t + NGW, pB, aB, kB, qB);
      } }
#undef P2_LOADROW
#undef P2_DOROW
}
constexpr int ML_QS = 0, ML_KS = 17408, ML_HS = 0;
constexpr int ML_KWT = 34816;
constexpr int ML_VT = 53248;
constexpr int ML_SW = 73984;
constexpr int ML_CT = 83200;
constexpr int ML_GA = 122368;
constexpr int ML_CW = ML_GA + 1024;
constexpr int ML_END = ML_CW + (1024 + 384) * 4;
static_assert(ML_END <= MISC_OFF, "mLSTM LDS map");
constexpr size_t ML_STATE_BYTES = 8 * 9 * 64 * 16;
__device__ __forceinline__ bf16x8 lds_frag(const LAS unsigned char* base, int stride_b, int row0, int kb, int lane) {
    return *(const LAS bf16x8*)(base + (row0 + (lane & 15)) * stride_b + kb + (lane >> 4) * 16);
}
__device__ __forceinline__ bf16x8 lds_frag_sw(const LAS unsigned char* base, int row0, int ks, int lane) {
    const int row = row0 + (lane & 15); return *(const LAS bf16x8*)(base + row * 144 + 16 * (((ks * 4 + (lane >> 4)) + (row >> 3)) & 7));
}
#define MFMA16(a_, b_, c_) __builtin_amdgcn_mfma_f32_16x16x32_bf16(a_, b_, c_, 0, 0, 0)
constexpr int CV_NMI = 2 * (32 * 16 * 32 + 32 * 8 * 32);
constexpr int CV_SCR = ML_END, CV_SCRW = 32 * 33 * 4;
static_assert(CV_SCR + 8 * CV_SCRW <= MISC_OFF, "conversion scratch");
struct CvItem { const float* src; bf16* dst; int ldw, K; };
__device__ __forceinline__ CvItem cv_item(const Args& a, int mi) {
    const int it = mi >> 1, hk = mi & 1; CvItem r;
    if (it < 32 * 16 * 32) { const int e = it >> 9, q = it & 511, kb = q >> 5, nb = q & 31, t = nb >> 3, bj = (nb >> 2) & 1, i0 = (nb & 3) * 32, k0 = 64 * kb + 32 * hk;
        r.src = (bj ? a.in[IN_WEU] : a.in[IN_WEG]) + (size_t)e * 1024 * 512 + (size_t)k0 * 512 + 128 * t + i0; r.ldw = 512; r.K = 1024;
        r.dst = (bf16*)(a.ws + WS_GU) + ((size_t)e * 1024 + 32 * nb) * 1024 + k0;
    } else { const int r2 = it - 32 * 16 * 32, e = r2 >> 8, q = r2 & 255, kb = q >> 5, nb = q & 31, k0 = 64 * kb + 32 * hk;
        r.src = a.in[IN_WED] + (size_t)e * 512 * 1024 + (size_t)k0 * 1024 + 32 * nb; r.ldw = 1024; r.K = 512;
        r.dst = (bf16*)(a.ws + WS_DN) + ((size_t)e * 1024 + 32 * nb) * 512 + k0; }
    return r;
}
__device__ __forceinline__ void cv_load(const CvItem& it, f32x4 (&v)[4], int lane) {
#pragma unroll
    for (int i = 0; i < 4; ++i) v[i] = *(const f32x4*)(it.src + (size_t)(8 * i + (lane >> 3)) * it.ldw + 4 * (lane & 7));
}
__device__ __forceinline__ void cv_finish(const CvItem& it, const f32x4 (&v)[4], LAS float* scr, int lane, bool valid) {
#pragma unroll
    for (int i = 0; i < 4; ++i) { LAS float* d = scr + (8 * i + (lane >> 3)) * 33 + 4 * (lane & 7); d[0] = v[i][0]; d[1] = v[i][1]; d[2] = v[i][2]; d[3] = v[i][3]; }
    LDS_WAIT(); asm volatile("" ::: "memory");
#pragma unroll
    for (int j = 0; j < 2; ++j) { const int n = (lane >> 2) + 16 * j, cq = lane & 3; const LAS float* sp = scr + (8 * cq) * 33 + n;
        v4u o; o.x = pk2(sp[0 * 33], sp[1 * 33]); o.y = pk2(sp[2 * 33], sp[3 * 33]); o.z = pk2(sp[4 * 33], sp[5 * 33]); o.w = pk2(sp[6 * 33], sp[7 * 33]);
        if (valid) *(v4u*)(it.dst + (size_t)n * it.K + 8 * cq) = o; }
    LDS_WAIT(); asm volatile("" ::: "memory");
}
template <int MODE>
__device__ __forceinline__ void mlstm_unit(const Args& a, const Ctx& c, int b, int h, int g) {
    const int tid = c.tid, wave = c.wave; LAS unsigned char* lds = c.lds;
#define ML_LAUNDER() int tv_ = tid; asm volatile("" : "+v"(tv_)); const int lane = tv_ & 63, seg = tv_ & 15, r2 = (tv_ >> 4) * 2; (void)lane; (void)seg; (void)r2
    const bf16* PQ = proj_tile(a, TL_MQ + (h >> 1)) + (h & 1) * 128;
    const bf16* PK = proj_tile(a, TL_MK + (h >> 1)) + (h & 1) * 128;
    const bf16* PV = proj_tile(a, TL_MV + (h >> 1)) + (h & 1) * 128;
    const bf16* PO = proj_tile(a, TL_MO + (h >> 1)) + (h & 1) * 128;
    const bf16* PS = (const bf16*)((unsigned char*)a.out + DO_SMB);
    bf16* YML = (bf16*)((unsigned char*)a.out + DO_YML);
    unsigned char* STB = a.ws + WS_MLST; float* MST = (float*)(a.ws + WS_MLST + 256 * ML_STATE_BYTES);
    LAS float* GAa = (LAS float*)(lds + ML_GA); LAS float* GAm = GAa + 64; LAS float* GAw = GAa + 128; LAS float* GAe = GAa + 192;
    LAS float* CWQ = (LAS float*)(lds + ML_CW); LAS float* CWK = CWQ + 512; LAS float* CBQ = CWQ + 1024; LAS float* CBK = CBQ + 128; LAS float* GN = CBK + 128;
    LAS bf16* VTs = (LAS bf16*)(lds + ML_VT);
    { const float* wc = a.in[IN_WCONV]; const int j = tid >> 7, d = tid & 127;
      CWQ[tid] = wc[j * 1024 + h * 128 + d]; CWK[tid] = wc[j * 1024 + 512 + h * 128 + d];
      if (tid < 128) { CBQ[tid] = a.in[IN_BCONV][h * 128 + tid]; CBK[tid] = a.in[IN_BCONV][512 + h * 128 + tid]; GN[tid] = a.in[IN_GML][h * 128 + tid]; } }
    for (int i = tid; i < 16 * 64; i += 512) { const int r = i >> 6, cc = i & 63; VTs[(128 + r) * 72 + cc] = (r == 0) ? (bf16)0x3F80 : (bf16)0; }
    const float big = a.in[IN_BI][h], bfg = a.in[IN_BF][h];
    const int slot0 = (b * 4 + h) * 8;
    f32x4 cacc[9];
    float m_st = 0.f;
    if (MODE == 1 && g > 0) { ML_LAUNDER();
        const f32x4* sp = (const f32x4*)(STB + (size_t)(slot0 + g) * ML_STATE_BYTES) + wave * 576 + lane;
#pragma unroll
        for (int i = 0; i < 9; ++i) cacc[i] = sp[64 * i];
        m_st = MST[slot0 + g];
#pragma unroll
        for (int ee = 0; ee < 9; ++ee) { v2u w; w.x = pk2(cacc[ee][0], cacc[ee][1]); w.y = pk2(cacc[ee][2], cacc[ee][3]);
            *(LAS v2u*)(lds + ML_CT + (ee * 16 + (lane & 15)) * 272 + (wave * 16 + 4 * (lane >> 4)) * 2) = w; }
    } else {
#pragma unroll
        for (int i = 0; i < 9; ++i) cacc[i] = (f32x4){0.f, 0.f, 0.f, 0.f};
        for (int i = tid; i < 144 * 136 / 2; i += 512) ((LAS unsigned*)(lds + ML_CT))[i] = 0u;
    }
    const size_t tb = (size_t)b * SEQ;
    const char* bq = (const char*)(PQ + tb * 256); const char* bk = (const char*)(PK + tb * 256); const char* bv = (const char*)(PV + tb * 256); const char* bo = (const char*)(PO + tb * 256); const char* bs = (const char*)(PS + tb * 16);
    v4u rq[5], rk[5], rv[2]; unsigned short gi = 0, gf = 0;
#define ML_LOAD(kc) do { _Pragma("unroll") for (int j_ = 0; j_ < 5; ++j_) { const int rr_ = 64 * (kc) + r2 - 3 + j_; const unsigned o_ = (unsigned)((rr_ < 0 ? 0 : rr_) * 512 + seg * 16); \
            v4u q_ = (v4u){0u, 0u, 0u, 0u}; if (MODE == 1) q_ = *(const v4u*)(bq + o_); v4u k_ = *(const v4u*)(bk + o_); if (rr_ < 0) { q_ = (v4u){0u, 0u, 0u, 0u}; k_ = q_; } rq[j_] = q_; rk[j_] = k_; } \
        _Pragma("unroll") for (int i_ = 0; i_ < 2; ++i_) rv[i_] = *(const v4u*)(bv + (unsigned)((64 * (kc) + r2 + i_) * 512 + seg * 16)); \
        gi = *(const unsigned short*)(bs + (unsigned)((64 * (kc) + lane) * 32 + (8 + h) * 2)); gf = *(const unsigned short*)(bs + (unsigned)((64 * (kc) + lane) * 32 + (12 + h) * 2)); } while (0)
    const int kc0 = (MODE == 1) ? 8 * g : 0, kc1 = (MODE == 1) ? 8 * g + 8 : 56;
    { ML_LAUNDER(); ML_LOAD(kc0); }
    const int cv_gw = c.vcu * NWAVES + c.wave, cv_ngw = c.G * NWAVES; f32x4 cvv[4]; CvItem cvi; int cvk = 0; bool cvp = false;
    LAS float* cv_scr = (LAS float*)(lds + CV_SCR + wave * CV_SCRW);
#define CV_SLOT() do { if (MODE == 1) { ML_LAUNDER(); if (cvp) cv_finish(cvi, cvv, cv_scr, lane, cv_gw + (cvk - 1) * cv_ngw < CV_NMI); \
        { int mi_ = cv_gw + cvk * cv_ngw; mi_ = mi_ < CV_NMI ? mi_ : CV_NMI - 1; cvi = cv_item(a, __builtin_amdgcn_readfirstlane(mi_)); cv_load(cvi, cvv, lane); cvp = true; ++cvk; } } } while (0)
    __syncthreads();
#pragma unroll 1
    for (int kc = kc0; kc < kc1; ++kc) {
        float wkv, decay, m_new;
        if (MODE == 0 && kc > 0 && (kc & 7) == 0) { ML_LAUNDER();
            f32x4* sp = (f32x4*)(STB + (size_t)(slot0 + (kc >> 3)) * ML_STATE_BYTES) + wave * 576 + lane;
#pragma unroll
            for (int i = 0; i < 9; ++i) sp[64 * i] = cacc[i];
            if (tid == 0) MST[slot0 + (kc >> 3)] = m_st; }
        CV_SLOT();
        { ML_LAUNDER();
        const float fpre = bf2f(gf) + bfg, lf = fminf(fpre, 0.f) - log1pf(__expf(-fabsf(fpre)));
        const float ig = bf2f(gi) + big;
#define ML_SHR(x_, n_, id_) __int_as_float(__builtin_amdgcn_update_dpp(__float_as_int(id_), __float_as_int(x_), 0x110 + (n_), 0xF, 0xF, false))
        float bc = lf;
        bc += ML_SHR(bc, 1, 0.f); bc += ML_SHR(bc, 2, 0.f); bc += ML_SHR(bc, 4, 0.f); bc += ML_SHR(bc, 8, 0.f);
        { const float t0 = __int_as_float(__builtin_amdgcn_readlane(__float_as_int(bc), 15)), t1 = __int_as_float(__builtin_amdgcn_readlane(__float_as_int(bc), 31)), t2 = __int_as_float(__builtin_amdgcn_readlane(__float_as_int(bc), 47));
          bc += (lane >= 48) ? (t0 + t1 + t2) : ((lane >= 32) ? (t0 + t1) : ((lane >= 16) ? t0 : 0.f)); }
        const float av = ig - bc; float Ac = av;
        Ac = fmaxf(Ac, ML_SHR(Ac, 1, -3.0e38f)); Ac = fmaxf(Ac, ML_SHR(Ac, 2, -3.0e38f)); Ac = fmaxf(Ac, ML_SHR(Ac, 4, -3.0e38f)); Ac = fmaxf(Ac, ML_SHR(Ac, 8, -3.0e38f));
        { const float t0 = __int_as_float(__builtin_amdgcn_readlane(__float_as_int(Ac), 15)), t1 = __int_as_float(__builtin_amdgcn_readlane(__float_as_int(Ac), 31)), t2 = __int_as_float(__builtin_amdgcn_readlane(__float_as_int(Ac), 47));
          const float m01 = fmaxf(t0, t1), m012 = fmaxf(m01, t2);
          Ac = fmaxf(Ac, (lane >= 48) ? m012 : ((lane >= 32) ? m01 : ((lane >= 16) ? t0 : -3.0e38f))); }
#undef ML_SHR
        const float mA = fmaxf(m_st, Ac), Mk = __int_as_float(__builtin_amdgcn_readlane(__float_as_int(mA), 63)), blast = __int_as_float(__builtin_amdgcn_readlane(__float_as_int(bc), 63));
        wkv = __expf(av - Mk); decay = __expf(m_st - Mk); m_new = blast + Mk;
        if (MODE == 1 && wave == 0) { GAa[lane] = av; GAm[lane] = mA; GAw[lane] = __expf(m_st - mA); GAe[lane] = __expf(-(bc + mA)); } }
        { ML_LAUNDER(); float kw_[2][8];
#pragma unroll
          for (int i = 0; i < 2; ++i) { const int t = r2 + i; const float wkt = __shfl(wkv, t);
            float aq_[8], ak_[8];
            { const f32x4 b0 = *(const LAS f32x4*)(CBQ + seg * 8), b1 = *(const LAS f32x4*)(CBQ + seg * 8 + 4), c0 = *(const LAS f32x4*)(CBK + seg * 8), c1 = *(const LAS f32x4*)(CBK + seg * 8 + 4);
              aq_[0] = b0[0]; aq_[1] = b0[1]; aq_[2] = b0[2]; aq_[3] = b0[3]; aq_[4] = b1[0]; aq_[5] = b1[1]; aq_[6] = b1[2]; aq_[7] = b1[3];
              ak_[0] = c0[0]; ak_[1] = c0[1]; ak_[2] = c0[2]; ak_[3] = c0[3]; ak_[4] = c1[0]; ak_[5] = c1[1]; ak_[6] = c1[2]; ak_[7] = c1[3]; }
#pragma unroll
            for (int j = 0; j < 4; ++j) { float fk_[8]; unpack8(rk[i + j], fk_);
                const f32x4 x0 = *(const LAS f32x4*)(CWK + j * 128 + seg * 8), x1 = *(const LAS f32x4*)(CWK + j * 128 + seg * 8 + 4);
#pragma unroll
                for (int e = 0; e < 4; ++e) { ak_[e] += x0[e] * fk_[e]; ak_[4 + e] += x1[e] * fk_[4 + e]; }
                if (MODE == 1) { float fq_[8]; unpack8(rq[i + j], fq_);
                    const f32x4 w0 = *(const LAS f32x4*)(CWQ + j * 128 + seg * 8), w1 = *(const LAS f32x4*)(CWQ + j * 128 + seg * 8 + 4);
#pragma unroll
                    for (int e = 0; e < 4; ++e) { aq_[e] += w0[e] * fq_[e]; aq_[4 + e] += w1[e] * fq_[4 + e]; } } }
#pragma unroll
            for (int e = 0; e < 8; ++e) { ak_[e] = ak_[e] * sigm(ak_[e]) * 0.08838834764831845f; kw_[i][e] = ak_[e] * wkt; }
            if (MODE == 1) {
#pragma unroll
                for (int e = 0; e < 8; ++e) aq_[e] = aq_[e] * sigm(aq_[e]);
                *(LAS v4u*)(lds + ML_QS + t * 272 + seg * 16) = pack8(aq_);
                *(LAS v4u*)(lds + ML_KS + t * 272 + seg * 16) = pack8(ak_); } }
          const unsigned va[4] = {rv[0].x, rv[0].y, rv[0].z, rv[0].w}, vb[4] = {rv[1].x, rv[1].y, rv[1].z, rv[1].w};
          const int swo = 16 * (((r2 >> 3) + seg) & 7) + 2 * (r2 & 7);
#pragma unroll
          for (int e = 0; e < 8; ++e) { const int ro = (seg * 8 + e) * 144 + swo;
              *(LAS unsigned*)(lds + ML_KWT + ro) = pk2(kw_[0][e], kw_[1][e]);
              const unsigned lo = (e & 1) ? (va[e >> 1] >> 16) : (va[e >> 1] & 0xffffu), hi = (e & 1) ? (vb[e >> 1] >> 16) : (vb[e >> 1] & 0xffffu);
              *(LAS unsigned*)(lds + ML_VT + ro) = lo | (hi << 16); }
        if (kc + 1 < kc1) ML_LOAD(kc + 1); }
        __syncthreads();
        f32x4 hacc[5]; unsigned mo_r[8];
        const int tt = wave & 3, t0 = tt * 16, ne = (wave < 4) ? 5 : 4, e_first = (wave < 4) ? 0 : 5;
        CV_SLOT();
        if (MODE == 1) {
        { ML_LAUNDER(); const int tq = t0 + (lane & 15);
        bf16x8 qf[4];
#pragma unroll
        for (int ks = 0; ks < 4; ++ks) qf[ks] = lds_frag(lds + ML_QS, 272, t0, ks * 64, lane);
        const float mAt = GAm[tq], wit = GAw[tq];
#pragma unroll
        for (int si = 0; si < 2; ++si) { const int ss = 2 * (wave >> 2) + si, s0 = ss * 16; f32x4 sacc = (f32x4){0.f, 0.f, 0.f, 0.f};
            if (ss <= tt) {
#pragma unroll
                for (int ks = 0; ks < 4; ++ks) sacc = MFMA16(lds_frag(lds + ML_KS, 272, s0, ks * 64, lane), qf[ks], sacc);
#pragma unroll
                for (int r = 0; r < 4; ++r) { const int s = s0 + 4 * (lane >> 4) + r; sacc[r] = (s <= tq) ? sacc[r] * __expf(GAa[s] - mAt) : 0.f; } }
            v2u w; w.x = pk2(sacc[0], sacc[1]); w.y = pk2(sacc[2], sacc[3]);
            *(LAS v2u*)(lds + ML_SW + tq * 144 + s0 * 2 + (lane >> 4) * 8) = w; }
#pragma unroll
        for (int i = 0; i < 5; ++i) { hacc[i] = (f32x4){0.f, 0.f, 0.f, 0.f};
            if (i < ne) {
#pragma unroll
                for (int ks = 0; ks < 4; ++ks) hacc[i] = MFMA16(lds_frag(lds + ML_CT, 272, (e_first + i) * 16, ks * 64, lane), qf[ks], hacc[i]);
                hacc[i] = hacc[i] * wit; } }
#pragma unroll
        for (int i = 0; i < 8; ++i) mo_r[i] = *(const unsigned*)(bo + (unsigned)((64 * kc + 8 * wave + i) * 512 + 4 * lane)); }
        __syncthreads();
        { ML_LAUNDER(); const int tq = t0 + (lane & 15); bf16x8 swf[2];
#pragma unroll
          for (int ks = 0; ks < 2; ++ks) swf[ks] = lds_frag(lds + ML_SW, 144, t0, ks * 64, lane);
#pragma unroll
          for (int i = 0; i < 5; ++i) if (i < ne) { const int ee = e_first + i;
#pragma unroll
              for (int ks = 0; ks < 2; ++ks) hacc[i] = MFMA16(lds_frag_sw(lds + ML_VT, ee * 16, ks, lane), swf[ks], hacc[i]);
              if (ee < 8) *(LAS f32x4*)(lds + ML_HS + tq * 528 + (ee * 16 + 4 * (lane >> 4)) * 4) = hacc[i];
              else if ((lane >> 4) == 0) *(LAS float*)(lds + ML_HS + tq * 528 + 128 * 4) = hacc[i][0]; } }
        }
        CV_SLOT();
        { ML_LAUNDER(); const int d0 = wave * 16; bf16x8 kwf[2];
#pragma unroll
          for (int ks = 0; ks < 2; ++ks) kwf[ks] = lds_frag_sw(lds + ML_KWT, d0, ks, lane);
#pragma unroll
          for (int ee = 0; ee < 9; ++ee) { cacc[ee] = cacc[ee] * decay;
#pragma unroll
              for (int ks = 0; ks < 2; ++ks) cacc[ee] = MFMA16(kwf[ks], lds_frag_sw(lds + ML_VT, ee * 16, ks, lane), cacc[ee]);
              if (MODE == 1) { v2u w; w.x = pk2(cacc[ee][0], cacc[ee][1]); w.y = pk2(cacc[ee][2], cacc[ee][3]);
                  *(LAS v2u*)(lds + ML_CT + (ee * 16 + (lane & 15)) * 272 + (d0 + 4 * (lane >> 4)) * 2) = w; } } }
        __syncthreads();
        if (MODE == 1) {
        { ML_LAUNDER();
#pragma unroll
        for (int i = 0; i < 8; ++i) { const int t = 8 * wave + i;
            const f32x2 nv = *(const LAS f32x2*)(lds + ML_HS + t * 528 + lane * 8); const float den = *(const LAS float*)(lds + ML_HS + t * 528 + 512);
            const float dd = fmaxf(fabsf(den), GAe[t]); const float h0 = nv.x / dd, h1 = nv.y / dd;
            const float r = rsqrtf(wave_sum(h0 * h0 + h1 * h1) * (1.f / 128.f) + EPS);
            const float y0 = h0 * r * GN[2 * lane] * sigm(bf2f(mo_r[i] & 0xffffu)), y1 = h1 * r * GN[2 * lane + 1] * sigm(bf2f(mo_r[i] >> 16));
            *(unsigned*)(YML + (tb + 64 * kc + t) * 512 + h * 128 + 2 * lane) = pk2(y0, y1); } }
        __syncthreads();
        }
        m_st = m_new;
    }
    if (MODE == 1) { ML_LAUNDER(); if (cvp) cv_finish(cvi, cvv, cv_scr, lane, cv_gw + (cvk - 1) * cv_ngw < CV_NMI); }
#undef CV_SLOT
    if (MODE == 0) { ML_LAUNDER();
        f32x4* sp = (f32x4*)(STB + (size_t)(slot0 + 7) * ML_STATE_BYTES) + wave * 576 + lane;
#pragma unroll
        for (int i = 0; i < 9; ++i) sp[64 * i] = cacc[i];
        if (tid == 0) MST[slot0 + 7] = m_st; }
#undef ML_LOAD
#undef ML_LAUNDER
}
constexpr int AT_HIST = 0;
constexpr int AT_HROW = 2049;
constexpr int AT_SEL = 131072 + 256;
constexpr int AT_MROW = 129;
constexpr int AT_SM = AT_SEL + 8448;
constexpr int AT_LUT = AT_SM + 256;
constexpr int AT_SEL2 = AT_LUT + 256;
static_assert(AT_SEL2 + 8448 <= MISC_OFF, "attention LDS map");
__device__ __forceinline__ unsigned score_key(float s) { unsigned u = __float_as_uint(s + 0.0f); return (u & 0x80000000u) ? ~u : (u | 0x80000000u); }
__device__ __forceinline__ unsigned wave_suffix_sum(unsigned v, int lane) {
#define AT_SHL(x_, n_) ((unsigned)__builtin_amdgcn_update_dpp(0, (int)(x_), 0x100 + (n_), 0xF, 0xF, false))
    v += AT_SHL(v, 1); v += AT_SHL(v, 2); v += AT_SHL(v, 4); v += AT_SHL(v, 8);
#undef AT_SHL
    const unsigned t1 = (unsigned)__builtin_amdgcn_readlane((int)v, 16), t2 = (unsigned)__builtin_amdgcn_readlane((int)v, 32), t3 = (unsigned)__builtin_amdgcn_readlane((int)v, 48);
    return v + ((lane < 16) ? (t1 + t2 + t3) : ((lane < 32) ? (t2 + t3) : ((lane < 48) ? t3 : 0u)));
}
template <int NK> __device__ __forceinline__ void at_resolve(const LAS unsigned long long* cand, LAS unsigned* mask, int m, int nd, int lane) {
    unsigned long long cv[NK];
#pragma unroll
    for (int k = 0; k < NK; ++k) { const int i = 64 * k + lane; unsigned long long x = 0ull; if (i < m) x = cand[i]; cv[k] = (i < m) ? ((((x >> 32) & 0xFFFFFull) << 16) | (x & 0xFFFFull)) : 0ull; }
    unsigned long long T = 0ull;
#pragma unroll 1
    for (int bit = 35; bit >= 16; --bit) { const unsigned long long test = T | (1ull << bit); int cge = 0;
#pragma unroll
        for (int k = 0; k < NK; ++k) cge += __popcll(__ballot(cv[k] >= test));
        if (cge >= nd) T = test; }
    int g = 0, t = 0;
#pragma unroll
    for (int k = 0; k < NK; ++k) { g += __popcll(__ballot(cv[k] >= T + 0x10000ull)); t += __popcll(__ballot(cv[k] >= T)); }
    t -= g;
    if (t > nd - g) {
#pragma unroll 1
        for (int bit = 15; bit >= 0; --bit) { const unsigned long long test = T | (1ull << bit); int cge = 0;
#pragma unroll
            for (int k = 0; k < NK; ++k) cge += __popcll(__ballot(cv[k] >= test));
            if (cge >= nd) T = test; } }
#pragma unroll
    for (int k = 0; k < NK; ++k) if (cv[k] >= T && cv[k] != 0ull) { const unsigned key = 0xFFFFu - (unsigned)(cv[k] & 0xFFFFull);
        __hip_atomic_fetch_or(&mask[key >> 5], 1u << (key & 31u), __ATOMIC_RELAXED, __HIP_MEMORY_SCOPE_WORKGROUP); }
}
__device__ __forceinline__ void attn_unit(const Args& a, const Ctx& c, int b, int qt, float cshift) {
    const int tid = c.tid, wave = c.wave; LAS unsigned char* lds = c.lds;
#define AT_LAUNDER() int tv_ = tid; asm volatile("" : "+v"(tv_)); const int lane = tv_ & 63, qi = tv_ & 15, fq = (tv_ >> 4) & 3; (void)lane; (void)qi; (void)fq
    const int q0u = qt * 32, ch = q0u >> 6, n = 64 * (ch + 1), ntiles = n >> 4;
    const size_t tb = (size_t)b * SEQ;
    unsigned char* dout = (unsigned char*)a.out;
    const bf16* AQN = (const bf16*)(dout + DO_AQN); const bf16* KN = (const bf16*)(dout + DO_KN); const bf16* IQR = (const bf16*)(dout + DO_IQR); const bf16* IKR = (const bf16*)(dout + DO_IKR);
    bf16* YATT = (bf16*)(dout + DO_YATT);
    const bf16* VB = proj_tile(a, TL_KV); const bf16* PS = (const bf16*)(dout + DO_SMB);
    LAS unsigned* HIST = (LAS unsigned*)(lds + AT_HIST);
    LAS unsigned long long* CAND = (LAS unsigned long long*)(lds + AT_HIST);
    LAS int* SM = (LAS int*)(lds + AT_SM);
    float* SC = (blockIdx.x < 240) ? (float*)(a.ws + WS_SC) + (size_t)blockIdx.x * (16 * 4096) : (float*)(a.ws + WS_SC2) + (size_t)(blockIdx.x - 240) * (16 * 4096);
#ifndef DBG_REP_DENSE
#define DBG_REP_DENSE 1
#endif
#pragma unroll 1
    for (int rsel = 0; rsel < 2; ++rsel) {
    const int q0 = q0u + 16 * rsel;
    LAS unsigned* MASK = (LAS unsigned*)(lds + (rsel ? AT_SEL2 : AT_SEL));
    if (n > 256) {
        for (int i = tid; i < 8192 + 4; i += 512) ((LAS v4u*)HIST)[i] = (v4u){0u, 0u, 0u, 0u};
        if (tid < 64) SM[tid] = 0;
        for (int i = tid; i < 16 * AT_MROW; i += 512) MASK[i] = 0u;
        bf16x8 qf[8]; float wv[8]; bf16x8 qsh, qsl;
        { AT_LAUNDER();
        const size_t trow = tb + q0 + qi;
#pragma unroll
        for (int h = 0; h < 8; ++h) qf[h] = *(const bf16x8*)(IQR + trow * 256 + h * 32 + 8 * fq);
        { float t8[8]; unpack8(*(const v4u*)(PS + trow * 16), t8);
#pragma unroll
          for (int h = 0; h < 8; ++h) wv[h] = t8[h] * 0.03125f; }
        { float qs[8];
#pragma unroll
          for (int j = 0; j < 8; ++j) qs[j] = 0.f;
#pragma unroll
          for (int h = 0; h < 8; ++h) { float f8[8]; unpack8(__builtin_bit_cast(v4u, qf[h]), f8);
#pragma unroll
            for (int j = 0; j < 8; ++j) qs[j] = __builtin_fmaf(wv[h], f8[j], qs[j]); }
          float hi8[8], lo8[8]; const v4u ph = pack8(qs); unpack8(ph, hi8);
#pragma unroll
          for (int j = 0; j < 8; ++j) lo8[j] = qs[j] - hi8[j];
          qsh = __builtin_bit_cast(bf16x8, ph); qsl = __builtin_bit_cast(bf16x8, pack8(lo8)); } }
        __syncthreads();
#define AT_LOADK(kt_) (*(const bf16x8*)(IKR + (tb + (size_t)(kt_) * 16 + qi) * 32 + 8 * fq))
#define AT_SCORES(kf_, sc_) do { \
        { const f32x4 l0_ = MFMA16(kf_, qsl, ((f32x4){0.f, 0.f, 0.f, 0.f})); const f32x4 l1_ = MFMA16(kf_, qsh, l0_); \
          _Pragma("unroll") for (int r_ = 0; r_ < 4; ++r_) sc_[r_] = l1_[r_]; } \
        _Pragma("unroll") for (int h_ = 0; h_ < 8; ++h_) { const f32x4 d_ = MFMA16(kf_, qf[h_], ((f32x4){0.f, 0.f, 0.f, 0.f})); \
            _Pragma("unroll") for (int r_ = 0; r_ < 4; ++r_) { sc_[r_] = __builtin_fmaf(wv[h_], __builtin_fabsf(d_[r_]), sc_[r_]); asm("" : "+v"(sc_[r_])); } } } while (0)
        const int cnt = (ntiles - wave + 7) >> 3;
#ifndef DBG_RA
#define DBG_RA 1
#endif
#pragma unroll 1
        for (int rA = 0; rA < DBG_RA; ++rA) { if (rA) { for (int i = tid; i < 8192 + 4; i += 512) ((LAS v4u*)HIST)[i] = (v4u){0u, 0u, 0u, 0u}; __syncthreads(); }
#define AT_LOADG(dst_, i0_) do { _Pragma("unroll") for (int j_ = 0; j_ < 8; ++j_) { int kt_ = wave + 8 * ((i0_) + j_); kt_ = kt_ < ntiles ? kt_ : ntiles - 1; dst_[j_] = AT_LOADK(kt_); } } while (0)
#define AT_P1GROUP(buf_, base_) do { _Pragma("unroll") for (int j2 = 0; j2 < 8; ++j2) { const bool valid = ((base_) + j2 < cnt); const int kt = wave + 8 * ((base_) + j2); float sc[4]; AT_SCORES(buf_[j2], sc); \
                if (valid) *(f32x4*)(SC + qi * 4096 + kt * 16 + 4 * fq) = (f32x4){sc[0], sc[1], sc[2], sc[3]}; \
                _Pragma("unroll") for (int r = 0; r < 4; ++r) { const unsigned bin = score_key(sc[r]) >> 20; \
                    __hip_atomic_fetch_add(&HIST[qi * AT_HROW + (bin >> 1)], valid ? (1u << ((bin & 1u) * 16)) : 0u, __ATOMIC_RELAXED, __HIP_MEMORY_SCOPE_WORKGROUP); } } } while (0)
        { AT_LAUNDER(); bf16x8 ka[8], kb[8]; AT_LOADG(ka, 0);
#pragma unroll 1
          for (int i0 = 0; i0 < cnt; i0 += 16) {
            AT_LOADG(kb, i0 + 8);
            AT_P1GROUP(ka, i0);
            AT_LOADG(ka, i0 + 16);
            AT_P1GROUP(kb, i0 + 8); } }
#undef AT_P1GROUP
        __syncthreads();
        }
#ifndef DBG_RB
#define DBG_RB 1
#endif
#pragma unroll 1
        for (int rB = 0; rB < DBG_RB; ++rB) {
#pragma unroll 1
        for (int j = 0; j < 2; ++j) { AT_LAUNDER(); const int q = 2 * wave + j; unsigned tot = 0;
            for (int i = 0; i < 32; ++i) { const unsigned w = HIST[q * AT_HROW + 32 * lane + ((i + lane) & 31)]; tot += (w & 0xffffu) + (w >> 16); }
            const unsigned suf = wave_suffix_sum(tot, lane);
            const unsigned long long mk = __ballot(suf >= 256u); const int L = 63 - __clzll((long long)mk);
            const unsigned above_L = (unsigned)__builtin_amdgcn_readlane((int)(suf - tot), L);
            const unsigned w2 = HIST[q * AT_HROW + 32 * L + (lane >> 1)]; const unsigned cb = (lane & 1) ? (w2 >> 16) : (w2 & 0xffffu);
            const unsigned sfx = wave_suffix_sum(cb, lane);
            const unsigned long long mk2 = __ballot(above_L + sfx >= 256u); const int l2 = 63 - __clzll((long long)mk2);
            if (lane == l2) { SM[q] = 64 * L + l2; SM[16 + q] = (int)(256u - (above_L + sfx - cb)); } }
        __syncthreads();
        }
#ifndef DBG_RC
#define DBG_RC 1
#endif
#pragma unroll 1
        for (int rC = 0; rC < DBG_RC; ++rC) { if (rC) { if (tid < 16) SM[48 + tid] = 0; __syncthreads(); }
        { AT_LAUNDER(); const int Bq = SM[qi]; f32x4 scur[8];
#define AT_LOADS(dst_, i0_) do { _Pragma("unroll") for (int j_ = 0; j_ < 8; ++j_) { int kt_ = wave + 8 * ((i0_) + j_); kt_ = kt_ < ntiles ? kt_ : ntiles - 1; dst_[j_] = *(const f32x4*)(SC + qi * 4096 + kt_ * 16 + 4 * fq); } } while (0)
#define AT_P2GROUP(buf_, base_) do { _Pragma("unroll") for (int j2 = 0; j2 < 8; ++j2) { const bool valid = ((base_) + j2 < cnt); const int kt = wave + 8 * ((base_) + j2); \
                unsigned nib = 0u, cnib = 0u; unsigned uu[4]; \
                _Pragma("unroll") for (int r = 0; r < 4; ++r) { uu[r] = score_key(buf_[j2][r]); const int bin = (int)(uu[r] >> 20); nib |= (bin > Bq) ? (1u << r) : 0u; cnib |= (bin == Bq) ? (1u << r) : 0u; } \
                if (!valid) { nib = 0u; cnib = 0u; } \
                if (cnib) { int p = __hip_atomic_fetch_add(&SM[48 + qi], (int)__popc(cnib), __ATOMIC_RELAXED, __HIP_MEMORY_SCOPE_WORKGROUP); \
                    _Pragma("unroll") for (int r = 0; r < 4; ++r) if ((cnib >> r) & 1u) { if (p < 512) CAND[qi * 1024 + p] = ((unsigned long long)uu[r] << 32) | (unsigned long long)(0xFFFFu - (unsigned)(kt * 16 + 4 * fq + r)); ++p; } } \
                if (nib) __hip_atomic_fetch_or(&MASK[qi * AT_MROW + (kt >> 1)], nib << (16 * (kt & 1) + 4 * fq), __ATOMIC_RELAXED, __HIP_MEMORY_SCOPE_WORKGROUP); } } while (0)
          f32x4 sb2[8];
          AT_LOADS(scur, 0);
#pragma unroll 1
          for (int i0 = 0; i0 < cnt; i0 += 16) {
            AT_LOADS(sb2, i0 + 8);
            AT_P2GROUP(scur, i0);
            AT_LOADS(scur, i0 + 16);
            AT_P2GROUP(sb2, i0 + 8); } }
#undef AT_P2GROUP
#undef AT_LOADS
        __syncthreads();
        }
#ifndef DBG_RD
#define DBG_RD 1
#endif
#pragma unroll 1
        for (int rD = 0; rD < DBG_RD; ++rD) {
#pragma unroll 1
        for (int j = 0; j < 2; ++j) { AT_LAUNDER(); const int q = 2 * wave + j; int m = SM[48 + q]; m = m < 512 ? m : 512; const int nd = SM[16 + q];
            if (m <= 256) at_resolve<4>(CAND + q * 1024, MASK + q * AT_MROW, m, nd, lane); else at_resolve<8>(CAND + q * 1024, MASK + q * AT_MROW, m, nd, lane); }
        __syncthreads();
        }
#undef AT_SCORES
#undef AT_LOADK
#undef AT_LOADG
    } else {
#pragma unroll 1
        for (int i = tid; i < 16 * AT_MROW; i += 512) MASK[i] = ((i % AT_MROW) < (n >> 5)) ? 0xFFFFFFFFu : 0u;
        __syncthreads();
    }
    }
#pragma unroll 1
    for (int rden = 0; rden < DBG_REP_DENSE; ++rden) {
    { const int g = wave >> 2, qh = (wave >> 1) & 1, hp = wave & 1, NS = n >> 6;
      const unsigned ring0 = (unsigned)(size_t)(lds + AT_HIST);
      if (tid < 64) *(LAS float*)(lds + AT_LUT + 4 * tid) = ((tid >> 2) >> (tid & 3)) & 1 ? -cshift : -1.0e30f;
      const bf16* dsrc[4]; unsigned ddst[4];
      { AT_LAUNDER();
#pragma unroll
        for (int i_ = 0; i_ < 4; ++i_) { const int in_ = 4 * wave + i_; const int row_ = 4 * (in_ & 15) + (lane >> 4), pos_ = lane & 15;
            dsrc[i_] = (in_ < 16) ? (KN + (tb + row_) * 128 + ((pos_ ^ (row_ & 15)) << 3)) : (VB + (tb + row_) * 256 + 128 + ((pos_ ^ (2 * (row_ & 7))) << 3));
            ddst[i_] = (unsigned)(in_ * 1024); } }
      const size_t dstep = (wave < 4) ? (size_t)64 * 128 : (size_t)64 * 256;
#define AT_STAGE(s_) do { const unsigned sb_ = ring0 + (unsigned)(((s_) & 3) * 32768); \
        _Pragma("unroll") for (int i_ = 0; i_ < 4; ++i_) { const bf16* src_ = dsrc[i_] + (size_t)(s_) * dstep; \
            const unsigned dst_ = __builtin_amdgcn_readfirstlane(sb_ + ddst[i_]); unsigned keep_; \
            asm volatile("s_mov_b32 %0, m0\n\ts_mov_b32 m0, %2\n\ts_nop 0\n\tglobal_load_lds_dwordx4 %1, off\n\ts_mov_b32 m0, %0" : "=&s"(keep_) : "v"(src_), "s"(dst_) : "memory"); } } while (0)
      bf16x8 qa[2], qb[2]; f32x4 oacc[2][4], lacc[2];
      { AT_LAUNDER();
#pragma unroll
        for (int hi = 0; hi < 2; ++hi) { const bf16* qp = AQN + (tb + q0u + 16 * qh + qi) * 512 + (g * 4 + 2 * hp + hi) * 64 + 8 * fq; qa[hi] = *(const bf16x8*)qp; qb[hi] = *(const bf16x8*)(qp + 32); } }
#pragma unroll
      for (int hi = 0; hi < 2; ++hi) { lacc[hi] = (f32x4){0.f, 0.f, 0.f, 0.f};
#pragma unroll
        for (int dt = 0; dt < 4; ++dt) oacc[hi][dt] = (f32x4){0.f, 0.f, 0.f, 0.f}; }
      const bf16x8 ones = (bf16x8){0x3F80, 0x3F80, 0x3F80, 0x3F80, 0x3F80, 0x3F80, 0x3F80, 0x3F80};
      asm volatile("s_waitcnt vmcnt(0)" ::: "memory");
#pragma unroll 1
      for (int s = 0; s < 3 && s < NS; ++s) AT_STAGE(s);
      typedef short s4_t __attribute__((ext_vector_type(4)));
      AT_LAUNDER();
      const LAS unsigned* mrow = (const LAS unsigned*)(lds + (qh ? AT_SEL2 : AT_SEL)) + qi * AT_MROW;
      const unsigned koff0 = (unsigned)(qi * 256 + (((g * 8 + fq) ^ qi) << 4)), koff1 = (unsigned)(qi * 256 + (((g * 8 + 4 + fq) ^ qi) << 4));
#define AT_LDK(kf_, ci_, slot_, tp_, mw_) do { const LAS unsigned char* kb_ = lds + AT_HIST + (slot_) * 32768 + (tp_) * 8192; \
          _Pragma("unroll") for (int t = 0; t < 2; ++t) { kf_[t][0] = *(const LAS bf16x8*)(kb_ + t * 4096 + koff0); kf_[t][1] = *(const LAS bf16x8*)(kb_ + t * 4096 + koff1); \
              ci_[t] = *(const LAS f32x4*)(lds + AT_LUT + ((((mw_) >> (16 * t + 4 * fq)) & 15u) << 4)); } } while (0)
#define AT_LDV(va_, slot_, vkh_) do { const LAS unsigned char* vb_ = lds + AT_HIST + (slot_) * 32768 + 16384 + (vkh_) * 8192; \
          _Pragma("unroll") for (int dt = 0; dt < 4; ++dt) { const int r1 = 4 * fq + (qi >> 2); const int ch_ = g * 8 + 2 * dt + ((lane & 3) >> 1); \
              const s4_t lo = __builtin_amdgcn_ds_read_tr16_b64_v4i16((LAS s4_t*)(vb_ + r1 * 256 + ((ch_ ^ (2 * (r1 & 7))) << 4) + (lane & 1) * 8)); \
              const s4_t hi4 = __builtin_amdgcn_ds_read_tr16_b64_v4i16((LAS s4_t*)(vb_ + (r1 + 16) * 256 + ((ch_ ^ (2 * (r1 & 7))) << 4) + (lane & 1) * 8)); \
              va_[dt] = (bf16x8){lo[0], lo[1], lo[2], lo[3], hi4[0], hi4[1], hi4[2], hi4[3]}; } } while (0)
#define AT_QKM(dst_, kf_, ci_) do { \
          _Pragma("unroll") for (int t = 0; t < 2; ++t) { \
              _Pragma("unroll") for (int hi = 0; hi < 2; ++hi) { const f32x4 d_ = MFMA16(kf_[t][0], qa[hi], ci_[t]); dst_[hi][t] = MFMA16(kf_[t][1], qb[hi], d_); } } } while (0)
#define AT_EXP(pb_, cur_) do { \
          _Pragma("unroll") for (int hi = 0; hi < 2; ++hi) { float pv[8]; \
              _Pragma("unroll") for (int j = 0; j < 8; ++j) pv[j] = __builtin_amdgcn_exp2f(cur_[hi][j >> 2][j & 3]); \
              v4u pw; pw.x = pk2(pv[0], pv[1]); pw.y = pk2(pv[2], pv[3]); pw.z = pk2(pv[4], pv[5]); pw.w = pk2(pv[6], pv[7]); pb_[hi] = __builtin_bit_cast(bf16x8, pw); } } while (0)
#define AT_PV(pb_, va_) do { \
          _Pragma("unroll") for (int hi = 0; hi < 2; ++hi) lacc[hi] = MFMA16(ones, pb_[hi], lacc[hi]); \
          _Pragma("unroll") for (int dt = 0; dt < 4; ++dt) { \
              _Pragma("unroll") for (int hi = 0; hi < 2; ++hi) oacc[hi][dt] = MFMA16(va_[dt], pb_[hi], oacc[hi][dt]); } } while (0)
      f32x4 st0[2][2], st1[2][2]; bf16x8 kfA[2][2], kfB[2][2]; f32x4 ciA[2], ciB[2]; bf16x8 vaP[4], vaQ[4], pbP[2], pbQ[2];
      if (NS >= 3) asm volatile("s_waitcnt vmcnt(8)" ::: "memory"); else asm volatile("s_waitcnt vmcnt(0)" ::: "memory");
      __builtin_amdgcn_s_barrier(); asm volatile("" ::: "memory");
      unsigned m1A, m1B;
      { const unsigned m0A = mrow[0], m0B = mrow[1]; const int sx = (NS > 1) ? 1 : 0; m1A = mrow[2 * sx]; m1B = mrow[2 * sx + 1];
        AT_LDK(kfB, ciB, 0, 0, m0A); AT_LDK(kfA, ciA, 0, 1, m0B);
        AT_QKM(st0, kfB, ciB);
#pragma unroll
        for (int hi = 0; hi < 2; ++hi) pbP[hi] = (bf16x8){0, 0, 0, 0, 0, 0, 0, 0};
#pragma unroll
        for (int dt = 0; dt < 4; ++dt) vaP[dt] = (bf16x8){0, 0, 0, 0, 0, 0, 0, 0}; }
#pragma unroll 1
      for (int s = 0; s < NS; ++s) {
          if (s + 2 < NS) asm volatile("s_waitcnt vmcnt(4)" ::: "memory"); else asm volatile("s_waitcnt vmcnt(0)" ::: "memory");
          __builtin_amdgcn_s_barrier(); asm volatile("" ::: "memory");
          if (s + 3 < NS) AT_STAGE(s + 3);
          const int s1 = (s + 1 < NS) ? s + 1 : s, s2 = (s + 2 < NS) ? s + 2 : NS - 1;
          const unsigned m2A = mrow[2 * s2], m2B = mrow[2 * s2 + 1];
          AT_LDK(kfB, ciB, (s1 & 3), 0, m1A); AT_LDV(vaQ, (s & 3), 0);
          AT_QKM(st1, kfA, ciA); AT_EXP(pbQ, st0); AT_PV(pbP, vaP);
          __builtin_amdgcn_sched_barrier(0);
          AT_LDK(kfA, ciA, (s1 & 3), 1, m1B); AT_LDV(vaP, (s & 3), 1);
          AT_QKM(st0, kfB, ciB); AT_EXP(pbP, st1); AT_PV(pbQ, vaQ);
          __builtin_amdgcn_sched_barrier(0);
          m1A = m2A; m1B = m2B; }
      AT_PV(pbP, vaP);
#undef AT_LDK
#undef AT_LDV
#undef AT_QKM
#undef AT_EXP
#undef AT_PV
      { AT_LAUNDER();
#pragma unroll
        for (int hi = 0; hi < 2; ++hi) { const float inv = 1.0f / lacc[hi][0];
            bf16* yp = YATT + (tb + q0u + 16 * qh + qi) * 512 + (g * 4 + 2 * hp + hi) * 64 + 4 * fq;
#pragma unroll
            for (int dt = 0; dt < 4; ++dt) { const f32x4 o = oacc[hi][dt];
                v2u w; w.x = pk2(o[0] * inv, o[1] * inv); w.y = pk2(o[2] * inv, o[3] * inv); *(v2u*)(yp + 16 * dt) = w; } } }
#undef AT_STAGE
    }
    __syncthreads();
    }
#undef AT_LAUNDER
    __syncthreads();
}

#ifndef DBG_REP_ML
#define DBG_REP_ML 1
#endif
#ifndef DBG_REP_ATT
#define DBG_REP_ATT 1
#endif
__device__ __forceinline__ void p3_mixer(const Args& a, const Ctx& c, volatile LAS unsigned* MISC, int rep) {
#if !defined(NO_MLSTM)
#pragma unroll 1
    for (int rr = 0; rr < DBG_REP_ML; ++rr)
#pragma unroll 1
        for (int u = blockIdx.x; u < 32; u += c.G) mlstm_unit<0>(a, c, u >> 2, u & 3, 0);
#endif
    unsigned* ctl = (unsigned*)(a.ws + WS_CTL);
    const int x = (int)(__builtin_amdgcn_s_getreg((3 << 11) | 20) & 7u);
    float cshift;
    { float gq = fabsf(a.in[IN_GQ][c.lane]), gk = fabsf(a.in[IN_GK][c.lane]);
#pragma unroll
      for (int o = 1; o < 64; o <<= 1) { gq = fmaxf(gq, __shfl_xor(gq, o)); gk = fmaxf(gk, __shfl_xor(gk, o)); }
      cshift = 8.0f * 1.4426950408889634f * gq * gk; }
#pragma unroll 1
    for (int rot = 0; rot < 8 * DBG_REP_ATT; ++rot) { rep = rot >> 3; const int bq = (x + rot) & 7;
        if (c.tid == 0) MISC[16] = __hip_atomic_fetch_add(ctl + CW_Q + 512 * rep + 64 * bq, 1u, RLX_AGENT);
        __syncthreads();
        int u = (int)MISC[16];
        __syncthreads();
#pragma unroll 1
        while (u < 128) {
            unsigned nxt = 0u;
            if (c.tid == 0) nxt = __hip_atomic_fetch_add(ctl + CW_Q + 512 * rep + 64 * bq, 1u, RLX_AGENT);
#if !defined(NO_ATTN)
            attn_unit(a, c, bq, 127 - u, cshift);
#endif
            if (c.tid == 0) MISC[16] = nxt;
            __syncthreads();
            u = (int)MISC[16];
            __syncthreads();
        } }
}
constexpr int RT_WT = 0;
constexpr int RT_WROW = 1028;
constexpr int RT_LG = 36 * RT_WROW * 4;
constexpr int RT_RSTD = RT_LG + 64 * 36 * 4;
constexpr int RT_LCNT = RT_RSTD + 512;
static_assert(RT_LCNT + 128 <= MISC_OFF, "router LDS map");
__device__ __forceinline__ void p6_router(const Args& a, const Ctx& c) {
    const int tid = c.tid, lane = c.lane, wave = c.wave; LAS unsigned char* lds = c.lds;
    LAS float* WT = (LAS float*)(lds + RT_WT); LAS float* LG = (LAS float*)(lds + RT_LG); LAS float* RSTD = (LAS float*)(lds + RT_RSTD); LAS int* LCNT = (LAS int*)(lds + RT_LCNT);
    { int* RT = (int*)(a.ws + WS_ROWTOK); for (int i = blockIdx.x * 512 + tid; i < NROWS_MAX; i += c.G * 512) RT[i] = 0; }
    { const f32x4* src = (const f32x4*)(a.ws + WS_WTG); LAS f32x4* dst = (LAS f32x4*)WT; for (int i = tid; i < 36 * RT_WROW / 4; i += 512) dst[i] = src[i]; }
    f32x4 gv[4];
#pragma unroll
    for (int j = 0; j < 4; ++j) gv[j] = *(const f32x4*)(a.in[IN_GMOE] + 4 * lane + 256 * j);
    const float* X1 = a.out; bf16* XN = (bf16*)(a.ws + WS_XN);
    int* TOKE = (int*)(a.ws + WS_TOKE); int* TOKR = (int*)(a.ws + WS_TOKR); float* TOKG = (float*)(a.ws + WS_TOKG); int* CNT = (int*)(a.ws + WS_CNT);
    __syncthreads();
    for (int blk = blockIdx.x; blk < 256; blk += c.G) {
        if (tid < 32) LCNT[tid] = 0;
#pragma unroll 1
        for (int ri = 0; ri < 16; ri += 2) { const int tA = blk * 128 + wave * 16 + ri, tB = tA + 1;
            const f32x4* xa = (const f32x4*)(X1 + (size_t)tA * D) + lane; const f32x4* xb = (const f32x4*)(X1 + (size_t)tB * D) + lane;
            f32x4 va[4], vb[4]; float sa = 0.f, sb = 0.f;
#pragma unroll
            for (int j = 0; j < 4; ++j) { va[j] = xa[64 * j]; vb[j] = xb[64 * j]; }
#pragma unroll
            for (int j = 0; j < 4; ++j) { sa += (va[j].x * va[j].x + va[j].y * va[j].y) + (va[j].z * va[j].z + va[j].w * va[j].w); sb += (vb[j].x * vb[j].x + vb[j].y * vb[j].y) + (vb[j].z * vb[j].z + vb[j].w * vb[j].w); }
            const float ra = rsqrtf(wave_sum(sa) * (1.f / D) + EPS), rb = rsqrtf(wave_sum(sb) * (1.f / D) + EPS);
            if (lane == 0) { RSTD[wave * 16 + ri] = ra; RSTD[wave * 16 + ri + 1] = rb; }
            v2u* oa = (v2u*)(XN + (size_t)tA * D) + lane; v2u* ob = (v2u*)(XN + (size_t)tB * D) + lane;
#pragma unroll
            for (int j = 0; j < 4; ++j) { v2u w; w.x = pk2(va[j].x * ra * gv[j].x, va[j].y * ra * gv[j].y); w.y = pk2(va[j].z * ra * gv[j].z, va[j].w * ra * gv[j].w); oa[64 * j] = w;
                v2u u; u.x = pk2(vb[j].x * rb * gv[j].x, vb[j].y * rb * gv[j].y); u.y = pk2(vb[j].z * rb * gv[j].z, vb[j].w * rb * gv[j].w); ob[64 * j] = u; } }
        f32x4 acc[3];
#pragma unroll
        for (int ct = 0; ct < 3; ++ct) acc[ct] = (f32x4){0.f, 0.f, 0.f, 0.f};
        { const int row = lane & 15, kq = lane >> 4;
          const f32x4* ap = (const f32x4*)(X1 + (size_t)(blk * 128 + wave * 16 + row) * D + 4 * kq);
          int cj[3]; cj[0] = row; cj[1] = 16 + row; cj[2] = (32 + row) < 36 ? (32 + row) : 35;
          const LAS f32x4* bp0 = (const LAS f32x4*)(WT + cj[0] * RT_WROW + 4 * kq); const LAS f32x4* bp1 = (const LAS f32x4*)(WT + cj[1] * RT_WROW + 4 * kq); const LAS f32x4* bp2 = (const LAS f32x4*)(WT + cj[2] * RT_WROW + 4 * kq);
#define RT_LOADA(dst_, b_) do { _Pragma("unroll") for (int i_ = 0; i_ < 8; ++i_) dst_[i_] = ap[4 * (8 * ((b_) < 8 ? (b_) : 7) + i_)]; } while (0)
#define RT_MMA(src_, b_) do { _Pragma("unroll") for (int i_ = 0; i_ < 8; ++i_) { const int ks_ = 8 * (b_) + i_; const f32x4 b0 = bp0[4 * ks_], b1 = bp1[4 * ks_], b2 = bp2[4 * ks_]; \
              _Pragma("unroll") for (int j = 0; j < 4; ++j) { acc[0] = __builtin_amdgcn_mfma_f32_16x16x4f32(src_[i_][j], b0[j], acc[0], 0, 0, 0); acc[1] = __builtin_amdgcn_mfma_f32_16x16x4f32(src_[i_][j], b1[j], acc[1], 0, 0, 0); \
                  acc[2] = __builtin_amdgcn_mfma_f32_16x16x4f32(src_[i_][j], b2[j], acc[2], 0, 0, 0); } } } while (0)
          f32x4 aA[8], aB[8]; RT_LOADA(aA, 0);
#pragma unroll 1
          for (int bb = 0; bb < 8; bb += 2) { RT_LOADA(aB, bb + 1); RT_MMA(aA, bb); RT_LOADA(aA, bb + 2); RT_MMA(aB, bb + 1); }
#undef RT_LOADA
#undef RT_MMA
        }
#pragma unroll 1
        for (int half = 0; half < 2; ++half) {
            __syncthreads();
            if ((wave >> 2) == half) { const int col = lane & 15, kq = lane >> 4;
#pragma unroll
                for (int ct = 0; ct < 3; ++ct) if (16 * ct + col < 36) {
#pragma unroll
                    for (int r = 0; r < 4; ++r) LG[((wave & 3) * 16 + 4 * kq + r) * 36 + 16 * ct + col] = acc[ct][r]; } }
            __syncthreads();
            if (tid < 64) { const int row = half * 64 + tid, t = blk * 128 + row; const float rs = RSTD[row]; const LAS float* lg = LG + tid * 36;
                float gl[4];
#pragma unroll
                for (int i = 0; i < 4; ++i) gl[i] = rs * lg[32 + i] + a.in[IN_BRG][i];
                int gs = 0; float gmax = gl[0];
#pragma unroll
                for (int i = 1; i < 4; ++i) if (gl[i] > gmax) { gmax = gl[i]; gs = i; }
                float gsum = 0.f;
#pragma unroll
                for (int i = 0; i < 4; ++i) gsum += expf(gl[i] - gmax);
                const float gtop = 1.0f / gsum;
                float ev[8];
#pragma unroll
                for (int i = 0; i < 8; ++i) ev[i] = rs * lg[gs * 8 + i] + a.in[IN_BRE][gs * 8 + i];
                int l0 = 0; float v0 = ev[0];
#pragma unroll
                for (int i = 1; i < 8; ++i) if (ev[i] > v0) { v0 = ev[i]; l0 = i; }
                int l1 = -1; float v1 = -3.0e38f;
#pragma unroll
                for (int i = 0; i < 8; ++i) if (i != l0 && ev[i] > v1) { v1 = ev[i]; l1 = i; }
                const float e1 = expf(v1 - v0), s0 = 1.0f / (1.0f + e1), s1 = e1 * s0;
                const int ex0 = gs * 8 + l0, ex1 = gs * 8 + l1;
                const int rk0 = __hip_atomic_fetch_add(&LCNT[ex0], 1, __ATOMIC_RELAXED, __HIP_MEMORY_SCOPE_WORKGROUP);
                const int rk1 = __hip_atomic_fetch_add(&LCNT[ex1], 1, __ATOMIC_RELAXED, __HIP_MEMORY_SCOPE_WORKGROUP);
                TOKE[2 * t] = ex0; TOKE[2 * t + 1] = ex1; TOKR[2 * t] = rk0; TOKR[2 * t + 1] = rk1; TOKG[2 * t] = s0 * gtop; TOKG[2 * t + 1] = s1 * gtop; }
        }
        __syncthreads();
        if (tid < 32) CNT[blk * 32 + tid] = LCNT[tid];
        __syncthreads();
    }
}
__device__ __forceinline__ void p7_gather(const Args& a, const Ctx& c) {
    const int tid = c.tid, lane = c.lane, wave = c.wave;
    LAS int* PART = (LAS int*)c.lds; LAS int* PPRE = PART + 512; LAS int* TOT = PPRE + 512; LAS int* TS = TOT + 32; LAS int* BASE = TS + 64;
    const int* CNT = (const int*)(a.ws + WS_CNT); const int* TOKE = (const int*)(a.ws + WS_TOKE); const int* TOKR = (const int*)(a.ws + WS_TOKR); int* TOKP = (int*)(a.ws + WS_TOKP);
    int* RT = (int*)(a.ws + WS_ROWTOK);
    { const int e = tid & 31, p = tid >> 5; int s = 0; for (int k = 0; k < 16; ++k) s += CNT[(16 * p + k) * 32 + e]; PART[p * 32 + e] = s; }
    __syncthreads();
    if (tid < 32) { int run = 0; for (int p = 0; p < 16; ++p) { PPRE[p * 32 + tid] = run; run += PART[p * 32 + tid]; } TOT[tid] = run; }
    __syncthreads();
    if (tid == 0) { int ts = 0; for (int e = 0; e < 32; ++e) { TS[e] = ts; ts += (TOT[e] + 255) >> 8; } TS[32] = ts; }
    __syncthreads();
    if (blockIdx.x == 0 && tid < 33) ((int*)(a.ws + WS_SMALL))[tid] = TS[tid];
    for (int blk = blockIdx.x; blk < 256; blk += c.G) {
        if (tid < 32) { int s = TS[tid] * 256 + PPRE[(blk >> 4) * 32 + tid]; for (int b2 = (blk & ~15); b2 < blk; ++b2) s += CNT[b2 * 32 + tid]; BASE[tid] = s; }
        __syncthreads();
        { const int t = blk * 128 + (tid >> 2), jj = tid & 3;
          if (jj < 2) { const int pos = BASE[TOKE[2 * t + jj]] + TOKR[2 * t + jj]; TOKP[2 * t + jj] = pos; RT[pos] = t; } }
        __syncthreads();
    }
}
__device__ __forceinline__ void p10_combine(const Args& a, const Ctx& c) {
    const int lane = c.lane, gw = c.vcu * NWAVES + c.wave, NGW = c.G * NWAVES;
    const int* TOKP = (const int*)(a.ws + WS_TOKP); const float* TOKG = (const float*)(a.ws + WS_TOKG); const bf16* Y = (const bf16*)(a.ws + WS_Y);
    for (int t0 = gw; t0 < T; t0 += 2 * NGW) {
        const int tA = t0, tB = (t0 + NGW < T) ? t0 + NGW : t0; const bool hasB = (t0 + NGW < T);
        const int pA0 = TOKP[2 * tA], pA1 = TOKP[2 * tA + 1], pB0 = TOKP[2 * tB], pB1 = TOKP[2 * tB + 1];
        const float gA0 = TOKG[2 * tA], gA1 = TOKG[2 * tA + 1], gB0 = TOKG[2 * tB], gB1 = TOKG[2 * tB + 1];
        f32x4 xa[4], xb[4]; v2u ya0[4], ya1[4], yb0[4], yb1[4];
#pragma unroll
        for (int j = 0; j < 4; ++j) { const int cc = 4 * lane + 256 * j;
            xa[j] = *(const f32x4*)(a.out + (size_t)tA * D + cc); xb[j] = *(const f32x4*)(a.out + (size_t)tB * D + cc);
            ya0[j] = *(const v2u*)(Y + (size_t)pA0 * D + cc); ya1[j] = *(const v2u*)(Y + (size_t)pA1 * D + cc);
            yb0[j] = *(const v2u*)(Y + (size_t)pB0 * D + cc); yb1[j] = *(const v2u*)(Y + (size_t)pB1 * D + cc); }
#pragma unroll
        for (int j = 0; j < 4; ++j) { const int cc = 4 * lane + 256 * j; f32x4 x = xa[j];
            x[0] += gA0 * bf2f(ya0[j].x & 0xffffu) + gA1 * bf2f(ya1[j].x & 0xffffu); x[1] += gA0 * bf2f(ya0[j].x >> 16) + gA1 * bf2f(ya1[j].x >> 16);
            x[2] += gA0 * bf2f(ya0[j].y & 0xffffu) + gA1 * bf2f(ya1[j].y & 0xffffu); x[3] += gA0 * bf2f(ya0[j].y >> 16) + gA1 * bf2f(ya1[j].y >> 16);
            *(f32x4*)(a.out + (size_t)tA * D + cc) = x; }
        if (hasB) {
#pragma unroll
        for (int j = 0; j < 4; ++j) { const int cc = 4 * lane + 256 * j; f32x4 x = xb[j];
            x[0] += gB0 * bf2f(yb0[j].x & 0xffffu) + gB1 * bf2f(yb1[j].x & 0xffffu); x[1] += gB0 * bf2f(yb0[j].x >> 16) + gB1 * bf2f(yb1[j].x >> 16);
            x[2] += gB0 * bf2f(yb0[j].y & 0xffffu) + gB1 * bf2f(yb1[j].y & 0xffffu); x[3] += gB0 * bf2f(yb0[j].y >> 16) + gB1 * bf2f(yb1[j].y >> 16);
            *(f32x4*)(a.out + (size_t)tB * D + cc) = x; } }
    }
}
__global__ void __launch_bounds__(NWAVES * 64, 2) hybrid_fwd(Args args) {
    extern __shared__ __attribute__((aligned(16))) unsigned char lds_raw[];
    Ctx c; c.lds = (LAS unsigned char*)lds_raw;
    volatile LAS unsigned* MISC = (volatile LAS unsigned*)(c.lds + MISC_OFF);
    c.tid = threadIdx.x; c.lane = c.tid & 63; c.wave = __builtin_amdgcn_readfirstlane(c.tid >> 6);
    c.G = gridDim.x; { const int bx = blockIdx.x; c.vcu = (c.G % 8 == 0) ? (bx % 8) * (c.G / 8) + bx / 8 : bx; }
    unsigned* ctl = (unsigned*)(args.ws + WS_CTL);
    if (c.tid < 128) MISC[c.tid] = 0u;
    __syncthreads();
    XcdBarrier bar; bar.bar = ctl + CW_BAR; bar.x = 0; bar.st = nullptr;
    if (N_LAUNCHES == 1) bar = xcd_barrier_post(ctl + CW_BAR, MISC + 8);
#define GRID_BAR() do { if (N_LAUNCHES == 1) xcd_barrier(bar); } while (0)
    const int lo = args.ph_lo, hi = args.ph_hi;
#ifndef PH_MASK
#define PH_MASK 0xfff
#endif
#define IN(k) (((PH_MASK >> (k)) & 1) && lo <= (k) && (k) < hi)
#define BOTH(k) (IN(k) && IN((k) + 1))
    unsigned char* ws = args.ws; unsigned char* dout = (unsigned char*)args.out;
#ifndef DBG_REPEAT
#define DBG_REPEAT -1
#endif
#define REPS(k) (((k) == DBG_REPEAT) ? 2 : 1)
    if (IN(0)) { _Pragma("unroll") for (int rep = 0; rep < REPS(0); ++rep) { if (rep) GRID_BAR(); p0_prologue<0>(args, c, c.vcu * NWAVES + c.wave, c.G * NWAVES); } if (BOTH(0)) GRID_BAR(); }
    if (IN(1)) { _Pragma("unroll") for (int rep = 0; rep < REPS(1); ++rep) { if (rep) GRID_BAR();
#ifdef DBG_STAGGER
        if ((blockIdx.x >> 3) & 1) { const unsigned long long t0 = wall_clock64(); while (wall_clock64() - t0 < (unsigned long long)DBG_STAGGER) __builtin_amdgcn_s_sleep(16); }
#endif
        pg8::Gemm g{(const pg8::bf16_t*)(dout + DO_H), (const pg8::bf16_t*)(ws + WS_WIN), T, NPROJ, D}; pg8::StaticOrder S; S.init(T, NPROJ, c.G, (int)blockIdx.x);
        pg8::EpiBf16<0> E{(pg8::bf16_t*)(ws + WS_PROJ), 256, nullptr, 256, (size_t)T * 256, 1.f};
        pg8::gemm_phase<pg8::EpiBf16<0>, pg8::StaticOrder, true, true>(c.lds, g, S, E); }
        if (BOTH(1)) GRID_BAR();
    }
#ifndef DBG_R2
#define DBG_R2 1
#endif
#ifndef DBG_R4A
#define DBG_R4A 1
#endif
#ifndef DBG_R4B
#define DBG_R4B 1
#endif
#ifndef DBG_R7
#define DBG_R7 1
#endif
    if (IN(2)) { _Pragma("unroll 1") for (int rep = 0; rep < DBG_R2; ++rep) { if (rep) GRID_BAR(); p2_prep(args, c); } if (BOTH(2)) GRID_BAR(); }
    if (IN(3)) { _Pragma("unroll") for (int rep = 0; rep < REPS(3); ++rep) { if (rep) GRID_BAR(); p3_mixer(args, c, MISC, rep); } if (BOTH(3)) GRID_BAR(); }
    if (IN(4)) {
#pragma unroll 1
        for (int rep = 0; rep < DBG_R4A; ++rep) {
            const int gw = c.vcu * NWAVES + c.wave, ngw = c.G * NWAVES, kdone = ((int)blockIdx.x < 256) ? 24 : 0;
            LAS float* scr = (LAS float*)(c.lds + CV_SCR + c.wave * CV_SCRW);
#pragma unroll 1
            for (int k = kdone; gw + k * ngw < CV_NMI; ++k) { const CvItem it = cv_item(args, gw + k * ngw); f32x4 v[4]; cv_load(it, v, c.lane); cv_finish(it, v, scr, c.lane, true); }
            __syncthreads(); }
#pragma unroll 1
        for (int rep = 0; rep < DBG_R4B; ++rep)
#pragma unroll 1
        for (int u = blockIdx.x; u < 256; u += c.G) mlstm_unit<1>(args, c, u >> 5, (u >> 3) & 3, u & 7);
        if (BOTH(4)) GRID_BAR();
    }
    if (IN(5)) {
        { pg8::Gemm g{(const pg8::bf16_t*)(dout + DO_YATT), (const pg8::bf16_t*)(ws + WS_WPA), T, D, 512}; pg8::StaticOrder S; S.init(T, D, c.G, (int)blockIdx.x);
          pg8::EpiGate<false> E{(pg8::bf16_t*)(ws + WS_MERGED), D, (const pg8::bf16_t*)(ws + WS_PROJ + (size_t)TL_GA * PROJ_TILE), (size_t)T * 256};
          pg8::gemm_phase<pg8::EpiGate<false>, pg8::StaticOrder, true, true>(c.lds, g, S, E); }
        __syncthreads();
        { pg8::Gemm g{(const pg8::bf16_t*)(dout + DO_YML), (const pg8::bf16_t*)(ws + WS_WPM), T, D, 512}; pg8::StaticOrder S; S.init(T, D, c.G, (int)blockIdx.x);
          pg8::EpiGate<true> E{(pg8::bf16_t*)(ws + WS_MERGED), D, (const pg8::bf16_t*)(ws + WS_PROJ + (size_t)TL_GM * PROJ_TILE), (size_t)T * 256};
          pg8::gemm_phase<pg8::EpiGate<true>, pg8::StaticOrder, true, true>(c.lds, g, S, E); }
        if (BOTH(5)) GRID_BAR();
    }
    if (IN(6)) {
        pg8::Gemm g{(const pg8::bf16_t*)(ws + WS_MERGED), (const pg8::bf16_t*)(ws + WS_WOUT), T, D, D}; pg8::StaticOrder S; S.init(T, D, c.G, (int)blockIdx.x);
        pg8::EpiRes E{args.out, args.in[IN_X], D};
        pg8::gemm_phase<pg8::EpiRes, pg8::StaticOrder, true, true>(c.lds, g, S, E);
        if (BOTH(6)) GRID_BAR();
    }
    if (IN(7)) { _Pragma("unroll 1") for (int rep = 0; rep < DBG_R7; ++rep) { if (rep) { GRID_BAR(); } p6_router(args, c); } if (BOTH(7)) GRID_BAR(); }
    if (IN(8)) { _Pragma("unroll") for (int rep = 0; rep < REPS(8); ++rep) { if (rep) GRID_BAR(); p7_gather(args, c); } if (BOTH(8)) GRID_BAR(); }
    if (IN(9) || IN(10)) {
        LAS int* TSL = (LAS int*)(c.lds + MISC_OFF + 256);
        if (c.tid < 33) TSL[c.tid] = (int)__hip_atomic_load((unsigned*)(ws + WS_SMALL) + c.tid, RLX_AGENT);
        __syncthreads();
        if (IN(9)) {
            pg8::MoeOrder<true> S{TSL, c.G, (int)blockIdx.x, (const int*)(ws + WS_ROWTOK)};
            pg8::Gemm g{(const pg8::bf16_t*)(ws + WS_XN), (const pg8::bf16_t*)(ws + WS_GU), 0, 0, D};
            pg8::EpiSwiGLU E{(pg8::bf16_t*)(ws + WS_HID)};
            pg8::gemm_phase<pg8::EpiSwiGLU, pg8::MoeOrder<true>, true, true>(c.lds, g, S, E);
            if (BOTH(9)) GRID_BAR();
        }
        if (IN(10)) {
            pg8::MoeOrder<false> S{TSL, c.G, (int)blockIdx.x, nullptr};
            pg8::Gemm g{(const pg8::bf16_t*)(ws + WS_HID), (const pg8::bf16_t*)(ws + WS_DN), 0, 0, 512};
            pg8::EpiDown E{(pg8::bf16_t*)(ws + WS_Y)};
            pg8::gemm_phase<pg8::EpiDown, pg8::MoeOrder<false>, true, true>(c.lds, g, S, E);
            if (BOTH(10)) GRID_BAR();
        }
    }
    if (IN(11)) p10_combine(args, c);
#undef IN
#undef BOTH
#undef GRID_BAR
}

extern "C" void kernel_launch(void* const* d_in, const int* in_sizes, int n_in, void* d_out, int out_size, void* d_ws, size_t ws_size, hipStream_t stream) {
    static int grid = 0;
    if (grid == 0) {
        if (n_in != 22 || in_sizes[0] != T * D || out_size != T * D || ws_size < WS_END) { fprintf(stderr, "kernel_launch: unexpected shapes (n_in %d, in0 %d, out %d, ws %zu); nothing launched\n", n_in, n_in > 0 ? in_sizes[0] : -1, out_size, ws_size); grid = -1; return; }
        int dev = 0, cus = 0, per_cu = 0;
        if (hipGetDevice(&dev) != hipSuccess || hipDeviceGetAttribute(&cus, hipDeviceAttributeMultiprocessorCount, dev) != hipSuccess) { grid = -1; return; }
        if (hipFuncSetAttribute((const void*)hybrid_fwd, hipFuncAttributeMaxDynamicSharedMemorySize, LDS_BYTES) != hipSuccess) { fprintf(stderr, "kernel_launch: hipFuncSetAttribute failed\n"); grid = -1; return; }
        if (hipOccupancyMaxActiveBlocksPerMultiprocessor(&per_cu, (const void*)hybrid_fwd, NWAVES * 64, LDS_BYTES) != hipSuccess || per_cu < 1)
            fprintf(stderr, "kernel_launch: note: occupancy query reports %d workgroups per CU\n", per_cu);
        (void)hipGetLastError();
        grid = cus;
    }
    if (grid < 0) return;
    if (hipMemsetAsync((char*)d_ws + WS_CTL, 0, CTL_ZERO_BYTES, stream) != hipSuccess) return;
    Args a{};
    for (int i = 0; i < 22; ++i) a.in[i] = (const float*)d_in[i];
    a.out = (float*)d_out; a.ws = (unsigned char*)d_ws;
    for (int li = 0; li < N_LAUNCHES; ++li) {
        a.ph_lo = (N_LAUNCHES == 1) ? 0 : li; a.ph_hi = (N_LAUNCHES == 1) ? NPH : li + 1; a.li = li;
        hipLaunchKernelGGL(hybrid_fwd, dim3(grid), dim3(NWAVES * 64), LDS_BYTES, stream, a);
        if (hipPeekAtLastError() != hipSuccess) { fprintf(stderr, "kernel_launch: launch %d failed\n", li); break; }
    }
}
```

```cpp
#include <hip/hip_runtime.h>
#include <cstdio>
#include <cstdint>
namespace pg8 {
#define PG8_LAS __attribute__((address_space(3)))
typedef unsigned short bf16_t;
typedef short bf16x8 __attribute__((ext_vector_type(8)));
typedef float f32x4 __attribute__((ext_vector_type(4)));
typedef unsigned u32x4 __attribute__((ext_vector_type(4)));
constexpr int BM = 256, BK = 64, HALF = 128, HTB = HALF * BK * 2  , STAGE_BYTES = 8 * HTB, NXCD = 8, WGM = 8;

__host__ __device__ __forceinline__ int lds_byte(int r, int c) { const int st = (r >> 4) * 2 + (c >> 5), rr = r & 15, cc = c & 31, ob = rr * 64 + cc * 2; return st * 1024 + (ob ^ (((ob >> 9) & 1) << 5)); }
__host__ __device__ __forceinline__ void stage_rc(int b, int& R, int& C) { const int st = b / 1024, sb = b % 1024, swz = sb ^ (((sb >> 9) & 1) << 5); R = (st >> 1) * 16 + swz / 64; C = (st & 1) * 32 + (swz % 64) / 2; }
__host__ __device__ __forceinline__ int perm32(int rho) { const int n = rho >> 4, i = rho & 15; return 8 * (i >> 2) + 4 * n + (i & 3); }

struct Unit { int pm, pn; };
struct Gemm { const bf16_t* A; const bf16_t* Bt; int M, N, K; };

struct StaticOrder {
    static constexpr bool GATHER = false;
    int nM, nN, nwg, G, c;
    __host__ __device__ void init(int M, int N, int G_, int c_) { nM = M / BM; nN = N / BM; nwg = nM * nN; G = G_; c = c_; }
    __host__ __device__ bool next(int i, Unit& u) const {
        const long L = (long)i * G + c; if (L >= nwg) return false;
        int wgid = (int)L; { const int q = nwg / NXCD, r = nwg % NXCD, xcd = wgid % NXCD, off = wgid / NXCD; wgid = (xcd < r ? xcd * (q + 1) : r * (q + 1) + (xcd - r) * q) + off; }
        const int nig = WGM * nN, gid = wgid / nig, fm = gid * WGM, gsz = (nM - fm) < WGM ? (nM - fm) : WGM;
        u.pm = fm + ((wgid % nig) % gsz); u.pn = (wgid % nig) / gsz; return true;
    }
    __device__ __forceinline__ void a_ready(const Unit&) const {}
    __device__ __forceinline__ void done(const Unit&) const {}
};

typedef __bf16 bf2_t __attribute__((ext_vector_type(2)));
__device__ __forceinline__ unsigned cvt_pk_bf16(float lo, float hi) { bf2_t v; v[0] = (__bf16)lo; v[1] = (__bf16)hi; return __builtin_bit_cast(unsigned, v); }
typedef float f32x2 __attribute__((ext_vector_type(2)));
template <int ACT  > struct EpiBf16 {
    static constexpr bool PERM = true, AFTER_DRAIN = false; static_assert(ACT == 0, "EpiBf16: no activation here");
    bf16_t* O; int ldc; const float* bias; int split_cols; size_t split_stride; float scale0;
    __device__ __forceinline__ void operator()(const f32x4 (&acc)[2][2][4][2], const Unit& u, int wr, int wc, int fr, int fq) const {
        const int row0 = u.pm * BM + wr * 64 + fr; int colt = u.pn * BM; bf16_t* base = O;
        float sc = 1.f; if (split_cols) { const int t = colt / split_cols; base += (size_t)t * split_stride; colt -= t * split_cols; if (t == 0) sc = scale0; }
        const int col0 = colt + wc * 32 + 8 * fq, bcol0 = u.pn * BM + wc * 32 + 8 * fq;
        f32x4 bv[2][2];
#pragma unroll
        for (int bj = 0; bj < 2; ++bj)
#pragma unroll
            for (int n = 0; n < 2; ++n) bv[bj][n] = bias ? *(const f32x4*)(bias + bcol0 + bj * HALF + 4 * n) : (f32x4){0.f, 0.f, 0.f, 0.f};
#pragma unroll
        for (int ai = 0; ai < 2; ++ai)
#pragma unroll
            for (int m = 0; m < 4; ++m) { bf16_t* rowp = base + (size_t)(row0 + ai * HALF + m * 16) * ldc + col0;
#pragma unroll
                for (int bj = 0; bj < 2; ++bj) { f32x4 v0 = acc[ai][bj][m][0] + bv[bj][0], v1 = acc[ai][bj][m][1] + bv[bj][1];
                    v0 = v0 * sc; v1 = v1 * sc; u32x4 w; w.x = cvt_pk_bf16(v0[0], v0[1]); w.y = cvt_pk_bf16(v0[2], v0[3]); w.z = cvt_pk_bf16(v1[0], v1[1]); w.w = cvt_pk_bf16(v1[2], v1[3]);
                    *(u32x4*)(rowp + bj * HALF) = w; } }
    }
};
__device__ __forceinline__ float bf2f_(unsigned b16) { return __uint_as_float(b16 << 16); }
__device__ __forceinline__ float sigm_(float x) { return 1.0f / (1.0f + __expf(-x)); }
template <bool ADD> struct EpiGate {
    static constexpr bool PERM = true, AFTER_DRAIN = false;
    bf16_t* O; int ldc; const bf16_t* gate; size_t gstride;
    __device__ __forceinline__ void operator()(const f32x4 (&acc)[2][2][4][2], const Unit& u, int wr, int wc, int fr, int fq) const {
        const int row0 = u.pm * BM + wr * 64 + fr, colt = wc * 32 + 8 * fq;
        const bf16_t* gt = gate + (size_t)u.pn * gstride;
#pragma unroll
        for (int ai = 0; ai < 2; ++ai)
#pragma unroll
            for (int m = 0; m < 4; ++m) { const size_t row = (size_t)(row0 + ai * HALF + m * 16);
#pragma unroll
                for (int bj = 0; bj < 2; ++bj) { const int c = colt + bj * HALF;
                    const u32x4 gv = *(const u32x4*)(gt + row * 256 + c);
                    bf16_t* op = O + row * ldc + u.pn * BM + c;
                    float pv[8] = {0.f, 0.f, 0.f, 0.f, 0.f, 0.f, 0.f, 0.f};
                    if (ADD) { const u32x4 p = *(const u32x4*)op; pv[0] = bf2f_(p.x & 0xffffu); pv[1] = bf2f_(p.x >> 16); pv[2] = bf2f_(p.y & 0xffffu); pv[3] = bf2f_(p.y >> 16);
                        pv[4] = bf2f_(p.z & 0xffffu); pv[5] = bf2f_(p.z >> 16); pv[6] = bf2f_(p.w & 0xffffu); pv[7] = bf2f_(p.w >> 16); }
                    const f32x4 v0 = acc[ai][bj][m][0], v1 = acc[ai][bj][m][1];
                    float o[8];
                    o[0] = pv[0] + sigm_(bf2f_(gv.x & 0xffffu)) * v0[0]; o[1] = pv[1] + sigm_(bf2f_(gv.x >> 16)) * v0[1];
                    o[2] = pv[2] + sigm_(bf2f_(gv.y & 0xffffu)) * v0[2]; o[3] = pv[3] + sigm_(bf2f_(gv.y >> 16)) * v0[3];
                    o[4] = pv[4] + sigm_(bf2f_(gv.z & 0xffffu)) * v1[0]; o[5] = pv[5] + sigm_(bf2f_(gv.z >> 16)) * v1[1];
                    o[6] = pv[6] + sigm_(bf2f_(gv.w & 0xffffu)) * v1[2]; o[7] = pv[7] + sigm_(bf2f_(gv.w >> 16)) * v1[3];
                    u32x4 w; w.x = cvt_pk_bf16(o[0], o[1]); w.y = cvt_pk_bf16(o[2], o[3]); w.z = cvt_pk_bf16(o[4], o[5]); w.w = cvt_pk_bf16(o[6], o[7]);
                    *(u32x4*)op = w; } }
    }
};
struct EpiRes {
    static constexpr bool PERM = false, AFTER_DRAIN = false;
    float* C; const float* R; int ldc;
    __device__ __forceinline__ void operator()(const f32x4 (&acc)[2][2][4][2], const Unit& u, int wr, int wc, int fr, int fq) const {
        const int row0 = u.pm * BM + wr * 64 + fr, col0 = u.pn * BM + wc * 32 + 4 * fq;
#pragma unroll
        for (int ai = 0; ai < 2; ++ai)
#pragma unroll
            for (int m = 0; m < 4; ++m) { const size_t ro = (size_t)(row0 + ai * HALF + m * 16) * ldc + col0;
#pragma unroll
                for (int bj = 0; bj < 2; ++bj)
#pragma unroll
                    for (int n = 0; n < 2; ++n) { const size_t off = ro + bj * HALF + n * 16; *(f32x4*)(C + off) = *(const f32x4*)(R + off) + acc[ai][bj][m][n]; } }
    }
};
struct EpiSwiGLU {
    static constexpr bool PERM = true, AFTER_DRAIN = false;
    bf16_t* H;
    __device__ __forceinline__ void operator()(const f32x4 (&acc)[2][2][4][2], const Unit& u, int wr, int wc, int fr, int fq) const {
        const int row0 = u.pm * BM + wr * 64 + fr, hc = (u.pn & 3) * 128 + wc * 32 + 8 * fq;
#pragma unroll
        for (int ai = 0; ai < 2; ++ai)
#pragma unroll
            for (int m = 0; m < 4; ++m) { const size_t row = (size_t)(row0 + ai * HALF + m * 16);
                float o[8];
#pragma unroll
                for (int n = 0; n < 2; ++n)
#pragma unroll
                    for (int i = 0; i < 4; ++i) { const float g = acc[ai][0][m][n][i], up = acc[ai][1][m][n][i]; o[n * 4 + i] = g * sigm_(g) * up; }
                u32x4 w; w.x = cvt_pk_bf16(o[0], o[1]); w.y = cvt_pk_bf16(o[2], o[3]); w.z = cvt_pk_bf16(o[4], o[5]); w.w = cvt_pk_bf16(o[6], o[7]);
                *(u32x4*)(H + row * 512 + hc) = w; }
    }
};
struct EpiDown {
    static constexpr bool PERM = true, AFTER_DRAIN = false;
    bf16_t* Y;
    __device__ __forceinline__ void operator()(const f32x4 (&acc)[2][2][4][2], const Unit& u, int wr, int wc, int fr, int fq) const {
        const int row0 = u.pm * BM + wr * 64 + fr, c0 = (u.pn & 3) * 256 + wc * 32 + 8 * fq;
#pragma unroll
        for (int ai = 0; ai < 2; ++ai)
#pragma unroll
            for (int m = 0; m < 4; ++m) { const size_t row = (size_t)(row0 + ai * HALF + m * 16);
#pragma unroll
                for (int bj = 0; bj < 2; ++bj) { const f32x4 v0 = acc[ai][bj][m][0], v1 = acc[ai][bj][m][1];
                    u32x4 w; w.x = cvt_pk_bf16(v0[0], v0[1]); w.y = cvt_pk_bf16(v0[2], v0[3]); w.z = cvt_pk_bf16(v1[0], v1[1]); w.w = cvt_pk_bf16(v1[2], v1[3]);
                    *(u32x4*)(Y + row * 1024 + c0 + bj * HALF) = w; } }
    }
};
template <bool GA_> struct MoeOrder {
    static constexpr bool GATHER = GA_;
    const PG8_LAS int* ts; int G, c; const int* rowtok;
    __device__ __forceinline__ bool next(int i, Unit& u) const {
        const int nt = ts[32]; const long L = (long)i * G + c; if (L >= 4L * nt) return false;
        const int pm = (int)(L >> 2), j = (int)(L & 3); int e = 0;
#pragma unroll
        for (int k = 1; k < 32; ++k) e += (ts[k] <= pm) ? 1 : 0;
        u.pm = pm; u.pn = e * 4 + j; return true;
    }
    __device__ __forceinline__ void a_ready(const Unit&) const {}
    __device__ __forceinline__ void done(const Unit&) const {}
};
template <class E_> struct is_epibf16 { static constexpr bool value = false; }; template <int A_> struct is_epibf16<EpiBf16<A_>> { static constexpr bool value = true; };
template <class Epi, class Sched, bool ALIGN_EPI = false, bool SP2 = false>
__device__ __forceinline__ void gemm_phase(PG8_LAS unsigned char* lds, const Gemm g, const Sched& S, const Epi& E) {
    const int tid = threadIdx.x, wid = __builtin_amdgcn_readfirstlane(tid >> 6), lane = tid & 63, wr = wid >> 2, wc = wid & 3, fr = lane & 15, fq = lane >> 4;
    const int K = g.K, nt = K / BK;
    unsigned voffA[2], voffB[2];
#pragma unroll
    for (int i = 0; i < 2; ++i) { int R, C; stage_rc(tid * 16 + i * 8192, R, C); const int Rb = Epi::PERM ? ((R & ~31) + perm32(R & 31)) : R;
        voffA[i] = (unsigned)(R * K + C) * 2u; voffB[i] = (unsigned)(Rb * K + C) * 2u; }
    const size_t kstep = (size_t)(BK * 2);
    const size_t hstep = (size_t)HALF * K * 2;
    const size_t tstep = 2 * hstep;
    constexpr bool GA = Sched::GATHER;
    static_assert(!GA || SP2, "gathered A rows: SP2 loop only");
    const size_t hstepA = GA ? 0 : hstep;
    unsigned gcur[2][2] = {{0u, 0u}, {0u, 0u}}, gnxt[2][2] = {{0u, 0u}, {0u, 0u}}; int gR[2] = {0, 0}; unsigned gC[2] = {0u, 0u};
    if constexpr (GA) { _Pragma("unroll") for (int i = 0; i < 2; ++i) { int R, C; stage_rc(tid * 16 + i * 8192, R, C); gR[i] = R; gC[i] = (unsigned)C * 2u; } }
#define PG8_GOFF(dst, u) do { if constexpr (GA) { _Pragma("unroll") for (int h_ = 0; h_ < 2; ++h_) _Pragma("unroll") for (int i_ = 0; i_ < 2; ++i_) dst[h_][i_] = (unsigned)S.rowtok[(u).pm * BM + h_ * HALF + gR[i_]] * (unsigned)(K * 2) + gC[i_]; } } while (0)
#define PG8_VA(h, sel) (GA ? ((sel) ? gnxt[h] : gcur[h]) : voffA)
    const unsigned ldsw = (unsigned)wid * 1024u;
    const int aoff = lds_byte(wr * 64 + fr, fq * 8), boff = lds_byte(wc * 32 + fr, fq * 8);
#define PG8_SA(b, h) (((b) * 2 + (h)) * HTB)
#define PG8_SB(b, h) ((4 + (b) * 2 + (h)) * HTB)
#define PG8_STAGE(bufoff, gbase, voff) do { _Pragma("unroll") for (int _i = 0; _i < 2; ++_i) \
        __builtin_amdgcn_global_load_lds((const unsigned*)((const char*)(gbase) + (voff)[_i]), (PG8_LAS unsigned*)(lds + (bufoff) + ldsw + _i * 8192), 16, 0, 0); } while (0)
#define PG8_LDA(dst, b, h) do { _Pragma("unroll") for (int m = 0; m < 4; ++m) _Pragma("unroll") for (int k = 0; k < 2; ++k) dst[m][k] = *(const PG8_LAS bf16x8*)(lds + PG8_SA(b, h) + aoff + m * 2048 + k * 1024); } while (0)
#define PG8_LDB(dst, b, h) do { _Pragma("unroll") for (int n = 0; n < 2; ++n) _Pragma("unroll") for (int k = 0; k < 2; ++k) dst[n][k] = *(const PG8_LAS bf16x8*)(lds + PG8_SB(b, h) + boff + n * 2048 + k * 1024); } while (0)
#define PG8_MMA(ai, bj, At, Bt) do { __builtin_amdgcn_s_setprio(1); _Pragma("unroll") for (int m = 0; m < 4; ++m) _Pragma("unroll") for (int n = 0; n < 2; ++n) _Pragma("unroll") for (int k = 0; k < 2; ++k) \
        acc[ai][bj][m][n] = __builtin_amdgcn_mfma_f32_16x16x32_bf16(Bt[n][k], At[m][k], acc[ai][bj][m][n], 0, 0, 0); __builtin_amdgcn_s_setprio(0); } while (0)
#define PG8_WAIT_V(n) asm volatile("s_waitcnt vmcnt(" #n ")" ::: "memory")
#define PG8_WAIT_L(n) asm volatile("s_waitcnt lgkmcnt(" #n ")" ::: "memory")
#define PG8_BAR __builtin_amdgcn_s_barrier()
#define PG8_SCHED __builtin_amdgcn_sched_barrier(0)
    Unit cur, nxt; int ui = 0;
    if (!S.next(0, cur)) return;
    f32x4 acc[2][2][4][2];
#pragma unroll
    for (int a = 0; a < 2; ++a)
#pragma unroll
        for (int b = 0; b < 2; ++b)
#pragma unroll
            for (int m = 0; m < 4; ++m)
#pragma unroll
                for (int n = 0; n < 2; ++n) acc[a][b][m][n] = (f32x4){0.f, 0.f, 0.f, 0.f};
    bf16x8 At[4][2], B0[2][2], B1[2][2];
    const char* cA = (const char*)g.A + (GA ? 0 : (size_t)cur.pm * tstep); const char* cB = (const char*)g.Bt + (size_t)cur.pn * tstep;
    S.a_ready(cur);
    PG8_GOFF(gcur, cur);
    if constexpr (SP2) {
        PG8_STAGE(PG8_SB(0, 0), cB, voffB); PG8_STAGE(PG8_SB(0, 1), cB + hstep, voffB); PG8_STAGE(PG8_SA(0, 0), cA, PG8_VA(0, false)); PG8_STAGE(PG8_SA(0, 1), cA + hstepA, PG8_VA(1, false));
        if (wr == 1) PG8_BAR;
        PG8_WAIT_V(2); PG8_BAR;
        PG8_STAGE(PG8_SB(1, 0), cB + kstep, voffB); PG8_STAGE(PG8_SA(1, 0), cA + kstep, PG8_VA(0, false)); PG8_STAGE(PG8_SB(1, 1), cB + hstep + kstep, voffB);
        PG8_WAIT_V(6); PG8_BAR;
    } else {
        PG8_STAGE(PG8_SB(0, 0), cB, voffB); PG8_STAGE(PG8_SA(0, 0), cA, voffA); PG8_STAGE(PG8_SB(0, 1), cB + hstep, voffB); PG8_STAGE(PG8_SA(0, 1), cA + hstep, voffA);
        if (wr == 1) PG8_BAR;
        PG8_WAIT_V(4); PG8_BAR;
        PG8_STAGE(PG8_SB(1, 0), cB + kstep, voffB); PG8_STAGE(PG8_SA(1, 0), cA + kstep, voffA); PG8_STAGE(PG8_SB(1, 1), cB + hstep + kstep, voffB);
        PG8_WAIT_V(6); PG8_BAR;
    }
    for (;;) {
        const bool has_next = S.next(ui + 1, nxt);
        if (has_next) PG8_GOFF(gnxt, nxt);
        const char* nA = has_next ? (const char*)g.A + (GA ? 0 : (size_t)nxt.pm * tstep) : cA; const char* nB = has_next ? (const char*)g.Bt + (size_t)nxt.pn * tstep : cB;
        for (int t = 0; t < nt; t += 2) {
            const bool last = (t == nt - 2);
            const char* a1 = cA + (size_t)(t + 1) * kstep;
            const char* a2 = last ? nA : cA + (size_t)(t + 2) * kstep; const char* b2 = last ? nB : cB + (size_t)(t + 2) * kstep;
            const char* a3 = a2 + kstep; const char* b3 = b2 + kstep;
            if (last && has_next) S.a_ready(nxt);
            const bool seln = last && has_next;
            if constexpr (SP2) {
            PG8_LDB(B0, 0, 0); PG8_LDB(B1, 0, 1); PG8_SCHED; PG8_LDA(At, 0, 0); PG8_STAGE(PG8_SA(1, 1), a1 + hstepA, PG8_VA(1, false));
            PG8_WAIT_V(8); PG8_WAIT_L(0); PG8_BAR; PG8_MMA(0, 0, At, B0); PG8_MMA(0, 1, At, B1); PG8_BAR; PG8_SCHED;
            PG8_LDA(At, 0, 1); PG8_STAGE(PG8_SB(0, 0), b2, voffB); PG8_STAGE(PG8_SB(0, 1), b2 + hstep, voffB); PG8_STAGE(PG8_SA(0, 0), a2, PG8_VA(0, seln));
            PG8_WAIT_V(8); PG8_WAIT_L(0); PG8_BAR; PG8_MMA(1, 0, At, B0); PG8_MMA(1, 1, At, B1); PG8_BAR; PG8_SCHED;
            PG8_LDB(B0, 1, 0); PG8_LDB(B1, 1, 1); PG8_SCHED; PG8_LDA(At, 1, 0); PG8_STAGE(PG8_SA(0, 1), a2 + hstepA, PG8_VA(1, seln));
            PG8_WAIT_V(8); PG8_WAIT_L(0); PG8_BAR; PG8_MMA(0, 0, At, B0); PG8_MMA(0, 1, At, B1); PG8_BAR; PG8_SCHED;
            PG8_LDA(At, 1, 1); PG8_STAGE(PG8_SB(1, 0), b3, voffB); PG8_STAGE(PG8_SB(1, 1), b3 + hstep, voffB); PG8_STAGE(PG8_SA(1, 0), a3, PG8_VA(0, seln));
            PG8_WAIT_V(8); PG8_WAIT_L(0); PG8_BAR; PG8_MMA(1, 0, At, B0); PG8_MMA(1, 1, At, B1); PG8_BAR; PG8_SCHED;
            } else {
            PG8_LDB(B0, 0, 0); PG8_SCHED; PG8_LDA(At, 0, 0); PG8_STAGE(PG8_SA(1, 1), a1 + hstep, voffA);
            PG8_WAIT_L(8); PG8_BAR; PG8_WAIT_L(0); PG8_MMA(0, 0, At, B0); PG8_BAR; PG8_SCHED;
            PG8_LDB(B1, 0, 1); PG8_STAGE(PG8_SB(0, 0), b2, voffB);
            PG8_BAR; PG8_WAIT_L(0); PG8_MMA(0, 1, At, B1); PG8_BAR;
            PG8_LDA(At, 0, 1); PG8_STAGE(PG8_SA(0, 0), a2, voffA);
            PG8_BAR; PG8_WAIT_L(0); PG8_MMA(1, 0, At, B0); PG8_BAR; PG8_SCHED;
            PG8_STAGE(PG8_SB(0, 1), b2 + hstep, voffB);
            PG8_WAIT_V(6); PG8_BAR; PG8_MMA(1, 1, At, B1); PG8_BAR;
            PG8_LDB(B0, 1, 0); PG8_SCHED; PG8_LDA(At, 1, 0); PG8_STAGE(PG8_SA(0, 1), a2 + hstep, voffA);
            PG8_WAIT_L(8); PG8_BAR; PG8_WAIT_L(0); PG8_MMA(0, 0, At, B0); PG8_BAR; PG8_SCHED;
            PG8_LDB(B1, 1, 1); PG8_STAGE(PG8_SB(1, 0), b3, voffB);
            PG8_BAR; PG8_WAIT_L(0); PG8_MMA(0, 1, At, B1); PG8_BAR;
            PG8_LDA(At, 1, 1); PG8_STAGE(PG8_SA(1, 0), a3, voffA);
            PG8_BAR; PG8_WAIT_L(0); PG8_MMA(1, 0, At, B0); PG8_BAR; PG8_SCHED;
            PG8_STAGE(PG8_SB(1, 1), b3 + hstep, voffB);
            PG8_WAIT_V(6); PG8_BAR; PG8_MMA(1, 1, At, B1); PG8_BAR;
            }
        }
        if constexpr (ALIGN_EPI) { if (wr == 0) PG8_BAR; }
        if constexpr (!Epi::AFTER_DRAIN) { E(acc, cur, wr, wc, fr, fq); S.done(cur); }
#ifdef DBG_EPI2
        if constexpr (is_epibf16<Epi>::value) { asm volatile("" ::: "memory"); E(acc, cur, wr, wc, fr, fq); }
#endif
        if (!has_next) break;
#pragma unroll
        for (int a = 0; a < 2; ++a)
#pragma unroll
            for (int b = 0; b < 2; ++b)
#pragma unroll
                for (int m = 0; m < 4; ++m)
#pragma unroll
                    for (int n = 0; n < 2; ++n) acc[a][b][m][n] = (f32x4){0.f, 0.f, 0.f, 0.f};
        cur = nxt; cA = nA; cB = nB; ++ui;
        if constexpr (GA) { _Pragma("unroll") for (int h_ = 0; h_ < 2; ++h_) _Pragma("unroll") for (int i_ = 0; i_ < 2; ++i_) gcur[h_][i_] = gnxt[h_][i_]; }
        if constexpr (ALIGN_EPI) { if (wr == 1) PG8_BAR; }
    }
    PG8_WAIT_V(0);
    if constexpr (!ALIGN_EPI) { if (wr == 0) PG8_BAR; }
    PG8_BAR;
    if constexpr (Epi::AFTER_DRAIN) { E.fused(acc, cur, wr, wc, fr, fq, lds, wid, lane); S.done(cur); }
#undef PG8_GOFF
#undef PG8_VA
#undef PG8_SA
#undef PG8_SB
#undef PG8_STAGE
#undef PG8_LDA
#undef PG8_LDB
#undef PG8_MMA
#undef PG8_WAIT_V
#undef PG8_WAIT_L
#undef PG8_BAR
#undef PG8_SCHED
}
}
constexpr int NWAVES = 8;
constexpr int BATCH = 8, SEQ = 4096, D = 1024, T = BATCH * SEQ;
constexpr int NPROJ = 5120;
constexpr int NTILE = NPROJ / 256;
constexpr float EPS = 1e-6f;
#ifndef MK_N_LAUNCHES
#define MK_N_LAUNCHES 1
#endif
#ifndef DBG_NPH
#define DBG_NPH 12
#endif
constexpr int NPH = DBG_NPH;
constexpr int N_LAUNCHES = MK_N_LAUNCHES;
static_assert(N_LAUNCHES == 1 || N_LAUNCHES == NPH, "MK_N_LAUNCHES is 1 or NPH");

constexpr size_t MiB = 1u << 20;
constexpr size_t WS_CTL = 0, CTL_ZERO_BYTES = 1 * MiB;
constexpr size_t WS_SMALL = 1 * MiB;
constexpr size_t WS_WIN = 2 * MiB;
constexpr size_t WS_WPA = 13 * MiB, WS_WPM = 14 * MiB, WS_WOUT = 15 * MiB;
constexpr size_t WS_TOKE = 17 * MiB;
constexpr size_t WS_TOKR = WS_TOKE + 256 * 1024;
constexpr size_t WS_TOKP = WS_TOKR + 256 * 1024;
constexpr size_t WS_TOKG = WS_TOKP + 256 * 1024;
constexpr size_t WS_CNT = WS_TOKG + 256 * 1024;
constexpr size_t WS_ROWTOK = WS_CNT + 64 * 1024;
constexpr int NROWS_MAX = 73728;
constexpr size_t WS_SC = 452 * MiB;
constexpr size_t WS_SC2 = 116 * MiB + 3 * ((size_t)T * 256 * 2);
constexpr size_t WS_GU = 20 * MiB;
constexpr size_t WS_DN = 84 * MiB;
constexpr size_t WS_PROJ = 116 * MiB;
constexpr size_t PROJ_TILE = (size_t)T * 256 * 2;
constexpr size_t WS_MLST = 116 * MiB;
constexpr size_t WS_MERGED = 116 * MiB;
constexpr size_t WS_XN = 180 * MiB;
constexpr size_t WS_XG = 244 * MiB;
constexpr size_t WS_HID = 388 * MiB;
constexpr size_t WS_Y = 244 * MiB;
constexpr size_t WS_END = 512 * MiB;
static_assert(WS_PROJ + NTILE * PROJ_TILE == 436 * MiB, "proj map");
constexpr size_t DO_H = 0, DO_YATT = 0, DO_YML = 32 * MiB, DO_KN = 64 * MiB, DO_IKR = 72 * MiB, DO_IQR = 74 * MiB, DO_AQN = 90 * MiB;
constexpr int TL_AQ = 0, TL_KV = 2, TL_IQ = 3, TL_MQ = 4, TL_MK = 6, TL_MV = 8, TL_MO = 10, TL_GA = 12, TL_GM = 16;
constexpr size_t WS_WSM = WS_SMALL + 64 * 1024;
constexpr size_t WS_WTG = WS_SMALL + 192 * 1024;
constexpr size_t DO_SMB = 122 * MiB;
constexpr int CW_BAR = 4096;
constexpr int CW_Q = 16384;
constexpr int LDS_BYTES = 163840, MISC_OFF = LDS_BYTES - 512;

#define GAS __attribute__((address_space(1)))
#define LAS __attribute__((address_space(3)))
typedef unsigned short bf16;
typedef unsigned v4u __attribute__((ext_vector_type(4)));
typedef unsigned v2u __attribute__((ext_vector_type(2)));
typedef float f32x4 __attribute__((ext_vector_type(4)));
typedef float f32x2 __attribute__((ext_vector_type(2)));
typedef short bf16x8 __attribute__((ext_vector_type(8)));
typedef GAS unsigned gu32;
#define RLX_AGENT __ATOMIC_RELAXED, __HIP_MEMORY_SCOPE_AGENT
#define LDS_WAIT() asm volatile("s_waitcnt lgkmcnt(0)" ::: "memory")
__device__ __forceinline__ float bf2f(unsigned b16) { return __uint_as_float(b16 << 16); }
__device__ __forceinline__ unsigned f2bf(float f) { unsigned u = __float_as_uint(f); return (u + 0x7fffu + ((u >> 16) & 1u)) >> 16; }
__device__ __forceinline__ unsigned pk2(float lo, float hi) { return pg8::cvt_pk_bf16(lo, hi); }
__device__ __forceinline__ float sigm(float x) { return 1.0f / (1.0f + __expf(-x)); }
__device__ __forceinline__ float wave_sum(float v) {
    v += __int_as_float(__builtin_amdgcn_update_dpp(0, __float_as_int(v), 0xB1, 0xF, 0xF, true));
    v += __int_as_float(__builtin_amdgcn_update_dpp(0, __float_as_int(v), 0x4E, 0xF, 0xF, true));
    v += __int_as_float(__builtin_amdgcn_update_dpp(0, __float_as_int(v), 0x124, 0xF, 0xF, true));
    v += __int_as_float(__builtin_amdgcn_update_dpp(0, __float_as_int(v), 0x128, 0xF, 0xF, true));
    { const auto r = __builtin_amdgcn_permlane16_swap(__float_as_uint(v), __float_as_uint(v), false, false); v = __uint_as_float(r[0]) + __uint_as_float(r[1]); }
    { const auto r = __builtin_amdgcn_permlane32_swap(__float_as_uint(v), __float_as_uint(v), false, false); v = __uint_as_float(r[0]) + __uint_as_float(r[1]); }
    return v;
}
__device__ __forceinline__ void unpack8(const v4u r, float (&f)[8]) {
    f[0] = bf2f(r.x & 0xffffu); f[1] = bf2f(r.x >> 16); f[2] = bf2f(r.y & 0xffffu); f[3] = bf2f(r.y >> 16);
    f[4] = bf2f(r.z & 0xffffu); f[5] = bf2f(r.z >> 16); f[6] = bf2f(r.w & 0xffffu); f[7] = bf2f(r.w >> 16);
}
__device__ __forceinline__ v4u pack8(const float (&f)[8]) { v4u w; w.x = pk2(f[0], f[1]); w.y = pk2(f[2], f[3]); w.z = pk2(f[4], f[5]); w.w = pk2(f[6], f[7]); return w; }
#define XB_TMO      128
#define XB_XCNT(j)  (256  + 64 * (j))
#define XB_XSUB(j)  (1280 + 64 * (j))
#define XB_XGEN(j)  (2304 + 64 * (j))
#define XB_TOP      3328
#define XB_TOPGEN   3392
#define XCD_BAR_WORDS 3456
#define XB_SPIN_CAP (1u << 18)

__device__ __forceinline__ unsigned xb_ld(unsigned* p)              { return __hip_atomic_load(p, __ATOMIC_RELAXED, __HIP_MEMORY_SCOPE_AGENT); }
__device__ __forceinline__ unsigned xb_add(unsigned* p, unsigned v) { return __hip_atomic_fetch_add(p, v, __ATOMIC_RELAXED, __HIP_MEMORY_SCOPE_AGENT); }
__device__ __forceinline__ unsigned xb_xcc_id() { return (unsigned)__builtin_amdgcn_s_getreg((3 << 11) | 20) & 0xFu; }
#define XB_SPIN(cond, bar) do { unsigned _sp = 0; while (cond) { __builtin_amdgcn_s_sleep(1); \
    if ((++_sp & 255u) == 0u) { if (xb_ld(&(bar)[XB_TMO])) break; if (_sp > XB_SPIN_CAP) { atomicAdd(&(bar)[XB_TMO], 1u); break; } } } } while (0)

struct XcdBarrier {
    unsigned* bar; unsigned x;
    volatile LAS unsigned* st;
};

__device__ __forceinline__ XcdBarrier xcd_barrier_post(unsigned* bar, volatile LAS unsigned* st) {
    XcdBarrier b; b.bar = bar; b.x = xb_xcc_id(); b.st = st;
    if (threadIdx.x == 0) (void)xb_add(&bar[XB_XCNT(b.x)], 1u);
    return b;
}
__device__ __forceinline__ void xcd_barrier_complete(unsigned* bar, unsigned x, unsigned& nloc, unsigned& nx) {
    const unsigned G = gridDim.x * gridDim.y * gridDim.z;
    unsigned sum, cnt, mine, sp = 0u;
    for (;;) {
        sum = 0u; cnt = 0u; mine = 0u;
#pragma unroll
        for (unsigned j = 0; j < 16; ++j) { const unsigned c = xb_ld(&bar[XB_XCNT(j)]); sum += c; cnt += (c > 0u) ? 1u : 0u; mine = (j == x) ? c : mine; }
        if (sum == G) break;
        __builtin_amdgcn_s_sleep(1);
        if ((++sp & 255u) == 0u) { if (xb_ld(&bar[XB_TMO])) break; if (sp > XB_SPIN_CAP) { atomicAdd(&bar[XB_TMO], 1u); break; } }
    }
    nloc = mine > 0u ? mine : 1u; nx = cnt > 0u ? cnt : 1u;
}

__device__ __forceinline__ void xcd_barrier(const XcdBarrier& b) {
    asm volatile("s_waitcnt vmcnt(0)" ::: "memory");
    __syncthreads();
    if (threadIdx.x == 0) {
        unsigned* bar = b.bar;
        __builtin_amdgcn_s_waitcnt(0);
        unsigned nloc = b.st[0], nx = b.st[1];
        if (nloc == 0u) { xcd_barrier_complete(bar, b.x, nloc, nx); b.st[0] = nloc; b.st[1] = nx; }
        const unsigned old = xb_add(&bar[XB_XSUB(b.x)], 1u);
        const unsigned gen = old / nloc;
        if (old + 1u == (gen + 1u) * nloc) {
            __builtin_amdgcn_fence(__ATOMIC_RELEASE, "agent");
            asm volatile("s_waitcnt vmcnt(0)" ::: "memory");
            const unsigned og = xb_add(&bar[XB_TOP], 1u);
            const unsigned tg = og / nx;
            if (og + 1u == (tg + 1u) * nx) xb_add(&bar[XB_TOPGEN], 1u);
            else XB_SPIN(xb_ld(&bar[XB_TOPGEN]) == tg, bar);
            __builtin_amdgcn_fence(__ATOMIC_ACQUIRE, "agent");
            xb_add(&bar[XB_XGEN(b.x)], 1u);
            asm volatile("s_waitcnt vmcnt(0)" ::: "memory");
        } else {
            XB_SPIN(xb_ld(&bar[XB_XGEN(b.x)]) == gen, bar);
            __builtin_amdgcn_fence(__ATOMIC_ACQUIRE, "agent");
            asm volatile("s_waitcnt vmcnt(0)" ::: "memory");
        }
    }
    __syncthreads();
}
struct Args { const float* in[22]; float* out; unsigned char* ws; int ph_lo, ph_hi, li, pad; };
struct Ctx { int tid, lane, wave, G, vcu; LAS unsigned char* lds; };
#define IN_X 0
#define IN_POS 1
#define IN_GMIX 2
#define IN_WIN 3
#define IN_GQ 4
#define IN_GK 5
#define IN_WCONV 6
#define IN_BCONV 7
#define IN_BI 8
#define IN_BF 9
#define IN_GML 10
#define IN_WPA 11
#define IN_WPM 12
#define IN_WOUT 13
#define IN_GMOE 14
#define IN_WRG 15
#define IN_BRG 16
#define IN_WRE 17
#define IN_BRE 18
#define IN_WEG 19
#define IN_WEU 20
#define IN_WED 21

__device__ __forceinline__ int win_src_col(int n) {
    if (n < 1024) return n;
    if (n < 3072) return n + 40;
    return n + 48;
}
__device__ __forceinline__ int wsm_src_col(int r) {
    return r < 40 ? 1024 + r : (r < 44 ? 3112 + (r - 40) : 3116 + (r - 44));
}
__device__ __forceinline__ void tr_item(const float* W, int ldw, int scol, int k0, bf16* wt0, int K, LAS float* scr, int lane) {
    const int sc0 = __builtin_amdgcn_readfirstlane(scol), sc31 = __builtin_amdgcn_readlane(scol, 31);
    if (sc0 >= 0 && sc31 == sc0 + 31 && (sc0 & 3) == 0 && (ldw & 3) == 0) {
#pragma unroll
        for (int i = 0; i < 8; ++i) { const int kk = 8 * i + (lane >> 3); const f32x4 v = *(const f32x4*)(W + (size_t)(k0 + kk) * ldw + sc0 + 4 * (lane & 7));
            LAS float* d = scr + kk * 33 + 4 * (lane & 7); d[0] = v[0]; d[1] = v[1]; d[2] = v[2]; d[3] = v[3]; }
    } else {
#pragma unroll 8
        for (int i = 0; i < 32; ++i) { const int kk = 2 * i + (lane >> 5); scr[kk * 33 + (lane & 31)] = scol >= 0 ? W[(size_t)(k0 + kk) * ldw + scol] : 0.f; }
    }
    LDS_WAIT(); asm volatile("" ::: "memory");
    const int c = lane & 7;
#pragma unroll
    for (int j = 0; j < 4; ++j) { const int n = (lane >> 3) + 8 * j; const LAS float* s = scr + (8 * c) * 33 + n;
        v4u o; o.x = pk2(s[0 * 33], s[1 * 33]); o.y = pk2(s[2 * 33], s[3 * 33]); o.z = pk2(s[4 * 33], s[5 * 33]); o.w = pk2(s[6 * 33], s[7 * 33]);
        *(v4u*)(wt0 + (size_t)n * K + 8 * c) = o; }
    LDS_WAIT(); asm volatile("" ::: "memory");
}
template <int PART> __device__ __forceinline__ void p0_prologue(const Args& a, const Ctx& c, int gw, int NGW) {
    unsigned char* ws = a.ws;
    LAS float* scr = (LAS float*)(c.lds + c.wave * 16384);
    const int lane = c.lane;
    constexpr int I_IN = 16 * 160, I_PA = 8 * 32, I_PM = 8 * 32, I_OUT = 16 * 32, I_GU = 32 * 16 * 32, I_DN = 32 * 8 * 32;
    constexpr int NPRJ = I_IN + I_PA + I_PM + I_OUT, NIT = NPRJ + I_GU + I_DN;
    for (int it = (PART ? NPRJ : 0) + gw; it < (PART ? NIT : NPRJ); it += NGW) {
        int r = it;
        if (r < I_IN) { const int kb = r / 160, nb = r % 160; tr_item(a.in[IN_WIN], 5168, win_src_col(32 * nb + (lane & 31)), 64 * kb, (bf16*)(ws + WS_WIN) + (size_t)(32 * nb) * 1024 + 64 * kb, 1024, scr, lane); continue; } r -= I_IN;
        if (r < I_PA) { const int kb = r / 32, nb = r % 32; tr_item(a.in[IN_WPA], 1024, 32 * nb + (lane & 31), 64 * kb, (bf16*)(ws + WS_WPA) + (size_t)(32 * nb) * 512 + 64 * kb, 512, scr, lane); continue; } r -= I_PA;
        if (r < I_PM) { const int kb = r / 32, nb = r % 32; tr_item(a.in[IN_WPM], 1024, 32 * nb + (lane & 31), 64 * kb, (bf16*)(ws + WS_WPM) + (size_t)(32 * nb) * 512 + 64 * kb, 512, scr, lane); continue; } r -= I_PM;
        if (r < I_OUT) { const int kb = r / 32, nb = r % 32; tr_item(a.in[IN_WOUT], 1024, 32 * nb + (lane & 31), 64 * kb, (bf16*)(ws + WS_WOUT) + (size_t)(32 * nb) * 1024 + 64 * kb, 1024, scr, lane); continue; } r -= I_OUT;
        if (r < I_GU) { const int e = r / 512, q = r % 512, kb = q / 32, nb = q % 32, t = nb >> 3, bj = (nb >> 2) & 1, i0 = (nb & 3) * 32;
            const float* src = (bj ? a.in[IN_WEU] : a.in[IN_WEG]) + (size_t)e * 1024 * 512;
            tr_item(src, 512, 128 * t + i0 + (lane & 31), 64 * kb, (bf16*)(ws + WS_GU) + ((size_t)e * 1024 + 32 * nb) * 1024 + 64 * kb, 1024, scr, lane); continue; } r -= I_GU;
        { const int e = r / 256, q = r % 256, kb = q / 32, nb = q % 32;
            tr_item(a.in[IN_WED] + (size_t)e * 512 * 1024, 1024, 32 * nb + (lane & 31), 64 * kb, (bf16*)(ws + WS_DN) + ((size_t)e * 1024 + 32 * nb) * 512 + 64 * kb, 512, scr, lane); }
    }
    if (PART) return;
    { float* WTG = (float*)(ws + WS_WTG); for (int i = gw * 64 + lane; i < 36 * 1024; i += NGW * 64) { const int j = i >> 10, k = i & 1023;
        WTG[j * 1028 + k] = (j < 32 ? a.in[IN_WRE][k * 32 + j] : a.in[IN_WRG][k * 4 + (j - 32)]) * a.in[IN_GMOE][k]; } }
    { bf16* WSM = (bf16*)(ws + WS_WSM); for (int i = gw * 64 + lane; i < 48 * 1024; i += NGW * 64) { const int r = i >> 10, k = i & 1023; WSM[i] = (bf16)f2bf(a.in[IN_WIN][(size_t)k * 5168 + wsm_src_col(r)]); } }
    const float* g = a.in[IN_GMIX]; f32x4 gv[4];
#pragma unroll
    for (int j = 0; j < 4; ++j) gv[j] = *(const f32x4*)(g + 4 * lane + 256 * j);
    bf16* H = (bf16*)((unsigned char*)a.out + DO_H);
    for (int m0 = gw; m0 < T; m0 += 2 * NGW) {
        const int mA = m0, mB = (m0 + NGW < T) ? m0 + NGW : m0; const bool hasB = (m0 + NGW < T);
        const f32x4* xa = (const f32x4*)(a.in[IN_X] + (size_t)mA * D) + lane; const f32x4* xb = (const f32x4*)(a.in[IN_X] + (size_t)mB * D) + lane;
        f32x4 va[4], vb[4]; float sa = 0.f, sb = 0.f;
#pragma unroll
        for (int j = 0; j < 4; ++j) { va[j] = xa[64 * j]; vb[j] = xb[64 * j]; }
#pragma unroll
        for (int j = 0; j < 4; ++j) { sa += (va[j].x * va[j].x + va[j].y * va[j].y) + (va[j].z * va[j].z + va[j].w * va[j].w); sb += (vb[j].x * vb[j].x + vb[j].y * vb[j].y) + (vb[j].z * vb[j].z + vb[j].w * vb[j].w); }
        const float ra = rsqrtf(wave_sum(sa) * (1.f / D) + EPS), rb = rsqrtf(wave_sum(sb) * (1.f / D) + EPS);
        v2u* oa = (v2u*)(H + (size_t)mA * D) + lane; v2u* ob = (v2u*)(H + (size_t)mB * D) + lane;
#pragma unroll
        for (int j = 0; j < 4; ++j) { v2u w; w.x = pk2(va[j].x * ra * gv[j].x, va[j].y * ra * gv[j].y); w.y = pk2(va[j].z * ra * gv[j].z, va[j].w * ra * gv[j].w); oa[64 * j] = w; }
        if (hasB) {
#pragma unroll
        for (int j = 0; j < 4; ++j) { v2u w; w.x = pk2(vb[j].x * rb * gv[j].x, vb[j].y * rb * gv[j].y); w.y = pk2(vb[j].z * rb * gv[j].z, vb[j].w * rb * gv[j].w); ob[64 * j] = w; } }
    }
}

__device__ __forceinline__ const bf16* proj_tile(const Args& a, int tile) { return (const bf16*)(a.ws + WS_PROJ + (size_t)tile * PROJ_TILE); }
#define DPPF(x_, ctrl_) __int_as_float(__builtin_amdgcn_update_dpp(0, __float_as_int(x_), ctrl_, 0xF, 0xF, true))
__device__ __forceinline__ void p2_prep(const Args& a, const Ctx& c) {
    const int lane = c.lane, gw = c.vcu * NWAVES + c.wave, NGW = c.G * NWAVES;
    float invf = 0.f;
    if (lane < 8) invf = (float)pow(500000.0, -(double)lane / 8.0); else if (lane < 12) invf = (float)pow(500000.0, -(double)(lane - 8) / 4.0);
    float gq[8], gk[8];
#pragma unroll
    for (int i = 0; i < 8; ++i) { gq[i] = a.in[IN_GQ][8 * (lane & 7) + i]; gk[i] = a.in[IN_GK][8 * (lane & 7) + i]; }
    const int* pos = (const int*)a.in[IN_POS];
    unsigned char* dout = (unsigned char*)a.out;
    bf16* AQN = (bf16*)(dout + DO_AQN); bf16* KN = (bf16*)(dout + DO_KN); bf16* IQR = (bf16*)(dout + DO_IQR); bf16* IKR = (bf16*)(dout + DO_IKR);
    { const bf16* Hh = (const bf16*)(dout + DO_H); const bf16* WSM = (const bf16*)(a.ws + WS_WSM); bf16* SMB = (bf16*)(dout + DO_SMB);
      const int row = lane & 15, kg = lane >> 4;
      const float invfk = (float)pow(500000.0, -(double)(lane & 3) / 4.0);
      for (int tile = gw; tile < T / 16; tile += NGW) { const int t0 = tile * 16;
          f32x4 acc[3];
#pragma unroll
          for (int ct = 0; ct < 3; ++ct) acc[ct] = (f32x4){0.f, 0.f, 0.f, 0.f};
          const bf16* ap = Hh + (size_t)(t0 + row) * 1024 + 8 * kg; const bf16* bp = WSM + (size_t)row * 1024 + 8 * kg;
#pragma unroll 8
          for (int ks = 0; ks < 32; ++ks) { const bf16x8 av = *(const bf16x8*)(ap + 32 * ks);
#pragma unroll
              for (int ct = 0; ct < 3; ++ct) acc[ct] = __builtin_amdgcn_mfma_f32_16x16x32_bf16(av, *(const bf16x8*)(bp + (size_t)ct * 16 * 1024 + 32 * ks), acc[ct], 0, 0, 0); }
          const int col = lane & 15;
#pragma unroll
          for (int r = 0; r < 4; ++r) { const int t = t0 + 4 * kg + r;
              const float angk = (float)pos[t] * invfk;
              const double revk = (double)angk * 0.15915494309189535; const float frk = (float)(revk - __builtin_rint(revk));
              const float ck = __builtin_amdgcn_cosf(frk), sk = __builtin_amdgcn_sinf(frk);
              const float v0 = acc[0][r], pr = __shfl_xor(v0, 4);
              const float o0 = (col < 4) ? (v0 * ck - pr * sk) : ((col < 8) ? (v0 * ck + pr * sk) : v0);
              IKR[(size_t)t * 32 + col] = (bf16)f2bf(o0); IKR[(size_t)t * 32 + 16 + col] = (bf16)f2bf(acc[1][r]);
              SMB[(size_t)t * 16 + col] = (bf16)f2bf(acc[2][r]); } } }
    const int l7 = lane & 7;
    const int aqcol = (lane >> 3) * 64 + 8 * l7, akcol = ((lane & 15) >> 3) * 64 + 8 * l7;
    const bf16* aqsrc = proj_tile(a, TL_AQ + (aqcol >> 8)) + (aqcol & 255); const bf16* aksrc = proj_tile(a, TL_KV) + akcol; const bf16* iqsrc = proj_tile(a, TL_IQ) + 4 * lane;
#define P2_LOADROW(t_, P_, A_, K_, Q_) do { const int tt_ = (t_) < T ? (t_) : T - 1; P_ = pos[tt_]; A_ = *(const v4u*)(aqsrc + (size_t)tt_ * 256); K_ = *(const v4u*)(aksrc + (size_t)tt_ * 256); Q_ = *(const v2u*)(iqsrc + (size_t)tt_ * 256); } while (0)
#define P2_DOROW(t, P_, A_, K_, Q_) do { \
        const float ang = (float)(P_) * invf; \
        const double rev = (double)ang * 0.15915494309189535; const float frv = (float)(rev - __builtin_rint(rev)); \
        float cs = __builtin_amdgcn_cosf(frv), sn = __builtin_amdgcn_sinf(frv); \
        float ca[8], sa[8], ci[4], si[4]; \
        _Pragma("unroll") for (int i = 0; i < 8; ++i) { ca[i] = __int_as_float(__builtin_amdgcn_readlane(__float_as_int(cs), i)); sa[i] = __int_as_float(__builtin_amdgcn_readlane(__float_as_int(sn), i)); } \
        _Pragma("unroll") for (int i = 0; i < 4; ++i) { ci[i] = __int_as_float(__builtin_amdgcn_readlane(__float_as_int(cs), 8 + i)); si[i] = __int_as_float(__builtin_amdgcn_readlane(__float_as_int(sn), 8 + i)); } \
        { float f[8]; unpack8(A_, f); float ss = 0.f; \
          _Pragma("unroll") for (int i = 0; i < 8; ++i) ss += f[i] * f[i]; \
          ss += DPPF(ss, 0xB1); ss += DPPF(ss, 0x4E); ss += DPPF(ss, 0x141); \
          const float r = rsqrtf(ss * (1.f / 64.f) + EPS); \
          _Pragma("unroll") for (int i = 0; i < 8; ++i) f[i] = f[i] * r * gq[i]; \
          float o[8]; \
          _Pragma("unroll") for (int i = 0; i < 8; ++i) { const float p = DPPF(f[i], 0xB1); o[i] = (l7 == 0) ? (f[i] * ca[i] - p * sa[i]) : ((l7 == 1) ? (f[i] * ca[i] + p * sa[i]) : f[i]); o[i] *= 0.125f * 1.4426950408889634f; } \
          *(v4u*)(AQN + (size_t)(t) * 512 + aqcol) = pack8(o); } \
        { float f[8]; unpack8(K_, f); float ss = 0.f; \
          _Pragma("unroll") for (int i = 0; i < 8; ++i) ss += f[i] * f[i]; \
          ss += DPPF(ss, 0xB1); ss += DPPF(ss, 0x4E); ss += DPPF(ss, 0x141); \
          const float r = rsqrtf(ss * (1.f / 64.f) + EPS); \
          _Pragma("unroll") for (int i = 0; i < 8; ++i) f[i] = f[i] * r * gk[i]; \
          float o[8]; \
          _Pragma("unroll") for (int i = 0; i < 8; ++i) { const float p = DPPF(f[i], 0xB1); o[i] = (l7 == 0) ? (f[i] * ca[i] - p * sa[i]) : ((l7 == 1) ? (f[i] * ca[i] + p * sa[i]) : f[i]); } \
          if (lane < 16) *(v4u*)(KN + (size_t)(t) * 128 + akcol) = pack8(o); } \
        { const v2u rw = Q_; \
          float f[4] = {bf2f(rw.x & 0xffffu), bf2f(rw.x >> 16), bf2f(rw.y & 0xffffu), bf2f(rw.y >> 16)}; float o[4]; \
          _Pragma("unroll") for (int i = 0; i < 4; ++i) { const float p = DPPF(f[i], 0xB1); o[i] = (l7 == 0) ? (f[i] * ci[i] - p * si[i]) : ((l7 == 1) ? (f[i] * ci[i] + p * si[i]) : f[i]); } \
          v2u w; w.x = pk2(o[0], o[1]); w.y = pk2(o[2], o[3]); *(v2u*)(IQR + (size_t)(t) * 256 + 4 * lane) = w; } } while (0)
    { int pA, pB; v4u aA, aB, kA, kB; v2u qA, qB;
      P2_LOADROW(gw, pA, aA, kA, qA);
#pragma unroll 1
      for (int t = gw; t < T; t += 2 * NGW) {
          P2_LOADROW(t + NGW, pB, aB, kB, qB);
          P2_DOROW(t, pA, aA, kA, qA);
          P2_LOADROW(t + 2 * NGW, pA, aA, kA, qA);
          if (t + NGW < T) P2_DOROW(t + NGW, pB, aB, kB, qB);
      } }
#undef P2_LOADROW
#undef P2_DOROW
}
constexpr int ML_QS = 0, ML_KS = 17408, ML_HS = 0;
constexpr int ML_KWT = 34816;
constexpr int ML_VT = 53248;
constexpr int ML_SW = 73984;
constexpr int ML_CT = 83200;
constexpr int ML_GA = 122368;
constexpr int ML_CW = ML_GA + 1024;
constexpr int ML_END = ML_CW + (1024 + 384) * 4;
static_assert(ML_END <= MISC_OFF, "mLSTM LDS map");
constexpr size_t ML_STATE_BYTES = 8 * 9 * 64 * 16;
__device__ __forceinline__ bf16x8 lds_frag(const LAS unsigned char* base, int stride_b, int row0, int kb, int lane) {
    return *(const LAS bf16x8*)(base + (row0 + (lane & 15)) * stride_b + kb + (lane >> 4) * 16);
}
__device__ __forceinline__ bf16x8 lds_frag_sw(const LAS unsigned char* base, int row0, int ks, int lane) {
    const int row = row0 + (lane & 15); return *(const LAS bf16x8*)(base + row * 144 + 16 * (((ks * 4 + (lane >> 4)) + (row >> 3)) & 7));
}
#define MFMA16(a_, b_, c_) __builtin_amdgcn_mfma_f32_16x16x32_bf16(a_, b_, c_, 0, 0, 0)
constexpr int CV_NMI = 2 * (32 * 16 * 32 + 32 * 8 * 32);
constexpr int CV_SCR = ML_END, CV_SCRW = 32 * 33 * 4;
static_assert(CV_SCR + 8 * CV_SCRW <= MISC_OFF, "conversion scratch");
struct CvItem { const float* src; bf16* dst; int ldw, K; };
__device__ __forceinline__ CvItem cv_item(const Args& a, int mi) {
    const int it = mi >> 1, hk = mi & 1; CvItem r;
    if (it < 32 * 16 * 32) { const int e = it >> 9, q = it & 511, kb = q >> 5, nb = q & 31, t = nb >> 3, bj = (nb >> 2) & 1, i0 = (nb & 3) * 32, k0 = 64 * kb + 32 * hk;
        r.src = (bj ? a.in[IN_WEU] : a.in[IN_WEG]) + (size_t)e * 1024 * 512 + (size_t)k0 * 512 + 128 * t + i0; r.ldw = 512; r.K = 1024;
        r.dst = (bf16*)(a.ws + WS_GU) + ((size_t)e * 1024 + 32 * nb) * 1024 + k0;
    } else { const int r2 = it - 32 * 16 * 32, e = r2 >> 8, q = r2 & 255, kb = q >> 5, nb = q & 31, k0 = 64 * kb + 32 * hk;
        r.src = a.in[IN_WED] + (size_t)e * 512 * 1024 + (size_t)k0 * 1024 + 32 * nb; r.ldw = 1024; r.K = 512;
        r.dst = (bf16*)(a.ws + WS_DN) + ((size_t)e * 1024 + 32 * nb) * 512 + k0; }
    return r;
}
__device__ __forceinline__ void cv_load(const CvItem& it, f32x4 (&v)[4], int lane) {
#pragma unroll
    for (int i = 0; i < 4; ++i) v[i] = *(const f32x4*)(it.src + (size_t)(8 * i + (lane >> 3)) * it.ldw + 4 * (lane & 7));
}
__device__ __forceinline__ void cv_finish(const CvItem& it, const f32x4 (&v)[4], LAS float* scr, int lane, bool valid) {
#pragma unroll
    for (int i = 0; i < 4; ++i) { LAS float* d = scr + (8 * i + (lane >> 3)) * 33 + 4 * (lane & 7); d[0] = v[i][0]; d[1] = v[i][1]; d[2] = v[i][2]; d[3] = v[i][3]; }
    LDS_WAIT(); asm volatile("" ::: "memory");
#pragma unroll
    for (int j = 0; j < 2; ++j) { const int n = (lane >> 2) + 16 * j, cq = lane & 3; const LAS float* sp = scr + (8 * cq) * 33 + n;
        v4u o; o.x = pk2(sp[0 * 33], sp[1 * 33]); o.y = pk2(sp[2 * 33], sp[3 * 33]); o.z = pk2(sp[4 * 33], sp[5 * 33]); o.w = pk2(sp[6 * 33], sp[7 * 33]);
        if (valid) *(v4u*)(it.dst + (size_t)n * it.K + 8 * cq) = o; }
    LDS_WAIT(); asm volatile("" ::: "memory");
}
template <int MODE>
__device__ __forceinline__ void mlstm_unit(const Args& a, const Ctx& c, int b, int h, int g) {
    const int tid = c.tid, wave = c.wave; LAS unsigned char* lds = c.lds;
#define ML_LAUNDER() int tv_ = tid; asm volatile("" : "+v"(tv_)); const int lane = tv_ & 63, seg = tv_ & 15, r2 = (tv_ >> 4) * 2; (void)lane; (void)seg; (void)r2
    const bf16* PQ = proj_tile(a, TL_MQ + (h >> 1)) + (h & 1) * 128;
    const bf16* PK = proj_tile(a, TL_MK + (h >> 1)) + (h & 1) * 128;
    const bf16* PV = proj_tile(a, TL_MV + (h >> 1)) + (h & 1) * 128;
    const bf16* PO = proj_tile(a, TL_MO + (h >> 1)) + (h & 1) * 128;
    const bf16* PS = (const bf16*)((unsigned char*)a.out + DO_SMB);
    bf16* YML = (bf16*)((unsigned char*)a.out + DO_YML);
    unsigned char* STB = a.ws + WS_MLST; float* MST = (float*)(a.ws + WS_MLST + 256 * ML_STATE_BYTES);
    LAS float* GAa = (LAS float*)(lds + ML_GA); LAS float* GAm = GAa + 64; LAS float* GAw = GAa + 128; LAS float* GAe = GAa + 192;
    LAS float* CWQ = (LAS float*)(lds + ML_CW); LAS float* CWK = CWQ + 512; LAS float* CBQ = CWQ + 1024; LAS float* CBK = CBQ + 128; LAS float* GN = CBK + 128;
    LAS bf16* VTs = (LAS bf16*)(lds + ML_VT);
    { const float* wc = a.in[IN_WCONV]; const int j = tid >> 7, d = tid & 127;
      CWQ[tid] = wc[j * 1024 + h * 128 + d]; CWK[tid] = wc[j * 1024 + 512 + h * 128 + d];
      if (tid < 128) { CBQ[tid] = a.in[IN_BCONV][h * 128 + tid]; CBK[tid] = a.in[IN_BCONV][512 + h * 128 + tid]; GN[tid] = a.in[IN_GML][h * 128 + tid]; } }
    for (int i = tid; i < 16 * 64; i += 512) { const int r = i >> 6, cc = i & 63; VTs[(128 + r) * 72 + cc] = (r == 0) ? (bf16)0x3F80 : (bf16)0; }
    const float big = a.in[IN_BI][h], bfg = a.in[IN_BF][h];
    const int slot0 = (b * 4 + h) * 8;
    f32x4 cacc[9];
    float m_st = 0.f;
    if (MODE == 1 && g > 0) { ML_LAUNDER();
        const f32x4* sp = (const f32x4*)(STB + (size_t)(slot0 + g) * ML_STATE_BYTES) + wave * 576 + lane;
#pragma unroll
        for (int i = 0; i < 9; ++i) cacc[i] = sp[64 * i];
        m_st = MST[slot0 + g];
#pragma unroll
        for (int ee = 0; ee < 9; ++ee) { v2u w; w.x = pk2(cacc[ee][0], cacc[ee][1]); w.y = pk2(cacc[ee][2], cacc[ee][3]);
            *(LAS v2u*)(lds + ML_CT + (ee * 16 + (lane & 15)) * 272 + (wave * 16 + 4 * (lane >> 4)) * 2) = w; }
    } else {
#pragma unroll
        for (int i = 0; i < 9; ++i) cacc[i] = (f32x4){0.f, 0.f, 0.f, 0.f};
        for (int i = tid; i < 144 * 136 / 2; i += 512) ((LAS unsigned*)(lds + ML_CT))[i] = 0u;
    }
    const size_t tb = (size_t)b * SEQ;
    const char* bq = (const char*)(PQ + tb * 256); const char* bk = (const char*)(PK + tb * 256); const char* bv = (const char*)(PV + tb * 256); const char* bo = (const char*)(PO + tb * 256); const char* bs = (const char*)(PS + tb * 16);
    v4u rq[5], rk[5], rv[2]; unsigned short gi = 0, gf = 0;
#define ML_LOAD(kc) do { _Pragma("unroll") for (int j_ = 0; j_ < 5; ++j_) { const int rr_ = 64 * (kc) + r2 - 3 + j_; const unsigned o_ = (unsigned)((rr_ < 0 ? 0 : rr_) * 512 + seg * 16); \
            v4u q_ = (v4u){0u, 0u, 0u, 0u}; if (MODE == 1) q_ = *(const v4u*)(bq + o_); v4u k_ = *(const v4u*)(bk + o_); if (rr_ < 0) { q_ = (v4u){0u, 0u, 0u, 0u}; k_ = q_; } rq[j_] = q_; rk[j_] = k_; } \
        _Pragma("unroll") for (int i_ = 0; i_ < 2; ++i_) rv[i_] = *(const v4u*)(bv + (unsigned)((64 * (kc) + r2 + i_) * 512 + seg * 16)); \
        gi = *(const unsigned short*)(bs + (unsigned)((64 * (kc) + lane) * 32 + (8 + h) * 2)); gf = *(const unsigned short*)(bs + (unsigned)((64 * (kc) + lane) * 32 + (12 + h) * 2)); } while (0)
    const int kc0 = (MODE == 1) ? 8 * g : 0, kc1 = (MODE == 1) ? 8 * g + 8 : 56;
    { ML_LAUNDER(); ML_LOAD(kc0); }
    const int cv_gw = c.vcu * NWAVES + c.wave, cv_ngw = c.G * NWAVES; f32x4 cvv[4]; CvItem cvi; int cvk = 0; bool cvp = false;
    LAS float* cv_scr = (LAS float*)(lds + CV_SCR + wave * CV_SCRW);
#define CV_SLOT() do { if (MODE == 1) { ML_LAUNDER(); if (cvp) cv_finish(cvi, cvv, cv_scr, lane, cv_gw + (cvk - 1) * cv_ngw < CV_NMI); \
        { int mi_ = cv_gw + cvk * cv_ngw; mi_ = mi_ < CV_NMI ? mi_ : CV_NMI - 1; cvi = cv_item(a, __builtin_amdgcn_readfirstlane(mi_)); cv_load(cvi, cvv, lane); cvp = true; ++cvk; } } } while (0)
    __syncthreads();
#pragma unroll 1
    for (int kc = kc0; kc < kc1; ++kc) {
        float wkv, decay, m_new;
        if (MODE == 0 && kc > 0 && (kc & 7) == 0) { ML_LAUNDER();
            f32x4* sp = (f32x4*)(STB + (size_t)(slot0 + (kc >> 3)) * ML_STATE_BYTES) + wave * 576 + lane;
#pragma unroll
            for (int i = 0; i < 9; ++i) sp[64 * i] = cacc[i];
            if (tid == 0) MST[slot0 + (kc >> 3)] = m_st; }
        CV_SLOT();
        { ML_LAUNDER();
        const float fpre = bf2f(gf) + bfg, lf = fminf(fpre, 0.f) - log1pf(__expf(-fabsf(fpre)));
        const float ig = bf2f(gi) + big;
#define ML_SHR(x_, n_, id_) __int_as_float(__builtin_amdgcn_update_dpp(__float_as_int(id_), __float_as_int(x_), 0x110 + (n_), 0xF, 0xF, false))
        float bc = lf;
        bc += ML_SHR(bc, 1, 0.f); bc += ML_SHR(bc, 2, 0.f); bc += ML_SHR(bc, 4, 0.f); bc += ML_SHR(bc, 8, 0.f);
        { const float t0 = __int_as_float(__builtin_amdgcn_readlane(__float_as_int(bc), 15)), t1 = __int_as_float(__builtin_amdgcn_readlane(__float_as_int(bc), 31)), t2 = __int_as_float(__builtin_amdgcn_readlane(__float_as_int(bc), 47));
          bc += (lane >= 48) ? (t0 + t1 + t2) : ((lane >= 32) ? (t0 + t1) : ((lane >= 16) ? t0 : 0.f)); }
        const float av = ig - bc; float Ac = av;
        Ac = fmaxf(Ac, ML_SHR(Ac, 1, -3.0e38f)); Ac = fmaxf(Ac, ML_SHR(Ac, 2, -3.0e38f)); Ac = fmaxf(Ac, ML_SHR(Ac, 4, -3.0e38f)); Ac = fmaxf(Ac, ML_SHR(Ac, 8, -3.0e38f));
        { const float t0 = __int_as_float(__builtin_amdgcn_readlane(__float_as_int(Ac), 15)), t1 = __int_as_float(__builtin_amdgcn_readlane(__float_as_int(Ac), 31)), t2 = __int_as_float(__builtin_amdgcn_readlane(__float_as_int(Ac), 47));
          const float m01 = fmaxf(t0, t1), m012 = fmaxf(m01, t2);
          Ac = fmaxf(Ac, (lane >= 48) ? m012 : ((lane >= 32) ? m01 : ((lane >= 16) ? t0 : -3.0e38f))); }
#undef ML_SHR
        const float mA = fmaxf(m_st, Ac), Mk = __int_as_float(__builtin_amdgcn_readlane(__float_as_int(mA), 63)), blast = __int_as_float(__builtin_amdgcn_readlane(__float_as_int(bc), 63));
        wkv = __expf(av - Mk); decay = __expf(m_st - Mk); m_new = blast + Mk;
        if (MODE == 1 && wave == 0) { GAa[lane] = av; GAm[lane] = mA; GAw[lane] = __expf(m_st - mA); GAe[lane] = __expf(-(bc + mA)); } }
        { ML_LAUNDER(); float kw_[2][8];
#pragma unroll
          for (int i = 0; i < 2; ++i) { const int t = r2 + i; const float wkt = __shfl(wkv, t);
            float aq_[8], ak_[8];
            { const f32x4 b0 = *(const LAS f32x4*)(CBQ + seg * 8), b1 = *(const LAS f32x4*)(CBQ + seg * 8 + 4), c0 = *(const LAS f32x4*)(CBK + seg * 8), c1 = *(const LAS f32x4*)(CBK + seg * 8 + 4);
              aq_[0] = b0[0]; aq_[1] = b0[1]; aq_[2] = b0[2]; aq_[3] = b0[3]; aq_[4] = b1[0]; aq_[5] = b1[1]; aq_[6] = b1[2]; aq_[7] = b1[3];
              ak_[0] = c0[0]; ak_[1] = c0[1]; ak_[2] = c0[2]; ak_[3] = c0[3]; ak_[4] = c1[0]; ak_[5] = c1[1]; ak_[6] = c1[2]; ak_[7] = c1[3]; }
#pragma unroll
            for (int j = 0; j < 4; ++j) { float fk_[8]; unpack8(rk[i + j], fk_);
                const f32x4 x0 = *(const LAS f32x4*)(CWK + j * 128 + seg * 8), x1 = *(const LAS f32x4*)(CWK + j * 128 + seg * 8 + 4);
#pragma unroll
                for (int e = 0; e < 4; ++e) { ak_[e] += x0[e] * fk_[e]; ak_[4 + e] += x1[e] * fk_[4 + e]; }
                if (MODE == 1) { float fq_[8]; unpack8(rq[i + j], fq_);
                    const f32x4 w0 = *(const LAS f32x4*)(CWQ + j * 128 + seg * 8), w1 = *(const LAS f32x4*)(CWQ + j * 128 + seg * 8 + 4);
#pragma unroll
                    for (int e = 0; e < 4; ++e) { aq_[e] += w0[e] * fq_[e]; aq_[4 + e] += w1[e] * fq_[4 + e]; } } }
#pragma unroll
            for (int e = 0; e < 8; ++e) { ak_[e] = ak_[e] * sigm(ak_[e]) * 0.08838834764831845f; kw_[i][e] = ak_[e] * wkt; }
            if (MODE == 1) {
#pragma unroll
                for (int e = 0; e < 8; ++e) aq_[e] = aq_[e] * sigm(aq_[e]);
                *(LAS v4u*)(lds + ML_QS + t * 272 + seg * 16) = pack8(aq_);
                *(LAS v4u*)(lds + ML_KS + t * 272 + seg * 16) = pack8(ak_); } }
          const unsigned va[4] = {rv[0].x, rv[0].y, rv[0].z, rv[0].w}, vb[4] = {rv[1].x, rv[1].y, rv[1].z, rv[1].w};
          const int swo = 16 * (((r2 >> 3) + seg) & 7) + 2 * (r2 & 7);
#pragma unroll
          for (int e = 0; e < 8; ++e) { const int ro = (seg * 8 + e) * 144 + swo;
              *(LAS unsigned*)(lds + ML_KWT + ro) = pk2(kw_[0][e], kw_[1][e]);
              const unsigned lo = (e & 1) ? (va[e >> 1] >> 16) : (va[e >> 1] & 0xffffu), hi = (e & 1) ? (vb[e >> 1] >> 16) : (vb[e >> 1] & 0xffffu);
              *(LAS unsigned*)(lds + ML_VT + ro) = lo | (hi << 16); }
        if (kc + 1 < kc1) ML_LOAD(kc + 1); }
        __syncthreads();
        f32x4 hacc[5]; unsigned mo_r[8];
        const int tt = wave & 3, t0 = tt * 16, ne = (wave < 4) ? 5 : 4, e_first = (wave < 4) ? 0 : 5;
        CV_SLOT();
        if (MODE == 1) {
        { ML_LAUNDER(); const int tq = t0 + (lane & 15);
        bf16x8 qf[4];
#pragma unroll
        for (int ks = 0; ks < 4; ++ks) qf[ks] = lds_frag(lds + ML_QS, 272, t0, ks * 64, lane);
        const float mAt = GAm[tq], wit = GAw[tq];
#pragma unroll
        for (int si = 0; si < 2; ++si) { const int ss = 2 * (wave >> 2) + si, s0 = ss * 16; f32x4 sacc = (f32x4){0.f, 0.f, 0.f, 0.f};
            if (ss <= tt) {
#pragma unroll
                for (int ks = 0; ks < 4; ++ks) sacc = MFMA16(lds_frag(lds + ML_KS, 272, s0, ks * 64, lane), qf[ks], sacc);
#pragma unroll
                for (int r = 0; r < 4; ++r) { const int s = s0 + 4 * (lane >> 4) + r; sacc[r] = (s <= tq) ? sacc[r] * __expf(GAa[s] - mAt) : 0.f; } }
            v2u w; w.x = pk2(sacc[0], sacc[1]); w.y = pk2(sacc[2], sacc[3]);
            *(LAS v2u*)(lds + ML_SW + tq * 144 + s0 * 2 + (lane >> 4) * 8) = w; }
#pragma unroll
        for (int i = 0; i < 5; ++i) { hacc[i] = (f32x4){0.f, 0.f, 0.f, 0.f};
            if (i < ne) {
#pragma unroll
                for (int ks = 0; ks < 4; ++ks) hacc[i] = MFMA16(lds_frag(lds + ML_CT, 272, (e_first + i) * 16, ks * 64, lane), qf[ks], hacc[i]);
                hacc[i] = hacc[i] * wit; } }
#pragma unroll
        for (int i = 0; i < 8; ++i) mo_r[i] = *(const unsigned*)(bo + (unsigned)((64 * kc + 8 * wave + i) * 512 + 4 * lane)); }
        __syncthreads();
        { ML_LAUNDER(); const int tq = t0 + (lane & 15); bf16x8 swf[2];
#pragma unroll
          for (int ks = 0; ks < 2; ++ks) swf[ks] = lds_frag(lds + ML_SW, 144, t0, ks * 64, lane);
#pragma unroll
          for (int i = 0; i < 5; ++i) if (i < ne) { const int ee = e_first + i;
#pragma unroll
              for (int ks = 0; ks < 2; ++ks) hacc[i] = MFMA16(lds_frag_sw(lds + ML_VT, ee * 16, ks, lane), swf[ks], hacc[i]);
              if (ee < 8) *(LAS f32x4*)(lds + ML_HS + tq * 528 + (ee * 16 + 4 * (lane >> 4)) * 4) = hacc[i];
              else if ((lane >> 4) == 0) *(LAS float*)(lds + ML_HS + tq * 528 + 128 * 4) = hacc[i][0]; } }
        }
        CV_SLOT();
        { ML_LAUNDER(); const int d0 = wave * 16; bf16x8 kwf[2];
#pragma unroll
          for (int ks = 0; ks < 2; ++ks) kwf[ks] = lds_frag_sw(lds + ML_KWT, d0, ks, lane);
#pragma unroll
          for (int ee = 0; ee < 9; ++ee) { cacc[ee] = cacc[ee] * decay;
#pragma unroll
              for (int ks = 0; ks < 2; ++ks) cacc[ee] = MFMA16(kwf[ks], lds_frag_sw(lds + ML_VT, ee * 16, ks, lane), cacc[ee]);
              if (MODE == 1) { v2u w; w.x = pk2(cacc[ee][0], cacc[ee][1]); w.y = pk2(cacc[ee][2], cacc[ee][3]);
                  *(LAS v2u*)(lds + ML_CT + (ee * 16 + (lane & 15)) * 272 + (d0 + 4 * (lane >> 4)) * 2) = w; } } }
        __syncthreads();
        if (MODE == 1) {
        { ML_LAUNDER();
#pragma unroll
        for (int i = 0; i < 8; ++i) { const int t = 8 * wave + i;
            const f32x2 nv = *(const LAS f32x2*)(lds + ML_HS + t * 528 + lane * 8); const float den = *(const LAS float*)(lds + ML_HS + t * 528 + 512);
            const float dd = fmaxf(fabsf(den), GAe[t]); const float h0 = nv.x / dd, h1 = nv.y / dd;
            const float r = rsqrtf(wave_sum(h0 * h0 + h1 * h1) * (1.f / 128.f) + EPS);
            const float y0 = h0 * r * GN[2 * lane] * sigm(bf2f(mo_r[i] & 0xffffu)), y1 = h1 * r * GN[2 * lane + 1] * sigm(bf2f(mo_r[i] >> 16));
            *(unsigned*)(YML + (tb + 64 * kc + t) * 512 + h * 128 + 2 * lane) = pk2(y0, y1); } }
        __syncthreads();
        }
        m_st = m_new;
    }
    if (MODE == 1) { ML_LAUNDER(); if (cvp) cv_finish(cvi, cvv, cv_scr, lane, cv_gw + (cvk - 1) * cv_ngw < CV_NMI); }
#undef CV_SLOT
    if (MODE == 0) { ML_LAUNDER();
        f32x4* sp = (f32x4*)(STB + (size_t)(slot0 + 7) * ML_STATE_BYTES) + wave * 576 + lane;
#pragma unroll
        for (int i = 0; i < 9; ++i) sp[64 * i] = cacc[i];
        if (tid == 0) MST[slot0 + 7] = m_st; }
#undef ML_LOAD
#undef ML_LAUNDER
}
constexpr int AT_HIST = 0;
constexpr int AT_HROW = 2049;
constexpr int AT_SEL = 131072 + 256;
constexpr int AT_MROW = 129;
constexpr int AT_SM = AT_SEL + 8448;
constexpr int AT_LUT = AT_SM + 256;
constexpr int AT_SEL2 = AT_LUT + 256;
static_assert(AT_SEL2 + 8448 <= MISC_OFF, "attention LDS map");
__device__ __forceinline__ unsigned score_key(float s) { unsigned u = __float_as_uint(s + 0.0f); return (u & 0x80000000u) ? ~u : (u | 0x80000000u); }
__device__ __forceinline__ unsigned wave_suffix_sum(unsigned v, int lane) {
#define AT_SHL(x_, n_) ((unsigned)__builtin_amdgcn_update_dpp(0, (int)(x_), 0x100 + (n_), 0xF, 0xF, false))
    v += AT_SHL(v, 1); v += AT_SHL(v, 2); v += AT_SHL(v, 4); v += AT_SHL(v, 8);
#undef AT_SHL
    const unsigned t1 = (unsigned)__builtin_amdgcn_readlane((int)v, 16), t2 = (unsigned)__builtin_amdgcn_readlane((int)v, 32), t3 = (unsigned)__builtin_amdgcn_readlane((int)v, 48);
    return v + ((lane < 16) ? (t1 + t2 + t3) : ((lane < 32) ? (t2 + t3) : ((lane < 48) ? t3 : 0u)));
}
template <int NK> __device__ __forceinline__ void at_resolve(const LAS unsigned long long* cand, LAS unsigned* mask, int m, int nd, int lane) {
    unsigned long long cv[NK];
#pragma unroll
    for (int k = 0; k < NK; ++k) { const int i = 64 * k + lane; unsigned long long x = 0ull; if (i < m) x = cand[i]; cv[k] = (i < m) ? ((((x >> 32) & 0xFFFFFull) << 16) | (x & 0xFFFFull)) : 0ull; }
    unsigned long long T = 0ull;
#pragma unroll 1
    for (int bit = 35; bit >= 16; --bit) { const unsigned long long test = T | (1ull << bit); int cge = 0;
#pragma unroll
        for (int k = 0; k < NK; ++k) cge += __popcll(__ballot(cv[k] >= test));
        if (cge >= nd) T = test; }
    int g = 0, t = 0;
#pragma unroll
    for (int k = 0; k < NK; ++k) { g += __popcll(__ballot(cv[k] >= T + 0x10000ull)); t += __popcll(__ballot(cv[k] >= T)); }
    t -= g;
    if (t > nd - g) {
#pragma unroll 1
        for (int bit = 15; bit >= 0; --bit) { const unsigned long long test = T | (1ull << bit); int cge = 0;
#pragma unroll
            for (int k = 0; k < NK; ++k) cge += __popcll(__ballot(cv[k] >= test));
            if (cge >= nd) T = test; } }
#pragma unroll
    for (int k = 0; k < NK; ++k) if (cv[k] >= T && cv[k] != 0ull) { const unsigned key = 0xFFFFu - (unsigned)(cv[k] & 0xFFFFull);
        __hip_atomic_fetch_or(&mask[key >> 5], 1u << (key & 31u), __ATOMIC_RELAXED, __HIP_MEMORY_SCOPE_WORKGROUP); }
}
__device__ __forceinline__ void attn_unit(const Args& a, const Ctx& c, int b, int qt, float cshift) {
    const int tid = c.tid, wave = c.wave; LAS unsigned char* lds = c.lds;
#define AT_LAUNDER() int tv_ = tid; asm volatile("" : "+v"(tv_)); const int lane = tv_ & 63, qi = tv_ & 15, fq = (tv_ >> 4) & 3; (void)lane; (void)qi; (void)fq
    const int q0u = qt * 32, ch = q0u >> 6, n = 64 * (ch + 1), ntiles = n >> 4;
    const size_t tb = (size_t)b * SEQ;
    unsigned char* dout = (unsigned char*)a.out;
    const bf16* AQN = (const bf16*)(dout + DO_AQN); const bf16* KN = (const bf16*)(dout + DO_KN); const bf16* IQR = (const bf16*)(dout + DO_IQR); const bf16* IKR = (const bf16*)(dout + DO_IKR);
    bf16* YATT = (bf16*)(dout + DO_YATT);
    const bf16* VB = proj_tile(a, TL_KV); const bf16* PS = (const bf16*)(dout + DO_SMB);
    LAS unsigned* HIST = (LAS unsigned*)(lds + AT_HIST);
    LAS unsigned long long* CAND = (LAS unsigned long long*)(lds + AT_HIST);
    LAS int* SM = (LAS int*)(lds + AT_SM);
    float* SC = (blockIdx.x < 240) ? (float*)(a.ws + WS_SC) + (size_t)blockIdx.x * (16 * 4096) : (float*)(a.ws + WS_SC2) + (size_t)(blockIdx.x - 240) * (16 * 4096);
#ifndef DBG_REP_DENSE
#define DBG_REP_DENSE 1
#endif
#pragma unroll 1
    for (int rsel = 0; rsel < 2; ++rsel) {
    const int q0 = q0u + 16 * rsel;
    LAS unsigned* MASK = (LAS unsigned*)(lds + (rsel ? AT_SEL2 : AT_SEL));
    if (n > 256) {
        for (int i = tid; i < 8192 + 4; i += 512) ((LAS v4u*)HIST)[i] = (v4u){0u, 0u, 0u, 0u};
        if (tid < 64) SM[tid] = 0;
        for (int i = tid; i < 16 * AT_MROW; i += 512) MASK[i] = 0u;
        bf16x8 qf[8]; float wv[8]; bf16x8 qsh, qsl;
        { AT_LAUNDER();
        const size_t trow = tb + q0 + qi;
#pragma unroll
        for (int h = 0; h < 8; ++h) qf[h] = *(const bf16x8*)(IQR + trow * 256 + h * 32 + 8 * fq);
        { float t8[8]; unpack8(*(const v4u*)(PS + trow * 16), t8);
#pragma unroll
          for (int h = 0; h < 8; ++h) wv[h] = t8[h] * 0.03125f; }
        { float qs[8];
#pragma unroll
          for (int j = 0; j < 8; ++j) qs[j] = 0.f;
#pragma unroll
          for (int h = 0; h < 8; ++h) { float f8[8]; unpack8(__builtin_bit_cast(v4u, qf[h]), f8);
#pragma unroll
            for (int j = 0; j < 8; ++j) qs[j] = __builtin_fmaf(wv[h], f8[j], qs[j]); }
          float hi8[8], lo8[8]; const v4u ph = pack8(qs); unpack8(ph, hi8);
#pragma unroll
          for (int j = 0; j < 8; ++j) lo8[j] = qs[j] - hi8[j];
          qsh = __builtin_bit_cast(bf16x8, ph); qsl = __builtin_bit_cast(bf16x8, pack8(lo8)); } }
        __syncthreads();
#define AT_LOADK(kt_) (*(const bf16x8*)(IKR + (tb + (size_t)(kt_) * 16 + qi) * 32 + 8 * fq))
#define AT_SCORES(kf_, sc_) do { \
        { const f32x4 l0_ = MFMA16(kf_, qsl, ((f32x4){0.f, 0.f, 0.f, 0.f})); const f32x4 l1_ = MFMA16(kf_, qsh, l0_); \
          _Pragma("unroll") for (int r_ = 0; r_ < 4; ++r_) sc_[r_] = l1_[r_]; } \
        _Pragma("unroll") for (int h_ = 0; h_ < 8; ++h_) { const f32x4 d_ = MFMA16(kf_, qf[h_], ((f32x4){0.f, 0.f, 0.f, 0.f})); \
            _Pragma("unroll") for (int r_ = 0; r_ < 4; ++r_) { sc_[r_] = __builtin_fmaf(wv[h_], __builtin_fabsf(d_[r_]), sc_[r_]); asm("" : "+v"(sc_[r_])); } } } while (0)
        const int cnt = (ntiles - wave + 7) >> 3;
#ifndef DBG_RA
#define DBG_RA 1
#endif
#pragma unroll 1
        for (int rA = 0; rA < DBG_RA; ++rA) { if (rA) { for (int i = tid; i < 8192 + 4; i += 512) ((LAS v4u*)HIST)[i] = (v4u){0u, 0u, 0u, 0u}; __syncthreads(); }
#define AT_LOADG(dst_, i0_) do { _Pragma("unroll") for (int j_ = 0; j_ < 8; ++j_) { int kt_ = wave + 8 * ((i0_) + j_); kt_ = kt_ < ntiles ? kt_ : ntiles - 1; dst_[j_] = AT_LOADK(kt_); } } while (0)
#define AT_P1GROUP(buf_, base_) do { _Pragma("unroll") for (int j2 = 0; j2 < 8; ++j2) { const bool valid = ((base_) + j2 < cnt); const int kt = wave + 8 * ((base_) + j2); float sc[4]; AT_SCORES(buf_[j2], sc); \
                if (valid) *(f32x4*)(SC + qi * 4096 + kt * 16 + 4 * fq) = (f32x4){sc[0], sc[1], sc[2], sc[3]}; \
                _Pragma("unroll") for (int r = 0; r < 4; ++r) { const unsigned bin = score_key(sc[r]) >> 20; \
                    __hip_atomic_fetch_add(&HIST[qi * AT_HROW + (bin >> 1)], valid ? (1u << ((bin & 1u) * 16)) : 0u, __ATOMIC_RELAXED, __HIP_MEMORY_SCOPE_WORKGROUP); } } } while (0)
        { AT_LAUNDER(); bf16x8 ka[8], kb[8]; AT_LOADG(ka, 0);
#pragma unroll 1
          for (int i0 = 0; i0 < cnt; i0 += 16) {
            AT_LOADG(kb, i0 + 8);
            AT_P1GROUP(ka, i0);
            AT_LOADG(ka, i0 + 16);
            AT_P1GROUP(kb, i0 + 8); } }
#undef AT_P1GROUP
        __syncthreads();
        }
#ifndef DBG_RB
#define DBG_RB 1
#endif
#pragma unroll 1
        for (int rB = 0; rB < DBG_RB; ++rB) {
#pragma unroll 1
        for (int j = 0; j < 2; ++j) { AT_LAUNDER(); const int q = 2 * wave + j; unsigned tot = 0;
            for (int i = 0; i < 32; ++i) { const unsigned w = HIST[q * AT_HROW + 32 * lane + ((i + lane) & 31)]; tot += (w & 0xffffu) + (w >> 16); }
            const unsigned suf = wave_suffix_sum(tot, lane);
            const unsigned long long mk = __ballot(suf >= 256u); const int L = 63 - __clzll((long long)mk);
            const unsigned above_L = (unsigned)__builtin_amdgcn_readlane((int)(suf - tot), L);
            const unsigned w2 = HIST[q * AT_HROW + 32 * L + (lane >> 1)]; const unsigned cb = (lane & 1) ? (w2 >> 16) : (w2 & 0xffffu);
            const unsigned sfx = wave_suffix_sum(cb, lane);
            const unsigned long long mk2 = __ballot(above_L + sfx >= 256u); const int l2 = 63 - __clzll((long long)mk2);
            if (lane == l2) { SM[q] = 64 * L + l2; SM[16 + q] = (int)(256u - (above_L + sfx - cb)); } }
        __syncthreads();
        }
#ifndef DBG_RC
#define DBG_RC 1
#endif
#pragma unroll 1
        for (int rC = 0; rC < DBG_RC; ++rC) { if (rC) { if (tid < 16) SM[48 + tid] = 0; __syncthreads(); }
        { AT_LAUNDER(); const int Bq = SM[qi]; f32x4 scur[8];
#define AT_LOADS(dst_, i0_) do { _Pragma("unroll") for (int j_ = 0; j_ < 8; ++j_) { int kt_ = wave + 8 * ((i0_) + j_); kt_ = kt_ < ntiles ? kt_ : ntiles - 1; dst_[j_] = *(const f32x4*)(SC + qi * 4096 + kt_ * 16 + 4 * fq); } } while (0)
#define AT_P2GROUP(buf_, base_) do { _Pragma("unroll") for (int j2 = 0; j2 < 8; ++j2) { const bool valid = ((base_) + j2 < cnt); const int kt = wave + 8 * ((base_) + j2); \
                unsigned nib = 0u, cnib = 0u; unsigned uu[4]; \
                _Pragma("unroll") for (int r = 0; r < 4; ++r) { uu[r] = score_key(buf_[j2][r]); const int bin = (int)(uu[r] >> 20); nib |= (bin > Bq) ? (1u << r) : 0u; cnib |= (bin == Bq) ? (1u << r) : 0u; } \
                if (!valid) { nib = 0u; cnib = 0u; } \
                if (cnib) { int p = __hip_atomic_fetch_add(&SM[48 + qi], (int)__popc(cnib), __ATOMIC_RELAXED, __HIP_MEMORY_SCOPE_WORKGROUP); \
                    _Pragma("unroll") for (int r = 0; r < 4; ++r) if ((cnib >> r) & 1u) { if (p < 512) CAND[qi * 1024 + p] = ((unsigned long long)uu[r] << 32) | (unsigned long long)(0xFFFFu - (unsigned)(kt * 16 + 4 * fq + r)); ++p; } } \
                if (nib) __hip_atomic_fetch_or(&MASK[qi * AT_MROW + (kt >> 1)], nib << (16 * (kt & 1) + 4 * fq), __ATOMIC_RELAXED, __HIP_MEMORY_SCOPE_WORKGROUP); } } while (0)
          f32x4 sb2[8];
          AT_LOADS(scur, 0);
#pragma unroll 1
          for (int i0 = 0; i0 < cnt; i0 += 16) {
            AT_LOADS(sb2, i0 + 8);
            AT_P2GROUP(scur, i0);
            AT_LOADS(scur, i0 + 16);
            AT_P2GROUP(sb2, i0 + 8); } }
#undef AT_P2GROUP
#undef AT_LOADS
        __syncthreads();
        }
#ifndef DBG_RD
#define DBG_RD 1
#endif
#pragma unroll 1
        for (int rD = 0; rD < DBG_RD; ++rD) {
#pragma unroll 1
        for (int j = 0; j < 2; ++j) { AT_LAUNDER(); const int q = 2 * wave + j; int m = SM[48 + q]; m = m < 512 ? m : 512; const int nd = SM[16 + q];
            if (m <= 256) at_resolve<4>(CAND + q * 1024, MASK + q * AT_MROW, m, nd, lane); else at_resolve<8>(CAND + q * 1024, MASK + q * AT_MROW, m, nd, lane); }
        __syncthreads();
        }
#undef AT_SCORES
#undef AT_LOADK
#undef AT_LOADG
    } else {
#pragma unroll 1
        for (int i = tid; i < 16 * AT_MROW; i += 512) MASK[i] = ((i % AT_MROW) < (n >> 5)) ? 0xFFFFFFFFu : 0u;
        __syncthreads();
    }
    }
#pragma unroll 1
    for (int rden = 0; rden < DBG_REP_DENSE; ++rden) {
    { const int g = wave >> 2, qh = (wave >> 1) & 1, hp = wave & 1, NS = n >> 6;
      const unsigned ring0 = (unsigned)(size_t)(lds + AT_HIST);
      if (tid < 64) *(LAS float*)(lds + AT_LUT + 4 * tid) = ((tid >> 2) >> (tid & 3)) & 1 ? -cshift : -1.0e30f;
      const bf16* dsrc[4]; unsigned ddst[4];
      { AT_LAUNDER();
#pragma unroll
        for (int i_ = 0; i_ < 4; ++i_) { const int in_ = 4 * wave + i_; const int row_ = 4 * (in_ & 15) + (lane >> 4), pos_ = lane & 15;
            dsrc[i_] = (in_ < 16) ? (KN + (tb + row_) * 128 + ((pos_ ^ (row_ & 15)) << 3)) : (VB + (tb + row_) * 256 + 128 + ((pos_ ^ (2 * (row_ & 7))) << 3));
            ddst[i_] = (unsigned)(in_ * 1024); } }
      const size_t dstep = (wave < 4) ? (size_t)64 * 128 : (size_t)64 * 256;
#define AT_STAGE(s_) do { const unsigned sb_ = ring0 + (unsigned)(((s_) & 3) * 32768); \
        _Pragma("unroll") for (int i_ = 0; i_ < 4; ++i_) { const bf16* src_ = dsrc[i_] + (size_t)(s_) * dstep; \
            const unsigned dst_ = __builtin_amdgcn_readfirstlane(sb_ + ddst[i_]); unsigned keep_; \
            asm volatile("s_mov_b32 %0, m0\n\ts_mov_b32 m0, %2\n\ts_nop 0\n\tglobal_load_lds_dwordx4 %1, off\n\ts_mov_b32 m0, %0" : "=&s"(keep_) : "v"(src_), "s"(dst_) : "memory"); } } while (0)
      bf16x8 qa[2], qb[2]; f32x4 oacc[2][4], lacc[2];
      { AT_LAUNDER();
#pragma unroll
        for (int hi = 0; hi < 2; ++hi) { const bf16* qp = AQN + (tb + q0u + 16 * qh + qi) * 512 + (g * 4 + 2 * hp + hi) * 64 + 8 * fq; qa[hi] = *(const bf16x8*)qp; qb[hi] = *(const bf16x8*)(qp + 32); } }
#pragma unroll
      for (int hi = 0; hi < 2; ++hi) { lacc[hi] = (f32x4){0.f, 0.f, 0.f, 0.f};
#pragma unroll
        for (int dt = 0; dt < 4; ++dt) oacc[hi][dt] = (f32x4){0.f, 0.f, 0.f, 0.f}; }
      const bf16x8 ones = (bf16x8){0x3F80, 0x3F80, 0x3F80, 0x3F80, 0x3F80, 0x3F80, 0x3F80, 0x3F80};
      asm volatile("s_waitcnt vmcnt(0)" ::: "memory");
#pragma unroll 1
      for (int s = 0; s < 3 && s < NS; ++s) AT_STAGE(s);
      typedef short s4_t __attribute__((ext_vector_type(4)));
      AT_LAUNDER();
      const LAS unsigned* mrow = (const LAS unsigned*)(lds + (qh ? AT_SEL2 : AT_SEL)) + qi * AT_MROW;
      const unsigned koff0 = (unsigned)(qi * 256 + (((g * 8 + fq) ^ qi) << 4)), koff1 = (unsigned)(qi * 256 + (((g * 8 + 4 + fq) ^ qi) << 4));
#define AT_LDK(kf_, ci_, slot_, tp_, mw_) do { const LAS unsigned char* kb_ = lds + AT_HIST + (slot_) * 32768 + (tp_) * 8192; \
          _Pragma("unroll") for (int t = 0; t < 2; ++t) { kf_[t][0] = *(const LAS bf16x8*)(kb_ + t * 4096 + koff0); kf_[t][1] = *(const LAS bf16x8*)(kb_ + t * 4096 + koff1); \
              ci_[t] = *(const LAS f32x4*)(lds + AT_LUT + ((((mw_) >> (16 * t + 4 * fq)) & 15u) << 4)); } } while (0)
#define AT_LDV(va_, slot_, vkh_) do { const LAS unsigned char* vb_ = lds + AT_HIST + (slot_) * 32768 + 16384 + (vkh_) * 8192; \
          _Pragma("unroll") for (int dt = 0; dt < 4; ++dt) { const int r1 = 4 * fq + (qi >> 2); const int ch_ = g * 8 + 2 * dt + ((lane & 3) >> 1); \
              const s4_t lo = __builtin_amdgcn_ds_read_tr16_b64_v4i16((LAS s4_t*)(vb_ + r1 * 256 + ((ch_ ^ (2 * (r1 & 7))) << 4) + (lane & 1) * 8)); \
              const s4_t hi4 = __builtin_amdgcn_ds_read_tr16_b64_v4i16((LAS s4_t*)(vb_ + (r1 + 16) * 256 + ((ch_ ^ (2 * (r1 & 7))) << 4) + (lane & 1) * 8)); \
              va_[dt] = (bf16x8){lo[0], lo[1], lo[2], lo[3], hi4[0], hi4[1], hi4[2], hi4[3]}; } } while (0)
#define AT_QKM(dst_, kf_, ci_) do { \
          _Pragma("unroll") for (int t = 0; t < 2; ++t) { \
              _Pragma("unroll") for (int hi = 0; hi < 2; ++hi) { const f32x4 d_ = MFMA16(kf_[t][0], qa[hi], ci_[t]); dst_[hi][t] = MFMA16(kf_[t][1], qb[hi], d_); } } } while (0)
#define AT_EXP(pb_, cur_) do { \
          _Pragma("unroll") for (int hi = 0; hi < 2; ++hi) { float pv[8]; \
              _Pragma("unroll") for (int j = 0; j < 8; ++j) pv[j] = __builtin_amdgcn_exp2f(cur_[hi][j >> 2][j & 3]); \
              v4u pw; pw.x = pk2(pv[0], pv[1]); pw.y = pk2(pv[2], pv[3]); pw.z = pk2(pv[4], pv[5]); pw.w = pk2(pv[6], pv[7]); pb_[hi] = __builtin_bit_cast(bf16x8, pw); } } while (0)
#define AT_PV(pb_, va_) do { \
          _Pragma("unroll") for (int hi = 0; hi < 2; ++hi) lacc[hi] = MFMA16(ones, pb_[hi], lacc[hi]); \
          _Pragma("unroll") for (int dt = 0; dt < 4; ++dt) { \
              _Pragma("unroll") for (int hi = 0; hi < 2; ++hi) oacc[hi][dt] = MFMA16(va_[dt], pb_[hi], oacc[hi][dt]); } } while (0)
      f32x4 st0[2][2], st1[2][2]; bf16x8 kfA[2][2], kfB[2][2]; f32x4 ciA[2], ciB[2]; bf16x8 vaP[4], vaQ[4], pbP[2], pbQ[2];
      if (NS >= 3) asm volatile("s_waitcnt vmcnt(8)" ::: "memory"); else asm volatile("s_waitcnt vmcnt(0)" ::: "memory");
      __builtin_amdgcn_s_barrier(); asm volatile("" ::: "memory");
      unsigned m1A, m1B;
      { const unsigned m0A = mrow[0], m0B = mrow[1]; const int sx = (NS > 1) ? 1 : 0; m1A = mrow[2 * sx]; m1B = mrow[2 * sx + 1];
        AT_LDK(kfB, ciB, 0, 0, m0A); AT_LDK(kfA, ciA, 0, 1, m0B);
        AT_QKM(st0, kfB, ciB);
#pragma unroll
        for (int hi = 0; hi < 2; ++hi) pbP[hi] = (bf16x8){0, 0, 0, 0, 0, 0, 0, 0};
#pragma unroll
        for (int dt = 0; dt < 4; ++dt) vaP[dt] = (bf16x8){0, 0, 0, 0, 0, 0, 0, 0}; }
#pragma unroll 1
      for (int s = 0; s < NS; ++s) {
          if (s + 2 < NS) asm volatile("s_waitcnt vmcnt(4)" ::: "memory"); else asm volatile("s_waitcnt vmcnt(0)" ::: "memory");
          __builtin_amdgcn_s_barrier(); asm volatile("" ::: "memory");
          if (s + 3 < NS) AT_STAGE(s + 3);
          const int s1 = (s + 1 < NS) ? s + 1 : s, s2 = (s + 2 < NS) ? s + 2 : NS - 1;
          const unsigned m2A = mrow[2 * s2], m2B = mrow[2 * s2 + 1];
          AT_LDK(kfB, ciB, (s1 & 3), 0, m1A); AT_LDV(vaQ, (s & 3), 0);
          AT_QKM(st1, kfA, ciA); AT_EXP(pbQ, st0); AT_PV(pbP, vaP);
          __builtin_amdgcn_sched_barrier(0);
          AT_LDK(kfA, ciA, (s1 & 3), 1, m1B); AT_LDV(vaP, (s & 3), 1);
          AT_QKM(st0, kfB, ciB); AT_EXP(pbP, st1); AT_PV(pbQ, vaQ);
          __builtin_amdgcn_sched_barrier(0);
          m1A = m2A; m1B = m2B; }
      AT_PV(pbP, vaP);
#undef AT_LDK
#undef AT_LDV
#undef AT_QKM
#undef AT_EXP
#undef AT_PV
      { AT_LAUNDER();
#pragma unroll
        for (int hi = 0; hi < 2; ++hi) { const float inv = 1.0f / lacc[hi][0];
            bf16* yp = YATT + (tb + q0u + 16 * qh + qi) * 512 + (g * 4 + 2 * hp + hi) * 64 + 4 * fq;
#pragma unroll
            for (int dt = 0; dt < 4; ++dt) { const f32x4 o = oacc[hi][dt];
                v2u w; w.x = pk2(o[0] * inv, o[1] * inv); w.y = pk2(o[2] * inv, o[3] * inv); *(v2u*)(yp + 16 * dt) = w; } } }
#undef AT_STAGE
    }
    __syncthreads();
    }
#undef AT_LAUNDER
    __syncthreads();
}

#ifndef DBG_REP_ML
#define DBG_REP_ML 1
#endif
#ifndef DBG_REP_ATT
#define DBG_REP_ATT 1
#endif
__device__ __forceinline__ void p3_mixer(const Args& a, const Ctx& c, volatile LAS unsigned* MISC, int rep) {
#if !defined(NO_MLSTM)
#pragma unroll 1
    for (int rr = 0; rr < DBG_REP_ML; ++rr)
#pragma unroll 1
        for (int u = blockIdx.x; u < 32; u += c.G) mlstm_unit<0>(a, c, u >> 2, u & 3, 0);
#endif
    unsigned* ctl = (unsigned*)(a.ws + WS_CTL);
    const int x = (int)(__builtin_amdgcn_s_getreg((3 << 11) | 20) & 7u);
    float cshift;
    { float gq = fabsf(a.in[IN_GQ][c.lane]), gk = fabsf(a.in[IN_GK][c.lane]);
#pragma unroll
      for (int o = 1; o < 64; o <<= 1) { gq = fmaxf(gq, __shfl_xor(gq, o)); gk = fmaxf(gk, __shfl_xor(gk, o)); }
      cshift = 8.0f * 1.4426950408889634f * gq * gk; }
#pragma unroll 1
    for (int rot = 0; rot < 8 * DBG_REP_ATT; ++rot) { rep = rot >> 3; const int bq = (x + rot) & 7;
        if (c.tid == 0) MISC[16] = __hip_atomic_fetch_add(ctl + CW_Q + 512 * rep + 64 * bq, 1u, RLX_AGENT);
        __syncthreads();
        int u = (int)MISC[16];
        __syncthreads();
#pragma unroll 1
        while (u < 128) {
            unsigned nxt = 0u;
            if (c.tid == 0) nxt = __hip_atomic_fetch_add(ctl + CW_Q + 512 * rep + 64 * bq, 1u, RLX_AGENT);
#if !defined(NO_ATTN)
            attn_unit(a, c, bq, 127 - u, cshift);
#endif
            if (c.tid == 0) MISC[16] = nxt;
            __syncthreads();
            u = (int)MISC[16];
            __syncthreads();
        } }
}
constexpr int RT_WT = 0;
constexpr int RT_WROW = 1028;
constexpr int RT_WBYTES = 36 * RT_WROW * 4;
constexpr int RT_NPIECE = (RT_WBYTES + 1023) / 1024;
constexpr int RT_LG = 0;
constexpr int RT_RSTD = RT_NPIECE * 1024;
constexpr int RT_LCNT = RT_RSTD + 512;
constexpr int RT_BIAS = RT_LCNT + 128;
static_assert(RT_BIAS + 144 <= MISC_OFF, "router LDS map");
__device__ __forceinline__ void p6_router(const Args& a, const Ctx& c) {
    const int tid = c.tid, lane = c.lane, wave = c.wave; LAS unsigned char* lds = c.lds;
    LAS float* WT = (LAS float*)(lds + RT_WT); LAS float* LG = (LAS float*)(lds + RT_LG); LAS float* RSTD = (LAS float*)(lds + RT_RSTD); LAS int* LCNT = (LAS int*)(lds + RT_LCNT); LAS float* BIAS = (LAS float*)(lds + RT_BIAS);
    { int* RT = (int*)(a.ws + WS_ROWTOK); for (int i = blockIdx.x * 512 + tid; i < NROWS_MAX; i += c.G * 512) RT[i] = 0; }
    if (tid < 36) BIAS[tid] = tid < 32 ? a.in[IN_BRE][tid] : a.in[IN_BRG][tid - 32];
    f32x4 gv[4];
#pragma unroll
    for (int j = 0; j < 4; ++j) gv[j] = *(const f32x4*)(a.in[IN_GMOE] + 4 * lane + 256 * j);
    const float* X1 = a.out; bf16* XN = (bf16*)(a.ws + WS_XN);
    int* TOKE = (int*)(a.ws + WS_TOKE); int* TOKR = (int*)(a.ws + WS_TOKR); float* TOKG = (float*)(a.ws + WS_TOKG); int* CNT = (int*)(a.ws + WS_CNT);
    for (int blk = blockIdx.x; blk < 256; blk += c.G) {
        __syncthreads();
        { const unsigned char* src = a.ws + WS_WTG;
#pragma unroll 1
          for (int pc = wave; pc < RT_NPIECE; pc += NWAVES)
              __builtin_amdgcn_global_load_lds((const unsigned*)(src + (size_t)pc * 1024 + lane * 16), (LAS unsigned*)(lds + RT_WT + pc * 1024), 16, 0, 0); }
        if (tid < 32) LCNT[tid] = 0;
#pragma unroll 1
        for (int ri = 0; ri < 16; ri += 4) { const int t0 = blk * 128 + wave * 16 + ri;
            f32x4 v[4][4]; float ss[4];
#pragma unroll
            for (int q = 0; q < 4; ++q) { const f32x4* xp = (const f32x4*)(X1 + (size_t)(t0 + q) * D) + lane;
#pragma unroll
                for (int j = 0; j < 4; ++j) v[q][j] = xp[64 * j]; }
#pragma unroll
            for (int q = 0; q < 4; ++q) { float sq = 0.f;
#pragma unroll
                for (int j = 0; j < 4; ++j) sq += (v[q][j].x * v[q][j].x + v[q][j].y * v[q][j].y) + (v[q][j].z * v[q][j].z + v[q][j].w * v[q][j].w);
                ss[q] = rsqrtf(wave_sum(sq) * (1.f / D) + EPS); }
            if (lane < 4) RSTD[wave * 16 + ri + lane] = (lane == 0) ? ss[0] : ((lane == 1) ? ss[1] : ((lane == 2) ? ss[2] : ss[3]));
#pragma unroll
            for (int q = 0; q < 4; ++q) { v2u* op = (v2u*)(XN + (size_t)(t0 + q) * D) + lane; const float r = ss[q];
#pragma unroll
                for (int j = 0; j < 4; ++j) { v2u w; w.x = pk2(v[q][j].x * r * gv[j].x, v[q][j].y * r * gv[j].y); w.y = pk2(v[q][j].z * r * gv[j].z, v[q][j].w * r * gv[j].w); op[64 * j] = w; } } }
        asm volatile("s_waitcnt vmcnt(0)" ::: "memory");
        __syncthreads();
        f32x4 acc[3];
#pragma unroll
        for (int ct = 0; ct < 3; ++ct) acc[ct] = (f32x4){0.f, 0.f, 0.f, 0.f};
        { const int row = lane & 15, kq = lane >> 4;
          const f32x4* ap = (const f32x4*)(X1 + (size_t)(blk * 128 + wave * 16 + row) * D + 4 * kq);
          int cj[3]; cj[0] = row; cj[1] = 16 + row; cj[2] = (32 + row) < 36 ? (32 + row) : 35;
          const LAS f32x4* bp0 = (const LAS f32x4*)(WT + cj[0] * RT_WROW + 4 * kq); const LAS f32x4* bp1 = (const LAS f32x4*)(WT + cj[1] * RT_WROW + 4 * kq); const LAS f32x4* bp2 = (const LAS f32x4*)(WT + cj[2] * RT_WROW + 4 * kq);
#define RT_LOADA(dst_, b_) do { _Pragma("unroll") for (int i_ = 0; i_ < 8; ++i_) dst_[i_] = ap[4 * (8 * ((b_) < 8 ? (b_) : 7) + i_)]; } while (0)
#define RT_MMA(src_, b_) do { _Pragma("unroll") for (int i_ = 0; i_ < 8; ++i_) { const int ks_ = 8 * (b_) + i_; const f32x4 b0 = bp0[4 * ks_], b1 = bp1[4 * ks_], b2 = bp2[4 * ks_]; \
              _Pragma("unroll") for (int j = 0; j < 4; ++j) { acc[0] = __builtin_amdgcn_mfma_f32_16x16x4f32(src_[i_][j], b0[j], acc[0], 0, 0, 0); acc[1] = __builtin_amdgcn_mfma_f32_16x16x4f32(src_[i_][j], b1[j], acc[1], 0, 0, 0); \
                  acc[2] = __builtin_amdgcn_mfma_f32_16x16x4f32(src_[i_][j], b2[j], acc[2], 0, 0, 0); } } } while (0)
          f32x4 aA[8], aB[8]; RT_LOADA(aA, 0);
#pragma unroll 1
          for (int bb = 0; bb < 8; bb += 2) { RT_LOADA(aB, bb + 1); RT_MMA(aA, bb); RT_LOADA(aA, bb + 2); RT_MMA(aB, bb + 1); }
#undef RT_LOADA
#undef RT_MMA
        }
        __syncthreads();
        { const int col = lane & 15, kq = lane >> 4;
#pragma unroll
          for (int ct = 0; ct < 3; ++ct) if (16 * ct + col < 36) {
#pragma unroll
              for (int r = 0; r < 4; ++r) LG[(wave * 16 + 4 * kq + r) * 36 + 16 * ct + col] = acc[ct][r]; } }
        __syncthreads();
        if (tid < 128) { const int row = tid, t = blk * 128 + row; const float rs = RSTD[row]; const LAS float* lg = LG + tid * 36;
            float gl[4];
#pragma unroll
            for (int i = 0; i < 4; ++i) gl[i] = rs * lg[32 + i] + BIAS[32 + i];
            int gs = 0; float gmax = gl[0];
#pragma unroll
            for (int i = 1; i < 4; ++i) if (gl[i] > gmax) { gmax = gl[i]; gs = i; }
            float gsum = 0.f;
#pragma unroll
            for (int i = 0; i < 4; ++i) gsum += expf(gl[i] - gmax);
            const float gtop = 1.0f / gsum;
            float ev[8];
#pragma unroll
            for (int i = 0; i < 8; ++i) ev[i] = rs * lg[gs * 8 + i] + BIAS[gs * 8 + i];
            int l0 = 0; float v0 = ev[0];
#pragma unroll
            for (int i = 1; i < 8; ++i) if (ev[i] > v0) { v0 = ev[i]; l0 = i; }
            int l1 = -1; float v1 = -3.0e38f;
#pragma unroll
            for (int i = 0; i < 8; ++i) if (i != l0 && ev[i] > v1) { v1 = ev[i]; l1 = i; }
            const float e1 = expf(v1 - v0), s0 = 1.0f / (1.0f + e1), s1 = e1 * s0;
            const int ex0 = gs * 8 + l0, ex1 = gs * 8 + l1;
            const int rk0 = __hip_atomic_fetch_add(&LCNT[ex0], 1, __ATOMIC_RELAXED, __HIP_MEMORY_SCOPE_WORKGROUP);
            const int rk1 = __hip_atomic_fetch_add(&LCNT[ex1], 1, __ATOMIC_RELAXED, __HIP_MEMORY_SCOPE_WORKGROUP);
            TOKE[2 * t] = ex0; TOKE[2 * t + 1] = ex1; TOKR[2 * t] = rk0; TOKR[2 * t + 1] = rk1; TOKG[2 * t] = s0 * gtop; TOKG[2 * t + 1] = s1 * gtop; }
        __syncthreads();
        if (tid < 32) CNT[blk * 32 + tid] = LCNT[tid];
    }
}
__device__ __forceinline__ void p7_gather(const Args& a, const Ctx& c) {
    const int tid = c.tid, lane = c.lane, wave = c.wave;
    LAS int* PART = (LAS int*)c.lds; LAS int* PPRE = PART + 512; LAS int* TOT = PPRE + 512; LAS int* TS = TOT + 32; LAS int* BASE = TS + 64;
    const int* CNT = (const int*)(a.ws + WS_CNT); const int* TOKE = (const int*)(a.ws + WS_TOKE); const int* TOKR = (const int*)(a.ws + WS_TOKR); int* TOKP = (int*)(a.ws + WS_TOKP);
    int* RT = (int*)(a.ws + WS_ROWTOK);
    { const int e = tid & 31, p = tid >> 5; int s = 0; for (int k = 0; k < 16; ++k) s += CNT[(16 * p + k) * 32 + e]; PART[p * 32 + e] = s; }
    __syncthreads();
    if (tid < 32) { int run = 0; for (int p = 0; p < 16; ++p) { PPRE[p * 32 + tid] = run; run += PART[p * 32 + tid]; } TOT[tid] = run; }
    __syncthreads();
    if (tid == 0) { int ts = 0; for (int e = 0; e < 32; ++e) { TS[e] = ts; ts += (TOT[e] + 255) >> 8; } TS[32] = ts; }
    __syncthreads();
    if (blockIdx.x == 0 && tid < 33) ((int*)(a.ws + WS_SMALL))[tid] = TS[tid];
    for (int blk = blockIdx.x; blk < 256; blk += c.G) {
        if (tid < 32) { int s = TS[tid] * 256 + PPRE[(blk >> 4) * 32 + tid]; for (int b2 = (blk & ~15); b2 < blk; ++b2) s += CNT[b2 * 32 + tid]; BASE[tid] = s; }
        __syncthreads();
        { const int t = blk * 128 + (tid >> 2), jj = tid & 3;
          if (jj < 2) { const int pos = BASE[TOKE[2 * t + jj]] + TOKR[2 * t + jj]; TOKP[2 * t + jj] = pos; RT[pos] = t; } }
        __syncthreads();
    }
}
__device__ __forceinline__ void p10_combine(const Args& a, const Ctx& c) {
    const int lane = c.lane, gw = c.vcu * NWAVES + c.wave, NGW = c.G * NWAVES;
    const int* TOKP = (const int*)(a.ws + WS_TOKP); const float* TOKG = (const float*)(a.ws + WS_TOKG); const bf16* Y = (const bf16*)(a.ws + WS_Y);
    for (int t0 = gw; t0 < T; t0 += 2 * NGW) {
        const int tA = t0, tB = (t0 + NGW < T) ? t0 + NGW : t0; const bool hasB = (t0 + NGW < T);
        const int pA0 = TOKP[2 * tA], pA1 = TOKP[2 * tA + 1], pB0 = TOKP[2 * tB], pB1 = TOKP[2 * tB + 1];
        const float gA0 = TOKG[2 * tA], gA1 = TOKG[2 * tA + 1], gB0 = TOKG[2 * tB], gB1 = TOKG[2 * tB + 1];
        f32x4 xa[4], xb[4]; v2u ya0[4], ya1[4], yb0[4], yb1[4];
#pragma unroll
        for (int j = 0; j < 4; ++j) { const int cc = 4 * lane + 256 * j;
            xa[j] = *(const f32x4*)(a.out + (size_t)tA * D + cc); xb[j] = *(const f32x4*)(a.out + (size_t)tB * D + cc);
            ya0[j] = *(const v2u*)(Y + (size_t)pA0 * D + cc); ya1[j] = *(const v2u*)(Y + (size_t)pA1 * D + cc);
            yb0[j] = *(const v2u*)(Y + (size_t)pB0 * D + cc); yb1[j] = *(const v2u*)(Y + (size_t)pB1 * D + cc); }
#pragma unroll
        for (int j = 0; j < 4; ++j) { const int cc = 4 * lane + 256 * j; f32x4 x = xa[j];
            x[0] += gA0 * bf2f(ya0[j].x & 0xffffu) + gA1 * bf2f(ya1[j].x & 0xffffu); x[1] += gA0 * bf2f(ya0[j].x >> 16) + gA1 * bf2f(ya1[j].x >> 16);
            x[2] += gA0 * bf2f(ya0[j].y & 0xffffu) + gA1 * bf2f(ya1[j].y & 0xffffu); x[3] += gA0 * bf2f(ya0[j].y >> 16) + gA1 * bf2f(ya1[j].y >> 16);
            *(f32x4*)(a.out + (size_t)tA * D + cc) = x; }
        if (hasB) {
#pragma unroll
        for (int j = 0; j < 4; ++j) { const int cc = 4 * lane + 256 * j; f32x4 x = xb[j];
            x[0] += gB0 * bf2f(yb0[j].x & 0xffffu) + gB1 * bf2f(yb1[j].x & 0xffffu); x[1] += gB0 * bf2f(yb0[j].x >> 16) + gB1 * bf2f(yb1[j].x >> 16);
            x[2] += gB0 * bf2f(yb0[j].y & 0xffffu) + gB1 * bf2f(yb1[j].y & 0xffffu); x[3] += gB0 * bf2f(yb0[j].y >> 16) + gB1 * bf2f(yb1[j].y >> 16);
            *(f32x4*)(a.out + (size_t)tB * D + cc) = x; } }
    }
}
__global__ void __launch_bounds__(NWAVES * 64, 2) hybrid_fwd(Args args) {
    extern __shared__ __attribute__((aligned(16))) unsigned char lds_raw[];
    Ctx c; c.lds = (LAS unsigned char*)lds_raw;
    volatile LAS unsigned* MISC = (volatile LAS unsigned*)(c.lds + MISC_OFF);
    c.tid = threadIdx.x; c.lane = c.tid & 63; c.wave = __builtin_amdgcn_readfirstlane(c.tid >> 6);
    c.G = gridDim.x; { const int bx = blockIdx.x; c.vcu = (c.G % 8 == 0) ? (bx % 8) * (c.G / 8) + bx / 8 : bx; }
    unsigned* ctl = (unsigned*)(args.ws + WS_CTL);
    if (c.tid < 128) MISC[c.tid] = 0u;
    __syncthreads();
    XcdBarrier bar; bar.bar = ctl + CW_BAR; bar.x = 0; bar.st = nullptr;
    if (N_LAUNCHES == 1) bar = xcd_barrier_post(ctl + CW_BAR, MISC + 8);
#define GRID_BAR() do { if (N_LAUNCHES == 1) xcd_barrier(bar); } while (0)
    const int lo = args.ph_lo, hi = args.ph_hi;
#ifndef PH_MASK
#define PH_MASK 0xfff
#endif
#define IN(k) (((PH_MASK >> (k)) & 1) && lo <= (k) && (k) < hi)
#define BOTH(k) (IN(k) && IN((k) + 1))
    unsigned char* ws = args.ws; unsigned char* dout = (unsigned char*)args.out;
#ifndef DBG_REPEAT
#define DBG_REPEAT -1
#endif
#define REPS(k) (((k) == DBG_REPEAT) ? 2 : 1)
    if (IN(0)) { _Pragma("unroll") for (int rep = 0; rep < REPS(0); ++rep) { if (rep) GRID_BAR(); p0_prologue<0>(args, c, c.vcu * NWAVES + c.wave, c.G * NWAVES); } if (BOTH(0)) GRID_BAR(); }
    if (IN(1)) { _Pragma("unroll") for (int rep = 0; rep < REPS(1); ++rep) { if (rep) GRID_BAR();
#ifdef DBG_STAGGER
        if ((blockIdx.x >> 3) & 1) { const unsigned long long t0 = wall_clock64(); while (wall_clock64() - t0 < (unsigned long long)DBG_STAGGER) __builtin_amdgcn_s_sleep(16); }
#endif
        pg8::Gemm g{(const pg8::bf16_t*)(dout + DO_H), (const pg8::bf16_t*)(ws + WS_WIN), T, NPROJ, D}; pg8::StaticOrder S; S.init(T, NPROJ, c.G, (int)blockIdx.x);
        pg8::EpiBf16<0> E{(pg8::bf16_t*)(ws + WS_PROJ), 256, nullptr, 256, (size_t)T * 256, 1.f};
        pg8::gemm_phase<pg8::EpiBf16<0>, pg8::StaticOrder, true, true>(c.lds, g, S, E); }
        if (BOTH(1)) GRID_BAR();
    }
#ifndef DBG_R2
#define DBG_R2 1
#endif
#ifndef DBG_R4A
#define DBG_R4A 1
#endif
#ifndef DBG_R4B
#define DBG_R4B 1
#endif
#ifndef DBG_R7
#define DBG_R7 1
#endif
    if (IN(2)) { _Pragma("unroll 1") for (int rep = 0; rep < DBG_R2; ++rep) { if (rep) GRID_BAR(); p2_prep(args, c); } if (BOTH(2)) GRID_BAR(); }
    if (IN(3)) { _Pragma("unroll") for (int rep = 0; rep < REPS(3); ++rep) { if (rep) GRID_BAR(); p3_mixer(args, c, MISC, rep); } if (BOTH(3)) GRID_BAR(); }
    if (IN(4)) {
#pragma unroll 1
        for (int rep = 0; rep < DBG_R4A; ++rep) {
            const int gw = c.vcu * NWAVES + c.wave, ngw = c.G * NWAVES, kdone = ((int)blockIdx.x < 256) ? 24 : 0;
            LAS float* scr = (LAS float*)(c.lds + CV_SCR + c.wave * CV_SCRW);
#pragma unroll 1
            for (int k = kdone; gw + k * ngw < CV_NMI; ++k) { const CvItem it = cv_item(args, gw + k * ngw); f32x4 v[4]; cv_load(it, v, c.lane); cv_finish(it, v, scr, c.lane, true); }
            __syncthreads(); }
#pragma unroll 1
        for (int rep = 0; rep < DBG_R4B; ++rep)
#pragma unroll 1
        for (int u = blockIdx.x; u < 256; u += c.G) mlstm_unit<1>(args, c, u >> 5, (u >> 3) & 3, u & 7);
        if (BOTH(4)) GRID_BAR();
    }
    if (IN(5)) {
        { pg8::Gemm g{(const pg8::bf16_t*)(dout + DO_YATT), (const pg8::bf16_t*)(ws + WS_WPA), T, D, 512}; pg8::StaticOrder S; S.init(T, D, c.G, (int)blockIdx.x);
          pg8::EpiGate<false> E{(pg8::bf16_t*)(ws + WS_MERGED), D, (const pg8::bf16_t*)(ws + WS_PROJ + (size_t)TL_GA * PROJ_TILE), (size_t)T * 256};
          pg8::gemm_phase<pg8::EpiGate<false>, pg8::StaticOrder, true, true>(c.lds, g, S, E); }
        __syncthreads();
        { pg8::Gemm g{(const pg8::bf16_t*)(dout + DO_YML), (const pg8::bf16_t*)(ws + WS_WPM), T, D, 512}; pg8::StaticOrder S; S.init(T, D, c.G, (int)blockIdx.x);
          pg8::EpiGate<true> E{(pg8::bf16_t*)(ws + WS_MERGED), D, (const pg8::bf16_t*)(ws + WS_PROJ + (size_t)TL_GM * PROJ_TILE), (size_t)T * 256};
          pg8::gemm_phase<pg8::EpiGate<true>, pg8::StaticOrder, true, true>(c.lds, g, S, E); }
        if (BOTH(5)) GRID_BAR();
    }
    if (IN(6)) {
        pg8::Gemm g{(const pg8::bf16_t*)(ws + WS_MERGED), (const pg8::bf16_t*)(ws + WS_WOUT), T, D, D}; pg8::StaticOrder S; S.init(T, D, c.G, (int)blockIdx.x);
        pg8::EpiRes E{args.out, args.in[IN_X], D};
        pg8::gemm_phase<pg8::EpiRes, pg8::StaticOrder, true, true>(c.lds, g, S, E);
        if (BOTH(6)) GRID_BAR();
    }
    if (IN(7)) { _Pragma("unroll 1") for (int rep = 0; rep < DBG_R7; ++rep) { if (rep) { GRID_BAR(); } p6_router(args, c); } if (BOTH(7)) GRID_BAR(); }
    if (IN(8)) { _Pragma("unroll") for (int rep = 0; rep < REPS(8); ++rep) { if (rep) GRID_BAR(); p7_gather(args, c); } if (BOTH(8)) GRID_BAR(); }
    if (IN(9) || IN(10)) {
        LAS int* TSL = (LAS int*)(c.lds + MISC_OFF + 256);
        if (c.tid < 33) TSL[c.tid] = (int)__hip_atomic_load((unsigned*)(ws + WS_SMALL) + c.tid, RLX_AGENT);
        __syncthreads();
        if (IN(9)) {
            pg8::MoeOrder<true> S{TSL, c.G, (int)blockIdx.x, (const int*)(ws + WS_ROWTOK)};
            pg8::Gemm g{(const pg8::bf16_t*)(ws + WS_XN), (const pg8::bf16_t*)(ws + WS_GU), 0, 0, D};
            pg8::EpiSwiGLU E{(pg8::bf16_t*)(ws + WS_HID)};
            pg8::gemm_phase<pg8::EpiSwiGLU, pg8::MoeOrder<true>, true, true>(c.lds, g, S, E);
            if (BOTH(9)) GRID_BAR();
        }
        if (IN(10)) {
            pg8::MoeOrder<false> S{TSL, c.G, (int)blockIdx.x, nullptr};
            pg8::Gemm g{(const pg8::bf16_t*)(ws + WS_HID), (const pg8::bf16_t*)(ws + WS_DN), 0, 0, 512};
            pg8::EpiDown E{(pg8::bf16_t*)(ws + WS_Y)};
            pg8::gemm_phase<pg8::EpiDown, pg8::MoeOrder<false>, true, true>(c.lds, g, S, E);
            if (BOTH(10)) GRID_BAR();
        }
    }
    if (IN(11)) p10_combine(args, c);
#undef IN
#undef BOTH
#undef GRID_BAR
}

extern "C" void kernel_launch(void* const* d_in, const int* in_sizes, int n_in, void* d_out, int out_size, void* d_ws, size_t ws_size, hipStream_t stream) {
    static int grid = 0;
    if (grid == 0) {
        if (n_in != 22 || in_sizes[0] != T * D || out_size != T * D || ws_size < WS_END) { fprintf(stderr, "kernel_launch: unexpected shapes (n_in %d, in0 %d, out %d, ws %zu); nothing launched\n", n_in, n_in > 0 ? in_sizes[0] : -1, out_size, ws_size); grid = -1; return; }
        int dev = 0, cus = 0, per_cu = 0;
        if (hipGetDevice(&dev) != hipSuccess || hipDeviceGetAttribute(&cus, hipDeviceAttributeMultiprocessorCount, dev) != hipSuccess) { grid = -1; return; }
        if (hipFuncSetAttribute((const void*)hybrid_fwd, hipFuncAttributeMaxDynamicSharedMemorySize, LDS_BYTES) != hipSuccess) { fprintf(stderr, "kernel_launch: hipFuncSetAttribute failed\n"); grid = -1; return; }
        if (hipOccupancyMaxActiveBlocksPerMultiprocessor(&per_cu, (const void*)hybrid_fwd, NWAVES * 64, LDS_BYTES) != hipSuccess || per_cu < 1)
            fprintf(stderr, "kernel_launch: note: occupancy query reports %d workgroups per CU\n", per_cu);
        (void)hipGetLastError();
        grid = cus;
    }
    if (grid < 0) return;
    if (hipMemsetAsync((char*)d_ws + WS_CTL, 0, CTL_ZERO_BYTES, stream) != hipSuccess) return;
    Args a{};
    for (int i = 0; i < 22; ++i) a.in[i] = (const float*)d_in[i];
    a.out = (float*)d_out; a.ws = (unsigned char*)d_ws;
    for (int li = 0; li < N_LAUNCHES; ++li) {
        a.ph_lo = (N_LAUNCHES == 1) ? 0 : li; a.ph_hi = (N_LAUNCHES == 1) ? NPH : li + 1; a.li = li;
        hipLaunchKernelGGL(hybrid_fwd, dim3(grid), dim3(NWAVES * 64), LDS_BYTES, stream, a);
        if (hipPeekAtLastError() != hipSuccess) { fprintf(stderr, "kernel_launch: launch %d failed\n", li); break; }
    }
}
```

```cpp
#include <hip/hip_runtime.h>
#include <cstdio>
#include <cstdint>
namespace pg8 {
#define PG8_LAS __attribute__((address_space(3)))
typedef unsigned short bf16_t;
typedef short bf16x8 __attribute__((ext_vector_type(8)));
typedef float f32x4 __attribute__((ext_vector_type(4)));
typedef unsigned u32x4 __attribute__((ext_vector_type(4)));
constexpr int BM = 256, BK = 64, HALF = 128, HTB = HALF * BK * 2  , STAGE_BYTES = 8 * HTB, NXCD = 8, WGM = 8;

__host__ __device__ __forceinline__ int lds_byte(int r, int c) { const int st = (r >> 4) * 2 + (c >> 5), rr = r & 15, cc = c & 31, ob = rr * 64 + cc * 2; return st * 1024 + (ob ^ (((ob >> 9) & 1) << 5)); }
__host__ __device__ __forceinline__ void stage_rc(int b, int& R, int& C) { const int st = b / 1024, sb = b % 1024, swz = sb ^ (((sb >> 9) & 1) << 5); R = (st >> 1) * 16 + swz / 64; C = (st & 1) * 32 + (swz % 64) / 2; }
__host__ __device__ __forceinline__ int perm32(int rho) { const int n = rho >> 4, i = rho & 15; return 8 * (i >> 2) + 4 * n + (i & 3); }

struct Unit { int pm, pn; };
struct Gemm { const bf16_t* A; const bf16_t* Bt; int M, N, K; };

struct StaticOrder {
    static constexpr bool GATHER = false;
    int nM, nN, nwg, G, c;
    __host__ __device__ void init(int M, int N, int G_, int c_) { nM = M / BM; nN = N / BM; nwg = nM * nN; G = G_; c = c_; }
    __host__ __device__ bool next(int i, Unit& u) const {
        const long L = (long)i * G + c; if (L >= nwg) return false;
        int wgid = (int)L; { const int q = nwg / NXCD, r = nwg % NXCD, xcd = wgid % NXCD, off = wgid / NXCD; wgid = (xcd < r ? xcd * (q + 1) : r * (q + 1) + (xcd - r) * q) + off; }
        const int nig = WGM * nN, gid = wgid / nig, fm = gid * WGM, gsz = (nM - fm) < WGM ? (nM - fm) : WGM;
        u.pm = fm + ((wgid % nig) % gsz); u.pn = (wgid % nig) / gsz; return true;
    }
    __device__ __forceinline__ void a_ready(const Unit&) const {}
    __device__ __forceinline__ void done(const Unit&) const {}
};

typedef __bf16 bf2_t __attribute__((ext_vector_type(2)));
__device__ __forceinline__ unsigned cvt_pk_bf16(float lo, float hi) { bf2_t v; v[0] = (__bf16)lo; v[1] = (__bf16)hi; return __builtin_bit_cast(unsigned, v); }
typedef float f32x2 __attribute__((ext_vector_type(2)));
template <int ACT  > struct EpiBf16 {
    static constexpr bool PERM = true, AFTER_DRAIN = false; static_assert(ACT == 0, "EpiBf16: no activation here");
    bf16_t* O; int ldc; const float* bias; int split_cols; size_t split_stride; float scale0;
    __device__ __forceinline__ void operator()(const f32x4 (&acc)[2][2][4][2], const Unit& u, int wr, int wc, int fr, int fq) const {
        const int row0 = u.pm * BM + wr * 64 + fr; int colt = u.pn * BM; bf16_t* base = O;
        float sc = 1.f; if (split_cols) { const int t = colt / split_cols; base += (size_t)t * split_stride; colt -= t * split_cols; if (t == 0) sc = scale0; }
        const int col0 = colt + wc * 32 + 8 * fq, bcol0 = u.pn * BM + wc * 32 + 8 * fq;
        f32x4 bv[2][2];
#pragma unroll
        for (int bj = 0; bj < 2; ++bj)
#pragma unroll
            for (int n = 0; n < 2; ++n) bv[bj][n] = bias ? *(const f32x4*)(bias + bcol0 + bj * HALF + 4 * n) : (f32x4){0.f, 0.f, 0.f, 0.f};
#pragma unroll
        for (int ai = 0; ai < 2; ++ai)
#pragma unroll
            for (int m = 0; m < 4; ++m) { bf16_t* rowp = base + (size_t)(row0 + ai * HALF + m * 16) * ldc + col0;
#pragma unroll
                for (int bj = 0; bj < 2; ++bj) { f32x4 v0 = acc[ai][bj][m][0] + bv[bj][0], v1 = acc[ai][bj][m][1] + bv[bj][1];
                    v0 = v0 * sc; v1 = v1 * sc; u32x4 w; w.x = cvt_pk_bf16(v0[0], v0[1]); w.y = cvt_pk_bf16(v0[2], v0[3]); w.z = cvt_pk_bf16(v1[0], v1[1]); w.w = cvt_pk_bf16(v1[2], v1[3]);
                    *(u32x4*)(rowp + bj * HALF) = w; } }
    }
};
__device__ __forceinline__ float bf2f_(unsigned b16) { return __uint_as_float(b16 << 16); }
__device__ __forceinline__ float sigm_(float x) { return 1.0f / (1.0f + __expf(-x)); }
template <bool ADD> struct EpiGate {
    static constexpr bool PERM = true, AFTER_DRAIN = false;
    bf16_t* O; int ldc; const bf16_t* gate; size_t gstride;
    __device__ __forceinline__ void operator()(const f32x4 (&acc)[2][2][4][2], const Unit& u, int wr, int wc, int fr, int fq) const {
        const int row0 = u.pm * BM + wr * 64 + fr, colt = wc * 32 + 8 * fq;
        const bf16_t* gt = gate + (size_t)u.pn * gstride;
#pragma unroll
        for (int ai = 0; ai < 2; ++ai)
#pragma unroll
            for (int m = 0; m < 4; ++m) { const size_t row = (size_t)(row0 + ai * HALF + m * 16);
#pragma unroll
                for (int bj = 0; bj < 2; ++bj) { const int c = colt + bj * HALF;
                    const u32x4 gv = *(const u32x4*)(gt + row * 256 + c);
                    bf16_t* op = O + row * ldc + u.pn * BM + c;
                    float pv[8] = {0.f, 0.f, 0.f, 0.f, 0.f, 0.f, 0.f, 0.f};
                    if (ADD) { const u32x4 p = *(const u32x4*)op; pv[0] = bf2f_(p.x & 0xffffu); pv[1] = bf2f_(p.x >> 16); pv[2] = bf2f_(p.y & 0xffffu); pv[3] = bf2f_(p.y >> 16);
                        pv[4] = bf2f_(p.z & 0xffffu); pv[5] = bf2f_(p.z >> 16); pv[6] = bf2f_(p.w & 0xffffu); pv[7] = bf2f_(p.w >> 16); }
                    const f32x4 v0 = acc[ai][bj][m][0], v1 = acc[ai][bj][m][1];
                    float o[8];
                    o[0] = pv[0] + sigm_(bf2f_(gv.x & 0xffffu)) * v0[0]; o[1] = pv[1] + sigm_(bf2f_(gv.x >> 16)) * v0[1];
                    o[2] = pv[2] + sigm_(bf2f_(gv.y & 0xffffu)) * v0[2]; o[3] = pv[3] + sigm_(bf2f_(gv.y >> 16)) * v0[3];
                    o[4] = pv[4] + sigm_(bf2f_(gv.z & 0xffffu)) * v1[0]; o[5] = pv[5] + sigm_(bf2f_(gv.z >> 16)) * v1[1];
                    o[6] = pv[6] + sigm_(bf2f_(gv.w & 0xffffu)) * v1[2]; o[7] = pv[7] + sigm_(bf2f_(gv.w >> 16)) * v1[3];
                    u32x4 w; w.x = cvt_pk_bf16(o[0], o[1]); w.y = cvt_pk_bf16(o[2], o[3]); w.z = cvt_pk_bf16(o[4], o[5]); w.w = cvt_pk_bf16(o[6], o[7]);
                    *(u32x4*)op = w; } }
    }
};
struct EpiRes {
    static constexpr bool PERM = false, AFTER_DRAIN = false;
    float* C; const float* R; int ldc;
    __device__ __forceinline__ void operator()(const f32x4 (&acc)[2][2][4][2], const Unit& u, int wr, int wc, int fr, int fq) const {
        const int row0 = u.pm * BM + wr * 64 + fr, col0 = u.pn * BM + wc * 32 + 4 * fq;
#pragma unroll
        for (int ai = 0; ai < 2; ++ai)
#pragma unroll
            for (int m = 0; m < 4; ++m) { const size_t ro = (size_t)(row0 + ai * HALF + m * 16) * ldc + col0;
#pragma unroll
                for (int bj = 0; bj < 2; ++bj)
#pragma unroll
                    for (int n = 0; n < 2; ++n) { const size_t off = ro + bj * HALF + n * 16; *(f32x4*)(C + off) = *(const f32x4*)(R + off) + acc[ai][bj][m][n]; } }
    }
};
struct EpiSwiGLU {
    static constexpr bool PERM = true, AFTER_DRAIN = false;
    bf16_t* H;
    __device__ __forceinline__ void operator()(const f32x4 (&acc)[2][2][4][2], const Unit& u, int wr, int wc, int fr, int fq) const {
        const int row0 = u.pm * BM + wr * 64 + fr, hc = (u.pn & 3) * 128 + wc * 32 + 8 * fq;
#pragma unroll
        for (int ai = 0; ai < 2; ++ai)
#pragma unroll
            for (int m = 0; m < 4; ++m) { const size_t row = (size_t)(row0 + ai * HALF + m * 16);
                float o[8];
#pragma unroll
                for (int n = 0; n < 2; ++n)
#pragma unroll
                    for (int i = 0; i < 4; ++i) { const float g = acc[ai][0][m][n][i], up = acc[ai][1][m][n][i]; o[n * 4 + i] = g * sigm_(g) * up; }
                u32x4 w; w.x = cvt_pk_bf16(o[0], o[1]); w.y = cvt_pk_bf16(o[2], o[3]); w.z = cvt_pk_bf16(o[4], o[5]); w.w = cvt_pk_bf16(o[6], o[7]);
                *(u32x4*)(H + row * 512 + hc) = w; }
    }
};
struct EpiDown {
    static constexpr bool PERM = true, AFTER_DRAIN = false;
    bf16_t* Y;
    __device__ __forceinline__ void operator()(const f32x4 (&acc)[2][2][4][2], const Unit& u, int wr, int wc, int fr, int fq) const {
        const int row0 = u.pm * BM + wr * 64 + fr, c0 = (u.pn & 3) * 256 + wc * 32 + 8 * fq;
#pragma unroll
        for (int ai = 0; ai < 2; ++ai)
#pragma unroll
            for (int m = 0; m < 4; ++m) { const size_t row = (size_t)(row0 + ai * HALF + m * 16);
#pragma unroll
                for (int bj = 0; bj < 2; ++bj) { const f32x4 v0 = acc[ai][bj][m][0], v1 = acc[ai][bj][m][1];
                    u32x4 w; w.x = cvt_pk_bf16(v0[0], v0[1]); w.y = cvt_pk_bf16(v0[2], v0[3]); w.z = cvt_pk_bf16(v1[0], v1[1]); w.w = cvt_pk_bf16(v1[2], v1[3]);
                    *(u32x4*)(Y + row * 1024 + c0 + bj * HALF) = w; } }
    }
};
template <bool GA_> struct MoeOrder {
    static constexpr bool GATHER = GA_;
    const PG8_LAS int* ts; int nl, lx, lo, hi; const int* rowtok; unsigned* rdy;
    __device__ __forceinline__ bool next(int i, Unit& u) const {
        const int U = 4 * (hi - lo), G = nl, c = lx; long L;
        if constexpr (GA_) L = (long)i * G + c;
        else { const int r = U % G;
            if (c >= r) L = (i == 0) ? (long)(c - r) : ((i == 1) ? (long)(G - r) + (c - r) : 2L * (G - r) + (long)(i - 2) * G + c);
            else L = 2L * (G - r) + (long)i * G + c; }
        if (L >= (long)U) return false;
        const int pm = lo + (int)(L >> 2), j = (int)(L & 3); int e = 0;
#pragma unroll
        for (int k = 1; k < 32; ++k) e += (ts[k] <= pm) ? 1 : 0;
        u.pm = pm; u.pn = e * 4 + j; return true;
    }
    __device__ __forceinline__ void a_ready(const Unit& u) const {
        if constexpr (!GA_) { unsigned sp = 0u;
            while (__hip_atomic_load(rdy + 16 * u.pm, __ATOMIC_RELAXED, __HIP_MEMORY_SCOPE_AGENT) < 32u) { __builtin_amdgcn_s_sleep(2); if (++sp > (1u << 22)) break; }
            asm volatile("" ::: "memory"); }
    }
    __device__ __forceinline__ void done(const Unit& u) const {
        if constexpr (GA_) { asm volatile("s_waitcnt vmcnt(0)" ::: "memory");
            if ((threadIdx.x & 63) == 0) (void)__hip_atomic_fetch_add(rdy + 16 * u.pm, 1u, __ATOMIC_RELAXED, __HIP_MEMORY_SCOPE_AGENT); }
    }
};
template <class E_> struct is_epibf16 { static constexpr bool value = false; }; template <int A_> struct is_epibf16<EpiBf16<A_>> { static constexpr bool value = true; };
template <class Epi, class Sched, bool ALIGN_EPI = false, bool SP2 = false>
__device__ __forceinline__ void gemm_phase(PG8_LAS unsigned char* lds, const Gemm g, const Sched& S, const Epi& E) {
    const int tid = threadIdx.x, wid = __builtin_amdgcn_readfirstlane(tid >> 6), lane = tid & 63, wr = wid >> 2, wc = wid & 3, fr = lane & 15, fq = lane >> 4;
    const int K = g.K, nt = K / BK;
    unsigned voffA[2], voffB[2];
#pragma unroll
    for (int i = 0; i < 2; ++i) { int R, C; stage_rc(tid * 16 + i * 8192, R, C); const int Rb = Epi::PERM ? ((R & ~31) + perm32(R & 31)) : R;
        voffA[i] = (unsigned)(R * K + C) * 2u; voffB[i] = (unsigned)(Rb * K + C) * 2u; }
    const size_t kstep = (size_t)(BK * 2);
    const size_t hstep = (size_t)HALF * K * 2;
    const size_t tstep = 2 * hstep;
    constexpr bool GA = Sched::GATHER;
    static_assert(!GA || SP2, "gathered A rows: SP2 loop only");
    const size_t hstepA = GA ? 0 : hstep;
    unsigned gcur[2][2] = {{0u, 0u}, {0u, 0u}}, gnxt[2][2] = {{0u, 0u}, {0u, 0u}}; int gR[2] = {0, 0}; unsigned gC[2] = {0u, 0u};
    if constexpr (GA) { _Pragma("unroll") for (int i = 0; i < 2; ++i) { int R, C; stage_rc(tid * 16 + i * 8192, R, C); gR[i] = R; gC[i] = (unsigned)C * 2u; } }
#define PG8_GOFF(dst, u) do { if constexpr (GA) { _Pragma("unroll") for (int h_ = 0; h_ < 2; ++h_) _Pragma("unroll") for (int i_ = 0; i_ < 2; ++i_) dst[h_][i_] = (unsigned)S.rowtok[(u).pm * BM + h_ * HALF + gR[i_]] * (unsigned)(K * 2) + gC[i_]; } } while (0)
#define PG8_VA(h, sel) (GA ? ((sel) ? gnxt[h] : gcur[h]) : voffA)
    const unsigned ldsw = (unsigned)wid * 1024u;
    const int aoff = lds_byte(wr * 64 + fr, fq * 8), boff = lds_byte(wc * 32 + fr, fq * 8);
#define PG8_SA(b, h) (((b) * 2 + (h)) * HTB)
#define PG8_SB(b, h) ((4 + (b) * 2 + (h)) * HTB)
#define PG8_STAGE(bufoff, gbase, voff) do { _Pragma("unroll") for (int _i = 0; _i < 2; ++_i) \
        __builtin_amdgcn_global_load_lds((const unsigned*)((const char*)(gbase) + (voff)[_i]), (PG8_LAS unsigned*)(lds + (bufoff) + ldsw + _i * 8192), 16, 0, 0); } while (0)
#define PG8_LDA(dst, b, h) do { _Pragma("unroll") for (int m = 0; m < 4; ++m) _Pragma("unroll") for (int k = 0; k < 2; ++k) dst[m][k] = *(const PG8_LAS bf16x8*)(lds + PG8_SA(b, h) + aoff + m * 2048 + k * 1024); } while (0)
#define PG8_LDB(dst, b, h) do { _Pragma("unroll") for (int n = 0; n < 2; ++n) _Pragma("unroll") for (int k = 0; k < 2; ++k) dst[n][k] = *(const PG8_LAS bf16x8*)(lds + PG8_SB(b, h) + boff + n * 2048 + k * 1024); } while (0)
#define PG8_MMA(ai, bj, At, Bt) do { __builtin_amdgcn_s_setprio(1); _Pragma("unroll") for (int m = 0; m < 4; ++m) _Pragma("unroll") for (int n = 0; n < 2; ++n) _Pragma("unroll") for (int k = 0; k < 2; ++k) \
        acc[ai][bj][m][n] = __builtin_amdgcn_mfma_f32_16x16x32_bf16(Bt[n][k], At[m][k], acc[ai][bj][m][n], 0, 0, 0); __builtin_amdgcn_s_setprio(0); } while (0)
#define PG8_WAIT_V(n) asm volatile("s_waitcnt vmcnt(" #n ")" ::: "memory")
#define PG8_WAIT_L(n) asm volatile("s_waitcnt lgkmcnt(" #n ")" ::: "memory")
#define PG8_BAR __builtin_amdgcn_s_barrier()
#define PG8_SCHED __builtin_amdgcn_sched_barrier(0)
    Unit cur, nxt; int ui = 0;
    if (!S.next(0, cur)) return;
    f32x4 acc[2][2][4][2];
#pragma unroll
    for (int a = 0; a < 2; ++a)
#pragma unroll
        for (int b = 0; b < 2; ++b)
#pragma unroll
            for (int m = 0; m < 4; ++m)
#pragma unroll
                for (int n = 0; n < 2; ++n) acc[a][b][m][n] = (f32x4){0.f, 0.f, 0.f, 0.f};
    bf16x8 At[4][2], B0[2][2], B1[2][2];
    const char* cA = (const char*)g.A + (GA ? 0 : (size_t)cur.pm * tstep); const char* cB = (const char*)g.Bt + (size_t)cur.pn * tstep;
    S.a_ready(cur);
    PG8_GOFF(gcur, cur);
    if constexpr (SP2) {
        PG8_STAGE(PG8_SB(0, 0), cB, voffB); PG8_STAGE(PG8_SB(0, 1), cB + hstep, voffB); PG8_STAGE(PG8_SA(0, 0), cA, PG8_VA(0, false)); PG8_STAGE(PG8_SA(0, 1), cA + hstepA, PG8_VA(1, false));
        if (wr == 1) PG8_BAR;
        PG8_WAIT_V(2); PG8_BAR;
        PG8_STAGE(PG8_SB(1, 0), cB + kstep, voffB); PG8_STAGE(PG8_SA(1, 0), cA + kstep, PG8_VA(0, false)); PG8_STAGE(PG8_SB(1, 1), cB + hstep + kstep, voffB);
        PG8_WAIT_V(6); PG8_BAR;
    } else {
        PG8_STAGE(PG8_SB(0, 0), cB, voffB); PG8_STAGE(PG8_SA(0, 0), cA, voffA); PG8_STAGE(PG8_SB(0, 1), cB + hstep, voffB); PG8_STAGE(PG8_SA(0, 1), cA + hstep, voffA);
        if (wr == 1) PG8_BAR;
        PG8_WAIT_V(4); PG8_BAR;
        PG8_STAGE(PG8_SB(1, 0), cB + kstep, voffB); PG8_STAGE(PG8_SA(1, 0), cA + kstep, voffA); PG8_STAGE(PG8_SB(1, 1), cB + hstep + kstep, voffB);
        PG8_WAIT_V(6); PG8_BAR;
    }
    for (;;) {
        const bool has_next = S.next(ui + 1, nxt);
        if (has_next) PG8_GOFF(gnxt, nxt);
        const char* nA = has_next ? (const char*)g.A + (GA ? 0 : (size_t)nxt.pm * tstep) : cA; const char* nB = has_next ? (const char*)g.Bt + (size_t)nxt.pn * tstep : cB;
        for (int t = 0; t < nt; t += 2) {
            const bool last = (t == nt - 2);
            const char* a1 = cA + (size_t)(t + 1) * kstep;
            const char* a2 = last ? nA : cA + (size_t)(t + 2) * kstep; const char* b2 = last ? nB : cB + (size_t)(t + 2) * kstep;
            const char* a3 = a2 + kstep; const char* b3 = b2 + kstep;
            if (last && has_next) S.a_ready(nxt);
            const bool seln = last && has_next;
            if constexpr (SP2) {
            PG8_LDB(B0, 0, 0); PG8_LDB(B1, 0, 1); PG8_SCHED; PG8_LDA(At, 0, 0); PG8_STAGE(PG8_SA(1, 1), a1 + hstepA, PG8_VA(1, false));
            PG8_WAIT_V(8); PG8_WAIT_L(0); PG8_BAR; PG8_MMA(0, 0, At, B0); PG8_MMA(0, 1, At, B1); PG8_BAR; PG8_SCHED;
            PG8_LDA(At, 0, 1); PG8_STAGE(PG8_SB(0, 0), b2, voffB); PG8_STAGE(PG8_SB(0, 1), b2 + hstep, voffB); PG8_STAGE(PG8_SA(0, 0), a2, PG8_VA(0, seln));
            PG8_WAIT_V(8); PG8_WAIT_L(0); PG8_BAR; PG8_MMA(1, 0, At, B0); PG8_MMA(1, 1, At, B1); PG8_BAR; PG8_SCHED;
            PG8_LDB(B0, 1, 0); PG8_LDB(B1, 1, 1); PG8_SCHED; PG8_LDA(At, 1, 0); PG8_STAGE(PG8_SA(0, 1), a2 + hstepA, PG8_VA(1, seln));
            PG8_WAIT_V(8); PG8_WAIT_L(0); PG8_BAR; PG8_MMA(0, 0, At, B0); PG8_MMA(0, 1, At, B1); PG8_BAR; PG8_SCHED;
            PG8_LDA(At, 1, 1); PG8_STAGE(PG8_SB(1, 0), b3, voffB); PG8_STAGE(PG8_SB(1, 1), b3 + hstep, voffB); PG8_STAGE(PG8_SA(1, 0), a3, PG8_VA(0, seln));
            PG8_WAIT_V(8); PG8_WAIT_L(0); PG8_BAR; PG8_MMA(1, 0, At, B0); PG8_MMA(1, 1, At, B1); PG8_BAR; PG8_SCHED;
            } else {
            PG8_LDB(B0, 0, 0); PG8_SCHED; PG8_LDA(At, 0, 0); PG8_STAGE(PG8_SA(1, 1), a1 + hstep, voffA);
            PG8_WAIT_L(8); PG8_BAR; PG8_WAIT_L(0); PG8_MMA(0, 0, At, B0); PG8_BAR; PG8_SCHED;
            PG8_LDB(B1, 0, 1); PG8_STAGE(PG8_SB(0, 0), b2, voffB);
            PG8_BAR; PG8_WAIT_L(0); PG8_MMA(0, 1, At, B1); PG8_BAR;
            PG8_LDA(At, 0, 1); PG8_STAGE(PG8_SA(0, 0), a2, voffA);
            PG8_BAR; PG8_WAIT_L(0); PG8_MMA(1, 0, At, B0); PG8_BAR; PG8_SCHED;
            PG8_STAGE(PG8_SB(0, 1), b2 + hstep, voffB);
            PG8_WAIT_V(6); PG8_BAR; PG8_MMA(1, 1, At, B1); PG8_BAR;
            PG8_LDB(B0, 1, 0); PG8_SCHED; PG8_LDA(At, 1, 0); PG8_STAGE(PG8_SA(0, 1), a2 + hstep, voffA);
            PG8_WAIT_L(8); PG8_BAR; PG8_WAIT_L(0); PG8_MMA(0, 0, At, B0); PG8_BAR; PG8_SCHED;
            PG8_LDB(B1, 1, 1); PG8_STAGE(PG8_SB(1, 0), b3, voffB);
            PG8_BAR; PG8_WAIT_L(0); PG8_MMA(0, 1, At, B1); PG8_BAR;
            PG8_LDA(At, 1, 1); PG8_STAGE(PG8_SA(1, 0), a3, voffA);
            PG8_BAR; PG8_WAIT_L(0); PG8_MMA(1, 0, At, B0); PG8_BAR; PG8_SCHED;
            PG8_STAGE(PG8_SB(1, 1), b3 + hstep, voffB);
            PG8_WAIT_V(6); PG8_BAR; PG8_MMA(1, 1, At, B1); PG8_BAR;
            }
        }
        if constexpr (ALIGN_EPI) { if (wr == 0) PG8_BAR; }
        if constexpr (!Epi::AFTER_DRAIN) { E(acc, cur, wr, wc, fr, fq); S.done(cur); }
#ifdef DBG_EPI2
        if constexpr (is_epibf16<Epi>::value) { asm volatile("" ::: "memory"); E(acc, cur, wr, wc, fr, fq); }
#endif
        if (!has_next) break;
#pragma unroll
        for (int a = 0; a < 2; ++a)
#pragma unroll
            for (int b = 0; b < 2; ++b)
#pragma unroll
                for (int m = 0; m < 4; ++m)
#pragma unroll
                    for (int n = 0; n < 2; ++n) acc[a][b][m][n] = (f32x4){0.f, 0.f, 0.f, 0.f};
        cur = nxt; cA = nA; cB = nB; ++ui;
        if constexpr (GA) { _Pragma("unroll") for (int h_ = 0; h_ < 2; ++h_) _Pragma("unroll") for (int i_ = 0; i_ < 2; ++i_) gcur[h_][i_] = gnxt[h_][i_]; }
        if constexpr (ALIGN_EPI) { if (wr == 1) PG8_BAR; }
    }
    PG8_WAIT_V(0);
    if constexpr (!ALIGN_EPI) { if (wr == 0) PG8_BAR; }
    PG8_BAR;
    if constexpr (Epi::AFTER_DRAIN) { E.fused(acc, cur, wr, wc, fr, fq, lds, wid, lane); S.done(cur); }
#undef PG8_GOFF
#undef PG8_VA
#undef PG8_SA
#undef PG8_SB
#undef PG8_STAGE
#undef PG8_LDA
#undef PG8_LDB
#undef PG8_MMA
#undef PG8_WAIT_V
#undef PG8_WAIT_L
#undef PG8_BAR
#undef PG8_SCHED
}
}
constexpr int NWAVES = 8;
constexpr int BATCH = 8, SEQ = 4096, D = 1024, T = BATCH * SEQ;
constexpr int NPROJ = 5120;
constexpr int NTILE = NPROJ / 256;
constexpr float EPS = 1e-6f;
#ifndef MK_N_LAUNCHES
#define MK_N_LAUNCHES 1
#endif
#ifndef DBG_NPH
#define DBG_NPH 12
#endif
constexpr int NPH = DBG_NPH;
constexpr int N_LAUNCHES = MK_N_LAUNCHES;
static_assert(N_LAUNCHES == 1 || N_LAUNCHES == NPH, "MK_N_LAUNCHES is 1 or NPH");

constexpr size_t MiB = 1u << 20;
constexpr size_t WS_CTL = 0, CTL_ZERO_BYTES = 1 * MiB;
constexpr size_t WS_SMALL = 1 * MiB;
constexpr size_t WS_WIN = 2 * MiB;
constexpr size_t WS_WPA = 13 * MiB, WS_WPM = 14 * MiB, WS_WOUT = 15 * MiB;
constexpr size_t WS_TOKE = 17 * MiB;
constexpr size_t WS_TOKR = WS_TOKE + 256 * 1024;
constexpr size_t WS_TOKP = WS_TOKR + 256 * 1024;
constexpr size_t WS_TOKG = WS_TOKP + 256 * 1024;
constexpr size_t WS_CNT = WS_TOKG + 256 * 1024;
constexpr size_t WS_ROWTOK = WS_CNT + 64 * 1024;
constexpr int NROWS_MAX = 73728;
constexpr size_t WS_SC = 452 * MiB;
constexpr size_t WS_SC2 = 116 * MiB + 3 * ((size_t)T * 256 * 2);
constexpr size_t WS_GU = 20 * MiB;
constexpr size_t WS_DN = 84 * MiB;
constexpr size_t WS_PROJ = 116 * MiB;
constexpr size_t PROJ_TILE = (size_t)T * 256 * 2;
constexpr size_t WS_MLST = 116 * MiB;
constexpr size_t WS_MERGED = 116 * MiB;
constexpr size_t WS_XN = 180 * MiB;
constexpr size_t WS_XG = 244 * MiB;
constexpr size_t WS_HID = 388 * MiB;
constexpr size_t WS_Y = 244 * MiB;
constexpr size_t WS_END = 512 * MiB;
static_assert(WS_PROJ + NTILE * PROJ_TILE == 436 * MiB, "proj map");
constexpr size_t DO_H = 0, DO_YATT = 0, DO_YML = 32 * MiB, DO_KN = 64 * MiB, DO_IKR = 72 * MiB, DO_IQR = 74 * MiB, DO_AQN = 90 * MiB;
constexpr int TL_AQ = 0, TL_KV = 2, TL_IQ = 3, TL_MQ = 4, TL_MK = 6, TL_MV = 8, TL_MO = 10, TL_GA = 12, TL_GM = 16;
constexpr size_t WS_WSM = WS_SMALL + 64 * 1024;
constexpr size_t WS_WTG = WS_SMALL + 192 * 1024;
constexpr size_t DO_SMB = 122 * MiB;
constexpr int CW_BAR = 4096;
constexpr int CW_Q = 16384;
constexpr int CW_RDY = 32768;
constexpr int LDS_BYTES = 163840, MISC_OFF = LDS_BYTES - 512;

#define GAS __attribute__((address_space(1)))
#define LAS __attribute__((address_space(3)))
typedef unsigned short bf16;
typedef unsigned v4u __attribute__((ext_vector_type(4)));
typedef unsigned v2u __attribute__((ext_vector_type(2)));
typedef float f32x4 __attribute__((ext_vector_type(4)));
typedef float f32x2 __attribute__((ext_vector_type(2)));
typedef short bf16x8 __attribute__((ext_vector_type(8)));
typedef GAS unsigned gu32;
#define RLX_AGENT __ATOMIC_RELAXED, __HIP_MEMORY_SCOPE_AGENT
#define LDS_WAIT() asm volatile("s_waitcnt lgkmcnt(0)" ::: "memory")
__device__ __forceinline__ float bf2f(unsigned b16) { return __uint_as_float(b16 << 16); }
__device__ __forceinline__ unsigned f2bf(float f) { unsigned u = __float_as_uint(f); return (u + 0x7fffu + ((u >> 16) & 1u)) >> 16; }
__device__ __forceinline__ unsigned pk2(float lo, float hi) { return pg8::cvt_pk_bf16(lo, hi); }
__device__ __forceinline__ float sigm(float x) { return 1.0f / (1.0f + __expf(-x)); }
__device__ __forceinline__ float wave_sum(float v) {
    v += __int_as_float(__builtin_amdgcn_update_dpp(0, __float_as_int(v), 0xB1, 0xF, 0xF, true));
    v += __int_as_float(__builtin_amdgcn_update_dpp(0, __float_as_int(v), 0x4E, 0xF, 0xF, true));
    v += __int_as_float(__builtin_amdgcn_update_dpp(0, __float_as_int(v), 0x124, 0xF, 0xF, true));
    v += __int_as_float(__builtin_amdgcn_update_dpp(0, __float_as_int(v), 0x128, 0xF, 0xF, true));
    { const auto r = __builtin_amdgcn_permlane16_swap(__float_as_uint(v), __float_as_uint(v), false, false); v = __uint_as_float(r[0]) + __uint_as_float(r[1]); }
    { const auto r = __builtin_amdgcn_permlane32_swap(__float_as_uint(v), __float_as_uint(v), false, false); v = __uint_as_float(r[0]) + __uint_as_float(r[1]); }
    return v;
}
__device__ __forceinline__ void unpack8(const v4u r, float (&f)[8]) {
    f[0] = bf2f(r.x & 0xffffu); f[1] = bf2f(r.x >> 16); f[2] = bf2f(r.y & 0xffffu); f[3] = bf2f(r.y >> 16);
    f[4] = bf2f(r.z & 0xffffu); f[5] = bf2f(r.z >> 16); f[6] = bf2f(r.w & 0xffffu); f[7] = bf2f(r.w >> 16);
}
__device__ __forceinline__ v4u pack8(const float (&f)[8]) { v4u w; w.x = pk2(f[0], f[1]); w.y = pk2(f[2], f[3]); w.z = pk2(f[4], f[5]); w.w = pk2(f[6], f[7]); return w; }
#define XB_TMO      128
#define XB_XCNT(j)  (256  + 64 * (j))
#define XB_XSUB(j)  (1280 + 64 * (j))
#define XB_XGEN(j)  (2304 + 64 * (j))
#define XB_TOP      3328
#define XB_TOPGEN   3392
#define XCD_BAR_WORDS 3456
#define XB_SPIN_CAP (1u << 18)

__device__ __forceinline__ unsigned xb_ld(unsigned* p)              { return __hip_atomic_load(p, __ATOMIC_RELAXED, __HIP_MEMORY_SCOPE_AGENT); }
__device__ __forceinline__ unsigned xb_add(unsigned* p, unsigned v) { return __hip_atomic_fetch_add(p, v, __ATOMIC_RELAXED, __HIP_MEMORY_SCOPE_AGENT); }
__device__ __forceinline__ unsigned xb_xcc_id() { return (unsigned)__builtin_amdgcn_s_getreg((3 << 11) | 20) & 0xFu; }
#define XB_SPIN(cond, bar) do { unsigned _sp = 0; while (cond) { __builtin_amdgcn_s_sleep(1); \
    if ((++_sp & 255u) == 0u) { if (xb_ld(&(bar)[XB_TMO])) break; if (_sp > XB_SPIN_CAP) { atomicAdd(&(bar)[XB_TMO], 1u); break; } } } } while (0)

struct XcdBarrier {
    unsigned* bar; unsigned x;
    volatile LAS unsigned* st;
};

__device__ __forceinline__ XcdBarrier xcd_barrier_post(unsigned* bar, volatile LAS unsigned* st) {
    XcdBarrier b; b.bar = bar; b.x = xb_xcc_id(); b.st = st;
    if (threadIdx.x == 0) st[12] = xb_add(&bar[XB_XCNT(b.x)], 1u);
    return b;
}
__device__ __forceinline__ void xcd_barrier_complete(unsigned* bar, unsigned x, unsigned& nloc, unsigned& nx) {
    const unsigned G = gridDim.x * gridDim.y * gridDim.z;
    unsigned sum, cnt, mine, sp = 0u;
    for (;;) {
        sum = 0u; cnt = 0u; mine = 0u;
#pragma unroll
        for (unsigned j = 0; j < 16; ++j) { const unsigned c = xb_ld(&bar[XB_XCNT(j)]); sum += c; cnt += (c > 0u) ? 1u : 0u; mine = (j == x) ? c : mine; }
        if (sum == G) break;
        __builtin_amdgcn_s_sleep(1);
        if ((++sp & 255u) == 0u) { if (xb_ld(&bar[XB_TMO])) break; if (sp > XB_SPIN_CAP) { atomicAdd(&bar[XB_TMO], 1u); break; } }
    }
    nloc = mine > 0u ? mine : 1u; nx = cnt > 0u ? cnt : 1u;
}

__device__ __forceinline__ void xcd_barrier(const XcdBarrier& b) {
    asm volatile("s_waitcnt vmcnt(0)" ::: "memory");
    __syncthreads();
    if (threadIdx.x == 0) {
        unsigned* bar = b.bar;
        __builtin_amdgcn_s_waitcnt(0);
        unsigned nloc = b.st[0], nx = b.st[1];
        if (nloc == 0u) { xcd_barrier_complete(bar, b.x, nloc, nx); b.st[0] = nloc; b.st[1] = nx; }
        const unsigned old = xb_add(&bar[XB_XSUB(b.x)], 1u);
        const unsigned gen = old / nloc;
        if (old + 1u == (gen + 1u) * nloc) {
            __builtin_amdgcn_fence(__ATOMIC_RELEASE, "agent");
            asm volatile("s_waitcnt vmcnt(0)" ::: "memory");
            const unsigned og = xb_add(&bar[XB_TOP], 1u);
            const unsigned tg = og / nx;
            if (og + 1u == (tg + 1u) * nx) xb_add(&bar[XB_TOPGEN], 1u);
            else XB_SPIN(xb_ld(&bar[XB_TOPGEN]) == tg, bar);
            __builtin_amdgcn_fence(__ATOMIC_ACQUIRE, "agent");
            xb_add(&bar[XB_XGEN(b.x)], 1u);
            asm volatile("s_waitcnt vmcnt(0)" ::: "memory");
        } else {
            XB_SPIN(xb_ld(&bar[XB_XGEN(b.x)]) == gen, bar);
            __builtin_amdgcn_fence(__ATOMIC_ACQUIRE, "agent");
            asm volatile("s_waitcnt vmcnt(0)" ::: "memory");
        }
    }
    __syncthreads();
}
struct Args { const float* in[22]; float* out; unsigned char* ws; int ph_lo, ph_hi, li, pad; };
struct Ctx { int tid, lane, wave, G, vcu; LAS unsigned char* lds; };
#define IN_X 0
#define IN_POS 1
#define IN_GMIX 2
#define IN_WIN 3
#define IN_GQ 4
#define IN_GK 5
#define IN_WCONV 6
#define IN_BCONV 7
#define IN_BI 8
#define IN_BF 9
#define IN_GML 10
#define IN_WPA 11
#define IN_WPM 12
#define IN_WOUT 13
#define IN_GMOE 14
#define IN_WRG 15
#define IN_BRG 16
#define IN_WRE 17
#define IN_BRE 18
#define IN_WEG 19
#define IN_WEU 20
#define IN_WED 21

__device__ __forceinline__ int win_src_col(int n) {
    if (n < 1024) return n;
    if (n < 3072) return n + 40;
    return n + 48;
}
__device__ __forceinline__ int wsm_src_col(int r) {
    return r < 40 ? 1024 + r : (r < 44 ? 3112 + (r - 40) : 3116 + (r - 44));
}
__device__ __forceinline__ void tr_item(const float* W, int ldw, int scol, int k0, bf16* wt0, int K, LAS float* scr, int lane) {
    const int sc0 = __builtin_amdgcn_readfirstlane(scol), sc31 = __builtin_amdgcn_readlane(scol, 31);
    if (sc0 >= 0 && sc31 == sc0 + 31 && (sc0 & 3) == 0 && (ldw & 3) == 0) {
#pragma unroll
        for (int i = 0; i < 8; ++i) { const int kk = 8 * i + (lane >> 3); const f32x4 v = *(const f32x4*)(W + (size_t)(k0 + kk) * ldw + sc0 + 4 * (lane & 7));
            LAS float* d = scr + kk * 33 + 4 * (lane & 7); d[0] = v[0]; d[1] = v[1]; d[2] = v[2]; d[3] = v[3]; }
    } else {
#pragma unroll 8
        for (int i = 0; i < 32; ++i) { const int kk = 2 * i + (lane >> 5); scr[kk * 33 + (lane & 31)] = scol >= 0 ? W[(size_t)(k0 + kk) * ldw + scol] : 0.f; }
    }
    LDS_WAIT(); asm volatile("" ::: "memory");
    const int c = lane & 7;
#pragma unroll
    for (int j = 0; j < 4; ++j) { const int n = (lane >> 3) + 8 * j; const LAS float* s = scr + (8 * c) * 33 + n;
        v4u o; o.x = pk2(s[0 * 33], s[1 * 33]); o.y = pk2(s[2 * 33], s[3 * 33]); o.z = pk2(s[4 * 33], s[5 * 33]); o.w = pk2(s[6 * 33], s[7 * 33]);
        *(v4u*)(wt0 + (size_t)n * K + 8 * c) = o; }
    LDS_WAIT(); asm volatile("" ::: "memory");
}
template <int PART> __device__ __forceinline__ void p0_prologue(const Args& a, const Ctx& c, int gw, int NGW) {
    unsigned char* ws = a.ws;
    LAS float* scr = (LAS float*)(c.lds + c.wave * 16384);
    const int lane = c.lane;
    constexpr int I_IN = 16 * 160, I_PA = 8 * 32, I_PM = 8 * 32, I_OUT = 16 * 32, I_GU = 32 * 16 * 32, I_DN = 32 * 8 * 32;
    constexpr int NPRJ = I_IN + I_PA + I_PM + I_OUT, NIT = NPRJ + I_GU + I_DN;
    for (int it = (PART ? NPRJ : 0) + gw; it < (PART ? NIT : NPRJ); it += NGW) {
        int r = it;
        if (r < I_IN) { const int kb = r / 160, nb = r % 160; tr_item(a.in[IN_WIN], 5168, win_src_col(32 * nb + (lane & 31)), 64 * kb, (bf16*)(ws + WS_WIN) + (size_t)(32 * nb) * 1024 + 64 * kb, 1024, scr, lane); continue; } r -= I_IN;
        if (r < I_PA) { const int kb = r / 32, nb = r % 32; tr_item(a.in[IN_WPA], 1024, 32 * nb + (lane & 31), 64 * kb, (bf16*)(ws + WS_WPA) + (size_t)(32 * nb) * 512 + 64 * kb, 512, scr, lane); continue; } r -= I_PA;
        if (r < I_PM) { const int kb = r / 32, nb = r % 32; tr_item(a.in[IN_WPM], 1024, 32 * nb + (lane & 31), 64 * kb, (bf16*)(ws + WS_WPM) + (size_t)(32 * nb) * 512 + 64 * kb, 512, scr, lane); continue; } r -= I_PM;
        if (r < I_OUT) { const int kb = r / 32, nb = r % 32; tr_item(a.in[IN_WOUT], 1024, 32 * nb + (lane & 31), 64 * kb, (bf16*)(ws + WS_WOUT) + (size_t)(32 * nb) * 1024 + 64 * kb, 1024, scr, lane); continue; } r -= I_OUT;
        if (r < I_GU) { const int e = r / 512, q = r % 512, kb = q / 32, nb = q % 32, t = nb >> 3, bj = (nb >> 2) & 1, i0 = (nb & 3) * 32;
            const float* src = (bj ? a.in[IN_WEU] : a.in[IN_WEG]) + (size_t)e * 1024 * 512;
            tr_item(src, 512, 128 * t + i0 + (lane & 31), 64 * kb, (bf16*)(ws + WS_GU) + ((size_t)e * 1024 + 32 * nb) * 1024 + 64 * kb, 1024, scr, lane); continue; } r -= I_GU;
        { const int e = r / 256, q = r % 256, kb = q / 32, nb = q % 32;
            tr_item(a.in[IN_WED] + (size_t)e * 512 * 1024, 1024, 32 * nb + (lane & 31), 64 * kb, (bf16*)(ws + WS_DN) + ((size_t)e * 1024 + 32 * nb) * 512 + 64 * kb, 512, scr, lane); }
    }
    if (PART) return;
    { float* WTG = (float*)(ws + WS_WTG); for (int i = gw * 64 + lane; i < 36 * 1024; i += NGW * 64) { const int j = i >> 10, k = i & 1023;
        WTG[j * 1028 + k] = (j < 32 ? a.in[IN_WRE][k * 32 + j] : a.in[IN_WRG][k * 4 + (j - 32)]) * a.in[IN_GMOE][k]; } }
    { bf16* WSM = (bf16*)(ws + WS_WSM); for (int i = gw * 64 + lane; i < 48 * 1024; i += NGW * 64) { const int r = i >> 10, k = i & 1023; WSM[i] = (bf16)f2bf(a.in[IN_WIN][(size_t)k * 5168 + wsm_src_col(r)]); } }
    const float* g = a.in[IN_GMIX]; f32x4 gv[4];
#pragma unroll
    for (int j = 0; j < 4; ++j) gv[j] = *(const f32x4*)(g + 4 * lane + 256 * j);
    bf16* H = (bf16*)((unsigned char*)a.out + DO_H);
    for (int m0 = gw; m0 < T; m0 += 2 * NGW) {
        const int mA = m0, mB = (m0 + NGW < T) ? m0 + NGW : m0; const bool hasB = (m0 + NGW < T);
        const f32x4* xa = (const f32x4*)(a.in[IN_X] + (size_t)mA * D) + lane; const f32x4* xb = (const f32x4*)(a.in[IN_X] + (size_t)mB * D) + lane;
        f32x4 va[4], vb[4]; float sa = 0.f, sb = 0.f;
#pragma unroll
        for (int j = 0; j < 4; ++j) { va[j] = xa[64 * j]; vb[j] = xb[64 * j]; }
#pragma unroll
        for (int j = 0; j < 4; ++j) { sa += (va[j].x * va[j].x + va[j].y * va[j].y) + (va[j].z * va[j].z + va[j].w * va[j].w); sb += (vb[j].x * vb[j].x + vb[j].y * vb[j].y) + (vb[j].z * vb[j].z + vb[j].w * vb[j].w); }
        const float ra = rsqrtf(wave_sum(sa) * (1.f / D) + EPS), rb = rsqrtf(wave_sum(sb) * (1.f / D) + EPS);
        v2u* oa = (v2u*)(H + (size_t)mA * D) + lane; v2u* ob = (v2u*)(H + (size_t)mB * D) + lane;
#pragma unroll
        for (int j = 0; j < 4; ++j) { v2u w; w.x = pk2(va[j].x * ra * gv[j].x, va[j].y * ra * gv[j].y); w.y = pk2(va[j].z * ra * gv[j].z, va[j].w * ra * gv[j].w); oa[64 * j] = w; }
        if (hasB) {
#pragma unroll
        for (int j = 0; j < 4; ++j) { v2u w; w.x = pk2(vb[j].x * rb * gv[j].x, vb[j].y * rb * gv[j].y); w.y = pk2(vb[j].z * rb * gv[j].z, vb[j].w * rb * gv[j].w); ob[64 * j] = w; } }
    }
}

__device__ __forceinline__ const bf16* proj_tile(const Args& a, int tile) { return (const bf16*)(a.ws + WS_PROJ + (size_t)tile * PROJ_TILE); }
#define DPPF(x_, ctrl_) __int_as_float(__builtin_amdgcn_update_dpp(0, __float_as_int(x_), ctrl_, 0xF, 0xF, true))
__device__ __forceinline__ void p2_prep(const Args& a, const Ctx& c) {
    const int lane = c.lane, gw = c.vcu * NWAVES + c.wave, NGW = c.G * NWAVES;
    float invf = 0.f;
    if (lane < 8) invf = (float)pow(500000.0, -(double)lane / 8.0); else if (lane < 12) invf = (float)pow(500000.0, -(double)(lane - 8) / 4.0);
    float gq[8], gk[8];
#pragma unroll
    for (int i = 0; i < 8; ++i) { gq[i] = a.in[IN_GQ][8 * (lane & 7) + i]; gk[i] = a.in[IN_GK][8 * (lane & 7) + i]; }
    const int* pos = (const int*)a.in[IN_POS];
    unsigned char* dout = (unsigned char*)a.out;
    bf16* AQN = (bf16*)(dout + DO_AQN); bf16* KN = (bf16*)(dout + DO_KN); bf16* IQR = (bf16*)(dout + DO_IQR); bf16* IKR = (bf16*)(dout + DO_IKR);
    { const bf16* Hh = (const bf16*)(dout + DO_H); const bf16* WSM = (const bf16*)(a.ws + WS_WSM); bf16* SMB = (bf16*)(dout + DO_SMB);
      const int row = lane & 15, kg = lane >> 4;
      const float invfk = (float)pow(500000.0, -(double)(lane & 3) / 4.0);
      for (int tile = gw; tile < T / 16; tile += NGW) { const int t0 = tile * 16;
          f32x4 acc[3];
#pragma unroll
          for (int ct = 0; ct < 3; ++ct) acc[ct] = (f32x4){0.f, 0.f, 0.f, 0.f};
          const bf16* ap = Hh + (size_t)(t0 + row) * 1024 + 8 * kg; const bf16* bp = WSM + (size_t)row * 1024 + 8 * kg;
#pragma unroll 8
          for (int ks = 0; ks < 32; ++ks) { const bf16x8 av = *(const bf16x8*)(ap + 32 * ks);
#pragma unroll
              for (int ct = 0; ct < 3; ++ct) acc[ct] = __builtin_amdgcn_mfma_f32_16x16x32_bf16(av, *(const bf16x8*)(bp + (size_t)ct * 16 * 1024 + 32 * ks), acc[ct], 0, 0, 0); }
          const int col = lane & 15;
#pragma unroll
          for (int r = 0; r < 4; ++r) { const int t = t0 + 4 * kg + r;
              const float angk = (float)pos[t] * invfk;
              const double revk = (double)angk * 0.15915494309189535; const float frk = (float)(revk - __builtin_rint(revk));
              const float ck = __builtin_amdgcn_cosf(frk), sk = __builtin_amdgcn_sinf(frk);
              const float v0 = acc[0][r], pr = __shfl_xor(v0, 4);
              const float o0 = (col < 4) ? (v0 * ck - pr * sk) : ((col < 8) ? (v0 * ck + pr * sk) : v0);
              IKR[(size_t)t * 32 + col] = (bf16)f2bf(o0); IKR[(size_t)t * 32 + 16 + col] = (bf16)f2bf(acc[1][r]);
              SMB[(size_t)t * 16 + col] = (bf16)f2bf(acc[2][r]); } } }
    const int l7 = lane & 7;
    const int aqcol = (lane >> 3) * 64 + 8 * l7, akcol = ((lane & 15) >> 3) * 64 + 8 * l7;
    const bf16* aqsrc = proj_tile(a, TL_AQ + (aqcol >> 8)) + (aqcol & 255); const bf16* aksrc = proj_tile(a, TL_KV) + akcol; const bf16* iqsrc = proj_tile(a, TL_IQ) + 4 * lane;
#define P2_LOADROW(t_, P_, A_, K_, Q_) do { const int tt_ = (t_) < T ? (t_) : T - 1; P_ = pos[tt_]; A_ = *(const v4u*)(aqsrc + (size_t)tt_ * 256); K_ = *(const v4u*)(aksrc + (size_t)tt_ * 256); Q_ = *(const v2u*)(iqsrc + (size_t)tt_ * 256); } while (0)
#define P2_DOROW(t, P_, A_, K_, Q_) do { \
        const float ang = (float)(P_) * invf; \
        const double rev = (double)ang * 0.15915494309189535; const float frv = (float)(rev - __builtin_rint(rev)); \
        float cs = __builtin_amdgcn_cosf(frv), sn = __builtin_amdgcn_sinf(frv); \
        float ca[8], sa[8], ci[4], si[4]; \
        _Pragma("unroll") for (int i = 0; i < 8; ++i) { ca[i] = __int_as_float(__builtin_amdgcn_readlane(__float_as_int(cs), i)); sa[i] = __int_as_float(__builtin_amdgcn_readlane(__float_as_int(sn), i)); } \
        _Pragma("unroll") for (int i = 0; i < 4; ++i) { ci[i] = __int_as_float(__builtin_amdgcn_readlane(__float_as_int(cs), 8 + i)); si[i] = __int_as_float(__builtin_amdgcn_readlane(__float_as_int(sn), 8 + i)); } \
        { float f[8]; unpack8(A_, f); float ss = 0.f; \
          _Pragma("unroll") for (int i = 0; i < 8; ++i) ss += f[i] * f[i]; \
          ss += DPPF(ss, 0xB1); ss += DPPF(ss, 0x4E); ss += DPPF(ss, 0x141); \
          const float r = rsqrtf(ss * (1.f / 64.f) + EPS); \
          _Pragma("unroll") for (int i = 0; i < 8; ++i) f[i] = f[i] * r * gq[i]; \
          float o[8]; \
          _Pragma("unroll") for (int i = 0; i < 8; ++i) { const float p = DPPF(f[i], 0xB1); o[i] = (l7 == 0) ? (f[i] * ca[i] - p * sa[i]) : ((l7 == 1) ? (f[i] * ca[i] + p * sa[i]) : f[i]); o[i] *= 0.125f * 1.4426950408889634f; } \
          *(v4u*)(AQN + (size_t)(t) * 512 + aqcol) = pack8(o); } \
        { float f[8]; unpack8(K_, f); float ss = 0.f; \
          _Pragma("unroll") for (int i = 0; i < 8; ++i) ss += f[i] * f[i]; \
          ss += DPPF(ss, 0xB1); ss += DPPF(ss, 0x4E); ss += DPPF(ss, 0x141); \
          const float r = rsqrtf(ss * (1.f / 64.f) + EPS); \
          _Pragma("unroll") for (int i = 0; i < 8; ++i) f[i] = f[i] * r * gk[i]; \
          float o[8]; \
          _Pragma("unroll") for (int i = 0; i < 8; ++i) { const float p = DPPF(f[i], 0xB1); o[i] = (l7 == 0) ? (f[i] * ca[i] - p * sa[i]) : ((l7 == 1) ? (f[i] * ca[i] + p * sa[i]) : f[i]); } \
          if (lane < 16) *(v4u*)(KN + (size_t)(t) * 128 + akcol) = pack8(o); } \
        { const v2u rw = Q_; \
          float f[4] = {bf2f(rw.x & 0xffffu), bf2f(rw.x >> 16), bf2f(rw.y & 0xffffu), bf2f(rw.y >> 16)}; float o[4]; \
          _Pragma("unroll") for (int i = 0; i < 4; ++i) { const float p = DPPF(f[i], 0xB1); o[i] = (l7 == 0) ? (f[i] * ci[i] - p * si[i]) : ((l7 == 1) ? (f[i] * ci[i] + p * si[i]) : f[i]); } \
          v2u w; w.x = pk2(o[0], o[1]); w.y = pk2(o[2], o[3]); *(v2u*)(IQR + (size_t)(t) * 256 + 4 * lane) = w; } } while (0)
    { int pA, pB; v4u aA, aB, kA, kB; v2u qA, qB;
      P2_LOADROW(gw, pA, aA, kA, qA);
#pragma unroll 1
      for (int t = gw; t < T; t += 2 * NGW) {
          P2_LOADROW(t + NGW, pB, aB, kB, qB);
          P2_DOROW(t, pA, aA, kA, qA);
          P2_LOADROW(t + 2 * NGW, pA, aA, kA, qA);
          if (t + NGW < T) P2_DOROW(t + NGW, pB, aB, kB, qB);
      } }
#undef P2_LOADROW
#undef P2_DOROW
}
constexpr int ML_QS = 0, ML_KS = 17408, ML_HS = 0;
constexpr int ML_KWT = 34816;
constexpr int ML_VT = 53248;
constexpr int ML_SW = 73984;
constexpr int ML_CT = 83200;
constexpr int ML_GA = 122368;
constexpr int ML_CW = ML_GA + 1024;
constexpr int ML_END = ML_CW + (1024 + 384) * 4;
static_assert(ML_END <= MISC_OFF, "mLSTM LDS map");
constexpr size_t ML_STATE_BYTES = 8 * 9 * 64 * 16;
__device__ __forceinline__ bf16x8 lds_frag(const LAS unsigned char* base, int stride_b, int row0, int kb, int lane) {
    return *(const LAS bf16x8*)(base + (row0 + (lane & 15)) * stride_b + kb + (lane >> 4) * 16);
}
__device__ __forceinline__ bf16x8 lds_frag_sw(const LAS unsigned char* base, int row0, int ks, int lane) {
    const int row = row0 + (lane & 15); return *(const LAS bf16x8*)(base + row * 144 + 16 * (((ks * 4 + (lane >> 4)) + (row >> 3)) & 7));
}
#define MFMA16(a_, b_, c_) __builtin_amdgcn_mfma_f32_16x16x32_bf16(a_, b_, c_, 0, 0, 0)
constexpr int CV_NMI = 2 * (32 * 16 * 32 + 32 * 8 * 32);
constexpr int CV_SCR = ML_END, CV_SCRW = 32 * 33 * 4;
static_assert(CV_SCR + 8 * CV_SCRW <= MISC_OFF, "conversion scratch");
struct CvItem { const float* src; bf16* dst; int ldw, K; };
__device__ __forceinline__ CvItem cv_item(const Args& a, int mi) {
    const int it = mi >> 1, hk = mi & 1; CvItem r;
    if (it < 32 * 16 * 32) { const int e = it >> 9, q = it & 511, kb = q >> 5, nb = q & 31, t = nb >> 3, bj = (nb >> 2) & 1, i0 = (nb & 3) * 32, k0 = 64 * kb + 32 * hk;
        r.src = (bj ? a.in[IN_WEU] : a.in[IN_WEG]) + (size_t)e * 1024 * 512 + (size_t)k0 * 512 + 128 * t + i0; r.ldw = 512; r.K = 1024;
        r.dst = (bf16*)(a.ws + WS_GU) + ((size_t)e * 1024 + 32 * nb) * 1024 + k0;
    } else { const int r2 = it - 32 * 16 * 32, e = r2 >> 8, q = r2 & 255, kb = q >> 5, nb = q & 31, k0 = 64 * kb + 32 * hk;
        r.src = a.in[IN_WED] + (size_t)e * 512 * 1024 + (size_t)k0 * 1024 + 32 * nb; r.ldw = 1024; r.K = 512;
        r.dst = (bf16*)(a.ws + WS_DN) + ((size_t)e * 1024 + 32 * nb) * 512 + k0; }
    return r;
}
__device__ __forceinline__ void cv_load(const CvItem& it, f32x4 (&v)[4], int lane) {
#pragma unroll
    for (int i = 0; i < 4; ++i) v[i] = *(const f32x4*)(it.src + (size_t)(8 * i + (lane >> 3)) * it.ldw + 4 * (lane & 7));
}
__device__ __forceinline__ void cv_finish(const CvItem& it, const f32x4 (&v)[4], LAS float* scr, int lane, bool valid) {
#pragma unroll
    for (int i = 0; i < 4; ++i) { LAS float* d = scr + (8 * i + (lane >> 3)) * 33 + 4 * (lane & 7); d[0] = v[i][0]; d[1] = v[i][1]; d[2] = v[i][2]; d[3] = v[i][3]; }
    LDS_WAIT(); asm volatile("" ::: "memory");
#pragma unroll
    for (int j = 0; j < 2; ++j) { const int n = (lane >> 2) + 16 * j, cq = lane & 3; const LAS float* sp = scr + (8 * cq) * 33 + n;
        v4u o; o.x = pk2(sp[0 * 33], sp[1 * 33]); o.y = pk2(sp[2 * 33], sp[3 * 33]); o.z = pk2(sp[4 * 33], sp[5 * 33]); o.w = pk2(sp[6 * 33], sp[7 * 33]);
        if (valid) *(v4u*)(it.dst + (size_t)n * it.K + 8 * cq) = o; }
    LDS_WAIT(); asm volatile("" ::: "memory");
}
template <int MODE>
__device__ __forceinline__ void mlstm_unit(const Args& a, const Ctx& c, int b, int h, int g) {
    const int tid = c.tid, wave = c.wave; LAS unsigned char* lds = c.lds;
#define ML_LAUNDER() int tv_ = tid; asm volatile("" : "+v"(tv_)); const int lane = tv_ & 63, seg = tv_ & 15, r2 = (tv_ >> 4) * 2; (void)lane; (void)seg; (void)r2
    const bf16* PQ = proj_tile(a, TL_MQ + (h >> 1)) + (h & 1) * 128;
    const bf16* PK = proj_tile(a, TL_MK + (h >> 1)) + (h & 1) * 128;
    const bf16* PV = proj_tile(a, TL_MV + (h >> 1)) + (h & 1) * 128;
    const bf16* PO = proj_tile(a, TL_MO + (h >> 1)) + (h & 1) * 128;
    const bf16* PS = (const bf16*)((unsigned char*)a.out + DO_SMB);
    bf16* YML = (bf16*)((unsigned char*)a.out + DO_YML);
    unsigned char* STB = a.ws + WS_MLST; float* MST = (float*)(a.ws + WS_MLST + 256 * ML_STATE_BYTES);
    LAS float* GAa = (LAS float*)(lds + ML_GA); LAS float* GAm = GAa + 64; LAS float* GAw = GAa + 128; LAS float* GAe = GAa + 192;
    LAS float* CWQ = (LAS float*)(lds + ML_CW); LAS float* CWK = CWQ + 512; LAS float* CBQ = CWQ + 1024; LAS float* CBK = CBQ + 128; LAS float* GN = CBK + 128;
    LAS bf16* VTs = (LAS bf16*)(lds + ML_VT);
    { const float* wc = a.in[IN_WCONV]; const int j = tid >> 7, d = tid & 127;
      CWQ[tid] = wc[j * 1024 + h * 128 + d]; CWK[tid] = wc[j * 1024 + 512 + h * 128 + d];
      if (tid < 128) { CBQ[tid] = a.in[IN_BCONV][h * 128 + tid]; CBK[tid] = a.in[IN_BCONV][512 + h * 128 + tid]; GN[tid] = a.in[IN_GML][h * 128 + tid]; } }
    for (int i = tid; i < 16 * 64; i += 512) { const int r = i >> 6, cc = i & 63; VTs[(128 + r) * 72 + cc] = (r == 0) ? (bf16)0x3F80 : (bf16)0; }
    const float big = a.in[IN_BI][h], bfg = a.in[IN_BF][h];
    const int slot0 = (b * 4 + h) * 8;
    f32x4 cacc[9];
    float m_st = 0.f;
    if (MODE == 1 && g > 0) { ML_LAUNDER();
        const f32x4* sp = (const f32x4*)(STB + (size_t)(slot0 + g) * ML_STATE_BYTES) + wave * 576 + lane;
#pragma unroll
        for (int i = 0; i < 9; ++i) cacc[i] = sp[64 * i];
        m_st = MST[slot0 + g];
#pragma unroll
        for (int ee = 0; ee < 9; ++ee) { v2u w; w.x = pk2(cacc[ee][0], cacc[ee][1]); w.y = pk2(cacc[ee][2], cacc[ee][3]);
            *(LAS v2u*)(lds + ML_CT + (ee * 16 + (lane & 15)) * 272 + (wave * 16 + 4 * (lane >> 4)) * 2) = w; }
    } else {
#pragma unroll
        for (int i = 0; i < 9; ++i) cacc[i] = (f32x4){0.f, 0.f, 0.f, 0.f};
        for (int i = tid; i < 144 * 136 / 2; i += 512) ((LAS unsigned*)(lds + ML_CT))[i] = 0u;
    }
    const size_t tb = (size_t)b * SEQ;
    const char* bq = (const char*)(PQ + tb * 256); const char* bk = (const char*)(PK + tb * 256); const char* bv = (const char*)(PV + tb * 256); const char* bo = (const char*)(PO + tb * 256); const char* bs = (const char*)(PS + tb * 16);
    v4u rq[5], rk[5], rv[2]; unsigned short gi = 0, gf = 0;
#define ML_LOAD(kc) do { _Pragma("unroll") for (int j_ = 0; j_ < 5; ++j_) { const int rr_ = 64 * (kc) + r2 - 3 + j_; const unsigned o_ = (unsigned)((rr_ < 0 ? 0 : rr_) * 512 + seg * 16); \
            v4u q_ = (v4u){0u, 0u, 0u, 0u}; if (MODE == 1) q_ = *(const v4u*)(bq + o_); v4u k_ = *(const v4u*)(bk + o_); if (rr_ < 0) { q_ = (v4u){0u, 0u, 0u, 0u}; k_ = q_; } rq[j_] = q_; rk[j_] = k_; } \
        _Pragma("unroll") for (int i_ = 0; i_ < 2; ++i_) rv[i_] = *(const v4u*)(bv + (unsigned)((64 * (kc) + r2 + i_) * 512 + seg * 16)); \
        gi = *(const unsigned short*)(bs + (unsigned)((64 * (kc) + lane) * 32 + (8 + h) * 2)); gf = *(const unsigned short*)(bs + (unsigned)((64 * (kc) + lane) * 32 + (12 + h) * 2)); } while (0)
    const int kc0 = (MODE == 1) ? 8 * g : 0, kc1 = (MODE == 1) ? 8 * g + 8 : 56;
    { ML_LAUNDER(); ML_LOAD(kc0); }
    const int cv_gw = c.vcu * NWAVES + c.wave, cv_ngw = c.G * NWAVES; f32x4 cvv[4]; CvItem cvi; int cvk = 0; bool cvp = false;
    LAS float* cv_scr = (LAS float*)(lds + CV_SCR + wave * CV_SCRW);
#define CV_SLOT() do { if (MODE == 1) { ML_LAUNDER(); if (cvp) cv_finish(cvi, cvv, cv_scr, lane, cv_gw + (cvk - 1) * cv_ngw < CV_NMI); \
        { int mi_ = cv_gw + cvk * cv_ngw; mi_ = mi_ < CV_NMI ? mi_ : CV_NMI - 1; cvi = cv_item(a, __builtin_amdgcn_readfirstlane(mi_)); cv_load(cvi, cvv, lane); cvp = true; ++cvk; } } } while (0)
    __syncthreads();
#pragma unroll 1
    for (int kc = kc0; kc < kc1; ++kc) {
        float wkv, decay, m_new;
        if (MODE == 0 && kc > 0 && (kc & 7) == 0) { ML_LAUNDER();
            f32x4* sp = (f32x4*)(STB + (size_t)(slot0 + (kc >> 3)) * ML_STATE_BYTES) + wave * 576 + lane;
#pragma unroll
            for (int i = 0; i < 9; ++i) sp[64 * i] = cacc[i];
            if (tid == 0) MST[slot0 + (kc >> 3)] = m_st; }
        CV_SLOT();
        { ML_LAUNDER();
        const float fpre = bf2f(gf) + bfg, lf = fminf(fpre, 0.f) - log1pf(__expf(-fabsf(fpre)));
        const float ig = bf2f(gi) + big;
#define ML_SHR(x_, n_, id_) __int_as_float(__builtin_amdgcn_update_dpp(__float_as_int(id_), __float_as_int(x_), 0x110 + (n_), 0xF, 0xF, false))
        float bc = lf;
        bc += ML_SHR(bc, 1, 0.f); bc += ML_SHR(bc, 2, 0.f); bc += ML_SHR(bc, 4, 0.f); bc += ML_SHR(bc, 8, 0.f);
        { const float t0 = __int_as_float(__builtin_amdgcn_readlane(__float_as_int(bc), 15)), t1 = __int_as_float(__builtin_amdgcn_readlane(__float_as_int(bc), 31)), t2 = __int_as_float(__builtin_amdgcn_readlane(__float_as_int(bc), 47));
          bc += (lane >= 48) ? (t0 + t1 + t2) : ((lane >= 32) ? (t0 + t1) : ((lane >= 16) ? t0 : 0.f)); }
        const float av = ig - bc; float Ac = av;
        Ac = fmaxf(Ac, ML_SHR(Ac, 1, -3.0e38f)); Ac = fmaxf(Ac, ML_SHR(Ac, 2, -3.0e38f)); Ac = fmaxf(Ac, ML_SHR(Ac, 4, -3.0e38f)); Ac = fmaxf(Ac, ML_SHR(Ac, 8, -3.0e38f));
        { const float t0 = __int_as_float(__builtin_amdgcn_readlane(__float_as_int(Ac), 15)), t1 = __int_as_float(__builtin_amdgcn_readlane(__float_as_int(Ac), 31)), t2 = __int_as_float(__builtin_amdgcn_readlane(__float_as_int(Ac), 47));
          const float m01 = fmaxf(t0, t1), m012 = fmaxf(m01, t2);
          Ac = fmaxf(Ac, (lane >= 48) ? m012 : ((lane >= 32) ? m01 : ((lane >= 16) ? t0 : -3.0e38f))); }
#undef ML_SHR
        const float mA = fmaxf(m_st, Ac), Mk = __int_as_float(__builtin_amdgcn_readlane(__float_as_int(mA), 63)), blast = __int_as_float(__builtin_amdgcn_readlane(__float_as_int(bc), 63));
        wkv = __expf(av - Mk); decay = __expf(m_st - Mk); m_new = blast + Mk;
        if (MODE == 1 && wave == 0) { GAa[lane] = av; GAm[lane] = mA; GAw[lane] = __expf(m_st - mA); GAe[lane] = __expf(-(bc + mA)); } }
        { ML_LAUNDER(); float kw_[2][8];
#pragma unroll
          for (int i = 0; i < 2; ++i) { const int t = r2 + i; const float wkt = __shfl(wkv, t);
            float aq_[8], ak_[8];
            { const f32x4 b0 = *(const LAS f32x4*)(CBQ + seg * 8), b1 = *(const LAS f32x4*)(CBQ + seg * 8 + 4), c0 = *(const LAS f32x4*)(CBK + seg * 8), c1 = *(const LAS f32x4*)(CBK + seg * 8 + 4);
              aq_[0] = b0[0]; aq_[1] = b0[1]; aq_[2] = b0[2]; aq_[3] = b0[3]; aq_[4] = b1[0]; aq_[5] = b1[1]; aq_[6] = b1[2]; aq_[7] = b1[3];
              ak_[0] = c0[0]; ak_[1] = c0[1]; ak_[2] = c0[2]; ak_[3] = c0[3]; ak_[4] = c1[0]; ak_[5] = c1[1]; ak_[6] = c1[2]; ak_[7] = c1[3]; }
#pragma unroll
            for (int j = 0; j < 4; ++j) { float fk_[8]; unpack8(rk[i + j], fk_);
                const f32x4 x0 = *(const LAS f32x4*)(CWK + j * 128 + seg * 8), x1 = *(const LAS f32x4*)(CWK + j * 128 + seg * 8 + 4);
#pragma unroll
                for (int e = 0; e < 4; ++e) { ak_[e] += x0[e] * fk_[e]; ak_[4 + e] += x1[e] * fk_[4 + e]; }
                if (MODE == 1) { float fq_[8]; unpack8(rq[i + j], fq_);
                    const f32x4 w0 = *(const LAS f32x4*)(CWQ + j * 128 + seg * 8), w1 = *(const LAS f32x4*)(CWQ + j * 128 + seg * 8 + 4);
#pragma unroll
                    for (int e = 0; e < 4; ++e) { aq_[e] += w0[e] * fq_[e]; aq_[4 + e] += w1[e] * fq_[4 + e]; } } }
#pragma unroll
            for (int e = 0; e < 8; ++e) { ak_[e] = ak_[e] * sigm(ak_[e]) * 0.08838834764831845f; kw_[i][e] = ak_[e] * wkt; }
            if (MODE == 1) {
#pragma unroll
                for (int e = 0; e < 8; ++e) aq_[e] = aq_[e] * sigm(aq_[e]);
                *(LAS v4u*)(lds + ML_QS + t * 272 + seg * 16) = pack8(aq_);
                *(LAS v4u*)(lds + ML_KS + t * 272 + seg * 16) = pack8(ak_); } }
          const unsigned va[4] = {rv[0].x, rv[0].y, rv[0].z, rv[0].w}, vb[4] = {rv[1].x, rv[1].y, rv[1].z, rv[1].w};
          const int swo = 16 * (((r2 >> 3) + seg) & 7) + 2 * (r2 & 7);
#pragma unroll
          for (int e = 0; e < 8; ++e) { const int ro = (seg * 8 + e) * 144 + swo;
              *(LAS unsigned*)(lds + ML_KWT + ro) = pk2(kw_[0][e], kw_[1][e]);
              const unsigned lo = (e & 1) ? (va[e >> 1] >> 16) : (va[e >> 1] & 0xffffu), hi = (e & 1) ? (vb[e >> 1] >> 16) : (vb[e >> 1] & 0xffffu);
              *(LAS unsigned*)(lds + ML_VT + ro) = lo | (hi << 16); }
        if (kc + 1 < kc1) ML_LOAD(kc + 1); }
        __syncthreads();
        f32x4 hacc[5]; unsigned mo_r[8];
        const int tt = wave & 3, t0 = tt * 16, ne = (wave < 4) ? 5 : 4, e_first = (wave < 4) ? 0 : 5;
        CV_SLOT();
        if (MODE == 1) {
        { ML_LAUNDER(); const int tq = t0 + (lane & 15);
        bf16x8 qf[4];
#pragma unroll
        for (int ks = 0; ks < 4; ++ks) qf[ks] = lds_frag(lds + ML_QS, 272, t0, ks * 64, lane);
        const float mAt = GAm[tq], wit = GAw[tq];
#pragma unroll
        for (int si = 0; si < 2; ++si) { const int ss = 2 * (wave >> 2) + si, s0 = ss * 16; f32x4 sacc = (f32x4){0.f, 0.f, 0.f, 0.f};
            if (ss <= tt) {
#pragma unroll
                for (int ks = 0; ks < 4; ++ks) sacc = MFMA16(lds_frag(lds + ML_KS, 272, s0, ks * 64, lane), qf[ks], sacc);
#pragma unroll
                for (int r = 0; r < 4; ++r) { const int s = s0 + 4 * (lane >> 4) + r; sacc[r] = (s <= tq) ? sacc[r] * __expf(GAa[s] - mAt) : 0.f; } }
            v2u w; w.x = pk2(sacc[0], sacc[1]); w.y = pk2(sacc[2], sacc[3]);
            *(LAS v2u*)(lds + ML_SW + tq * 144 + s0 * 2 + (lane >> 4) * 8) = w; }
#pragma unroll
        for (int i = 0; i < 5; ++i) { hacc[i] = (f32x4){0.f, 0.f, 0.f, 0.f};
            if (i < ne) {
#pragma unroll
                for (int ks = 0; ks < 4; ++ks) hacc[i] = MFMA16(lds_frag(lds + ML_CT, 272, (e_first + i) * 16, ks * 64, lane), qf[ks], hacc[i]);
                hacc[i] = hacc[i] * wit; } }
#pragma unroll
        for (int i = 0; i < 8; ++i) mo_r[i] = *(const unsigned*)(bo + (unsigned)((64 * kc + 8 * wave + i) * 512 + 4 * lane)); }
        __syncthreads();
        { ML_LAUNDER(); const int tq = t0 + (lane & 15); bf16x8 swf[2];
#pragma unroll
          for (int ks = 0; ks < 2; ++ks) swf[ks] = lds_frag(lds + ML_SW, 144, t0, ks * 64, lane);
#pragma unroll
          for (int i = 0; i < 5; ++i) if (i < ne) { const int ee = e_first + i;
#pragma unroll
              for (int ks = 0; ks < 2; ++ks) hacc[i] = MFMA16(lds_frag_sw(lds + ML_VT, ee * 16, ks, lane), swf[ks], hacc[i]);
              if (ee < 8) *(LAS f32x4*)(lds + ML_HS + tq * 528 + (ee * 16 + 4 * (lane >> 4)) * 4) = hacc[i];
              else if ((lane >> 4) == 0) *(LAS float*)(lds + ML_HS + tq * 528 + 128 * 4) = hacc[i][0]; } }
        }
        CV_SLOT();
        { ML_LAUNDER(); const int d0 = wave * 16; bf16x8 kwf[2];
#pragma unroll
          for (int ks = 0; ks < 2; ++ks) kwf[ks] = lds_frag_sw(lds + ML_KWT, d0, ks, lane);
#pragma unroll
          for (int ee = 0; ee < 9; ++ee) { cacc[ee] = cacc[ee] * decay;
#pragma unroll
              for (int ks = 0; ks < 2; ++ks) cacc[ee] = MFMA16(kwf[ks], lds_frag_sw(lds + ML_VT, ee * 16, ks, lane), cacc[ee]);
              if (MODE == 1) { v2u w; w.x = pk2(cacc[ee][0], cacc[ee][1]); w.y = pk2(cacc[ee][2], cacc[ee][3]);
                  *(LAS v2u*)(lds + ML_CT + (ee * 16 + (lane & 15)) * 272 + (d0 + 4 * (lane >> 4)) * 2) = w; } } }
        __syncthreads();
        if (MODE == 1) {
        { ML_LAUNDER();
#pragma unroll
        for (int i = 0; i < 8; ++i) { const int t = 8 * wave + i;
            const f32x2 nv = *(const LAS f32x2*)(lds + ML_HS + t * 528 + lane * 8); const float den = *(const LAS float*)(lds + ML_HS + t * 528 + 512);
            const float dd = fmaxf(fabsf(den), GAe[t]); const float h0 = nv.x / dd, h1 = nv.y / dd;
            const float r = rsqrtf(wave_sum(h0 * h0 + h1 * h1) * (1.f / 128.f) + EPS);
            const float y0 = h0 * r * GN[2 * lane] * sigm(bf2f(mo_r[i] & 0xffffu)), y1 = h1 * r * GN[2 * lane + 1] * sigm(bf2f(mo_r[i] >> 16));
            *(unsigned*)(YML + (tb + 64 * kc + t) * 512 + h * 128 + 2 * lane) = pk2(y0, y1); } }
        __syncthreads();
        }
        m_st = m_new;
    }
    if (MODE == 1) { ML_LAUNDER(); if (cvp) cv_finish(cvi, cvv, cv_scr, lane, cv_gw + (cvk - 1) * cv_ngw < CV_NMI); }
#undef CV_SLOT
    if (MODE == 0) { ML_LAUNDER();
        f32x4* sp = (f32x4*)(STB + (size_t)(slot0 + 7) * ML_STATE_BYTES) + wave * 576 + lane;
#pragma unroll
        for (int i = 0; i < 9; ++i) sp[64 * i] = cacc[i];
        if (tid == 0) MST[slot0 + 7] = m_st; }
#undef ML_LOAD
#undef ML_LAUNDER
}
constexpr int AT_HIST = 0;
constexpr int AT_HROW = 2049;
constexpr int AT_SEL = 131072 + 256;
constexpr int AT_MROW = 129;
constexpr int AT_SM = AT_SEL + 8448;
constexpr int AT_LUT = AT_SM + 256;
constexpr int AT_SEL2 = AT_LUT + 256;
static_assert(AT_SEL2 + 8448 <= MISC_OFF, "attention LDS map");
__device__ __forceinline__ unsigned score_key(float s) { unsigned u = __float_as_uint(s + 0.0f); return (u & 0x80000000u) ? ~u : (u | 0x80000000u); }
__device__ __forceinline__ unsigned wave_suffix_sum(unsigned v, int lane) {
#define AT_SHL(x_, n_) ((unsigned)__builtin_amdgcn_update_dpp(0, (int)(x_), 0x100 + (n_), 0xF, 0xF, false))
    v += AT_SHL(v, 1); v += AT_SHL(v, 2); v += AT_SHL(v, 4); v += AT_SHL(v, 8);
#undef AT_SHL
    const unsigned t1 = (unsigned)__builtin_amdgcn_readlane((int)v, 16), t2 = (unsigned)__builtin_amdgcn_readlane((int)v, 32), t3 = (unsigned)__builtin_amdgcn_readlane((int)v, 48);
    return v + ((lane < 16) ? (t1 + t2 + t3) : ((lane < 32) ? (t2 + t3) : ((lane < 48) ? t3 : 0u)));
}
template <int NK> __device__ __forceinline__ void at_resolve(const LAS unsigned long long* cand, LAS unsigned* mask, int m, int nd, int lane) {
    unsigned long long cv[NK];
#pragma unroll
    for (int k = 0; k < NK; ++k) { const int i = 64 * k + lane; unsigned long long x = 0ull; if (i < m) x = cand[i]; cv[k] = (i < m) ? ((((x >> 32) & 0xFFFFFull) << 16) | (x & 0xFFFFull)) : 0ull; }
    unsigned long long T = 0ull;
#pragma unroll 1
    for (int bit = 35; bit >= 16; --bit) { const unsigned long long test = T | (1ull << bit); int cge = 0;
#pragma unroll
        for (int k = 0; k < NK; ++k) cge += __popcll(__ballot(cv[k] >= test));
        if (cge >= nd) T = test; }
    int g = 0, t = 0;
#pragma unroll
    for (int k = 0; k < NK; ++k) { g += __popcll(__ballot(cv[k] >= T + 0x10000ull)); t += __popcll(__ballot(cv[k] >= T)); }
    t -= g;
    if (t > nd - g) {
#pragma unroll 1
        for (int bit = 15; bit >= 0; --bit) { const unsigned long long test = T | (1ull << bit); int cge = 0;
#pragma unroll
            for (int k = 0; k < NK; ++k) cge += __popcll(__ballot(cv[k] >= test));
            if (cge >= nd) T = test; } }
#pragma unroll
    for (int k = 0; k < NK; ++k) if (cv[k] >= T && cv[k] != 0ull) { const unsigned key = 0xFFFFu - (unsigned)(cv[k] & 0xFFFFull);
        __hip_atomic_fetch_or(&mask[key >> 5], 1u << (key & 31u), __ATOMIC_RELAXED, __HIP_MEMORY_SCOPE_WORKGROUP); }
}
__device__ __forceinline__ void attn_unit(const Args& a, const Ctx& c, int b, int qt, float cshift) {
    const int tid = c.tid, wave = c.wave; LAS unsigned char* lds = c.lds;
#define AT_LAUNDER() int tv_ = tid; asm volatile("" : "+v"(tv_)); const int lane = tv_ & 63, qi = tv_ & 15, fq = (tv_ >> 4) & 3; (void)lane; (void)qi; (void)fq
    const int q0u = qt * 32, ch = q0u >> 6, n = 64 * (ch + 1), ntiles = n >> 4;
    const size_t tb = (size_t)b * SEQ;
    unsigned char* dout = (unsigned char*)a.out;
    const bf16* AQN = (const bf16*)(dout + DO_AQN); const bf16* KN = (const bf16*)(dout + DO_KN); const bf16* IQR = (const bf16*)(dout + DO_IQR); const bf16* IKR = (const bf16*)(dout + DO_IKR);
    bf16* YATT = (bf16*)(dout + DO_YATT);
    const bf16* VB = proj_tile(a, TL_KV); const bf16* PS = (const bf16*)(dout + DO_SMB);
    LAS unsigned* HIST = (LAS unsigned*)(lds + AT_HIST);
    LAS unsigned long long* CAND = (LAS unsigned long long*)(lds + AT_HIST);
    LAS int* SM = (LAS int*)(lds + AT_SM);
    float* SC = (blockIdx.x < 240) ? (float*)(a.ws + WS_SC) + (size_t)blockIdx.x * (16 * 4096) : (float*)(a.ws + WS_SC2) + (size_t)(blockIdx.x - 240) * (16 * 4096);
#ifndef DBG_REP_DENSE
#define DBG_REP_DENSE 1
#endif
#pragma unroll 1
    for (int rsel = 0; rsel < 2; ++rsel) {
    const int q0 = q0u + 16 * rsel;
    LAS unsigned* MASK = (LAS unsigned*)(lds + (rsel ? AT_SEL2 : AT_SEL));
    if (n > 256) {
        for (int i = tid; i < 8192 + 4; i += 512) ((LAS v4u*)HIST)[i] = (v4u){0u, 0u, 0u, 0u};
        if (tid < 64) SM[tid] = 0;
        for (int i = tid; i < 16 * AT_MROW; i += 512) MASK[i] = 0u;
        bf16x8 qf[8]; float wv[8]; bf16x8 qsh, qsl;
        { AT_LAUNDER();
        const size_t trow = tb + q0 + qi;
#pragma unroll
        for (int h = 0; h < 8; ++h) qf[h] = *(const bf16x8*)(IQR + trow * 256 + h * 32 + 8 * fq);
        { float t8[8]; unpack8(*(const v4u*)(PS + trow * 16), t8);
#pragma unroll
          for (int h = 0; h < 8; ++h) wv[h] = t8[h] * 0.03125f; }
        { float qs[8];
#pragma unroll
          for (int j = 0; j < 8; ++j) qs[j] = 0.f;
#pragma unroll
          for (int h = 0; h < 8; ++h) { float f8[8]; unpack8(__builtin_bit_cast(v4u, qf[h]), f8);
#pragma unroll
            for (int j = 0; j < 8; ++j) qs[j] = __builtin_fmaf(wv[h], f8[j], qs[j]); }
          float hi8[8], lo8[8]; const v4u ph = pack8(qs); unpack8(ph, hi8);
#pragma unroll
          for (int j = 0; j < 8; ++j) lo8[j] = qs[j] - hi8[j];
          qsh = __builtin_bit_cast(bf16x8, ph); qsl = __builtin_bit_cast(bf16x8, pack8(lo8)); } }
        __syncthreads();
#define AT_LOADK(kt_) (*(const bf16x8*)(IKR + (tb + (size_t)(kt_) * 16 + qi) * 32 + 8 * fq))
#define AT_SCORES(kf_, sc_) do { \
        { const f32x4 l0_ = MFMA16(kf_, qsl, ((f32x4){0.f, 0.f, 0.f, 0.f})); const f32x4 l1_ = MFMA16(kf_, qsh, l0_); \
          _Pragma("unroll") for (int r_ = 0; r_ < 4; ++r_) sc_[r_] = l1_[r_]; } \
        _Pragma("unroll") for (int h_ = 0; h_ < 8; ++h_) { const f32x4 d_ = MFMA16(kf_, qf[h_], ((f32x4){0.f, 0.f, 0.f, 0.f})); \
            _Pragma("unroll") for (int r_ = 0; r_ < 4; ++r_) { sc_[r_] = __builtin_fmaf(wv[h_], __builtin_fabsf(d_[r_]), sc_[r_]); asm("" : "+v"(sc_[r_])); } } } while (0)
        const int cnt = (ntiles - wave + 7) >> 3;
#ifndef DBG_RA
#define DBG_RA 1
#endif
#pragma unroll 1
        for (int rA = 0; rA < DBG_RA; ++rA) { if (rA) { for (int i = tid; i < 8192 + 4; i += 512) ((LAS v4u*)HIST)[i] = (v4u){0u, 0u, 0u, 0u}; __syncthreads(); }
#define AT_LOADG(dst_, i0_) do { _Pragma("unroll") for (int j_ = 0; j_ < 8; ++j_) { int kt_ = wave + 8 * ((i0_) + j_); kt_ = kt_ < ntiles ? kt_ : ntiles - 1; dst_[j_] = AT_LOADK(kt_); } } while (0)
#define AT_P1GROUP(buf_, base_) do { _Pragma("unroll") for (int j2 = 0; j2 < 8; ++j2) { const bool valid = ((base_) + j2 < cnt); const int kt = wave + 8 * ((base_) + j2); float sc[4]; AT_SCORES(buf_[j2], sc); \
                if (valid) *(f32x4*)(SC + qi * 4096 + kt * 16 + 4 * fq) = (f32x4){sc[0], sc[1], sc[2], sc[3]}; \
                _Pragma("unroll") for (int r = 0; r < 4; ++r) { const unsigned bin = score_key(sc[r]) >> 20; \
                    __hip_atomic_fetch_add(&HIST[qi * AT_HROW + (bin >> 1)], valid ? (1u << ((bin & 1u) * 16)) : 0u, __ATOMIC_RELAXED, __HIP_MEMORY_SCOPE_WORKGROUP); } } } while (0)
        { AT_LAUNDER(); bf16x8 ka[8], kb[8]; AT_LOADG(ka, 0);
#pragma unroll 1
          for (int i0 = 0; i0 < cnt; i0 += 16) {
            AT_LOADG(kb, i0 + 8);
            AT_P1GROUP(ka, i0);
            AT_LOADG(ka, i0 + 16);
            AT_P1GROUP(kb, i0 + 8); } }
#undef AT_P1GROUP
        __syncthreads();
        }
#ifndef DBG_RB
#define DBG_RB 1
#endif
#pragma unroll 1
        for (int rB = 0; rB < DBG_RB; ++rB) {
#pragma unroll 1
        for (int j = 0; j < 2; ++j) { AT_LAUNDER(); const int q = 2 * wave + j; unsigned tot = 0;
            for (int i = 0; i < 32; ++i) { const unsigned w = HIST[q * AT_HROW + 32 * lane + ((i + lane) & 31)]; tot += (w & 0xffffu) + (w >> 16); }
            const unsigned suf = wave_suffix_sum(tot, lane);
            const unsigned long long mk = __ballot(suf >= 256u); const int L = 63 - __clzll((long long)mk);
            const unsigned above_L = (unsigned)__builtin_amdgcn_readlane((int)(suf - tot), L);
            const unsigned w2 = HIST[q * AT_HROW + 32 * L + (lane >> 1)]; const unsigned cb = (lane & 1) ? (w2 >> 16) : (w2 & 0xffffu);
            const unsigned sfx = wave_suffix_sum(cb, lane);
            const unsigned long long mk2 = __ballot(above_L + sfx >= 256u); const int l2 = 63 - __clzll((long long)mk2);
            if (lane == l2) { SM[q] = 64 * L + l2; SM[16 + q] = (int)(256u - (above_L + sfx - cb)); } }
        __syncthreads();
        }
#ifndef DBG_RC
#define DBG_RC 1
#endif
#pragma unroll 1
        for (int rC = 0; rC < DBG_RC; ++rC) { if (rC) { if (tid < 16) SM[48 + tid] = 0; __syncthreads(); }
        { AT_LAUNDER(); const int Bq = SM[qi]; f32x4 scur[8];
#define AT_LOADS(dst_, i0_) do { _Pragma("unroll") for (int j_ = 0; j_ < 8; ++j_) { int kt_ = wave + 8 * ((i0_) + j_); kt_ = kt_ < ntiles ? kt_ : ntiles - 1; dst_[j_] = *(const f32x4*)(SC + qi * 4096 + kt_ * 16 + 4 * fq); } } while (0)
#define AT_P2GROUP(buf_, base_) do { _Pragma("unroll") for (int j2 = 0; j2 < 8; ++j2) { const bool valid = ((base_) + j2 < cnt); const int kt = wave + 8 * ((base_) + j2); \
                unsigned nib = 0u, cnib = 0u; unsigned uu[4]; \
                _Pragma("unroll") for (int r = 0; r < 4; ++r) { uu[r] = score_key(buf_[j2][r]); const int bin = (int)(uu[r] >> 20); nib |= (bin > Bq) ? (1u << r) : 0u; cnib |= (bin == Bq) ? (1u << r) : 0u; } \
                if (!valid) { nib = 0u; cnib = 0u; } \
                if (cnib) { int p = __hip_atomic_fetch_add(&SM[48 + qi], (int)__popc(cnib), __ATOMIC_RELAXED, __HIP_MEMORY_SCOPE_WORKGROUP); \
                    _Pragma("unroll") for (int r = 0; r < 4; ++r) if ((cnib >> r) & 1u) { if (p < 512) CAND[qi * 1024 + p] = ((unsigned long long)uu[r] << 32) | (unsigned long long)(0xFFFFu - (unsigned)(kt * 16 + 4 * fq + r)); ++p; } } \
                if (nib) __hip_atomic_fetch_or(&MASK[qi * AT_MROW + (kt >> 1)], nib << (16 * (kt & 1) + 4 * fq), __ATOMIC_RELAXED, __HIP_MEMORY_SCOPE_WORKGROUP); } } while (0)
          f32x4 sb2[8];
          AT_LOADS(scur, 0);
#pragma unroll 1
          for (int i0 = 0; i0 < cnt; i0 += 16) {
            AT_LOADS(sb2, i0 + 8);
            AT_P2GROUP(scur, i0);
            AT_LOADS(scur, i0 + 16);
            AT_P2GROUP(sb2, i0 + 8); } }
#undef AT_P2GROUP
#undef AT_LOADS
        __syncthreads();
        }
#ifndef DBG_RD
#define DBG_RD 1
#endif
#pragma unroll 1
        for (int rD = 0; rD < DBG_RD; ++rD) {
#pragma unroll 1
        for (int j = 0; j < 2; ++j) { AT_LAUNDER(); const int q = 2 * wave + j; int m = SM[48 + q]; m = m < 512 ? m : 512; const int nd = SM[16 + q];
            if (m <= 256) at_resolve<4>(CAND + q * 1024, MASK + q * AT_MROW, m, nd, lane); else at_resolve<8>(CAND + q * 1024, MASK + q * AT_MROW, m, nd, lane); }
        __syncthreads();
        }
#undef AT_SCORES
#undef AT_LOADK
#undef AT_LOADG
    } else {
#pragma unroll 1
        for (int i = tid; i < 16 * AT_MROW; i += 512) MASK[i] = ((i % AT_MROW) < (n >> 5)) ? 0xFFFFFFFFu : 0u;
        __syncthreads();
    }
    }
#pragma unroll 1
    for (int rden = 0; rden < DBG_REP_DENSE; ++rden) {
    { const int g = wave >> 2, qh = (wave >> 1) & 1, hp = wave & 1, NS = n >> 6;
      const unsigned ring0 = (unsigned)(size_t)(lds + AT_HIST);
      if (tid < 64) *(LAS float*)(lds + AT_LUT + 4 * tid) = ((tid >> 2) >> (tid & 3)) & 1 ? -cshift : -1.0e30f;
      const bf16* dsrc[4]; unsigned ddst[4];
      { AT_LAUNDER();
#pragma unroll
        for (int i_ = 0; i_ < 4; ++i_) { const int in_ = 4 * wave + i_; const int row_ = 4 * (in_ & 15) + (lane >> 4), pos_ = lane & 15;
            dsrc[i_] = (in_ < 16) ? (KN + (tb + row_) * 128 + ((pos_ ^ (row_ & 15)) << 3)) : (VB + (tb + row_) * 256 + 128 + ((pos_ ^ (2 * (row_ & 7))) << 3));
            ddst[i_] = (unsigned)(in_ * 1024); } }
      const size_t dstep = (wave < 4) ? (size_t)64 * 128 : (size_t)64 * 256;
#define AT_STAGE(s_) do { const unsigned sb_ = ring0 + (unsigned)(((s_) & 3) * 32768); \
        _Pragma("unroll") for (int i_ = 0; i_ < 4; ++i_) { const bf16* src_ = dsrc[i_] + (size_t)(s_) * dstep; \
            const unsigned dst_ = __builtin_amdgcn_readfirstlane(sb_ + ddst[i_]); unsigned keep_; \
            asm volatile("s_mov_b32 %0, m0\n\ts_mov_b32 m0, %2\n\ts_nop 0\n\tglobal_load_lds_dwordx4 %1, off\n\ts_mov_b32 m0, %0" : "=&s"(keep_) : "v"(src_), "s"(dst_) : "memory"); } } while (0)
      bf16x8 qa[2], qb[2]; f32x4 oacc[2][4], lacc[2];
      { AT_LAUNDER();
#pragma unroll
        for (int hi = 0; hi < 2; ++hi) { const bf16* qp = AQN + (tb + q0u + 16 * qh + qi) * 512 + (g * 4 + 2 * hp + hi) * 64 + 8 * fq; qa[hi] = *(const bf16x8*)qp; qb[hi] = *(const bf16x8*)(qp + 32); } }
#pragma unroll
      for (int hi = 0; hi < 2; ++hi) { lacc[hi] = (f32x4){0.f, 0.f, 0.f, 0.f};
#pragma unroll
        for (int dt = 0; dt < 4; ++dt) oacc[hi][dt] = (f32x4){0.f, 0.f, 0.f, 0.f}; }
      const bf16x8 ones = (bf16x8){0x3F80, 0x3F80, 0x3F80, 0x3F80, 0x3F80, 0x3F80, 0x3F80, 0x3F80};
      asm volatile("s_waitcnt vmcnt(0)" ::: "memory");
#pragma unroll 1
      for (int s = 0; s < 3 && s < NS; ++s) AT_STAGE(s);
      typedef short s4_t __attribute__((ext_vector_type(4)));
      AT_LAUNDER();
      const LAS unsigned* mrow = (const LAS unsigned*)(lds + (qh ? AT_SEL2 : AT_SEL)) + qi * AT_MROW;
      const unsigned koff0 = (unsigned)(qi * 256 + (((g * 8 + fq) ^ qi) << 4)), koff1 = (unsigned)(qi * 256 + (((g * 8 + 4 + fq) ^ qi) << 4));
#define AT_LDK(kf_, ci_, slot_, tp_, mw_) do { const LAS unsigned char* kb_ = lds + AT_HIST + (slot_) * 32768 + (tp_) * 8192; \
          _Pragma("unroll") for (int t = 0; t < 2; ++t) { kf_[t][0] = *(const LAS bf16x8*)(kb_ + t * 4096 + koff0); kf_[t][1] = *(const LAS bf16x8*)(kb_ + t * 4096 + koff1); \
              ci_[t] = *(const LAS f32x4*)(lds + AT_LUT + ((((mw_) >> (16 * t + 4 * fq)) & 15u) << 4)); } } while (0)
#define AT_LDV(va_, slot_, vkh_) do { const LAS unsigned char* vb_ = lds + AT_HIST + (slot_) * 32768 + 16384 + (vkh_) * 8192; \
          _Pragma("unroll") for (int dt = 0; dt < 4; ++dt) { const int r1 = 4 * fq + (qi >> 2); const int ch_ = g * 8 + 2 * dt + ((lane & 3) >> 1); \
              const s4_t lo = __builtin_amdgcn_ds_read_tr16_b64_v4i16((LAS s4_t*)(vb_ + r1 * 256 + ((ch_ ^ (2 * (r1 & 7))) << 4) + (lane & 1) * 8)); \
              const s4_t hi4 = __builtin_amdgcn_ds_read_tr16_b64_v4i16((LAS s4_t*)(vb_ + (r1 + 16) * 256 + ((ch_ ^ (2 * (r1 & 7))) << 4) + (lane & 1) * 8)); \
              va_[dt] = (bf16x8){lo[0], lo[1], lo[2], lo[3], hi4[0], hi4[1], hi4[2], hi4[3]}; } } while (0)
#define AT_QKM(dst_, kf_, ci_) do { \
          _Pragma("unroll") for (int t = 0; t < 2; ++t) { \
              _Pragma("unroll") for (int hi = 0; hi < 2; ++hi) { const f32x4 d_ = MFMA16(kf_[t][0], qa[hi], ci_[t]); dst_[hi][t] = MFMA16(kf_[t][1], qb[hi], d_); } } } while (0)
#define AT_EXP(pb_, cur_) do { \
          _Pragma("unroll") for (int hi = 0; hi < 2; ++hi) { float pv[8]; \
              _Pragma("unroll") for (int j = 0; j < 8; ++j) pv[j] = __builtin_amdgcn_exp2f(cur_[hi][j >> 2][j & 3]); \
              v4u pw; pw.x = pk2(pv[0], pv[1]); pw.y = pk2(pv[2], pv[3]); pw.z = pk2(pv[4], pv[5]); pw.w = pk2(pv[6], pv[7]); pb_[hi] = __builtin_bit_cast(bf16x8, pw); } } while (0)
#define AT_PV(pb_, va_) do { \
          _Pragma("unroll") for (int hi = 0; hi < 2; ++hi) lacc[hi] = MFMA16(ones, pb_[hi], lacc[hi]); \
          _Pragma("unroll") for (int dt = 0; dt < 4; ++dt) { \
              _Pragma("unroll") for (int hi = 0; hi < 2; ++hi) oacc[hi][dt] = MFMA16(va_[dt], pb_[hi], oacc[hi][dt]); } } while (0)
      f32x4 st0[2][2], st1[2][2]; bf16x8 kfA[2][2], kfB[2][2]; f32x4 ciA[2], ciB[2]; bf16x8 vaP[4], vaQ[4], pbP[2], pbQ[2];
      if (NS >= 3) asm volatile("s_waitcnt vmcnt(8)" ::: "memory"); else asm volatile("s_waitcnt vmcnt(0)" ::: "memory");
      __builtin_amdgcn_s_barrier(); asm volatile("" ::: "memory");
      unsigned m1A, m1B;
      { const unsigned m0A = mrow[0], m0B = mrow[1]; const int sx = (NS > 1) ? 1 : 0; m1A = mrow[2 * sx]; m1B = mrow[2 * sx + 1];
        AT_LDK(kfB, ciB, 0, 0, m0A); AT_LDK(kfA, ciA, 0, 1, m0B);
        AT_QKM(st0, kfB, ciB);
#pragma unroll
        for (int hi = 0; hi < 2; ++hi) pbP[hi] = (bf16x8){0, 0, 0, 0, 0, 0, 0, 0};
#pragma unroll
        for (int dt = 0; dt < 4; ++dt) vaP[dt] = (bf16x8){0, 0, 0, 0, 0, 0, 0, 0}; }
#pragma unroll 1
      for (int s = 0; s < NS; ++s) {
          if (s + 2 < NS) asm volatile("s_waitcnt vmcnt(4)" ::: "memory"); else asm volatile("s_waitcnt vmcnt(0)" ::: "memory");
          __builtin_amdgcn_s_barrier(); asm volatile("" ::: "memory");
          if (s + 3 < NS) AT_STAGE(s + 3);
          const int s1 = (s + 1 < NS) ? s + 1 : s, s2 = (s + 2 < NS) ? s + 2 : NS - 1;
          const unsigned m2A = mrow[2 * s2], m2B = mrow[2 * s2 + 1];
          AT_LDK(kfB, ciB, (s1 & 3), 0, m1A); AT_LDV(vaQ, (s & 3), 0);
          AT_QKM(st1, kfA, ciA); AT_EXP(pbQ, st0); AT_PV(pbP, vaP);
          __builtin_amdgcn_sched_barrier(0);
          AT_LDK(kfA, ciA, (s1 & 3), 1, m1B); AT_LDV(vaP, (s & 3), 1);
          AT_QKM(st0, kfB, ciB); AT_EXP(pbP, st1); AT_PV(pbQ, vaQ);
          __builtin_amdgcn_sched_barrier(0);
          m1A = m2A; m1B = m2B; }
      AT_PV(pbP, vaP);
#undef AT_LDK
#undef AT_LDV
#undef AT_QKM
#undef AT_EXP
#undef AT_PV
      { AT_LAUNDER();
#pragma unroll
        for (int hi = 0; hi < 2; ++hi) { const float inv = 1.0f / lacc[hi][0];
            bf16* yp = YATT + (tb + q0u + 16 * qh + qi) * 512 + (g * 4 + 2 * hp + hi) * 64 + 4 * fq;
#pragma unroll
            for (int dt = 0; dt < 4; ++dt) { const f32x4 o = oacc[hi][dt];
                v2u w; w.x = pk2(o[0] * inv, o[1] * inv); w.y = pk2(o[2] * inv, o[3] * inv); *(v2u*)(yp + 16 * dt) = w; } } }
#undef AT_STAGE
    }
    __syncthreads();
    }
#undef AT_LAUNDER
    __syncthreads();
}

#ifndef DBG_REP_ML
#define DBG_REP_ML 1
#endif
#ifndef DBG_REP_ATT
#define DBG_REP_ATT 1
#endif
__device__ __forceinline__ void p3_mixer(const Args& a, const Ctx& c, volatile LAS unsigned* MISC, int rep) {
#if !defined(NO_MLSTM)
#pragma unroll 1
    for (int rr = 0; rr < DBG_REP_ML; ++rr)
#pragma unroll 1
        for (int u = blockIdx.x; u < 32; u += c.G) mlstm_unit<0>(a, c, u >> 2, u & 3, 0);
#endif
    unsigned* ctl = (unsigned*)(a.ws + WS_CTL);
    const int x = (int)(__builtin_amdgcn_s_getreg((3 << 11) | 20) & 7u);
    float cshift;
    { float gq = fabsf(a.in[IN_GQ][c.lane]), gk = fabsf(a.in[IN_GK][c.lane]);
#pragma unroll
      for (int o = 1; o < 64; o <<= 1) { gq = fmaxf(gq, __shfl_xor(gq, o)); gk = fmaxf(gk, __shfl_xor(gk, o)); }
      cshift = 8.0f * 1.4426950408889634f * gq * gk; }
#pragma unroll 1
    for (int rot = 0; rot < 8 * DBG_REP_ATT; ++rot) { rep = rot >> 3; const int bq = (x + rot) & 7;
        if (c.tid == 0) MISC[16] = __hip_atomic_fetch_add(ctl + CW_Q + 512 * rep + 64 * bq, 1u, RLX_AGENT);
        __syncthreads();
        int u = (int)MISC[16];
        __syncthreads();
#pragma unroll 1
        while (u < 128) {
            unsigned nxt = 0u;
            if (c.tid == 0) nxt = __hip_atomic_fetch_add(ctl + CW_Q + 512 * rep + 64 * bq, 1u, RLX_AGENT);
#if !defined(NO_ATTN)
            attn_unit(a, c, bq, 127 - u, cshift);
#endif
            if (c.tid == 0) MISC[16] = nxt;
            __syncthreads();
            u = (int)MISC[16];
            __syncthreads();
        } }
}
constexpr int RT_WT = 0;
constexpr int RT_WROW = 1028;
constexpr int RT_WBYTES = 36 * RT_WROW * 4;
constexpr int RT_NPIECE = (RT_WBYTES + 1023) / 1024;
constexpr int RT_LG = 0;
constexpr int RT_RSTD = RT_NPIECE * 1024;
constexpr int RT_LCNT = RT_RSTD + 512;
constexpr int RT_BIAS = RT_LCNT + 128;
static_assert(RT_BIAS + 144 <= MISC_OFF, "router LDS map");
__device__ __forceinline__ void p6_router(const Args& a, const Ctx& c) {
    const int tid = c.tid, lane = c.lane, wave = c.wave; LAS unsigned char* lds = c.lds;
    LAS float* WT = (LAS float*)(lds + RT_WT); LAS float* LG = (LAS float*)(lds + RT_LG); LAS float* RSTD = (LAS float*)(lds + RT_RSTD); LAS int* LCNT = (LAS int*)(lds + RT_LCNT); LAS float* BIAS = (LAS float*)(lds + RT_BIAS);
    { int* RT = (int*)(a.ws + WS_ROWTOK); for (int i = blockIdx.x * 512 + tid; i < NROWS_MAX; i += c.G * 512) RT[i] = 0; }
    if (tid < 36) BIAS[tid] = tid < 32 ? a.in[IN_BRE][tid] : a.in[IN_BRG][tid - 32];
    f32x4 gv[4];
#pragma unroll
    for (int j = 0; j < 4; ++j) gv[j] = *(const f32x4*)(a.in[IN_GMOE] + 4 * lane + 256 * j);
    const float* X1 = a.out; bf16* XN = (bf16*)(a.ws + WS_XN);
    int* TOKE = (int*)(a.ws + WS_TOKE); int* TOKR = (int*)(a.ws + WS_TOKR); float* TOKG = (float*)(a.ws + WS_TOKG); int* CNT = (int*)(a.ws + WS_CNT);
    for (int blk = blockIdx.x; blk < 256; blk += c.G) {
        __syncthreads();
        { const unsigned char* src = a.ws + WS_WTG;
#pragma unroll 1
          for (int pc = wave; pc < RT_NPIECE; pc += NWAVES)
              __builtin_amdgcn_global_load_lds((const unsigned*)(src + (size_t)pc * 1024 + lane * 16), (LAS unsigned*)(lds + RT_WT + pc * 1024), 16, 0, 0); }
        if (tid < 32) LCNT[tid] = 0;
#pragma unroll 1
        for (int ri = 0; ri < 16; ri += 4) { const int t0 = blk * 128 + wave * 16 + ri;
            f32x4 v[4][4]; float ss[4];
#pragma unroll
            for (int q = 0; q < 4; ++q) { const f32x4* xp = (const f32x4*)(X1 + (size_t)(t0 + q) * D) + lane;
#pragma unroll
                for (int j = 0; j < 4; ++j) v[q][j] = xp[64 * j]; }
#pragma unroll
            for (int q = 0; q < 4; ++q) { float sq = 0.f;
#pragma unroll
                for (int j = 0; j < 4; ++j) sq += (v[q][j].x * v[q][j].x + v[q][j].y * v[q][j].y) + (v[q][j].z * v[q][j].z + v[q][j].w * v[q][j].w);
                ss[q] = rsqrtf(wave_sum(sq) * (1.f / D) + EPS); }
            if (lane < 4) RSTD[wave * 16 + ri + lane] = (lane == 0) ? ss[0] : ((lane == 1) ? ss[1] : ((lane == 2) ? ss[2] : ss[3]));
#pragma unroll
            for (int q = 0; q < 4; ++q) { v2u* op = (v2u*)(XN + (size_t)(t0 + q) * D) + lane; const float r = ss[q];
#pragma unroll
                for (int j = 0; j < 4; ++j) { v2u w; w.x = pk2(v[q][j].x * r * gv[j].x, v[q][j].y * r * gv[j].y); w.y = pk2(v[q][j].z * r * gv[j].z, v[q][j].w * r * gv[j].w); op[64 * j] = w; } } }
        asm volatile("s_waitcnt vmcnt(0)" ::: "memory");
        __syncthreads();
        f32x4 acc[3];
#pragma unroll
        for (int ct = 0; ct < 3; ++ct) acc[ct] = (f32x4){0.f, 0.f, 0.f, 0.f};
        { const int row = lane & 15, kq = lane >> 4;
          const f32x4* ap = (const f32x4*)(X1 + (size_t)(blk * 128 + wave * 16 + row) * D + 4 * kq);
          int cj[3]; cj[0] = row; cj[1] = 16 + row; cj[2] = (32 + row) < 36 ? (32 + row) : 35;
          const LAS f32x4* bp0 = (const LAS f32x4*)(WT + cj[0] * RT_WROW + 4 * kq); const LAS f32x4* bp1 = (const LAS f32x4*)(WT + cj[1] * RT_WROW + 4 * kq); const LAS f32x4* bp2 = (const LAS f32x4*)(WT + cj[2] * RT_WROW + 4 * kq);
#define RT_LOADA(dst_, b_) do { _Pragma("unroll") for (int i_ = 0; i_ < 8; ++i_) dst_[i_] = ap[4 * (8 * ((b_) < 8 ? (b_) : 7) + i_)]; } while (0)
#define RT_MMA(src_, b_) do { _Pragma("unroll") for (int i_ = 0; i_ < 8; ++i_) { const int ks_ = 8 * (b_) + i_; const f32x4 b0 = bp0[4 * ks_], b1 = bp1[4 * ks_], b2 = bp2[4 * ks_]; \
              _Pragma("unroll") for (int j = 0; j < 4; ++j) { acc[0] = __builtin_amdgcn_mfma_f32_16x16x4f32(src_[i_][j], b0[j], acc[0], 0, 0, 0); acc[1] = __builtin_amdgcn_mfma_f32_16x16x4f32(src_[i_][j], b1[j], acc[1], 0, 0, 0); \
                  acc[2] = __builtin_amdgcn_mfma_f32_16x16x4f32(src_[i_][j], b2[j], acc[2], 0, 0, 0); } } } while (0)
          f32x4 aA[8], aB[8]; RT_LOADA(aA, 0);
#pragma unroll 1
          for (int bb = 0; bb < 8; bb += 2) { RT_LOADA(aB, bb + 1); RT_MMA(aA, bb); RT_LOADA(aA, bb + 2); RT_MMA(aB, bb + 1); }
#undef RT_LOADA
#undef RT_MMA
        }
        __syncthreads();
        { const int col = lane & 15, kq = lane >> 4;
#pragma unroll
          for (int ct = 0; ct < 3; ++ct) if (16 * ct + col < 36) {
#pragma unroll
              for (int r = 0; r < 4; ++r) LG[(wave * 16 + 4 * kq + r) * 36 + 16 * ct + col] = acc[ct][r]; } }
        __syncthreads();
        if (tid < 128) { const int row = tid, t = blk * 128 + row; const float rs = RSTD[row]; const LAS float* lg = LG + tid * 36;
            float gl[4];
#pragma unroll
            for (int i = 0; i < 4; ++i) gl[i] = rs * lg[32 + i] + BIAS[32 + i];
            int gs = 0; float gmax = gl[0];
#pragma unroll
            for (int i = 1; i < 4; ++i) if (gl[i] > gmax) { gmax = gl[i]; gs = i; }
            float gsum = 0.f;
#pragma unroll
            for (int i = 0; i < 4; ++i) gsum += expf(gl[i] - gmax);
            const float gtop = 1.0f / gsum;
            float ev[8];
#pragma unroll
            for (int i = 0; i < 8; ++i) ev[i] = rs * lg[gs * 8 + i] + BIAS[gs * 8 + i];
            int l0 = 0; float v0 = ev[0];
#pragma unroll
            for (int i = 1; i < 8; ++i) if (ev[i] > v0) { v0 = ev[i]; l0 = i; }
            int l1 = -1; float v1 = -3.0e38f;
#pragma unroll
            for (int i = 0; i < 8; ++i) if (i != l0 && ev[i] > v1) { v1 = ev[i]; l1 = i; }
            const float e1 = expf(v1 - v0), s0 = 1.0f / (1.0f + e1), s1 = e1 * s0;
            const int ex0 = gs * 8 + l0, ex1 = gs * 8 + l1;
            const int rk0 = __hip_atomic_fetch_add(&LCNT[ex0], 1, __ATOMIC_RELAXED, __HIP_MEMORY_SCOPE_WORKGROUP);
            const int rk1 = __hip_atomic_fetch_add(&LCNT[ex1], 1, __ATOMIC_RELAXED, __HIP_MEMORY_SCOPE_WORKGROUP);
            TOKE[2 * t] = ex0; TOKE[2 * t + 1] = ex1; TOKR[2 * t] = rk0; TOKR[2 * t + 1] = rk1; TOKG[2 * t] = s0 * gtop; TOKG[2 * t + 1] = s1 * gtop; }
        __syncthreads();
        if (tid < 32) CNT[blk * 32 + tid] = LCNT[tid];
    }
}
__device__ __forceinline__ void p7_gather(const Args& a, const Ctx& c) {
    const int tid = c.tid, lane = c.lane, wave = c.wave;
    LAS int* PART = (LAS int*)c.lds; LAS int* PPRE = PART + 512; LAS int* TOT = PPRE + 512; LAS int* TS = TOT + 32; LAS int* BASE = TS + 64;
    const int* CNT = (const int*)(a.ws + WS_CNT); const int* TOKE = (const int*)(a.ws + WS_TOKE); const int* TOKR = (const int*)(a.ws + WS_TOKR); int* TOKP = (int*)(a.ws + WS_TOKP);
    int* RT = (int*)(a.ws + WS_ROWTOK);
    { const int e = tid & 31, p = tid >> 5; int s = 0; for (int k = 0; k < 16; ++k) s += CNT[(16 * p + k) * 32 + e]; PART[p * 32 + e] = s; }
    __syncthreads();
    if (tid < 32) { int run = 0; for (int p = 0; p < 16; ++p) { PPRE[p * 32 + tid] = run; run += PART[p * 32 + tid]; } TOT[tid] = run; }
    __syncthreads();
    if (tid == 0) { int ts = 0; for (int e = 0; e < 32; ++e) { TS[e] = ts; ts += (TOT[e] + 255) >> 8; } TS[32] = ts; }
    __syncthreads();
    if (blockIdx.x == 0 && tid < 33) ((int*)(a.ws + WS_SMALL))[tid] = TS[tid];
    for (int blk = blockIdx.x; blk < 256; blk += c.G) {
        if (tid < 32) { int s = TS[tid] * 256 + PPRE[(blk >> 4) * 32 + tid]; for (int b2 = (blk & ~15); b2 < blk; ++b2) s += CNT[b2 * 32 + tid]; BASE[tid] = s; }
        __syncthreads();
        { const int t = blk * 128 + (tid >> 2), jj = tid & 3;
          if (jj < 2) { const int pos = BASE[TOKE[2 * t + jj]] + TOKR[2 * t + jj]; TOKP[2 * t + jj] = pos; RT[pos] = t; } }
        __syncthreads();
    }
}
__device__ __forceinline__ void p10_combine(const Args& a, const Ctx& c) {
    const int lane = c.lane, gw = c.vcu * NWAVES + c.wave, NGW = c.G * NWAVES;
    const int* TOKP = (const int*)(a.ws + WS_TOKP); const float* TOKG = (const float*)(a.ws + WS_TOKG); const bf16* Y = (const bf16*)(a.ws + WS_Y);
    for (int t0 = gw; t0 < T; t0 += 2 * NGW) {
        const int tA = t0, tB = (t0 + NGW < T) ? t0 + NGW : t0; const bool hasB = (t0 + NGW < T);
        const int pA0 = TOKP[2 * tA], pA1 = TOKP[2 * tA + 1], pB0 = TOKP[2 * tB], pB1 = TOKP[2 * tB + 1];
        const float gA0 = TOKG[2 * tA], gA1 = TOKG[2 * tA + 1], gB0 = TOKG[2 * tB], gB1 = TOKG[2 * tB + 1];
        f32x4 xa[4], xb[4]; v2u ya0[4], ya1[4], yb0[4], yb1[4];
#pragma unroll
        for (int j = 0; j < 4; ++j) { const int cc = 4 * lane + 256 * j;
            xa[j] = *(const f32x4*)(a.out + (size_t)tA * D + cc); xb[j] = *(const f32x4*)(a.out + (size_t)tB * D + cc);
            ya0[j] = *(const v2u*)(Y + (size_t)pA0 * D + cc); ya1[j] = *(const v2u*)(Y + (size_t)pA1 * D + cc);
            yb0[j] = *(const v2u*)(Y + (size_t)pB0 * D + cc); yb1[j] = *(const v2u*)(Y + (size_t)pB1 * D + cc); }
#pragma unroll
        for (int j = 0; j < 4; ++j) { const int cc = 4 * lane + 256 * j; f32x4 x = xa[j];
            x[0] += gA0 * bf2f(ya0[j].x & 0xffffu) + gA1 * bf2f(ya1[j].x & 0xffffu); x[1] += gA0 * bf2f(ya0[j].x >> 16) + gA1 * bf2f(ya1[j].x >> 16);
            x[2] += gA0 * bf2f(ya0[j].y & 0xffffu) + gA1 * bf2f(ya1[j].y & 0xffffu); x[3] += gA0 * bf2f(ya0[j].y >> 16) + gA1 * bf2f(ya1[j].y >> 16);
            *(f32x4*)(a.out + (size_t)tA * D + cc) = x; }
        if (hasB) {
#pragma unroll
        for (int j = 0; j < 4; ++j) { const int cc = 4 * lane + 256 * j; f32x4 x = xb[j];
            x[0] += gB0 * bf2f(yb0[j].x & 0xffffu) + gB1 * bf2f(yb1[j].x & 0xffffu); x[1] += gB0 * bf2f(yb0[j].x >> 16) + gB1 * bf2f(yb1[j].x >> 16);
            x[2] += gB0 * bf2f(yb0[j].y & 0xffffu) + gB1 * bf2f(yb1[j].y & 0xffffu); x[3] += gB0 * bf2f(yb0[j].y >> 16) + gB1 * bf2f(yb1[j].y >> 16);
            *(f32x4*)(a.out + (size_t)tB * D + cc) = x; } }
    }
}
__global__ void __launch_bounds__(NWAVES * 64, 2) hybrid_fwd(Args args) {
    extern __shared__ __attribute__((aligned(16))) unsigned char lds_raw[];
    Ctx c; c.lds = (LAS unsigned char*)lds_raw;
    volatile LAS unsigned* MISC = (volatile LAS unsigned*)(c.lds + MISC_OFF);
    c.tid = threadIdx.x; c.lane = c.tid & 63; c.wave = __builtin_amdgcn_readfirstlane(c.tid >> 6);
    c.G = gridDim.x; { const int bx = blockIdx.x; c.vcu = (c.G % 8 == 0) ? (bx % 8) * (c.G / 8) + bx / 8 : bx; }
    unsigned* ctl = (unsigned*)(args.ws + WS_CTL);
    if (c.tid < 128) MISC[c.tid] = 0u;
    __syncthreads();
    XcdBarrier bar; bar.bar = ctl + CW_BAR; bar.x = 0; bar.st = nullptr;
    if (N_LAUNCHES == 1) bar = xcd_barrier_post(ctl + CW_BAR, MISC + 8);
#define GRID_BAR() do { if (N_LAUNCHES == 1) xcd_barrier(bar); } while (0)
    const int lo = args.ph_lo, hi = args.ph_hi;
#ifndef PH_MASK
#define PH_MASK 0xfff
#endif
#define IN(k) (((PH_MASK >> (k)) & 1) && lo <= (k) && (k) < hi)
#define BOTH(k) (IN(k) && IN((k) + 1))
    unsigned char* ws = args.ws; unsigned char* dout = (unsigned char*)args.out;
#ifndef DBG_REPEAT
#define DBG_REPEAT -1
#endif
#define REPS(k) (((k) == DBG_REPEAT) ? 2 : 1)
    if (IN(0)) { _Pragma("unroll") for (int rep = 0; rep < REPS(0); ++rep) { if (rep) GRID_BAR(); p0_prologue<0>(args, c, c.vcu * NWAVES + c.wave, c.G * NWAVES); } if (BOTH(0)) GRID_BAR(); }
    if (IN(1)) { _Pragma("unroll") for (int rep = 0; rep < REPS(1); ++rep) { if (rep) GRID_BAR();
#ifdef DBG_STAGGER
        if ((blockIdx.x >> 3) & 1) { const unsigned long long t0 = wall_clock64(); while (wall_clock64() - t0 < (unsigned long long)DBG_STAGGER) __builtin_amdgcn_s_sleep(16); }
#endif
        pg8::Gemm g{(const pg8::bf16_t*)(dout + DO_H), (const pg8::bf16_t*)(ws + WS_WIN), T, NPROJ, D}; pg8::StaticOrder S; S.init(T, NPROJ, c.G, (int)blockIdx.x);
        pg8::EpiBf16<0> E{(pg8::bf16_t*)(ws + WS_PROJ), 256, nullptr, 256, (size_t)T * 256, 1.f};
        pg8::gemm_phase<pg8::EpiBf16<0>, pg8::StaticOrder, true, true>(c.lds, g, S, E); }
        if (BOTH(1)) GRID_BAR();
    }
#ifndef DBG_R2
#define DBG_R2 1
#endif
#ifndef DBG_R4A
#define DBG_R4A 1
#endif
#ifndef DBG_R4B
#define DBG_R4B 1
#endif
#ifndef DBG_R7
#define DBG_R7 1
#endif
    if (IN(2)) { _Pragma("unroll 1") for (int rep = 0; rep < DBG_R2; ++rep) { if (rep) GRID_BAR(); p2_prep(args, c); } if (BOTH(2)) GRID_BAR(); }
    if (IN(3)) { _Pragma("unroll") for (int rep = 0; rep < REPS(3); ++rep) { if (rep) GRID_BAR(); p3_mixer(args, c, MISC, rep); } if (BOTH(3)) GRID_BAR(); }
    if (IN(4)) {
#pragma unroll 1
        for (int rep = 0; rep < DBG_R4A; ++rep) {
            const int gw = c.vcu * NWAVES + c.wave, ngw = c.G * NWAVES, kdone = ((int)blockIdx.x < 256) ? 24 : 0;
            LAS float* scr = (LAS float*)(c.lds + CV_SCR + c.wave * CV_SCRW);
#pragma unroll 1
            for (int k = kdone; gw + k * ngw < CV_NMI; ++k) { const CvItem it = cv_item(args, gw + k * ngw); f32x4 v[4]; cv_load(it, v, c.lane); cv_finish(it, v, scr, c.lane, true); }
            __syncthreads(); }
#pragma unroll 1
        for (int rep = 0; rep < DBG_R4B; ++rep)
#pragma unroll 1
        for (int u = blockIdx.x; u < 256; u += c.G) mlstm_unit<1>(args, c, u >> 5, (u >> 3) & 3, u & 7);
        if (BOTH(4)) GRID_BAR();
    }
    if (IN(5)) {
        { pg8::Gemm g{(const pg8::bf16_t*)(dout + DO_YATT), (const pg8::bf16_t*)(ws + WS_WPA), T, D, 512}; pg8::StaticOrder S; S.init(T, D, c.G, (int)blockIdx.x);
          pg8::EpiGate<false> E{(pg8::bf16_t*)(ws + WS_MERGED), D, (const pg8::bf16_t*)(ws + WS_PROJ + (size_t)TL_GA * PROJ_TILE), (size_t)T * 256};
          pg8::gemm_phase<pg8::EpiGate<false>, pg8::StaticOrder, true, true>(c.lds, g, S, E); }
        __syncthreads();
        { pg8::Gemm g{(const pg8::bf16_t*)(dout + DO_YML), (const pg8::bf16_t*)(ws + WS_WPM), T, D, 512}; pg8::StaticOrder S; S.init(T, D, c.G, (int)blockIdx.x);
          pg8::EpiGate<true> E{(pg8::bf16_t*)(ws + WS_MERGED), D, (const pg8::bf16_t*)(ws + WS_PROJ + (size_t)TL_GM * PROJ_TILE), (size_t)T * 256};
          pg8::gemm_phase<pg8::EpiGate<true>, pg8::StaticOrder, true, true>(c.lds, g, S, E); }
        if (BOTH(5)) GRID_BAR();
    }
    if (IN(6)) {
        pg8::Gemm g{(const pg8::bf16_t*)(ws + WS_MERGED), (const pg8::bf16_t*)(ws + WS_WOUT), T, D, D}; pg8::StaticOrder S; S.init(T, D, c.G, (int)blockIdx.x);
        pg8::EpiRes E{args.out, args.in[IN_X], D};
        pg8::gemm_phase<pg8::EpiRes, pg8::StaticOrder, true, true>(c.lds, g, S, E);
        if (BOTH(6)) GRID_BAR();
    }
    if (IN(7)) { _Pragma("unroll 1") for (int rep = 0; rep < DBG_R7; ++rep) { if (rep) { GRID_BAR(); } p6_router(args, c); } if (BOTH(7)) GRID_BAR(); }
    if (IN(8)) { _Pragma("unroll") for (int rep = 0; rep < REPS(8); ++rep) { if (rep) GRID_BAR(); p7_gather(args, c); } if (BOTH(8)) GRID_BAR(); }
    if (IN(9) || IN(10)) {
        LAS int* TSL = (LAS int*)(c.lds + MISC_OFF + 256);
        LAS int* XS = (LAS int*)(c.lds + MISC_OFF + 400);
        if (c.tid < 33) TSL[c.tid] = (int)__hip_atomic_load((unsigned*)(ws + WS_SMALL) + c.tid, RLX_AGENT);
        if (c.tid == 64) { const int ntt = (int)__hip_atomic_load((unsigned*)(ws + WS_SMALL) + 32, RLX_AGENT); int lo_t = 0, hi_t = ntt, nl = c.G, lx = (int)blockIdx.x;
            if (N_LAUNCHES == 1) { unsigned pre = 0u, mine = 0u;
                for (unsigned j = 0; j < 16; ++j) { const unsigned cj = xb_ld(&bar.bar[XB_XCNT(j)]); pre += (j < bar.x) ? cj : 0u; mine = (j == bar.x) ? cj : mine; }
                nl = (int)mine; lx = (int)MISC[20]; lo_t = (int)((long)ntt * pre / c.G); hi_t = (int)((long)ntt * (pre + mine) / c.G); }
            XS[0] = lo_t; XS[1] = hi_t; XS[2] = nl; XS[3] = lx; }
        __syncthreads();
        const int xs_lo = XS[0], xs_hi = XS[1], xs_nl = XS[2], xs_lx = XS[3];
        if (IN(9)) {
            pg8::MoeOrder<true> S{TSL, xs_nl, xs_lx, xs_lo, xs_hi, (const int*)(ws + WS_ROWTOK), (unsigned*)(ws + WS_CTL) + CW_RDY};
            pg8::Gemm g{(const pg8::bf16_t*)(ws + WS_XN), (const pg8::bf16_t*)(ws + WS_GU), 0, 0, D};
            pg8::EpiSwiGLU E{(pg8::bf16_t*)(ws + WS_HID)};
            pg8::gemm_phase<pg8::EpiSwiGLU, pg8::MoeOrder<true>, true, true>(c.lds, g, S, E);
            if (BOTH(9)) __syncthreads();
        }
        if (IN(10)) {
            pg8::MoeOrder<false> S{TSL, xs_nl, xs_lx, xs_lo, xs_hi, nullptr, (unsigned*)(ws + WS_CTL) + CW_RDY};
            pg8::Gemm g{(const pg8::bf16_t*)(ws + WS_HID), (const pg8::bf16_t*)(ws + WS_DN), 0, 0, 512};
            pg8::EpiDown E{(pg8::bf16_t*)(ws + WS_Y)};
            pg8::gemm_phase<pg8::EpiDown, pg8::MoeOrder<false>, true, true>(c.lds, g, S, E);
            if (BOTH(10)) GRID_BAR();
        }
    }
    if (IN(11)) p10_combine(args, c);
#undef IN
#undef BOTH
#undef GRID_BAR
}

extern "C" void kernel_launch(void* const* d_in, const int* in_sizes, int n_in, void* d_out, int out_size, void* d_ws, size_t ws_size, hipStream_t stream) {
    static int grid = 0;
    if (grid == 0) {
        if (n_in != 22 || in_sizes[0] != T * D || out_size != T * D || ws_size < WS_END) { fprintf(stderr, "kernel_launch: unexpected shapes (n_in %d, in0 %d, out %d, ws %zu); nothing launched\n", n_in, n_in > 0 ? in_sizes[0] : -1, out_size, ws_size); grid = -1; return; }
        int dev = 0, cus = 0, per_cu = 0;
        if (hipGetDevice(&dev) != hipSuccess || hipDeviceGetAttribute(&cus, hipDeviceAttributeMultiprocessorCount, dev) != hipSuccess) { grid = -1; return; }
        if (hipFuncSetAttribute((const void*)hybrid_fwd, hipFuncAttributeMaxDynamicSharedMemorySize, LDS_BYTES) != hipSuccess) { fprintf(stderr, "kernel_launch: hipFuncSetAttribute failed\n"); grid = -1; return; }
        if (hipOccupancyMaxActiveBlocksPerMultiprocessor(&per_cu, (const void*)hybrid_fwd, NWAVES * 64, LDS_BYTES) != hipSuccess || per_cu < 1)
            fprintf(stderr, "kernel_launch: note: occupancy query reports %d workgroups per CU\n", per_cu);
        (void)hipGetLastError();
        grid = cus;
    }
    if (grid < 0) return;
    if (hipMemsetAsync((char*)d_ws + WS_CTL, 0, CTL_ZERO_BYTES, stream) != hipSuccess) return;
    Args a{};
    for (int i = 0; i < 22; ++i) a.in[i] = (const float*)d_in[i];
    a.out = (float*)d_out; a.ws = (unsigned char*)d_ws;
    for (int li = 0; li < N_LAUNCHES; ++li) {
        a.ph_lo = (N_LAUNCHES == 1) ? 0 : li; a.ph_hi = (N_LAUNCHES == 1) ? NPH : li + 1; a.li = li;
        hipLaunchKernelGGL(hybrid_fwd, dim3(grid), dim3(NWAVES * 64), LDS_BYTES, stream, a);
        if (hipPeekAtLastError() != hipSuccess) { fprintf(stderr, "kernel_launch: launch %d failed\n", li); break; }
    }
}
```

```cpp
#include <hip/hip_runtime.h>
#include <cstdio>
#include <cstdint>
namespace pg8 {
#define PG8_LAS __attribute__((address_space(3)))
typedef unsigned short bf16_t;
typedef short bf16x8 __attribute__((ext_vector_type(8)));
typedef float f32x4 __attribute__((ext_vector_type(4)));
typedef unsigned u32x4 __attribute__((ext_vector_type(4)));
constexpr int BM = 256, BK = 64, HALF = 128, HTB = HALF * BK * 2  , STAGE_BYTES = 8 * HTB, NXCD = 8, WGM = 8;

__host__ __device__ __forceinline__ int lds_byte(int r, int c) { const int st = (r >> 4) * 2 + (c >> 5), rr = r & 15, cc = c & 31, ob = rr * 64 + cc * 2; return st * 1024 + (ob ^ (((ob >> 9) & 1) << 5)); }
__host__ __device__ __forceinline__ void stage_rc(int b, int& R, int& C) { const int st = b / 1024, sb = b % 1024, swz = sb ^ (((sb >> 9) & 1) << 5); R = (st >> 1) * 16 + swz / 64; C = (st & 1) * 32 + (swz % 64) / 2; }
__host__ __device__ __forceinline__ int perm32(int rho) { const int n = rho >> 4, i = rho & 15; return 8 * (i >> 2) + 4 * n + (i & 3); }

struct Unit { int pm, pn; };
struct Gemm { const bf16_t* A; const bf16_t* Bt; int M, N, K; };

struct StaticOrder {
    static constexpr bool GATHER = false;
    int nM, nN, nwg, G, c;
    __host__ __device__ void init(int M, int N, int G_, int c_) { nM = M / BM; nN = N / BM; nwg = nM * nN; G = G_; c = c_; }
    __host__ __device__ bool next(int i, Unit& u) const {
        const long L = (long)i * G + c; if (L >= nwg) return false;
        int wgid = (int)L; { const int q = nwg / NXCD, r = nwg % NXCD, xcd = wgid % NXCD, off = wgid / NXCD; wgid = (xcd < r ? xcd * (q + 1) : r * (q + 1) + (xcd - r) * q) + off; }
        const int nig = WGM * nN, gid = wgid / nig, fm = gid * WGM, gsz = (nM - fm) < WGM ? (nM - fm) : WGM;
        u.pm = fm + ((wgid % nig) % gsz); u.pn = (wgid % nig) / gsz; return true;
    }
    __device__ __forceinline__ void a_ready(const Unit&) const {}
    __device__ __forceinline__ void done(const Unit&) const {}
};

typedef __bf16 bf2_t __attribute__((ext_vector_type(2)));
__device__ __forceinline__ unsigned cvt_pk_bf16(float lo, float hi) { bf2_t v; v[0] = (__bf16)lo; v[1] = (__bf16)hi; return __builtin_bit_cast(unsigned, v); }
typedef float f32x2 __attribute__((ext_vector_type(2)));
template <int ACT  > struct EpiBf16 {
    static constexpr bool PERM = true, AFTER_DRAIN = false; static_assert(ACT == 0, "EpiBf16: no activation here");
    bf16_t* O; int ldc; const float* bias; int split_cols; size_t split_stride; float scale0;
    __device__ __forceinline__ void operator()(const f32x4 (&acc)[2][2][4][2], const Unit& u, int wr, int wc, int fr, int fq) const {
        const int row0 = u.pm * BM + wr * 64 + fr; int colt = u.pn * BM; bf16_t* base = O;
        float sc = 1.f; if (split_cols) { const int t = colt / split_cols; base += (size_t)t * split_stride; colt -= t * split_cols; if (t == 0) sc = scale0; }
        const int col0 = colt + wc * 32 + 8 * fq, bcol0 = u.pn * BM + wc * 32 + 8 * fq;
        f32x4 bv[2][2];
#pragma unroll
        for (int bj = 0; bj < 2; ++bj)
#pragma unroll
            for (int n = 0; n < 2; ++n) bv[bj][n] = bias ? *(const f32x4*)(bias + bcol0 + bj * HALF + 4 * n) : (f32x4){0.f, 0.f, 0.f, 0.f};
#pragma unroll
        for (int ai = 0; ai < 2; ++ai)
#pragma unroll
            for (int m = 0; m < 4; ++m) { bf16_t* rowp = base + (size_t)(row0 + ai * HALF + m * 16) * ldc + col0;
#pragma unroll
                for (int bj = 0; bj < 2; ++bj) { f32x4 v0 = acc[ai][bj][m][0] + bv[bj][0], v1 = acc[ai][bj][m][1] + bv[bj][1];
                    v0 = v0 * sc; v1 = v1 * sc; u32x4 w; w.x = cvt_pk_bf16(v0[0], v0[1]); w.y = cvt_pk_bf16(v0[2], v0[3]); w.z = cvt_pk_bf16(v1[0], v1[1]); w.w = cvt_pk_bf16(v1[2], v1[3]);
                    *(u32x4*)(rowp + bj * HALF) = w; } }
    }
};
__device__ __forceinline__ float bf2f_(unsigned b16) { return __uint_as_float(b16 << 16); }
__device__ __forceinline__ float sigm_(float x) { return 1.0f / (1.0f + __expf(-x)); }
template <bool ADD> struct EpiGate {
    static constexpr bool PERM = true, AFTER_DRAIN = false;
    bf16_t* O; int ldc; const bf16_t* gate; size_t gstride;
    __device__ __forceinline__ void operator()(const f32x4 (&acc)[2][2][4][2], const Unit& u, int wr, int wc, int fr, int fq) const {
        const int row0 = u.pm * BM + wr * 64 + fr, colt = wc * 32 + 8 * fq;
        const bf16_t* gt = gate + (size_t)u.pn * gstride;
#pragma unroll
        for (int ai = 0; ai < 2; ++ai) {
            u32x4 gv[4][2], pp[4][2];
#pragma unroll
            for (int m = 0; m < 4; ++m) { const size_t row = (size_t)(row0 + ai * HALF + m * 16);
#pragma unroll
                for (int bj = 0; bj < 2; ++bj) { const int c = colt + bj * HALF; gv[m][bj] = *(const u32x4*)(gt + row * 256 + c);
                    if (ADD) pp[m][bj] = *(const u32x4*)(O + row * ldc + u.pn * BM + c); } }
#pragma unroll
            for (int m = 0; m < 4; ++m) { const size_t row = (size_t)(row0 + ai * HALF + m * 16);
#pragma unroll
                for (int bj = 0; bj < 2; ++bj) { const int c = colt + bj * HALF; const u32x4 g4 = gv[m][bj];
                    bf16_t* op = O + row * ldc + u.pn * BM + c;
                    float pv[8] = {0.f, 0.f, 0.f, 0.f, 0.f, 0.f, 0.f, 0.f};
                    if (ADD) { const u32x4 p = pp[m][bj]; pv[0] = bf2f_(p.x & 0xffffu); pv[1] = bf2f_(p.x >> 16); pv[2] = bf2f_(p.y & 0xffffu); pv[3] = bf2f_(p.y >> 16);
                        pv[4] = bf2f_(p.z & 0xffffu); pv[5] = bf2f_(p.z >> 16); pv[6] = bf2f_(p.w & 0xffffu); pv[7] = bf2f_(p.w >> 16); }
                    const f32x4 v0 = acc[ai][bj][m][0], v1 = acc[ai][bj][m][1];
                    float o[8];
                    o[0] = pv[0] + sigm_(bf2f_(g4.x & 0xffffu)) * v0[0]; o[1] = pv[1] + sigm_(bf2f_(g4.x >> 16)) * v0[1];
                    o[2] = pv[2] + sigm_(bf2f_(g4.y & 0xffffu)) * v0[2]; o[3] = pv[3] + sigm_(bf2f_(g4.y >> 16)) * v0[3];
                    o[4] = pv[4] + sigm_(bf2f_(g4.z & 0xffffu)) * v1[0]; o[5] = pv[5] + sigm_(bf2f_(g4.z >> 16)) * v1[1];
                    o[6] = pv[6] + sigm_(bf2f_(g4.w & 0xffffu)) * v1[2]; o[7] = pv[7] + sigm_(bf2f_(g4.w >> 16)) * v1[3];
                    u32x4 w; w.x = cvt_pk_bf16(o[0], o[1]); w.y = cvt_pk_bf16(o[2], o[3]); w.z = cvt_pk_bf16(o[4], o[5]); w.w = cvt_pk_bf16(o[6], o[7]);
                    *(u32x4*)op = w; } } }
    }
};
struct EpiRes {
    static constexpr bool PERM = false, AFTER_DRAIN = false;
    float* C; const float* R; int ldc;
    __device__ __forceinline__ void operator()(const f32x4 (&acc)[2][2][4][2], const Unit& u, int wr, int wc, int fr, int fq) const {
        const int row0 = u.pm * BM + wr * 64 + fr, col0 = u.pn * BM + wc * 32 + 4 * fq;
#pragma unroll
        for (int ai = 0; ai < 2; ++ai) {
            f32x4 rv[4][2][2];
#pragma unroll
            for (int m = 0; m < 4; ++m) { const size_t ro = (size_t)(row0 + ai * HALF + m * 16) * ldc + col0;
#pragma unroll
                for (int bj = 0; bj < 2; ++bj)
#pragma unroll
                    for (int n = 0; n < 2; ++n) rv[m][bj][n] = *(const f32x4*)(R + ro + bj * HALF + n * 16); }
#pragma unroll
            for (int m = 0; m < 4; ++m) { const size_t ro = (size_t)(row0 + ai * HALF + m * 16) * ldc + col0;
#pragma unroll
                for (int bj = 0; bj < 2; ++bj)
#pragma unroll
                    for (int n = 0; n < 2; ++n) *(f32x4*)(C + ro + bj * HALF + n * 16) = rv[m][bj][n] + acc[ai][bj][m][n]; } }
    }
};
struct EpiSwiGLU {
    static constexpr bool PERM = true, AFTER_DRAIN = false;
    bf16_t* H;
    __device__ __forceinline__ void operator()(const f32x4 (&acc)[2][2][4][2], const Unit& u, int wr, int wc, int fr, int fq) const {
        const int row0 = u.pm * BM + wr * 64 + fr, hc = (u.pn & 3) * 128 + wc * 32 + 8 * fq;
#pragma unroll
        for (int ai = 0; ai < 2; ++ai)
#pragma unroll
            for (int m = 0; m < 4; ++m) { const size_t row = (size_t)(row0 + ai * HALF + m * 16);
                float o[8];
#pragma unroll
                for (int n = 0; n < 2; ++n)
#pragma unroll
                    for (int i = 0; i < 4; ++i) { const float g = acc[ai][0][m][n][i], up = acc[ai][1][m][n][i]; o[n * 4 + i] = g * sigm_(g) * up; }
                u32x4 w; w.x = cvt_pk_bf16(o[0], o[1]); w.y = cvt_pk_bf16(o[2], o[3]); w.z = cvt_pk_bf16(o[4], o[5]); w.w = cvt_pk_bf16(o[6], o[7]);
                *(u32x4*)(H + row * 512 + hc) = w; }
    }
};
struct EpiDown {
    static constexpr bool PERM = true, AFTER_DRAIN = false;
    bf16_t* Y;
    __device__ __forceinline__ void operator()(const f32x4 (&acc)[2][2][4][2], const Unit& u, int wr, int wc, int fr, int fq) const {
        const int row0 = u.pm * BM + wr * 64 + fr, c0 = (u.pn & 3) * 256 + wc * 32 + 8 * fq;
#pragma unroll
        for (int ai = 0; ai < 2; ++ai)
#pragma unroll
            for (int m = 0; m < 4; ++m) { const size_t row = (size_t)(row0 + ai * HALF + m * 16);
#pragma unroll
                for (int bj = 0; bj < 2; ++bj) { const f32x4 v0 = acc[ai][bj][m][0], v1 = acc[ai][bj][m][1];
                    u32x4 w; w.x = cvt_pk_bf16(v0[0], v0[1]); w.y = cvt_pk_bf16(v0[2], v0[3]); w.z = cvt_pk_bf16(v1[0], v1[1]); w.w = cvt_pk_bf16(v1[2], v1[3]);
                    *(u32x4*)(Y + row * 1024 + c0 + bj * HALF) = w; } }
    }
};
template <bool GA_> struct MoeOrder {
    static constexpr bool GATHER = GA_;
    const PG8_LAS int* ts; int nl, lx, lo, hi; const int* rowtok; unsigned* rdy;
    __device__ __forceinline__ bool next(int i, Unit& u) const {
        const int U = 4 * (hi - lo), G = nl, c = lx; long L;
        if constexpr (GA_) L = (long)i * G + c;
        else { const int r = U % G;
            if (c >= r) L = (i == 0) ? (long)(c - r) : ((i == 1) ? (long)(G - r) + (c - r) : 2L * (G - r) + (long)(i - 2) * G + c);
            else L = 2L * (G - r) + (long)i * G + c; }
        if (L >= (long)U) return false;
        const int pm = lo + (int)(L >> 2), j = (int)(L & 3); int e = 0;
#pragma unroll
        for (int k = 1; k < 32; ++k) e += (ts[k] <= pm) ? 1 : 0;
        u.pm = pm; u.pn = e * 4 + j; return true;
    }
    __device__ __forceinline__ void a_ready(const Unit& u) const {
        if constexpr (!GA_) { unsigned sp = 0u;
            while (__hip_atomic_load(rdy + 16 * u.pm, __ATOMIC_RELAXED, __HIP_MEMORY_SCOPE_AGENT) < 32u) { __builtin_amdgcn_s_sleep(2); if (++sp > (1u << 22)) break; }
            asm volatile("" ::: "memory"); }
    }
    __device__ __forceinline__ void done(const Unit& u) const {
        if constexpr (GA_) { asm volatile("s_waitcnt vmcnt(0)" ::: "memory");
            if ((threadIdx.x & 63) == 0) (void)__hip_atomic_fetch_add(rdy + 16 * u.pm, 1u, __ATOMIC_RELAXED, __HIP_MEMORY_SCOPE_AGENT); }
    }
};
template <class E_> struct is_epibf16 { static constexpr bool value = false; }; template <int A_> struct is_epibf16<EpiBf16<A_>> { static constexpr bool value = true; };
template <class Epi, class Sched, bool ALIGN_EPI = false, bool SP2 = false>
__device__ __forceinline__ void gemm_phase(PG8_LAS unsigned char* lds, const Gemm g, const Sched& S, const Epi& E) {
    const int tid = threadIdx.x, wid = __builtin_amdgcn_readfirstlane(tid >> 6), lane = tid & 63, wr = wid >> 2, wc = wid & 3, fr = lane & 15, fq = lane >> 4;
    const int K = g.K, nt = K / BK;
    unsigned voffA[2], voffB[2];
#pragma unroll
    for (int i = 0; i < 2; ++i) { int R, C; stage_rc(tid * 16 + i * 8192, R, C); const int Rb = Epi::PERM ? ((R & ~31) + perm32(R & 31)) : R;
        voffA[i] = (unsigned)(R * K + C) * 2u; voffB[i] = (unsigned)(Rb * K + C) * 2u; }
    const size_t kstep = (size_t)(BK * 2);
    const size_t hstep = (size_t)HALF * K * 2;
    const size_t tstep = 2 * hstep;
    constexpr bool GA = Sched::GATHER;
    static_assert(!GA || SP2, "gathered A rows: SP2 loop only");
    const size_t hstepA = GA ? 0 : hstep;
    unsigned gcur[2][2] = {{0u, 0u}, {0u, 0u}}, gnxt[2][2] = {{0u, 0u}, {0u, 0u}}; int gR[2] = {0, 0}; unsigned gC[2] = {0u, 0u};
    if constexpr (GA) { _Pragma("unroll") for (int i = 0; i < 2; ++i) { int R, C; stage_rc(tid * 16 + i * 8192, R, C); gR[i] = R; gC[i] = (unsigned)C * 2u; } }
#define PG8_GOFF(dst, u) do { if constexpr (GA) { _Pragma("unroll") for (int h_ = 0; h_ < 2; ++h_) _Pragma("unroll") for (int i_ = 0; i_ < 2; ++i_) dst[h_][i_] = (unsigned)S.rowtok[(u).pm * BM + h_ * HALF + gR[i_]] * (unsigned)(K * 2) + gC[i_]; } } while (0)
#define PG8_VA(h, sel) (GA ? ((sel) ? gnxt[h] : gcur[h]) : voffA)
    const unsigned ldsw = (unsigned)wid * 1024u;
    const int aoff = lds_byte(wr * 64 + fr, fq * 8), boff = lds_byte(wc * 32 + fr, fq * 8);
#define PG8_SA(b, h) (((b) * 2 + (h)) * HTB)
#define PG8_SB(b, h) ((4 + (b) * 2 + (h)) * HTB)
#define PG8_STAGE(bufoff, gbase, voff) do { _Pragma("unroll") for (int _i = 0; _i < 2; ++_i) \
        __builtin_amdgcn_global_load_lds((const unsigned*)((const char*)(gbase) + (voff)[_i]), (PG8_LAS unsigned*)(lds + (bufoff) + ldsw + _i * 8192), 16, 0, 0); } while (0)
#define PG8_LDA(dst, b, h) do { _Pragma("unroll") for (int m = 0; m < 4; ++m) _Pragma("unroll") for (int k = 0; k < 2; ++k) dst[m][k] = *(const PG8_LAS bf16x8*)(lds + PG8_SA(b, h) + aoff + m * 2048 + k * 1024); } while (0)
#define PG8_LDB(dst, b, h) do { _Pragma("unroll") for (int n = 0; n < 2; ++n) _Pragma("unroll") for (int k = 0; k < 2; ++k) dst[n][k] = *(const PG8_LAS bf16x8*)(lds + PG8_SB(b, h) + boff + n * 2048 + k * 1024); } while (0)
#define PG8_MMA(ai, bj, At, Bt) do { __builtin_amdgcn_s_setprio(1); _Pragma("unroll") for (int m = 0; m < 4; ++m) _Pragma("unroll") for (int n = 0; n < 2; ++n) _Pragma("unroll") for (int k = 0; k < 2; ++k) \
        acc[ai][bj][m][n] = __builtin_amdgcn_mfma_f32_16x16x32_bf16(Bt[n][k], At[m][k], acc[ai][bj][m][n], 0, 0, 0); __builtin_amdgcn_s_setprio(0); } while (0)
#define PG8_WAIT_V(n) asm volatile("s_waitcnt vmcnt(" #n ")" ::: "memory")
#define PG8_WAIT_L(n) asm volatile("s_waitcnt lgkmcnt(" #n ")" ::: "memory")
#define PG8_BAR __builtin_amdgcn_s_barrier()
#define PG8_SCHED __builtin_amdgcn_sched_barrier(0)
    Unit cur, nxt; int ui = 0;
    if (!S.next(0, cur)) return;
    f32x4 acc[2][2][4][2];
#pragma unroll
    for (int a = 0; a < 2; ++a)
#pragma unroll
        for (int b = 0; b < 2; ++b)
#pragma unroll
            for (int m = 0; m < 4; ++m)
#pragma unroll
                for (int n = 0; n < 2; ++n) acc[a][b][m][n] = (f32x4){0.f, 0.f, 0.f, 0.f};
    bf16x8 At[4][2], B0[2][2], B1[2][2];
    const char* cA = (const char*)g.A + (GA ? 0 : (size_t)cur.pm * tstep); const char* cB = (const char*)g.Bt + (size_t)cur.pn * tstep;
    S.a_ready(cur);
    PG8_GOFF(gcur, cur);
    if constexpr (SP2) {
        PG8_STAGE(PG8_SB(0, 0), cB, voffB); PG8_STAGE(PG8_SB(0, 1), cB + hstep, voffB); PG8_STAGE(PG8_SA(0, 0), cA, PG8_VA(0, false)); PG8_STAGE(PG8_SA(0, 1), cA + hstepA, PG8_VA(1, false));
        if (wr == 1) PG8_BAR;
        PG8_WAIT_V(2); PG8_BAR;
        PG8_STAGE(PG8_SB(1, 0), cB + kstep, voffB); PG8_STAGE(PG8_SA(1, 0), cA + kstep, PG8_VA(0, false)); PG8_STAGE(PG8_SB(1, 1), cB + hstep + kstep, voffB);
        PG8_WAIT_V(6); PG8_BAR;
    } else {
        PG8_STAGE(PG8_SB(0, 0), cB, voffB); PG8_STAGE(PG8_SA(0, 0), cA, voffA); PG8_STAGE(PG8_SB(0, 1), cB + hstep, voffB); PG8_STAGE(PG8_SA(0, 1), cA + hstep, voffA);
        if (wr == 1) PG8_BAR;
        PG8_WAIT_V(4); PG8_BAR;
        PG8_STAGE(PG8_SB(1, 0), cB + kstep, voffB); PG8_STAGE(PG8_SA(1, 0), cA + kstep, voffA); PG8_STAGE(PG8_SB(1, 1), cB + hstep + kstep, voffB);
        PG8_WAIT_V(6); PG8_BAR;
    }
    for (;;) {
        const bool has_next = S.next(ui + 1, nxt);
        if (has_next) PG8_GOFF(gnxt, nxt);
        const char* nA = has_next ? (const char*)g.A + (GA ? 0 : (size_t)nxt.pm * tstep) : cA; const char* nB = has_next ? (const char*)g.Bt + (size_t)nxt.pn * tstep : cB;
        for (int t = 0; t < nt; t += 2) {
            const bool last = (t == nt - 2);
            const char* a1 = cA + (size_t)(t + 1) * kstep;
            const char* a2 = last ? nA : cA + (size_t)(t + 2) * kstep; const char* b2 = last ? nB : cB + (size_t)(t + 2) * kstep;
            const char* a3 = a2 + kstep; const char* b3 = b2 + kstep;
            if (last && has_next) S.a_ready(nxt);
            const bool seln = last && has_next;
            if constexpr (SP2) {
            PG8_LDB(B0, 0, 0); PG8_LDB(B1, 0, 1); PG8_SCHED; PG8_LDA(At, 0, 0); PG8_STAGE(PG8_SA(1, 1), a1 + hstepA, PG8_VA(1, false));
            PG8_WAIT_V(8); PG8_WAIT_L(0); PG8_BAR; PG8_MMA(0, 0, At, B0); PG8_MMA(0, 1, At, B1); PG8_BAR; PG8_SCHED;
            PG8_LDA(At, 0, 1); PG8_STAGE(PG8_SB(0, 0), b2, voffB); PG8_STAGE(PG8_SB(0, 1), b2 + hstep, voffB); PG8_STAGE(PG8_SA(0, 0), a2, PG8_VA(0, seln));
            PG8_WAIT_V(8); PG8_WAIT_L(0); PG8_BAR; PG8_MMA(1, 0, At, B0); PG8_MMA(1, 1, At, B1); PG8_BAR; PG8_SCHED;
            PG8_LDB(B0, 1, 0); PG8_LDB(B1, 1, 1); PG8_SCHED; PG8_LDA(At, 1, 0); PG8_STAGE(PG8_SA(0, 1), a2 + hstepA, PG8_VA(1, seln));
            PG8_WAIT_V(8); PG8_WAIT_L(0); PG8_BAR; PG8_MMA(0, 0, At, B0); PG8_MMA(0, 1, At, B1); PG8_BAR; PG8_SCHED;
            PG8_LDA(At, 1, 1); PG8_STAGE(PG8_SB(1, 0), b3, voffB); PG8_STAGE(PG8_SB(1, 1), b3 + hstep, voffB); PG8_STAGE(PG8_SA(1, 0), a3, PG8_VA(0, seln));
            PG8_WAIT_V(8); PG8_WAIT_L(0); PG8_BAR; PG8_MMA(1, 0, At, B0); PG8_MMA(1, 1, At, B1); PG8_BAR; PG8_SCHED;
            } else {
            PG8_LDB(B0, 0, 0); PG8_SCHED; PG8_LDA(At, 0, 0); PG8_STAGE(PG8_SA(1, 1), a1 + hstep, voffA);
            PG8_WAIT_L(8); PG8_BAR; PG8_WAIT_L(0); PG8_MMA(0, 0, At, B0); PG8_BAR; PG8_SCHED;
            PG8_LDB(B1, 0, 1); PG8_STAGE(PG8_SB(0, 0), b2, voffB);
            PG8_BAR; PG8_WAIT_L(0); PG8_MMA(0, 1, At, B1); PG8_BAR;
            PG8_LDA(At, 0, 1); PG8_STAGE(PG8_SA(0, 0), a2, voffA);
            PG8_BAR; PG8_WAIT_L(0); PG8_MMA(1, 0, At, B0); PG8_BAR; PG8_SCHED;
            PG8_STAGE(PG8_SB(0, 1), b2 + hstep, voffB);
            PG8_WAIT_V(6); PG8_BAR; PG8_MMA(1, 1, At, B1); PG8_BAR;
            PG8_LDB(B0, 1, 0); PG8_SCHED; PG8_LDA(At, 1, 0); PG8_STAGE(PG8_SA(0, 1), a2 + hstep, voffA);
            PG8_WAIT_L(8); PG8_BAR; PG8_WAIT_L(0); PG8_MMA(0, 0, At, B0); PG8_BAR; PG8_SCHED;
            PG8_LDB(B1, 1, 1); PG8_STAGE(PG8_SB(1, 0), b3, voffB);
            PG8_BAR; PG8_WAIT_L(0); PG8_MMA(0, 1, At, B1); PG8_BAR;
            PG8_LDA(At, 1, 1); PG8_STAGE(PG8_SA(1, 0), a3, voffA);
            PG8_BAR; PG8_WAIT_L(0); PG8_MMA(1, 0, At, B0); PG8_BAR; PG8_SCHED;
            PG8_STAGE(PG8_SB(1, 1), b3 + hstep, voffB);
            PG8_WAIT_V(6); PG8_BAR; PG8_MMA(1, 1, At, B1); PG8_BAR;
            }
        }
        if constexpr (ALIGN_EPI) { if (wr == 0) PG8_BAR; }
        if constexpr (!Epi::AFTER_DRAIN) { E(acc, cur, wr, wc, fr, fq); S.done(cur); }
#ifdef DBG_EPI2
        if constexpr (is_epibf16<Epi>::value) { asm volatile("" ::: "memory"); E(acc, cur, wr, wc, fr, fq); }
#endif
#ifdef DBG_EPI2R
        if constexpr (!Epi::PERM) { asm volatile("" ::: "memory"); E(acc, cur, wr, wc, fr, fq); }
#endif
        if (!has_next) break;
#pragma unroll
        for (int a = 0; a < 2; ++a)
#pragma unroll
            for (int b = 0; b < 2; ++b)
#pragma unroll
                for (int m = 0; m < 4; ++m)
#pragma unroll
                    for (int n = 0; n < 2; ++n) acc[a][b][m][n] = (f32x4){0.f, 0.f, 0.f, 0.f};
        cur = nxt; cA = nA; cB = nB; ++ui;
        if constexpr (GA) { _Pragma("unroll") for (int h_ = 0; h_ < 2; ++h_) _Pragma("unroll") for (int i_ = 0; i_ < 2; ++i_) gcur[h_][i_] = gnxt[h_][i_]; }
        if constexpr (ALIGN_EPI) { if (wr == 1) PG8_BAR; }
    }
    PG8_WAIT_V(0);
    if constexpr (!ALIGN_EPI) { if (wr == 0) PG8_BAR; }
    PG8_BAR;
    if constexpr (Epi::AFTER_DRAIN) { E.fused(acc, cur, wr, wc, fr, fq, lds, wid, lane); S.done(cur); }
#undef PG8_GOFF
#undef PG8_VA
#undef PG8_SA
#undef PG8_SB
#undef PG8_STAGE
#undef PG8_LDA
#undef PG8_LDB
#undef PG8_MMA
#undef PG8_WAIT_V
#undef PG8_WAIT_L
#undef PG8_BAR
#undef PG8_SCHED
}
}
constexpr int NWAVES = 8;
constexpr int BATCH = 8, SEQ = 4096, D = 1024, T = BATCH * SEQ;
constexpr int NPROJ = 5120;
constexpr int NTILE = NPROJ / 256;
constexpr float EPS = 1e-6f;
#ifndef MK_N_LAUNCHES
#define MK_N_LAUNCHES 1
#endif
#ifndef DBG_NPH
#define DBG_NPH 12
#endif
constexpr int NPH = DBG_NPH;
constexpr int N_LAUNCHES = MK_N_LAUNCHES;
static_assert(N_LAUNCHES == 1 || N_LAUNCHES == NPH, "MK_N_LAUNCHES is 1 or NPH");

constexpr size_t MiB = 1u << 20;
constexpr size_t WS_CTL = 0, CTL_ZERO_BYTES = 1 * MiB;
constexpr size_t WS_SMALL = 1 * MiB;
constexpr size_t WS_WIN = 2 * MiB;
constexpr size_t WS_WPA = 13 * MiB, WS_WPM = 14 * MiB, WS_WOUT = 15 * MiB;
constexpr size_t WS_TOKE = 17 * MiB;
constexpr size_t WS_TOKR = WS_TOKE + 256 * 1024;
constexpr size_t WS_TOKP = WS_TOKR + 256 * 1024;
constexpr size_t WS_TOKG = WS_TOKP + 256 * 1024;
constexpr size_t WS_CNT = WS_TOKG + 256 * 1024;
constexpr size_t WS_ROWTOK = WS_CNT + 64 * 1024;
constexpr int NROWS_MAX = 73728;
constexpr size_t WS_SC = 452 * MiB;
constexpr size_t WS_SC2 = 116 * MiB + 3 * ((size_t)T * 256 * 2);
constexpr size_t WS_GU = 20 * MiB;
constexpr size_t WS_DN = 84 * MiB;
constexpr size_t WS_PROJ = 116 * MiB;
constexpr size_t PROJ_TILE = (size_t)T * 256 * 2;
constexpr size_t WS_MLST = 116 * MiB;
constexpr size_t WS_MERGED = 116 * MiB;
constexpr size_t WS_XN = 180 * MiB;
constexpr size_t WS_XG = 244 * MiB;
constexpr size_t WS_HID = 388 * MiB;
constexpr size_t WS_Y = 244 * MiB;
constexpr size_t WS_END = 512 * MiB;
static_assert(WS_PROJ + NTILE * PROJ_TILE == 436 * MiB, "proj map");
constexpr size_t DO_H = 0, DO_YATT = 0, DO_YML = 32 * MiB, DO_KN = 64 * MiB, DO_IKR = 72 * MiB, DO_IQR = 74 * MiB, DO_AQN = 90 * MiB;
constexpr int TL_AQ = 0, TL_KV = 2, TL_IQ = 3, TL_MQ = 4, TL_MK = 6, TL_MV = 8, TL_MO = 10, TL_GA = 12, TL_GM = 16;
constexpr size_t WS_WSM = WS_SMALL + 64 * 1024;
constexpr size_t WS_WTG = WS_SMALL + 192 * 1024;
constexpr size_t DO_SMB = 122 * MiB;
constexpr int CW_BAR = 4096;
constexpr int CW_Q = 16384;
constexpr int CW_KMAX = 24576;
constexpr int CW_RDY = 32768;
constexpr int LDS_BYTES = 163840, MISC_OFF = LDS_BYTES - 512;

#define GAS __attribute__((address_space(1)))
#define LAS __attribute__((address_space(3)))
typedef unsigned short bf16;
typedef unsigned v4u __attribute__((ext_vector_type(4)));
typedef unsigned v2u __attribute__((ext_vector_type(2)));
typedef float f32x4 __attribute__((ext_vector_type(4)));
typedef float f32x2 __attribute__((ext_vector_type(2)));
typedef short bf16x8 __attribute__((ext_vector_type(8)));
typedef GAS unsigned gu32;
#define RLX_AGENT __ATOMIC_RELAXED, __HIP_MEMORY_SCOPE_AGENT
#define LDS_WAIT() asm volatile("s_waitcnt lgkmcnt(0)" ::: "memory")
__device__ __forceinline__ float bf2f(unsigned b16) { return __uint_as_float(b16 << 16); }
__device__ __forceinline__ unsigned f2bf(float f) { unsigned u = __float_as_uint(f); return (u + 0x7fffu + ((u >> 16) & 1u)) >> 16; }
__device__ __forceinline__ unsigned pk2(float lo, float hi) { return pg8::cvt_pk_bf16(lo, hi); }
__device__ __forceinline__ float sigm(float x) { return 1.0f / (1.0f + __expf(-x)); }
__device__ __forceinline__ float wave_sum(float v) {
    v += __int_as_float(__builtin_amdgcn_update_dpp(0, __float_as_int(v), 0xB1, 0xF, 0xF, true));
    v += __int_as_float(__builtin_amdgcn_update_dpp(0, __float_as_int(v), 0x4E, 0xF, 0xF, true));
    v += __int_as_float(__builtin_amdgcn_update_dpp(0, __float_as_int(v), 0x124, 0xF, 0xF, true));
    v += __int_as_float(__builtin_amdgcn_update_dpp(0, __float_as_int(v), 0x128, 0xF, 0xF, true));
    { const auto r = __builtin_amdgcn_permlane16_swap(__float_as_uint(v), __float_as_uint(v), false, false); v = __uint_as_float(r[0]) + __uint_as_float(r[1]); }
    { const auto r = __builtin_amdgcn_permlane32_swap(__float_as_uint(v), __float_as_uint(v), false, false); v = __uint_as_float(r[0]) + __uint_as_float(r[1]); }
    return v;
}
__device__ __forceinline__ void unpack8(const v4u r, float (&f)[8]) {
    f[0] = bf2f(r.x & 0xffffu); f[1] = bf2f(r.x >> 16); f[2] = bf2f(r.y & 0xffffu); f[3] = bf2f(r.y >> 16);
    f[4] = bf2f(r.z & 0xffffu); f[5] = bf2f(r.z >> 16); f[6] = bf2f(r.w & 0xffffu); f[7] = bf2f(r.w >> 16);
}
__device__ __forceinline__ v4u pack8(const float (&f)[8]) { v4u w; w.x = pk2(f[0], f[1]); w.y = pk2(f[2], f[3]); w.z = pk2(f[4], f[5]); w.w = pk2(f[6], f[7]); return w; }
#define XB_TMO      128
#define XB_XCNT(j)  (256  + 64 * (j))
#define XB_XSUB(j)  (1280 + 64 * (j))
#define XB_XGEN(j)  (2304 + 64 * (j))
#define XB_TOP      3328
#define XB_TOPGEN   3392
#define XCD_BAR_WORDS 3456
#define XB_SPIN_CAP (1u << 18)

__device__ __forceinline__ unsigned xb_ld(unsigned* p)              { return __hip_atomic_load(p, __ATOMIC_RELAXED, __HIP_MEMORY_SCOPE_AGENT); }
__device__ __forceinline__ unsigned xb_add(unsigned* p, unsigned v) { return __hip_atomic_fetch_add(p, v, __ATOMIC_RELAXED, __HIP_MEMORY_SCOPE_AGENT); }
__device__ __forceinline__ unsigned xb_xcc_id() { return (unsigned)__builtin_amdgcn_s_getreg((3 << 11) | 20) & 0xFu; }
#define XB_SPIN(cond, bar) do { unsigned _sp = 0; while (cond) { __builtin_amdgcn_s_sleep(1); \
    if ((++_sp & 255u) == 0u) { if (xb_ld(&(bar)[XB_TMO])) break; if (_sp > XB_SPIN_CAP) { atomicAdd(&(bar)[XB_TMO], 1u); break; } } } } while (0)

struct XcdBarrier {
    unsigned* bar; unsigned x;
    volatile LAS unsigned* st;
};

__device__ __forceinline__ XcdBarrier xcd_barrier_post(unsigned* bar, volatile LAS unsigned* st) {
    XcdBarrier b; b.bar = bar; b.x = xb_xcc_id(); b.st = st;
    if (threadIdx.x == 0) st[12] = xb_add(&bar[XB_XCNT(b.x)], 1u);
    return b;
}
__device__ __forceinline__ void xcd_barrier_complete(unsigned* bar, unsigned x, unsigned& nloc, unsigned& nx) {
    const unsigned G = gridDim.x * gridDim.y * gridDim.z;
    unsigned sum, cnt, mine, sp = 0u;
    for (;;) {
        sum = 0u; cnt = 0u; mine = 0u;
#pragma unroll
        for (unsigned j = 0; j < 16; ++j) { const unsigned c = xb_ld(&bar[XB_XCNT(j)]); sum += c; cnt += (c > 0u) ? 1u : 0u; mine = (j == x) ? c : mine; }
        if (sum == G) break;
        __builtin_amdgcn_s_sleep(1);
        if ((++sp & 255u) == 0u) { if (xb_ld(&bar[XB_TMO])) break; if (sp > XB_SPIN_CAP) { atomicAdd(&bar[XB_TMO], 1u); break; } }
    }
    nloc = mine > 0u ? mine : 1u; nx = cnt > 0u ? cnt : 1u;
}

__device__ __forceinline__ void xcd_barrier(const XcdBarrier& b) {
    asm volatile("s_waitcnt vmcnt(0)" ::: "memory");
    __syncthreads();
    if (threadIdx.x == 0) {
        unsigned* bar = b.bar;
        __builtin_amdgcn_s_waitcnt(0);
        unsigned nloc = b.st[0], nx = b.st[1];
        if (nloc == 0u) { xcd_barrier_complete(bar, b.x, nloc, nx); b.st[0] = nloc; b.st[1] = nx; }
        const unsigned old = xb_add(&bar[XB_XSUB(b.x)], 1u);
        const unsigned gen = old / nloc;
        if (old + 1u == (gen + 1u) * nloc) {
            __builtin_amdgcn_fence(__ATOMIC_RELEASE, "agent");
            asm volatile("s_waitcnt vmcnt(0)" ::: "memory");
            const unsigned og = xb_add(&bar[XB_TOP], 1u);
            const unsigned tg = og / nx;
            if (og + 1u == (tg + 1u) * nx) xb_add(&bar[XB_TOPGEN], 1u);
            else XB_SPIN(xb_ld(&bar[XB_TOPGEN]) == tg, bar);
            __builtin_amdgcn_fence(__ATOMIC_ACQUIRE, "agent");
            xb_add(&bar[XB_XGEN(b.x)], 1u);
            asm volatile("s_waitcnt vmcnt(0)" ::: "memory");
        } else {
            XB_SPIN(xb_ld(&bar[XB_XGEN(b.x)]) == gen, bar);
            __builtin_amdgcn_fence(__ATOMIC_ACQUIRE, "agent");
            asm volatile("s_waitcnt vmcnt(0)" ::: "memory");
        }
    }
    __syncthreads();
}
struct Args { const float* in[22]; float* out; unsigned char* ws; int ph_lo, ph_hi, li, pad; };
struct Ctx { int tid, lane, wave, G, vcu; LAS unsigned char* lds; };
#define IN_X 0
#define IN_POS 1
#define IN_GMIX 2
#define IN_WIN 3
#define IN_GQ 4
#define IN_GK 5
#define IN_WCONV 6
#define IN_BCONV 7
#define IN_BI 8
#define IN_BF 9
#define IN_GML 10
#define IN_WPA 11
#define IN_WPM 12
#define IN_WOUT 13
#define IN_GMOE 14
#define IN_WRG 15
#define IN_BRG 16
#define IN_WRE 17
#define IN_BRE 18
#define IN_WEG 19
#define IN_WEU 20
#define IN_WED 21

__device__ __forceinline__ int win_src_col(int n) {
    if (n < 1024) return n;
    if (n < 3072) return n + 40;
    return n + 48;
}
__device__ __forceinline__ int wsm_src_col(int r) {
    return r < 40 ? 1024 + r : (r < 44 ? 3112 + (r - 40) : 3116 + (r - 44));
}
__device__ __forceinline__ void tr_item(const float* W, int ldw, int scol, int k0, bf16* wt0, int K, LAS float* scr, int lane) {
    const int sc0 = __builtin_amdgcn_readfirstlane(scol), sc31 = __builtin_amdgcn_readlane(scol, 31);
    if (sc0 >= 0 && sc31 == sc0 + 31 && (sc0 & 3) == 0 && (ldw & 3) == 0) {
#pragma unroll
        for (int i = 0; i < 8; ++i) { const int kk = 8 * i + (lane >> 3); const f32x4 v = *(const f32x4*)(W + (size_t)(k0 + kk) * ldw + sc0 + 4 * (lane & 7));
            LAS float* d = scr + kk * 33 + 4 * (lane & 7); d[0] = v[0]; d[1] = v[1]; d[2] = v[2]; d[3] = v[3]; }
    } else {
#pragma unroll 8
        for (int i = 0; i < 32; ++i) { const int kk = 2 * i + (lane >> 5); scr[kk * 33 + (lane & 31)] = scol >= 0 ? W[(size_t)(k0 + kk) * ldw + scol] : 0.f; }
    }
    LDS_WAIT(); asm volatile("" ::: "memory");
    const int c = lane & 7;
#pragma unroll
    for (int j = 0; j < 4; ++j) { const int n = (lane >> 3) + 8 * j; const LAS float* s = scr + (8 * c) * 33 + n;
        v4u o; o.x = pk2(s[0 * 33], s[1 * 33]); o.y = pk2(s[2 * 33], s[3 * 33]); o.z = pk2(s[4 * 33], s[5 * 33]); o.w = pk2(s[6 * 33], s[7 * 33]);
        *(v4u*)(wt0 + (size_t)n * K + 8 * c) = o; }
    LDS_WAIT(); asm volatile("" ::: "memory");
}
template <int PART> __device__ __forceinline__ void p0_prologue(const Args& a, const Ctx& c, int gw, int NGW) {
    unsigned char* ws = a.ws;
    LAS float* scr = (LAS float*)(c.lds + c.wave * 16384);
    const int lane = c.lane;
    constexpr int I_IN = 16 * 160, I_PA = 8 * 32, I_PM = 8 * 32, I_OUT = 16 * 32, I_GU = 32 * 16 * 32, I_DN = 32 * 8 * 32;
    constexpr int NPRJ = I_IN + I_PA + I_PM + I_OUT, NIT = NPRJ + I_GU + I_DN;
    for (int it = (PART ? NPRJ : 0) + gw; it < (PART ? NIT : NPRJ); it += NGW) {
        int r = it;
        if (r < I_IN) { const int kb = r / 160, nb = r % 160; tr_item(a.in[IN_WIN], 5168, win_src_col(32 * nb + (lane & 31)), 64 * kb, (bf16*)(ws + WS_WIN) + (size_t)(32 * nb) * 1024 + 64 * kb, 1024, scr, lane); continue; } r -= I_IN;
        if (r < I_PA) { const int kb = r / 32, nb = r % 32; tr_item(a.in[IN_WPA], 1024, 32 * nb + (lane & 31), 64 * kb, (bf16*)(ws + WS_WPA) + (size_t)(32 * nb) * 512 + 64 * kb, 512, scr, lane); continue; } r -= I_PA;
        if (r < I_PM) { const int kb = r / 32, nb = r % 32; tr_item(a.in[IN_WPM], 1024, 32 * nb + (lane & 31), 64 * kb, (bf16*)(ws + WS_WPM) + (size_t)(32 * nb) * 512 + 64 * kb, 512, scr, lane); continue; } r -= I_PM;
        if (r < I_OUT) { const int kb = r / 32, nb = r % 32; tr_item(a.in[IN_WOUT], 1024, 32 * nb + (lane & 31), 64 * kb, (bf16*)(ws + WS_WOUT) + (size_t)(32 * nb) * 1024 + 64 * kb, 1024, scr, lane); continue; } r -= I_OUT;
        if (r < I_GU) { const int e = r / 512, q = r % 512, kb = q / 32, nb = q % 32, t = nb >> 3, bj = (nb >> 2) & 1, i0 = (nb & 3) * 32;
            const float* src = (bj ? a.in[IN_WEU] : a.in[IN_WEG]) + (size_t)e * 1024 * 512;
            tr_item(src, 512, 128 * t + i0 + (lane & 31), 64 * kb, (bf16*)(ws + WS_GU) + ((size_t)e * 1024 + 32 * nb) * 1024 + 64 * kb, 1024, scr, lane); continue; } r -= I_GU;
        { const int e = r / 256, q = r % 256, kb = q / 32, nb = q % 32;
            tr_item(a.in[IN_WED] + (size_t)e * 512 * 1024, 1024, 32 * nb + (lane & 31), 64 * kb, (bf16*)(ws + WS_DN) + ((size_t)e * 1024 + 32 * nb) * 512 + 64 * kb, 512, scr, lane); }
    }
    if (PART) return;
    { float* WTG = (float*)(ws + WS_WTG); for (int i = gw * 64 + lane; i < 36 * 1024; i += NGW * 64) { const int j = i >> 10, k = i & 1023;
        WTG[j * 1028 + k] = (j < 32 ? a.in[IN_WRE][k * 32 + j] : a.in[IN_WRG][k * 4 + (j - 32)]) * a.in[IN_GMOE][k]; } }
    { bf16* WSM = (bf16*)(ws + WS_WSM); for (int i = gw * 64 + lane; i < 48 * 1024; i += NGW * 64) { const int r = i >> 10, k = i & 1023; WSM[i] = (bf16)f2bf(a.in[IN_WIN][(size_t)k * 5168 + wsm_src_col(r)]); } }
    const float* g = a.in[IN_GMIX]; f32x4 gv[4];
#pragma unroll
    for (int j = 0; j < 4; ++j) gv[j] = *(const f32x4*)(g + 4 * lane + 256 * j);
    bf16* H = (bf16*)((unsigned char*)a.out + DO_H);
    for (int m0 = gw; m0 < T; m0 += 2 * NGW) {
        const int mA = m0, mB = (m0 + NGW < T) ? m0 + NGW : m0; const bool hasB = (m0 + NGW < T);
        const f32x4* xa = (const f32x4*)(a.in[IN_X] + (size_t)mA * D) + lane; const f32x4* xb = (const f32x4*)(a.in[IN_X] + (size_t)mB * D) + lane;
        f32x4 va[4], vb[4]; float sa = 0.f, sb = 0.f;
#pragma unroll
        for (int j = 0; j < 4; ++j) { va[j] = xa[64 * j]; vb[j] = xb[64 * j]; }
#pragma unroll
        for (int j = 0; j < 4; ++j) { sa += (va[j].x * va[j].x + va[j].y * va[j].y) + (va[j].z * va[j].z + va[j].w * va[j].w); sb += (vb[j].x * vb[j].x + vb[j].y * vb[j].y) + (vb[j].z * vb[j].z + vb[j].w * vb[j].w); }
        const float ra = rsqrtf(wave_sum(sa) * (1.f / D) + EPS), rb = rsqrtf(wave_sum(sb) * (1.f / D) + EPS);
        v2u* oa = (v2u*)(H + (size_t)mA * D) + lane; v2u* ob = (v2u*)(H + (size_t)mB * D) + lane;
#pragma unroll
        for (int j = 0; j < 4; ++j) { v2u w; w.x = pk2(va[j].x * ra * gv[j].x, va[j].y * ra * gv[j].y); w.y = pk2(va[j].z * ra * gv[j].z, va[j].w * ra * gv[j].w); oa[64 * j] = w; }
        if (hasB) {
#pragma unroll
        for (int j = 0; j < 4; ++j) { v2u w; w.x = pk2(vb[j].x * rb * gv[j].x, vb[j].y * rb * gv[j].y); w.y = pk2(vb[j].z * rb * gv[j].z, vb[j].w * rb * gv[j].w); ob[64 * j] = w; } }
    }
}

__device__ __forceinline__ const bf16* proj_tile(const Args& a, int tile) { return (const bf16*)(a.ws + WS_PROJ + (size_t)tile * PROJ_TILE); }
#define DPPF(x_, ctrl_) __int_as_float(__builtin_amdgcn_update_dpp(0, __float_as_int(x_), ctrl_, 0xF, 0xF, true))
__device__ __forceinline__ void p2_prep(const Args& a, const Ctx& c) {
    const int lane = c.lane, gw = c.vcu * NWAVES + c.wave, NGW = c.G * NWAVES;
    float invf = 0.f;
    if (lane < 8) invf = (float)pow(500000.0, -(double)lane / 8.0); else if (lane < 12) invf = (float)pow(500000.0, -(double)(lane - 8) / 4.0);
    float gq[8], gk[8];
#pragma unroll
    for (int i = 0; i < 8; ++i) { gq[i] = a.in[IN_GQ][8 * (lane & 7) + i]; gk[i] = a.in[IN_GK][8 * (lane & 7) + i]; }
    const int* pos = (const int*)a.in[IN_POS];
    unsigned char* dout = (unsigned char*)a.out;
    bf16* AQN = (bf16*)(dout + DO_AQN); bf16* KN = (bf16*)(dout + DO_KN); bf16* IQR = (bf16*)(dout + DO_IQR); bf16* IKR = (bf16*)(dout + DO_IKR);
    { const bf16* Hh = (const bf16*)(dout + DO_H); const bf16* WSM = (const bf16*)(a.ws + WS_WSM); bf16* SMB = (bf16*)(dout + DO_SMB);
      const int row = lane & 15, kg = lane >> 4;
      const float invfk = (float)pow(500000.0, -(double)(lane & 3) / 4.0);
      for (int tile = gw; tile < T / 16; tile += NGW) { const int t0 = tile * 16;
          f32x4 acc[3];
#pragma unroll
          for (int ct = 0; ct < 3; ++ct) acc[ct] = (f32x4){0.f, 0.f, 0.f, 0.f};
          const bf16* ap = Hh + (size_t)(t0 + row) * 1024 + 8 * kg; const bf16* bp = WSM + (size_t)row * 1024 + 8 * kg;
#pragma unroll 8
          for (int ks = 0; ks < 32; ++ks) { const bf16x8 av = *(const bf16x8*)(ap + 32 * ks);
#pragma unroll
              for (int ct = 0; ct < 3; ++ct) acc[ct] = __builtin_amdgcn_mfma_f32_16x16x32_bf16(av, *(const bf16x8*)(bp + (size_t)ct * 16 * 1024 + 32 * ks), acc[ct], 0, 0, 0); }
          const int col = lane & 15;
#pragma unroll
          for (int r = 0; r < 4; ++r) { const int t = t0 + 4 * kg + r;
              const float angk = (float)pos[t] * invfk;
              const double revk = (double)angk * 0.15915494309189535; const float frk = (float)(revk - __builtin_rint(revk));
              const float ck = __builtin_amdgcn_cosf(frk), sk = __builtin_amdgcn_sinf(frk);
              const float v0 = acc[0][r], pr = __shfl_xor(v0, 4);
              const float o0 = (col < 4) ? (v0 * ck - pr * sk) : ((col < 8) ? (v0 * ck + pr * sk) : v0);
              IKR[(size_t)t * 32 + col] = (bf16)f2bf(o0); IKR[(size_t)t * 32 + 16 + col] = (bf16)f2bf(acc[1][r]);
              SMB[(size_t)t * 16 + col] = (bf16)f2bf(acc[2][r]); }
          { float nk = 0.f;
#pragma unroll
            for (int r = 0; r < 4; ++r) { float q2 = acc[0][r] * acc[0][r] + acc[1][r] * acc[1][r];
                q2 += DPPF(q2, 0xB1); q2 += DPPF(q2, 0x4E); q2 += DPPF(q2, 0x141); q2 += DPPF(q2, 0x140);
                nk = fmaxf(nk, q2); }
            nk = fmaxf(nk, __shfl_xor(nk, 16)); nk = fmaxf(nk, __shfl_xor(nk, 32));
            if (lane == 0) atomicMax((unsigned*)(a.ws + WS_CTL) + CW_KMAX + 16 * (t0 / SEQ), __float_as_uint(nk)); } } }
    const int l7 = lane & 7;
    const int aqcol = (lane >> 3) * 64 + 8 * l7, akcol = ((lane & 15) >> 3) * 64 + 8 * l7;
    const bf16* aqsrc = proj_tile(a, TL_AQ + (aqcol >> 8)) + (aqcol & 255); const bf16* aksrc = proj_tile(a, TL_KV) + akcol; const bf16* iqsrc = proj_tile(a, TL_IQ) + 4 * lane;
#define P2_LOADROW(t_, P_, A_, K_, Q_) do { const int tt_ = (t_) < T ? (t_) : T - 1; P_ = pos[tt_]; A_ = *(const v4u*)(aqsrc + (size_t)tt_ * 256); K_ = *(const v4u*)(aksrc + (size_t)tt_ * 256); Q_ = *(const v2u*)(iqsrc + (size_t)tt_ * 256); } while (0)
#define P2_DOROW(t, P_, A_, K_, Q_) do { \
        const float ang = (float)(P_) * invf; \
        const double rev = (double)ang * 0.15915494309189535; const float frv = (float)(rev - __builtin_rint(rev)); \
        float cs = __builtin_amdgcn_cosf(frv), sn = __builtin_amdgcn_sinf(frv); \
        float ca[8], sa[8], ci[4], si[4]; \
        _Pragma("unroll") for (int i = 0; i < 8; ++i) { ca[i] = __int_as_float(__builtin_amdgcn_readlane(__float_as_int(cs), i)); sa[i] = __int_as_float(__builtin_amdgcn_readlane(__float_as_int(sn), i)); } \
        _Pragma("unroll") for (int i = 0; i < 4; ++i) { ci[i] = __int_as_float(__builtin_amdgcn_readlane(__float_as_int(cs), 8 + i)); si[i] = __int_as_float(__builtin_amdgcn_readlane(__float_as_int(sn), 8 + i)); } \
        { float f[8]; unpack8(A_, f); float ss = 0.f; \
          _Pragma("unroll") for (int i = 0; i < 8; ++i) ss += f[i] * f[i]; \
          ss += DPPF(ss, 0xB1); ss += DPPF(ss, 0x4E); ss += DPPF(ss, 0x141); \
          const float r = rsqrtf(ss * (1.f / 64.f) + EPS); \
          _Pragma("unroll") for (int i = 0; i < 8; ++i) f[i] = f[i] * r * gq[i]; \
          float o[8]; \
          _Pragma("unroll") for (int i = 0; i < 8; ++i) { const float p = DPPF(f[i], 0xB1); o[i] = (l7 == 0) ? (f[i] * ca[i] - p * sa[i]) : ((l7 == 1) ? (f[i] * ca[i] + p * sa[i]) : f[i]); o[i] *= 0.125f * 1.4426950408889634f; } \
          *(v4u*)(AQN + (size_t)(t) * 512 + aqcol) = pack8(o); } \
        { float f[8]; unpack8(K_, f); float ss = 0.f; \
          _Pragma("unroll") for (int i = 0; i < 8; ++i) ss += f[i] * f[i]; \
          ss += DPPF(ss, 0xB1); ss += DPPF(ss, 0x4E); ss += DPPF(ss, 0x141); \
          const float r = rsqrtf(ss * (1.f / 64.f) + EPS); \
          _Pragma("unroll") for (int i = 0; i < 8; ++i) f[i] = f[i] * r * gk[i]; \
          float o[8]; \
          _Pragma("unroll") for (int i = 0; i < 8; ++i) { const float p = DPPF(f[i], 0xB1); o[i] = (l7 == 0) ? (f[i] * ca[i] - p * sa[i]) : ((l7 == 1) ? (f[i] * ca[i] + p * sa[i]) : f[i]); } \
          if (lane < 16) *(v4u*)(KN + (size_t)(t) * 128 + akcol) = pack8(o); } \
        { const v2u rw = Q_; \
          float f[4] = {bf2f(rw.x & 0xffffu), bf2f(rw.x >> 16), bf2f(rw.y & 0xffffu), bf2f(rw.y >> 16)}; float o[4]; \
          _Pragma("unroll") for (int i = 0; i < 4; ++i) { const float p = DPPF(f[i], 0xB1); o[i] = (l7 == 0) ? (f[i] * ci[i] - p * si[i]) : ((l7 == 1) ? (f[i] * ci[i] + p * si[i]) : f[i]); } \
          v2u w; w.x = pk2(o[0], o[1]); w.y = pk2(o[2], o[3]); *(v2u*)(IQR + (size_t)(t) * 256 + 4 * lane) = w; } } while (0)
    { int pA, pB; v4u aA, aB, kA, kB; v2u qA, qB;
      P2_LOADROW(gw, pA, aA, kA, qA);
#pragma unroll 1
      for (int t = gw; t < T; t += 2 * NGW) {
          P2_LOADROW(t + NGW, pB, aB, kB, qB);
          P2_DOROW(t, pA, aA, kA, qA);
          P2_LOADROW(t + 2 * NGW, pA, aA, kA, qA);
          if (t + NGW < T) P2_DOROW(t + NGW, pB, aB, kB, qB);
      } }
#undef P2_LOADROW
#undef P2_DOROW
}
constexpr int ML_QS = 0, ML_KS = 17408, ML_HS = 0;
constexpr int ML_KWT = 34816;
constexpr int ML_VT = 53248;
constexpr int ML_SW = 73984;
constexpr int ML_CT = 83200;
constexpr int ML_GA = 122368;
constexpr int ML_CW = ML_GA + 1024;
constexpr int ML_END = ML_CW + (1024 + 384) * 4;
static_assert(ML_END <= MISC_OFF, "mLSTM LDS map");
constexpr size_t ML_STATE_BYTES = 8 * 9 * 64 * 16;
__device__ __forceinline__ bf16x8 lds_frag(const LAS unsigned char* base, int stride_b, int row0, int kb, int lane) {
    return *(const LAS bf16x8*)(base + (row0 + (lane & 15)) * stride_b + kb + (lane >> 4) * 16);
}
__device__ __forceinline__ bf16x8 lds_frag_sw(const LAS unsigned char* base, int row0, int ks, int lane) {
    const int row = row0 + (lane & 15); return *(const LAS bf16x8*)(base + row * 144 + 16 * (((ks * 4 + (lane >> 4)) + (row >> 3)) & 7));
}
#define MFMA16(a_, b_, c_) __builtin_amdgcn_mfma_f32_16x16x32_bf16(a_, b_, c_, 0, 0, 0)
constexpr int CV_NMI = 2 * (32 * 16 * 32 + 32 * 8 * 32);
constexpr int CV_SCR = ML_END, CV_SCRW = 32 * 33 * 4;
static_assert(CV_SCR + 8 * CV_SCRW <= MISC_OFF, "conversion scratch");
struct CvItem { const float* src; bf16* dst; int ldw, K; };
__device__ __forceinline__ CvItem cv_item(const Args& a, int mi) {
    const int it = mi >> 1, hk = mi & 1; CvItem r;
    if (it < 32 * 16 * 32) { const int e = it >> 9, q = it & 511, kb = q >> 5, nb = q & 31, t = nb >> 3, bj = (nb >> 2) & 1, i0 = (nb & 3) * 32, k0 = 64 * kb + 32 * hk;
        r.src = (bj ? a.in[IN_WEU] : a.in[IN_WEG]) + (size_t)e * 1024 * 512 + (size_t)k0 * 512 + 128 * t + i0; r.ldw = 512; r.K = 1024;
        r.dst = (bf16*)(a.ws + WS_GU) + ((size_t)e * 1024 + 32 * nb) * 1024 + k0;
    } else { const int r2 = it - 32 * 16 * 32, e = r2 >> 8, q = r2 & 255, kb = q >> 5, nb = q & 31, k0 = 64 * kb + 32 * hk;
        r.src = a.in[IN_WED] + (size_t)e * 512 * 1024 + (size_t)k0 * 1024 + 32 * nb; r.ldw = 1024; r.K = 512;
        r.dst = (bf16*)(a.ws + WS_DN) + ((size_t)e * 1024 + 32 * nb) * 512 + k0; }
    return r;
}
__device__ __forceinline__ void cv_load(const CvItem& it, f32x4 (&v)[4], int lane) {
#pragma unroll
    for (int i = 0; i < 4; ++i) v[i] = *(const f32x4*)(it.src + (size_t)(8 * i + (lane >> 3)) * it.ldw + 4 * (lane & 7));
}
__device__ __forceinline__ void cv_finish(const CvItem& it, const f32x4 (&v)[4], LAS float* scr, int lane, bool valid) {
#pragma unroll
    for (int i = 0; i < 4; ++i) { LAS float* d = scr + (8 * i + (lane >> 3)) * 33 + 4 * (lane & 7); d[0] = v[i][0]; d[1] = v[i][1]; d[2] = v[i][2]; d[3] = v[i][3]; }
    LDS_WAIT(); asm volatile("" ::: "memory");
#pragma unroll
    for (int j = 0; j < 2; ++j) { const int n = (lane >> 2) + 16 * j, cq = lane & 3; const LAS float* sp = scr + (8 * cq) * 33 + n;
        v4u o; o.x = pk2(sp[0 * 33], sp[1 * 33]); o.y = pk2(sp[2 * 33], sp[3 * 33]); o.z = pk2(sp[4 * 33], sp[5 * 33]); o.w = pk2(sp[6 * 33], sp[7 * 33]);
        if (valid) *(v4u*)(it.dst + (size_t)n * it.K + 8 * cq) = o; }
    LDS_WAIT(); asm volatile("" ::: "memory");
}
template <int MODE>
__device__ __forceinline__ void mlstm_unit(const Args& a, const Ctx& c, int b, int h, int g) {
    const int tid = c.tid, wave = c.wave; LAS unsigned char* lds = c.lds;
#define ML_LAUNDER() int tv_ = tid; asm volatile("" : "+v"(tv_)); const int lane = tv_ & 63, seg = tv_ & 15, r2 = (tv_ >> 4) * 2; (void)lane; (void)seg; (void)r2
    const bf16* PQ = proj_tile(a, TL_MQ + (h >> 1)) + (h & 1) * 128;
    const bf16* PK = proj_tile(a, TL_MK + (h >> 1)) + (h & 1) * 128;
    const bf16* PV = proj_tile(a, TL_MV + (h >> 1)) + (h & 1) * 128;
    const bf16* PO = proj_tile(a, TL_MO + (h >> 1)) + (h & 1) * 128;
    const bf16* PS = (const bf16*)((unsigned char*)a.out + DO_SMB);
    bf16* YML = (bf16*)((unsigned char*)a.out + DO_YML);
    unsigned char* STB = a.ws + WS_MLST; float* MST = (float*)(a.ws + WS_MLST + 256 * ML_STATE_BYTES);
    LAS float* GAa = (LAS float*)(lds + ML_GA); LAS float* GAm = GAa + 64; LAS float* GAw = GAa + 128; LAS float* GAe = GAa + 192;
    LAS float* CWQ = (LAS float*)(lds + ML_CW); LAS float* CWK = CWQ + 512; LAS float* CBQ = CWQ + 1024; LAS float* CBK = CBQ + 128; LAS float* GN = CBK + 128;
    LAS bf16* VTs = (LAS bf16*)(lds + ML_VT);
    { const float* wc = a.in[IN_WCONV]; const int j = tid >> 7, d = tid & 127;
      CWQ[tid] = wc[j * 1024 + h * 128 + d]; CWK[tid] = wc[j * 1024 + 512 + h * 128 + d];
      if (tid < 128) { CBQ[tid] = a.in[IN_BCONV][h * 128 + tid]; CBK[tid] = a.in[IN_BCONV][512 + h * 128 + tid]; GN[tid] = a.in[IN_GML][h * 128 + tid]; } }
    for (int i = tid; i < 16 * 64; i += 512) { const int r = i >> 6, cc = i & 63; VTs[(128 + r) * 72 + cc] = (r == 0) ? (bf16)0x3F80 : (bf16)0; }
    const float big = a.in[IN_BI][h], bfg = a.in[IN_BF][h];
    const int slot0 = (b * 4 + h) * 8;
    f32x4 cacc[9];
    float m_st = 0.f;
    if (MODE == 1 && g > 0) { ML_LAUNDER();
        const f32x4* sp = (const f32x4*)(STB + (size_t)(slot0 + g) * ML_STATE_BYTES) + wave * 576 + lane;
#pragma unroll
        for (int i = 0; i < 9; ++i) cacc[i] = sp[64 * i];
        m_st = MST[slot0 + g];
#pragma unroll
        for (int ee = 0; ee < 9; ++ee) { v2u w; w.x = pk2(cacc[ee][0], cacc[ee][1]); w.y = pk2(cacc[ee][2], cacc[ee][3]);
            *(LAS v2u*)(lds + ML_CT + (ee * 16 + (lane & 15)) * 272 + (wave * 16 + 4 * (lane >> 4)) * 2) = w; }
    } else {
#pragma unroll
        for (int i = 0; i < 9; ++i) cacc[i] = (f32x4){0.f, 0.f, 0.f, 0.f};
        for (int i = tid; i < 144 * 136 / 2; i += 512) ((LAS unsigned*)(lds + ML_CT))[i] = 0u;
    }
    const size_t tb = (size_t)b * SEQ;
    const char* bq = (const char*)(PQ + tb * 256); const char* bk = (const char*)(PK + tb * 256); const char* bv = (const char*)(PV + tb * 256); const char* bo = (const char*)(PO + tb * 256); const char* bs = (const char*)(PS + tb * 16);
    v4u rq[5], rk[5], rv[2]; unsigned short gi = 0, gf = 0;
#define ML_LOAD(kc) do { _Pragma("unroll") for (int j_ = 0; j_ < 5; ++j_) { const int rr_ = 64 * (kc) + r2 - 3 + j_; const unsigned o_ = (unsigned)((rr_ < 0 ? 0 : rr_) * 512 + seg * 16); \
            v4u q_ = (v4u){0u, 0u, 0u, 0u}; if (MODE == 1) q_ = *(const v4u*)(bq + o_); v4u k_ = *(const v4u*)(bk + o_); if (rr_ < 0) { q_ = (v4u){0u, 0u, 0u, 0u}; k_ = q_; } rq[j_] = q_; rk[j_] = k_; } \
        _Pragma("unroll") for (int i_ = 0; i_ < 2; ++i_) rv[i_] = *(const v4u*)(bv + (unsigned)((64 * (kc) + r2 + i_) * 512 + seg * 16)); \
        gi = *(const unsigned short*)(bs + (unsigned)((64 * (kc) + lane) * 32 + (8 + h) * 2)); gf = *(const unsigned short*)(bs + (unsigned)((64 * (kc) + lane) * 32 + (12 + h) * 2)); } while (0)
    const int kc0 = (MODE == 1) ? 8 * g : 0, kc1 = (MODE == 1) ? 8 * g + 8 : 56;
    { ML_LAUNDER(); ML_LOAD(kc0); }
    const int cv_gw = c.vcu * NWAVES + c.wave, cv_ngw = c.G * NWAVES; f32x4 cvv[4]; CvItem cvi; int cvk = 0; bool cvp = false;
    LAS float* cv_scr = (LAS float*)(lds + CV_SCR + wave * CV_SCRW);
#define CV_SLOT() do { if (MODE == 1) { ML_LAUNDER(); if (cvp) cv_finish(cvi, cvv, cv_scr, lane, cv_gw + (cvk - 1) * cv_ngw < CV_NMI); \
        { int mi_ = cv_gw + cvk * cv_ngw; mi_ = mi_ < CV_NMI ? mi_ : CV_NMI - 1; cvi = cv_item(a, __builtin_amdgcn_readfirstlane(mi_)); cv_load(cvi, cvv, lane); cvp = true; ++cvk; } } } while (0)
    __syncthreads();
#pragma unroll 1
    for (int kc = kc0; kc < kc1; ++kc) {
        float wkv, decay, m_new;
        if (MODE == 0 && kc > 0 && (kc & 7) == 0) { ML_LAUNDER();
            f32x4* sp = (f32x4*)(STB + (size_t)(slot0 + (kc >> 3)) * ML_STATE_BYTES) + wave * 576 + lane;
#pragma unroll
            for (int i = 0; i < 9; ++i) sp[64 * i] = cacc[i];
            if (tid == 0) MST[slot0 + (kc >> 3)] = m_st; }
        CV_SLOT();
        { ML_LAUNDER();
        const float fpre = bf2f(gf) + bfg, lf = fminf(fpre, 0.f) - log1pf(__expf(-fabsf(fpre)));
        const float ig = bf2f(gi) + big;
#define ML_SHR(x_, n_, id_) __int_as_float(__builtin_amdgcn_update_dpp(__float_as_int(id_), __float_as_int(x_), 0x110 + (n_), 0xF, 0xF, false))
        float bc = lf;
        bc += ML_SHR(bc, 1, 0.f); bc += ML_SHR(bc, 2, 0.f); bc += ML_SHR(bc, 4, 0.f); bc += ML_SHR(bc, 8, 0.f);
        { const float t0 = __int_as_float(__builtin_amdgcn_readlane(__float_as_int(bc), 15)), t1 = __int_as_float(__builtin_amdgcn_readlane(__float_as_int(bc), 31)), t2 = __int_as_float(__builtin_amdgcn_readlane(__float_as_int(bc), 47));
          bc += (lane >= 48) ? (t0 + t1 + t2) : ((lane >= 32) ? (t0 + t1) : ((lane >= 16) ? t0 : 0.f)); }
        const float av = ig - bc; float Ac = av;
        Ac = fmaxf(Ac, ML_SHR(Ac, 1, -3.0e38f)); Ac = fmaxf(Ac, ML_SHR(Ac, 2, -3.0e38f)); Ac = fmaxf(Ac, ML_SHR(Ac, 4, -3.0e38f)); Ac = fmaxf(Ac, ML_SHR(Ac, 8, -3.0e38f));
        { const float t0 = __int_as_float(__builtin_amdgcn_readlane(__float_as_int(Ac), 15)), t1 = __int_as_float(__builtin_amdgcn_readlane(__float_as_int(Ac), 31)), t2 = __int_as_float(__builtin_amdgcn_readlane(__float_as_int(Ac), 47));
          const float m01 = fmaxf(t0, t1), m012 = fmaxf(m01, t2);
          Ac = fmaxf(Ac, (lane >= 48) ? m012 : ((lane >= 32) ? m01 : ((lane >= 16) ? t0 : -3.0e38f))); }
#undef ML_SHR
        const float mA = fmaxf(m_st, Ac), Mk = __int_as_float(__builtin_amdgcn_readlane(__float_as_int(mA), 63)), blast = __int_as_float(__builtin_amdgcn_readlane(__float_as_int(bc), 63));
        wkv = __expf(av - Mk); decay = __expf(m_st - Mk); m_new = blast + Mk;
        if (MODE == 1 && wave == 0) { GAa[lane] = av; GAm[lane] = mA; GAw[lane] = __expf(m_st - mA); GAe[lane] = __expf(-(bc + mA)); } }
        { ML_LAUNDER(); float kw_[2][8];
#pragma unroll
          for (int i = 0; i < 2; ++i) { const int t = r2 + i; const float wkt = __shfl(wkv, t);
            float aq_[8], ak_[8];
            { const f32x4 b0 = *(const LAS f32x4*)(CBQ + seg * 8), b1 = *(const LAS f32x4*)(CBQ + seg * 8 + 4), c0 = *(const LAS f32x4*)(CBK + seg * 8), c1 = *(const LAS f32x4*)(CBK + seg * 8 + 4);
              aq_[0] = b0[0]; aq_[1] = b0[1]; aq_[2] = b0[2]; aq_[3] = b0[3]; aq_[4] = b1[0]; aq_[5] = b1[1]; aq_[6] = b1[2]; aq_[7] = b1[3];
              ak_[0] = c0[0]; ak_[1] = c0[1]; ak_[2] = c0[2]; ak_[3] = c0[3]; ak_[4] = c1[0]; ak_[5] = c1[1]; ak_[6] = c1[2]; ak_[7] = c1[3]; }
#pragma unroll
            for (int j = 0; j < 4; ++j) { float fk_[8]; unpack8(rk[i + j], fk_);
                const f32x4 x0 = *(const LAS f32x4*)(CWK + j * 128 + seg * 8), x1 = *(const LAS f32x4*)(CWK + j * 128 + seg * 8 + 4);
#pragma unroll
                for (int e = 0; e < 4; ++e) { ak_[e] += x0[e] * fk_[e]; ak_[4 + e] += x1[e] * fk_[4 + e]; }
                if (MODE == 1) { float fq_[8]; unpack8(rq[i + j], fq_);
                    const f32x4 w0 = *(const LAS f32x4*)(CWQ + j * 128 + seg * 8), w1 = *(const LAS f32x4*)(CWQ + j * 128 + seg * 8 + 4);
#pragma unroll
                    for (int e = 0; e < 4; ++e) { aq_[e] += w0[e] * fq_[e]; aq_[4 + e] += w1[e] * fq_[4 + e]; } } }
#pragma unroll
            for (int e = 0; e < 8; ++e) { ak_[e] = ak_[e] * sigm(ak_[e]) * 0.08838834764831845f; kw_[i][e] = ak_[e] * wkt; }
            if (MODE == 1) {
#pragma unroll
                for (int e = 0; e < 8; ++e) aq_[e] = aq_[e] * sigm(aq_[e]);
                *(LAS v4u*)(lds + ML_QS + t * 272 + seg * 16) = pack8(aq_);
                *(LAS v4u*)(lds + ML_KS + t * 272 + seg * 16) = pack8(ak_); } }
          const unsigned va[4] = {rv[0].x, rv[0].y, rv[0].z, rv[0].w}, vb[4] = {rv[1].x, rv[1].y, rv[1].z, rv[1].w};
          const int swo = 16 * (((r2 >> 3) + seg) & 7) + 2 * (r2 & 7);
#pragma unroll
          for (int e = 0; e < 8; ++e) { const int ro = (seg * 8 + e) * 144 + swo;
              *(LAS unsigned*)(lds + ML_KWT + ro) = pk2(kw_[0][e], kw_[1][e]);
              const unsigned lo = (e & 1) ? (va[e >> 1] >> 16) : (va[e >> 1] & 0xffffu), hi = (e & 1) ? (vb[e >> 1] >> 16) : (vb[e >> 1] & 0xffffu);
              *(LAS unsigned*)(lds + ML_VT + ro) = lo | (hi << 16); }
        if (kc + 1 < kc1) ML_LOAD(kc + 1); }
        __syncthreads();
        f32x4 hacc[5]; unsigned mo_r[8];
        const int tt = wave & 3, t0 = tt * 16, ne = (wave < 4) ? 5 : 4, e_first = (wave < 4) ? 0 : 5;
        CV_SLOT();
        if (MODE == 1) {
        { ML_LAUNDER(); const int tq = t0 + (lane & 15);
        bf16x8 qf[4];
#pragma unroll
        for (int ks = 0; ks < 4; ++ks) qf[ks] = lds_frag(lds + ML_QS, 272, t0, ks * 64, lane);
        const float mAt = GAm[tq], wit = GAw[tq];
#pragma unroll
        for (int si = 0; si < 2; ++si) { const int ss = 2 * (wave >> 2) + si, s0 = ss * 16; f32x4 sacc = (f32x4){0.f, 0.f, 0.f, 0.f};
            if (ss <= tt) {
#pragma unroll
                for (int ks = 0; ks < 4; ++ks) sacc = MFMA16(lds_frag(lds + ML_KS, 272, s0, ks * 64, lane), qf[ks], sacc);
#pragma unroll
                for (int r = 0; r < 4; ++r) { const int s = s0 + 4 * (lane >> 4) + r; sacc[r] = (s <= tq) ? sacc[r] * __expf(GAa[s] - mAt) : 0.f; } }
            v2u w; w.x = pk2(sacc[0], sacc[1]); w.y = pk2(sacc[2], sacc[3]);
            *(LAS v2u*)(lds + ML_SW + tq * 144 + s0 * 2 + (lane >> 4) * 8) = w; }
#pragma unroll
        for (int i = 0; i < 5; ++i) { hacc[i] = (f32x4){0.f, 0.f, 0.f, 0.f};
            if (i < ne) {
#pragma unroll
                for (int ks = 0; ks < 4; ++ks) hacc[i] = MFMA16(lds_frag(lds + ML_CT, 272, (e_first + i) * 16, ks * 64, lane), qf[ks], hacc[i]);
                hacc[i] = hacc[i] * wit; } }
#pragma unroll
        for (int i = 0; i < 8; ++i) mo_r[i] = *(const unsigned*)(bo + (unsigned)((64 * kc + 8 * wave + i) * 512 + 4 * lane)); }
        __syncthreads();
        { ML_LAUNDER(); const int tq = t0 + (lane & 15); bf16x8 swf[2];
#pragma unroll
          for (int ks = 0; ks < 2; ++ks) swf[ks] = lds_frag(lds + ML_SW, 144, t0, ks * 64, lane);
#pragma unroll
          for (int i = 0; i < 5; ++i) if (i < ne) { const int ee = e_first + i;
#pragma unroll
              for (int ks = 0; ks < 2; ++ks) hacc[i] = MFMA16(lds_frag_sw(lds + ML_VT, ee * 16, ks, lane), swf[ks], hacc[i]);
              if (ee < 8) *(LAS f32x4*)(lds + ML_HS + tq * 528 + (ee * 16 + 4 * (lane >> 4)) * 4) = hacc[i];
              else if ((lane >> 4) == 0) *(LAS float*)(lds + ML_HS + tq * 528 + 128 * 4) = hacc[i][0]; } }
        }
        CV_SLOT();
        { ML_LAUNDER(); const int d0 = wave * 16; bf16x8 kwf[2];
#pragma unroll
          for (int ks = 0; ks < 2; ++ks) kwf[ks] = lds_frag_sw(lds + ML_KWT, d0, ks, lane);
#pragma unroll
          for (int ee = 0; ee < 9; ++ee) { cacc[ee] = cacc[ee] * decay;
#pragma unroll
              for (int ks = 0; ks < 2; ++ks) cacc[ee] = MFMA16(kwf[ks], lds_frag_sw(lds + ML_VT, ee * 16, ks, lane), cacc[ee]);
              if (MODE == 1) { v2u w; w.x = pk2(cacc[ee][0], cacc[ee][1]); w.y = pk2(cacc[ee][2], cacc[ee][3]);
                  *(LAS v2u*)(lds + ML_CT + (ee * 16 + (lane & 15)) * 272 + (d0 + 4 * (lane >> 4)) * 2) = w; } } }
        __syncthreads();
        if (MODE == 1) {
        { ML_LAUNDER();
#pragma unroll
        for (int i = 0; i < 8; ++i) { const int t = 8 * wave + i;
            const f32x2 nv = *(const LAS f32x2*)(lds + ML_HS + t * 528 + lane * 8); const float den = *(const LAS float*)(lds + ML_HS + t * 528 + 512);
            const float dd = fmaxf(fabsf(den), GAe[t]); const float h0 = nv.x / dd, h1 = nv.y / dd;
            const float r = rsqrtf(wave_sum(h0 * h0 + h1 * h1) * (1.f / 128.f) + EPS);
            const float y0 = h0 * r * GN[2 * lane] * sigm(bf2f(mo_r[i] & 0xffffu)), y1 = h1 * r * GN[2 * lane + 1] * sigm(bf2f(mo_r[i] >> 16));
            *(unsigned*)(YML + (tb + 64 * kc + t) * 512 + h * 128 + 2 * lane) = pk2(y0, y1); } }
        __syncthreads();
        }
        m_st = m_new;
    }
    if (MODE == 1) { ML_LAUNDER(); if (cvp) cv_finish(cvi, cvv, cv_scr, lane, cv_gw + (cvk - 1) * cv_ngw < CV_NMI); }
#undef CV_SLOT
    if (MODE == 0) { ML_LAUNDER();
        f32x4* sp = (f32x4*)(STB + (size_t)(slot0 + 7) * ML_STATE_BYTES) + wave * 576 + lane;
#pragma unroll
        for (int i = 0; i < 9; ++i) sp[64 * i] = cacc[i];
        if (tid == 0) MST[slot0 + 7] = m_st; }
#undef ML_LOAD
#undef ML_LAUNDER
}
constexpr int AT_HIST = 0;
constexpr int AT_HROW = 2049;
constexpr int AT_SEL = 131072 + 256;
constexpr int AT_MROW = 129;
constexpr int AT_SM = AT_SEL + 8448;
constexpr int AT_LUT = AT_SM + 256;
constexpr int AT_SEL2 = AT_LUT + 256;
static_assert(AT_SEL2 + 8448 <= MISC_OFF, "attention LDS map");
__device__ __forceinline__ unsigned at_bin(float s, float inv) { const float x = __builtin_fmaf(s, inv, 2048.0f); return (unsigned)(int)__builtin_amdgcn_fmed3f(x, 0.0f, 4095.0f); }
__device__ __forceinline__ unsigned score_key(float s) { unsigned u = __float_as_uint(s + 0.0f); return (u & 0x80000000u) ? ~u : (u | 0x80000000u); }
__device__ __forceinline__ unsigned wave_suffix_sum(unsigned v, int lane) {
#define AT_SHL(x_, n_) ((unsigned)__builtin_amdgcn_update_dpp(0, (int)(x_), 0x100 + (n_), 0xF, 0xF, false))
    v += AT_SHL(v, 1); v += AT_SHL(v, 2); v += AT_SHL(v, 4); v += AT_SHL(v, 8);
#undef AT_SHL
    const unsigned t1 = (unsigned)__builtin_amdgcn_readlane((int)v, 16), t2 = (unsigned)__builtin_amdgcn_readlane((int)v, 32), t3 = (unsigned)__builtin_amdgcn_readlane((int)v, 48);
    return v + ((lane < 16) ? (t1 + t2 + t3) : ((lane < 32) ? (t2 + t3) : ((lane < 48) ? t3 : 0u)));
}
template <int NK> __device__ __forceinline__ void at_resolve2(const LAS unsigned long long* candA, LAS unsigned* maskA, int mA, int ndA,
                                                              const LAS unsigned long long* candB, LAS unsigned* maskB, int mB, int ndB, int lane) {
    unsigned long long ca[NK], cb[NK];
#pragma unroll
    for (int k = 0; k < NK; ++k) { const int i = 64 * k + lane; unsigned long long x = 0ull, y = 0ull; if (i < mA) x = candA[i]; if (i < mB) y = candB[i];
        ca[k] = (i < mA) ? (((x >> 32) << 16) | (x & 0xFFFFull)) : 0ull; cb[k] = (i < mB) ? (((y >> 32) << 16) | (y & 0xFFFFull)) : 0ull; }
    unsigned long long TA = 0ull, TB = 0ull;
#pragma unroll 1
    for (int bit = 47; bit >= 16; --bit) { const unsigned long long ta = TA | (1ull << bit), tb = TB | (1ull << bit); int ga = 0, gb = 0;
#pragma unroll
        for (int k = 0; k < NK; ++k) { ga += __popcll(__ballot(ca[k] >= ta)); gb += __popcll(__ballot(cb[k] >= tb)); }
        if (ga >= ndA) TA = ta; if (gb >= ndB) TB = tb; }
    int gA = 0, tA = 0, gB = 0, tB = 0;
#pragma unroll
    for (int k = 0; k < NK; ++k) { gA += __popcll(__ballot(ca[k] >= TA + 0x10000ull)); tA += __popcll(__ballot(ca[k] >= TA)); gB += __popcll(__ballot(cb[k] >= TB + 0x10000ull)); tB += __popcll(__ballot(cb[k] >= TB)); }
    tA -= gA; tB -= gB;
    if (tA > ndA - gA || tB > ndB - gB) {
#pragma unroll 1
        for (int bit = 15; bit >= 0; --bit) { const unsigned long long ta = TA | (1ull << bit), tb = TB | (1ull << bit); int ga = 0, gb = 0;
#pragma unroll
            for (int k = 0; k < NK; ++k) { ga += __popcll(__ballot(ca[k] >= ta)); gb += __popcll(__ballot(cb[k] >= tb)); }
            if (ga >= ndA) TA = ta; if (gb >= ndB) TB = tb; } }
#pragma unroll
    for (int k = 0; k < NK; ++k) {
        if (ca[k] >= TA && ca[k] != 0ull) { const unsigned key = 0xFFFFu - (unsigned)(ca[k] & 0xFFFFull);
            __hip_atomic_fetch_or(&maskA[key >> 5], 1u << (key & 31u), __ATOMIC_RELAXED, __HIP_MEMORY_SCOPE_WORKGROUP); }
        if (cb[k] >= TB && cb[k] != 0ull) { const unsigned key = 0xFFFFu - (unsigned)(cb[k] & 0xFFFFull);
            __hip_atomic_fetch_or(&maskB[key >> 5], 1u << (key & 31u), __ATOMIC_RELAXED, __HIP_MEMORY_SCOPE_WORKGROUP); } }
}
__device__ __forceinline__ void attn_unit(const Args& a, const Ctx& c, int b, int qt, float cshift) {
    const int tid = c.tid, wave = c.wave; LAS unsigned char* lds = c.lds;
#define AT_LAUNDER() int tv_ = tid; asm volatile("" : "+v"(tv_)); const int lane = tv_ & 63, qi = tv_ & 15, fq = (tv_ >> 4) & 3; (void)lane; (void)qi; (void)fq
    const int q0u = qt * 32, ch = q0u >> 6, n = 64 * (ch + 1), ntiles = n >> 4;
    const size_t tb = (size_t)b * SEQ;
    unsigned char* dout = (unsigned char*)a.out;
    const bf16* AQN = (const bf16*)(dout + DO_AQN); const bf16* KN = (const bf16*)(dout + DO_KN); const bf16* IQR = (const bf16*)(dout + DO_IQR); const bf16* IKR = (const bf16*)(dout + DO_IKR);
    bf16* YATT = (bf16*)(dout + DO_YATT);
    const bf16* VB = proj_tile(a, TL_KV); const bf16* PS = (const bf16*)(dout + DO_SMB);
    LAS unsigned* HIST = (LAS unsigned*)(lds + AT_HIST);
    LAS unsigned long long* CAND = (LAS unsigned long long*)(lds + AT_HIST);
    LAS int* SM = (LAS int*)(lds + AT_SM);
    float* SC = (blockIdx.x < 240) ? (float*)(a.ws + WS_SC) + (size_t)blockIdx.x * (16 * 4096) : (float*)(a.ws + WS_SC2) + (size_t)(blockIdx.x - 240) * (16 * 4096);
#ifndef DBG_REP_DENSE
#define DBG_REP_DENSE 1
#endif
#pragma unroll 1
    for (int rsel = 0; rsel < 2; ++rsel) {
    const int q0 = q0u + 16 * rsel;
    LAS unsigned* MASK = (LAS unsigned*)(lds + (rsel ? AT_SEL2 : AT_SEL));
    if (n > 256) {
        for (int i = tid; i < 8192 + 4; i += 512) ((LAS v4u*)HIST)[i] = (v4u){0u, 0u, 0u, 0u};
        if (tid < 64) SM[tid] = 0;
        for (int i = tid; i < 16 * AT_MROW; i += 512) MASK[i] = 0u;
        bf16x8 qf[8]; float wv[8]; bf16x8 qsh, qsl; float binv;
        { AT_LAUNDER();
        const size_t trow = tb + q0 + qi;
#pragma unroll
        for (int h = 0; h < 8; ++h) qf[h] = *(const bf16x8*)(IQR + trow * 256 + h * 32 + 8 * fq);
        { float t8[8]; unpack8(*(const v4u*)(PS + trow * 16), t8);
#pragma unroll
          for (int h = 0; h < 8; ++h) wv[h] = t8[h] * 0.03125f; }
        { float rq = 0.f;
#pragma unroll
          for (int h = 0; h < 8; ++h) { float f8[8]; unpack8(__builtin_bit_cast(v4u, qf[h]), f8); float q2 = 0.f;
#pragma unroll
            for (int j = 0; j < 8; ++j) q2 = __builtin_fmaf(f8[j], f8[j], q2);
            q2 += __shfl_xor(q2, 16); q2 += __shfl_xor(q2, 32);
            rq = __builtin_fmaf(fabsf(wv[h]), __builtin_sqrtf(q2), rq); }
          const float kmax = __builtin_sqrtf(__uint_as_float(__hip_atomic_load((const unsigned*)(a.ws + WS_CTL) + CW_KMAX + 16 * b, __ATOMIC_RELAXED, __HIP_MEMORY_SCOPE_AGENT)));
          binv = 2048.0f / fmaxf(rq * kmax, 1.0e-30f); }
        { float qs[8];
#pragma unroll
          for (int j = 0; j < 8; ++j) qs[j] = 0.f;
#pragma unroll
          for (int h = 0; h < 8; ++h) { float f8[8]; unpack8(__builtin_bit_cast(v4u, qf[h]), f8);
#pragma unroll
            for (int j = 0; j < 8; ++j) qs[j] = __builtin_fmaf(wv[h], f8[j], qs[j]); }
          float hi8[8], lo8[8]; const v4u ph = pack8(qs); unpack8(ph, hi8);
#pragma unroll
          for (int j = 0; j < 8; ++j) lo8[j] = qs[j] - hi8[j];
          qsh = __builtin_bit_cast(bf16x8, ph); qsl = __builtin_bit_cast(bf16x8, pack8(lo8)); } }
        __syncthreads();
#define AT_LOADK(kt_) (*(const bf16x8*)(IKR + (tb + (size_t)(kt_) * 16 + qi) * 32 + 8 * fq))
#define AT_SCORES(kf_, sc_) do { \
        { const f32x4 l0_ = MFMA16(kf_, qsl, ((f32x4){0.f, 0.f, 0.f, 0.f})); const f32x4 l1_ = MFMA16(kf_, qsh, l0_); \
          _Pragma("unroll") for (int r_ = 0; r_ < 4; ++r_) sc_[r_] = l1_[r_]; } \
        _Pragma("unroll") for (int h_ = 0; h_ < 8; ++h_) { const f32x4 d_ = MFMA16(kf_, qf[h_], ((f32x4){0.f, 0.f, 0.f, 0.f})); \
            _Pragma("unroll") for (int r_ = 0; r_ < 4; ++r_) { sc_[r_] = __builtin_fmaf(wv[h_], __builtin_fabsf(d_[r_]), sc_[r_]); asm("" : "+v"(sc_[r_])); } } } while (0)
        const int cnt = (ntiles - wave + 7) >> 3;
#ifndef DBG_RA
#define DBG_RA 1
#endif
#pragma unroll 1
        for (int rA = 0; rA < DBG_RA; ++rA) { if (rA) { for (int i = tid; i < 8192 + 4; i += 512) ((LAS v4u*)HIST)[i] = (v4u){0u, 0u, 0u, 0u}; __syncthreads(); }
#define AT_LOADG(dst_, i0_) do { _Pragma("unroll") for (int j_ = 0; j_ < 8; ++j_) { int kt_ = wave + 8 * ((i0_) + j_); kt_ = kt_ < ntiles ? kt_ : ntiles - 1; dst_[j_] = AT_LOADK(kt_); } } while (0)
#define AT_P1GROUP(buf_, base_) do { _Pragma("unroll") for (int j2 = 0; j2 < 8; ++j2) { const bool valid = ((base_) + j2 < cnt); const int kt = wave + 8 * ((base_) + j2); float sc[4]; AT_SCORES(buf_[j2], sc); \
                if (valid) *(f32x4*)(SC + qi * 4096 + kt * 16 + 4 * fq) = (f32x4){sc[0], sc[1], sc[2], sc[3]}; \
                _Pragma("unroll") for (int r = 0; r < 4; ++r) { const unsigned bin = at_bin(sc[r], binv); \
                    __hip_atomic_fetch_add(&HIST[qi * AT_HROW + (bin >> 1)], valid ? (1u << ((bin & 1u) * 16)) : 0u, __ATOMIC_RELAXED, __HIP_MEMORY_SCOPE_WORKGROUP); } } } while (0)
        { AT_LAUNDER(); bf16x8 ka[8], kb[8]; AT_LOADG(ka, 0);
#pragma unroll 1
          for (int i0 = 0; i0 < cnt; i0 += 16) {
            AT_LOADG(kb, i0 + 8);
            AT_P1GROUP(ka, i0);
            AT_LOADG(ka, i0 + 16);
            AT_P1GROUP(kb, i0 + 8); } }
#undef AT_P1GROUP
        __syncthreads();
        }
#ifndef DBG_RB
#define DBG_RB 1
#endif
#pragma unroll 1
        for (int rB = 0; rB < DBG_RB; ++rB) {
#pragma unroll 1
        for (int j = 0; j < 2; ++j) { AT_LAUNDER(); const int q = 2 * wave + j; unsigned tot = 0;
            for (int i = 0; i < 32; ++i) { const unsigned w = HIST[q * AT_HROW + 32 * lane + ((i + lane) & 31)]; tot += (w & 0xffffu) + (w >> 16); }
            const unsigned suf = wave_suffix_sum(tot, lane);
            const unsigned long long mk = __ballot(suf >= 256u); const int L = 63 - __clzll((long long)mk);
            const unsigned above_L = (unsigned)__builtin_amdgcn_readlane((int)(suf - tot), L);
            const unsigned w2 = HIST[q * AT_HROW + 32 * L + (lane >> 1)]; const unsigned cb = (lane & 1) ? (w2 >> 16) : (w2 & 0xffffu);
            const unsigned sfx = wave_suffix_sum(cb, lane);
            const unsigned long long mk2 = __ballot(above_L + sfx >= 256u); const int l2 = 63 - __clzll((long long)mk2);
            if (lane == l2) { SM[q] = 64 * L + l2; SM[16 + q] = (int)(256u - (above_L + sfx - cb)); } }
        __syncthreads();
        }
#ifndef DBG_RC
#define DBG_RC 1
#endif
#pragma unroll 1
        for (int rC = 0; rC < DBG_RC; ++rC) { if (rC) { if (tid < 16) SM[48 + tid] = 0; __syncthreads(); }
        { AT_LAUNDER(); const int Bq = SM[qi]; f32x4 scur[8];
#define AT_LOADS(dst_, i0_) do { _Pragma("unroll") for (int j_ = 0; j_ < 8; ++j_) { int kt_ = wave + 8 * ((i0_) + j_); kt_ = kt_ < ntiles ? kt_ : ntiles - 1; dst_[j_] = *(const f32x4*)(SC + qi * 4096 + kt_ * 16 + 4 * fq); } } while (0)
#define AT_P2GROUP(buf_, base_) do { _Pragma("unroll") for (int j2 = 0; j2 < 8; ++j2) { const bool valid = ((base_) + j2 < cnt); const int kt = wave + 8 * ((base_) + j2); \
                unsigned nib = 0u, cnib = 0u; unsigned uu[4]; \
                _Pragma("unroll") for (int r = 0; r < 4; ++r) { uu[r] = __float_as_uint(buf_[j2][r]); const int bin = (int)at_bin(buf_[j2][r], binv); nib |= (bin > Bq) ? (1u << r) : 0u; cnib |= (bin == Bq) ? (1u << r) : 0u; } \
                if (!valid) { nib = 0u; cnib = 0u; } \
                if (cnib) { int p = __hip_atomic_fetch_add(&SM[48 + qi], (int)__popc(cnib), __ATOMIC_RELAXED, __HIP_MEMORY_SCOPE_WORKGROUP); \
                    _Pragma("unroll") for (int r = 0; r < 4; ++r) if ((cnib >> r) & 1u) { if (p < 512) CAND[qi * 1024 + p] = ((unsigned long long)score_key(__uint_as_float(uu[r])) << 32) | (unsigned long long)(0xFFFFu - (unsigned)(kt * 16 + 4 * fq + r)); ++p; } } \
                if (nib) __hip_atomic_fetch_or(&MASK[qi * AT_MROW + (kt >> 1)], nib << (16 * (kt & 1) + 4 * fq), __ATOMIC_RELAXED, __HIP_MEMORY_SCOPE_WORKGROUP); } } while (0)
          f32x4 sb2[8];
          AT_LOADS(scur, 0);
#pragma unroll 1
          for (int i0 = 0; i0 < cnt; i0 += 16) {
            AT_LOADS(sb2, i0 + 8);
            AT_P2GROUP(scur, i0);
            AT_LOADS(scur, i0 + 16);
            AT_P2GROUP(sb2, i0 + 8); } }
#undef AT_P2GROUP
#undef AT_LOADS
        __syncthreads();
        }
#ifndef DBG_RD
#define DBG_RD 1
#endif
#pragma unroll 1
        for (int rD = 0; rD < DBG_RD; ++rD) {
        { AT_LAUNDER(); const int qa_ = 2 * wave, qb_ = 2 * wave + 1; int ma = SM[48 + qa_], mb = SM[48 + qb_]; ma = ma < 512 ? ma : 512; mb = mb < 512 ? mb : 512; const int nda = SM[16 + qa_], ndb = SM[16 + qb_];
            const int mm = ma > mb ? ma : mb;
            if (mm <= 64) at_resolve2<1>(CAND + qa_ * 1024, MASK + qa_ * AT_MROW, ma, nda, CAND + qb_ * 1024, MASK + qb_ * AT_MROW, mb, ndb, lane);
            else if (mm <= 256) at_resolve2<4>(CAND + qa_ * 1024, MASK + qa_ * AT_MROW, ma, nda, CAND + qb_ * 1024, MASK + qb_ * AT_MROW, mb, ndb, lane);
            else at_resolve2<8>(CAND + qa_ * 1024, MASK + qa_ * AT_MROW, ma, nda, CAND + qb_ * 1024, MASK + qb_ * AT_MROW, mb, ndb, lane); }
        __syncthreads();
        }
#undef AT_SCORES
#undef AT_LOADK
#undef AT_LOADG
    } else {
#pragma unroll 1
        for (int i = tid; i < 16 * AT_MROW; i += 512) MASK[i] = ((i % AT_MROW) < (n >> 5)) ? 0xFFFFFFFFu : 0u;
        __syncthreads();
    }
    }
#pragma unroll 1
    for (int rden = 0; rden < DBG_REP_DENSE; ++rden) {
    { const int g = wave >> 2, qh = (wave >> 1) & 1, hp = wave & 1, NS = n >> 6;
      const unsigned ring0 = (unsigned)(size_t)(lds + AT_HIST);
      if (tid < 64) *(LAS float*)(lds + AT_LUT + 4 * tid) = ((tid >> 2) >> (tid & 3)) & 1 ? -cshift : -1.0e30f;
      const bf16* dsrc[4]; unsigned ddst[4];
      { AT_LAUNDER();
#pragma unroll
        for (int i_ = 0; i_ < 4; ++i_) { const int in_ = 4 * wave + i_; const int row_ = 4 * (in_ & 15) + (lane >> 4), pos_ = lane & 15;
            dsrc[i_] = (in_ < 16) ? (KN + (tb + row_) * 128 + ((pos_ ^ (row_ & 15)) << 3)) : (VB + (tb + row_) * 256 + 128 + ((pos_ ^ (2 * (row_ & 7))) << 3));
            ddst[i_] = (unsigned)(in_ * 1024); } }
      const size_t dstep = (wave < 4) ? (size_t)64 * 128 : (size_t)64 * 256;
#define AT_STAGE(s_) do { const unsigned sb_ = ring0 + (unsigned)(((s_) & 3) * 32768); \
        _Pragma("unroll") for (int i_ = 0; i_ < 4; ++i_) { const bf16* src_ = dsrc[i_] + (size_t)(s_) * dstep; \
            const unsigned dst_ = __builtin_amdgcn_readfirstlane(sb_ + ddst[i_]); unsigned keep_; \
            asm volatile("s_mov_b32 %0, m0\n\ts_mov_b32 m0, %2\n\ts_nop 0\n\tglobal_load_lds_dwordx4 %1, off\n\ts_mov_b32 m0, %0" : "=&s"(keep_) : "v"(src_), "s"(dst_) : "memory"); } } while (0)
      bf16x8 qa[2], qb[2]; f32x4 oacc[2][4], lacc[2];
      { AT_LAUNDER();
#pragma unroll
        for (int hi = 0; hi < 2; ++hi) { const bf16* qp = AQN + (tb + q0u + 16 * qh + qi) * 512 + (g * 4 + 2 * hp + hi) * 64 + 8 * fq; qa[hi] = *(const bf16x8*)qp; qb[hi] = *(const bf16x8*)(qp + 32); } }
#pragma unroll
      for (int hi = 0; hi < 2; ++hi) { lacc[hi] = (f32x4){0.f, 0.f, 0.f, 0.f};
#pragma unroll
        for (int dt = 0; dt < 4; ++dt) oacc[hi][dt] = (f32x4){0.f, 0.f, 0.f, 0.f}; }
      const bf16x8 ones = (bf16x8){0x3F80, 0x3F80, 0x3F80, 0x3F80, 0x3F80, 0x3F80, 0x3F80, 0x3F80};
      asm volatile("s_waitcnt vmcnt(0)" ::: "memory");
#pragma unroll 1
      for (int s = 0; s < 3 && s < NS; ++s) AT_STAGE(s);
      typedef short s4_t __attribute__((ext_vector_type(4)));
      AT_LAUNDER();
      const LAS unsigned* mrow = (const LAS unsigned*)(lds + (qh ? AT_SEL2 : AT_SEL)) + qi * AT_MROW;
      const unsigned koff0 = (unsigned)(qi * 256 + (((g * 8 + fq) ^ qi) << 4)), koff1 = (unsigned)(qi * 256 + (((g * 8 + 4 + fq) ^ qi) << 4));
#define AT_LDK(kf_, ci_, slot_, tp_, mw_) do { const LAS unsigned char* kb_ = lds + AT_HIST + (slot_) * 32768 + (tp_) * 8192; \
          _Pragma("unroll") for (int t = 0; t < 2; ++t) { kf_[t][0] = *(const LAS bf16x8*)(kb_ + t * 4096 + koff0); kf_[t][1] = *(const LAS bf16x8*)(kb_ + t * 4096 + koff1); \
              ci_[t] = *(const LAS f32x4*)(lds + AT_LUT + ((((mw_) >> (16 * t + 4 * fq)) & 15u) << 4)); } } while (0)
#define AT_LDV(va_, slot_, vkh_) do { const LAS unsigned char* vb_ = lds + AT_HIST + (slot_) * 32768 + 16384 + (vkh_) * 8192; \
          _Pragma("unroll") for (int dt = 0; dt < 4; ++dt) { const int r1 = 4 * fq + (qi >> 2); const int ch_ = g * 8 + 2 * dt + ((lane & 3) >> 1); \
              const s4_t lo = __builtin_amdgcn_ds_read_tr16_b64_v4i16((LAS s4_t*)(vb_ + r1 * 256 + ((ch_ ^ (2 * (r1 & 7))) << 4) + (lane & 1) * 8)); \
              const s4_t hi4 = __builtin_amdgcn_ds_read_tr16_b64_v4i16((LAS s4_t*)(vb_ + (r1 + 16) * 256 + ((ch_ ^ (2 * (r1 & 7))) << 4) + (lane & 1) * 8)); \
              va_[dt] = (bf16x8){lo[0], lo[1], lo[2], lo[3], hi4[0], hi4[1], hi4[2], hi4[3]}; } } while (0)
#define AT_QKM(dst_, kf_, ci_) do { \
          _Pragma("unroll") for (int t = 0; t < 2; ++t) { \
              _Pragma("unroll") for (int hi = 0; hi < 2; ++hi) { const f32x4 d_ = MFMA16(kf_[t][0], qa[hi], ci_[t]); dst_[hi][t] = MFMA16(kf_[t][1], qb[hi], d_); } } } while (0)
#define AT_EXP(pb_, cur_) do { \
          _Pragma("unroll") for (int hi = 0; hi < 2; ++hi) { float pv[8]; \
              _Pragma("unroll") for (int j = 0; j < 8; ++j) pv[j] = __builtin_amdgcn_exp2f(cur_[hi][j >> 2][j & 3]); \
              v4u pw; pw.x = pk2(pv[0], pv[1]); pw.y = pk2(pv[2], pv[3]); pw.z = pk2(pv[4], pv[5]); pw.w = pk2(pv[6], pv[7]); pb_[hi] = __builtin_bit_cast(bf16x8, pw); } } while (0)
#define AT_PV(pb_, va_) do { \
          _Pragma("unroll") for (int hi = 0; hi < 2; ++hi) lacc[hi] = MFMA16(ones, pb_[hi], lacc[hi]); \
          _Pragma("unroll") for (int dt = 0; dt < 4; ++dt) { \
              _Pragma("unroll") for (int hi = 0; hi < 2; ++hi) oacc[hi][dt] = MFMA16(va_[dt], pb_[hi], oacc[hi][dt]); } } while (0)
      f32x4 st0[2][2], st1[2][2]; bf16x8 kfA[2][2], kfB[2][2]; f32x4 ciA[2], ciB[2]; bf16x8 vaP[4], vaQ[4], pbP[2], pbQ[2];
      if (NS >= 3) asm volatile("s_waitcnt vmcnt(8)" ::: "memory"); else asm volatile("s_waitcnt vmcnt(0)" ::: "memory");
      __builtin_amdgcn_s_barrier(); asm volatile("" ::: "memory");
      unsigned m1A, m1B;
      { const unsigned m0A = mrow[0], m0B = mrow[1]; const int sx = (NS > 1) ? 1 : 0; m1A = mrow[2 * sx]; m1B = mrow[2 * sx + 1];
        AT_LDK(kfB, ciB, 0, 0, m0A); AT_LDK(kfA, ciA, 0, 1, m0B);
        AT_QKM(st0, kfB, ciB);
#pragma unroll
        for (int hi = 0; hi < 2; ++hi) pbP[hi] = (bf16x8){0, 0, 0, 0, 0, 0, 0, 0};
#pragma unroll
        for (int dt = 0; dt < 4; ++dt) vaP[dt] = (bf16x8){0, 0, 0, 0, 0, 0, 0, 0}; }
#pragma unroll 1
      for (int s = 0; s < NS; ++s) {
          if (s + 2 < NS) asm volatile("s_waitcnt vmcnt(4)" ::: "memory"); else asm volatile("s_waitcnt vmcnt(0)" ::: "memory");
          __builtin_amdgcn_s_barrier(); asm volatile("" ::: "memory");
          if (s + 3 < NS) AT_STAGE(s + 3);
          const int s1 = (s + 1 < NS) ? s + 1 : s, s2 = (s + 2 < NS) ? s + 2 : NS - 1;
          const unsigned m2A = mrow[2 * s2], m2B = mrow[2 * s2 + 1];
          AT_LDK(kfB, ciB, (s1 & 3), 0, m1A); AT_LDV(vaQ, (s & 3), 0);
          AT_QKM(st1, kfA, ciA); AT_EXP(pbQ, st0); AT_PV(pbP, vaP);
          __builtin_amdgcn_sched_barrier(0);
          AT_LDK(kfA, ciA, (s1 & 3), 1, m1B); AT_LDV(vaP, (s & 3), 1);
          AT_QKM(st0, kfB, ciB); AT_EXP(pbP, st1); AT_PV(pbQ, vaQ);
          __builtin_amdgcn_sched_barrier(0);
          m1A = m2A; m1B = m2B; }
      AT_PV(pbP, vaP);
#undef AT_LDK
#undef AT_LDV
#undef AT_QKM
#undef AT_EXP
#undef AT_PV
      { AT_LAUNDER();
#pragma unroll
        for (int hi = 0; hi < 2; ++hi) { const float inv = 1.0f / lacc[hi][0];
            bf16* yp = YATT + (tb + q0u + 16 * qh + qi) * 512 + (g * 4 + 2 * hp + hi) * 64 + 4 * fq;
#pragma unroll
            for (int dt = 0; dt < 4; ++dt) { const f32x4 o = oacc[hi][dt];
                v2u w; w.x = pk2(o[0] * inv, o[1] * inv); w.y = pk2(o[2] * inv, o[3] * inv); *(v2u*)(yp + 16 * dt) = w; } } }
#undef AT_STAGE
    }
    __syncthreads();
    }
#undef AT_LAUNDER
    __syncthreads();
}

#ifndef DBG_REP_ML
#define DBG_REP_ML 1
#endif
#ifndef DBG_REP_ATT
#define DBG_REP_ATT 1
#endif
__device__ __forceinline__ void p3_mixer(const Args& a, const Ctx& c, volatile LAS unsigned* MISC, int rep) {
#if !defined(NO_MLSTM)
#pragma unroll 1
    for (int rr = 0; rr < DBG_REP_ML; ++rr)
#pragma unroll 1
        for (int u = blockIdx.x; u < 32; u += c.G) mlstm_unit<0>(a, c, u >> 2, u & 3, 0);
#endif
    unsigned* ctl = (unsigned*)(a.ws + WS_CTL);
    const int x = (int)(__builtin_amdgcn_s_getreg((3 << 11) | 20) & 7u);
    float cshift;
    { float gq = fabsf(a.in[IN_GQ][c.lane]), gk = fabsf(a.in[IN_GK][c.lane]);
#pragma unroll
      for (int o = 1; o < 64; o <<= 1) { gq = fmaxf(gq, __shfl_xor(gq, o)); gk = fmaxf(gk, __shfl_xor(gk, o)); }
      cshift = 8.0f * 1.4426950408889634f * gq * gk; }
#pragma unroll 1
    for (int rot = 0; rot < 8 * DBG_REP_ATT; ++rot) { rep = rot >> 3; const int bq = (x + rot) & 7;
        if (c.tid == 0) MISC[16] = __hip_atomic_fetch_add(ctl + CW_Q + 512 * rep + 64 * bq, 1u, RLX_AGENT);
        __syncthreads();
        int u = (int)MISC[16];
        __syncthreads();
#pragma unroll 1
        while (u < 128) {
            unsigned nxt = 0u;
            if (c.tid == 0) nxt = __hip_atomic_fetch_add(ctl + CW_Q + 512 * rep + 64 * bq, 1u, RLX_AGENT);
#if !defined(NO_ATTN)
            attn_unit(a, c, bq, 127 - u, cshift);
#endif
            if (c.tid == 0) MISC[16] = nxt;
            __syncthreads();
            u = (int)MISC[16];
            __syncthreads();
        } }
}
constexpr int RT_WT = 0;
constexpr int RT_WROW = 1028;
constexpr int RT_WBYTES = 36 * RT_WROW * 4;
constexpr int RT_NPIECE = (RT_WBYTES + 1023) / 1024;
constexpr int RT_LG = 0;
constexpr int RT_RSTD = RT_NPIECE * 1024;
constexpr int RT_LCNT = RT_RSTD + 512;
constexpr int RT_BIAS = RT_LCNT + 128;
static_assert(RT_BIAS + 144 <= MISC_OFF, "router LDS map");
__device__ __forceinline__ void p6_router(const Args& a, const Ctx& c) {
    const int tid = c.tid, lane = c.lane, wave = c.wave; LAS unsigned char* lds = c.lds;
    LAS float* WT = (LAS float*)(lds + RT_WT); LAS float* LG = (LAS float*)(lds + RT_LG); LAS float* RSTD = (LAS float*)(lds + RT_RSTD); LAS int* LCNT = (LAS int*)(lds + RT_LCNT); LAS float* BIAS = (LAS float*)(lds + RT_BIAS);
    { int* RT = (int*)(a.ws + WS_ROWTOK); for (int i = blockIdx.x * 512 + tid; i < NROWS_MAX; i += c.G * 512) RT[i] = 0; }
    if (tid < 36) BIAS[tid] = tid < 32 ? a.in[IN_BRE][tid] : a.in[IN_BRG][tid - 32];
    f32x4 gv[4];
#pragma unroll
    for (int j = 0; j < 4; ++j) gv[j] = *(const f32x4*)(a.in[IN_GMOE] + 4 * lane + 256 * j);
    const float* X1 = a.out; bf16* XN = (bf16*)(a.ws + WS_XN);
    int* TOKE = (int*)(a.ws + WS_TOKE); int* TOKR = (int*)(a.ws + WS_TOKR); float* TOKG = (float*)(a.ws + WS_TOKG); int* CNT = (int*)(a.ws + WS_CNT);
    for (int blk = blockIdx.x; blk < 256; blk += c.G) {
        __syncthreads();
        { const unsigned char* src = a.ws + WS_WTG;
#pragma unroll 1
          for (int pc = wave; pc < RT_NPIECE; pc += NWAVES)
              __builtin_amdgcn_global_load_lds((const unsigned*)(src + (size_t)pc * 1024 + lane * 16), (LAS unsigned*)(lds + RT_WT + pc * 1024), 16, 0, 0); }
        if (tid < 32) LCNT[tid] = 0;
#pragma unroll 1
        for (int ri = 0; ri < 16; ri += 4) { const int t0 = blk * 128 + wave * 16 + ri;
            f32x4 v[4][4]; float ss[4];
#pragma unroll
            for (int q = 0; q < 4; ++q) { const f32x4* xp = (const f32x4*)(X1 + (size_t)(t0 + q) * D) + lane;
#pragma unroll
                for (int j = 0; j < 4; ++j) v[q][j] = xp[64 * j]; }
#pragma unroll
            for (int q = 0; q < 4; ++q) { float sq = 0.f;
#pragma unroll
                for (int j = 0; j < 4; ++j) sq += (v[q][j].x * v[q][j].x + v[q][j].y * v[q][j].y) + (v[q][j].z * v[q][j].z + v[q][j].w * v[q][j].w);
                ss[q] = rsqrtf(wave_sum(sq) * (1.f / D) + EPS); }
            if (lane < 4) RSTD[wave * 16 + ri + lane] = (lane == 0) ? ss[0] : ((lane == 1) ? ss[1] : ((lane == 2) ? ss[2] : ss[3]));
#pragma unroll
            for (int q = 0; q < 4; ++q) { v2u* op = (v2u*)(XN + (size_t)(t0 + q) * D) + lane; const float r = ss[q];
#pragma unroll
                for (int j = 0; j < 4; ++j) { v2u w; w.x = pk2(v[q][j].x * r * gv[j].x, v[q][j].y * r * gv[j].y); w.y = pk2(v[q][j].z * r * gv[j].z, v[q][j].w * r * gv[j].w); op[64 * j] = w; } } }
        asm volatile("s_waitcnt vmcnt(0)" ::: "memory");
        __syncthreads();
        f32x4 acc[3];
#pragma unroll
        for (int ct = 0; ct < 3; ++ct) acc[ct] = (f32x4){0.f, 0.f, 0.f, 0.f};
        { const int row = lane & 15, kq = lane >> 4;
          const f32x4* ap = (const f32x4*)(X1 + (size_t)(blk * 128 + wave * 16 + row) * D + 4 * kq);
          int cj[3]; cj[0] = row; cj[1] = 16 + row; cj[2] = (32 + row) < 36 ? (32 + row) : 35;
          const LAS f32x4* bp0 = (const LAS f32x4*)(WT + cj[0] * RT_WROW + 4 * kq); const LAS f32x4* bp1 = (const LAS f32x4*)(WT + cj[1] * RT_WROW + 4 * kq); const LAS f32x4* bp2 = (const LAS f32x4*)(WT + cj[2] * RT_WROW + 4 * kq);
#define RT_LOADA(dst_, b_) do { _Pragma("unroll") for (int i_ = 0; i_ < 8; ++i_) dst_[i_] = ap[4 * (8 * ((b_) < 8 ? (b_) : 7) + i_)]; } while (0)
#define RT_MMA(src_, b_) do { _Pragma("unroll") for (int i_ = 0; i_ < 8; ++i_) { const int ks_ = 8 * (b_) + i_; const f32x4 b0 = bp0[4 * ks_], b1 = bp1[4 * ks_], b2 = bp2[4 * ks_]; \
              _Pragma("unroll") for (int j = 0; j < 4; ++j) { acc[0] = __builtin_amdgcn_mfma_f32_16x16x4f32(src_[i_][j], b0[j], acc[0], 0, 0, 0); acc[1] = __builtin_amdgcn_mfma_f32_16x16x4f32(src_[i_][j], b1[j], acc[1], 0, 0, 0); \
                  acc[2] = __builtin_amdgcn_mfma_f32_16x16x4f32(src_[i_][j], b2[j], acc[2], 0, 0, 0); } } } while (0)
          f32x4 aA[8], aB[8]; RT_LOADA(aA, 0);
#pragma unroll 1
          for (int bb = 0; bb < 8; bb += 2) { RT_LOADA(aB, bb + 1); RT_MMA(aA, bb); RT_LOADA(aA, bb + 2); RT_MMA(aB, bb + 1); }
#undef RT_LOADA
#undef RT_MMA
        }
        __syncthreads();
        { const int col = lane & 15, kq = lane >> 4;
#pragma unroll
          for (int ct = 0; ct < 3; ++ct) if (16 * ct + col < 36) {
#pragma unroll
              for (int r = 0; r < 4; ++r) LG[(wave * 16 + 4 * kq + r) * 36 + 16 * ct + col] = acc[ct][r]; } }
        __syncthreads();
        if (tid < 128) { const int row = tid, t = blk * 128 + row; const float rs = RSTD[row]; const LAS float* lg = LG + tid * 36;
            float gl[4];
#pragma unroll
            for (int i = 0; i < 4; ++i) gl[i] = rs * lg[32 + i] + BIAS[32 + i];
            int gs = 0; float gmax = gl[0];
#pragma unroll
            for (int i = 1; i < 4; ++i) if (gl[i] > gmax) { gmax = gl[i]; gs = i; }
            float gsum = 0.f;
#pragma unroll
            for (int i = 0; i < 4; ++i) gsum += expf(gl[i] - gmax);
            const float gtop = 1.0f / gsum;
            float ev[8];
#pragma unroll
            for (int i = 0; i < 8; ++i) ev[i] = rs * lg[gs * 8 + i] + BIAS[gs * 8 + i];
            int l0 = 0; float v0 = ev[0];
#pragma unroll
            for (int i = 1; i < 8; ++i) if (ev[i] > v0) { v0 = ev[i]; l0 = i; }
            int l1 = -1; float v1 = -3.0e38f;
#pragma unroll
            for (int i = 0; i < 8; ++i) if (i != l0 && ev[i] > v1) { v1 = ev[i]; l1 = i; }
            const float e1 = expf(v1 - v0), s0 = 1.0f / (1.0f + e1), s1 = e1 * s0;
            const int ex0 = gs * 8 + l0, ex1 = gs * 8 + l1;
            const int rk0 = __hip_atomic_fetch_add(&LCNT[ex0], 1, __ATOMIC_RELAXED, __HIP_MEMORY_SCOPE_WORKGROUP);
            const int rk1 = __hip_atomic_fetch_add(&LCNT[ex1], 1, __ATOMIC_RELAXED, __HIP_MEMORY_SCOPE_WORKGROUP);
            TOKE[2 * t] = ex0; TOKE[2 * t + 1] = ex1; TOKR[2 * t] = rk0; TOKR[2 * t + 1] = rk1; TOKG[2 * t] = s0 * gtop; TOKG[2 * t + 1] = s1 * gtop; }
        __syncthreads();
        if (tid < 32) CNT[blk * 32 + tid] = LCNT[tid];
    }
}
__device__ __forceinline__ void p7_gather(const Args& a, const Ctx& c) {
    const int tid = c.tid, lane = c.lane, wave = c.wave;
    LAS int* PART = (LAS int*)c.lds; LAS int* PPRE = PART + 512; LAS int* TOT = PPRE + 512; LAS int* TS = TOT + 32; LAS int* BASE = TS + 64;
    const int* CNT = (const int*)(a.ws + WS_CNT); const int* TOKE = (const int*)(a.ws + WS_TOKE); const int* TOKR = (const int*)(a.ws + WS_TOKR); int* TOKP = (int*)(a.ws + WS_TOKP);
    int* RT = (int*)(a.ws + WS_ROWTOK);
    { const int e = tid & 31, p = tid >> 5; int s = 0; for (int k = 0; k < 16; ++k) s += CNT[(16 * p + k) * 32 + e]; PART[p * 32 + e] = s; }
    __syncthreads();
    if (tid < 32) { int run = 0; for (int p = 0; p < 16; ++p) { PPRE[p * 32 + tid] = run; run += PART[p * 32 + tid]; } TOT[tid] = run; }
    __syncthreads();
    if (tid == 0) { int ts = 0; for (int e = 0; e < 32; ++e) { TS[e] = ts; ts += (TOT[e] + 255) >> 8; } TS[32] = ts; }
    __syncthreads();
    if (blockIdx.x == 0 && tid < 33) ((int*)(a.ws + WS_SMALL))[tid] = TS[tid];
    for (int blk = blockIdx.x; blk < 256; blk += c.G) {
        if (tid < 32) { int s = TS[tid] * 256 + PPRE[(blk >> 4) * 32 + tid]; for (int b2 = (blk & ~15); b2 < blk; ++b2) s += CNT[b2 * 32 + tid]; BASE[tid] = s; }
        __syncthreads();
        { const int t = blk * 128 + (tid >> 2), jj = tid & 3;
          if (jj < 2) { const int pos = BASE[TOKE[2 * t + jj]] + TOKR[2 * t + jj]; TOKP[2 * t + jj] = pos; RT[pos] = t; } }
        __syncthreads();
    }
}
__device__ __forceinline__ void p10_combine(const Args& a, const Ctx& c) {
    const int lane = c.lane, gw = c.vcu * NWAVES + c.wave, NGW = c.G * NWAVES;
    const int* TOKP = (const int*)(a.ws + WS_TOKP); const float* TOKG = (const float*)(a.ws + WS_TOKG); const bf16* Y = (const bf16*)(a.ws + WS_Y);
    for (int t0 = gw; t0 < T; t0 += 2 * NGW) {
        const int tA = t0, tB = (t0 + NGW < T) ? t0 + NGW : t0; const bool hasB = (t0 + NGW < T);
        const int pA0 = TOKP[2 * tA], pA1 = TOKP[2 * tA + 1], pB0 = TOKP[2 * tB], pB1 = TOKP[2 * tB + 1];
        const float gA0 = TOKG[2 * tA], gA1 = TOKG[2 * tA + 1], gB0 = TOKG[2 * tB], gB1 = TOKG[2 * tB + 1];
        f32x4 xa[4], xb[4]; v2u ya0[4], ya1[4], yb0[4], yb1[4];
#pragma unroll
        for (int j = 0; j < 4; ++j) { const int cc = 4 * lane + 256 * j;
            xa[j] = *(const f32x4*)(a.out + (size_t)tA * D + cc); xb[j] = *(const f32x4*)(a.out + (size_t)tB * D + cc);
            ya0[j] = *(const v2u*)(Y + (size_t)pA0 * D + cc); ya1[j] = *(const v2u*)(Y + (size_t)pA1 * D + cc);
            yb0[j] = *(const v2u*)(Y + (size_t)pB0 * D + cc); yb1[j] = *(const v2u*)(Y + (size_t)pB1 * D + cc); }
#pragma unroll
        for (int j = 0; j < 4; ++j) { const int cc = 4 * lane + 256 * j; f32x4 x = xa[j];
            x[0] += gA0 * bf2f(ya0[j].x & 0xffffu) + gA1 * bf2f(ya1[j].x & 0xffffu); x[1] += gA0 * bf2f(ya0[j].x >> 16) + gA1 * bf2f(ya1[j].x >> 16);
            x[2] += gA0 * bf2f(ya0[j].y & 0xffffu) + gA1 * bf2f(ya1[j].y & 0xffffu); x[3] += gA0 * bf2f(ya0[j].y >> 16) + gA1 * bf2f(ya1[j].y >> 16);
            *(f32x4*)(a.out + (size_t)tA * D + cc) = x; }
        if (hasB) {
#pragma unroll
        for (int j = 0; j < 4; ++j) { const int cc = 4 * lane + 256 * j; f32x4 x = xb[j];
            x[0] += gB0 * bf2f(yb0[j].x & 0xffffu) + gB1 * bf2f(yb1[j].x & 0xffffu); x[1] += gB0 * bf2f(yb0[j].x >> 16) + gB1 * bf2f(yb1[j].x >> 16);
            x[2] += gB0 * bf2f(yb0[j].y & 0xffffu) + gB1 * bf2f(yb1[j].y & 0xffffu); x[3] += gB0 * bf2f(yb0[j].y >> 16) + gB1 * bf2f(yb1[j].y >> 16);
            *(f32x4*)(a.out + (size_t)tB * D + cc) = x; } }
    }
}
__global__ void __launch_bounds__(NWAVES * 64, 2) hybrid_fwd(Args args) {
    extern __shared__ __attribute__((aligned(16))) unsigned char lds_raw[];
    Ctx c; c.lds = (LAS unsigned char*)lds_raw;
    volatile LAS unsigned* MISC = (volatile LAS unsigned*)(c.lds + MISC_OFF);
    c.tid = threadIdx.x; c.lane = c.tid & 63; c.wave = __builtin_amdgcn_readfirstlane(c.tid >> 6);
    c.G = gridDim.x; { const int bx = blockIdx.x; c.vcu = (c.G % 8 == 0) ? (bx % 8) * (c.G / 8) + bx / 8 : bx; }
    unsigned* ctl = (unsigned*)(args.ws + WS_CTL);
    if (c.tid < 128) MISC[c.tid] = 0u;
    __syncthreads();
    XcdBarrier bar; bar.bar = ctl + CW_BAR; bar.x = 0; bar.st = nullptr;
    if (N_LAUNCHES == 1) bar = xcd_barrier_post(ctl + CW_BAR, MISC + 8);
#define GRID_BAR() do { if (N_LAUNCHES == 1) xcd_barrier(bar); } while (0)
    const int lo = args.ph_lo, hi = args.ph_hi;
#ifndef PH_MASK
#define PH_MASK 0xfff
#endif
#define IN(k) (((PH_MASK >> (k)) & 1) && lo <= (k) && (k) < hi)
#define BOTH(k) (IN(k) && IN((k) + 1))
    unsigned char* ws = args.ws; unsigned char* dout = (unsigned char*)args.out;
#ifndef DBG_REPEAT
#define DBG_REPEAT -1
#endif
#define REPS(k) (((k) == DBG_REPEAT) ? 2 : 1)
#if DBG_REPEAT == 5
#define RB5 _Pragma("unroll 1") for (int rep5 = 0; rep5 < 2; ++rep5) { if (rep5) GRID_BAR();
#define RE5 }
#else
#define RB5
#define RE5
#endif
#if DBG_REPEAT == 6
#define RB6 _Pragma("unroll 1") for (int rep6 = 0; rep6 < 2; ++rep6) { if (rep6) GRID_BAR();
#define RE6 }
#else
#define RB6
#define RE6
#endif
    if (IN(0)) { _Pragma("unroll") for (int rep = 0; rep < REPS(0); ++rep) { if (rep) GRID_BAR(); p0_prologue<0>(args, c, c.vcu * NWAVES + c.wave, c.G * NWAVES); } if (BOTH(0)) GRID_BAR(); }
    if (IN(1)) { _Pragma("unroll") for (int rep = 0; rep < REPS(1); ++rep) { if (rep) GRID_BAR();
#ifdef DBG_STAGGER
        if ((blockIdx.x >> 3) & 1) { const unsigned long long t0 = wall_clock64(); while (wall_clock64() - t0 < (unsigned long long)DBG_STAGGER) __builtin_amdgcn_s_sleep(16); }
#endif
        pg8::Gemm g{(const pg8::bf16_t*)(dout + DO_H), (const pg8::bf16_t*)(ws + WS_WIN), T, NPROJ, D}; pg8::StaticOrder S; S.init(T, NPROJ, c.G, (int)blockIdx.x);
        pg8::EpiBf16<0> E{(pg8::bf16_t*)(ws + WS_PROJ), 256, nullptr, 256, (size_t)T * 256, 1.f};
        pg8::gemm_phase<pg8::EpiBf16<0>, pg8::StaticOrder, true, true>(c.lds, g, S, E); }
        if (BOTH(1)) GRID_BAR();
    }
#ifndef DBG_R2
#define DBG_R2 1
#endif
#ifndef DBG_R4A
#define DBG_R4A 1
#endif
#ifndef DBG_R4B
#define DBG_R4B 1
#endif
#ifndef DBG_R7
#define DBG_R7 1
#endif
    if (IN(2)) { _Pragma("unroll 1") for (int rep = 0; rep < DBG_R2; ++rep) { if (rep) GRID_BAR(); p2_prep(args, c); } if (BOTH(2)) GRID_BAR(); }
    if (IN(3)) { _Pragma("unroll") for (int rep = 0; rep < REPS(3); ++rep) { if (rep) GRID_BAR(); p3_mixer(args, c, MISC, rep); } if (BOTH(3)) GRID_BAR(); }
    if (IN(4)) {
#pragma unroll 1
        for (int rep = 0; rep < DBG_R4A; ++rep) {
            const int gw = c.vcu * NWAVES + c.wave, ngw = c.G * NWAVES, kdone = ((int)blockIdx.x < 256) ? 24 : 0;
            LAS float* scr = (LAS float*)(c.lds + CV_SCR + c.wave * CV_SCRW);
#pragma unroll 1
            for (int k = kdone; gw + k * ngw < CV_NMI; ++k) { const CvItem it = cv_item(args, gw + k * ngw); f32x4 v[4]; cv_load(it, v, c.lane); cv_finish(it, v, scr, c.lane, true); }
            __syncthreads(); }
#pragma unroll 1
        for (int rep = 0; rep < DBG_R4B; ++rep)
#pragma unroll 1
        for (int u = blockIdx.x; u < 256; u += c.G) mlstm_unit<1>(args, c, u >> 5, (u >> 3) & 3, u & 7);
        if (BOTH(4)) GRID_BAR();
    }
    if (IN(5)) { RB5
#ifdef DBG_STAG5
        if ((blockIdx.x >> 3) & 1) { const unsigned long long t0 = wall_clock64(); while (wall_clock64() - t0 < (unsigned long long)DBG_STAG5) __builtin_amdgcn_s_sleep(16); }
#endif
        { pg8::Gemm g{(const pg8::bf16_t*)(dout + DO_YATT), (const pg8::bf16_t*)(ws + WS_WPA), T, D, 512}; pg8::StaticOrder S; S.init(T, D, c.G, (int)blockIdx.x);
          pg8::EpiGate<false> E{(pg8::bf16_t*)(ws + WS_MERGED), D, (const pg8::bf16_t*)(ws + WS_PROJ + (size_t)TL_GA * PROJ_TILE), (size_t)T * 256};
          pg8::gemm_phase<pg8::EpiGate<false>, pg8::StaticOrder, true, true>(c.lds, g, S, E); }
        __syncthreads();
        { pg8::Gemm g{(const pg8::bf16_t*)(dout + DO_YML), (const pg8::bf16_t*)(ws + WS_WPM), T, D, 512}; pg8::StaticOrder S; S.init(T, D, c.G, (int)blockIdx.x);
          pg8::EpiGate<true> E{(pg8::bf16_t*)(ws + WS_MERGED), D, (const pg8::bf16_t*)(ws + WS_PROJ + (size_t)TL_GM * PROJ_TILE), (size_t)T * 256};
          pg8::gemm_phase<pg8::EpiGate<true>, pg8::StaticOrder, true, true>(c.lds, g, S, E); } RE5
        if (BOTH(5)) GRID_BAR();
    }
    if (IN(6)) { RB6
#ifdef DBG_STAG6
        if ((blockIdx.x >> 3) & 1) { const unsigned long long t0 = wall_clock64(); while (wall_clock64() - t0 < (unsigned long long)DBG_STAG6) __builtin_amdgcn_s_sleep(16); }
#endif
        pg8::Gemm g{(const pg8::bf16_t*)(ws + WS_MERGED), (const pg8::bf16_t*)(ws + WS_WOUT), T, D, D}; pg8::StaticOrder S; S.init(T, D, c.G, (int)blockIdx.x);
        pg8::EpiRes E{args.out, args.in[IN_X], D};
        pg8::gemm_phase<pg8::EpiRes, pg8::StaticOrder, true, true>(c.lds, g, S, E); RE6
        if (BOTH(6)) GRID_BAR();
    }
    if (IN(7)) { _Pragma("unroll 1") for (int rep = 0; rep < DBG_R7; ++rep) { if (rep) { GRID_BAR(); } p6_router(args, c); } if (BOTH(7)) GRID_BAR(); }
    if (IN(8)) { _Pragma("unroll") for (int rep = 0; rep < REPS(8); ++rep) { if (rep) GRID_BAR(); p7_gather(args, c); } if (BOTH(8)) GRID_BAR(); }
    if (IN(9) || IN(10)) {
        LAS int* TSL = (LAS int*)(c.lds + MISC_OFF + 256);
        LAS int* XS = (LAS int*)(c.lds + MISC_OFF + 400);
        if (c.tid < 33) TSL[c.tid] = (int)__hip_atomic_load((unsigned*)(ws + WS_SMALL) + c.tid, RLX_AGENT);
        if (c.tid == 64) { const int ntt = (int)__hip_atomic_load((unsigned*)(ws + WS_SMALL) + 32, RLX_AGENT); int lo_t = 0, hi_t = ntt, nl = c.G, lx = (int)blockIdx.x;
            if (N_LAUNCHES == 1) { unsigned pre = 0u, mine = 0u;
                for (unsigned j = 0; j < 16; ++j) { const unsigned cj = xb_ld(&bar.bar[XB_XCNT(j)]); pre += (j < bar.x) ? cj : 0u; mine = (j == bar.x) ? cj : mine; }
                nl = (int)mine; lx = (int)MISC[20]; lo_t = (int)((long)ntt * pre / c.G); hi_t = (int)((long)ntt * (pre + mine) / c.G); }
            XS[0] = lo_t; XS[1] = hi_t; XS[2] = nl; XS[3] = lx; }
        __syncthreads();
        const int xs_lo = XS[0], xs_hi = XS[1], xs_nl = XS[2], xs_lx = XS[3];
        if (IN(9)) {
            pg8::MoeOrder<true> S{TSL, xs_nl, xs_lx, xs_lo, xs_hi, (const int*)(ws + WS_ROWTOK), (unsigned*)(ws + WS_CTL) + CW_RDY};
            pg8::Gemm g{(const pg8::bf16_t*)(ws + WS_XN), (const pg8::bf16_t*)(ws + WS_GU), 0, 0, D};
            pg8::EpiSwiGLU E{(pg8::bf16_t*)(ws + WS_HID)};
            pg8::gemm_phase<pg8::EpiSwiGLU, pg8::MoeOrder<true>, true, true>(c.lds, g, S, E);
            if (BOTH(9)) __syncthreads();
        }
        if (IN(10)) {
            pg8::MoeOrder<false> S{TSL, xs_nl, xs_lx, xs_lo, xs_hi, nullptr, (unsigned*)(ws + WS_CTL) + CW_RDY};
            pg8::Gemm g{(const pg8::bf16_t*)(ws + WS_HID), (const pg8::bf16_t*)(ws + WS_DN), 0, 0, 512};
            pg8::EpiDown E{(pg8::bf16_t*)(ws + WS_Y)};
            pg8::gemm_phase<pg8::EpiDown, pg8::MoeOrder<false>, true, true>(c.lds, g, S, E);
            if (BOTH(10)) GRID_BAR();
        }
    }
    if (IN(11)) p10_combine(args, c);
#undef IN
#undef BOTH
#undef GRID_BAR
}

extern "C" void kernel_launch(void* const* d_in, const int* in_sizes, int n_in, void* d_out, int out_size, void* d_ws, size_t ws_size, hipStream_t stream) {
    static int grid = 0;
    if (grid == 0) {
        if (n_in != 22 || in_sizes[0] != T * D || out_size != T * D || ws_size < WS_END) { fprintf(stderr, "kernel_launch: unexpected shapes (n_in %d, in0 %d, out %d, ws %zu); nothing launched\n", n_in, n_in > 0 ? in_sizes[0] : -1, out_size, ws_size); grid = -1; return; }
        int dev = 0, cus = 0, per_cu = 0;
        if (hipGetDevice(&dev) != hipSuccess || hipDeviceGetAttribute(&cus, hipDeviceAttributeMultiprocessorCount, dev) != hipSuccess) { grid = -1; return; }
        if (hipFuncSetAttribute((const void*)hybrid_fwd, hipFuncAttributeMaxDynamicSharedMemorySize, LDS_BYTES) != hipSuccess) { fprintf(stderr, "kernel_launch: hipFuncSetAttribute failed\n"); grid = -1; return; }
        if (hipOccupancyMaxActiveBlocksPerMultiprocessor(&per_cu, (const void*)hybrid_fwd, NWAVES * 64, LDS_BYTES) != hipSuccess || per_cu < 1)
            fprintf(stderr, "kernel_launch: note: occupancy query reports %d workgroups per CU\n", per_cu);
        (void)hipGetLastError();
        grid = cus;
    }
    if (grid < 0) return;
    if (hipMemsetAsync((char*)d_ws + WS_CTL, 0, CTL_ZERO_BYTES, stream) != hipSuccess) return;
    Args a{};
    for (int i = 0; i < 22; ++i) a.in[i] = (const float*)d_in[i];
    a.out = (float*)d_out; a.ws = (unsigned char*)d_ws;
    for (int li = 0; li < N_LAUNCHES; ++li) {
        a.ph_lo = (N_LAUNCHES == 1) ? 0 : li; a.ph_hi = (N_LAUNCHES == 1) ? NPH : li + 1; a.li = li;
        hipLaunchKernelGGL(hybrid_fwd, dim3(grid), dim3(NWAVES * 64), LDS_BYTES, stream, a);
        if (hipPeekAtLastError() != hipSuccess) { fprintf(stderr, "kernel_launch: launch %d failed\n", li); break; }
    }
}
```

```cpp
#include <hip/hip_runtime.h>
#include <cstdio>
#include <cstdint>
namespace pg8 {
#define PG8_LAS __attribute__((address_space(3)))
typedef unsigned short bf16_t;
typedef short bf16x8 __attribute__((ext_vector_type(8)));
typedef float f32x4 __attribute__((ext_vector_type(4)));
typedef unsigned u32x4 __attribute__((ext_vector_type(4)));
constexpr int BM = 256, BK = 64, HALF = 128, HTB = HALF * BK * 2  , STAGE_BYTES = 8 * HTB, NXCD = 8, WGM = 8;

__host__ __device__ __forceinline__ int lds_byte(int r, int c) { const int st = (r >> 4) * 2 + (c >> 5), rr = r & 15, cc = c & 31, ob = rr * 64 + cc * 2; return st * 1024 + (ob ^ (((ob >> 9) & 1) << 5)); }
__host__ __device__ __forceinline__ void stage_rc(int b, int& R, int& C) { const int st = b / 1024, sb = b % 1024, swz = sb ^ (((sb >> 9) & 1) << 5); R = (st >> 1) * 16 + swz / 64; C = (st & 1) * 32 + (swz % 64) / 2; }
__host__ __device__ __forceinline__ int perm32(int rho) { const int n = rho >> 4, i = rho & 15; return 8 * (i >> 2) + 4 * n + (i & 3); }

struct Unit { int pm, pn; };
struct Gemm { const bf16_t* A; const bf16_t* Bt; int M, N, K; const bf16_t* A2 = nullptr; const bf16_t* Bt2 = nullptr; };

struct StaticOrder {
    static constexpr bool GATHER = false;
    int nM, nN, nwg, G, c;
    __host__ __device__ void init(int M, int N, int G_, int c_) { nM = M / BM; nN = N / BM; nwg = nM * nN; G = G_; c = c_; }
    __host__ __device__ bool next(int i, Unit& u) const {
        const long L = (long)i * G + c; if (L >= nwg) return false;
        int wgid = (int)L; { const int q = nwg / NXCD, r = nwg % NXCD, xcd = wgid % NXCD, off = wgid / NXCD; wgid = (xcd < r ? xcd * (q + 1) : r * (q + 1) + (xcd - r) * q) + off; }
        const int nig = WGM * nN, gid = wgid / nig, fm = gid * WGM, gsz = (nM - fm) < WGM ? (nM - fm) : WGM;
        u.pm = fm + ((wgid % nig) % gsz); u.pn = (wgid % nig) / gsz; return true;
    }
    __device__ __forceinline__ void a_ready(const Unit&) const {}
    __device__ __forceinline__ void done(const Unit&) const {}
};

typedef __bf16 bf2_t __attribute__((ext_vector_type(2)));
__device__ __forceinline__ unsigned cvt_pk_bf16(float lo, float hi) { bf2_t v; v[0] = (__bf16)lo; v[1] = (__bf16)hi; return __builtin_bit_cast(unsigned, v); }
typedef float f32x2 __attribute__((ext_vector_type(2)));
template <int ACT  > struct EpiBf16 {
    static constexpr bool PERM = true, AFTER_DRAIN = false; static_assert(ACT == 0, "EpiBf16: no activation here");
    bf16_t* O; int ldc; const float* bias; int split_cols; size_t split_stride; float scale0;
    __device__ __forceinline__ void operator()(const f32x4 (&acc)[2][2][4][2], const Unit& u, int wr, int wc, int fr, int fq) const {
        const int row0 = u.pm * BM + wr * 64 + fr; int colt = u.pn * BM; bf16_t* base = O;
        float sc = 1.f; if (split_cols) { const int t = colt / split_cols; base += (size_t)t * split_stride; colt -= t * split_cols; if (t == 0) sc = scale0; }
        const int col0 = colt + wc * 32 + 8 * fq, bcol0 = u.pn * BM + wc * 32 + 8 * fq;
        f32x4 bv[2][2];
#pragma unroll
        for (int bj = 0; bj < 2; ++bj)
#pragma unroll
            for (int n = 0; n < 2; ++n) bv[bj][n] = bias ? *(const f32x4*)(bias + bcol0 + bj * HALF + 4 * n) : (f32x4){0.f, 0.f, 0.f, 0.f};
#pragma unroll
        for (int ai = 0; ai < 2; ++ai)
#pragma unroll
            for (int m = 0; m < 4; ++m) { bf16_t* rowp = base + (size_t)(row0 + ai * HALF + m * 16) * ldc + col0;
#pragma unroll
                for (int bj = 0; bj < 2; ++bj) { f32x4 v0 = acc[ai][bj][m][0] + bv[bj][0], v1 = acc[ai][bj][m][1] + bv[bj][1];
                    v0 = v0 * sc; v1 = v1 * sc; u32x4 w; w.x = cvt_pk_bf16(v0[0], v0[1]); w.y = cvt_pk_bf16(v0[2], v0[3]); w.z = cvt_pk_bf16(v1[0], v1[1]); w.w = cvt_pk_bf16(v1[2], v1[3]);
                    *(u32x4*)(rowp + bj * HALF) = w; } }
    }
};
__device__ __forceinline__ float bf2f_(unsigned b16) { return __uint_as_float(b16 << 16); }
__device__ __forceinline__ float sigm_(float x) { return 1.0f / (1.0f + __expf(-x)); }
template <bool ADD> struct EpiGate {
    static constexpr bool PERM = true, AFTER_DRAIN = false;
    bf16_t* O; int ldc; const bf16_t* gate; size_t gstride;
    __device__ __forceinline__ void operator()(const f32x4 (&acc)[2][2][4][2], const Unit& u, int wr, int wc, int fr, int fq) const {
        const int row0 = u.pm * BM + wr * 64 + fr, colt = wc * 32 + 8 * fq;
        const bf16_t* gt = gate + (size_t)u.pn * gstride;
#pragma unroll
        for (int ai = 0; ai < 2; ++ai) {
            u32x4 gv[4][2], pp[4][2];
#pragma unroll
            for (int m = 0; m < 4; ++m) { const size_t row = (size_t)(row0 + ai * HALF + m * 16);
#pragma unroll
                for (int bj = 0; bj < 2; ++bj) { const int c = colt + bj * HALF; gv[m][bj] = *(const u32x4*)(gt + row * 256 + c);
                    if (ADD) pp[m][bj] = *(const u32x4*)(O + row * ldc + u.pn * BM + c); } }
#pragma unroll
            for (int m = 0; m < 4; ++m) { const size_t row = (size_t)(row0 + ai * HALF + m * 16);
#pragma unroll
                for (int bj = 0; bj < 2; ++bj) { const int c = colt + bj * HALF; const u32x4 g4 = gv[m][bj];
                    bf16_t* op = O + row * ldc + u.pn * BM + c;
                    float pv[8] = {0.f, 0.f, 0.f, 0.f, 0.f, 0.f, 0.f, 0.f};
                    if (ADD) { const u32x4 p = pp[m][bj]; pv[0] = bf2f_(p.x & 0xffffu); pv[1] = bf2f_(p.x >> 16); pv[2] = bf2f_(p.y & 0xffffu); pv[3] = bf2f_(p.y >> 16);
                        pv[4] = bf2f_(p.z & 0xffffu); pv[5] = bf2f_(p.z >> 16); pv[6] = bf2f_(p.w & 0xffffu); pv[7] = bf2f_(p.w >> 16); }
                    const f32x4 v0 = acc[ai][bj][m][0], v1 = acc[ai][bj][m][1];
                    float o[8];
                    o[0] = pv[0] + sigm_(bf2f_(g4.x & 0xffffu)) * v0[0]; o[1] = pv[1] + sigm_(bf2f_(g4.x >> 16)) * v0[1];
                    o[2] = pv[2] + sigm_(bf2f_(g4.y & 0xffffu)) * v0[2]; o[3] = pv[3] + sigm_(bf2f_(g4.y >> 16)) * v0[3];
                    o[4] = pv[4] + sigm_(bf2f_(g4.z & 0xffffu)) * v1[0]; o[5] = pv[5] + sigm_(bf2f_(g4.z >> 16)) * v1[1];
                    o[6] = pv[6] + sigm_(bf2f_(g4.w & 0xffffu)) * v1[2]; o[7] = pv[7] + sigm_(bf2f_(g4.w >> 16)) * v1[3];
                    u32x4 w; w.x = cvt_pk_bf16(o[0], o[1]); w.y = cvt_pk_bf16(o[2], o[3]); w.z = cvt_pk_bf16(o[4], o[5]); w.w = cvt_pk_bf16(o[6], o[7]);
                    *(u32x4*)op = w; } } }
    }
};
struct EpiGate2 {
    static constexpr bool PERM = true, AFTER_DRAIN = false;
    bf16_t* O; int ldc; const bf16_t* gate1; const bf16_t* gate2; size_t gstride;
    __device__ __forceinline__ void mid(f32x4 (&acc)[2][2][4][2], const Unit& u, int wr, int wc, int fr, int fq) const {
        const int row0 = u.pm * BM + wr * 64 + fr, colt = wc * 32 + 8 * fq;
        const bf16_t* g1 = gate1 + (size_t)u.pn * gstride; const bf16_t* g2 = gate2 + (size_t)u.pn * gstride;
#pragma unroll
        for (int ai = 0; ai < 2; ++ai)
#pragma unroll
          for (int bj = 0; bj < 2; ++bj) { u32x4 ga[4], gb[4]; const int c = colt + bj * HALF;
            int r0_ = row0; asm volatile("" : "+v"(r0_) :: "memory");
#pragma unroll
            for (int m = 0; m < 4; ++m) { const size_t row = (size_t)(r0_ + ai * HALF + m * 16); ga[m] = *(const u32x4*)(g1 + row * 256 + c); gb[m] = *(const u32x4*)(g2 + row * 256 + c); }
#pragma unroll
            for (int m = 0; m < 4; ++m) { const u32x4 x = ga[m], y = gb[m];
#define EG2_R(xa_, xb_) ((1.0f + __expf(-(xb_))) * __builtin_amdgcn_rcpf(1.0f + __expf(-(xa_))))
                    f32x4& v0 = acc[ai][bj][m][0]; f32x4& v1 = acc[ai][bj][m][1];
                    v0[0] *= EG2_R(bf2f_(x.x & 0xffffu), bf2f_(y.x & 0xffffu)); v0[1] *= EG2_R(bf2f_(x.x >> 16), bf2f_(y.x >> 16));
                    v0[2] *= EG2_R(bf2f_(x.y & 0xffffu), bf2f_(y.y & 0xffffu)); v0[3] *= EG2_R(bf2f_(x.y >> 16), bf2f_(y.y >> 16));
                    v1[0] *= EG2_R(bf2f_(x.z & 0xffffu), bf2f_(y.z & 0xffffu)); v1[1] *= EG2_R(bf2f_(x.z >> 16), bf2f_(y.z >> 16));
                    v1[2] *= EG2_R(bf2f_(x.w & 0xffffu), bf2f_(y.w & 0xffffu)); v1[3] *= EG2_R(bf2f_(x.w >> 16), bf2f_(y.w >> 16));
#undef EG2_R
            } }
    }
    __device__ __forceinline__ void operator()(const f32x4 (&acc)[2][2][4][2], const Unit& u, int wr, int wc, int fr, int fq) const {
        const int row0 = u.pm * BM + wr * 64 + fr, colt = wc * 32 + 8 * fq;
        const bf16_t* g2 = gate2 + (size_t)u.pn * gstride;
#pragma unroll
        for (int ai = 0; ai < 2; ++ai) { u32x4 gb[4][2];
#pragma unroll
            for (int m = 0; m < 4; ++m) { const size_t row = (size_t)(row0 + ai * HALF + m * 16);
#pragma unroll
                for (int bj = 0; bj < 2; ++bj) gb[m][bj] = *(const u32x4*)(g2 + row * 256 + colt + bj * HALF); }
#pragma unroll
            for (int m = 0; m < 4; ++m) { const size_t row = (size_t)(row0 + ai * HALF + m * 16);
#pragma unroll
                for (int bj = 0; bj < 2; ++bj) { const u32x4 y = gb[m][bj]; const f32x4 v0 = acc[ai][bj][m][0], v1 = acc[ai][bj][m][1];
                    float o[8];
                    o[0] = sigm_(bf2f_(y.x & 0xffffu)) * v0[0]; o[1] = sigm_(bf2f_(y.x >> 16)) * v0[1]; o[2] = sigm_(bf2f_(y.y & 0xffffu)) * v0[2]; o[3] = sigm_(bf2f_(y.y >> 16)) * v0[3];
                    o[4] = sigm_(bf2f_(y.z & 0xffffu)) * v1[0]; o[5] = sigm_(bf2f_(y.z >> 16)) * v1[1]; o[6] = sigm_(bf2f_(y.w & 0xffffu)) * v1[2]; o[7] = sigm_(bf2f_(y.w >> 16)) * v1[3];
                    u32x4 w; w.x = cvt_pk_bf16(o[0], o[1]); w.y = cvt_pk_bf16(o[2], o[3]); w.z = cvt_pk_bf16(o[4], o[5]); w.w = cvt_pk_bf16(o[6], o[7]);
                    *(u32x4*)(O + row * ldc + u.pn * BM + colt + bj * HALF) = w; } } }
    }
};
struct EpiRes {
    static constexpr bool PERM = false, AFTER_DRAIN = false;
    float* C; const float* R; int ldc;
    __device__ __forceinline__ void operator()(const f32x4 (&acc)[2][2][4][2], const Unit& u, int wr, int wc, int fr, int fq) const {
        const int row0 = u.pm * BM + wr * 64 + fr, col0 = u.pn * BM + wc * 32 + 4 * fq;
#pragma unroll
        for (int ai = 0; ai < 2; ++ai) {
            f32x4 rv[4][2][2];
#pragma unroll
            for (int m = 0; m < 4; ++m) { const size_t ro = (size_t)(row0 + ai * HALF + m * 16) * ldc + col0;
#pragma unroll
                for (int bj = 0; bj < 2; ++bj)
#pragma unroll
                    for (int n = 0; n < 2; ++n) rv[m][bj][n] = *(const f32x4*)(R + ro + bj * HALF + n * 16); }
#pragma unroll
            for (int m = 0; m < 4; ++m) { const size_t ro = (size_t)(row0 + ai * HALF + m * 16) * ldc + col0;
#pragma unroll
                for (int bj = 0; bj < 2; ++bj)
#pragma unroll
                    for (int n = 0; n < 2; ++n) *(f32x4*)(C + ro + bj * HALF + n * 16) = rv[m][bj][n] + acc[ai][bj][m][n]; } }
    }
};
struct EpiSwiGLU {
    static constexpr bool PERM = true, AFTER_DRAIN = false;
    bf16_t* H;
    __device__ __forceinline__ void operator()(const f32x4 (&acc)[2][2][4][2], const Unit& u, int wr, int wc, int fr, int fq) const {
        const int row0 = u.pm * BM + wr * 64 + fr, hc = (u.pn & 3) * 128 + wc * 32 + 8 * fq;
#pragma unroll
        for (int ai = 0; ai < 2; ++ai)
#pragma unroll
            for (int m = 0; m < 4; ++m) { const size_t row = (size_t)(row0 + ai * HALF + m * 16);
                float o[8];
#pragma unroll
                for (int n = 0; n < 2; ++n)
#pragma unroll
                    for (int i = 0; i < 4; ++i) { const float g = acc[ai][0][m][n][i], up = acc[ai][1][m][n][i]; o[n * 4 + i] = g * sigm_(g) * up; }
                u32x4 w; w.x = cvt_pk_bf16(o[0], o[1]); w.y = cvt_pk_bf16(o[2], o[3]); w.z = cvt_pk_bf16(o[4], o[5]); w.w = cvt_pk_bf16(o[6], o[7]);
                *(u32x4*)(H + row * 512 + hc) = w; }
    }
};
struct EpiDown {
    static constexpr bool PERM = true, AFTER_DRAIN = false;
    bf16_t* Y;
    __device__ __forceinline__ void operator()(const f32x4 (&acc)[2][2][4][2], const Unit& u, int wr, int wc, int fr, int fq) const {
        const int row0 = u.pm * BM + wr * 64 + fr, c0 = (u.pn & 3) * 256 + wc * 32 + 8 * fq;
#pragma unroll
        for (int ai = 0; ai < 2; ++ai)
#pragma unroll
            for (int m = 0; m < 4; ++m) { const size_t row = (size_t)(row0 + ai * HALF + m * 16);
#pragma unroll
                for (int bj = 0; bj < 2; ++bj) { const f32x4 v0 = acc[ai][bj][m][0], v1 = acc[ai][bj][m][1];
                    u32x4 w; w.x = cvt_pk_bf16(v0[0], v0[1]); w.y = cvt_pk_bf16(v0[2], v0[3]); w.z = cvt_pk_bf16(v1[0], v1[1]); w.w = cvt_pk_bf16(v1[2], v1[3]);
                    *(u32x4*)(Y + row * 1024 + c0 + bj * HALF) = w; } }
    }
};
template <bool GA_> struct MoeOrder {
    static constexpr bool GATHER = GA_;
    const PG8_LAS int* ts; int nl, lx, lo, hi; const int* rowtok; unsigned* rdy;
    __device__ __forceinline__ bool next(int i, Unit& u) const {
        const int U = 4 * (hi - lo), G = nl, c = lx; long L;
        if constexpr (GA_) L = (long)i * G + c;
        else { const int r = U % G;
            if (c >= r) L = (i == 0) ? (long)(c - r) : ((i == 1) ? (long)(G - r) + (c - r) : 2L * (G - r) + (long)(i - 2) * G + c);
            else L = 2L * (G - r) + (long)i * G + c; }
        if (L >= (long)U) return false;
        const int pm = lo + (int)(L >> 2), j = (int)(L & 3); int e = 0;
#pragma unroll
        for (int k = 1; k < 32; ++k) e += (ts[k] <= pm) ? 1 : 0;
        u.pm = pm; u.pn = e * 4 + j; return true;
    }
    __device__ __forceinline__ void a_ready(const Unit& u) const {
        if constexpr (!GA_) { unsigned sp = 0u;
            while (__hip_atomic_load(rdy + 16 * u.pm, __ATOMIC_RELAXED, __HIP_MEMORY_SCOPE_AGENT) < 32u) { __builtin_amdgcn_s_sleep(2); if (++sp > (1u << 22)) break; }
            asm volatile("" ::: "memory"); }
    }
    __device__ __forceinline__ void done(const Unit& u) const {
        if constexpr (GA_) { asm volatile("s_waitcnt vmcnt(0)" ::: "memory");
            if ((threadIdx.x & 63) == 0) (void)__hip_atomic_fetch_add(rdy + 16 * u.pm, 1u, __ATOMIC_RELAXED, __HIP_MEMORY_SCOPE_AGENT); }
    }
};
template <class E_> struct is_epibf16 { static constexpr bool value = false; }; template <int A_> struct is_epibf16<EpiBf16<A_>> { static constexpr bool value = true; };
template <class Epi, class Sched, bool ALIGN_EPI = false, bool SP2 = false, bool DUAL = false>
__device__ __forceinline__ void gemm_phase(PG8_LAS unsigned char* lds, const Gemm g, const Sched& S, const Epi& E) {
    const int tid = threadIdx.x, wid = __builtin_amdgcn_readfirstlane(tid >> 6), lane = tid & 63, wr = wid >> 2, wc = wid & 3, fr = lane & 15, fq = lane >> 4;
    const int K = g.K, nh = K / BK, nt = DUAL ? 2 * nh : nh;
    static_assert(!DUAL || SP2, "two operand pairs: SP2 loop only");
    unsigned voffA[2], voffB[2];
#pragma unroll
    for (int i = 0; i < 2; ++i) { int R, C; stage_rc(tid * 16 + i * 8192, R, C); const int Rb = Epi::PERM ? ((R & ~31) + perm32(R & 31)) : R;
        voffA[i] = (unsigned)(R * K + C) * 2u; voffB[i] = (unsigned)(Rb * K + C) * 2u; }
    const size_t kstep = (size_t)(BK * 2);
    const size_t hstep = (size_t)HALF * K * 2;
    const size_t tstep = 2 * hstep;
    constexpr bool GA = Sched::GATHER;
    static_assert(!GA || SP2, "gathered A rows: SP2 loop only");
    const size_t hstepA = GA ? 0 : hstep;
    unsigned gcur[2][2] = {{0u, 0u}, {0u, 0u}}, gnxt[2][2] = {{0u, 0u}, {0u, 0u}}; int gR[2] = {0, 0}; unsigned gC[2] = {0u, 0u};
    if constexpr (GA) { _Pragma("unroll") for (int i = 0; i < 2; ++i) { int R, C; stage_rc(tid * 16 + i * 8192, R, C); gR[i] = R; gC[i] = (unsigned)C * 2u; } }
#define PG8_GOFF(dst, u) do { if constexpr (GA) { _Pragma("unroll") for (int h_ = 0; h_ < 2; ++h_) _Pragma("unroll") for (int i_ = 0; i_ < 2; ++i_) dst[h_][i_] = (unsigned)S.rowtok[(u).pm * BM + h_ * HALF + gR[i_]] * (unsigned)(K * 2) + gC[i_]; } } while (0)
#define PG8_VA(h, sel) (GA ? ((sel) ? gnxt[h] : gcur[h]) : voffA)
    const unsigned ldsw = (unsigned)wid * 1024u;
    const int aoff = lds_byte(wr * 64 + fr, fq * 8), boff = lds_byte(wc * 32 + fr, fq * 8);
#define PG8_SA(b, h) (((b) * 2 + (h)) * HTB)
#define PG8_SB(b, h) ((4 + (b) * 2 + (h)) * HTB)
#define PG8_STAGE(bufoff, gbase, voff) do { _Pragma("unroll") for (int _i = 0; _i < 2; ++_i) \
        __builtin_amdgcn_global_load_lds((const unsigned*)((const char*)(gbase) + (voff)[_i]), (PG8_LAS unsigned*)(lds + (bufoff) + ldsw + _i * 8192), 16, 0, 0); } while (0)
#define PG8_LDA(dst, b, h) do { _Pragma("unroll") for (int m = 0; m < 4; ++m) _Pragma("unroll") for (int k = 0; k < 2; ++k) dst[m][k] = *(const PG8_LAS bf16x8*)(lds + PG8_SA(b, h) + aoff + m * 2048 + k * 1024); } while (0)
#define PG8_LDB(dst, b, h) do { _Pragma("unroll") for (int n = 0; n < 2; ++n) _Pragma("unroll") for (int k = 0; k < 2; ++k) dst[n][k] = *(const PG8_LAS bf16x8*)(lds + PG8_SB(b, h) + boff + n * 2048 + k * 1024); } while (0)
#define PG8_MMA(ai, bj, At, Bt) do { __builtin_amdgcn_s_setprio(1); _Pragma("unroll") for (int m = 0; m < 4; ++m) _Pragma("unroll") for (int n = 0; n < 2; ++n) _Pragma("unroll") for (int k = 0; k < 2; ++k) \
        acc[ai][bj][m][n] = __builtin_amdgcn_mfma_f32_16x16x32_bf16(Bt[n][k], At[m][k], acc[ai][bj][m][n], 0, 0, 0); __builtin_amdgcn_s_setprio(0); } while (0)
#define PG8_WAIT_V(n) asm volatile("s_waitcnt vmcnt(" #n ")" ::: "memory")
#define PG8_WAIT_L(n) asm volatile("s_waitcnt lgkmcnt(" #n ")" ::: "memory")
#define PG8_BAR __builtin_amdgcn_s_barrier()
#define PG8_SCHED __builtin_amdgcn_sched_barrier(0)
    Unit cur, nxt; int ui = 0;
    if (!S.next(0, cur)) return;
    f32x4 acc[2][2][4][2];
#pragma unroll
    for (int a = 0; a < 2; ++a)
#pragma unroll
        for (int b = 0; b < 2; ++b)
#pragma unroll
            for (int m = 0; m < 4; ++m)
#pragma unroll
                for (int n = 0; n < 2; ++n) acc[a][b][m][n] = (f32x4){0.f, 0.f, 0.f, 0.f};
    bf16x8 At[4][2], B0[2][2], B1[2][2];
    const char* cA = (const char*)g.A + (GA ? 0 : (size_t)cur.pm * tstep); const char* cB = (const char*)g.Bt + (size_t)cur.pn * tstep;
    S.a_ready(cur);
    PG8_GOFF(gcur, cur);
    if constexpr (SP2) {
        PG8_STAGE(PG8_SB(0, 0), cB, voffB); PG8_STAGE(PG8_SB(0, 1), cB + hstep, voffB); PG8_STAGE(PG8_SA(0, 0), cA, PG8_VA(0, false)); PG8_STAGE(PG8_SA(0, 1), cA + hstepA, PG8_VA(1, false));
        if (wr == 1) PG8_BAR;
        PG8_WAIT_V(2); PG8_BAR;
        PG8_STAGE(PG8_SB(1, 0), cB + kstep, voffB); PG8_STAGE(PG8_SA(1, 0), cA + kstep, PG8_VA(0, false)); PG8_STAGE(PG8_SB(1, 1), cB + hstep + kstep, voffB);
        PG8_WAIT_V(6); PG8_BAR;
    } else {
        PG8_STAGE(PG8_SB(0, 0), cB, voffB); PG8_STAGE(PG8_SA(0, 0), cA, voffA); PG8_STAGE(PG8_SB(0, 1), cB + hstep, voffB); PG8_STAGE(PG8_SA(0, 1), cA + hstep, voffA);
        if (wr == 1) PG8_BAR;
        PG8_WAIT_V(4); PG8_BAR;
        PG8_STAGE(PG8_SB(1, 0), cB + kstep, voffB); PG8_STAGE(PG8_SA(1, 0), cA + kstep, voffA); PG8_STAGE(PG8_SB(1, 1), cB + hstep + kstep, voffB);
        PG8_WAIT_V(6); PG8_BAR;
    }
    for (;;) {
        const bool has_next = S.next(ui + 1, nxt);
        if (has_next) PG8_GOFF(gnxt, nxt);
        const char* nA = has_next ? (const char*)g.A + (GA ? 0 : (size_t)nxt.pm * tstep) : cA; const char* nB = has_next ? (const char*)g.Bt + (size_t)nxt.pn * tstep : cB;
        const char* dA = cA; const char* dB = cB;
        if constexpr (DUAL) { dA = (const char*)g.A2 + (size_t)cur.pm * tstep - (size_t)nh * kstep; dB = (const char*)g.Bt2 + (size_t)cur.pn * tstep - (size_t)nh * kstep; }
        for (int th = 0; th < (DUAL ? 2 : 1); ++th) {
        for (int t = th * nh; t < (DUAL ? (th + 1) * nh : nt); t += 2) {
            const bool last = (t == nt - 2);
            const char* a1 = ((DUAL && t + 1 >= nh) ? dA : cA) + (size_t)(t + 1) * kstep;
            const char* a2 = last ? nA : ((DUAL && t + 2 >= nh) ? dA : cA) + (size_t)(t + 2) * kstep; const char* b2 = last ? nB : ((DUAL && t + 2 >= nh) ? dB : cB) + (size_t)(t + 2) * kstep;
            const char* a3 = a2 + kstep; const char* b3 = b2 + kstep;
            if (last && has_next) S.a_ready(nxt);
            const bool seln = last && has_next;
            if constexpr (SP2) {
            PG8_LDB(B0, 0, 0); PG8_LDB(B1, 0, 1); PG8_SCHED; PG8_LDA(At, 0, 0); PG8_STAGE(PG8_SA(1, 1), a1 + hstepA, PG8_VA(1, false));
            PG8_WAIT_V(8); PG8_WAIT_L(0); PG8_BAR; PG8_MMA(0, 0, At, B0); PG8_MMA(0, 1, At, B1); PG8_BAR; PG8_SCHED;
            PG8_LDA(At, 0, 1); PG8_STAGE(PG8_SB(0, 0), b2, voffB); PG8_STAGE(PG8_SB(0, 1), b2 + hstep, voffB); PG8_STAGE(PG8_SA(0, 0), a2, PG8_VA(0, seln));
            PG8_WAIT_V(8); PG8_WAIT_L(0); PG8_BAR; PG8_MMA(1, 0, At, B0); PG8_MMA(1, 1, At, B1); PG8_BAR; PG8_SCHED;
            PG8_LDB(B0, 1, 0); PG8_LDB(B1, 1, 1); PG8_SCHED; PG8_LDA(At, 1, 0); PG8_STAGE(PG8_SA(0, 1), a2 + hstepA, PG8_VA(1, seln));
            PG8_WAIT_V(8); PG8_WAIT_L(0); PG8_BAR; PG8_MMA(0, 0, At, B0); PG8_MMA(0, 1, At, B1); PG8_BAR; PG8_SCHED;
            PG8_LDA(At, 1, 1); PG8_STAGE(PG8_SB(1, 0), b3, voffB); PG8_STAGE(PG8_SB(1, 1), b3 + hstep, voffB); PG8_STAGE(PG8_SA(1, 0), a3, PG8_VA(0, seln));
            PG8_WAIT_V(8); PG8_WAIT_L(0); PG8_BAR; PG8_MMA(1, 0, At, B0); PG8_MMA(1, 1, At, B1); PG8_BAR; PG8_SCHED;
            } else {
            PG8_LDB(B0, 0, 0); PG8_SCHED; PG8_LDA(At, 0, 0); PG8_STAGE(PG8_SA(1, 1), a1 + hstep, voffA);
            PG8_WAIT_L(8); PG8_BAR; PG8_WAIT_L(0); PG8_MMA(0, 0, At, B0); PG8_BAR; PG8_SCHED;
            PG8_LDB(B1, 0, 1); PG8_STAGE(PG8_SB(0, 0), b2, voffB);
            PG8_BAR; PG8_WAIT_L(0); PG8_MMA(0, 1, At, B1); PG8_BAR;
            PG8_LDA(At, 0, 1); PG8_STAGE(PG8_SA(0, 0), a2, voffA);
            PG8_BAR; PG8_WAIT_L(0); PG8_MMA(1, 0, At, B0); PG8_BAR; PG8_SCHED;
            PG8_STAGE(PG8_SB(0, 1), b2 + hstep, voffB);
            PG8_WAIT_V(6); PG8_BAR; PG8_MMA(1, 1, At, B1); PG8_BAR;
            PG8_LDB(B0, 1, 0); PG8_SCHED; PG8_LDA(At, 1, 0); PG8_STAGE(PG8_SA(0, 1), a2 + hstep, voffA);
            PG8_WAIT_L(8); PG8_BAR; PG8_WAIT_L(0); PG8_MMA(0, 0, At, B0); PG8_BAR; PG8_SCHED;
            PG8_LDB(B1, 1, 1); PG8_STAGE(PG8_SB(1, 0), b3, voffB);
            PG8_BAR; PG8_WAIT_L(0); PG8_MMA(0, 1, At, B1); PG8_BAR;
            PG8_LDA(At, 1, 1); PG8_STAGE(PG8_SA(1, 0), a3, voffA);
            PG8_BAR; PG8_WAIT_L(0); PG8_MMA(1, 0, At, B0); PG8_BAR; PG8_SCHED;
            PG8_STAGE(PG8_SB(1, 1), b3 + hstep, voffB);
            PG8_WAIT_V(6); PG8_BAR; PG8_MMA(1, 1, At, B1); PG8_BAR;
            }
        }
        if constexpr (DUAL) { if (th == 0) E.mid(acc, cur, wr, wc, fr, fq); }
        }
        if constexpr (ALIGN_EPI) { if (wr == 0) PG8_BAR; }
        if constexpr (!Epi::AFTER_DRAIN) { E(acc, cur, wr, wc, fr, fq); S.done(cur); }
#ifdef DBG_EPI2
        if constexpr (is_epibf16<Epi>::value) { asm volatile("" ::: "memory"); E(acc, cur, wr, wc, fr, fq); }
#endif
#ifdef DBG_EPI2R
        if constexpr (!Epi::PERM) { asm volatile("" ::: "memory"); E(acc, cur, wr, wc, fr, fq); }
#endif
        if (!has_next) break;
#pragma unroll
        for (int a = 0; a < 2; ++a)
#pragma unroll
            for (int b = 0; b < 2; ++b)
#pragma unroll
                for (int m = 0; m < 4; ++m)
#pragma unroll
                    for (int n = 0; n < 2; ++n) acc[a][b][m][n] = (f32x4){0.f, 0.f, 0.f, 0.f};
        cur = nxt; cA = nA; cB = nB; ++ui;
        if constexpr (GA) { _Pragma("unroll") for (int h_ = 0; h_ < 2; ++h_) _Pragma("unroll") for (int i_ = 0; i_ < 2; ++i_) gcur[h_][i_] = gnxt[h_][i_]; }
        if constexpr (ALIGN_EPI) { if (wr == 1) PG8_BAR; }
    }
    PG8_WAIT_V(0);
    if constexpr (!ALIGN_EPI) { if (wr == 0) PG8_BAR; }
    PG8_BAR;
    if constexpr (Epi::AFTER_DRAIN) { E.fused(acc, cur, wr, wc, fr, fq, lds, wid, lane); S.done(cur); }
#undef PG8_GOFF
#undef PG8_VA
#undef PG8_SA
#undef PG8_SB
#undef PG8_STAGE
#undef PG8_LDA
#undef PG8_LDB
#undef PG8_MMA
#undef PG8_WAIT_V
#undef PG8_WAIT_L
#undef PG8_BAR
#undef PG8_SCHED
}
}
constexpr int NWAVES = 8;
constexpr int BATCH = 8, SEQ = 4096, D = 1024, T = BATCH * SEQ;
constexpr int NPROJ = 5120;
constexpr int NTILE = NPROJ / 256;
constexpr float EPS = 1e-6f;
#ifndef MK_N_LAUNCHES
#define MK_N_LAUNCHES 1
#endif
#ifndef DBG_NPH
#define DBG_NPH 12
#endif
constexpr int NPH = DBG_NPH;
constexpr int N_LAUNCHES = MK_N_LAUNCHES;
static_assert(N_LAUNCHES == 1 || N_LAUNCHES == NPH, "MK_N_LAUNCHES is 1 or NPH");

constexpr size_t MiB = 1u << 20;
constexpr size_t WS_CTL = 0, CTL_ZERO_BYTES = 1 * MiB;
constexpr size_t WS_SMALL = 1 * MiB;
constexpr size_t WS_WIN = 2 * MiB;
constexpr size_t WS_WPA = 13 * MiB, WS_WPM = 14 * MiB, WS_WOUT = 15 * MiB;
constexpr size_t WS_TOKE = 17 * MiB;
constexpr size_t WS_TOKR = WS_TOKE + 256 * 1024;
constexpr size_t WS_TOKP = WS_TOKR + 256 * 1024;
constexpr size_t WS_TOKG = WS_TOKP + 256 * 1024;
constexpr size_t WS_CNT = WS_TOKG + 256 * 1024;
constexpr size_t WS_ROWTOK = WS_CNT + 64 * 1024;
constexpr int NROWS_MAX = 73728;
constexpr size_t WS_SC = 452 * MiB;
constexpr size_t WS_SC2 = 116 * MiB + 3 * ((size_t)T * 256 * 2);
constexpr size_t WS_GU = 20 * MiB;
constexpr size_t WS_DN = 84 * MiB;
constexpr size_t WS_PROJ = 116 * MiB;
constexpr size_t PROJ_TILE = (size_t)T * 256 * 2;
constexpr size_t WS_MLST = 116 * MiB;
constexpr size_t WS_MERGED = 116 * MiB;
constexpr size_t WS_XN = 180 * MiB;
constexpr size_t WS_XG = 244 * MiB;
constexpr size_t WS_HID = 388 * MiB;
constexpr size_t WS_Y = 244 * MiB;
constexpr size_t WS_END = 512 * MiB;
static_assert(WS_PROJ + NTILE * PROJ_TILE == 436 * MiB, "proj map");
constexpr size_t DO_H = 0, DO_YATT = 0, DO_YML = 32 * MiB, DO_KN = 64 * MiB, DO_IKR = 72 * MiB, DO_IQR = 74 * MiB, DO_AQN = 90 * MiB;
constexpr int TL_AQ = 0, TL_KV = 2, TL_IQ = 3, TL_MQ = 4, TL_MK = 6, TL_MV = 8, TL_MO = 10, TL_GA = 12, TL_GM = 16;
constexpr size_t WS_WSM = WS_SMALL + 64 * 1024;
constexpr size_t WS_WTG = WS_SMALL + 192 * 1024;
constexpr size_t DO_SMB = 122 * MiB;
constexpr int CW_BAR = 4096;
constexpr int CW_Q = 16384;
constexpr int CW_KMAX = 24576;
constexpr int CW_RDY = 32768;
constexpr int LDS_BYTES = 163840, MISC_OFF = LDS_BYTES - 512;

#define GAS __attribute__((address_space(1)))
#define LAS __attribute__((address_space(3)))
typedef unsigned short bf16;
typedef unsigned v4u __attribute__((ext_vector_type(4)));
typedef unsigned v2u __attribute__((ext_vector_type(2)));
typedef float f32x4 __attribute__((ext_vector_type(4)));
typedef float f32x2 __attribute__((ext_vector_type(2)));
typedef short bf16x8 __attribute__((ext_vector_type(8)));
typedef GAS unsigned gu32;
#define RLX_AGENT __ATOMIC_RELAXED, __HIP_MEMORY_SCOPE_AGENT
#define LDS_WAIT() asm volatile("s_waitcnt lgkmcnt(0)" ::: "memory")
__device__ __forceinline__ float bf2f(unsigned b16) { return __uint_as_float(b16 << 16); }
__device__ __forceinline__ unsigned f2bf(float f) { unsigned u = __float_as_uint(f); return (u + 0x7fffu + ((u >> 16) & 1u)) >> 16; }
__device__ __forceinline__ unsigned pk2(float lo, float hi) { return pg8::cvt_pk_bf16(lo, hi); }
__device__ __forceinline__ float sigm(float x) { return 1.0f / (1.0f + __expf(-x)); }
__device__ __forceinline__ float wave_sum(float v) {
    v += __int_as_float(__builtin_amdgcn_update_dpp(0, __float_as_int(v), 0xB1, 0xF, 0xF, true));
    v += __int_as_float(__builtin_amdgcn_update_dpp(0, __float_as_int(v), 0x4E, 0xF, 0xF, true));
    v += __int_as_float(__builtin_amdgcn_update_dpp(0, __float_as_int(v), 0x124, 0xF, 0xF, true));
    v += __int_as_float(__builtin_amdgcn_update_dpp(0, __float_as_int(v), 0x128, 0xF, 0xF, true));
    { const auto r = __builtin_amdgcn_permlane16_swap(__float_as_uint(v), __float_as_uint(v), false, false); v = __uint_as_float(r[0]) + __uint_as_float(r[1]); }
    { const auto r = __builtin_amdgcn_permlane32_swap(__float_as_uint(v), __float_as_uint(v), false, false); v = __uint_as_float(r[0]) + __uint_as_float(r[1]); }
    return v;
}
__device__ __forceinline__ void unpack8(const v4u r, float (&f)[8]) {
    f[0] = bf2f(r.x & 0xffffu); f[1] = bf2f(r.x >> 16); f[2] = bf2f(r.y & 0xffffu); f[3] = bf2f(r.y >> 16);
    f[4] = bf2f(r.z & 0xffffu); f[5] = bf2f(r.z >> 16); f[6] = bf2f(r.w & 0xffffu); f[7] = bf2f(r.w >> 16);
}
__device__ __forceinline__ v4u pack8(const float (&f)[8]) { v4u w; w.x = pk2(f[0], f[1]); w.y = pk2(f[2], f[3]); w.z = pk2(f[4], f[5]); w.w = pk2(f[6], f[7]); return w; }
#define XB_TMO      128
#define XB_XCNT(j)  (256  + 64 * (j))
#define XB_XSUB(j)  (1280 + 64 * (j))
#define XB_XGEN(j)  (2304 + 64 * (j))
#define XB_TOP      3328
#define XB_TOPGEN   3392
#define XCD_BAR_WORDS 3456
#define XB_SPIN_CAP (1u << 18)

__device__ __forceinline__ unsigned xb_ld(unsigned* p)              { return __hip_atomic_load(p, __ATOMIC_RELAXED, __HIP_MEMORY_SCOPE_AGENT); }
__device__ __forceinline__ unsigned xb_add(unsigned* p, unsigned v) { return __hip_atomic_fetch_add(p, v, __ATOMIC_RELAXED, __HIP_MEMORY_SCOPE_AGENT); }
__device__ __forceinline__ unsigned xb_xcc_id() { return (unsigned)__builtin_amdgcn_s_getreg((3 << 11) | 20) & 0xFu; }
#define XB_SPIN(cond, bar) do { unsigned _sp = 0; while (cond) { __builtin_amdgcn_s_sleep(1); \
    if ((++_sp & 255u) == 0u) { if (xb_ld(&(bar)[XB_TMO])) break; if (_sp > XB_SPIN_CAP) { atomicAdd(&(bar)[XB_TMO], 1u); break; } } } } while (0)

struct XcdBarrier {
    unsigned* bar; unsigned x;
    volatile LAS unsigned* st;
};

__device__ __forceinline__ XcdBarrier xcd_barrier_post(unsigned* bar, volatile LAS unsigned* st) {
    XcdBarrier b; b.bar = bar; b.x = xb_xcc_id(); b.st = st;
    if (threadIdx.x == 0) st[12] = xb_add(&bar[XB_XCNT(b.x)], 1u);
    return b;
}
__device__ __forceinline__ void xcd_barrier_complete(unsigned* bar, unsigned x, unsigned& nloc, unsigned& nx) {
    const unsigned G = gridDim.x * gridDim.y * gridDim.z;
    unsigned sum, cnt, mine, sp = 0u;
    for (;;) {
        sum = 0u; cnt = 0u; mine = 0u;
#pragma unroll
        for (unsigned j = 0; j < 16; ++j) { const unsigned c = xb_ld(&bar[XB_XCNT(j)]); sum += c; cnt += (c > 0u) ? 1u : 0u; mine = (j == x) ? c : mine; }
        if (sum == G) break;
        __builtin_amdgcn_s_sleep(1);
        if ((++sp & 255u) == 0u) { if (xb_ld(&bar[XB_TMO])) break; if (sp > XB_SPIN_CAP) { atomicAdd(&bar[XB_TMO], 1u); break; } }
    }
    nloc = mine > 0u ? mine : 1u; nx = cnt > 0u ? cnt : 1u;
}

__device__ __forceinline__ void xcd_barrier(const XcdBarrier& b) {
    asm volatile("s_waitcnt vmcnt(0)" ::: "memory");
    __syncthreads();
    if (threadIdx.x == 0) {
        unsigned* bar = b.bar;
        __builtin_amdgcn_s_waitcnt(0);
        unsigned nloc = b.st[0], nx = b.st[1];
        if (nloc == 0u) { xcd_barrier_complete(bar, b.x, nloc, nx); b.st[0] = nloc; b.st[1] = nx; }
        const unsigned old = xb_add(&bar[XB_XSUB(b.x)], 1u);
        const unsigned gen = old / nloc;
        if (old + 1u == (gen + 1u) * nloc) {
            __builtin_amdgcn_fence(__ATOMIC_RELEASE, "agent");
            asm volatile("s_waitcnt vmcnt(0)" ::: "memory");
            const unsigned og = xb_add(&bar[XB_TOP], 1u);
            const unsigned tg = og / nx;
            if (og + 1u == (tg + 1u) * nx) xb_add(&bar[XB_TOPGEN], 1u);
            else XB_SPIN(xb_ld(&bar[XB_TOPGEN]) == tg, bar);
            __builtin_amdgcn_fence(__ATOMIC_ACQUIRE, "agent");
            xb_add(&bar[XB_XGEN(b.x)], 1u);
            asm volatile("s_waitcnt vmcnt(0)" ::: "memory");
        } else {
            XB_SPIN(xb_ld(&bar[XB_XGEN(b.x)]) == gen, bar);
            __builtin_amdgcn_fence(__ATOMIC_ACQUIRE, "agent");
            asm volatile("s_waitcnt vmcnt(0)" ::: "memory");
        }
    }
    __syncthreads();
}
struct Args { const float* in[22]; float* out; unsigned char* ws; int ph_lo, ph_hi, li, pad; };
struct Ctx { int tid, lane, wave, G, vcu; LAS unsigned char* lds; };
#define IN_X 0
#define IN_POS 1
#define IN_GMIX 2
#define IN_WIN 3
#define IN_GQ 4
#define IN_GK 5
#define IN_WCONV 6
#define IN_BCONV 7
#define IN_BI 8
#define IN_BF 9
#define IN_GML 10
#define IN_WPA 11
#define IN_WPM 12
#define IN_WOUT 13
#define IN_GMOE 14
#define IN_WRG 15
#define IN_BRG 16
#define IN_WRE 17
#define IN_BRE 18
#define IN_WEG 19
#define IN_WEU 20
#define IN_WED 21

__device__ __forceinline__ int win_src_col(int n) {
    if (n < 1024) return n;
    if (n < 3072) return n + 40;
    return n + 48;
}
__device__ __forceinline__ int wsm_src_col(int r) {
    return r < 40 ? 1024 + r : (r < 44 ? 3112 + (r - 40) : 3116 + (r - 44));
}
__device__ __forceinline__ void tr_item(const float* W, int ldw, int scol, int k0, bf16* wt0, int K, LAS float* scr, int lane) {
    const int sc0 = __builtin_amdgcn_readfirstlane(scol), sc31 = __builtin_amdgcn_readlane(scol, 31);
    if (sc0 >= 0 && sc31 == sc0 + 31 && (sc0 & 3) == 0 && (ldw & 3) == 0) {
#pragma unroll
        for (int i = 0; i < 8; ++i) { const int kk = 8 * i + (lane >> 3); const f32x4 v = *(const f32x4*)(W + (size_t)(k0 + kk) * ldw + sc0 + 4 * (lane & 7));
            LAS float* d = scr + kk * 33 + 4 * (lane & 7); d[0] = v[0]; d[1] = v[1]; d[2] = v[2]; d[3] = v[3]; }
    } else {
#pragma unroll 8
        for (int i = 0; i < 32; ++i) { const int kk = 2 * i + (lane >> 5); scr[kk * 33 + (lane & 31)] = scol >= 0 ? W[(size_t)(k0 + kk) * ldw + scol] : 0.f; }
    }
    LDS_WAIT(); asm volatile("" ::: "memory");
    const int c = lane & 7;
#pragma unroll
    for (int j = 0; j < 4; ++j) { const int n = (lane >> 3) + 8 * j; const LAS float* s = scr + (8 * c) * 33 + n;
        v4u o; o.x = pk2(s[0 * 33], s[1 * 33]); o.y = pk2(s[2 * 33], s[3 * 33]); o.z = pk2(s[4 * 33], s[5 * 33]); o.w = pk2(s[6 * 33], s[7 * 33]);
        *(v4u*)(wt0 + (size_t)n * K + 8 * c) = o; }
    LDS_WAIT(); asm volatile("" ::: "memory");
}
template <int PART> __device__ __forceinline__ void p0_prologue(const Args& a, const Ctx& c, int gw, int NGW) {
    unsigned char* ws = a.ws;
    LAS float* scr = (LAS float*)(c.lds + c.wave * 16384);
    const int lane = c.lane;
    constexpr int I_IN = 16 * 160, I_PA = 8 * 32, I_PM = 8 * 32, I_OUT = 16 * 32, I_GU = 32 * 16 * 32, I_DN = 32 * 8 * 32;
    constexpr int NPRJ = I_IN + I_PA + I_PM + I_OUT, NIT = NPRJ + I_GU + I_DN;
    for (int it = (PART ? NPRJ : 0) + gw; it < (PART ? NIT : NPRJ); it += NGW) {
        int r = it;
        if (r < I_IN) { const int kb = r / 160, nb = r % 160; tr_item(a.in[IN_WIN], 5168, win_src_col(32 * nb + (lane & 31)), 64 * kb, (bf16*)(ws + WS_WIN) + (size_t)(32 * nb) * 1024 + 64 * kb, 1024, scr, lane); continue; } r -= I_IN;
        if (r < I_PA) { const int kb = r / 32, nb = r % 32; tr_item(a.in[IN_WPA], 1024, 32 * nb + (lane & 31), 64 * kb, (bf16*)(ws + WS_WPA) + (size_t)(32 * nb) * 512 + 64 * kb, 512, scr, lane); continue; } r -= I_PA;
        if (r < I_PM) { const int kb = r / 32, nb = r % 32; tr_item(a.in[IN_WPM], 1024, 32 * nb + (lane & 31), 64 * kb, (bf16*)(ws + WS_WPM) + (size_t)(32 * nb) * 512 + 64 * kb, 512, scr, lane); continue; } r -= I_PM;
        if (r < I_OUT) { const int kb = r / 32, nb = r % 32; tr_item(a.in[IN_WOUT], 1024, 32 * nb + (lane & 31), 64 * kb, (bf16*)(ws + WS_WOUT) + (size_t)(32 * nb) * 1024 + 64 * kb, 1024, scr, lane); continue; } r -= I_OUT;
        if (r < I_GU) { const int e = r / 512, q = r % 512, kb = q / 32, nb = q % 32, t = nb >> 3, bj = (nb >> 2) & 1, i0 = (nb & 3) * 32;
            const float* src = (bj ? a.in[IN_WEU] : a.in[IN_WEG]) + (size_t)e * 1024 * 512;
            tr_item(src, 512, 128 * t + i0 + (lane & 31), 64 * kb, (bf16*)(ws + WS_GU) + ((size_t)e * 1024 + 32 * nb) * 1024 + 64 * kb, 1024, scr, lane); continue; } r -= I_GU;
        { const int e = r / 256, q = r % 256, kb = q / 32, nb = q % 32;
            tr_item(a.in[IN_WED] + (size_t)e * 512 * 1024, 1024, 32 * nb + (lane & 31), 64 * kb, (bf16*)(ws + WS_DN) + ((size_t)e * 1024 + 32 * nb) * 512 + 64 * kb, 512, scr, lane); }
    }
    if (PART) return;
    { float* WTG = (float*)(ws + WS_WTG); for (int i = gw * 64 + lane; i < 36 * 1024; i += NGW * 64) { const int j = i >> 10, k = i & 1023;
        WTG[j * 1028 + k] = (j < 32 ? a.in[IN_WRE][k * 32 + j] : a.in[IN_WRG][k * 4 + (j - 32)]) * a.in[IN_GMOE][k]; } }
    { bf16* WSM = (bf16*)(ws + WS_WSM); for (int i = gw * 64 + lane; i < 48 * 1024; i += NGW * 64) { const int r = i >> 10, k = i & 1023; WSM[i] = (bf16)f2bf(a.in[IN_WIN][(size_t)k * 5168 + wsm_src_col(r)]); } }
    const float* g = a.in[IN_GMIX]; f32x4 gv[4];
#pragma unroll
    for (int j = 0; j < 4; ++j) gv[j] = *(const f32x4*)(g + 4 * lane + 256 * j);
    bf16* H = (bf16*)((unsigned char*)a.out + DO_H);
    for (int m0 = gw; m0 < T; m0 += 2 * NGW) {
        const int mA = m0, mB = (m0 + NGW < T) ? m0 + NGW : m0; const bool hasB = (m0 + NGW < T);
        const f32x4* xa = (const f32x4*)(a.in[IN_X] + (size_t)mA * D) + lane; const f32x4* xb = (const f32x4*)(a.in[IN_X] + (size_t)mB * D) + lane;
        f32x4 va[4], vb[4]; float sa = 0.f, sb = 0.f;
#pragma unroll
        for (int j = 0; j < 4; ++j) { va[j] = xa[64 * j]; vb[j] = xb[64 * j]; }
#pragma unroll
        for (int j = 0; j < 4; ++j) { sa += (va[j].x * va[j].x + va[j].y * va[j].y) + (va[j].z * va[j].z + va[j].w * va[j].w); sb += (vb[j].x * vb[j].x + vb[j].y * vb[j].y) + (vb[j].z * vb[j].z + vb[j].w * vb[j].w); }
        const float ra = rsqrtf(wave_sum(sa) * (1.f / D) + EPS), rb = rsqrtf(wave_sum(sb) * (1.f / D) + EPS);
        v2u* oa = (v2u*)(H + (size_t)mA * D) + lane; v2u* ob = (v2u*)(H + (size_t)mB * D) + lane;
#pragma unroll
        for (int j = 0; j < 4; ++j) { v2u w; w.x = pk2(va[j].x * ra * gv[j].x, va[j].y * ra * gv[j].y); w.y = pk2(va[j].z * ra * gv[j].z, va[j].w * ra * gv[j].w); oa[64 * j] = w; }
        if (hasB) {
#pragma unroll
        for (int j = 0; j < 4; ++j) { v2u w; w.x = pk2(vb[j].x * rb * gv[j].x, vb[j].y * rb * gv[j].y); w.y = pk2(vb[j].z * rb * gv[j].z, vb[j].w * rb * gv[j].w); ob[64 * j] = w; } }
    }
}

__device__ __forceinline__ const bf16* proj_tile(const Args& a, int tile) { return (const bf16*)(a.ws + WS_PROJ + (size_t)tile * PROJ_TILE); }
#define DPPF(x_, ctrl_) __int_as_float(__builtin_amdgcn_update_dpp(0, __float_as_int(x_), ctrl_, 0xF, 0xF, true))
__device__ __forceinline__ void p2_prep(const Args& a, const Ctx& c) {
    const int lane = c.lane, gw = c.vcu * NWAVES + c.wave, NGW = c.G * NWAVES;
    float invf = 0.f;
    if (lane < 8) invf = (float)pow(500000.0, -(double)lane / 8.0); else if (lane < 12) invf = (float)pow(500000.0, -(double)(lane - 8) / 4.0);
    float gq[8], gk[8];
#pragma unroll
    for (int i = 0; i < 8; ++i) { gq[i] = a.in[IN_GQ][8 * (lane & 7) + i]; gk[i] = a.in[IN_GK][8 * (lane & 7) + i]; }
    const int* pos = (const int*)a.in[IN_POS];
    unsigned char* dout = (unsigned char*)a.out;
    bf16* AQN = (bf16*)(dout + DO_AQN); bf16* KN = (bf16*)(dout + DO_KN); bf16* IQR = (bf16*)(dout + DO_IQR); bf16* IKR = (bf16*)(dout + DO_IKR);
    { const bf16* Hh = (const bf16*)(dout + DO_H); const bf16* WSM = (const bf16*)(a.ws + WS_WSM); bf16* SMB = (bf16*)(dout + DO_SMB);
      const int row = lane & 15, kg = lane >> 4;
      const float invfk = (float)pow(500000.0, -(double)(lane & 3) / 4.0);
      for (int tile = gw; tile < T / 16; tile += NGW) { const int t0 = tile * 16;
          f32x4 acc[3];
#pragma unroll
          for (int ct = 0; ct < 3; ++ct) acc[ct] = (f32x4){0.f, 0.f, 0.f, 0.f};
          const bf16* ap = Hh + (size_t)(t0 + row) * 1024 + 8 * kg; const bf16* bp = WSM + (size_t)row * 1024 + 8 * kg;
#pragma unroll 8
          for (int ks = 0; ks < 32; ++ks) { const bf16x8 av = *(const bf16x8*)(ap + 32 * ks);
#pragma unroll
              for (int ct = 0; ct < 3; ++ct) acc[ct] = __builtin_amdgcn_mfma_f32_16x16x32_bf16(av, *(const bf16x8*)(bp + (size_t)ct * 16 * 1024 + 32 * ks), acc[ct], 0, 0, 0); }
          const int col = lane & 15;
#pragma unroll
          for (int r = 0; r < 4; ++r) { const int t = t0 + 4 * kg + r;
              const float angk = (float)pos[t] * invfk;
              const double revk = (double)angk * 0.15915494309189535; const float frk = (float)(revk - __builtin_rint(revk));
              const float ck = __builtin_amdgcn_cosf(frk), sk = __builtin_amdgcn_sinf(frk);
              const float v0 = acc[0][r], pr = __shfl_xor(v0, 4);
              const float o0 = (col < 4) ? (v0 * ck - pr * sk) : ((col < 8) ? (v0 * ck + pr * sk) : v0);
              IKR[(size_t)t * 32 + col] = (bf16)f2bf(o0); IKR[(size_t)t * 32 + 16 + col] = (bf16)f2bf(acc[1][r]);
              SMB[(size_t)t * 16 + col] = (bf16)f2bf(acc[2][r]); }
          { float nk = 0.f;
#pragma unroll
            for (int r = 0; r < 4; ++r) { float q2 = acc[0][r] * acc[0][r] + acc[1][r] * acc[1][r];
                q2 += DPPF(q2, 0xB1); q2 += DPPF(q2, 0x4E); q2 += DPPF(q2, 0x141); q2 += DPPF(q2, 0x140);
                nk = fmaxf(nk, q2); }
            nk = fmaxf(nk, __shfl_xor(nk, 16)); nk = fmaxf(nk, __shfl_xor(nk, 32));
            if (lane == 0) atomicMax((unsigned*)(a.ws + WS_CTL) + CW_KMAX + 16 * (t0 / SEQ), __float_as_uint(nk)); } } }
    const int l7 = lane & 7;
    const int aqcol = (lane >> 3) * 64 + 8 * l7, akcol = ((lane & 15) >> 3) * 64 + 8 * l7;
    const bf16* aqsrc = proj_tile(a, TL_AQ + (aqcol >> 8)) + (aqcol & 255); const bf16* aksrc = proj_tile(a, TL_KV) + akcol; const bf16* iqsrc = proj_tile(a, TL_IQ) + 4 * lane;
#define P2_LOADROW(t_, P_, A_, K_, Q_) do { const int tt_ = (t_) < T ? (t_) : T - 1; P_ = pos[tt_]; A_ = *(const v4u*)(aqsrc + (size_t)tt_ * 256); K_ = *(const v4u*)(aksrc + (size_t)tt_ * 256); Q_ = *(const v2u*)(iqsrc + (size_t)tt_ * 256); } while (0)
#define P2_DOROW(t, P_, A_, K_, Q_) do { \
        const float ang = (float)(P_) * invf; \
        const double rev = (double)ang * 0.15915494309189535; const float frv = (float)(rev - __builtin_rint(rev)); \
        float cs = __builtin_amdgcn_cosf(frv), sn = __builtin_amdgcn_sinf(frv); \
        float ca[8], sa[8], ci[4], si[4]; \
        _Pragma("unroll") for (int i = 0; i < 8; ++i) { ca[i] = __int_as_float(__builtin_amdgcn_readlane(__float_as_int(cs), i)); sa[i] = __int_as_float(__builtin_amdgcn_readlane(__float_as_int(sn), i)); } \
        _Pragma("unroll") for (int i = 0; i < 4; ++i) { ci[i] = __int_as_float(__builtin_amdgcn_readlane(__float_as_int(cs), 8 + i)); si[i] = __int_as_float(__builtin_amdgcn_readlane(__float_as_int(sn), 8 + i)); } \
        { float f[8]; unpack8(A_, f); float ss = 0.f; \
          _Pragma("unroll") for (int i = 0; i < 8; ++i) ss += f[i] * f[i]; \
          ss += DPPF(ss, 0xB1); ss += DPPF(ss, 0x4E); ss += DPPF(ss, 0x141); \
          const float r = rsqrtf(ss * (1.f / 64.f) + EPS); \
          _Pragma("unroll") for (int i = 0; i < 8; ++i) f[i] = f[i] * r * gq[i]; \
          float o[8]; \
          _Pragma("unroll") for (int i = 0; i < 8; ++i) { const float p = DPPF(f[i], 0xB1); o[i] = (l7 == 0) ? (f[i] * ca[i] - p * sa[i]) : ((l7 == 1) ? (f[i] * ca[i] + p * sa[i]) : f[i]); o[i] *= 0.125f * 1.4426950408889634f; } \
          *(v4u*)(AQN + (size_t)(t) * 512 + aqcol) = pack8(o); } \
        { float f[8]; unpack8(K_, f); float ss = 0.f; \
          _Pragma("unroll") for (int i = 0; i < 8; ++i) ss += f[i] * f[i]; \
          ss += DPPF(ss, 0xB1); ss += DPPF(ss, 0x4E); ss += DPPF(ss, 0x141); \
          const float r = rsqrtf(ss * (1.f / 64.f) + EPS); \
          _Pragma("unroll") for (int i = 0; i < 8; ++i) f[i] = f[i] * r * gk[i]; \
          float o[8]; \
          _Pragma("unroll") for (int i = 0; i < 8; ++i) { const float p = DPPF(f[i], 0xB1); o[i] = (l7 == 0) ? (f[i] * ca[i] - p * sa[i]) : ((l7 == 1) ? (f[i] * ca[i] + p * sa[i]) : f[i]); } \
          if (lane < 16) *(v4u*)(KN + (size_t)(t) * 128 + akcol) = pack8(o); } \
        { const v2u rw = Q_; \
          float f[4] = {bf2f(rw.x & 0xffffu), bf2f(rw.x >> 16), bf2f(rw.y & 0xffffu), bf2f(rw.y >> 16)}; float o[4]; \
          _Pragma("unroll") for (int i = 0; i < 4; ++i) { const float p = DPPF(f[i], 0xB1); o[i] = (l7 == 0) ? (f[i] * ci[i] - p * si[i]) : ((l7 == 1) ? (f[i] * ci[i] + p * si[i]) : f[i]); } \
          v2u w; w.x = pk2(o[0], o[1]); w.y = pk2(o[2], o[3]); *(v2u*)(IQR + (size_t)(t) * 256 + 4 * lane) = w; } } while (0)
    { int pA, pB; v4u aA, aB, kA, kB; v2u qA, qB;
      P2_LOADROW(gw, pA, aA, kA, qA);
#pragma unroll 1
      for (int t = gw; t < T; t += 2 * NGW) {
          P2_LOADROW(t + NGW, pB, aB, kB, qB);
          P2_DOROW(t, pA, aA, kA, qA);
          P2_LOADROW(t + 2 * NGW, pA, aA, kA, qA);
          if (t + NGW < T) P2_DOROW(t + NGW, pB, aB, kB, qB);
      } }
#undef P2_LOADROW
#undef P2_DOROW
}
constexpr int ML_QS = 0, ML_KS = 17408, ML_HS = 0;
constexpr int ML_KWT = 34816;
constexpr int ML_VT = 53248;
constexpr int ML_SW = 73984;
constexpr int ML_CT = 83200;
constexpr int ML_GA = 122368;
constexpr int ML_CW = ML_GA + 1024;
constexpr int ML_END = ML_CW + (1024 + 384) * 4;
static_assert(ML_END <= MISC_OFF, "mLSTM LDS map");
constexpr size_t ML_STATE_BYTES = 8 * 9 * 64 * 16;
__device__ __forceinline__ bf16x8 lds_frag(const LAS unsigned char* base, int stride_b, int row0, int kb, int lane) {
    return *(const LAS bf16x8*)(base + (row0 + (lane & 15)) * stride_b + kb + (lane >> 4) * 16);
}
__device__ __forceinline__ bf16x8 lds_frag_sw(const LAS unsigned char* base, int row0, int ks, int lane) {
    const int row = row0 + (lane & 15); return *(const LAS bf16x8*)(base + row * 144 + 16 * (((ks * 4 + (lane >> 4)) + (row >> 3)) & 7));
}
#define MFMA16(a_, b_, c_) __builtin_amdgcn_mfma_f32_16x16x32_bf16(a_, b_, c_, 0, 0, 0)
constexpr int CV_NMI = 2 * (32 * 16 * 32 + 32 * 8 * 32);
constexpr int CV_SCR = ML_END, CV_SCRW = 32 * 33 * 4;
static_assert(CV_SCR + 8 * CV_SCRW <= MISC_OFF, "conversion scratch");
struct CvItem { const float* src; bf16* dst; int ldw, K; };
__device__ __forceinline__ CvItem cv_item(const Args& a, int mi) {
    const int it = mi >> 1, hk = mi & 1; CvItem r;
    if (it < 32 * 16 * 32) { const int e = it >> 9, q = it & 511, kb = q >> 5, nb = q & 31, t = nb >> 3, bj = (nb >> 2) & 1, i0 = (nb & 3) * 32, k0 = 64 * kb + 32 * hk;
        r.src = (bj ? a.in[IN_WEU] : a.in[IN_WEG]) + (size_t)e * 1024 * 512 + (size_t)k0 * 512 + 128 * t + i0; r.ldw = 512; r.K = 1024;
        r.dst = (bf16*)(a.ws + WS_GU) + ((size_t)e * 1024 + 32 * nb) * 1024 + k0;
    } else { const int r2 = it - 32 * 16 * 32, e = r2 >> 8, q = r2 & 255, kb = q >> 5, nb = q & 31, k0 = 64 * kb + 32 * hk;
        r.src = a.in[IN_WED] + (size_t)e * 512 * 1024 + (size_t)k0 * 1024 + 32 * nb; r.ldw = 1024; r.K = 512;
        r.dst = (bf16*)(a.ws + WS_DN) + ((size_t)e * 1024 + 32 * nb) * 512 + k0; }
    return r;
}
__device__ __forceinline__ void cv_load(const CvItem& it, f32x4 (&v)[4], int lane) {
#pragma unroll
    for (int i = 0; i < 4; ++i) v[i] = *(const f32x4*)(it.src + (size_t)(8 * i + (lane >> 3)) * it.ldw + 4 * (lane & 7));
}
__device__ __forceinline__ void cv_finish(const CvItem& it, const f32x4 (&v)[4], LAS float* scr, int lane, bool valid) {
#pragma unroll
    for (int i = 0; i < 4; ++i) { LAS float* d = scr + (8 * i + (lane >> 3)) * 33 + 4 * (lane & 7); d[0] = v[i][0]; d[1] = v[i][1]; d[2] = v[i][2]; d[3] = v[i][3]; }
    LDS_WAIT(); asm volatile("" ::: "memory");
#pragma unroll
    for (int j = 0; j < 2; ++j) { const int n = (lane >> 2) + 16 * j, cq = lane & 3; const LAS float* sp = scr + (8 * cq) * 33 + n;
        v4u o; o.x = pk2(sp[0 * 33], sp[1 * 33]); o.y = pk2(sp[2 * 33], sp[3 * 33]); o.z = pk2(sp[4 * 33], sp[5 * 33]); o.w = pk2(sp[6 * 33], sp[7 * 33]);
        if (valid) *(v4u*)(it.dst + (size_t)n * it.K + 8 * cq) = o; }
    LDS_WAIT(); asm volatile("" ::: "memory");
}
template <int MODE>
__device__ __forceinline__ void mlstm_unit(const Args& a, const Ctx& c, int b, int h, int g) {
    const int tid = c.tid, wave = c.wave; LAS unsigned char* lds = c.lds;
#define ML_LAUNDER() int tv_ = tid; asm volatile("" : "+v"(tv_)); const int lane = tv_ & 63, seg = tv_ & 15, r2 = (tv_ >> 4) * 2; (void)lane; (void)seg; (void)r2
    const bf16* PQ = proj_tile(a, TL_MQ + (h >> 1)) + (h & 1) * 128;
    const bf16* PK = proj_tile(a, TL_MK + (h >> 1)) + (h & 1) * 128;
    const bf16* PV = proj_tile(a, TL_MV + (h >> 1)) + (h & 1) * 128;
    const bf16* PO = proj_tile(a, TL_MO + (h >> 1)) + (h & 1) * 128;
    const bf16* PS = (const bf16*)((unsigned char*)a.out + DO_SMB);
    bf16* YML = (bf16*)((unsigned char*)a.out + DO_YML);
    unsigned char* STB = a.ws + WS_MLST; float* MST = (float*)(a.ws + WS_MLST + 256 * ML_STATE_BYTES);
    LAS float* GAa = (LAS float*)(lds + ML_GA); LAS float* GAm = GAa + 64; LAS float* GAw = GAa + 128; LAS float* GAe = GAa + 192;
    LAS float* CWQ = (LAS float*)(lds + ML_CW); LAS float* CWK = CWQ + 512; LAS float* CBQ = CWQ + 1024; LAS float* CBK = CBQ + 128; LAS float* GN = CBK + 128;
    LAS bf16* VTs = (LAS bf16*)(lds + ML_VT);
    { const float* wc = a.in[IN_WCONV]; const int j = tid >> 7, d = tid & 127;
      CWQ[tid] = wc[j * 1024 + h * 128 + d]; CWK[tid] = wc[j * 1024 + 512 + h * 128 + d];
      if (tid < 128) { CBQ[tid] = a.in[IN_BCONV][h * 128 + tid]; CBK[tid] = a.in[IN_BCONV][512 + h * 128 + tid]; GN[tid] = a.in[IN_GML][h * 128 + tid]; } }
    for (int i = tid; i < 16 * 64; i += 512) { const int r = i >> 6, cc = i & 63; VTs[(128 + r) * 72 + cc] = (r == 0) ? (bf16)0x3F80 : (bf16)0; }
    const float big = a.in[IN_BI][h], bfg = a.in[IN_BF][h];
    const int slot0 = (b * 4 + h) * 8;
    f32x4 cacc[9];
    float m_st = 0.f;
    if (MODE == 1 && g > 0) { ML_LAUNDER();
        const f32x4* sp = (const f32x4*)(STB + (size_t)(slot0 + g) * ML_STATE_BYTES) + wave * 576 + lane;
#pragma unroll
        for (int i = 0; i < 9; ++i) cacc[i] = sp[64 * i];
        m_st = MST[slot0 + g];
#pragma unroll
        for (int ee = 0; ee < 9; ++ee) { v2u w; w.x = pk2(cacc[ee][0], cacc[ee][1]); w.y = pk2(cacc[ee][2], cacc[ee][3]);
            *(LAS v2u*)(lds + ML_CT + (ee * 16 + (lane & 15)) * 272 + (wave * 16 + 4 * (lane >> 4)) * 2) = w; }
    } else {
#pragma unroll
        for (int i = 0; i < 9; ++i) cacc[i] = (f32x4){0.f, 0.f, 0.f, 0.f};
        for (int i = tid; i < 144 * 136 / 2; i += 512) ((LAS unsigned*)(lds + ML_CT))[i] = 0u;
    }
    const size_t tb = (size_t)b * SEQ;
    const char* bq = (const char*)(PQ + tb * 256); const char* bk = (const char*)(PK + tb * 256); const char* bv = (const char*)(PV + tb * 256); const char* bo = (const char*)(PO + tb * 256); const char* bs = (const char*)(PS + tb * 16);
    v4u rq[5], rk[5], rv[2]; unsigned short gi = 0, gf = 0;
#define ML_LOAD(kc) do { _Pragma("unroll") for (int j_ = 0; j_ < 5; ++j_) { const int rr_ = 64 * (kc) + r2 - 3 + j_; const unsigned o_ = (unsigned)((rr_ < 0 ? 0 : rr_) * 512 + seg * 16); \
            v4u q_ = (v4u){0u, 0u, 0u, 0u}; if (MODE == 1) q_ = *(const v4u*)(bq + o_); v4u k_ = *(const v4u*)(bk + o_); if (rr_ < 0) { q_ = (v4u){0u, 0u, 0u, 0u}; k_ = q_; } rq[j_] = q_; rk[j_] = k_; } \
        _Pragma("unroll") for (int i_ = 0; i_ < 2; ++i_) rv[i_] = *(const v4u*)(bv + (unsigned)((64 * (kc) + r2 + i_) * 512 + seg * 16)); \
        gi = *(const unsigned short*)(bs + (unsigned)((64 * (kc) + lane) * 32 + (8 + h) * 2)); gf = *(const unsigned short*)(bs + (unsigned)((64 * (kc) + lane) * 32 + (12 + h) * 2)); } while (0)
    const int kc0 = (MODE == 1) ? 8 * g : 0, kc1 = (MODE == 1) ? 8 * g + 8 : 56;
    { ML_LAUNDER(); ML_LOAD(kc0); }
    const int cv_gw = c.vcu * NWAVES + c.wave, cv_ngw = c.G * NWAVES; f32x4 cvv[4]; CvItem cvi; int cvk = 0; bool cvp = false;
    LAS float* cv_scr = (LAS float*)(lds + CV_SCR + wave * CV_SCRW);
#define CV_SLOT() do { if (MODE == 1) { ML_LAUNDER(); if (cvp) cv_finish(cvi, cvv, cv_scr, lane, cv_gw + (cvk - 1) * cv_ngw < CV_NMI); \
        { int mi_ = cv_gw + cvk * cv_ngw; mi_ = mi_ < CV_NMI ? mi_ : CV_NMI - 1; cvi = cv_item(a, __builtin_amdgcn_readfirstlane(mi_)); cv_load(cvi, cvv, lane); cvp = true; ++cvk; } } } while (0)
    __syncthreads();
#pragma unroll 1
    for (int kc = kc0; kc < kc1; ++kc) {
        float wkv, decay, m_new;
        if (MODE == 0 && kc > 0 && (kc & 7) == 0) { ML_LAUNDER();
            f32x4* sp = (f32x4*)(STB + (size_t)(slot0 + (kc >> 3)) * ML_STATE_BYTES) + wave * 576 + lane;
#pragma unroll
            for (int i = 0; i < 9; ++i) sp[64 * i] = cacc[i];
            if (tid == 0) MST[slot0 + (kc >> 3)] = m_st; }
        CV_SLOT();
        { ML_LAUNDER();
        const float fpre = bf2f(gf) + bfg, lf = fminf(fpre, 0.f) - log1pf(__expf(-fabsf(fpre)));
        const float ig = bf2f(gi) + big;
#define ML_SHR(x_, n_, id_) __int_as_float(__builtin_amdgcn_update_dpp(__float_as_int(id_), __float_as_int(x_), 0x110 + (n_), 0xF, 0xF, false))
        float bc = lf;
        bc += ML_SHR(bc, 1, 0.f); bc += ML_SHR(bc, 2, 0.f); bc += ML_SHR(bc, 4, 0.f); bc += ML_SHR(bc, 8, 0.f);
        { const float t0 = __int_as_float(__builtin_amdgcn_readlane(__float_as_int(bc), 15)), t1 = __int_as_float(__builtin_amdgcn_readlane(__float_as_int(bc), 31)), t2 = __int_as_float(__builtin_amdgcn_readlane(__float_as_int(bc), 47));
          bc += (lane >= 48) ? (t0 + t1 + t2) : ((lane >= 32) ? (t0 + t1) : ((lane >= 16) ? t0 : 0.f)); }
        const float av = ig - bc; float Ac = av;
        Ac = fmaxf(Ac, ML_SHR(Ac, 1, -3.0e38f)); Ac = fmaxf(Ac, ML_SHR(Ac, 2, -3.0e38f)); Ac = fmaxf(Ac, ML_SHR(Ac, 4, -3.0e38f)); Ac = fmaxf(Ac, ML_SHR(Ac, 8, -3.0e38f));
        { const float t0 = __int_as_float(__builtin_amdgcn_readlane(__float_as_int(Ac), 15)), t1 = __int_as_float(__builtin_amdgcn_readlane(__float_as_int(Ac), 31)), t2 = __int_as_float(__builtin_amdgcn_readlane(__float_as_int(Ac), 47));
          const float m01 = fmaxf(t0, t1), m012 = fmaxf(m01, t2);
          Ac = fmaxf(Ac, (lane >= 48) ? m012 : ((lane >= 32) ? m01 : ((lane >= 16) ? t0 : -3.0e38f))); }
#undef ML_SHR
        const float mA = fmaxf(m_st, Ac), Mk = __int_as_float(__builtin_amdgcn_readlane(__float_as_int(mA), 63)), blast = __int_as_float(__builtin_amdgcn_readlane(__float_as_int(bc), 63));
        wkv = __expf(av - Mk); decay = __expf(m_st - Mk); m_new = blast + Mk;
        if (MODE == 1 && wave == 0) { GAa[lane] = av; GAm[lane] = mA; GAw[lane] = __expf(m_st - mA); GAe[lane] = __expf(-(bc + mA)); } }
        { ML_LAUNDER(); float kw_[2][8];
#pragma unroll
          for (int i = 0; i < 2; ++i) { const int t = r2 + i; const float wkt = __shfl(wkv, t);
            float aq_[8], ak_[8];
            { const f32x4 b0 = *(const LAS f32x4*)(CBQ + seg * 8), b1 = *(const LAS f32x4*)(CBQ + seg * 8 + 4), c0 = *(const LAS f32x4*)(CBK + seg * 8), c1 = *(const LAS f32x4*)(CBK + seg * 8 + 4);
              aq_[0] = b0[0]; aq_[1] = b0[1]; aq_[2] = b0[2]; aq_[3] = b0[3]; aq_[4] = b1[0]; aq_[5] = b1[1]; aq_[6] = b1[2]; aq_[7] = b1[3];
              ak_[0] = c0[0]; ak_[1] = c0[1]; ak_[2] = c0[2]; ak_[3] = c0[3]; ak_[4] = c1[0]; ak_[5] = c1[1]; ak_[6] = c1[2]; ak_[7] = c1[3]; }
#pragma unroll
            for (int j = 0; j < 4; ++j) { float fk_[8]; unpack8(rk[i + j], fk_);
                const f32x4 x0 = *(const LAS f32x4*)(CWK + j * 128 + seg * 8), x1 = *(const LAS f32x4*)(CWK + j * 128 + seg * 8 + 4);
#pragma unroll
                for (int e = 0; e < 4; ++e) { ak_[e] += x0[e] * fk_[e]; ak_[4 + e] += x1[e] * fk_[4 + e]; }
                if (MODE == 1) { float fq_[8]; unpack8(rq[i + j], fq_);
                    const f32x4 w0 = *(const LAS f32x4*)(CWQ + j * 128 + seg * 8), w1 = *(const LAS f32x4*)(CWQ + j * 128 + seg * 8 + 4);
#pragma unroll
                    for (int e = 0; e < 4; ++e) { aq_[e] += w0[e] * fq_[e]; aq_[4 + e] += w1[e] * fq_[4 + e]; } } }
#pragma unroll
            for (int e = 0; e < 8; ++e) { ak_[e] = ak_[e] * sigm(ak_[e]) * 0.08838834764831845f; kw_[i][e] = ak_[e] * wkt; }
            if (MODE == 1) {
#pragma unroll
                for (int e = 0; e < 8; ++e) aq_[e] = aq_[e] * sigm(aq_[e]);
                *(LAS v4u*)(lds + ML_QS + t * 272 + seg * 16) = pack8(aq_);
                *(LAS v4u*)(lds + ML_KS + t * 272 + seg * 16) = pack8(ak_); } }
          const unsigned va[4] = {rv[0].x, rv[0].y, rv[0].z, rv[0].w}, vb[4] = {rv[1].x, rv[1].y, rv[1].z, rv[1].w};
          const int swo = 16 * (((r2 >> 3) + seg) & 7) + 2 * (r2 & 7);
#pragma unroll
          for (int e = 0; e < 8; ++e) { const int ro = (seg * 8 + e) * 144 + swo;
              *(LAS unsigned*)(lds + ML_KWT + ro) = pk2(kw_[0][e], kw_[1][e]);
              const unsigned lo = (e & 1) ? (va[e >> 1] >> 16) : (va[e >> 1] & 0xffffu), hi = (e & 1) ? (vb[e >> 1] >> 16) : (vb[e >> 1] & 0xffffu);
              *(LAS unsigned*)(lds + ML_VT + ro) = lo | (hi << 16); }
        if (kc + 1 < kc1) ML_LOAD(kc + 1); }
        __syncthreads();
        f32x4 hacc[5]; unsigned mo_r[8];
        const int tt = wave & 3, t0 = tt * 16, ne = (wave < 4) ? 5 : 4, e_first = (wave < 4) ? 0 : 5;
        CV_SLOT();
        if (MODE == 1) {
        { ML_LAUNDER(); const int tq = t0 + (lane & 15);
        bf16x8 qf[4];
#pragma unroll
        for (int ks = 0; ks < 4; ++ks) qf[ks] = lds_frag(lds + ML_QS, 272, t0, ks * 64, lane);
        const float mAt = GAm[tq], wit = GAw[tq];
#pragma unroll
        for (int si = 0; si < 2; ++si) { const int ss = 2 * (wave >> 2) + si, s0 = ss * 16; f32x4 sacc = (f32x4){0.f, 0.f, 0.f, 0.f};
            if (ss <= tt) {
#pragma unroll
                for (int ks = 0; ks < 4; ++ks) sacc = MFMA16(lds_frag(lds + ML_KS, 272, s0, ks * 64, lane), qf[ks], sacc);
#pragma unroll
                for (int r = 0; r < 4; ++r) { const int s = s0 + 4 * (lane >> 4) + r; sacc[r] = (s <= tq) ? sacc[r] * __expf(GAa[s] - mAt) : 0.f; } }
            v2u w; w.x = pk2(sacc[0], sacc[1]); w.y = pk2(sacc[2], sacc[3]);
            *(LAS v2u*)(lds + ML_SW + tq * 144 + s0 * 2 + (lane >> 4) * 8) = w; }
#pragma unroll
        for (int i = 0; i < 5; ++i) { hacc[i] = (f32x4){0.f, 0.f, 0.f, 0.f};
            if (i < ne) {
#pragma unroll
                for (int ks = 0; ks < 4; ++ks) hacc[i] = MFMA16(lds_frag(lds + ML_CT, 272, (e_first + i) * 16, ks * 64, lane), qf[ks], hacc[i]);
                hacc[i] = hacc[i] * wit; } }
#pragma unroll
        for (int i = 0; i < 8; ++i) mo_r[i] = *(const unsigned*)(bo + (unsigned)((64 * kc + 8 * wave + i) * 512 + 4 * lane)); }
        __syncthreads();
        { ML_LAUNDER(); const int tq = t0 + (lane & 15); bf16x8 swf[2];
#pragma unroll
          for (int ks = 0; ks < 2; ++ks) swf[ks] = lds_frag(lds + ML_SW, 144, t0, ks * 64, lane);
#pragma unroll
          for (int i = 0; i < 5; ++i) if (i < ne) { const int ee = e_first + i;
#pragma unroll
              for (int ks = 0; ks < 2; ++ks) hacc[i] = MFMA16(lds_frag_sw(lds + ML_VT, ee * 16, ks, lane), swf[ks], hacc[i]);
              if (ee < 8) *(LAS f32x4*)(lds + ML_HS + tq * 528 + (ee * 16 + 4 * (lane >> 4)) * 4) = hacc[i];
              else if ((lane >> 4) == 0) *(LAS float*)(lds + ML_HS + tq * 528 + 128 * 4) = hacc[i][0]; } }
        }
        CV_SLOT();
        { ML_LAUNDER(); const int d0 = wave * 16; bf16x8 kwf[2];
#pragma unroll
          for (int ks = 0; ks < 2; ++ks) kwf[ks] = lds_frag_sw(lds + ML_KWT, d0, ks, lane);
#pragma unroll
          for (int ee = 0; ee < 9; ++ee) { cacc[ee] = cacc[ee] * decay;
#pragma unroll
              for (int ks = 0; ks < 2; ++ks) cacc[ee] = MFMA16(kwf[ks], lds_frag_sw(lds + ML_VT, ee * 16, ks, lane), cacc[ee]);
              if (MODE == 1) { v2u w; w.x = pk2(cacc[ee][0], cacc[ee][1]); w.y = pk2(cacc[ee][2], cacc[ee][3]);
                  *(LAS v2u*)(lds + ML_CT + (ee * 16 + (lane & 15)) * 272 + (d0 + 4 * (lane >> 4)) * 2) = w; } } }
        __syncthreads();
        if (MODE == 1) {
        { ML_LAUNDER();
#pragma unroll
        for (int i = 0; i < 8; ++i) { const int t = 8 * wave + i;
            const f32x2 nv = *(const LAS f32x2*)(lds + ML_HS + t * 528 + lane * 8); const float den = *(const LAS float*)(lds + ML_HS + t * 528 + 512);
            const float dd = fmaxf(fabsf(den), GAe[t]); const float h0 = nv.x / dd, h1 = nv.y / dd;
            const float r = rsqrtf(wave_sum(h0 * h0 + h1 * h1) * (1.f / 128.f) + EPS);
            const float y0 = h0 * r * GN[2 * lane] * sigm(bf2f(mo_r[i] & 0xffffu)), y1 = h1 * r * GN[2 * lane + 1] * sigm(bf2f(mo_r[i] >> 16));
            *(unsigned*)(YML + (tb + 64 * kc + t) * 512 + h * 128 + 2 * lane) = pk2(y0, y1); } }
        __syncthreads();
        }
        m_st = m_new;
    }
    if (MODE == 1) { ML_LAUNDER(); if (cvp) cv_finish(cvi, cvv, cv_scr, lane, cv_gw + (cvk - 1) * cv_ngw < CV_NMI); }
#undef CV_SLOT
    if (MODE == 0) { ML_LAUNDER();
        f32x4* sp = (f32x4*)(STB + (size_t)(slot0 + 7) * ML_STATE_BYTES) + wave * 576 + lane;
#pragma unroll
        for (int i = 0; i < 9; ++i) sp[64 * i] = cacc[i];
        if (tid == 0) MST[slot0 + 7] = m_st; }
#undef ML_LOAD
#undef ML_LAUNDER
}
constexpr int AT_HIST = 0;
constexpr int AT_HROW = 2049;
constexpr int AT_SEL = 131072 + 256;
constexpr int AT_MROW = 129;
constexpr int AT_SM = AT_SEL + 8448;
constexpr int AT_LUT = AT_SM + 256;
constexpr int AT_SEL2 = AT_LUT + 256;
static_assert(AT_SEL2 + 8448 <= MISC_OFF, "attention LDS map");
__device__ __forceinline__ unsigned at_bin(float s, float inv) { const float x = __builtin_fmaf(s, inv, 2048.0f); return (unsigned)(int)__builtin_amdgcn_fmed3f(x, 0.0f, 4095.0f); }
__device__ __forceinline__ unsigned score_key(float s) { unsigned u = __float_as_uint(s + 0.0f); return (u & 0x80000000u) ? ~u : (u | 0x80000000u); }
__device__ __forceinline__ unsigned wave_suffix_sum(unsigned v, int lane) {
#define AT_SHL(x_, n_) ((unsigned)__builtin_amdgcn_update_dpp(0, (int)(x_), 0x100 + (n_), 0xF, 0xF, false))
    v += AT_SHL(v, 1); v += AT_SHL(v, 2); v += AT_SHL(v, 4); v += AT_SHL(v, 8);
#undef AT_SHL
    const unsigned t1 = (unsigned)__builtin_amdgcn_readlane((int)v, 16), t2 = (unsigned)__builtin_amdgcn_readlane((int)v, 32), t3 = (unsigned)__builtin_amdgcn_readlane((int)v, 48);
    return v + ((lane < 16) ? (t1 + t2 + t3) : ((lane < 32) ? (t2 + t3) : ((lane < 48) ? t3 : 0u)));
}
template <int NK> __device__ __forceinline__ void at_resolve2(const LAS unsigned long long* candA, LAS unsigned* maskA, int mA, int ndA,
                                                              const LAS unsigned long long* candB, LAS unsigned* maskB, int mB, int ndB, int lane) {
    unsigned long long ca[NK], cb[NK];
#pragma unroll
    for (int k = 0; k < NK; ++k) { const int i = 64 * k + lane; unsigned long long x = 0ull, y = 0ull; if (i < mA) x = candA[i]; if (i < mB) y = candB[i];
        ca[k] = (i < mA) ? (((x >> 32) << 16) | (x & 0xFFFFull)) : 0ull; cb[k] = (i < mB) ? (((y >> 32) << 16) | (y & 0xFFFFull)) : 0ull; }
    unsigned long long TA = 0ull, TB = 0ull;
#pragma unroll 1
    for (int bit = 47; bit >= 16; --bit) { const unsigned long long ta = TA | (1ull << bit), tb = TB | (1ull << bit); int ga = 0, gb = 0;
#pragma unroll
        for (int k = 0; k < NK; ++k) { ga += __popcll(__ballot(ca[k] >= ta)); gb += __popcll(__ballot(cb[k] >= tb)); }
        if (ga >= ndA) TA = ta; if (gb >= ndB) TB = tb; }
    int gA = 0, tA = 0, gB = 0, tB = 0;
#pragma unroll
    for (int k = 0; k < NK; ++k) { gA += __popcll(__ballot(ca[k] >= TA + 0x10000ull)); tA += __popcll(__ballot(ca[k] >= TA)); gB += __popcll(__ballot(cb[k] >= TB + 0x10000ull)); tB += __popcll(__ballot(cb[k] >= TB)); }
    tA -= gA; tB -= gB;
    if (tA > ndA - gA || tB > ndB - gB) {
#pragma unroll 1
        for (int bit = 15; bit >= 0; --bit) { const unsigned long long ta = TA | (1ull << bit), tb = TB | (1ull << bit); int ga = 0, gb = 0;
#pragma unroll
            for (int k = 0; k < NK; ++k) { ga += __popcll(__ballot(ca[k] >= ta)); gb += __popcll(__ballot(cb[k] >= tb)); }
            if (ga >= ndA) TA = ta; if (gb >= ndB) TB = tb; } }
#pragma unroll
    for (int k = 0; k < NK; ++k) {
        if (ca[k] >= TA && ca[k] != 0ull) { const unsigned key = 0xFFFFu - (unsigned)(ca[k] & 0xFFFFull);
            __hip_atomic_fetch_or(&maskA[key >> 5], 1u << (key & 31u), __ATOMIC_RELAXED, __HIP_MEMORY_SCOPE_WORKGROUP); }
        if (cb[k] >= TB && cb[k] != 0ull) { const unsigned key = 0xFFFFu - (unsigned)(cb[k] & 0xFFFFull);
            __hip_atomic_fetch_or(&maskB[key >> 5], 1u << (key & 31u), __ATOMIC_RELAXED, __HIP_MEMORY_SCOPE_WORKGROUP); } }
}
__device__ __forceinline__ void attn_unit(const Args& a, const Ctx& c, int b, int qt, float cshift) {
    const int tid = c.tid, wave = c.wave; LAS unsigned char* lds = c.lds;
#define AT_LAUNDER() int tv_ = tid; asm volatile("" : "+v"(tv_)); const int lane = tv_ & 63, qi = tv_ & 15, fq = (tv_ >> 4) & 3; (void)lane; (void)qi; (void)fq
    const int q0u = qt * 32, ch = q0u >> 6, n = 64 * (ch + 1), ntiles = n >> 4;
    const size_t tb = (size_t)b * SEQ;
    unsigned char* dout = (unsigned char*)a.out;
    const bf16* AQN = (const bf16*)(dout + DO_AQN); const bf16* KN = (const bf16*)(dout + DO_KN); const bf16* IQR = (const bf16*)(dout + DO_IQR); const bf16* IKR = (const bf16*)(dout + DO_IKR);
    bf16* YATT = (bf16*)(dout + DO_YATT);
    const bf16* VB = proj_tile(a, TL_KV); const bf16* PS = (const bf16*)(dout + DO_SMB);
    LAS unsigned* HIST = (LAS unsigned*)(lds + AT_HIST);
    LAS unsigned long long* CAND = (LAS unsigned long long*)(lds + AT_HIST);
    LAS int* SM = (LAS int*)(lds + AT_SM);
    float* SC = (blockIdx.x < 240) ? (float*)(a.ws + WS_SC) + (size_t)blockIdx.x * (16 * 4096) : (float*)(a.ws + WS_SC2) + (size_t)(blockIdx.x - 240) * (16 * 4096);
#ifndef DBG_REP_DENSE
#define DBG_REP_DENSE 1
#endif
#pragma unroll 1
    for (int rsel = 0; rsel < 2; ++rsel) {
    const int q0 = q0u + 16 * rsel;
    LAS unsigned* MASK = (LAS unsigned*)(lds + (rsel ? AT_SEL2 : AT_SEL));
    if (n > 256) {
        for (int i = tid; i < 8192 + 4; i += 512) ((LAS v4u*)HIST)[i] = (v4u){0u, 0u, 0u, 0u};
        if (tid < 64) SM[tid] = 0;
        for (int i = tid; i < 16 * AT_MROW; i += 512) MASK[i] = 0u;
        bf16x8 qf[8]; float wv[8]; bf16x8 qsh, qsl; float binv;
        { AT_LAUNDER();
        const size_t trow = tb + q0 + qi;
#pragma unroll
        for (int h = 0; h < 8; ++h) qf[h] = *(const bf16x8*)(IQR + trow * 256 + h * 32 + 8 * fq);
        { float t8[8]; unpack8(*(const v4u*)(PS + trow * 16), t8);
#pragma unroll
          for (int h = 0; h < 8; ++h) wv[h] = t8[h] * 0.03125f; }
        { float rq = 0.f;
#pragma unroll
          for (int h = 0; h < 8; ++h) { float f8[8]; unpack8(__builtin_bit_cast(v4u, qf[h]), f8); float q2 = 0.f;
#pragma unroll
            for (int j = 0; j < 8; ++j) q2 = __builtin_fmaf(f8[j], f8[j], q2);
            q2 += __shfl_xor(q2, 16); q2 += __shfl_xor(q2, 32);
            rq = __builtin_fmaf(fabsf(wv[h]), __builtin_sqrtf(q2), rq); }
          const float kmax = __builtin_sqrtf(__uint_as_float(__hip_atomic_load((const unsigned*)(a.ws + WS_CTL) + CW_KMAX + 16 * b, __ATOMIC_RELAXED, __HIP_MEMORY_SCOPE_AGENT)));
          binv = 2048.0f / fmaxf(rq * kmax, 1.0e-30f); }
        { float qs[8];
#pragma unroll
          for (int j = 0; j < 8; ++j) qs[j] = 0.f;
#pragma unroll
          for (int h = 0; h < 8; ++h) { float f8[8]; unpack8(__builtin_bit_cast(v4u, qf[h]), f8);
#pragma unroll
            for (int j = 0; j < 8; ++j) qs[j] = __builtin_fmaf(wv[h], f8[j], qs[j]); }
          float hi8[8], lo8[8]; const v4u ph = pack8(qs); unpack8(ph, hi8);
#pragma unroll
          for (int j = 0; j < 8; ++j) lo8[j] = qs[j] - hi8[j];
          qsh = __builtin_bit_cast(bf16x8, ph); qsl = __builtin_bit_cast(bf16x8, pack8(lo8)); } }
        __syncthreads();
#define AT_LOADK(kt_) (*(const bf16x8*)(IKR + (tb + (size_t)(kt_) * 16 + qi) * 32 + 8 * fq))
#define AT_SCORES(kf_, sc_) do { \
        { const f32x4 l0_ = MFMA16(kf_, qsl, ((f32x4){0.f, 0.f, 0.f, 0.f})); const f32x4 l1_ = MFMA16(kf_, qsh, l0_); \
          _Pragma("unroll") for (int r_ = 0; r_ < 4; ++r_) sc_[r_] = l1_[r_]; } \
        _Pragma("unroll") for (int h_ = 0; h_ < 8; ++h_) { const f32x4 d_ = MFMA16(kf_, qf[h_], ((f32x4){0.f, 0.f, 0.f, 0.f})); \
            _Pragma("unroll") for (int r_ = 0; r_ < 4; ++r_) { sc_[r_] = __builtin_fmaf(wv[h_], __builtin_fabsf(d_[r_]), sc_[r_]); asm("" : "+v"(sc_[r_])); } } } while (0)
        const int cnt = (ntiles - wave + 7) >> 3;
#ifndef DBG_RA
#define DBG_RA 1
#endif
#pragma unroll 1
        for (int rA = 0; rA < DBG_RA; ++rA) { if (rA) { for (int i = tid; i < 8192 + 4; i += 512) ((LAS v4u*)HIST)[i] = (v4u){0u, 0u, 0u, 0u}; __syncthreads(); }
#define AT_LOADG(dst_, i0_) do { _Pragma("unroll") for (int j_ = 0; j_ < 8; ++j_) { int kt_ = wave + 8 * ((i0_) + j_); kt_ = kt_ < ntiles ? kt_ : ntiles - 1; dst_[j_] = AT_LOADK(kt_); } } while (0)
#define AT_P1GROUP(buf_, base_) do { _Pragma("unroll") for (int j2 = 0; j2 < 8; ++j2) { const bool valid = ((base_) + j2 < cnt); const int kt = wave + 8 * ((base_) + j2); float sc[4]; AT_SCORES(buf_[j2], sc); \
                if (valid) *(f32x4*)(SC + qi * 4096 + kt * 16 + 4 * fq) = (f32x4){sc[0], sc[1], sc[2], sc[3]}; \
                _Pragma("unroll") for (int r = 0; r < 4; ++r) { const unsigned bin = at_bin(sc[r], binv); \
                    __hip_atomic_fetch_add(&HIST[qi * AT_HROW + (bin >> 1)], valid ? (1u << ((bin & 1u) * 16)) : 0u, __ATOMIC_RELAXED, __HIP_MEMORY_SCOPE_WORKGROUP); } } } while (0)
        { AT_LAUNDER(); bf16x8 ka[8], kb[8]; AT_LOADG(ka, 0);
#pragma unroll 1
          for (int i0 = 0; i0 < cnt; i0 += 16) {
            AT_LOADG(kb, i0 + 8);
            AT_P1GROUP(ka, i0);
            AT_LOADG(ka, i0 + 16);
            AT_P1GROUP(kb, i0 + 8); } }
#undef AT_P1GROUP
        __syncthreads();
        }
#ifndef DBG_RB
#define DBG_RB 1
#endif
#pragma unroll 1
        for (int rB = 0; rB < DBG_RB; ++rB) {
#pragma unroll 1
        for (int j = 0; j < 2; ++j) { AT_LAUNDER(); const int q = 2 * wave + j; unsigned tot = 0;
            for (int i = 0; i < 32; ++i) { const unsigned w = HIST[q * AT_HROW + 32 * lane + ((i + lane) & 31)]; tot += (w & 0xffffu) + (w >> 16); }
            const unsigned suf = wave_suffix_sum(tot, lane);
            const unsigned long long mk = __ballot(suf >= 256u); const int L = 63 - __clzll((long long)mk);
            const unsigned above_L = (unsigned)__builtin_amdgcn_readlane((int)(suf - tot), L);
            const unsigned w2 = HIST[q * AT_HROW + 32 * L + (lane >> 1)]; const unsigned cb = (lane & 1) ? (w2 >> 16) : (w2 & 0xffffu);
            const unsigned sfx = wave_suffix_sum(cb, lane);
            const unsigned long long mk2 = __ballot(above_L + sfx >= 256u); const int l2 = 63 - __clzll((long long)mk2);
            if (lane == l2) { SM[q] = 64 * L + l2; SM[16 + q] = (int)(256u - (above_L + sfx - cb)); } }
        __syncthreads();
        }
#ifndef DBG_RC
#define DBG_RC 1
#endif
#pragma unroll 1
        for (int rC = 0; rC < DBG_RC; ++rC) { if (rC) { if (tid < 16) SM[48 + tid] = 0; __syncthreads(); }
        { AT_LAUNDER(); const int Bq = SM[qi]; f32x4 scur[8];
#define AT_LOADS(dst_, i0_) do { _Pragma("unroll") for (int j_ = 0; j_ < 8; ++j_) { int kt_ = wave + 8 * ((i0_) + j_); kt_ = kt_ < ntiles ? kt_ : ntiles - 1; dst_[j_] = *(const f32x4*)(SC + qi * 4096 + kt_ * 16 + 4 * fq); } } while (0)
#define AT_P2GROUP(buf_, base_) do { _Pragma("unroll") for (int j2 = 0; j2 < 8; ++j2) { const bool valid = ((base_) + j2 < cnt); const int kt = wave + 8 * ((base_) + j2); \
                unsigned nib = 0u, cnib = 0u; unsigned uu[4]; \
                _Pragma("unroll") for (int r = 0; r < 4; ++r) { uu[r] = __float_as_uint(buf_[j2][r]); const int bin = (int)at_bin(buf_[j2][r], binv); nib |= (bin > Bq) ? (1u << r) : 0u; cnib |= (bin == Bq) ? (1u << r) : 0u; } \
                if (!valid) { nib = 0u; cnib = 0u; } \
                if (cnib) { int p = __hip_atomic_fetch_add(&SM[48 + qi], (int)__popc(cnib), __ATOMIC_RELAXED, __HIP_MEMORY_SCOPE_WORKGROUP); \
                    _Pragma("unroll") for (int r = 0; r < 4; ++r) if ((cnib >> r) & 1u) { if (p < 512) CAND[qi * 1024 + p] = ((unsigned long long)score_key(__uint_as_float(uu[r])) << 32) | (unsigned long long)(0xFFFFu - (unsigned)(kt * 16 + 4 * fq + r)); ++p; } } \
                if (nib) __hip_atomic_fetch_or(&MASK[qi * AT_MROW + (kt >> 1)], nib << (16 * (kt & 1) + 4 * fq), __ATOMIC_RELAXED, __HIP_MEMORY_SCOPE_WORKGROUP); } } while (0)
          f32x4 sb2[8];
          AT_LOADS(scur, 0);
#pragma unroll 1
          for (int i0 = 0; i0 < cnt; i0 += 16) {
            AT_LOADS(sb2, i0 + 8);
            AT_P2GROUP(scur, i0);
            AT_LOADS(scur, i0 + 16);
            AT_P2GROUP(sb2, i0 + 8); } }
#undef AT_P2GROUP
#undef AT_LOADS
        __syncthreads();
        }
#ifndef DBG_RD
#define DBG_RD 1
#endif
#pragma unroll 1
        for (int rD = 0; rD < DBG_RD; ++rD) {
        { AT_LAUNDER(); const int qa_ = 2 * wave, qb_ = 2 * wave + 1; int ma = SM[48 + qa_], mb = SM[48 + qb_]; ma = ma < 512 ? ma : 512; mb = mb < 512 ? mb : 512; const int nda = SM[16 + qa_], ndb = SM[16 + qb_];
            const int mm = ma > mb ? ma : mb;
            if (mm <= 64) at_resolve2<1>(CAND + qa_ * 1024, MASK + qa_ * AT_MROW, ma, nda, CAND + qb_ * 1024, MASK + qb_ * AT_MROW, mb, ndb, lane);
            else if (mm <= 256) at_resolve2<4>(CAND + qa_ * 1024, MASK + qa_ * AT_MROW, ma, nda, CAND + qb_ * 1024, MASK + qb_ * AT_MROW, mb, ndb, lane);
            else at_resolve2<8>(CAND + qa_ * 1024, MASK + qa_ * AT_MROW, ma, nda, CAND + qb_ * 1024, MASK + qb_ * AT_MROW, mb, ndb, lane); }
        __syncthreads();
        }
#undef AT_SCORES
#undef AT_LOADK
#undef AT_LOADG
    } else {
#pragma unroll 1
        for (int i = tid; i < 16 * AT_MROW; i += 512) MASK[i] = ((i % AT_MROW) < (n >> 5)) ? 0xFFFFFFFFu : 0u;
        __syncthreads();
    }
    }
#pragma unroll 1
    for (int rden = 0; rden < DBG_REP_DENSE; ++rden) {
    { const int g = wave >> 2, qh = (wave >> 1) & 1, hp = wave & 1, NS = n >> 6;
      const unsigned ring0 = (unsigned)(size_t)(lds + AT_HIST);
      if (tid < 64) *(LAS float*)(lds + AT_LUT + 4 * tid) = ((tid >> 2) >> (tid & 3)) & 1 ? -cshift : -1.0e30f;
      const bf16* dsrc[4]; unsigned ddst[4];
      { AT_LAUNDER();
#pragma unroll
        for (int i_ = 0; i_ < 4; ++i_) { const int in_ = 4 * wave + i_; const int row_ = 4 * (in_ & 15) + (lane >> 4), pos_ = lane & 15;
            dsrc[i_] = (in_ < 16) ? (KN + (tb + row_) * 128 + ((pos_ ^ (row_ & 15)) << 3)) : (VB + (tb + row_) * 256 + 128 + ((pos_ ^ (2 * (row_ & 7))) << 3));
            ddst[i_] = (unsigned)(in_ * 1024); } }
      const size_t dstep = (wave < 4) ? (size_t)64 * 128 : (size_t)64 * 256;
#define AT_STAGE(s_) do { const unsigned sb_ = ring0 + (unsigned)(((s_) & 3) * 32768); \
        _Pragma("unroll") for (int i_ = 0; i_ < 4; ++i_) { const bf16* src_ = dsrc[i_] + (size_t)(s_) * dstep; \
            const unsigned dst_ = __builtin_amdgcn_readfirstlane(sb_ + ddst[i_]); unsigned keep_; \
            asm volatile("s_mov_b32 %0, m0\n\ts_mov_b32 m0, %2\n\ts_nop 0\n\tglobal_load_lds_dwordx4 %1, off\n\ts_mov_b32 m0, %0" : "=&s"(keep_) : "v"(src_), "s"(dst_) : "memory"); } } while (0)
      bf16x8 qa[2], qb[2]; f32x4 oacc[2][4], lacc[2];
      { AT_LAUNDER();
#pragma unroll
        for (int hi = 0; hi < 2; ++hi) { const bf16* qp = AQN + (tb + q0u + 16 * qh + qi) * 512 + (g * 4 + 2 * hp + hi) * 64 + 8 * fq; qa[hi] = *(const bf16x8*)qp; qb[hi] = *(const bf16x8*)(qp + 32); } }
#pragma unroll
      for (int hi = 0; hi < 2; ++hi) { lacc[hi] = (f32x4){0.f, 0.f, 0.f, 0.f};
#pragma unroll
        for (int dt = 0; dt < 4; ++dt) oacc[hi][dt] = (f32x4){0.f, 0.f, 0.f, 0.f}; }
      const bf16x8 ones = (bf16x8){0x3F80, 0x3F80, 0x3F80, 0x3F80, 0x3F80, 0x3F80, 0x3F80, 0x3F80};
      asm volatile("s_waitcnt vmcnt(0)" ::: "memory");
#pragma unroll 1
      for (int s = 0; s < 3 && s < NS; ++s) AT_STAGE(s);
      typedef short s4_t __attribute__((ext_vector_type(4)));
      AT_LAUNDER();
      const LAS unsigned* mrow = (const LAS unsigned*)(lds + (qh ? AT_SEL2 : AT_SEL)) + qi * AT_MROW;
      const unsigned koff0 = (unsigned)(qi * 256 + (((g * 8 + fq) ^ qi) << 4)), koff1 = (unsigned)(qi * 256 + (((g * 8 + 4 + fq) ^ qi) << 4));
#define AT_LDK(kf_, ci_, slot_, tp_, mw_) do { const LAS unsigned char* kb_ = lds + AT_HIST + (slot_) * 32768 + (tp_) * 8192; \
          _Pragma("unroll") for (int t = 0; t < 2; ++t) { kf_[t][0] = *(const LAS bf16x8*)(kb_ + t * 4096 + koff0); kf_[t][1] = *(const LAS bf16x8*)(kb_ + t * 4096 + koff1); \
              ci_[t] = *(const LAS f32x4*)(lds + AT_LUT + ((((mw_) >> (16 * t + 4 * fq)) & 15u) << 4)); } } while (0)
#define AT_LDV(va_, slot_, vkh_) do { const LAS unsigned char* vb_ = lds + AT_HIST + (slot_) * 32768 + 16384 + (vkh_) * 8192; \
          _Pragma("unroll") for (int dt = 0; dt < 4; ++dt) { const int r1 = 4 * fq + (qi >> 2); const int ch_ = g * 8 + 2 * dt + ((lane & 3) >> 1); \
              const s4_t lo = __builtin_amdgcn_ds_read_tr16_b64_v4i16((LAS s4_t*)(vb_ + r1 * 256 + ((ch_ ^ (2 * (r1 & 7))) << 4) + (lane & 1) * 8)); \
              const s4_t hi4 = __builtin_amdgcn_ds_read_tr16_b64_v4i16((LAS s4_t*)(vb_ + (r1 + 16) * 256 + ((ch_ ^ (2 * (r1 & 7))) << 4) + (lane & 1) * 8)); \
              va_[dt] = (bf16x8){lo[0], lo[1], lo[2], lo[3], hi4[0], hi4[1], hi4[2], hi4[3]}; } } while (0)
#define AT_QKM(dst_, kf_, ci_) do { \
          _Pragma("unroll") for (int t = 0; t < 2; ++t) { \
              _Pragma("unroll") for (int hi = 0; hi < 2; ++hi) { const f32x4 d_ = MFMA16(kf_[t][0], qa[hi], ci_[t]); dst_[hi][t] = MFMA16(kf_[t][1], qb[hi], d_); } } } while (0)
#define AT_EXP(pb_, cur_) do { \
          _Pragma("unroll") for (int hi = 0; hi < 2; ++hi) { float pv[8]; \
              _Pragma("unroll") for (int j = 0; j < 8; ++j) pv[j] = __builtin_amdgcn_exp2f(cur_[hi][j >> 2][j & 3]); \
              v4u pw; pw.x = pk2(pv[0], pv[1]); pw.y = pk2(pv[2], pv[3]); pw.z = pk2(pv[4], pv[5]); pw.w = pk2(pv[6], pv[7]); pb_[hi] = __builtin_bit_cast(bf16x8, pw); } } while (0)
#define AT_PV(pb_, va_) do { \
          _Pragma("unroll") for (int hi = 0; hi < 2; ++hi) lacc[hi] = MFMA16(ones, pb_[hi], lacc[hi]); \
          _Pragma("unroll") for (int dt = 0; dt < 4; ++dt) { \
              _Pragma("unroll") for (int hi = 0; hi < 2; ++hi) oacc[hi][dt] = MFMA16(va_[dt], pb_[hi], oacc[hi][dt]); } } while (0)
      f32x4 st0[2][2], st1[2][2]; bf16x8 kfA[2][2], kfB[2][2]; f32x4 ciA[2], ciB[2]; bf16x8 vaP[4], vaQ[4], pbP[2], pbQ[2];
      if (NS >= 3) asm volatile("s_waitcnt vmcnt(8)" ::: "memory"); else asm volatile("s_waitcnt vmcnt(0)" ::: "memory");
      __builtin_amdgcn_s_barrier(); asm volatile("" ::: "memory");
      unsigned m1A, m1B;
      { const unsigned m0A = mrow[0], m0B = mrow[1]; const int sx = (NS > 1) ? 1 : 0; m1A = mrow[2 * sx]; m1B = mrow[2 * sx + 1];
        AT_LDK(kfB, ciB, 0, 0, m0A); AT_LDK(kfA, ciA, 0, 1, m0B);
        AT_QKM(st0, kfB, ciB);
#pragma unroll
        for (int hi = 0; hi < 2; ++hi) pbP[hi] = (bf16x8){0, 0, 0, 0, 0, 0, 0, 0};
#pragma unroll
        for (int dt = 0; dt < 4; ++dt) vaP[dt] = (bf16x8){0, 0, 0, 0, 0, 0, 0, 0}; }
#pragma unroll 1
      for (int s = 0; s < NS; ++s) {
          if (s + 2 < NS) asm volatile("s_waitcnt vmcnt(4)" ::: "memory"); else asm volatile("s_waitcnt vmcnt(0)" ::: "memory");
          __builtin_amdgcn_s_barrier(); asm volatile("" ::: "memory");
          if (s + 3 < NS) AT_STAGE(s + 3);
          const int s1 = (s + 1 < NS) ? s + 1 : s, s2 = (s + 2 < NS) ? s + 2 : NS - 1;
          const unsigned m2A = mrow[2 * s2], m2B = mrow[2 * s2 + 1];
          AT_LDK(kfB, ciB, (s1 & 3), 0, m1A); AT_LDV(vaQ, (s & 3), 0);
          AT_QKM(st1, kfA, ciA); AT_EXP(pbQ, st0); AT_PV(pbP, vaP);
          __builtin_amdgcn_sched_barrier(0);
          AT_LDK(kfA, ciA, (s1 & 3), 1, m1B); AT_LDV(vaP, (s & 3), 1);
          AT_QKM(st0, kfB, ciB); AT_EXP(pbP, st1); AT_PV(pbQ, vaQ);
          __builtin_amdgcn_sched_barrier(0);
          m1A = m2A; m1B = m2B; }
      AT_PV(pbP, vaP);
#undef AT_LDK
#undef AT_LDV
#undef AT_QKM
#undef AT_EXP
#undef AT_PV
      { AT_LAUNDER();
#pragma unroll
        for (int hi = 0; hi < 2; ++hi) { const float inv = 1.0f / lacc[hi][0];
            bf16* yp = YATT + (tb + q0u + 16 * qh + qi) * 512 + (g * 4 + 2 * hp + hi) * 64 + 4 * fq;
#pragma unroll
            for (int dt = 0; dt < 4; ++dt) { const f32x4 o = oacc[hi][dt];
                v2u w; w.x = pk2(o[0] * inv, o[1] * inv); w.y = pk2(o[2] * inv, o[3] * inv); *(v2u*)(yp + 16 * dt) = w; } } }
#undef AT_STAGE
    }
    __syncthreads();
    }
#undef AT_LAUNDER
    __syncthreads();
}

#ifndef DBG_REP_ML
#define DBG_REP_ML 1
#endif
#ifndef DBG_REP_ATT
#define DBG_REP_ATT 1
#endif
__device__ __forceinline__ void p3_mixer(const Args& a, const Ctx& c, volatile LAS unsigned* MISC, int rep) {
#if !defined(NO_MLSTM)
#pragma unroll 1
    for (int rr = 0; rr < DBG_REP_ML; ++rr)
#pragma unroll 1
        for (int u = blockIdx.x; u < 32; u += c.G) mlstm_unit<0>(a, c, u >> 2, u & 3, 0);
#endif
    unsigned* ctl = (unsigned*)(a.ws + WS_CTL);
    const int x = (int)(__builtin_amdgcn_s_getreg((3 << 11) | 20) & 7u);
    float cshift;
    { float gq = fabsf(a.in[IN_GQ][c.lane]), gk = fabsf(a.in[IN_GK][c.lane]);
#pragma unroll
      for (int o = 1; o < 64; o <<= 1) { gq = fmaxf(gq, __shfl_xor(gq, o)); gk = fmaxf(gk, __shfl_xor(gk, o)); }
      cshift = 8.0f * 1.4426950408889634f * gq * gk; }
#pragma unroll 1
    for (int rot = 0; rot < 8 * DBG_REP_ATT; ++rot) { rep = rot >> 3; const int bq = (x + rot) & 7;
        if (c.tid == 0) MISC[16] = __hip_atomic_fetch_add(ctl + CW_Q + 512 * rep + 64 * bq, 1u, RLX_AGENT);
        __syncthreads();
        int u = (int)MISC[16];
        __syncthreads();
#pragma unroll 1
        while (u < 128) {
            unsigned nxt = 0u;
            if (c.tid == 0) nxt = __hip_atomic_fetch_add(ctl + CW_Q + 512 * rep + 64 * bq, 1u, RLX_AGENT);
#if !defined(NO_ATTN)
            attn_unit(a, c, bq, 127 - u, cshift);
#endif
            if (c.tid == 0) MISC[16] = nxt;
            __syncthreads();
            u = (int)MISC[16];
            __syncthreads();
        } }
}
constexpr int RT_WT = 0;
constexpr int RT_WROW = 1028;
constexpr int RT_WBYTES = 36 * RT_WROW * 4;
constexpr int RT_NPIECE = (RT_WBYTES + 1023) / 1024;
constexpr int RT_LG = 0;
constexpr int RT_RSTD = RT_NPIECE * 1024;
constexpr int RT_LCNT = RT_RSTD + 512;
constexpr int RT_BIAS = RT_LCNT + 128;
static_assert(RT_BIAS + 144 <= MISC_OFF, "router LDS map");
__device__ __forceinline__ void p6_router(const Args& a, const Ctx& c) {
    const int tid = c.tid, lane = c.lane, wave = c.wave; LAS unsigned char* lds = c.lds;
    LAS float* WT = (LAS float*)(lds + RT_WT); LAS float* LG = (LAS float*)(lds + RT_LG); LAS float* RSTD = (LAS float*)(lds + RT_RSTD); LAS int* LCNT = (LAS int*)(lds + RT_LCNT); LAS float* BIAS = (LAS float*)(lds + RT_BIAS);
    { int* RT = (int*)(a.ws + WS_ROWTOK); for (int i = blockIdx.x * 512 + tid; i < NROWS_MAX; i += c.G * 512) RT[i] = 0; }
    if (tid < 36) BIAS[tid] = tid < 32 ? a.in[IN_BRE][tid] : a.in[IN_BRG][tid - 32];
    f32x4 gv[4];
#pragma unroll
    for (int j = 0; j < 4; ++j) gv[j] = *(const f32x4*)(a.in[IN_GMOE] + 4 * lane + 256 * j);
    const float* X1 = a.out; bf16* XN = (bf16*)(a.ws + WS_XN);
    int* TOKE = (int*)(a.ws + WS_TOKE); int* TOKR = (int*)(a.ws + WS_TOKR); float* TOKG = (float*)(a.ws + WS_TOKG); int* CNT = (int*)(a.ws + WS_CNT);
    for (int blk = blockIdx.x; blk < 256; blk += c.G) {
        __syncthreads();
        { const unsigned char* src = a.ws + WS_WTG;
#pragma unroll 1
          for (int pc = wave; pc < RT_NPIECE; pc += NWAVES)
              __builtin_amdgcn_global_load_lds((const unsigned*)(src + (size_t)pc * 1024 + lane * 16), (LAS unsigned*)(lds + RT_WT + pc * 1024), 16, 0, 0); }
        if (tid < 32) LCNT[tid] = 0;
#pragma unroll 1
        for (int ri = 0; ri < 16; ri += 4) { const int t0 = blk * 128 + wave * 16 + ri;
            f32x4 v[4][4]; float ss[4];
#pragma unroll
            for (int q = 0; q < 4; ++q) { const f32x4* xp = (const f32x4*)(X1 + (size_t)(t0 + q) * D) + lane;
#pragma unroll
                for (int j = 0; j < 4; ++j) v[q][j] = xp[64 * j]; }
#pragma unroll
            for (int q = 0; q < 4; ++q) { float sq = 0.f;
#pragma unroll
                for (int j = 0; j < 4; ++j) sq += (v[q][j].x * v[q][j].x + v[q][j].y * v[q][j].y) + (v[q][j].z * v[q][j].z + v[q][j].w * v[q][j].w);
                ss[q] = rsqrtf(wave_sum(sq) * (1.f / D) + EPS); }
            if (lane < 4) RSTD[wave * 16 + ri + lane] = (lane == 0) ? ss[0] : ((lane == 1) ? ss[1] : ((lane == 2) ? ss[2] : ss[3]));
#pragma unroll
            for (int q = 0; q < 4; ++q) { v2u* op = (v2u*)(XN + (size_t)(t0 + q) * D) + lane; const float r = ss[q];
#pragma unroll
                for (int j = 0; j < 4; ++j) { v2u w; w.x = pk2(v[q][j].x * r * gv[j].x, v[q][j].y * r * gv[j].y); w.y = pk2(v[q][j].z * r * gv[j].z, v[q][j].w * r * gv[j].w); op[64 * j] = w; } } }
        asm volatile("s_waitcnt vmcnt(0)" ::: "memory");
        __syncthreads();
        f32x4 acc[3];
#pragma unroll
        for (int ct = 0; ct < 3; ++ct) acc[ct] = (f32x4){0.f, 0.f, 0.f, 0.f};
        { const int row = lane & 15, kq = lane >> 4;
          const f32x4* ap = (const f32x4*)(X1 + (size_t)(blk * 128 + wave * 16 + row) * D + 4 * kq);
          int cj[3]; cj[0] = row; cj[1] = 16 + row; cj[2] = (32 + row) < 36 ? (32 + row) : 35;
          const LAS f32x4* bp0 = (const LAS f32x4*)(WT + cj[0] * RT_WROW + 4 * kq); const LAS f32x4* bp1 = (const LAS f32x4*)(WT + cj[1] * RT_WROW + 4 * kq); const LAS f32x4* bp2 = (const LAS f32x4*)(WT + cj[2] * RT_WROW + 4 * kq);
#define RT_LOADA(dst_, b_) do { _Pragma("unroll") for (int i_ = 0; i_ < 8; ++i_) dst_[i_] = ap[4 * (8 * ((b_) < 8 ? (b_) : 7) + i_)]; } while (0)
#define RT_MMA(src_, b_) do { _Pragma("unroll") for (int i_ = 0; i_ < 8; ++i_) { const int ks_ = 8 * (b_) + i_; const f32x4 b0 = bp0[4 * ks_], b1 = bp1[4 * ks_], b2 = bp2[4 * ks_]; \
              _Pragma("unroll") for (int j = 0; j < 4; ++j) { acc[0] = __builtin_amdgcn_mfma_f32_16x16x4f32(src_[i_][j], b0[j], acc[0], 0, 0, 0); acc[1] = __builtin_amdgcn_mfma_f32_16x16x4f32(src_[i_][j], b1[j], acc[1], 0, 0, 0); \
                  acc[2] = __builtin_amdgcn_mfma_f32_16x16x4f32(src_[i_][j], b2[j], acc[2], 0, 0, 0); } } } while (0)
          f32x4 aA[8], aB[8]; RT_LOADA(aA, 0);
#pragma unroll 1
          for (int bb = 0; bb < 8; bb += 2) { RT_LOADA(aB, bb + 1); RT_MMA(aA, bb); RT_LOADA(aA, bb + 2); RT_MMA(aB, bb + 1); }
#undef RT_LOADA
#undef RT_MMA
        }
        __syncthreads();
        { const int col = lane & 15, kq = lane >> 4;
#pragma unroll
          for (int ct = 0; ct < 3; ++ct) if (16 * ct + col < 36) {
#pragma unroll
              for (int r = 0; r < 4; ++r) LG[(wave * 16 + 4 * kq + r) * 36 + 16 * ct + col] = acc[ct][r]; } }
        __syncthreads();
        if (tid < 128) { const int row = tid, t = blk * 128 + row; const float rs = RSTD[row]; const LAS float* lg = LG + tid * 36;
            float gl[4];
#pragma unroll
            for (int i = 0; i < 4; ++i) gl[i] = rs * lg[32 + i] + BIAS[32 + i];
            int gs = 0; float gmax = gl[0];
#pragma unroll
            for (int i = 1; i < 4; ++i) if (gl[i] > gmax) { gmax = gl[i]; gs = i; }
            float gsum = 0.f;
#pragma unroll
            for (int i = 0; i < 4; ++i) gsum += expf(gl[i] - gmax);
            const float gtop = 1.0f / gsum;
            float ev[8];
#pragma unroll
            for (int i = 0; i < 8; ++i) ev[i] = rs * lg[gs * 8 + i] + BIAS[gs * 8 + i];
            int l0 = 0; float v0 = ev[0];
#pragma unroll
            for (int i = 1; i < 8; ++i) if (ev[i] > v0) { v0 = ev[i]; l0 = i; }
            int l1 = -1; float v1 = -3.0e38f;
#pragma unroll
            for (int i = 0; i < 8; ++i) if (i != l0 && ev[i] > v1) { v1 = ev[i]; l1 = i; }
            const float e1 = expf(v1 - v0), s0 = 1.0f / (1.0f + e1), s1 = e1 * s0;
            const int ex0 = gs * 8 + l0, ex1 = gs * 8 + l1;
            const int rk0 = __hip_atomic_fetch_add(&LCNT[ex0], 1, __ATOMIC_RELAXED, __HIP_MEMORY_SCOPE_WORKGROUP);
            const int rk1 = __hip_atomic_fetch_add(&LCNT[ex1], 1, __ATOMIC_RELAXED, __HIP_MEMORY_SCOPE_WORKGROUP);
            TOKE[2 * t] = ex0; TOKE[2 * t + 1] = ex1; TOKR[2 * t] = rk0; TOKR[2 * t + 1] = rk1; TOKG[2 * t] = s0 * gtop; TOKG[2 * t + 1] = s1 * gtop; }
        __syncthreads();
        if (tid < 32) CNT[blk * 32 + tid] = LCNT[tid];
    }
}
__device__ __forceinline__ void p7_gather(const Args& a, const Ctx& c) {
    const int tid = c.tid, lane = c.lane, wave = c.wave;
    LAS int* PART = (LAS int*)c.lds; LAS int* PPRE = PART + 512; LAS int* TOT = PPRE + 512; LAS int* TS = TOT + 32; LAS int* BASE = TS + 64;
    const int* CNT = (const int*)(a.ws + WS_CNT); const int* TOKE = (const int*)(a.ws + WS_TOKE); const int* TOKR = (const int*)(a.ws + WS_TOKR); int* TOKP = (int*)(a.ws + WS_TOKP);
    int* RT = (int*)(a.ws + WS_ROWTOK);
    { const int e = tid & 31, p = tid >> 5; int s = 0; for (int k = 0; k < 16; ++k) s += CNT[(16 * p + k) * 32 + e]; PART[p * 32 + e] = s; }
    __syncthreads();
    if (tid < 32) { int run = 0; for (int p = 0; p < 16; ++p) { PPRE[p * 32 + tid] = run; run += PART[p * 32 + tid]; } TOT[tid] = run; }
    __syncthreads();
    if (tid == 0) { int ts = 0; for (int e = 0; e < 32; ++e) { TS[e] = ts; ts += (TOT[e] + 255) >> 8; } TS[32] = ts; }
    __syncthreads();
    if (blockIdx.x == 0 && tid < 33) ((int*)(a.ws + WS_SMALL))[tid] = TS[tid];
    for (int blk = blockIdx.x; blk < 256; blk += c.G) {
        if (tid < 32) { int s = TS[tid] * 256 + PPRE[(blk >> 4) * 32 + tid]; for (int b2 = (blk & ~15); b2 < blk; ++b2) s += CNT[b2 * 32 + tid]; BASE[tid] = s; }
        __syncthreads();
        { const int t = blk * 128 + (tid >> 2), jj = tid & 3;
          if (jj < 2) { const int pos = BASE[TOKE[2 * t + jj]] + TOKR[2 * t + jj]; TOKP[2 * t + jj] = pos; RT[pos] = t; } }
        __syncthreads();
    }
}
__device__ __forceinline__ void p10_combine(const Args& a, const Ctx& c) {
    const int lane = c.lane, gw = c.vcu * NWAVES + c.wave, NGW = c.G * NWAVES;
    const int* TOKP = (const int*)(a.ws + WS_TOKP); const float* TOKG = (const float*)(a.ws + WS_TOKG); const bf16* Y = (const bf16*)(a.ws + WS_Y);
    for (int t0 = gw; t0 < T; t0 += 2 * NGW) {
        const int tA = t0, tB = (t0 + NGW < T) ? t0 + NGW : t0; const bool hasB = (t0 + NGW < T);
        const int pA0 = TOKP[2 * tA], pA1 = TOKP[2 * tA + 1], pB0 = TOKP[2 * tB], pB1 = TOKP[2 * tB + 1];
        const float gA0 = TOKG[2 * tA], gA1 = TOKG[2 * tA + 1], gB0 = TOKG[2 * tB], gB1 = TOKG[2 * tB + 1];
        f32x4 xa[4], xb[4]; v2u ya0[4], ya1[4], yb0[4], yb1[4];
#pragma unroll
        for (int j = 0; j < 4; ++j) { const int cc = 4 * lane + 256 * j;
            xa[j] = *(const f32x4*)(a.out + (size_t)tA * D + cc); xb[j] = *(const f32x4*)(a.out + (size_t)tB * D + cc);
            ya0[j] = *(const v2u*)(Y + (size_t)pA0 * D + cc); ya1[j] = *(const v2u*)(Y + (size_t)pA1 * D + cc);
            yb0[j] = *(const v2u*)(Y + (size_t)pB0 * D + cc); yb1[j] = *(const v2u*)(Y + (size_t)pB1 * D + cc); }
#pragma unroll
        for (int j = 0; j < 4; ++j) { const int cc = 4 * lane + 256 * j; f32x4 x = xa[j];
            x[0] += gA0 * bf2f(ya0[j].x & 0xffffu) + gA1 * bf2f(ya1[j].x & 0xffffu); x[1] += gA0 * bf2f(ya0[j].x >> 16) + gA1 * bf2f(ya1[j].x >> 16);
            x[2] += gA0 * bf2f(ya0[j].y & 0xffffu) + gA1 * bf2f(ya1[j].y & 0xffffu); x[3] += gA0 * bf2f(ya0[j].y >> 16) + gA1 * bf2f(ya1[j].y >> 16);
            *(f32x4*)(a.out + (size_t)tA * D + cc) = x; }
        if (hasB) {
#pragma unroll
        for (int j = 0; j < 4; ++j) { const int cc = 4 * lane + 256 * j; f32x4 x = xb[j];
            x[0] += gB0 * bf2f(yb0[j].x & 0xffffu) + gB1 * bf2f(yb1[j].x & 0xffffu); x[1] += gB0 * bf2f(yb0[j].x >> 16) + gB1 * bf2f(yb1[j].x >> 16);
            x[2] += gB0 * bf2f(yb0[j].y & 0xffffu) + gB1 * bf2f(yb1[j].y & 0xffffu); x[3] += gB0 * bf2f(yb0[j].y >> 16) + gB1 * bf2f(yb1[j].y >> 16);
            *(f32x4*)(a.out + (size_t)tB * D + cc) = x; } }
    }
}
__global__ void __launch_bounds__(NWAVES * 64, 2) hybrid_fwd(Args args) {
    extern __shared__ __attribute__((aligned(16))) unsigned char lds_raw[];
    Ctx c; c.lds = (LAS unsigned char*)lds_raw;
    volatile LAS unsigned* MISC = (volatile LAS unsigned*)(c.lds + MISC_OFF);
    c.tid = threadIdx.x; c.lane = c.tid & 63; c.wave = __builtin_amdgcn_readfirstlane(c.tid >> 6);
    c.G = gridDim.x; { const int bx = blockIdx.x; c.vcu = (c.G % 8 == 0) ? (bx % 8) * (c.G / 8) + bx / 8 : bx; }
    unsigned* ctl = (unsigned*)(args.ws + WS_CTL);
    if (c.tid < 128) MISC[c.tid] = 0u;
    __syncthreads();
    XcdBarrier bar; bar.bar = ctl + CW_BAR; bar.x = 0; bar.st = nullptr;
    if (N_LAUNCHES == 1) bar = xcd_barrier_post(ctl + CW_BAR, MISC + 8);
#define GRID_BAR() do { if (N_LAUNCHES == 1) xcd_barrier(bar); } while (0)
    const int lo = args.ph_lo, hi = args.ph_hi;
#ifndef PH_MASK
#define PH_MASK 0xfff
#endif
#ifdef DBG_TIME
    unsigned long long tprev_ = wall_clock64(), tdur_ = 0ull; const unsigned long long tstart_ = tprev_;
#define PH_STAMP(k) do { const unsigned long long tn_ = wall_clock64(); if ((k) == DBG_TIME) tdur_ = tn_ - tprev_; tprev_ = tn_; } while (0)
#else
#define PH_STAMP(k) do { } while (0)
#endif
#define IN(k) (((PH_MASK >> (k)) & 1) && lo <= (k) && (k) < hi)
#define BOTH(k) (IN(k) && IN((k) + 1))
    unsigned char* ws = args.ws; unsigned char* dout = (unsigned char*)args.out;
#ifndef DBG_REPEAT
#define DBG_REPEAT -1
#endif
#define REPS(k) (((k) == DBG_REPEAT) ? 2 : 1)
#if DBG_REPEAT == 5
#define RB5 _Pragma("unroll 1") for (int rep5 = 0; rep5 < 2; ++rep5) { if (rep5) GRID_BAR();
#define RE5 }
#else
#define RB5
#define RE5
#endif
#if DBG_REPEAT == 6
#define RB6 _Pragma("unroll 1") for (int rep6 = 0; rep6 < 2; ++rep6) { if (rep6) GRID_BAR();
#define RE6 }
#else
#define RB6
#define RE6
#endif
    if (IN(0)) { _Pragma("unroll") for (int rep = 0; rep < REPS(0); ++rep) { if (rep) GRID_BAR(); p0_prologue<0>(args, c, c.vcu * NWAVES + c.wave, c.G * NWAVES); } if (BOTH(0)) GRID_BAR(); PH_STAMP(0); }
    if (IN(1)) { _Pragma("unroll") for (int rep = 0; rep < REPS(1); ++rep) { if (rep) GRID_BAR();
#ifdef DBG_STAGGER
        if ((blockIdx.x >> 3) & 1) { const unsigned long long t0 = wall_clock64(); while (wall_clock64() - t0 < (unsigned long long)DBG_STAGGER) __builtin_amdgcn_s_sleep(16); }
#endif
        pg8::Gemm g{(const pg8::bf16_t*)(dout + DO_H), (const pg8::bf16_t*)(ws + WS_WIN), T, NPROJ, D}; pg8::StaticOrder S; S.init(T, NPROJ, c.G, (int)blockIdx.x);
        pg8::EpiBf16<0> E{(pg8::bf16_t*)(ws + WS_PROJ), 256, nullptr, 256, (size_t)T * 256, 1.f};
        pg8::gemm_phase<pg8::EpiBf16<0>, pg8::StaticOrder, true, true>(c.lds, g, S, E); }
        if (BOTH(1)) GRID_BAR(); PH_STAMP(1);
    }
#ifndef DBG_R2
#define DBG_R2 1
#endif
#ifndef DBG_R4A
#define DBG_R4A 1
#endif
#ifndef DBG_R4B
#define DBG_R4B 1
#endif
#ifndef DBG_R7
#define DBG_R7 1
#endif
    if (IN(2)) { _Pragma("unroll 1") for (int rep = 0; rep < DBG_R2; ++rep) { if (rep) GRID_BAR(); p2_prep(args, c); } if (BOTH(2)) GRID_BAR(); PH_STAMP(2); }
    if (IN(3)) { _Pragma("unroll") for (int rep = 0; rep < REPS(3); ++rep) { if (rep) GRID_BAR(); p3_mixer(args, c, MISC, rep); } if (BOTH(3)) GRID_BAR(); PH_STAMP(3); }
    if (IN(4)) {
#pragma unroll 1
        for (int rep = 0; rep < DBG_R4A; ++rep) {
            const int gw = c.vcu * NWAVES + c.wave, ngw = c.G * NWAVES, kdone = ((int)blockIdx.x < 256) ? 24 : 0;
            LAS float* scr = (LAS float*)(c.lds + CV_SCR + c.wave * CV_SCRW);
#pragma unroll 1
            for (int k = kdone; gw + k * ngw < CV_NMI; ++k) { const CvItem it = cv_item(args, gw + k * ngw); f32x4 v[4]; cv_load(it, v, c.lane); cv_finish(it, v, scr, c.lane, true); }
            __syncthreads(); }
#pragma unroll 1
        for (int rep = 0; rep < DBG_R4B; ++rep)
#pragma unroll 1
        for (int u = blockIdx.x; u < 256; u += c.G) mlstm_unit<1>(args, c, u >> 5, (u >> 3) & 3, u & 7);
        if (BOTH(4)) GRID_BAR(); PH_STAMP(4);
    }
    if (IN(5)) { RB5
#ifdef DBG_STAG5
        if ((blockIdx.x >> 3) & 1) { const unsigned long long t0 = wall_clock64(); while (wall_clock64() - t0 < (unsigned long long)DBG_STAG5) __builtin_amdgcn_s_sleep(16); }
#endif
        { pg8::Gemm g{(const pg8::bf16_t*)(dout + DO_YATT), (const pg8::bf16_t*)(ws + WS_WPA), T, D, 512, (const pg8::bf16_t*)(dout + DO_YML), (const pg8::bf16_t*)(ws + WS_WPM)};
          pg8::StaticOrder S; S.init(T, D, c.G, (int)blockIdx.x);
          pg8::EpiGate2 E{(pg8::bf16_t*)(ws + WS_MERGED), D, (const pg8::bf16_t*)(ws + WS_PROJ + (size_t)TL_GA * PROJ_TILE), (const pg8::bf16_t*)(ws + WS_PROJ + (size_t)TL_GM * PROJ_TILE), (size_t)T * 256};
          pg8::gemm_phase<pg8::EpiGate2, pg8::StaticOrder, true, true, true>(c.lds, g, S, E); } RE5
        if (BOTH(5)) GRID_BAR(); PH_STAMP(5);
    }
    if (IN(6)) { RB6
#ifdef DBG_STAG6
        if ((blockIdx.x >> 3) & 1) { const unsigned long long t0 = wall_clock64(); while (wall_clock64() - t0 < (unsigned long long)DBG_STAG6) __builtin_amdgcn_s_sleep(16); }
#endif
        pg8::Gemm g{(const pg8::bf16_t*)(ws + WS_MERGED), (const pg8::bf16_t*)(ws + WS_WOUT), T, D, D}; pg8::StaticOrder S; S.init(T, D, c.G, (int)blockIdx.x);
        pg8::EpiRes E{args.out, args.in[IN_X], D};
        pg8::gemm_phase<pg8::EpiRes, pg8::StaticOrder, true, true>(c.lds, g, S, E); RE6
        if (BOTH(6)) GRID_BAR(); PH_STAMP(6);
    }
    if (IN(7)) { _Pragma("unroll 1") for (int rep = 0; rep < DBG_R7; ++rep) { if (rep) { GRID_BAR(); } p6_router(args, c); } if (BOTH(7)) GRID_BAR(); PH_STAMP(7); }
    if (IN(8)) { _Pragma("unroll") for (int rep = 0; rep < REPS(8); ++rep) { if (rep) GRID_BAR(); p7_gather(args, c); } if (BOTH(8)) GRID_BAR(); PH_STAMP(8); }
    if (IN(9) || IN(10)) {
        LAS int* TSL = (LAS int*)(c.lds + MISC_OFF + 256);
        LAS int* XS = (LAS int*)(c.lds + MISC_OFF + 400);
        if (c.tid < 33) TSL[c.tid] = (int)__hip_atomic_load((unsigned*)(ws + WS_SMALL) + c.tid, RLX_AGENT);
        if (c.tid == 64) { const int ntt = (int)__hip_atomic_load((unsigned*)(ws + WS_SMALL) + 32, RLX_AGENT); int lo_t = 0, hi_t = ntt, nl = c.G, lx = (int)blockIdx.x;
            if (N_LAUNCHES == 1) { unsigned pre = 0u, mine = 0u;
                for (unsigned j = 0; j < 16; ++j) { const unsigned cj = xb_ld(&bar.bar[XB_XCNT(j)]); pre += (j < bar.x) ? cj : 0u; mine = (j == bar.x) ? cj : mine; }
                nl = (int)mine; lx = (int)MISC[20]; lo_t = (int)((long)ntt * pre / c.G); hi_t = (int)((long)ntt * (pre + mine) / c.G); }
            XS[0] = lo_t; XS[1] = hi_t; XS[2] = nl; XS[3] = lx; }
        __syncthreads();
        const int xs_lo = XS[0], xs_hi = XS[1], xs_nl = XS[2], xs_lx = XS[3];
        if (IN(9)) {
            pg8::MoeOrder<true> S{TSL, xs_nl, xs_lx, xs_lo, xs_hi, (const int*)(ws + WS_ROWTOK), (unsigned*)(ws + WS_CTL) + CW_RDY};
            pg8::Gemm g{(const pg8::bf16_t*)(ws + WS_XN), (const pg8::bf16_t*)(ws + WS_GU), 0, 0, D};
            pg8::EpiSwiGLU E{(pg8::bf16_t*)(ws + WS_HID)};
            pg8::gemm_phase<pg8::EpiSwiGLU, pg8::MoeOrder<true>, true, true>(c.lds, g, S, E);
            if (BOTH(9)) __syncthreads();
        }
        if (IN(10)) {
            pg8::MoeOrder<false> S{TSL, xs_nl, xs_lx, xs_lo, xs_hi, nullptr, (unsigned*)(ws + WS_CTL) + CW_RDY};
            pg8::Gemm g{(const pg8::bf16_t*)(ws + WS_HID), (const pg8::bf16_t*)(ws + WS_DN), 0, 0, 512};
            pg8::EpiDown E{(pg8::bf16_t*)(ws + WS_Y)};
            pg8::gemm_phase<pg8::EpiDown, pg8::MoeOrder<false>, true, true>(c.lds, g, S, E);
            if (BOTH(10)) GRID_BAR(); PH_STAMP(10);
        }
    }
    if (IN(11)) p10_combine(args, c);
#ifdef DBG_TIME
    PH_STAMP(11);
    if (DBG_TIME == 99) tdur_ = wall_clock64() - tstart_;
    if (DBG_TIME == 98) tdur_ = 10000ull;
    if (blockIdx.x == 0) { const unsigned long long t0_ = wall_clock64(); while (wall_clock64() - t0_ < tdur_) __builtin_amdgcn_s_sleep(8); }
#endif
#undef IN
#undef BOTH
#undef GRID_BAR
}

extern "C" void kernel_launch(void* const* d_in, const int* in_sizes, int n_in, void* d_out, int out_size, void* d_ws, size_t ws_size, hipStream_t stream) {
    static int grid = 0;
    if (grid == 0) {
        if (n_in != 22 || in_sizes[0] != T * D || out_size != T * D || ws_size < WS_END) { fprintf(stderr, "kernel_launch: unexpected shapes (n_in %d, in0 %d, out %d, ws %zu); nothing launched\n", n_in, n_in > 0 ? in_sizes[0] : -1, out_size, ws_size); grid = -1; return; }
        int dev = 0, cus = 0, per_cu = 0;
        if (hipGetDevice(&dev) != hipSuccess || hipDeviceGetAttribute(&cus, hipDeviceAttributeMultiprocessorCount, dev) != hipSuccess) { grid = -1; return; }
        if (hipFuncSetAttribute((const void*)hybrid_fwd, hipFuncAttributeMaxDynamicSharedMemorySize, LDS_BYTES) != hipSuccess) { fprintf(stderr, "kernel_launch: hipFuncSetAttribute failed\n"); grid = -1; return; }
        if (hipOccupancyMaxActiveBlocksPerMultiprocessor(&per_cu, (const void*)hybrid_fwd, NWAVES * 64, LDS_BYTES) != hipSuccess || per_cu < 1)
            fprintf(stderr, "kernel_launch: note: occupancy query reports %d workgroups per CU\n", per_cu);
        (void)hipGetLastError();
        grid = cus;
    }
    if (grid < 0) return;
    if (hipMemsetAsync((char*)d_ws + WS_CTL, 0, CTL_ZERO_BYTES, stream) != hipSuccess) return;
    Args a{};
    for (int i = 0; i < 22; ++i) a.in[i] = (const float*)d_in[i];
    a.out = (float*)d_out; a.ws = (unsigned char*)d_ws;
    for (int li = 0; li < N_LAUNCHES; ++li) {
        a.ph_lo = (N_LAUNCHES == 1) ? 0 : li; a.ph_hi = (N_LAUNCHES == 1) ? NPH : li + 1; a.li = li;
        hipLaunchKernelGGL(hybrid_fwd, dim3(grid), dim3(NWAVES * 64), LDS_BYTES, stream, a);
        if (hipPeekAtLastError() != hipSuccess) { fprintf(stderr, "kernel_launch: launch %d failed\n", li); break; }
    }
}
```

```cpp
#include <hip/hip_runtime.h>
#include <cstdio>
#include <cstdint>
namespace pg8 {
#define PG8_LAS __attribute__((address_space(3)))
typedef unsigned short bf16_t;
typedef short bf16x8 __attribute__((ext_vector_type(8)));
typedef float f32x4 __attribute__((ext_vector_type(4)));
typedef unsigned u32x4 __attribute__((ext_vector_type(4)));
constexpr int BM = 256, BK = 64, HALF = 128, HTB = HALF * BK * 2  , STAGE_BYTES = 8 * HTB, NXCD = 8, WGM = 8;

__host__ __device__ __forceinline__ int lds_byte(int r, int c) { const int st = (r >> 4) * 2 + (c >> 5), rr = r & 15, cc = c & 31, ob = rr * 64 + cc * 2; return st * 1024 + (ob ^ (((ob >> 9) & 1) << 5)); }
__host__ __device__ __forceinline__ void stage_rc(int b, int& R, int& C) { const int st = b / 1024, sb = b % 1024, swz = sb ^ (((sb >> 9) & 1) << 5); R = (st >> 1) * 16 + swz / 64; C = (st & 1) * 32 + (swz % 64) / 2; }
__host__ __device__ __forceinline__ int perm32(int rho) { const int n = rho >> 4, i = rho & 15; return 8 * (i >> 2) + 4 * n + (i & 3); }

struct Unit { int pm, pn; };
struct Gemm { const bf16_t* A; const bf16_t* Bt; int M, N, K; const bf16_t* A2 = nullptr; const bf16_t* Bt2 = nullptr; };

struct StaticOrder {
    static constexpr bool GATHER = false;
    int nM, nN, nwg, G, c;
    __host__ __device__ void init(int M, int N, int G_, int c_) { nM = M / BM; nN = N / BM; nwg = nM * nN; G = G_; c = c_; }
    __host__ __device__ bool next(int i, Unit& u) const {
        const long L = (long)i * G + c; if (L >= nwg) return false;
        int wgid = (int)L; { const int q = nwg / NXCD, r = nwg % NXCD, xcd = wgid % NXCD, off = wgid / NXCD; wgid = (xcd < r ? xcd * (q + 1) : r * (q + 1) + (xcd - r) * q) + off; }
        const int nig = WGM * nN, gid = wgid / nig, fm = gid * WGM, gsz = (nM - fm) < WGM ? (nM - fm) : WGM;
        u.pm = fm + ((wgid % nig) % gsz); u.pn = (wgid % nig) / gsz; return true;
    }
    __device__ __forceinline__ void a_ready(const Unit&) const {}
    __device__ __forceinline__ void done(const Unit&) const {}
};

typedef __bf16 bf2_t __attribute__((ext_vector_type(2)));
__device__ __forceinline__ unsigned cvt_pk_bf16(float lo, float hi) { bf2_t v; v[0] = (__bf16)lo; v[1] = (__bf16)hi; return __builtin_bit_cast(unsigned, v); }
typedef float f32x2 __attribute__((ext_vector_type(2)));
template <int ACT  > struct EpiBf16 {
    static constexpr bool PERM = true, AFTER_DRAIN = false; static_assert(ACT == 0, "EpiBf16: no activation here");
    bf16_t* O; int ldc; const float* bias; int split_cols; size_t split_stride; float scale0;
    __device__ __forceinline__ void operator()(const f32x4 (&acc)[2][2][4][2], const Unit& u, int wr, int wc, int fr, int fq) const {
        const int row0 = u.pm * BM + wr * 64 + fr; int colt = u.pn * BM; bf16_t* base = O;
        float sc = 1.f; if (split_cols) { const int t = colt / split_cols; base += (size_t)t * split_stride; colt -= t * split_cols; if (t == 0) sc = scale0; }
        const int col0 = colt + wc * 32 + 8 * fq, bcol0 = u.pn * BM + wc * 32 + 8 * fq;
        f32x4 bv[2][2];
#pragma unroll
        for (int bj = 0; bj < 2; ++bj)
#pragma unroll
            for (int n = 0; n < 2; ++n) bv[bj][n] = bias ? *(const f32x4*)(bias + bcol0 + bj * HALF + 4 * n) : (f32x4){0.f, 0.f, 0.f, 0.f};
#pragma unroll
        for (int ai = 0; ai < 2; ++ai)
#pragma unroll
            for (int m = 0; m < 4; ++m) { bf16_t* rowp = base + (size_t)(row0 + ai * HALF + m * 16) * ldc + col0;
#pragma unroll
                for (int bj = 0; bj < 2; ++bj) { f32x4 v0 = acc[ai][bj][m][0] + bv[bj][0], v1 = acc[ai][bj][m][1] + bv[bj][1];
                    v0 = v0 * sc; v1 = v1 * sc; u32x4 w; w.x = cvt_pk_bf16(v0[0], v0[1]); w.y = cvt_pk_bf16(v0[2], v0[3]); w.z = cvt_pk_bf16(v1[0], v1[1]); w.w = cvt_pk_bf16(v1[2], v1[3]);
                    *(u32x4*)(rowp + bj * HALF) = w; } }
    }
};
__device__ __forceinline__ float bf2f_(unsigned b16) { return __uint_as_float(b16 << 16); }
__device__ __forceinline__ float sigm_(float x) { return __builtin_amdgcn_rcpf(1.0f + __expf(-x)); }
template <bool ADD> struct EpiGate {
    static constexpr bool PERM = true, AFTER_DRAIN = false;
    bf16_t* O; int ldc; const bf16_t* gate; size_t gstride;
    __device__ __forceinline__ void operator()(const f32x4 (&acc)[2][2][4][2], const Unit& u, int wr, int wc, int fr, int fq) const {
        const int row0 = u.pm * BM + wr * 64 + fr, colt = wc * 32 + 8 * fq;
        const bf16_t* gt = gate + (size_t)u.pn * gstride;
#pragma unroll
        for (int ai = 0; ai < 2; ++ai) {
            u32x4 gv[4][2], pp[4][2];
#pragma unroll
            for (int m = 0; m < 4; ++m) { const size_t row = (size_t)(row0 + ai * HALF + m * 16);
#pragma unroll
                for (int bj = 0; bj < 2; ++bj) { const int c = colt + bj * HALF; gv[m][bj] = *(const u32x4*)(gt + row * 256 + c);
                    if (ADD) pp[m][bj] = *(const u32x4*)(O + row * ldc + u.pn * BM + c); } }
#pragma unroll
            for (int m = 0; m < 4; ++m) { const size_t row = (size_t)(row0 + ai * HALF + m * 16);
#pragma unroll
                for (int bj = 0; bj < 2; ++bj) { const int c = colt + bj * HALF; const u32x4 g4 = gv[m][bj];
                    bf16_t* op = O + row * ldc + u.pn * BM + c;
                    float pv[8] = {0.f, 0.f, 0.f, 0.f, 0.f, 0.f, 0.f, 0.f};
                    if (ADD) { const u32x4 p = pp[m][bj]; pv[0] = bf2f_(p.x & 0xffffu); pv[1] = bf2f_(p.x >> 16); pv[2] = bf2f_(p.y & 0xffffu); pv[3] = bf2f_(p.y >> 16);
                        pv[4] = bf2f_(p.z & 0xffffu); pv[5] = bf2f_(p.z >> 16); pv[6] = bf2f_(p.w & 0xffffu); pv[7] = bf2f_(p.w >> 16); }
                    const f32x4 v0 = acc[ai][bj][m][0], v1 = acc[ai][bj][m][1];
                    float o[8];
                    o[0] = pv[0] + sigm_(bf2f_(g4.x & 0xffffu)) * v0[0]; o[1] = pv[1] + sigm_(bf2f_(g4.x >> 16)) * v0[1];
                    o[2] = pv[2] + sigm_(bf2f_(g4.y & 0xffffu)) * v0[2]; o[3] = pv[3] + sigm_(bf2f_(g4.y >> 16)) * v0[3];
                    o[4] = pv[4] + sigm_(bf2f_(g4.z & 0xffffu)) * v1[0]; o[5] = pv[5] + sigm_(bf2f_(g4.z >> 16)) * v1[1];
                    o[6] = pv[6] + sigm_(bf2f_(g4.w & 0xffffu)) * v1[2]; o[7] = pv[7] + sigm_(bf2f_(g4.w >> 16)) * v1[3];
                    u32x4 w; w.x = cvt_pk_bf16(o[0], o[1]); w.y = cvt_pk_bf16(o[2], o[3]); w.z = cvt_pk_bf16(o[4], o[5]); w.w = cvt_pk_bf16(o[6], o[7]);
                    *(u32x4*)op = w; } } }
    }
};
struct EpiGate2 {
    static constexpr bool PERM = true, AFTER_DRAIN = false;
    bf16_t* O; int ldc; const bf16_t* gate1; const bf16_t* gate2; size_t gstride;
    __device__ __forceinline__ void mid(f32x4 (&acc)[2][2][4][2], const Unit& u, int wr, int wc, int fr, int fq) const {
        const int row0 = u.pm * BM + wr * 64 + fr, colt = wc * 32 + 8 * fq;
        const bf16_t* g1 = gate1 + (size_t)u.pn * gstride; const bf16_t* g2 = gate2 + (size_t)u.pn * gstride;
#pragma unroll
        for (int ai = 0; ai < 2; ++ai)
#pragma unroll
          for (int bj = 0; bj < 2; ++bj) { u32x4 ga[4], gb[4]; const int c = colt + bj * HALF;
            int r0_ = row0; asm volatile("" : "+v"(r0_) :: "memory");
#pragma unroll
            for (int m = 0; m < 4; ++m) { const size_t row = (size_t)(r0_ + ai * HALF + m * 16); ga[m] = *(const u32x4*)(g1 + row * 256 + c); gb[m] = *(const u32x4*)(g2 + row * 256 + c); }
#pragma unroll
            for (int m = 0; m < 4; ++m) { const u32x4 x = ga[m], y = gb[m];
#define EG2_R(xa_, xb_) ((1.0f + __expf(-(xb_))) * __builtin_amdgcn_rcpf(1.0f + __expf(-(xa_))))
                    f32x4& v0 = acc[ai][bj][m][0]; f32x4& v1 = acc[ai][bj][m][1];
                    v0[0] *= EG2_R(bf2f_(x.x & 0xffffu), bf2f_(y.x & 0xffffu)); v0[1] *= EG2_R(bf2f_(x.x >> 16), bf2f_(y.x >> 16));
                    v0[2] *= EG2_R(bf2f_(x.y & 0xffffu), bf2f_(y.y & 0xffffu)); v0[3] *= EG2_R(bf2f_(x.y >> 16), bf2f_(y.y >> 16));
                    v1[0] *= EG2_R(bf2f_(x.z & 0xffffu), bf2f_(y.z & 0xffffu)); v1[1] *= EG2_R(bf2f_(x.z >> 16), bf2f_(y.z >> 16));
                    v1[2] *= EG2_R(bf2f_(x.w & 0xffffu), bf2f_(y.w & 0xffffu)); v1[3] *= EG2_R(bf2f_(x.w >> 16), bf2f_(y.w >> 16));
#undef EG2_R
            } }
    }
    __device__ __forceinline__ void operator()(const f32x4 (&acc)[2][2][4][2], const Unit& u, int wr, int wc, int fr, int fq) const {
        const int row0 = u.pm * BM + wr * 64 + fr, colt = wc * 32 + 8 * fq;
        const bf16_t* g2 = gate2 + (size_t)u.pn * gstride;
#pragma unroll
        for (int ai = 0; ai < 2; ++ai) { u32x4 gb[4][2];
#pragma unroll
            for (int m = 0; m < 4; ++m) { const size_t row = (size_t)(row0 + ai * HALF + m * 16);
#pragma unroll
                for (int bj = 0; bj < 2; ++bj) gb[m][bj] = *(const u32x4*)(g2 + row * 256 + colt + bj * HALF); }
#pragma unroll
            for (int m = 0; m < 4; ++m) { const size_t row = (size_t)(row0 + ai * HALF + m * 16);
#pragma unroll
                for (int bj = 0; bj < 2; ++bj) { const u32x4 y = gb[m][bj]; const f32x4 v0 = acc[ai][bj][m][0], v1 = acc[ai][bj][m][1];
                    float o[8];
                    o[0] = sigm_(bf2f_(y.x & 0xffffu)) * v0[0]; o[1] = sigm_(bf2f_(y.x >> 16)) * v0[1]; o[2] = sigm_(bf2f_(y.y & 0xffffu)) * v0[2]; o[3] = sigm_(bf2f_(y.y >> 16)) * v0[3];
                    o[4] = sigm_(bf2f_(y.z & 0xffffu)) * v1[0]; o[5] = sigm_(bf2f_(y.z >> 16)) * v1[1]; o[6] = sigm_(bf2f_(y.w & 0xffffu)) * v1[2]; o[7] = sigm_(bf2f_(y.w >> 16)) * v1[3];
                    u32x4 w; w.x = cvt_pk_bf16(o[0], o[1]); w.y = cvt_pk_bf16(o[2], o[3]); w.z = cvt_pk_bf16(o[4], o[5]); w.w = cvt_pk_bf16(o[6], o[7]);
                    *(u32x4*)(O + row * ldc + u.pn * BM + colt + bj * HALF) = w; } } }
    }
};
struct EpiRes {
    static constexpr bool PERM = false, AFTER_DRAIN = false;
    float* C; const float* R; int ldc;
    __device__ __forceinline__ void operator()(const f32x4 (&acc)[2][2][4][2], const Unit& u, int wr, int wc, int fr, int fq) const {
        const int row0 = u.pm * BM + wr * 64 + fr, col0 = u.pn * BM + wc * 32 + 4 * fq;
#pragma unroll
        for (int ai = 0; ai < 2; ++ai) {
            f32x4 rv[4][2][2];
#pragma unroll
            for (int m = 0; m < 4; ++m) { const size_t ro = (size_t)(row0 + ai * HALF + m * 16) * ldc + col0;
#pragma unroll
                for (int bj = 0; bj < 2; ++bj)
#pragma unroll
                    for (int n = 0; n < 2; ++n) rv[m][bj][n] = *(const f32x4*)(R + ro + bj * HALF + n * 16); }
#pragma unroll
            for (int m = 0; m < 4; ++m) { const size_t ro = (size_t)(row0 + ai * HALF + m * 16) * ldc + col0;
#pragma unroll
                for (int bj = 0; bj < 2; ++bj)
#pragma unroll
                    for (int n = 0; n < 2; ++n) *(f32x4*)(C + ro + bj * HALF + n * 16) = rv[m][bj][n] + acc[ai][bj][m][n]; } }
    }
};
struct EpiSwiGLU {
    static constexpr bool PERM = true, AFTER_DRAIN = false;
    bf16_t* H;
    __device__ __forceinline__ void operator()(const f32x4 (&acc)[2][2][4][2], const Unit& u, int wr, int wc, int fr, int fq) const {
        const int row0 = u.pm * BM + wr * 64 + fr, hc = (u.pn & 3) * 128 + wc * 32 + 8 * fq;
#pragma unroll
        for (int ai = 0; ai < 2; ++ai)
#pragma unroll
            for (int m = 0; m < 4; ++m) { const size_t row = (size_t)(row0 + ai * HALF + m * 16);
                float o[8];
#pragma unroll
                for (int n = 0; n < 2; ++n)
#pragma unroll
                    for (int i = 0; i < 4; ++i) { const float g = acc[ai][0][m][n][i], up = acc[ai][1][m][n][i]; o[n * 4 + i] = g * sigm_(g) * up; }
                u32x4 w; w.x = cvt_pk_bf16(o[0], o[1]); w.y = cvt_pk_bf16(o[2], o[3]); w.z = cvt_pk_bf16(o[4], o[5]); w.w = cvt_pk_bf16(o[6], o[7]);
                *(u32x4*)(H + row * 512 + hc) = w; }
    }
};
struct EpiDown {
    static constexpr bool PERM = true, AFTER_DRAIN = false;
    bf16_t* Y;
    __device__ __forceinline__ void operator()(const f32x4 (&acc)[2][2][4][2], const Unit& u, int wr, int wc, int fr, int fq) const {
        const int row0 = u.pm * BM + wr * 64 + fr, c0 = (u.pn & 3) * 256 + wc * 32 + 8 * fq;
#pragma unroll
        for (int ai = 0; ai < 2; ++ai)
#pragma unroll
            for (int m = 0; m < 4; ++m) { const size_t row = (size_t)(row0 + ai * HALF + m * 16);
#pragma unroll
                for (int bj = 0; bj < 2; ++bj) { const f32x4 v0 = acc[ai][bj][m][0], v1 = acc[ai][bj][m][1];
                    u32x4 w; w.x = cvt_pk_bf16(v0[0], v0[1]); w.y = cvt_pk_bf16(v0[2], v0[3]); w.z = cvt_pk_bf16(v1[0], v1[1]); w.w = cvt_pk_bf16(v1[2], v1[3]);
                    *(u32x4*)(Y + row * 1024 + c0 + bj * HALF) = w; } }
    }
};
template <bool GA_> struct MoeOrder {
    static constexpr bool GATHER = GA_;
    const PG8_LAS int* ts; int nl, lx, lo, hi; const int* rowtok; unsigned* rdy;
    __device__ __forceinline__ bool next(int i, Unit& u) const {
        const int U = 4 * (hi - lo), G = nl, c = lx; long L;
        if constexpr (GA_) L = (long)i * G + c;
        else { const int r = U % G;
            if (c >= r) L = (i == 0) ? (long)(c - r) : ((i == 1) ? (long)(G - r) + (c - r) : 2L * (G - r) + (long)(i - 2) * G + c);
            else L = 2L * (G - r) + (long)i * G + c; }
        if (L >= (long)U) return false;
        const int pm = lo + (int)(L >> 2), j = (int)(L & 3); int e = 0;
#pragma unroll
        for (int k = 1; k < 32; ++k) e += (ts[k] <= pm) ? 1 : 0;
        u.pm = pm; u.pn = e * 4 + j; return true;
    }
    __device__ __forceinline__ void a_ready(const Unit& u) const {
        if constexpr (!GA_) { unsigned sp = 0u;
            while (__hip_atomic_load(rdy + 16 * u.pm, __ATOMIC_RELAXED, __HIP_MEMORY_SCOPE_AGENT) < 32u) { __builtin_amdgcn_s_sleep(2); if (++sp > (1u << 22)) break; }
            asm volatile("" ::: "memory"); }
    }
    __device__ __forceinline__ void done(const Unit& u) const {
        if constexpr (GA_) { asm volatile("s_waitcnt vmcnt(0)" ::: "memory");
            if ((threadIdx.x & 63) == 0) (void)__hip_atomic_fetch_add(rdy + 16 * u.pm, 1u, __ATOMIC_RELAXED, __HIP_MEMORY_SCOPE_AGENT); }
    }
};
template <class E_> struct is_epibf16 { static constexpr bool value = false; }; template <int A_> struct is_epibf16<EpiBf16<A_>> { static constexpr bool value = true; };
template <class Epi, class Sched, bool ALIGN_EPI = false, bool SP2 = false, bool DUAL = false>
__device__ __forceinline__ void gemm_phase(PG8_LAS unsigned char* lds, const Gemm g, const Sched& S, const Epi& E) {
    const int tid = threadIdx.x, wid = __builtin_amdgcn_readfirstlane(tid >> 6), lane = tid & 63, wr = wid >> 2, wc = wid & 3, fr = lane & 15, fq = lane >> 4;
    const int K = g.K, nh = K / BK, nt = DUAL ? 2 * nh : nh;
    static_assert(!DUAL || SP2, "two operand pairs: SP2 loop only");
    unsigned voffA[2], voffB[2];
#pragma unroll
    for (int i = 0; i < 2; ++i) { int R, C; stage_rc(tid * 16 + i * 8192, R, C); const int Rb = Epi::PERM ? ((R & ~31) + perm32(R & 31)) : R;
        voffA[i] = (unsigned)(R * K + C) * 2u; voffB[i] = (unsigned)(Rb * K + C) * 2u; }
    const size_t kstep = (size_t)(BK * 2);
    const size_t hstep = (size_t)HALF * K * 2;
    const size_t tstep = 2 * hstep;
    constexpr bool GA = Sched::GATHER;
    static_assert(!GA || SP2, "gathered A rows: SP2 loop only");
    const size_t hstepA = GA ? 0 : hstep;
    unsigned gcur[2][2] = {{0u, 0u}, {0u, 0u}}, gnxt[2][2] = {{0u, 0u}, {0u, 0u}}; int gR[2] = {0, 0}; unsigned gC[2] = {0u, 0u};
    if constexpr (GA) { _Pragma("unroll") for (int i = 0; i < 2; ++i) { int R, C; stage_rc(tid * 16 + i * 8192, R, C); gR[i] = R; gC[i] = (unsigned)C * 2u; } }
#define PG8_GOFF(dst, u) do { if constexpr (GA) { _Pragma("unroll") for (int h_ = 0; h_ < 2; ++h_) _Pragma("unroll") for (int i_ = 0; i_ < 2; ++i_) dst[h_][i_] = (unsigned)S.rowtok[(u).pm * BM + h_ * HALF + gR[i_]] * (unsigned)(K * 2) + gC[i_]; } } while (0)
#define PG8_VA(h, sel) (GA ? ((sel) ? gnxt[h] : gcur[h]) : voffA)
    const unsigned ldsw = (unsigned)wid * 1024u;
    const int aoff = lds_byte(wr * 64 + fr, fq * 8), boff = lds_byte(wc * 32 + fr, fq * 8);
#define PG8_SA(b, h) (((b) * 2 + (h)) * HTB)
#define PG8_SB(b, h) ((4 + (b) * 2 + (h)) * HTB)
#define PG8_STAGE(bufoff, gbase, voff) do { _Pragma("unroll") for (int _i = 0; _i < 2; ++_i) \
        __builtin_amdgcn_global_load_lds((const unsigned*)((const char*)(gbase) + (voff)[_i]), (PG8_LAS unsigned*)(lds + (bufoff) + ldsw + _i * 8192), 16, 0, 0); } while (0)
#define PG8_LDA(dst, b, h) do { _Pragma("unroll") for (int m = 0; m < 4; ++m) _Pragma("unroll") for (int k = 0; k < 2; ++k) dst[m][k] = *(const PG8_LAS bf16x8*)(lds + PG8_SA(b, h) + aoff + m * 2048 + k * 1024); } while (0)
#define PG8_LDB(dst, b, h) do { _Pragma("unroll") for (int n = 0; n < 2; ++n) _Pragma("unroll") for (int k = 0; k < 2; ++k) dst[n][k] = *(const PG8_LAS bf16x8*)(lds + PG8_SB(b, h) + boff + n * 2048 + k * 1024); } while (0)
#define PG8_MMA(ai, bj, At, Bt) do { __builtin_amdgcn_s_setprio(1); _Pragma("unroll") for (int m = 0; m < 4; ++m) _Pragma("unroll") for (int n = 0; n < 2; ++n) _Pragma("unroll") for (int k = 0; k < 2; ++k) \
        acc[ai][bj][m][n] = __builtin_amdgcn_mfma_f32_16x16x32_bf16(Bt[n][k], At[m][k], acc[ai][bj][m][n], 0, 0, 0); __builtin_amdgcn_s_setprio(0); } while (0)
#define PG8_WAIT_V(n) asm volatile("s_waitcnt vmcnt(" #n ")" ::: "memory")
#define PG8_WAIT_L(n) asm volatile("s_waitcnt lgkmcnt(" #n ")" ::: "memory")
#define PG8_BAR __builtin_amdgcn_s_barrier()
#define PG8_SCHED __builtin_amdgcn_sched_barrier(0)
    Unit cur, nxt; int ui = 0;
    if (!S.next(0, cur)) return;
    f32x4 acc[2][2][4][2];
#pragma unroll
    for (int a = 0; a < 2; ++a)
#pragma unroll
        for (int b = 0; b < 2; ++b)
#pragma unroll
            for (int m = 0; m < 4; ++m)
#pragma unroll
                for (int n = 0; n < 2; ++n) acc[a][b][m][n] = (f32x4){0.f, 0.f, 0.f, 0.f};
    bf16x8 At[4][2], B0[2][2], B1[2][2];
    const char* cA = (const char*)g.A + (GA ? 0 : (size_t)cur.pm * tstep); const char* cB = (const char*)g.Bt + (size_t)cur.pn * tstep;
    S.a_ready(cur);
    PG8_GOFF(gcur, cur);
    if constexpr (SP2) {
        PG8_STAGE(PG8_SB(0, 0), cB, voffB); PG8_STAGE(PG8_SB(0, 1), cB + hstep, voffB); PG8_STAGE(PG8_SA(0, 0), cA, PG8_VA(0, false)); PG8_STAGE(PG8_SA(0, 1), cA + hstepA, PG8_VA(1, false));
        if (wr == 1) PG8_BAR;
        PG8_WAIT_V(2); PG8_BAR;
        PG8_STAGE(PG8_SB(1, 0), cB + kstep, voffB); PG8_STAGE(PG8_SA(1, 0), cA + kstep, PG8_VA(0, false)); PG8_STAGE(PG8_SB(1, 1), cB + hstep + kstep, voffB);
        PG8_WAIT_V(6); PG8_BAR;
    } else {
        PG8_STAGE(PG8_SB(0, 0), cB, voffB); PG8_STAGE(PG8_SA(0, 0), cA, voffA); PG8_STAGE(PG8_SB(0, 1), cB + hstep, voffB); PG8_STAGE(PG8_SA(0, 1), cA + hstep, voffA);
        if (wr == 1) PG8_BAR;
        PG8_WAIT_V(4); PG8_BAR;
        PG8_STAGE(PG8_SB(1, 0), cB + kstep, voffB); PG8_STAGE(PG8_SA(1, 0), cA + kstep, voffA); PG8_STAGE(PG8_SB(1, 1), cB + hstep + kstep, voffB);
        PG8_WAIT_V(6); PG8_BAR;
    }
    for (;;) {
        const bool has_next = S.next(ui + 1, nxt);
        if (has_next) PG8_GOFF(gnxt, nxt);
        const char* nA = has_next ? (const char*)g.A + (GA ? 0 : (size_t)nxt.pm * tstep) : cA; const char* nB = has_next ? (const char*)g.Bt + (size_t)nxt.pn * tstep : cB;
        const char* dA = cA; const char* dB = cB;
        if constexpr (DUAL) { dA = (const char*)g.A2 + (size_t)cur.pm * tstep - (size_t)nh * kstep; dB = (const char*)g.Bt2 + (size_t)cur.pn * tstep - (size_t)nh * kstep; }
        for (int th = 0; th < (DUAL ? 2 : 1); ++th) {
        for (int t = th * nh; t < (DUAL ? (th + 1) * nh : nt); t += 2) {
            const bool last = (t == nt - 2);
            const char* a1 = ((DUAL && t + 1 >= nh) ? dA : cA) + (size_t)(t + 1) * kstep;
            const char* a2 = last ? nA : ((DUAL && t + 2 >= nh) ? dA : cA) + (size_t)(t + 2) * kstep; const char* b2 = last ? nB : ((DUAL && t + 2 >= nh) ? dB : cB) + (size_t)(t + 2) * kstep;
            const char* a3 = a2 + kstep; const char* b3 = b2 + kstep;
            if (last && has_next) S.a_ready(nxt);
            const bool seln = last && has_next;
            if constexpr (SP2) {
            PG8_LDB(B0, 0, 0); PG8_LDB(B1, 0, 1); PG8_SCHED; PG8_LDA(At, 0, 0); PG8_STAGE(PG8_SA(1, 1), a1 + hstepA, PG8_VA(1, false));
            PG8_WAIT_V(8); PG8_WAIT_L(0); PG8_BAR; PG8_MMA(0, 0, At, B0); PG8_MMA(0, 1, At, B1); PG8_BAR; PG8_SCHED;
            PG8_LDA(At, 0, 1); PG8_STAGE(PG8_SB(0, 0), b2, voffB); PG8_STAGE(PG8_SB(0, 1), b2 + hstep, voffB); PG8_STAGE(PG8_SA(0, 0), a2, PG8_VA(0, seln));
            PG8_WAIT_V(8); PG8_WAIT_L(0); PG8_BAR; PG8_MMA(1, 0, At, B0); PG8_MMA(1, 1, At, B1); PG8_BAR; PG8_SCHED;
            PG8_LDB(B0, 1, 0); PG8_LDB(B1, 1, 1); PG8_SCHED; PG8_LDA(At, 1, 0); PG8_STAGE(PG8_SA(0, 1), a2 + hstepA, PG8_VA(1, seln));
            PG8_WAIT_V(8); PG8_WAIT_L(0); PG8_BAR; PG8_MMA(0, 0, At, B0); PG8_MMA(0, 1, At, B1); PG8_BAR; PG8_SCHED;
            PG8_LDA(At, 1, 1); PG8_STAGE(PG8_SB(1, 0), b3, voffB); PG8_STAGE(PG8_SB(1, 1), b3 + hstep, voffB); PG8_STAGE(PG8_SA(1, 0), a3, PG8_VA(0, seln));
            PG8_WAIT_V(8); PG8_WAIT_L(0); PG8_BAR; PG8_MMA(1, 0, At, B0); PG8_MMA(1, 1, At, B1); PG8_BAR; PG8_SCHED;
            } else {
            PG8_LDB(B0, 0, 0); PG8_SCHED; PG8_LDA(At, 0, 0); PG8_STAGE(PG8_SA(1, 1), a1 + hstep, voffA);
            PG8_WAIT_L(8); PG8_BAR; PG8_WAIT_L(0); PG8_MMA(0, 0, At, B0); PG8_BAR; PG8_SCHED;
            PG8_LDB(B1, 0, 1); PG8_STAGE(PG8_SB(0, 0), b2, voffB);
            PG8_BAR; PG8_WAIT_L(0); PG8_MMA(0, 1, At, B1); PG8_BAR;
            PG8_LDA(At, 0, 1); PG8_STAGE(PG8_SA(0, 0), a2, voffA);
            PG8_BAR; PG8_WAIT_L(0); PG8_MMA(1, 0, At, B0); PG8_BAR; PG8_SCHED;
            PG8_STAGE(PG8_SB(0, 1), b2 + hstep, voffB);
            PG8_WAIT_V(6); PG8_BAR; PG8_MMA(1, 1, At, B1); PG8_BAR;
            PG8_LDB(B0, 1, 0); PG8_SCHED; PG8_LDA(At, 1, 0); PG8_STAGE(PG8_SA(0, 1), a2 + hstep, voffA);
            PG8_WAIT_L(8); PG8_BAR; PG8_WAIT_L(0); PG8_MMA(0, 0, At, B0); PG8_BAR; PG8_SCHED;
            PG8_LDB(B1, 1, 1); PG8_STAGE(PG8_SB(1, 0), b3, voffB);
            PG8_BAR; PG8_WAIT_L(0); PG8_MMA(0, 1, At, B1); PG8_BAR;
            PG8_LDA(At, 1, 1); PG8_STAGE(PG8_SA(1, 0), a3, voffA);
            PG8_BAR; PG8_WAIT_L(0); PG8_MMA(1, 0, At, B0); PG8_BAR; PG8_SCHED;
            PG8_STAGE(PG8_SB(1, 1), b3 + hstep, voffB);
            PG8_WAIT_V(6); PG8_BAR; PG8_MMA(1, 1, At, B1); PG8_BAR;
            }
        }
        if constexpr (DUAL) { if (th == 0) E.mid(acc, cur, wr, wc, fr, fq); }
        }
        if constexpr (ALIGN_EPI) { if (wr == 0) PG8_BAR; }
        if constexpr (!Epi::AFTER_DRAIN) { E(acc, cur, wr, wc, fr, fq); S.done(cur); }
#ifdef DBG_EPI2
        if constexpr (is_epibf16<Epi>::value) { asm volatile("" ::: "memory"); E(acc, cur, wr, wc, fr, fq); }
#endif
#ifdef DBG_EPI2R
        if constexpr (!Epi::PERM) { asm volatile("" ::: "memory"); E(acc, cur, wr, wc, fr, fq); }
#endif
        if (!has_next) break;
#pragma unroll
        for (int a = 0; a < 2; ++a)
#pragma unroll
            for (int b = 0; b < 2; ++b)
#pragma unroll
                for (int m = 0; m < 4; ++m)
#pragma unroll
                    for (int n = 0; n < 2; ++n) acc[a][b][m][n] = (f32x4){0.f, 0.f, 0.f, 0.f};
        cur = nxt; cA = nA; cB = nB; ++ui;
        if constexpr (GA) { _Pragma("unroll") for (int h_ = 0; h_ < 2; ++h_) _Pragma("unroll") for (int i_ = 0; i_ < 2; ++i_) gcur[h_][i_] = gnxt[h_][i_]; }
        if constexpr (ALIGN_EPI) { if (wr == 1) PG8_BAR; }
    }
    PG8_WAIT_V(0);
    if constexpr (!ALIGN_EPI) { if (wr == 0) PG8_BAR; }
    PG8_BAR;
    if constexpr (Epi::AFTER_DRAIN) { E.fused(acc, cur, wr, wc, fr, fq, lds, wid, lane); S.done(cur); }
#undef PG8_GOFF
#undef PG8_VA
#undef PG8_SA
#undef PG8_SB
#undef PG8_STAGE
#undef PG8_LDA
#undef PG8_LDB
#undef PG8_MMA
#undef PG8_WAIT_V
#undef PG8_WAIT_L
#undef PG8_BAR
#undef PG8_SCHED
}
}
constexpr int NWAVES = 8;
constexpr int BATCH = 8, SEQ = 4096, D = 1024, T = BATCH * SEQ;
constexpr int NPROJ = 5120;
constexpr int NTILE = NPROJ / 256;
constexpr float EPS = 1e-6f;
#ifndef MK_N_LAUNCHES
#define MK_N_LAUNCHES 1
#endif
#ifndef DBG_NPH
#define DBG_NPH 12
#endif
constexpr int NPH = DBG_NPH;
constexpr int N_LAUNCHES = MK_N_LAUNCHES;
static_assert(N_LAUNCHES == 1 || N_LAUNCHES == NPH, "MK_N_LAUNCHES is 1 or NPH");

constexpr size_t MiB = 1u << 20;
constexpr size_t WS_CTL = 0, CTL_ZERO_BYTES = 1 * MiB;
constexpr size_t WS_SMALL = 1 * MiB;
constexpr size_t WS_WIN = 2 * MiB;
constexpr size_t WS_WPA = 13 * MiB, WS_WPM = 14 * MiB, WS_WOUT = 15 * MiB;
constexpr size_t WS_TOKE = 17 * MiB;
constexpr size_t WS_TOKR = WS_TOKE + 256 * 1024;
constexpr size_t WS_TOKP = WS_TOKR + 256 * 1024;
constexpr size_t WS_TOKG = WS_TOKP + 256 * 1024;
constexpr size_t WS_CNT = WS_TOKG + 256 * 1024;
constexpr size_t WS_ROWTOK = WS_CNT + 64 * 1024;
constexpr int NROWS_MAX = 73728;
constexpr size_t WS_SC = 452 * MiB;
constexpr size_t WS_SC2 = 116 * MiB + 3 * ((size_t)T * 256 * 2);
constexpr size_t WS_GU = 20 * MiB;
constexpr size_t WS_DN = 84 * MiB;
constexpr size_t WS_PROJ = 116 * MiB;
constexpr size_t PROJ_TILE = (size_t)T * 256 * 2;
constexpr size_t WS_MLST = 116 * MiB;
constexpr size_t WS_MERGED = 116 * MiB;
constexpr size_t WS_XN = 180 * MiB;
constexpr size_t WS_XG = 244 * MiB;
constexpr size_t WS_HID = 388 * MiB;
constexpr size_t WS_Y = 244 * MiB;
constexpr size_t WS_END = 512 * MiB;
static_assert(WS_PROJ + NTILE * PROJ_TILE == 436 * MiB, "proj map");
constexpr size_t DO_H = 0, DO_YATT = 0, DO_YML = 32 * MiB, DO_KN = 64 * MiB, DO_IKR = 72 * MiB, DO_IQR = 74 * MiB, DO_AQN = 90 * MiB;
constexpr int TL_AQ = 0, TL_KV = 2, TL_IQ = 3, TL_MQ = 4, TL_MK = 6, TL_MV = 8, TL_MO = 10, TL_GA = 12, TL_GM = 16;
constexpr size_t WS_WSM = WS_SMALL + 64 * 1024;
constexpr size_t WS_WTG = WS_SMALL + 192 * 1024;
constexpr size_t DO_SMB = 122 * MiB;
constexpr int CW_BAR = 4096;
constexpr int CW_Q = 16384;
constexpr int CW_KMAX = 24576;
constexpr int CW_RDY = 32768;
constexpr int LDS_BYTES = 163840, MISC_OFF = LDS_BYTES - 512;

#define GAS __attribute__((address_space(1)))
#define LAS __attribute__((address_space(3)))
typedef unsigned short bf16;
typedef unsigned v4u __attribute__((ext_vector_type(4)));
typedef unsigned v2u __attribute__((ext_vector_type(2)));
typedef float f32x4 __attribute__((ext_vector_type(4)));
typedef float f32x2 __attribute__((ext_vector_type(2)));
typedef short bf16x8 __attribute__((ext_vector_type(8)));
typedef GAS unsigned gu32;
#define RLX_AGENT __ATOMIC_RELAXED, __HIP_MEMORY_SCOPE_AGENT
#define LDS_WAIT() asm volatile("s_waitcnt lgkmcnt(0)" ::: "memory")
__device__ __forceinline__ float bf2f(unsigned b16) { return __uint_as_float(b16 << 16); }
__device__ __forceinline__ unsigned f2bf(float f) { unsigned u = __float_as_uint(f); return (u + 0x7fffu + ((u >> 16) & 1u)) >> 16; }
__device__ __forceinline__ unsigned pk2(float lo, float hi) { return pg8::cvt_pk_bf16(lo, hi); }
__device__ __forceinline__ float sigm(float x) { return __builtin_amdgcn_rcpf(1.0f + __expf(-x)); }
__device__ __forceinline__ float wave_sum(float v) {
    v += __int_as_float(__builtin_amdgcn_update_dpp(0, __float_as_int(v), 0xB1, 0xF, 0xF, true));
    v += __int_as_float(__builtin_amdgcn_update_dpp(0, __float_as_int(v), 0x4E, 0xF, 0xF, true));
    v += __int_as_float(__builtin_amdgcn_update_dpp(0, __float_as_int(v), 0x124, 0xF, 0xF, true));
    v += __int_as_float(__builtin_amdgcn_update_dpp(0, __float_as_int(v), 0x128, 0xF, 0xF, true));
    { const auto r = __builtin_amdgcn_permlane16_swap(__float_as_uint(v), __float_as_uint(v), false, false); v = __uint_as_float(r[0]) + __uint_as_float(r[1]); }
    { const auto r = __builtin_amdgcn_permlane32_swap(__float_as_uint(v), __float_as_uint(v), false, false); v = __uint_as_float(r[0]) + __uint_as_float(r[1]); }
    return v;
}
__device__ __forceinline__ void unpack8(const v4u r, float (&f)[8]) {
    f[0] = bf2f(r.x & 0xffffu); f[1] = bf2f(r.x >> 16); f[2] = bf2f(r.y & 0xffffu); f[3] = bf2f(r.y >> 16);
    f[4] = bf2f(r.z & 0xffffu); f[5] = bf2f(r.z >> 16); f[6] = bf2f(r.w & 0xffffu); f[7] = bf2f(r.w >> 16);
}
__device__ __forceinline__ v4u pack8(const float (&f)[8]) { v4u w; w.x = pk2(f[0], f[1]); w.y = pk2(f[2], f[3]); w.z = pk2(f[4], f[5]); w.w = pk2(f[6], f[7]); return w; }
#define XB_TMO      128
#define XB_XCNT(j)  (256  + 64 * (j))
#define XB_XSUB(j)  (1280 + 64 * (j))
#define XB_XGEN(j)  (2304 + 64 * (j))
#define XB_TOP      3328
#define XB_TOPGEN   3392
#define XCD_BAR_WORDS 3456
#define XB_SPIN_CAP (1u << 18)

__device__ __forceinline__ unsigned xb_ld(unsigned* p)              { return __hip_atomic_load(p, __ATOMIC_RELAXED, __HIP_MEMORY_SCOPE_AGENT); }
__device__ __forceinline__ unsigned xb_add(unsigned* p, unsigned v) { return __hip_atomic_fetch_add(p, v, __ATOMIC_RELAXED, __HIP_MEMORY_SCOPE_AGENT); }
__device__ __forceinline__ unsigned xb_xcc_id() { return (unsigned)__builtin_amdgcn_s_getreg((3 << 11) | 20) & 0xFu; }
#define XB_SPIN(cond, bar) do { unsigned _sp = 0; while (cond) { __builtin_amdgcn_s_sleep(1); \
    if ((++_sp & 255u) == 0u) { if (xb_ld(&(bar)[XB_TMO])) break; if (_sp > XB_SPIN_CAP) { atomicAdd(&(bar)[XB_TMO], 1u); break; } } } } while (0)

struct XcdBarrier {
    unsigned* bar; unsigned x;
    volatile LAS unsigned* st;
};

__device__ __forceinline__ XcdBarrier xcd_barrier_post(unsigned* bar, volatile LAS unsigned* st) {
    XcdBarrier b; b.bar = bar; b.x = xb_xcc_id(); b.st = st;
    if (threadIdx.x == 0) st[12] = xb_add(&bar[XB_XCNT(b.x)], 1u);
    return b;
}
__device__ __forceinline__ void xcd_barrier_complete(unsigned* bar, unsigned x, unsigned& nloc, unsigned& nx) {
    const unsigned G = gridDim.x * gridDim.y * gridDim.z;
    unsigned sum, cnt, mine, sp = 0u;
    for (;;) {
        sum = 0u; cnt = 0u; mine = 0u;
#pragma unroll
        for (unsigned j = 0; j < 16; ++j) { const unsigned c = xb_ld(&bar[XB_XCNT(j)]); sum += c; cnt += (c > 0u) ? 1u : 0u; mine = (j == x) ? c : mine; }
        if (sum == G) break;
        __builtin_amdgcn_s_sleep(1);
        if ((++sp & 255u) == 0u) { if (xb_ld(&bar[XB_TMO])) break; if (sp > XB_SPIN_CAP) { atomicAdd(&bar[XB_TMO], 1u); break; } }
    }
    nloc = mine > 0u ? mine : 1u; nx = cnt > 0u ? cnt : 1u;
}

__device__ __forceinline__ void xcd_barrier(const XcdBarrier& b) {
    asm volatile("s_waitcnt vmcnt(0)" ::: "memory");
    __syncthreads();
    if (threadIdx.x == 0) {
        unsigned* bar = b.bar;
        __builtin_amdgcn_s_waitcnt(0);
        unsigned nloc = b.st[0], nx = b.st[1];
        if (nloc == 0u) { xcd_barrier_complete(bar, b.x, nloc, nx); b.st[0] = nloc; b.st[1] = nx; }
        const unsigned old = xb_add(&bar[XB_XSUB(b.x)], 1u);
        const unsigned gen = old / nloc;
        if (old + 1u == (gen + 1u) * nloc) {
            __builtin_amdgcn_fence(__ATOMIC_RELEASE, "agent");
            asm volatile("s_waitcnt vmcnt(0)" ::: "memory");
            const unsigned og = xb_add(&bar[XB_TOP], 1u);
            const unsigned tg = og / nx;
            if (og + 1u == (tg + 1u) * nx) xb_add(&bar[XB_TOPGEN], 1u);
            else XB_SPIN(xb_ld(&bar[XB_TOPGEN]) == tg, bar);
            __builtin_amdgcn_fence(__ATOMIC_ACQUIRE, "agent");
            xb_add(&bar[XB_XGEN(b.x)], 1u);
            asm volatile("s_waitcnt vmcnt(0)" ::: "memory");
        } else {
            XB_SPIN(xb_ld(&bar[XB_XGEN(b.x)]) == gen, bar);
            __builtin_amdgcn_fence(__ATOMIC_ACQUIRE, "agent");
            asm volatile("s_waitcnt vmcnt(0)" ::: "memory");
        }
    }
    __syncthreads();
}
struct Args { const float* in[22]; float* out; unsigned char* ws; int ph_lo, ph_hi, li, pad; };
struct Ctx { int tid, lane, wave, G, vcu; LAS unsigned char* lds; };
#define IN_X 0
#define IN_POS 1
#define IN_GMIX 2
#define IN_WIN 3
#define IN_GQ 4
#define IN_GK 5
#define IN_WCONV 6
#define IN_BCONV 7
#define IN_BI 8
#define IN_BF 9
#define IN_GML 10
#define IN_WPA 11
#define IN_WPM 12
#define IN_WOUT 13
#define IN_GMOE 14
#define IN_WRG 15
#define IN_BRG 16
#define IN_WRE 17
#define IN_BRE 18
#define IN_WEG 19
#define IN_WEU 20
#define IN_WED 21

__device__ __forceinline__ int win_src_col(int n) {
    if (n < 1024) return n;
    if (n < 3072) return n + 40;
    return n + 48;
}
__device__ __forceinline__ int wsm_src_col(int r) {
    return r < 40 ? 1024 + r : (r < 44 ? 3112 + (r - 40) : 3116 + (r - 44));
}
__device__ __forceinline__ void tr_item(const float* W, int ldw, int scol, int k0, bf16* wt0, int K, LAS float* scr, int lane) {
    const int sc0 = __builtin_amdgcn_readfirstlane(scol), sc31 = __builtin_amdgcn_readlane(scol, 31);
    if (sc0 >= 0 && sc31 == sc0 + 31 && (sc0 & 3) == 0 && (ldw & 3) == 0) {
#pragma unroll
        for (int i = 0; i < 8; ++i) { const int kk = 8 * i + (lane >> 3); const f32x4 v = *(const f32x4*)(W + (size_t)(k0 + kk) * ldw + sc0 + 4 * (lane & 7));
            LAS float* d = scr + kk * 33 + 4 * (lane & 7); d[0] = v[0]; d[1] = v[1]; d[2] = v[2]; d[3] = v[3]; }
    } else {
#pragma unroll 8
        for (int i = 0; i < 32; ++i) { const int kk = 2 * i + (lane >> 5); scr[kk * 33 + (lane & 31)] = scol >= 0 ? W[(size_t)(k0 + kk) * ldw + scol] : 0.f; }
    }
    LDS_WAIT(); asm volatile("" ::: "memory");
    const int c = lane & 7;
#pragma unroll
    for (int j = 0; j < 4; ++j) { const int n = (lane >> 3) + 8 * j; const LAS float* s = scr + (8 * c) * 33 + n;
        v4u o; o.x = pk2(s[0 * 33], s[1 * 33]); o.y = pk2(s[2 * 33], s[3 * 33]); o.z = pk2(s[4 * 33], s[5 * 33]); o.w = pk2(s[6 * 33], s[7 * 33]);
        *(v4u*)(wt0 + (size_t)n * K + 8 * c) = o; }
    LDS_WAIT(); asm volatile("" ::: "memory");
}
template <int PART> __device__ __forceinline__ void p0_prologue(const Args& a, const Ctx& c, int gw, int NGW) {
    unsigned char* ws = a.ws;
    LAS float* scr = (LAS float*)(c.lds + c.wave * 16384);
    const int lane = c.lane;
    constexpr int I_IN = 16 * 160, I_PA = 8 * 32, I_PM = 8 * 32, I_OUT = 16 * 32, I_GU = 32 * 16 * 32, I_DN = 32 * 8 * 32;
    constexpr int NPRJ = I_IN + I_PA + I_PM + I_OUT, NIT = NPRJ + I_GU + I_DN;
    for (int it = (PART ? NPRJ : 0) + gw; it < (PART ? NIT : NPRJ); it += NGW) {
        int r = it;
        if (r < I_IN) { const int kb = r / 160, nb = r % 160; tr_item(a.in[IN_WIN], 5168, win_src_col(32 * nb + (lane & 31)), 64 * kb, (bf16*)(ws + WS_WIN) + (size_t)(32 * nb) * 1024 + 64 * kb, 1024, scr, lane); continue; } r -= I_IN;
        if (r < I_PA) { const int kb = r / 32, nb = r % 32; tr_item(a.in[IN_WPA], 1024, 32 * nb + (lane & 31), 64 * kb, (bf16*)(ws + WS_WPA) + (size_t)(32 * nb) * 512 + 64 * kb, 512, scr, lane); continue; } r -= I_PA;
        if (r < I_PM) { const int kb = r / 32, nb = r % 32; tr_item(a.in[IN_WPM], 1024, 32 * nb + (lane & 31), 64 * kb, (bf16*)(ws + WS_WPM) + (size_t)(32 * nb) * 512 + 64 * kb, 512, scr, lane); continue; } r -= I_PM;
        if (r < I_OUT) { const int kb = r / 32, nb = r % 32; tr_item(a.in[IN_WOUT], 1024, 32 * nb + (lane & 31), 64 * kb, (bf16*)(ws + WS_WOUT) + (size_t)(32 * nb) * 1024 + 64 * kb, 1024, scr, lane); continue; } r -= I_OUT;
        if (r < I_GU) { const int e = r / 512, q = r % 512, kb = q / 32, nb = q % 32, t = nb >> 3, bj = (nb >> 2) & 1, i0 = (nb & 3) * 32;
            const float* src = (bj ? a.in[IN_WEU] : a.in[IN_WEG]) + (size_t)e * 1024 * 512;
            tr_item(src, 512, 128 * t + i0 + (lane & 31), 64 * kb, (bf16*)(ws + WS_GU) + ((size_t)e * 1024 + 32 * nb) * 1024 + 64 * kb, 1024, scr, lane); continue; } r -= I_GU;
        { const int e = r / 256, q = r % 256, kb = q / 32, nb = q % 32;
            tr_item(a.in[IN_WED] + (size_t)e * 512 * 1024, 1024, 32 * nb + (lane & 31), 64 * kb, (bf16*)(ws + WS_DN) + ((size_t)e * 1024 + 32 * nb) * 512 + 64 * kb, 512, scr, lane); }
    }
    if (PART) return;
    { float* WTG = (float*)(ws + WS_WTG); for (int i = gw * 64 + lane; i < 36 * 1024; i += NGW * 64) { const int j = i >> 10, k = i & 1023;
        WTG[j * 1028 + k] = (j < 32 ? a.in[IN_WRE][k * 32 + j] : a.in[IN_WRG][k * 4 + (j - 32)]) * a.in[IN_GMOE][k]; } }
    { bf16* WSM = (bf16*)(ws + WS_WSM); for (int i = gw * 64 + lane; i < 48 * 1024; i += NGW * 64) { const int r = i >> 10, k = i & 1023; WSM[i] = (bf16)f2bf(a.in[IN_WIN][(size_t)k * 5168 + wsm_src_col(r)]); } }
    const float* g = a.in[IN_GMIX]; f32x4 gv[4];
#pragma unroll
    for (int j = 0; j < 4; ++j) gv[j] = *(const f32x4*)(g + 4 * lane + 256 * j);
    bf16* H = (bf16*)((unsigned char*)a.out + DO_H);
    for (int m0 = gw; m0 < T; m0 += 2 * NGW) {
        const int mA = m0, mB = (m0 + NGW < T) ? m0 + NGW : m0; const bool hasB = (m0 + NGW < T);
        const f32x4* xa = (const f32x4*)(a.in[IN_X] + (size_t)mA * D) + lane; const f32x4* xb = (const f32x4*)(a.in[IN_X] + (size_t)mB * D) + lane;
        f32x4 va[4], vb[4]; float sa = 0.f, sb = 0.f;
#pragma unroll
        for (int j = 0; j < 4; ++j) { va[j] = xa[64 * j]; vb[j] = xb[64 * j]; }
#pragma unroll
        for (int j = 0; j < 4; ++j) { sa += (va[j].x * va[j].x + va[j].y * va[j].y) + (va[j].z * va[j].z + va[j].w * va[j].w); sb += (vb[j].x * vb[j].x + vb[j].y * vb[j].y) + (vb[j].z * vb[j].z + vb[j].w * vb[j].w); }
        const float ra = rsqrtf(wave_sum(sa) * (1.f / D) + EPS), rb = rsqrtf(wave_sum(sb) * (1.f / D) + EPS);
        v2u* oa = (v2u*)(H + (size_t)mA * D) + lane; v2u* ob = (v2u*)(H + (size_t)mB * D) + lane;
#pragma unroll
        for (int j = 0; j < 4; ++j) { v2u w; w.x = pk2(va[j].x * ra * gv[j].x, va[j].y * ra * gv[j].y); w.y = pk2(va[j].z * ra * gv[j].z, va[j].w * ra * gv[j].w); oa[64 * j] = w; }
        if (hasB) {
#pragma unroll
        for (int j = 0; j < 4; ++j) { v2u w; w.x = pk2(vb[j].x * rb * gv[j].x, vb[j].y * rb * gv[j].y); w.y = pk2(vb[j].z * rb * gv[j].z, vb[j].w * rb * gv[j].w); ob[64 * j] = w; } }
    }
}

__device__ __forceinline__ const bf16* proj_tile(const Args& a, int tile) { return (const bf16*)(a.ws + WS_PROJ + (size_t)tile * PROJ_TILE); }
#define DPPF(x_, ctrl_) __int_as_float(__builtin_amdgcn_update_dpp(0, __float_as_int(x_), ctrl_, 0xF, 0xF, true))
__device__ __forceinline__ void p2_prep(const Args& a, const Ctx& c) {
    const int lane = c.lane, gw = c.vcu * NWAVES + c.wave, NGW = c.G * NWAVES;
    float invf = 0.f;
    if (lane < 8) invf = (float)pow(500000.0, -(double)lane / 8.0); else if (lane < 12) invf = (float)pow(500000.0, -(double)(lane - 8) / 4.0);
    float gq[8], gk[8];
#pragma unroll
    for (int i = 0; i < 8; ++i) { gq[i] = a.in[IN_GQ][8 * (lane & 7) + i]; gk[i] = a.in[IN_GK][8 * (lane & 7) + i]; }
    const int* pos = (const int*)a.in[IN_POS];
    unsigned char* dout = (unsigned char*)a.out;
    bf16* AQN = (bf16*)(dout + DO_AQN); bf16* KN = (bf16*)(dout + DO_KN); bf16* IQR = (bf16*)(dout + DO_IQR); bf16* IKR = (bf16*)(dout + DO_IKR);
    { const bf16* Hh = (const bf16*)(dout + DO_H); const bf16* WSM = (const bf16*)(a.ws + WS_WSM); bf16* SMB = (bf16*)(dout + DO_SMB);
      const int row = lane & 15, kg = lane >> 4;
      const float invfk = (float)pow(500000.0, -(double)(lane & 3) / 4.0);
      for (int tile = gw; tile < T / 16; tile += NGW) { const int t0 = tile * 16;
          f32x4 acc[3];
#pragma unroll
          for (int ct = 0; ct < 3; ++ct) acc[ct] = (f32x4){0.f, 0.f, 0.f, 0.f};
          const bf16* ap = Hh + (size_t)(t0 + row) * 1024 + 8 * kg; const bf16* bp = WSM + (size_t)row * 1024 + 8 * kg;
#pragma unroll 8
          for (int ks = 0; ks < 32; ++ks) { const bf16x8 av = *(const bf16x8*)(ap + 32 * ks);
#pragma unroll
              for (int ct = 0; ct < 3; ++ct) acc[ct] = __builtin_amdgcn_mfma_f32_16x16x32_bf16(av, *(const bf16x8*)(bp + (size_t)ct * 16 * 1024 + 32 * ks), acc[ct], 0, 0, 0); }
          const int col = lane & 15;
#pragma unroll
          for (int r = 0; r < 4; ++r) { const int t = t0 + 4 * kg + r;
              const float angk = (float)pos[t] * invfk;
              const double revk = (double)angk * 0.15915494309189535; const float frk = (float)(revk - __builtin_rint(revk));
              const float ck = __builtin_amdgcn_cosf(frk), sk = __builtin_amdgcn_sinf(frk);
              const float v0 = acc[0][r], pr = __shfl_xor(v0, 4);
              const float o0 = (col < 4) ? (v0 * ck - pr * sk) : ((col < 8) ? (v0 * ck + pr * sk) : v0);
              IKR[(size_t)t * 32 + col] = (bf16)f2bf(o0); IKR[(size_t)t * 32 + 16 + col] = (bf16)f2bf(acc[1][r]);
              SMB[(size_t)t * 16 + col] = (bf16)f2bf(acc[2][r]); }
          { float nk = 0.f;
#pragma unroll
            for (int r = 0; r < 4; ++r) { float q2 = acc[0][r] * acc[0][r] + acc[1][r] * acc[1][r];
                q2 += DPPF(q2, 0xB1); q2 += DPPF(q2, 0x4E); q2 += DPPF(q2, 0x141); q2 += DPPF(q2, 0x140);
                nk = fmaxf(nk, q2); }
            nk = fmaxf(nk, __shfl_xor(nk, 16)); nk = fmaxf(nk, __shfl_xor(nk, 32));
            if (lane == 0) atomicMax((unsigned*)(a.ws + WS_CTL) + CW_KMAX + 16 * (t0 / SEQ), __float_as_uint(nk)); } } }
    const int l7 = lane & 7;
    const int aqcol = (lane >> 3) * 64 + 8 * l7, akcol = ((lane & 15) >> 3) * 64 + 8 * l7;
    const bf16* aqsrc = proj_tile(a, TL_AQ + (aqcol >> 8)) + (aqcol & 255); const bf16* aksrc = proj_tile(a, TL_KV) + akcol; const bf16* iqsrc = proj_tile(a, TL_IQ) + 4 * lane;
#define P2_LOADROW(t_, P_, A_, K_, Q_) do { const int tt_ = (t_) < T ? (t_) : T - 1; P_ = pos[tt_]; A_ = *(const v4u*)(aqsrc + (size_t)tt_ * 256); K_ = *(const v4u*)(aksrc + (size_t)tt_ * 256); Q_ = *(const v2u*)(iqsrc + (size_t)tt_ * 256); } while (0)
#define P2_DOROW(t, P_, A_, K_, Q_) do { \
        const float ang = (float)(P_) * invf; \
        const double rev = (double)ang * 0.15915494309189535; const float frv = (float)(rev - __builtin_rint(rev)); \
        float cs = __builtin_amdgcn_cosf(frv), sn = __builtin_amdgcn_sinf(frv); \
        float ca[8], sa[8], ci[4], si[4]; \
        _Pragma("unroll") for (int i = 0; i < 8; ++i) { ca[i] = __int_as_float(__builtin_amdgcn_readlane(__float_as_int(cs), i)); sa[i] = __int_as_float(__builtin_amdgcn_readlane(__float_as_int(sn), i)); } \
        _Pragma("unroll") for (int i = 0; i < 4; ++i) { ci[i] = __int_as_float(__builtin_amdgcn_readlane(__float_as_int(cs), 8 + i)); si[i] = __int_as_float(__builtin_amdgcn_readlane(__float_as_int(sn), 8 + i)); } \
        { float f[8]; unpack8(A_, f); float ss = 0.f; \
          _Pragma("unroll") for (int i = 0; i < 8; ++i) ss += f[i] * f[i]; \
          ss += DPPF(ss, 0xB1); ss += DPPF(ss, 0x4E); ss += DPPF(ss, 0x141); \
          const float r = rsqrtf(ss * (1.f / 64.f) + EPS); \
          _Pragma("unroll") for (int i = 0; i < 8; ++i) f[i] = f[i] * r * gq[i]; \
          float o[8]; \
          _Pragma("unroll") for (int i = 0; i < 8; ++i) { const float p = DPPF(f[i], 0xB1); o[i] = (l7 == 0) ? (f[i] * ca[i] - p * sa[i]) : ((l7 == 1) ? (f[i] * ca[i] + p * sa[i]) : f[i]); o[i] *= 0.125f * 1.4426950408889634f; } \
          *(v4u*)(AQN + (size_t)(t) * 512 + aqcol) = pack8(o); } \
        { float f[8]; unpack8(K_, f); float ss = 0.f; \
          _Pragma("unroll") for (int i = 0; i < 8; ++i) ss += f[i] * f[i]; \
          ss += DPPF(ss, 0xB1); ss += DPPF(ss, 0x4E); ss += DPPF(ss, 0x141); \
          const float r = rsqrtf(ss * (1.f / 64.f) + EPS); \
          _Pragma("unroll") for (int i = 0; i < 8; ++i) f[i] = f[i] * r * gk[i]; \
          float o[8]; \
          _Pragma("unroll") for (int i = 0; i < 8; ++i) { const float p = DPPF(f[i], 0xB1); o[i] = (l7 == 0) ? (f[i] * ca[i] - p * sa[i]) : ((l7 == 1) ? (f[i] * ca[i] + p * sa[i]) : f[i]); } \
          if (lane < 16) *(v4u*)(KN + (size_t)(t) * 128 + akcol) = pack8(o); } \
        { const v2u rw = Q_; \
          float f[4] = {bf2f(rw.x & 0xffffu), bf2f(rw.x >> 16), bf2f(rw.y & 0xffffu), bf2f(rw.y >> 16)}; float o[4]; \
          _Pragma("unroll") for (int i = 0; i < 4; ++i) { const float p = DPPF(f[i], 0xB1); o[i] = (l7 == 0) ? (f[i] * ci[i] - p * si[i]) : ((l7 == 1) ? (f[i] * ci[i] + p * si[i]) : f[i]); } \
          v2u w; w.x = pk2(o[0], o[1]); w.y = pk2(o[2], o[3]); *(v2u*)(IQR + (size_t)(t) * 256 + 4 * lane) = w; } } while (0)
    { int pA, pB; v4u aA, aB, kA, kB; v2u qA, qB;
      P2_LOADROW(gw, pA, aA, kA, qA);
#pragma unroll 1
      for (int t = gw; t < T; t += 2 * NGW) {
          P2_LOADROW(t + NGW, pB, aB, kB, qB);
          P2_DOROW(t, pA, aA, kA, qA);
          P2_LOADROW(t + 2 * NGW, pA, aA, kA, qA);
          if (t + NGW < T) P2_DOROW(t + NGW, pB, aB, kB, qB);
      } }
#undef P2_LOADROW
#undef P2_DOROW
}
constexpr int ML_QS = 0, ML_KS = 17408, ML_HS = 0;
constexpr int ML_KWT = 34816;
constexpr int ML_VT = 53248;
constexpr int ML_SW = 73984;
constexpr int ML_CT = 83200;
constexpr int ML_GA = 122368;
constexpr int ML_CW = ML_GA + 1024;
constexpr int ML_END = ML_CW + (1024 + 384) * 4;
static_assert(ML_END <= MISC_OFF, "mLSTM LDS map");
constexpr size_t ML_STATE_BYTES = 8 * 9 * 64 * 16;
__device__ __forceinline__ bf16x8 lds_frag(const LAS unsigned char* base, int stride_b, int row0, int kb, int lane) {
    return *(const LAS bf16x8*)(base + (row0 + (lane & 15)) * stride_b + kb + (lane >> 4) * 16);
}
__device__ __forceinline__ bf16x8 lds_frag_sw(const LAS unsigned char* base, int row0, int ks, int lane) {
    const int row = row0 + (lane & 15); return *(const LAS bf16x8*)(base + row * 144 + 16 * (((ks * 4 + (lane >> 4)) + (row >> 3)) & 7));
}
#define MFMA16(a_, b_, c_) __builtin_amdgcn_mfma_f32_16x16x32_bf16(a_, b_, c_, 0, 0, 0)
constexpr int CV_NMI = 2 * (32 * 16 * 32 + 32 * 8 * 32);
constexpr int CV_SCR = ML_END, CV_SCRW = 32 * 33 * 4;
static_assert(CV_SCR + 8 * CV_SCRW <= MISC_OFF, "conversion scratch");
struct CvItem { const float* src; bf16* dst; int ldw, K; };
__device__ __forceinline__ CvItem cv_item(const Args& a, int mi) {
    const int it = mi >> 1, hk = mi & 1; CvItem r;
    if (it < 32 * 16 * 32) { const int e = it >> 9, q = it & 511, kb = q >> 5, nb = q & 31, t = nb >> 3, bj = (nb >> 2) & 1, i0 = (nb & 3) * 32, k0 = 64 * kb + 32 * hk;
        r.src = (bj ? a.in[IN_WEU] : a.in[IN_WEG]) + (size_t)e * 1024 * 512 + (size_t)k0 * 512 + 128 * t + i0; r.ldw = 512; r.K = 1024;
        r.dst = (bf16*)(a.ws + WS_GU) + ((size_t)e * 1024 + 32 * nb) * 1024 + k0;
    } else { const int r2 = it - 32 * 16 * 32, e = r2 >> 8, q = r2 & 255, kb = q >> 5, nb = q & 31, k0 = 64 * kb + 32 * hk;
        r.src = a.in[IN_WED] + (size_t)e * 512 * 1024 + (size_t)k0 * 1024 + 32 * nb; r.ldw = 1024; r.K = 512;
        r.dst = (bf16*)(a.ws + WS_DN) + ((size_t)e * 1024 + 32 * nb) * 512 + k0; }
    return r;
}
__device__ __forceinline__ void cv_load(const CvItem& it, f32x4 (&v)[4], int lane) {
#pragma unroll
    for (int i = 0; i < 4; ++i) v[i] = *(const f32x4*)(it.src + (size_t)(8 * i + (lane >> 3)) * it.ldw + 4 * (lane & 7));
}
__device__ __forceinline__ void cv_finish(const CvItem& it, const f32x4 (&v)[4], LAS float* scr, int lane, bool valid) {
#pragma unroll
    for (int i = 0; i < 4; ++i) { LAS float* d = scr + (8 * i + (lane >> 3)) * 33 + 4 * (lane & 7); d[0] = v[i][0]; d[1] = v[i][1]; d[2] = v[i][2]; d[3] = v[i][3]; }
    LDS_WAIT(); asm volatile("" ::: "memory");
#pragma unroll
    for (int j = 0; j < 2; ++j) { const int n = (lane >> 2) + 16 * j, cq = lane & 3; const LAS float* sp = scr + (8 * cq) * 33 + n;
        v4u o; o.x = pk2(sp[0 * 33], sp[1 * 33]); o.y = pk2(sp[2 * 33], sp[3 * 33]); o.z = pk2(sp[4 * 33], sp[5 * 33]); o.w = pk2(sp[6 * 33], sp[7 * 33]);
        if (valid) *(v4u*)(it.dst + (size_t)n * it.K + 8 * cq) = o; }
    LDS_WAIT(); asm volatile("" ::: "memory");
}
template <int MODE>
__device__ __forceinline__ void mlstm_unit(const Args& a, const Ctx& c, int b, int h, int g) {
    const int tid = c.tid, wave = c.wave; LAS unsigned char* lds = c.lds;
#define ML_LAUNDER() int tv_ = tid; asm volatile("" : "+v"(tv_)); const int lane = tv_ & 63, seg = tv_ & 15, r2 = (tv_ >> 4) * 2; (void)lane; (void)seg; (void)r2
    const bf16* PQ = proj_tile(a, TL_MQ + (h >> 1)) + (h & 1) * 128;
    const bf16* PK = proj_tile(a, TL_MK + (h >> 1)) + (h & 1) * 128;
    const bf16* PV = proj_tile(a, TL_MV + (h >> 1)) + (h & 1) * 128;
    const bf16* PO = proj_tile(a, TL_MO + (h >> 1)) + (h & 1) * 128;
    const bf16* PS = (const bf16*)((unsigned char*)a.out + DO_SMB);
    bf16* YML = (bf16*)((unsigned char*)a.out + DO_YML);
    unsigned char* STB = a.ws + WS_MLST; float* MST = (float*)(a.ws + WS_MLST + 256 * ML_STATE_BYTES);
    LAS float* GAa = (LAS float*)(lds + ML_GA); LAS float* GAm = GAa + 64; LAS float* GAw = GAa + 128; LAS float* GAe = GAa + 192;
    LAS float* CWQ = (LAS float*)(lds + ML_CW); LAS float* CWK = CWQ + 512; LAS float* CBQ = CWQ + 1024; LAS float* CBK = CBQ + 128; LAS float* GN = CBK + 128;
    LAS bf16* VTs = (LAS bf16*)(lds + ML_VT);
    { const float* wc = a.in[IN_WCONV]; const int j = tid >> 7, d = tid & 127;
      CWQ[tid] = wc[j * 1024 + h * 128 + d]; CWK[tid] = wc[j * 1024 + 512 + h * 128 + d];
      if (tid < 128) { CBQ[tid] = a.in[IN_BCONV][h * 128 + tid]; CBK[tid] = a.in[IN_BCONV][512 + h * 128 + tid]; GN[tid] = a.in[IN_GML][h * 128 + tid]; } }
    for (int i = tid; i < 16 * 64; i += 512) { const int r = i >> 6, cc = i & 63; VTs[(128 + r) * 72 + cc] = (r == 0) ? (bf16)0x3F80 : (bf16)0; }
    const float big = a.in[IN_BI][h], bfg = a.in[IN_BF][h];
    const int slot0 = (b * 4 + h) * 8;
    f32x4 cacc[9];
    float m_st = 0.f;
    if (MODE == 1 && g > 0) { ML_LAUNDER();
        const f32x4* sp = (const f32x4*)(STB + (size_t)(slot0 + g) * ML_STATE_BYTES) + wave * 576 + lane;
#pragma unroll
        for (int i = 0; i < 9; ++i) cacc[i] = sp[64 * i];
        m_st = MST[slot0 + g];
#pragma unroll
        for (int ee = 0; ee < 9; ++ee) { v2u w; w.x = pk2(cacc[ee][0], cacc[ee][1]); w.y = pk2(cacc[ee][2], cacc[ee][3]);
            *(LAS v2u*)(lds + ML_CT + (ee * 16 + (lane & 15)) * 272 + (wave * 16 + 4 * (lane >> 4)) * 2) = w; }
    } else {
#pragma unroll
        for (int i = 0; i < 9; ++i) cacc[i] = (f32x4){0.f, 0.f, 0.f, 0.f};
        for (int i = tid; i < 144 * 136 / 2; i += 512) ((LAS unsigned*)(lds + ML_CT))[i] = 0u;
    }
    const size_t tb = (size_t)b * SEQ;
    const char* bq = (const char*)(PQ + tb * 256); const char* bk = (const char*)(PK + tb * 256); const char* bv = (const char*)(PV + tb * 256); const char* bo = (const char*)(PO + tb * 256); const char* bs = (const char*)(PS + tb * 16);
    v4u rq[5], rk[5], rv[2]; unsigned short gi = 0, gf = 0;
#define ML_LOAD(kc) do { _Pragma("unroll") for (int j_ = 0; j_ < 5; ++j_) { const int rr_ = 64 * (kc) + r2 - 3 + j_; const unsigned o_ = (unsigned)((rr_ < 0 ? 0 : rr_) * 512 + seg * 16); \
            v4u q_ = (v4u){0u, 0u, 0u, 0u}; if (MODE == 1) q_ = *(const v4u*)(bq + o_); v4u k_ = *(const v4u*)(bk + o_); if (rr_ < 0) { q_ = (v4u){0u, 0u, 0u, 0u}; k_ = q_; } rq[j_] = q_; rk[j_] = k_; } \
        _Pragma("unroll") for (int i_ = 0; i_ < 2; ++i_) rv[i_] = *(const v4u*)(bv + (unsigned)((64 * (kc) + r2 + i_) * 512 + seg * 16)); \
        gi = *(const unsigned short*)(bs + (unsigned)((64 * (kc) + lane) * 32 + (8 + h) * 2)); gf = *(const unsigned short*)(bs + (unsigned)((64 * (kc) + lane) * 32 + (12 + h) * 2)); } while (0)
    const int kc0 = (MODE == 1) ? 8 * g : 0, kc1 = (MODE == 1) ? 8 * g + 8 : 56;
    { ML_LAUNDER(); ML_LOAD(kc0); }
    const int cv_gw = c.vcu * NWAVES + c.wave, cv_ngw = c.G * NWAVES; f32x4 cvv[4]; CvItem cvi; int cvk = 0; bool cvp = false;
    LAS float* cv_scr = (LAS float*)(lds + CV_SCR + wave * CV_SCRW);
#define CV_SLOT() do { if (MODE == 1) { ML_LAUNDER(); if (cvp) cv_finish(cvi, cvv, cv_scr, lane, cv_gw + (cvk - 1) * cv_ngw < CV_NMI); \
        { int mi_ = cv_gw + cvk * cv_ngw; mi_ = mi_ < CV_NMI ? mi_ : CV_NMI - 1; cvi = cv_item(a, __builtin_amdgcn_readfirstlane(mi_)); cv_load(cvi, cvv, lane); cvp = true; ++cvk; } } } while (0)
    __syncthreads();
#pragma unroll 1
    for (int kc = kc0; kc < kc1; ++kc) {
        float wkv, decay, m_new;
        if (MODE == 0 && kc > 0 && (kc & 7) == 0) { ML_LAUNDER();
            f32x4* sp = (f32x4*)(STB + (size_t)(slot0 + (kc >> 3)) * ML_STATE_BYTES) + wave * 576 + lane;
#pragma unroll
            for (int i = 0; i < 9; ++i) sp[64 * i] = cacc[i];
            if (tid == 0) MST[slot0 + (kc >> 3)] = m_st; }
        CV_SLOT();
        { ML_LAUNDER();
        const float fpre = bf2f(gf) + bfg, lf = fminf(fpre, 0.f) - log1pf(__expf(-fabsf(fpre)));
        const float ig = bf2f(gi) + big;
#define ML_SHR(x_, n_, id_) __int_as_float(__builtin_amdgcn_update_dpp(__float_as_int(id_), __float_as_int(x_), 0x110 + (n_), 0xF, 0xF, false))
        float bc = lf;
        bc += ML_SHR(bc, 1, 0.f); bc += ML_SHR(bc, 2, 0.f); bc += ML_SHR(bc, 4, 0.f); bc += ML_SHR(bc, 8, 0.f);
        { const float t0 = __int_as_float(__builtin_amdgcn_readlane(__float_as_int(bc), 15)), t1 = __int_as_float(__builtin_amdgcn_readlane(__float_as_int(bc), 31)), t2 = __int_as_float(__builtin_amdgcn_readlane(__float_as_int(bc), 47));
          bc += (lane >= 48) ? (t0 + t1 + t2) : ((lane >= 32) ? (t0 + t1) : ((lane >= 16) ? t0 : 0.f)); }
        const float av = ig - bc; float Ac = av;
        Ac = fmaxf(Ac, ML_SHR(Ac, 1, -3.0e38f)); Ac = fmaxf(Ac, ML_SHR(Ac, 2, -3.0e38f)); Ac = fmaxf(Ac, ML_SHR(Ac, 4, -3.0e38f)); Ac = fmaxf(Ac, ML_SHR(Ac, 8, -3.0e38f));
        { const float t0 = __int_as_float(__builtin_amdgcn_readlane(__float_as_int(Ac), 15)), t1 = __int_as_float(__builtin_amdgcn_readlane(__float_as_int(Ac), 31)), t2 = __int_as_float(__builtin_amdgcn_readlane(__float_as_int(Ac), 47));
          const float m01 = fmaxf(t0, t1), m012 = fmaxf(m01, t2);
          Ac = fmaxf(Ac, (lane >= 48) ? m012 : ((lane >= 32) ? m01 : ((lane >= 16) ? t0 : -3.0e38f))); }
#undef ML_SHR
        const float mA = fmaxf(m_st, Ac), Mk = __int_as_float(__builtin_amdgcn_readlane(__float_as_int(mA), 63)), blast = __int_as_float(__builtin_amdgcn_readlane(__float_as_int(bc), 63));
        wkv = __expf(av - Mk); decay = __expf(m_st - Mk); m_new = blast + Mk;
        if (MODE == 1 && wave == 0) { GAa[lane] = av; GAm[lane] = mA; GAw[lane] = __expf(m_st - mA); GAe[lane] = __expf(-(bc + mA)); } }
#ifndef DBG_MLB
#define DBG_MLB 1
#endif
#ifndef DBG_MLF
#define DBG_MLF 1
#endif
        _Pragma("unroll 1") for (int pb_ = 0; pb_ < DBG_MLB; ++pb_)
        { ML_LAUNDER(); float kw_[2][8];
#pragma unroll
          for (int i = 0; i < 2; ++i) { const int t = r2 + i; const float wkt = __shfl(wkv, t);
            float aq_[8], ak_[8];
            { const f32x4 b0 = *(const LAS f32x4*)(CBQ + seg * 8), b1 = *(const LAS f32x4*)(CBQ + seg * 8 + 4), c0 = *(const LAS f32x4*)(CBK + seg * 8), c1 = *(const LAS f32x4*)(CBK + seg * 8 + 4);
              aq_[0] = b0[0]; aq_[1] = b0[1]; aq_[2] = b0[2]; aq_[3] = b0[3]; aq_[4] = b1[0]; aq_[5] = b1[1]; aq_[6] = b1[2]; aq_[7] = b1[3];
              ak_[0] = c0[0]; ak_[1] = c0[1]; ak_[2] = c0[2]; ak_[3] = c0[3]; ak_[4] = c1[0]; ak_[5] = c1[1]; ak_[6] = c1[2]; ak_[7] = c1[3]; }
#pragma unroll
            for (int j = 0; j < 4; ++j) { float fk_[8]; unpack8(rk[i + j], fk_);
                const f32x4 x0 = *(const LAS f32x4*)(CWK + j * 128 + seg * 8), x1 = *(const LAS f32x4*)(CWK + j * 128 + seg * 8 + 4);
#pragma unroll
                for (int e = 0; e < 4; ++e) { ak_[e] += x0[e] * fk_[e]; ak_[4 + e] += x1[e] * fk_[4 + e]; }
                if (MODE == 1) { float fq_[8]; unpack8(rq[i + j], fq_);
                    const f32x4 w0 = *(const LAS f32x4*)(CWQ + j * 128 + seg * 8), w1 = *(const LAS f32x4*)(CWQ + j * 128 + seg * 8 + 4);
#pragma unroll
                    for (int e = 0; e < 4; ++e) { aq_[e] += w0[e] * fq_[e]; aq_[4 + e] += w1[e] * fq_[4 + e]; } } }
#pragma unroll
            for (int e = 0; e < 8; ++e) { ak_[e] = ak_[e] * sigm(ak_[e]) * 0.08838834764831845f; kw_[i][e] = ak_[e] * wkt; }
            if (MODE == 1) {
#pragma unroll
                for (int e = 0; e < 8; ++e) aq_[e] = aq_[e] * sigm(aq_[e]);
                *(LAS v4u*)(lds + ML_QS + t * 272 + seg * 16) = pack8(aq_);
                *(LAS v4u*)(lds + ML_KS + t * 272 + seg * 16) = pack8(ak_); } }
          const unsigned va[4] = {rv[0].x, rv[0].y, rv[0].z, rv[0].w}, vb[4] = {rv[1].x, rv[1].y, rv[1].z, rv[1].w};
          const int swo = 16 * (((r2 >> 3) + seg) & 7) + 2 * (r2 & 7);
#pragma unroll
          for (int e = 0; e < 8; ++e) { const int ro = (seg * 8 + e) * 144 + swo;
              *(LAS unsigned*)(lds + ML_KWT + ro) = pk2(kw_[0][e], kw_[1][e]);
              const unsigned lo = (e & 1) ? (va[e >> 1] >> 16) : (va[e >> 1] & 0xffffu), hi = (e & 1) ? (vb[e >> 1] >> 16) : (vb[e >> 1] & 0xffffu);
              *(LAS unsigned*)(lds + ML_VT + ro) = lo | (hi << 16); } }
        { ML_LAUNDER(); if (kc + 1 < kc1) ML_LOAD(kc + 1); }
        __syncthreads();
        f32x4 hacc[5]; unsigned mo_r[8];
        const int tt = wave & 3, t0 = tt * 16, ne = (wave < 4) ? 5 : 4, e_first = (wave < 4) ? 0 : 5;
        CV_SLOT();
        if (MODE == 1) {
        { ML_LAUNDER(); const int tq = t0 + (lane & 15);
        bf16x8 qf[4];
#pragma unroll
        for (int ks = 0; ks < 4; ++ks) qf[ks] = lds_frag(lds + ML_QS, 272, t0, ks * 64, lane);
        const float mAt = GAm[tq], wit = GAw[tq];
#pragma unroll
        for (int si = 0; si < 2; ++si) { const int ss = 2 * (wave >> 2) + si, s0 = ss * 16; f32x4 sacc = (f32x4){0.f, 0.f, 0.f, 0.f};
            if (ss <= tt) {
#pragma unroll
                for (int ks = 0; ks < 4; ++ks) sacc = MFMA16(lds_frag(lds + ML_KS, 272, s0, ks * 64, lane), qf[ks], sacc);
#pragma unroll
                for (int r = 0; r < 4; ++r) { const int s = s0 + 4 * (lane >> 4) + r; sacc[r] = (s <= tq) ? sacc[r] * __expf(GAa[s] - mAt) : 0.f; } }
            v2u w; w.x = pk2(sacc[0], sacc[1]); w.y = pk2(sacc[2], sacc[3]);
            *(LAS v2u*)(lds + ML_SW + tq * 144 + s0 * 2 + (lane >> 4) * 8) = w; }
#pragma unroll
        for (int i = 0; i < 5; ++i) { hacc[i] = (f32x4){0.f, 0.f, 0.f, 0.f};
            if (i < ne) {
#pragma unroll
                for (int ks = 0; ks < 4; ++ks) hacc[i] = MFMA16(lds_frag(lds + ML_CT, 272, (e_first + i) * 16, ks * 64, lane), qf[ks], hacc[i]);
                hacc[i] = hacc[i] * wit; } }
#pragma unroll
        for (int i = 0; i < 8; ++i) mo_r[i] = *(const unsigned*)(bo + (unsigned)((64 * kc + 8 * wave + i) * 512 + 4 * lane)); }
        __syncthreads();
        { ML_LAUNDER(); const int tq = t0 + (lane & 15); bf16x8 swf[2];
#pragma unroll
          for (int ks = 0; ks < 2; ++ks) swf[ks] = lds_frag(lds + ML_SW, 144, t0, ks * 64, lane);
#pragma unroll
          for (int i = 0; i < 5; ++i) if (i < ne) { const int ee = e_first + i;
#pragma unroll
              for (int ks = 0; ks < 2; ++ks) hacc[i] = MFMA16(lds_frag_sw(lds + ML_VT, ee * 16, ks, lane), swf[ks], hacc[i]);
              if (ee < 8) *(LAS f32x4*)(lds + ML_HS + tq * 528 + (ee * 16 + 4 * (lane >> 4)) * 4) = hacc[i];
              else if ((lane >> 4) == 0) *(LAS float*)(lds + ML_HS + tq * 528 + 128 * 4) = hacc[i][0]; } }
        }
        CV_SLOT();
        { ML_LAUNDER(); const int d0 = wave * 16; bf16x8 kwf[2];
#pragma unroll
          for (int ks = 0; ks < 2; ++ks) kwf[ks] = lds_frag_sw(lds + ML_KWT, d0, ks, lane);
#pragma unroll
          for (int ee = 0; ee < 9; ++ee) { cacc[ee] = cacc[ee] * decay;
#pragma unroll
              for (int ks = 0; ks < 2; ++ks) cacc[ee] = MFMA16(kwf[ks], lds_frag_sw(lds + ML_VT, ee * 16, ks, lane), cacc[ee]);
              if (MODE == 1) { v2u w; w.x = pk2(cacc[ee][0], cacc[ee][1]); w.y = pk2(cacc[ee][2], cacc[ee][3]);
                  *(LAS v2u*)(lds + ML_CT + (ee * 16 + (lane & 15)) * 272 + (d0 + 4 * (lane >> 4)) * 2) = w; } } }
        __syncthreads();
        if (MODE == 1) {
        _Pragma("unroll 1") for (int pf_ = 0; pf_ < DBG_MLF; ++pf_)
        { ML_LAUNDER();
#pragma unroll
        for (int i = 0; i < 8; ++i) { const int t = 8 * wave + i;
            const f32x2 nv = *(const LAS f32x2*)(lds + ML_HS + t * 528 + lane * 8); const float den = *(const LAS float*)(lds + ML_HS + t * 528 + 512);
            const float dd = __builtin_amdgcn_rcpf(fmaxf(fabsf(den), GAe[t])); const float h0 = nv.x * dd, h1 = nv.y * dd;
            const float r = rsqrtf(wave_sum(h0 * h0 + h1 * h1) * (1.f / 128.f) + EPS);
            const float y0 = h0 * r * GN[2 * lane] * sigm(bf2f(mo_r[i] & 0xffffu)), y1 = h1 * r * GN[2 * lane + 1] * sigm(bf2f(mo_r[i] >> 16));
            *(unsigned*)(YML + (tb + 64 * kc + t) * 512 + h * 128 + 2 * lane) = pk2(y0, y1); } }
        __syncthreads();
        }
        m_st = m_new;
    }
    if (MODE == 1) { ML_LAUNDER(); if (cvp) cv_finish(cvi, cvv, cv_scr, lane, cv_gw + (cvk - 1) * cv_ngw < CV_NMI); }
#undef CV_SLOT
    if (MODE == 0) { ML_LAUNDER();
        f32x4* sp = (f32x4*)(STB + (size_t)(slot0 + 7) * ML_STATE_BYTES) + wave * 576 + lane;
#pragma unroll
        for (int i = 0; i < 9; ++i) sp[64 * i] = cacc[i];
        if (tid == 0) MST[slot0 + 7] = m_st; }
#undef ML_LOAD
#undef ML_LAUNDER
}
constexpr int AT_HIST = 0;
constexpr int AT_HROW = 2049;
constexpr int AT_SEL = 131072 + 256;
constexpr int AT_MROW = 129;
constexpr int AT_SM = AT_SEL + 8448;
constexpr int AT_LUT = AT_SM + 256;
constexpr int AT_SEL2 = AT_LUT + 256;
static_assert(AT_SEL2 + 8448 <= MISC_OFF, "attention LDS map");
__device__ __forceinline__ unsigned at_bin(float s, float inv) { const float x = __builtin_fmaf(s, inv, 2048.0f); return (unsigned)(int)__builtin_amdgcn_fmed3f(x, 0.0f, 4095.0f); }
__device__ __forceinline__ unsigned score_key(float s) { unsigned u = __float_as_uint(s + 0.0f); return (u & 0x80000000u) ? ~u : (u | 0x80000000u); }
__device__ __forceinline__ unsigned wave_suffix_sum(unsigned v, int lane) {
#define AT_SHL(x_, n_) ((unsigned)__builtin_amdgcn_update_dpp(0, (int)(x_), 0x100 + (n_), 0xF, 0xF, false))
    v += AT_SHL(v, 1); v += AT_SHL(v, 2); v += AT_SHL(v, 4); v += AT_SHL(v, 8);
#undef AT_SHL
    const unsigned t1 = (unsigned)__builtin_amdgcn_readlane((int)v, 16), t2 = (unsigned)__builtin_amdgcn_readlane((int)v, 32), t3 = (unsigned)__builtin_amdgcn_readlane((int)v, 48);
    return v + ((lane < 16) ? (t1 + t2 + t3) : ((lane < 32) ? (t2 + t3) : ((lane < 48) ? t3 : 0u)));
}
template <int NK> __device__ __forceinline__ void at_resolve2(const LAS unsigned long long* candA, LAS unsigned* maskA, int mA, int ndA,
                                                              const LAS unsigned long long* candB, LAS unsigned* maskB, int mB, int ndB, int lane) {
    unsigned long long ca[NK], cb[NK];
#pragma unroll
    for (int k = 0; k < NK; ++k) { const int i = 64 * k + lane; unsigned long long x = 0ull, y = 0ull; if (i < mA) x = candA[i]; if (i < mB) y = candB[i];
        ca[k] = (i < mA) ? (((x >> 32) << 16) | (x & 0xFFFFull)) : 0ull; cb[k] = (i < mB) ? (((y >> 32) << 16) | (y & 0xFFFFull)) : 0ull; }
    unsigned long long TA = 0ull, TB = 0ull;
#pragma unroll 1
    for (int bit = 47; bit >= 16; --bit) { const unsigned long long ta = TA | (1ull << bit), tb = TB | (1ull << bit); int ga = 0, gb = 0;
#pragma unroll
        for (int k = 0; k < NK; ++k) { ga += __popcll(__ballot(ca[k] >= ta)); gb += __popcll(__ballot(cb[k] >= tb)); }
        if (ga >= ndA) TA = ta; if (gb >= ndB) TB = tb; }
    int gA = 0, tA = 0, gB = 0, tB = 0;
#pragma unroll
    for (int k = 0; k < NK; ++k) { gA += __popcll(__ballot(ca[k] >= TA + 0x10000ull)); tA += __popcll(__ballot(ca[k] >= TA)); gB += __popcll(__ballot(cb[k] >= TB + 0x10000ull)); tB += __popcll(__ballot(cb[k] >= TB)); }
    tA -= gA; tB -= gB;
    if (tA > ndA - gA || tB > ndB - gB) {
#pragma unroll 1
        for (int bit = 15; bit >= 0; --bit) { const unsigned long long ta = TA | (1ull << bit), tb = TB | (1ull << bit); int ga = 0, gb = 0;
#pragma unroll
            for (int k = 0; k < NK; ++k) { ga += __popcll(__ballot(ca[k] >= ta)); gb += __popcll(__ballot(cb[k] >= tb)); }
            if (ga >= ndA) TA = ta; if (gb >= ndB) TB = tb; } }
#pragma unroll
    for (int k = 0; k < NK; ++k) {
        if (ca[k] >= TA && ca[k] != 0ull) { const unsigned key = 0xFFFFu - (unsigned)(ca[k] & 0xFFFFull);
            __hip_atomic_fetch_or(&maskA[key >> 5], 1u << (key & 31u), __ATOMIC_RELAXED, __HIP_MEMORY_SCOPE_WORKGROUP); }
        if (cb[k] >= TB && cb[k] != 0ull) { const unsigned key = 0xFFFFu - (unsigned)(cb[k] & 0xFFFFull);
            __hip_atomic_fetch_or(&maskB[key >> 5], 1u << (key & 31u), __ATOMIC_RELAXED, __HIP_MEMORY_SCOPE_WORKGROUP); } }
}
__device__ __forceinline__ void attn_unit(const Args& a, const Ctx& c, int b, int qt, float cshift) {
    const int tid = c.tid, wave = c.wave; LAS unsigned char* lds = c.lds;
#define AT_LAUNDER() int tv_ = tid; asm volatile("" : "+v"(tv_)); const int lane = tv_ & 63, qi = tv_ & 15, fq = (tv_ >> 4) & 3; (void)lane; (void)qi; (void)fq
    const int q0u = qt * 32, ch = q0u >> 6, n = 64 * (ch + 1), ntiles = n >> 4;
    const size_t tb = (size_t)b * SEQ;
    unsigned char* dout = (unsigned char*)a.out;
    const bf16* AQN = (const bf16*)(dout + DO_AQN); const bf16* KN = (const bf16*)(dout + DO_KN); const bf16* IQR = (const bf16*)(dout + DO_IQR); const bf16* IKR = (const bf16*)(dout + DO_IKR);
    bf16* YATT = (bf16*)(dout + DO_YATT);
    const bf16* VB = proj_tile(a, TL_KV); const bf16* PS = (const bf16*)(dout + DO_SMB);
    LAS unsigned* HIST = (LAS unsigned*)(lds + AT_HIST);
    LAS unsigned long long* CAND = (LAS unsigned long long*)(lds + AT_HIST);
    LAS int* SM = (LAS int*)(lds + AT_SM);
    float* SC = (blockIdx.x < 240) ? (float*)(a.ws + WS_SC) + (size_t)blockIdx.x * (16 * 4096) : (float*)(a.ws + WS_SC2) + (size_t)(blockIdx.x - 240) * (16 * 4096);
#ifndef DBG_REP_DENSE
#define DBG_REP_DENSE 1
#endif
#pragma unroll 1
    for (int rsel = 0; rsel < 2; ++rsel) {
    const int q0 = q0u + 16 * rsel;
    LAS unsigned* MASK = (LAS unsigned*)(lds + (rsel ? AT_SEL2 : AT_SEL));
    if (n > 256) {
        for (int i = tid; i < 8192 + 4; i += 512) ((LAS v4u*)HIST)[i] = (v4u){0u, 0u, 0u, 0u};
        if (tid < 64) SM[tid] = 0;
        for (int i = tid; i < 16 * AT_MROW; i += 512) MASK[i] = 0u;
        bf16x8 qf[8]; float wv[8]; bf16x8 qsh, qsl; float binv;
        { AT_LAUNDER();
        const size_t trow = tb + q0 + qi;
#pragma unroll
        for (int h = 0; h < 8; ++h) qf[h] = *(const bf16x8*)(IQR + trow * 256 + h * 32 + 8 * fq);
        { float t8[8]; unpack8(*(const v4u*)(PS + trow * 16), t8);
#pragma unroll
          for (int h = 0; h < 8; ++h) wv[h] = t8[h] * 0.03125f; }
        { float rq = 0.f;
#pragma unroll
          for (int h = 0; h < 8; ++h) { float f8[8]; unpack8(__builtin_bit_cast(v4u, qf[h]), f8); float q2 = 0.f;
#pragma unroll
            for (int j = 0; j < 8; ++j) q2 = __builtin_fmaf(f8[j], f8[j], q2);
            q2 += __shfl_xor(q2, 16); q2 += __shfl_xor(q2, 32);
            rq = __builtin_fmaf(fabsf(wv[h]), __builtin_sqrtf(q2), rq); }
          const float kmax = __builtin_sqrtf(__uint_as_float(__hip_atomic_load((const unsigned*)(a.ws + WS_CTL) + CW_KMAX + 16 * b, __ATOMIC_RELAXED, __HIP_MEMORY_SCOPE_AGENT)));
          binv = 2048.0f / fmaxf(rq * kmax, 1.0e-30f); }
        { float qs[8];
#pragma unroll
          for (int j = 0; j < 8; ++j) qs[j] = 0.f;
#pragma unroll
          for (int h = 0; h < 8; ++h) { float f8[8]; unpack8(__builtin_bit_cast(v4u, qf[h]), f8);
#pragma unroll
            for (int j = 0; j < 8; ++j) qs[j] = __builtin_fmaf(wv[h], f8[j], qs[j]); }
          float hi8[8], lo8[8]; const v4u ph = pack8(qs); unpack8(ph, hi8);
#pragma unroll
          for (int j = 0; j < 8; ++j) lo8[j] = qs[j] - hi8[j];
          qsh = __builtin_bit_cast(bf16x8, ph); qsl = __builtin_bit_cast(bf16x8, pack8(lo8)); } }
        __syncthreads();
#define AT_LOADK(kt_) (*(const bf16x8*)(IKR + (tb + (size_t)(kt_) * 16 + qi) * 32 + 8 * fq))
#define AT_SCORES(kf_, sc_) do { \
        { const f32x4 l0_ = MFMA16(kf_, qsl, ((f32x4){0.f, 0.f, 0.f, 0.f})); const f32x4 l1_ = MFMA16(kf_, qsh, l0_); \
          _Pragma("unroll") for (int r_ = 0; r_ < 4; ++r_) sc_[r_] = l1_[r_]; } \
        _Pragma("unroll") for (int h_ = 0; h_ < 8; ++h_) { const f32x4 d_ = MFMA16(kf_, qf[h_], ((f32x4){0.f, 0.f, 0.f, 0.f})); \
            _Pragma("unroll") for (int r_ = 0; r_ < 4; ++r_) { sc_[r_] = __builtin_fmaf(wv[h_], __builtin_fabsf(d_[r_]), sc_[r_]); asm("" : "+v"(sc_[r_])); } } } while (0)
        const int cnt = (ntiles - wave + 7) >> 3;
#ifndef DBG_RA
#define DBG_RA 1
#endif
#pragma unroll 1
        for (int rA = 0; rA < DBG_RA; ++rA) { if (rA) { for (int i = tid; i < 8192 + 4; i += 512) ((LAS v4u*)HIST)[i] = (v4u){0u, 0u, 0u, 0u}; __syncthreads(); }
#define AT_LOADG(dst_, i0_) do { _Pragma("unroll") for (int j_ = 0; j_ < 8; ++j_) { int kt_ = wave + 8 * ((i0_) + j_); kt_ = kt_ < ntiles ? kt_ : ntiles - 1; dst_[j_] = AT_LOADK(kt_); } } while (0)
#define AT_P1GROUP(buf_, base_) do { _Pragma("unroll") for (int j2 = 0; j2 < 8; ++j2) { const bool valid = ((base_) + j2 < cnt); const int kt = wave + 8 * ((base_) + j2); float sc[4]; AT_SCORES(buf_[j2], sc); \
                if (valid) *(f32x4*)(SC + qi * 4096 + kt * 16 + 4 * fq) = (f32x4){sc[0], sc[1], sc[2], sc[3]}; \
                _Pragma("unroll") for (int r = 0; r < 4; ++r) { const unsigned bin = at_bin(sc[r], binv); \
                    __hip_atomic_fetch_add(&HIST[qi * AT_HROW + (bin >> 1)], valid ? (1u << ((bin & 1u) * 16)) : 0u, __ATOMIC_RELAXED, __HIP_MEMORY_SCOPE_WORKGROUP); } } } while (0)
        { AT_LAUNDER(); bf16x8 ka[8], kb[8]; AT_LOADG(ka, 0);
#pragma unroll 1
          for (int i0 = 0; i0 < cnt; i0 += 16) {
            AT_LOADG(kb, i0 + 8);
            AT_P1GROUP(ka, i0);
            AT_LOADG(ka, i0 + 16);
            AT_P1GROUP(kb, i0 + 8); } }
#undef AT_P1GROUP
        __syncthreads();
        }
#ifndef DBG_RB
#define DBG_RB 1
#endif
#pragma unroll 1
        for (int rB = 0; rB < DBG_RB; ++rB) {
#pragma unroll 1
        for (int j = 0; j < 2; ++j) { AT_LAUNDER(); const int q = 2 * wave + j; unsigned tot = 0;
            for (int i = 0; i < 32; ++i) { const unsigned w = HIST[q * AT_HROW + 32 * lane + ((i + lane) & 31)]; tot += (w & 0xffffu) + (w >> 16); }
            const unsigned suf = wave_suffix_sum(tot, lane);
            const unsigned long long mk = __ballot(suf >= 256u); const int L = 63 - __clzll((long long)mk);
            const unsigned above_L = (unsigned)__builtin_amdgcn_readlane((int)(suf - tot), L);
            const unsigned w2 = HIST[q * AT_HROW + 32 * L + (lane >> 1)]; const unsigned cb = (lane & 1) ? (w2 >> 16) : (w2 & 0xffffu);
            const unsigned sfx = wave_suffix_sum(cb, lane);
            const unsigned long long mk2 = __ballot(above_L + sfx >= 256u); const int l2 = 63 - __clzll((long long)mk2);
            if (lane == l2) { SM[q] = 64 * L + l2; SM[16 + q] = (int)(256u - (above_L + sfx - cb)); } }
        __syncthreads();
        }
#ifndef DBG_RC
#define DBG_RC 1
#endif
#pragma unroll 1
        for (int rC = 0; rC < DBG_RC; ++rC) { if (rC) { if (tid < 16) SM[48 + tid] = 0; __syncthreads(); }
        { AT_LAUNDER(); const int Bq = SM[qi]; f32x4 scur[8];
#define AT_LOADS(dst_, i0_) do { _Pragma("unroll") for (int j_ = 0; j_ < 8; ++j_) { int kt_ = wave + 8 * ((i0_) + j_); kt_ = kt_ < ntiles ? kt_ : ntiles - 1; dst_[j_] = *(const f32x4*)(SC + qi * 4096 + kt_ * 16 + 4 * fq); } } while (0)
#define AT_P2GROUP(buf_, base_) do { _Pragma("unroll") for (int j2 = 0; j2 < 8; ++j2) { const bool valid = ((base_) + j2 < cnt); const int kt = wave + 8 * ((base_) + j2); \
                unsigned nib = 0u, cnib = 0u; unsigned uu[4]; \
                _Pragma("unroll") for (int r = 0; r < 4; ++r) { uu[r] = __float_as_uint(buf_[j2][r]); const int bin = (int)at_bin(buf_[j2][r], binv); nib |= (bin > Bq) ? (1u << r) : 0u; cnib |= (bin == Bq) ? (1u << r) : 0u; } \
                if (!valid) { nib = 0u; cnib = 0u; } \
                if (cnib) { int p = __hip_atomic_fetch_add(&SM[48 + qi], (int)__popc(cnib), __ATOMIC_RELAXED, __HIP_MEMORY_SCOPE_WORKGROUP); \
                    _Pragma("unroll") for (int r = 0; r < 4; ++r) if ((cnib >> r) & 1u) { if (p < 512) CAND[qi * 1024 + p] = ((unsigned long long)score_key(__uint_as_float(uu[r])) << 32) | (unsigned long long)(0xFFFFu - (unsigned)(kt * 16 + 4 * fq + r)); ++p; } } \
                if (nib) __hip_atomic_fetch_or(&MASK[qi * AT_MROW + (kt >> 1)], nib << (16 * (kt & 1) + 4 * fq), __ATOMIC_RELAXED, __HIP_MEMORY_SCOPE_WORKGROUP); } } while (0)
          f32x4 sb2[8];
          AT_LOADS(scur, 0);
#pragma unroll 1
          for (int i0 = 0; i0 < cnt; i0 += 16) {
            AT_LOADS(sb2, i0 + 8);
            AT_P2GROUP(scur, i0);
            AT_LOADS(scur, i0 + 16);
            AT_P2GROUP(sb2, i0 + 8); } }
#undef AT_P2GROUP
#undef AT_LOADS
        __syncthreads();
        }
#ifndef DBG_RD
#define DBG_RD 1
#endif
#pragma unroll 1
        for (int rD = 0; rD < DBG_RD; ++rD) {
        { AT_LAUNDER(); const int qa_ = 2 * wave, qb_ = 2 * wave + 1; int ma = SM[48 + qa_], mb = SM[48 + qb_]; ma = ma < 512 ? ma : 512; mb = mb < 512 ? mb : 512; const int nda = SM[16 + qa_], ndb = SM[16 + qb_];
            const int mm = ma > mb ? ma : mb;
            if (mm <= 64) at_resolve2<1>(CAND + qa_ * 1024, MASK + qa_ * AT_MROW, ma, nda, CAND + qb_ * 1024, MASK + qb_ * AT_MROW, mb, ndb, lane);
            else if (mm <= 256) at_resolve2<4>(CAND + qa_ * 1024, MASK + qa_ * AT_MROW, ma, nda, CAND + qb_ * 1024, MASK + qb_ * AT_MROW, mb, ndb, lane);
            else at_resolve2<8>(CAND + qa_ * 1024, MASK + qa_ * AT_MROW, ma, nda, CAND + qb_ * 1024, MASK + qb_ * AT_MROW, mb, ndb, lane); }
        __syncthreads();
        }
#undef AT_SCORES
#undef AT_LOADK
#undef AT_LOADG
    } else {
#pragma unroll 1
        for (int i = tid; i < 16 * AT_MROW; i += 512) MASK[i] = ((i % AT_MROW) < (n >> 5)) ? 0xFFFFFFFFu : 0u;
        __syncthreads();
    }
    }
#pragma unroll 1
    for (int rden = 0; rden < DBG_REP_DENSE; ++rden) {
    { const int g = wave >> 2, qh = (wave >> 1) & 1, hp = wave & 1, NS = n >> 6;
      const unsigned ring0 = (unsigned)(size_t)(lds + AT_HIST);
      if (tid < 64) *(LAS float*)(lds + AT_LUT + 4 * tid) = ((tid >> 2) >> (tid & 3)) & 1 ? -cshift : -1.0e30f;
      const bf16* dsrc[4]; unsigned ddst[4];
      { AT_LAUNDER();
#pragma unroll
        for (int i_ = 0; i_ < 4; ++i_) { const int in_ = 4 * wave + i_; const int row_ = 4 * (in_ & 15) + (lane >> 4), pos_ = lane & 15;
            dsrc[i_] = (in_ < 16) ? (KN + (tb + row_) * 128 + ((pos_ ^ (row_ & 15)) << 3)) : (VB + (tb + row_) * 256 + 128 + ((pos_ ^ (2 * (row_ & 7))) << 3));
            ddst[i_] = (unsigned)(in_ * 1024); } }
      const size_t dstep = (wave < 4) ? (size_t)64 * 128 : (size_t)64 * 256;
#define AT_STAGE(s_) do { const unsigned sb_ = ring0 + (unsigned)(((s_) & 3) * 32768); \
        _Pragma("unroll") for (int i_ = 0; i_ < 4; ++i_) { const bf16* src_ = dsrc[i_] + (size_t)(s_) * dstep; \
            const unsigned dst_ = __builtin_amdgcn_readfirstlane(sb_ + ddst[i_]); unsigned keep_; \
            asm volatile("s_mov_b32 %0, m0\n\ts_mov_b32 m0, %2\n\ts_nop 0\n\tglobal_load_lds_dwordx4 %1, off\n\ts_mov_b32 m0, %0" : "=&s"(keep_) : "v"(src_), "s"(dst_) : "memory"); } } while (0)
      bf16x8 qa[2], qb[2]; f32x4 oacc[2][4], lacc[2];
      { AT_LAUNDER();
#pragma unroll
        for (int hi = 0; hi < 2; ++hi) { const bf16* qp = AQN + (tb + q0u + 16 * qh + qi) * 512 + (g * 4 + 2 * hp + hi) * 64 + 8 * fq; qa[hi] = *(const bf16x8*)qp; qb[hi] = *(const bf16x8*)(qp + 32); } }
#pragma unroll
      for (int hi = 0; hi < 2; ++hi) { lacc[hi] = (f32x4){0.f, 0.f, 0.f, 0.f};
#pragma unroll
        for (int dt = 0; dt < 4; ++dt) oacc[hi][dt] = (f32x4){0.f, 0.f, 0.f, 0.f}; }
      const bf16x8 ones = (bf16x8){0x3F80, 0x3F80, 0x3F80, 0x3F80, 0x3F80, 0x3F80, 0x3F80, 0x3F80};
      asm volatile("s_waitcnt vmcnt(0)" ::: "memory");
#pragma unroll 1
      for (int s = 0; s < 3 && s < NS; ++s) AT_STAGE(s);
      typedef short s4_t __attribute__((ext_vector_type(4)));
      AT_LAUNDER();
      const LAS unsigned* mrow = (const LAS unsigned*)(lds + (qh ? AT_SEL2 : AT_SEL)) + qi * AT_MROW;
      const unsigned koff0 = (unsigned)(qi * 256 + (((g * 8 + fq) ^ qi) << 4)), koff1 = (unsigned)(qi * 256 + (((g * 8 + 4 + fq) ^ qi) << 4));
#define AT_LDK(kf_, ci_, slot_, tp_, mw_) do { const LAS unsigned char* kb_ = lds + AT_HIST + (slot_) * 32768 + (tp_) * 8192; \
          _Pragma("unroll") for (int t = 0; t < 2; ++t) { kf_[t][0] = *(const LAS bf16x8*)(kb_ + t * 4096 + koff0); kf_[t][1] = *(const LAS bf16x8*)(kb_ + t * 4096 + koff1); \
              ci_[t] = *(const LAS f32x4*)(lds + AT_LUT + ((((mw_) >> (16 * t + 4 * fq)) & 15u) << 4)); } } while (0)
#define AT_LDV(va_, slot_, vkh_) do { const LAS unsigned char* vb_ = lds + AT_HIST + (slot_) * 32768 + 16384 + (vkh_) * 8192; \
          _Pragma("unroll") for (int dt = 0; dt < 4; ++dt) { const int r1 = 4 * fq + (qi >> 2); const int ch_ = g * 8 + 2 * dt + ((lane & 3) >> 1); \
              const s4_t lo = __builtin_amdgcn_ds_read_tr16_b64_v4i16((LAS s4_t*)(vb_ + r1 * 256 + ((ch_ ^ (2 * (r1 & 7))) << 4) + (lane & 1) * 8)); \
              const s4_t hi4 = __builtin_amdgcn_ds_read_tr16_b64_v4i16((LAS s4_t*)(vb_ + (r1 + 16) * 256 + ((ch_ ^ (2 * (r1 & 7))) << 4) + (lane & 1) * 8)); \
              va_[dt] = (bf16x8){lo[0], lo[1], lo[2], lo[3], hi4[0], hi4[1], hi4[2], hi4[3]}; } } while (0)
#define AT_QKM(dst_, kf_, ci_) do { \
          _Pragma("unroll") for (int t = 0; t < 2; ++t) { \
              _Pragma("unroll") for (int hi = 0; hi < 2; ++hi) { const f32x4 d_ = MFMA16(kf_[t][0], qa[hi], ci_[t]); dst_[hi][t] = MFMA16(kf_[t][1], qb[hi], d_); } } } while (0)
#define AT_EXP(pb_, cur_) do { \
          _Pragma("unroll") for (int hi = 0; hi < 2; ++hi) { float pv[8]; \
              _Pragma("unroll") for (int j = 0; j < 8; ++j) pv[j] = __builtin_amdgcn_exp2f(cur_[hi][j >> 2][j & 3]); \
              v4u pw; pw.x = pk2(pv[0], pv[1]); pw.y = pk2(pv[2], pv[3]); pw.z = pk2(pv[4], pv[5]); pw.w = pk2(pv[6], pv[7]); pb_[hi] = __builtin_bit_cast(bf16x8, pw); } } while (0)
#define AT_PV(pb_, va_) do { \
          _Pragma("unroll") for (int hi = 0; hi < 2; ++hi) lacc[hi] = MFMA16(ones, pb_[hi], lacc[hi]); \
          _Pragma("unroll") for (int dt = 0; dt < 4; ++dt) { \
              _Pragma("unroll") for (int hi = 0; hi < 2; ++hi) oacc[hi][dt] = MFMA16(va_[dt], pb_[hi], oacc[hi][dt]); } } while (0)
      f32x4 st0[2][2], st1[2][2]; bf16x8 kfA[2][2], kfB[2][2]; f32x4 ciA[2], ciB[2]; bf16x8 vaP[4], vaQ[4], pbP[2], pbQ[2];
      if (NS >= 3) asm volatile("s_waitcnt vmcnt(8)" ::: "memory"); else asm volatile("s_waitcnt vmcnt(0)" ::: "memory");
      __builtin_amdgcn_s_barrier(); asm volatile("" ::: "memory");
      unsigned m1A, m1B;
      { const unsigned m0A = mrow[0], m0B = mrow[1]; const int sx = (NS > 1) ? 1 : 0; m1A = mrow[2 * sx]; m1B = mrow[2 * sx + 1];
        AT_LDK(kfB, ciB, 0, 0, m0A); AT_LDK(kfA, ciA, 0, 1, m0B);
        AT_QKM(st0, kfB, ciB);
#pragma unroll
        for (int hi = 0; hi < 2; ++hi) pbP[hi] = (bf16x8){0, 0, 0, 0, 0, 0, 0, 0};
#pragma unroll
        for (int dt = 0; dt < 4; ++dt) vaP[dt] = (bf16x8){0, 0, 0, 0, 0, 0, 0, 0}; }
#pragma unroll 1
      for (int s = 0; s < NS; ++s) {
          if (s + 2 < NS) asm volatile("s_waitcnt vmcnt(4)" ::: "memory"); else asm volatile("s_waitcnt vmcnt(0)" ::: "memory");
          __builtin_amdgcn_s_barrier(); asm volatile("" ::: "memory");
          if (s + 3 < NS) AT_STAGE(s + 3);
          const int s1 = (s + 1 < NS) ? s + 1 : s, s2 = (s + 2 < NS) ? s + 2 : NS - 1;
          const unsigned m2A = mrow[2 * s2], m2B = mrow[2 * s2 + 1];
          AT_LDK(kfB, ciB, (s1 & 3), 0, m1A); AT_LDV(vaQ, (s & 3), 0);
          AT_QKM(st1, kfA, ciA); AT_EXP(pbQ, st0); AT_PV(pbP, vaP);
          __builtin_amdgcn_sched_barrier(0);
          AT_LDK(kfA, ciA, (s1 & 3), 1, m1B); AT_LDV(vaP, (s & 3), 1);
          AT_QKM(st0, kfB, ciB); AT_EXP(pbP, st1); AT_PV(pbQ, vaQ);
          __builtin_amdgcn_sched_barrier(0);
          m1A = m2A; m1B = m2B; }
      AT_PV(pbP, vaP);
#undef AT_LDK
#undef AT_LDV
#undef AT_QKM
#undef AT_EXP
#undef AT_PV
      { AT_LAUNDER();
#pragma unroll
        for (int hi = 0; hi < 2; ++hi) { const float inv = 1.0f / lacc[hi][0];
            bf16* yp = YATT + (tb + q0u + 16 * qh + qi) * 512 + (g * 4 + 2 * hp + hi) * 64 + 4 * fq;
#pragma unroll
            for (int dt = 0; dt < 4; ++dt) { const f32x4 o = oacc[hi][dt];
                v2u w; w.x = pk2(o[0] * inv, o[1] * inv); w.y = pk2(o[2] * inv, o[3] * inv); *(v2u*)(yp + 16 * dt) = w; } } }
#undef AT_STAGE
    }
    __syncthreads();
    }
#undef AT_LAUNDER
    __syncthreads();
}

#ifndef DBG_REP_ML
#define DBG_REP_ML 1
#endif
#ifndef DBG_REP_ATT
#define DBG_REP_ATT 1
#endif
__device__ __forceinline__ void p3_mixer(const Args& a, const Ctx& c, volatile LAS unsigned* MISC, int rep) {
#if !defined(NO_MLSTM)
#pragma unroll 1
    for (int rr = 0; rr < DBG_REP_ML; ++rr)
#pragma unroll 1
        for (int u = blockIdx.x; u < 32; u += c.G) mlstm_unit<0>(a, c, u >> 2, u & 3, 0);
#endif
    unsigned* ctl = (unsigned*)(a.ws + WS_CTL);
    const int x = (int)(__builtin_amdgcn_s_getreg((3 << 11) | 20) & 7u);
    float cshift;
    { float gq = fabsf(a.in[IN_GQ][c.lane]), gk = fabsf(a.in[IN_GK][c.lane]);
#pragma unroll
      for (int o = 1; o < 64; o <<= 1) { gq = fmaxf(gq, __shfl_xor(gq, o)); gk = fmaxf(gk, __shfl_xor(gk, o)); }
      cshift = 8.0f * 1.4426950408889634f * gq * gk; }
#pragma unroll 1
    for (int rot = 0; rot < 8 * DBG_REP_ATT; ++rot) { rep = rot >> 3; const int bq = (x + rot) & 7;
        if (c.tid == 0) MISC[16] = __hip_atomic_fetch_add(ctl + CW_Q + 512 * rep + 64 * bq, 1u, RLX_AGENT);
        __syncthreads();
        int u = (int)MISC[16];
        __syncthreads();
#pragma unroll 1
        while (u < 128) {
            unsigned nxt = 0u;
            if (c.tid == 0) nxt = __hip_atomic_fetch_add(ctl + CW_Q + 512 * rep + 64 * bq, 1u, RLX_AGENT);
#if !defined(NO_ATTN)
            attn_unit(a, c, bq, 127 - u, cshift);
#endif
            if (c.tid == 0) MISC[16] = nxt;
            __syncthreads();
            u = (int)MISC[16];
            __syncthreads();
        } }
}
constexpr int RT_WT = 0;
constexpr int RT_WROW = 1028;
constexpr int RT_WBYTES = 36 * RT_WROW * 4;
constexpr int RT_NPIECE = (RT_WBYTES + 1023) / 1024;
constexpr int RT_LG = 0;
constexpr int RT_RSTD = RT_NPIECE * 1024;
constexpr int RT_LCNT = RT_RSTD + 512;
constexpr int RT_BIAS = RT_LCNT + 128;
static_assert(RT_BIAS + 144 <= MISC_OFF, "router LDS map");
__device__ __forceinline__ void p6_router(const Args& a, const Ctx& c) {
    const int tid = c.tid, lane = c.lane, wave = c.wave; LAS unsigned char* lds = c.lds;
    LAS float* WT = (LAS float*)(lds + RT_WT); LAS float* LG = (LAS float*)(lds + RT_LG); LAS float* RSTD = (LAS float*)(lds + RT_RSTD); LAS int* LCNT = (LAS int*)(lds + RT_LCNT); LAS float* BIAS = (LAS float*)(lds + RT_BIAS);
    { int* RT = (int*)(a.ws + WS_ROWTOK); for (int i = blockIdx.x * 512 + tid; i < NROWS_MAX; i += c.G * 512) RT[i] = 0; }
    if (tid < 36) BIAS[tid] = tid < 32 ? a.in[IN_BRE][tid] : a.in[IN_BRG][tid - 32];
    f32x4 gv[4];
#pragma unroll
    for (int j = 0; j < 4; ++j) gv[j] = *(const f32x4*)(a.in[IN_GMOE] + 4 * lane + 256 * j);
    const float* X1 = a.out; bf16* XN = (bf16*)(a.ws + WS_XN);
    int* TOKE = (int*)(a.ws + WS_TOKE); int* TOKR = (int*)(a.ws + WS_TOKR); float* TOKG = (float*)(a.ws + WS_TOKG); int* CNT = (int*)(a.ws + WS_CNT);
    for (int blk = blockIdx.x; blk < 256; blk += c.G) {
        __syncthreads();
        { const unsigned char* src = a.ws + WS_WTG;
#pragma unroll 1
          for (int pc = wave; pc < RT_NPIECE; pc += NWAVES)
              __builtin_amdgcn_global_load_lds((const unsigned*)(src + (size_t)pc * 1024 + lane * 16), (LAS unsigned*)(lds + RT_WT + pc * 1024), 16, 0, 0); }
        if (tid < 32) LCNT[tid] = 0;
#pragma unroll 1
        for (int ri = 0; ri < 16; ri += 4) { const int t0 = blk * 128 + wave * 16 + ri;
            f32x4 v[4][4]; float ss[4];
#pragma unroll
            for (int q = 0; q < 4; ++q) { const f32x4* xp = (const f32x4*)(X1 + (size_t)(t0 + q) * D) + lane;
#pragma unroll
                for (int j = 0; j < 4; ++j) v[q][j] = xp[64 * j]; }
#pragma unroll
            for (int q = 0; q < 4; ++q) { float sq = 0.f;
#pragma unroll
                for (int j = 0; j < 4; ++j) sq += (v[q][j].x * v[q][j].x + v[q][j].y * v[q][j].y) + (v[q][j].z * v[q][j].z + v[q][j].w * v[q][j].w);
                ss[q] = rsqrtf(wave_sum(sq) * (1.f / D) + EPS); }
            if (lane < 4) RSTD[wave * 16 + ri + lane] = (lane == 0) ? ss[0] : ((lane == 1) ? ss[1] : ((lane == 2) ? ss[2] : ss[3]));
#pragma unroll
            for (int q = 0; q < 4; ++q) { v2u* op = (v2u*)(XN + (size_t)(t0 + q) * D) + lane; const float r = ss[q];
#pragma unroll
                for (int j = 0; j < 4; ++j) { v2u w; w.x = pk2(v[q][j].x * r * gv[j].x, v[q][j].y * r * gv[j].y); w.y = pk2(v[q][j].z * r * gv[j].z, v[q][j].w * r * gv[j].w); op[64 * j] = w; } } }
        asm volatile("s_waitcnt vmcnt(0)" ::: "memory");
        __syncthreads();
        f32x4 acc[3];
#pragma unroll
        for (int ct = 0; ct < 3; ++ct) acc[ct] = (f32x4){0.f, 0.f, 0.f, 0.f};
        { const int row = lane & 15, kq = lane >> 4;
          const f32x4* ap = (const f32x4*)(X1 + (size_t)(blk * 128 + wave * 16 + row) * D + 4 * kq);
          int cj[3]; cj[0] = row; cj[1] = 16 + row; cj[2] = (32 + row) < 36 ? (32 + row) : 35;
          const LAS f32x4* bp0 = (const LAS f32x4*)(WT + cj[0] * RT_WROW + 4 * kq); const LAS f32x4* bp1 = (const LAS f32x4*)(WT + cj[1] * RT_WROW + 4 * kq); const LAS f32x4* bp2 = (const LAS f32x4*)(WT + cj[2] * RT_WROW + 4 * kq);
#define RT_LOADA(dst_, b_) do { _Pragma("unroll") for (int i_ = 0; i_ < 8; ++i_) dst_[i_] = ap[4 * (8 * ((b_) < 8 ? (b_) : 7) + i_)]; } while (0)
#define RT_MMA(src_, b_) do { _Pragma("unroll") for (int i_ = 0; i_ < 8; ++i_) { const int ks_ = 8 * (b_) + i_; const f32x4 b0 = bp0[4 * ks_], b1 = bp1[4 * ks_], b2 = bp2[4 * ks_]; \
              _Pragma("unroll") for (int j = 0; j < 4; ++j) { acc[0] = __builtin_amdgcn_mfma_f32_16x16x4f32(src_[i_][j], b0[j], acc[0], 0, 0, 0); acc[1] = __builtin_amdgcn_mfma_f32_16x16x4f32(src_[i_][j], b1[j], acc[1], 0, 0, 0); \
                  acc[2] = __builtin_amdgcn_mfma_f32_16x16x4f32(src_[i_][j], b2[j], acc[2], 0, 0, 0); } } } while (0)
          f32x4 aA[8], aB[8]; RT_LOADA(aA, 0);
#pragma unroll 1
          for (int bb = 0; bb < 8; bb += 2) { RT_LOADA(aB, bb + 1); RT_MMA(aA, bb); RT_LOADA(aA, bb + 2); RT_MMA(aB, bb + 1); }
#undef RT_LOADA
#undef RT_MMA
        }
        __syncthreads();
        { const int col = lane & 15, kq = lane >> 4;
#pragma unroll
          for (int ct = 0; ct < 3; ++ct) if (16 * ct + col < 36) {
#pragma unroll
              for (int r = 0; r < 4; ++r) LG[(wave * 16 + 4 * kq + r) * 36 + 16 * ct + col] = acc[ct][r]; } }
        __syncthreads();
        if (tid < 128) { const int row = tid, t = blk * 128 + row; const float rs = RSTD[row]; const LAS float* lg = LG + tid * 36;
            float gl[4];
#pragma unroll
            for (int i = 0; i < 4; ++i) gl[i] = rs * lg[32 + i] + BIAS[32 + i];
            int gs = 0; float gmax = gl[0];
#pragma unroll
            for (int i = 1; i < 4; ++i) if (gl[i] > gmax) { gmax = gl[i]; gs = i; }
            float gsum = 0.f;
#pragma unroll
            for (int i = 0; i < 4; ++i) gsum += expf(gl[i] - gmax);
            const float gtop = 1.0f / gsum;
            float ev[8];
#pragma unroll
            for (int i = 0; i < 8; ++i) ev[i] = rs * lg[gs * 8 + i] + BIAS[gs * 8 + i];
            int l0 = 0; float v0 = ev[0];
#pragma unroll
            for (int i = 1; i < 8; ++i) if (ev[i] > v0) { v0 = ev[i]; l0 = i; }
            int l1 = -1; float v1 = -3.0e38f;
#pragma unroll
            for (int i = 0; i < 8; ++i) if (i != l0 && ev[i] > v1) { v1 = ev[i]; l1 = i; }
            const float e1 = expf(v1 - v0), s0 = 1.0f / (1.0f + e1), s1 = e1 * s0;
            const int ex0 = gs * 8 + l0, ex1 = gs * 8 + l1;
            const int rk0 = __hip_atomic_fetch_add(&LCNT[ex0], 1, __ATOMIC_RELAXED, __HIP_MEMORY_SCOPE_WORKGROUP);
            const int rk1 = __hip_atomic_fetch_add(&LCNT[ex1], 1, __ATOMIC_RELAXED, __HIP_MEMORY_SCOPE_WORKGROUP);
            TOKE[2 * t] = ex0; TOKE[2 * t + 1] = ex1; TOKR[2 * t] = rk0; TOKR[2 * t + 1] = rk1; TOKG[2 * t] = s0 * gtop; TOKG[2 * t + 1] = s1 * gtop; }
        __syncthreads();
        if (tid < 32) CNT[blk * 32 + tid] = LCNT[tid];
    }
}
__device__ __forceinline__ void p7_gather(const Args& a, const Ctx& c) {
    const int tid = c.tid, lane = c.lane, wave = c.wave;
    LAS int* PART = (LAS int*)c.lds; LAS int* PPRE = PART + 512; LAS int* TOT = PPRE + 512; LAS int* TS = TOT + 32; LAS int* BASE = TS + 64;
    const int* CNT = (const int*)(a.ws + WS_CNT); const int* TOKE = (const int*)(a.ws + WS_TOKE); const int* TOKR = (const int*)(a.ws + WS_TOKR); int* TOKP = (int*)(a.ws + WS_TOKP);
    int* RT = (int*)(a.ws + WS_ROWTOK);
    { const int e = tid & 31, p = tid >> 5; int s = 0; for (int k = 0; k < 16; ++k) s += CNT[(16 * p + k) * 32 + e]; PART[p * 32 + e] = s; }
    __syncthreads();
    if (tid < 32) { int run = 0; for (int p = 0; p < 16; ++p) { PPRE[p * 32 + tid] = run; run += PART[p * 32 + tid]; } TOT[tid] = run; }
    __syncthreads();
    if (tid == 0) { int ts = 0; for (int e = 0; e < 32; ++e) { TS[e] = ts; ts += (TOT[e] + 255) >> 8; } TS[32] = ts; }
    __syncthreads();
    if (blockIdx.x == 0 && tid < 33) ((int*)(a.ws + WS_SMALL))[tid] = TS[tid];
    for (int blk = blockIdx.x; blk < 256; blk += c.G) {
        if (tid < 32) { int s = TS[tid] * 256 + PPRE[(blk >> 4) * 32 + tid]; for (int b2 = (blk & ~15); b2 < blk; ++b2) s += CNT[b2 * 32 + tid]; BASE[tid] = s; }
        __syncthreads();
        { const int t = blk * 128 + (tid >> 2), jj = tid & 3;
          if (jj < 2) { const int pos = BASE[TOKE[2 * t + jj]] + TOKR[2 * t + jj]; TOKP[2 * t + jj] = pos; RT[pos] = t; } }
        __syncthreads();
    }
}
__device__ __forceinline__ void p10_combine(const Args& a, const Ctx& c) {
    const int lane = c.lane, gw = c.vcu * NWAVES + c.wave, NGW = c.G * NWAVES;
    const int* TOKP = (const int*)(a.ws + WS_TOKP); const float* TOKG = (const float*)(a.ws + WS_TOKG); const bf16* Y = (const bf16*)(a.ws + WS_Y);
    for (int t0 = gw; t0 < T; t0 += 2 * NGW) {
        const int tA = t0, tB = (t0 + NGW < T) ? t0 + NGW : t0; const bool hasB = (t0 + NGW < T);
        const int pA0 = TOKP[2 * tA], pA1 = TOKP[2 * tA + 1], pB0 = TOKP[2 * tB], pB1 = TOKP[2 * tB + 1];
        const float gA0 = TOKG[2 * tA], gA1 = TOKG[2 * tA + 1], gB0 = TOKG[2 * tB], gB1 = TOKG[2 * tB + 1];
        f32x4 xa[4], xb[4]; v2u ya0[4], ya1[4], yb0[4], yb1[4];
#pragma unroll
        for (int j = 0; j < 4; ++j) { const int cc = 4 * lane + 256 * j;
            xa[j] = *(const f32x4*)(a.out + (size_t)tA * D + cc); xb[j] = *(const f32x4*)(a.out + (size_t)tB * D + cc);
            ya0[j] = *(const v2u*)(Y + (size_t)pA0 * D + cc); ya1[j] = *(const v2u*)(Y + (size_t)pA1 * D + cc);
            yb0[j] = *(const v2u*)(Y + (size_t)pB0 * D + cc); yb1[j] = *(const v2u*)(Y + (size_t)pB1 * D + cc); }
#pragma unroll
        for (int j = 0; j < 4; ++j) { const int cc = 4 * lane + 256 * j; f32x4 x = xa[j];
            x[0] += gA0 * bf2f(ya0[j].x & 0xffffu) + gA1 * bf2f(ya1[j].x & 0xffffu); x[1] += gA0 * bf2f(ya0[j].x >> 16) + gA1 * bf2f(ya1[j].x >> 16);
            x[2] += gA0 * bf2f(ya0[j].y & 0xffffu) + gA1 * bf2f(ya1[j].y & 0xffffu); x[3] += gA0 * bf2f(ya0[j].y >> 16) + gA1 * bf2f(ya1[j].y >> 16);
            *(f32x4*)(a.out + (size_t)tA * D + cc) = x; }
        if (hasB) {
#pragma unroll
        for (int j = 0; j < 4; ++j) { const int cc = 4 * lane + 256 * j; f32x4 x = xb[j];
            x[0] += gB0 * bf2f(yb0[j].x & 0xffffu) + gB1 * bf2f(yb1[j].x & 0xffffu); x[1] += gB0 * bf2f(yb0[j].x >> 16) + gB1 * bf2f(yb1[j].x >> 16);
            x[2] += gB0 * bf2f(yb0[j].y & 0xffffu) + gB1 * bf2f(yb1[j].y & 0xffffu); x[3] += gB0 * bf2f(yb0[j].y >> 16) + gB1 * bf2f(yb1[j].y >> 16);
            *(f32x4*)(a.out + (size_t)tB * D + cc) = x; } }
    }
}
__global__ void __launch_bounds__(NWAVES * 64, 2) hybrid_fwd(Args args) {
    extern __shared__ __attribute__((aligned(16))) unsigned char lds_raw[];
    Ctx c; c.lds = (LAS unsigned char*)lds_raw;
    volatile LAS unsigned* MISC = (volatile LAS unsigned*)(c.lds + MISC_OFF);
    c.tid = threadIdx.x; c.lane = c.tid & 63; c.wave = __builtin_amdgcn_readfirstlane(c.tid >> 6);
    c.G = gridDim.x; { const int bx = blockIdx.x; c.vcu = (c.G % 8 == 0) ? (bx % 8) * (c.G / 8) + bx / 8 : bx; }
    unsigned* ctl = (unsigned*)(args.ws + WS_CTL);
    if (c.tid < 128) MISC[c.tid] = 0u;
    __syncthreads();
    XcdBarrier bar; bar.bar = ctl + CW_BAR; bar.x = 0; bar.st = nullptr;
    if (N_LAUNCHES == 1) bar = xcd_barrier_post(ctl + CW_BAR, MISC + 8);
#define GRID_BAR() do { if (N_LAUNCHES == 1) xcd_barrier(bar); } while (0)
    const int lo = args.ph_lo, hi = args.ph_hi;
#ifndef PH_MASK
#define PH_MASK 0xfff
#endif
#ifdef DBG_TIME
    unsigned long long tprev_ = wall_clock64(), tdur_ = 0ull; const unsigned long long tstart_ = tprev_;
#define PH_STAMP(k) do { const unsigned long long tn_ = wall_clock64(); if ((k) == DBG_TIME) tdur_ = tn_ - tprev_; tprev_ = tn_; } while (0)
#else
#define PH_STAMP(k) do { } while (0)
#endif
#define IN(k) (((PH_MASK >> (k)) & 1) && lo <= (k) && (k) < hi)
#define BOTH(k) (IN(k) && IN((k) + 1))
    unsigned char* ws = args.ws; unsigned char* dout = (unsigned char*)args.out;
#ifndef DBG_REPEAT
#define DBG_REPEAT -1
#endif
#define REPS(k) (((k) == DBG_REPEAT) ? 2 : 1)
#if DBG_REPEAT == 5
#define RB5 _Pragma("unroll 1") for (int rep5 = 0; rep5 < 2; ++rep5) { if (rep5) GRID_BAR();
#define RE5 }
#else
#define RB5
#define RE5
#endif
#if DBG_REPEAT == 6
#define RB6 _Pragma("unroll 1") for (int rep6 = 0; rep6 < 2; ++rep6) { if (rep6) GRID_BAR();
#define RE6 }
#else
#define RB6
#define RE6
#endif
    if (IN(0)) { _Pragma("unroll") for (int rep = 0; rep < REPS(0); ++rep) { if (rep) GRID_BAR(); p0_prologue<0>(args, c, c.vcu * NWAVES + c.wave, c.G * NWAVES); } if (BOTH(0)) GRID_BAR(); PH_STAMP(0); }
    if (IN(1)) { _Pragma("unroll") for (int rep = 0; rep < REPS(1); ++rep) { if (rep) GRID_BAR();
#ifdef DBG_STAGGER
        if ((blockIdx.x >> 3) & 1) { const unsigned long long t0 = wall_clock64(); while (wall_clock64() - t0 < (unsigned long long)DBG_STAGGER) __builtin_amdgcn_s_sleep(16); }
#endif
        pg8::Gemm g{(const pg8::bf16_t*)(dout + DO_H), (const pg8::bf16_t*)(ws + WS_WIN), T, NPROJ, D}; pg8::StaticOrder S; S.init(T, NPROJ, c.G, (int)blockIdx.x);
        pg8::EpiBf16<0> E{(pg8::bf16_t*)(ws + WS_PROJ), 256, nullptr, 256, (size_t)T * 256, 1.f};
        pg8::gemm_phase<pg8::EpiBf16<0>, pg8::StaticOrder, true, true>(c.lds, g, S, E); }
        if (BOTH(1)) GRID_BAR(); PH_STAMP(1);
    }
#ifndef DBG_R2
#define DBG_R2 1
#endif
#ifndef DBG_R4A
#define DBG_R4A 1
#endif
#ifndef DBG_R4B
#define DBG_R4B 1
#endif
#ifndef DBG_R7
#define DBG_R7 1
#endif
    if (IN(2)) { _Pragma("unroll 1") for (int rep = 0; rep < DBG_R2; ++rep) { if (rep) GRID_BAR(); p2_prep(args, c); } if (BOTH(2)) GRID_BAR(); PH_STAMP(2); }
    if (IN(3)) { _Pragma("unroll") for (int rep = 0; rep < REPS(3); ++rep) { if (rep) GRID_BAR(); p3_mixer(args, c, MISC, rep); } if (BOTH(3)) GRID_BAR(); PH_STAMP(3); }
    if (IN(4)) {
#pragma unroll 1
        for (int rep = 0; rep < DBG_R4A; ++rep) {
            const int gw = c.vcu * NWAVES + c.wave, ngw = c.G * NWAVES, kdone = ((int)blockIdx.x < 256) ? 24 : 0;
            LAS float* scr = (LAS float*)(c.lds + CV_SCR + c.wave * CV_SCRW);
#pragma unroll 1
            for (int k = kdone; gw + k * ngw < CV_NMI; ++k) { const CvItem it = cv_item(args, gw + k * ngw); f32x4 v[4]; cv_load(it, v, c.lane); cv_finish(it, v, scr, c.lane, true); }
            __syncthreads(); }
#pragma unroll 1
        for (int rep = 0; rep < DBG_R4B; ++rep)
#pragma unroll 1
        for (int u = blockIdx.x; u < 256; u += c.G) mlstm_unit<1>(args, c, u >> 5, (u >> 3) & 3, u & 7);
        if (BOTH(4)) GRID_BAR(); PH_STAMP(4);
    }
    if (IN(5)) { RB5
#ifdef DBG_STAG5
        if ((blockIdx.x >> 3) & 1) { const unsigned long long t0 = wall_clock64(); while (wall_clock64() - t0 < (unsigned long long)DBG_STAG5) __builtin_amdgcn_s_sleep(16); }
#endif
        { pg8::Gemm g{(const pg8::bf16_t*)(dout + DO_YATT), (const pg8::bf16_t*)(ws + WS_WPA), T, D, 512, (const pg8::bf16_t*)(dout + DO_YML), (const pg8::bf16_t*)(ws + WS_WPM)};
          pg8::StaticOrder S; S.init(T, D, c.G, (int)blockIdx.x);
          pg8::EpiGate2 E{(pg8::bf16_t*)(ws + WS_MERGED), D, (const pg8::bf16_t*)(ws + WS_PROJ + (size_t)TL_GA * PROJ_TILE), (const pg8::bf16_t*)(ws + WS_PROJ + (size_t)TL_GM * PROJ_TILE), (size_t)T * 256};
          pg8::gemm_phase<pg8::EpiGate2, pg8::StaticOrder, true, true, true>(c.lds, g, S, E); } RE5
        if (BOTH(5)) GRID_BAR(); PH_STAMP(5);
    }
    if (IN(6)) { RB6
#ifdef DBG_STAG6
        if ((blockIdx.x >> 3) & 1) { const unsigned long long t0 = wall_clock64(); while (wall_clock64() - t0 < (unsigned long long)DBG_STAG6) __builtin_amdgcn_s_sleep(16); }
#endif
        pg8::Gemm g{(const pg8::bf16_t*)(ws + WS_MERGED), (const pg8::bf16_t*)(ws + WS_WOUT), T, D, D}; pg8::StaticOrder S; S.init(T, D, c.G, (int)blockIdx.x);
        pg8::EpiRes E{args.out, args.in[IN_X], D};
        pg8::gemm_phase<pg8::EpiRes, pg8::StaticOrder, true, true>(c.lds, g, S, E); RE6
        if (BOTH(6)) GRID_BAR(); PH_STAMP(6);
    }
    if (IN(7)) { _Pragma("unroll 1") for (int rep = 0; rep < DBG_R7; ++rep) { if (rep) { GRID_BAR(); } p6_router(args, c); } if (BOTH(7)) GRID_BAR(); PH_STAMP(7); }
    if (IN(8)) { _Pragma("unroll") for (int rep = 0; rep < REPS(8); ++rep) { if (rep) GRID_BAR(); p7_gather(args, c); } if (BOTH(8)) GRID_BAR(); PH_STAMP(8); }
    if (IN(9) || IN(10)) {
        LAS int* TSL = (LAS int*)(c.lds + MISC_OFF + 256);
        LAS int* XS = (LAS int*)(c.lds + MISC_OFF + 400);
        if (c.tid < 33) TSL[c.tid] = (int)__hip_atomic_load((unsigned*)(ws + WS_SMALL) + c.tid, RLX_AGENT);
        if (c.tid == 64) { const int ntt = (int)__hip_atomic_load((unsigned*)(ws + WS_SMALL) + 32, RLX_AGENT); int lo_t = 0, hi_t = ntt, nl = c.G, lx = (int)blockIdx.x;
            if (N_LAUNCHES == 1) { unsigned pre = 0u, mine = 0u;
                for (unsigned j = 0; j < 16; ++j) { const unsigned cj = xb_ld(&bar.bar[XB_XCNT(j)]); pre += (j < bar.x) ? cj : 0u; mine = (j == bar.x) ? cj : mine; }
                nl = (int)mine; lx = (int)MISC[20]; lo_t = (int)((long)ntt * pre / c.G); hi_t = (int)((long)ntt * (pre + mine) / c.G); }
            XS[0] = lo_t; XS[1] = hi_t; XS[2] = nl; XS[3] = lx; }
        __syncthreads();
        const int xs_lo = XS[0], xs_hi = XS[1], xs_nl = XS[2], xs_lx = XS[3];
        if (IN(9)) {
            pg8::MoeOrder<true> S{TSL, xs_nl, xs_lx, xs_lo, xs_hi, (const int*)(ws + WS_ROWTOK), (unsigned*)(ws + WS_CTL) + CW_RDY};
            pg8::Gemm g{(const pg8::bf16_t*)(ws + WS_XN), (const pg8::bf16_t*)(ws + WS_GU), 0, 0, D};
            pg8::EpiSwiGLU E{(pg8::bf16_t*)(ws + WS_HID)};
            pg8::gemm_phase<pg8::EpiSwiGLU, pg8::MoeOrder<true>, true, true>(c.lds, g, S, E);
            if (BOTH(9)) __syncthreads();
        }
        if (IN(10)) {
            pg8::MoeOrder<false> S{TSL, xs_nl, xs_lx, xs_lo, xs_hi, nullptr, (unsigned*)(ws + WS_CTL) + CW_RDY};
            pg8::Gemm g{(const pg8::bf16_t*)(ws + WS_HID), (const pg8::bf16_t*)(ws + WS_DN), 0, 0, 512};
            pg8::EpiDown E{(pg8::bf16_t*)(ws + WS_Y)};
            pg8::gemm_phase<pg8::EpiDown, pg8::MoeOrder<false>, true, true>(c.lds, g, S, E);
            if (BOTH(10)) GRID_BAR(); PH_STAMP(10);
        }
    }
    if (IN(11)) p10_combine(args, c);
#ifdef DBG_TIME
    PH_STAMP(11);
    if (DBG_TIME == 99) tdur_ = wall_clock64() - tstart_;
    if (DBG_TIME == 98) tdur_ = 10000ull;
    if (blockIdx.x == 0) { const unsigned long long t0_ = wall_clock64(); while (wall_clock64() - t0_ < tdur_) __builtin_amdgcn_s_sleep(8); }
#endif
#undef IN
#undef BOTH
#undef GRID_BAR
}

extern "C" void kernel_launch(void* const* d_in, const int* in_sizes, int n_in, void* d_out, int out_size, void* d_ws, size_t ws_size, hipStream_t stream) {
    static int grid = 0;
    if (grid == 0) {
        if (n_in != 22 || in_sizes[0] != T * D || out_size != T * D || ws_size < WS_END) { fprintf(stderr, "kernel_launch: unexpected shapes (n_in %d, in0 %d, out %d, ws %zu); nothing launched\n", n_in, n_in > 0 ? in_sizes[0] : -1, out_size, ws_size); grid = -1; return; }
        int dev = 0, cus = 0, per_cu = 0;
        if (hipGetDevice(&dev) != hipSuccess || hipDeviceGetAttribute(&cus, hipDeviceAttributeMultiprocessorCount, dev) != hipSuccess) { grid = -1; return; }
        if (hipFuncSetAttribute((const void*)hybrid_fwd, hipFuncAttributeMaxDynamicSharedMemorySize, LDS_BYTES) != hipSuccess) { fprintf(stderr, "kernel_launch: hipFuncSetAttribute failed\n"); grid = -1; return; }
        if (hipOccupancyMaxActiveBlocksPerMultiprocessor(&per_cu, (const void*)hybrid_fwd, NWAVES * 64, LDS_BYTES) != hipSuccess || per_cu < 1)
            fprintf(stderr, "kernel_launch: note: occupancy query reports %d workgroups per CU\n", per_cu);
        (void)hipGetLastError();
        grid = cus;
    }
    if (grid < 0) return;
    if (hipMemsetAsync((char*)d_ws + WS_CTL, 0, CTL_ZERO_BYTES, stream) != hipSuccess) return;
    Args a{};
    for (int i = 0; i < 22; ++i) a.in[i] = (const float*)d_in[i];
    a.out = (float*)d_out; a.ws = (unsigned char*)d_ws;
    for (int li = 0; li < N_LAUNCHES; ++li) {
        a.ph_lo = (N_LAUNCHES == 1) ? 0 : li; a.ph_hi = (N_LAUNCHES == 1) ? NPH : li + 1; a.li = li;
        hipLaunchKernelGGL(hybrid_fwd, dim3(grid), dim3(NWAVES * 64), LDS_BYTES, stream, a);
        if (hipPeekAtLastError() != hipSuccess) { fprintf(stderr, "kernel_launch: launch %d failed\n", li); break; }
    }
}
```

```cpp
#include <hip/hip_runtime.h>
#include <cstdio>
#include <cstdint>
namespace pg8 {
#define PG8_LAS __attribute__((address_space(3)))
typedef unsigned short bf16_t;
typedef short bf16x8 __attribute__((ext_vector_type(8)));
typedef float f32x4 __attribute__((ext_vector_type(4)));
typedef unsigned u32x4 __attribute__((ext_vector_type(4)));
constexpr int BM = 256, BK = 64, HALF = 128, HTB = HALF * BK * 2  , STAGE_BYTES = 8 * HTB, NXCD = 8, WGM = 8;

__host__ __device__ __forceinline__ int lds_byte(int r, int c) { const int st = (r >> 4) * 2 + (c >> 5), rr = r & 15, cc = c & 31, ob = rr * 64 + cc * 2; return st * 1024 + (ob ^ (((ob >> 9) & 1) << 5)); }
__host__ __device__ __forceinline__ void stage_rc(int b, int& R, int& C) { const int st = b / 1024, sb = b % 1024, swz = sb ^ (((sb >> 9) & 1) << 5); R = (st >> 1) * 16 + swz / 64; C = (st & 1) * 32 + (swz % 64) / 2; }
__host__ __device__ __forceinline__ int perm32(int rho) { const int n = rho >> 4, i = rho & 15; return 8 * (i >> 2) + 4 * n + (i & 3); }

struct Unit { int pm, pn; };
struct Gemm { const bf16_t* A; const bf16_t* Bt; int M, N, K; const bf16_t* A2 = nullptr; const bf16_t* Bt2 = nullptr; };

struct StaticOrder {
    static constexpr bool GATHER = false;
    int nM, nN, nwg, G, c;
    __host__ __device__ void init(int M, int N, int G_, int c_) { nM = M / BM; nN = N / BM; nwg = nM * nN; G = G_; c = c_; }
    __host__ __device__ bool next(int i, Unit& u) const {
        const long L = (long)i * G + c; if (L >= nwg) return false;
        int wgid = (int)L; { const int q = nwg / NXCD, r = nwg % NXCD, xcd = wgid % NXCD, off = wgid / NXCD; wgid = (xcd < r ? xcd * (q + 1) : r * (q + 1) + (xcd - r) * q) + off; }
        const int nig = WGM * nN, gid = wgid / nig, fm = gid * WGM, gsz = (nM - fm) < WGM ? (nM - fm) : WGM;
        u.pm = fm + ((wgid % nig) % gsz); u.pn = (wgid % nig) / gsz; return true;
    }
    __device__ __forceinline__ void a_ready(const Unit&) const {}
    __device__ __forceinline__ void done(const Unit&) const {}
};

typedef __bf16 bf2_t __attribute__((ext_vector_type(2)));
__device__ __forceinline__ unsigned cvt_pk_bf16(float lo, float hi) { bf2_t v; v[0] = (__bf16)lo; v[1] = (__bf16)hi; return __builtin_bit_cast(unsigned, v); }
typedef float f32x2 __attribute__((ext_vector_type(2)));
template <int ACT  > struct EpiBf16 {
    static constexpr bool PERM = true, AFTER_DRAIN = false; static_assert(ACT == 0, "EpiBf16: no activation here");
    bf16_t* O; int ldc; const float* bias; int split_cols; size_t split_stride; float scale0;
    __device__ __forceinline__ void operator()(const f32x4 (&acc)[2][2][4][2], const Unit& u, int wr, int wc, int fr, int fq) const {
        const int row0 = u.pm * BM + wr * 64 + fr; int colt = u.pn * BM; bf16_t* base = O;
        float sc = 1.f; if (split_cols) { const int t = colt / split_cols; base += (size_t)t * split_stride; colt -= t * split_cols; if (t == 0) sc = scale0; }
        const int col0 = colt + wc * 32 + 8 * fq, bcol0 = u.pn * BM + wc * 32 + 8 * fq;
        f32x4 bv[2][2];
#pragma unroll
        for (int bj = 0; bj < 2; ++bj)
#pragma unroll
            for (int n = 0; n < 2; ++n) bv[bj][n] = bias ? *(const f32x4*)(bias + bcol0 + bj * HALF + 4 * n) : (f32x4){0.f, 0.f, 0.f, 0.f};
#pragma unroll
        for (int ai = 0; ai < 2; ++ai)
#pragma unroll
            for (int m = 0; m < 4; ++m) { bf16_t* rowp = base + (size_t)(row0 + ai * HALF + m * 16) * ldc + col0;
#pragma unroll
                for (int bj = 0; bj < 2; ++bj) { f32x4 v0 = acc[ai][bj][m][0] + bv[bj][0], v1 = acc[ai][bj][m][1] + bv[bj][1];
                    v0 = v0 * sc; v1 = v1 * sc; u32x4 w; w.x = cvt_pk_bf16(v0[0], v0[1]); w.y = cvt_pk_bf16(v0[2], v0[3]); w.z = cvt_pk_bf16(v1[0], v1[1]); w.w = cvt_pk_bf16(v1[2], v1[3]);
                    *(u32x4*)(rowp + bj * HALF) = w; } }
    }
};
__device__ __forceinline__ float bf2f_(unsigned b16) { return __uint_as_float(b16 << 16); }
__device__ __forceinline__ float sigm_(float x) { return __builtin_amdgcn_rcpf(1.0f + __expf(-x)); }
template <bool ADD> struct EpiGate {
    static constexpr bool PERM = true, AFTER_DRAIN = false;
    bf16_t* O; int ldc; const bf16_t* gate; size_t gstride;
    __device__ __forceinline__ void operator()(const f32x4 (&acc)[2][2][4][2], const Unit& u, int wr, int wc, int fr, int fq) const {
        const int row0 = u.pm * BM + wr * 64 + fr, colt = wc * 32 + 8 * fq;
        const bf16_t* gt = gate + (size_t)u.pn * gstride;
#pragma unroll
        for (int ai = 0; ai < 2; ++ai) {
            u32x4 gv[4][2], pp[4][2];
#pragma unroll
            for (int m = 0; m < 4; ++m) { const size_t row = (size_t)(row0 + ai * HALF + m * 16);
#pragma unroll
                for (int bj = 0; bj < 2; ++bj) { const int c = colt + bj * HALF; gv[m][bj] = *(const u32x4*)(gt + row * 256 + c);
                    if (ADD) pp[m][bj] = *(const u32x4*)(O + row * ldc + u.pn * BM + c); } }
#pragma unroll
            for (int m = 0; m < 4; ++m) { const size_t row = (size_t)(row0 + ai * HALF + m * 16);
#pragma unroll
                for (int bj = 0; bj < 2; ++bj) { const int c = colt + bj * HALF; const u32x4 g4 = gv[m][bj];
                    bf16_t* op = O + row * ldc + u.pn * BM + c;
                    float pv[8] = {0.f, 0.f, 0.f, 0.f, 0.f, 0.f, 0.f, 0.f};
                    if (ADD) { const u32x4 p = pp[m][bj]; pv[0] = bf2f_(p.x & 0xffffu); pv[1] = bf2f_(p.x >> 16); pv[2] = bf2f_(p.y & 0xffffu); pv[3] = bf2f_(p.y >> 16);
                        pv[4] = bf2f_(p.z & 0xffffu); pv[5] = bf2f_(p.z >> 16); pv[6] = bf2f_(p.w & 0xffffu); pv[7] = bf2f_(p.w >> 16); }
                    const f32x4 v0 = acc[ai][bj][m][0], v1 = acc[ai][bj][m][1];
                    float o[8];
                    o[0] = pv[0] + sigm_(bf2f_(g4.x & 0xffffu)) * v0[0]; o[1] = pv[1] + sigm_(bf2f_(g4.x >> 16)) * v0[1];
                    o[2] = pv[2] + sigm_(bf2f_(g4.y & 0xffffu)) * v0[2]; o[3] = pv[3] + sigm_(bf2f_(g4.y >> 16)) * v0[3];
                    o[4] = pv[4] + sigm_(bf2f_(g4.z & 0xffffu)) * v1[0]; o[5] = pv[5] + sigm_(bf2f_(g4.z >> 16)) * v1[1];
                    o[6] = pv[6] + sigm_(bf2f_(g4.w & 0xffffu)) * v1[2]; o[7] = pv[7] + sigm_(bf2f_(g4.w >> 16)) * v1[3];
                    u32x4 w; w.x = cvt_pk_bf16(o[0], o[1]); w.y = cvt_pk_bf16(o[2], o[3]); w.z = cvt_pk_bf16(o[4], o[5]); w.w = cvt_pk_bf16(o[6], o[7]);
                    *(u32x4*)op = w; } } }
    }
};
struct EpiGate2 {
    static constexpr bool PERM = true, AFTER_DRAIN = false;
    bf16_t* O; int ldc; const bf16_t* gate1; const bf16_t* gate2; size_t gstride;
    __device__ __forceinline__ void mid(f32x4 (&acc)[2][2][4][2], const Unit& u, int wr, int wc, int fr, int fq) const {
        const int row0 = u.pm * BM + wr * 64 + fr, colt = wc * 32 + 8 * fq;
        const bf16_t* g1 = gate1 + (size_t)u.pn * gstride; const bf16_t* g2 = gate2 + (size_t)u.pn * gstride;
#pragma unroll
        for (int ai = 0; ai < 2; ++ai)
#pragma unroll
          for (int bj = 0; bj < 2; ++bj) { u32x4 ga[4], gb[4]; const int c = colt + bj * HALF;
            int r0_ = row0; asm volatile("" : "+v"(r0_) :: "memory");
#pragma unroll
            for (int m = 0; m < 4; ++m) { const size_t row = (size_t)(r0_ + ai * HALF + m * 16); ga[m] = *(const u32x4*)(g1 + row * 256 + c); gb[m] = *(const u32x4*)(g2 + row * 256 + c); }
#pragma unroll
            for (int m = 0; m < 4; ++m) { const u32x4 x = ga[m], y = gb[m];
#define EG2_R(xa_, xb_) ((1.0f + __expf(-(xb_))) * __builtin_amdgcn_rcpf(1.0f + __expf(-(xa_))))
                    f32x4& v0 = acc[ai][bj][m][0]; f32x4& v1 = acc[ai][bj][m][1];
                    v0[0] *= EG2_R(bf2f_(x.x & 0xffffu), bf2f_(y.x & 0xffffu)); v0[1] *= EG2_R(bf2f_(x.x >> 16), bf2f_(y.x >> 16));
                    v0[2] *= EG2_R(bf2f_(x.y & 0xffffu), bf2f_(y.y & 0xffffu)); v0[3] *= EG2_R(bf2f_(x.y >> 16), bf2f_(y.y >> 16));
                    v1[0] *= EG2_R(bf2f_(x.z & 0xffffu), bf2f_(y.z & 0xffffu)); v1[1] *= EG2_R(bf2f_(x.z >> 16), bf2f_(y.z >> 16));
                    v1[2] *= EG2_R(bf2f_(x.w & 0xffffu), bf2f_(y.w & 0xffffu)); v1[3] *= EG2_R(bf2f_(x.w >> 16), bf2f_(y.w >> 16));
#undef EG2_R
            } }
    }
    __device__ __forceinline__ void operator()(const f32x4 (&acc)[2][2][4][2], const Unit& u, int wr, int wc, int fr, int fq) const {
        const int row0 = u.pm * BM + wr * 64 + fr, colt = wc * 32 + 8 * fq;
        const bf16_t* g2 = gate2 + (size_t)u.pn * gstride;
#pragma unroll
        for (int ai = 0; ai < 2; ++ai) { u32x4 gb[4][2];
#pragma unroll
            for (int m = 0; m < 4; ++m) { const size_t row = (size_t)(row0 + ai * HALF + m * 16);
#pragma unroll
                for (int bj = 0; bj < 2; ++bj) gb[m][bj] = *(const u32x4*)(g2 + row * 256 + colt + bj * HALF); }
#pragma unroll
            for (int m = 0; m < 4; ++m) { const size_t row = (size_t)(row0 + ai * HALF + m * 16);
#pragma unroll
                for (int bj = 0; bj < 2; ++bj) { const u32x4 y = gb[m][bj]; const f32x4 v0 = acc[ai][bj][m][0], v1 = acc[ai][bj][m][1];
                    float o[8];
                    o[0] = sigm_(bf2f_(y.x & 0xffffu)) * v0[0]; o[1] = sigm_(bf2f_(y.x >> 16)) * v0[1]; o[2] = sigm_(bf2f_(y.y & 0xffffu)) * v0[2]; o[3] = sigm_(bf2f_(y.y >> 16)) * v0[3];
                    o[4] = sigm_(bf2f_(y.z & 0xffffu)) * v1[0]; o[5] = sigm_(bf2f_(y.z >> 16)) * v1[1]; o[6] = sigm_(bf2f_(y.w & 0xffffu)) * v1[2]; o[7] = sigm_(bf2f_(y.w >> 16)) * v1[3];
                    u32x4 w; w.x = cvt_pk_bf16(o[0], o[1]); w.y = cvt_pk_bf16(o[2], o[3]); w.z = cvt_pk_bf16(o[4], o[5]); w.w = cvt_pk_bf16(o[6], o[7]);
                    *(u32x4*)(O + row * ldc + u.pn * BM + colt + bj * HALF) = w; } } }
    }
};
struct EpiRes {
    static constexpr bool PERM = false, AFTER_DRAIN = false;
    float* C; const float* R; int ldc;
    __device__ __forceinline__ void operator()(const f32x4 (&acc)[2][2][4][2], const Unit& u, int wr, int wc, int fr, int fq) const {
        const int row0 = u.pm * BM + wr * 64 + fr, col0 = u.pn * BM + wc * 32 + 4 * fq;
#pragma unroll
        for (int ai = 0; ai < 2; ++ai) {
            f32x4 rv[4][2][2];
#pragma unroll
            for (int m = 0; m < 4; ++m) { const size_t ro = (size_t)(row0 + ai * HALF + m * 16) * ldc + col0;
#pragma unroll
                for (int bj = 0; bj < 2; ++bj)
#pragma unroll
                    for (int n = 0; n < 2; ++n) rv[m][bj][n] = *(const f32x4*)(R + ro + bj * HALF + n * 16); }
#pragma unroll
            for (int m = 0; m < 4; ++m) { const size_t ro = (size_t)(row0 + ai * HALF + m * 16) * ldc + col0;
#pragma unroll
                for (int bj = 0; bj < 2; ++bj)
#pragma unroll
                    for (int n = 0; n < 2; ++n) *(f32x4*)(C + ro + bj * HALF + n * 16) = rv[m][bj][n] + acc[ai][bj][m][n]; } }
    }
};
struct EpiSwiGLU {
    static constexpr bool PERM = true, AFTER_DRAIN = false;
    bf16_t* H;
    __device__ __forceinline__ void operator()(const f32x4 (&acc)[2][2][4][2], const Unit& u, int wr, int wc, int fr, int fq) const {
        const int row0 = u.pm * BM + wr * 64 + fr, hc = (u.pn & 3) * 128 + wc * 32 + 8 * fq;
#pragma unroll
        for (int ai = 0; ai < 2; ++ai)
#pragma unroll
            for (int m = 0; m < 4; ++m) { const size_t row = (size_t)(row0 + ai * HALF + m * 16);
                float o[8];
#pragma unroll
                for (int n = 0; n < 2; ++n)
#pragma unroll
                    for (int i = 0; i < 4; ++i) { const float g = acc[ai][0][m][n][i], up = acc[ai][1][m][n][i]; o[n * 4 + i] = g * sigm_(g) * up; }
                u32x4 w; w.x = cvt_pk_bf16(o[0], o[1]); w.y = cvt_pk_bf16(o[2], o[3]); w.z = cvt_pk_bf16(o[4], o[5]); w.w = cvt_pk_bf16(o[6], o[7]);
                *(u32x4*)(H + row * 512 + hc) = w; }
    }
};
struct EpiDown {
    static constexpr bool PERM = true, AFTER_DRAIN = false;
    bf16_t* Y;
    __device__ __forceinline__ void operator()(const f32x4 (&acc)[2][2][4][2], const Unit& u, int wr, int wc, int fr, int fq) const {
        const int row0 = u.pm * BM + wr * 64 + fr, c0 = (u.pn & 3) * 256 + wc * 32 + 8 * fq;
#pragma unroll
        for (int ai = 0; ai < 2; ++ai)
#pragma unroll
            for (int m = 0; m < 4; ++m) { const size_t row = (size_t)(row0 + ai * HALF + m * 16);
#pragma unroll
                for (int bj = 0; bj < 2; ++bj) { const f32x4 v0 = acc[ai][bj][m][0], v1 = acc[ai][bj][m][1];
                    u32x4 w; w.x = cvt_pk_bf16(v0[0], v0[1]); w.y = cvt_pk_bf16(v0[2], v0[3]); w.z = cvt_pk_bf16(v1[0], v1[1]); w.w = cvt_pk_bf16(v1[2], v1[3]);
                    *(u32x4*)(Y + row * 1024 + c0 + bj * HALF) = w; } }
    }
};
template <bool GA_> struct MoeOrder {
    static constexpr bool GATHER = GA_;
    const PG8_LAS int* ts; int nl, lx, lo, hi; const int* rowtok; unsigned* rdy;
    __device__ __forceinline__ bool next(int i, Unit& u) const {
        const int U = 4 * (hi - lo), G = nl, c = lx; long L;
        if constexpr (GA_) L = (long)i * G + c;
        else { const int r = U % G;
            if (c >= r) L = (i == 0) ? (long)(c - r) : ((i == 1) ? (long)(G - r) + (c - r) : 2L * (G - r) + (long)(i - 2) * G + c);
            else L = 2L * (G - r) + (long)i * G + c; }
        if (L >= (long)U) return false;
        const int pm = lo + (int)(L >> 2), j = (int)(L & 3); int e = 0;
#pragma unroll
        for (int k = 1; k < 32; ++k) e += (ts[k] <= pm) ? 1 : 0;
        u.pm = pm; u.pn = e * 4 + j; return true;
    }
    __device__ __forceinline__ void a_ready(const Unit& u) const {
        if constexpr (!GA_) { unsigned sp = 0u;
            while (__hip_atomic_load(rdy + 16 * u.pm, __ATOMIC_RELAXED, __HIP_MEMORY_SCOPE_AGENT) < 32u) { __builtin_amdgcn_s_sleep(2); if (++sp > (1u << 22)) break; }
            asm volatile("" ::: "memory"); }
    }
    __device__ __forceinline__ void done(const Unit& u) const {
        if constexpr (GA_) { asm volatile("s_waitcnt vmcnt(0)" ::: "memory");
            if ((threadIdx.x & 63) == 0) (void)__hip_atomic_fetch_add(rdy + 16 * u.pm, 1u, __ATOMIC_RELAXED, __HIP_MEMORY_SCOPE_AGENT); }
    }
};
template <class E_> struct is_epibf16 { static constexpr bool value = false; }; template <int A_> struct is_epibf16<EpiBf16<A_>> { static constexpr bool value = true; };
template <class Epi, class Sched, bool ALIGN_EPI = false, bool SP2 = false, bool DUAL = false>
__device__ __forceinline__ void gemm_phase(PG8_LAS unsigned char* lds, const Gemm g, const Sched& S, const Epi& E) {
    const int tid = threadIdx.x, wid = __builtin_amdgcn_readfirstlane(tid >> 6), lane = tid & 63, wr = wid >> 2, wc = wid & 3, fr = lane & 15, fq = lane >> 4;
    const int K = g.K, nh = K / BK, nt = DUAL ? 2 * nh : nh;
    static_assert(!DUAL || SP2, "two operand pairs: SP2 loop only");
    unsigned voffA[2], voffB[2];
#pragma unroll
    for (int i = 0; i < 2; ++i) { int R, C; stage_rc(tid * 16 + i * 8192, R, C); const int Rb = Epi::PERM ? ((R & ~31) + perm32(R & 31)) : R;
        voffA[i] = (unsigned)(R * K + C) * 2u; voffB[i] = (unsigned)(Rb * K + C) * 2u; }
    const size_t kstep = (size_t)(BK * 2);
    const size_t hstep = (size_t)HALF * K * 2;
    const size_t tstep = 2 * hstep;
    constexpr bool GA = Sched::GATHER;
    static_assert(!GA || SP2, "gathered A rows: SP2 loop only");
    const size_t hstepA = GA ? 0 : hstep;
    unsigned gcur[2][2] = {{0u, 0u}, {0u, 0u}}, gnxt[2][2] = {{0u, 0u}, {0u, 0u}}; int gR[2] = {0, 0}; unsigned gC[2] = {0u, 0u};
    if constexpr (GA) { _Pragma("unroll") for (int i = 0; i < 2; ++i) { int R, C; stage_rc(tid * 16 + i * 8192, R, C); gR[i] = R; gC[i] = (unsigned)C * 2u; } }
#define PG8_GOFF(dst, u) do { if constexpr (GA) { _Pragma("unroll") for (int h_ = 0; h_ < 2; ++h_) _Pragma("unroll") for (int i_ = 0; i_ < 2; ++i_) dst[h_][i_] = (unsigned)S.rowtok[(u).pm * BM + h_ * HALF + gR[i_]] * (unsigned)(K * 2) + gC[i_]; } } while (0)
#define PG8_VA(h, sel) (GA ? ((sel) ? gnxt[h] : gcur[h]) : voffA)
    const unsigned ldsw = (unsigned)wid * 1024u;
    const int aoff = lds_byte(wr * 64 + fr, fq * 8), boff = lds_byte(wc * 32 + fr, fq * 8);
#define PG8_SA(b, h) (((b) * 2 + (h)) * HTB)
#define PG8_SB(b, h) ((4 + (b) * 2 + (h)) * HTB)
#define PG8_STAGE(bufoff, gbase, voff) do { _Pragma("unroll") for (int _i = 0; _i < 2; ++_i) \
        __builtin_amdgcn_global_load_lds((const unsigned*)((const char*)(gbase) + (voff)[_i]), (PG8_LAS unsigned*)(lds + (bufoff) + ldsw + _i * 8192), 16, 0, 0); } while (0)
#define PG8_LDA(dst, b, h) do { _Pragma("unroll") for (int m = 0; m < 4; ++m) _Pragma("unroll") for (int k = 0; k < 2; ++k) dst[m][k] = *(const PG8_LAS bf16x8*)(lds + PG8_SA(b, h) + aoff + m * 2048 + k * 1024); } while (0)
#define PG8_LDB(dst, b, h) do { _Pragma("unroll") for (int n = 0; n < 2; ++n) _Pragma("unroll") for (int k = 0; k < 2; ++k) dst[n][k] = *(const PG8_LAS bf16x8*)(lds + PG8_SB(b, h) + boff + n * 2048 + k * 1024); } while (0)
#define PG8_MMA(ai, bj, At, Bt) do { __builtin_amdgcn_s_setprio(1); _Pragma("unroll") for (int m = 0; m < 4; ++m) _Pragma("unroll") for (int n = 0; n < 2; ++n) _Pragma("unroll") for (int k = 0; k < 2; ++k) \
        acc[ai][bj][m][n] = __builtin_amdgcn_mfma_f32_16x16x32_bf16(Bt[n][k], At[m][k], acc[ai][bj][m][n], 0, 0, 0); __builtin_amdgcn_s_setprio(0); } while (0)
#define PG8_WAIT_V(n) asm volatile("s_waitcnt vmcnt(" #n ")" ::: "memory")
#define PG8_WAIT_L(n) asm volatile("s_waitcnt lgkmcnt(" #n ")" ::: "memory")
#define PG8_BAR __builtin_amdgcn_s_barrier()
#define PG8_SCHED __builtin_amdgcn_sched_barrier(0)
    Unit cur, nxt; int ui = 0;
    if (!S.next(0, cur)) return;
    f32x4 acc[2][2][4][2];
#pragma unroll
    for (int a = 0; a < 2; ++a)
#pragma unroll
        for (int b = 0; b < 2; ++b)
#pragma unroll
            for (int m = 0; m < 4; ++m)
#pragma unroll
                for (int n = 0; n < 2; ++n) acc[a][b][m][n] = (f32x4){0.f, 0.f, 0.f, 0.f};
    bf16x8 At[4][2], B0[2][2], B1[2][2];
    const char* cA = (const char*)g.A + (GA ? 0 : (size_t)cur.pm * tstep); const char* cB = (const char*)g.Bt + (size_t)cur.pn * tstep;
    S.a_ready(cur);
    PG8_GOFF(gcur, cur);
    if constexpr (SP2) {
        PG8_STAGE(PG8_SB(0, 0), cB, voffB); PG8_STAGE(PG8_SB(0, 1), cB + hstep, voffB); PG8_STAGE(PG8_SA(0, 0), cA, PG8_VA(0, false)); PG8_STAGE(PG8_SA(0, 1), cA + hstepA, PG8_VA(1, false));
        if (wr == 1) PG8_BAR;
        PG8_WAIT_V(2); PG8_BAR;
        PG8_STAGE(PG8_SB(1, 0), cB + kstep, voffB); PG8_STAGE(PG8_SA(1, 0), cA + kstep, PG8_VA(0, false)); PG8_STAGE(PG8_SB(1, 1), cB + hstep + kstep, voffB);
        PG8_WAIT_V(6); PG8_BAR;
    } else {
        PG8_STAGE(PG8_SB(0, 0), cB, voffB); PG8_STAGE(PG8_SA(0, 0), cA, voffA); PG8_STAGE(PG8_SB(0, 1), cB + hstep, voffB); PG8_STAGE(PG8_SA(0, 1), cA + hstep, voffA);
        if (wr == 1) PG8_BAR;
        PG8_WAIT_V(4); PG8_BAR;
        PG8_STAGE(PG8_SB(1, 0), cB + kstep, voffB); PG8_STAGE(PG8_SA(1, 0), cA + kstep, voffA); PG8_STAGE(PG8_SB(1, 1), cB + hstep + kstep, voffB);
        PG8_WAIT_V(6); PG8_BAR;
    }
    for (;;) {
        const bool has_next = S.next(ui + 1, nxt);
        if (has_next) PG8_GOFF(gnxt, nxt);
        const char* nA = has_next ? (const char*)g.A + (GA ? 0 : (size_t)nxt.pm * tstep) : cA; const char* nB = has_next ? (const char*)g.Bt + (size_t)nxt.pn * tstep : cB;
        const char* dA = cA; const char* dB = cB;
        if constexpr (DUAL) { dA = (const char*)g.A2 + (size_t)cur.pm * tstep - (size_t)nh * kstep; dB = (const char*)g.Bt2 + (size_t)cur.pn * tstep - (size_t)nh * kstep; }
        for (int th = 0; th < (DUAL ? 2 : 1); ++th) {
        for (int t = th * nh; t < (DUAL ? (th + 1) * nh : nt); t += 2) {
            const bool last = (t == nt - 2);
            const char* a1 = ((DUAL && t + 1 >= nh) ? dA : cA) + (size_t)(t + 1) * kstep;
            const char* a2 = last ? nA : ((DUAL && t + 2 >= nh) ? dA : cA) + (size_t)(t + 2) * kstep; const char* b2 = last ? nB : ((DUAL && t + 2 >= nh) ? dB : cB) + (size_t)(t + 2) * kstep;
            const char* a3 = a2 + kstep; const char* b3 = b2 + kstep;
            if (last && has_next) S.a_ready(nxt);
            const bool seln = last && has_next;
            if constexpr (SP2) {
            PG8_LDB(B0, 0, 0); PG8_LDB(B1, 0, 1); PG8_SCHED; PG8_LDA(At, 0, 0); PG8_STAGE(PG8_SA(1, 1), a1 + hstepA, PG8_VA(1, false));
            PG8_WAIT_V(8); PG8_WAIT_L(0); PG8_BAR; PG8_MMA(0, 0, At, B0); PG8_MMA(0, 1, At, B1); PG8_BAR; PG8_SCHED;
            PG8_LDA(At, 0, 1); PG8_STAGE(PG8_SB(0, 0), b2, voffB); PG8_STAGE(PG8_SB(0, 1), b2 + hstep, voffB); PG8_STAGE(PG8_SA(0, 0), a2, PG8_VA(0, seln));
            PG8_WAIT_V(8); PG8_WAIT_L(0); PG8_BAR; PG8_MMA(1, 0, At, B0); PG8_MMA(1, 1, At, B1); PG8_BAR; PG8_SCHED;
            PG8_LDB(B0, 1, 0); PG8_LDB(B1, 1, 1); PG8_SCHED; PG8_LDA(At, 1, 0); PG8_STAGE(PG8_SA(0, 1), a2 + hstepA, PG8_VA(1, seln));
            PG8_WAIT_V(8); PG8_WAIT_L(0); PG8_BAR; PG8_MMA(0, 0, At, B0); PG8_MMA(0, 1, At, B1); PG8_BAR; PG8_SCHED;
            PG8_LDA(At, 1, 1); PG8_STAGE(PG8_SB(1, 0), b3, voffB); PG8_STAGE(PG8_SB(1, 1), b3 + hstep, voffB); PG8_STAGE(PG8_SA(1, 0), a3, PG8_VA(0, seln));
            PG8_WAIT_V(8); PG8_WAIT_L(0); PG8_BAR; PG8_MMA(1, 0, At, B0); PG8_MMA(1, 1, At, B1); PG8_BAR; PG8_SCHED;
            } else {
            PG8_LDB(B0, 0, 0); PG8_SCHED; PG8_LDA(At, 0, 0); PG8_STAGE(PG8_SA(1, 1), a1 + hstep, voffA);
            PG8_WAIT_L(8); PG8_BAR; PG8_WAIT_L(0); PG8_MMA(0, 0, At, B0); PG8_BAR; PG8_SCHED;
            PG8_LDB(B1, 0, 1); PG8_STAGE(PG8_SB(0, 0), b2, voffB);
            PG8_BAR; PG8_WAIT_L(0); PG8_MMA(0, 1, At, B1); PG8_BAR;
            PG8_LDA(At, 0, 1); PG8_STAGE(PG8_SA(0, 0), a2, voffA);
            PG8_BAR; PG8_WAIT_L(0); PG8_MMA(1, 0, At, B0); PG8_BAR; PG8_SCHED;
            PG8_STAGE(PG8_SB(0, 1), b2 + hstep, voffB);
            PG8_WAIT_V(6); PG8_BAR; PG8_MMA(1, 1, At, B1); PG8_BAR;
            PG8_LDB(B0, 1, 0); PG8_SCHED; PG8_LDA(At, 1, 0); PG8_STAGE(PG8_SA(0, 1), a2 + hstep, voffA);
            PG8_WAIT_L(8); PG8_BAR; PG8_WAIT_L(0); PG8_MMA(0, 0, At, B0); PG8_BAR; PG8_SCHED;
            PG8_LDB(B1, 1, 1); PG8_STAGE(PG8_SB(1, 0), b3, voffB);
            PG8_BAR; PG8_WAIT_L(0); PG8_MMA(0, 1, At, B1); PG8_BAR;
            PG8_LDA(At, 1, 1); PG8_STAGE(PG8_SA(1, 0), a3, voffA);
            PG8_BAR; PG8_WAIT_L(0); PG8_MMA(1, 0, At, B0); PG8_BAR; PG8_SCHED;
            PG8_STAGE(PG8_SB(1, 1), b3 + hstep, voffB);
            PG8_WAIT_V(6); PG8_BAR; PG8_MMA(1, 1, At, B1); PG8_BAR;
            }
        }
        if constexpr (DUAL) { if (th == 0) E.mid(acc, cur, wr, wc, fr, fq); }
        }
        if constexpr (ALIGN_EPI) { if (wr == 0) PG8_BAR; }
        if constexpr (!Epi::AFTER_DRAIN) { E(acc, cur, wr, wc, fr, fq); S.done(cur); }
#ifdef DBG_EPI2
        if constexpr (is_epibf16<Epi>::value) { asm volatile("" ::: "memory"); E(acc, cur, wr, wc, fr, fq); }
#endif
#ifdef DBG_EPI2R
        if constexpr (!Epi::PERM) { asm volatile("" ::: "memory"); E(acc, cur, wr, wc, fr, fq); }
#endif
        if (!has_next) break;
#pragma unroll
        for (int a = 0; a < 2; ++a)
#pragma unroll
            for (int b = 0; b < 2; ++b)
#pragma unroll
                for (int m = 0; m < 4; ++m)
#pragma unroll
                    for (int n = 0; n < 2; ++n) acc[a][b][m][n] = (f32x4){0.f, 0.f, 0.f, 0.f};
        cur = nxt; cA = nA; cB = nB; ++ui;
        if constexpr (GA) { _Pragma("unroll") for (int h_ = 0; h_ < 2; ++h_) _Pragma("unroll") for (int i_ = 0; i_ < 2; ++i_) gcur[h_][i_] = gnxt[h_][i_]; }
        if constexpr (ALIGN_EPI) { if (wr == 1) PG8_BAR; }
    }
    PG8_WAIT_V(0);
    if constexpr (!ALIGN_EPI) { if (wr == 0) PG8_BAR; }
    PG8_BAR;
    if constexpr (Epi::AFTER_DRAIN) { E.fused(acc, cur, wr, wc, fr, fq, lds, wid, lane); S.done(cur); }
#undef PG8_GOFF
#undef PG8_VA
#undef PG8_SA
#undef PG8_SB
#undef PG8_STAGE
#undef PG8_LDA
#undef PG8_LDB
#undef PG8_MMA
#undef PG8_WAIT_V
#undef PG8_WAIT_L
#undef PG8_BAR
#undef PG8_SCHED
}
}
constexpr int NWAVES = 8;
constexpr int BATCH = 8, SEQ = 4096, D = 1024, T = BATCH * SEQ;
constexpr int NPROJ = 5120;
constexpr int NTILE = NPROJ / 256;
constexpr float EPS = 1e-6f;
#ifndef MK_N_LAUNCHES
#define MK_N_LAUNCHES 1
#endif
#ifndef DBG_NPH
#define DBG_NPH 12
#endif
constexpr int NPH = DBG_NPH;
constexpr int N_LAUNCHES = MK_N_LAUNCHES;
static_assert(N_LAUNCHES == 1 || N_LAUNCHES == NPH, "MK_N_LAUNCHES is 1 or NPH");

constexpr size_t MiB = 1u << 20;
constexpr size_t WS_CTL = 0, CTL_ZERO_BYTES = 1 * MiB;
constexpr size_t WS_SMALL = 1 * MiB;
constexpr size_t WS_WIN = 2 * MiB;
constexpr size_t WS_WPA = 13 * MiB, WS_WPM = 14 * MiB, WS_WOUT = 15 * MiB;
constexpr size_t WS_TOKE = 17 * MiB;
constexpr size_t WS_TOKR = WS_TOKE + 256 * 1024;
constexpr size_t WS_TOKP = WS_TOKR + 256 * 1024;
constexpr size_t WS_TOKG = WS_TOKP + 256 * 1024;
constexpr size_t WS_CNT = WS_TOKG + 256 * 1024;
constexpr size_t WS_ROWTOK = WS_CNT + 64 * 1024;
constexpr int NROWS_MAX = 73728;
constexpr size_t WS_SC = 452 * MiB;
constexpr size_t WS_SC2 = 116 * MiB + 3 * ((size_t)T * 256 * 2);
constexpr size_t WS_GU = 20 * MiB;
constexpr size_t WS_DN = 84 * MiB;
constexpr size_t WS_PROJ = 116 * MiB;
constexpr size_t PROJ_TILE = (size_t)T * 256 * 2;
constexpr size_t WS_MLST = 116 * MiB;
constexpr size_t WS_MERGED = 116 * MiB;
constexpr size_t WS_XN = 180 * MiB;
constexpr size_t WS_XG = 244 * MiB;
constexpr size_t WS_HID = 388 * MiB;
constexpr size_t WS_Y = 244 * MiB;
constexpr size_t WS_END = 512 * MiB;
static_assert(WS_PROJ + NTILE * PROJ_TILE == 436 * MiB, "proj map");
constexpr size_t DO_H = 0, DO_YATT = 0, DO_YML = 32 * MiB, DO_KN = 64 * MiB, DO_IKR = 72 * MiB, DO_IQR = 74 * MiB, DO_AQN = 90 * MiB;
constexpr int TL_AQ = 0, TL_KV = 2, TL_IQ = 3, TL_MQ = 4, TL_MK = 6, TL_MV = 8, TL_MO = 10, TL_GA = 12, TL_GM = 16;
constexpr size_t WS_WSM = WS_SMALL + 64 * 1024;
constexpr size_t WS_WTG = WS_SMALL + 192 * 1024;
constexpr size_t DO_SMB = 122 * MiB;
constexpr int CW_BAR = 4096;
constexpr int CW_Q = 16384;
constexpr int CW_KMAX = 24576;
constexpr int CW_RDY = 32768;
constexpr int LDS_BYTES = 163840, MISC_OFF = LDS_BYTES - 512;

#define GAS __attribute__((address_space(1)))
#define LAS __attribute__((address_space(3)))
typedef unsigned short bf16;
typedef unsigned v4u __attribute__((ext_vector_type(4)));
typedef unsigned v2u __attribute__((ext_vector_type(2)));
typedef float f32x4 __attribute__((ext_vector_type(4)));
typedef float f32x2 __attribute__((ext_vector_type(2)));
typedef short bf16x8 __attribute__((ext_vector_type(8)));
typedef GAS unsigned gu32;
#define RLX_AGENT __ATOMIC_RELAXED, __HIP_MEMORY_SCOPE_AGENT
#define LDS_WAIT() asm volatile("s_waitcnt lgkmcnt(0)" ::: "memory")
__device__ __forceinline__ float bf2f(unsigned b16) { return __uint_as_float(b16 << 16); }
__device__ __forceinline__ unsigned f2bf(float f) { unsigned u = __float_as_uint(f); return (u + 0x7fffu + ((u >> 16) & 1u)) >> 16; }
__device__ __forceinline__ unsigned pk2(float lo, float hi) { return pg8::cvt_pk_bf16(lo, hi); }
__device__ __forceinline__ float sigm(float x) { return __builtin_amdgcn_rcpf(1.0f + __expf(-x)); }
__device__ __forceinline__ float wave_sum(float v) {
    v += __int_as_float(__builtin_amdgcn_update_dpp(0, __float_as_int(v), 0xB1, 0xF, 0xF, true));
    v += __int_as_float(__builtin_amdgcn_update_dpp(0, __float_as_int(v), 0x4E, 0xF, 0xF, true));
    v += __int_as_float(__builtin_amdgcn_update_dpp(0, __float_as_int(v), 0x124, 0xF, 0xF, true));
    v += __int_as_float(__builtin_amdgcn_update_dpp(0, __float_as_int(v), 0x128, 0xF, 0xF, true));
    { const auto r = __builtin_amdgcn_permlane16_swap(__float_as_uint(v), __float_as_uint(v), false, false); v = __uint_as_float(r[0]) + __uint_as_float(r[1]); }
    { const auto r = __builtin_amdgcn_permlane32_swap(__float_as_uint(v), __float_as_uint(v), false, false); v = __uint_as_float(r[0]) + __uint_as_float(r[1]); }
    return v;
}
__device__ __forceinline__ void unpack8(const v4u r, float (&f)[8]) {
    f[0] = bf2f(r.x & 0xffffu); f[1] = bf2f(r.x >> 16); f[2] = bf2f(r.y & 0xffffu); f[3] = bf2f(r.y >> 16);
    f[4] = bf2f(r.z & 0xffffu); f[5] = bf2f(r.z >> 16); f[6] = bf2f(r.w & 0xffffu); f[7] = bf2f(r.w >> 16);
}
__device__ __forceinline__ v4u pack8(const float (&f)[8]) { v4u w; w.x = pk2(f[0], f[1]); w.y = pk2(f[2], f[3]); w.z = pk2(f[4], f[5]); w.w = pk2(f[6], f[7]); return w; }
#define XB_TMO      128
#define XB_XCNT(j)  (256  + 64 * (j))
#define XB_XSUB(j)  (1280 + 64 * (j))
#define XB_XGEN(j)  (2304 + 64 * (j))
#define XB_TOP      3328
#define XB_TOPGEN   3392
#define XCD_BAR_WORDS 3456
#define XB_SPIN_CAP (1u << 18)

__device__ __forceinline__ unsigned xb_ld(unsigned* p)              { return __hip_atomic_load(p, __ATOMIC_RELAXED, __HIP_MEMORY_SCOPE_AGENT); }
__device__ __forceinline__ unsigned xb_add(unsigned* p, unsigned v) { return __hip_atomic_fetch_add(p, v, __ATOMIC_RELAXED, __HIP_MEMORY_SCOPE_AGENT); }
__device__ __forceinline__ unsigned xb_xcc_id() { return (unsigned)__builtin_amdgcn_s_getreg((3 << 11) | 20) & 0xFu; }
#define XB_SPIN(cond, bar) do { unsigned _sp = 0; while (cond) { __builtin_amdgcn_s_sleep(1); \
    if ((++_sp & 255u) == 0u) { if (xb_ld(&(bar)[XB_TMO])) break; if (_sp > XB_SPIN_CAP) { atomicAdd(&(bar)[XB_TMO], 1u); break; } } } } while (0)

struct XcdBarrier {
    unsigned* bar; unsigned x;
    volatile LAS unsigned* st;
};

__device__ __forceinline__ XcdBarrier xcd_barrier_post(unsigned* bar, volatile LAS unsigned* st) {
    XcdBarrier b; b.bar = bar; b.x = xb_xcc_id(); b.st = st;
    if (threadIdx.x == 0) st[12] = xb_add(&bar[XB_XCNT(b.x)], 1u);
    return b;
}
__device__ __forceinline__ void xcd_barrier_complete(unsigned* bar, unsigned x, unsigned& nloc, unsigned& nx) {
    const unsigned G = gridDim.x * gridDim.y * gridDim.z;
    unsigned sum, cnt, mine, sp = 0u;
    for (;;) {
        sum = 0u; cnt = 0u; mine = 0u;
#pragma unroll
        for (unsigned j = 0; j < 16; ++j) { const unsigned c = xb_ld(&bar[XB_XCNT(j)]); sum += c; cnt += (c > 0u) ? 1u : 0u; mine = (j == x) ? c : mine; }
        if (sum == G) break;
        __builtin_amdgcn_s_sleep(1);
        if ((++sp & 255u) == 0u) { if (xb_ld(&bar[XB_TMO])) break; if (sp > XB_SPIN_CAP) { atomicAdd(&bar[XB_TMO], 1u); break; } }
    }
    nloc = mine > 0u ? mine : 1u; nx = cnt > 0u ? cnt : 1u;
}

__device__ __forceinline__ void xcd_barrier(const XcdBarrier& b) {
    asm volatile("s_waitcnt vmcnt(0)" ::: "memory");
    __syncthreads();
    if (threadIdx.x == 0) {
        unsigned* bar = b.bar;
        __builtin_amdgcn_s_waitcnt(0);
        unsigned nloc = b.st[0], nx = b.st[1];
        if (nloc == 0u) { xcd_barrier_complete(bar, b.x, nloc, nx); b.st[0] = nloc; b.st[1] = nx; }
        const unsigned old = xb_add(&bar[XB_XSUB(b.x)], 1u);
        const unsigned gen = old / nloc;
        if (old + 1u == (gen + 1u) * nloc) {
            __builtin_amdgcn_fence(__ATOMIC_RELEASE, "agent");
            asm volatile("s_waitcnt vmcnt(0)" ::: "memory");
            const unsigned og = xb_add(&bar[XB_TOP], 1u);
            const unsigned tg = og / nx;
            if (og + 1u == (tg + 1u) * nx) xb_add(&bar[XB_TOPGEN], 1u);
            else XB_SPIN(xb_ld(&bar[XB_TOPGEN]) == tg, bar);
            __builtin_amdgcn_fence(__ATOMIC_ACQUIRE, "agent");
            xb_add(&bar[XB_XGEN(b.x)], 1u);
            asm volatile("s_waitcnt vmcnt(0)" ::: "memory");
        } else {
            XB_SPIN(xb_ld(&bar[XB_XGEN(b.x)]) == gen, bar);
            __builtin_amdgcn_fence(__ATOMIC_ACQUIRE, "agent");
            asm volatile("s_waitcnt vmcnt(0)" ::: "memory");
        }
    }
    __syncthreads();
}
struct Args { const float* in[22]; float* out; unsigned char* ws; int ph_lo, ph_hi, li, pad; };
struct Ctx { int tid, lane, wave, G, vcu; LAS unsigned char* lds; };
#define IN_X 0
#define IN_POS 1
#define IN_GMIX 2
#define IN_WIN 3
#define IN_GQ 4
#define IN_GK 5
#define IN_WCONV 6
#define IN_BCONV 7
#define IN_BI 8
#define IN_BF 9
#define IN_GML 10
#define IN_WPA 11
#define IN_WPM 12
#define IN_WOUT 13
#define IN_GMOE 14
#define IN_WRG 15
#define IN_BRG 16
#define IN_WRE 17
#define IN_BRE 18
#define IN_WEG 19
#define IN_WEU 20
#define IN_WED 21

__device__ __forceinline__ int win_src_col(int n) {
    if (n < 1024) return n;
    if (n < 3072) return n + 40;
    return n + 48;
}
__device__ __forceinline__ int wsm_src_col(int r) {
    return r < 40 ? 1024 + r : (r < 44 ? 3112 + (r - 40) : 3116 + (r - 44));
}
__device__ __forceinline__ void tr_item(const float* W, int ldw, int scol, int k0, bf16* wt0, int K, LAS float* scr, int lane) {
    const int sc0 = __builtin_amdgcn_readfirstlane(scol), sc31 = __builtin_amdgcn_readlane(scol, 31);
    if (sc0 >= 0 && sc31 == sc0 + 31 && (sc0 & 3) == 0 && (ldw & 3) == 0) {
#pragma unroll
        for (int i = 0; i < 8; ++i) { const int kk = 8 * i + (lane >> 3); const f32x4 v = *(const f32x4*)(W + (size_t)(k0 + kk) * ldw + sc0 + 4 * (lane & 7));
            LAS float* d = scr + kk * 33 + 4 * (lane & 7); d[0] = v[0]; d[1] = v[1]; d[2] = v[2]; d[3] = v[3]; }
    } else {
#pragma unroll 8
        for (int i = 0; i < 32; ++i) { const int kk = 2 * i + (lane >> 5); scr[kk * 33 + (lane & 31)] = scol >= 0 ? W[(size_t)(k0 + kk) * ldw + scol] : 0.f; }
    }
    LDS_WAIT(); asm volatile("" ::: "memory");
    const int c = lane & 7;
#pragma unroll
    for (int j = 0; j < 4; ++j) { const int n = (lane >> 3) + 8 * j; const LAS float* s = scr + (8 * c) * 33 + n;
        v4u o; o.x = pk2(s[0 * 33], s[1 * 33]); o.y = pk2(s[2 * 33], s[3 * 33]); o.z = pk2(s[4 * 33], s[5 * 33]); o.w = pk2(s[6 * 33], s[7 * 33]);
        *(v4u*)(wt0 + (size_t)n * K + 8 * c) = o; }
    LDS_WAIT(); asm volatile("" ::: "memory");
}
template <int PART> __device__ __forceinline__ void p0_prologue(const Args& a, const Ctx& c, int gw, int NGW) {
    unsigned char* ws = a.ws;
    LAS float* scr = (LAS float*)(c.lds + c.wave * 16384);
    const int lane = c.lane;
    constexpr int I_IN = 16 * 160, I_PA = 8 * 32, I_PM = 8 * 32, I_OUT = 16 * 32, I_GU = 32 * 16 * 32, I_DN = 32 * 8 * 32;
    constexpr int NPRJ = I_IN + I_PA + I_PM + I_OUT, NIT = NPRJ + I_GU + I_DN;
    for (int it = (PART ? NPRJ : 0) + gw; it < (PART ? NIT : NPRJ); it += NGW) {
        int r = it;
        if (r < I_IN) { const int kb = r / 160, nb = r % 160; tr_item(a.in[IN_WIN], 5168, win_src_col(32 * nb + (lane & 31)), 64 * kb, (bf16*)(ws + WS_WIN) + (size_t)(32 * nb) * 1024 + 64 * kb, 1024, scr, lane); continue; } r -= I_IN;
        if (r < I_PA) { const int kb = r / 32, nb = r % 32; tr_item(a.in[IN_WPA], 1024, 32 * nb + (lane & 31), 64 * kb, (bf16*)(ws + WS_WPA) + (size_t)(32 * nb) * 512 + 64 * kb, 512, scr, lane); continue; } r -= I_PA;
        if (r < I_PM) { const int kb = r / 32, nb = r % 32; tr_item(a.in[IN_WPM], 1024, 32 * nb + (lane & 31), 64 * kb, (bf16*)(ws + WS_WPM) + (size_t)(32 * nb) * 512 + 64 * kb, 512, scr, lane); continue; } r -= I_PM;
        if (r < I_OUT) { const int kb = r / 32, nb = r % 32; tr_item(a.in[IN_WOUT], 1024, 32 * nb + (lane & 31), 64 * kb, (bf16*)(ws + WS_WOUT) + (size_t)(32 * nb) * 1024 + 64 * kb, 1024, scr, lane); continue; } r -= I_OUT;
        if (r < I_GU) { const int e = r / 512, q = r % 512, kb = q / 32, nb = q % 32, t = nb >> 3, bj = (nb >> 2) & 1, i0 = (nb & 3) * 32;
            const float* src = (bj ? a.in[IN_WEU] : a.in[IN_WEG]) + (size_t)e * 1024 * 512;
            tr_item(src, 512, 128 * t + i0 + (lane & 31), 64 * kb, (bf16*)(ws + WS_GU) + ((size_t)e * 1024 + 32 * nb) * 1024 + 64 * kb, 1024, scr, lane); continue; } r -= I_GU;
        { const int e = r / 256, q = r % 256, kb = q / 32, nb = q % 32;
            tr_item(a.in[IN_WED] + (size_t)e * 512 * 1024, 1024, 32 * nb + (lane & 31), 64 * kb, (bf16*)(ws + WS_DN) + ((size_t)e * 1024 + 32 * nb) * 512 + 64 * kb, 512, scr, lane); }
    }
    if (PART) return;
    { float* WTG = (float*)(ws + WS_WTG); for (int i = gw * 64 + lane; i < 36 * 1024; i += NGW * 64) { const int j = i >> 10, k = i & 1023;
        WTG[j * 1028 + k] = (j < 32 ? a.in[IN_WRE][k * 32 + j] : a.in[IN_WRG][k * 4 + (j - 32)]) * a.in[IN_GMOE][k]; } }
    { bf16* WSM = (bf16*)(ws + WS_WSM); for (int i = gw * 64 + lane; i < 48 * 1024; i += NGW * 64) { const int r = i >> 10, k = i & 1023; WSM[i] = (bf16)f2bf(a.in[IN_WIN][(size_t)k * 5168 + wsm_src_col(r)]); } }
    const float* g = a.in[IN_GMIX]; f32x4 gv[4];
#pragma unroll
    for (int j = 0; j < 4; ++j) gv[j] = *(const f32x4*)(g + 4 * lane + 256 * j);
    bf16* H = (bf16*)((unsigned char*)a.out + DO_H);
    for (int m0 = gw; m0 < T; m0 += 2 * NGW) {
        const int mA = m0, mB = (m0 + NGW < T) ? m0 + NGW : m0; const bool hasB = (m0 + NGW < T);
        const f32x4* xa = (const f32x4*)(a.in[IN_X] + (size_t)mA * D) + lane; const f32x4* xb = (const f32x4*)(a.in[IN_X] + (size_t)mB * D) + lane;
        f32x4 va[4], vb[4]; float sa = 0.f, sb = 0.f;
#pragma unroll
        for (int j = 0; j < 4; ++j) { va[j] = xa[64 * j]; vb[j] = xb[64 * j]; }
#pragma unroll
        for (int j = 0; j < 4; ++j) { sa += (va[j].x * va[j].x + va[j].y * va[j].y) + (va[j].z * va[j].z + va[j].w * va[j].w); sb += (vb[j].x * vb[j].x + vb[j].y * vb[j].y) + (vb[j].z * vb[j].z + vb[j].w * vb[j].w); }
        const float ra = rsqrtf(wave_sum(sa) * (1.f / D) + EPS), rb = rsqrtf(wave_sum(sb) * (1.f / D) + EPS);
        v2u* oa = (v2u*)(H + (size_t)mA * D) + lane; v2u* ob = (v2u*)(H + (size_t)mB * D) + lane;
#pragma unroll
        for (int j = 0; j < 4; ++j) { v2u w; w.x = pk2(va[j].x * ra * gv[j].x, va[j].y * ra * gv[j].y); w.y = pk2(va[j].z * ra * gv[j].z, va[j].w * ra * gv[j].w); oa[64 * j] = w; }
        if (hasB) {
#pragma unroll
        for (int j = 0; j < 4; ++j) { v2u w; w.x = pk2(vb[j].x * rb * gv[j].x, vb[j].y * rb * gv[j].y); w.y = pk2(vb[j].z * rb * gv[j].z, vb[j].w * rb * gv[j].w); ob[64 * j] = w; } }
    }
}

__device__ __forceinline__ const bf16* proj_tile(const Args& a, int tile) { return (const bf16*)(a.ws + WS_PROJ + (size_t)tile * PROJ_TILE); }
#define DPPF(x_, ctrl_) __int_as_float(__builtin_amdgcn_update_dpp(0, __float_as_int(x_), ctrl_, 0xF, 0xF, true))
__device__ __forceinline__ void p2_prep(const Args& a, const Ctx& c) {
    const int lane = c.lane, gw = c.vcu * NWAVES + c.wave, NGW = c.G * NWAVES;
    float invf = 0.f;
    if (lane < 8) invf = (float)pow(500000.0, -(double)lane / 8.0); else if (lane < 12) invf = (float)pow(500000.0, -(double)(lane - 8) / 4.0);
    float gq[8], gk[8];
#pragma unroll
    for (int i = 0; i < 8; ++i) { gq[i] = a.in[IN_GQ][8 * (lane & 7) + i]; gk[i] = a.in[IN_GK][8 * (lane & 7) + i]; }
    const int* pos = (const int*)a.in[IN_POS];
    unsigned char* dout = (unsigned char*)a.out;
    bf16* AQN = (bf16*)(dout + DO_AQN); bf16* KN = (bf16*)(dout + DO_KN); bf16* IQR = (bf16*)(dout + DO_IQR); bf16* IKR = (bf16*)(dout + DO_IKR);
#ifdef DBG_TIME
    const unsigned long long p2t0_ = wall_clock64();
#endif
    { const bf16* Hh = (const bf16*)(dout + DO_H); const bf16* WSM = (const bf16*)(a.ws + WS_WSM); bf16* SMB = (bf16*)(dout + DO_SMB);
      const int row = lane & 15, kg = lane >> 4;
      const float invfk = (float)pow(500000.0, -(double)(lane & 3) / 4.0);
      for (int tile = gw; tile < T / 16; tile += NGW) { const int t0 = tile * 16;
          f32x4 acc[3];
#pragma unroll
          for (int ct = 0; ct < 3; ++ct) acc[ct] = (f32x4){0.f, 0.f, 0.f, 0.f};
          const bf16* ap = Hh + (size_t)(t0 + row) * 1024 + 8 * kg; const bf16* bp = WSM + (size_t)row * 1024 + 8 * kg;
#pragma unroll 8
          for (int ks = 0; ks < 32; ++ks) { const bf16x8 av = *(const bf16x8*)(ap + 32 * ks);
#pragma unroll
              for (int ct = 0; ct < 3; ++ct) acc[ct] = __builtin_amdgcn_mfma_f32_16x16x32_bf16(av, *(const bf16x8*)(bp + (size_t)ct * 16 * 1024 + 32 * ks), acc[ct], 0, 0, 0); }
          const int col = lane & 15;
#pragma unroll
          for (int r = 0; r < 4; ++r) { const int t = t0 + 4 * kg + r;
              const float angk = (float)pos[t] * invfk;
              const double revk = (double)angk * 0.15915494309189535; const float frk = (float)(revk - __builtin_rint(revk));
              const float ck = __builtin_amdgcn_cosf(frk), sk = __builtin_amdgcn_sinf(frk);
              const float v0 = acc[0][r], pr = __shfl_xor(v0, 4);
              const float o0 = (col < 4) ? (v0 * ck - pr * sk) : ((col < 8) ? (v0 * ck + pr * sk) : v0);
              IKR[(size_t)t * 32 + col] = (bf16)f2bf(o0); IKR[(size_t)t * 32 + 16 + col] = (bf16)f2bf(acc[1][r]);
              SMB[(size_t)t * 16 + col] = (bf16)f2bf(acc[2][r]); }
          { float nk = 0.f;
#pragma unroll
            for (int r = 0; r < 4; ++r) { float q2 = acc[0][r] * acc[0][r] + acc[1][r] * acc[1][r];
                q2 += DPPF(q2, 0xB1); q2 += DPPF(q2, 0x4E); q2 += DPPF(q2, 0x141); q2 += DPPF(q2, 0x140);
                nk = fmaxf(nk, q2); }
            nk = fmaxf(nk, __shfl_xor(nk, 16)); nk = fmaxf(nk, __shfl_xor(nk, 32));
            if (lane == 0) atomicMax((unsigned*)(a.ws + WS_CTL) + CW_KMAX + 16 * (t0 / SEQ), __float_as_uint(nk)); } } }
#ifdef DBG_TIME
    const unsigned long long p2t1_ = wall_clock64();
#endif
    const int l7 = lane & 7;
    const int aqcol = (lane >> 3) * 64 + 8 * l7, akcol = ((lane & 15) >> 3) * 64 + 8 * l7;
    const bf16* aqsrc = proj_tile(a, TL_AQ + (aqcol >> 8)) + (aqcol & 255); const bf16* aksrc = proj_tile(a, TL_KV) + akcol; const bf16* iqsrc = proj_tile(a, TL_IQ) + 4 * lane;
#define P2_LOADROW(t_, P_, A_, K_, Q_) do { const int tt_ = (t_) < T ? (t_) : T - 1; P_ = pos[tt_]; A_ = *(const v4u*)(aqsrc + (size_t)tt_ * 256); K_ = *(const v4u*)(aksrc + (size_t)tt_ * 256); Q_ = *(const v2u*)(iqsrc + (size_t)tt_ * 256); } while (0)
#define P2_DOROW(t, P_, A_, K_, Q_) do { \
        const float ang = (float)(P_) * invf; \
        const double rev = (double)ang * 0.15915494309189535; const float frv = (float)(rev - __builtin_rint(rev)); \
        float cs = __builtin_amdgcn_cosf(frv), sn = __builtin_amdgcn_sinf(frv); \
        float ca[8], sa[8], ci[4], si[4]; \
        _Pragma("unroll") for (int i = 0; i < 8; ++i) { ca[i] = __int_as_float(__builtin_amdgcn_readlane(__float_as_int(cs), i)); sa[i] = __int_as_float(__builtin_amdgcn_readlane(__float_as_int(sn), i)); } \
        _Pragma("unroll") for (int i = 0; i < 4; ++i) { ci[i] = __int_as_float(__builtin_amdgcn_readlane(__float_as_int(cs), 8 + i)); si[i] = __int_as_float(__builtin_amdgcn_readlane(__float_as_int(sn), 8 + i)); } \
        { float f[8]; unpack8(A_, f); float ss = 0.f; \
          _Pragma("unroll") for (int i = 0; i < 8; ++i) ss += f[i] * f[i]; \
          ss += DPPF(ss, 0xB1); ss += DPPF(ss, 0x4E); ss += DPPF(ss, 0x141); \
          const float r = rsqrtf(ss * (1.f / 64.f) + EPS); \
          _Pragma("unroll") for (int i = 0; i < 8; ++i) f[i] = f[i] * r * gq[i]; \
          float o[8]; \
          _Pragma("unroll") for (int i = 0; i < 8; ++i) { const float p = DPPF(f[i], 0xB1); o[i] = (l7 == 0) ? (f[i] * ca[i] - p * sa[i]) : ((l7 == 1) ? (f[i] * ca[i] + p * sa[i]) : f[i]); o[i] *= 0.125f * 1.4426950408889634f; } \
          *(v4u*)(AQN + (size_t)(t) * 512 + aqcol) = pack8(o); } \
        { float f[8]; unpack8(K_, f); float ss = 0.f; \
          _Pragma("unroll") for (int i = 0; i < 8; ++i) ss += f[i] * f[i]; \
          ss += DPPF(ss, 0xB1); ss += DPPF(ss, 0x4E); ss += DPPF(ss, 0x141); \
          const float r = rsqrtf(ss * (1.f / 64.f) + EPS); \
          _Pragma("unroll") for (int i = 0; i < 8; ++i) f[i] = f[i] * r * gk[i]; \
          float o[8]; \
          _Pragma("unroll") for (int i = 0; i < 8; ++i) { const float p = DPPF(f[i], 0xB1); o[i] = (l7 == 0) ? (f[i] * ca[i] - p * sa[i]) : ((l7 == 1) ? (f[i] * ca[i] + p * sa[i]) : f[i]); } \
          if (lane < 16) *(v4u*)(KN + (size_t)(t) * 128 + akcol) = pack8(o); } \
        { const v2u rw = Q_; \
          float f[4] = {bf2f(rw.x & 0xffffu), bf2f(rw.x >> 16), bf2f(rw.y & 0xffffu), bf2f(rw.y >> 16)}; float o[4]; \
          _Pragma("unroll") for (int i = 0; i < 4; ++i) { const float p = DPPF(f[i], 0xB1); o[i] = (l7 == 0) ? (f[i] * ci[i] - p * si[i]) : ((l7 == 1) ? (f[i] * ci[i] + p * si[i]) : f[i]); } \
          v2u w; w.x = pk2(o[0], o[1]); w.y = pk2(o[2], o[3]); *(v2u*)(IQR + (size_t)(t) * 256 + 4 * lane) = w; } } while (0)
    { int pA, pB; v4u aA, aB, kA, kB; v2u qA, qB;
      P2_LOADROW(gw, pA, aA, kA, qA);
#pragma unroll 1
      for (int t = gw; t < T; t += 2 * NGW) {
          P2_LOADROW(t + NGW, pB, aB, kB, qB);
          P2_DOROW(t, pA, aA, kA, qA);
          P2_LOADROW(t + 2 * NGW, pA, aA, kA, qA);
          if (t + NGW < T) P2_DOROW(t + NGW, pB, aB, kB, qB);
      } }
#undef P2_LOADROW
#undef P2_DOROW
#ifdef DBG_TIME
    { const unsigned long long p2t2_ = wall_clock64(); volatile LAS unsigned* M_ = (volatile LAS unsigned*)(c.lds + MISC_OFF);
      if (c.tid == 0) { if (DBG_TIME == 20) M_[30] = (unsigned)(p2t1_ - p2t0_); if (DBG_TIME == 21) M_[30] = (unsigned)(p2t2_ - p2t1_); } }
#endif
}
constexpr int ML_QS = 0, ML_KS = 17408, ML_HS = 0;
constexpr int ML_KWT = 34816;
constexpr int ML_VT = 53248;
constexpr int ML_SW = 73984;
constexpr int ML_CT = 83200;
constexpr int ML_GA = 122368;
constexpr int ML_CW = ML_GA + 1024;
constexpr int ML_END = ML_CW + (1024 + 384) * 4;
static_assert(ML_END <= MISC_OFF, "mLSTM LDS map");
constexpr size_t ML_STATE_BYTES = 8 * 9 * 64 * 16;
__device__ __forceinline__ bf16x8 lds_frag(const LAS unsigned char* base, int stride_b, int row0, int kb, int lane) {
    return *(const LAS bf16x8*)(base + (row0 + (lane & 15)) * stride_b + kb + (lane >> 4) * 16);
}
__device__ __forceinline__ bf16x8 lds_frag_sw(const LAS unsigned char* base, int row0, int ks, int lane) {
    const int row = row0 + (lane & 15); return *(const LAS bf16x8*)(base + row * 144 + 16 * (((ks * 4 + (lane >> 4)) + (row >> 3)) & 7));
}
#define MFMA16(a_, b_, c_) __builtin_amdgcn_mfma_f32_16x16x32_bf16(a_, b_, c_, 0, 0, 0)
constexpr int CV_NMI = 2 * (32 * 16 * 32 + 32 * 8 * 32);
constexpr int CV_SCR = ML_END, CV_SCRW = 32 * 33 * 4;
static_assert(CV_SCR + 8 * CV_SCRW <= MISC_OFF, "conversion scratch");
struct CvItem { const float* src; bf16* dst; int ldw, K; };
__device__ __forceinline__ CvItem cv_item(const Args& a, int mi) {
    const int it = mi >> 1, hk = mi & 1; CvItem r;
    if (it < 32 * 16 * 32) { const int e = it >> 9, q = it & 511, kb = q >> 5, nb = q & 31, t = nb >> 3, bj = (nb >> 2) & 1, i0 = (nb & 3) * 32, k0 = 64 * kb + 32 * hk;
        r.src = (bj ? a.in[IN_WEU] : a.in[IN_WEG]) + (size_t)e * 1024 * 512 + (size_t)k0 * 512 + 128 * t + i0; r.ldw = 512; r.K = 1024;
        r.dst = (bf16*)(a.ws + WS_GU) + ((size_t)e * 1024 + 32 * nb) * 1024 + k0;
    } else { const int r2 = it - 32 * 16 * 32, e = r2 >> 8, q = r2 & 255, kb = q >> 5, nb = q & 31, k0 = 64 * kb + 32 * hk;
        r.src = a.in[IN_WED] + (size_t)e * 512 * 1024 + (size_t)k0 * 1024 + 32 * nb; r.ldw = 1024; r.K = 512;
        r.dst = (bf16*)(a.ws + WS_DN) + ((size_t)e * 1024 + 32 * nb) * 512 + k0; }
    return r;
}
__device__ __forceinline__ void cv_load(const CvItem& it, f32x4 (&v)[4], int lane) {
#pragma unroll
    for (int i = 0; i < 4; ++i) v[i] = *(const f32x4*)(it.src + (size_t)(8 * i + (lane >> 3)) * it.ldw + 4 * (lane & 7));
}
__device__ __forceinline__ void cv_finish(const CvItem& it, const f32x4 (&v)[4], LAS float* scr, int lane, bool valid) {
#pragma unroll
    for (int i = 0; i < 4; ++i) { LAS float* d = scr + (8 * i + (lane >> 3)) * 33 + 4 * (lane & 7); d[0] = v[i][0]; d[1] = v[i][1]; d[2] = v[i][2]; d[3] = v[i][3]; }
    LDS_WAIT(); asm volatile("" ::: "memory");
#pragma unroll
    for (int j = 0; j < 2; ++j) { const int n = (lane >> 2) + 16 * j, cq = lane & 3; const LAS float* sp = scr + (8 * cq) * 33 + n;
        v4u o; o.x = pk2(sp[0 * 33], sp[1 * 33]); o.y = pk2(sp[2 * 33], sp[3 * 33]); o.z = pk2(sp[4 * 33], sp[5 * 33]); o.w = pk2(sp[6 * 33], sp[7 * 33]);
        if (valid) *(v4u*)(it.dst + (size_t)n * it.K + 8 * cq) = o; }
    LDS_WAIT(); asm volatile("" ::: "memory");
}
template <int MODE>
__device__ __forceinline__ void mlstm_unit(const Args& a, const Ctx& c, int b, int h, int g) {
    const int tid = c.tid, wave = c.wave; LAS unsigned char* lds = c.lds;
#define ML_LAUNDER() int tv_ = tid; asm volatile("" : "+v"(tv_)); const int lane = tv_ & 63, seg = tv_ & 15, r2 = (tv_ >> 4) * 2; (void)lane; (void)seg; (void)r2
    const bf16* PQ = proj_tile(a, TL_MQ + (h >> 1)) + (h & 1) * 128;
    const bf16* PK = proj_tile(a, TL_MK + (h >> 1)) + (h & 1) * 128;
    const bf16* PV = proj_tile(a, TL_MV + (h >> 1)) + (h & 1) * 128;
    const bf16* PO = proj_tile(a, TL_MO + (h >> 1)) + (h & 1) * 128;
    const bf16* PS = (const bf16*)((unsigned char*)a.out + DO_SMB);
    bf16* YML = (bf16*)((unsigned char*)a.out + DO_YML);
    unsigned char* STB = a.ws + WS_MLST; float* MST = (float*)(a.ws + WS_MLST + 256 * ML_STATE_BYTES);
    LAS float* GAa = (LAS float*)(lds + ML_GA); LAS float* GAm = GAa + 64; LAS float* GAw = GAa + 128; LAS float* GAe = GAa + 192;
    LAS float* CWQ = (LAS float*)(lds + ML_CW); LAS float* CWK = CWQ + 512; LAS float* CBQ = CWQ + 1024; LAS float* CBK = CBQ + 128; LAS float* GN = CBK + 128;
    LAS bf16* VTs = (LAS bf16*)(lds + ML_VT);
    { const float* wc = a.in[IN_WCONV]; const int j = tid >> 7, d = tid & 127;
      CWQ[tid] = wc[j * 1024 + h * 128 + d]; CWK[tid] = wc[j * 1024 + 512 + h * 128 + d];
      if (tid < 128) { CBQ[tid] = a.in[IN_BCONV][h * 128 + tid]; CBK[tid] = a.in[IN_BCONV][512 + h * 128 + tid]; GN[tid] = a.in[IN_GML][h * 128 + tid]; } }
    for (int i = tid; i < 16 * 64; i += 512) { const int r = i >> 6, cc = i & 63; VTs[(128 + r) * 72 + cc] = (r == 0) ? (bf16)0x3F80 : (bf16)0; }
    const float big = a.in[IN_BI][h], bfg = a.in[IN_BF][h];
    const int slot0 = (b * 4 + h) * 8;
    f32x4 cacc[9];
    float m_st = 0.f;
    if (MODE == 1 && g > 0) { ML_LAUNDER();
        const f32x4* sp = (const f32x4*)(STB + (size_t)(slot0 + g) * ML_STATE_BYTES) + wave * 576 + lane;
#pragma unroll
        for (int i = 0; i < 9; ++i) cacc[i] = sp[64 * i];
        m_st = MST[slot0 + g];
#pragma unroll
        for (int ee = 0; ee < 9; ++ee) { v2u w; w.x = pk2(cacc[ee][0], cacc[ee][1]); w.y = pk2(cacc[ee][2], cacc[ee][3]);
            *(LAS v2u*)(lds + ML_CT + (ee * 16 + (lane & 15)) * 272 + (wave * 16 + 4 * (lane >> 4)) * 2) = w; }
    } else {
#pragma unroll
        for (int i = 0; i < 9; ++i) cacc[i] = (f32x4){0.f, 0.f, 0.f, 0.f};
        for (int i = tid; i < 144 * 136 / 2; i += 512) ((LAS unsigned*)(lds + ML_CT))[i] = 0u;
    }
    const size_t tb = (size_t)b * SEQ;
    const char* bq = (const char*)(PQ + tb * 256); const char* bk = (const char*)(PK + tb * 256); const char* bv = (const char*)(PV + tb * 256); const char* bo = (const char*)(PO + tb * 256); const char* bs = (const char*)(PS + tb * 16);
    v4u rq[5], rk[5], rv[2]; unsigned short gi = 0, gf = 0;
#define ML_LOAD(kc) do { _Pragma("unroll") for (int j_ = 0; j_ < 5; ++j_) { const int rr_ = 64 * (kc) + r2 - 3 + j_; const unsigned o_ = (unsigned)((rr_ < 0 ? 0 : rr_) * 512 + seg * 16); \
            v4u q_ = (v4u){0u, 0u, 0u, 0u}; if (MODE == 1) q_ = *(const v4u*)(bq + o_); v4u k_ = *(const v4u*)(bk + o_); if (rr_ < 0) { q_ = (v4u){0u, 0u, 0u, 0u}; k_ = q_; } rq[j_] = q_; rk[j_] = k_; } \
        _Pragma("unroll") for (int i_ = 0; i_ < 2; ++i_) rv[i_] = *(const v4u*)(bv + (unsigned)((64 * (kc) + r2 + i_) * 512 + seg * 16)); \
        gi = *(const unsigned short*)(bs + (unsigned)((64 * (kc) + lane) * 32 + (8 + h) * 2)); gf = *(const unsigned short*)(bs + (unsigned)((64 * (kc) + lane) * 32 + (12 + h) * 2)); } while (0)
    const int kc0 = (MODE == 1) ? 8 * g : 0, kc1 = (MODE == 1) ? 8 * g + 8 : 56;
    { ML_LAUNDER(); ML_LOAD(kc0); }
    const int cv_gw = c.vcu * NWAVES + c.wave, cv_ngw = c.G * NWAVES; f32x4 cvv[4]; CvItem cvi; int cvk = 0; bool cvp = false;
    LAS float* cv_scr = (LAS float*)(lds + CV_SCR + wave * CV_SCRW);
#define CV_SLOT() do { if (MODE == 1) { ML_LAUNDER(); if (cvp) cv_finish(cvi, cvv, cv_scr, lane, cv_gw + (cvk - 1) * cv_ngw < CV_NMI); \
        { int mi_ = cv_gw + cvk * cv_ngw; mi_ = mi_ < CV_NMI ? mi_ : CV_NMI - 1; cvi = cv_item(a, __builtin_amdgcn_readfirstlane(mi_)); cv_load(cvi, cvv, lane); cvp = true; ++cvk; } } } while (0)
    __syncthreads();
#pragma unroll 1
    for (int kc = kc0; kc < kc1; ++kc) {
        float wkv, decay, m_new;
        if (MODE == 0 && kc > 0 && (kc & 7) == 0) { ML_LAUNDER();
            f32x4* sp = (f32x4*)(STB + (size_t)(slot0 + (kc >> 3)) * ML_STATE_BYTES) + wave * 576 + lane;
#pragma unroll
            for (int i = 0; i < 9; ++i) sp[64 * i] = cacc[i];
            if (tid == 0) MST[slot0 + (kc >> 3)] = m_st; }
        CV_SLOT();
        { ML_LAUNDER();
        const float fpre = bf2f(gf) + bfg, lf = fminf(fpre, 0.f) - log1pf(__expf(-fabsf(fpre)));
        const float ig = bf2f(gi) + big;
#define ML_SHR(x_, n_, id_) __int_as_float(__builtin_amdgcn_update_dpp(__float_as_int(id_), __float_as_int(x_), 0x110 + (n_), 0xF, 0xF, false))
        float bc = lf;
        bc += ML_SHR(bc, 1, 0.f); bc += ML_SHR(bc, 2, 0.f); bc += ML_SHR(bc, 4, 0.f); bc += ML_SHR(bc, 8, 0.f);
        { const float t0 = __int_as_float(__builtin_amdgcn_readlane(__float_as_int(bc), 15)), t1 = __int_as_float(__builtin_amdgcn_readlane(__float_as_int(bc), 31)), t2 = __int_as_float(__builtin_amdgcn_readlane(__float_as_int(bc), 47));
          bc += (lane >= 48) ? (t0 + t1 + t2) : ((lane >= 32) ? (t0 + t1) : ((lane >= 16) ? t0 : 0.f)); }
        const float av = ig - bc; float Ac = av;
        Ac = fmaxf(Ac, ML_SHR(Ac, 1, -3.0e38f)); Ac = fmaxf(Ac, ML_SHR(Ac, 2, -3.0e38f)); Ac = fmaxf(Ac, ML_SHR(Ac, 4, -3.0e38f)); Ac = fmaxf(Ac, ML_SHR(Ac, 8, -3.0e38f));
        { const float t0 = __int_as_float(__builtin_amdgcn_readlane(__float_as_int(Ac), 15)), t1 = __int_as_float(__builtin_amdgcn_readlane(__float_as_int(Ac), 31)), t2 = __int_as_float(__builtin_amdgcn_readlane(__float_as_int(Ac), 47));
          const float m01 = fmaxf(t0, t1), m012 = fmaxf(m01, t2);
          Ac = fmaxf(Ac, (lane >= 48) ? m012 : ((lane >= 32) ? m01 : ((lane >= 16) ? t0 : -3.0e38f))); }
#undef ML_SHR
        const float mA = fmaxf(m_st, Ac), Mk = __int_as_float(__builtin_amdgcn_readlane(__float_as_int(mA), 63)), blast = __int_as_float(__builtin_amdgcn_readlane(__float_as_int(bc), 63));
        wkv = __expf(av - Mk); decay = __expf(m_st - Mk); m_new = blast + Mk;
        if (MODE == 1 && wave == 0) { GAa[lane] = av; GAm[lane] = mA; GAw[lane] = __expf(m_st - mA); GAe[lane] = __expf(-(bc + mA)); } }
#ifndef DBG_MLB
#define DBG_MLB 1
#endif
#ifndef DBG_MLF
#define DBG_MLF 1
#endif
        _Pragma("unroll 1") for (int pb_ = 0; pb_ < DBG_MLB; ++pb_)
        { ML_LAUNDER(); float kw_[2][8];
#pragma unroll
          for (int i = 0; i < 2; ++i) { const int t = r2 + i; const float wkt = __shfl(wkv, t);
            float aq_[8], ak_[8];
            { const f32x4 b0 = *(const LAS f32x4*)(CBQ + seg * 8), b1 = *(const LAS f32x4*)(CBQ + seg * 8 + 4), c0 = *(const LAS f32x4*)(CBK + seg * 8), c1 = *(const LAS f32x4*)(CBK + seg * 8 + 4);
              aq_[0] = b0[0]; aq_[1] = b0[1]; aq_[2] = b0[2]; aq_[3] = b0[3]; aq_[4] = b1[0]; aq_[5] = b1[1]; aq_[6] = b1[2]; aq_[7] = b1[3];
              ak_[0] = c0[0]; ak_[1] = c0[1]; ak_[2] = c0[2]; ak_[3] = c0[3]; ak_[4] = c1[0]; ak_[5] = c1[1]; ak_[6] = c1[2]; ak_[7] = c1[3]; }
#pragma unroll
            for (int j = 0; j < 4; ++j) { float fk_[8]; unpack8(rk[i + j], fk_);
                const f32x4 x0 = *(const LAS f32x4*)(CWK + j * 128 + seg * 8), x1 = *(const LAS f32x4*)(CWK + j * 128 + seg * 8 + 4);
#pragma unroll
                for (int e = 0; e < 4; ++e) { ak_[e] += x0[e] * fk_[e]; ak_[4 + e] += x1[e] * fk_[4 + e]; }
                if (MODE == 1) { float fq_[8]; unpack8(rq[i + j], fq_);
                    const f32x4 w0 = *(const LAS f32x4*)(CWQ + j * 128 + seg * 8), w1 = *(const LAS f32x4*)(CWQ + j * 128 + seg * 8 + 4);
#pragma unroll
                    for (int e = 0; e < 4; ++e) { aq_[e] += w0[e] * fq_[e]; aq_[4 + e] += w1[e] * fq_[4 + e]; } } }
#pragma unroll
            for (int e = 0; e < 8; ++e) { ak_[e] = ak_[e] * sigm(ak_[e]) * 0.08838834764831845f; kw_[i][e] = ak_[e] * wkt; }
            if (MODE == 1) {
#pragma unroll
                for (int e = 0; e < 8; ++e) aq_[e] = aq_[e] * sigm(aq_[e]);
                *(LAS v4u*)(lds + ML_QS + t * 272 + seg * 16) = pack8(aq_);
                *(LAS v4u*)(lds + ML_KS + t * 272 + seg * 16) = pack8(ak_); } }
          const unsigned va[4] = {rv[0].x, rv[0].y, rv[0].z, rv[0].w}, vb[4] = {rv[1].x, rv[1].y, rv[1].z, rv[1].w};
          const int swo = 16 * (((r2 >> 3) + seg) & 7) + 2 * (r2 & 7);
#pragma unroll
          for (int e = 0; e < 8; ++e) { const int ro = (seg * 8 + e) * 144 + swo;
              *(LAS unsigned*)(lds + ML_KWT + ro) = pk2(kw_[0][e], kw_[1][e]);
              const unsigned lo = (e & 1) ? (va[e >> 1] >> 16) : (va[e >> 1] & 0xffffu), hi = (e & 1) ? (vb[e >> 1] >> 16) : (vb[e >> 1] & 0xffffu);
              *(LAS unsigned*)(lds + ML_VT + ro) = lo | (hi << 16); } }
        { ML_LAUNDER(); if (kc + 1 < kc1) ML_LOAD(kc + 1); }
        __syncthreads();
        f32x4 hacc[5]; unsigned mo_r[8];
        const int tt = wave & 3, t0 = tt * 16, ne = (wave < 4) ? 5 : 4, e_first = (wave < 4) ? 0 : 5;
        CV_SLOT();
        if (MODE == 1) {
        { ML_LAUNDER(); const int tq = t0 + (lane & 15);
        bf16x8 qf[4];
#pragma unroll
        for (int ks = 0; ks < 4; ++ks) qf[ks] = lds_frag(lds + ML_QS, 272, t0, ks * 64, lane);
        const float mAt = GAm[tq], wit = GAw[tq];
#pragma unroll
        for (int si = 0; si < 2; ++si) { const int ss = 2 * (wave >> 2) + si, s0 = ss * 16; f32x4 sacc = (f32x4){0.f, 0.f, 0.f, 0.f};
            if (ss <= tt) {
#pragma unroll
                for (int ks = 0; ks < 4; ++ks) sacc = MFMA16(lds_frag(lds + ML_KS, 272, s0, ks * 64, lane), qf[ks], sacc);
#pragma unroll
                for (int r = 0; r < 4; ++r) { const int s = s0 + 4 * (lane >> 4) + r; sacc[r] = (s <= tq) ? sacc[r] * __expf(GAa[s] - mAt) : 0.f; } }
            v2u w; w.x = pk2(sacc[0], sacc[1]); w.y = pk2(sacc[2], sacc[3]);
            *(LAS v2u*)(lds + ML_SW + tq * 144 + s0 * 2 + (lane >> 4) * 8) = w; }
#pragma unroll
        for (int i = 0; i < 5; ++i) { hacc[i] = (f32x4){0.f, 0.f, 0.f, 0.f};
            if (i < ne) {
#pragma unroll
                for (int ks = 0; ks < 4; ++ks) hacc[i] = MFMA16(lds_frag(lds + ML_CT, 272, (e_first + i) * 16, ks * 64, lane), qf[ks], hacc[i]);
                hacc[i] = hacc[i] * wit; } }
#pragma unroll
        for (int i = 0; i < 8; ++i) mo_r[i] = *(const unsigned*)(bo + (unsigned)((64 * kc + 8 * wave + i) * 512 + 4 * lane)); }
        __syncthreads();
        { ML_LAUNDER(); const int tq = t0 + (lane & 15); bf16x8 swf[2];
#pragma unroll
          for (int ks = 0; ks < 2; ++ks) swf[ks] = lds_frag(lds + ML_SW, 144, t0, ks * 64, lane);
#pragma unroll
          for (int i = 0; i < 5; ++i) if (i < ne) { const int ee = e_first + i;
#pragma unroll
              for (int ks = 0; ks < 2; ++ks) hacc[i] = MFMA16(lds_frag_sw(lds + ML_VT, ee * 16, ks, lane), swf[ks], hacc[i]);
              if (ee < 8) *(LAS f32x4*)(lds + ML_HS + tq * 528 + (ee * 16 + 4 * (lane >> 4)) * 4) = hacc[i];
              else if ((lane >> 4) == 0) *(LAS float*)(lds + ML_HS + tq * 528 + 128 * 4) = hacc[i][0]; } }
        }
        CV_SLOT();
        { ML_LAUNDER(); const int d0 = wave * 16; bf16x8 kwf[2];
#pragma unroll
          for (int ks = 0; ks < 2; ++ks) kwf[ks] = lds_frag_sw(lds + ML_KWT, d0, ks, lane);
#pragma unroll
          for (int ee = 0; ee < 9; ++ee) { cacc[ee] = cacc[ee] * decay;
#pragma unroll
              for (int ks = 0; ks < 2; ++ks) cacc[ee] = MFMA16(kwf[ks], lds_frag_sw(lds + ML_VT, ee * 16, ks, lane), cacc[ee]);
              if (MODE == 1) { v2u w; w.x = pk2(cacc[ee][0], cacc[ee][1]); w.y = pk2(cacc[ee][2], cacc[ee][3]);
                  *(LAS v2u*)(lds + ML_CT + (ee * 16 + (lane & 15)) * 272 + (d0 + 4 * (lane >> 4)) * 2) = w; } } }
        __syncthreads();
        if (MODE == 1) {
        _Pragma("unroll 1") for (int pf_ = 0; pf_ < DBG_MLF; ++pf_)
        { ML_LAUNDER();
#pragma unroll
        for (int i = 0; i < 8; ++i) { const int t = 8 * wave + i;
            const f32x2 nv = *(const LAS f32x2*)(lds + ML_HS + t * 528 + lane * 8); const float den = *(const LAS float*)(lds + ML_HS + t * 528 + 512);
            const float dd = __builtin_amdgcn_rcpf(fmaxf(fabsf(den), GAe[t])); const float h0 = nv.x * dd, h1 = nv.y * dd;
            const float r = rsqrtf(wave_sum(h0 * h0 + h1 * h1) * (1.f / 128.f) + EPS);
            const float y0 = h0 * r * GN[2 * lane] * sigm(bf2f(mo_r[i] & 0xffffu)), y1 = h1 * r * GN[2 * lane + 1] * sigm(bf2f(mo_r[i] >> 16));
            *(unsigned*)(YML + (tb + 64 * kc + t) * 512 + h * 128 + 2 * lane) = pk2(y0, y1); } }
        __syncthreads();
        }
        m_st = m_new;
    }
    if (MODE == 1) { ML_LAUNDER(); if (cvp) cv_finish(cvi, cvv, cv_scr, lane, cv_gw + (cvk - 1) * cv_ngw < CV_NMI); }
#undef CV_SLOT
    if (MODE == 0) { ML_LAUNDER();
        f32x4* sp = (f32x4*)(STB + (size_t)(slot0 + 7) * ML_STATE_BYTES) + wave * 576 + lane;
#pragma unroll
        for (int i = 0; i < 9; ++i) sp[64 * i] = cacc[i];
        if (tid == 0) MST[slot0 + 7] = m_st; }
#undef ML_LOAD
#undef ML_LAUNDER
}
constexpr int AT_HIST = 0;
constexpr int AT_HROW = 2049;
constexpr int AT_SEL = 131072 + 256;
constexpr int AT_MROW = 129;
constexpr int AT_SM = AT_SEL + 8448;
constexpr int AT_LUT = AT_SM + 256;
constexpr int AT_SEL2 = AT_LUT + 256;
static_assert(AT_SEL2 + 8448 <= MISC_OFF, "attention LDS map");
__device__ __forceinline__ unsigned at_bin(float s, float inv) { const float x = __builtin_fmaf(s, inv, 1024.0f); return (unsigned)(int)__builtin_amdgcn_fmed3f(x, 0.0f, 2047.0f); }
__device__ __forceinline__ unsigned score_key(float s) { unsigned u = __float_as_uint(s + 0.0f); return (u & 0x80000000u) ? ~u : (u | 0x80000000u); }
__device__ __forceinline__ unsigned wave_suffix_sum(unsigned v, int lane) {
#define AT_SHL(x_, n_) ((unsigned)__builtin_amdgcn_update_dpp(0, (int)(x_), 0x100 + (n_), 0xF, 0xF, false))
    v += AT_SHL(v, 1); v += AT_SHL(v, 2); v += AT_SHL(v, 4); v += AT_SHL(v, 8);
#undef AT_SHL
    const unsigned t1 = (unsigned)__builtin_amdgcn_readlane((int)v, 16), t2 = (unsigned)__builtin_amdgcn_readlane((int)v, 32), t3 = (unsigned)__builtin_amdgcn_readlane((int)v, 48);
    return v + ((lane < 16) ? (t1 + t2 + t3) : ((lane < 32) ? (t2 + t3) : ((lane < 48) ? t3 : 0u)));
}
template <int NK> __device__ __forceinline__ void at_resolve2(const LAS unsigned long long* candA, LAS unsigned* maskA, int mA, int ndA,
                                                              const LAS unsigned long long* candB, LAS unsigned* maskB, int mB, int ndB, int lane) {
    unsigned long long ca[NK], cb[NK];
#pragma unroll
    for (int k = 0; k < NK; ++k) { const int i = 64 * k + lane; unsigned long long x = 0ull, y = 0ull; if (i < mA) x = candA[i]; if (i < mB) y = candB[i];
        ca[k] = (i < mA) ? (((x >> 32) << 16) | (x & 0xFFFFull)) : 0ull; cb[k] = (i < mB) ? (((y >> 32) << 16) | (y & 0xFFFFull)) : 0ull; }
    unsigned long long TA = 0ull, TB = 0ull;
#pragma unroll 1
    for (int bit = 47; bit >= 16; --bit) { const unsigned long long ta = TA | (1ull << bit), tb = TB | (1ull << bit); int ga = 0, gb = 0;
#pragma unroll
        for (int k = 0; k < NK; ++k) { ga += __popcll(__ballot(ca[k] >= ta)); gb += __popcll(__ballot(cb[k] >= tb)); }
        if (ga >= ndA) TA = ta; if (gb >= ndB) TB = tb; }
    int gA = 0, tA = 0, gB = 0, tB = 0;
#pragma unroll
    for (int k = 0; k < NK; ++k) { gA += __popcll(__ballot(ca[k] >= TA + 0x10000ull)); tA += __popcll(__ballot(ca[k] >= TA)); gB += __popcll(__ballot(cb[k] >= TB + 0x10000ull)); tB += __popcll(__ballot(cb[k] >= TB)); }
    tA -= gA; tB -= gB;
    if (tA > ndA - gA || tB > ndB - gB) {
#pragma unroll 1
        for (int bit = 15; bit >= 0; --bit) { const unsigned long long ta = TA | (1ull << bit), tb = TB | (1ull << bit); int ga = 0, gb = 0;
#pragma unroll
            for (int k = 0; k < NK; ++k) { ga += __popcll(__ballot(ca[k] >= ta)); gb += __popcll(__ballot(cb[k] >= tb)); }
            if (ga >= ndA) TA = ta; if (gb >= ndB) TB = tb; } }
#pragma unroll
    for (int k = 0; k < NK; ++k) {
        if (ca[k] >= TA && ca[k] != 0ull) { const unsigned key = 0xFFFFu - (unsigned)(ca[k] & 0xFFFFull);
            __hip_atomic_fetch_or(&maskA[key >> 5], 1u << (key & 31u), __ATOMIC_RELAXED, __HIP_MEMORY_SCOPE_WORKGROUP); }
        if (cb[k] >= TB && cb[k] != 0ull) { const unsigned key = 0xFFFFu - (unsigned)(cb[k] & 0xFFFFull);
            __hip_atomic_fetch_or(&maskB[key >> 5], 1u << (key & 31u), __ATOMIC_RELAXED, __HIP_MEMORY_SCOPE_WORKGROUP); } }
}
__device__ __forceinline__ void attn_unit(const Args& a, const Ctx& c, int b, int qt, float cshift) {
    const int tid = c.tid, wave = c.wave; LAS unsigned char* lds = c.lds;
#define AT_LAUNDER() int tv_ = tid; asm volatile("" : "+v"(tv_)); const int lane = tv_ & 63, qi = tv_ & 15, fq = (tv_ >> 4) & 3; (void)lane; (void)qi; (void)fq
    const int q0u = qt * 32, ch = q0u >> 6, n = 64 * (ch + 1), ntiles = n >> 4;
    const size_t tb = (size_t)b * SEQ;
    unsigned char* dout = (unsigned char*)a.out;
    const bf16* AQN = (const bf16*)(dout + DO_AQN); const bf16* KN = (const bf16*)(dout + DO_KN); const bf16* IQR = (const bf16*)(dout + DO_IQR); const bf16* IKR = (const bf16*)(dout + DO_IKR);
    bf16* YATT = (bf16*)(dout + DO_YATT);
    const bf16* VB = proj_tile(a, TL_KV); const bf16* PS = (const bf16*)(dout + DO_SMB);
    LAS unsigned* HIST = (LAS unsigned*)(lds + AT_HIST);
    LAS unsigned long long* CAND = (LAS unsigned long long*)(lds + AT_HIST);
    LAS int* SM = (LAS int*)(lds + AT_SM);
    float* SC = (blockIdx.x < 240) ? (float*)(a.ws + WS_SC) + (size_t)blockIdx.x * (16 * 4096) : (float*)(a.ws + WS_SC2) + (size_t)(blockIdx.x - 240) * (16 * 4096);
#ifndef DBG_REP_DENSE
#define DBG_REP_DENSE 1
#endif
#pragma unroll 1
    for (int rsel = 0; rsel < 2; ++rsel) {
    const int q0 = q0u + 16 * rsel;
    LAS unsigned* MASK = (LAS unsigned*)(lds + (rsel ? AT_SEL2 : AT_SEL));
    if (n > 256) {
        for (int i = tid; i < 8192 + 4; i += 512) ((LAS v4u*)HIST)[i] = (v4u){0u, 0u, 0u, 0u};
        if (tid < 64) SM[tid] = 0;
        for (int i = tid; i < 16 * AT_MROW; i += 512) MASK[i] = 0u;
        bf16x8 qf[8]; float wv[8]; bf16x8 qsh, qsl; float binv;
        { AT_LAUNDER();
        const size_t trow = tb + q0 + qi;
#pragma unroll
        for (int h = 0; h < 8; ++h) qf[h] = *(const bf16x8*)(IQR + trow * 256 + h * 32 + 8 * fq);
        { float t8[8]; unpack8(*(const v4u*)(PS + trow * 16), t8);
#pragma unroll
          for (int h = 0; h < 8; ++h) wv[h] = t8[h] * 0.03125f; }
        { float rq = 0.f;
#pragma unroll
          for (int h = 0; h < 8; ++h) { float f8[8]; unpack8(__builtin_bit_cast(v4u, qf[h]), f8); float q2 = 0.f;
#pragma unroll
            for (int j = 0; j < 8; ++j) q2 = __builtin_fmaf(f8[j], f8[j], q2);
            q2 += __shfl_xor(q2, 16); q2 += __shfl_xor(q2, 32);
            rq = __builtin_fmaf(fabsf(wv[h]), __builtin_sqrtf(q2), rq); }
          const float kmax = __builtin_sqrtf(__uint_as_float(__hip_atomic_load((const unsigned*)(a.ws + WS_CTL) + CW_KMAX + 16 * b, __ATOMIC_RELAXED, __HIP_MEMORY_SCOPE_AGENT)));
          binv = 1024.0f / fmaxf(rq * kmax, 1.0e-30f); }
        { float qs[8];
#pragma unroll
          for (int j = 0; j < 8; ++j) qs[j] = 0.f;
#pragma unroll
          for (int h = 0; h < 8; ++h) { float f8[8]; unpack8(__builtin_bit_cast(v4u, qf[h]), f8);
#pragma unroll
            for (int j = 0; j < 8; ++j) qs[j] = __builtin_fmaf(wv[h], f8[j], qs[j]); }
          float hi8[8], lo8[8]; const v4u ph = pack8(qs); unpack8(ph, hi8);
#pragma unroll
          for (int j = 0; j < 8; ++j) lo8[j] = qs[j] - hi8[j];
          qsh = __builtin_bit_cast(bf16x8, ph); qsl = __builtin_bit_cast(bf16x8, pack8(lo8)); } }
        __syncthreads();
#define AT_LOADK(kt_) (*(const bf16x8*)(IKR + (tb + (size_t)(kt_) * 16 + qi) * 32 + 8 * fq))
#define AT_SCORES(kf_, sc_) do { \
        { const f32x4 l0_ = MFMA16(kf_, qsl, ((f32x4){0.f, 0.f, 0.f, 0.f})); const f32x4 l1_ = MFMA16(kf_, qsh, l0_); \
          _Pragma("unroll") for (int r_ = 0; r_ < 4; ++r_) sc_[r_] = l1_[r_]; } \
        _Pragma("unroll") for (int h_ = 0; h_ < 8; ++h_) { const f32x4 d_ = MFMA16(kf_, qf[h_], ((f32x4){0.f, 0.f, 0.f, 0.f})); \
            _Pragma("unroll") for (int r_ = 0; r_ < 4; ++r_) { sc_[r_] = __builtin_fmaf(wv[h_], __builtin_fabsf(d_[r_]), sc_[r_]); asm("" : "+v"(sc_[r_])); } } } while (0)
        const int cnt = (ntiles - wave + 7) >> 3;
#ifndef DBG_RA
#define DBG_RA 1
#endif
#pragma unroll 1
        for (int rA = 0; rA < DBG_RA; ++rA) { if (rA) { for (int i = tid; i < 8192 + 4; i += 512) ((LAS v4u*)HIST)[i] = (v4u){0u, 0u, 0u, 0u}; __syncthreads(); }
#define AT_LOADG(dst_, i0_) do { _Pragma("unroll") for (int j_ = 0; j_ < 8; ++j_) { int kt_ = wave + 8 * ((i0_) + j_); kt_ = kt_ < ntiles ? kt_ : ntiles - 1; dst_[j_] = AT_LOADK(kt_); } } while (0)
#define AT_P1GROUP(buf_, base_) do { _Pragma("unroll") for (int j2 = 0; j2 < 8; ++j2) { const bool valid = ((base_) + j2 < cnt); const int kt = wave + 8 * ((base_) + j2); float sc[4]; AT_SCORES(buf_[j2], sc); \
                if (valid) *(f32x4*)(SC + qi * 4096 + kt * 16 + 4 * fq) = (f32x4){sc[0], sc[1], sc[2], sc[3]}; \
                _Pragma("unroll") for (int r = 0; r < 4; ++r) { const unsigned bin = at_bin(sc[r], binv); \
                    __hip_atomic_fetch_add(&HIST[qi * AT_HROW + bin], valid ? 1u : 0u, __ATOMIC_RELAXED, __HIP_MEMORY_SCOPE_WORKGROUP); } } } while (0)
        { AT_LAUNDER(); bf16x8 ka[8], kb[8]; AT_LOADG(ka, 0);
#pragma unroll 1
          for (int i0 = 0; i0 < cnt; i0 += 16) {
            AT_LOADG(kb, i0 + 8);
            AT_P1GROUP(ka, i0);
            AT_LOADG(ka, i0 + 16);
            AT_P1GROUP(kb, i0 + 8); } }
#undef AT_P1GROUP
        __syncthreads();
        }
#ifndef DBG_RB
#define DBG_RB 1
#endif
#pragma unroll 1
        for (int rB = 0; rB < DBG_RB; ++rB) {
        { AT_LAUNDER(); const int qa_ = 2 * wave, qb_ = qa_ + 1; unsigned ta = 0, tb = 0;
            for (int i = 0; i < 32; ++i) { const int o = 32 * lane + ((i + lane) & 31); ta += HIST[qa_ * AT_HROW + o]; tb += HIST[qb_ * AT_HROW + o]; }
            const unsigned sa_ = wave_suffix_sum(ta, lane), sb_ = wave_suffix_sum(tb, lane);
            const int La = 63 - __clzll((long long)__ballot(sa_ >= 256u)), Lb = 63 - __clzll((long long)__ballot(sb_ >= 256u));
            const unsigned abA = (unsigned)__builtin_amdgcn_readlane((int)(sa_ - ta), La), abB = (unsigned)__builtin_amdgcn_readlane((int)(sb_ - tb), Lb);
            const unsigned ca_ = (lane < 32) ? HIST[qa_ * AT_HROW + 32 * La + lane] : 0u, cb_ = (lane < 32) ? HIST[qb_ * AT_HROW + 32 * Lb + lane] : 0u;
            const unsigned fa_ = wave_suffix_sum(ca_, lane), fb_ = wave_suffix_sum(cb_, lane);
            const int la2 = 63 - __clzll((long long)__ballot(abA + fa_ >= 256u)), lb2 = 63 - __clzll((long long)__ballot(abB + fb_ >= 256u));
            if (lane == la2) { SM[qa_] = 32 * La + la2; SM[16 + qa_] = (int)(256u - (abA + fa_ - ca_)); }
            if (lane == lb2) { SM[qb_] = 32 * Lb + lb2; SM[16 + qb_] = (int)(256u - (abB + fb_ - cb_)); } }
        __syncthreads();
        }
#ifndef DBG_RC
#define DBG_RC 1
#endif
#pragma unroll 1
        for (int rC = 0; rC < DBG_RC; ++rC) { if (rC) { if (tid < 16) SM[48 + tid] = 0; __syncthreads(); }
        { AT_LAUNDER(); const int Bq = SM[qi]; f32x4 scur[8];
          const float loF = (Bq <= 0) ? -__builtin_inff() : (float)Bq, hiF = (Bq >= 2047) ? __builtin_inff() : (float)(Bq + 1);
#define AT_LOADS(dst_, i0_) do { _Pragma("unroll") for (int j_ = 0; j_ < 8; ++j_) { int kt_ = wave + 8 * ((i0_) + j_); kt_ = kt_ < ntiles ? kt_ : ntiles - 1; dst_[j_] = *(const f32x4*)(SC + qi * 4096 + kt_ * 16 + 4 * fq); } } while (0)
#define AT_P2GROUP(buf_, base_) do { _Pragma("unroll") for (int j2 = 0; j2 < 8; ++j2) { const bool valid = ((base_) + j2 < cnt); const int kt = wave + 8 * ((base_) + j2); \
                unsigned nib = 0u, cnib = 0u; unsigned uu[4]; \
                _Pragma("unroll") for (int r = 0; r < 4; ++r) { uu[r] = __float_as_uint(buf_[j2][r]); const float x_ = __builtin_fmaf(buf_[j2][r], binv, 1024.0f); const bool hi_ = x_ >= hiF; nib |= hi_ ? (1u << r) : 0u; cnib |= (x_ >= loF && !hi_) ? (1u << r) : 0u; } \
                if (!valid) { nib = 0u; cnib = 0u; } \
                if (cnib) { int p = __hip_atomic_fetch_add(&SM[48 + qi], (int)__popc(cnib), __ATOMIC_RELAXED, __HIP_MEMORY_SCOPE_WORKGROUP); \
                    _Pragma("unroll") for (int r = 0; r < 4; ++r) if ((cnib >> r) & 1u) { if (p < 512) CAND[qi * 1024 + p] = ((unsigned long long)score_key(__uint_as_float(uu[r])) << 32) | (unsigned long long)(0xFFFFu - (unsigned)(kt * 16 + 4 * fq + r)); ++p; } } \
                if (nib) __hip_atomic_fetch_or(&MASK[qi * AT_MROW + (kt >> 1)], nib << (16 * (kt & 1) + 4 * fq), __ATOMIC_RELAXED, __HIP_MEMORY_SCOPE_WORKGROUP); } } while (0)
          f32x4 sb2[8];
          AT_LOADS(scur, 0);
#pragma unroll 1
          for (int i0 = 0; i0 < cnt; i0 += 16) {
            AT_LOADS(sb2, i0 + 8);
            AT_P2GROUP(scur, i0);
            AT_LOADS(scur, i0 + 16);
            AT_P2GROUP(sb2, i0 + 8); } }
#undef AT_P2GROUP
#undef AT_LOADS
        __syncthreads();
        }
#ifndef DBG_RD
#define DBG_RD 1
#endif
#pragma unroll 1
        for (int rD = 0; rD < DBG_RD; ++rD) {
        { AT_LAUNDER(); const int qa_ = 2 * wave, qb_ = 2 * wave + 1; int ma = SM[48 + qa_], mb = SM[48 + qb_]; ma = ma < 512 ? ma : 512; mb = mb < 512 ? mb : 512; const int nda = SM[16 + qa_], ndb = SM[16 + qb_];
            const int mm = ma > mb ? ma : mb;
            if (mm <= 64) at_resolve2<1>(CAND + qa_ * 1024, MASK + qa_ * AT_MROW, ma, nda, CAND + qb_ * 1024, MASK + qb_ * AT_MROW, mb, ndb, lane);
            else if (mm <= 256) at_resolve2<4>(CAND + qa_ * 1024, MASK + qa_ * AT_MROW, ma, nda, CAND + qb_ * 1024, MASK + qb_ * AT_MROW, mb, ndb, lane);
            else at_resolve2<8>(CAND + qa_ * 1024, MASK + qa_ * AT_MROW, ma, nda, CAND + qb_ * 1024, MASK + qb_ * AT_MROW, mb, ndb, lane); }
        __syncthreads();
        }
#undef AT_SCORES
#undef AT_LOADK
#undef AT_LOADG
    } else {
#pragma unroll 1
        for (int i = tid; i < 16 * AT_MROW; i += 512) MASK[i] = ((i % AT_MROW) < (n >> 5)) ? 0xFFFFFFFFu : 0u;
        __syncthreads();
    }
    }
#pragma unroll 1
    for (int rden = 0; rden < DBG_REP_DENSE; ++rden) {
    { const int g = wave >> 2, qh = (wave >> 1) & 1, hp = wave & 1, NS = n >> 6;
      const unsigned ring0 = (unsigned)(size_t)(lds + AT_HIST);
      if (tid < 64) *(LAS float*)(lds + AT_LUT + 4 * tid) = ((tid >> 2) >> (tid & 3)) & 1 ? -cshift : -1.0e30f;
      const bf16* dsrc[4]; unsigned ddst[4];
      { AT_LAUNDER();
#pragma unroll
        for (int i_ = 0; i_ < 4; ++i_) { const int in_ = 4 * wave + i_; const int row_ = 4 * (in_ & 15) + (lane >> 4), pos_ = lane & 15;
            dsrc[i_] = (in_ < 16) ? (KN + (tb + row_) * 128 + ((pos_ ^ (row_ & 15)) << 3)) : (VB + (tb + row_) * 256 + 128 + ((pos_ ^ (2 * (row_ & 7))) << 3));
            ddst[i_] = (unsigned)(in_ * 1024); } }
      const size_t dstep = (wave < 4) ? (size_t)64 * 128 : (size_t)64 * 256;
#define AT_STAGE(s_) do { const unsigned sb_ = ring0 + (unsigned)(((s_) & 3) * 32768); \
        _Pragma("unroll") for (int i_ = 0; i_ < 4; ++i_) { const bf16* src_ = dsrc[i_] + (size_t)(s_) * dstep; \
            const unsigned dst_ = __builtin_amdgcn_readfirstlane(sb_ + ddst[i_]); unsigned keep_; \
            asm volatile("s_mov_b32 %0, m0\n\ts_mov_b32 m0, %2\n\ts_nop 0\n\tglobal_load_lds_dwordx4 %1, off\n\ts_mov_b32 m0, %0" : "=&s"(keep_) : "v"(src_), "s"(dst_) : "memory"); } } while (0)
      bf16x8 qa[2], qb[2]; f32x4 oacc[2][4], lacc[2];
      { AT_LAUNDER();
#pragma unroll
        for (int hi = 0; hi < 2; ++hi) { const bf16* qp = AQN + (tb + q0u + 16 * qh + qi) * 512 + (g * 4 + 2 * hp + hi) * 64 + 8 * fq; qa[hi] = *(const bf16x8*)qp; qb[hi] = *(const bf16x8*)(qp + 32); } }
#pragma unroll
      for (int hi = 0; hi < 2; ++hi) { lacc[hi] = (f32x4){0.f, 0.f, 0.f, 0.f};
#pragma unroll
        for (int dt = 0; dt < 4; ++dt) oacc[hi][dt] = (f32x4){0.f, 0.f, 0.f, 0.f}; }
      const bf16x8 ones = (bf16x8){0x3F80, 0x3F80, 0x3F80, 0x3F80, 0x3F80, 0x3F80, 0x3F80, 0x3F80};
      asm volatile("s_waitcnt vmcnt(0)" ::: "memory");
#pragma unroll 1
      for (int s = 0; s < 3 && s < NS; ++s) AT_STAGE(s);
      typedef short s4_t __attribute__((ext_vector_type(4)));
      AT_LAUNDER();
      const LAS unsigned* mrow = (const LAS unsigned*)(lds + (qh ? AT_SEL2 : AT_SEL)) + qi * AT_MROW;
      const unsigned koff0 = (unsigned)(qi * 256 + (((g * 8 + fq) ^ qi) << 4)), koff1 = (unsigned)(qi * 256 + (((g * 8 + 4 + fq) ^ qi) << 4));
#define AT_LDK(kf_, ci_, slot_, tp_, mw_) do { const LAS unsigned char* kb_ = lds + AT_HIST + (slot_) * 32768 + (tp_) * 8192; \
          _Pragma("unroll") for (int t = 0; t < 2; ++t) { kf_[t][0] = *(const LAS bf16x8*)(kb_ + t * 4096 + koff0); kf_[t][1] = *(const LAS bf16x8*)(kb_ + t * 4096 + koff1); \
              ci_[t] = *(const LAS f32x4*)(lds + AT_LUT + ((((mw_) >> (16 * t + 4 * fq)) & 15u) << 4)); } } while (0)
#define AT_LDV(va_, slot_, vkh_) do { const LAS unsigned char* vb_ = lds + AT_HIST + (slot_) * 32768 + 16384 + (vkh_) * 8192; \
          _Pragma("unroll") for (int dt = 0; dt < 4; ++dt) { const int r1 = 4 * fq + (qi >> 2); const int ch_ = g * 8 + 2 * dt + ((lane & 3) >> 1); \
              const s4_t lo = __builtin_amdgcn_ds_read_tr16_b64_v4i16((LAS s4_t*)(vb_ + r1 * 256 + ((ch_ ^ (2 * (r1 & 7))) << 4) + (lane & 1) * 8)); \
              const s4_t hi4 = __builtin_amdgcn_ds_read_tr16_b64_v4i16((LAS s4_t*)(vb_ + (r1 + 16) * 256 + ((ch_ ^ (2 * (r1 & 7))) << 4) + (lane & 1) * 8)); \
              va_[dt] = (bf16x8){lo[0], lo[1], lo[2], lo[3], hi4[0], hi4[1], hi4[2], hi4[3]}; } } while (0)
#define AT_QKM(dst_, kf_, ci_) do { \
          _Pragma("unroll") for (int t = 0; t < 2; ++t) { \
              _Pragma("unroll") for (int hi = 0; hi < 2; ++hi) { const f32x4 d_ = MFMA16(kf_[t][0], qa[hi], ci_[t]); dst_[hi][t] = MFMA16(kf_[t][1], qb[hi], d_); } } } while (0)
#define AT_EXP(pb_, cur_) do { \
          _Pragma("unroll") for (int hi = 0; hi < 2; ++hi) { float pv[8]; \
              _Pragma("unroll") for (int j = 0; j < 8; ++j) pv[j] = __builtin_amdgcn_exp2f(cur_[hi][j >> 2][j & 3]); \
              v4u pw; pw.x = pk2(pv[0], pv[1]); pw.y = pk2(pv[2], pv[3]); pw.z = pk2(pv[4], pv[5]); pw.w = pk2(pv[6], pv[7]); pb_[hi] = __builtin_bit_cast(bf16x8, pw); } } while (0)
#define AT_PV(pb_, va_) do { \
          _Pragma("unroll") for (int hi = 0; hi < 2; ++hi) lacc[hi] = MFMA16(ones, pb_[hi], lacc[hi]); \
          _Pragma("unroll") for (int dt = 0; dt < 4; ++dt) { \
              _Pragma("unroll") for (int hi = 0; hi < 2; ++hi) oacc[hi][dt] = MFMA16(va_[dt], pb_[hi], oacc[hi][dt]); } } while (0)
#ifdef DBG_PRIO
      if (wave >= 4) __builtin_amdgcn_s_setprio(1);
#endif
      f32x4 st0[2][2], st1[2][2]; bf16x8 kfA[2][2], kfB[2][2]; f32x4 ciA[2], ciB[2]; bf16x8 vaP[4], vaQ[4], pbP[2], pbQ[2];
      if (NS >= 3) asm volatile("s_waitcnt vmcnt(8)" ::: "memory"); else asm volatile("s_waitcnt vmcnt(0)" ::: "memory");
      __builtin_amdgcn_s_barrier(); asm volatile("" ::: "memory");
      unsigned m1A, m1B;
      { const unsigned m0A = mrow[0], m0B = mrow[1]; const int sx = (NS > 1) ? 1 : 0; m1A = mrow[2 * sx]; m1B = mrow[2 * sx + 1];
        AT_LDK(kfB, ciB, 0, 0, m0A); AT_LDK(kfA, ciA, 0, 1, m0B);
        AT_QKM(st0, kfB, ciB);
#pragma unroll
        for (int hi = 0; hi < 2; ++hi) pbP[hi] = (bf16x8){0, 0, 0, 0, 0, 0, 0, 0};
#pragma unroll
        for (int dt = 0; dt < 4; ++dt) vaP[dt] = (bf16x8){0, 0, 0, 0, 0, 0, 0, 0}; }
#pragma unroll 1
      for (int s = 0; s < NS; ++s) {
          if (s + 2 < NS) asm volatile("s_waitcnt vmcnt(4)" ::: "memory"); else asm volatile("s_waitcnt vmcnt(0)" ::: "memory");
          __builtin_amdgcn_s_barrier(); asm volatile("" ::: "memory");
          if (s + 3 < NS) AT_STAGE(s + 3);
          const int s1 = (s + 1 < NS) ? s + 1 : s, s2 = (s + 2 < NS) ? s + 2 : NS - 1;
          const unsigned m2A = mrow[2 * s2], m2B = mrow[2 * s2 + 1];
          AT_LDK(kfB, ciB, (s1 & 3), 0, m1A); AT_LDV(vaQ, (s & 3), 0);
          AT_QKM(st1, kfA, ciA); AT_EXP(pbQ, st0); AT_PV(pbP, vaP);
          __builtin_amdgcn_sched_barrier(0);
          AT_LDK(kfA, ciA, (s1 & 3), 1, m1B); AT_LDV(vaP, (s & 3), 1);
          AT_QKM(st0, kfB, ciB); AT_EXP(pbP, st1); AT_PV(pbQ, vaQ);
          __builtin_amdgcn_sched_barrier(0);
          m1A = m2A; m1B = m2B; }
      AT_PV(pbP, vaP);
#ifdef DBG_PRIO
      __builtin_amdgcn_s_setprio(0);
#endif
#undef AT_LDK
#undef AT_LDV
#undef AT_QKM
#undef AT_EXP
#undef AT_PV
      { AT_LAUNDER();
#pragma unroll
        for (int hi = 0; hi < 2; ++hi) { const float inv = 1.0f / lacc[hi][0];
            bf16* yp = YATT + (tb + q0u + 16 * qh + qi) * 512 + (g * 4 + 2 * hp + hi) * 64 + 4 * fq;
#pragma unroll
            for (int dt = 0; dt < 4; ++dt) { const f32x4 o = oacc[hi][dt];
                v2u w; w.x = pk2(o[0] * inv, o[1] * inv); w.y = pk2(o[2] * inv, o[3] * inv); *(v2u*)(yp + 16 * dt) = w; } } }
#undef AT_STAGE
    }
    __syncthreads();
    }
#undef AT_LAUNDER
    __syncthreads();
}

#ifndef DBG_REP_ML
#define DBG_REP_ML 1
#endif
#ifndef DBG_REP_ATT
#define DBG_REP_ATT 1
#endif
__device__ __forceinline__ void p3_mixer(const Args& a, const Ctx& c, volatile LAS unsigned* MISC, int rep) {
#if !defined(NO_MLSTM)
#pragma unroll 1
    for (int rr = 0; rr < DBG_REP_ML; ++rr)
#pragma unroll 1
        for (int u = blockIdx.x; u < 32; u += c.G) mlstm_unit<0>(a, c, u >> 2, u & 3, 0);
#endif
    unsigned* ctl = (unsigned*)(a.ws + WS_CTL);
    const int x = (int)(__builtin_amdgcn_s_getreg((3 << 11) | 20) & 7u);
    float cshift;
    { float gq = fabsf(a.in[IN_GQ][c.lane]), gk = fabsf(a.in[IN_GK][c.lane]);
#pragma unroll
      for (int o = 1; o < 64; o <<= 1) { gq = fmaxf(gq, __shfl_xor(gq, o)); gk = fmaxf(gk, __shfl_xor(gk, o)); }
      cshift = 8.0f * 1.4426950408889634f * gq * gk; }
#pragma unroll 1
    for (int rot = 0; rot < 8 * DBG_REP_ATT; ++rot) { rep = rot >> 3; const int bq = (x + rot) & 7;
        if (c.tid == 0) MISC[16] = __hip_atomic_fetch_add(ctl + CW_Q + 512 * rep + 64 * bq, 1u, RLX_AGENT);
        __syncthreads();
        int u = (int)MISC[16];
        __syncthreads();
#pragma unroll 1
        while (u < 128) {
            unsigned nxt = 0u;
            if (c.tid == 0) nxt = __hip_atomic_fetch_add(ctl + CW_Q + 512 * rep + 64 * bq, 1u, RLX_AGENT);
#if !defined(NO_ATTN)
            attn_unit(a, c, bq, 127 - u, cshift);
#endif
            if (c.tid == 0) MISC[16] = nxt;
            __syncthreads();
            u = (int)MISC[16];
            __syncthreads();
        } }
}
constexpr int RT_WT = 0;
constexpr int RT_WROW = 1028;
constexpr int RT_WBYTES = 36 * RT_WROW * 4;
constexpr int RT_NPIECE = (RT_WBYTES + 1023) / 1024;
constexpr int RT_LG = 0;
constexpr int RT_RSTD = RT_NPIECE * 1024;
constexpr int RT_LCNT = RT_RSTD + 512;
constexpr int RT_BIAS = RT_LCNT + 128;
static_assert(RT_BIAS + 144 <= MISC_OFF, "router LDS map");
__device__ __forceinline__ void p6_router(const Args& a, const Ctx& c) {
    const int tid = c.tid, lane = c.lane, wave = c.wave; LAS unsigned char* lds = c.lds;
    LAS float* WT = (LAS float*)(lds + RT_WT); LAS float* LG = (LAS float*)(lds + RT_LG); LAS float* RSTD = (LAS float*)(lds + RT_RSTD); LAS int* LCNT = (LAS int*)(lds + RT_LCNT); LAS float* BIAS = (LAS float*)(lds + RT_BIAS);
    { int* RT = (int*)(a.ws + WS_ROWTOK); for (int i = blockIdx.x * 512 + tid; i < NROWS_MAX; i += c.G * 512) RT[i] = 0; }
    if (tid < 36) BIAS[tid] = tid < 32 ? a.in[IN_BRE][tid] : a.in[IN_BRG][tid - 32];
    f32x4 gv[4];
#pragma unroll
    for (int j = 0; j < 4; ++j) gv[j] = *(const f32x4*)(a.in[IN_GMOE] + 4 * lane + 256 * j);
    const float* X1 = a.out; bf16* XN = (bf16*)(a.ws + WS_XN);
    int* TOKE = (int*)(a.ws + WS_TOKE); int* TOKR = (int*)(a.ws + WS_TOKR); float* TOKG = (float*)(a.ws + WS_TOKG); int* CNT = (int*)(a.ws + WS_CNT);
    for (int blk = blockIdx.x; blk < 256; blk += c.G) {
        __syncthreads();
        { const unsigned char* src = a.ws + WS_WTG;
#pragma unroll 1
          for (int pc = wave; pc < RT_NPIECE; pc += NWAVES)
              __builtin_amdgcn_global_load_lds((const unsigned*)(src + (size_t)pc * 1024 + lane * 16), (LAS unsigned*)(lds + RT_WT + pc * 1024), 16, 0, 0); }
        if (tid < 32) LCNT[tid] = 0;
#pragma unroll 1
        for (int ri = 0; ri < 16; ri += 4) { const int t0 = blk * 128 + wave * 16 + ri;
            f32x4 v[4][4]; float ss[4];
#pragma unroll
            for (int q = 0; q < 4; ++q) { const f32x4* xp = (const f32x4*)(X1 + (size_t)(t0 + q) * D) + lane;
#pragma unroll
                for (int j = 0; j < 4; ++j) v[q][j] = xp[64 * j]; }
#pragma unroll
            for (int q = 0; q < 4; ++q) { float sq = 0.f;
#pragma unroll
                for (int j = 0; j < 4; ++j) sq += (v[q][j].x * v[q][j].x + v[q][j].y * v[q][j].y) + (v[q][j].z * v[q][j].z + v[q][j].w * v[q][j].w);
                ss[q] = rsqrtf(wave_sum(sq) * (1.f / D) + EPS); }
            if (lane < 4) RSTD[wave * 16 + ri + lane] = (lane == 0) ? ss[0] : ((lane == 1) ? ss[1] : ((lane == 2) ? ss[2] : ss[3]));
#pragma unroll
            for (int q = 0; q < 4; ++q) { v2u* op = (v2u*)(XN + (size_t)(t0 + q) * D) + lane; const float r = ss[q];
#pragma unroll
                for (int j = 0; j < 4; ++j) { v2u w; w.x = pk2(v[q][j].x * r * gv[j].x, v[q][j].y * r * gv[j].y); w.y = pk2(v[q][j].z * r * gv[j].z, v[q][j].w * r * gv[j].w); op[64 * j] = w; } } }
        asm volatile("s_waitcnt vmcnt(0)" ::: "memory");
        __syncthreads();
        f32x4 acc[3];
#pragma unroll
        for (int ct = 0; ct < 3; ++ct) acc[ct] = (f32x4){0.f, 0.f, 0.f, 0.f};
        { const int row = lane & 15, kq = lane >> 4;
          const f32x4* ap = (const f32x4*)(X1 + (size_t)(blk * 128 + wave * 16 + row) * D + 4 * kq);
          int cj[3]; cj[0] = row; cj[1] = 16 + row; cj[2] = (32 + row) < 36 ? (32 + row) : 35;
          const LAS f32x4* bp0 = (const LAS f32x4*)(WT + cj[0] * RT_WROW + 4 * kq); const LAS f32x4* bp1 = (const LAS f32x4*)(WT + cj[1] * RT_WROW + 4 * kq); const LAS f32x4* bp2 = (const LAS f32x4*)(WT + cj[2] * RT_WROW + 4 * kq);
#define RT_LOADA(dst_, b_) do { _Pragma("unroll") for (int i_ = 0; i_ < 8; ++i_) dst_[i_] = ap[4 * (8 * ((b_) < 8 ? (b_) : 7) + i_)]; } while (0)
#define RT_MMA(src_, b_) do { _Pragma("unroll") for (int i_ = 0; i_ < 8; ++i_) { const int ks_ = 8 * (b_) + i_; const f32x4 b0 = bp0[4 * ks_], b1 = bp1[4 * ks_], b2 = bp2[4 * ks_]; \
              _Pragma("unroll") for (int j = 0; j < 4; ++j) { acc[0] = __builtin_amdgcn_mfma_f32_16x16x4f32(src_[i_][j], b0[j], acc[0], 0, 0, 0); acc[1] = __builtin_amdgcn_mfma_f32_16x16x4f32(src_[i_][j], b1[j], acc[1], 0, 0, 0); \
                  acc[2] = __builtin_amdgcn_mfma_f32_16x16x4f32(src_[i_][j], b2[j], acc[2], 0, 0, 0); } } } while (0)
          f32x4 aA[8], aB[8]; RT_LOADA(aA, 0);
#pragma unroll 1
          for (int bb = 0; bb < 8; bb += 2) { RT_LOADA(aB, bb + 1); RT_MMA(aA, bb); RT_LOADA(aA, bb + 2); RT_MMA(aB, bb + 1); }
#undef RT_LOADA
#undef RT_MMA
        }
        __syncthreads();
        { const int col = lane & 15, kq = lane >> 4;
#pragma unroll
          for (int ct = 0; ct < 3; ++ct) if (16 * ct + col < 36) {
#pragma unroll
              for (int r = 0; r < 4; ++r) LG[(wave * 16 + 4 * kq + r) * 36 + 16 * ct + col] = acc[ct][r]; } }
        __syncthreads();
        if (tid < 128) { const int row = tid, t = blk * 128 + row; const float rs = RSTD[row]; const LAS float* lg = LG + tid * 36;
            float gl[4];
#pragma unroll
            for (int i = 0; i < 4; ++i) gl[i] = rs * lg[32 + i] + BIAS[32 + i];
            int gs = 0; float gmax = gl[0];
#pragma unroll
            for (int i = 1; i < 4; ++i) if (gl[i] > gmax) { gmax = gl[i]; gs = i; }
            float gsum = 0.f;
#pragma unroll
            for (int i = 0; i < 4; ++i) gsum += expf(gl[i] - gmax);
            const float gtop = 1.0f / gsum;
            float ev[8];
#pragma unroll
            for (int i = 0; i < 8; ++i) ev[i] = rs * lg[gs * 8 + i] + BIAS[gs * 8 + i];
            int l0 = 0; float v0 = ev[0];
#pragma unroll
            for (int i = 1; i < 8; ++i) if (ev[i] > v0) { v0 = ev[i]; l0 = i; }
            int l1 = -1; float v1 = -3.0e38f;
#pragma unroll
            for (int i = 0; i < 8; ++i) if (i != l0 && ev[i] > v1) { v1 = ev[i]; l1 = i; }
            const float e1 = expf(v1 - v0), s0 = 1.0f / (1.0f + e1), s1 = e1 * s0;
            const int ex0 = gs * 8 + l0, ex1 = gs * 8 + l1;
            const int rk0 = __hip_atomic_fetch_add(&LCNT[ex0], 1, __ATOMIC_RELAXED, __HIP_MEMORY_SCOPE_WORKGROUP);
            const int rk1 = __hip_atomic_fetch_add(&LCNT[ex1], 1, __ATOMIC_RELAXED, __HIP_MEMORY_SCOPE_WORKGROUP);
            TOKE[2 * t] = ex0; TOKE[2 * t + 1] = ex1; TOKR[2 * t] = rk0; TOKR[2 * t + 1] = rk1; TOKG[2 * t] = s0 * gtop; TOKG[2 * t + 1] = s1 * gtop; }
        __syncthreads();
        if (tid < 32) CNT[blk * 32 + tid] = LCNT[tid];
    }
}
__device__ __forceinline__ void p7_gather(const Args& a, const Ctx& c) {
    const int tid = c.tid, lane = c.lane, wave = c.wave;
    LAS int* PART = (LAS int*)c.lds; LAS int* PPRE = PART + 512; LAS int* TOT = PPRE + 512; LAS int* TS = TOT + 32; LAS int* BASE = TS + 64;
    const int* CNT = (const int*)(a.ws + WS_CNT); const int* TOKE = (const int*)(a.ws + WS_TOKE); const int* TOKR = (const int*)(a.ws + WS_TOKR); int* TOKP = (int*)(a.ws + WS_TOKP);
    int* RT = (int*)(a.ws + WS_ROWTOK);
    { const int e = tid & 31, p = tid >> 5; int s = 0; for (int k = 0; k < 16; ++k) s += CNT[(16 * p + k) * 32 + e]; PART[p * 32 + e] = s; }
    __syncthreads();
    if (tid < 32) { int run = 0; for (int p = 0; p < 16; ++p) { PPRE[p * 32 + tid] = run; run += PART[p * 32 + tid]; } TOT[tid] = run; }
    __syncthreads();
    if (tid == 0) { int ts = 0; for (int e = 0; e < 32; ++e) { TS[e] = ts; ts += (TOT[e] + 255) >> 8; } TS[32] = ts; }
    __syncthreads();
    if (blockIdx.x == 0 && tid < 33) ((int*)(a.ws + WS_SMALL))[tid] = TS[tid];
    for (int blk = blockIdx.x; blk < 256; blk += c.G) {
        if (tid < 32) { int s = TS[tid] * 256 + PPRE[(blk >> 4) * 32 + tid]; for (int b2 = (blk & ~15); b2 < blk; ++b2) s += CNT[b2 * 32 + tid]; BASE[tid] = s; }
        __syncthreads();
        { const int t = blk * 128 + (tid >> 2), jj = tid & 3;
          if (jj < 2) { const int pos = BASE[TOKE[2 * t + jj]] + TOKR[2 * t + jj]; TOKP[2 * t + jj] = pos; RT[pos] = t; } }
        __syncthreads();
    }
}
__device__ __forceinline__ void p10_combine(const Args& a, const Ctx& c) {
    const int lane = c.lane, gw = c.vcu * NWAVES + c.wave, NGW = c.G * NWAVES;
    const int* TOKP = (const int*)(a.ws + WS_TOKP); const float* TOKG = (const float*)(a.ws + WS_TOKG); const bf16* Y = (const bf16*)(a.ws + WS_Y);
    for (int t0 = gw; t0 < T; t0 += 2 * NGW) {
        const int tA = t0, tB = (t0 + NGW < T) ? t0 + NGW : t0; const bool hasB = (t0 + NGW < T);
        const int pA0 = TOKP[2 * tA], pA1 = TOKP[2 * tA + 1], pB0 = TOKP[2 * tB], pB1 = TOKP[2 * tB + 1];
        const float gA0 = TOKG[2 * tA], gA1 = TOKG[2 * tA + 1], gB0 = TOKG[2 * tB], gB1 = TOKG[2 * tB + 1];
        f32x4 xa[4], xb[4]; v2u ya0[4], ya1[4], yb0[4], yb1[4];
#pragma unroll
        for (int j = 0; j < 4; ++j) { const int cc = 4 * lane + 256 * j;
            xa[j] = *(const f32x4*)(a.out + (size_t)tA * D + cc); xb[j] = *(const f32x4*)(a.out + (size_t)tB * D + cc);
            ya0[j] = *(const v2u*)(Y + (size_t)pA0 * D + cc); ya1[j] = *(const v2u*)(Y + (size_t)pA1 * D + cc);
            yb0[j] = *(const v2u*)(Y + (size_t)pB0 * D + cc); yb1[j] = *(const v2u*)(Y + (size_t)pB1 * D + cc); }
#pragma unroll
        for (int j = 0; j < 4; ++j) { const int cc = 4 * lane + 256 * j; f32x4 x = xa[j];
            x[0] += gA0 * bf2f(ya0[j].x & 0xffffu) + gA1 * bf2f(ya1[j].x & 0xffffu); x[1] += gA0 * bf2f(ya0[j].x >> 16) + gA1 * bf2f(ya1[j].x >> 16);
            x[2] += gA0 * bf2f(ya0[j].y & 0xffffu) + gA1 * bf2f(ya1[j].y & 0xffffu); x[3] += gA0 * bf2f(ya0[j].y >> 16) + gA1 * bf2f(ya1[j].y >> 16);
            *(f32x4*)(a.out + (size_t)tA * D + cc) = x; }
        if (hasB) {
#pragma unroll
        for (int j = 0; j < 4; ++j) { const int cc = 4 * lane + 256 * j; f32x4 x = xb[j];
            x[0] += gB0 * bf2f(yb0[j].x & 0xffffu) + gB1 * bf2f(yb1[j].x & 0xffffu); x[1] += gB0 * bf2f(yb0[j].x >> 16) + gB1 * bf2f(yb1[j].x >> 16);
            x[2] += gB0 * bf2f(yb0[j].y & 0xffffu) + gB1 * bf2f(yb1[j].y & 0xffffu); x[3] += gB0 * bf2f(yb0[j].y >> 16) + gB1 * bf2f(yb1[j].y >> 16);
            *(f32x4*)(a.out + (size_t)tB * D + cc) = x; } }
    }
}
__global__ void __launch_bounds__(NWAVES * 64, 2) hybrid_fwd(Args args) {
    extern __shared__ __attribute__((aligned(16))) unsigned char lds_raw[];
    Ctx c; c.lds = (LAS unsigned char*)lds_raw;
    volatile LAS unsigned* MISC = (volatile LAS unsigned*)(c.lds + MISC_OFF);
    c.tid = threadIdx.x; c.lane = c.tid & 63; c.wave = __builtin_amdgcn_readfirstlane(c.tid >> 6);
    c.G = gridDim.x; { const int bx = blockIdx.x; c.vcu = (c.G % 8 == 0) ? (bx % 8) * (c.G / 8) + bx / 8 : bx; }
    unsigned* ctl = (unsigned*)(args.ws + WS_CTL);
    if (c.tid < 128) MISC[c.tid] = 0u;
    __syncthreads();
    XcdBarrier bar; bar.bar = ctl + CW_BAR; bar.x = 0; bar.st = nullptr;
    if (N_LAUNCHES == 1) bar = xcd_barrier_post(ctl + CW_BAR, MISC + 8);
#define GRID_BAR() do { if (N_LAUNCHES == 1) xcd_barrier(bar); } while (0)
    const int lo = args.ph_lo, hi = args.ph_hi;
#ifndef PH_MASK
#define PH_MASK 0xfff
#endif
#ifdef DBG_TIME
    unsigned long long tprev_ = wall_clock64(), tdur_ = 0ull; const unsigned long long tstart_ = tprev_;
#define PH_STAMP(k) do { const unsigned long long tn_ = wall_clock64(); if ((k) == DBG_TIME) tdur_ = tn_ - tprev_; tprev_ = tn_; } while (0)
#else
#define PH_STAMP(k) do { } while (0)
#endif
#define IN(k) (((PH_MASK >> (k)) & 1) && lo <= (k) && (k) < hi)
#define BOTH(k) (IN(k) && IN((k) + 1))
    unsigned char* ws = args.ws; unsigned char* dout = (unsigned char*)args.out;
#ifndef DBG_REPEAT
#define DBG_REPEAT -1
#endif
#define REPS(k) (((k) == DBG_REPEAT) ? 2 : 1)
#if DBG_REPEAT == 5
#define RB5 _Pragma("unroll 1") for (int rep5 = 0; rep5 < 2; ++rep5) { if (rep5) GRID_BAR();
#define RE5 }
#else
#define RB5
#define RE5
#endif
#if DBG_REPEAT == 6
#define RB6 _Pragma("unroll 1") for (int rep6 = 0; rep6 < 2; ++rep6) { if (rep6) GRID_BAR();
#define RE6 }
#else
#define RB6
#define RE6
#endif
    if (IN(0)) { _Pragma("unroll") for (int rep = 0; rep < REPS(0); ++rep) { if (rep) GRID_BAR(); p0_prologue<0>(args, c, c.vcu * NWAVES + c.wave, c.G * NWAVES); } if (BOTH(0)) GRID_BAR(); PH_STAMP(0); }
    if (IN(1)) { _Pragma("unroll") for (int rep = 0; rep < REPS(1); ++rep) { if (rep) GRID_BAR();
#ifdef DBG_STAGGER
        if ((blockIdx.x >> 3) & 1) { const unsigned long long t0 = wall_clock64(); while (wall_clock64() - t0 < (unsigned long long)DBG_STAGGER) __builtin_amdgcn_s_sleep(16); }
#endif
        pg8::Gemm g{(const pg8::bf16_t*)(dout + DO_H), (const pg8::bf16_t*)(ws + WS_WIN), T, NPROJ, D}; pg8::StaticOrder S; S.init(T, NPROJ, c.G, (int)blockIdx.x);
        pg8::EpiBf16<0> E{(pg8::bf16_t*)(ws + WS_PROJ), 256, nullptr, 256, (size_t)T * 256, 1.f};
        pg8::gemm_phase<pg8::EpiBf16<0>, pg8::StaticOrder, true, true>(c.lds, g, S, E); }
        if (BOTH(1)) GRID_BAR(); PH_STAMP(1);
    }
#ifndef DBG_R2
#define DBG_R2 1
#endif
#ifndef DBG_R4A
#define DBG_R4A 1
#endif
#ifndef DBG_R4B
#define DBG_R4B 1
#endif
#ifndef DBG_R7
#define DBG_R7 1
#endif
    if (IN(2)) { _Pragma("unroll 1") for (int rep = 0; rep < DBG_R2; ++rep) { if (rep) GRID_BAR(); p2_prep(args, c); } if (BOTH(2)) GRID_BAR(); PH_STAMP(2); }
    if (IN(3)) { _Pragma("unroll") for (int rep = 0; rep < REPS(3); ++rep) { if (rep) GRID_BAR(); p3_mixer(args, c, MISC, rep); } if (BOTH(3)) GRID_BAR(); PH_STAMP(3); }
    if (IN(4)) {
#pragma unroll 1
        for (int rep = 0; rep < DBG_R4A; ++rep) {
            const int gw = c.vcu * NWAVES + c.wave, ngw = c.G * NWAVES, kdone = ((int)blockIdx.x < 256) ? 24 : 0;
            LAS float* scr = (LAS float*)(c.lds + CV_SCR + c.wave * CV_SCRW);
#pragma unroll 1
            for (int k = kdone; gw + k * ngw < CV_NMI; ++k) { const CvItem it = cv_item(args, gw + k * ngw); f32x4 v[4]; cv_load(it, v, c.lane); cv_finish(it, v, scr, c.lane, true); }
            __syncthreads(); }
#pragma unroll 1
        for (int rep = 0; rep < DBG_R4B; ++rep)
#pragma unroll 1
        for (int u = blockIdx.x; u < 256; u += c.G) mlstm_unit<1>(args, c, u >> 5, (u >> 3) & 3, u & 7);
        if (BOTH(4)) GRID_BAR(); PH_STAMP(4);
    }
    if (IN(5)) { RB5
#ifdef DBG_STAG5
        if ((blockIdx.x >> 3) & 1) { const unsigned long long t0 = wall_clock64(); while (wall_clock64() - t0 < (unsigned long long)DBG_STAG5) __builtin_amdgcn_s_sleep(16); }
#endif
        { pg8::Gemm g{(const pg8::bf16_t*)(dout + DO_YATT), (const pg8::bf16_t*)(ws + WS_WPA), T, D, 512, (const pg8::bf16_t*)(dout + DO_YML), (const pg8::bf16_t*)(ws + WS_WPM)};
          pg8::StaticOrder S; S.init(T, D, c.G, (int)blockIdx.x);
          pg8::EpiGate2 E{(pg8::bf16_t*)(ws + WS_MERGED), D, (const pg8::bf16_t*)(ws + WS_PROJ + (size_t)TL_GA * PROJ_TILE), (const pg8::bf16_t*)(ws + WS_PROJ + (size_t)TL_GM * PROJ_TILE), (size_t)T * 256};
          pg8::gemm_phase<pg8::EpiGate2, pg8::StaticOrder, true, true, true>(c.lds, g, S, E); } RE5
        if (BOTH(5)) GRID_BAR(); PH_STAMP(5);
    }
    if (IN(6)) { RB6
#ifdef DBG_STAG6
        if ((blockIdx.x >> 3) & 1) { const unsigned long long t0 = wall_clock64(); while (wall_clock64() - t0 < (unsigned long long)DBG_STAG6) __builtin_amdgcn_s_sleep(16); }
#endif
        pg8::Gemm g{(const pg8::bf16_t*)(ws + WS_MERGED), (const pg8::bf16_t*)(ws + WS_WOUT), T, D, D}; pg8::StaticOrder S; S.init(T, D, c.G, (int)blockIdx.x);
        pg8::EpiRes E{args.out, args.in[IN_X], D};
        pg8::gemm_phase<pg8::EpiRes, pg8::StaticOrder, true, true>(c.lds, g, S, E); RE6
        if (BOTH(6)) GRID_BAR(); PH_STAMP(6);
    }
    if (IN(7)) { _Pragma("unroll 1") for (int rep = 0; rep < DBG_R7; ++rep) { if (rep) { GRID_BAR(); } p6_router(args, c); } if (BOTH(7)) GRID_BAR(); PH_STAMP(7); }
    if (IN(8)) { _Pragma("unroll") for (int rep = 0; rep < REPS(8); ++rep) { if (rep) GRID_BAR(); p7_gather(args, c); } if (BOTH(8)) GRID_BAR(); PH_STAMP(8); }
    if (IN(9) || IN(10)) {
        LAS int* TSL = (LAS int*)(c.lds + MISC_OFF + 256);
        LAS int* XS = (LAS int*)(c.lds + MISC_OFF + 400);
        if (c.tid < 33) TSL[c.tid] = (int)__hip_atomic_load((unsigned*)(ws + WS_SMALL) + c.tid, RLX_AGENT);
        if (c.tid == 64) { const int ntt = (int)__hip_atomic_load((unsigned*)(ws + WS_SMALL) + 32, RLX_AGENT); int lo_t = 0, hi_t = ntt, nl = c.G, lx = (int)blockIdx.x;
            if (N_LAUNCHES == 1) { unsigned pre = 0u, mine = 0u;
                for (unsigned j = 0; j < 16; ++j) { const unsigned cj = xb_ld(&bar.bar[XB_XCNT(j)]); pre += (j < bar.x) ? cj : 0u; mine = (j == bar.x) ? cj : mine; }
                nl = (int)mine; lx = (int)MISC[20]; lo_t = (int)((long)ntt * pre / c.G); hi_t = (int)((long)ntt * (pre + mine) / c.G); }
            XS[0] = lo_t; XS[1] = hi_t; XS[2] = nl; XS[3] = lx; }
        __syncthreads();
        const int xs_lo = XS[0], xs_hi = XS[1], xs_nl = XS[2], xs_lx = XS[3];
        if (IN(9)) {
            pg8::MoeOrder<true> S{TSL, xs_nl, xs_lx, xs_lo, xs_hi, (const int*)(ws + WS_ROWTOK), (unsigned*)(ws + WS_CTL) + CW_RDY};
            pg8::Gemm g{(const pg8::bf16_t*)(ws + WS_XN), (const pg8::bf16_t*)(ws + WS_GU), 0, 0, D};
            pg8::EpiSwiGLU E{(pg8::bf16_t*)(ws + WS_HID)};
            pg8::gemm_phase<pg8::EpiSwiGLU, pg8::MoeOrder<true>, true, true>(c.lds, g, S, E);
            if (BOTH(9)) __syncthreads();
        }
        if (IN(10)) {
            pg8::MoeOrder<false> S{TSL, xs_nl, xs_lx, xs_lo, xs_hi, nullptr, (unsigned*)(ws + WS_CTL) + CW_RDY};
            pg8::Gemm g{(const pg8::bf16_t*)(ws + WS_HID), (const pg8::bf16_t*)(ws + WS_DN), 0, 0, 512};
            pg8::EpiDown E{(pg8::bf16_t*)(ws + WS_Y)};
            pg8::gemm_phase<pg8::EpiDown, pg8::MoeOrder<false>, true, true>(c.lds, g, S, E);
            if (BOTH(10)) GRID_BAR(); PH_STAMP(10);
        }
    }
    if (IN(11)) p10_combine(args, c);
#ifdef DBG_TIME
    PH_STAMP(11);
    if (DBG_TIME == 99) tdur_ = wall_clock64() - tstart_;
    if (DBG_TIME >= 20 && DBG_TIME < 30) tdur_ = (unsigned long long)MISC[30];
    if (DBG_TIME == 98) tdur_ = 10000ull;
    if (blockIdx.x == 0) { const unsigned long long t0_ = wall_clock64(); while (wall_clock64() - t0_ < tdur_) __builtin_amdgcn_s_sleep(8); }
#endif
#undef IN
#undef BOTH
#undef GRID_BAR
}

extern "C" void kernel_launch(void* const* d_in, const int* in_sizes, int n_in, void* d_out, int out_size, void* d_ws, size_t ws_size, hipStream_t stream) {
    static int grid = 0;
    if (grid == 0) {
        if (n_in != 22 || in_sizes[0] != T * D || out_size != T * D || ws_size < WS_END) { fprintf(stderr, "kernel_launch: unexpected shapes (n_in %d, in0 %d, out %d, ws %zu); nothing launched\n", n_in, n_in > 0 ? in_sizes[0] : -1, out_size, ws_size); grid = -1; return; }
        int dev = 0, cus = 0, per_cu = 0;
        if (hipGetDevice(&dev) != hipSuccess || hipDeviceGetAttribute(&cus, hipDeviceAttributeMultiprocessorCount, dev) != hipSuccess) { grid = -1; return; }
        if (hipFuncSetAttribute((const void*)hybrid_fwd, hipFuncAttributeMaxDynamicSharedMemorySize, LDS_BYTES) != hipSuccess) { fprintf(stderr, "kernel_launch: hipFuncSetAttribute failed\n"); grid = -1; return; }
        if (hipOccupancyMaxActiveBlocksPerMultiprocessor(&per_cu, (const void*)hybrid_fwd, NWAVES * 64, LDS_BYTES) != hipSuccess || per_cu < 1)
            fprintf(stderr, "kernel_launch: note: occupancy query reports %d workgroups per CU\n", per_cu);
        (void)hipGetLastError();
        grid = cus;
    }
    if (grid < 0) return;
    if (hipMemsetAsync((char*)d_ws + WS_CTL, 0, CTL_ZERO_BYTES, stream) != hipSuccess) return;
    Args a{};
    for (int i = 0; i < 22; ++i) a.in[i] = (const float*)d_in[i];
    a.out = (float*)d_out; a.ws = (unsigned char*)d_ws;
    for (int li = 0; li < N_LAUNCHES; ++li) {
        a.ph_lo = (N_LAUNCHES == 1) ? 0 : li; a.ph_hi = (N_LAUNCHES == 1) ? NPH : li + 1; a.li = li;
        hipLaunchKernelGGL(hybrid_fwd, dim3(grid), dim3(NWAVES * 64), LDS_BYTES, stream, a);
        if (hipPeekAtLastError() != hipSuccess) { fprintf(stderr, "kernel_launch: launch %d failed\n", li); break; }
    }
}
```

```cpp
#include <hip/hip_runtime.h>
#include <cstdio>
#include <cstdint>
namespace pg8 {
#define PG8_LAS __attribute__((address_space(3)))
typedef unsigned short bf16_t;
typedef short bf16x8 __attribute__((ext_vector_type(8)));
typedef float f32x4 __attribute__((ext_vector_type(4)));
typedef unsigned u32x4 __attribute__((ext_vector_type(4)));
constexpr int BM = 256, BK = 64, HALF = 128, HTB = HALF * BK * 2  , STAGE_BYTES = 8 * HTB, NXCD = 8, WGM = 8;

__host__ __device__ __forceinline__ int lds_byte(int r, int c) { const int st = (r >> 4) * 2 + (c >> 5), rr = r & 15, cc = c & 31, ob = rr * 64 + cc * 2; return st * 1024 + (ob ^ (((ob >> 9) & 1) << 5)); }
__host__ __device__ __forceinline__ void stage_rc(int b, int& R, int& C) { const int st = b / 1024, sb = b % 1024, swz = sb ^ (((sb >> 9) & 1) << 5); R = (st >> 1) * 16 + swz / 64; C = (st & 1) * 32 + (swz % 64) / 2; }
__host__ __device__ __forceinline__ int perm32(int rho) { const int n = rho >> 4, i = rho & 15; return 8 * (i >> 2) + 4 * n + (i & 3); }

struct Unit { int pm, pn; };
struct Gemm { const bf16_t* A; const bf16_t* Bt; int M, N, K; const bf16_t* A2 = nullptr; const bf16_t* Bt2 = nullptr; };

struct StaticOrder {
    static constexpr bool GATHER = false;
    int nM, nN, nwg, G, c;
    __host__ __device__ void init(int M, int N, int G_, int c_) { nM = M / BM; nN = N / BM; nwg = nM * nN; G = G_; c = c_; }
    __host__ __device__ bool next(int i, Unit& u) const {
        const long L = (long)i * G + c; if (L >= nwg) return false;
        int wgid = (int)L; { const int q = nwg / NXCD, r = nwg % NXCD, xcd = wgid % NXCD, off = wgid / NXCD; wgid = (xcd < r ? xcd * (q + 1) : r * (q + 1) + (xcd - r) * q) + off; }
        const int nig = WGM * nN, gid = wgid / nig, fm = gid * WGM, gsz = (nM - fm) < WGM ? (nM - fm) : WGM;
        u.pm = fm + ((wgid % nig) % gsz); u.pn = (wgid % nig) / gsz; return true;
    }
    __device__ __forceinline__ void a_ready(const Unit&) const {}
    __device__ __forceinline__ void done(const Unit&) const {}
};

typedef __bf16 bf2_t __attribute__((ext_vector_type(2)));
__device__ __forceinline__ unsigned cvt_pk_bf16(float lo, float hi) { bf2_t v; v[0] = (__bf16)lo; v[1] = (__bf16)hi; return __builtin_bit_cast(unsigned, v); }
typedef float f32x2 __attribute__((ext_vector_type(2)));
template <int ACT  > struct EpiBf16 {
    static constexpr bool PERM = true, AFTER_DRAIN = false; static_assert(ACT == 0, "EpiBf16: no activation here");
    bf16_t* O; int ldc; const float* bias; int split_cols; size_t split_stride; float scale0; int native_from = 1 << 30;
    __device__ __forceinline__ void operator()(const f32x4 (&acc)[2][2][4][2], const Unit& u, int wr, int wc, int fr, int fq) const {
        const int row0 = u.pm * BM + wr * 64 + fr; int colt = u.pn * BM; bf16_t* base = O;
        float sc = 1.f; bool native = false; if (split_cols) { const int t = colt / split_cols; base += (size_t)t * split_stride; colt -= t * split_cols; if (t == 0) sc = scale0; native = (t >= native_from); }
        const int sA = native ? 32768 : HALF * ldc, sM = native ? 8192 : 16 * ldc, sB = native ? 4096 : HALF;
        const int col0 = colt + wc * 32 + 8 * fq, bcol0 = u.pn * BM + wc * 32 + 8 * fq;
        f32x4 bv[2][2];
#pragma unroll
        for (int bj = 0; bj < 2; ++bj)
#pragma unroll
            for (int n = 0; n < 2; ++n) bv[bj][n] = bias ? *(const f32x4*)(bias + bcol0 + bj * HALF + 4 * n) : (f32x4){0.f, 0.f, 0.f, 0.f};
#pragma unroll
        for (int ai = 0; ai < 2; ++ai)
#pragma unroll
            for (int m = 0; m < 4; ++m) { bf16_t* rowp = (native ? base + (size_t)u.pm * BM * ldc + (size_t)(((wr * 4 + wc) * 64 + fq * 16 + fr) * 8) : base + (size_t)row0 * ldc + col0) + (size_t)(ai * sA + m * sM);
#pragma unroll
                for (int bj = 0; bj < 2; ++bj) { f32x4 v0 = acc[ai][bj][m][0] + bv[bj][0], v1 = acc[ai][bj][m][1] + bv[bj][1];
                    v0 = v0 * sc; v1 = v1 * sc; u32x4 w; w.x = cvt_pk_bf16(v0[0], v0[1]); w.y = cvt_pk_bf16(v0[2], v0[3]); w.z = cvt_pk_bf16(v1[0], v1[1]); w.w = cvt_pk_bf16(v1[2], v1[3]);
                    __builtin_nontemporal_store(w, (u32x4*)(rowp + bj * sB)); } }
    }
};
__device__ __forceinline__ float bf2f_(unsigned b16) { return __uint_as_float(b16 << 16); }
__device__ __forceinline__ float sigm_(float x) { return __builtin_amdgcn_rcpf(1.0f + __expf(-x)); }
template <bool ADD> struct EpiGate {
    static constexpr bool PERM = true, AFTER_DRAIN = false;
    bf16_t* O; int ldc; const bf16_t* gate; size_t gstride;
    __device__ __forceinline__ void operator()(const f32x4 (&acc)[2][2][4][2], const Unit& u, int wr, int wc, int fr, int fq) const {
        const int row0 = u.pm * BM + wr * 64 + fr, colt = wc * 32 + 8 * fq;
        const bf16_t* gt = gate + (size_t)u.pn * gstride;
#pragma unroll
        for (int ai = 0; ai < 2; ++ai) {
            u32x4 gv[4][2], pp[4][2];
#pragma unroll
            for (int m = 0; m < 4; ++m) { const size_t row = (size_t)(row0 + ai * HALF + m * 16);
#pragma unroll
                for (int bj = 0; bj < 2; ++bj) { const int c = colt + bj * HALF; gv[m][bj] = *(const u32x4*)(gt + row * 256 + c);
                    if (ADD) pp[m][bj] = *(const u32x4*)(O + row * ldc + u.pn * BM + c); } }
#pragma unroll
            for (int m = 0; m < 4; ++m) { const size_t row = (size_t)(row0 + ai * HALF + m * 16);
#pragma unroll
                for (int bj = 0; bj < 2; ++bj) { const int c = colt + bj * HALF; const u32x4 g4 = gv[m][bj];
                    bf16_t* op = O + row * ldc + u.pn * BM + c;
                    float pv[8] = {0.f, 0.f, 0.f, 0.f, 0.f, 0.f, 0.f, 0.f};
                    if (ADD) { const u32x4 p = pp[m][bj]; pv[0] = bf2f_(p.x & 0xffffu); pv[1] = bf2f_(p.x >> 16); pv[2] = bf2f_(p.y & 0xffffu); pv[3] = bf2f_(p.y >> 16);
                        pv[4] = bf2f_(p.z & 0xffffu); pv[5] = bf2f_(p.z >> 16); pv[6] = bf2f_(p.w & 0xffffu); pv[7] = bf2f_(p.w >> 16); }
                    const f32x4 v0 = acc[ai][bj][m][0], v1 = acc[ai][bj][m][1];
                    float o[8];
                    o[0] = pv[0] + sigm_(bf2f_(g4.x & 0xffffu)) * v0[0]; o[1] = pv[1] + sigm_(bf2f_(g4.x >> 16)) * v0[1];
                    o[2] = pv[2] + sigm_(bf2f_(g4.y & 0xffffu)) * v0[2]; o[3] = pv[3] + sigm_(bf2f_(g4.y >> 16)) * v0[3];
                    o[4] = pv[4] + sigm_(bf2f_(g4.z & 0xffffu)) * v1[0]; o[5] = pv[5] + sigm_(bf2f_(g4.z >> 16)) * v1[1];
                    o[6] = pv[6] + sigm_(bf2f_(g4.w & 0xffffu)) * v1[2]; o[7] = pv[7] + sigm_(bf2f_(g4.w >> 16)) * v1[3];
                    u32x4 w; w.x = cvt_pk_bf16(o[0], o[1]); w.y = cvt_pk_bf16(o[2], o[3]); w.z = cvt_pk_bf16(o[4], o[5]); w.w = cvt_pk_bf16(o[6], o[7]);
                    *(u32x4*)op = w; } } }
    }
};
struct EpiGate2 {
    static constexpr bool PERM = true, AFTER_DRAIN = false;
    bf16_t* O; int ldc; const bf16_t* gate1; const bf16_t* gate2; size_t gstride;
    __device__ __forceinline__ void mid(f32x4 (&acc)[2][2][4][2], const Unit& u, int wr, int wc, int fr, int fq) const {
        const int row0 = u.pm * BM + wr * 64 + fr, colt = wc * 32 + 8 * fq;
        const bf16_t* g1 = gate1 + (size_t)u.pn * gstride; const bf16_t* g2 = gate2 + (size_t)u.pn * gstride;
#pragma unroll
        for (int ai = 0; ai < 2; ++ai)
#pragma unroll
          for (int bj = 0; bj < 2; ++bj) { u32x4 ga[4], gb[4]; const int c = colt + bj * HALF;
            int r0_ = (wr * 4 + wc) * 64 + fq * 16 + fr; asm volatile("" : "+v"(r0_) :: "memory");
#pragma unroll
            for (int m = 0; m < 4; ++m) { const size_t ub = ((size_t)u.pm * BM * 256 + (size_t)(((ai * 4 + m) * 2 + bj) * 4096)) * 2;
                ga[m] = __builtin_nontemporal_load((const u32x4*)((const char*)g1 + ub + (unsigned)(r0_ * 16))); gb[m] = *(const u32x4*)((const char*)g2 + ub + (unsigned)(r0_ * 16)); }
#pragma unroll
            for (int m = 0; m < 4; ++m) { const u32x4 x = ga[m], y = gb[m];
#define EG2_R(xa_, xb_) ((1.0f + __expf(-__builtin_amdgcn_fmed3f((xb_), -30.0f, 30.0f))) * __builtin_amdgcn_rcpf(1.0f + __expf(-(xa_))))
                    f32x4& v0 = acc[ai][bj][m][0]; f32x4& v1 = acc[ai][bj][m][1];
                    v0[0] *= EG2_R(bf2f_(x.x & 0xffffu), bf2f_(y.x & 0xffffu)); v0[1] *= EG2_R(bf2f_(x.x >> 16), bf2f_(y.x >> 16));
                    v0[2] *= EG2_R(bf2f_(x.y & 0xffffu), bf2f_(y.y & 0xffffu)); v0[3] *= EG2_R(bf2f_(x.y >> 16), bf2f_(y.y >> 16));
                    v1[0] *= EG2_R(bf2f_(x.z & 0xffffu), bf2f_(y.z & 0xffffu)); v1[1] *= EG2_R(bf2f_(x.z >> 16), bf2f_(y.z >> 16));
                    v1[2] *= EG2_R(bf2f_(x.w & 0xffffu), bf2f_(y.w & 0xffffu)); v1[3] *= EG2_R(bf2f_(x.w >> 16), bf2f_(y.w >> 16));
#undef EG2_R
            } }
    }
#define EG2_C(x_) __builtin_amdgcn_fmed3f((x_), -30.0f, 30.0f)
    __device__ __forceinline__ void operator()(const f32x4 (&acc)[2][2][4][2], const Unit& u, int wr, int wc, int fr, int fq) const {
        const int row0 = u.pm * BM + wr * 64 + fr, colt = wc * 32 + 8 * fq;
        const bf16_t* g2 = gate2 + (size_t)u.pn * gstride;
#pragma unroll
        for (int ai = 0; ai < 2; ++ai) { u32x4 gb[4][2]; int t16_ = ((wr * 4 + wc) * 64 + fq * 16 + fr) * 16; asm volatile("" : "+v"(t16_) :: "memory");
#pragma unroll
            for (int m = 0; m < 4; ++m) {
#pragma unroll
                for (int bj = 0; bj < 2; ++bj) gb[m][bj] = __builtin_nontemporal_load((const u32x4*)((const char*)g2 + ((size_t)u.pm * BM * 256 + (size_t)(((ai * 4 + m) * 2 + bj) * 4096)) * 2 + (unsigned)t16_)); }
#pragma unroll
            for (int m = 0; m < 4; ++m) { const size_t row = (size_t)(row0 + ai * HALF + m * 16);
#pragma unroll
                for (int bj = 0; bj < 2; ++bj) { const u32x4 y = gb[m][bj]; const f32x4 v0 = acc[ai][bj][m][0], v1 = acc[ai][bj][m][1];
                    float o[8];
                    o[0] = sigm_(EG2_C(bf2f_(y.x & 0xffffu))) * v0[0]; o[1] = sigm_(EG2_C(bf2f_(y.x >> 16))) * v0[1]; o[2] = sigm_(EG2_C(bf2f_(y.y & 0xffffu))) * v0[2]; o[3] = sigm_(EG2_C(bf2f_(y.y >> 16))) * v0[3];
                    o[4] = sigm_(EG2_C(bf2f_(y.z & 0xffffu))) * v1[0]; o[5] = sigm_(EG2_C(bf2f_(y.z >> 16))) * v1[1]; o[6] = sigm_(EG2_C(bf2f_(y.w & 0xffffu))) * v1[2]; o[7] = sigm_(EG2_C(bf2f_(y.w >> 16))) * v1[3];
                    u32x4 w; w.x = cvt_pk_bf16(o[0], o[1]); w.y = cvt_pk_bf16(o[2], o[3]); w.z = cvt_pk_bf16(o[4], o[5]); w.w = cvt_pk_bf16(o[6], o[7]);
                    *(u32x4*)(O + row * ldc + u.pn * BM + colt + bj * HALF) = w; } } }
    }
};
#undef EG2_C
struct EpiRes {
    static constexpr bool PERM = true, AFTER_DRAIN = false;
    bf16_t* CA; bf16_t* CB; int split; const float* R; int ldc;
    __device__ __forceinline__ void operator()(const f32x4 (&acc)[2][2][4][2], const Unit& u, int wr, int wc, int fr, int fq) const {
        const int rl0 = wr * 64 + fr, col0 = u.pn * BM + wc * 32 + 8 * fq;
        bf16_t* C = (u.pm < split) ? CA + (size_t)u.pm * BM * 1024 : CB + (size_t)(u.pm - split) * BM * 1024;
        const float* Rt = R + (size_t)u.pm * BM * ldc;
#pragma unroll
        for (int ai = 0; ai < 2; ++ai) {
            f32x4 rv[4][2][2];
#pragma unroll
            for (int m = 0; m < 4; ++m) { const size_t ro = (size_t)(rl0 + ai * HALF + m * 16) * ldc + col0;
#pragma unroll
                for (int bj = 0; bj < 2; ++bj)
#pragma unroll
                    for (int n = 0; n < 2; ++n) rv[m][bj][n] = __builtin_nontemporal_load((const f32x4*)(Rt + ro + bj * HALF + n * 4)); }
#pragma unroll
            for (int m = 0; m < 4; ++m) { const size_t ro = (size_t)(rl0 + ai * HALF + m * 16) * 1024 + col0;
#pragma unroll
                for (int bj = 0; bj < 2; ++bj) { const f32x4 lo = rv[m][bj][0] + acc[ai][bj][m][0], hi = rv[m][bj][1] + acc[ai][bj][m][1];
                    u32x4 w; w.x = cvt_pk_bf16(lo[0], lo[1]); w.y = cvt_pk_bf16(lo[2], lo[3]); w.z = cvt_pk_bf16(hi[0], hi[1]); w.w = cvt_pk_bf16(hi[2], hi[3]);
                    *(u32x4*)(C + ro + bj * HALF) = w; } } }
    }
};
struct EpiSwiGLU {
    static constexpr bool PERM = true, AFTER_DRAIN = false;
    bf16_t* H;
    const float* RS;
    __device__ __forceinline__ void operator()(const f32x4 (&acc)[2][2][4][2], const Unit& u, int wr, int wc, int fr, int fq) const {
        const int row0 = u.pm * BM + wr * 64 + fr, hc = (u.pn & 3) * 128 + wc * 32 + 8 * fq;
        float rs[2][4];
#pragma unroll
        for (int ai = 0; ai < 2; ++ai)
#pragma unroll
            for (int m = 0; m < 4; ++m) rs[ai][m] = RS[row0 + ai * HALF + m * 16];
#pragma unroll
        for (int ai = 0; ai < 2; ++ai)
#pragma unroll
            for (int m = 0; m < 4; ++m) { const size_t row = (size_t)(row0 + ai * HALF + m * 16); const float r = rs[ai][m];
                float o[8];
#pragma unroll
                for (int n = 0; n < 2; ++n)
#pragma unroll
                    for (int i = 0; i < 4; ++i) { const float g = r * acc[ai][0][m][n][i], up = r * acc[ai][1][m][n][i]; o[n * 4 + i] = g * sigm_(g) * up; }
                u32x4 w; w.x = cvt_pk_bf16(o[0], o[1]); w.y = cvt_pk_bf16(o[2], o[3]); w.z = cvt_pk_bf16(o[4], o[5]); w.w = cvt_pk_bf16(o[6], o[7]);
                *(u32x4*)(H + row * 512 + hc) = w; }
    }
};
struct EpiDown {
    static constexpr bool PERM = true, AFTER_DRAIN = false;
    bf16_t* Y;
    __device__ __forceinline__ void operator()(const f32x4 (&acc)[2][2][4][2], const Unit& u, int wr, int wc, int fr, int fq) const {
        const int row0 = u.pm * BM + wr * 64 + fr, c0 = (u.pn & 3) * 256 + wc * 32 + 8 * fq;
#pragma unroll
        for (int ai = 0; ai < 2; ++ai)
#pragma unroll
            for (int m = 0; m < 4; ++m) { const size_t row = (size_t)(row0 + ai * HALF + m * 16);
#pragma unroll
                for (int bj = 0; bj < 2; ++bj) { const f32x4 v0 = acc[ai][bj][m][0], v1 = acc[ai][bj][m][1];
                    u32x4 w; w.x = cvt_pk_bf16(v0[0], v0[1]); w.y = cvt_pk_bf16(v0[2], v0[3]); w.z = cvt_pk_bf16(v1[0], v1[1]); w.w = cvt_pk_bf16(v1[2], v1[3]);
                    *(u32x4*)(Y + row * 1024 + c0 + bj * HALF) = w; } }
    }
};
template <bool GA_> struct MoeOrder {
    static constexpr bool GATHER = GA_;
    const PG8_LAS int* ts; int nl, lx, lo, hi; const int* rowtok; unsigned* rdy;
    __device__ __forceinline__ bool next(int i, Unit& u) const {
        const int U = 4 * (hi - lo), G = nl, c = lx; long L;
        if constexpr (GA_) L = (long)i * G + c;
        else { const int r = U % G;
            if (c >= r) L = (i == 0) ? (long)(c - r) : ((i == 1) ? (long)(G - r) + (c - r) : 2L * (G - r) + (long)(i - 2) * G + c);
            else L = 2L * (G - r) + (long)i * G + c; }
        if (L >= (long)U) return false;
        const int pm = lo + (int)(L >> 2), j = (int)(L & 3); int e = 0;
#pragma unroll
        for (int k = 1; k < 32; ++k) e += (ts[k] <= pm) ? 1 : 0;
        u.pm = pm; u.pn = e * 4 + j; return true;
    }
    __device__ __forceinline__ void a_ready(const Unit& u) const {
        if constexpr (!GA_) { unsigned sp = 0u;
            while (__hip_atomic_load(rdy + 16 * u.pm, __ATOMIC_RELAXED, __HIP_MEMORY_SCOPE_AGENT) < 32u) { __builtin_amdgcn_s_sleep(2); if (++sp > (1u << 22)) break; }
            asm volatile("" ::: "memory"); }
    }
    __device__ __forceinline__ void done(const Unit& u) const {
        if constexpr (GA_) { asm volatile("s_waitcnt vmcnt(0)" ::: "memory");
            if ((threadIdx.x & 63) == 0) (void)__hip_atomic_fetch_add(rdy + 16 * u.pm, 1u, __ATOMIC_RELAXED, __HIP_MEMORY_SCOPE_AGENT); }
    }
};
template <class E_> struct is_epibf16 { static constexpr bool value = false; }; template <int A_> struct is_epibf16<EpiBf16<A_>> { static constexpr bool value = true; };
template <class Epi, class Sched, bool ALIGN_EPI = false, bool SP2 = false, bool DUAL = false>
__device__ __forceinline__ void gemm_phase(PG8_LAS unsigned char* lds, const Gemm g, const Sched& S, const Epi& E) {
    const int tid = threadIdx.x, wid = __builtin_amdgcn_readfirstlane(tid >> 6), lane = tid & 63, wr = wid >> 2, wc = wid & 3, fr = lane & 15, fq = lane >> 4;
    const int K = g.K, nh = K / BK, nt = DUAL ? 2 * nh : nh;
    static_assert(!DUAL || SP2, "two operand pairs: SP2 loop only");
    unsigned voffA[2], voffB[2];
#pragma unroll
    for (int i = 0; i < 2; ++i) { int R, C; stage_rc(tid * 16 + i * 8192, R, C); const int Rb = Epi::PERM ? ((R & ~31) + perm32(R & 31)) : R;
        voffA[i] = (unsigned)(R * K + C) * 2u; voffB[i] = (unsigned)(Rb * K + C) * 2u; }
    const size_t kstep = (size_t)(BK * 2);
    const size_t hstep = (size_t)HALF * K * 2;
    const size_t tstep = 2 * hstep;
    constexpr bool GA = Sched::GATHER;
    static_assert(!GA || SP2, "gathered A rows: SP2 loop only");
    const size_t hstepA = GA ? 0 : hstep;
    unsigned gcur[2][2] = {{0u, 0u}, {0u, 0u}}, gnxt[2][2] = {{0u, 0u}, {0u, 0u}}; int gR[2] = {0, 0}; unsigned gC[2] = {0u, 0u};
    if constexpr (GA) { _Pragma("unroll") for (int i = 0; i < 2; ++i) { int R, C; stage_rc(tid * 16 + i * 8192, R, C); gR[i] = R; gC[i] = (unsigned)C * 2u; } }
#define PG8_GOFF(dst, u) do { if constexpr (GA) { _Pragma("unroll") for (int h_ = 0; h_ < 2; ++h_) _Pragma("unroll") for (int i_ = 0; i_ < 2; ++i_) dst[h_][i_] = (unsigned)S.rowtok[(u).pm * BM + h_ * HALF + gR[i_]] * (unsigned)(K * 2) + gC[i_]; } } while (0)
#define PG8_VA(h, sel) (GA ? ((sel) ? gnxt[h] : gcur[h]) : voffA)
    const unsigned ldsw = (unsigned)wid * 1024u;
    const int aoff = lds_byte(wr * 64 + fr, fq * 8), boff = lds_byte(wc * 32 + fr, fq * 8);
#define PG8_SA(b, h) (((b) * 2 + (h)) * HTB)
#define PG8_SB(b, h) ((4 + (b) * 2 + (h)) * HTB)
#define PG8_STAGE(bufoff, gbase, voff) do { _Pragma("unroll") for (int _i = 0; _i < 2; ++_i) \
        __builtin_amdgcn_global_load_lds((const unsigned*)((const char*)(gbase) + (voff)[_i]), (PG8_LAS unsigned*)(lds + (bufoff) + ldsw + _i * 8192), 16, 0, 0); } while (0)
#define PG8_LDA(dst, b, h) do { _Pragma("unroll") for (int m = 0; m < 4; ++m) _Pragma("unroll") for (int k = 0; k < 2; ++k) dst[m][k] = *(const PG8_LAS bf16x8*)(lds + PG8_SA(b, h) + aoff + m * 2048 + k * 1024); } while (0)
#define PG8_LDB(dst, b, h) do { _Pragma("unroll") for (int n = 0; n < 2; ++n) _Pragma("unroll") for (int k = 0; k < 2; ++k) dst[n][k] = *(const PG8_LAS bf16x8*)(lds + PG8_SB(b, h) + boff + n * 2048 + k * 1024); } while (0)
#define PG8_MMA(ai, bj, At, Bt) do { __builtin_amdgcn_s_setprio(1); _Pragma("unroll") for (int m = 0; m < 4; ++m) _Pragma("unroll") for (int n = 0; n < 2; ++n) _Pragma("unroll") for (int k = 0; k < 2; ++k) \
        acc[ai][bj][m][n] = __builtin_amdgcn_mfma_f32_16x16x32_bf16(Bt[n][k], At[m][k], acc[ai][bj][m][n], 0, 0, 0); __builtin_amdgcn_s_setprio(0); } while (0)
#define PG8_WAIT_V(n) asm volatile("s_waitcnt vmcnt(" #n ")" ::: "memory")
#define PG8_WAIT_L(n) asm volatile("s_waitcnt lgkmcnt(" #n ")" ::: "memory")
#define PG8_BAR __builtin_amdgcn_s_barrier()
#define PG8_SCHED __builtin_amdgcn_sched_barrier(0)
    Unit cur, nxt; int ui = 0;
    if (!S.next(0, cur)) return;
    f32x4 acc[2][2][4][2];
#pragma unroll
    for (int a = 0; a < 2; ++a)
#pragma unroll
        for (int b = 0; b < 2; ++b)
#pragma unroll
            for (int m = 0; m < 4; ++m)
#pragma unroll
                for (int n = 0; n < 2; ++n) acc[a][b][m][n] = (f32x4){0.f, 0.f, 0.f, 0.f};
    bf16x8 At[4][2], B0[2][2], B1[2][2];
    const char* cA = (const char*)g.A + (GA ? 0 : (size_t)cur.pm * tstep); const char* cB = (const char*)g.Bt + (size_t)cur.pn * tstep;
    S.a_ready(cur);
    PG8_GOFF(gcur, cur);
    if constexpr (SP2) {
        PG8_STAGE(PG8_SB(0, 0), cB, voffB); PG8_STAGE(PG8_SB(0, 1), cB + hstep, voffB); PG8_STAGE(PG8_SA(0, 0), cA, PG8_VA(0, false)); PG8_STAGE(PG8_SA(0, 1), cA + hstepA, PG8_VA(1, false));
        if (wr == 1) PG8_BAR;
        PG8_WAIT_V(2); PG8_BAR;
        PG8_STAGE(PG8_SB(1, 0), cB + kstep, voffB); PG8_STAGE(PG8_SA(1, 0), cA + kstep, PG8_VA(0, false)); PG8_STAGE(PG8_SB(1, 1), cB + hstep + kstep, voffB);
        PG8_WAIT_V(6); PG8_BAR;
    } else {
        PG8_STAGE(PG8_SB(0, 0), cB, voffB); PG8_STAGE(PG8_SA(0, 0), cA, voffA); PG8_STAGE(PG8_SB(0, 1), cB + hstep, voffB); PG8_STAGE(PG8_SA(0, 1), cA + hstep, voffA);
        if (wr == 1) PG8_BAR;
        PG8_WAIT_V(4); PG8_BAR;
        PG8_STAGE(PG8_SB(1, 0), cB + kstep, voffB); PG8_STAGE(PG8_SA(1, 0), cA + kstep, voffA); PG8_STAGE(PG8_SB(1, 1), cB + hstep + kstep, voffB);
        PG8_WAIT_V(6); PG8_BAR;
    }
    for (;;) {
        const bool has_next = S.next(ui + 1, nxt);
        if (has_next) PG8_GOFF(gnxt, nxt);
        const char* nA = has_next ? (const char*)g.A + (GA ? 0 : (size_t)nxt.pm * tstep) : cA; const char* nB = has_next ? (const char*)g.Bt + (size_t)nxt.pn * tstep : cB;
        const char* dA = cA; const char* dB = cB;
        if constexpr (DUAL) { dA = (const char*)g.A2 + (size_t)cur.pm * tstep - (size_t)nh * kstep; dB = (const char*)g.Bt2 + (size_t)cur.pn * tstep - (size_t)nh * kstep; }
        for (int th = 0; th < (DUAL ? 2 : 1); ++th) {
        for (int t = th * nh; t < (DUAL ? (th + 1) * nh : nt); t += 2) {
            const bool last = (t == nt - 2);
            const char* a1 = ((DUAL && t + 1 >= nh) ? dA : cA) + (size_t)(t + 1) * kstep;
            const char* a2 = last ? nA : ((DUAL && t + 2 >= nh) ? dA : cA) + (size_t)(t + 2) * kstep; const char* b2 = last ? nB : ((DUAL && t + 2 >= nh) ? dB : cB) + (size_t)(t + 2) * kstep;
            const char* a3 = a2 + kstep; const char* b3 = b2 + kstep;
            if (last && has_next) S.a_ready(nxt);
            const bool seln = last && has_next;
            if constexpr (SP2) {
            PG8_LDB(B0, 0, 0); PG8_LDB(B1, 0, 1); PG8_SCHED; PG8_LDA(At, 0, 0); PG8_STAGE(PG8_SA(1, 1), a1 + hstepA, PG8_VA(1, false));
            PG8_WAIT_V(8); PG8_WAIT_L(0); PG8_BAR; PG8_MMA(0, 0, At, B0); PG8_MMA(0, 1, At, B1); PG8_BAR; PG8_SCHED;
            PG8_LDA(At, 0, 1); PG8_STAGE(PG8_SB(0, 0), b2, voffB); PG8_STAGE(PG8_SB(0, 1), b2 + hstep, voffB); PG8_STAGE(PG8_SA(0, 0), a2, PG8_VA(0, seln));
            PG8_WAIT_V(8); PG8_WAIT_L(0); PG8_BAR; PG8_MMA(1, 0, At, B0); PG8_MMA(1, 1, At, B1); PG8_BAR; PG8_SCHED;
            PG8_LDB(B0, 1, 0); PG8_LDB(B1, 1, 1); PG8_SCHED; PG8_LDA(At, 1, 0); PG8_STAGE(PG8_SA(0, 1), a2 + hstepA, PG8_VA(1, seln));
            PG8_WAIT_V(8); PG8_WAIT_L(0); PG8_BAR; PG8_MMA(0, 0, At, B0); PG8_MMA(0, 1, At, B1); PG8_BAR; PG8_SCHED;
            PG8_LDA(At, 1, 1); PG8_STAGE(PG8_SB(1, 0), b3, voffB); PG8_STAGE(PG8_SB(1, 1), b3 + hstep, voffB); PG8_STAGE(PG8_SA(1, 0), a3, PG8_VA(0, seln));
            PG8_WAIT_V(8); PG8_WAIT_L(0); PG8_BAR; PG8_MMA(1, 0, At, B0); PG8_MMA(1, 1, At, B1); PG8_BAR; PG8_SCHED;
            } else {
            PG8_LDB(B0, 0, 0); PG8_SCHED; PG8_LDA(At, 0, 0); PG8_STAGE(PG8_SA(1, 1), a1 + hstep, voffA);
            PG8_WAIT_L(8); PG8_BAR; PG8_WAIT_L(0); PG8_MMA(0, 0, At, B0); PG8_BAR; PG8_SCHED;
            PG8_LDB(B1, 0, 1); PG8_STAGE(PG8_SB(0, 0), b2, voffB);
            PG8_BAR; PG8_WAIT_L(0); PG8_MMA(0, 1, At, B1); PG8_BAR;
            PG8_LDA(At, 0, 1); PG8_STAGE(PG8_SA(0, 0), a2, voffA);
            PG8_BAR; PG8_WAIT_L(0); PG8_MMA(1, 0, At, B0); PG8_BAR; PG8_SCHED;
            PG8_STAGE(PG8_SB(0, 1), b2 + hstep, voffB);
            PG8_WAIT_V(6); PG8_BAR; PG8_MMA(1, 1, At, B1); PG8_BAR;
            PG8_LDB(B0, 1, 0); PG8_SCHED; PG8_LDA(At, 1, 0); PG8_STAGE(PG8_SA(0, 1), a2 + hstep, voffA);
            PG8_WAIT_L(8); PG8_BAR; PG8_WAIT_L(0); PG8_MMA(0, 0, At, B0); PG8_BAR; PG8_SCHED;
            PG8_LDB(B1, 1, 1); PG8_STAGE(PG8_SB(1, 0), b3, voffB);
            PG8_BAR; PG8_WAIT_L(0); PG8_MMA(0, 1, At, B1); PG8_BAR;
            PG8_LDA(At, 1, 1); PG8_STAGE(PG8_SA(1, 0), a3, voffA);
            PG8_BAR; PG8_WAIT_L(0); PG8_MMA(1, 0, At, B0); PG8_BAR; PG8_SCHED;
            PG8_STAGE(PG8_SB(1, 1), b3 + hstep, voffB);
            PG8_WAIT_V(6); PG8_BAR; PG8_MMA(1, 1, At, B1); PG8_BAR;
            }
        }
        if constexpr (DUAL) { if (th == 0) E.mid(acc, cur, wr, wc, fr, fq); }
        }
        if constexpr (ALIGN_EPI) { if (wr == 0) PG8_BAR; }
        if constexpr (!Epi::AFTER_DRAIN) { E(acc, cur, wr, wc, fr, fq); S.done(cur); }
#ifdef DBG_EPI2
        if constexpr (is_epibf16<Epi>::value) { asm volatile("" ::: "memory"); E(acc, cur, wr, wc, fr, fq); }
#endif
#ifdef DBG_EPI2R
        if constexpr (!Epi::PERM) { asm volatile("" ::: "memory"); E(acc, cur, wr, wc, fr, fq); }
#endif
        if (!has_next) break;
#pragma unroll
        for (int a = 0; a < 2; ++a)
#pragma unroll
            for (int b = 0; b < 2; ++b)
#pragma unroll
                for (int m = 0; m < 4; ++m)
#pragma unroll
                    for (int n = 0; n < 2; ++n) acc[a][b][m][n] = (f32x4){0.f, 0.f, 0.f, 0.f};
        cur = nxt; cA = nA; cB = nB; ++ui;
        if constexpr (GA) { _Pragma("unroll") for (int h_ = 0; h_ < 2; ++h_) _Pragma("unroll") for (int i_ = 0; i_ < 2; ++i_) gcur[h_][i_] = gnxt[h_][i_]; }
        if constexpr (ALIGN_EPI) { if (wr == 1) PG8_BAR; }
    }
    PG8_WAIT_V(0);
    if constexpr (!ALIGN_EPI) { if (wr == 0) PG8_BAR; }
    PG8_BAR;
    if constexpr (Epi::AFTER_DRAIN) { E.fused(acc, cur, wr, wc, fr, fq, lds, wid, lane); S.done(cur); }
#undef PG8_GOFF
#undef PG8_VA
#undef PG8_SA
#undef PG8_SB
#undef PG8_STAGE
#undef PG8_LDA
#undef PG8_LDB
#undef PG8_MMA
#undef PG8_WAIT_V
#undef PG8_WAIT_L
#undef PG8_BAR
#undef PG8_SCHED
}
}
constexpr int NWAVES = 8;
constexpr int BATCH = 8, SEQ = 4096, D = 1024, T = BATCH * SEQ;
constexpr int NPROJ = 5120;
constexpr int NTILE = NPROJ / 256;
constexpr float EPS = 1e-6f;
#ifndef MK_N_LAUNCHES
#define MK_N_LAUNCHES 1
#endif
#ifndef DBG_NPH
#define DBG_NPH 12
#endif
constexpr int NPH = DBG_NPH;
constexpr int N_LAUNCHES = MK_N_LAUNCHES;
static_assert(N_LAUNCHES == 1 || N_LAUNCHES == NPH, "MK_N_LAUNCHES is 1 or NPH");

constexpr size_t MiB = 1u << 20;
constexpr size_t WS_CTL = 0, CTL_ZERO_BYTES = 1 * MiB;
constexpr size_t WS_SMALL = 1 * MiB;
constexpr size_t WS_WIN = 2 * MiB;
constexpr size_t WS_WPA = 13 * MiB, WS_WPM = 14 * MiB, WS_WOUT = 15 * MiB;
constexpr size_t WS_TOKE = 17 * MiB;
constexpr size_t WS_TOKR = WS_TOKE + 256 * 1024;
constexpr size_t WS_TOKP = WS_TOKR + 256 * 1024;
constexpr size_t WS_TOKG = WS_TOKP + 256 * 1024;
constexpr size_t WS_CNT = WS_TOKG + 256 * 1024;
constexpr size_t WS_ROWTOK = WS_CNT + 64 * 1024;
constexpr int NROWS_MAX = 73728;
constexpr size_t WS_RSTDG = 19 * MiB;
constexpr size_t WS_ROWRS = WS_RSTDG + 128 * 1024;
constexpr size_t WS_SC = 452 * MiB;
constexpr size_t WS_SC2 = 436 * MiB;
constexpr size_t WS_GU = 20 * MiB;
constexpr size_t WS_DN = 84 * MiB;
constexpr size_t WS_PROJ = 116 * MiB;
constexpr size_t PROJ_TILE = (size_t)T * 256 * 2;
constexpr size_t DO_MLST = 90 * MiB;
constexpr size_t WS_MLST_UNUSED = 116 * MiB;
constexpr size_t WS_MERGED = 116 * MiB;
constexpr size_t WS_XN = 180 * MiB;
constexpr size_t WS_XG = 244 * MiB;
constexpr size_t WS_HID = 388 * MiB;
constexpr size_t WS_Y = 244 * MiB;
constexpr size_t WS_END = 512 * MiB;
constexpr size_t WS_X1A = 460 * MiB, WS_X1B = 2 * MiB;
constexpr int X1B_SPLIT_ROWS = 26624;
static_assert(WS_X1A + (size_t)X1B_SPLIT_ROWS * 2048 <= WS_END && WS_X1B + (size_t)(T - X1B_SPLIT_ROWS) * 2048 <= 15 * MiB, "x1 pieces");
static_assert(WS_PROJ + NTILE * PROJ_TILE == 436 * MiB, "proj map");
constexpr size_t DO_H = 0, DO_YATT = 0, DO_YML = 32 * MiB, DO_KN = 64 * MiB, DO_IKR = 72 * MiB, DO_IQR = 74 * MiB, DO_AQN = 90 * MiB;
constexpr int TL_AQ = 0, TL_KV = 2, TL_IQ = 3, TL_MQ = 4, TL_MK = 6, TL_MV = 8, TL_MO = 10, TL_GA = 12, TL_GM = 16;
constexpr size_t WS_WSM = WS_SMALL + 64 * 1024;
constexpr size_t WS_WTG = WS_SMALL + 192 * 1024;
constexpr size_t DO_SMB = 122 * MiB;
constexpr int CW_BAR = 4096;
constexpr int CW_Q = 16384;
constexpr int CW_MLDONE = 20480;
constexpr int CW_KMAX = 24576;
constexpr int CW_RDY = 32768;
constexpr int LDS_BYTES = 163840, MISC_OFF = LDS_BYTES - 512;

#define GAS __attribute__((address_space(1)))
#define LAS __attribute__((address_space(3)))
typedef unsigned short bf16;
typedef unsigned v4u __attribute__((ext_vector_type(4)));
typedef unsigned v2u __attribute__((ext_vector_type(2)));
typedef float f32x4 __attribute__((ext_vector_type(4)));
typedef float f32x2 __attribute__((ext_vector_type(2)));
typedef short bf16x8 __attribute__((ext_vector_type(8)));
typedef GAS unsigned gu32;
#define RLX_AGENT __ATOMIC_RELAXED, __HIP_MEMORY_SCOPE_AGENT
#define LDS_WAIT() asm volatile("s_waitcnt lgkmcnt(0)" ::: "memory")
__device__ __forceinline__ float bf2f(unsigned b16) { return __uint_as_float(b16 << 16); }
__device__ __forceinline__ unsigned f2bf(float f) { unsigned u = __float_as_uint(f); return (u + 0x7fffu + ((u >> 16) & 1u)) >> 16; }
__device__ __forceinline__ unsigned pk2(float lo, float hi) { return pg8::cvt_pk_bf16(lo, hi); }
__device__ __forceinline__ float sigm(float x) { return __builtin_amdgcn_rcpf(1.0f + __expf(-x)); }
__device__ __forceinline__ float wave_sum(float v) {
    v += __int_as_float(__builtin_amdgcn_update_dpp(0, __float_as_int(v), 0xB1, 0xF, 0xF, true));
    v += __int_as_float(__builtin_amdgcn_update_dpp(0, __float_as_int(v), 0x4E, 0xF, 0xF, true));
    v += __int_as_float(__builtin_amdgcn_update_dpp(0, __float_as_int(v), 0x124, 0xF, 0xF, true));
    v += __int_as_float(__builtin_amdgcn_update_dpp(0, __float_as_int(v), 0x128, 0xF, 0xF, true));
    { const auto r = __builtin_amdgcn_permlane16_swap(__float_as_uint(v), __float_as_uint(v), false, false); v = __uint_as_float(r[0]) + __uint_as_float(r[1]); }
    { const auto r = __builtin_amdgcn_permlane32_swap(__float_as_uint(v), __float_as_uint(v), false, false); v = __uint_as_float(r[0]) + __uint_as_float(r[1]); }
    return v;
}
__device__ __forceinline__ void unpack8(const v4u r, float (&f)[8]) {
    f[0] = bf2f(r.x & 0xffffu); f[1] = bf2f(r.x >> 16); f[2] = bf2f(r.y & 0xffffu); f[3] = bf2f(r.y >> 16);
    f[4] = bf2f(r.z & 0xffffu); f[5] = bf2f(r.z >> 16); f[6] = bf2f(r.w & 0xffffu); f[7] = bf2f(r.w >> 16);
}
__device__ __forceinline__ v4u pack8(const float (&f)[8]) { v4u w; w.x = pk2(f[0], f[1]); w.y = pk2(f[2], f[3]); w.z = pk2(f[4], f[5]); w.w = pk2(f[6], f[7]); return w; }
#define XB_TMO      128
#define XB_XCNT(j)  (256  + 64 * (j))
#define XB_XSUB(j)  (1280 + 64 * (j))
#define XB_XGEN(j)  (2304 + 64 * (j))
#define XB_TOP      3328
#define XB_TOPGEN   3392
#define XCD_BAR_WORDS 3456
#define XB_SPIN_CAP (1u << 18)

__device__ __forceinline__ unsigned xb_ld(unsigned* p)              { return __hip_atomic_load(p, __ATOMIC_RELAXED, __HIP_MEMORY_SCOPE_AGENT); }
__device__ __forceinline__ unsigned xb_add(unsigned* p, unsigned v) { return __hip_atomic_fetch_add(p, v, __ATOMIC_RELAXED, __HIP_MEMORY_SCOPE_AGENT); }
__device__ __forceinline__ unsigned xb_xcc_id() { return (unsigned)__builtin_amdgcn_s_getreg((3 << 11) | 20) & 0xFu; }
#define XB_SPIN(cond, bar) do { unsigned _sp = 0; while (cond) { __builtin_amdgcn_s_sleep(1); \
    if ((++_sp & 255u) == 0u) { if (xb_ld(&(bar)[XB_TMO])) break; if (_sp > XB_SPIN_CAP) { atomicAdd(&(bar)[XB_TMO], 1u); break; } } } } while (0)

struct XcdBarrier {
    unsigned* bar; unsigned x;
    volatile LAS unsigned* st;
};

__device__ __forceinline__ XcdBarrier xcd_barrier_post(unsigned* bar, volatile LAS unsigned* st) {
    XcdBarrier b; b.bar = bar; b.x = xb_xcc_id(); b.st = st;
    if (threadIdx.x == 0) st[12] = xb_add(&bar[XB_XCNT(b.x)], 1u);
    return b;
}
__device__ __forceinline__ void xcd_barrier_complete(unsigned* bar, unsigned x, unsigned& nloc, unsigned& nx) {
    const unsigned G = gridDim.x * gridDim.y * gridDim.z;
    unsigned sum, cnt, mine, sp = 0u;
    for (;;) {
        sum = 0u; cnt = 0u; mine = 0u;
#pragma unroll
        for (unsigned j = 0; j < 16; ++j) { const unsigned c = xb_ld(&bar[XB_XCNT(j)]); sum += c; cnt += (c > 0u) ? 1u : 0u; mine = (j == x) ? c : mine; }
        if (sum == G) break;
        __builtin_amdgcn_s_sleep(1);
        if ((++sp & 255u) == 0u) { if (xb_ld(&bar[XB_TMO])) break; if (sp > XB_SPIN_CAP) { atomicAdd(&bar[XB_TMO], 1u); break; } }
    }
    nloc = mine > 0u ? mine : 1u; nx = cnt > 0u ? cnt : 1u;
}

__device__ __forceinline__ void xcd_barrier(const XcdBarrier& b) {
    asm volatile("s_waitcnt vmcnt(0)" ::: "memory");
    __syncthreads();
    if (threadIdx.x == 0) {
        unsigned* bar = b.bar;
        __builtin_amdgcn_s_waitcnt(0);
        unsigned nloc = b.st[0], nx = b.st[1];
        if (nloc == 0u) { xcd_barrier_complete(bar, b.x, nloc, nx); b.st[0] = nloc; b.st[1] = nx; }
        const unsigned old = xb_add(&bar[XB_XSUB(b.x)], 1u);
        const unsigned gen = old / nloc;
        if (old + 1u == (gen + 1u) * nloc) {
            __builtin_amdgcn_fence(__ATOMIC_RELEASE, "agent");
            asm volatile("s_waitcnt vmcnt(0)" ::: "memory");
            const unsigned og = xb_add(&bar[XB_TOP], 1u);
            const unsigned tg = og / nx;
            if (og + 1u == (tg + 1u) * nx) xb_add(&bar[XB_TOPGEN], 1u);
            else XB_SPIN(xb_ld(&bar[XB_TOPGEN]) == tg, bar);
            __builtin_amdgcn_fence(__ATOMIC_ACQUIRE, "agent");
            xb_add(&bar[XB_XGEN(b.x)], 1u);
            asm volatile("s_waitcnt vmcnt(0)" ::: "memory");
        } else {
            XB_SPIN(xb_ld(&bar[XB_XGEN(b.x)]) == gen, bar);
            __builtin_amdgcn_fence(__ATOMIC_ACQUIRE, "agent");
            asm volatile("s_waitcnt vmcnt(0)" ::: "memory");
        }
    }
    __syncthreads();
}
struct Args { const float* in[22]; float* out; unsigned char* ws; int ph_lo, ph_hi, li, pad; };
struct Ctx { int tid, lane, wave, G, vcu; LAS unsigned char* lds; };
__device__ __forceinline__ int fresh_lane(int tid) { int t = tid; asm volatile("" : "+v"(t)); return t & 63; }
#define IN_X 0
#define IN_POS 1
#define IN_GMIX 2
#define IN_WIN 3
#define IN_GQ 4
#define IN_GK 5
#define IN_WCONV 6
#define IN_BCONV 7
#define IN_BI 8
#define IN_BF 9
#define IN_GML 10
#define IN_WPA 11
#define IN_WPM 12
#define IN_WOUT 13
#define IN_GMOE 14
#define IN_WRG 15
#define IN_BRG 16
#define IN_WRE 17
#define IN_BRE 18
#define IN_WEG 19
#define IN_WEU 20
#define IN_WED 21

__device__ __forceinline__ int win_src_col(int n) {
    if (n < 1024) return n;
    if (n < 3072) return n + 40;
    return n + 48;
}
__device__ __forceinline__ int wsm_src_col(int r) {
    return r < 40 ? 1024 + r : (r < 44 ? 3112 + (r - 40) : 3116 + (r - 44));
}
__device__ __forceinline__ void tr_item(const float* W, int ldw, int scol, int k0, bf16* wt0, int K, LAS float* scr, int lane) {
    const int sc0 = __builtin_amdgcn_readfirstlane(scol), sc31 = __builtin_amdgcn_readlane(scol, 31);
    if (sc0 >= 0 && sc31 == sc0 + 31 && (sc0 & 3) == 0 && (ldw & 3) == 0) {
#pragma unroll
        for (int i = 0; i < 8; ++i) { const int kk = 8 * i + (lane >> 3); const f32x4 v = __builtin_nontemporal_load((const f32x4*)(W + (size_t)(k0 + kk) * ldw + sc0 + 4 * (lane & 7)));
            LAS float* d = scr + kk * 33 + 4 * (lane & 7); d[0] = v[0]; d[1] = v[1]; d[2] = v[2]; d[3] = v[3]; }
    } else {
#pragma unroll 8
        for (int i = 0; i < 32; ++i) { const int kk = 2 * i + (lane >> 5); scr[kk * 33 + (lane & 31)] = scol >= 0 ? W[(size_t)(k0 + kk) * ldw + scol] : 0.f; }
    }
    LDS_WAIT(); asm volatile("" ::: "memory");
    const int c = lane & 7;
#pragma unroll
    for (int j = 0; j < 4; ++j) { const int n = (lane >> 3) + 8 * j; const LAS float* s = scr + (8 * c) * 33 + n;
        v4u o; o.x = pk2(s[0 * 33], s[1 * 33]); o.y = pk2(s[2 * 33], s[3 * 33]); o.z = pk2(s[4 * 33], s[5 * 33]); o.w = pk2(s[6 * 33], s[7 * 33]);
        *(v4u*)(wt0 + (size_t)n * K + 8 * c) = o; }
    LDS_WAIT(); asm volatile("" ::: "memory");
}
template <int PART> __device__ __forceinline__ void p0_prologue(const Args& a, const Ctx& c, int gw, int NGW) {
    unsigned char* ws = a.ws;
    LAS float* scr = (LAS float*)(c.lds + c.wave * 16384);
    const int lane = fresh_lane(c.tid);
    constexpr int I_IN = 16 * 160, I_PA = 8 * 32, I_PM = 8 * 32, I_OUT = 16 * 32, I_GU = 32 * 16 * 32, I_DN = 32 * 8 * 32;
    constexpr int NPRJ = I_IN + I_PA + I_PM + I_OUT, NIT = NPRJ + I_GU + I_DN;
#ifdef DBG_TIME
    const unsigned long long p0t0_ = wall_clock64();
#endif
#define P0_ITEM(it_) do { int r = (it_); \
        if (r < I_IN) { const int kb = r / 160, nb = r % 160; tr_item(a.in[IN_WIN], 5168, win_src_col(32 * nb + (lane & 31)), 64 * kb, (bf16*)(ws + WS_WIN) + (size_t)(32 * nb) * 1024 + 64 * kb, 1024, scr, lane); break; } r -= I_IN; \
        if (r < I_PA) { const int kb = r / 32, nb = r % 32; tr_item(a.in[IN_WPA], 1024, 32 * nb + (lane & 31), 64 * kb, (bf16*)(ws + WS_WPA) + (size_t)(32 * nb) * 512 + 64 * kb, 512, scr, lane); break; } r -= I_PA; \
        if (r < I_PM) { const int kb = r / 32, nb = r % 32; tr_item(a.in[IN_WPM], 1024, 32 * nb + (lane & 31), 64 * kb, (bf16*)(ws + WS_WPM) + (size_t)(32 * nb) * 512 + 64 * kb, 512, scr, lane); break; } r -= I_PM; \
        if (r < I_OUT) { const int kb = r / 32, nb = r % 32; tr_item(a.in[IN_WOUT], 1024, 32 * nb + (lane & 31), 64 * kb, (bf16*)(ws + WS_WOUT) + (size_t)(32 * nb) * 1024 + 64 * kb, 1024, scr, lane); break; } r -= I_OUT; \
        if (r < I_GU) { const int e = r / 512, q = r % 512, kb = q / 32, nb = q % 32, t = nb >> 3, bj = (nb >> 2) & 1, i0 = (nb & 3) * 32; \
            const float* src = (bj ? a.in[IN_WEU] : a.in[IN_WEG]) + (size_t)e * 1024 * 512; \
            tr_item(src, 512, 128 * t + i0 + (lane & 31), 64 * kb, (bf16*)(ws + WS_GU) + ((size_t)e * 1024 + 32 * nb) * 1024 + 64 * kb, 1024, scr, lane); break; } r -= I_GU; \
        { const int e = r / 256, q = r % 256, kb = q / 32, nb = q % 32; \
            tr_item(a.in[IN_WED] + (size_t)e * 512 * 1024, 1024, 32 * nb + (lane & 31), 64 * kb, (bf16*)(ws + WS_DN) + ((size_t)e * 1024 + 32 * nb) * 512 + 64 * kb, 512, scr, lane); } } while (0)
    if (PART) { for (int it = NPRJ + gw; it < NIT; it += NGW) P0_ITEM(it); return; }
    int itn = gw;
#ifdef DBG_TIME
    const unsigned long long p0t1_ = wall_clock64();
#endif
    { bf16* WH = (bf16*)(ws + WS_WTG); bf16* WL = WH + 36 * 1032; for (int i = (NGW - 1 - gw) * 64 + lane; i < 36 * 1024; i += NGW * 64) { const int j = i >> 10, k = i & 1023;
        const float v = (j < 32 ? a.in[IN_WRE][k * 32 + j] : a.in[IN_WRG][k * 4 + (j - 32)]) * a.in[IN_GMOE][k]; const unsigned h = f2bf(v);
        WH[j * 1032 + k] = (bf16)h; WL[j * 1032 + k] = (bf16)f2bf(v - bf2f(h)); } }
    { bf16* WSM = (bf16*)(ws + WS_WSM); for (int i = ((NGW - 1 - gw + 8 * NGW - 576) % NGW) * 64 + lane; i < 48 * 1024; i += NGW * 64) { const int r = i >> 10, k = i & 1023; WSM[i] = (bf16)f2bf(a.in[IN_WIN][(size_t)k * 5168 + wsm_src_col(r)]); } }
#ifdef DBG_TIME
    const unsigned long long p0t2_ = wall_clock64();
#endif
    const float* g = a.in[IN_GMIX]; f32x4 gv[4];
#pragma unroll
    for (int j = 0; j < 4; ++j) gv[j] = *(const f32x4*)(g + 4 * lane + 256 * j);
    bf16* H = (bf16*)((unsigned char*)a.out + DO_H);
    for (int m0 = gw; m0 < T; m0 += 4 * NGW) {
        f32x4 v[4][4]; float rs[4];
#pragma unroll
        for (int q = 0; q < 4; ++q) { const int m = (m0 + q * NGW < T) ? m0 + q * NGW : m0; const f32x4* xp = (const f32x4*)(a.in[IN_X] + (size_t)m * D) + lane;
#pragma unroll
            for (int j = 0; j < 4; ++j) v[q][j] = __builtin_nontemporal_load(xp + 64 * j); }
        if (itn < NPRJ) { __builtin_amdgcn_sched_barrier(0); P0_ITEM(itn); itn += NGW; __builtin_amdgcn_sched_barrier(0); }
#pragma unroll
        for (int q = 0; q < 4; ++q) { float sq = 0.f;
#pragma unroll
            for (int j = 0; j < 4; ++j) sq += (v[q][j].x * v[q][j].x + v[q][j].y * v[q][j].y) + (v[q][j].z * v[q][j].z + v[q][j].w * v[q][j].w);
            rs[q] = rsqrtf(wave_sum(sq) * (1.f / D) + EPS); }
#pragma unroll
        for (int q = 0; q < 4; ++q) if (m0 + q * NGW < T) { v2u* op = (v2u*)(H + (size_t)(m0 + q * NGW) * D) + lane; const float r = rs[q];
#pragma unroll
            for (int j = 0; j < 4; ++j) { v2u w; w.x = pk2(v[q][j].x * r * gv[j].x, v[q][j].y * r * gv[j].y); w.y = pk2(v[q][j].z * r * gv[j].z, v[q][j].w * r * gv[j].w); op[64 * j] = w; } }
    }
    for (; itn < NPRJ; itn += NGW) P0_ITEM(itn);
#undef P0_ITEM
#ifdef DBG_TIME
    { const unsigned long long p0t3_ = wall_clock64(); volatile LAS unsigned* M_ = (volatile LAS unsigned*)(c.lds + MISC_OFF);
      if (c.tid == 0) { if (DBG_TIME == 22) M_[30] = (unsigned)(p0t1_ - p0t0_); if (DBG_TIME == 23) M_[30] = (unsigned)(p0t2_ - p0t1_); if (DBG_TIME == 24) M_[30] = (unsigned)(p0t3_ - p0t2_); } }
#endif
}

__device__ __forceinline__ const bf16* proj_tile(const Args& a, int tile) { return (const bf16*)(a.ws + WS_PROJ + (size_t)tile * PROJ_TILE); }
#define DPPF(x_, ctrl_) __int_as_float(__builtin_amdgcn_update_dpp(0, __float_as_int(x_), ctrl_, 0xF, 0xF, true))
__device__ __forceinline__ void p2_prep(const Args& a, const Ctx& c) {
    const int lane = fresh_lane(c.tid), gw = c.vcu * NWAVES + c.wave, NGW = c.G * NWAVES;
    float invf = 0.f;
    if (lane < 8) invf = (float)pow(500000.0, -(double)lane / 8.0); else if (lane < 12) invf = (float)pow(500000.0, -(double)(lane - 8) / 4.0);
    float gq[8], gk[8];
#pragma unroll
    for (int i = 0; i < 8; ++i) { gq[i] = a.in[IN_GQ][8 * (lane & 7) + i]; gk[i] = a.in[IN_GK][8 * (lane & 7) + i]; }
    const int* pos = (const int*)a.in[IN_POS];
    unsigned char* dout = (unsigned char*)a.out;
    bf16* AQN = (bf16*)(dout + DO_AQN); bf16* KN = (bf16*)(dout + DO_KN); bf16* IQR = (bf16*)(dout + DO_IQR); bf16* IKR = (bf16*)(dout + DO_IKR);
#ifdef DBG_TIME
    const unsigned long long p2t0_ = wall_clock64();
#endif
    { const bf16* Hh = (const bf16*)(dout + DO_H); const bf16* WSM = (const bf16*)(a.ws + WS_WSM); bf16* SMB = (bf16*)(dout + DO_SMB);
      const int row = lane & 15, kg = lane >> 4;
      const float invfk = (float)pow(500000.0, -(double)(lane & 3) / 4.0);
#pragma unroll 1
      for (int pc = c.wave; pc < 96; pc += NWAVES)
          __builtin_amdgcn_global_load_lds((const unsigned*)((const unsigned char*)WSM + (size_t)pc * 1024 + lane * 16), (LAS unsigned*)(c.lds + (pc >> 1) * 2064 + (pc & 1) * 1024), 16, 0, 0);
      bool first = true;
      for (int tile = gw; tile < T / 16 || first; tile += NGW) { const int t0 = (tile < T / 16 ? tile : 0) * 16;
          const bool live = tile < T / 16;
          f32x4 acc[3];
#pragma unroll
          for (int ct = 0; ct < 3; ++ct) acc[ct] = (f32x4){0.f, 0.f, 0.f, 0.f};
          const bf16* ap = Hh + (size_t)(t0 + row) * 1024 + 8 * kg; const LAS unsigned char* bp = c.lds + row * 2064 + 16 * kg;
          bf16x8 avA[16], avB[16];
#pragma unroll
          for (int ks = 0; ks < 16; ++ks) avA[ks] = __builtin_nontemporal_load((const bf16x8*)(ap + 32 * ks));
#pragma unroll
          for (int ks = 0; ks < 16; ++ks) avB[ks] = __builtin_nontemporal_load((const bf16x8*)(ap + 32 * (16 + ks)));
          if (first) { asm volatile("s_waitcnt vmcnt(0)" ::: "memory"); __syncthreads(); first = false; }
          if (!live) break;
          __builtin_amdgcn_sched_barrier(0);
#pragma unroll
          for (int ks = 0; ks < 16; ++ks) {
#pragma unroll
              for (int ct = 0; ct < 3; ++ct) acc[ct] = __builtin_amdgcn_mfma_f32_16x16x32_bf16(avA[ks], *(const LAS bf16x8*)(bp + ct * 16 * 2064 + 64 * ks), acc[ct], 0, 0, 0); }
#pragma unroll
          for (int ks = 0; ks < 16; ++ks) {
#pragma unroll
              for (int ct = 0; ct < 3; ++ct) acc[ct] = __builtin_amdgcn_mfma_f32_16x16x32_bf16(avB[ks], *(const LAS bf16x8*)(bp + ct * 16 * 2064 + 64 * (16 + ks)), acc[ct], 0, 0, 0); }
          const int col = lane & 15;
#pragma unroll
          for (int r = 0; r < 4; ++r) { const int t = t0 + 4 * kg + r;
              const float angk = (float)pos[t] * invfk;
              const double revk = (double)angk * 0.15915494309189535; const float frk = (float)(revk - __builtin_rint(revk));
              const float ck = __builtin_amdgcn_cosf(frk), sk = __builtin_amdgcn_sinf(frk);
              const float v0 = acc[0][r], pr = __shfl_xor(v0, 4);
              const float o0 = (col < 4) ? (v0 * ck - pr * sk) : ((col < 8) ? (v0 * ck + pr * sk) : v0);
              IKR[(size_t)t * 32 + col] = (bf16)f2bf(o0); IKR[(size_t)t * 32 + 16 + col] = (bf16)f2bf(acc[1][r]);
              SMB[(size_t)t * 16 + col] = (bf16)f2bf(acc[2][r]); }
          { float nk = 0.f;
#pragma unroll
            for (int r = 0; r < 4; ++r) { float q2 = acc[0][r] * acc[0][r] + acc[1][r] * acc[1][r];
                q2 += DPPF(q2, 0xB1); q2 += DPPF(q2, 0x4E); q2 += DPPF(q2, 0x141); q2 += DPPF(q2, 0x140);
                nk = fmaxf(nk, q2); }
            nk = fmaxf(nk, __shfl_xor(nk, 16)); nk = fmaxf(nk, __shfl_xor(nk, 32));
            if (lane == 0) atomicMax((unsigned*)(a.ws + WS_CTL) + CW_KMAX + 16 * (t0 / SEQ), __float_as_uint(nk)); } } }
#ifdef DBG_TIME
    const unsigned long long p2t1_ = wall_clock64();
#endif
    const int l7 = lane & 7;
    const int aqcol = (lane >> 3) * 64 + 8 * l7, akcol = ((lane & 15) >> 3) * 64 + 8 * l7;
    const bf16* aqsrc = proj_tile(a, TL_AQ + (aqcol >> 8)) + (aqcol & 255); const bf16* aksrc = proj_tile(a, TL_KV) + akcol; const bf16* iqsrc = proj_tile(a, TL_IQ) + 4 * lane;
    if (gw == 0 && lane < 12) ((float*)(a.ws + WS_SMALL))[64 + lane] = invf;
#define P2_LOADROW(t_, P_, A_, K_, Q_) do { const int tt_ = (t_) < T ? (t_) : T - 1; P_ = pos[tt_]; K_ = __builtin_nontemporal_load((const v4u*)(aksrc + (size_t)tt_ * 256)); } while (0)
#define P2_DOROW(t, P_, A_, K_, Q_) do { \
        const float ang = (float)(P_) * invf; \
        const double rev = (double)ang * 0.15915494309189535; const float frv = (float)(rev - __builtin_rint(rev)); \
        float cs = __builtin_amdgcn_cosf(frv), sn = __builtin_amdgcn_sinf(frv); \
        float ca[8], sa[8]; \
        _Pragma("unroll") for (int i = 0; i < 8; ++i) { ca[i] = __int_as_float(__builtin_amdgcn_readlane(__float_as_int(cs), i)); sa[i] = __int_as_float(__builtin_amdgcn_readlane(__float_as_int(sn), i)); } \
        { float f[8]; unpack8(K_, f); float ss = 0.f; \
          _Pragma("unroll") for (int i = 0; i < 8; ++i) ss += f[i] * f[i]; \
          ss += DPPF(ss, 0xB1); ss += DPPF(ss, 0x4E); ss += DPPF(ss, 0x141); \
          const float r = rsqrtf(ss * (1.f / 64.f) + EPS); \
          _Pragma("unroll") for (int i = 0; i < 8; ++i) f[i] = f[i] * r * gk[i]; \
          float o[8]; \
          _Pragma("unroll") for (int i = 0; i < 8; ++i) { const float p = DPPF(f[i], 0xB1); o[i] = (l7 == 0) ? (f[i] * ca[i] - p * sa[i]) : ((l7 == 1) ? (f[i] * ca[i] + p * sa[i]) : f[i]); } \
          if (lane < 16) *(v4u*)(KN + (size_t)(t) * 128 + akcol) = pack8(o); } } while (0)
    { int pA[4], pB[4]; v4u aA[4], aB[4], kA[4], kB[4]; v2u qA[4], qB[4];
#define P2_LOAD4(t0_, P_, A_, K_, Q_) do { _Pragma("unroll") for (int j_ = 0; j_ < 4; ++j_) P2_LOADROW((t0_) + j_ * NGW, P_[j_], A_[j_], K_[j_], Q_[j_]); } while (0)
#define P2_DO4(t0_, P_, A_, K_, Q_) do { _Pragma("unroll") for (int j_ = 0; j_ < 4; ++j_) if ((t0_) + j_ * NGW < T) P2_DOROW((t0_) + j_ * NGW, P_[j_], A_[j_], K_[j_], Q_[j_]); } while (0)
      P2_LOAD4(gw, pA, aA, kA, qA);
#pragma unroll 1
      for (int t = gw; t < T; t += 8 * NGW) {
          P2_LOAD4(t + 4 * NGW, pB, aB, kB, qB);
          __builtin_amdgcn_sched_barrier(0);
          P2_DO4(t, pA, aA, kA, qA);
          __builtin_amdgcn_sched_barrier(0);
          P2_LOAD4(t + 8 * NGW, pA, aA, kA, qA);
          __builtin_amdgcn_sched_barrier(0);
          P2_DO4(t + 4 * NGW, pB, aB, kB, qB);
          __builtin_amdgcn_sched_barrier(0);
      } }
#undef P2_LOAD4
#undef P2_DO4
#undef P2_LOADROW
#undef P2_DOROW
#ifdef DBG_TIME
    { const unsigned long long p2t2_ = wall_clock64(); volatile LAS unsigned* M_ = (volatile LAS unsigned*)(c.lds + MISC_OFF);
      if (c.tid == 0) { if (DBG_TIME == 20) M_[30] = (unsigned)(p2t1_ - p2t0_); if (DBG_TIME == 21) M_[30] = (unsigned)(p2t2_ - p2t1_); } }
#endif
}
constexpr int ML_QS = 0, ML_KS = 17408, ML_HS = 0;
constexpr int ML_KWT = 34816;
constexpr int ML_VT = 53248;
constexpr int ML_SW = 73984;
constexpr int ML_CT = 83200;
constexpr int ML_GA = 122368;
constexpr int ML_CW = ML_GA + 1024;
constexpr int ML_END = ML_CW + (1024 + 384) * 4;
static_assert(ML_END <= MISC_OFF, "mLSTM LDS map");
constexpr size_t ML_STATE_BYTES = 8 * 9 * 64 * 16;
__device__ __forceinline__ bf16x8 lds_frag(const LAS unsigned char* base, int stride_b, int row0, int kb, int lane) {
    return *(const LAS bf16x8*)(base + (row0 + (lane & 15)) * stride_b + kb + (lane >> 4) * 16);
}
__device__ __forceinline__ bf16x8 lds_frag_sw(const LAS unsigned char* base, int row0, int ks, int lane) {
    const int row = row0 + (lane & 15); return *(const LAS bf16x8*)(base + row * 144 + 16 * (((ks * 4 + (lane >> 4)) + (row >> 3)) & 7));
}
#define MFMA16(a_, b_, c_) __builtin_amdgcn_mfma_f32_16x16x32_bf16(a_, b_, c_, 0, 0, 0)
constexpr int CV_NMI = 2 * (32 * 16 * 32 + 32 * 8 * 32);
constexpr int CV_SCR = ML_END, CV_SCRW = 32 * 33 * 4;
static_assert(CV_SCR + 8 * CV_SCRW <= MISC_OFF, "conversion scratch");
struct CvItem { const float* src; bf16* dst; const float* gp; int ldw, K; };
__device__ __forceinline__ CvItem cv_item(const Args& a, int mi) {
    const int it = mi >> 1, hk = mi & 1; CvItem r;
    if (it < 32 * 16 * 32) { const int e = it >> 9, q = it & 511, kb = q >> 5, nb = q & 31, t = nb >> 3, bj = (nb >> 2) & 1, i0 = (nb & 3) * 32, k0 = 64 * kb + 32 * hk;
        r.src = (bj ? a.in[IN_WEU] : a.in[IN_WEG]) + (size_t)e * 1024 * 512 + (size_t)k0 * 512 + 128 * t + i0; r.ldw = 512; r.K = 1024;
        r.dst = (bf16*)(a.ws + WS_GU) + ((size_t)e * 1024 + 32 * nb) * 1024 + k0; r.gp = a.in[IN_GMOE] + k0;
    } else { const int r2 = it - 32 * 16 * 32, e = r2 >> 8, q = r2 & 255, kb = q >> 5, nb = q & 31, k0 = 64 * kb + 32 * hk;
        r.src = a.in[IN_WED] + (size_t)e * 512 * 1024 + (size_t)k0 * 1024 + 32 * nb; r.ldw = 1024; r.K = 512;
        r.dst = (bf16*)(a.ws + WS_DN) + ((size_t)e * 1024 + 32 * nb) * 512 + k0; r.gp = nullptr; }
    return r;
}
__device__ __forceinline__ void cv_load(const CvItem& it, f32x4 (&v)[4], float& gq, int lane) {
#pragma unroll
    for (int i = 0; i < 4; ++i) v[i] = __builtin_nontemporal_load((const f32x4*)(it.src + (size_t)(8 * i + (lane >> 3)) * it.ldw + 4 * (lane & 7)));
    gq = it.gp ? it.gp[lane & 31] : 1.0f;
}
__device__ __forceinline__ void cv_finish(const CvItem& it, const f32x4 (&v)[4], float gq, LAS float* scr, int lane, bool valid) {
#pragma unroll
    for (int i = 0; i < 4; ++i) { LAS float* d = scr + (8 * i + (lane >> 3)) * 33 + 4 * (lane & 7);
        const float gg = __int_as_float(__builtin_amdgcn_ds_bpermute(4 * (8 * i + (lane >> 3)), __float_as_int(gq)));
        d[0] = v[i][0] * gg; d[1] = v[i][1] * gg; d[2] = v[i][2] * gg; d[3] = v[i][3] * gg; }
    LDS_WAIT(); asm volatile("" ::: "memory");
#pragma unroll
    for (int j = 0; j < 2; ++j) { const int n = (lane >> 2) + 16 * j, cq = lane & 3; const LAS float* sp = scr + (8 * cq) * 33 + n;
        v4u o; o.x = pk2(sp[0 * 33], sp[1 * 33]); o.y = pk2(sp[2 * 33], sp[3 * 33]); o.z = pk2(sp[4 * 33], sp[5 * 33]); o.w = pk2(sp[6 * 33], sp[7 * 33]);
        if (valid) __builtin_nontemporal_store(o, (v4u*)(it.dst + (size_t)n * it.K + 8 * cq)); }
    LDS_WAIT(); asm volatile("" ::: "memory");
}
template <int MODE>
__device__ __forceinline__ void mlstm_unit(const Args& a, const Ctx& c, int b, int h, int g) {
    const int tid = c.tid, wave = c.wave; LAS unsigned char* lds = c.lds;
#if defined(DBG_TIME) && DBG_TIME >= 30 && DBG_TIME < 40
    const unsigned long long mlentry_ = wall_clock64();
#endif
#define ML_LAUNDER() int tv_ = tid; asm volatile("" : "+v"(tv_)); const int lane = tv_ & 63, seg = tv_ & 15, r2 = (tv_ >> 4) * 2; (void)lane; (void)seg; (void)r2
    const bf16* PQ = proj_tile(a, TL_MQ + (h >> 1)) + (h & 1) * 128;
    const bf16* PK = proj_tile(a, TL_MK + (h >> 1)) + (h & 1) * 128;
    const bf16* PV = proj_tile(a, TL_MV + (h >> 1)) + (h & 1) * 128;
    const bf16* PO = proj_tile(a, TL_MO + (h >> 1)) + (h & 1) * 128;
    const bf16* PS = (const bf16*)((unsigned char*)a.out + DO_SMB);
    bf16* YML = (bf16*)((unsigned char*)a.out + DO_YML);
    unsigned char* STB = (unsigned char*)a.out + DO_MLST; float* MST = (float*)((unsigned char*)a.out + DO_MLST + 256 * ML_STATE_BYTES);
    LAS float* GAa = (LAS float*)(lds + ML_GA); LAS float* GAm = GAa + 64; LAS float* GAw = GAa + 128; LAS float* GAe = GAa + 192;
    LAS float* CWQ = (LAS float*)(lds + ML_CW); LAS float* CWK = CWQ + 512; LAS float* CBQ = CWQ + 1024; LAS float* CBK = CBQ + 128; LAS float* GN = CBK + 128;
    LAS bf16* VTs = (LAS bf16*)(lds + ML_VT);
    { const float* wc = a.in[IN_WCONV]; const int j = tid >> 7, d = tid & 127;
      CWQ[tid] = wc[j * 1024 + h * 128 + d]; CWK[tid] = wc[j * 1024 + 512 + h * 128 + d];
      if (tid < 128) { CBQ[tid] = a.in[IN_BCONV][h * 128 + tid]; CBK[tid] = a.in[IN_BCONV][512 + h * 128 + tid]; GN[tid] = a.in[IN_GML][h * 128 + tid]; } }
    for (int i = tid; i < 16 * 64; i += 512) { const int r = i >> 6, cc = i & 63; VTs[(128 + r) * 72 + cc] = (r == 0) ? (bf16)0x3F80 : (bf16)0; }
    const float big = a.in[IN_BI][h], bfg = a.in[IN_BF][h];
    const int slot0 = (b * 4 + h) * 8;
    f32x4 cacc[9];
    float m_st = 0.f;
    if (MODE == 1 && g > 0) { ML_LAUNDER();
        const f32x4* sp = (const f32x4*)(STB + (size_t)(slot0 + g) * ML_STATE_BYTES) + wave * 576 + lane;
#pragma unroll
        for (int i = 0; i < 9; ++i) cacc[i] = sp[64 * i];
        m_st = MST[slot0 + g];
#pragma unroll
        for (int ee = 0; ee < 9; ++ee) { v2u w; w.x = pk2(cacc[ee][0], cacc[ee][1]); w.y = pk2(cacc[ee][2], cacc[ee][3]);
            *(LAS v2u*)(lds + ML_CT + (ee * 16 + (lane & 15)) * 272 + (wave * 16 + 4 * (lane >> 4)) * 2) = w; }
    } else {
#pragma unroll
        for (int i = 0; i < 9; ++i) cacc[i] = (f32x4){0.f, 0.f, 0.f, 0.f};
        for (int i = tid; i < 144 * 136 / 2; i += 512) ((LAS unsigned*)(lds + ML_CT))[i] = 0u;
    }
    const size_t tb = (size_t)b * SEQ;
    const char* bq = (const char*)(PQ + tb * 256); const char* bk = (const char*)(PK + tb * 256); const char* bv = (const char*)(PV + tb * 256); const char* bo = (const char*)(PO + tb * 256); const char* bs = (const char*)(PS + tb * 16);
    v4u rq[5], rk[5], rv[2]; unsigned short gi = 0, gf = 0;
#define ML_LOAD(kc) do { _Pragma("unroll") for (int j_ = 0; j_ < 5; ++j_) { const int rr_ = 64 * (kc) + r2 - 3 + j_; const unsigned o_ = (unsigned)((rr_ < 0 ? 0 : rr_) * 512 + seg * 16); \
            v4u q_ = (v4u){0u, 0u, 0u, 0u}; if (MODE == 1) q_ = *(const v4u*)(bq + o_); v4u k_ = *(const v4u*)(bk + o_); if (rr_ < 0) { q_ = (v4u){0u, 0u, 0u, 0u}; k_ = q_; } rq[j_] = q_; rk[j_] = k_; } \
        _Pragma("unroll") for (int i_ = 0; i_ < 2; ++i_) rv[i_] = *(const v4u*)(bv + (unsigned)((64 * (kc) + r2 + i_) * 512 + seg * 16)); \
        gi = *(const unsigned short*)(bs + (unsigned)((64 * (kc) + lane) * 32 + (8 + h) * 2)); gf = *(const unsigned short*)(bs + (unsigned)((64 * (kc) + lane) * 32 + (12 + h) * 2)); } while (0)
    const int kc0 = (MODE == 1) ? 8 * g : 0, kc1 = (MODE == 1) ? 8 * g + 8 : 56;
    { ML_LAUNDER(); ML_LOAD(kc0); }
    const int cv_gw = c.vcu * NWAVES + c.wave, cv_ngw = c.G * NWAVES; f32x4 cvv[4]; float cvg = 1.0f; CvItem cvi; int cvk = 0; bool cvp = false;
    LAS float* cv_scr = (LAS float*)(lds + CV_SCR + wave * CV_SCRW);
#define CV_SLOT() do { if (MODE == 1) { ML_LAUNDER(); if (cvp) cv_finish(cvi, cvv, cvg, cv_scr, lane, cv_gw + (cvk - 1) * cv_ngw < CV_NMI); \
        { int mi_ = cv_gw + cvk * cv_ngw; mi_ = mi_ < CV_NMI ? mi_ : CV_NMI - 1; cvi = cv_item(a, __builtin_amdgcn_readfirstlane(mi_)); cv_load(cvi, cvv, cvg, lane); cvp = true; ++cvk; } } } while (0)
    __syncthreads();
#if defined(DBG_TIME) && DBG_TIME >= 30 && DBG_TIME < 40
    unsigned long long mlt_ = wall_clock64(); unsigned mlacc_ = 0u; if (DBG_TIME == 34) mlacc_ = (unsigned)(mlt_ - mlentry_);
#define ML_STAMP(k) do { const unsigned long long tn_ = wall_clock64(); if (MODE == 1 && (k) == DBG_TIME - 30) mlacc_ += (unsigned)(tn_ - mlt_); mlt_ = tn_; } while (0)
#else
#define ML_STAMP(k) do { } while (0)
#endif
#pragma unroll 1
    for (int kc = kc0; kc < kc1; ++kc) {
        float wkv, decay, m_new;
        if (MODE == 0 && kc > 0 && (kc & 7) == 0) { ML_LAUNDER();
            f32x4* sp = (f32x4*)(STB + (size_t)(slot0 + (kc >> 3)) * ML_STATE_BYTES) + wave * 576 + lane;
#pragma unroll
            for (int i = 0; i < 9; ++i) sp[64 * i] = cacc[i];
            if (tid == 0) MST[slot0 + (kc >> 3)] = m_st; }
        CV_SLOT();
        { ML_LAUNDER();
        const float fpre = bf2f(gf) + bfg, lf = fminf(fpre, 0.f) - log1pf(__expf(-fabsf(fpre)));
        const float ig = bf2f(gi) + big;
#define ML_SHR(x_, n_, id_) __int_as_float(__builtin_amdgcn_update_dpp(__float_as_int(id_), __float_as_int(x_), 0x110 + (n_), 0xF, 0xF, false))
        float bc = lf;
        bc += ML_SHR(bc, 1, 0.f); bc += ML_SHR(bc, 2, 0.f); bc += ML_SHR(bc, 4, 0.f); bc += ML_SHR(bc, 8, 0.f);
        { const float t0 = __int_as_float(__builtin_amdgcn_readlane(__float_as_int(bc), 15)), t1 = __int_as_float(__builtin_amdgcn_readlane(__float_as_int(bc), 31)), t2 = __int_as_float(__builtin_amdgcn_readlane(__float_as_int(bc), 47));
          bc += (lane >= 48) ? (t0 + t1 + t2) : ((lane >= 32) ? (t0 + t1) : ((lane >= 16) ? t0 : 0.f)); }
        const float av = ig - bc; float Ac = av;
        Ac = fmaxf(Ac, ML_SHR(Ac, 1, -3.0e38f)); Ac = fmaxf(Ac, ML_SHR(Ac, 2, -3.0e38f)); Ac = fmaxf(Ac, ML_SHR(Ac, 4, -3.0e38f)); Ac = fmaxf(Ac, ML_SHR(Ac, 8, -3.0e38f));
        { const float t0 = __int_as_float(__builtin_amdgcn_readlane(__float_as_int(Ac), 15)), t1 = __int_as_float(__builtin_amdgcn_readlane(__float_as_int(Ac), 31)), t2 = __int_as_float(__builtin_amdgcn_readlane(__float_as_int(Ac), 47));
          const float m01 = fmaxf(t0, t1), m012 = fmaxf(m01, t2);
          Ac = fmaxf(Ac, (lane >= 48) ? m012 : ((lane >= 32) ? m01 : ((lane >= 16) ? t0 : -3.0e38f))); }
#undef ML_SHR
        const float mA = fmaxf(m_st, Ac), Mk = __int_as_float(__builtin_amdgcn_readlane(__float_as_int(mA), 63)), blast = __int_as_float(__builtin_amdgcn_readlane(__float_as_int(bc), 63));
        wkv = __expf(av - Mk); decay = __expf(m_st - Mk); m_new = blast + Mk;
        if (MODE == 1 && wave == 0) { GAa[lane] = av; GAm[lane] = mA; GAw[lane] = __expf(m_st - mA); GAe[lane] = __expf(-(bc + mA)); } }
#ifndef DBG_MLB
#define DBG_MLB 1
#endif
#ifndef DBG_MLF
#define DBG_MLF 1
#endif
        _Pragma("unroll 1") for (int pb_ = 0; pb_ < DBG_MLB; ++pb_)
        { ML_LAUNDER(); float kw_[2][8];
          float aq_[2][8], ak_[2][8];
          { const f32x4 b0 = *(const LAS f32x4*)(CBQ + seg * 8), b1 = *(const LAS f32x4*)(CBQ + seg * 8 + 4), c0 = *(const LAS f32x4*)(CBK + seg * 8), c1 = *(const LAS f32x4*)(CBK + seg * 8 + 4);
#pragma unroll
            for (int i = 0; i < 2; ++i) {
#pragma unroll
              for (int e = 0; e < 4; ++e) { aq_[i][e] = b0[e]; aq_[i][4 + e] = b1[e]; ak_[i][e] = c0[e]; ak_[i][4 + e] = c1[e]; } } }
          { float fkc[8], fqc[8]; unpack8(rk[0], fkc); if (MODE == 1) unpack8(rq[0], fqc);
#pragma unroll
            for (int j = 0; j < 4; ++j) { float fkn[8], fqn[8]; unpack8(rk[j + 1], fkn); if (MODE == 1) unpack8(rq[j + 1], fqn);
                const f32x4 x0 = *(const LAS f32x4*)(CWK + j * 128 + seg * 8), x1 = *(const LAS f32x4*)(CWK + j * 128 + seg * 8 + 4);
#pragma unroll
                for (int e = 0; e < 4; ++e) { ak_[0][e] += x0[e] * fkc[e]; ak_[0][4 + e] += x1[e] * fkc[4 + e]; ak_[1][e] += x0[e] * fkn[e]; ak_[1][4 + e] += x1[e] * fkn[4 + e]; }
                if (MODE == 1) { const f32x4 w0 = *(const LAS f32x4*)(CWQ + j * 128 + seg * 8), w1 = *(const LAS f32x4*)(CWQ + j * 128 + seg * 8 + 4);
#pragma unroll
                    for (int e = 0; e < 4; ++e) { aq_[0][e] += w0[e] * fqc[e]; aq_[0][4 + e] += w1[e] * fqc[4 + e]; aq_[1][e] += w0[e] * fqn[e]; aq_[1][4 + e] += w1[e] * fqn[4 + e]; } }
#pragma unroll
                for (int e = 0; e < 8; ++e) { fkc[e] = fkn[e]; if (MODE == 1) fqc[e] = fqn[e]; } } }
#pragma unroll
          for (int i = 0; i < 2; ++i) { const int t = r2 + i; const float wkt = __shfl(wkv, t);
#pragma unroll
            for (int e = 0; e < 8; ++e) { ak_[i][e] = ak_[i][e] * sigm(ak_[i][e]) * 0.08838834764831845f; kw_[i][e] = ak_[i][e] * wkt; }
            if (MODE == 1) {
#pragma unroll
                for (int e = 0; e < 8; ++e) aq_[i][e] = aq_[i][e] * sigm(aq_[i][e]);
                *(LAS v4u*)(lds + ML_QS + t * 272 + seg * 16) = pack8(aq_[i]);
                *(LAS v4u*)(lds + ML_KS + t * 272 + seg * 16) = pack8(ak_[i]); } }
          const unsigned va[4] = {rv[0].x, rv[0].y, rv[0].z, rv[0].w}, vb[4] = {rv[1].x, rv[1].y, rv[1].z, rv[1].w};
          const int swo = 16 * (((r2 >> 3) + seg) & 7) + 2 * (r2 & 7);
#pragma unroll
          for (int e = 0; e < 8; ++e) { const int ro = (seg * 8 + e) * 144 + swo;
              *(LAS unsigned*)(lds + ML_KWT + ro) = pk2(kw_[0][e], kw_[1][e]);
              const unsigned lo = (e & 1) ? (va[e >> 1] >> 16) : (va[e >> 1] & 0xffffu), hi = (e & 1) ? (vb[e >> 1] >> 16) : (vb[e >> 1] & 0xffffu);
              *(LAS unsigned*)(lds + ML_VT + ro) = lo | (hi << 16); } }
        { ML_LAUNDER(); if (kc + 1 < kc1) ML_LOAD(kc + 1); }
        __syncthreads();
        ML_STAMP(0);
        f32x4 hacc[5]; unsigned mo_r[8];
        const int tt = wave & 3, t0 = tt * 16, ne = (wave < 4) ? 5 : 4, e_first = (wave < 4) ? 0 : 5;
        CV_SLOT();
        if (MODE == 1) {
        { ML_LAUNDER(); const int tq = t0 + (lane & 15);
        bf16x8 qf[4];
#pragma unroll
        for (int ks = 0; ks < 4; ++ks) qf[ks] = lds_frag(lds + ML_QS, 272, t0, ks * 64, lane);
        const float mAt = GAm[tq], wit = GAw[tq];
        { bf16x8 kfr[2][4]; f32x4 sacc[2];
#pragma unroll
          for (int si = 0; si < 2; ++si) { sacc[si] = (f32x4){0.f, 0.f, 0.f, 0.f};
#pragma unroll
            for (int ks = 0; ks < 4; ++ks) kfr[si][ks] = lds_frag(lds + ML_KS, 272, (2 * (wave >> 2) + si) * 16, ks * 64, lane); }
          __builtin_amdgcn_sched_barrier(0);
#pragma unroll
          for (int ks = 0; ks < 4; ++ks)
#pragma unroll
            for (int si = 0; si < 2; ++si) sacc[si] = MFMA16(kfr[si][ks], qf[ks], sacc[si]);
#pragma unroll
          for (int si = 0; si < 2; ++si) { const int ss = 2 * (wave >> 2) + si, s0 = ss * 16;
            if (ss <= tt) {
#pragma unroll
                for (int r = 0; r < 4; ++r) { const int s = s0 + 4 * (lane >> 4) + r; sacc[si][r] = (s <= tq) ? sacc[si][r] * __expf(GAa[s] - mAt) : 0.f; } }
            else sacc[si] = (f32x4){0.f, 0.f, 0.f, 0.f};
            v2u w; w.x = pk2(sacc[si][0], sacc[si][1]); w.y = pk2(sacc[si][2], sacc[si][3]);
            *(LAS v2u*)(lds + ML_SW + tq * 144 + s0 * 2 + (lane >> 4) * 8) = w; } }
#pragma unroll
        for (int i = 0; i < 5; ++i) hacc[i] = (f32x4){0.f, 0.f, 0.f, 0.f};
#pragma unroll
        for (int kh = 0; kh < 2; ++kh) { bf16x8 cfr[5][2];
#pragma unroll
          for (int i = 0; i < 5; ++i) { const int ei = (i < ne) ? i : ne - 1;
#pragma unroll
            for (int k2 = 0; k2 < 2; ++k2) cfr[i][k2] = lds_frag(lds + ML_CT, 272, (e_first + ei) * 16, (2 * kh + k2) * 64, lane); }
          __builtin_amdgcn_sched_barrier(0);
#pragma unroll
          for (int k2 = 0; k2 < 2; ++k2)
#pragma unroll
            for (int i = 0; i < 5; ++i) if (i < ne) hacc[i] = MFMA16(cfr[i][k2], qf[2 * kh + k2], hacc[i]);
          __builtin_amdgcn_sched_barrier(0); }
#pragma unroll
        for (int i = 0; i < 5; ++i) if (i < ne) hacc[i] = hacc[i] * wit;
#pragma unroll
        for (int i = 0; i < 8; ++i) mo_r[i] = *(const unsigned*)(bo + (unsigned)((64 * kc + 8 * wave + i) * 512 + 4 * lane)); }
        __syncthreads();
        ML_STAMP(1);
        { ML_LAUNDER(); const int tq = t0 + (lane & 15); bf16x8 swf[2];
#pragma unroll
          for (int ks = 0; ks < 2; ++ks) swf[ks] = lds_frag(lds + ML_SW, 144, t0, ks * 64, lane);
          { bf16x8 vfr[5][2];
#pragma unroll
            for (int i = 0; i < 5; ++i) { const int ei = (i < ne) ? i : ne - 1;
#pragma unroll
              for (int ks = 0; ks < 2; ++ks) vfr[i][ks] = lds_frag_sw(lds + ML_VT, (e_first + ei) * 16, ks, lane); }
            __builtin_amdgcn_sched_barrier(0);
#pragma unroll
            for (int ks = 0; ks < 2; ++ks)
#pragma unroll
              for (int i = 0; i < 5; ++i) if (i < ne) hacc[i] = MFMA16(vfr[i][ks], swf[ks], hacc[i]); }
#pragma unroll
          for (int i = 0; i < 5; ++i) if (i < ne) { const int ee = e_first + i;
              if (ee < 8) *(LAS f32x4*)(lds + ML_HS + tq * 528 + (ee * 16 + 4 * (lane >> 4)) * 4) = hacc[i];
              else if ((lane >> 4) == 0) *(LAS float*)(lds + ML_HS + tq * 528 + 128 * 4) = hacc[i][0]; } }
        }
        CV_SLOT();
        { ML_LAUNDER(); const int d0 = wave * 16; bf16x8 kwf[2];
#pragma unroll
          for (int ks = 0; ks < 2; ++ks) kwf[ks] = lds_frag_sw(lds + ML_KWT, d0, ks, lane);
#pragma unroll
          for (int ee = 0; ee < 9; ++ee) cacc[ee] = cacc[ee] * decay;
#pragma unroll
          for (int eh = 0; eh < 2; ++eh) { bf16x8 efr[5][2];
#pragma unroll
            for (int i = 0; i < 5; ++i) { const int ee = (5 * eh + i < 9) ? 5 * eh + i : 8;
#pragma unroll
              for (int ks = 0; ks < 2; ++ks) efr[i][ks] = lds_frag_sw(lds + ML_VT, ee * 16, ks, lane); }
            __builtin_amdgcn_sched_barrier(0);
#pragma unroll
            for (int ks = 0; ks < 2; ++ks)
#pragma unroll
              for (int i = 0; i < 5; ++i) if (5 * eh + i < 9) cacc[5 * eh + i] = MFMA16(kwf[ks], efr[i][ks], cacc[5 * eh + i]);
            __builtin_amdgcn_sched_barrier(0); }
#pragma unroll
          for (int ee = 0; ee < 9; ++ee) {
              if (MODE == 1) { v2u w; w.x = pk2(cacc[ee][0], cacc[ee][1]); w.y = pk2(cacc[ee][2], cacc[ee][3]);
                  *(LAS v2u*)(lds + ML_CT + (ee * 16 + (lane & 15)) * 272 + (d0 + 4 * (lane >> 4)) * 2) = w; } } }
        __syncthreads();
        ML_STAMP(2);
        if (MODE == 1) {
        _Pragma("unroll 1") for (int pf_ = 0; pf_ < DBG_MLF; ++pf_)
        { ML_LAUNDER();
#pragma unroll
        for (int i = 0; i < 8; ++i) { const int t = 8 * wave + i;
            const f32x2 nv = *(const LAS f32x2*)(lds + ML_HS + t * 528 + lane * 8); const float den = *(const LAS float*)(lds + ML_HS + t * 528 + 512);
            const float dd = __builtin_amdgcn_rcpf(fmaxf(fabsf(den), GAe[t])); const float h0 = nv.x * dd, h1 = nv.y * dd;
            const float r = rsqrtf(wave_sum(h0 * h0 + h1 * h1) * (1.f / 128.f) + EPS);
            const float y0 = h0 * r * GN[2 * lane] * sigm(bf2f(mo_r[i] & 0xffffu)), y1 = h1 * r * GN[2 * lane + 1] * sigm(bf2f(mo_r[i] >> 16));
            *(unsigned*)(YML + (tb + 64 * kc + t) * 512 + h * 128 + 2 * lane) = pk2(y0, y1); } }
        __syncthreads();
        ML_STAMP(3);
        }
        m_st = m_new;
    }
    if (MODE == 1) { ML_LAUNDER(); if (cvp) cv_finish(cvi, cvv, cvg, cv_scr, lane, cv_gw + (cvk - 1) * cv_ngw < CV_NMI); }
#if defined(DBG_TIME) && DBG_TIME >= 30 && DBG_TIME < 40
    if (DBG_TIME == 35) mlacc_ = (unsigned)(wall_clock64() - mlentry_);
    if (MODE == 1 && tid == 0) ((volatile LAS unsigned*)(lds + MISC_OFF))[30] = mlacc_;
#endif
#undef ML_STAMP
#undef CV_SLOT
    if (MODE == 0) { ML_LAUNDER();
        f32x4* sp = (f32x4*)(STB + (size_t)(slot0 + 7) * ML_STATE_BYTES) + wave * 576 + lane;
#pragma unroll
        for (int i = 0; i < 9; ++i) sp[64 * i] = cacc[i];
        if (tid == 0) MST[slot0 + 7] = m_st; }
#undef ML_LOAD
#undef ML_LAUNDER
}
constexpr int AT_HIST = 0;
constexpr int AT_HROW = 2049;
constexpr int AT_SEL = 131072 + 256;
constexpr int AT_MROW = 129;
constexpr int AT_SM = AT_SEL + 8448;
constexpr int AT_LUT = AT_SM + 256;
constexpr int AT_SEL2 = AT_LUT + 256;
static_assert(AT_SEL2 + 8448 <= MISC_OFF, "attention LDS map");
__device__ __forceinline__ unsigned at_bin(float s, float inv) { const float x = __builtin_fmaf(s, inv, 1024.0f); return (unsigned)(int)__builtin_amdgcn_fmed3f(x, 0.0f, 2047.0f); }
__device__ __forceinline__ unsigned score_key(float s) { unsigned u = __float_as_uint(s + 0.0f); return (u & 0x80000000u) ? ~u : (u | 0x80000000u); }
__device__ __forceinline__ unsigned wave_suffix_sum(unsigned v, int lane) {
#define AT_SHL(x_, n_) ((unsigned)__builtin_amdgcn_update_dpp(0, (int)(x_), 0x100 + (n_), 0xF, 0xF, false))
    v += AT_SHL(v, 1); v += AT_SHL(v, 2); v += AT_SHL(v, 4); v += AT_SHL(v, 8);
#undef AT_SHL
    const unsigned t1 = (unsigned)__builtin_amdgcn_readlane((int)v, 16), t2 = (unsigned)__builtin_amdgcn_readlane((int)v, 32), t3 = (unsigned)__builtin_amdgcn_readlane((int)v, 48);
    return v + ((lane < 16) ? (t1 + t2 + t3) : ((lane < 32) ? (t2 + t3) : ((lane < 48) ? t3 : 0u)));
}
template <int NK> __device__ __forceinline__ void at_resolve2(const LAS unsigned long long* candA, LAS unsigned* maskA, int mA, int ndA,
                                                              const LAS unsigned long long* candB, LAS unsigned* maskB, int mB, int ndB, int lane) {
    unsigned long long ca[NK], cb[NK];
#pragma unroll
    for (int k = 0; k < NK; ++k) { const int i = 64 * k + lane; unsigned long long x = 0ull, y = 0ull; if (i < mA) x = candA[i]; if (i < mB) y = candB[i];
        ca[k] = (i < mA) ? (((x >> 32) << 16) | (x & 0xFFFFull)) : 0ull; cb[k] = (i < mB) ? (((y >> 32) << 16) | (y & 0xFFFFull)) : 0ull; }
    unsigned long long TA = 0ull, TB = 0ull;
#pragma unroll 1
    for (int bit = 47; bit >= 16; --bit) { const unsigned long long ta = TA | (1ull << bit), tb = TB | (1ull << bit); int ga = 0, gb = 0;
#pragma unroll
        for (int k = 0; k < NK; ++k) { ga += __popcll(__ballot(ca[k] >= ta)); gb += __popcll(__ballot(cb[k] >= tb)); }
        if (ga >= ndA) TA = ta; if (gb >= ndB) TB = tb; }
    int gA = 0, tA = 0, gB = 0, tB = 0;
#pragma unroll
    for (int k = 0; k < NK; ++k) { gA += __popcll(__ballot(ca[k] >= TA + 0x10000ull)); tA += __popcll(__ballot(ca[k] >= TA)); gB += __popcll(__ballot(cb[k] >= TB + 0x10000ull)); tB += __popcll(__ballot(cb[k] >= TB)); }
    tA -= gA; tB -= gB;
    if (tA > ndA - gA || tB > ndB - gB) {
#pragma unroll 1
        for (int bit = 15; bit >= 0; --bit) { const unsigned long long ta = TA | (1ull << bit), tb = TB | (1ull << bit); int ga = 0, gb = 0;
#pragma unroll
            for (int k = 0; k < NK; ++k) { ga += __popcll(__ballot(ca[k] >= ta)); gb += __popcll(__ballot(cb[k] >= tb)); }
            if (ga >= ndA) TA = ta; if (gb >= ndB) TB = tb; } }
#pragma unroll
    for (int k = 0; k < NK; ++k) {
        if (ca[k] >= TA && ca[k] != 0ull) { const unsigned key = 0xFFFFu - (unsigned)(ca[k] & 0xFFFFull);
            __hip_atomic_fetch_or(&maskA[key >> 5], 1u << (key & 31u), __ATOMIC_RELAXED, __HIP_MEMORY_SCOPE_WORKGROUP); }
        if (cb[k] >= TB && cb[k] != 0ull) { const unsigned key = 0xFFFFu - (unsigned)(cb[k] & 0xFFFFull);
            __hip_atomic_fetch_or(&maskB[key >> 5], 1u << (key & 31u), __ATOMIC_RELAXED, __HIP_MEMORY_SCOPE_WORKGROUP); } }
}
__device__ __forceinline__ void attn_unit(const Args& a, const Ctx& c, int b, int qt, float cshift) {
    const int tid = c.tid, wave = c.wave; LAS unsigned char* lds = c.lds;
#define AT_LAUNDER() int tv_ = tid; asm volatile("" : "+v"(tv_)); const int lane = tv_ & 63, qi = tv_ & 15, fq = (tv_ >> 4) & 3; (void)lane; (void)qi; (void)fq
    const int q0u = qt * 32, ch = q0u >> 6, n = 64 * (ch + 1), ntiles = n >> 4;
    const size_t tb = (size_t)b * SEQ;
    unsigned char* dout = (unsigned char*)a.out;
    const bf16* AQN = (const bf16*)(dout + DO_AQN); const bf16* KN = (const bf16*)(dout + DO_KN); const bf16* IQR = (const bf16*)(dout + DO_IQR); const bf16* IKR = (const bf16*)(dout + DO_IKR);
    bf16* YATT = (bf16*)(dout + DO_YATT);
    const bf16* VB = proj_tile(a, TL_KV); const bf16* PS = (const bf16*)(dout + DO_SMB);
    LAS unsigned* HIST = (LAS unsigned*)(lds + AT_HIST);
    LAS unsigned long long* CAND = (LAS unsigned long long*)(lds + AT_HIST);
    LAS int* SM = (LAS int*)(lds + AT_SM);
    float* SC = (blockIdx.x < 240) ? (float*)(a.ws + WS_SC) + (size_t)blockIdx.x * (16 * 4096) : (float*)(a.ws + WS_SC2) + (size_t)(blockIdx.x - 240) * (16 * 4096);
#ifndef DBG_REP_DENSE
#define DBG_REP_DENSE 1
#endif
#pragma unroll 1
    for (int rsel = 0; rsel < 2; ++rsel) {
    const int q0 = q0u + 16 * rsel;
    LAS unsigned* MASK = (LAS unsigned*)(lds + (rsel ? AT_SEL2 : AT_SEL));
    if (n > 256) {
#if defined(DBG_TIME) && DBG_TIME >= 37 && DBG_TIME <= 38
        const unsigned long long atp0_ = wall_clock64();
#endif
        for (int i = tid; i < 8192 + 4; i += 512) ((LAS v4u*)HIST)[i] = (v4u){0u, 0u, 0u, 0u};
        if (tid < 64) SM[tid] = 0;
        for (int i = tid; i < 16 * AT_MROW; i += 512) MASK[i] = 0u;
        bf16x8 qf[8]; float wv[8]; bf16x8 qsh, qsl; float binv;
        { AT_LAUNDER();
        const size_t trow = tb + q0 + qi;
#pragma unroll
#ifdef QF_SEL_OLD
        for (int h = 0; h < 8; ++h) qf[h] = *(const bf16x8*)(IQR + trow * 256 + h * 32 + 8 * fq);
#else
        for (int h = 0; h < 8; ++h) qf[h] = *(const bf16x8*)(proj_tile(a, TL_IQ) + trow * 256 + h * 32 + 8 * fq);
#ifdef QF_X1
        { const float pq_ = 0.f; const float* ft_ = (const float*)(a.ws + WS_SMALL) + 64 + 8; float ci[4], si[4];
#elif defined(QF_X2)
        { const float pq_ = (float)((const int*)a.in[IN_POS])[trow]; const float ftc_[4] = {1.f, 0.1f, 0.01f, 0.001f}; const float* ft_ = ftc_; float ci[4], si[4];
#else
        { const float pq_ = (float)((const int*)a.in[IN_POS])[trow]; const float* ft_ = (const float*)(a.ws + WS_SMALL) + 64 + 8; float ci[4], si[4];
#endif
#pragma unroll
          for (int i = 0; i < 4; ++i) { const float ang = pq_ * ft_[i]; const double rev = (double)ang * 0.15915494309189535; const float frv = (float)(rev - __builtin_rint(rev));
              ci[i] = __builtin_amdgcn_cosf(frv); si[i] = __builtin_amdgcn_sinf(frv); }
#pragma unroll
          for (int h = 0; h < 8; ++h) { float f[8], o[8]; unpack8(__builtin_bit_cast(v4u, qf[h]), f);
#pragma unroll
              for (int i = 0; i < 4; ++i) { o[i] = f[i] * ci[i] - f[4 + i] * si[i]; o[4 + i] = f[4 + i] * ci[i] + f[i] * si[i]; }
              const bf16x8 rq_ = __builtin_bit_cast(bf16x8, pack8(o)); if (fq == 0) qf[h] = rq_; } }
#endif
        { float t8[8]; unpack8(*(const v4u*)(PS + trow * 16), t8);
#pragma unroll
          for (int h = 0; h < 8; ++h) wv[h] = t8[h] * 0.03125f; }
        { float rq = 0.f;
#pragma unroll
          for (int h = 0; h < 8; ++h) { float f8[8]; unpack8(__builtin_bit_cast(v4u, qf[h]), f8); float q2 = 0.f;
#pragma unroll
            for (int j = 0; j < 8; ++j) q2 = __builtin_fmaf(f8[j], f8[j], q2);
            q2 += __shfl_xor(q2, 16); q2 += __shfl_xor(q2, 32);
            rq = __builtin_fmaf(fabsf(wv[h]), __builtin_sqrtf(q2), rq); }
          const float kmax = __builtin_sqrtf(__uint_as_float(__hip_atomic_load((const unsigned*)(a.ws + WS_CTL) + CW_KMAX + 16 * b, __ATOMIC_RELAXED, __HIP_MEMORY_SCOPE_AGENT)));
          binv = 1024.0f / fmaxf(rq * kmax, 1.0e-30f); }
        { float qs[8];
#pragma unroll
          for (int j = 0; j < 8; ++j) qs[j] = 0.f;
#pragma unroll
          for (int h = 0; h < 8; ++h) { float f8[8]; unpack8(__builtin_bit_cast(v4u, qf[h]), f8);
#pragma unroll
            for (int j = 0; j < 8; ++j) qs[j] = __builtin_fmaf(wv[h], f8[j], qs[j]); }
          float hi8[8], lo8[8]; const v4u ph = pack8(qs); unpack8(ph, hi8);
#pragma unroll
          for (int j = 0; j < 8; ++j) lo8[j] = qs[j] - hi8[j];
          qsh = __builtin_bit_cast(bf16x8, ph); qsl = __builtin_bit_cast(bf16x8, pack8(lo8)); } }
        __syncthreads();
#if defined(DBG_TIME) && DBG_TIME >= 37 && DBG_TIME <= 38
        if (DBG_TIME == 37 && tid == 0) ((volatile LAS unsigned*)(lds + MISC_OFF))[30] += (unsigned)(wall_clock64() - atp0_);
#endif
#define AT_LOADK(kt_) (*(const bf16x8*)(IKR + (tb + (size_t)(kt_) * 16 + qi) * 32 + 8 * fq))
#define AT_MM(kf_, dd_) do { { const f32x4 l0_ = MFMA16(kf_, qsl, ((f32x4){0.f, 0.f, 0.f, 0.f})); dd_[8] = MFMA16(kf_, qsh, l0_); } \
        _Pragma("unroll") for (int h_ = 0; h_ < 8; ++h_) dd_[h_] = MFMA16(kf_, qf[h_], ((f32x4){0.f, 0.f, 0.f, 0.f})); } while (0)
#define AT_COMB(dd_, sc_) do { \
        _Pragma("unroll") for (int r_ = 0; r_ < 4; ++r_) sc_[r_] = dd_[8][r_]; \
        _Pragma("unroll") for (int h_ = 0; h_ < 8; ++h_) { \
            _Pragma("unroll") for (int r_ = 0; r_ < 4; ++r_) { sc_[r_] = __builtin_fmaf(wv[h_], __builtin_fabsf(dd_[h_][r_]), sc_[r_]); asm("" : "+v"(sc_[r_])); } } } while (0)
        const int cnt = (ntiles - wave + 7) >> 3;
#ifndef DBG_RA
#define DBG_RA 1
#endif
#pragma unroll 1
        for (int rA = 0; rA < DBG_RA; ++rA) { if (rA) { for (int i = tid; i < 8192 + 4; i += 512) ((LAS v4u*)HIST)[i] = (v4u){0u, 0u, 0u, 0u}; __syncthreads(); }
#define AT_LOADG(dst_, i0_) do { _Pragma("unroll") for (int j_ = 0; j_ < 8; ++j_) { int kt_ = wave + 8 * ((i0_) + j_); kt_ = kt_ < ntiles ? kt_ : ntiles - 1; dst_[j_] = AT_LOADK(kt_); } } while (0)
#ifdef DBG_SC2
#define AT_SC_EXTRA asm volatile("" ::: "memory"); *(f32x4*)(SC + kt * 256 + qi * 16 + 4 * fq) = (f32x4){sc[0], sc[1], sc[2], sc[3]};
#else
#define AT_SC_EXTRA
#endif
#ifdef DBG_HIST2
#define AT_HIST_EXTRA(bin_) __hip_atomic_fetch_add((LAS unsigned*)(lds + 151552) + ((qi * 67 + (bin_)) & 2047), 1u, __ATOMIC_RELAXED, __HIP_MEMORY_SCOPE_WORKGROUP);
#else
#define AT_HIST_EXTRA(bin_)
#endif
#define AT_P1GROUP(buf_, base_) do { f32x4 dA_[9], dB_[9]; AT_MM(buf_[0], dA_); \
            _Pragma("unroll") for (int j2 = 0; j2 < 8; ++j2) { const bool valid = ((base_) + j2 < cnt); const int kt = wave + 8 * ((base_) + j2); float sc[4]; \
                if (j2 < 7) { if (j2 & 1) AT_MM(buf_[(j2 + 1) & 7], dA_); else AT_MM(buf_[(j2 + 1) & 7], dB_); } \
                __builtin_amdgcn_sched_barrier(0); \
                if (j2 & 1) AT_COMB(dB_, sc); else AT_COMB(dA_, sc); \
                if (valid) { *(f32x4*)(SC + kt * 256 + qi * 16 + 4 * fq) = (f32x4){sc[0], sc[1], sc[2], sc[3]}; AT_SC_EXTRA } \
                _Pragma("unroll") for (int r = 0; r < 4; ++r) { const unsigned bin = at_bin(sc[r], binv); \
                    __hip_atomic_fetch_add(&HIST[qi * AT_HROW + bin], valid ? 1u : 0u, __ATOMIC_RELAXED, __HIP_MEMORY_SCOPE_WORKGROUP); \
                    AT_HIST_EXTRA(bin) } } } while (0)
        { AT_LAUNDER(); bf16x8 ka[8], kb[8]; AT_LOADG(ka, 0);
#pragma unroll 1
          for (int i0 = 0; i0 < cnt; i0 += 16) {
            AT_LOADG(kb, i0 + 8);
            AT_P1GROUP(ka, i0);
            AT_LOADG(ka, i0 + 16);
            AT_P1GROUP(kb, i0 + 8); } }
#undef AT_P1GROUP
        __syncthreads();
        }
#ifndef DBG_RB
#define DBG_RB 1
#endif
#pragma unroll 1
        for (int rB = 0; rB < DBG_RB; ++rB) {
        { AT_LAUNDER(); const int qa_ = 2 * wave, qb_ = qa_ + 1; unsigned ta = 0, tb = 0;
            for (int i = 0; i < 32; ++i) { const int o = 32 * lane + ((i + lane) & 31); ta += HIST[qa_ * AT_HROW + o]; tb += HIST[qb_ * AT_HROW + o]; }
            const unsigned sa_ = wave_suffix_sum(ta, lane), sb_ = wave_suffix_sum(tb, lane);
            const int La = 63 - __clzll((long long)__ballot(sa_ >= 256u)), Lb = 63 - __clzll((long long)__ballot(sb_ >= 256u));
            const unsigned abA = (unsigned)__builtin_amdgcn_readlane((int)(sa_ - ta), La), abB = (unsigned)__builtin_amdgcn_readlane((int)(sb_ - tb), Lb);
            const unsigned ca_ = (lane < 32) ? HIST[qa_ * AT_HROW + 32 * La + lane] : 0u, cb_ = (lane < 32) ? HIST[qb_ * AT_HROW + 32 * Lb + lane] : 0u;
            const unsigned fa_ = wave_suffix_sum(ca_, lane), fb_ = wave_suffix_sum(cb_, lane);
            const int la2 = 63 - __clzll((long long)__ballot(abA + fa_ >= 256u)), lb2 = 63 - __clzll((long long)__ballot(abB + fb_ >= 256u));
            if (lane == la2) { SM[qa_] = 32 * La + la2; SM[16 + qa_] = (int)(256u - (abA + fa_ - ca_)); }
            if (lane == lb2) { SM[qb_] = 32 * Lb + lb2; SM[16 + qb_] = (int)(256u - (abB + fb_ - cb_)); } }
        __syncthreads();
        }
#ifndef DBG_RC
#define DBG_RC 1
#endif
#pragma unroll 1
        for (int rC = 0; rC < DBG_RC; ++rC) { if (rC) { if (tid < 16) SM[48 + tid] = 0; __syncthreads(); }
        { AT_LAUNDER(); const int Bq = SM[qi]; f32x4 scur[8];
          const float loF = (Bq <= 0) ? -__builtin_inff() : (float)Bq, hiF = (Bq >= 2047) ? __builtin_inff() : (float)(Bq + 1);
#define AT_LOADS(dst_, i0_) do { _Pragma("unroll") for (int j_ = 0; j_ < 8; ++j_) { int kt_ = wave + 8 * ((i0_) + j_); kt_ = kt_ < ntiles ? kt_ : ntiles - 1; dst_[j_] = *(const f32x4*)(SC + kt_ * 256 + qi * 16 + 4 * fq); } } while (0)
#define AT_P2GROUP(buf_, base_) do { _Pragma("unroll") for (int j2 = 0; j2 < 8; ++j2) { const bool valid = ((base_) + j2 < cnt); const int kt = wave + 8 * ((base_) + j2); \
                unsigned nib = 0u, cnib = 0u; unsigned uu[4]; \
                _Pragma("unroll") for (int r = 0; r < 4; ++r) { uu[r] = __float_as_uint(buf_[j2][r]); const float x_ = __builtin_fmaf(buf_[j2][r], binv, 1024.0f); const bool hi_ = x_ >= hiF; nib |= hi_ ? (1u << r) : 0u; cnib |= (x_ >= loF && !hi_) ? (1u << r) : 0u; } \
                if (!valid) { nib = 0u; cnib = 0u; } \
                if (cnib) { int p = __hip_atomic_fetch_add(&SM[48 + qi], (int)__popc(cnib), __ATOMIC_RELAXED, __HIP_MEMORY_SCOPE_WORKGROUP); \
                    _Pragma("unroll") for (int r = 0; r < 4; ++r) if ((cnib >> r) & 1u) { if (p < 1024) CAND[qi * 1024 + p] = ((unsigned long long)score_key(__uint_as_float(uu[r])) << 32) | (unsigned long long)(0xFFFFu - (unsigned)(kt * 16 + 4 * fq + r)); ++p; } } \
                if (nib) __hip_atomic_fetch_or(&MASK[qi * AT_MROW + (kt >> 1)], nib << (16 * (kt & 1) + 4 * fq), __ATOMIC_RELAXED, __HIP_MEMORY_SCOPE_WORKGROUP); } } while (0)
          f32x4 sb2[8];
          AT_LOADS(scur, 0);
#pragma unroll 1
          for (int i0 = 0; i0 < cnt; i0 += 16) {
            AT_LOADS(sb2, i0 + 8);
            AT_P2GROUP(scur, i0);
            AT_LOADS(scur, i0 + 16);
            AT_P2GROUP(sb2, i0 + 8); } }
#undef AT_P2GROUP
#undef AT_LOADS
        __syncthreads();
        }
#ifndef DBG_RD
#define DBG_RD 1
#endif
#pragma unroll 1
        for (int rD = 0; rD < DBG_RD; ++rD) {
        { AT_LAUNDER(); const int qa_ = 2 * wave, qb_ = 2 * wave + 1; int ma = SM[48 + qa_], mb = SM[48 + qb_]; ma = ma < 1024 ? ma : 1024; mb = mb < 1024 ? mb : 1024; const int nda = SM[16 + qa_], ndb = SM[16 + qb_];
            const int mm = ma > mb ? ma : mb;
            if (mm <= 64) at_resolve2<1>(CAND + qa_ * 1024, MASK + qa_ * AT_MROW, ma, nda, CAND + qb_ * 1024, MASK + qb_ * AT_MROW, mb, ndb, lane);
            else if (mm <= 256) at_resolve2<4>(CAND + qa_ * 1024, MASK + qa_ * AT_MROW, ma, nda, CAND + qb_ * 1024, MASK + qb_ * AT_MROW, mb, ndb, lane);
            else if (mm <= 512) at_resolve2<8>(CAND + qa_ * 1024, MASK + qa_ * AT_MROW, ma, nda, CAND + qb_ * 1024, MASK + qb_ * AT_MROW, mb, ndb, lane);
            else at_resolve2<16>(CAND + qa_ * 1024, MASK + qa_ * AT_MROW, ma, nda, CAND + qb_ * 1024, MASK + qb_ * AT_MROW, mb, ndb, lane); }
        __syncthreads();
        }
#undef AT_MM
#undef AT_COMB
#undef AT_LOADK
#undef AT_LOADG
    } else {
#pragma unroll 1
        for (int i = tid; i < 16 * AT_MROW; i += 512) MASK[i] = ((i % AT_MROW) < (n >> 5)) ? 0xFFFFFFFFu : 0u;
        __syncthreads();
    }
    }
#pragma unroll 1
    for (int rden = 0; rden < DBG_REP_DENSE; ++rden) {
#if defined(DBG_TIME) && DBG_TIME >= 37 && DBG_TIME <= 38
    const unsigned long long atd0_ = wall_clock64();
#endif
    { const int g = wave >> 2, qh = (wave >> 1) & 1, hp = wave & 1, NS = n >> 6;
      const unsigned ring0 = (unsigned)(size_t)(lds + AT_HIST);
      if (tid < 64) *(LAS float*)(lds + AT_LUT + 4 * tid) = ((tid >> 2) >> (tid & 3)) & 1 ? -cshift : -1.0e30f;
      const bf16* dsrc[4]; unsigned ddst[4];
      { AT_LAUNDER();
#pragma unroll
        for (int i_ = 0; i_ < 4; ++i_) { const int in_ = 4 * wave + i_; const int row_ = 4 * (in_ & 15) + (lane >> 4), pos_ = lane & 15;
            dsrc[i_] = (in_ < 16) ? (KN + (tb + row_) * 128 + ((pos_ ^ (row_ & 15)) << 3)) : (VB + (tb + row_) * 256 + 128 + ((pos_ ^ (2 * (row_ & 7))) << 3));
            ddst[i_] = (unsigned)(in_ * 1024); } }
      const size_t dstep = (wave < 4) ? (size_t)64 * 128 : (size_t)64 * 256;
#define AT_STAGE(s_) do { const unsigned sb_ = ring0 + (unsigned)(((s_) & 3) * 32768); \
        _Pragma("unroll") for (int i_ = 0; i_ < 4; ++i_) { const bf16* src_ = dsrc[i_] + (size_t)(s_) * dstep; \
            const unsigned dst_ = __builtin_amdgcn_readfirstlane(sb_ + ddst[i_]); unsigned keep_; \
            asm volatile("s_mov_b32 %0, m0\n\ts_mov_b32 m0, %2\n\ts_nop 0\n\tglobal_load_lds_dwordx4 %1, off\n\ts_mov_b32 m0, %0" : "=&s"(keep_) : "v"(src_), "s"(dst_) : "memory"); } } while (0)
      bf16x8 qa[2], qb[2]; f32x4 oacc[2][4], lacc[2];
      { AT_LAUNDER();
#pragma unroll
#ifdef QF_DENSE_OLD
        for (int hi = 0; hi < 2; ++hi) { const bf16* qp = AQN + (tb + q0u + 16 * qh + qi) * 512 + (g * 4 + 2 * hp + hi) * 64 + 8 * fq; qa[hi] = *(const bf16x8*)qp; qb[hi] = *(const bf16x8*)(qp + 32); } }
#else
        for (int hi = 0; hi < 2; ++hi) { const int col_ = (g * 4 + 2 * hp + hi) * 64 + 8 * fq; const bf16* qp = proj_tile(a, TL_AQ + (col_ >> 8)) + (tb + q0u + 16 * qh + qi) * 256 + (col_ & 255); qa[hi] = *(const bf16x8*)qp; qb[hi] = *(const bf16x8*)(qp + 32); }
        { const float pq_ = (float)((const int*)a.in[IN_POS])[tb + q0u + 16 * qh + qi]; const float* ft_ = (const float*)(a.ws + WS_SMALL) + 64; float ca[8], sa[8];
#pragma unroll
          for (int i = 0; i < 8; ++i) { const float ang = pq_ * ft_[i]; const double rev = (double)ang * 0.15915494309189535; const float frv = (float)(rev - __builtin_rint(rev));
              ca[i] = __builtin_amdgcn_cosf(frv); sa[i] = __builtin_amdgcn_sinf(frv); }
          float ga_[8], gb_[8];
#pragma unroll
          for (int i = 0; i < 8; ++i) { ga_[i] = a.in[IN_GQ][8 * fq + i]; gb_[i] = a.in[IN_GQ][32 + 8 * fq + i]; }
#pragma unroll
          for (int hi = 0; hi < 2; ++hi) { float fa[8], fb[8]; unpack8(__builtin_bit_cast(v4u, qa[hi]), fa); unpack8(__builtin_bit_cast(v4u, qb[hi]), fb); float ss = 0.f;
#pragma unroll
              for (int i = 0; i < 8; ++i) ss += fa[i] * fa[i] + fb[i] * fb[i];
              ss += __shfl_xor(ss, 16); ss += __shfl_xor(ss, 32);
              const float r = rsqrtf(ss * (1.f / 64.f) + EPS); float oa[8], ob[8];
#pragma unroll
              for (int i = 0; i < 8; ++i) { fa[i] = fa[i] * r * ga_[i]; fb[i] = fb[i] * r * gb_[i]; }
#pragma unroll
              for (int i = 0; i < 8; ++i) { const float p = __shfl_xor(fa[i], 16);
                  oa[i] = (fq == 0) ? (fa[i] * ca[i] - p * sa[i]) : ((fq == 1) ? (fa[i] * ca[i] + p * sa[i]) : fa[i]);
                  oa[i] *= 0.125f * 1.4426950408889634f; ob[i] = fb[i] * (0.125f * 1.4426950408889634f); }
              qa[hi] = __builtin_bit_cast(bf16x8, pack8(oa)); qb[hi] = __builtin_bit_cast(bf16x8, pack8(ob)); } } }
#endif
#pragma unroll
      for (int hi = 0; hi < 2; ++hi) { lacc[hi] = (f32x4){0.f, 0.f, 0.f, 0.f};
#pragma unroll
        for (int dt = 0; dt < 4; ++dt) oacc[hi][dt] = (f32x4){0.f, 0.f, 0.f, 0.f}; }
      const bf16x8 ones = (bf16x8){0x3F80, 0x3F80, 0x3F80, 0x3F80, 0x3F80, 0x3F80, 0x3F80, 0x3F80};
      asm volatile("s_waitcnt vmcnt(0)" ::: "memory");
#pragma unroll 1
      for (int s = 0; s < 3 && s < NS; ++s) AT_STAGE(s);
      typedef short s4_t __attribute__((ext_vector_type(4)));
      AT_LAUNDER();
      const LAS unsigned* mrow = (const LAS unsigned*)(lds + (qh ? AT_SEL2 : AT_SEL)) + qi * AT_MROW;
      const unsigned koff0 = (unsigned)(qi * 256 + (((g * 8 + fq) ^ qi) << 4)), koff1 = (unsigned)(qi * 256 + (((g * 8 + 4 + fq) ^ qi) << 4));
#define AT_LDK(kf_, ci_, slot_, tp_, mw_) do { const LAS unsigned char* kb_ = lds + AT_HIST + (slot_) * 32768 + (tp_) * 8192; \
          _Pragma("unroll") for (int t = 0; t < 2; ++t) { kf_[t][0] = *(const LAS bf16x8*)(kb_ + t * 4096 + koff0); kf_[t][1] = *(const LAS bf16x8*)(kb_ + t * 4096 + koff1); \
              ci_[t] = *(const LAS f32x4*)(lds + AT_LUT + ((((mw_) >> (16 * t + 4 * fq)) & 15u) << 4)); } } while (0)
#define AT_LDV(va_, slot_, vkh_) do { const LAS unsigned char* vb_ = lds + AT_HIST + (slot_) * 32768 + 16384 + (vkh_) * 8192; \
          _Pragma("unroll") for (int dt = 0; dt < 4; ++dt) { const int r1 = 4 * fq + (qi >> 2); const int ch_ = g * 8 + 2 * dt + ((lane & 3) >> 1); \
              const s4_t lo = __builtin_amdgcn_ds_read_tr16_b64_v4i16((LAS s4_t*)(vb_ + r1 * 256 + ((ch_ ^ (2 * (r1 & 7))) << 4) + (lane & 1) * 8)); \
              const s4_t hi4 = __builtin_amdgcn_ds_read_tr16_b64_v4i16((LAS s4_t*)(vb_ + (r1 + 16) * 256 + ((ch_ ^ (2 * (r1 & 7))) << 4) + (lane & 1) * 8)); \
              va_[dt] = (bf16x8){lo[0], lo[1], lo[2], lo[3], hi4[0], hi4[1], hi4[2], hi4[3]}; } } while (0)
#define AT_QKM(dst_, kf_, ci_) do { \
          _Pragma("unroll") for (int t = 0; t < 2; ++t) { \
              _Pragma("unroll") for (int hi = 0; hi < 2; ++hi) { const f32x4 d_ = MFMA16(kf_[t][0], qa[hi], ci_[t]); dst_[hi][t] = MFMA16(kf_[t][1], qb[hi], d_); } } } while (0)
#define AT_EXP(pb_, cur_) do { \
          _Pragma("unroll") for (int hi = 0; hi < 2; ++hi) { float pv[8]; \
              _Pragma("unroll") for (int j = 0; j < 8; ++j) pv[j] = __builtin_amdgcn_exp2f(cur_[hi][j >> 2][j & 3]); \
              v4u pw; pw.x = pk2(pv[0], pv[1]); pw.y = pk2(pv[2], pv[3]); pw.z = pk2(pv[4], pv[5]); pw.w = pk2(pv[6], pv[7]); pb_[hi] = __builtin_bit_cast(bf16x8, pw); } } while (0)
#define AT_PV(pb_, va_) do { \
          _Pragma("unroll") for (int hi = 0; hi < 2; ++hi) lacc[hi] = MFMA16(ones, pb_[hi], lacc[hi]); \
          _Pragma("unroll") for (int dt = 0; dt < 4; ++dt) { \
              _Pragma("unroll") for (int hi = 0; hi < 2; ++hi) oacc[hi][dt] = MFMA16(va_[dt], pb_[hi], oacc[hi][dt]); } } while (0)
#ifdef DBG_PRIO
      if (wave >= 4) __builtin_amdgcn_s_setprio(1);
#endif
#ifndef AT_PIPE_V
#define AT_PIPE_V 1
#endif
#define AT_PIPE() do { _Pragma("unroll") for (int pi_ = 0; pi_ < 18; ++pi_) { __builtin_amdgcn_sched_group_barrier(0x008, 1, 0); __builtin_amdgcn_sched_group_barrier(0x100, 1, 0); __builtin_amdgcn_sched_group_barrier(0x002, AT_PIPE_V, 0); } } while (0)
      f32x4 st0[2][2], st1[2][2]; bf16x8 kfA[2][2], kfB[2][2]; f32x4 ciA[2], ciB[2]; bf16x8 vaP[4], vaQ[4], pbP[2], pbQ[2];
      if (NS >= 3) asm volatile("s_waitcnt vmcnt(8)" ::: "memory"); else asm volatile("s_waitcnt vmcnt(0)" ::: "memory");
      __builtin_amdgcn_s_barrier(); asm volatile("" ::: "memory");
      unsigned m1A, m1B;
      { const unsigned m0A = mrow[0], m0B = mrow[1]; const int sx = (NS > 1) ? 1 : 0; m1A = mrow[2 * sx]; m1B = mrow[2 * sx + 1];
        AT_LDK(kfB, ciB, 0, 0, m0A); AT_LDK(kfA, ciA, 0, 1, m0B);
        AT_QKM(st0, kfB, ciB);
#pragma unroll
        for (int hi = 0; hi < 2; ++hi) pbP[hi] = (bf16x8){0, 0, 0, 0, 0, 0, 0, 0};
#pragma unroll
        for (int dt = 0; dt < 4; ++dt) vaP[dt] = (bf16x8){0, 0, 0, 0, 0, 0, 0, 0}; }
#if defined(DBG_TIME) && DBG_TIME >= 37 && DBG_TIME <= 38
      if (DBG_TIME == 38 && tid == 0) ((volatile LAS unsigned*)(lds + MISC_OFF))[30] += (unsigned)(wall_clock64() - atd0_);
#endif
#pragma unroll 1
      for (int s = 0; s < NS; ++s) {
          if (s + 2 < NS) asm volatile("s_waitcnt vmcnt(4)" ::: "memory"); else asm volatile("s_waitcnt vmcnt(0)" ::: "memory");
          __builtin_amdgcn_s_barrier(); asm volatile("" ::: "memory");
          if (s + 3 < NS) AT_STAGE(s + 3);
          const int s1 = (s + 1 < NS) ? s + 1 : s, s2 = (s + 2 < NS) ? s + 2 : NS - 1;
          const unsigned m2A = mrow[2 * s2], m2B = mrow[2 * s2 + 1];
          AT_LDK(kfB, ciB, (s1 & 3), 0, m1A); AT_LDV(vaQ, (s & 3), 0);
          AT_QKM(st1, kfA, ciA); AT_EXP(pbQ, st0); AT_PV(pbP, vaP);
          AT_PIPE();
          __builtin_amdgcn_sched_barrier(0);
          AT_LDK(kfA, ciA, (s1 & 3), 1, m1B); AT_LDV(vaP, (s & 3), 1);
          AT_QKM(st0, kfB, ciB); AT_EXP(pbP, st1); AT_PV(pbQ, vaQ);
          AT_PIPE();
          __builtin_amdgcn_sched_barrier(0);
          m1A = m2A; m1B = m2B; }
      AT_PV(pbP, vaP);
#ifdef DBG_PRIO
      __builtin_amdgcn_s_setprio(0);
#endif
#undef AT_PIPE
#undef AT_LDK
#undef AT_LDV
#undef AT_QKM
#undef AT_EXP
#undef AT_PV
      { AT_LAUNDER();
#pragma unroll
        for (int hi = 0; hi < 2; ++hi) { const float inv = 1.0f / lacc[hi][0];
            bf16* yp = YATT + (tb + q0u + 16 * qh + qi) * 512 + (g * 4 + 2 * hp + hi) * 64 + 4 * fq;
#pragma unroll
            for (int dt = 0; dt < 4; ++dt) { const f32x4 o = oacc[hi][dt];
                v2u w; w.x = pk2(o[0] * inv, o[1] * inv); w.y = pk2(o[2] * inv, o[3] * inv); *(v2u*)(yp + 16 * dt) = w; } } }
#undef AT_STAGE
    }
    __syncthreads();
    }
#undef AT_LAUNDER
    __syncthreads();
}

#ifndef DBG_REP_ML
#define DBG_REP_ML 1
#endif
#ifndef DBG_REP_ATT
#define DBG_REP_ATT 1
#endif
__device__ __forceinline__ void p3_mixer(const Args& a, const Ctx& c, volatile LAS unsigned* MISC, int rep) {
#if !defined(NO_MLSTM)
#pragma unroll 1
    for (int rr = 0; rr < DBG_REP_ML; ++rr)
#pragma unroll 1
        for (int u = blockIdx.x; u < 32; u += c.G) mlstm_unit<0>(a, c, u >> 2, u & 3, 0);
    { int nu = 0; for (int u = blockIdx.x; u < 32; u += c.G) ++nu;
      if (nu > 0) { asm volatile("s_waitcnt vmcnt(0)" ::: "memory"); __syncthreads();
          if (c.tid == 0) { __builtin_amdgcn_fence(__ATOMIC_RELEASE, "agent"); asm volatile("s_waitcnt vmcnt(0)" ::: "memory");
              (void)__hip_atomic_fetch_add((unsigned*)(a.ws + WS_CTL) + CW_MLDONE, (unsigned)nu, __ATOMIC_RELAXED, __HIP_MEMORY_SCOPE_AGENT); } } }
#endif
    unsigned* ctl = (unsigned*)(a.ws + WS_CTL);
    const int x = (int)(__builtin_amdgcn_s_getreg((3 << 11) | 20) & 7u);
    float cshift;
    { const int ln_ = fresh_lane(c.tid); float gq = fabsf(a.in[IN_GQ][ln_]), gk = fabsf(a.in[IN_GK][ln_]);
#pragma unroll
      for (int o = 1; o < 64; o <<= 1) { gq = fmaxf(gq, __shfl_xor(gq, o)); gk = fmaxf(gk, __shfl_xor(gk, o)); }
      cshift = 8.0f * 1.4426950408889634f * gq * gk; }
#pragma unroll 1
    for (int rot = 0; rot < 8 * DBG_REP_ATT; ++rot) { rep = rot >> 3; const int bq = (x + rot) & 7;
        if (c.tid == 0) MISC[16] = __hip_atomic_fetch_add(ctl + CW_Q + 512 * rep + 64 * bq, 1u, RLX_AGENT);
        __syncthreads();
        int u = (int)MISC[16];
        __syncthreads();
#pragma unroll 1
        while (u < 128) {
            unsigned nxt = 0u;
            if (c.tid == 0) nxt = __hip_atomic_fetch_add(ctl + CW_Q + 512 * rep + 64 * bq, 1u, RLX_AGENT);
#if !defined(NO_ATTN)
            attn_unit(a, c, bq, 127 - u, cshift);
#endif
            if (c.tid == 0) MISC[16] = nxt;
            __syncthreads();
            u = (int)MISC[16];
            __syncthreads();
        } }
}
constexpr int RT_WT = 0;
constexpr int RT_WROWB = 2064;
constexpr int RT_IMG = 36 * RT_WROWB;
constexpr int RT_WBYTES = 2 * RT_IMG;
constexpr int RT_NPIECE = (RT_WBYTES + 1023) / 1024;
constexpr int RT_LG = 0;
constexpr int RT_RSTD = RT_NPIECE * 1024;
constexpr int RT_LCNT = RT_RSTD + 512;
constexpr int RT_BIAS = RT_LCNT + 128;
static_assert(RT_BIAS + 144 <= MISC_OFF, "router LDS map");
__device__ __forceinline__ const bf16* x1_row(const Args& a, int t) {
    return (t < X1B_SPLIT_ROWS) ? (const bf16*)(a.ws + WS_X1A) + (size_t)t * D : (const bf16*)(a.ws + WS_X1B) + (size_t)(t - X1B_SPLIT_ROWS) * D; }
__device__ __forceinline__ void p6_router(const Args& a, const Ctx& c) {
    const int tid = c.tid, wave = c.wave; LAS unsigned char* lds = c.lds;
    int tv_ = tid; asm volatile("" : "+v"(tv_)); const int lane = tv_ & 63;
    LAS float* LG = (LAS float*)(lds + RT_LG); LAS float* RSTD = (LAS float*)(lds + RT_RSTD); LAS int* LCNT = (LAS int*)(lds + RT_LCNT); LAS float* BIAS = (LAS float*)(lds + RT_BIAS);
    { int* RT = (int*)(a.ws + WS_ROWTOK); float* RR = (float*)(a.ws + WS_ROWRS); for (int i = blockIdx.x * 512 + tid; i < NROWS_MAX; i += c.G * 512) { RT[i] = 0; RR[i] = 0.f; } }
    if (tid < 36) BIAS[tid] = tid < 32 ? a.in[IN_BRE][tid] : a.in[IN_BRG][tid - 32];
    float* RSG = (float*)(a.ws + WS_RSTDG);
    int* TOKE = (int*)(a.ws + WS_TOKE); int* TOKR = (int*)(a.ws + WS_TOKR); float* TOKG = (float*)(a.ws + WS_TOKG); int* CNT = (int*)(a.ws + WS_CNT);
    for (int blk = blockIdx.x; blk < 256; blk += c.G) {
        __syncthreads();
        { const unsigned char* src = a.ws + WS_WTG;
#pragma unroll 1
          for (int pc = wave; pc < RT_NPIECE; pc += NWAVES)
              __builtin_amdgcn_global_load_lds((const unsigned*)(src + (size_t)pc * 1024 + lane * 16), (LAS unsigned*)(lds + RT_WT + pc * 1024), 16, 0, 0); }
        if (tid < 32) LCNT[tid] = 0;
        f32x4 acc[3]; float sq_ = 0.f;
#pragma unroll
        for (int ct = 0; ct < 3; ++ct) acc[ct] = (f32x4){0.f, 0.f, 0.f, 0.f};
        { const int row = lane & 15, kq = lane >> 4;
          const bf16x8* ap = (const bf16x8*)(x1_row(a, blk * 128 + wave * 16 + row) + 8 * kq);
          const int r2 = (32 + row < 35) ? 32 + row : 35;
          const LAS unsigned char* bp0 = lds + RT_WT + row * RT_WROWB + 16 * kq; const LAS unsigned char* bp1 = lds + RT_WT + (16 + row) * RT_WROWB + 16 * kq; const LAS unsigned char* bp2 = lds + RT_WT + r2 * RT_WROWB + 16 * kq;
#define RT_LOADA(dst_, b_) do { _Pragma("unroll") for (int i_ = 0; i_ < 8; ++i_) dst_[i_] = ap[4 * (8 * ((b_) < 4 ? (b_) : 3) + i_)]; } while (0)
#define RT_SQ(w_) do { const unsigned u_ = (unsigned)(w_); const float lo_ = __uint_as_float(u_ << 16), hi_ = __uint_as_float(u_ & 0xffff0000u); sq_ = __builtin_fmaf(lo_, lo_, sq_); sq_ = __builtin_fmaf(hi_, hi_, sq_); } while (0)
#define RT_MMA(src_, b_) do { _Pragma("unroll") for (int i_ = 0; i_ < 8; ++i_) { const int ko_ = 64 * (8 * (b_) + i_); \
              const bf16x8 h0 = *(const LAS bf16x8*)(bp0 + ko_), h1 = *(const LAS bf16x8*)(bp1 + ko_), h2 = *(const LAS bf16x8*)(bp2 + ko_); \
              const bf16x8 l0 = *(const LAS bf16x8*)(bp0 + RT_IMG + ko_), l1 = *(const LAS bf16x8*)(bp1 + RT_IMG + ko_), l2 = *(const LAS bf16x8*)(bp2 + RT_IMG + ko_); \
              acc[0] = MFMA16(src_[i_], h0, acc[0]); acc[1] = MFMA16(src_[i_], h1, acc[1]); acc[2] = MFMA16(src_[i_], h2, acc[2]); \
              acc[0] = MFMA16(src_[i_], l0, acc[0]); acc[1] = MFMA16(src_[i_], l1, acc[1]); acc[2] = MFMA16(src_[i_], l2, acc[2]); \
              { const v4u w_ = __builtin_bit_cast(v4u, src_[i_]); RT_SQ(w_.x); RT_SQ(w_.y); RT_SQ(w_.z); RT_SQ(w_.w); } } } while (0)
          bf16x8 aA[8], aB[8]; RT_LOADA(aA, 0);
          asm volatile("s_waitcnt vmcnt(0)" ::: "memory");
          __syncthreads();
#pragma unroll 1
          for (int bb = 0; bb < 4; bb += 2) { RT_LOADA(aB, bb + 1); __builtin_amdgcn_sched_barrier(0); RT_MMA(aA, bb); __builtin_amdgcn_sched_barrier(0); RT_LOADA(aA, bb + 2); __builtin_amdgcn_sched_barrier(0); RT_MMA(aB, bb + 1); __builtin_amdgcn_sched_barrier(0); }
#undef RT_LOADA
#undef RT_SQ
#undef RT_MMA
        }
        __syncthreads();
        { const int col = lane & 15, kq = lane >> 4;
#pragma unroll
          for (int ct = 0; ct < 2; ++ct) {
#pragma unroll
              for (int r = 0; r < 4; ++r) LG[(wave * 16 + 4 * kq + r) * 36 + 16 * ct + col] = acc[ct][r]; }
          if (col < 4) {
#pragma unroll
              for (int r = 0; r < 4; ++r) LG[(wave * 16 + 4 * kq + r) * 36 + 32 + col] = acc[2][r]; }
          { float v = sq_; v += __shfl_xor(v, 16); v += __shfl_xor(v, 32);
            if (kq == 0) { const float sv = rsqrtf(v * (1.f / D) + EPS); RSTD[wave * 16 + col] = sv; RSG[blk * 128 + wave * 16 + col] = sv; } } }
        __syncthreads();
        if (tid < 128) { const int row = tid, t = blk * 128 + row; const float rs = RSTD[row]; const LAS float* lg = LG + tid * 36;
            float gl[4];
#pragma unroll
            for (int i = 0; i < 4; ++i) gl[i] = rs * lg[32 + i] + BIAS[32 + i];
            int gs = 0; float gmax = gl[0];
#pragma unroll
            for (int i = 1; i < 4; ++i) if (gl[i] > gmax) { gmax = gl[i]; gs = i; }
            float gsum = 0.f;
#pragma unroll
            for (int i = 0; i < 4; ++i) gsum += expf(gl[i] - gmax);
            const float gtop = 1.0f / gsum;
            float ev[8];
#pragma unroll
            for (int i = 0; i < 8; ++i) ev[i] = rs * lg[gs * 8 + i] + BIAS[gs * 8 + i];
            int l0 = 0; float v0 = ev[0];
#pragma unroll
            for (int i = 1; i < 8; ++i) if (ev[i] > v0) { v0 = ev[i]; l0 = i; }
            int l1 = -1; float v1 = -3.0e38f;
#pragma unroll
            for (int i = 0; i < 8; ++i) if (i != l0 && ev[i] > v1) { v1 = ev[i]; l1 = i; }
            const float e1 = expf(v1 - v0), s0 = 1.0f / (1.0f + e1), s1 = e1 * s0;
            const int ex0 = gs * 8 + l0, ex1 = gs * 8 + l1;
            const int rk0 = __hip_atomic_fetch_add(&LCNT[ex0], 1, __ATOMIC_RELAXED, __HIP_MEMORY_SCOPE_WORKGROUP);
            const int rk1 = __hip_atomic_fetch_add(&LCNT[ex1], 1, __ATOMIC_RELAXED, __HIP_MEMORY_SCOPE_WORKGROUP);
            TOKE[2 * t] = ex0; TOKE[2 * t + 1] = ex1; TOKR[2 * t] = rk0; TOKR[2 * t + 1] = rk1; TOKG[2 * t] = s0 * gtop; TOKG[2 * t + 1] = s1 * gtop; }
        __syncthreads();
        if (tid < 32) CNT[blk * 32 + tid] = LCNT[tid];
    }
}
__device__ __forceinline__ void p7_gather(const Args& a, const Ctx& c) {
    const int tid = c.tid, lane = fresh_lane(c.tid), wave = c.wave;
    LAS int* PART = (LAS int*)c.lds; LAS int* PPRE = PART + 512; LAS int* TOT = PPRE + 512; LAS int* TS = TOT + 32; LAS int* BASE = TS + 64;
    const int* CNT = (const int*)(a.ws + WS_CNT); const int* TOKE = (const int*)(a.ws + WS_TOKE); const int* TOKR = (const int*)(a.ws + WS_TOKR); int* TOKP = (int*)(a.ws + WS_TOKP);
    int* RT = (int*)(a.ws + WS_ROWTOK); float* RR = (float*)(a.ws + WS_ROWRS); const float* RSG = (const float*)(a.ws + WS_RSTDG);
    { const int e = tid & 31, p = tid >> 5; int s = 0; for (int k = 0; k < 16; ++k) s += CNT[(16 * p + k) * 32 + e]; PART[p * 32 + e] = s; }
    __syncthreads();
    if (tid < 32) { int run = 0; for (int p = 0; p < 16; ++p) { PPRE[p * 32 + tid] = run; run += PART[p * 32 + tid]; } TOT[tid] = run; }
    __syncthreads();
    if (tid == 0) { int ts = 0; for (int e = 0; e < 32; ++e) { TS[e] = ts; ts += (TOT[e] + 255) >> 8; } TS[32] = ts; }
    __syncthreads();
    if (blockIdx.x == 0 && tid < 33) ((int*)(a.ws + WS_SMALL))[tid] = TS[tid];
    for (int blk = blockIdx.x; blk < 256; blk += c.G) {
        if (tid < 32) { int s = TS[tid] * 256 + PPRE[(blk >> 4) * 32 + tid]; for (int b2 = (blk & ~15); b2 < blk; ++b2) s += CNT[b2 * 32 + tid]; BASE[tid] = s; }
        __syncthreads();
        { const int t = blk * 128 + (tid >> 2), jj = tid & 3;
          if (jj < 2) { const int pos = BASE[TOKE[2 * t + jj]] + TOKR[2 * t + jj]; TOKP[2 * t + jj] = pos;
              RT[pos] = (t < X1B_SPLIT_ROWS) ? (int)((WS_X1A - WS_X1B) / 2048) + t : t - X1B_SPLIT_ROWS; RR[pos] = RSG[t]; } }
        __syncthreads();
    }
}
__device__ __forceinline__ void p10_combine(const Args& a, const Ctx& c) {
    const int lane = fresh_lane(c.tid), gw = c.vcu * NWAVES + c.wave, NGW = c.G * NWAVES;
    const int* TOKP = (const int*)(a.ws + WS_TOKP); const float* TOKG = (const float*)(a.ws + WS_TOKG); const bf16* Y = (const bf16*)(a.ws + WS_Y);
    for (int t0 = gw; t0 < T; t0 += 2 * NGW) {
        const int tA = t0, tB = (t0 + NGW < T) ? t0 + NGW : t0; const bool hasB = (t0 + NGW < T);
        const int pA0 = TOKP[2 * tA], pA1 = TOKP[2 * tA + 1], pB0 = TOKP[2 * tB], pB1 = TOKP[2 * tB + 1];
        const float gA0 = TOKG[2 * tA], gA1 = TOKG[2 * tA + 1], gB0 = TOKG[2 * tB], gB1 = TOKG[2 * tB + 1];
        v2u xa[4], xb[4]; v2u ya0[4], ya1[4], yb0[4], yb1[4]; const bf16* xrA = x1_row(a, tA); const bf16* xrB = x1_row(a, tB);
#pragma unroll
        for (int j = 0; j < 4; ++j) { const int cc = 4 * lane + 256 * j;
            xa[j] = __builtin_nontemporal_load((const v2u*)(xrA + cc)); xb[j] = __builtin_nontemporal_load((const v2u*)(xrB + cc));
            ya0[j] = __builtin_nontemporal_load((const v2u*)(Y + (size_t)pA0 * D + cc)); ya1[j] = __builtin_nontemporal_load((const v2u*)(Y + (size_t)pA1 * D + cc));
            yb0[j] = __builtin_nontemporal_load((const v2u*)(Y + (size_t)pB0 * D + cc)); yb1[j] = __builtin_nontemporal_load((const v2u*)(Y + (size_t)pB1 * D + cc)); }
#pragma unroll
        for (int j = 0; j < 4; ++j) { const int cc = 4 * lane + 256 * j; f32x4 x = {bf2f(xa[j].x & 0xffffu), __uint_as_float(xa[j].x & 0xffff0000u), bf2f(xa[j].y & 0xffffu), __uint_as_float(xa[j].y & 0xffff0000u)};
            x[0] += gA0 * bf2f(ya0[j].x & 0xffffu) + gA1 * bf2f(ya1[j].x & 0xffffu); x[1] += gA0 * bf2f(ya0[j].x >> 16) + gA1 * bf2f(ya1[j].x >> 16);
            x[2] += gA0 * bf2f(ya0[j].y & 0xffffu) + gA1 * bf2f(ya1[j].y & 0xffffu); x[3] += gA0 * bf2f(ya0[j].y >> 16) + gA1 * bf2f(ya1[j].y >> 16);
            __builtin_nontemporal_store(x, (f32x4*)(a.out + (size_t)tA * D + cc)); }
        if (hasB) {
#pragma unroll
        for (int j = 0; j < 4; ++j) { const int cc = 4 * lane + 256 * j; f32x4 x = {bf2f(xb[j].x & 0xffffu), __uint_as_float(xb[j].x & 0xffff0000u), bf2f(xb[j].y & 0xffffu), __uint_as_float(xb[j].y & 0xffff0000u)};
            x[0] += gB0 * bf2f(yb0[j].x & 0xffffu) + gB1 * bf2f(yb1[j].x & 0xffffu); x[1] += gB0 * bf2f(yb0[j].x >> 16) + gB1 * bf2f(yb1[j].x >> 16);
            x[2] += gB0 * bf2f(yb0[j].y & 0xffffu) + gB1 * bf2f(yb1[j].y & 0xffffu); x[3] += gB0 * bf2f(yb0[j].y >> 16) + gB1 * bf2f(yb1[j].y >> 16);
            __builtin_nontemporal_store(x, (f32x4*)(a.out + (size_t)tB * D + cc)); } }
    }
}
__global__ void __launch_bounds__(NWAVES * 64, 2) hybrid_fwd(Args args) {
    extern __shared__ __attribute__((aligned(16))) unsigned char lds_raw[];
    Ctx c; c.lds = (LAS unsigned char*)lds_raw;
    volatile LAS unsigned* MISC = (volatile LAS unsigned*)(c.lds + MISC_OFF);
    c.tid = threadIdx.x; c.lane = c.tid & 63; c.wave = __builtin_amdgcn_readfirstlane(c.tid >> 6);
    c.G = gridDim.x; { const int bx = blockIdx.x; c.vcu = (c.G % 8 == 0) ? (bx % 8) * (c.G / 8) + bx / 8 : bx; }
    unsigned* ctl = (unsigned*)(args.ws + WS_CTL);
    if (c.tid < 128) MISC[c.tid] = 0u;
    __syncthreads();
    XcdBarrier bar; bar.bar = ctl + CW_BAR; bar.x = 0; bar.st = nullptr;
    if (N_LAUNCHES == 1) bar = xcd_barrier_post(ctl + CW_BAR, MISC + 8);
#define GRID_BAR() do { if (N_LAUNCHES == 1) xcd_barrier(bar); } while (0)
    const int lo = args.ph_lo, hi = args.ph_hi;
#ifndef PH_MASK
#define PH_MASK 0xfff
#endif
#ifdef DBG_TIME
    unsigned long long tprev_ = wall_clock64(), tdur_ = 0ull; const unsigned long long tstart_ = tprev_;
#define PH_STAMP(k) do { const unsigned long long tn_ = wall_clock64(); if ((k) == DBG_TIME) tdur_ = tn_ - tprev_; tprev_ = tn_; } while (0)
#else
#define PH_STAMP(k) do { } while (0)
#endif
#define IN(k) (((PH_MASK >> (k)) & 1) && lo <= (k) && (k) < hi)
#define BOTH(k) (IN(k) && IN((k) + 1))
    unsigned char* ws = args.ws; unsigned char* dout = (unsigned char*)args.out;
#ifndef DBG_REPEAT
#define DBG_REPEAT -1
#endif
#define REPS(k) (((k) == DBG_REPEAT) ? 2 : 1)
#if DBG_REPEAT == 5
#define RB5 _Pragma("unroll 1") for (int rep5 = 0; rep5 < 2; ++rep5) { if (rep5) GRID_BAR();
#define RE5 }
#else
#define RB5
#define RE5
#endif
#if DBG_REPEAT == 6
#define RB6 _Pragma("unroll 1") for (int rep6 = 0; rep6 < 2; ++rep6) { if (rep6) GRID_BAR();
#define RE6 }
#else
#define RB6
#define RE6
#endif
    if (IN(0)) { _Pragma("unroll") for (int rep = 0; rep < REPS(0); ++rep) { if (rep) GRID_BAR(); p0_prologue<0>(args, c, c.vcu * NWAVES + c.wave, c.G * NWAVES); } if (BOTH(0)) GRID_BAR(); PH_STAMP(0); }
    if (IN(1)) { _Pragma("unroll") for (int rep = 0; rep < REPS(1); ++rep) { if (rep) GRID_BAR();
#ifdef DBG_STAGGER
        if ((blockIdx.x >> 3) & 1) { const unsigned long long t0 = wall_clock64(); while (wall_clock64() - t0 < (unsigned long long)DBG_STAGGER) __builtin_amdgcn_s_sleep(16); }
#endif
        pg8::Gemm g{(const pg8::bf16_t*)(dout + DO_H), (const pg8::bf16_t*)(ws + WS_WIN), T, NPROJ, D}; pg8::StaticOrder S; S.init(T, NPROJ, c.G, (int)blockIdx.x);
        pg8::EpiBf16<0> E{(pg8::bf16_t*)(ws + WS_PROJ), 256, nullptr, 256, (size_t)T * 256, 1.f, TL_GA};
        pg8::gemm_phase<pg8::EpiBf16<0>, pg8::StaticOrder, true, true>(c.lds, g, S, E); }
        if (BOTH(1)) GRID_BAR(); PH_STAMP(1);
    }
#ifndef DBG_R2
#define DBG_R2 1
#endif
#ifndef DBG_R4A
#define DBG_R4A 1
#endif
#ifndef DBG_R4B
#define DBG_R4B 1
#endif
#ifndef DBG_R7
#define DBG_R7 1
#endif
    if (IN(2)) { _Pragma("unroll 1") for (int rep = 0; rep < DBG_R2; ++rep) { if (rep) GRID_BAR(); p2_prep(args, c); } if (BOTH(2)) GRID_BAR(); PH_STAMP(2); }
    if (IN(3)) { _Pragma("unroll") for (int rep = 0; rep < REPS(3); ++rep) { if (rep) GRID_BAR(); p3_mixer(args, c, MISC, rep); }
#ifdef DBG_TIME
        const unsigned long long t3a_ = wall_clock64();
#endif
        if (BOTH(3)) {
            if (c.tid == 0) { unsigned sp = 0u;
                while (xb_ld(ctl + CW_MLDONE) < 32u * (unsigned)REPS(3)) { __builtin_amdgcn_s_sleep(4); if (++sp > (1u << 22)) break; }
                __builtin_amdgcn_fence(__ATOMIC_ACQUIRE, "agent"); asm volatile("s_waitcnt vmcnt(0)" ::: "memory"); }
            __syncthreads(); }
        PH_STAMP(3);
#ifdef DBG_TIME
        if (DBG_TIME == 36) tdur_ = wall_clock64() - t3a_;
#endif
    }
    if (IN(4)) {
#pragma unroll 1
        for (int rep = 0; rep < DBG_R4A; ++rep) {
            const int gw = c.vcu * NWAVES + c.wave, ngw = c.G * NWAVES, kdone = ((int)blockIdx.x < 256) ? 24 : 0;
            LAS float* scr = (LAS float*)(c.lds + CV_SCR + c.wave * CV_SCRW);
            { const int ln_ = fresh_lane(c.tid);
#pragma unroll 1
            for (int k = kdone; gw + k * ngw < CV_NMI; ++k) { const CvItem it = cv_item(args, gw + k * ngw); f32x4 v[4]; float gq; cv_load(it, v, gq, ln_); cv_finish(it, v, gq, scr, ln_, true); } }
            __syncthreads(); }
#pragma unroll 1
        for (int rep = 0; rep < DBG_R4B; ++rep)
#pragma unroll 1
        for (int u = blockIdx.x; u < 256; u += c.G) mlstm_unit<1>(args, c, u >> 5, (u >> 3) & 3, u & 7);
        if (BOTH(4)) GRID_BAR(); PH_STAMP(4);
    }
    if (IN(5)) { RB5
#ifdef DBG_STAG5
        if ((blockIdx.x >> 3) & 1) { const unsigned long long t0 = wall_clock64(); while (wall_clock64() - t0 < (unsigned long long)DBG_STAG5) __builtin_amdgcn_s_sleep(16); }
#endif
        { pg8::Gemm g{(const pg8::bf16_t*)(dout + DO_YATT), (const pg8::bf16_t*)(ws + WS_WPA), T, D, 512, (const pg8::bf16_t*)(dout + DO_YML), (const pg8::bf16_t*)(ws + WS_WPM)};
          pg8::StaticOrder S; S.init(T, D, c.G, (int)blockIdx.x);
          pg8::EpiGate2 E{(pg8::bf16_t*)(ws + WS_MERGED), D, (const pg8::bf16_t*)(ws + WS_PROJ + (size_t)TL_GA * PROJ_TILE), (const pg8::bf16_t*)(ws + WS_PROJ + (size_t)TL_GM * PROJ_TILE), (size_t)T * 256};
          pg8::gemm_phase<pg8::EpiGate2, pg8::StaticOrder, true, true, true>(c.lds, g, S, E); } RE5
        if (BOTH(5)) GRID_BAR(); PH_STAMP(5);
    }
    if (IN(6)) { RB6
#ifdef DBG_STAG6
        if ((blockIdx.x >> 3) & 1) { const unsigned long long t0 = wall_clock64(); while (wall_clock64() - t0 < (unsigned long long)DBG_STAG6) __builtin_amdgcn_s_sleep(16); }
#endif
        pg8::Gemm g{(const pg8::bf16_t*)(ws + WS_MERGED), (const pg8::bf16_t*)(ws + WS_WOUT), T, D, D}; pg8::StaticOrder S; S.init(T, D, c.G, (int)blockIdx.x);
        pg8::EpiRes E{(pg8::bf16_t*)(args.ws + WS_X1A), (pg8::bf16_t*)(args.ws + WS_X1B), X1B_SPLIT_ROWS / 256, args.in[IN_X], D};
        pg8::gemm_phase<pg8::EpiRes, pg8::StaticOrder, true, true>(c.lds, g, S, E); RE6
        if (BOTH(6)) GRID_BAR(); PH_STAMP(6);
    }
    if (IN(7)) { _Pragma("unroll 1") for (int rep = 0; rep < DBG_R7; ++rep) { if (rep) { GRID_BAR(); } p6_router(args, c); } if (BOTH(7)) GRID_BAR(); PH_STAMP(7); }
    if (IN(8)) { _Pragma("unroll") for (int rep = 0; rep < REPS(8); ++rep) { if (rep) GRID_BAR(); p7_gather(args, c); } if (BOTH(8)) GRID_BAR(); PH_STAMP(8); }
    if (IN(9) || IN(10)) {
        LAS int* TSL = (LAS int*)(c.lds + MISC_OFF + 256);
        LAS int* XS = (LAS int*)(c.lds + MISC_OFF + 400);
        if (c.tid < 33) TSL[c.tid] = (int)__hip_atomic_load((unsigned*)(ws + WS_SMALL) + c.tid, RLX_AGENT);
        if (c.tid == 64) { const int ntt = (int)__hip_atomic_load((unsigned*)(ws + WS_SMALL) + 32, RLX_AGENT); int lo_t = 0, hi_t = ntt, nl = c.G, lx = (int)blockIdx.x;
            if (N_LAUNCHES == 1) { unsigned pre = 0u, mine = 0u;
                for (unsigned j = 0; j < 16; ++j) { const unsigned cj = xb_ld(&bar.bar[XB_XCNT(j)]); pre += (j < bar.x) ? cj : 0u; mine = (j == bar.x) ? cj : mine; }
                nl = (int)mine; lx = (int)MISC[20]; lo_t = (int)((long)ntt * pre / c.G); hi_t = (int)((long)ntt * (pre + mine) / c.G); }
            XS[0] = lo_t; XS[1] = hi_t; XS[2] = nl; XS[3] = lx; }
        __syncthreads();
        const int xs_lo = XS[0], xs_hi = XS[1], xs_nl = XS[2], xs_lx = XS[3];
        if (IN(9)) {
            pg8::MoeOrder<true> S{TSL, xs_nl, xs_lx, xs_lo, xs_hi, (const int*)(ws + WS_ROWTOK), (unsigned*)(ws + WS_CTL) + CW_RDY};
            pg8::Gemm g{(const pg8::bf16_t*)(ws + WS_X1B), (const pg8::bf16_t*)(ws + WS_GU), 0, 0, D};
            pg8::EpiSwiGLU E{(pg8::bf16_t*)(ws + WS_HID), (const float*)(ws + WS_ROWRS)};
            pg8::gemm_phase<pg8::EpiSwiGLU, pg8::MoeOrder<true>, true, true>(c.lds, g, S, E);
            if (BOTH(9)) __syncthreads();
        }
        if (IN(10)) {
            pg8::MoeOrder<false> S{TSL, xs_nl, xs_lx, xs_lo, xs_hi, nullptr, (unsigned*)(ws + WS_CTL) + CW_RDY};
            pg8::Gemm g{(const pg8::bf16_t*)(ws + WS_HID), (const pg8::bf16_t*)(ws + WS_DN), 0, 0, 512};
            pg8::EpiDown E{(pg8::bf16_t*)(ws + WS_Y)};
            pg8::gemm_phase<pg8::EpiDown, pg8::MoeOrder<false>, true, true>(c.lds, g, S, E);
            if (BOTH(10)) GRID_BAR(); PH_STAMP(10);
        }
    }
    if (IN(11)) p10_combine(args, c);
#ifdef DBG_TIME
    PH_STAMP(11);
    if (DBG_TIME == 99) tdur_ = wall_clock64() - tstart_;
    if (DBG_TIME >= 20 && DBG_TIME < 40 && DBG_TIME != 36) tdur_ = (unsigned long long)MISC[30];
    if (DBG_TIME == 98) tdur_ = 10000ull;
#ifndef DBG_WG
#define DBG_WG 0
#endif
    if (blockIdx.x == DBG_WG) { const unsigned long long t0_ = wall_clock64(); while (wall_clock64() - t0_ < tdur_) __builtin_amdgcn_s_sleep(8); }
#endif
#undef IN
#undef BOTH
#undef GRID_BAR
}

extern "C" void kernel_launch(void* const* d_in, const int* in_sizes, int n_in, void* d_out, int out_size, void* d_ws, size_t ws_size, hipStream_t stream) {
    static int grid = 0;
    if (grid == 0) {
        if (n_in != 22 || in_sizes[0] != T * D || out_size != T * D || ws_size < WS_END) { fprintf(stderr, "kernel_launch: unexpected shapes (n_in %d, in0 %d, out %d, ws %zu); nothing launched\n", n_in, n_in > 0 ? in_sizes[0] : -1, out_size, ws_size); grid = -1; return; }
        int dev = 0, cus = 0, per_cu = 0;
        if (hipGetDevice(&dev) != hipSuccess || hipDeviceGetAttribute(&cus, hipDeviceAttributeMultiprocessorCount, dev) != hipSuccess) { grid = -1; return; }
        if (hipFuncSetAttribute((const void*)hybrid_fwd, hipFuncAttributeMaxDynamicSharedMemorySize, LDS_BYTES) != hipSuccess) { fprintf(stderr, "kernel_launch: hipFuncSetAttribute failed\n"); grid = -1; return; }
        if (hipOccupancyMaxActiveBlocksPerMultiprocessor(&per_cu, (const void*)hybrid_fwd, NWAVES * 64, LDS_BYTES) != hipSuccess || per_cu < 1)
            fprintf(stderr, "kernel_launch: note: occupancy query reports %d workgroups per CU\n", per_cu);
        (void)hipGetLastError();
        grid = cus;
    }
    if (grid < 0) return;
    if (hipMemsetAsync((char*)d_ws + WS_CTL, 0, CTL_ZERO_BYTES, stream) != hipSuccess) return;
    Args a{};
    for (int i = 0; i < 22; ++i) a.in[i] = (const float*)d_in[i];
    a.out = (float*)d_out; a.ws = (unsigned char*)d_ws;
    for (int li = 0; li < N_LAUNCHES; ++li) {
        a.ph_lo = (N_LAUNCHES == 1) ? 0 : li; a.ph_hi = (N_LAUNCHES == 1) ? NPH : li + 1; a.li = li;
        hipLaunchKernelGGL(hybrid_fwd, dim3(grid), dim3(NWAVES * 64), LDS_BYTES, stream, a);
        if (hipPeekAtLastError() != hipSuccess) { fprintf(stderr, "kernel_launch: launch %d failed\n", li); break; }
    }
}
```
